# Optimizing an MI355X kernel written in HIP

```python
import functools
import jax, jax.numpy as jnp
from jax import lax
import numpy as np

D_MODEL = 2048
BATCH = 1
SEQ = 16384
DEPTH = 2
DEC_BATCH = 32
DEC_SEQ = 32
PAST_LEN = 4096

CHUNK = 64
N_BRANCH = 4
W_BR = 512
HEAD_DIM = 64
CONV_W = 31
N_HEADS_B = W_BR // HEAD_DIM
Q_BLOCK = 128
N_HEADS_C = W_BR // HEAD_DIM
LORA_W = 64
LORA_A = 64
SHIFT_W = 3 * W_BR + LORA_W + LORA_A
POOL_WINDOWS = (2, 4, 8, 16)
POOL_GROUPS = 4
POOL_GW = W_BR // POOL_GROUPS
POOL_MAX = 16
IN_A = 3 * W_BR
IN_B = 4 * W_BR + N_HEADS_B
IN_C = SHIFT_W + W_BR
IN_D = 2 * W_BR
IN_G = N_BRANCH * D_MODEL
IN_W = IN_A + IN_B + IN_C + IN_D + IN_G

RMS_EPS = 1e-6
LN_EPS = 1e-5
GN_EPS = 64e-5

kernel_name = "hybrid_stream_encoder_step"

F32 = jnp.float32


def rmsnorm(x, g):
    xf = x.astype(F32)
    y = xf * lax.rsqrt(jnp.mean(xf * xf, axis=-1, keepdims=True) + RMS_EPS)
    return (y * g.astype(F32)).astype(x.dtype)


def layernorm(x, g, b, eps):
    xf = x.astype(F32)
    mu = jnp.mean(xf, axis=-1, keepdims=True)
    var = jnp.mean(jnp.square(xf - mu), axis=-1, keepdims=True)
    return ((xf - mu) * lax.rsqrt(var + eps) * g.astype(F32) + b.astype(F32)).astype(x.dtype)


def conformer_conv(a_val, a_gate, conv_buf, conv_w, conv_b, ln_g, ln_b):
    glu = a_val * jax.nn.sigmoid(a_gate)
    z = jnp.concatenate([conv_buf.astype(glu.dtype), glu], axis=1)
    h = lax.conv_general_dilated(z, conv_w[:, None, :].astype(z.dtype), window_strides=(1,),
                                 padding='VALID', dimension_numbers=('NWC', 'WIO', 'NWC'),
                                 feature_group_count=W_BR) + conv_b
    h = jax.nn.silu(layernorm(h, ln_g, ln_b, LN_EPS))
    return h, z[:, -(CONV_W - 1):]


def fox_prompt(q, k, v, logf):
    T = q.shape[1]
    Ft = jnp.transpose(jnp.cumsum(logf, axis=1), (0, 2, 1))
    kpos = jnp.arange(T)
    scale = HEAD_DIM ** -0.5

    def block(i):
        s0 = i * Q_BLOCK
        qb = lax.dynamic_slice_in_dim(q, s0, Q_BLOCK, axis=1)
        Fq = lax.dynamic_slice_in_dim(Ft, s0, Q_BLOCK, axis=2)
        qpos = s0 + jnp.arange(Q_BLOCK)
        s = jnp.einsum('bqhd,bkhd->bhqk', qb, k, preferred_element_type=F32) * scale
        s = s + Fq[..., :, None] - Ft[..., None, :]
        s = jnp.where(kpos[None, :] <= qpos[:, None], s, -jnp.inf)
        p = jax.nn.softmax(s, axis=-1)
        return jnp.einsum('bhqk,bkhd->bqhd', p.astype(v.dtype), v)

    out = lax.map(block, jnp.arange(T // Q_BLOCK))
    return jnp.transpose(out, (1, 0, 2, 3, 4)).reshape(q.shape)


def fox_sample(q, k, v, logf, ck, cv, clogf):
    P, T = ck.shape[1], q.shape[1]
    k_all = jnp.concatenate([ck.astype(k.dtype), k], axis=1)
    v_all = jnp.concatenate([cv.astype(v.dtype), v], axis=1)
    F = jnp.cumsum(jnp.concatenate([clogf.astype(F32), logf], axis=1), axis=1)
    Ft = jnp.transpose(F, (0, 2, 1))
    s = jnp.einsum('bqhd,bkhd->bhqk', q, k_all, preferred_element_type=F32) * (HEAD_DIM ** -0.5)
    s = s + Ft[..., P:, None] - Ft[..., None, :]
    mask = jnp.arange(P + T)[None, :] <= (P + jnp.arange(T))[:, None]
    p = jax.nn.softmax(jnp.where(mask, s, -jnp.inf), axis=-1)
    return jnp.einsum('bhqk,bkhd->bqhd', p.astype(v_all.dtype), v_all)


def rwkv7(xc, shift_buf, S0, mu, w0, w2, a0, a2, k_k, k_a, r_k, gn_g, gn_b):
    B, T, _ = xc.shape
    prev = jnp.concatenate([shift_buf.astype(xc.dtype), xc[:, :-1]], axis=1)
    xs = xc + (prev - xc) * mu
    r, k, v, wl, al = jnp.split(xs, [W_BR, 2 * W_BR, 3 * W_BR, 3 * W_BR + LORA_W], axis=-1)
    w_log = -jax.nn.softplus(-(w0 + jnp.tanh(wl) @ w2).astype(F32)) - 0.5
    decay = jnp.exp(-jnp.exp(w_log))
    a = jax.nn.sigmoid((a0 + al @ a2).astype(F32))
    hs = lambda t: t.reshape(B, T, N_HEADS_C, HEAD_DIM).astype(F32)
    kk = hs(k * k_k)
    kk = kk * lax.rsqrt(jnp.maximum(jnp.sum(kk * kk, axis=-1, keepdims=True), 1e-24))
    k_mod = k.astype(F32) * (1.0 + (a - 1.0) * k_a.astype(F32))
    r_, k_, v_, a_, w_ = hs(r), hs(k_mod), hs(v), hs(a), hs(decay)

    def step(S, inp):
        rt, kt, vt, at, wt, kkt = inp
        sa = jnp.einsum('bhij,bhj->bhi', S, -kkt)
        S = (S * wt[:, :, None, :] + sa[..., None] * (kkt * at)[:, :, None, :]
             + vt[..., None] * kt[:, :, None, :])
        return S, jnp.einsum('bhij,bhj->bhi', S, rt)

    seq = tuple(jnp.moveaxis(t, 1, 0) for t in (r_, k_, v_, a_, w_, kk))
    S, y = lax.scan(step, S0.astype(F32), seq)
    y = jnp.moveaxis(y, 0, 1)
    ym = jnp.mean(y, axis=-1, keepdims=True)
    yv = jnp.mean(jnp.square(y - ym), axis=-1, keepdims=True)
    y = ((y - ym) * lax.rsqrt(yv + GN_EPS)).reshape(B, T, W_BR) * gn_g.astype(F32) + gn_b.astype(F32)
    bonus = jnp.sum(r_ * k_ * r_k.astype(F32), axis=-1, keepdims=True) * v_
    y = y + bonus.reshape(B, T, W_BR)
    return y.astype(xc.dtype), xc[:, -1:], S


def pool_mixer(u, pool_buf, pos0, pool_w, pool_b, pool_scale):
    B, T, _ = u.shape
    z = jnp.concatenate([pool_buf.astype(u.dtype), u], axis=1)
    cs = jnp.concatenate([jnp.zeros((B, 1, W_BR), F32), jnp.cumsum(z.astype(F32), axis=1)], axis=1)
    pos = pos0 + jnp.arange(T)
    means = []
    for g, w in enumerate(POOL_WINDOWS):
        sl = slice(g * POOL_GW, (g + 1) * POOL_GW)
        ssum = cs[:, POOL_MAX:POOL_MAX + T, sl] - cs[:, POOL_MAX - w:POOL_MAX - w + T, sl]
        cnt = jnp.minimum(w, pos + 1).astype(F32)[None, :, None]
        means.append(ssum / cnt)
    pooled = (jnp.concatenate(means, axis=-1) - u.astype(F32)).astype(u.dtype)
    h = jnp.einsum('btgc,gcd->btgd', pooled.reshape(B, T, POOL_GROUPS, POOL_GW), pool_w)
    h = (h.reshape(B, T, W_BR) + pool_b) * pool_scale
    return h, z[:, -(POOL_MAX - 1):]


def trunk_layer(x, c, pos0, attn_fn, conv_buf, shift_buf, wkv_state, pool_buf, p):
    B, T, _ = x.shape
    shift, scale, gate = jnp.split(jax.nn.silu(c) @ p['w_ada'] + p['b_ada'], 3, axis=-1)
    h = rmsnorm(x, p['norm_g']) * (1 + scale[:, None]) + shift[:, None]
    u = h @ p['w_in']
    uA, uB, uC, uD, uG = jnp.split(
        u, [IN_A, IN_A + IN_B, IN_A + IN_B + IN_C, IN_A + IN_B + IN_C + IN_D], axis=-1)
    a_val, a_gate, a_sg = jnp.split(uA, 3, axis=-1)
    o_a, conv_new = conformer_conv(a_val, a_gate, conv_buf, p['conv_w'], p['conv_b'],
                                   p['conv_ln_g'], p['conv_ln_b'])
    o_a = o_a * jax.nn.silu(a_sg)
    q, k, v, f, b_sg = jnp.split(uB, [W_BR, 2 * W_BR, 3 * W_BR, 3 * W_BR + N_HEADS_B], axis=-1)
    logf = jax.nn.log_sigmoid(f.astype(F32) + p['b_f'].astype(F32))
    hd = lambda t: t.reshape(B, T, N_HEADS_B, HEAD_DIM)
    q, k, v = hd(q), hd(k), hd(v)
    o_b = attn_fn(q, k, v, logf).reshape(B, T, W_BR) * jax.nn.silu(b_sg)
    xc, c_sg = jnp.split(uC, [SHIFT_W], axis=-1)
    o_c, shift_new, wkv_new = rwkv7(xc, shift_buf, wkv_state, p['rk_mu'], p['rk_w0'], p['rk_w2'],
                                    p['rk_a0'], p['rk_a2'], p['rk_kk'], p['rk_ka'], p['rk_rk'],
                                    p['rk_gn_g'], p['rk_gn_b'])
    o_c = o_c * jax.nn.silu(c_sg)
    d_in, d_sg = jnp.split(uD, 2, axis=-1)
    o_d, pool_new = pool_mixer(d_in, pool_buf, pos0, p['pool_w'], p['pool_b'], p['pool_scale'])
    o_d = o_d * jax.nn.silu(d_sg)
    gates = jnp.split(uG, N_BRANCH, axis=-1)
    merged = sum(jax.nn.sigmoid(g) * (o @ p['w_branch'][n])
                 for n, (o, g) in enumerate(zip((o_a, o_b, o_c, o_d), gates)))
    x = x + gate[:, None] * (merged @ p['w_out'])
    return x, (k, v, logf, conv_new, shift_new, wkv_new, pool_new)


def setup_inputs(seed: int = 0) -> dict:
    key = jax.random.key(seed)
    ks = iter(jax.random.split(key, 48))

    def nrm(shape, scale=1.0):
        return jax.random.normal(next(ks), shape, F32) * scale

    def unif(shape, lo, hi):
        return jax.random.uniform(next(ks), shape, F32, lo, hi)

    L = DEPTH
    return {
        "x_prompt": nrm((BATCH, SEQ, D_MODEL)),
        "x_sample": nrm((DEC_BATCH, DEC_SEQ, D_MODEL)),
        "cache_k": nrm((L, DEC_BATCH, PAST_LEN, N_HEADS_B, HEAD_DIM)),
        "cache_v": nrm((L, DEC_BATCH, PAST_LEN, N_HEADS_B, HEAD_DIM)),
        "cache_logf": jax.nn.log_sigmoid(2.5 + nrm((L, DEC_BATCH, PAST_LEN, N_HEADS_B), 0.5)),
        "state_conv": nrm((L, DEC_BATCH, CONV_W - 1, W_BR)),
        "state_shift": nrm((L, DEC_BATCH, 1, SHIFT_W)),
        "state_wkv": nrm((L, DEC_BATCH, N_HEADS_C, HEAD_DIM, HEAD_DIM), 0.1),
        "state_pool": nrm((L, DEC_BATCH, POOL_MAX - 1, W_BR)),
        "c_prompt": nrm((BATCH, D_MODEL)),
        "c_sample": nrm((DEC_BATCH, D_MODEL)),
        "norm_g": 1.0 + nrm((L, D_MODEL), 0.1),
        "w_ada": nrm((L, D_MODEL, 3 * D_MODEL), 0.5 * D_MODEL ** -0.5),
        "b_ada": nrm((L, 3 * D_MODEL), 0.1),
        "w_in": nrm((L, D_MODEL, IN_W), D_MODEL ** -0.5),
        "b_f": unif((L, N_HEADS_B), 1.0, 4.0),
        "conv_w": nrm((L, CONV_W, W_BR), CONV_W ** -0.5),
        "conv_b": nrm((L, W_BR), 0.01),
        "conv_ln_g": 1.0 + nrm((L, W_BR), 0.1),
        "conv_ln_b": nrm((L, W_BR), 0.01),
        "rk_mu": unif((L, SHIFT_W), 0.0, 1.0),
        "rk_w0": unif((L, W_BR), -3.0, 0.0),
        "rk_w2": nrm((L, LORA_W, W_BR), 0.5 * LORA_W ** -0.5),
        "rk_a0": nrm((L, W_BR), 0.1),
        "rk_a2": nrm((L, LORA_A, W_BR), 0.5 * LORA_A ** -0.5),
        "rk_kk": 0.85 + nrm((L, W_BR), 0.05),
        "rk_ka": 1.0 + nrm((L, W_BR), 0.05),
        "rk_rk": nrm((L, N_HEADS_C, HEAD_DIM), 0.1),
        "rk_gn_g": 1.0 + nrm((L, W_BR), 0.1),
        "rk_gn_b": nrm((L, W_BR), 0.01),
        "pool_w": nrm((L, POOL_GROUPS, POOL_GW, POOL_GW), POOL_GW ** -0.5),
        "pool_b": nrm((L, W_BR), 0.01),
        "pool_scale": 1.0 + nrm((L, W_BR), 0.1),
        "w_branch": nrm((L, N_BRANCH, W_BR, D_MODEL), W_BR ** -0.5),
        "w_out": nrm((L, D_MODEL, D_MODEL), D_MODEL ** -0.5),
        "final_g": 1.0 + nrm((D_MODEL,), 0.1),
    }


def reference(x_prompt, x_sample, cache_k, cache_v, cache_logf, state_conv, state_shift,
              state_wkv, state_pool, c_prompt, c_sample, norm_g, w_ada, b_ada, w_in, b_f,
              conv_w, conv_b, conv_ln_g, conv_ln_b, rk_mu, rk_w0, rk_w2, rk_a0, rk_a2, rk_kk,
              rk_ka, rk_rk, rk_gn_g, rk_gn_b, pool_w, pool_b, pool_scale, w_branch, w_out,
              final_g):
    dt = x_prompt.dtype
    bp = x_prompt.shape[0]
    past = cache_k.shape[2]
    conv0 = jnp.zeros((bp, CONV_W - 1, W_BR), dt)
    shift0 = jnp.zeros((bp, 1, SHIFT_W), dt)
    wkv0 = jnp.zeros((bp, N_HEADS_C, HEAD_DIM, HEAD_DIM), F32)
    pool0 = jnp.zeros((bp, POOL_MAX - 1, W_BR), dt)
    xp, xs = x_prompt, x_sample
    st_p, st_s = [], []
    for l in range(DEPTH):
        p = dict(norm_g=norm_g[l], w_ada=w_ada[l], b_ada=b_ada[l], w_in=w_in[l], b_f=b_f[l],
                 conv_w=conv_w[l], conv_b=conv_b[l], conv_ln_g=conv_ln_g[l], conv_ln_b=conv_ln_b[l],
                 rk_mu=rk_mu[l], rk_w0=rk_w0[l], rk_w2=rk_w2[l], rk_a0=rk_a0[l], rk_a2=rk_a2[l],
                 rk_kk=rk_kk[l], rk_ka=rk_ka[l], rk_rk=rk_rk[l], rk_gn_g=rk_gn_g[l],
                 rk_gn_b=rk_gn_b[l], pool_w=pool_w[l], pool_b=pool_b[l], pool_scale=pool_scale[l],
                 w_branch=w_branch[l], w_out=w_out[l])
        xp, sp = trunk_layer(xp, c_prompt, 0, fox_prompt, conv0, shift0, wkv0, pool0, p)
        attn_s = functools.partial(fox_sample, ck=cache_k[l], cv=cache_v[l], clogf=cache_logf[l])
        xs, ss = trunk_layer(xs, c_sample, past, attn_s, state_conv[l], state_shift[l],
                             state_wkv[l], state_pool[l], p)
        st_p.append(sp)
        st_s.append(ss)
    y_prompt = rmsnorm(xp, final_g)
    y_sample = rmsnorm(xs, final_g)
    p_k, p_v, p_logf, p_conv, p_shift, p_wkv, p_pool = [jnp.stack(t) for t in zip(*st_p)]
    s_k, s_v, s_logf, s_conv, s_shift, s_wkv, s_pool = [jnp.stack(t) for t in zip(*st_s)]
    return (y_prompt, y_sample, p_k, p_v, p_logf, p_conv, p_shift, p_wkv, p_pool,
            s_k, s_v, s_logf, s_conv, s_shift, s_wkv, s_pool)
```

```cpp
#include <hip/hip_runtime.h>
#include <cstdio>
#include <cstdint>
namespace pg8 {
#define PG8_LAS __attribute__((address_space(3)))
typedef unsigned short bf16_t;
typedef short bf16x8 __attribute__((ext_vector_type(8)));
typedef float f32x4 __attribute__((ext_vector_type(4)));
typedef unsigned u32x4 __attribute__((ext_vector_type(4)));
constexpr int BM = 256, BK = 64, HALF = 128, HTB = HALF * BK * 2  , STAGE_BYTES = 8 * HTB, NXCD = 8, WGM = 8;

__host__ __device__ __forceinline__ int lds_byte(int r, int c) { const int st = (r >> 4) * 2 + (c >> 5), rr = r & 15, cc = c & 31, ob = rr * 64 + cc * 2; return st * 1024 + (ob ^ (((ob >> 9) & 1) << 5)); }
__host__ __device__ __forceinline__ void stage_rc(int b, int& R, int& C) { const int st = b / 1024, sb = b % 1024, swz = sb ^ (((sb >> 9) & 1) << 5); R = (st >> 1) * 16 + swz / 64; C = (st & 1) * 32 + (swz % 64) / 2; }
__host__ __device__ __forceinline__ int perm32(int rho) { const int n = rho >> 4, i = rho & 15; return 8 * (i >> 2) + 4 * n + (i & 3); }

struct Unit { int pm, pn; };
struct Gemm { const bf16_t* A; const bf16_t* Bt; int M, N, K; };

struct StaticOrder {
    int nM, nN, nwg, G, c;
    __host__ __device__ void init(int M, int N, int G_, int c_) { nM = M / BM; nN = N / BM; nwg = nM * nN; G = G_; c = c_; }
    __host__ __device__ bool next(int i, Unit& u) const {
        const long L = (long)i * G + c; if (L >= nwg) return false;
        int wgid = (int)L; { const int q = nwg / NXCD, r = nwg % NXCD, xcd = wgid % NXCD, off = wgid / NXCD; wgid = (xcd < r ? xcd * (q + 1) : r * (q + 1) + (xcd - r) * q) + off; }
        const int nig = WGM * nN, gid = wgid / nig, fm = gid * WGM, gsz = (nM - fm) < WGM ? (nM - fm) : WGM;
        u.pm = fm + ((wgid % nig) % gsz); u.pn = (wgid % nig) / gsz; return true;
    }
    __device__ __forceinline__ void a_ready(const Unit&) const {}
    __device__ __forceinline__ void done(const Unit&) const {}
};
__device__ __forceinline__ unsigned cvt_pk_bf16(float lo, float hi) { unsigned r; asm volatile("v_cvt_pk_bf16_f32 %0, %1, %2" : "=v"(r) : "v"(lo), "v"(hi)); return r; }
typedef float f32x2 __attribute__((ext_vector_type(2)));
template <class Epi, class Sched, bool STAMP = false>
__device__ __forceinline__ void gemm_phase(PG8_LAS unsigned char* lds, const Gemm g, const Sched& S, const Epi& E, unsigned long long* stamps) {
    int tid = threadIdx.x; asm volatile("" : "+v"(tid));
    const int wid = __builtin_amdgcn_readfirstlane(tid >> 6), lane = tid & 63, wr = wid >> 2, wc = wid & 3, fr = lane & 15, fq = lane >> 4;
    const int K = g.K, nt = K / BK;
    int ts_lo = 0, ts_hi = 0, nts = 0; const unsigned long long rt_entry = STAMP ? (unsigned long long)wall_clock64() : 0ull;
#define PG8_STAMP() do { if (STAMP && wid == 0 && nts < 64) { const unsigned long long _c = (unsigned long long)clock64(); \
        ts_lo = (lane == nts) ? (int)(unsigned)_c : ts_lo; ts_hi = (lane == nts) ? (int)(unsigned)(_c >> 32) : ts_hi; ++nts; } } while (0)
    PG8_STAMP();
    unsigned voffA[2], voffB[2];
#pragma unroll
    for (int i = 0; i < 2; ++i) { int R, C; stage_rc(tid * 16 + i * 8192, R, C); const int Rb = Epi::PERM ? ((R & ~31) + perm32(R & 31)) : R;
        voffA[i] = (unsigned)(R * K + C) * 2u; voffB[i] = (unsigned)(Rb * K + C) * 2u; }
    const size_t kstep = (size_t)(BK * 2);
    const size_t hstep = (size_t)HALF * K * 2;
    const size_t tstep = 2 * hstep;
    const unsigned ldsw = (unsigned)wid * 1024u;
    const int aoff = lds_byte(wr * 64 + fr, fq * 8), boff = lds_byte(wc * 32 + fr, fq * 8);
#define PG8_SA(b, h) (((b) * 2 + (h)) * HTB)
#define PG8_SB(b, h) ((4 + (b) * 2 + (h)) * HTB)
#define PG8_STAGE(bufoff, gbase, voff) do { _Pragma("unroll") for (int _i = 0; _i < 2; ++_i) \
        __builtin_amdgcn_global_load_lds((const unsigned*)((const char*)(gbase) + (voff)[_i]), (PG8_LAS unsigned*)(lds + (bufoff) + ldsw + _i * 8192), 16, 0, 0); } while (0)
#define PG8_LDA(dst, b, h) do { _Pragma("unroll") for (int m = 0; m < 4; ++m) _Pragma("unroll") for (int k = 0; k < 2; ++k) dst[m][k] = *(const PG8_LAS bf16x8*)(lds + PG8_SA(b, h) + aoff + m * 2048 + k * 1024); } while (0)
#define PG8_LDB(dst, b, h) do { _Pragma("unroll") for (int n = 0; n < 2; ++n) _Pragma("unroll") for (int k = 0; k < 2; ++k) dst[n][k] = *(const PG8_LAS bf16x8*)(lds + PG8_SB(b, h) + boff + n * 2048 + k * 1024); } while (0)
#define PG8_MMA(ai, bj, At, Bt) do { __builtin_amdgcn_s_setprio(1); _Pragma("unroll") for (int m = 0; m < 4; ++m) _Pragma("unroll") for (int n = 0; n < 2; ++n) _Pragma("unroll") for (int k = 0; k < 2; ++k) \
        acc[ai][bj][m][n] = __builtin_amdgcn_mfma_f32_16x16x32_bf16(Bt[n][k], At[m][k], acc[ai][bj][m][n], 0, 0, 0); __builtin_amdgcn_s_setprio(0); } while (0)
#define PG8_WAIT_V(n) asm volatile("s_waitcnt vmcnt(" #n ")" ::: "memory")
#define PG8_WAIT_L(n) asm volatile("s_waitcnt lgkmcnt(" #n ")" ::: "memory")
#define PG8_BAR __builtin_amdgcn_s_barrier()
#define PG8_SCHED __builtin_amdgcn_sched_barrier(0)
    Unit cur, nxt; int ui = 0;
    if (!S.next(0, cur)) return;
    f32x4 acc[2][2][4][2];
#pragma unroll
    for (int a = 0; a < 2; ++a)
#pragma unroll
        for (int b = 0; b < 2; ++b)
#pragma unroll
            for (int m = 0; m < 4; ++m)
#pragma unroll
                for (int n = 0; n < 2; ++n) acc[a][b][m][n] = (f32x4){0.f, 0.f, 0.f, 0.f};
    bf16x8 At[4][2], B0[2][2], B1[2][2];
    const char* cA = (const char*)g.A + (size_t)cur.pm * tstep; const char* cB = (const char*)g.Bt + (size_t)cur.pn * tstep;
    S.a_ready(cur);
    PG8_STAGE(PG8_SB(0, 0), cB, voffB); PG8_STAGE(PG8_SA(0, 0), cA, voffA); PG8_STAGE(PG8_SB(0, 1), cB + hstep, voffB); PG8_STAGE(PG8_SA(0, 1), cA + hstep, voffA);
    if (wr == 1) PG8_BAR;
    PG8_WAIT_V(4); PG8_BAR;
    PG8_STAGE(PG8_SB(1, 0), cB + kstep, voffB); PG8_STAGE(PG8_SA(1, 0), cA + kstep, voffA); PG8_STAGE(PG8_SB(1, 1), cB + hstep + kstep, voffB);
    PG8_WAIT_V(6); PG8_BAR;
    PG8_STAMP();
    for (;;) {
        const bool has_next = S.next(ui + 1, nxt);
        const char* nA = has_next ? (const char*)g.A + (size_t)nxt.pm * tstep : cA; const char* nB = has_next ? (const char*)g.Bt + (size_t)nxt.pn * tstep : cB;
        for (int t = 0; t < nt; t += 2) {
            const bool last = (t == nt - 2);
            const char* a1 = cA + (size_t)(t + 1) * kstep;
            const char* a2 = last ? nA : cA + (size_t)(t + 2) * kstep; const char* b2 = last ? nB : cB + (size_t)(t + 2) * kstep;
            const char* a3 = a2 + kstep; const char* b3 = b2 + kstep;
            if (last && has_next) S.a_ready(nxt);
            PG8_LDB(B0, 0, 0); PG8_SCHED; PG8_LDA(At, 0, 0); PG8_STAGE(PG8_SA(1, 1), a1 + hstep, voffA);
            PG8_WAIT_L(8); PG8_BAR; PG8_WAIT_L(0); PG8_MMA(0, 0, At, B0); PG8_BAR; PG8_SCHED;
            PG8_LDB(B1, 0, 1); PG8_STAGE(PG8_SB(0, 0), b2, voffB);
            PG8_BAR; PG8_WAIT_L(0); PG8_MMA(0, 1, At, B1); PG8_BAR;
            PG8_LDA(At, 0, 1); PG8_STAGE(PG8_SA(0, 0), a2, voffA);
            PG8_BAR; PG8_WAIT_L(0); PG8_MMA(1, 0, At, B0); PG8_BAR; PG8_SCHED;
            PG8_STAGE(PG8_SB(0, 1), b2 + hstep, voffB);
            PG8_WAIT_V(6); PG8_BAR; PG8_MMA(1, 1, At, B1); PG8_BAR;
            PG8_LDB(B0, 1, 0); PG8_SCHED; PG8_LDA(At, 1, 0); PG8_STAGE(PG8_SA(0, 1), a2 + hstep, voffA);
            PG8_WAIT_L(8); PG8_BAR; PG8_WAIT_L(0); PG8_MMA(0, 0, At, B0); PG8_BAR; PG8_SCHED;
            PG8_LDB(B1, 1, 1); PG8_STAGE(PG8_SB(1, 0), b3, voffB);
            PG8_BAR; PG8_WAIT_L(0); PG8_MMA(0, 1, At, B1); PG8_BAR;
            PG8_LDA(At, 1, 1); PG8_STAGE(PG8_SA(1, 0), a3, voffA);
            PG8_BAR; PG8_WAIT_L(0); PG8_MMA(1, 0, At, B0); PG8_BAR; PG8_SCHED;
            PG8_STAGE(PG8_SB(1, 1), b3 + hstep, voffB);
            PG8_WAIT_V(6); PG8_BAR; PG8_MMA(1, 1, At, B1); PG8_BAR;
        }
        PG8_STAMP();
        if constexpr (!Epi::AFTER_DRAIN) { E(acc, cur, wr, wc, fr, fq); S.done(cur); }
        PG8_STAMP();
        if (!has_next) break;
#pragma unroll
        for (int a = 0; a < 2; ++a)
#pragma unroll
            for (int b = 0; b < 2; ++b)
#pragma unroll
                for (int m = 0; m < 4; ++m)
#pragma unroll
                    for (int n = 0; n < 2; ++n) acc[a][b][m][n] = (f32x4){0.f, 0.f, 0.f, 0.f};
        cur = nxt; cA = nA; cB = nB; ++ui;
    }
    PG8_WAIT_V(0);
    if (wr == 0) PG8_BAR;
    PG8_BAR;
    if constexpr (Epi::AFTER_DRAIN) { E.fused(acc, cur, wr, wc, fr, fq, lds, wid, lane); S.done(cur); }
    PG8_STAMP();
    if (STAMP && wid == 0) { stamps[lane] = lane < nts ? (((unsigned long long)(unsigned)ts_hi << 32) | (unsigned)ts_lo) : 0ull;
        if (lane == 62) stamps[62] = rt_entry; if (lane == 63) stamps[63] = (unsigned long long)wall_clock64(); }
#undef PG8_STAMP
#undef PG8_SA
#undef PG8_SB
#undef PG8_STAGE
#undef PG8_LDA
#undef PG8_LDB
#undef PG8_MMA
#undef PG8_WAIT_V
#undef PG8_WAIT_L
#undef PG8_BAR
#undef PG8_SCHED
}
}
#define XB_TMO      128
#define XB_XCNT(j)  (256  + 64 * (j))
#define XB_XSUB(j)  (1280 + 64 * (j))
#define XB_XGEN(j)  (2304 + 64 * (j))
#define XB_TOP      3328
#define XB_TOPGEN   3392
#define XCD_BAR_WORDS 3456
#define XB_SPIN_CAP (1u << 18)
#define LAS __attribute__((address_space(3)))

__device__ __forceinline__ unsigned xb_ld(unsigned* p)              { return __hip_atomic_load(p, __ATOMIC_RELAXED, __HIP_MEMORY_SCOPE_AGENT); }
__device__ __forceinline__ unsigned xb_add(unsigned* p, unsigned v) { return __hip_atomic_fetch_add(p, v, __ATOMIC_RELAXED, __HIP_MEMORY_SCOPE_AGENT); }
__device__ __forceinline__ unsigned xb_xcc_id() { return (unsigned)__builtin_amdgcn_s_getreg((3 << 11) | 20) & 0xFu; }
#define XB_SPIN(cond, bar) do { unsigned _sp = 0; while (cond) { __builtin_amdgcn_s_sleep(1); \
    if ((++_sp & 255u) == 0u) { if (xb_ld(&(bar)[XB_TMO])) break; if (_sp > XB_SPIN_CAP) { atomicAdd(&(bar)[XB_TMO], 1u); break; } } } } while (0)

struct XcdBarrier {
    unsigned* bar; unsigned x;
    volatile LAS unsigned* st;
};

__device__ __forceinline__ XcdBarrier xcd_barrier_post(unsigned* bar, volatile LAS unsigned* st) {
    XcdBarrier b; b.bar = bar; b.x = xb_xcc_id(); b.st = st;
    if (threadIdx.x == 0) (void)xb_add(&bar[XB_XCNT(b.x)], 1u);
    return b;
}
__device__ __forceinline__ void xcd_barrier_complete(unsigned* bar, unsigned x, unsigned& nloc, unsigned& nx) {
    const unsigned G = gridDim.x * gridDim.y * gridDim.z;
    unsigned sum, cnt, mine, sp = 0u;
    for (;;) {
        sum = 0u; cnt = 0u; mine = 0u;
#pragma unroll
        for (unsigned j = 0; j < 16; ++j) { const unsigned c = xb_ld(&bar[XB_XCNT(j)]); sum += c; cnt += (c > 0u) ? 1u : 0u; mine = (j == x) ? c : mine; }
        if (sum == G) break;
        __builtin_amdgcn_s_sleep(1);
        if ((++sp & 255u) == 0u) { if (xb_ld(&bar[XB_TMO])) break; if (sp > XB_SPIN_CAP) { atomicAdd(&bar[XB_TMO], 1u); break; } }
    }
    nloc = mine > 0u ? mine : 1u; nx = cnt > 0u ? cnt : 1u;
}

__device__ __forceinline__ void xcd_barrier(const XcdBarrier& b) {
    asm volatile("s_waitcnt vmcnt(0)" ::: "memory");
    __syncthreads();
    if (threadIdx.x == 0) {
        unsigned* bar = b.bar;
        __builtin_amdgcn_s_waitcnt(0);
        unsigned nloc = b.st[0], nx = b.st[1];
        if (nloc == 0u) { xcd_barrier_complete(bar, b.x, nloc, nx); b.st[0] = nloc; b.st[1] = nx; }
        const unsigned old = xb_add(&bar[XB_XSUB(b.x)], 1u);
        const unsigned gen = old / nloc;
        if (old + 1u == (gen + 1u) * nloc) {
            __builtin_amdgcn_fence(__ATOMIC_RELEASE, "agent");
            asm volatile("s_waitcnt vmcnt(0)" ::: "memory");
            const unsigned og = xb_add(&bar[XB_TOP], 1u);
            const unsigned tg = og / nx;
            if (og + 1u == (tg + 1u) * nx) xb_add(&bar[XB_TOPGEN], 1u);
            else XB_SPIN(xb_ld(&bar[XB_TOPGEN]) == tg, bar);
            __builtin_amdgcn_fence(__ATOMIC_ACQUIRE, "agent");
            xb_add(&bar[XB_XGEN(b.x)], 1u);
            asm volatile("s_waitcnt vmcnt(0)" ::: "memory");
        } else {
            XB_SPIN(xb_ld(&bar[XB_XGEN(b.x)]) == gen, bar);
            __builtin_amdgcn_fence(__ATOMIC_ACQUIRE, "agent");
            asm volatile("s_waitcnt vmcnt(0)" ::: "memory");
        }
    }
    __syncthreads();
}
typedef unsigned short bf16_t;
typedef short bf16x8 __attribute__((ext_vector_type(8)));
typedef float f32x4 __attribute__((ext_vector_type(4)));
typedef float f32x16 __attribute__((ext_vector_type(16)));
typedef unsigned u32x4 __attribute__((ext_vector_type(4)));
typedef unsigned u32x2 __attribute__((ext_vector_type(2)));
using pg8::cvt_pk_bf16;

constexpr int DM = 2048, TP = 16384, NSB = 32, TSQ = 32, NTOK = TP + NSB * TSQ, NSEQ = 33, PAST = 4096, NLAYER = 2;
constexpr int NU = 15104;
constexpr int U_AVAL = 0, U_AGATE = 512, U_ASG = 1024, U_Q = 1536, U_K = 2048, U_V = 2560, U_BSG = 3072, U_XC = 3584, U_CSG = 5248, U_DIN = 5760, U_DSG = 6272, U_G = 6784, U_F = 14976;
constexpr int IN_W = 14984, SHIFT_W = 1664;
constexpr float LOG2E = 1.4426950408889634f;
enum { I_XP = 0, I_XS, I_CK, I_CV, I_CLF, I_SCONV, I_SSHIFT, I_SWKV, I_SPOOL, I_CP, I_CS, I_NORMG, I_WADA, I_BADA, I_WIN, I_BF, I_CONVW, I_CONVB, I_CLNG, I_CLNB, I_MU, I_W0, I_W2, I_A0, I_A2,
       I_KK, I_KA, I_RK, I_GNG, I_GNB, I_POOLW, I_POOLB, I_POOLS, I_WBR, I_WOUT, I_FING, N_IN };
constexpr size_t O_YP = 0, O_YS = O_YP + (size_t)TP * DM, O_PK = O_YS + (size_t)1024 * DM, O_PV = O_PK + (size_t)2 * TP * 512, O_PLF = O_PV + (size_t)2 * TP * 512, O_PCONV = O_PLF + (size_t)2 * TP * 8,
                 O_PSHIFT = O_PCONV + 2 * 30 * 512, O_PWKV = O_PSHIFT + 2 * 1664, O_PPOOL = O_PWKV + 2 * 8 * 64 * 64, O_SK = O_PPOOL + 2 * 15 * 512, O_SV = O_SK + (size_t)2 * 1024 * 512,
                 O_SLF = O_SV + (size_t)2 * 1024 * 512, O_SCONV = O_SLF + 2 * 1024 * 8, O_SSHIFT = O_SCONV + (size_t)2 * 32 * 30 * 512, O_SWKV = O_SSHIFT + 2 * 32 * 1664,
                 O_SPOOL = O_SWKV + (size_t)2 * 32 * 8 * 64 * 64, O_END = O_SPOOL + (size_t)2 * 32 * 15 * 512;
static_assert(O_END == 75374848, "output size");
constexpr size_t al256(size_t x) { return (x + 255) & ~(size_t)255; }
constexpr int NCU_CH = 288, NRU = NCU_CH * 8;
constexpr size_t WS_CTL = 0, CTL_BYTES = 512 * 1024;
constexpr size_t WS_WIN = CTL_BYTES;
constexpr size_t WS_WBR = al256(WS_WIN + (size_t)2 * NU * 2048 * 2);
constexpr size_t WS_WOUT = al256(WS_WBR + (size_t)2 * 4 * 2048 * 512 * 2);
constexpr size_t WS_POOLW = al256(WS_WOUT + (size_t)2 * 2048 * 2048 * 2);
constexpr size_t WS_ADA = al256(WS_POOLW + (size_t)2 * 4 * 128 * 128 * 2);
constexpr size_t WS_H = al256(WS_ADA + (size_t)2 * 33 * 6144 * 4);
constexpr size_t WS_U = al256(WS_H + (size_t)NTOK * 2048 * 2);
constexpr size_t WS_XBUF = al256(WS_U + (size_t)NTOK * NU * 2);
constexpr size_t WS_OCAT = al256(WS_XBUF + (size_t)NTOK * 2048 * 4);
constexpr size_t WS_MG = al256(WS_OCAT + (size_t)4 * NTOK * 512 * 2);
constexpr size_t WS_MERGED = al256(WS_MG + (size_t)NTOK * 2048 * 4);
constexpr size_t WS_FP = al256(WS_MERGED + (size_t)NTOK * 2048 * 2);
constexpr int GS_LEN = PAST + TSQ;
constexpr size_t WS_GS = al256(WS_FP + (size_t)8 * TP * 4);
constexpr size_t WS_VT = al256(WS_GS + (size_t)32 * 8 * GS_LEN * 4);
constexpr size_t WS_TQ = al256(WS_VT + (size_t)8 * 64 * TP * 2);
constexpr size_t WS_GM = al256(WS_TQ + (size_t)NRU * 4096 * 4);
constexpr size_t WS_ET = al256(WS_GM + (size_t)NRU * 4096 * 4);
constexpr size_t WS_Y0T = al256(WS_ET + (size_t)NRU * 4096 * 4);
constexpr size_t WS_SC = al256(WS_Y0T + (size_t)NRU * 4096 * 4);
constexpr size_t WS_BONUS = al256(WS_SC + (size_t)NRU * 4096 * 4);
constexpr size_t WS_END = al256(WS_BONUS + (size_t)NRU * 64 * 4);
static_assert(WS_END < (size_t)2100 * 1024 * 1024, "workspace map exceeds the guaranteed d_ws size");
constexpr int CW_BAR = 0;
constexpr int CW_QUEUE = 16 * 3456 + 64;
static_assert((CW_QUEUE + 64 * 8) * 4 <= (int)CTL_BYTES, "ctl");
constexpr int LDS_BYTES = 163840 - 256;
constexpr int LDS_XB_OFF = LDS_BYTES - 16;
constexpr int SLOT_F = 64 * 65;

struct Params { const float* in[N_IN]; float* out; unsigned char* ws; int ph_lo, ph_hi, li, pad; };
typedef const __attribute__((address_space(4))) Params* KP;
__device__ __forceinline__ KP kp_fresh(KP k) { asm volatile("" : "+s"(k)); return k; }

__device__ __forceinline__ float bf2f(unsigned short b) { return __uint_as_float(((unsigned)b) << 16); }
__device__ __forceinline__ float bflo(unsigned w) { return __uint_as_float(w << 16); }
__device__ __forceinline__ float bfhi(unsigned w) { return __uint_as_float(w & 0xffff0000u); }
__device__ __forceinline__ unsigned short f2bf(float f) { return (unsigned short)(cvt_pk_bf16(f, 0.f) & 0xffffu); }
__device__ __forceinline__ float sigmoidf_(float x) { return 1.f / (1.f + __expf(-x)); }
__device__ __forceinline__ float siluf_(float x) { return x / (1.f + __expf(-x)); }
__device__ __forceinline__ float log_sigmoidf_(float z) { return fminf(z, 0.f) - log1pf(expf(-fabsf(z))); }
__device__ __forceinline__ float wave_sum(float v) {
#pragma unroll
    for (int o = 1; o < 64; o <<= 1) v += __shfl_xor(v, o);
    return v;
}
__device__ __forceinline__ void tr_tile(const float* __restrict__ src, size_t ld, int k0, int c0, int nvalid, bf16_t* __restrict__ dst, int K, LAS float* scr, int lane) {
#pragma unroll 8
    for (int kk = 0; kk < 64; ++kk) scr[kk * 65 + lane] = (lane < nvalid) ? src[(size_t)(k0 + kk) * ld + c0 + lane] : 0.f;
    const int k2 = (lane & 31) * 2, nh = lane >> 5;
#pragma unroll 8
    for (int it = 0; it < 32; ++it) { const int nn = 2 * it + nh; *(unsigned*)(dst + (size_t)nn * K + k0 + k2) = cvt_pk_bf16(scr[k2 * 65 + nn], scr[(k2 + 1) * 65 + nn]); }
}
__device__ __forceinline__ void p0_weights(KP p, LAS unsigned char* lds, int gw, int ngw, int wave, int lane) {
    LAS float* scr = (LAS float*)lds + wave * SLOT_F;
    constexpr int T_WIN = (NU / 64) * 32, T_WBR = 4 * 32 * 8, T_WOUT = 32 * 32, T_POOL = 4 * 2 * 2, T_L = T_WIN + T_WBR + T_WOUT + T_POOL;
    for (int it = gw; it < 2 * T_L; it += ngw) {
        const int l = it / T_L; int r = it % T_L;
        if (r < T_WIN) {
            const int nt = r / 32, kt = r % 32, m0 = nt * 64;
            int c0, nvalid = 64;
            if (m0 < 3072) c0 = m0; else if (m0 < U_F) c0 = m0 + 8; else if (m0 == U_F) { c0 = 3072; nvalid = 8; } else { c0 = 0; nvalid = 0; }
            tr_tile(p->in[I_WIN] + (size_t)l * 2048 * IN_W, IN_W, kt * 64, c0, nvalid, (bf16_t*)(p->ws + WS_WIN) + ((size_t)l * NU + m0) * 2048, 2048, scr, lane);
            continue; }
        r -= T_WIN;
        if (r < T_WBR) {
            const int n = r / 256, q = r % 256, nt = q / 8, kt = q % 8;
            tr_tile(p->in[I_WBR] + ((size_t)(l * 4 + n) * 512) * 2048, 2048, kt * 64, nt * 64, 64, (bf16_t*)(p->ws + WS_WBR) + ((size_t)(l * 4 + n) * 2048 + nt * 64) * 512, 512, scr, lane);
            continue; }
        r -= T_WBR;
        if (r < T_WOUT) {
            const int nt = r / 32, kt = r % 32;
            tr_tile(p->in[I_WOUT] + (size_t)l * 2048 * 2048, 2048, kt * 64, nt * 64, 64, (bf16_t*)(p->ws + WS_WOUT) + ((size_t)l * 2048 + nt * 64) * 2048, 2048, scr, lane);
            continue; }
        r -= T_WOUT;
        {
            const int g = r / 4, q = r % 4, nt = q / 2, kt = q % 2;
            tr_tile(p->in[I_POOLW] + (size_t)(l * 4 + g) * 128 * 128, 128, kt * 64, nt * 64, 64, (bf16_t*)(p->ws + WS_POOLW) + ((size_t)(l * 4 + g) * 128 + nt * 64) * 128, 128, scr, lane);
        }
    }
}
__device__ __forceinline__ void ada_unit(KP p, int unit, LAS unsigned char* lds, int tid) {
    const int wave = tid >> 6, lane = tid & 63, l = unit / 96, n0 = (unit % 96) * 64;
    LAS float* cs = (LAS float*)lds + wave * (33 * 64);
    LAS float* red = (LAS float*)lds + 8 * 33 * 64;
    const float* W = p->in[I_WADA] + (size_t)l * 2048 * 6144;
    const float* cp = p->in[I_CP]; const float* csm = p->in[I_CS];
    float acc[33];
#pragma unroll
    for (int s = 0; s < 33; ++s) acc[s] = 0.f;
    for (int ch = 0; ch < 4; ++ch) {
        const int k0 = wave * 256 + ch * 64;
#pragma unroll
        for (int s = 0; s < 33; ++s) { const float c = (s == 0) ? cp[k0 + lane] : csm[(size_t)(s - 1) * 2048 + k0 + lane]; cs[s * 64 + lane] = siluf_(c); }
        for (int kk = 0; kk < 64; kk += 4) {
            const float w0 = W[(size_t)(k0 + kk) * 6144 + n0 + lane], w1 = W[(size_t)(k0 + kk + 1) * 6144 + n0 + lane], w2 = W[(size_t)(k0 + kk + 2) * 6144 + n0 + lane], w3 = W[(size_t)(k0 + kk + 3) * 6144 + n0 + lane];
#pragma unroll
            for (int s = 0; s < 33; ++s) { const f32x4 c4 = *(const LAS f32x4*)(cs + s * 64 + kk); acc[s] += c4.x * w0 + c4.y * w1 + c4.z * w2 + c4.w * w3; }
        }
    }
#pragma unroll
    for (int s = 0; s < 33; ++s) red[(wave * 33 + s) * 64 + lane] = acc[s];
    __syncthreads();
    for (int idx = tid; idx < 33 * 64; idx += 512) { const int s = idx >> 6, n = idx & 63; float v = p->in[I_BADA][l * 6144 + n0 + n];
#pragma unroll
        for (int w = 0; w < 8; ++w) v += red[(w * 33 + s) * 64 + n];
        ((float*)(p->ws + WS_ADA))[((size_t)l * 33 + s) * 6144 + n0 + n] = v; }
    __syncthreads();
}
__device__ __forceinline__ const float* x_row(KP p, int l, int row) {
    return l == 0 ? (row < TP ? p->in[I_XP] + (size_t)row * DM : p->in[I_XS] + (size_t)(row - TP) * DM) : (const float*)(p->ws + WS_XBUF) + (size_t)row * DM;
}
__device__ __forceinline__ void p1_rows(KP p, int l, int gw, int ngw, int lane) {
    const f32x4* g4 = (const f32x4*)(p->in[I_NORMG] + l * DM) + lane;
    for (int row = gw; row < NTOK; row += ngw) {
        const f32x4* x4 = (const f32x4*)x_row(p, l, row) + lane;
        const int seq = row < TP ? 0 : 1 + ((row - TP) >> 5);
        const f32x4* sh4 = (const f32x4*)((const float*)(p->ws + WS_ADA) + ((size_t)l * 33 + seq) * 6144) + lane; const f32x4* sc4 = sh4 + 512;
        f32x4 v[8]; float ss = 0.f;
#pragma unroll
        for (int j = 0; j < 8; ++j) { v[j] = x4[64 * j]; ss += (v[j].x * v[j].x + v[j].y * v[j].y) + (v[j].z * v[j].z + v[j].w * v[j].w); }
        const float rstd = 1.f / sqrtf(wave_sum(ss) * (1.f / DM) + 1e-6f);
        u32x2* o = (u32x2*)((bf16_t*)(p->ws + WS_H) + (size_t)row * DM) + lane;
#pragma unroll
        for (int j = 0; j < 8; ++j) { const f32x4 g = g4[64 * j], sc = sc4[64 * j], sh = sh4[64 * j]; const f32x4 y = v[j] * rstd * g * (sc + 1.f) + sh;
            u32x2 w; w.x = cvt_pk_bf16(y.x, y.y); w.y = cvt_pk_bf16(y.z, y.w); o[64 * j] = w; }
    }
}
__device__ __forceinline__ void p_final_rows(KP p, int gw, int ngw, int lane) {
    const f32x4* g4 = (const f32x4*)p->in[I_FING] + lane;
    for (int row = gw; row < NTOK; row += ngw) {
        const f32x4* x4 = (const f32x4*)((const float*)(p->ws + WS_XBUF) + (size_t)row * DM) + lane;
        f32x4 v[8]; float ss = 0.f;
#pragma unroll
        for (int j = 0; j < 8; ++j) { v[j] = x4[64 * j]; ss += (v[j].x * v[j].x + v[j].y * v[j].y) + (v[j].z * v[j].z + v[j].w * v[j].w); }
        const float rstd = 1.f / sqrtf(wave_sum(ss) * (1.f / DM) + 1e-6f);
        f32x4* o = (f32x4*)(p->out + O_YP + (size_t)row * DM) + lane;
#pragma unroll
        for (int j = 0; j < 8; ++j) o[64 * j] = v[j] * rstd * g4[64 * j];
    }
}
struct EpiU {
    static constexpr bool PERM = true, AFTER_DRAIN = false;
    bf16_t* U; float* out; const float* bf; int l;
    __device__ __forceinline__ void operator()(const f32x4 (&acc)[2][2][4][2], const pg8::Unit& u, int wr, int wc, int fr, int fq) const {
        const int row0 = u.pm * 256 + wr * 64 + fr, col0 = u.pn * 256 + wc * 32 + 8 * fq;
#pragma unroll
        for (int ai = 0; ai < 2; ++ai)
#pragma unroll
            for (int m = 0; m < 4; ++m) { bf16_t* rowp = U + (size_t)(row0 + ai * 128 + m * 16) * NU + col0;
#pragma unroll
                for (int bj = 0; bj < 2; ++bj) { const f32x4 v0 = acc[ai][bj][m][0], v1 = acc[ai][bj][m][1];
                    u32x4 w; w.x = cvt_pk_bf16(v0[0], v0[1]); w.y = cvt_pk_bf16(v0[2], v0[3]); w.z = cvt_pk_bf16(v1[0], v1[1]); w.w = cvt_pk_bf16(v1[2], v1[3]);
                    *(u32x4*)(rowp + bj * 128) = w; } }
        if (u.pn >= 8 && u.pn < 12) {
            const bool isv = u.pn >= 10; const int cin = (u.pn - (isv ? 10 : 8)) * 256 + wc * 32 + 8 * fq;
#pragma unroll
            for (int ai = 0; ai < 2; ++ai)
#pragma unroll
                for (int m = 0; m < 4; ++m) { const int row = row0 + ai * 128 + m * 16;
                    float* dst = row < TP ? out + (isv ? O_PV : O_PK) + ((size_t)l * TP + row) * 512 : out + (isv ? O_SV : O_SK) + ((size_t)l * 1024 + (row - TP)) * 512;
#pragma unroll
                    for (int bj = 0; bj < 2; ++bj) { *(f32x4*)(dst + cin + bj * 128) = acc[ai][bj][m][0]; *(f32x4*)(dst + cin + bj * 128 + 4) = acc[ai][bj][m][1]; } }
        }
        if (u.pn == 58 && wc == 0 && fq == 0) {
            const f32x4 b0 = *(const f32x4*)(bf + l * 8), b1 = *(const f32x4*)(bf + l * 8 + 4);
#pragma unroll
            for (int ai = 0; ai < 2; ++ai)
#pragma unroll
                for (int m = 0; m < 4; ++m) { const int row = row0 + ai * 128 + m * 16;
                    float* dst = row < TP ? out + O_PLF + ((size_t)l * TP + row) * 8 : out + O_SLF + ((size_t)l * 1024 + (row - TP)) * 8;
                    const f32x4 z0 = acc[ai][1][m][0] + b0, z1 = acc[ai][1][m][1] + b1; f32x4 o0, o1;
#pragma unroll
                    for (int e = 0; e < 4; ++e) { o0[e] = log_sigmoidf_(z0[e]); o1[e] = log_sigmoidf_(z1[e]); }
                    *(f32x4*)dst = o0; *(f32x4*)(dst + 4) = o1; }
        }
    }
};
struct BranchOrder {
    int G, c;
    __device__ __forceinline__ bool next(int i, pg8::Unit& u) const { const int tile = (i >> 2) * G + c, n = i & 3; if (tile >= 68 * 8) return false; u.pm = n * 68 + (tile >> 3); u.pn = n * 8 + (tile & 7); return true; }
    __device__ __forceinline__ void a_ready(const pg8::Unit&) const {}
    __device__ __forceinline__ void done(const pg8::Unit&) const {}
};
struct EpiBranch {
    static constexpr bool PERM = true, AFTER_DRAIN = false;
    const bf16_t* U; float* mg; bf16_t* merged;
    __device__ __forceinline__ void operator()(const f32x4 (&acc)[2][2][4][2], const pg8::Unit& u, int wr, int wc, int fr, int fq) const {
        const int n = u.pm / 68, tm = u.pm - n * 68, tn = u.pn & 7;
        const int row0 = tm * 256 + wr * 64 + fr, col0 = tn * 256 + wc * 32 + 8 * fq;
#pragma unroll
        for (int ai = 0; ai < 2; ++ai)
#pragma unroll
            for (int m = 0; m < 4; ++m) { const int row = row0 + ai * 128 + m * 16;
#pragma unroll
                for (int bj = 0; bj < 2; ++bj) { const int col = col0 + bj * 128;
                    const u32x4 g = *(const u32x4*)(U + (size_t)row * NU + U_G + n * 2048 + col);
                    f32x4 v0 = acc[ai][bj][m][0], v1 = acc[ai][bj][m][1];
                    v0[0] *= sigmoidf_(bflo(g.x)); v0[1] *= sigmoidf_(bfhi(g.x)); v0[2] *= sigmoidf_(bflo(g.y)); v0[3] *= sigmoidf_(bfhi(g.y));
                    v1[0] *= sigmoidf_(bflo(g.z)); v1[1] *= sigmoidf_(bfhi(g.z)); v1[2] *= sigmoidf_(bflo(g.w)); v1[3] *= sigmoidf_(bfhi(g.w));
                    float* mp = mg + (size_t)row * DM + col;
                    if (n > 0) { v0 += *(const f32x4*)mp; v1 += *(const f32x4*)(mp + 4); }
                    if (n < 3) { *(f32x4*)mp = v0; *(f32x4*)(mp + 4) = v1; }
                    else { u32x4 w; w.x = cvt_pk_bf16(v0[0], v0[1]); w.y = cvt_pk_bf16(v0[2], v0[3]); w.z = cvt_pk_bf16(v1[0], v1[1]); w.w = cvt_pk_bf16(v1[2], v1[3]);
                        *(u32x4*)(merged + (size_t)row * DM + col) = w; } } }
    }
};
struct EpiOut {
    static constexpr bool PERM = false, AFTER_DRAIN = false;
    const float* xp; const float* xs; const float* xb; const float* ada; float* xout; int l;
    __device__ __forceinline__ void operator()(const f32x4 (&acc)[2][2][4][2], const pg8::Unit& u, int wr, int wc, int fr, int fq) const {
        const int row0 = u.pm * 256 + wr * 64 + fr, col0 = u.pn * 256 + wc * 32 + 4 * fq;
#pragma unroll
        for (int ai = 0; ai < 2; ++ai)
#pragma unroll
            for (int m = 0; m < 4; ++m) { const int row = row0 + ai * 128 + m * 16;
                const float* base = l == 0 ? (row < TP ? xp + (size_t)row * DM : xs + (size_t)(row - TP) * DM) : xb + (size_t)row * DM;
                const int seq = row < TP ? 0 : 1 + ((row - TP) >> 5);
                const float* gate = ada + ((size_t)l * 33 + seq) * 6144 + 4096;
#pragma unroll
                for (int bj = 0; bj < 2; ++bj)
#pragma unroll
                    for (int n = 0; n < 2; ++n) { const int col = col0 + bj * 128 + n * 16;
                        *(f32x4*)(xout + (size_t)row * DM + col) = *(const f32x4*)(base + col) + *(const f32x4*)(gate + col) * acc[ai][bj][m][n]; } }
    }
};
__device__ __forceinline__ void conv_unit(KP p, int l, int tile, LAS unsigned char* lds, int tid) {
    const bf16_t* U = (const bf16_t*)(p->ws + WS_U);
    const int c = tid, wave = tid >> 6, lane = tid & 63;
    const bool samp = tile >= 512; const int b = tile - 512, row0 = samp ? TP + b * 32 : tile * 32;
    const bool last = samp || tile == 511;
    LAS float* red = (LAS float*)lds;
    LAS float* st = red + 8 * 32;
    const float cb = p->in[I_CONVB][l * 512 + c], lg = p->in[I_CLNG][l * 512 + c], lb = p->in[I_CLNB][l * 512 + c];
    bf16_t* oa = (bf16_t*)(p->ws + WS_OCAT);
#pragma unroll 1
    for (int half = 0; half < 2; ++half) {
        float z[46];
#pragma unroll
        for (int i = 0; i < 46; ++i) { const int rel = 16 * half + i - 30; float v;
            if (rel >= 0) { const size_t r = (size_t)(row0 + rel) * NU; v = bf2f(U[r + U_AVAL + c]) * sigmoidf_(bf2f(U[r + U_AGATE + c])); }
            else if (samp) v = p->in[I_SCONV][(((size_t)l * 32 + b) * 30 + (30 + rel)) * 512 + c];
            else if (row0 == 0) v = 0.f;
            else { const size_t r = (size_t)(row0 + rel) * NU; v = bf2f(U[r + U_AVAL + c]) * sigmoidf_(bf2f(U[r + U_AGATE + c])); }
            z[i] = v; }
        if (last) {
            float* dst = samp ? p->out + O_SCONV + (((size_t)l * 32 + b) * 30) * 512 + c : p->out + O_PCONV + ((size_t)l * 30) * 512 + c;
#pragma unroll
            for (int tt = 0; tt < 16; ++tt) { const int t = 16 * half + tt; if (t >= 2) dst[(size_t)(t - 2) * 512] = z[30 + tt]; }
        }
        float hv[16];
#pragma unroll
        for (int tt = 0; tt < 16; ++tt) hv[tt] = cb;
#pragma unroll
        for (int k = 0; k < 31; ++k) { const float w = p->in[I_CONVW][((size_t)l * 31 + k) * 512 + c];
#pragma unroll
            for (int tt = 0; tt < 16; ++tt) hv[tt] += z[tt + k] * w; }
#pragma unroll
        for (int tt = 0; tt < 16; ++tt) { const float s1 = wave_sum(hv[tt]), s2 = wave_sum(hv[tt] * hv[tt]); if (lane == 0) { red[(wave * 16 + tt) * 2] = s1; red[(wave * 16 + tt) * 2 + 1] = s2; } }
        __syncthreads();
        if (tid < 16) { float s1 = 0.f, s2 = 0.f;
#pragma unroll
            for (int w = 0; w < 8; ++w) { s1 += red[(w * 16 + tid) * 2]; s2 += red[(w * 16 + tid) * 2 + 1]; }
            const float mean = s1 * (1.f / 512.f), var = fmaxf(s2 * (1.f / 512.f) - mean * mean, 0.f);
            st[tid * 2] = mean; st[tid * 2 + 1] = 1.f / sqrtf(var + 1e-5f); }
        __syncthreads();
#pragma unroll
        for (int tt = 0; tt < 16; ++tt) { const float y = (hv[tt] - st[tt * 2]) * st[tt * 2 + 1] * lg + lb; const size_t r = (size_t)(row0 + 16 * half + tt);
            oa[r * 512 + c] = f2bf(siluf_(y) * siluf_(bf2f(U[r * NU + U_ASG + c]))); }
        __syncthreads();
    }
}
__device__ __forceinline__ void pool_unit(KP p, int l, int tile, LAS unsigned char* lds, int tid) {
    const bf16_t* U = (const bf16_t*)(p->ws + WS_U);
    const int c = tid, wave = tid >> 6, lane = tid & 63;
    const bool samp = tile >= 512; const int b = tile - 512, row0 = samp ? TP + b * 32 : tile * 32;
    constexpr int PST = 520;
    LAS bf16_t* pl = (LAS bf16_t*)lds;
    {
        float z[47];
#pragma unroll
        for (int i = 0; i < 15; ++i) {
            float v;
            if (samp) v = p->in[I_SPOOL][(((size_t)l * 32 + b) * 15 + i) * 512 + c];
            else if (row0 == 0) v = 0.f;
            else v = bf2f(U[(size_t)(row0 - 15 + i) * NU + U_DIN + c]);
            z[i] = v; }
#pragma unroll
        for (int t = 0; t < 32; ++t) z[15 + t] = bf2f(U[(size_t)(row0 + t) * NU + U_DIN + c]);
        if (samp || tile == 511) {
            float* dst = samp ? p->out + O_SPOOL + (((size_t)l * 32 + b) * 15) * 512 + c : p->out + O_PPOOL + ((size_t)l * 15) * 512 + c;
#pragma unroll
            for (int t = 17; t < 32; ++t) dst[(size_t)(t - 17) * 512] = z[15 + t];
        }
        const int w = 2 << (c >> 7);
#pragma unroll
        for (int t = 0; t < 32; ++t) { float s = 0.f;
#pragma unroll
            for (int i = 0; i < 16; ++i) s += (i < w) ? z[15 + t - i] : 0.f;
            const int pos = samp ? PAST + t : row0 + t; const int cnt = (pos + 1 < w) ? pos + 1 : w;
            pl[t * PST + c] = f2bf(s / (float)cnt - z[15 + t]); }
    }
    __syncthreads();
    {
        const int g = wave >> 1, fr = lane & 15, kq = lane >> 4;
        const bf16_t* WT = (const bf16_t*)(p->ws + WS_POOLW) + (size_t)(l * 4 + g) * 128 * 128;
        f32x4 acc[2][4];
#pragma unroll
        for (int mt = 0; mt < 2; ++mt)
#pragma unroll
            for (int nt = 0; nt < 4; ++nt) acc[mt][nt] = (f32x4){0.f, 0.f, 0.f, 0.f};
#pragma unroll
        for (int ks = 0; ks < 4; ++ks) {
            bf16x8 af[2];
#pragma unroll
            for (int mt = 0; mt < 2; ++mt) af[mt] = *(const LAS bf16x8*)(pl + (16 * mt + fr) * PST + g * 128 + 32 * ks + 8 * kq);
#pragma unroll
            for (int nt = 0; nt < 4; ++nt) { const int dl = (wave & 1) * 64 + 16 * nt + fr;
                const bf16x8 bfr = *(const bf16x8*)(WT + (size_t)dl * 128 + 32 * ks + 8 * kq);
#pragma unroll
                for (int mt = 0; mt < 2; ++mt) acc[mt][nt] = __builtin_amdgcn_mfma_f32_16x16x32_bf16(af[mt], bfr, acc[mt][nt], 0, 0, 0); }
        }
        bf16_t* od = (bf16_t*)(p->ws + WS_OCAT) + (size_t)3 * NTOK * 512;
#pragma unroll
        for (int nt = 0; nt < 4; ++nt) { const int d = wave * 64 + 16 * nt + fr; const float pb = p->in[I_POOLB][l * 512 + d], ps = p->in[I_POOLS][l * 512 + d];
#pragma unroll
            for (int mt = 0; mt < 2; ++mt)
#pragma unroll
                for (int r = 0; r < 4; ++r) { const size_t row = (size_t)(row0 + 16 * mt + 4 * kq + r);
                    od[row * 512 + d] = f2bf((acc[mt][nt][r] + pb) * ps * siluf_(bf2f(U[row * NU + U_DSG + d]))); } }
    }
    __syncthreads();
}
__device__ __forceinline__ void fp_unit(KP p, int l, int h, LAS unsigned char* lds, int tid) {
    const float* lf = p->out + O_PLF + (size_t)l * TP * 8 + h;
    LAS float* part = (LAS float*)lds;
    float v[32]; float s = 0.f;
#pragma unroll
    for (int i = 0; i < 32; ++i) { v[i] = lf[(size_t)(tid * 32 + i) * 8]; s += v[i]; }
    part[tid] = s;
    __syncthreads();
    float pre = 0.f;
    for (int j = 0; j < tid; ++j) pre += part[j];
    float* F = (float*)(p->ws + WS_FP) + (size_t)h * TP + tid * 32;
#pragma unroll
    for (int i = 0; i < 32; ++i) { pre += v[i]; F[i] = pre * LOG2E; }
    __syncthreads();
}
__device__ __forceinline__ void gs_unit(KP p, int l, int b, LAS unsigned char* lds, int tid) {
    const int h = tid & 7, ch = tid >> 3;
    const float* cl = p->in[I_CLF] + (((size_t)l * 32 + b) * PAST) * 8 + h;
    LAS float* part = (LAS float*)lds;
    float s = 0.f;
    for (int i = 0; i < 64; ++i) s += cl[(size_t)(ch * 64 + i) * 8];
    part[ch * 8 + h] = s;
    __syncthreads();
    float suf = 0.f;
    for (int j = ch + 1; j < 64; ++j) suf += part[j * 8 + h];
    float* G = (float*)(p->ws + WS_GS) + ((size_t)b * 8 + h) * GS_LEN;
    for (int i = 63; i >= 0; --i) { const int t = ch * 64 + i; G[t] = -suf * LOG2E; suf += cl[(size_t)t * 8]; }
    if (tid < 8) { const float* nl = p->out + O_SLF + ((size_t)l * 1024 + b * 32) * 8 + tid; float run = 0.f;
        for (int i = 0; i < 32; ++i) { run += nl[i * 8]; G[PAST + i] = run * LOG2E; } }
    __syncthreads();
}
__device__ __forceinline__ void vt_tile(KP p, int tile, LAS unsigned char* lds, int wave, int lane) {
    const int h = tile >> 8, tb = tile & 255;
    const bf16_t* U = (const bf16_t*)(p->ws + WS_U);
    LAS unsigned* scr = (LAS unsigned*)lds + wave * SLOT_F;
#pragma unroll 8
    for (int tt = 0; tt < 64; ++tt) scr[tt * 65 + lane] = U[(size_t)(tb * 64 + tt) * NU + U_V + h * 64 + lane];
    bf16_t* Vt = (bf16_t*)(p->ws + WS_VT);
    const int t2 = (lane & 31) * 2, dh = lane >> 5;
#pragma unroll 8
    for (int it = 0; it < 32; ++it) { const int d = 2 * it + dh; *(unsigned*)(Vt + ((size_t)h * 64 + d) * TP + tb * 64 + t2) = scr[t2 * 65 + d] | (scr[(t2 + 1) * 65 + d] << 16); }
}
__device__ __forceinline__ void shift_out(KP p, int l, int tid) {
    const bf16_t* U = (const bf16_t*)(p->ws + WS_U);
    for (int idx = tid; idx < NSEQ * SHIFT_W; idx += 512) { const int s = idx / SHIFT_W, j = idx - s * SHIFT_W;
        const int row = s == 0 ? TP - 1 : TP + (s - 1) * 32 + 31;
        float* dst = s == 0 ? p->out + O_PSHIFT + (size_t)l * SHIFT_W + j : p->out + O_SSHIFT + ((size_t)l * 32 + (s - 1)) * SHIFT_W + j;
        *dst = bf2f(U[(size_t)row * NU + U_XC + j]); }
}
template <bool AT, bool BT, bool NEGA>
__device__ __forceinline__ void mm32(f32x16& acc, const LAS float* Ap, int i0, const LAS float* Bp, int j0, int lane) {
    const int li = lane & 31, kh = lane >> 5;
    const LAS float* ap = AT ? Ap + kh * 65 + i0 + li : Ap + (i0 + li) * 65 + kh;
    const LAS float* bp = BT ? Bp + (j0 + li) * 65 + kh : Bp + kh * 65 + j0 + li;
#pragma unroll 8
    for (int s = 0; s < 32; ++s) {
        float a = AT ? ap[s * 130] : ap[s * 2];
        const float b = BT ? bp[s * 2] : bp[s * 130];
        if (NEGA) a = -a;
        acc = __builtin_amdgcn_mfma_f32_32x32x2f32(a, b, acc, 0, 0, 0);
    }
}
template <int MASK>
__device__ __forceinline__ void st_tile(LAS float* dst, const f32x16& acc, int i0, int j0, int lane) {
    const int li = lane & 31, hi = lane >> 5, j = j0 + li;
#pragma unroll
    for (int r = 0; r < 16; ++r) { const int i = i0 + (r & 3) + 8 * (r >> 2) + 4 * hi; float v = acc[r];
        if (MASK == 1 && !(i < j)) v = 0.f; if (MASK == 2 && !(i <= j)) v = 0.f; dst[i * 65 + j] = v; }
}
struct RwkvSeqInfo { int row0, ntok, prev_kind  , b; };
__device__ __forceinline__ RwkvSeqInfo rwkv_info(int cu) { RwkvSeqInfo s; if (cu < 256) { s.row0 = cu * 64; s.ntok = 64; s.prev_kind = cu == 0 ? 0 : 1; s.b = 0; } else { s.b = cu - 256; s.row0 = TP + s.b * 32; s.ntok = 32; s.prev_kind = 2; } return s; }

__device__ __forceinline__ void rwkv_r1(KP p, int l, int unit, LAS unsigned char* lds, int tid) {
    const int cu = unit >> 3, h = unit & 7, wave = tid >> 6, lane = tid & 63, li = lane & 31, hi = lane >> 5;
    const RwkvSeqInfo si = rwkv_info(cu);
    const bf16_t* U = (const bf16_t*)(p->ws + WS_U);
    LAS float* S0 = (LAS float*)lds; LAS float *S1 = S0 + SLOT_F, *S2 = S0 + 2 * SLOT_F, *S3 = S0 + 3 * SLOT_F, *S4 = S0 + 4 * SLOT_F, *S5 = S0 + 5 * SLOT_F, *S6 = S0 + 6 * SLOT_F, *S7 = S0 + 7 * SLOT_F, *S8 = S0 + 8 * SLOT_F;
    LAS float* gC = S0 + 9 * SLOT_F;
    const int q = wave >> 2, wq = wave & 3, i0 = (wq >> 1) * 32, j0 = (wq & 1) * 32;
    {
        const int j = tid & 63, tq = tid >> 6;
        const int offs[5] = {h * 64, 512 + h * 64, 1024 + h * 64, 1536, 1600};
#pragma unroll
        for (int cs = 0; cs < 5; ++cs) {
            const int xo = offs[cs] + j; const float mu = p->in[I_MU][l * SHIFT_W + xo];
            LAS float* dst = cs == 0 ? S0 : cs == 1 ? S1 : cs == 2 ? S2 : cs == 3 ? S3 : S4;
            const int t0 = tq * 8; float prev;
            if (t0 == 0) prev = si.prev_kind == 0 ? 0.f : si.prev_kind == 1 ? bf2f(U[(size_t)(si.row0 - 1) * NU + U_XC + xo]) : p->in[I_SSHIFT][((size_t)l * 32 + si.b) * SHIFT_W + xo];
            else prev = (t0 - 1 < si.ntok) ? bf2f(U[(size_t)(si.row0 + t0 - 1) * NU + U_XC + xo]) : 0.f;
#pragma unroll
            for (int tt = 0; tt < 8; ++tt) { const int t = t0 + tt; float xs = 0.f;
                if (t < si.ntok) { const float x = bf2f(U[(size_t)(si.row0 + t) * NU + U_XC + xo]); xs = x + (prev - x) * mu; prev = x; }
                if (cs == 3) xs = tanhf(xs);
                dst[t * 65 + j] = xs; }
        }
#pragma unroll
        for (int mm = 0; mm < 8; ++mm) { const int m = tq * 8 + mm;
            S5[m * 65 + j] = p->in[I_W2][((size_t)l * 64 + m) * 512 + h * 64 + j]; S6[m * 65 + j] = p->in[I_A2][((size_t)l * 64 + m) * 512 + h * 64 + j]; }
    }
    __syncthreads();
    {
        f32x16 acc = {};
        const int c = j0 + li;
        if (q == 0) { mm32<false, false, false>(acc, S3, i0, S5, j0, lane); const float w0 = p->in[I_W0][l * 512 + h * 64 + c];
#pragma unroll
            for (int r = 0; r < 16; ++r) { const int t = i0 + (r & 3) + 8 * (r >> 2) + 4 * hi; const float zz = acc[r] + w0;
                const float sp = fmaxf(-zz, 0.f) + log1pf(expf(-fabsf(zz)));
                S7[t * 65 + c] = (t < si.ntok) ? -expf(-sp - 0.5f) : 0.f; } }
        else { mm32<false, false, false>(acc, S4, i0, S6, j0, lane); const float a0 = p->in[I_A0][l * 512 + h * 64 + c];
#pragma unroll
            for (int r = 0; r < 16; ++r) { const int t = i0 + (r & 3) + 8 * (r >> 2) + 4 * hi; S8[t * 65 + c] = 1.f / (1.f + expf(-(acc[r] + a0))); } }
    }
    __syncthreads();
    if (wave == 0) { float run = 0.f;
#pragma unroll 8
        for (int t = 0; t < 64; ++t) { run += S7[t * 65 + lane]; S3[t * 65 + lane] = run; } }
    else { const int c = lane; const float kkw = p->in[I_KK][l * 512 + h * 64 + c], kaw = p->in[I_KA][l * 512 + h * 64 + c], rkw = p->in[I_RK][l * 512 + h * 64 + c];
        for (int t = wave - 1; t < 64; t += 7) { const float kr = S1[t * 65 + c], kv = kr * kkw; const float ss = wave_sum(kv * kv);
            const float kn = kv * (1.f / sqrtf(fmaxf(ss, 1e-24f))); const float a = S8[t * 65 + c]; const float km = kr * (1.f + (a - 1.f) * kaw);
            const float bon = wave_sum(S0[t * 65 + c] * km * rkw);
            S4[t * 65 + c] = kn; S1[t * 65 + c] = km; S8[t * 65 + c] = kn * a;
            if (lane == 0) ((float*)(p->ws + WS_BONUS))[(size_t)unit * 64 + t] = bon; } }
    __syncthreads();
    { const int c = tid & 63, tq = tid >> 6;
#pragma unroll
        for (int tt = 0; tt < 8; ++tt) { const int t = tq * 8 + tt, o = t * 65 + c; const float Lg = S3[o], lw = S7[o];
            const float g = expf(Lg), gi = expf(-Lg), gp = expf(Lg - lw);
            S0[o] *= g; S1[o] *= gi; S8[o] *= gi; S4[o] *= gp; if (t == 63) gC[c] = g; } }
    __syncthreads();
    { f32x16 acc = {};
      if (q == 0) { mm32<false, true, false>(acc, S1, i0, S4, j0, lane); st_tile<1>(S3, acc, i0, j0, lane); }
      else { mm32<false, true, false>(acc, S8, i0, S4, j0, lane); st_tile<1>(S5, acc, i0, j0, lane); } }
    __syncthreads();
    { f32x16 acc = {};
      if (q == 0) { mm32<true, false, false>(acc, S2, i0, S3, j0, lane); st_tile<0>(S6, acc, i0, j0, lane); }
      else { mm32<false, true, false>(acc, S1, i0, S0, j0, lane); st_tile<2>(S7, acc, i0, j0, lane); } }
    __syncthreads();
    { float x[16]; const int r0 = (wave & 3) * 16;
      if (wave < 4) {
#pragma unroll
          for (int rr = 0; rr < 16; ++rr) x[rr] = S4[lane * 65 + r0 + rr]; }
      else {
#pragma unroll
          for (int rr = 0; rr < 16; ++rr) x[rr] = S6[(r0 + rr) * 65 + lane]; }
      __syncthreads();
#pragma unroll
      for (int s = 0; s < 63; ++s) { const float mrow = S5[s * 65 + lane];
#pragma unroll
          for (int rr = 0; rr < 16; ++rr) x[rr] -= __builtin_bit_cast(float, __builtin_amdgcn_readlane(__builtin_bit_cast(int, x[rr]), s)) * mrow; }
      LAS float* dst = wave < 4 ? S3 : S6;
#pragma unroll
      for (int rr = 0; rr < 16; ++rr) dst[(r0 + rr) * 65 + lane] = x[rr]; }
    __syncthreads();
    { f32x16 acc = {};
      if (q == 1) { mm32<false, true, false>(acc, S8, i0, S0, j0, lane); st_tile<2>(S4, acc, i0, j0, lane); }
      else { mm32<false, false, false>(acc, S3, i0, S8, j0, lane);
          const int jc = j0 + li; const float gc = gC[jc]; float* TQ = (float*)(p->ws + WS_TQ) + (size_t)unit * 4096;
#pragma unroll
          for (int rg = 0; rg < 4; ++rg) { const int ab = i0 + 8 * rg + 4 * hi; f32x4 o;
#pragma unroll
              for (int e = 0; e < 4; ++e) o[e] = ((ab + e == jc) ? gc : 0.f) - acc[rg * 4 + e] * gc;
              *(f32x4*)(TQ + ((((jc >> 4) * 4 + (ab >> 4)) * 64 + ((ab & 15) >> 2) * 16 + (jc & 15)) * 4)) = o; } } }
    __syncthreads();
    { f32x16 acc = {};
      if (q == 0) { mm32<true, false, false>(acc, S2, i0, S1, j0, lane); mm32<false, false, true>(acc, S6, i0, S8, j0, lane);
          const int jc = j0 + li; const float gc = gC[jc]; float* GM = (float*)(p->ws + WS_GM) + (size_t)unit * 4096;
#pragma unroll
          for (int r = 0; r < 16; ++r) GM[(i0 + (r & 3) + 8 * (r >> 2) + 4 * hi) * 64 + jc] = acc[r] * gc; }
      else { mm32<true, false, false>(acc, S2, i0, S7, j0, lane); mm32<false, false, true>(acc, S6, i0, S4, j0, lane);
          float* Y0T = (float*)(p->ws + WS_Y0T) + (size_t)unit * 4096 + (j0 + li) * 64;
#pragma unroll
          for (int rg = 0; rg < 4; ++rg) *(f32x4*)(Y0T + i0 + 8 * rg + 4 * hi) = (f32x4){acc[rg * 4], acc[rg * 4 + 1], acc[rg * 4 + 2], acc[rg * 4 + 3]}; } }
    if (q == 0) { f32x16 acc;
#pragma unroll
        for (int r = 0; r < 16; ++r) acc[r] = S0[(j0 + li) * 65 + i0 + (r & 3) + 8 * (r >> 2) + 4 * hi];
        mm32<false, false, true>(acc, S3, i0, S4, j0, lane);
        float* ET = (float*)(p->ws + WS_ET) + (size_t)unit * 4096 + (j0 + li) * 64;
#pragma unroll
        for (int rg = 0; rg < 4; ++rg) *(f32x4*)(ET + i0 + 8 * rg + 4 * hi) = (f32x4){acc[rg * 4], acc[rg * 4 + 1], acc[rg * 4 + 2], acc[rg * 4 + 3]}; }
    __syncthreads();
}
__device__ __forceinline__ void rwkv_r2_task(KP p, int l, int task, int lane) {
    int h, iq, unit0, nch, b = 0; bool samp = task >= 32;
    if (!samp) { h = task >> 2; iq = task & 3; unit0 = h; nch = 256; }
    else { const int t2 = task - 32; iq = t2 & 3; h = (t2 >> 2) & 7; b = t2 >> 5; unit0 = (256 + b) * 8 + h; nch = 1; }
    const int fr = lane & 15, g = lane >> 4, i = iq * 16 + fr;
    f32x4 st[4];
    if (samp) { const float* s0 = p->in[I_SWKV] + ((((size_t)l * 32 + b) * 8 + h) * 64 + i) * 64;
#pragma unroll
        for (int tl = 0; tl < 4; ++tl) st[tl] = *(const f32x4*)(s0 + 16 * tl + 4 * g); }
    else {
#pragma unroll
        for (int tl = 0; tl < 4; ++tl) st[tl] = (f32x4){0.f, 0.f, 0.f, 0.f}; }
    const float* TQ = (const float*)(p->ws + WS_TQ); const float* GM = (const float*)(p->ws + WS_GM); float* SC = (float*)(p->ws + WS_SC);
    f32x4 tq[16], gm[4];
    { const size_t ub = (size_t)unit0 * 4096;
#pragma unroll
      for (int x = 0; x < 16; ++x) tq[x] = *(const f32x4*)(TQ + ub + (x * 64 + lane) * 4);
#pragma unroll
      for (int tl = 0; tl < 4; ++tl) gm[tl] = *(const f32x4*)(GM + ub + i * 64 + 16 * tl + 4 * g); }
    for (int c = 0; c < nch; ++c) {
        const size_t ub = (size_t)(unit0 + c * 8) * 4096;
#pragma unroll
        for (int tl = 0; tl < 4; ++tl) *(f32x4*)(SC + ub + i * 64 + 16 * tl + 4 * g) = st[tl];
        f32x4 tqn[16], gmn[4];
        if (c + 1 < nch) { const size_t un = ub + 8 * 4096;
#pragma unroll
            for (int x = 0; x < 16; ++x) tqn[x] = *(const f32x4*)(TQ + un + (x * 64 + lane) * 4);
#pragma unroll
            for (int tl = 0; tl < 4; ++tl) gmn[tl] = *(const f32x4*)(GM + un + i * 64 + 16 * tl + 4 * g); }
        else {
#pragma unroll
            for (int x = 0; x < 16; ++x) tqn[x] = tq[x];
#pragma unroll
            for (int tl = 0; tl < 4; ++tl) gmn[tl] = gm[tl]; }
        f32x4 acc[4];
#pragma unroll
        for (int tp = 0; tp < 4; ++tp) acc[tp] = gm[tp];
#pragma unroll
        for (int tl = 0; tl < 4; ++tl)
#pragma unroll
            for (int r = 0; r < 4; ++r)
#pragma unroll
                for (int tp = 0; tp < 4; ++tp) acc[tp] = __builtin_amdgcn_mfma_f32_16x16x4f32(tq[tp * 4 + tl][r], st[tl][r], acc[tp], 0, 0, 0);
#pragma unroll
        for (int tl = 0; tl < 4; ++tl) st[tl] = acc[tl];
#pragma unroll
        for (int x = 0; x < 16; ++x) tq[x] = tqn[x];
#pragma unroll
        for (int tl = 0; tl < 4; ++tl) gm[tl] = gmn[tl];
    }
    float* dst = samp ? p->out + O_SWKV + ((((size_t)l * 32 + b) * 8 + h) * 64 + i) * 64 : p->out + O_PWKV + (((size_t)l * 8 + h) * 64 + i) * 64;
#pragma unroll
    for (int tl = 0; tl < 4; ++tl) *(f32x4*)(dst + 16 * tl + 4 * g) = st[tl];
}
__device__ __forceinline__ void rwkv_r3_task(KP p, int l, int task, int lane) {
    const int unit = task >> 1, th = task & 1, cu = unit >> 3, h = unit & 7, li = lane & 31, hi = lane >> 5;
    const RwkvSeqInfo si = rwkv_info(cu);
    if (th * 32 >= si.ntok) return;
    const bf16_t* U = (const bf16_t*)(p->ws + WS_U);
    const size_t ub = (size_t)unit * 4096; const int t = th * 32 + li;
    const float* SC = (const float*)(p->ws + WS_SC) + ub; const float* ET = (const float*)(p->ws + WS_ET) + ub + t * 64 + 32 * hi; const float* Y0T = (const float*)(p->ws + WS_Y0T) + ub + t * 64;
    f32x16 acc[2];
#pragma unroll
    for (int ti = 0; ti < 2; ++ti)
#pragma unroll
        for (int rg = 0; rg < 4; ++rg) { const f32x4 y0 = *(const f32x4*)(Y0T + 32 * ti + 8 * rg + 4 * hi);
#pragma unroll
            for (int e = 0; e < 4; ++e) acc[ti][rg * 4 + e] = y0[e]; }
#pragma unroll
    for (int s4 = 0; s4 < 8; ++s4) {
        const f32x4 eb = *(const f32x4*)(ET + 4 * s4);
        const f32x4 sa0 = *(const f32x4*)(SC + (li) * 64 + 32 * hi + 4 * s4), sa1 = *(const f32x4*)(SC + (32 + li) * 64 + 32 * hi + 4 * s4);
#pragma unroll
        for (int e = 0; e < 4; ++e) { acc[0] = __builtin_amdgcn_mfma_f32_32x32x2f32(sa0[e], eb[e], acc[0], 0, 0, 0); acc[1] = __builtin_amdgcn_mfma_f32_32x32x2f32(sa1[e], eb[e], acc[1], 0, 0, 0); }
    }
    float s1 = 0.f;
#pragma unroll
    for (int ti = 0; ti < 2; ++ti)
#pragma unroll
        for (int r = 0; r < 16; ++r) s1 += acc[ti][r];
    s1 += __shfl_xor(s1, 32); const float mean = s1 * (1.f / 64.f);
    float s2 = 0.f;
#pragma unroll
    for (int ti = 0; ti < 2; ++ti)
#pragma unroll
        for (int r = 0; r < 16; ++r) { const float d = acc[ti][r] - mean; s2 += d * d; }
    s2 += __shfl_xor(s2, 32); const float rstd = 1.f / sqrtf(s2 * (1.f / 64.f) + 64e-5f);
    if (t >= si.ntok) return;
    const float bon = ((const float*)(p->ws + WS_BONUS))[(size_t)unit * 64 + t];
    const size_t row = (size_t)(si.row0 + t);
    bf16_t* oc = (bf16_t*)(p->ws + WS_OCAT) + (size_t)2 * NTOK * 512 + row * 512 + h * 64;
#pragma unroll
    for (int ti = 0; ti < 2; ++ti)
#pragma unroll
        for (int rg = 0; rg < 4; ++rg) { const int i = 32 * ti + 8 * rg + 4 * hi, c = h * 64 + i;
            const f32x4 gg = *(const f32x4*)(p->in[I_GNG] + l * 512 + c), gb = *(const f32x4*)(p->in[I_GNB] + l * 512 + c), mu = *(const f32x4*)(p->in[I_MU] + l * SHIFT_W + 1024 + c);
            const u32x2 vx = *(const u32x2*)(U + row * NU + U_XC + 1024 + c); const u32x2 sg = *(const u32x2*)(U + row * NU + U_CSG + c);
            f32x4 vc = (f32x4){bflo(vx.x), bfhi(vx.x), bflo(vx.y), bfhi(vx.y)}, vp;
            if (t > 0 || si.prev_kind == 1) { const u32x2 px = *(const u32x2*)(U + (row - 1) * NU + U_XC + 1024 + c); vp = (f32x4){bflo(px.x), bfhi(px.x), bflo(px.y), bfhi(px.y)}; }
            else if (si.prev_kind == 2) vp = *(const f32x4*)(p->in[I_SSHIFT] + ((size_t)l * 32 + si.b) * SHIFT_W + 1024 + c);
            else vp = (f32x4){0.f, 0.f, 0.f, 0.f};
            const f32x4 vs = vc + (vp - vc) * mu;
            const f32x4 sgf = (f32x4){bflo(sg.x), bfhi(sg.x), bflo(sg.y), bfhi(sg.y)};
            f32x4 o;
#pragma unroll
            for (int e = 0; e < 4; ++e) o[e] = (((acc[ti][rg * 4 + e] - mean) * rstd) * gg[e] + gb[e] + bon * vs[e]) * siluf_(sgf[e]);
            u32x2 w; w.x = cvt_pk_bf16(o[0], o[1]); w.y = cvt_pk_bf16(o[2], o[3]); *(u32x2*)(oc + i) = w; }
}
__device__ __forceinline__ int krow(int i) { return (i & 3) + 4 * ((i >> 3) & 1) + 8 * ((i >> 2) & 1) + 16 * (i >> 4); }
__device__ __forceinline__ bf16x8 pack8(const f32x16& v, int o) { u32x4 w; w.x = cvt_pk_bf16(v[o], v[o + 1]); w.y = cvt_pk_bf16(v[o + 2], v[o + 3]); w.z = cvt_pk_bf16(v[o + 4], v[o + 5]); w.w = cvt_pk_bf16(v[o + 6], v[o + 7]); return __builtin_bit_cast(bf16x8, w); }
__device__ __forceinline__ bf16x8 pack8f(const f32x4 a, const f32x4 b) { u32x4 w; w.x = cvt_pk_bf16(a[0], a[1]); w.y = cvt_pk_bf16(a[2], a[3]); w.z = cvt_pk_bf16(b[0], b[1]); w.w = cvt_pk_bf16(b[2], b[3]); return __builtin_bit_cast(bf16x8, w); }
constexpr float ATT_NEG = -1e30f;
template <bool HALF>
__device__ __forceinline__ void softmax_tile(f32x16& p0, f32x16& p1, float& m, float& lsum, f32x16 (&O)[2], bf16x8 (&pb)[4]) {
    float mx = p0[0];
#pragma unroll
    for (int r = 1; r < 16; ++r) mx = fmaxf(mx, p0[r]);
    if (!HALF) {
#pragma unroll
        for (int r = 0; r < 16; ++r) mx = fmaxf(mx, p1[r]); }
    mx = fmaxf(mx, __shfl_xor(mx, 32));
    const float mn = fmaxf(m, mx), alpha = __builtin_amdgcn_exp2f(m - mn);
    m = mn;
    float s = 0.f;
#pragma unroll
    for (int r = 0; r < 16; ++r) { p0[r] = __builtin_amdgcn_exp2f(p0[r] - mn); s += p0[r]; }
    if (!HALF) {
#pragma unroll
        for (int r = 0; r < 16; ++r) { p1[r] = __builtin_amdgcn_exp2f(p1[r] - mn); s += p1[r]; } }
    lsum = lsum * alpha + s;
#pragma unroll
    for (int r = 0; r < 16; ++r) { O[0][r] *= alpha; O[1][r] *= alpha; }
    pb[0] = pack8(p0, 0); pb[1] = pack8(p0, 8);
    if (!HALF) { pb[2] = pack8(p1, 0); pb[3] = pack8(p1, 8); }
}
constexpr int AKS = 72;
constexpr int ATT_KB = 0, ATT_VB = 2 * 64 * AKS * 2, ATT_FB = 4 * 64 * AKS * 2;
__device__ __forceinline__ void attn_prompt_unit(KP p, int h, int qb, LAS unsigned char* lds, int tid) {
    const bf16_t* U = (const bf16_t*)(p->ws + WS_U); const bf16_t* Vt = (const bf16_t*)(p->ws + WS_VT) + (size_t)h * 64 * TP; const float* F = (const float*)(p->ws + WS_FP) + (size_t)h * TP;
    const int wave = tid >> 6, lane = tid & 63, li = lane & 31, hi = lane >> 5;
    const int q0 = qb * 256, q = q0 + wave * 32 + li;
    bf16x8 qf[4];
    { const float sc = 0.125f * LOG2E;
#pragma unroll
      for (int d0 = 0; d0 < 4; ++d0) { const u32x4 w = *(const u32x4*)(U + (size_t)q * NU + U_Q + h * 64 + 16 * d0 + 8 * hi);
          qf[d0] = pack8f((f32x4){bflo(w.x) * sc, bfhi(w.x) * sc, bflo(w.y) * sc, bfhi(w.y) * sc}, (f32x4){bflo(w.z) * sc, bfhi(w.z) * sc, bflo(w.w) * sc, bfhi(w.w) * sc}); } }
    const float fq = F[q];
    float m = ATT_NEG, lsum = 0.f; f32x16 O[2] = {};
    const int NT = (q0 + 256) / 64;
    const int srow = tid >> 3, sch = tid & 7;
    const bf16_t* kg = U + (size_t)srow * NU + U_K + h * 64 + 8 * sch; const bf16_t* vg = Vt + (size_t)srow * TP + 8 * sch;
    LAS unsigned char* kdst = lds + ATT_KB + (srow * AKS + 8 * sch) * 2; LAS unsigned char* vdst = lds + ATT_VB + (srow * AKS + 8 * sch) * 2;
    u32x4 kr = *(const u32x4*)(kg + (size_t)(NT - 1) * 64 * NU), vr = *(const u32x4*)(vg + (NT - 1) * 64); float fr = tid < 64 ? F[(NT - 1) * 64 + tid] : 0.f;
    *(LAS u32x4*)kdst = kr; *(LAS u32x4*)vdst = vr; if (tid < 64) ((LAS float*)(lds + ATT_FB))[tid] = fr;
    __syncthreads();
    const int ka = krow(li);
    for (int t = NT - 1, buf = 0; t >= 0; --t, buf ^= 1) {
        if (t > 0) { kr = *(const u32x4*)(kg + (size_t)(t - 1) * 64 * NU); vr = *(const u32x4*)(vg + (t - 1) * 64); if (tid < 64) fr = F[(t - 1) * 64 + tid]; }
        if (64 * t <= q0 + wave * 32 + 31) {
            const LAS bf16_t* Kb = (const LAS bf16_t*)(lds + ATT_KB) + buf * 64 * AKS; const LAS bf16_t* Vb = (const LAS bf16_t*)(lds + ATT_VB) + buf * 64 * AKS; const LAS float* Fb = (const LAS float*)(lds + ATT_FB) + buf * 64;
            f32x16 p0, p1;
#pragma unroll
            for (int g2 = 0; g2 < 2; ++g2) { const f32x4 a = *(const LAS f32x4*)(Fb + 8 * hi + 16 * g2), b = *(const LAS f32x4*)(Fb + 8 * hi + 16 * g2 + 4), c = *(const LAS f32x4*)(Fb + 32 + 8 * hi + 16 * g2), d = *(const LAS f32x4*)(Fb + 32 + 8 * hi + 16 * g2 + 4);
#pragma unroll
                for (int e = 0; e < 4; ++e) { p0[8 * g2 + e] = fq - a[e]; p0[8 * g2 + 4 + e] = fq - b[e]; p1[8 * g2 + e] = fq - c[e]; p1[8 * g2 + 4 + e] = fq - d[e]; } }
#pragma unroll
            for (int d0 = 0; d0 < 4; ++d0) { const bf16x8 a0 = *(const LAS bf16x8*)(Kb + ka * AKS + 16 * d0 + 8 * hi), a1 = *(const LAS bf16x8*)(Kb + (ka + 32) * AKS + 16 * d0 + 8 * hi);
                p0 = __builtin_amdgcn_mfma_f32_32x32x16_bf16(a0, qf[d0], p0, 0, 0, 0); p1 = __builtin_amdgcn_mfma_f32_32x32x16_bf16(a1, qf[d0], p1, 0, 0, 0); }
            if (64 * t + 63 > q0 + wave * 32) {
#pragma unroll
                for (int r = 0; r < 16; ++r) { const int kv = 64 * t + 8 * hi + 16 * (r >> 3) + (r & 7); if (kv > q) p0[r] = -INFINITY; if (kv + 32 > q) p1[r] = -INFINITY; } }
            bf16x8 pb[4];
            softmax_tile<false>(p0, p1, m, lsum, O, pb);
#pragma unroll
            for (int dt = 0; dt < 2; ++dt)
#pragma unroll
                for (int s = 0; s < 4; ++s) { const bf16x8 a = *(const LAS bf16x8*)(Vb + (32 * dt + li) * AKS + 16 * (s & 1) + 32 * (s >> 1) + 8 * hi);
                    O[dt] = __builtin_amdgcn_mfma_f32_32x32x16_bf16(a, pb[s], O[dt], 0, 0, 0); }
        }
        if (t > 0) { const int nb = buf ^ 1; *(LAS u32x4*)(kdst + nb * 64 * AKS * 2) = kr; *(LAS u32x4*)(vdst + nb * 64 * AKS * 2) = vr; if (tid < 64) ((LAS float*)(lds + ATT_FB))[nb * 64 + tid] = fr; }
        __syncthreads();
    }
    const float inv = 1.f / (lsum + __shfl_xor(lsum, 32));
    bf16_t* ob = (bf16_t*)(p->ws + WS_OCAT) + (size_t)1 * NTOK * 512 + (size_t)q * 512 + h * 64;
#pragma unroll
    for (int dt = 0; dt < 2; ++dt)
#pragma unroll
        for (int rg = 0; rg < 4; ++rg) { const int d = 32 * dt + 8 * rg + 4 * hi; const u32x2 sg = *(const u32x2*)(U + (size_t)q * NU + U_BSG + h * 64 + d);
            u32x2 w; w.x = cvt_pk_bf16(O[dt][rg * 4] * inv * siluf_(bflo(sg.x)), O[dt][rg * 4 + 1] * inv * siluf_(bfhi(sg.x))); w.y = cvt_pk_bf16(O[dt][rg * 4 + 2] * inv * siluf_(bflo(sg.y)), O[dt][rg * 4 + 3] * inv * siluf_(bfhi(sg.y)));
            *(u32x2*)(ob + d) = w; }
}
__device__ __forceinline__ void attn_sample_unit(KP p, int l, int b, int h, LAS unsigned char* lds, int tid) {
    const bf16_t* U = (const bf16_t*)(p->ws + WS_U);
    const int wave = tid >> 6, lane = tid & 63, li = lane & 31, hi = lane >> 5;
    const size_t qrow = (size_t)TP + b * 32 + li;
    const float* G = (const float*)(p->ws + WS_GS) + ((size_t)b * 8 + h) * GS_LEN;
    bf16x8 qf[4];
    { const float sc = 0.125f * LOG2E;
#pragma unroll
      for (int d0 = 0; d0 < 4; ++d0) { const u32x4 w = *(const u32x4*)(U + qrow * NU + U_Q + h * 64 + 16 * d0 + 8 * hi);
          qf[d0] = pack8f((f32x4){bflo(w.x) * sc, bfhi(w.x) * sc, bflo(w.y) * sc, bfhi(w.y) * sc}, (f32x4){bflo(w.z) * sc, bfhi(w.z) * sc, bflo(w.w) * sc, bfhi(w.w) * sc}); } }
    const float fq = G[PAST + li];
    float m = ATT_NEG, lsum = 0.f; f32x16 O[2] = {};
    const float* CK = p->in[I_CK] + (((size_t)l * 32 + b) * PAST) * 512 + h * 64; const float* CV = p->in[I_CV] + (((size_t)l * 32 + b) * PAST) * 512 + h * 64;
    const int ka = krow(li);
    for (int tt = 0; tt < 8; ++tt) {
        const int key0 = (wave * 8 + tt) * 64;
        f32x16 p0, p1;
#pragma unroll
        for (int g2 = 0; g2 < 2; ++g2) { const float* gp = G + key0 + 8 * hi + 16 * g2; const f32x4 a = *(const f32x4*)gp, bq = *(const f32x4*)(gp + 4), c = *(const f32x4*)(gp + 32), d = *(const f32x4*)(gp + 36);
#pragma unroll
            for (int e = 0; e < 4; ++e) { p0[8 * g2 + e] = fq - a[e]; p0[8 * g2 + 4 + e] = fq - bq[e]; p1[8 * g2 + e] = fq - c[e]; p1[8 * g2 + 4 + e] = fq - d[e]; } }
#pragma unroll
        for (int d0 = 0; d0 < 4; ++d0) { const float* k0p = CK + (size_t)(key0 + ka) * 512 + 16 * d0 + 8 * hi; const float* k1p = k0p + (size_t)32 * 512;
            const bf16x8 a0 = pack8f(*(const f32x4*)k0p, *(const f32x4*)(k0p + 4)), a1 = pack8f(*(const f32x4*)k1p, *(const f32x4*)(k1p + 4));
            p0 = __builtin_amdgcn_mfma_f32_32x32x16_bf16(a0, qf[d0], p0, 0, 0, 0); p1 = __builtin_amdgcn_mfma_f32_32x32x16_bf16(a1, qf[d0], p1, 0, 0, 0); }
        bf16x8 pb[4];
        softmax_tile<false>(p0, p1, m, lsum, O, pb);
#pragma unroll
        for (int dt = 0; dt < 2; ++dt)
#pragma unroll
            for (int s = 0; s < 4; ++s) { const float* vp = CV + (size_t)(key0 + 16 * (s & 1) + 32 * (s >> 1) + 8 * hi) * 512 + 32 * dt + li;
                const bf16x8 a = pack8f((f32x4){vp[0], vp[512], vp[1024], vp[1536]}, (f32x4){vp[2048], vp[2560], vp[3072], vp[3584]});
                O[dt] = __builtin_amdgcn_mfma_f32_32x32x16_bf16(a, pb[s], O[dt], 0, 0, 0); }
    }
    if (wave == 7) {
        f32x16 p0, p1 = {};
#pragma unroll
        for (int g2 = 0; g2 < 2; ++g2) { const float* gp = G + PAST + 8 * hi + 16 * g2; const f32x4 a = *(const f32x4*)gp, bq = *(const f32x4*)(gp + 4);
#pragma unroll
            for (int e = 0; e < 4; ++e) { p0[8 * g2 + e] = fq - a[e]; p0[8 * g2 + 4 + e] = fq - bq[e]; } }
#pragma unroll
        for (int d0 = 0; d0 < 4; ++d0) { const bf16x8 a0 = *(const bf16x8*)(U + ((size_t)TP + b * 32 + ka) * NU + U_K + h * 64 + 16 * d0 + 8 * hi);
            p0 = __builtin_amdgcn_mfma_f32_32x32x16_bf16(a0, qf[d0], p0, 0, 0, 0); }
#pragma unroll
        for (int r = 0; r < 16; ++r) { const int kv = 8 * hi + 16 * (r >> 3) + (r & 7); if (kv > li) p0[r] = -INFINITY; }
        bf16x8 pb[4];
        softmax_tile<true>(p0, p1, m, lsum, O, pb);
#pragma unroll
        for (int dt = 0; dt < 2; ++dt)
#pragma unroll
            for (int s = 0; s < 2; ++s) { const bf16_t* vp = U + ((size_t)TP + b * 32 + 16 * s + 8 * hi) * NU + U_V + h * 64 + 32 * dt + li; u32x4 w;
                w.x = (unsigned)vp[0] | ((unsigned)vp[NU] << 16); w.y = (unsigned)vp[2 * NU] | ((unsigned)vp[3 * NU] << 16); w.z = (unsigned)vp[4 * NU] | ((unsigned)vp[5 * NU] << 16); w.w = (unsigned)vp[6 * NU] | ((unsigned)vp[7 * NU] << 16);
                O[dt] = __builtin_amdgcn_mfma_f32_32x32x16_bf16(__builtin_bit_cast(bf16x8, w), pb[s], O[dt], 0, 0, 0); }
    }
    LAS float* Ow = (LAS float*)lds;
    LAS float* ML = Ow + 8 * 32 * 64;
    lsum += __shfl_xor(lsum, 32);
#pragma unroll
    for (int dt = 0; dt < 2; ++dt)
#pragma unroll
        for (int r = 0; r < 16; ++r) Ow[(wave * 32 + dt * 16 + r) * 64 + lane] = O[dt][r];
    if (hi == 0) { ML[(wave * 2) * 32 + li] = m; ML[(wave * 2 + 1) * 32 + li] = lsum; }
    __syncthreads();
    { const int qq = tid & 31, dg = tid >> 5; float M = ATT_NEG;
#pragma unroll
      for (int w = 0; w < 8; ++w) M = fmaxf(M, ML[(w * 2) * 32 + qq]);
      float L = 0.f; f32x4 o = {0.f, 0.f, 0.f, 0.f};
      const int d = 4 * dg, idx0 = (d >> 5) * 16 + ((d >> 3) & 3) * 4, ln = ((d >> 2) & 1) * 32 + qq;
#pragma unroll
      for (int w = 0; w < 8; ++w) { const float f = __builtin_amdgcn_exp2f(ML[(w * 2) * 32 + qq] - M); L += ML[(w * 2 + 1) * 32 + qq] * f;
#pragma unroll
          for (int e = 0; e < 4; ++e) o[e] += Ow[(w * 32 + idx0 + e) * 64 + ln] * f; }
      const float inv = 1.f / L; const size_t row = (size_t)TP + b * 32 + qq;
      const u32x2 sg = *(const u32x2*)(U + row * NU + U_BSG + h * 64 + d);
      u32x2 wv; wv.x = cvt_pk_bf16(o[0] * inv * siluf_(bflo(sg.x)), o[1] * inv * siluf_(bfhi(sg.x))); wv.y = cvt_pk_bf16(o[2] * inv * siluf_(bflo(sg.y)), o[3] * inv * siluf_(bfhi(sg.y)));
      *(u32x2*)((bf16_t*)(p->ws + WS_OCAT) + (size_t)1 * NTOK * 512 + row * 512 + h * 64 + d) = wv; }
    __syncthreads();
}
constexpr int NPHASE = 16;
__global__ void __launch_bounds__(512, 2) hse_fwd(Params p_) {
    const KP kp = (KP)__builtin_amdgcn_kernarg_segment_ptr();
    (void)p_;
    extern __shared__ __attribute__((aligned(16))) unsigned char lds_raw[];
    LAS unsigned char* lds = (LAS unsigned char*)lds_raw;
    const int tid0 = threadIdx.x;
    const int G = gridDim.x, bid = blockIdx.x, ngw = G * 8;
#define PH_LOCALS const KP p = kp_fresh(kp); int tid = tid0; asm volatile("" : "+v"(tid)); const int lane = tid & 63, wave = __builtin_amdgcn_readfirstlane(tid >> 6), gw = bid * 8 + wave; (void)lane; (void)gw; (void)p;
    if (tid0 < 4) ((LAS unsigned*)(lds + LDS_XB_OFF))[tid0] = 0u;
    __syncthreads();
    unsigned* ctl = (unsigned*)(kp->ws + WS_CTL);
    XcdBarrier bar = xcd_barrier_post(ctl + CW_BAR + kp->li * XCD_BAR_WORDS, (volatile LAS unsigned*)(lds + LDS_XB_OFF));
    const int lo = kp->ph_lo, hi = kp->ph_hi;
#define IN(k) (lo <= (k) && (k) < hi)
#define SEAM(k) do { if (IN(k) && IN((k) + 1)) xcd_barrier(bar); } while (0)
    if (IN(0)) { PH_LOCALS
        for (int u = bid; u < 192; u += G) ada_unit(p, u, lds, tid);
        p0_weights(p, lds, gw, ngw, wave, lane);
    }
    SEAM(0);
    for (int l = 0; l < NLAYER; ++l) {
        const int pb = 1 + 7 * l;
        if (IN(pb)) { PH_LOCALS p1_rows(p, l, gw, ngw, lane); }
        SEAM(pb);
        if (IN(pb + 1)) { PH_LOCALS
            pg8::Gemm g{(const bf16_t*)(p->ws + WS_H), (const bf16_t*)(p->ws + WS_WIN) + (size_t)l * NU * 2048, NTOK, NU, 2048};
            pg8::StaticOrder S; S.init(NTOK, NU, G, bid);
            EpiU E{(bf16_t*)(p->ws + WS_U), p->out, p->in[I_BF], l};
            pg8::gemm_phase<EpiU, pg8::StaticOrder>(lds, g, S, E, nullptr);
        }
        SEAM(pb + 1);
        if (IN(pb + 2)) { PH_LOCALS
            for (int u = bid; u < NRU; u += G) rwkv_r1(p, l, u, lds, tid);
            for (int u = bid; u < 544; u += G) conv_unit(p, l, u, lds, tid);
            for (int u = bid; u < 544; u += G) pool_unit(p, l, u, lds, tid);
            for (int u = bid; u < 256; u += G) { vt_tile(p, u * 8 + wave, lds, wave, lane); }
            __syncthreads();
            for (int u = bid; u < 32; u += G) gs_unit(p, l, u, lds, tid);
            for (int u = G - 1 - bid; u < 8; u += G) fp_unit(p, l, u, lds, tid);
            if (bid == G / 2) shift_out(p, l, tid);
        }
        SEAM(pb + 2);
        if (IN(pb + 3)) { PH_LOCALS
            if (bid < 32) {
                if (wave == 0) rwkv_r2_task(p, l, bid, lane);
                else for (int tk = 32 + bid * 7 + (wave - 1); tk < 32 + 1024; tk += 224) rwkv_r2_task(p, l, tk, lane);
                __syncthreads();
            }
            LAS int* qslot = (LAS int*)(lds + LDS_XB_OFF - 16);
            for (;;) {
                if (tid == 0) *qslot = (int)atomicAdd(ctl + CW_QUEUE + 64 * (2 * l), 1u);
                __syncthreads();
                const int item = *qslot;
                __syncthreads();
                if (item >= 512) break;
                attn_prompt_unit(p, item & 7, 63 - (item >> 3), lds, tid);
            }
            for (;;) {
                if (tid == 0) *qslot = (int)atomicAdd(ctl + CW_QUEUE + 64 * (2 * l + 1), 1u);
                __syncthreads();
                const int item = *qslot;
                __syncthreads();
                if (item >= 256) break;
                attn_sample_unit(p, l, item >> 3, item & 7, lds, tid);
            }
        }
        SEAM(pb + 3);
        if (IN(pb + 4)) { PH_LOCALS for (int tk = gw; tk < NRU * 2; tk += ngw) rwkv_r3_task(p, l, tk, lane); }
        SEAM(pb + 4);
        if (IN(pb + 5)) { PH_LOCALS
            pg8::Gemm g{(const bf16_t*)(p->ws + WS_OCAT), (const bf16_t*)(p->ws + WS_WBR) + (size_t)l * 4 * 2048 * 512, 4 * NTOK, 4 * 2048, 512};
            BranchOrder S{G, bid};
            EpiBranch E{(const bf16_t*)(p->ws + WS_U), (float*)(p->ws + WS_MG), (bf16_t*)(p->ws + WS_MERGED)};
            pg8::gemm_phase<EpiBranch, BranchOrder>(lds, g, S, E, nullptr);
        }
        SEAM(pb + 5);
        if (IN(pb + 6)) { PH_LOCALS
            pg8::Gemm g{(const bf16_t*)(p->ws + WS_MERGED), (const bf16_t*)(p->ws + WS_WOUT) + (size_t)l * 2048 * 2048, NTOK, 2048, 2048};
            pg8::StaticOrder S; S.init(NTOK, 2048, G, bid);
            EpiOut E{p->in[I_XP], p->in[I_XS], (const float*)(p->ws + WS_XBUF), (const float*)(p->ws + WS_ADA), (float*)(p->ws + WS_XBUF), l};
            pg8::gemm_phase<EpiOut, pg8::StaticOrder>(lds, g, S, E, nullptr);
        }
        SEAM(pb + 6);
    }
    if (IN(15)) { PH_LOCALS p_final_rows(p, gw, ngw, lane); }
#undef IN
#undef SEAM
}
#ifndef MK_SPLIT
#define MK_SPLIT 0
#endif
extern "C" void kernel_launch(void* const* d_in, const int* in_sizes, int n_in, void* d_out, int out_size, void* d_ws, size_t ws_size, hipStream_t stream) {
    static int grid = 0;
    if (grid == 0) {
        if (n_in != N_IN || (size_t)out_size != O_END || ws_size < WS_END) { fprintf(stderr, "kernel_launch: unexpected shapes (n_in %d, out %d, ws %zu)\n", n_in, out_size, ws_size); grid = -1; return; }
        int dev = 0, cus = 0, per_cu = 0;
        if (hipGetDevice(&dev) != hipSuccess || hipDeviceGetAttribute(&cus, hipDeviceAttributeMultiprocessorCount, dev) != hipSuccess) { grid = -1; return; }
        if (hipFuncSetAttribute((const void*)hse_fwd, hipFuncAttributeMaxDynamicSharedMemorySize, LDS_BYTES) != hipSuccess) { fprintf(stderr, "kernel_launch: hipFuncSetAttribute failed\n"); grid = -1; return; }
        if (hipOccupancyMaxActiveBlocksPerMultiprocessor(&per_cu, (const void*)hse_fwd, 512, LDS_BYTES) != hipSuccess || per_cu < 1) fprintf(stderr, "kernel_launch: occupancy query reports %d\n", per_cu);
        (void)hipGetLastError();
        grid = cus;
    }
    if (grid < 0) return;
    if (hipMemsetAsync((char*)d_ws + WS_CTL, 0, CTL_BYTES, stream) != hipSuccess) return;
    Params a{};
    for (int i = 0; i < N_IN; ++i) a.in[i] = (const float*)d_in[i];
    a.out = (float*)d_out; a.ws = (unsigned char*)d_ws;
#if MK_SPLIT
    for (int ph = 0; ph < NPHASE; ++ph) { a.ph_lo = ph; a.ph_hi = ph + 1; a.li = ph; hipLaunchKernelGGL(hse_fwd, dim3(grid), dim3(512), LDS_BYTES, stream, a); }
#else
    a.ph_lo = 0; a.ph_hi = NPHASE; a.li = 0;
    hipLaunchKernelGGL(hse_fwd, dim3(grid), dim3(512), LDS_BYTES, stream, a);
#endif
    const hipError_t le = hipPeekAtLastError();
    if (le != hipSuccess) fprintf(stderr, "kernel_launch: launch failed: %s\n", hipGetErrorName(le));
}
```

```cpp
#include <hip/hip_runtime.h>
#include <cstdio>
#include <cstdint>
namespace pg8 {
#define PG8_LAS __attribute__((address_space(3)))
typedef unsigned short bf16_t;
typedef short bf16x8 __attribute__((ext_vector_type(8)));
typedef float f32x4 __attribute__((ext_vector_type(4)));
typedef unsigned u32x4 __attribute__((ext_vector_type(4)));
constexpr int BM = 256, BK = 64, HALF = 128, HTB = HALF * BK * 2  , STAGE_BYTES = 8 * HTB, NXCD = 8, WGM = 8;

__host__ __device__ __forceinline__ int lds_byte(int r, int c) { const int st = (r >> 4) * 2 + (c >> 5), rr = r & 15, cc = c & 31, ob = rr * 64 + cc * 2; return st * 1024 + (ob ^ (((ob >> 9) & 1) << 5)); }
__host__ __device__ __forceinline__ void stage_rc(int b, int& R, int& C) { const int st = b / 1024, sb = b % 1024, swz = sb ^ (((sb >> 9) & 1) << 5); R = (st >> 1) * 16 + swz / 64; C = (st & 1) * 32 + (swz % 64) / 2; }
__host__ __device__ __forceinline__ int perm32(int rho) { const int n = rho >> 4, i = rho & 15; return 8 * (i >> 2) + 4 * n + (i & 3); }

struct Unit { int pm, pn; };
struct Gemm { const bf16_t* A; const bf16_t* Bt; int M, N, K; };

struct StaticOrder {
    int nM, nN, nwg, G, c;
    __host__ __device__ void init(int M, int N, int G_, int c_) { nM = M / BM; nN = N / BM; nwg = nM * nN; G = G_; c = c_; }
    __host__ __device__ bool next(int i, Unit& u) const {
        const long L = (long)i * G + c; if (L >= nwg) return false;
        int wgid = (int)L; { const int q = nwg / NXCD, r = nwg % NXCD, xcd = wgid % NXCD, off = wgid / NXCD; wgid = (xcd < r ? xcd * (q + 1) : r * (q + 1) + (xcd - r) * q) + off; }
        const int nig = WGM * nN, gid = wgid / nig, fm = gid * WGM, gsz = (nM - fm) < WGM ? (nM - fm) : WGM;
        u.pm = fm + ((wgid % nig) % gsz); u.pn = (wgid % nig) / gsz; return true;
    }
    __device__ __forceinline__ void a_ready(const Unit&) const {}
    __device__ __forceinline__ void done(const Unit&) const {}
};
__device__ __forceinline__ unsigned cvt_pk_bf16(float lo, float hi) { unsigned r; asm volatile("v_cvt_pk_bf16_f32 %0, %1, %2" : "=v"(r) : "v"(lo), "v"(hi)); return r; }
typedef float f32x2 __attribute__((ext_vector_type(2)));
template <class Epi, class Sched, bool STAMP = false>
__device__ __forceinline__ void gemm_phase(PG8_LAS unsigned char* lds, const Gemm g, const Sched& S, const Epi& E, unsigned long long* stamps) {
    int tid = threadIdx.x; asm volatile("" : "+v"(tid));
    const int wid = __builtin_amdgcn_readfirstlane(tid >> 6), lane = tid & 63, wr = wid >> 2, wc = wid & 3, fr = lane & 15, fq = lane >> 4;
    const int K = g.K, nt = K / BK;
    int ts_lo = 0, ts_hi = 0, nts = 0; const unsigned long long rt_entry = STAMP ? (unsigned long long)wall_clock64() : 0ull;
#define PG8_STAMP() do { if (STAMP && wid == 0 && nts < 64) { const unsigned long long _c = (unsigned long long)clock64(); \
        ts_lo = (lane == nts) ? (int)(unsigned)_c : ts_lo; ts_hi = (lane == nts) ? (int)(unsigned)(_c >> 32) : ts_hi; ++nts; } } while (0)
    PG8_STAMP();
    unsigned voffA[2], voffB[2];
#pragma unroll
    for (int i = 0; i < 2; ++i) { int R, C; stage_rc(tid * 16 + i * 8192, R, C); const int Rb = Epi::PERM ? ((R & ~31) + perm32(R & 31)) : R;
        voffA[i] = (unsigned)(R * K + C) * 2u; voffB[i] = (unsigned)(Rb * K + C) * 2u; }
    const size_t kstep = (size_t)(BK * 2);
    const size_t hstep = (size_t)HALF * K * 2;
    const size_t tstep = 2 * hstep;
    const unsigned ldsw = (unsigned)wid * 1024u;
    const int aoff = lds_byte(wr * 64 + fr, fq * 8), boff = lds_byte(wc * 32 + fr, fq * 8);
#define PG8_SA(b, h) (((b) * 2 + (h)) * HTB)
#define PG8_SB(b, h) ((4 + (b) * 2 + (h)) * HTB)
#define PG8_STAGE(bufoff, gbase, voff) do { _Pragma("unroll") for (int _i = 0; _i < 2; ++_i) \
        __builtin_amdgcn_global_load_lds((const unsigned*)((const char*)(gbase) + (voff)[_i]), (PG8_LAS unsigned*)(lds + (bufoff) + ldsw + _i * 8192), 16, 0, 0); } while (0)
#define PG8_LDA(dst, b, h) do { _Pragma("unroll") for (int m = 0; m < 4; ++m) _Pragma("unroll") for (int k = 0; k < 2; ++k) dst[m][k] = *(const PG8_LAS bf16x8*)(lds + PG8_SA(b, h) + aoff + m * 2048 + k * 1024); } while (0)
#define PG8_LDB(dst, b, h) do { _Pragma("unroll") for (int n = 0; n < 2; ++n) _Pragma("unroll") for (int k = 0; k < 2; ++k) dst[n][k] = *(const PG8_LAS bf16x8*)(lds + PG8_SB(b, h) + boff + n * 2048 + k * 1024); } while (0)
#define PG8_MMA(ai, bj, At, Bt) do { __builtin_amdgcn_s_setprio(1); _Pragma("unroll") for (int m = 0; m < 4; ++m) _Pragma("unroll") for (int n = 0; n < 2; ++n) _Pragma("unroll") for (int k = 0; k < 2; ++k) \
        acc[ai][bj][m][n] = __builtin_amdgcn_mfma_f32_16x16x32_bf16(Bt[n][k], At[m][k], acc[ai][bj][m][n], 0, 0, 0); __builtin_amdgcn_s_setprio(0); } while (0)
#define PG8_WAIT_V(n) asm volatile("s_waitcnt vmcnt(" #n ")" ::: "memory")
#define PG8_WAIT_L(n) asm volatile("s_waitcnt lgkmcnt(" #n ")" ::: "memory")
#define PG8_BAR __builtin_amdgcn_s_barrier()
#define PG8_SCHED __builtin_amdgcn_sched_barrier(0)
    Unit cur, nxt; int ui = 0;
    if (!S.next(0, cur)) return;
    f32x4 acc[2][2][4][2];
#pragma unroll
    for (int a = 0; a < 2; ++a)
#pragma unroll
        for (int b = 0; b < 2; ++b)
#pragma unroll
            for (int m = 0; m < 4; ++m)
#pragma unroll
                for (int n = 0; n < 2; ++n) acc[a][b][m][n] = (f32x4){0.f, 0.f, 0.f, 0.f};
    bf16x8 At[4][2], B0[2][2], B1[2][2];
    const char* cA = (const char*)g.A + (size_t)cur.pm * tstep; const char* cB = (const char*)g.Bt + (size_t)cur.pn * tstep;
    S.a_ready(cur);
    PG8_STAGE(PG8_SB(0, 0), cB, voffB); PG8_STAGE(PG8_SA(0, 0), cA, voffA); PG8_STAGE(PG8_SB(0, 1), cB + hstep, voffB); PG8_STAGE(PG8_SA(0, 1), cA + hstep, voffA);
    if (wr == 1) PG8_BAR;
    PG8_WAIT_V(4); PG8_BAR;
    PG8_STAGE(PG8_SB(1, 0), cB + kstep, voffB); PG8_STAGE(PG8_SA(1, 0), cA + kstep, voffA); PG8_STAGE(PG8_SB(1, 1), cB + hstep + kstep, voffB);
    PG8_WAIT_V(6); PG8_BAR;
    PG8_STAMP();
    for (;;) {
        const bool has_next = S.next(ui + 1, nxt);
        const char* nA = has_next ? (const char*)g.A + (size_t)nxt.pm * tstep : cA; const char* nB = has_next ? (const char*)g.Bt + (size_t)nxt.pn * tstep : cB;
        for (int t = 0; t < nt; t += 2) {
            const bool last = (t == nt - 2);
            const char* a1 = cA + (size_t)(t + 1) * kstep;
            const char* a2 = last ? nA : cA + (size_t)(t + 2) * kstep; const char* b2 = last ? nB : cB + (size_t)(t + 2) * kstep;
            const char* a3 = a2 + kstep; const char* b3 = b2 + kstep;
            if (last && has_next) S.a_ready(nxt);
            PG8_LDB(B0, 0, 0); PG8_SCHED; PG8_LDA(At, 0, 0); PG8_STAGE(PG8_SA(1, 1), a1 + hstep, voffA);
            PG8_WAIT_L(8); PG8_BAR; PG8_WAIT_L(0); PG8_MMA(0, 0, At, B0); PG8_BAR; PG8_SCHED;
            PG8_LDB(B1, 0, 1); PG8_STAGE(PG8_SB(0, 0), b2, voffB);
            PG8_BAR; PG8_WAIT_L(0); PG8_MMA(0, 1, At, B1); PG8_BAR;
            PG8_LDA(At, 0, 1); PG8_STAGE(PG8_SA(0, 0), a2, voffA);
            PG8_BAR; PG8_WAIT_L(0); PG8_MMA(1, 0, At, B0); PG8_BAR; PG8_SCHED;
            PG8_STAGE(PG8_SB(0, 1), b2 + hstep, voffB);
            PG8_WAIT_V(6); PG8_BAR; PG8_MMA(1, 1, At, B1); PG8_BAR;
            PG8_LDB(B0, 1, 0); PG8_SCHED; PG8_LDA(At, 1, 0); PG8_STAGE(PG8_SA(0, 1), a2 + hstep, voffA);
            PG8_WAIT_L(8); PG8_BAR; PG8_WAIT_L(0); PG8_MMA(0, 0, At, B0); PG8_BAR; PG8_SCHED;
            PG8_LDB(B1, 1, 1); PG8_STAGE(PG8_SB(1, 0), b3, voffB);
            PG8_BAR; PG8_WAIT_L(0); PG8_MMA(0, 1, At, B1); PG8_BAR;
            PG8_LDA(At, 1, 1); PG8_STAGE(PG8_SA(1, 0), a3, voffA);
            PG8_BAR; PG8_WAIT_L(0); PG8_MMA(1, 0, At, B0); PG8_BAR; PG8_SCHED;
            PG8_STAGE(PG8_SB(1, 1), b3 + hstep, voffB);
            PG8_WAIT_V(6); PG8_BAR; PG8_MMA(1, 1, At, B1); PG8_BAR;
        }
        PG8_STAMP();
        if constexpr (!Epi::AFTER_DRAIN) { E(acc, cur, wr, wc, fr, fq); S.done(cur); }
        PG8_STAMP();
        if (!has_next) break;
#pragma unroll
        for (int a = 0; a < 2; ++a)
#pragma unroll
            for (int b = 0; b < 2; ++b)
#pragma unroll
                for (int m = 0; m < 4; ++m)
#pragma unroll
                    for (int n = 0; n < 2; ++n) acc[a][b][m][n] = (f32x4){0.f, 0.f, 0.f, 0.f};
        cur = nxt; cA = nA; cB = nB; ++ui;
    }
    PG8_WAIT_V(0);
    if (wr == 0) PG8_BAR;
    PG8_BAR;
    if constexpr (Epi::AFTER_DRAIN) { E.fused(acc, cur, wr, wc, fr, fq, lds, wid, lane); S.done(cur); }
    PG8_STAMP();
    if (STAMP && wid == 0) { stamps[lane] = lane < nts ? (((unsigned long long)(unsigned)ts_hi << 32) | (unsigned)ts_lo) : 0ull;
        if (lane == 62) stamps[62] = rt_entry; if (lane == 63) stamps[63] = (unsigned long long)wall_clock64(); }
#undef PG8_STAMP
#undef PG8_SA
#undef PG8_SB
#undef PG8_STAGE
#undef PG8_LDA
#undef PG8_LDB
#undef PG8_MMA
#undef PG8_WAIT_V
#undef PG8_WAIT_L
#undef PG8_BAR
#undef PG8_SCHED
}
}
#define XB_TMO      128
#define XB_XCNT(j)  (256  + 64 * (j))
#define XB_XSUB(j)  (1280 + 64 * (j))
#define XB_XGEN(j)  (2304 + 64 * (j))
#define XB_TOP      3328
#define XB_TOPGEN   3392
#define XCD_BAR_WORDS 3456
#define XB_SPIN_CAP (1u << 18)
#define LAS __attribute__((address_space(3)))

__device__ __forceinline__ unsigned xb_ld(unsigned* p)              { return __hip_atomic_load(p, __ATOMIC_RELAXED, __HIP_MEMORY_SCOPE_AGENT); }
__device__ __forceinline__ unsigned xb_add(unsigned* p, unsigned v) { return __hip_atomic_fetch_add(p, v, __ATOMIC_RELAXED, __HIP_MEMORY_SCOPE_AGENT); }
__device__ __forceinline__ unsigned xb_xcc_id() { return (unsigned)__builtin_amdgcn_s_getreg((3 << 11) | 20) & 0xFu; }
#define XB_SPIN(cond, bar) do { unsigned _sp = 0; while (cond) { __builtin_amdgcn_s_sleep(1); \
    if ((++_sp & 255u) == 0u) { if (xb_ld(&(bar)[XB_TMO])) break; if (_sp > XB_SPIN_CAP) { atomicAdd(&(bar)[XB_TMO], 1u); break; } } } } while (0)

struct XcdBarrier {
    unsigned* bar; unsigned x;
    volatile LAS unsigned* st;
};

__device__ __forceinline__ XcdBarrier xcd_barrier_post(unsigned* bar, volatile LAS unsigned* st) {
    XcdBarrier b; b.bar = bar; b.x = xb_xcc_id(); b.st = st;
    if (threadIdx.x == 0) (void)xb_add(&bar[XB_XCNT(b.x)], 1u);
    return b;
}
__device__ __forceinline__ void xcd_barrier_complete(unsigned* bar, unsigned x, unsigned& nloc, unsigned& nx) {
    const unsigned G = gridDim.x * gridDim.y * gridDim.z;
    unsigned sum, cnt, mine, sp = 0u;
    for (;;) {
        sum = 0u; cnt = 0u; mine = 0u;
#pragma unroll
        for (unsigned j = 0; j < 16; ++j) { const unsigned c = xb_ld(&bar[XB_XCNT(j)]); sum += c; cnt += (c > 0u) ? 1u : 0u; mine = (j == x) ? c : mine; }
        if (sum == G) break;
        __builtin_amdgcn_s_sleep(1);
        if ((++sp & 255u) == 0u) { if (xb_ld(&bar[XB_TMO])) break; if (sp > XB_SPIN_CAP) { atomicAdd(&bar[XB_TMO], 1u); break; } }
    }
    nloc = mine > 0u ? mine : 1u; nx = cnt > 0u ? cnt : 1u;
}

__device__ __forceinline__ void xcd_barrier(const XcdBarrier& b) {
    asm volatile("s_waitcnt vmcnt(0)" ::: "memory");
    __syncthreads();
    if (threadIdx.x == 0) {
        unsigned* bar = b.bar;
        __builtin_amdgcn_s_waitcnt(0);
        unsigned nloc = b.st[0], nx = b.st[1];
        if (nloc == 0u) { xcd_barrier_complete(bar, b.x, nloc, nx); b.st[0] = nloc; b.st[1] = nx; }
        const unsigned old = xb_add(&bar[XB_XSUB(b.x)], 1u);
        const unsigned gen = old / nloc;
        if (old + 1u == (gen + 1u) * nloc) {
            __builtin_amdgcn_fence(__ATOMIC_RELEASE, "agent");
            asm volatile("s_waitcnt vmcnt(0)" ::: "memory");
            const unsigned og = xb_add(&bar[XB_TOP], 1u);
            const unsigned tg = og / nx;
            if (og + 1u == (tg + 1u) * nx) xb_add(&bar[XB_TOPGEN], 1u);
            else XB_SPIN(xb_ld(&bar[XB_TOPGEN]) == tg, bar);
            __builtin_amdgcn_fence(__ATOMIC_ACQUIRE, "agent");
            xb_add(&bar[XB_XGEN(b.x)], 1u);
            asm volatile("s_waitcnt vmcnt(0)" ::: "memory");
        } else {
            XB_SPIN(xb_ld(&bar[XB_XGEN(b.x)]) == gen, bar);
            __builtin_amdgcn_fence(__ATOMIC_ACQUIRE, "agent");
            asm volatile("s_waitcnt vmcnt(0)" ::: "memory");
        }
    }
    __syncthreads();
}
typedef unsigned short bf16_t;
typedef short bf16x8 __attribute__((ext_vector_type(8)));
typedef float f32x4 __attribute__((ext_vector_type(4)));
typedef float f32x16 __attribute__((ext_vector_type(16)));
typedef unsigned u32x4 __attribute__((ext_vector_type(4)));
typedef unsigned u32x2 __attribute__((ext_vector_type(2)));
using pg8::cvt_pk_bf16;

constexpr int DM = 2048, TP = 16384, NSB = 32, TSQ = 32, NTOK = TP + NSB * TSQ, NSEQ = 33, PAST = 4096, NLAYER = 2;
constexpr int NU = 15104;
constexpr int U_AVAL = 0, U_AGATE = 512, U_ASG = 1024, U_Q = 1536, U_K = 2048, U_V = 2560, U_BSG = 3072, U_XC = 3584, U_CSG = 5248, U_DIN = 5760, U_DSG = 6272, U_G = 6784, U_F = 14976;
constexpr int IN_W = 14984, SHIFT_W = 1664;
constexpr float LOG2E = 1.4426950408889634f;
enum { I_XP = 0, I_XS, I_CK, I_CV, I_CLF, I_SCONV, I_SSHIFT, I_SWKV, I_SPOOL, I_CP, I_CS, I_NORMG, I_WADA, I_BADA, I_WIN, I_BF, I_CONVW, I_CONVB, I_CLNG, I_CLNB, I_MU, I_W0, I_W2, I_A0, I_A2,
       I_KK, I_KA, I_RK, I_GNG, I_GNB, I_POOLW, I_POOLB, I_POOLS, I_WBR, I_WOUT, I_FING, N_IN };
constexpr size_t O_YP = 0, O_YS = O_YP + (size_t)TP * DM, O_PK = O_YS + (size_t)1024 * DM, O_PV = O_PK + (size_t)2 * TP * 512, O_PLF = O_PV + (size_t)2 * TP * 512, O_PCONV = O_PLF + (size_t)2 * TP * 8,
                 O_PSHIFT = O_PCONV + 2 * 30 * 512, O_PWKV = O_PSHIFT + 2 * 1664, O_PPOOL = O_PWKV + 2 * 8 * 64 * 64, O_SK = O_PPOOL + 2 * 15 * 512, O_SV = O_SK + (size_t)2 * 1024 * 512,
                 O_SLF = O_SV + (size_t)2 * 1024 * 512, O_SCONV = O_SLF + 2 * 1024 * 8, O_SSHIFT = O_SCONV + (size_t)2 * 32 * 30 * 512, O_SWKV = O_SSHIFT + 2 * 32 * 1664,
                 O_SPOOL = O_SWKV + (size_t)2 * 32 * 8 * 64 * 64, O_END = O_SPOOL + (size_t)2 * 32 * 15 * 512;
static_assert(O_END == 75374848, "output size");
constexpr size_t al256(size_t x) { return (x + 255) & ~(size_t)255; }
constexpr int NCU_CH = 288, NRU = NCU_CH * 8;
constexpr size_t WS_CTL = 0, CTL_BYTES = 512 * 1024;
constexpr size_t WS_WIN = CTL_BYTES;
constexpr size_t WS_WBR = al256(WS_WIN + (size_t)2 * NU * 2048 * 2);
constexpr size_t WS_WOUT = al256(WS_WBR + (size_t)2 * 4 * 2048 * 512 * 2);
constexpr size_t WS_POOLW = al256(WS_WOUT + (size_t)2 * 2048 * 2048 * 2);
constexpr size_t WS_ADA = al256(WS_POOLW + (size_t)2 * 4 * 128 * 128 * 2);
constexpr size_t WS_H = al256(WS_ADA + (size_t)2 * 33 * 6144 * 4);
constexpr size_t WS_U = al256(WS_H + (size_t)NTOK * 2048 * 2);
constexpr size_t WS_XBUF = al256(WS_U + (size_t)NTOK * NU * 2);
constexpr size_t WS_OCAT = al256(WS_XBUF + (size_t)NTOK * 2048 * 4);
constexpr size_t WS_Z = al256(WS_OCAT + (size_t)4 * NTOK * 512 * 2);
constexpr size_t WS_MERGED = al256(WS_Z + (size_t)4 * NTOK * 2048 * 2);
constexpr size_t WS_FP = al256(WS_MERGED + (size_t)NTOK * 2048 * 2);
constexpr int GS_LEN = PAST + TSQ;
constexpr size_t WS_GS = al256(WS_FP + (size_t)8 * TP * 4);
constexpr size_t WS_VT = al256(WS_GS + (size_t)32 * 8 * GS_LEN * 4);
constexpr size_t WS_TQ = al256(WS_VT + (size_t)8 * 64 * TP * 2);
constexpr size_t WS_GM = al256(WS_TQ + (size_t)NRU * 4096 * 4);
constexpr size_t WS_ET = al256(WS_GM + (size_t)NRU * 4096 * 4);
constexpr size_t WS_Y0T = al256(WS_ET + (size_t)NRU * 4096 * 4);
constexpr size_t WS_SC = al256(WS_Y0T + (size_t)NRU * 4096 * 4);
constexpr size_t WS_BONUS = al256(WS_SC + (size_t)NRU * 4096 * 4);
constexpr size_t WS_END = al256(WS_BONUS + (size_t)NRU * 64 * 4);
static_assert(WS_END < (size_t)2100 * 1024 * 1024, "workspace map exceeds the guaranteed d_ws size");
constexpr int CW_BAR = 0;
constexpr int CW_QUEUE = 16 * 3456 + 64;
static_assert((CW_QUEUE + 64 * 8) * 4 <= (int)CTL_BYTES, "ctl");
constexpr int LDS_BYTES = 163840 - 256;
constexpr int LDS_XB_OFF = LDS_BYTES - 16;
constexpr int SLOT_F = 64 * 65;

struct Params { const float* in[N_IN]; float* out; unsigned char* ws; int ph_lo, ph_hi, li, pad; };
typedef const __attribute__((address_space(4))) Params* KP;
__device__ __forceinline__ KP kp_fresh(KP k) { asm volatile("" : "+s"(k)); return k; }

__device__ __forceinline__ float bf2f(unsigned short b) { return __uint_as_float(((unsigned)b) << 16); }
__device__ __forceinline__ float bflo(unsigned w) { return __uint_as_float(w << 16); }
__device__ __forceinline__ float bfhi(unsigned w) { return __uint_as_float(w & 0xffff0000u); }
__device__ __forceinline__ unsigned short f2bf(float f) { return (unsigned short)(cvt_pk_bf16(f, 0.f) & 0xffffu); }
__device__ __forceinline__ float sigmoidf_(float x) { return 1.f / (1.f + __expf(-x)); }
__device__ __forceinline__ float siluf_(float x) { return x / (1.f + __expf(-x)); }
__device__ __forceinline__ float log_sigmoidf_(float z) { return fminf(z, 0.f) - log1pf(expf(-fabsf(z))); }
template <int CTRL> __device__ __forceinline__ float dpp_mov(float v) { return __int_as_float(__builtin_amdgcn_update_dpp(0, __float_as_int(v), CTRL, 0xF, 0xF, true)); }
__device__ __forceinline__ float wave_sum(float v) {
    v += dpp_mov<0xB1>(v); v += dpp_mov<0x4E>(v); v += dpp_mov<0x141>(v); v += dpp_mov<0x140>(v);
    const float r0 = __int_as_float(__builtin_amdgcn_readlane(__float_as_int(v), 0)), r1 = __int_as_float(__builtin_amdgcn_readlane(__float_as_int(v), 16));
    const float r2 = __int_as_float(__builtin_amdgcn_readlane(__float_as_int(v), 32)), r3 = __int_as_float(__builtin_amdgcn_readlane(__float_as_int(v), 48));
    return (r0 + r1) + (r2 + r3);
}
__device__ __forceinline__ float xhalf_max(float m) { const auto rr = __builtin_amdgcn_permlane32_swap(__float_as_uint(m), __float_as_uint(m), false, false); return fmaxf(__uint_as_float(rr[0]), __uint_as_float(rr[1])); }
__device__ __forceinline__ float xhalf_sum(float m) { const auto rr = __builtin_amdgcn_permlane32_swap(__float_as_uint(m), __float_as_uint(m), false, false); return __uint_as_float(rr[0]) + __uint_as_float(rr[1]); }
__device__ __forceinline__ float fast_tanh(float x) { const float e = __expf(-2.f * fabsf(x)); const float t = (1.f - e) * __builtin_amdgcn_rcpf(1.f + e); return x < 0.f ? -t : t; }
__device__ __forceinline__ void tr_tile(const float* __restrict__ src, size_t ld, int k0, int c0, int nvalid, bf16_t* __restrict__ dst, int K, LAS float* scr, int lane) {
#pragma unroll 8
    for (int kk = 0; kk < 64; ++kk) scr[kk * 65 + lane] = (lane < nvalid) ? src[(size_t)(k0 + kk) * ld + c0 + lane] : 0.f;
    const int k2 = (lane & 31) * 2, nh = lane >> 5;
#pragma unroll 8
    for (int it = 0; it < 32; ++it) { const int nn = 2 * it + nh; *(unsigned*)(dst + (size_t)nn * K + k0 + k2) = cvt_pk_bf16(scr[k2 * 65 + nn], scr[(k2 + 1) * 65 + nn]); }
}
__device__ __forceinline__ void p0_weights(KP p, LAS unsigned char* lds, int gw, int ngw, int wave, int lane) {
    LAS float* scr = (LAS float*)lds + wave * SLOT_F;
    constexpr int T_WIN = (NU / 64) * 32, T_WBR = 4 * 32 * 8, T_WOUT = 32 * 32, T_POOL = 4 * 2 * 2, T_L = T_WIN + T_WBR + T_WOUT + T_POOL;
    for (int it = gw; it < 2 * T_L; it += ngw) {
        const int l = it / T_L; int r = it % T_L;
        if (r < T_WIN) {
            const int nt = r / 32, kt = r % 32, m0 = nt * 64;
            int c0, nvalid = 64;
            if (m0 < 3072) c0 = m0; else if (m0 < U_F) c0 = m0 + 8; else if (m0 == U_F) { c0 = 3072; nvalid = 8; } else { c0 = 0; nvalid = 0; }
            tr_tile(p->in[I_WIN] + (size_t)l * 2048 * IN_W, IN_W, kt * 64, c0, nvalid, (bf16_t*)(p->ws + WS_WIN) + ((size_t)l * NU + m0) * 2048, 2048, scr, lane);
            continue; }
        r -= T_WIN;
        if (r < T_WBR) {
            const int n = r / 256, q = r % 256, nt = q / 8, kt = q % 8;
            tr_tile(p->in[I_WBR] + ((size_t)(l * 4 + n) * 512) * 2048, 2048, kt * 64, nt * 64, 64, (bf16_t*)(p->ws + WS_WBR) + ((size_t)(l * 4 + n) * 2048 + nt * 64) * 512, 512, scr, lane);
            continue; }
        r -= T_WBR;
        if (r < T_WOUT) {
            const int nt = r / 32, kt = r % 32;
            tr_tile(p->in[I_WOUT] + (size_t)l * 2048 * 2048, 2048, kt * 64, nt * 64, 64, (bf16_t*)(p->ws + WS_WOUT) + ((size_t)l * 2048 + nt * 64) * 2048, 2048, scr, lane);
            continue; }
        r -= T_WOUT;
        {
            const int g = r / 4, q = r % 4, nt = q / 2, kt = q % 2;
            tr_tile(p->in[I_POOLW] + (size_t)(l * 4 + g) * 128 * 128, 128, kt * 64, nt * 64, 64, (bf16_t*)(p->ws + WS_POOLW) + ((size_t)(l * 4 + g) * 128 + nt * 64) * 128, 128, scr, lane);
        }
    }
}
__device__ __forceinline__ void ada_unit(KP p, int unit, LAS unsigned char* lds, int tid) {
    const int wave = tid >> 6, lane = tid & 63, l = unit / 96, n0 = (unit % 96) * 64;
    LAS float* cs = (LAS float*)lds + wave * (33 * 64);
    LAS float* red = (LAS float*)lds + 8 * 33 * 64;
    const float* W = p->in[I_WADA] + (size_t)l * 2048 * 6144;
    const float* cp = p->in[I_CP]; const float* csm = p->in[I_CS];
    float acc[33];
#pragma unroll
    for (int s = 0; s < 33; ++s) acc[s] = 0.f;
    for (int ch = 0; ch < 4; ++ch) {
        const int k0 = wave * 256 + ch * 64;
#pragma unroll
        for (int s = 0; s < 33; ++s) { const float c = (s == 0) ? cp[k0 + lane] : csm[(size_t)(s - 1) * 2048 + k0 + lane]; cs[s * 64 + lane] = siluf_(c); }
        for (int kk = 0; kk < 64; kk += 4) {
            const float w0 = W[(size_t)(k0 + kk) * 6144 + n0 + lane], w1 = W[(size_t)(k0 + kk + 1) * 6144 + n0 + lane], w2 = W[(size_t)(k0 + kk + 2) * 6144 + n0 + lane], w3 = W[(size_t)(k0 + kk + 3) * 6144 + n0 + lane];
#pragma unroll
            for (int s = 0; s < 33; ++s) { const f32x4 c4 = *(const LAS f32x4*)(cs + s * 64 + kk); acc[s] += c4.x * w0 + c4.y * w1 + c4.z * w2 + c4.w * w3; }
        }
    }
#pragma unroll
    for (int s = 0; s < 33; ++s) red[(wave * 33 + s) * 64 + lane] = acc[s];
    __syncthreads();
    for (int idx = tid; idx < 33 * 64; idx += 512) { const int s = idx >> 6, n = idx & 63; float v = p->in[I_BADA][l * 6144 + n0 + n];
#pragma unroll
        for (int w = 0; w < 8; ++w) v += red[(w * 33 + s) * 64 + n];
        ((float*)(p->ws + WS_ADA))[((size_t)l * 33 + s) * 6144 + n0 + n] = v; }
    __syncthreads();
}
__device__ __forceinline__ const float* x_row(KP p, int l, int row) {
    return l == 0 ? (row < TP ? p->in[I_XP] + (size_t)row * DM : p->in[I_XS] + (size_t)(row - TP) * DM) : (const float*)(p->ws + WS_XBUF) + (size_t)row * DM;
}
__device__ __forceinline__ void p1_rows(KP p, int l, int gw, int ngw, int lane) {
    const f32x4* g4 = (const f32x4*)(p->in[I_NORMG] + l * DM) + lane;
    for (int row = gw; row < NTOK; row += ngw) {
        const f32x4* x4 = (const f32x4*)x_row(p, l, row) + lane;
        const int seq = row < TP ? 0 : 1 + ((row - TP) >> 5);
        const f32x4* sh4 = (const f32x4*)((const float*)(p->ws + WS_ADA) + ((size_t)l * 33 + seq) * 6144) + lane; const f32x4* sc4 = sh4 + 512;
        f32x4 v[8]; float ss = 0.f;
#pragma unroll
        for (int j = 0; j < 8; ++j) { v[j] = x4[64 * j]; ss += (v[j].x * v[j].x + v[j].y * v[j].y) + (v[j].z * v[j].z + v[j].w * v[j].w); }
        const float rstd = 1.f / sqrtf(wave_sum(ss) * (1.f / DM) + 1e-6f);
        u32x2* o = (u32x2*)((bf16_t*)(p->ws + WS_H) + (size_t)row * DM) + lane;
#pragma unroll
        for (int j = 0; j < 8; ++j) { const f32x4 g = g4[64 * j], sc = sc4[64 * j], sh = sh4[64 * j]; const f32x4 y = v[j] * rstd * g * (sc + 1.f) + sh;
            u32x2 w; w.x = cvt_pk_bf16(y.x, y.y); w.y = cvt_pk_bf16(y.z, y.w); o[64 * j] = w; }
    }
}
__device__ __forceinline__ void p_final_rows(KP p, int gw, int ngw, int lane) {
    const f32x4* g4 = (const f32x4*)p->in[I_FING] + lane;
    for (int row = gw; row < NTOK; row += ngw) {
        const f32x4* x4 = (const f32x4*)((const float*)(p->ws + WS_XBUF) + (size_t)row * DM) + lane;
        f32x4 v[8]; float ss = 0.f;
#pragma unroll
        for (int j = 0; j < 8; ++j) { v[j] = x4[64 * j]; ss += (v[j].x * v[j].x + v[j].y * v[j].y) + (v[j].z * v[j].z + v[j].w * v[j].w); }
        const float rstd = 1.f / sqrtf(wave_sum(ss) * (1.f / DM) + 1e-6f);
        f32x4* o = (f32x4*)(p->out + O_YP + (size_t)row * DM) + lane;
#pragma unroll
        for (int j = 0; j < 8; ++j) o[64 * j] = v[j] * rstd * g4[64 * j];
    }
}
struct EpiU {
    static constexpr bool PERM = true, AFTER_DRAIN = false;
    bf16_t* U; float* out; const float* bf; int l;
    __device__ __forceinline__ void operator()(const f32x4 (&acc)[2][2][4][2], const pg8::Unit& u, int wr, int wc, int fr, int fq) const {
        const int row0 = u.pm * 256 + wr * 64 + fr, col0 = u.pn * 256 + wc * 32 + 8 * fq;
#pragma unroll
        for (int ai = 0; ai < 2; ++ai)
#pragma unroll
            for (int m = 0; m < 4; ++m) { bf16_t* rowp = U + (size_t)(row0 + ai * 128 + m * 16) * NU + col0;
#pragma unroll
                for (int bj = 0; bj < 2; ++bj) { const f32x4 v0 = acc[ai][bj][m][0], v1 = acc[ai][bj][m][1];
                    u32x4 w; w.x = cvt_pk_bf16(v0[0], v0[1]); w.y = cvt_pk_bf16(v0[2], v0[3]); w.z = cvt_pk_bf16(v1[0], v1[1]); w.w = cvt_pk_bf16(v1[2], v1[3]);
                    *(u32x4*)(rowp + bj * 128) = w; } }
        if (u.pn >= 8 && u.pn < 12) {
            const bool isv = u.pn >= 10; const int cin = (u.pn - (isv ? 10 : 8)) * 256 + wc * 32 + 8 * fq;
#pragma unroll
            for (int ai = 0; ai < 2; ++ai)
#pragma unroll
                for (int m = 0; m < 4; ++m) { const int row = row0 + ai * 128 + m * 16;
                    float* dst = row < TP ? out + (isv ? O_PV : O_PK) + ((size_t)l * TP + row) * 512 : out + (isv ? O_SV : O_SK) + ((size_t)l * 1024 + (row - TP)) * 512;
#pragma unroll
                    for (int bj = 0; bj < 2; ++bj) { *(f32x4*)(dst + cin + bj * 128) = acc[ai][bj][m][0]; *(f32x4*)(dst + cin + bj * 128 + 4) = acc[ai][bj][m][1]; } }
        }
        if (u.pn == 58 && wc == 0 && fq == 0) {
            const f32x4 b0 = *(const f32x4*)(bf + l * 8), b1 = *(const f32x4*)(bf + l * 8 + 4);
#pragma unroll
            for (int ai = 0; ai < 2; ++ai)
#pragma unroll
                for (int m = 0; m < 4; ++m) { const int row = row0 + ai * 128 + m * 16;
                    float* dst = row < TP ? out + O_PLF + ((size_t)l * TP + row) * 8 : out + O_SLF + ((size_t)l * 1024 + (row - TP)) * 8;
                    const f32x4 z0 = acc[ai][1][m][0] + b0, z1 = acc[ai][1][m][1] + b1; f32x4 o0, o1;
#pragma unroll
                    for (int e = 0; e < 4; ++e) { o0[e] = log_sigmoidf_(z0[e]); o1[e] = log_sigmoidf_(z1[e]); }
                    *(f32x4*)dst = o0; *(f32x4*)(dst + 4) = o1; }
        }
    }
};
struct BranchOrder {
    int G, c;
    __device__ __forceinline__ bool next(int i, pg8::Unit& u) const { const int L = i * G + c; if (L >= 4 * 544) return false; const int n = L / 544, t = L - n * 544; u.pm = n * 68 + (t >> 3); u.pn = n * 8 + (t & 7); return true; }
    __device__ __forceinline__ void a_ready(const pg8::Unit&) const {}
    __device__ __forceinline__ void done(const pg8::Unit&) const {}
};
struct EpiZ {
    static constexpr bool PERM = true, AFTER_DRAIN = false;
    bf16_t* Z;
    __device__ __forceinline__ void operator()(const f32x4 (&acc)[2][2][4][2], const pg8::Unit& u, int wr, int wc, int fr, int fq) const {
        const int row0 = u.pm * 256 + wr * 64 + fr, col0 = (u.pn & 7) * 256 + wc * 32 + 8 * fq;
#pragma unroll
        for (int ai = 0; ai < 2; ++ai)
#pragma unroll
            for (int m = 0; m < 4; ++m) { bf16_t* rowp = Z + (size_t)(row0 + ai * 128 + m * 16) * DM + col0;
#pragma unroll
                for (int bj = 0; bj < 2; ++bj) { const f32x4 v0 = acc[ai][bj][m][0], v1 = acc[ai][bj][m][1];
                    u32x4 w; w.x = cvt_pk_bf16(v0[0], v0[1]); w.y = cvt_pk_bf16(v0[2], v0[3]); w.z = cvt_pk_bf16(v1[0], v1[1]); w.w = cvt_pk_bf16(v1[2], v1[3]);
                    *(u32x4*)(rowp + bj * 128) = w; } }
    }
};
__device__ __forceinline__ void merge_pass(KP p, int gtid, int ngt) {
    const bf16_t* U = (const bf16_t*)(p->ws + WS_U); const bf16_t* Z = (const bf16_t*)(p->ws + WS_Z); bf16_t* M = (bf16_t*)(p->ws + WS_MERGED);
    for (int it = gtid; it < NTOK * 256; it += ngt) { const int row = it >> 8, col = (it & 255) * 8;
        float s[8];
#pragma unroll
        for (int e = 0; e < 8; ++e) s[e] = 0.f;
#pragma unroll
        for (int n = 0; n < 4; ++n) { const u32x4 g = *(const u32x4*)(U + (size_t)row * NU + U_G + n * 2048 + col); const u32x4 z = *(const u32x4*)(Z + ((size_t)n * NTOK + row) * DM + col);
            s[0] += sigmoidf_(bflo(g.x)) * bflo(z.x); s[1] += sigmoidf_(bfhi(g.x)) * bfhi(z.x); s[2] += sigmoidf_(bflo(g.y)) * bflo(z.y); s[3] += sigmoidf_(bfhi(g.y)) * bfhi(z.y);
            s[4] += sigmoidf_(bflo(g.z)) * bflo(z.z); s[5] += sigmoidf_(bfhi(g.z)) * bfhi(z.z); s[6] += sigmoidf_(bflo(g.w)) * bflo(z.w); s[7] += sigmoidf_(bfhi(g.w)) * bfhi(z.w); }
        u32x4 w; w.x = cvt_pk_bf16(s[0], s[1]); w.y = cvt_pk_bf16(s[2], s[3]); w.z = cvt_pk_bf16(s[4], s[5]); w.w = cvt_pk_bf16(s[6], s[7]);
        *(u32x4*)(M + (size_t)row * DM + col) = w; }
}
struct EpiOut {
    static constexpr bool PERM = false, AFTER_DRAIN = false;
    const float* xp; const float* xs; const float* xb; const float* ada; float* xout; int l;
    __device__ __forceinline__ void operator()(const f32x4 (&acc)[2][2][4][2], const pg8::Unit& u, int wr, int wc, int fr, int fq) const {
        const int row0 = u.pm * 256 + wr * 64 + fr, col0 = u.pn * 256 + wc * 32 + 4 * fq;
#pragma unroll
        for (int ai = 0; ai < 2; ++ai)
#pragma unroll
            for (int m = 0; m < 4; ++m) { const int row = row0 + ai * 128 + m * 16;
                const float* base = l == 0 ? (row < TP ? xp + (size_t)row * DM : xs + (size_t)(row - TP) * DM) : xb + (size_t)row * DM;
                const int seq = row < TP ? 0 : 1 + ((row - TP) >> 5);
                const float* gate = ada + ((size_t)l * 33 + seq) * 6144 + 4096;
#pragma unroll
                for (int bj = 0; bj < 2; ++bj)
#pragma unroll
                    for (int n = 0; n < 2; ++n) { const int col = col0 + bj * 128 + n * 16;
                        *(f32x4*)(xout + (size_t)row * DM + col) = *(const f32x4*)(base + col) + *(const f32x4*)(gate + col) * acc[ai][bj][m][n]; } }
    }
};
__device__ __forceinline__ void conv_unit(KP p, int l, int tile, LAS unsigned char* lds, int tid) {
    const bf16_t* U = (const bf16_t*)(p->ws + WS_U);
    const int c = tid, wave = tid >> 6, lane = tid & 63;
    const bool samp = tile >= 512; const int b = tile - 512, row0 = samp ? TP + b * 32 : tile * 32;
    const bool last = samp || tile == 511;
    LAS float* red = (LAS float*)lds;
    LAS float* st = red + 8 * 32;
    const float cb = p->in[I_CONVB][l * 512 + c], lg = p->in[I_CLNG][l * 512 + c], lb = p->in[I_CLNB][l * 512 + c];
    bf16_t* oa = (bf16_t*)(p->ws + WS_OCAT);
#pragma unroll 1
    for (int half = 0; half < 2; ++half) {
        float z[46];
#pragma unroll
        for (int i = 0; i < 46; ++i) { const int rel = 16 * half + i - 30; float v;
            if (rel >= 0) { const size_t r = (size_t)(row0 + rel) * NU; v = bf2f(U[r + U_AVAL + c]) * sigmoidf_(bf2f(U[r + U_AGATE + c])); }
            else if (samp) v = p->in[I_SCONV][(((size_t)l * 32 + b) * 30 + (30 + rel)) * 512 + c];
            else if (row0 == 0) v = 0.f;
            else { const size_t r = (size_t)(row0 + rel) * NU; v = bf2f(U[r + U_AVAL + c]) * sigmoidf_(bf2f(U[r + U_AGATE + c])); }
            z[i] = v; }
        if (last) {
            float* dst = samp ? p->out + O_SCONV + (((size_t)l * 32 + b) * 30) * 512 + c : p->out + O_PCONV + ((size_t)l * 30) * 512 + c;
#pragma unroll
            for (int tt = 0; tt < 16; ++tt) { const int t = 16 * half + tt; if (t >= 2) dst[(size_t)(t - 2) * 512] = z[30 + tt]; }
        }
        float hv[16];
#pragma unroll
        for (int tt = 0; tt < 16; ++tt) hv[tt] = cb;
#pragma unroll
        for (int k = 0; k < 31; ++k) { const float w = p->in[I_CONVW][((size_t)l * 31 + k) * 512 + c];
#pragma unroll
            for (int tt = 0; tt < 16; ++tt) hv[tt] += z[tt + k] * w; }
#pragma unroll
        for (int tt = 0; tt < 16; ++tt) { const float s1 = wave_sum(hv[tt]), s2 = wave_sum(hv[tt] * hv[tt]); if (lane == 0) { red[(wave * 16 + tt) * 2] = s1; red[(wave * 16 + tt) * 2 + 1] = s2; } }
        __syncthreads();
        if (tid < 16) { float s1 = 0.f, s2 = 0.f;
#pragma unroll
            for (int w = 0; w < 8; ++w) { s1 += red[(w * 16 + tid) * 2]; s2 += red[(w * 16 + tid) * 2 + 1]; }
            const float mean = s1 * (1.f / 512.f), var = fmaxf(s2 * (1.f / 512.f) - mean * mean, 0.f);
            st[tid * 2] = mean; st[tid * 2 + 1] = 1.f / sqrtf(var + 1e-5f); }
        __syncthreads();
#pragma unroll
        for (int tt = 0; tt < 16; ++tt) { const float y = (hv[tt] - st[tt * 2]) * st[tt * 2 + 1] * lg + lb; const size_t r = (size_t)(row0 + 16 * half + tt);
            oa[r * 512 + c] = f2bf(siluf_(y) * siluf_(bf2f(U[r * NU + U_ASG + c]))); }
        __syncthreads();
    }
}
__device__ __forceinline__ void pool_unit(KP p, int l, int tile, LAS unsigned char* lds, int tid) {
    const bf16_t* U = (const bf16_t*)(p->ws + WS_U);
    const int c = tid, wave = tid >> 6, lane = tid & 63;
    const bool samp = tile >= 512; const int b = tile - 512, row0 = samp ? TP + b * 32 : tile * 32;
    constexpr int PST = 520;
    LAS bf16_t* pl = (LAS bf16_t*)lds;
    {
        float z[47];
#pragma unroll
        for (int i = 0; i < 15; ++i) {
            float v;
            if (samp) v = p->in[I_SPOOL][(((size_t)l * 32 + b) * 15 + i) * 512 + c];
            else if (row0 == 0) v = 0.f;
            else v = bf2f(U[(size_t)(row0 - 15 + i) * NU + U_DIN + c]);
            z[i] = v; }
#pragma unroll
        for (int t = 0; t < 32; ++t) z[15 + t] = bf2f(U[(size_t)(row0 + t) * NU + U_DIN + c]);
        if (samp || tile == 511) {
            float* dst = samp ? p->out + O_SPOOL + (((size_t)l * 32 + b) * 15) * 512 + c : p->out + O_PPOOL + ((size_t)l * 15) * 512 + c;
#pragma unroll
            for (int t = 17; t < 32; ++t) dst[(size_t)(t - 17) * 512] = z[15 + t];
        }
        const int w = 2 << (c >> 7);
#pragma unroll
        for (int t = 0; t < 32; ++t) { float s = 0.f;
#pragma unroll
            for (int i = 0; i < 16; ++i) s += (i < w) ? z[15 + t - i] : 0.f;
            const int pos = samp ? PAST + t : row0 + t; const int cnt = (pos + 1 < w) ? pos + 1 : w;
            pl[t * PST + c] = f2bf(s / (float)cnt - z[15 + t]); }
    }
    __syncthreads();
    {
        const int g = wave >> 1, fr = lane & 15, kq = lane >> 4;
        const bf16_t* WT = (const bf16_t*)(p->ws + WS_POOLW) + (size_t)(l * 4 + g) * 128 * 128;
        f32x4 acc[2][4];
#pragma unroll
        for (int mt = 0; mt < 2; ++mt)
#pragma unroll
            for (int nt = 0; nt < 4; ++nt) acc[mt][nt] = (f32x4){0.f, 0.f, 0.f, 0.f};
#pragma unroll
        for (int ks = 0; ks < 4; ++ks) {
            bf16x8 af[2];
#pragma unroll
            for (int mt = 0; mt < 2; ++mt) af[mt] = *(const LAS bf16x8*)(pl + (16 * mt + fr) * PST + g * 128 + 32 * ks + 8 * kq);
#pragma unroll
            for (int nt = 0; nt < 4; ++nt) { const int dl = (wave & 1) * 64 + 16 * nt + fr;
                const bf16x8 bfr = *(const bf16x8*)(WT + (size_t)dl * 128 + 32 * ks + 8 * kq);
#pragma unroll
                for (int mt = 0; mt < 2; ++mt) acc[mt][nt] = __builtin_amdgcn_mfma_f32_16x16x32_bf16(af[mt], bfr, acc[mt][nt], 0, 0, 0); }
        }
        bf16_t* od = (bf16_t*)(p->ws + WS_OCAT) + (size_t)3 * NTOK * 512;
#pragma unroll
        for (int nt = 0; nt < 4; ++nt) { const int d = wave * 64 + 16 * nt + fr; const float pb = p->in[I_POOLB][l * 512 + d], ps = p->in[I_POOLS][l * 512 + d];
#pragma unroll
            for (int mt = 0; mt < 2; ++mt)
#pragma unroll
                for (int r = 0; r < 4; ++r) { const size_t row = (size_t)(row0 + 16 * mt + 4 * kq + r);
                    od[row * 512 + d] = f2bf((acc[mt][nt][r] + pb) * ps * siluf_(bf2f(U[row * NU + U_DSG + d]))); } }
    }
    __syncthreads();
}
__device__ __forceinline__ void fp_unit(KP p, int l, int h, LAS unsigned char* lds, int tid) {
    const float* lf = p->out + O_PLF + (size_t)l * TP * 8 + h;
    LAS float* part = (LAS float*)lds;
    float v[32]; float s = 0.f;
#pragma unroll
    for (int i = 0; i < 32; ++i) { v[i] = lf[(size_t)(tid * 32 + i) * 8]; s += v[i]; }
    part[tid] = s;
    __syncthreads();
    float pre = 0.f;
    for (int j = 0; j < tid; ++j) pre += part[j];
    float* F = (float*)(p->ws + WS_FP) + (size_t)h * TP + tid * 32;
#pragma unroll
    for (int i = 0; i < 32; ++i) { pre += v[i]; F[i] = pre * LOG2E; }
    __syncthreads();
}
__device__ __forceinline__ void gs_unit(KP p, int l, int b, LAS unsigned char* lds, int tid) {
    const int h = tid & 7, ch = tid >> 3;
    const float* cl = p->in[I_CLF] + (((size_t)l * 32 + b) * PAST) * 8 + h;
    LAS float* part = (LAS float*)lds;
    float s = 0.f;
    for (int i = 0; i < 64; ++i) s += cl[(size_t)(ch * 64 + i) * 8];
    part[ch * 8 + h] = s;
    __syncthreads();
    float suf = 0.f;
    for (int j = ch + 1; j < 64; ++j) suf += part[j * 8 + h];
    float* G = (float*)(p->ws + WS_GS) + ((size_t)b * 8 + h) * GS_LEN;
    for (int i = 63; i >= 0; --i) { const int t = ch * 64 + i; G[t] = -suf * LOG2E; suf += cl[(size_t)t * 8]; }
    if (tid < 8) { const float* nl = p->out + O_SLF + ((size_t)l * 1024 + b * 32) * 8 + tid; float run = 0.f;
        for (int i = 0; i < 32; ++i) { run += nl[i * 8]; G[PAST + i] = run * LOG2E; } }
    __syncthreads();
}
__device__ __forceinline__ void vt_tile(KP p, int tile, LAS unsigned char* lds, int wave, int lane) {
    const int h = tile >> 8, tb = tile & 255;
    const bf16_t* U = (const bf16_t*)(p->ws + WS_U);
    LAS unsigned* scr = (LAS unsigned*)lds + wave * SLOT_F;
#pragma unroll 8
    for (int tt = 0; tt < 64; ++tt) scr[tt * 65 + lane] = U[(size_t)(tb * 64 + tt) * NU + U_V + h * 64 + lane];
    bf16_t* Vt = (bf16_t*)(p->ws + WS_VT);
    const int t2 = (lane & 31) * 2, dh = lane >> 5;
#pragma unroll 8
    for (int it = 0; it < 32; ++it) { const int d = 2 * it + dh; *(unsigned*)(Vt + ((size_t)h * 64 + d) * TP + tb * 64 + t2) = scr[t2 * 65 + d] | (scr[(t2 + 1) * 65 + d] << 16); }
}
__device__ __forceinline__ void shift_out(KP p, int l, int tid) {
    const bf16_t* U = (const bf16_t*)(p->ws + WS_U);
    for (int idx = tid; idx < NSEQ * SHIFT_W; idx += 512) { const int s = idx / SHIFT_W, j = idx - s * SHIFT_W;
        const int row = s == 0 ? TP - 1 : TP + (s - 1) * 32 + 31;
        float* dst = s == 0 ? p->out + O_PSHIFT + (size_t)l * SHIFT_W + j : p->out + O_SSHIFT + ((size_t)l * 32 + (s - 1)) * SHIFT_W + j;
        *dst = bf2f(U[(size_t)row * NU + U_XC + j]); }
}
template <bool AT, bool BT, bool NEGA>
__device__ __forceinline__ void mm32(f32x16& acc, const LAS float* Ap, int i0, const LAS float* Bp, int j0, int lane) {
    const int li = lane & 31, kh = lane >> 5;
    const LAS float* ap = AT ? Ap + kh * 65 + i0 + li : Ap + (i0 + li) * 65 + kh;
    const LAS float* bp = BT ? Bp + (j0 + li) * 65 + kh : Bp + kh * 65 + j0 + li;
#pragma unroll 8
    for (int s = 0; s < 32; ++s) {
        float a = AT ? ap[s * 130] : ap[s * 2];
        const float b = BT ? bp[s * 2] : bp[s * 130];
        if (NEGA) a = -a;
        acc = __builtin_amdgcn_mfma_f32_32x32x2f32(a, b, acc, 0, 0, 0);
    }
}
template <int MASK>
__device__ __forceinline__ void st_tile(LAS float* dst, const f32x16& acc, int i0, int j0, int lane) {
    const int li = lane & 31, hi = lane >> 5, j = j0 + li;
#pragma unroll
    for (int r = 0; r < 16; ++r) { const int i = i0 + (r & 3) + 8 * (r >> 2) + 4 * hi; float v = acc[r];
        if (MASK == 1 && !(i < j)) v = 0.f; if (MASK == 2 && !(i <= j)) v = 0.f; dst[i * 65 + j] = v; }
}
struct RwkvSeqInfo { int row0, ntok, prev_kind  , b; };
__device__ __forceinline__ RwkvSeqInfo rwkv_info(int cu) { RwkvSeqInfo s; if (cu < 256) { s.row0 = cu * 64; s.ntok = 64; s.prev_kind = cu == 0 ? 0 : 1; s.b = 0; } else { s.b = cu - 256; s.row0 = TP + s.b * 32; s.ntok = 32; s.prev_kind = 2; } return s; }

__device__ __forceinline__ void rwkv_r1(KP p, int l, int unit, LAS unsigned char* lds, int tid) {
    const int cu = unit >> 3, h = unit & 7, wave = tid >> 6, lane = tid & 63, li = lane & 31, hi = lane >> 5;
    const RwkvSeqInfo si = rwkv_info(cu);
    const bf16_t* U = (const bf16_t*)(p->ws + WS_U);
    LAS float* S0 = (LAS float*)lds; LAS float *S1 = S0 + SLOT_F, *S2 = S0 + 2 * SLOT_F, *S3 = S0 + 3 * SLOT_F, *S4 = S0 + 4 * SLOT_F, *S5 = S0 + 5 * SLOT_F, *S6 = S0 + 6 * SLOT_F, *S7 = S0 + 7 * SLOT_F, *S8 = S0 + 8 * SLOT_F;
    LAS float* gC = S0 + 9 * SLOT_F;
    const int q = wave >> 2, wq = wave & 3, i0 = (wq >> 1) * 32, j0 = (wq & 1) * 32;
    {
        const int j = tid & 63, tq = tid >> 6;
        const int offs[5] = {h * 64, 512 + h * 64, 1024 + h * 64, 1536, 1600};
#pragma unroll
        for (int cs = 0; cs < 5; ++cs) {
            const int xo = offs[cs] + j; const float mu = p->in[I_MU][l * SHIFT_W + xo];
            LAS float* dst = cs == 0 ? S0 : cs == 1 ? S1 : cs == 2 ? S2 : cs == 3 ? S3 : S4;
            const int t0 = tq * 8; float prev;
            if (t0 == 0) prev = si.prev_kind == 0 ? 0.f : si.prev_kind == 1 ? bf2f(U[(size_t)(si.row0 - 1) * NU + U_XC + xo]) : p->in[I_SSHIFT][((size_t)l * 32 + si.b) * SHIFT_W + xo];
            else prev = (t0 - 1 < si.ntok) ? bf2f(U[(size_t)(si.row0 + t0 - 1) * NU + U_XC + xo]) : 0.f;
#pragma unroll
            for (int tt = 0; tt < 8; ++tt) { const int t = t0 + tt; float xs = 0.f;
                if (t < si.ntok) { const float x = bf2f(U[(size_t)(si.row0 + t) * NU + U_XC + xo]); xs = x + (prev - x) * mu; prev = x; }
                if (cs == 3) xs = fast_tanh(xs);
                dst[t * 65 + j] = xs; }
        }
#pragma unroll
        for (int mm = 0; mm < 8; ++mm) { const int m = tq * 8 + mm;
            S5[m * 65 + j] = p->in[I_W2][((size_t)l * 64 + m) * 512 + h * 64 + j]; S6[m * 65 + j] = p->in[I_A2][((size_t)l * 64 + m) * 512 + h * 64 + j]; }
    }
    __syncthreads();
    {
        f32x16 acc = {};
        const int c = j0 + li;
        if (q == 0) { mm32<false, false, false>(acc, S3, i0, S5, j0, lane); const float w0 = p->in[I_W0][l * 512 + h * 64 + c];
#pragma unroll
            for (int r = 0; r < 16; ++r) { const int t = i0 + (r & 3) + 8 * (r >> 2) + 4 * hi; const float zz = acc[r] + w0;
                const float sp = fmaxf(-zz, 0.f) + __logf(1.f + __expf(-fabsf(zz)));
                S7[t * 65 + c] = (t < si.ntok) ? -__expf(-sp - 0.5f) : 0.f; } }
        else { mm32<false, false, false>(acc, S4, i0, S6, j0, lane); const float a0 = p->in[I_A0][l * 512 + h * 64 + c];
#pragma unroll
            for (int r = 0; r < 16; ++r) { const int t = i0 + (r & 3) + 8 * (r >> 2) + 4 * hi; S8[t * 65 + c] = __builtin_amdgcn_rcpf(1.f + __expf(-(acc[r] + a0))); } }
    }
    __syncthreads();
    if (wave == 0) { float run = 0.f;
#pragma unroll 8
        for (int t = 0; t < 64; ++t) { run += S7[t * 65 + lane]; S3[t * 65 + lane] = run; } }
    else { const int c = lane; const float kkw = p->in[I_KK][l * 512 + h * 64 + c], kaw = p->in[I_KA][l * 512 + h * 64 + c], rkw = p->in[I_RK][l * 512 + h * 64 + c];
        for (int t = wave - 1; t < 64; t += 7) { const float kr = S1[t * 65 + c], kv = kr * kkw; const float ss = wave_sum(kv * kv);
            const float kn = kv * (1.f / sqrtf(fmaxf(ss, 1e-24f))); const float a = S8[t * 65 + c]; const float km = kr * (1.f + (a - 1.f) * kaw);
            const float bon = wave_sum(S0[t * 65 + c] * km * rkw);
            S4[t * 65 + c] = kn; S1[t * 65 + c] = km; S8[t * 65 + c] = kn * a;
            if (lane == 0) ((float*)(p->ws + WS_BONUS))[(size_t)unit * 64 + t] = bon; } }
    __syncthreads();
    { const int c = tid & 63, tq = tid >> 6;
#pragma unroll
        for (int tt = 0; tt < 8; ++tt) { const int t = tq * 8 + tt, o = t * 65 + c; const float Lg = S3[o], lw = S7[o];
            const float g = __expf(Lg), gi = __expf(-Lg), gp = __expf(Lg - lw);
            S0[o] *= g; S1[o] *= gi; S8[o] *= gi; S4[o] *= gp; if (t == 63) gC[c] = g; } }
    __syncthreads();
    { f32x16 acc = {};
      if (q == 0) { mm32<false, true, false>(acc, S1, i0, S4, j0, lane); st_tile<1>(S3, acc, i0, j0, lane); }
      else { mm32<false, true, false>(acc, S8, i0, S4, j0, lane); st_tile<1>(S5, acc, i0, j0, lane); } }
    __syncthreads();
    { f32x16 acc = {};
      if (q == 0) { mm32<true, false, false>(acc, S2, i0, S3, j0, lane); st_tile<0>(S6, acc, i0, j0, lane); }
      else { mm32<false, true, false>(acc, S1, i0, S0, j0, lane); st_tile<2>(S7, acc, i0, j0, lane); } }
    __syncthreads();
    { float x[16]; const int r0 = (wave & 3) * 16;
      if (wave < 4) {
#pragma unroll
          for (int rr = 0; rr < 16; ++rr) x[rr] = S4[lane * 65 + r0 + rr]; }
      else {
#pragma unroll
          for (int rr = 0; rr < 16; ++rr) x[rr] = S6[(r0 + rr) * 65 + lane]; }
      __syncthreads();
#pragma unroll
      for (int s = 0; s < 63; ++s) { const float mrow = S5[s * 65 + lane];
#pragma unroll
          for (int rr = 0; rr < 16; ++rr) x[rr] -= __builtin_bit_cast(float, __builtin_amdgcn_readlane(__builtin_bit_cast(int, x[rr]), s)) * mrow; }
      LAS float* dst = wave < 4 ? S3 : S6;
#pragma unroll
      for (int rr = 0; rr < 16; ++rr) dst[(r0 + rr) * 65 + lane] = x[rr]; }
    __syncthreads();
    { f32x16 acc = {};
      if (q == 1) { mm32<false, true, false>(acc, S8, i0, S0, j0, lane); st_tile<2>(S4, acc, i0, j0, lane); }
      else { mm32<false, false, false>(acc, S3, i0, S8, j0, lane);
          const int jc = j0 + li; const float gc = gC[jc]; float* TQ = (float*)(p->ws + WS_TQ) + (size_t)unit * 4096;
#pragma unroll
          for (int rg = 0; rg < 4; ++rg) { const int ab = i0 + 8 * rg + 4 * hi; f32x4 o;
#pragma unroll
              for (int e = 0; e < 4; ++e) o[e] = ((ab + e == jc) ? gc : 0.f) - acc[rg * 4 + e] * gc;
              *(f32x4*)(TQ + ((((jc >> 4) * 4 + (ab >> 4)) * 64 + ((ab & 15) >> 2) * 16 + (jc & 15)) * 4)) = o; } } }
    __syncthreads();
    { f32x16 acc = {};
      if (q == 0) { mm32<true, false, false>(acc, S2, i0, S1, j0, lane); mm32<false, false, true>(acc, S6, i0, S8, j0, lane);
          const int jc = j0 + li; const float gc = gC[jc]; float* GM = (float*)(p->ws + WS_GM) + (size_t)unit * 4096;
#pragma unroll
          for (int r = 0; r < 16; ++r) GM[(i0 + (r & 3) + 8 * (r >> 2) + 4 * hi) * 64 + jc] = acc[r] * gc; }
      else { mm32<true, false, false>(acc, S2, i0, S7, j0, lane); mm32<false, false, true>(acc, S6, i0, S4, j0, lane);
          float* Y0T = (float*)(p->ws + WS_Y0T) + (size_t)unit * 4096 + (j0 + li) * 64;
#pragma unroll
          for (int rg = 0; rg < 4; ++rg) *(f32x4*)(Y0T + i0 + 8 * rg + 4 * hi) = (f32x4){acc[rg * 4], acc[rg * 4 + 1], acc[rg * 4 + 2], acc[rg * 4 + 3]}; } }
    if (q == 0) { f32x16 acc;
#pragma unroll
        for (int r = 0; r < 16; ++r) acc[r] = S0[(j0 + li) * 65 + i0 + (r & 3) + 8 * (r >> 2) + 4 * hi];
        mm32<false, false, true>(acc, S3, i0, S4, j0, lane);
        float* ET = (float*)(p->ws + WS_ET) + (size_t)unit * 4096 + (j0 + li) * 64;
#pragma unroll
        for (int rg = 0; rg < 4; ++rg) *(f32x4*)(ET + i0 + 8 * rg + 4 * hi) = (f32x4){acc[rg * 4], acc[rg * 4 + 1], acc[rg * 4 + 2], acc[rg * 4 + 3]}; }
    __syncthreads();
}
__device__ __forceinline__ void rwkv_r2_task(KP p, int l, int task, int lane) {
    int h, iq, unit0, nch, b = 0; bool samp = task >= 32;
    if (!samp) { h = task >> 2; iq = task & 3; unit0 = h; nch = 256; }
    else { const int t2 = task - 32; iq = t2 & 3; h = (t2 >> 2) & 7; b = t2 >> 5; unit0 = (256 + b) * 8 + h; nch = 1; }
    const int fr = lane & 15, g = lane >> 4, i = iq * 16 + fr;
    f32x4 st[4];
    if (samp) { const float* s0 = p->in[I_SWKV] + ((((size_t)l * 32 + b) * 8 + h) * 64 + i) * 64;
#pragma unroll
        for (int tl = 0; tl < 4; ++tl) st[tl] = *(const f32x4*)(s0 + 16 * tl + 4 * g); }
    else {
#pragma unroll
        for (int tl = 0; tl < 4; ++tl) st[tl] = (f32x4){0.f, 0.f, 0.f, 0.f}; }
    const float* TQ = (const float*)(p->ws + WS_TQ); const float* GM = (const float*)(p->ws + WS_GM); float* SC = (float*)(p->ws + WS_SC);
    f32x4 tq[16], gm[4];
    { const size_t ub = (size_t)unit0 * 4096;
#pragma unroll
      for (int x = 0; x < 16; ++x) tq[x] = *(const f32x4*)(TQ + ub + (x * 64 + lane) * 4);
#pragma unroll
      for (int tl = 0; tl < 4; ++tl) gm[tl] = *(const f32x4*)(GM + ub + i * 64 + 16 * tl + 4 * g); }
    for (int c = 0; c < nch; ++c) {
        const size_t ub = (size_t)(unit0 + c * 8) * 4096;
#pragma unroll
        for (int tl = 0; tl < 4; ++tl) *(f32x4*)(SC + ub + i * 64 + 16 * tl + 4 * g) = st[tl];
        f32x4 tqn[16], gmn[4];
        if (c + 1 < nch) { const size_t un = ub + 8 * 4096;
#pragma unroll
            for (int x = 0; x < 16; ++x) tqn[x] = *(const f32x4*)(TQ + un + (x * 64 + lane) * 4);
#pragma unroll
            for (int tl = 0; tl < 4; ++tl) gmn[tl] = *(const f32x4*)(GM + un + i * 64 + 16 * tl + 4 * g); }
        else {
#pragma unroll
            for (int x = 0; x < 16; ++x) tqn[x] = tq[x];
#pragma unroll
            for (int tl = 0; tl < 4; ++tl) gmn[tl] = gm[tl]; }
        f32x4 acc[4];
#pragma unroll
        for (int tp = 0; tp < 4; ++tp) acc[tp] = gm[tp];
#pragma unroll
        for (int tl = 0; tl < 4; ++tl)
#pragma unroll
            for (int r = 0; r < 4; ++r)
#pragma unroll
                for (int tp = 0; tp < 4; ++tp) acc[tp] = __builtin_amdgcn_mfma_f32_16x16x4f32(tq[tp * 4 + tl][r], st[tl][r], acc[tp], 0, 0, 0);
#pragma unroll
        for (int tl = 0; tl < 4; ++tl) st[tl] = acc[tl];
#pragma unroll
        for (int x = 0; x < 16; ++x) tq[x] = tqn[x];
#pragma unroll
        for (int tl = 0; tl < 4; ++tl) gm[tl] = gmn[tl];
    }
    float* dst = samp ? p->out + O_SWKV + ((((size_t)l * 32 + b) * 8 + h) * 64 + i) * 64 : p->out + O_PWKV + (((size_t)l * 8 + h) * 64 + i) * 64;
#pragma unroll
    for (int tl = 0; tl < 4; ++tl) *(f32x4*)(dst + 16 * tl + 4 * g) = st[tl];
}
__device__ __forceinline__ void rwkv_r3_task(KP p, int l, int task, int lane) {
    const int unit = task >> 1, th = task & 1, cu = unit >> 3, h = unit & 7, li = lane & 31, hi = lane >> 5;
    const RwkvSeqInfo si = rwkv_info(cu);
    if (th * 32 >= si.ntok) return;
    const bf16_t* U = (const bf16_t*)(p->ws + WS_U);
    const size_t ub = (size_t)unit * 4096; const int t = th * 32 + li;
    const float* SC = (const float*)(p->ws + WS_SC) + ub; const float* ET = (const float*)(p->ws + WS_ET) + ub + t * 64 + 32 * hi; const float* Y0T = (const float*)(p->ws + WS_Y0T) + ub + t * 64;
    f32x16 acc[2];
#pragma unroll
    for (int ti = 0; ti < 2; ++ti)
#pragma unroll
        for (int rg = 0; rg < 4; ++rg) { const f32x4 y0 = *(const f32x4*)(Y0T + 32 * ti + 8 * rg + 4 * hi);
#pragma unroll
            for (int e = 0; e < 4; ++e) acc[ti][rg * 4 + e] = y0[e]; }
#pragma unroll
    for (int s4 = 0; s4 < 8; ++s4) {
        const f32x4 eb = *(const f32x4*)(ET + 4 * s4);
        const f32x4 sa0 = *(const f32x4*)(SC + (li) * 64 + 32 * hi + 4 * s4), sa1 = *(const f32x4*)(SC + (32 + li) * 64 + 32 * hi + 4 * s4);
#pragma unroll
        for (int e = 0; e < 4; ++e) { acc[0] = __builtin_amdgcn_mfma_f32_32x32x2f32(sa0[e], eb[e], acc[0], 0, 0, 0); acc[1] = __builtin_amdgcn_mfma_f32_32x32x2f32(sa1[e], eb[e], acc[1], 0, 0, 0); }
    }
    float s1 = 0.f;
#pragma unroll
    for (int ti = 0; ti < 2; ++ti)
#pragma unroll
        for (int r = 0; r < 16; ++r) s1 += acc[ti][r];
    s1 = xhalf_sum(s1); const float mean = s1 * (1.f / 64.f);
    float s2 = 0.f;
#pragma unroll
    for (int ti = 0; ti < 2; ++ti)
#pragma unroll
        for (int r = 0; r < 16; ++r) { const float d = acc[ti][r] - mean; s2 += d * d; }
    s2 = xhalf_sum(s2); const float rstd = 1.f / sqrtf(s2 * (1.f / 64.f) + 64e-5f);
    if (t >= si.ntok) return;
    const float bon = ((const float*)(p->ws + WS_BONUS))[(size_t)unit * 64 + t];
    const size_t row = (size_t)(si.row0 + t);
    bf16_t* oc = (bf16_t*)(p->ws + WS_OCAT) + (size_t)2 * NTOK * 512 + row * 512 + h * 64;
#pragma unroll
    for (int ti = 0; ti < 2; ++ti)
#pragma unroll
        for (int rg = 0; rg < 4; ++rg) { const int i = 32 * ti + 8 * rg + 4 * hi, c = h * 64 + i;
            const f32x4 gg = *(const f32x4*)(p->in[I_GNG] + l * 512 + c), gb = *(const f32x4*)(p->in[I_GNB] + l * 512 + c), mu = *(const f32x4*)(p->in[I_MU] + l * SHIFT_W + 1024 + c);
            const u32x2 vx = *(const u32x2*)(U + row * NU + U_XC + 1024 + c); const u32x2 sg = *(const u32x2*)(U + row * NU + U_CSG + c);
            f32x4 vc = (f32x4){bflo(vx.x), bfhi(vx.x), bflo(vx.y), bfhi(vx.y)}, vp;
            if (t > 0 || si.prev_kind == 1) { const u32x2 px = *(const u32x2*)(U + (row - 1) * NU + U_XC + 1024 + c); vp = (f32x4){bflo(px.x), bfhi(px.x), bflo(px.y), bfhi(px.y)}; }
            else if (si.prev_kind == 2) vp = *(const f32x4*)(p->in[I_SSHIFT] + ((size_t)l * 32 + si.b) * SHIFT_W + 1024 + c);
            else vp = (f32x4){0.f, 0.f, 0.f, 0.f};
            const f32x4 vs = vc + (vp - vc) * mu;
            const f32x4 sgf = (f32x4){bflo(sg.x), bfhi(sg.x), bflo(sg.y), bfhi(sg.y)};
            f32x4 o;
#pragma unroll
            for (int e = 0; e < 4; ++e) o[e] = (((acc[ti][rg * 4 + e] - mean) * rstd) * gg[e] + gb[e] + bon * vs[e]) * siluf_(sgf[e]);
            u32x2 w; w.x = cvt_pk_bf16(o[0], o[1]); w.y = cvt_pk_bf16(o[2], o[3]); *(u32x2*)(oc + i) = w; }
}
__device__ __forceinline__ int krow(int i) { return (i & 3) + 4 * ((i >> 3) & 1) + 8 * ((i >> 2) & 1) + 16 * (i >> 4); }
__device__ __forceinline__ bf16x8 pack8(const f32x16& v, int o) { u32x4 w; w.x = cvt_pk_bf16(v[o], v[o + 1]); w.y = cvt_pk_bf16(v[o + 2], v[o + 3]); w.z = cvt_pk_bf16(v[o + 4], v[o + 5]); w.w = cvt_pk_bf16(v[o + 6], v[o + 7]); return __builtin_bit_cast(bf16x8, w); }
__device__ __forceinline__ bf16x8 pack8f(const f32x4 a, const f32x4 b) { u32x4 w; w.x = cvt_pk_bf16(a[0], a[1]); w.y = cvt_pk_bf16(a[2], a[3]); w.z = cvt_pk_bf16(b[0], b[1]); w.w = cvt_pk_bf16(b[2], b[3]); return __builtin_bit_cast(bf16x8, w); }
constexpr float ATT_NEG = -1e30f;
template <bool HALF>
__device__ __forceinline__ void softmax_tile(f32x16& p0, f32x16& p1, float& m, float& lsum, f32x16 (&O)[2], bf16x8 (&pb)[4]) {
    float mx = p0[0];
#pragma unroll
    for (int r = 1; r < 16; ++r) mx = fmaxf(mx, p0[r]);
    if (!HALF) {
#pragma unroll
        for (int r = 0; r < 16; ++r) mx = fmaxf(mx, p1[r]); }
    mx = xhalf_max(mx);
    const float mn = fmaxf(m, mx), alpha = __builtin_amdgcn_exp2f(m - mn);
    m = mn;
    float s = 0.f;
#pragma unroll
    for (int r = 0; r < 16; ++r) { p0[r] = __builtin_amdgcn_exp2f(p0[r] - mn); s += p0[r]; }
    if (!HALF) {
#pragma unroll
        for (int r = 0; r < 16; ++r) { p1[r] = __builtin_amdgcn_exp2f(p1[r] - mn); s += p1[r]; } }
    lsum = lsum * alpha + s;
#pragma unroll
    for (int r = 0; r < 16; ++r) { O[0][r] *= alpha; O[1][r] *= alpha; }
    pb[0] = pack8(p0, 0); pb[1] = pack8(p0, 8);
    if (!HALF) { pb[2] = pack8(p1, 0); pb[3] = pack8(p1, 8); }
}
constexpr int AKS = 72;
constexpr int ATT_KB = 0, ATT_VB = 2 * 64 * AKS * 2, ATT_FB = 4 * 64 * AKS * 2;
__device__ __forceinline__ void attn_prompt_unit(KP p, int h, int qb, LAS unsigned char* lds, int tid) {
    const bf16_t* U = (const bf16_t*)(p->ws + WS_U); const bf16_t* Vt = (const bf16_t*)(p->ws + WS_VT) + (size_t)h * 64 * TP; const float* F = (const float*)(p->ws + WS_FP) + (size_t)h * TP;
    const int wave = tid >> 6, lane = tid & 63, li = lane & 31, hi = lane >> 5;
    const int q0 = qb * 256, q = q0 + wave * 32 + li;
    bf16x8 qf[4];
    { const float sc = 0.125f * LOG2E;
#pragma unroll
      for (int d0 = 0; d0 < 4; ++d0) { const u32x4 w = *(const u32x4*)(U + (size_t)q * NU + U_Q + h * 64 + 16 * d0 + 8 * hi);
          qf[d0] = pack8f((f32x4){bflo(w.x) * sc, bfhi(w.x) * sc, bflo(w.y) * sc, bfhi(w.y) * sc}, (f32x4){bflo(w.z) * sc, bfhi(w.z) * sc, bflo(w.w) * sc, bfhi(w.w) * sc}); } }
    const float fq = F[q];
    float m = ATT_NEG, lsum = 0.f; f32x16 O[2] = {};
    const int NT = (q0 + 256) / 64;
    const int srow = tid >> 3, sch = tid & 7;
    const bf16_t* kg = U + (size_t)srow * NU + U_K + h * 64 + 8 * sch; const bf16_t* vg = Vt + (size_t)srow * TP + 8 * sch;
    LAS unsigned char* kdst = lds + ATT_KB + (srow * AKS + 8 * sch) * 2; LAS unsigned char* vdst = lds + ATT_VB + (srow * AKS + 8 * sch) * 2;
    u32x4 kr = *(const u32x4*)(kg + (size_t)(NT - 1) * 64 * NU), vr = *(const u32x4*)(vg + (NT - 1) * 64); float fr = tid < 64 ? F[(NT - 1) * 64 + tid] : 0.f;
    *(LAS u32x4*)kdst = kr; *(LAS u32x4*)vdst = vr; if (tid < 64) ((LAS float*)(lds + ATT_FB))[tid] = fr;
    __syncthreads();
    const int ka = krow(li);
    for (int t = NT - 1, buf = 0; t >= 0; --t, buf ^= 1) {
        if (t > 0) { kr = *(const u32x4*)(kg + (size_t)(t - 1) * 64 * NU); vr = *(const u32x4*)(vg + (t - 1) * 64); if (tid < 64) fr = F[(t - 1) * 64 + tid]; }
        if (64 * t <= q0 + wave * 32 + 31) {
            const LAS bf16_t* Kb = (const LAS bf16_t*)(lds + ATT_KB) + buf * 64 * AKS; const LAS bf16_t* Vb = (const LAS bf16_t*)(lds + ATT_VB) + buf * 64 * AKS; const LAS float* Fb = (const LAS float*)(lds + ATT_FB) + buf * 64;
            f32x16 p0, p1;
#pragma unroll
            for (int g2 = 0; g2 < 2; ++g2) { const f32x4 a = *(const LAS f32x4*)(Fb + 8 * hi + 16 * g2), b = *(const LAS f32x4*)(Fb + 8 * hi + 16 * g2 + 4), c = *(const LAS f32x4*)(Fb + 32 + 8 * hi + 16 * g2), d = *(const LAS f32x4*)(Fb + 32 + 8 * hi + 16 * g2 + 4);
#pragma unroll
                for (int e = 0; e < 4; ++e) { p0[8 * g2 + e] = fq - a[e]; p0[8 * g2 + 4 + e] = fq - b[e]; p1[8 * g2 + e] = fq - c[e]; p1[8 * g2 + 4 + e] = fq - d[e]; } }
#pragma unroll
            for (int d0 = 0; d0 < 4; ++d0) { const bf16x8 a0 = *(const LAS bf16x8*)(Kb + ka * AKS + 16 * d0 + 8 * hi), a1 = *(const LAS bf16x8*)(Kb + (ka + 32) * AKS + 16 * d0 + 8 * hi);
                p0 = __builtin_amdgcn_mfma_f32_32x32x16_bf16(a0, qf[d0], p0, 0, 0, 0); p1 = __builtin_amdgcn_mfma_f32_32x32x16_bf16(a1, qf[d0], p1, 0, 0, 0); }
            if (64 * t + 63 > q0 + wave * 32) {
#pragma unroll
                for (int r = 0; r < 16; ++r) { const int kv = 64 * t + 8 * hi + 16 * (r >> 3) + (r & 7); if (kv > q) p0[r] = -INFINITY; if (kv + 32 > q) p1[r] = -INFINITY; } }
            bf16x8 pb[4];
            softmax_tile<false>(p0, p1, m, lsum, O, pb);
#pragma unroll
            for (int dt = 0; dt < 2; ++dt)
#pragma unroll
                for (int s = 0; s < 4; ++s) { const bf16x8 a = *(const LAS bf16x8*)(Vb + (32 * dt + li) * AKS + 16 * (s & 1) + 32 * (s >> 1) + 8 * hi);
                    O[dt] = __builtin_amdgcn_mfma_f32_32x32x16_bf16(a, pb[s], O[dt], 0, 0, 0); }
        }
        if (t > 0) { const int nb = buf ^ 1; *(LAS u32x4*)(kdst + nb * 64 * AKS * 2) = kr; *(LAS u32x4*)(vdst + nb * 64 * AKS * 2) = vr; if (tid < 64) ((LAS float*)(lds + ATT_FB))[nb * 64 + tid] = fr; }
        __syncthreads();
    }
    const float inv = 1.f / xhalf_sum(lsum);
    bf16_t* ob = (bf16_t*)(p->ws + WS_OCAT) + (size_t)1 * NTOK * 512 + (size_t)q * 512 + h * 64;
#pragma unroll
    for (int dt = 0; dt < 2; ++dt)
#pragma unroll
        for (int rg = 0; rg < 4; ++rg) { const int d = 32 * dt + 8 * rg + 4 * hi; const u32x2 sg = *(const u32x2*)(U + (size_t)q * NU + U_BSG + h * 64 + d);
            u32x2 w; w.x = cvt_pk_bf16(O[dt][rg * 4] * inv * siluf_(bflo(sg.x)), O[dt][rg * 4 + 1] * inv * siluf_(bfhi(sg.x))); w.y = cvt_pk_bf16(O[dt][rg * 4 + 2] * inv * siluf_(bflo(sg.y)), O[dt][rg * 4 + 3] * inv * siluf_(bfhi(sg.y)));
            *(u32x2*)(ob + d) = w; }
}
__device__ __forceinline__ void attn_sample_unit(KP p, int l, int b, int h, LAS unsigned char* lds, int tid) {
    const bf16_t* U = (const bf16_t*)(p->ws + WS_U);
    const int wave = tid >> 6, lane = tid & 63, li = lane & 31, hi = lane >> 5;
    const size_t qrow = (size_t)TP + b * 32 + li;
    const float* G = (const float*)(p->ws + WS_GS) + ((size_t)b * 8 + h) * GS_LEN;
    bf16x8 qf[4];
    { const float sc = 0.125f * LOG2E;
#pragma unroll
      for (int d0 = 0; d0 < 4; ++d0) { const u32x4 w = *(const u32x4*)(U + qrow * NU + U_Q + h * 64 + 16 * d0 + 8 * hi);
          qf[d0] = pack8f((f32x4){bflo(w.x) * sc, bfhi(w.x) * sc, bflo(w.y) * sc, bfhi(w.y) * sc}, (f32x4){bflo(w.z) * sc, bfhi(w.z) * sc, bflo(w.w) * sc, bfhi(w.w) * sc}); } }
    const float fq = G[PAST + li];
    float m = ATT_NEG, lsum = 0.f; f32x16 O[2] = {};
    const float* CK = p->in[I_CK] + (((size_t)l * 32 + b) * PAST) * 512 + h * 64; const float* CV = p->in[I_CV] + (((size_t)l * 32 + b) * PAST) * 512 + h * 64;
    const int ka = krow(li);
    for (int tt = 0; tt < 8; ++tt) {
        const int key0 = (wave * 8 + tt) * 64;
        f32x16 p0, p1;
#pragma unroll
        for (int g2 = 0; g2 < 2; ++g2) { const float* gp = G + key0 + 8 * hi + 16 * g2; const f32x4 a = *(const f32x4*)gp, bq = *(const f32x4*)(gp + 4), c = *(const f32x4*)(gp + 32), d = *(const f32x4*)(gp + 36);
#pragma unroll
            for (int e = 0; e < 4; ++e) { p0[8 * g2 + e] = fq - a[e]; p0[8 * g2 + 4 + e] = fq - bq[e]; p1[8 * g2 + e] = fq - c[e]; p1[8 * g2 + 4 + e] = fq - d[e]; } }
#pragma unroll
        for (int d0 = 0; d0 < 4; ++d0) { const float* k0p = CK + (size_t)(key0 + ka) * 512 + 16 * d0 + 8 * hi; const float* k1p = k0p + (size_t)32 * 512;
            const bf16x8 a0 = pack8f(*(const f32x4*)k0p, *(const f32x4*)(k0p + 4)), a1 = pack8f(*(const f32x4*)k1p, *(const f32x4*)(k1p + 4));
            p0 = __builtin_amdgcn_mfma_f32_32x32x16_bf16(a0, qf[d0], p0, 0, 0, 0); p1 = __builtin_amdgcn_mfma_f32_32x32x16_bf16(a1, qf[d0], p1, 0, 0, 0); }
        bf16x8 pb[4];
        softmax_tile<false>(p0, p1, m, lsum, O, pb);
#pragma unroll
        for (int dt = 0; dt < 2; ++dt)
#pragma unroll
            for (int s = 0; s < 4; ++s) { const float* vp = CV + (size_t)(key0 + 16 * (s & 1) + 32 * (s >> 1) + 8 * hi) * 512 + 32 * dt + li;
                const bf16x8 a = pack8f((f32x4){vp[0], vp[512], vp[1024], vp[1536]}, (f32x4){vp[2048], vp[2560], vp[3072], vp[3584]});
                O[dt] = __builtin_amdgcn_mfma_f32_32x32x16_bf16(a, pb[s], O[dt], 0, 0, 0); }
    }
    if (wave == 7) {
        f32x16 p0, p1 = {};
#pragma unroll
        for (int g2 = 0; g2 < 2; ++g2) { const float* gp = G + PAST + 8 * hi + 16 * g2; const f32x4 a = *(const f32x4*)gp, bq = *(const f32x4*)(gp + 4);
#pragma unroll
            for (int e = 0; e < 4; ++e) { p0[8 * g2 + e] = fq - a[e]; p0[8 * g2 + 4 + e] = fq - bq[e]; } }
#pragma unroll
        for (int d0 = 0; d0 < 4; ++d0) { const bf16x8 a0 = *(const bf16x8*)(U + ((size_t)TP + b * 32 + ka) * NU + U_K + h * 64 + 16 * d0 + 8 * hi);
            p0 = __builtin_amdgcn_mfma_f32_32x32x16_bf16(a0, qf[d0], p0, 0, 0, 0); }
#pragma unroll
        for (int r = 0; r < 16; ++r) { const int kv = 8 * hi + 16 * (r >> 3) + (r & 7); if (kv > li) p0[r] = -INFINITY; }
        bf16x8 pb[4];
        softmax_tile<true>(p0, p1, m, lsum, O, pb);
#pragma unroll
        for (int dt = 0; dt < 2; ++dt)
#pragma unroll
            for (int s = 0; s < 2; ++s) { const bf16_t* vp = U + ((size_t)TP + b * 32 + 16 * s + 8 * hi) * NU + U_V + h * 64 + 32 * dt + li; u32x4 w;
                w.x = (unsigned)vp[0] | ((unsigned)vp[NU] << 16); w.y = (unsigned)vp[2 * NU] | ((unsigned)vp[3 * NU] << 16); w.z = (unsigned)vp[4 * NU] | ((unsigned)vp[5 * NU] << 16); w.w = (unsigned)vp[6 * NU] | ((unsigned)vp[7 * NU] << 16);
                O[dt] = __builtin_amdgcn_mfma_f32_32x32x16_bf16(__builtin_bit_cast(bf16x8, w), pb[s], O[dt], 0, 0, 0); }
    }
    LAS float* Ow = (LAS float*)lds;
    LAS float* ML = Ow + 8 * 32 * 64;
    lsum = xhalf_sum(lsum);
#pragma unroll
    for (int dt = 0; dt < 2; ++dt)
#pragma unroll
        for (int r = 0; r < 16; ++r) Ow[(wave * 32 + dt * 16 + r) * 64 + lane] = O[dt][r];
    if (hi == 0) { ML[(wave * 2) * 32 + li] = m; ML[(wave * 2 + 1) * 32 + li] = lsum; }
    __syncthreads();
    { const int qq = tid & 31, dg = tid >> 5; float M = ATT_NEG;
#pragma unroll
      for (int w = 0; w < 8; ++w) M = fmaxf(M, ML[(w * 2) * 32 + qq]);
      float L = 0.f; f32x4 o = {0.f, 0.f, 0.f, 0.f};
      const int d = 4 * dg, idx0 = (d >> 5) * 16 + ((d >> 3) & 3) * 4, ln = ((d >> 2) & 1) * 32 + qq;
#pragma unroll
      for (int w = 0; w < 8; ++w) { const float f = __builtin_amdgcn_exp2f(ML[(w * 2) * 32 + qq] - M); L += ML[(w * 2 + 1) * 32 + qq] * f;
#pragma unroll
          for (int e = 0; e < 4; ++e) o[e] += Ow[(w * 32 + idx0 + e) * 64 + ln] * f; }
      const float inv = 1.f / L; const size_t row = (size_t)TP + b * 32 + qq;
      const u32x2 sg = *(const u32x2*)(U + row * NU + U_BSG + h * 64 + d);
      u32x2 wv; wv.x = cvt_pk_bf16(o[0] * inv * siluf_(bflo(sg.x)), o[1] * inv * siluf_(bfhi(sg.x))); wv.y = cvt_pk_bf16(o[2] * inv * siluf_(bflo(sg.y)), o[3] * inv * siluf_(bfhi(sg.y)));
      *(u32x2*)((bf16_t*)(p->ws + WS_OCAT) + (size_t)1 * NTOK * 512 + row * 512 + h * 64 + d) = wv; }
    __syncthreads();
}
constexpr int NPHASE = 18;
__global__ void __launch_bounds__(512, 2) hse_fwd(Params p_) {
    const KP kp = (KP)__builtin_amdgcn_kernarg_segment_ptr();
    (void)p_;
    extern __shared__ __attribute__((aligned(16))) unsigned char lds_raw[];
    LAS unsigned char* lds = (LAS unsigned char*)lds_raw;
    const int tid0 = threadIdx.x;
    const int G = gridDim.x, bid = blockIdx.x, ngw = G * 8;
#define PH_LOCALS const KP p = kp_fresh(kp); int tid = tid0; asm volatile("" : "+v"(tid)); const int lane = tid & 63, wave = __builtin_amdgcn_readfirstlane(tid >> 6), gw = bid * 8 + wave; (void)lane; (void)gw; (void)p;
    if (tid0 < 4) ((LAS unsigned*)(lds + LDS_XB_OFF))[tid0] = 0u;
    __syncthreads();
    unsigned* ctl = (unsigned*)(kp->ws + WS_CTL);
    XcdBarrier bar = xcd_barrier_post(ctl + CW_BAR + kp->li * XCD_BAR_WORDS, (volatile LAS unsigned*)(lds + LDS_XB_OFF));
    const int lo = kp->ph_lo, hi = kp->ph_hi;
#define IN(k) (lo <= (k) && (k) < hi)
#ifndef DUP_MASK
#define DUP_MASK 0
#endif
#define NREP(k) (((DUP_MASK >> (k)) & 1) + 1)
#define SEAM(k) do { if (IN(k) && IN((k) + 1)) xcd_barrier(bar); } while (0)
    if (IN(0)) { PH_LOCALS
        for (int u = bid; u < 192; u += G) ada_unit(p, u, lds, tid);
        p0_weights(p, lds, gw, ngw, wave, lane);
    }
    SEAM(0);
    for (int l = 0; l < NLAYER; ++l) {
        const int pb = 1 + 8 * l;
        for (int rep = 0; rep < NREP(0); ++rep) { if (rep) xcd_barrier(bar);
        if (IN(pb)) { PH_LOCALS p1_rows(p, l, gw, ngw, lane); } }
        SEAM(pb);
        for (int rep = 0; rep < NREP(1); ++rep) { if (rep) xcd_barrier(bar);
        if (IN(pb + 1)) { PH_LOCALS
            pg8::Gemm g{(const bf16_t*)(p->ws + WS_H), (const bf16_t*)(p->ws + WS_WIN) + (size_t)l * NU * 2048, NTOK, NU, 2048};
            pg8::StaticOrder S; S.init(NTOK, NU, G, bid);
            EpiU E{(bf16_t*)(p->ws + WS_U), p->out, p->in[I_BF], l};
            pg8::gemm_phase<EpiU, pg8::StaticOrder>(lds, g, S, E, nullptr);
        }
        }
        SEAM(pb + 1);
        for (int rep = 0; rep < NREP(2); ++rep) { if (rep) xcd_barrier(bar);
        if (IN(pb + 2)) { PH_LOCALS
#ifndef DUP_SUB
#define DUP_SUB 0
#endif
            for (int u = bid; u < NRU * ((DUP_SUB & 1) + 1); u += G) rwkv_r1(p, l, u % NRU, lds, tid);
            for (int u = bid; u < 544 * (((DUP_SUB >> 1) & 1) + 1); u += G) conv_unit(p, l, u % 544, lds, tid);
            for (int u = bid; u < 544 * (((DUP_SUB >> 2) & 1) + 1); u += G) pool_unit(p, l, u % 544, lds, tid);
            for (int u = bid; u < 256; u += G) { vt_tile(p, u * 8 + wave, lds, wave, lane); }
            __syncthreads();
            for (int u = bid; u < 32; u += G) gs_unit(p, l, u, lds, tid);
            for (int u = G - 1 - bid; u < 8; u += G) fp_unit(p, l, u, lds, tid);
            if (bid == G / 2) shift_out(p, l, tid);
        }
        }
        SEAM(pb + 2);
        for (int rep = 0; rep < NREP(3); ++rep) { if (rep) xcd_barrier(bar);
        if (IN(pb + 3)) { PH_LOCALS
            if (bid < 32) {
                if (wave == 0) rwkv_r2_task(p, l, bid, lane);
                else for (int tk = 32 + bid * 7 + (wave - 1); tk < 32 + 1024; tk += 224) rwkv_r2_task(p, l, tk, lane);
                __syncthreads();
            }
            LAS int* qslot = (LAS int*)(lds + LDS_XB_OFF - 16);
            for (;;) {
                if (tid == 0) *qslot = (int)atomicAdd(ctl + CW_QUEUE + 64 * (2 * l + 4 * rep), 1u);
                __syncthreads();
                const int item = *qslot;
                __syncthreads();
                if (item >= 512) break;
                attn_prompt_unit(p, item & 7, 63 - (item >> 3), lds, tid);
            }
            for (;;) {
                if (tid == 0) *qslot = (int)atomicAdd(ctl + CW_QUEUE + 64 * (2 * l + 1 + 4 * rep), 1u);
                __syncthreads();
                const int item = *qslot;
                __syncthreads();
                if (item >= 256) break;
                attn_sample_unit(p, l, item >> 3, item & 7, lds, tid);
            }
        }
        }
        SEAM(pb + 3);
        if (IN(pb + 4)) { PH_LOCALS for (int tk = gw; tk < NRU * 2; tk += ngw) rwkv_r3_task(p, l, tk, lane); }
        SEAM(pb + 4);
        for (int rep = 0; rep < NREP(5); ++rep) { if (rep) xcd_barrier(bar);
        if (IN(pb + 5)) { PH_LOCALS
            pg8::Gemm g{(const bf16_t*)(p->ws + WS_OCAT), (const bf16_t*)(p->ws + WS_WBR) + (size_t)l * 4 * 2048 * 512, 4 * NTOK, 4 * 2048, 512};
            BranchOrder S{G, bid};
            EpiZ E{(bf16_t*)(p->ws + WS_Z)};
            pg8::gemm_phase<EpiZ, BranchOrder>(lds, g, S, E, nullptr);
        }
        }
        SEAM(pb + 5);
        if (IN(pb + 6)) { PH_LOCALS merge_pass(p, bid * 512 + tid, G * 512); }
        SEAM(pb + 6);
        if (IN(pb + 7)) { PH_LOCALS
            pg8::Gemm g{(const bf16_t*)(p->ws + WS_MERGED), (const bf16_t*)(p->ws + WS_WOUT) + (size_t)l * 2048 * 2048, NTOK, 2048, 2048};
            pg8::StaticOrder S; S.init(NTOK, 2048, G, bid);
            EpiOut E{p->in[I_XP], p->in[I_XS], (const float*)(p->ws + WS_XBUF), (const float*)(p->ws + WS_ADA), (float*)(p->ws + WS_XBUF), l};
            pg8::gemm_phase<EpiOut, pg8::StaticOrder>(lds, g, S, E, nullptr);
        }
        SEAM(pb + 7);
    }
    if (IN(17)) { PH_LOCALS p_final_rows(p, gw, ngw, lane); }
#undef IN
#undef SEAM
}
#ifndef MK_SPLIT
#define MK_SPLIT 0
#endif
extern "C" void kernel_launch(void* const* d_in, const int* in_sizes, int n_in, void* d_out, int out_size, void* d_ws, size_t ws_size, hipStream_t stream) {
    static int grid = 0;
    if (grid == 0) {
        if (n_in != N_IN || (size_t)out_size != O_END || ws_size < WS_END) { fprintf(stderr, "kernel_launch: unexpected shapes (n_in %d, out %d, ws %zu)\n", n_in, out_size, ws_size); grid = -1; return; }
        int dev = 0, cus = 0, per_cu = 0;
        if (hipGetDevice(&dev) != hipSuccess || hipDeviceGetAttribute(&cus, hipDeviceAttributeMultiprocessorCount, dev) != hipSuccess) { grid = -1; return; }
        if (hipFuncSetAttribute((const void*)hse_fwd, hipFuncAttributeMaxDynamicSharedMemorySize, LDS_BYTES) != hipSuccess) { fprintf(stderr, "kernel_launch: hipFuncSetAttribute failed\n"); grid = -1; return; }
        if (hipOccupancyMaxActiveBlocksPerMultiprocessor(&per_cu, (const void*)hse_fwd, 512, LDS_BYTES) != hipSuccess || per_cu < 1) fprintf(stderr, "kernel_launch: occupancy query reports %d\n", per_cu);
        (void)hipGetLastError();
        grid = cus;
    }
    if (grid < 0) return;
    if (hipMemsetAsync((char*)d_ws + WS_CTL, 0, CTL_BYTES, stream) != hipSuccess) return;
    Params a{};
    for (int i = 0; i < N_IN; ++i) a.in[i] = (const float*)d_in[i];
    a.out = (float*)d_out; a.ws = (unsigned char*)d_ws;
#if MK_SPLIT
    for (int ph = 0; ph < NPHASE; ++ph) { a.ph_lo = ph; a.ph_hi = ph + 1; a.li = ph; hipLaunchKernelGGL(hse_fwd, dim3(grid), dim3(512), LDS_BYTES, stream, a); }
#else
    a.ph_lo = 0; a.ph_hi = NPHASE; a.li = 0;
    hipLaunchKernelGGL(hse_fwd, dim3(grid), dim3(512), LDS_BYTES, stream, a);
#endif
    const hipError_t le = hipPeekAtLastError();
    if (le != hipSuccess) fprintf(stderr, "kernel_launch: launch failed: %s\n", hipGetErrorName(le));
}
```

```cpp
#include <hip/hip_runtime.h>
#include <cstdio>
#include <cstdint>
namespace pg8 {
#define PG8_LAS __attribute__((address_space(3)))
typedef unsigned short bf16_t;
typedef short bf16x8 __attribute__((ext_vector_type(8)));
typedef float f32x4 __attribute__((ext_vector_type(4)));
typedef unsigned u32x4 __attribute__((ext_vector_type(4)));
constexpr int BM = 256, BK = 64, HALF = 128, HTB = HALF * BK * 2  , STAGE_BYTES = 8 * HTB, NXCD = 8, WGM = 8;

__host__ __device__ __forceinline__ int lds_byte(int r, int c) { const int st = (r >> 4) * 2 + (c >> 5), rr = r & 15, cc = c & 31, ob = rr * 64 + cc * 2; return st * 1024 + (ob ^ (((ob >> 9) & 1) << 5)); }
__host__ __device__ __forceinline__ void stage_rc(int b, int& R, int& C) { const int st = b / 1024, sb = b % 1024, swz = sb ^ (((sb >> 9) & 1) << 5); R = (st >> 1) * 16 + swz / 64; C = (st & 1) * 32 + (swz % 64) / 2; }
__host__ __device__ __forceinline__ int perm32(int rho) { const int n = rho >> 4, i = rho & 15; return 8 * (i >> 2) + 4 * n + (i & 3); }

struct Unit { int pm, pn; };
struct Gemm { const bf16_t* A; const bf16_t* Bt; int M, N, K; };

struct StaticOrder {
    int nM, nN, nwg, G, c;
    __host__ __device__ void init(int M, int N, int G_, int c_) { nM = M / BM; nN = N / BM; nwg = nM * nN; G = G_; c = c_; }
    __host__ __device__ bool next(int i, Unit& u) const {
        const long L = (long)i * G + c; if (L >= nwg) return false;
        int wgid = (int)L; { const int q = nwg / NXCD, r = nwg % NXCD, xcd = wgid % NXCD, off = wgid / NXCD; wgid = (xcd < r ? xcd * (q + 1) : r * (q + 1) + (xcd - r) * q) + off; }
        const int nig = WGM * nN, gid = wgid / nig, fm = gid * WGM, gsz = (nM - fm) < WGM ? (nM - fm) : WGM;
        u.pm = fm + ((wgid % nig) % gsz); u.pn = (wgid % nig) / gsz; return true;
    }
    __device__ __forceinline__ void a_ready(const Unit&) const {}
    __device__ __forceinline__ void done(const Unit&) const {}
};
__device__ __forceinline__ unsigned cvt_pk_bf16(float lo, float hi) { unsigned r; asm volatile("v_cvt_pk_bf16_f32 %0, %1, %2" : "=v"(r) : "v"(lo), "v"(hi)); return r; }
typedef float f32x2 __attribute__((ext_vector_type(2)));
template <class Epi, class Sched, bool STAMP = false>
__device__ __forceinline__ void gemm_phase(PG8_LAS unsigned char* lds, const Gemm g, const Sched& S, const Epi& E, unsigned long long* stamps) {
    int tid = threadIdx.x; asm volatile("" : "+v"(tid));
    const int wid = __builtin_amdgcn_readfirstlane(tid >> 6), lane = tid & 63, wr = wid >> 2, wc = wid & 3, fr = lane & 15, fq = lane >> 4;
    const int K = g.K, nt = K / BK;
    int ts_lo = 0, ts_hi = 0, nts = 0; const unsigned long long rt_entry = STAMP ? (unsigned long long)wall_clock64() : 0ull;
#define PG8_STAMP() do { if (STAMP && wid == 0 && nts < 64) { const unsigned long long _c = (unsigned long long)clock64(); \
        ts_lo = (lane == nts) ? (int)(unsigned)_c : ts_lo; ts_hi = (lane == nts) ? (int)(unsigned)(_c >> 32) : ts_hi; ++nts; } } while (0)
    PG8_STAMP();
    unsigned voffA[2], voffB[2];
#pragma unroll
    for (int i = 0; i < 2; ++i) { int R, C; stage_rc(tid * 16 + i * 8192, R, C); const int Rb = Epi::PERM ? ((R & ~31) + perm32(R & 31)) : R;
        voffA[i] = (unsigned)(R * K + C) * 2u; voffB[i] = (unsigned)(Rb * K + C) * 2u; }
    const size_t kstep = (size_t)(BK * 2);
    const size_t hstep = (size_t)HALF * K * 2;
    const size_t tstep = 2 * hstep;
    const unsigned ldsw = (unsigned)wid * 1024u;
    const int aoff = lds_byte(wr * 64 + fr, fq * 8), boff = lds_byte(wc * 32 + fr, fq * 8);
#define PG8_SA(b, h) (((b) * 2 + (h)) * HTB)
#define PG8_SB(b, h) ((4 + (b) * 2 + (h)) * HTB)
#define PG8_STAGE(bufoff, gbase, voff) do { _Pragma("unroll") for (int _i = 0; _i < 2; ++_i) \
        __builtin_amdgcn_global_load_lds((const unsigned*)((const char*)(gbase) + (voff)[_i]), (PG8_LAS unsigned*)(lds + (bufoff) + ldsw + _i * 8192), 16, 0, 0); } while (0)
#define PG8_LDA(dst, b, h) do { _Pragma("unroll") for (int m = 0; m < 4; ++m) _Pragma("unroll") for (int k = 0; k < 2; ++k) dst[m][k] = *(const PG8_LAS bf16x8*)(lds + PG8_SA(b, h) + aoff + m * 2048 + k * 1024); } while (0)
#define PG8_LDB(dst, b, h) do { _Pragma("unroll") for (int n = 0; n < 2; ++n) _Pragma("unroll") for (int k = 0; k < 2; ++k) dst[n][k] = *(const PG8_LAS bf16x8*)(lds + PG8_SB(b, h) + boff + n * 2048 + k * 1024); } while (0)
#define PG8_MMA(ai, bj, At, Bt) do { __builtin_amdgcn_s_setprio(1); _Pragma("unroll") for (int m = 0; m < 4; ++m) _Pragma("unroll") for (int n = 0; n < 2; ++n) _Pragma("unroll") for (int k = 0; k < 2; ++k) \
        acc[ai][bj][m][n] = __builtin_amdgcn_mfma_f32_16x16x32_bf16(Bt[n][k], At[m][k], acc[ai][bj][m][n], 0, 0, 0); __builtin_amdgcn_s_setprio(0); } while (0)
#define PG8_WAIT_V(n) asm volatile("s_waitcnt vmcnt(" #n ")" ::: "memory")
#define PG8_WAIT_L(n) asm volatile("s_waitcnt lgkmcnt(" #n ")" ::: "memory")
#define PG8_BAR __builtin_amdgcn_s_barrier()
#define PG8_SCHED __builtin_amdgcn_sched_barrier(0)
    Unit cur, nxt; int ui = 0;
    if (!S.next(0, cur)) return;
    f32x4 acc[2][2][4][2];
#pragma unroll
    for (int a = 0; a < 2; ++a)
#pragma unroll
        for (int b = 0; b < 2; ++b)
#pragma unroll
            for (int m = 0; m < 4; ++m)
#pragma unroll
                for (int n = 0; n < 2; ++n) acc[a][b][m][n] = (f32x4){0.f, 0.f, 0.f, 0.f};
    bf16x8 At[4][2], B0[2][2], B1[2][2];
    const char* cA = (const char*)g.A + (size_t)cur.pm * tstep; const char* cB = (const char*)g.Bt + (size_t)cur.pn * tstep;
    S.a_ready(cur);
    PG8_STAGE(PG8_SB(0, 0), cB, voffB); PG8_STAGE(PG8_SA(0, 0), cA, voffA); PG8_STAGE(PG8_SB(0, 1), cB + hstep, voffB); PG8_STAGE(PG8_SA(0, 1), cA + hstep, voffA);
    if (wr == 1) PG8_BAR;
    PG8_WAIT_V(4); PG8_BAR;
    PG8_STAGE(PG8_SB(1, 0), cB + kstep, voffB); PG8_STAGE(PG8_SA(1, 0), cA + kstep, voffA); PG8_STAGE(PG8_SB(1, 1), cB + hstep + kstep, voffB);
    PG8_WAIT_V(6); PG8_BAR;
    PG8_STAMP();
    for (;;) {
        const bool has_next = S.next(ui + 1, nxt);
        const char* nA = has_next ? (const char*)g.A + (size_t)nxt.pm * tstep : cA; const char* nB = has_next ? (const char*)g.Bt + (size_t)nxt.pn * tstep : cB;
        for (int t = 0; t < nt; t += 2) {
            const bool last = (t == nt - 2);
            const char* a1 = cA + (size_t)(t + 1) * kstep;
            const char* a2 = last ? nA : cA + (size_t)(t + 2) * kstep; const char* b2 = last ? nB : cB + (size_t)(t + 2) * kstep;
            const char* a3 = a2 + kstep; const char* b3 = b2 + kstep;
            if (last && has_next) S.a_ready(nxt);
            PG8_LDB(B0, 0, 0); PG8_SCHED; PG8_LDA(At, 0, 0); PG8_STAGE(PG8_SA(1, 1), a1 + hstep, voffA);
            PG8_WAIT_L(8); PG8_BAR; PG8_WAIT_L(0); PG8_MMA(0, 0, At, B0); PG8_BAR; PG8_SCHED;
            PG8_LDB(B1, 0, 1); PG8_STAGE(PG8_SB(0, 0), b2, voffB);
            PG8_BAR; PG8_WAIT_L(0); PG8_MMA(0, 1, At, B1); PG8_BAR;
            PG8_LDA(At, 0, 1); PG8_STAGE(PG8_SA(0, 0), a2, voffA);
            PG8_BAR; PG8_WAIT_L(0); PG8_MMA(1, 0, At, B0); PG8_BAR; PG8_SCHED;
            PG8_STAGE(PG8_SB(0, 1), b2 + hstep, voffB);
            PG8_WAIT_V(6); PG8_BAR; PG8_MMA(1, 1, At, B1); PG8_BAR;
            PG8_LDB(B0, 1, 0); PG8_SCHED; PG8_LDA(At, 1, 0); PG8_STAGE(PG8_SA(0, 1), a2 + hstep, voffA);
            PG8_WAIT_L(8); PG8_BAR; PG8_WAIT_L(0); PG8_MMA(0, 0, At, B0); PG8_BAR; PG8_SCHED;
            PG8_LDB(B1, 1, 1); PG8_STAGE(PG8_SB(1, 0), b3, voffB);
            PG8_BAR; PG8_WAIT_L(0); PG8_MMA(0, 1, At, B1); PG8_BAR;
            PG8_LDA(At, 1, 1); PG8_STAGE(PG8_SA(1, 0), a3, voffA);
            PG8_BAR; PG8_WAIT_L(0); PG8_MMA(1, 0, At, B0); PG8_BAR; PG8_SCHED;
            PG8_STAGE(PG8_SB(1, 1), b3 + hstep, voffB);
            PG8_WAIT_V(6); PG8_BAR; PG8_MMA(1, 1, At, B1); PG8_BAR;
        }
        PG8_STAMP();
        if constexpr (!Epi::AFTER_DRAIN) { E(acc, cur, wr, wc, fr, fq); S.done(cur); }
        PG8_STAMP();
        if (!has_next) break;
#pragma unroll
        for (int a = 0; a < 2; ++a)
#pragma unroll
            for (int b = 0; b < 2; ++b)
#pragma unroll
                for (int m = 0; m < 4; ++m)
#pragma unroll
                    for (int n = 0; n < 2; ++n) acc[a][b][m][n] = (f32x4){0.f, 0.f, 0.f, 0.f};
        cur = nxt; cA = nA; cB = nB; ++ui;
    }
    PG8_WAIT_V(0);
    if (wr == 0) PG8_BAR;
    PG8_BAR;
    if constexpr (Epi::AFTER_DRAIN) { E.fused(acc, cur, wr, wc, fr, fq, lds, wid, lane); S.done(cur); }
    PG8_STAMP();
    if (STAMP && wid == 0) { stamps[lane] = lane < nts ? (((unsigned long long)(unsigned)ts_hi << 32) | (unsigned)ts_lo) : 0ull;
        if (lane == 62) stamps[62] = rt_entry; if (lane == 63) stamps[63] = (unsigned long long)wall_clock64(); }
#undef PG8_STAMP
#undef PG8_SA
#undef PG8_SB
#undef PG8_STAGE
#undef PG8_LDA
#undef PG8_LDB
#undef PG8_MMA
#undef PG8_WAIT_V
#undef PG8_WAIT_L
#undef PG8_BAR
#undef PG8_SCHED
}
}
#define XB_TMO      128
#define XB_XCNT(j)  (256  + 64 * (j))
#define XB_XSUB(j)  (1280 + 64 * (j))
#define XB_XGEN(j)  (2304 + 64 * (j))
#define XB_TOP      3328
#define XB_TOPGEN   3392
#define XCD_BAR_WORDS 3456
#define XB_SPIN_CAP (1u << 18)
#define LAS __attribute__((address_space(3)))

__device__ __forceinline__ unsigned xb_ld(unsigned* p)              { return __hip_atomic_load(p, __ATOMIC_RELAXED, __HIP_MEMORY_SCOPE_AGENT); }
__device__ __forceinline__ unsigned xb_add(unsigned* p, unsigned v) { return __hip_atomic_fetch_add(p, v, __ATOMIC_RELAXED, __HIP_MEMORY_SCOPE_AGENT); }
__device__ __forceinline__ unsigned xb_xcc_id() { return (unsigned)__builtin_amdgcn_s_getreg((3 << 11) | 20) & 0xFu; }
#define XB_SPIN(cond, bar) do { unsigned _sp = 0; while (cond) { __builtin_amdgcn_s_sleep(1); \
    if ((++_sp & 255u) == 0u) { if (xb_ld(&(bar)[XB_TMO])) break; if (_sp > XB_SPIN_CAP) { atomicAdd(&(bar)[XB_TMO], 1u); break; } } } } while (0)

struct XcdBarrier {
    unsigned* bar; unsigned x;
    volatile LAS unsigned* st;
};

__device__ __forceinline__ XcdBarrier xcd_barrier_post(unsigned* bar, volatile LAS unsigned* st) {
    XcdBarrier b; b.bar = bar; b.x = xb_xcc_id(); b.st = st;
    if (threadIdx.x == 0) (void)xb_add(&bar[XB_XCNT(b.x)], 1u);
    return b;
}
__device__ __forceinline__ void xcd_barrier_complete(unsigned* bar, unsigned x, unsigned& nloc, unsigned& nx) {
    const unsigned G = gridDim.x * gridDim.y * gridDim.z;
    unsigned sum, cnt, mine, sp = 0u;
    for (;;) {
        sum = 0u; cnt = 0u; mine = 0u;
#pragma unroll
        for (unsigned j = 0; j < 16; ++j) { const unsigned c = xb_ld(&bar[XB_XCNT(j)]); sum += c; cnt += (c > 0u) ? 1u : 0u; mine = (j == x) ? c : mine; }
        if (sum == G) break;
        __builtin_amdgcn_s_sleep(1);
        if ((++sp & 255u) == 0u) { if (xb_ld(&bar[XB_TMO])) break; if (sp > XB_SPIN_CAP) { atomicAdd(&bar[XB_TMO], 1u); break; } }
    }
    nloc = mine > 0u ? mine : 1u; nx = cnt > 0u ? cnt : 1u;
}

__device__ __forceinline__ void xcd_barrier(const XcdBarrier& b) {
    asm volatile("s_waitcnt vmcnt(0)" ::: "memory");
    __syncthreads();
    if (threadIdx.x == 0) {
        unsigned* bar = b.bar;
        __builtin_amdgcn_s_waitcnt(0);
        unsigned nloc = b.st[0], nx = b.st[1];
        if (nloc == 0u) { xcd_barrier_complete(bar, b.x, nloc, nx); b.st[0] = nloc; b.st[1] = nx; }
        const unsigned old = xb_add(&bar[XB_XSUB(b.x)], 1u);
        const unsigned gen = old / nloc;
        if (old + 1u == (gen + 1u) * nloc) {
            __builtin_amdgcn_fence(__ATOMIC_RELEASE, "agent");
            asm volatile("s_waitcnt vmcnt(0)" ::: "memory");
            const unsigned og = xb_add(&bar[XB_TOP], 1u);
            const unsigned tg = og / nx;
            if (og + 1u == (tg + 1u) * nx) xb_add(&bar[XB_TOPGEN], 1u);
            else XB_SPIN(xb_ld(&bar[XB_TOPGEN]) == tg, bar);
            __builtin_amdgcn_fence(__ATOMIC_ACQUIRE, "agent");
            xb_add(&bar[XB_XGEN(b.x)], 1u);
            asm volatile("s_waitcnt vmcnt(0)" ::: "memory");
        } else {
            XB_SPIN(xb_ld(&bar[XB_XGEN(b.x)]) == gen, bar);
            __builtin_amdgcn_fence(__ATOMIC_ACQUIRE, "agent");
            asm volatile("s_waitcnt vmcnt(0)" ::: "memory");
        }
    }
    __syncthreads();
}
typedef unsigned short bf16_t;
typedef short bf16x8 __attribute__((ext_vector_type(8)));
typedef float f32x4 __attribute__((ext_vector_type(4)));
typedef float f32x16 __attribute__((ext_vector_type(16)));
typedef unsigned u32x4 __attribute__((ext_vector_type(4)));
typedef unsigned u32x2 __attribute__((ext_vector_type(2)));
using pg8::cvt_pk_bf16;

constexpr int DM = 2048, TP = 16384, NSB = 32, TSQ = 32, NTOK = TP + NSB * TSQ, NSEQ = 33, PAST = 4096, NLAYER = 2;
constexpr int NU = 15104;
constexpr int U_AVAL = 0, U_AGATE = 512, U_ASG = 1024, U_Q = 1536, U_K = 2048, U_V = 2560, U_BSG = 3072, U_XC = 3584, U_CSG = 5248, U_DIN = 5760, U_DSG = 6272, U_G = 6784, U_F = 14976;
constexpr int IN_W = 14984, SHIFT_W = 1664;
constexpr float LOG2E = 1.4426950408889634f;
enum { I_XP = 0, I_XS, I_CK, I_CV, I_CLF, I_SCONV, I_SSHIFT, I_SWKV, I_SPOOL, I_CP, I_CS, I_NORMG, I_WADA, I_BADA, I_WIN, I_BF, I_CONVW, I_CONVB, I_CLNG, I_CLNB, I_MU, I_W0, I_W2, I_A0, I_A2,
       I_KK, I_KA, I_RK, I_GNG, I_GNB, I_POOLW, I_POOLB, I_POOLS, I_WBR, I_WOUT, I_FING, N_IN };
constexpr size_t O_YP = 0, O_YS = O_YP + (size_t)TP * DM, O_PK = O_YS + (size_t)1024 * DM, O_PV = O_PK + (size_t)2 * TP * 512, O_PLF = O_PV + (size_t)2 * TP * 512, O_PCONV = O_PLF + (size_t)2 * TP * 8,
                 O_PSHIFT = O_PCONV + 2 * 30 * 512, O_PWKV = O_PSHIFT + 2 * 1664, O_PPOOL = O_PWKV + 2 * 8 * 64 * 64, O_SK = O_PPOOL + 2 * 15 * 512, O_SV = O_SK + (size_t)2 * 1024 * 512,
                 O_SLF = O_SV + (size_t)2 * 1024 * 512, O_SCONV = O_SLF + 2 * 1024 * 8, O_SSHIFT = O_SCONV + (size_t)2 * 32 * 30 * 512, O_SWKV = O_SSHIFT + 2 * 32 * 1664,
                 O_SPOOL = O_SWKV + (size_t)2 * 32 * 8 * 64 * 64, O_END = O_SPOOL + (size_t)2 * 32 * 15 * 512;
static_assert(O_END == 75374848, "output size");
constexpr size_t al256(size_t x) { return (x + 255) & ~(size_t)255; }
constexpr int NCU_CH = 288, NRU = NCU_CH * 8;
constexpr size_t WS_CTL = 0, CTL_BYTES = 512 * 1024;
constexpr size_t WS_WIN = CTL_BYTES;
constexpr size_t WS_WBR = al256(WS_WIN + (size_t)2 * NU * 2048 * 2);
constexpr size_t WS_WOUT = al256(WS_WBR + (size_t)2 * 4 * 2048 * 512 * 2);
constexpr size_t WS_POOLW = al256(WS_WOUT + (size_t)2 * 2048 * 2048 * 2);
constexpr size_t WS_ADA = al256(WS_POOLW + (size_t)2 * 4 * 128 * 128 * 2);
constexpr size_t WS_H = al256(WS_ADA + (size_t)2 * 33 * 6144 * 4);
constexpr size_t WS_U = al256(WS_H + (size_t)NTOK * 2048 * 2);
constexpr size_t WS_XBUF = al256(WS_U + (size_t)NTOK * NU * 2);
constexpr size_t WS_OCAT = al256(WS_XBUF + (size_t)NTOK * 2048 * 4);
constexpr size_t WS_Z = al256(WS_OCAT + (size_t)4 * NTOK * 512 * 2);
constexpr size_t WS_MERGED = al256(WS_Z + (size_t)4 * NTOK * 2048 * 2);
constexpr size_t WS_FP = al256(WS_MERGED + (size_t)NTOK * 2048 * 2);
constexpr int GS_LEN = PAST + TSQ;
constexpr size_t WS_GS = al256(WS_FP + (size_t)8 * TP * 4);
constexpr size_t WS_VT = al256(WS_GS + (size_t)32 * 8 * GS_LEN * 4);
constexpr size_t WS_TQ = al256(WS_VT + (size_t)8 * 64 * TP * 2);
constexpr size_t WS_GM = al256(WS_TQ + (size_t)NRU * 4096 * 4);
constexpr size_t WS_ET = al256(WS_GM + (size_t)NRU * 4096 * 4);
constexpr size_t WS_Y0T = al256(WS_ET + (size_t)NRU * 4096 * 4);
constexpr size_t WS_SC = al256(WS_Y0T + (size_t)NRU * 4096 * 4);
constexpr size_t WS_BONUS = al256(WS_SC + (size_t)NRU * 4096 * 4);
constexpr size_t WS_GG = al256(WS_BONUS + (size_t)NRU * 64 * 4);
constexpr size_t WS_TG = al256(WS_GG + (size_t)16 * 8 * 4096 * 4);
constexpr size_t WS_SG = al256(WS_TG + (size_t)16 * 8 * 4096 * 4);
constexpr size_t WS_END = al256(WS_SG + (size_t)16 * 8 * 4096 * 4);
static_assert(WS_END < (size_t)2100 * 1024 * 1024, "workspace map exceeds the guaranteed d_ws size");
constexpr int CW_BAR = 0;
constexpr int CW_QUEUE = 16 * 3456 + 64;
constexpr int CW_KMAX = CW_QUEUE + 64 * 8;
static_assert((CW_KMAX + 64) * 4 <= (int)CTL_BYTES, "ctl");
constexpr int LDS_BYTES = 163840 - 256;
constexpr int LDS_XB_OFF = LDS_BYTES - 16;
constexpr int SLOT_F = 64 * 65;

struct Params { const float* in[N_IN]; float* out; unsigned char* ws; int ph_lo, ph_hi, li, pad; };
typedef const __attribute__((address_space(4))) Params* KP;
__device__ __forceinline__ KP kp_fresh(KP k) { asm volatile("" : "+s"(k)); return k; }

__device__ __forceinline__ float bf2f(unsigned short b) { return __uint_as_float(((unsigned)b) << 16); }
__device__ __forceinline__ float bflo(unsigned w) { return __uint_as_float(w << 16); }
__device__ __forceinline__ float bfhi(unsigned w) { return __uint_as_float(w & 0xffff0000u); }
__device__ __forceinline__ unsigned short f2bf(float f) { return (unsigned short)(cvt_pk_bf16(f, 0.f) & 0xffffu); }
__device__ __forceinline__ float sigmoidf_(float x) { return 1.f / (1.f + __expf(-x)); }
__device__ __forceinline__ float siluf_(float x) { return x / (1.f + __expf(-x)); }
__device__ __forceinline__ float log_sigmoidf_(float z) { return fminf(z, 0.f) - log1pf(expf(-fabsf(z))); }
template <int CTRL> __device__ __forceinline__ float dpp_mov(float v) { return __int_as_float(__builtin_amdgcn_update_dpp(0, __float_as_int(v), CTRL, 0xF, 0xF, true)); }
__device__ __forceinline__ float wave_sum(float v) {
    v += dpp_mov<0xB1>(v); v += dpp_mov<0x4E>(v); v += dpp_mov<0x141>(v); v += dpp_mov<0x140>(v);
    const float r0 = __int_as_float(__builtin_amdgcn_readlane(__float_as_int(v), 0)), r1 = __int_as_float(__builtin_amdgcn_readlane(__float_as_int(v), 16));
    const float r2 = __int_as_float(__builtin_amdgcn_readlane(__float_as_int(v), 32)), r3 = __int_as_float(__builtin_amdgcn_readlane(__float_as_int(v), 48));
    return (r0 + r1) + (r2 + r3);
}
__device__ __forceinline__ float wave_max(float v) {
    v = fmaxf(v, dpp_mov<0xB1>(v)); v = fmaxf(v, dpp_mov<0x4E>(v)); v = fmaxf(v, dpp_mov<0x141>(v)); v = fmaxf(v, dpp_mov<0x140>(v));
    const float r0 = __int_as_float(__builtin_amdgcn_readlane(__float_as_int(v), 0)), r1 = __int_as_float(__builtin_amdgcn_readlane(__float_as_int(v), 16));
    const float r2 = __int_as_float(__builtin_amdgcn_readlane(__float_as_int(v), 32)), r3 = __int_as_float(__builtin_amdgcn_readlane(__float_as_int(v), 48));
    return fmaxf(fmaxf(r0, r1), fmaxf(r2, r3));
}
__device__ __forceinline__ float wave_min(float v) { return -wave_max(-v); }
__device__ __forceinline__ float xhalf_max(float m) { const auto rr = __builtin_amdgcn_permlane32_swap(__float_as_uint(m), __float_as_uint(m), false, false); return fmaxf(__uint_as_float(rr[0]), __uint_as_float(rr[1])); }
__device__ __forceinline__ float xhalf_sum(float m) { const auto rr = __builtin_amdgcn_permlane32_swap(__float_as_uint(m), __float_as_uint(m), false, false); return __uint_as_float(rr[0]) + __uint_as_float(rr[1]); }
__device__ __forceinline__ float fast_tanh(float x) { const float e = __expf(-2.f * fabsf(x)); const float t = (1.f - e) * __builtin_amdgcn_rcpf(1.f + e); return x < 0.f ? -t : t; }
__device__ __forceinline__ void tr_tile(const float* __restrict__ src, size_t ld, int k0, int c0, int nvalid, bf16_t* __restrict__ dst, int K, LAS float* scr, int lane) {
#pragma unroll 8
    for (int kk = 0; kk < 64; ++kk) scr[kk * 65 + lane] = (lane < nvalid) ? src[(size_t)(k0 + kk) * ld + c0 + lane] : 0.f;
    const int k2 = (lane & 31) * 2, nh = lane >> 5;
#pragma unroll 8
    for (int it = 0; it < 32; ++it) { const int nn = 2 * it + nh; *(unsigned*)(dst + (size_t)nn * K + k0 + k2) = cvt_pk_bf16(scr[k2 * 65 + nn], scr[(k2 + 1) * 65 + nn]); }
}
__device__ __forceinline__ void p0_weights(KP p, LAS unsigned char* lds, int gw, int ngw, int wave, int lane) {
    LAS float* scr = (LAS float*)lds + wave * SLOT_F;
    constexpr int T_WIN = (NU / 64) * 32, T_WBR = 4 * 32 * 8, T_WOUT = 32 * 32, T_POOL = 4 * 2 * 2, T_L = T_WIN + T_WBR + T_WOUT + T_POOL;
    for (int it = gw; it < 2 * T_L; it += ngw) {
        const int l = it / T_L; int r = it % T_L;
        if (r < T_WIN) {
            const int nt = r / 32, kt = r % 32, m0 = nt * 64;
            int c0, nvalid = 64;
            if (m0 < 3072) c0 = m0; else if (m0 < U_F) c0 = m0 + 8; else if (m0 == U_F) { c0 = 3072; nvalid = 8; } else { c0 = 0; nvalid = 0; }
            tr_tile(p->in[I_WIN] + (size_t)l * 2048 * IN_W, IN_W, kt * 64, c0, nvalid, (bf16_t*)(p->ws + WS_WIN) + ((size_t)l * NU + m0) * 2048, 2048, scr, lane);
            continue; }
        r -= T_WIN;
        if (r < T_WBR) {
            const int n = r / 256, q = r % 256, nt = q / 8, kt = q % 8;
            tr_tile(p->in[I_WBR] + ((size_t)(l * 4 + n) * 512) * 2048, 2048, kt * 64, nt * 64, 64, (bf16_t*)(p->ws + WS_WBR) + ((size_t)(l * 4 + n) * 2048 + nt * 64) * 512, 512, scr, lane);
            continue; }
        r -= T_WBR;
        if (r < T_WOUT) {
            const int nt = r / 32, kt = r % 32;
            tr_tile(p->in[I_WOUT] + (size_t)l * 2048 * 2048, 2048, kt * 64, nt * 64, 64, (bf16_t*)(p->ws + WS_WOUT) + ((size_t)l * 2048 + nt * 64) * 2048, 2048, scr, lane);
            continue; }
        r -= T_WOUT;
        {
            const int g = r / 4, q = r % 4, nt = q / 2, kt = q % 2;
            tr_tile(p->in[I_POOLW] + (size_t)(l * 4 + g) * 128 * 128, 128, kt * 64, nt * 64, 64, (bf16_t*)(p->ws + WS_POOLW) + ((size_t)(l * 4 + g) * 128 + nt * 64) * 128, 128, scr, lane);
        }
    }
}
__device__ __forceinline__ void ada_unit(KP p, int unit, LAS unsigned char* lds, int tid) {
    const int wave = tid >> 6, lane = tid & 63, l = unit / 96, n0 = (unit % 96) * 64;
    LAS float* cs = (LAS float*)lds + wave * (33 * 64);
    LAS float* red = (LAS float*)lds + 8 * 33 * 64;
    const float* W = p->in[I_WADA] + (size_t)l * 2048 * 6144;
    const float* cp = p->in[I_CP]; const float* csm = p->in[I_CS];
    float acc[33];
#pragma unroll
    for (int s = 0; s < 33; ++s) acc[s] = 0.f;
    for (int ch = 0; ch < 4; ++ch) {
        const int k0 = wave * 256 + ch * 64;
#pragma unroll
        for (int s = 0; s < 33; ++s) { const float c = (s == 0) ? cp[k0 + lane] : csm[(size_t)(s - 1) * 2048 + k0 + lane]; cs[s * 64 + lane] = siluf_(c); }
        for (int kk = 0; kk < 64; kk += 4) {
            const float w0 = W[(size_t)(k0 + kk) * 6144 + n0 + lane], w1 = W[(size_t)(k0 + kk + 1) * 6144 + n0 + lane], w2 = W[(size_t)(k0 + kk + 2) * 6144 + n0 + lane], w3 = W[(size_t)(k0 + kk + 3) * 6144 + n0 + lane];
#pragma unroll
            for (int s = 0; s < 33; ++s) { const f32x4 c4 = *(const LAS f32x4*)(cs + s * 64 + kk); acc[s] += c4.x * w0 + c4.y * w1 + c4.z * w2 + c4.w * w3; }
        }
    }
#pragma unroll
    for (int s = 0; s < 33; ++s) red[(wave * 33 + s) * 64 + lane] = acc[s];
    __syncthreads();
    for (int idx = tid; idx < 33 * 64; idx += 512) { const int s = idx >> 6, n = idx & 63; float v = p->in[I_BADA][l * 6144 + n0 + n];
#pragma unroll
        for (int w = 0; w < 8; ++w) v += red[(w * 33 + s) * 64 + n];
        ((float*)(p->ws + WS_ADA))[((size_t)l * 33 + s) * 6144 + n0 + n] = v; }
    __syncthreads();
}
__device__ __forceinline__ const float* x_row(KP p, int l, int row) {
    return l == 0 ? (row < TP ? p->in[I_XP] + (size_t)row * DM : p->in[I_XS] + (size_t)(row - TP) * DM) : (const float*)(p->ws + WS_XBUF) + (size_t)row * DM;
}
__device__ __forceinline__ void p1_rows(KP p, int l, int gw, int ngw, int lane) {
    const f32x4* g4 = (const f32x4*)(p->in[I_NORMG] + l * DM) + lane;
    for (int row = gw; row < NTOK; row += ngw) {
        const f32x4* x4 = (const f32x4*)x_row(p, l, row) + lane;
        const int seq = row < TP ? 0 : 1 + ((row - TP) >> 5);
        const f32x4* sh4 = (const f32x4*)((const float*)(p->ws + WS_ADA) + ((size_t)l * 33 + seq) * 6144) + lane; const f32x4* sc4 = sh4 + 512;
        f32x4 v[8]; float ss = 0.f;
#pragma unroll
        for (int j = 0; j < 8; ++j) { v[j] = x4[64 * j]; ss += (v[j].x * v[j].x + v[j].y * v[j].y) + (v[j].z * v[j].z + v[j].w * v[j].w); }
        const float rstd = 1.f / sqrtf(wave_sum(ss) * (1.f / DM) + 1e-6f);
        u32x2* o = (u32x2*)((bf16_t*)(p->ws + WS_H) + (size_t)row * DM) + lane;
#pragma unroll
        for (int j = 0; j < 8; ++j) { const f32x4 g = g4[64 * j], sc = sc4[64 * j], sh = sh4[64 * j]; const f32x4 y = v[j] * rstd * g * (sc + 1.f) + sh;
            u32x2 w; w.x = cvt_pk_bf16(y.x, y.y); w.y = cvt_pk_bf16(y.z, y.w); o[64 * j] = w; }
    }
}
__device__ __forceinline__ void p_final_rows(KP p, int gw, int ngw, int lane) {
    const f32x4* g4 = (const f32x4*)p->in[I_FING] + lane;
    for (int row = gw; row < NTOK; row += ngw) {
        const f32x4* x4 = (const f32x4*)((const float*)(p->ws + WS_XBUF) + (size_t)row * DM) + lane;
        f32x4 v[8]; float ss = 0.f;
#pragma unroll
        for (int j = 0; j < 8; ++j) { v[j] = x4[64 * j]; ss += (v[j].x * v[j].x + v[j].y * v[j].y) + (v[j].z * v[j].z + v[j].w * v[j].w); }
        const float rstd = 1.f / sqrtf(wave_sum(ss) * (1.f / DM) + 1e-6f);
        f32x4* o = (f32x4*)(p->out + O_YP + (size_t)row * DM) + lane;
#pragma unroll
        for (int j = 0; j < 8; ++j) o[64 * j] = v[j] * rstd * g4[64 * j];
    }
}
struct EpiU {
    static constexpr bool PERM = true, AFTER_DRAIN = false;
    bf16_t* U; float* out; const float* bf; int l;
    __device__ __forceinline__ void operator()(const f32x4 (&acc)[2][2][4][2], const pg8::Unit& u, int wr, int wc, int fr, int fq) const {
        const int row0 = u.pm * 256 + wr * 64 + fr, col0 = u.pn * 256 + wc * 32 + 8 * fq;
#pragma unroll
        for (int ai = 0; ai < 2; ++ai)
#pragma unroll
            for (int m = 0; m < 4; ++m) { bf16_t* rowp = U + (size_t)(row0 + ai * 128 + m * 16) * NU + col0;
#pragma unroll
                for (int bj = 0; bj < 2; ++bj) { const f32x4 v0 = acc[ai][bj][m][0], v1 = acc[ai][bj][m][1];
                    u32x4 w; w.x = cvt_pk_bf16(v0[0], v0[1]); w.y = cvt_pk_bf16(v0[2], v0[3]); w.z = cvt_pk_bf16(v1[0], v1[1]); w.w = cvt_pk_bf16(v1[2], v1[3]);
                    *(u32x4*)(rowp + bj * 128) = w; } }
        if (u.pn >= 8 && u.pn < 12) {
            const bool isv = u.pn >= 10; const int cin = (u.pn - (isv ? 10 : 8)) * 256 + wc * 32 + 8 * fq;
#pragma unroll
            for (int ai = 0; ai < 2; ++ai)
#pragma unroll
                for (int m = 0; m < 4; ++m) { const int row = row0 + ai * 128 + m * 16;
                    float* dst = row < TP ? out + (isv ? O_PV : O_PK) + ((size_t)l * TP + row) * 512 : out + (isv ? O_SV : O_SK) + ((size_t)l * 1024 + (row - TP)) * 512;
#pragma unroll
                    for (int bj = 0; bj < 2; ++bj) { *(f32x4*)(dst + cin + bj * 128) = acc[ai][bj][m][0]; *(f32x4*)(dst + cin + bj * 128 + 4) = acc[ai][bj][m][1]; } }
        }
        if (u.pn == 58 && wc == 0 && fq == 0) {
            const f32x4 b0 = *(const f32x4*)(bf + l * 8), b1 = *(const f32x4*)(bf + l * 8 + 4);
#pragma unroll
            for (int ai = 0; ai < 2; ++ai)
#pragma unroll
                for (int m = 0; m < 4; ++m) { const int row = row0 + ai * 128 + m * 16;
                    float* dst = row < TP ? out + O_PLF + ((size_t)l * TP + row) * 8 : out + O_SLF + ((size_t)l * 1024 + (row - TP)) * 8;
                    const f32x4 z0 = acc[ai][1][m][0] + b0, z1 = acc[ai][1][m][1] + b1; f32x4 o0, o1;
#pragma unroll
                    for (int e = 0; e < 4; ++e) { o0[e] = log_sigmoidf_(z0[e]); o1[e] = log_sigmoidf_(z1[e]); }
                    *(f32x4*)dst = o0; *(f32x4*)(dst + 4) = o1; }
        }
    }
};
struct BranchOrder {
    int G, c;
    __device__ __forceinline__ bool next(int i, pg8::Unit& u) const { const int L = i * G + c; if (L >= 4 * 544) return false; const int n = L / 544, t = L - n * 544; u.pm = n * 68 + (t >> 3); u.pn = n * 8 + (t & 7); return true; }
    __device__ __forceinline__ void a_ready(const pg8::Unit&) const {}
    __device__ __forceinline__ void done(const pg8::Unit&) const {}
};
struct EpiZ {
    static constexpr bool PERM = true, AFTER_DRAIN = false;
    bf16_t* Z;
    __device__ __forceinline__ void operator()(const f32x4 (&acc)[2][2][4][2], const pg8::Unit& u, int wr, int wc, int fr, int fq) const {
        const int row0 = u.pm * 256 + wr * 64 + fr, col0 = (u.pn & 7) * 256 + wc * 32 + 8 * fq;
#pragma unroll
        for (int ai = 0; ai < 2; ++ai)
#pragma unroll
            for (int m = 0; m < 4; ++m) { bf16_t* rowp = Z + (size_t)(row0 + ai * 128 + m * 16) * DM + col0;
#pragma unroll
                for (int bj = 0; bj < 2; ++bj) { const f32x4 v0 = acc[ai][bj][m][0], v1 = acc[ai][bj][m][1];
                    u32x4 w; w.x = cvt_pk_bf16(v0[0], v0[1]); w.y = cvt_pk_bf16(v0[2], v0[3]); w.z = cvt_pk_bf16(v1[0], v1[1]); w.w = cvt_pk_bf16(v1[2], v1[3]);
                    *(u32x4*)(rowp + bj * 128) = w; } }
    }
};
__device__ __forceinline__ void merge_pass(KP p, int gtid, int ngt) {
    const bf16_t* U = (const bf16_t*)(p->ws + WS_U); const bf16_t* Z = (const bf16_t*)(p->ws + WS_Z); bf16_t* M = (bf16_t*)(p->ws + WS_MERGED);
    for (int it = gtid; it < NTOK * 256; it += ngt) { const int row = it >> 8, col = (it & 255) * 8;
        float s[8];
#pragma unroll
        for (int e = 0; e < 8; ++e) s[e] = 0.f;
#pragma unroll
        for (int n = 0; n < 4; ++n) { const u32x4 g = *(const u32x4*)(U + (size_t)row * NU + U_G + n * 2048 + col); const u32x4 z = *(const u32x4*)(Z + ((size_t)n * NTOK + row) * DM + col);
            s[0] += sigmoidf_(bflo(g.x)) * bflo(z.x); s[1] += sigmoidf_(bfhi(g.x)) * bfhi(z.x); s[2] += sigmoidf_(bflo(g.y)) * bflo(z.y); s[3] += sigmoidf_(bfhi(g.y)) * bfhi(z.y);
            s[4] += sigmoidf_(bflo(g.z)) * bflo(z.z); s[5] += sigmoidf_(bfhi(g.z)) * bfhi(z.z); s[6] += sigmoidf_(bflo(g.w)) * bflo(z.w); s[7] += sigmoidf_(bfhi(g.w)) * bfhi(z.w); }
        u32x4 w; w.x = cvt_pk_bf16(s[0], s[1]); w.y = cvt_pk_bf16(s[2], s[3]); w.z = cvt_pk_bf16(s[4], s[5]); w.w = cvt_pk_bf16(s[6], s[7]);
        *(u32x4*)(M + (size_t)row * DM + col) = w; }
}
struct EpiOut {
    static constexpr bool PERM = false, AFTER_DRAIN = false;
    const float* xp; const float* xs; const float* xb; const float* ada; float* xout; int l;
    __device__ __forceinline__ void operator()(const f32x4 (&acc)[2][2][4][2], const pg8::Unit& u, int wr, int wc, int fr, int fq) const {
        const int row0 = u.pm * 256 + wr * 64 + fr, col0 = u.pn * 256 + wc * 32 + 4 * fq;
#pragma unroll
        for (int ai = 0; ai < 2; ++ai)
#pragma unroll
            for (int m = 0; m < 4; ++m) { const int row = row0 + ai * 128 + m * 16;
                const float* base = l == 0 ? (row < TP ? xp + (size_t)row * DM : xs + (size_t)(row - TP) * DM) : xb + (size_t)row * DM;
                const int seq = row < TP ? 0 : 1 + ((row - TP) >> 5);
                const float* gate = ada + ((size_t)l * 33 + seq) * 6144 + 4096;
#pragma unroll
                for (int bj = 0; bj < 2; ++bj)
#pragma unroll
                    for (int n = 0; n < 2; ++n) { const int col = col0 + bj * 128 + n * 16;
                        *(f32x4*)(xout + (size_t)row * DM + col) = *(const f32x4*)(base + col) + *(const f32x4*)(gate + col) * acc[ai][bj][m][n]; } }
    }
};
__device__ __forceinline__ void conv_unit(KP p, int l, int tile, LAS unsigned char* lds, int tid) {
    const bf16_t* U = (const bf16_t*)(p->ws + WS_U);
    const int c = tid, wave = tid >> 6, lane = tid & 63;
    const bool samp = tile >= 512; const int b = tile - 512, row0 = samp ? TP + b * 32 : tile * 32;
    const bool last = samp || tile == 511;
    LAS float* red = (LAS float*)lds;
    LAS float* st = red + 8 * 32;
    const float cb = p->in[I_CONVB][l * 512 + c], lg = p->in[I_CLNG][l * 512 + c], lb = p->in[I_CLNB][l * 512 + c];
    bf16_t* oa = (bf16_t*)(p->ws + WS_OCAT);
#pragma unroll 1
    for (int half = 0; half < 2; ++half) {
        float z[46];
#pragma unroll
        for (int i = 0; i < 46; ++i) { const int rel = 16 * half + i - 30; float v;
            if (rel >= 0) { const size_t r = (size_t)(row0 + rel) * NU; v = bf2f(U[r + U_AVAL + c]) * sigmoidf_(bf2f(U[r + U_AGATE + c])); }
            else if (samp) v = p->in[I_SCONV][(((size_t)l * 32 + b) * 30 + (30 + rel)) * 512 + c];
            else if (row0 == 0) v = 0.f;
            else { const size_t r = (size_t)(row0 + rel) * NU; v = bf2f(U[r + U_AVAL + c]) * sigmoidf_(bf2f(U[r + U_AGATE + c])); }
            z[i] = v; }
        if (last) {
            float* dst = samp ? p->out + O_SCONV + (((size_t)l * 32 + b) * 30) * 512 + c : p->out + O_PCONV + ((size_t)l * 30) * 512 + c;
#pragma unroll
            for (int tt = 0; tt < 16; ++tt) { const int t = 16 * half + tt; if (t >= 2) dst[(size_t)(t - 2) * 512] = z[30 + tt]; }
        }
        float hv[16];
#pragma unroll
        for (int tt = 0; tt < 16; ++tt) hv[tt] = cb;
#pragma unroll
        for (int k = 0; k < 31; ++k) { const float w = p->in[I_CONVW][((size_t)l * 31 + k) * 512 + c];
#pragma unroll
            for (int tt = 0; tt < 16; ++tt) hv[tt] += z[tt + k] * w; }
#pragma unroll
        for (int tt = 0; tt < 16; ++tt) { const float s1 = wave_sum(hv[tt]), s2 = wave_sum(hv[tt] * hv[tt]); if (lane == 0) { red[(wave * 16 + tt) * 2] = s1; red[(wave * 16 + tt) * 2 + 1] = s2; } }
        __syncthreads();
        if (tid < 16) { float s1 = 0.f, s2 = 0.f;
#pragma unroll
            for (int w = 0; w < 8; ++w) { s1 += red[(w * 16 + tid) * 2]; s2 += red[(w * 16 + tid) * 2 + 1]; }
            const float mean = s1 * (1.f / 512.f), var = fmaxf(s2 * (1.f / 512.f) - mean * mean, 0.f);
            st[tid * 2] = mean; st[tid * 2 + 1] = 1.f / sqrtf(var + 1e-5f); }
        __syncthreads();
#pragma unroll
        for (int tt = 0; tt < 16; ++tt) { const float y = (hv[tt] - st[tt * 2]) * st[tt * 2 + 1] * lg + lb; const size_t r = (size_t)(row0 + 16 * half + tt);
            oa[r * 512 + c] = f2bf(siluf_(y) * siluf_(bf2f(U[r * NU + U_ASG + c]))); }
        __syncthreads();
    }
}
__device__ __forceinline__ void pool_unit(KP p, int l, int tile, LAS unsigned char* lds, int tid) {
    const bf16_t* U = (const bf16_t*)(p->ws + WS_U);
    const int c = tid, wave = tid >> 6, lane = tid & 63;
    const bool samp = tile >= 512; const int b = tile - 512, row0 = samp ? TP + b * 32 : tile * 32;
    constexpr int PST = 520;
    LAS bf16_t* pl = (LAS bf16_t*)lds;
    {
        float z[47];
#pragma unroll
        for (int i = 0; i < 15; ++i) {
            float v;
            if (samp) v = p->in[I_SPOOL][(((size_t)l * 32 + b) * 15 + i) * 512 + c];
            else if (row0 == 0) v = 0.f;
            else v = bf2f(U[(size_t)(row0 - 15 + i) * NU + U_DIN + c]);
            z[i] = v; }
#pragma unroll
        for (int t = 0; t < 32; ++t) z[15 + t] = bf2f(U[(size_t)(row0 + t) * NU + U_DIN + c]);
        if (samp || tile == 511) {
            float* dst = samp ? p->out + O_SPOOL + (((size_t)l * 32 + b) * 15) * 512 + c : p->out + O_PPOOL + ((size_t)l * 15) * 512 + c;
#pragma unroll
            for (int t = 17; t < 32; ++t) dst[(size_t)(t - 17) * 512] = z[15 + t];
        }
        const int w = 2 << (c >> 7);
#pragma unroll
        for (int t = 0; t < 32; ++t) { float s = 0.f;
#pragma unroll
            for (int i = 0; i < 16; ++i) s += (i < w) ? z[15 + t - i] : 0.f;
            const int pos = samp ? PAST + t : row0 + t; const int cnt = (pos + 1 < w) ? pos + 1 : w;
            pl[t * PST + c] = f2bf(s / (float)cnt - z[15 + t]); }
    }
    __syncthreads();
    {
        const int g = wave >> 1, fr = lane & 15, kq = lane >> 4;
        const bf16_t* WT = (const bf16_t*)(p->ws + WS_POOLW) + (size_t)(l * 4 + g) * 128 * 128;
        f32x4 acc[2][4];
#pragma unroll
        for (int mt = 0; mt < 2; ++mt)
#pragma unroll
            for (int nt = 0; nt < 4; ++nt) acc[mt][nt] = (f32x4){0.f, 0.f, 0.f, 0.f};
#pragma unroll
        for (int ks = 0; ks < 4; ++ks) {
            bf16x8 af[2];
#pragma unroll
            for (int mt = 0; mt < 2; ++mt) af[mt] = *(const LAS bf16x8*)(pl + (16 * mt + fr) * PST + g * 128 + 32 * ks + 8 * kq);
#pragma unroll
            for (int nt = 0; nt < 4; ++nt) { const int dl = (wave & 1) * 64 + 16 * nt + fr;
                const bf16x8 bfr = *(const bf16x8*)(WT + (size_t)dl * 128 + 32 * ks + 8 * kq);
#pragma unroll
                for (int mt = 0; mt < 2; ++mt) acc[mt][nt] = __builtin_amdgcn_mfma_f32_16x16x32_bf16(af[mt], bfr, acc[mt][nt], 0, 0, 0); }
        }
        bf16_t* od = (bf16_t*)(p->ws + WS_OCAT) + (size_t)3 * NTOK * 512;
#pragma unroll
        for (int nt = 0; nt < 4; ++nt) { const int d = wave * 64 + 16 * nt + fr; const float pb = p->in[I_POOLB][l * 512 + d], ps = p->in[I_POOLS][l * 512 + d];
#pragma unroll
            for (int mt = 0; mt < 2; ++mt)
#pragma unroll
                for (int r = 0; r < 4; ++r) { const size_t row = (size_t)(row0 + 16 * mt + 4 * kq + r);
                    od[row * 512 + d] = f2bf((acc[mt][nt][r] + pb) * ps * siluf_(bf2f(U[row * NU + U_DSG + d]))); } }
    }
    __syncthreads();
}
__device__ __forceinline__ void fp_unit(KP p, int l, int h, LAS unsigned char* lds, int tid) {
    const float* lf = p->out + O_PLF + (size_t)l * TP * 8 + h;
    LAS float* part = (LAS float*)lds;
    float v[32]; float s = 0.f;
#pragma unroll
    for (int i = 0; i < 32; ++i) { v[i] = lf[(size_t)(tid * 32 + i) * 8]; s += v[i]; }
    part[tid] = s;
    __syncthreads();
    float pre = 0.f;
    for (int j = 0; j < tid; ++j) pre += part[j];
    float* F = (float*)(p->ws + WS_FP) + (size_t)h * TP + tid * 32;
#pragma unroll
    for (int i = 0; i < 32; ++i) { pre += v[i]; F[i] = pre * LOG2E; }
    __syncthreads();
}
__device__ __forceinline__ void gs_unit(KP p, int l, int b, LAS unsigned char* lds, int tid) {
    const int h = tid & 7, ch = tid >> 3;
    const float* cl = p->in[I_CLF] + (((size_t)l * 32 + b) * PAST) * 8 + h;
    LAS float* part = (LAS float*)lds;
    float s = 0.f;
    for (int i = 0; i < 64; ++i) s += cl[(size_t)(ch * 64 + i) * 8];
    part[ch * 8 + h] = s;
    __syncthreads();
    float suf = 0.f;
    for (int j = ch + 1; j < 64; ++j) suf += part[j * 8 + h];
    float* G = (float*)(p->ws + WS_GS) + ((size_t)b * 8 + h) * GS_LEN;
    for (int i = 63; i >= 0; --i) { const int t = ch * 64 + i; G[t] = -suf * LOG2E; suf += cl[(size_t)t * 8]; }
    if (tid < 8) { const float* nl = p->out + O_SLF + ((size_t)l * 1024 + b * 32) * 8 + tid; float run = 0.f;
        for (int i = 0; i < 32; ++i) { run += nl[i * 8]; G[PAST + i] = run * LOG2E; } }
    __syncthreads();
}
__device__ __forceinline__ void vt_tile(KP p, int l, int tile, LAS unsigned char* lds, int wave, int lane) {
    const int h = tile >> 8, tb = tile & 255;
    const bf16_t* U = (const bf16_t*)(p->ws + WS_U);
    LAS unsigned* scr = (LAS unsigned*)lds + wave * SLOT_F;
#pragma unroll 8
    for (int tt = 0; tt < 64; ++tt) scr[tt * 65 + lane] = U[(size_t)(tb * 64 + tt) * NU + U_V + h * 64 + lane];
    {
        float mx = 0.f;
#pragma unroll 8
        for (int tt = 0; tt < 64; ++tt) { const float kv = bf2f(U[(size_t)(tb * 64 + tt) * NU + U_K + h * 64 + lane]); mx = fmaxf(mx, wave_sum(kv * kv)); }
        if (lane == 0) atomicMax((unsigned*)(p->ws + WS_CTL) + CW_KMAX + l * 8 + h, __float_as_uint(mx));
    }
    bf16_t* Vt = (bf16_t*)(p->ws + WS_VT);
    const int t2 = (lane & 31) * 2, dh = lane >> 5;
#pragma unroll 8
    for (int it = 0; it < 32; ++it) { const int d = 2 * it + dh; *(unsigned*)(Vt + ((size_t)h * 64 + d) * TP + tb * 64 + t2) = scr[t2 * 65 + d] | (scr[(t2 + 1) * 65 + d] << 16); }
}
__device__ __forceinline__ void shift_out(KP p, int l, int tid) {
    const bf16_t* U = (const bf16_t*)(p->ws + WS_U);
    for (int idx = tid; idx < NSEQ * SHIFT_W; idx += 512) { const int s = idx / SHIFT_W, j = idx - s * SHIFT_W;
        const int row = s == 0 ? TP - 1 : TP + (s - 1) * 32 + 31;
        float* dst = s == 0 ? p->out + O_PSHIFT + (size_t)l * SHIFT_W + j : p->out + O_SSHIFT + ((size_t)l * 32 + (s - 1)) * SHIFT_W + j;
        *dst = bf2f(U[(size_t)row * NU + U_XC + j]); }
}
template <bool AT, bool BT, bool NEGA>
__device__ __forceinline__ void mm32(f32x16& acc, const LAS float* Ap, int i0, const LAS float* Bp, int j0, int lane) {
    const int li = lane & 31, kh = lane >> 5;
    const LAS float* ap = AT ? Ap + kh * 65 + i0 + li : Ap + (i0 + li) * 65 + kh;
    const LAS float* bp = BT ? Bp + (j0 + li) * 65 + kh : Bp + kh * 65 + j0 + li;
#pragma unroll 8
    for (int s = 0; s < 32; ++s) {
        float a = AT ? ap[s * 130] : ap[s * 2];
        const float b = BT ? bp[s * 2] : bp[s * 130];
        if (NEGA) a = -a;
        acc = __builtin_amdgcn_mfma_f32_32x32x2f32(a, b, acc, 0, 0, 0);
    }
}
template <int MASK>
__device__ __forceinline__ void st_tile(LAS float* dst, const f32x16& acc, int i0, int j0, int lane) {
    const int li = lane & 31, hi = lane >> 5, j = j0 + li;
#pragma unroll
    for (int r = 0; r < 16; ++r) { const int i = i0 + (r & 3) + 8 * (r >> 2) + 4 * hi; float v = acc[r];
        if (MASK == 1 && !(i < j)) v = 0.f; if (MASK == 2 && !(i <= j)) v = 0.f; dst[i * 65 + j] = v; }
}
struct RwkvSeqInfo { int row0, ntok, prev_kind  , b; };
__device__ __forceinline__ RwkvSeqInfo rwkv_info(int cu) { RwkvSeqInfo s; if (cu < 256) { s.row0 = cu * 64; s.ntok = 64; s.prev_kind = cu == 0 ? 0 : 1; s.b = 0; } else { s.b = cu - 256; s.row0 = TP + s.b * 32; s.ntok = 32; s.prev_kind = 2; } return s; }

__device__ __forceinline__ void rwkv_r1(KP p, int l, int unit, LAS unsigned char* lds, int tid) {
    const int cu = unit >> 3, h = unit & 7, wave = tid >> 6, lane = tid & 63, li = lane & 31, hi = lane >> 5;
    const RwkvSeqInfo si = rwkv_info(cu);
    const bf16_t* U = (const bf16_t*)(p->ws + WS_U);
    LAS float* S0 = (LAS float*)lds; LAS float *S1 = S0 + SLOT_F, *S2 = S0 + 2 * SLOT_F, *S3 = S0 + 3 * SLOT_F, *S4 = S0 + 4 * SLOT_F, *S5 = S0 + 5 * SLOT_F, *S6 = S0 + 6 * SLOT_F, *S7 = S0 + 7 * SLOT_F, *S8 = S0 + 8 * SLOT_F;
    LAS float* gC = S0 + 9 * SLOT_F;
    const int q = wave >> 2, wq = wave & 3, i0 = (wq >> 1) * 32, j0 = (wq & 1) * 32;
    {
        const int j = tid & 63, tq = tid >> 6;
        const int offs[5] = {h * 64, 512 + h * 64, 1024 + h * 64, 1536, 1600};
#pragma unroll
        for (int cs = 0; cs < 5; ++cs) {
            const int xo = offs[cs] + j; const float mu = p->in[I_MU][l * SHIFT_W + xo];
            LAS float* dst = cs == 0 ? S0 : cs == 1 ? S1 : cs == 2 ? S2 : cs == 3 ? S3 : S4;
            const int t0 = tq * 8; float prev;
            if (t0 == 0) prev = si.prev_kind == 0 ? 0.f : si.prev_kind == 1 ? bf2f(U[(size_t)(si.row0 - 1) * NU + U_XC + xo]) : p->in[I_SSHIFT][((size_t)l * 32 + si.b) * SHIFT_W + xo];
            else prev = (t0 - 1 < si.ntok) ? bf2f(U[(size_t)(si.row0 + t0 - 1) * NU + U_XC + xo]) : 0.f;
#pragma unroll
            for (int tt = 0; tt < 8; ++tt) { const int t = t0 + tt; float xs = 0.f;
                if (t < si.ntok) { const float x = bf2f(U[(size_t)(si.row0 + t) * NU + U_XC + xo]); xs = x + (prev - x) * mu; prev = x; }
                if (cs == 3) xs = fast_tanh(xs);
                dst[t * 65 + j] = xs; }
        }
#pragma unroll
        for (int mm = 0; mm < 8; ++mm) { const int m = tq * 8 + mm;
            S5[m * 65 + j] = p->in[I_W2][((size_t)l * 64 + m) * 512 + h * 64 + j]; S6[m * 65 + j] = p->in[I_A2][((size_t)l * 64 + m) * 512 + h * 64 + j]; }
    }
    __syncthreads();
    {
        f32x16 acc = {};
        const int c = j0 + li;
        if (q == 0) { mm32<false, false, false>(acc, S3, i0, S5, j0, lane); const float w0 = p->in[I_W0][l * 512 + h * 64 + c];
#pragma unroll
            for (int r = 0; r < 16; ++r) { const int t = i0 + (r & 3) + 8 * (r >> 2) + 4 * hi; const float zz = acc[r] + w0;
                const float sp = fmaxf(-zz, 0.f) + __logf(1.f + __expf(-fabsf(zz)));
                S7[t * 65 + c] = (t < si.ntok) ? -__expf(-sp - 0.5f) : 0.f; } }
        else { mm32<false, false, false>(acc, S4, i0, S6, j0, lane); const float a0 = p->in[I_A0][l * 512 + h * 64 + c];
#pragma unroll
            for (int r = 0; r < 16; ++r) { const int t = i0 + (r & 3) + 8 * (r >> 2) + 4 * hi; S8[t * 65 + c] = __builtin_amdgcn_rcpf(1.f + __expf(-(acc[r] + a0))); } }
    }
    __syncthreads();
    if (wave == 0) { float run = 0.f;
#pragma unroll 8
        for (int t = 0; t < 64; ++t) { run += S7[t * 65 + lane]; S3[t * 65 + lane] = run; } }
    else { const int c = lane; const float kkw = p->in[I_KK][l * 512 + h * 64 + c], kaw = p->in[I_KA][l * 512 + h * 64 + c], rkw = p->in[I_RK][l * 512 + h * 64 + c];
        for (int t = wave - 1; t < 64; t += 7) { const float kr = S1[t * 65 + c], kv = kr * kkw; const float ss = wave_sum(kv * kv);
            const float kn = kv * (1.f / sqrtf(fmaxf(ss, 1e-24f))); const float a = S8[t * 65 + c]; const float km = kr * (1.f + (a - 1.f) * kaw);
            const float bon = wave_sum(S0[t * 65 + c] * km * rkw);
            S4[t * 65 + c] = kn; S1[t * 65 + c] = km; S8[t * 65 + c] = kn * a;
            if (lane == 0) ((float*)(p->ws + WS_BONUS))[(size_t)unit * 64 + t] = bon; } }
    __syncthreads();
    { const int c = tid & 63, tq = tid >> 6;
#pragma unroll
        for (int tt = 0; tt < 8; ++tt) { const int t = tq * 8 + tt, o = t * 65 + c; const float Lg = S3[o], lw = S7[o];
            const float g = __expf(Lg), gi = __expf(-Lg), gp = __expf(Lg - lw);
            S0[o] *= g; S1[o] *= gi; S8[o] *= gi; S4[o] *= gp; if (t == 63) gC[c] = g; } }
    __syncthreads();
    { f32x16 acc = {};
      if (q == 0) { mm32<false, true, false>(acc, S1, i0, S4, j0, lane); st_tile<1>(S3, acc, i0, j0, lane); }
      else { mm32<false, true, false>(acc, S8, i0, S4, j0, lane); st_tile<1>(S5, acc, i0, j0, lane); } }
    __syncthreads();
    { f32x16 acc = {};
      if (q == 0) { mm32<true, false, false>(acc, S2, i0, S3, j0, lane); st_tile<0>(S6, acc, i0, j0, lane); }
      else { mm32<false, true, false>(acc, S1, i0, S0, j0, lane); st_tile<2>(S7, acc, i0, j0, lane); } }
    __syncthreads();
    { float x[16]; const int r0 = (wave & 3) * 16;
      if (wave < 4) {
#pragma unroll
          for (int rr = 0; rr < 16; ++rr) x[rr] = S4[lane * 65 + r0 + rr]; }
      else {
#pragma unroll
          for (int rr = 0; rr < 16; ++rr) x[rr] = S6[(r0 + rr) * 65 + lane]; }
      __syncthreads();
#pragma unroll
      for (int s = 0; s < 63; ++s) { const float mrow = S5[s * 65 + lane];
#pragma unroll
          for (int rr = 0; rr < 16; ++rr) x[rr] -= __builtin_bit_cast(float, __builtin_amdgcn_readlane(__builtin_bit_cast(int, x[rr]), s)) * mrow; }
      LAS float* dst = wave < 4 ? S3 : S6;
#pragma unroll
      for (int rr = 0; rr < 16; ++rr) dst[(r0 + rr) * 65 + lane] = x[rr]; }
    __syncthreads();
    { f32x16 acc = {};
      if (q == 1) { mm32<false, true, false>(acc, S8, i0, S0, j0, lane); st_tile<2>(S4, acc, i0, j0, lane); }
      else { mm32<false, false, false>(acc, S3, i0, S8, j0, lane);
          const int jc = j0 + li; const float gc = gC[jc]; float* TQ = (float*)(p->ws + WS_TQ) + (size_t)unit * 4096;
#pragma unroll
          for (int rg = 0; rg < 4; ++rg) { const int ab = i0 + 8 * rg + 4 * hi; f32x4 o;
#pragma unroll
              for (int e = 0; e < 4; ++e) o[e] = ((ab + e == jc) ? gc : 0.f) - acc[rg * 4 + e] * gc;
              *(f32x4*)(TQ + ((((jc >> 4) * 4 + (ab >> 4)) * 64 + ((ab & 15) >> 2) * 16 + (jc & 15)) * 4)) = o; } } }
    __syncthreads();
    { f32x16 acc = {};
      if (q == 0) { mm32<true, false, false>(acc, S2, i0, S1, j0, lane); mm32<false, false, true>(acc, S6, i0, S8, j0, lane);
          const int jc = j0 + li; const float gc = gC[jc]; float* GM = (float*)(p->ws + WS_GM) + (size_t)unit * 4096;
#pragma unroll
          for (int r = 0; r < 16; ++r) GM[(i0 + (r & 3) + 8 * (r >> 2) + 4 * hi) * 64 + jc] = acc[r] * gc; }
      else { mm32<true, false, false>(acc, S2, i0, S7, j0, lane); mm32<false, false, true>(acc, S6, i0, S4, j0, lane);
          float* Y0T = (float*)(p->ws + WS_Y0T) + (size_t)unit * 4096 + (j0 + li) * 64;
#pragma unroll
          for (int rg = 0; rg < 4; ++rg) *(f32x4*)(Y0T + i0 + 8 * rg + 4 * hi) = (f32x4){acc[rg * 4], acc[rg * 4 + 1], acc[rg * 4 + 2], acc[rg * 4 + 3]}; } }
    if (q == 0) { f32x16 acc;
#pragma unroll
        for (int r = 0; r < 16; ++r) acc[r] = S0[(j0 + li) * 65 + i0 + (r & 3) + 8 * (r >> 2) + 4 * hi];
        mm32<false, false, true>(acc, S3, i0, S4, j0, lane);
        float* ET = (float*)(p->ws + WS_ET) + (size_t)unit * 4096 + (j0 + li) * 64;
#pragma unroll
        for (int rg = 0; rg < 4; ++rg) *(f32x4*)(ET + i0 + 8 * rg + 4 * hi) = (f32x4){acc[rg * 4], acc[rg * 4 + 1], acc[rg * 4 + 2], acc[rg * 4 + 3]}; }
    __syncthreads();
}
__device__ __forceinline__ void chain_run(f32x4 (&st)[4], const float* TQ, const float* GM, float* SC, int nsteps, int i, int g, int lane) {
    constexpr size_t STRIDE = (size_t)8 * 4096;
    f32x4 tq[16], gm[4];
#pragma unroll
    for (int x = 0; x < 16; ++x) tq[x] = *(const f32x4*)(TQ + (x * 64 + lane) * 4);
#pragma unroll
    for (int tl = 0; tl < 4; ++tl) gm[tl] = GM ? *(const f32x4*)(GM + i * 64 + 16 * tl + 4 * g) : (f32x4){0.f, 0.f, 0.f, 0.f};
    for (int c = 0; c < nsteps; ++c) {
        if (SC) {
#pragma unroll
            for (int tl = 0; tl < 4; ++tl) *(f32x4*)(SC + c * STRIDE + i * 64 + 16 * tl + 4 * g) = st[tl]; }
        f32x4 tqn[16], gmn[4];
        const int cn = (c + 1 < nsteps) ? c + 1 : c;
#pragma unroll
        for (int x = 0; x < 16; ++x) tqn[x] = *(const f32x4*)(TQ + cn * STRIDE + (x * 64 + lane) * 4);
#pragma unroll
        for (int tl = 0; tl < 4; ++tl) gmn[tl] = GM ? *(const f32x4*)(GM + cn * STRIDE + i * 64 + 16 * tl + 4 * g) : (f32x4){0.f, 0.f, 0.f, 0.f};
        f32x4 acc[4];
#pragma unroll
        for (int tp = 0; tp < 4; ++tp) acc[tp] = gm[tp];
#pragma unroll
        for (int tl = 0; tl < 4; ++tl)
#pragma unroll
            for (int r = 0; r < 4; ++r)
#pragma unroll
                for (int tp = 0; tp < 4; ++tp) acc[tp] = __builtin_amdgcn_mfma_f32_16x16x4f32(tq[tp * 4 + tl][r], st[tl][r], acc[tp], 0, 0, 0);
#pragma unroll
        for (int tl = 0; tl < 4; ++tl) st[tl] = acc[tl];
#pragma unroll
        for (int x = 0; x < 16; ++x) tq[x] = tqn[x];
#pragma unroll
        for (int tl = 0; tl < 4; ++tl) gm[tl] = gmn[tl];
    }
}
__device__ __forceinline__ void rwkv_l1_task(KP p, int task, int lane) {
    const int iq = task & 3, kind = (task >> 2) & 1, h = (task >> 3) & 7, grp = task >> 6;
    const int fr = lane & 15, g = lane >> 4, i = iq * 16 + fr;
    const size_t u0 = ((size_t)(grp * 16) * 8 + h) * 4096;
    const float* TQ = (const float*)(p->ws + WS_TQ) + u0; const float* GM = (const float*)(p->ws + WS_GM) + u0;
    f32x4 st[4];
#pragma unroll
    for (int tl = 0; tl < 4; ++tl)
#pragma unroll
        for (int r = 0; r < 4; ++r) st[tl][r] = (kind == 1 && i == 16 * tl + 4 * g + r) ? 1.f : 0.f;
    chain_run(st, TQ, kind == 0 ? GM : nullptr, nullptr, 16, i, g, lane);
    const size_t gb = ((size_t)grp * 8 + h) * 4096;
    if (kind == 0) { float* GG = (float*)(p->ws + WS_GG) + gb;
#pragma unroll
        for (int tl = 0; tl < 4; ++tl) *(f32x4*)(GG + i * 64 + 16 * tl + 4 * g) = st[tl]; }
    else { float* TG = (float*)(p->ws + WS_TG) + gb;
#pragma unroll
        for (int tl = 0; tl < 4; ++tl)
#pragma unroll
            for (int r = 0; r < 4; ++r) TG[((tl * 4 + iq) * 64 + (fr >> 2) * 16 + 4 * g + r) * 4 + (fr & 3)] = st[tl][r]; }
}
__device__ __forceinline__ void rwkv_l2_task(KP p, int l, int task, int lane) {
    const int iq = task & 3, h = task >> 2, fr = lane & 15, g = lane >> 4, i = iq * 16 + fr;
    f32x4 st[4];
#pragma unroll
    for (int tl = 0; tl < 4; ++tl) st[tl] = (f32x4){0.f, 0.f, 0.f, 0.f};
    chain_run(st, (const float*)(p->ws + WS_TG) + (size_t)h * 4096, (const float*)(p->ws + WS_GG) + (size_t)h * 4096, (float*)(p->ws + WS_SG) + (size_t)h * 4096, 16, i, g, lane);
    float* dst = p->out + O_PWKV + (((size_t)l * 8 + h) * 64 + i) * 64;
#pragma unroll
    for (int tl = 0; tl < 4; ++tl) *(f32x4*)(dst + 16 * tl + 4 * g) = st[tl];
}
__device__ __forceinline__ void rwkv_l3_task(KP p, int l, int task, int lane) {
    const int fr = lane & 15, g = lane >> 4;
    f32x4 st[4];
    if (task < 512) { const int iq = task & 3, h = (task >> 2) & 7, grp = task >> 5, i = iq * 16 + fr;
        const float* s0 = (const float*)(p->ws + WS_SG) + ((size_t)grp * 8 + h) * 4096 + i * 64;
#pragma unroll
        for (int tl = 0; tl < 4; ++tl) st[tl] = *(const f32x4*)(s0 + 16 * tl + 4 * g);
        const size_t u0 = ((size_t)(grp * 16) * 8 + h) * 4096;
        chain_run(st, (const float*)(p->ws + WS_TQ) + u0, (const float*)(p->ws + WS_GM) + u0, (float*)(p->ws + WS_SC) + u0, 16, i, g, lane); }
    else { const int t2 = task - 512, iq = t2 & 3, h = (t2 >> 2) & 7, b = t2 >> 5, i = iq * 16 + fr;
        const float* s0 = p->in[I_SWKV] + ((((size_t)l * 32 + b) * 8 + h) * 64 + i) * 64;
#pragma unroll
        for (int tl = 0; tl < 4; ++tl) st[tl] = *(const f32x4*)(s0 + 16 * tl + 4 * g);
        const size_t u0 = ((size_t)(256 + b) * 8 + h) * 4096;
        chain_run(st, (const float*)(p->ws + WS_TQ) + u0, (const float*)(p->ws + WS_GM) + u0, (float*)(p->ws + WS_SC) + u0, 1, i, g, lane);
        float* dst = p->out + O_SWKV + ((((size_t)l * 32 + b) * 8 + h) * 64 + i) * 64;
#pragma unroll
        for (int tl = 0; tl < 4; ++tl) *(f32x4*)(dst + 16 * tl + 4 * g) = st[tl]; }
}
__device__ __forceinline__ void rwkv_r3_task(KP p, int l, int task, int lane) {
    const int unit = task >> 1, th = task & 1, cu = unit >> 3, h = unit & 7, li = lane & 31, hi = lane >> 5;
    const RwkvSeqInfo si = rwkv_info(cu);
    if (th * 32 >= si.ntok) return;
    const bf16_t* U = (const bf16_t*)(p->ws + WS_U);
    const size_t ub = (size_t)unit * 4096; const int t = th * 32 + li;
    const float* SC = (const float*)(p->ws + WS_SC) + ub; const float* ET = (const float*)(p->ws + WS_ET) + ub + t * 64 + 32 * hi; const float* Y0T = (const float*)(p->ws + WS_Y0T) + ub + t * 64;
    f32x16 acc[2];
#pragma unroll
    for (int ti = 0; ti < 2; ++ti)
#pragma unroll
        for (int rg = 0; rg < 4; ++rg) { const f32x4 y0 = *(const f32x4*)(Y0T + 32 * ti + 8 * rg + 4 * hi);
#pragma unroll
            for (int e = 0; e < 4; ++e) acc[ti][rg * 4 + e] = y0[e]; }
#pragma unroll
    for (int s4 = 0; s4 < 8; ++s4) {
        const f32x4 eb = *(const f32x4*)(ET + 4 * s4);
        const f32x4 sa0 = *(const f32x4*)(SC + (li) * 64 + 32 * hi + 4 * s4), sa1 = *(const f32x4*)(SC + (32 + li) * 64 + 32 * hi + 4 * s4);
#pragma unroll
        for (int e = 0; e < 4; ++e) { acc[0] = __builtin_amdgcn_mfma_f32_32x32x2f32(sa0[e], eb[e], acc[0], 0, 0, 0); acc[1] = __builtin_amdgcn_mfma_f32_32x32x2f32(sa1[e], eb[e], acc[1], 0, 0, 0); }
    }
    float s1 = 0.f;
#pragma unroll
    for (int ti = 0; ti < 2; ++ti)
#pragma unroll
        for (int r = 0; r < 16; ++r) s1 += acc[ti][r];
    s1 = xhalf_sum(s1); const float mean = s1 * (1.f / 64.f);
    float s2 = 0.f;
#pragma unroll
    for (int ti = 0; ti < 2; ++ti)
#pragma unroll
        for (int r = 0; r < 16; ++r) { const float d = acc[ti][r] - mean; s2 += d * d; }
    s2 = xhalf_sum(s2); const float rstd = 1.f / sqrtf(s2 * (1.f / 64.f) + 64e-5f);
    if (t >= si.ntok) return;
    const float bon = ((const float*)(p->ws + WS_BONUS))[(size_t)unit * 64 + t];
    const size_t row = (size_t)(si.row0 + t);
    bf16_t* oc = (bf16_t*)(p->ws + WS_OCAT) + (size_t)2 * NTOK * 512 + row * 512 + h * 64;
#pragma unroll
    for (int ti = 0; ti < 2; ++ti)
#pragma unroll
        for (int rg = 0; rg < 4; ++rg) { const int i = 32 * ti + 8 * rg + 4 * hi, c = h * 64 + i;
            const f32x4 gg = *(const f32x4*)(p->in[I_GNG] + l * 512 + c), gb = *(const f32x4*)(p->in[I_GNB] + l * 512 + c), mu = *(const f32x4*)(p->in[I_MU] + l * SHIFT_W + 1024 + c);
            const u32x2 vx = *(const u32x2*)(U + row * NU + U_XC + 1024 + c); const u32x2 sg = *(const u32x2*)(U + row * NU + U_CSG + c);
            f32x4 vc = (f32x4){bflo(vx.x), bfhi(vx.x), bflo(vx.y), bfhi(vx.y)}, vp;
            if (t > 0 || si.prev_kind == 1) { const u32x2 px = *(const u32x2*)(U + (row - 1) * NU + U_XC + 1024 + c); vp = (f32x4){bflo(px.x), bfhi(px.x), bflo(px.y), bfhi(px.y)}; }
            else if (si.prev_kind == 2) vp = *(const f32x4*)(p->in[I_SSHIFT] + ((size_t)l * 32 + si.b) * SHIFT_W + 1024 + c);
            else vp = (f32x4){0.f, 0.f, 0.f, 0.f};
            const f32x4 vs = vc + (vp - vc) * mu;
            const f32x4 sgf = (f32x4){bflo(sg.x), bfhi(sg.x), bflo(sg.y), bfhi(sg.y)};
            f32x4 o;
#pragma unroll
            for (int e = 0; e < 4; ++e) o[e] = (((acc[ti][rg * 4 + e] - mean) * rstd) * gg[e] + gb[e] + bon * vs[e]) * siluf_(sgf[e]);
            u32x2 w; w.x = cvt_pk_bf16(o[0], o[1]); w.y = cvt_pk_bf16(o[2], o[3]); *(u32x2*)(oc + i) = w; }
}
__device__ __forceinline__ int krow(int i) { return (i & 3) + 4 * ((i >> 3) & 1) + 8 * ((i >> 2) & 1) + 16 * (i >> 4); }
__device__ __forceinline__ bf16x8 pack8(const f32x16& v, int o) { u32x4 w; w.x = cvt_pk_bf16(v[o], v[o + 1]); w.y = cvt_pk_bf16(v[o + 2], v[o + 3]); w.z = cvt_pk_bf16(v[o + 4], v[o + 5]); w.w = cvt_pk_bf16(v[o + 6], v[o + 7]); return __builtin_bit_cast(bf16x8, w); }
__device__ __forceinline__ bf16x8 pack8f(const f32x4 a, const f32x4 b) { u32x4 w; w.x = cvt_pk_bf16(a[0], a[1]); w.y = cvt_pk_bf16(a[2], a[3]); w.z = cvt_pk_bf16(b[0], b[1]); w.w = cvt_pk_bf16(b[2], b[3]); return __builtin_bit_cast(bf16x8, w); }
constexpr float ATT_NEG = -1e30f;
template <bool HALF>
__device__ __forceinline__ void softmax_tile(f32x16& p0, f32x16& p1, float& m, float& lsum, f32x16 (&O)[2], bf16x8 (&pb)[4]) {
    float mx = p0[0];
#pragma unroll
    for (int r = 1; r < 16; ++r) mx = fmaxf(mx, p0[r]);
    if (!HALF) {
#pragma unroll
        for (int r = 0; r < 16; ++r) mx = fmaxf(mx, p1[r]); }
    mx = xhalf_max(mx);
    const float mn = fmaxf(m, mx), alpha = __builtin_amdgcn_exp2f(m - mn);
    m = mn;
    float s = 0.f;
#pragma unroll
    for (int r = 0; r < 16; ++r) { p0[r] = __builtin_amdgcn_exp2f(p0[r] - mn); s += p0[r]; }
    if (!HALF) {
#pragma unroll
        for (int r = 0; r < 16; ++r) { p1[r] = __builtin_amdgcn_exp2f(p1[r] - mn); s += p1[r]; } }
    lsum = lsum * alpha + s;
#pragma unroll
    for (int r = 0; r < 16; ++r) { O[0][r] *= alpha; O[1][r] *= alpha; }
    pb[0] = pack8(p0, 0); pb[1] = pack8(p0, 8);
    if (!HALF) { pb[2] = pack8(p1, 0); pb[3] = pack8(p1, 8); }
}
constexpr int AKS = 72;
constexpr int ATT_KB = 0, ATT_VB = 2 * 64 * AKS * 2, ATT_FB = 4 * 64 * AKS * 2, ATT_SC = ATT_FB + 2 * 64 * 4;
__device__ __forceinline__ void attn_prompt_unit(KP p, int l, int h, int qb, LAS unsigned char* lds, int tid) {
    const bf16_t* U = (const bf16_t*)(p->ws + WS_U); const bf16_t* Vt = (const bf16_t*)(p->ws + WS_VT) + (size_t)h * 64 * TP; const float* F = (const float*)(p->ws + WS_FP) + (size_t)h * TP;
    const int wave = tid >> 6, lane = tid & 63, li = lane & 31, hi = lane >> 5;
    const int q0 = qb * 256, q = q0 + wave * 32 + li;
    bf16x8 qf[4];
    { const float sc = 0.125f * LOG2E;
#pragma unroll
      for (int d0 = 0; d0 < 4; ++d0) { const u32x4 w = *(const u32x4*)(U + (size_t)q * NU + U_Q + h * 64 + 16 * d0 + 8 * hi);
          qf[d0] = pack8f((f32x4){bflo(w.x) * sc, bfhi(w.x) * sc, bflo(w.y) * sc, bfhi(w.y) * sc}, (f32x4){bflo(w.z) * sc, bfhi(w.z) * sc, bflo(w.w) * sc, bfhi(w.w) * sc}); } }
    const float fq = F[q];
    float m = ATT_NEG, lsum = 0.f; f32x16 O[2] = {};
    const int NT = (q0 + 256) / 64;
    LAS float* qmx = (LAS float*)(lds + ATT_SC); LAS float* mmv = qmx + 8;
    { float q2 = 0.f;
#pragma unroll
      for (int d0 = 0; d0 < 4; ++d0) { const u32x4 w = __builtin_bit_cast(u32x4, qf[d0]); q2 += bflo(w.x) * bflo(w.x) + bfhi(w.x) * bfhi(w.x) + bflo(w.y) * bflo(w.y) + bfhi(w.y) * bfhi(w.y) + bflo(w.z) * bflo(w.z) + bfhi(w.z) * bfhi(w.z) + bflo(w.w) * bflo(w.w) + bfhi(w.w) * bfhi(w.w); }
      q2 = wave_max(xhalf_sum(q2)); if (lane == 0) { qmx[wave] = q2; mmv[wave] = ATT_NEG; } }
    const float kmax2 = __uint_as_float(((const unsigned*)(p->ws + WS_CTL))[CW_KMAX + l * 8 + h]), fq0 = F[q0];
    const int srow = tid >> 3, sch = tid & 7;
    const bf16_t* kg = U + (size_t)srow * NU + U_K + h * 64 + 8 * sch; const bf16_t* vg = Vt + (size_t)srow * TP + 8 * sch;
    LAS unsigned char* kdst = lds + ATT_KB + (srow * AKS + 8 * sch) * 2; LAS unsigned char* vdst = lds + ATT_VB + (srow * AKS + 8 * sch) * 2;
    u32x4 kr = *(const u32x4*)(kg + (size_t)(NT - 1) * 64 * NU), vr = *(const u32x4*)(vg + (NT - 1) * 64); float fr = tid < 64 ? F[(NT - 1) * 64 + tid] : 0.f;
    *(LAS u32x4*)kdst = kr; *(LAS u32x4*)vdst = vr; if (tid < 64) ((LAS float*)(lds + ATT_FB))[tid] = fr;
    __syncthreads();
    const int ka = krow(li);
    float qkb; { float q2 = qmx[0];
#pragma unroll
      for (int w = 1; w < 8; ++w) q2 = fmaxf(q2, qmx[w]);
      qkb = 1.02f * sqrtf(q2 * kmax2) + fq0; }
    for (int t = NT - 1, buf = 0; t >= 0; --t, buf ^= 1) {
        { float mmin = mmv[0];
#pragma unroll
          for (int w = 1; w < 8; ++w) mmin = fminf(mmin, mmv[w]);
          if (qkb - ((const LAS float*)(lds + ATT_FB))[buf * 64 + 63] < mmin - 40.f) break; }
        if (t > 0) { kr = *(const u32x4*)(kg + (size_t)(t - 1) * 64 * NU); vr = *(const u32x4*)(vg + (t - 1) * 64); if (tid < 64) fr = F[(t - 1) * 64 + tid]; }
        if (64 * t <= q0 + wave * 32 + 31) {
            const LAS bf16_t* Kb = (const LAS bf16_t*)(lds + ATT_KB) + buf * 64 * AKS; const LAS bf16_t* Vb = (const LAS bf16_t*)(lds + ATT_VB) + buf * 64 * AKS; const LAS float* Fb = (const LAS float*)(lds + ATT_FB) + buf * 64;
            f32x16 p0, p1;
#pragma unroll
            for (int g2 = 0; g2 < 2; ++g2) { const f32x4 a = *(const LAS f32x4*)(Fb + 8 * hi + 16 * g2), b = *(const LAS f32x4*)(Fb + 8 * hi + 16 * g2 + 4), c = *(const LAS f32x4*)(Fb + 32 + 8 * hi + 16 * g2), d = *(const LAS f32x4*)(Fb + 32 + 8 * hi + 16 * g2 + 4);
#pragma unroll
                for (int e = 0; e < 4; ++e) { p0[8 * g2 + e] = fq - a[e]; p0[8 * g2 + 4 + e] = fq - b[e]; p1[8 * g2 + e] = fq - c[e]; p1[8 * g2 + 4 + e] = fq - d[e]; } }
#pragma unroll
            for (int d0 = 0; d0 < 4; ++d0) { const bf16x8 a0 = *(const LAS bf16x8*)(Kb + ka * AKS + 16 * d0 + 8 * hi), a1 = *(const LAS bf16x8*)(Kb + (ka + 32) * AKS + 16 * d0 + 8 * hi);
                p0 = __builtin_amdgcn_mfma_f32_32x32x16_bf16(a0, qf[d0], p0, 0, 0, 0); p1 = __builtin_amdgcn_mfma_f32_32x32x16_bf16(a1, qf[d0], p1, 0, 0, 0); }
            if (64 * t + 63 > q0 + wave * 32) {
#pragma unroll
                for (int r = 0; r < 16; ++r) { const int kv = 64 * t + 8 * hi + 16 * (r >> 3) + (r & 7); if (kv > q) p0[r] = -INFINITY; if (kv + 32 > q) p1[r] = -INFINITY; } }
            bf16x8 pb[4];
            softmax_tile<false>(p0, p1, m, lsum, O, pb);
#pragma unroll
            for (int dt = 0; dt < 2; ++dt)
#pragma unroll
                for (int s = 0; s < 4; ++s) { const bf16x8 a = *(const LAS bf16x8*)(Vb + (32 * dt + li) * AKS + 16 * (s & 1) + 32 * (s >> 1) + 8 * hi);
                    O[dt] = __builtin_amdgcn_mfma_f32_32x32x16_bf16(a, pb[s], O[dt], 0, 0, 0); }
        }
        { const float wm = wave_min(m); if (lane == 0) mmv[wave] = wm; }
        if (t > 0) { const int nb = buf ^ 1; *(LAS u32x4*)(kdst + nb * 64 * AKS * 2) = kr; *(LAS u32x4*)(vdst + nb * 64 * AKS * 2) = vr; if (tid < 64) ((LAS float*)(lds + ATT_FB))[nb * 64 + tid] = fr; }
        __syncthreads();
    }
    __syncthreads();
    const float inv = 1.f / xhalf_sum(lsum);
    bf16_t* ob = (bf16_t*)(p->ws + WS_OCAT) + (size_t)1 * NTOK * 512 + (size_t)q * 512 + h * 64;
#pragma unroll
    for (int dt = 0; dt < 2; ++dt)
#pragma unroll
        for (int rg = 0; rg < 4; ++rg) { const int d = 32 * dt + 8 * rg + 4 * hi; const u32x2 sg = *(const u32x2*)(U + (size_t)q * NU + U_BSG + h * 64 + d);
            u32x2 w; w.x = cvt_pk_bf16(O[dt][rg * 4] * inv * siluf_(bflo(sg.x)), O[dt][rg * 4 + 1] * inv * siluf_(bfhi(sg.x))); w.y = cvt_pk_bf16(O[dt][rg * 4 + 2] * inv * siluf_(bflo(sg.y)), O[dt][rg * 4 + 3] * inv * siluf_(bfhi(sg.y)));
            *(u32x2*)(ob + d) = w; }
}
__device__ __forceinline__ void attn_sample_unit(KP p, int l, int b, int h, LAS unsigned char* lds, int tid) {
    const bf16_t* U = (const bf16_t*)(p->ws + WS_U);
    const int wave = tid >> 6, lane = tid & 63, li = lane & 31, hi = lane >> 5;
    const size_t qrow = (size_t)TP + b * 32 + li;
    const float* G = (const float*)(p->ws + WS_GS) + ((size_t)b * 8 + h) * GS_LEN;
    bf16x8 qf[4];
    { const float sc = 0.125f * LOG2E;
#pragma unroll
      for (int d0 = 0; d0 < 4; ++d0) { const u32x4 w = *(const u32x4*)(U + qrow * NU + U_Q + h * 64 + 16 * d0 + 8 * hi);
          qf[d0] = pack8f((f32x4){bflo(w.x) * sc, bfhi(w.x) * sc, bflo(w.y) * sc, bfhi(w.y) * sc}, (f32x4){bflo(w.z) * sc, bfhi(w.z) * sc, bflo(w.w) * sc, bfhi(w.w) * sc}); } }
    const float fq = G[PAST + li];
    float m = ATT_NEG, lsum = 0.f; f32x16 O[2] = {};
    const float* CK = p->in[I_CK] + (((size_t)l * 32 + b) * PAST) * 512 + h * 64; const float* CV = p->in[I_CV] + (((size_t)l * 32 + b) * PAST) * 512 + h * 64;
    const int ka = krow(li);
    for (int tt = 0; tt < 8; ++tt) {
        const int key0 = (wave * 8 + tt) * 64;
        f32x16 p0, p1;
#pragma unroll
        for (int g2 = 0; g2 < 2; ++g2) { const float* gp = G + key0 + 8 * hi + 16 * g2; const f32x4 a = *(const f32x4*)gp, bq = *(const f32x4*)(gp + 4), c = *(const f32x4*)(gp + 32), d = *(const f32x4*)(gp + 36);
#pragma unroll
            for (int e = 0; e < 4; ++e) { p0[8 * g2 + e] = fq - a[e]; p0[8 * g2 + 4 + e] = fq - bq[e]; p1[8 * g2 + e] = fq - c[e]; p1[8 * g2 + 4 + e] = fq - d[e]; } }
#pragma unroll
        for (int d0 = 0; d0 < 4; ++d0) { const float* k0p = CK + (size_t)(key0 + ka) * 512 + 16 * d0 + 8 * hi; const float* k1p = k0p + (size_t)32 * 512;
            const bf16x8 a0 = pack8f(*(const f32x4*)k0p, *(const f32x4*)(k0p + 4)), a1 = pack8f(*(const f32x4*)k1p, *(const f32x4*)(k1p + 4));
            p0 = __builtin_amdgcn_mfma_f32_32x32x16_bf16(a0, qf[d0], p0, 0, 0, 0); p1 = __builtin_amdgcn_mfma_f32_32x32x16_bf16(a1, qf[d0], p1, 0, 0, 0); }
        bf16x8 pb[4];
        softmax_tile<false>(p0, p1, m, lsum, O, pb);
#pragma unroll
        for (int dt = 0; dt < 2; ++dt)
#pragma unroll
            for (int s = 0; s < 4; ++s) { const float* vp = CV + (size_t)(key0 + 16 * (s & 1) + 32 * (s >> 1) + 8 * hi) * 512 + 32 * dt + li;
                const bf16x8 a = pack8f((f32x4){vp[0], vp[512], vp[1024], vp[1536]}, (f32x4){vp[2048], vp[2560], vp[3072], vp[3584]});
                O[dt] = __builtin_amdgcn_mfma_f32_32x32x16_bf16(a, pb[s], O[dt], 0, 0, 0); }
    }
    if (wave == 7) {
        f32x16 p0, p1 = {};
#pragma unroll
        for (int g2 = 0; g2 < 2; ++g2) { const float* gp = G + PAST + 8 * hi + 16 * g2; const f32x4 a = *(const f32x4*)gp, bq = *(const f32x4*)(gp + 4);
#pragma unroll
            for (int e = 0; e < 4; ++e) { p0[8 * g2 + e] = fq - a[e]; p0[8 * g2 + 4 + e] = fq - bq[e]; } }
#pragma unroll
        for (int d0 = 0; d0 < 4; ++d0) { const bf16x8 a0 = *(const bf16x8*)(U + ((size_t)TP + b * 32 + ka) * NU + U_K + h * 64 + 16 * d0 + 8 * hi);
            p0 = __builtin_amdgcn_mfma_f32_32x32x16_bf16(a0, qf[d0], p0, 0, 0, 0); }
#pragma unroll
        for (int r = 0; r < 16; ++r) { const int kv = 8 * hi + 16 * (r >> 3) + (r & 7); if (kv > li) p0[r] = -INFINITY; }
        bf16x8 pb[4];
        softmax_tile<true>(p0, p1, m, lsum, O, pb);
#pragma unroll
        for (int dt = 0; dt < 2; ++dt)
#pragma unroll
            for (int s = 0; s < 2; ++s) { const bf16_t* vp = U + ((size_t)TP + b * 32 + 16 * s + 8 * hi) * NU + U_V + h * 64 + 32 * dt + li; u32x4 w;
                w.x = (unsigned)vp[0] | ((unsigned)vp[NU] << 16); w.y = (unsigned)vp[2 * NU] | ((unsigned)vp[3 * NU] << 16); w.z = (unsigned)vp[4 * NU] | ((unsigned)vp[5 * NU] << 16); w.w = (unsigned)vp[6 * NU] | ((unsigned)vp[7 * NU] << 16);
                O[dt] = __builtin_amdgcn_mfma_f32_32x32x16_bf16(__builtin_bit_cast(bf16x8, w), pb[s], O[dt], 0, 0, 0); }
    }
    LAS float* Ow = (LAS float*)lds;
    LAS float* ML = Ow + 8 * 32 * 64;
    lsum = xhalf_sum(lsum);
#pragma unroll
    for (int dt = 0; dt < 2; ++dt)
#pragma unroll
        for (int r = 0; r < 16; ++r) Ow[(wave * 32 + dt * 16 + r) * 64 + lane] = O[dt][r];
    if (hi == 0) { ML[(wave * 2) * 32 + li] = m; ML[(wave * 2 + 1) * 32 + li] = lsum; }
    __syncthreads();
    { const int qq = tid & 31, dg = tid >> 5; float M = ATT_NEG;
#pragma unroll
      for (int w = 0; w < 8; ++w) M = fmaxf(M, ML[(w * 2) * 32 + qq]);
      float L = 0.f; f32x4 o = {0.f, 0.f, 0.f, 0.f};
      const int d = 4 * dg, idx0 = (d >> 5) * 16 + ((d >> 3) & 3) * 4, ln = ((d >> 2) & 1) * 32 + qq;
#pragma unroll
      for (int w = 0; w < 8; ++w) { const float f = __builtin_amdgcn_exp2f(ML[(w * 2) * 32 + qq] - M); L += ML[(w * 2 + 1) * 32 + qq] * f;
#pragma unroll
          for (int e = 0; e < 4; ++e) o[e] += Ow[(w * 32 + idx0 + e) * 64 + ln] * f; }
      const float inv = 1.f / L; const size_t row = (size_t)TP + b * 32 + qq;
      const u32x2 sg = *(const u32x2*)(U + row * NU + U_BSG + h * 64 + d);
      u32x2 wv; wv.x = cvt_pk_bf16(o[0] * inv * siluf_(bflo(sg.x)), o[1] * inv * siluf_(bfhi(sg.x))); wv.y = cvt_pk_bf16(o[2] * inv * siluf_(bflo(sg.y)), o[3] * inv * siluf_(bfhi(sg.y)));
      *(u32x2*)((bf16_t*)(p->ws + WS_OCAT) + (size_t)1 * NTOK * 512 + row * 512 + h * 64 + d) = wv; }
    __syncthreads();
}
constexpr int NPHASE = 22;
__global__ void __launch_bounds__(512, 2) hse_fwd(Params p_) {
    const KP kp = (KP)__builtin_amdgcn_kernarg_segment_ptr();
    (void)p_;
    extern __shared__ __attribute__((aligned(16))) unsigned char lds_raw[];
    LAS unsigned char* lds = (LAS unsigned char*)lds_raw;
    const int tid0 = threadIdx.x;
    const int G = gridDim.x, bid = blockIdx.x, ngw = G * 8;
#define PH_LOCALS const KP p = kp_fresh(kp); int tid = tid0; asm volatile("" : "+v"(tid)); const int lane = tid & 63, wave = __builtin_amdgcn_readfirstlane(tid >> 6), gw = bid * 8 + wave; (void)lane; (void)gw; (void)p;
    if (tid0 < 4) ((LAS unsigned*)(lds + LDS_XB_OFF))[tid0] = 0u;
    __syncthreads();
    unsigned* ctl = (unsigned*)(kp->ws + WS_CTL);
    XcdBarrier bar = xcd_barrier_post(ctl + CW_BAR + kp->li * XCD_BAR_WORDS, (volatile LAS unsigned*)(lds + LDS_XB_OFF));
    const int lo = kp->ph_lo, hi = kp->ph_hi;
#define IN(k) (lo <= (k) && (k) < hi)
#ifndef DUP_MASK
#define DUP_MASK 0
#endif
#define NREP(k) (((DUP_MASK >> (k)) & 1) + 1)
#define SEAM(k) do { if (IN(k) && IN((k) + 1)) xcd_barrier(bar); } while (0)
    if (IN(0)) { PH_LOCALS
        for (int u = bid; u < 192; u += G) ada_unit(p, u, lds, tid);
        p0_weights(p, lds, gw, ngw, wave, lane);
    }
    SEAM(0);
    for (int l = 0; l < NLAYER; ++l) {
        const int pb = 1 + 10 * l;
        for (int rep = 0; rep < NREP(0); ++rep) { if (rep) xcd_barrier(bar);
        if (IN(pb)) { PH_LOCALS p1_rows(p, l, gw, ngw, lane); } }
        SEAM(pb);
        for (int rep = 0; rep < NREP(1); ++rep) { if (rep) xcd_barrier(bar);
        if (IN(pb + 1)) { PH_LOCALS
            pg8::Gemm g{(const bf16_t*)(p->ws + WS_H), (const bf16_t*)(p->ws + WS_WIN) + (size_t)l * NU * 2048, NTOK, NU, 2048};
            pg8::StaticOrder S; S.init(NTOK, NU, G, bid);
            EpiU E{(bf16_t*)(p->ws + WS_U), p->out, p->in[I_BF], l};
            pg8::gemm_phase<EpiU, pg8::StaticOrder>(lds, g, S, E, nullptr);
        }
        }
        SEAM(pb + 1);
        for (int rep = 0; rep < NREP(2); ++rep) { if (rep) xcd_barrier(bar);
        if (IN(pb + 2)) { PH_LOCALS
#ifndef DUP_SUB
#define DUP_SUB 0
#endif
            for (int u = bid; u < NRU * ((DUP_SUB & 1) + 1); u += G) rwkv_r1(p, l, u % NRU, lds, tid);
            for (int u = bid; u < 544 * (((DUP_SUB >> 1) & 1) + 1); u += G) conv_unit(p, l, u % 544, lds, tid);
            for (int u = bid; u < 544 * (((DUP_SUB >> 2) & 1) + 1); u += G) pool_unit(p, l, u % 544, lds, tid);
            for (int u = bid; u < 256; u += G) { vt_tile(p, l, u * 8 + wave, lds, wave, lane); }
            __syncthreads();
            for (int u = bid; u < 32; u += G) gs_unit(p, l, u, lds, tid);
            for (int u = G - 1 - bid; u < 8; u += G) fp_unit(p, l, u, lds, tid);
            if (bid == G / 2) shift_out(p, l, tid);
        }
        }
        SEAM(pb + 2);
        for (int rep = 0; rep < NREP(3); ++rep) { if (rep) xcd_barrier(bar);
        if (IN(pb + 3)) { PH_LOCALS
            if (wave < 4) for (int tk = bid * 4 + wave; tk < 1024; tk += G * 4) rwkv_l1_task(p, tk, lane);
            __syncthreads();
            LAS int* qslot = (LAS int*)(lds + LDS_XB_OFF - 16);
            for (;;) {
                if (tid == 0) *qslot = (int)atomicAdd(ctl + CW_QUEUE + 64 * (2 * l + 4 * rep), 1u);
                __syncthreads();
                const int item = *qslot;
                __syncthreads();
                if (item >= 512) break;
                attn_prompt_unit(p, l, item & 7, 63 - (item >> 3), lds, tid);
            }
            for (;;) {
                if (tid == 0) *qslot = (int)atomicAdd(ctl + CW_QUEUE + 64 * (2 * l + 1 + 4 * rep), 1u);
                __syncthreads();
                const int item = *qslot;
                __syncthreads();
                if (item >= 256) break;
                attn_sample_unit(p, l, item >> 3, item & 7, lds, tid);
            }
        }
        }
        SEAM(pb + 3);
        if (IN(pb + 4)) { PH_LOCALS if (wave == 0 && bid < 32) rwkv_l2_task(p, l, bid, lane); }
        SEAM(pb + 4);
        if (IN(pb + 5)) { PH_LOCALS for (int tk = (wave * G + bid); tk < 512 + 1024; tk += ngw) rwkv_l3_task(p, l, tk, lane); }
        SEAM(pb + 5);
        if (IN(pb + 6)) { PH_LOCALS for (int tk = gw; tk < NRU * 2; tk += ngw) rwkv_r3_task(p, l, tk, lane); }
        SEAM(pb + 6);
        for (int rep = 0; rep < NREP(7); ++rep) { if (rep) xcd_barrier(bar);
        if (IN(pb + 7)) { PH_LOCALS
            pg8::Gemm g{(const bf16_t*)(p->ws + WS_OCAT), (const bf16_t*)(p->ws + WS_WBR) + (size_t)l * 4 * 2048 * 512, 4 * NTOK, 4 * 2048, 512};
            BranchOrder S{G, bid};
            EpiZ E{(bf16_t*)(p->ws + WS_Z)};
            pg8::gemm_phase<EpiZ, BranchOrder>(lds, g, S, E, nullptr);
        }
        }
        SEAM(pb + 7);
        if (IN(pb + 8)) { PH_LOCALS merge_pass(p, bid * 512 + tid, G * 512); }
        SEAM(pb + 8);
        if (IN(pb + 9)) { PH_LOCALS
            pg8::Gemm g{(const bf16_t*)(p->ws + WS_MERGED), (const bf16_t*)(p->ws + WS_WOUT) + (size_t)l * 2048 * 2048, NTOK, 2048, 2048};
            pg8::StaticOrder S; S.init(NTOK, 2048, G, bid);
            EpiOut E{p->in[I_XP], p->in[I_XS], (const float*)(p->ws + WS_XBUF), (const float*)(p->ws + WS_ADA), (float*)(p->ws + WS_XBUF), l};
            pg8::gemm_phase<EpiOut, pg8::StaticOrder>(lds, g, S, E, nullptr);
        }
        SEAM(pb + 9);
    }
    if (IN(21)) { PH_LOCALS p_final_rows(p, gw, ngw, lane); }
#undef IN
#undef SEAM
}
#ifndef MK_SPLIT
#define MK_SPLIT 0
#endif
extern "C" void kernel_launch(void* const* d_in, const int* in_sizes, int n_in, void* d_out, int out_size, void* d_ws, size_t ws_size, hipStream_t stream) {
    static int grid = 0;
    if (grid == 0) {
        if (n_in != N_IN || (size_t)out_size != O_END || ws_size < WS_END) { fprintf(stderr, "kernel_launch: unexpected shapes (n_in %d, out %d, ws %zu)\n", n_in, out_size, ws_size); grid = -1; return; }
        int dev = 0, cus = 0, per_cu = 0;
        if (hipGetDevice(&dev) != hipSuccess || hipDeviceGetAttribute(&cus, hipDeviceAttributeMultiprocessorCount, dev) != hipSuccess) { grid = -1; return; }
        if (hipFuncSetAttribute((const void*)hse_fwd, hipFuncAttributeMaxDynamicSharedMemorySize, LDS_BYTES) != hipSuccess) { fprintf(stderr, "kernel_launch: hipFuncSetAttribute failed\n"); grid = -1; return; }
        if (hipOccupancyMaxActiveBlocksPerMultiprocessor(&per_cu, (const void*)hse_fwd, 512, LDS_BYTES) != hipSuccess || per_cu < 1) fprintf(stderr, "kernel_launch: occupancy query reports %d\n", per_cu);
        (void)hipGetLastError();
        grid = cus;
    }
    if (grid < 0) return;
    if (hipMemsetAsync((char*)d_ws + WS_CTL, 0, CTL_BYTES, stream) != hipSuccess) return;
    Params a{};
    for (int i = 0; i < N_IN; ++i) a.in[i] = (const float*)d_in[i];
    a.out = (float*)d_out; a.ws = (unsigned char*)d_ws;
#if MK_SPLIT
    for (int ph = 0; ph < NPHASE; ++ph) { a.ph_lo = ph; a.ph_hi = ph + 1; a.li = ph; hipLaunchKernelGGL(hse_fwd, dim3(grid), dim3(512), LDS_BYTES, stream, a); }
#else
    a.ph_lo = 0; a.ph_hi = NPHASE; a.li = 0;
    hipLaunchKernelGGL(hse_fwd, dim3(grid), dim3(512), LDS_BYTES, stream, a);
#endif
    const hipError_t le = hipPeekAtLastError();
    if (le != hipSuccess) fprintf(stderr, "kernel_launch: launch failed: %s\n", hipGetErrorName(le));
}
```

```cpp
#include <hip/hip_runtime.h>
#include <cstdio>
#include <cstdint>
namespace pg8 {
#define PG8_LAS __attribute__((address_space(3)))
typedef unsigned short bf16_t;
typedef short bf16x8 __attribute__((ext_vector_type(8)));
typedef float f32x4 __attribute__((ext_vector_type(4)));
typedef unsigned u32x4 __attribute__((ext_vector_type(4)));
constexpr int BM = 256, BK = 64, HALF = 128, HTB = HALF * BK * 2  , STAGE_BYTES = 8 * HTB, NXCD = 8, WGM = 8;

__host__ __device__ __forceinline__ int lds_byte(int r, int c) { const int st = (r >> 4) * 2 + (c >> 5), rr = r & 15, cc = c & 31, ob = rr * 64 + cc * 2; return st * 1024 + (ob ^ (((ob >> 9) & 1) << 5)); }
__host__ __device__ __forceinline__ void stage_rc(int b, int& R, int& C) { const int st = b / 1024, sb = b % 1024, swz = sb ^ (((sb >> 9) & 1) << 5); R = (st >> 1) * 16 + swz / 64; C = (st & 1) * 32 + (swz % 64) / 2; }
__host__ __device__ __forceinline__ int perm32(int rho) { const int n = rho >> 4, i = rho & 15; return 8 * (i >> 2) + 4 * n + (i & 3); }

struct Unit { int pm, pn; };
struct Gemm { const bf16_t* A; const bf16_t* Bt; int M, N, K; };

struct StaticOrder {
    int nM, nN, nwg, G, c;
    __host__ __device__ void init(int M, int N, int G_, int c_) { nM = M / BM; nN = N / BM; nwg = nM * nN; G = G_; c = c_; }
    __host__ __device__ bool next(int i, Unit& u) const {
        const long L = (long)i * G + c; if (L >= nwg) return false;
        int wgid = (int)L; { const int q = nwg / NXCD, r = nwg % NXCD, xcd = wgid % NXCD, off = wgid / NXCD; wgid = (xcd < r ? xcd * (q + 1) : r * (q + 1) + (xcd - r) * q) + off; }
        const int nig = WGM * nN, gid = wgid / nig, fm = gid * WGM, gsz = (nM - fm) < WGM ? (nM - fm) : WGM;
        u.pm = fm + ((wgid % nig) % gsz); u.pn = (wgid % nig) / gsz; return true;
    }
    __device__ __forceinline__ void a_ready(const Unit&) const {}
    __device__ __forceinline__ void done(const Unit&) const {}
};
__device__ __forceinline__ unsigned cvt_pk_bf16(float lo, float hi) { unsigned r; asm volatile("v_cvt_pk_bf16_f32 %0, %1, %2" : "=v"(r) : "v"(lo), "v"(hi)); return r; }
typedef float f32x2 __attribute__((ext_vector_type(2)));
template <class Epi, class Sched, bool STAMP = false>
__device__ __forceinline__ void gemm_phase(PG8_LAS unsigned char* lds, const Gemm g, const Sched& S, const Epi& E, unsigned long long* stamps) {
    int tid = threadIdx.x; asm volatile("" : "+v"(tid));
    const int wid = __builtin_amdgcn_readfirstlane(tid >> 6), lane = tid & 63, wr = wid >> 2, wc = wid & 3, fr = lane & 15, fq = lane >> 4;
    const int K = g.K, nt = K / BK;
    int ts_lo = 0, ts_hi = 0, nts = 0; const unsigned long long rt_entry = STAMP ? (unsigned long long)wall_clock64() : 0ull;
#define PG8_STAMP() do { if (STAMP && wid == 0 && nts < 64) { const unsigned long long _c = (unsigned long long)clock64(); \
        ts_lo = (lane == nts) ? (int)(unsigned)_c : ts_lo; ts_hi = (lane == nts) ? (int)(unsigned)(_c >> 32) : ts_hi; ++nts; } } while (0)
    PG8_STAMP();
    unsigned voffA[2], voffB[2];
#pragma unroll
    for (int i = 0; i < 2; ++i) { int R, C; stage_rc(tid * 16 + i * 8192, R, C); const int Rb = Epi::PERM ? ((R & ~31) + perm32(R & 31)) : R;
        voffA[i] = (unsigned)(R * K + C) * 2u; voffB[i] = (unsigned)(Rb * K + C) * 2u; }
    const size_t kstep = (size_t)(BK * 2);
    const size_t hstep = (size_t)HALF * K * 2;
    const size_t tstep = 2 * hstep;
    const unsigned ldsw = (unsigned)wid * 1024u;
    const int aoff = lds_byte(wr * 64 + fr, fq * 8), boff = lds_byte(wc * 32 + fr, fq * 8);
#define PG8_SA(b, h) (((b) * 2 + (h)) * HTB)
#define PG8_SB(b, h) ((4 + (b) * 2 + (h)) * HTB)
#define PG8_STAGE(bufoff, gbase, voff) do { _Pragma("unroll") for (int _i = 0; _i < 2; ++_i) \
        __builtin_amdgcn_global_load_lds((const unsigned*)((const char*)(gbase) + (voff)[_i]), (PG8_LAS unsigned*)(lds + (bufoff) + ldsw + _i * 8192), 16, 0, 0); } while (0)
#define PG8_LDA(dst, b, h) do { _Pragma("unroll") for (int m = 0; m < 4; ++m) _Pragma("unroll") for (int k = 0; k < 2; ++k) dst[m][k] = *(const PG8_LAS bf16x8*)(lds + PG8_SA(b, h) + aoff + m * 2048 + k * 1024); } while (0)
#define PG8_LDB(dst, b, h) do { _Pragma("unroll") for (int n = 0; n < 2; ++n) _Pragma("unroll") for (int k = 0; k < 2; ++k) dst[n][k] = *(const PG8_LAS bf16x8*)(lds + PG8_SB(b, h) + boff + n * 2048 + k * 1024); } while (0)
#define PG8_MMA(ai, bj, At, Bt) do { __builtin_amdgcn_s_setprio(1); _Pragma("unroll") for (int m = 0; m < 4; ++m) _Pragma("unroll") for (int n = 0; n < 2; ++n) _Pragma("unroll") for (int k = 0; k < 2; ++k) \
        acc[ai][bj][m][n] = __builtin_amdgcn_mfma_f32_16x16x32_bf16(Bt[n][k], At[m][k], acc[ai][bj][m][n], 0, 0, 0); __builtin_amdgcn_s_setprio(0); } while (0)
#define PG8_WAIT_V(n) asm volatile("s_waitcnt vmcnt(" #n ")" ::: "memory")
#define PG8_WAIT_L(n) asm volatile("s_waitcnt lgkmcnt(" #n ")" ::: "memory")
#define PG8_BAR __builtin_amdgcn_s_barrier()
#define PG8_SCHED __builtin_amdgcn_sched_barrier(0)
    Unit cur, nxt; int ui = 0;
    if (!S.next(0, cur)) return;
    f32x4 acc[2][2][4][2];
#pragma unroll
    for (int a = 0; a < 2; ++a)
#pragma unroll
        for (int b = 0; b < 2; ++b)
#pragma unroll
            for (int m = 0; m < 4; ++m)
#pragma unroll
                for (int n = 0; n < 2; ++n) acc[a][b][m][n] = (f32x4){0.f, 0.f, 0.f, 0.f};
    bf16x8 At[4][2], B0[2][2], B1[2][2];
    const char* cA = (const char*)g.A + (size_t)cur.pm * tstep; const char* cB = (const char*)g.Bt + (size_t)cur.pn * tstep;
    S.a_ready(cur);
    PG8_STAGE(PG8_SB(0, 0), cB, voffB); PG8_STAGE(PG8_SA(0, 0), cA, voffA); PG8_STAGE(PG8_SB(0, 1), cB + hstep, voffB); PG8_STAGE(PG8_SA(0, 1), cA + hstep, voffA);
    if (wr == 1) PG8_BAR;
    PG8_WAIT_V(4); PG8_BAR;
    PG8_STAGE(PG8_SB(1, 0), cB + kstep, voffB); PG8_STAGE(PG8_SA(1, 0), cA + kstep, voffA); PG8_STAGE(PG8_SB(1, 1), cB + hstep + kstep, voffB);
    PG8_WAIT_V(6); PG8_BAR;
    PG8_STAMP();
    for (;;) {
        const bool has_next = S.next(ui + 1, nxt);
        const char* nA = has_next ? (const char*)g.A + (size_t)nxt.pm * tstep : cA; const char* nB = has_next ? (const char*)g.Bt + (size_t)nxt.pn * tstep : cB;
        for (int t = 0; t < nt; t += 2) {
            const bool last = (t == nt - 2);
            const char* a1 = cA + (size_t)(t + 1) * kstep;
            const char* a2 = last ? nA : cA + (size_t)(t + 2) * kstep; const char* b2 = last ? nB : cB + (size_t)(t + 2) * kstep;
            const char* a3 = a2 + kstep; const char* b3 = b2 + kstep;
            if (last && has_next) S.a_ready(nxt);
            PG8_LDB(B0, 0, 0); PG8_SCHED; PG8_LDA(At, 0, 0); PG8_STAGE(PG8_SA(1, 1), a1 + hstep, voffA);
            PG8_WAIT_L(8); PG8_BAR; PG8_WAIT_L(0); PG8_MMA(0, 0, At, B0); PG8_BAR; PG8_SCHED;
            PG8_LDB(B1, 0, 1); PG8_STAGE(PG8_SB(0, 0), b2, voffB);
            PG8_BAR; PG8_WAIT_L(0); PG8_MMA(0, 1, At, B1); PG8_BAR;
            PG8_LDA(At, 0, 1); PG8_STAGE(PG8_SA(0, 0), a2, voffA);
            PG8_BAR; PG8_WAIT_L(0); PG8_MMA(1, 0, At, B0); PG8_BAR; PG8_SCHED;
            PG8_STAGE(PG8_SB(0, 1), b2 + hstep, voffB);
            PG8_WAIT_V(6); PG8_BAR; PG8_MMA(1, 1, At, B1); PG8_BAR;
            PG8_LDB(B0, 1, 0); PG8_SCHED; PG8_LDA(At, 1, 0); PG8_STAGE(PG8_SA(0, 1), a2 + hstep, voffA);
            PG8_WAIT_L(8); PG8_BAR; PG8_WAIT_L(0); PG8_MMA(0, 0, At, B0); PG8_BAR; PG8_SCHED;
            PG8_LDB(B1, 1, 1); PG8_STAGE(PG8_SB(1, 0), b3, voffB);
            PG8_BAR; PG8_WAIT_L(0); PG8_MMA(0, 1, At, B1); PG8_BAR;
            PG8_LDA(At, 1, 1); PG8_STAGE(PG8_SA(1, 0), a3, voffA);
            PG8_BAR; PG8_WAIT_L(0); PG8_MMA(1, 0, At, B0); PG8_BAR; PG8_SCHED;
            PG8_STAGE(PG8_SB(1, 1), b3 + hstep, voffB);
            PG8_WAIT_V(6); PG8_BAR; PG8_MMA(1, 1, At, B1); PG8_BAR;
        }
        PG8_STAMP();
        if constexpr (!Epi::AFTER_DRAIN) { E(acc, cur, wr, wc, fr, fq); S.done(cur); }
        PG8_STAMP();
        if (!has_next) break;
#pragma unroll
        for (int a = 0; a < 2; ++a)
#pragma unroll
            for (int b = 0; b < 2; ++b)
#pragma unroll
                for (int m = 0; m < 4; ++m)
#pragma unroll
                    for (int n = 0; n < 2; ++n) acc[a][b][m][n] = (f32x4){0.f, 0.f, 0.f, 0.f};
        cur = nxt; cA = nA; cB = nB; ++ui;
    }
    PG8_WAIT_V(0);
    if (wr == 0) PG8_BAR;
    PG8_BAR;
    if constexpr (Epi::AFTER_DRAIN) { E.fused(acc, cur, wr, wc, fr, fq, lds, wid, lane); S.done(cur); }
    PG8_STAMP();
    if (STAMP && wid == 0) { stamps[lane] = lane < nts ? (((unsigned long long)(unsigned)ts_hi << 32) | (unsigned)ts_lo) : 0ull;
        if (lane == 62) stamps[62] = rt_entry; if (lane == 63) stamps[63] = (unsigned long long)wall_clock64(); }
#undef PG8_STAMP
#undef PG8_SA
#undef PG8_SB
#undef PG8_STAGE
#undef PG8_LDA
#undef PG8_LDB
#undef PG8_MMA
#undef PG8_WAIT_V
#undef PG8_WAIT_L
#undef PG8_BAR
#undef PG8_SCHED
}
}
#define XB_TMO      128
#define XB_XCNT(j)  (256  + 64 * (j))
#define XB_XSUB(j)  (1280 + 64 * (j))
#define XB_XGEN(j)  (2304 + 64 * (j))
#define XB_TOP      3328
#define XB_TOPGEN   3392
#define XCD_BAR_WORDS 3456
#define XB_SPIN_CAP (1u << 18)
#define LAS __attribute__((address_space(3)))

__device__ __forceinline__ unsigned xb_ld(unsigned* p)              { return __hip_atomic_load(p, __ATOMIC_RELAXED, __HIP_MEMORY_SCOPE_AGENT); }
__device__ __forceinline__ unsigned xb_add(unsigned* p, unsigned v) { return __hip_atomic_fetch_add(p, v, __ATOMIC_RELAXED, __HIP_MEMORY_SCOPE_AGENT); }
__device__ __forceinline__ unsigned xb_xcc_id() { return (unsigned)__builtin_amdgcn_s_getreg((3 << 11) | 20) & 0xFu; }
#define XB_SPIN(cond, bar) do { unsigned _sp = 0; while (cond) { __builtin_amdgcn_s_sleep(1); \
    if ((++_sp & 255u) == 0u) { if (xb_ld(&(bar)[XB_TMO])) break; if (_sp > XB_SPIN_CAP) { atomicAdd(&(bar)[XB_TMO], 1u); break; } } } } while (0)

struct XcdBarrier {
    unsigned* bar; unsigned x;
    volatile LAS unsigned* st;
};

__device__ __forceinline__ XcdBarrier xcd_barrier_post(unsigned* bar, volatile LAS unsigned* st) {
    XcdBarrier b; b.bar = bar; b.x = xb_xcc_id(); b.st = st;
    if (threadIdx.x == 0) (void)xb_add(&bar[XB_XCNT(b.x)], 1u);
    return b;
}
__device__ __forceinline__ void xcd_barrier_complete(unsigned* bar, unsigned x, unsigned& nloc, unsigned& nx) {
    const unsigned G = gridDim.x * gridDim.y * gridDim.z;
    unsigned sum, cnt, mine, sp = 0u;
    for (;;) {
        sum = 0u; cnt = 0u; mine = 0u;
#pragma unroll
        for (unsigned j = 0; j < 16; ++j) { const unsigned c = xb_ld(&bar[XB_XCNT(j)]); sum += c; cnt += (c > 0u) ? 1u : 0u; mine = (j == x) ? c : mine; }
        if (sum == G) break;
        __builtin_amdgcn_s_sleep(1);
        if ((++sp & 255u) == 0u) { if (xb_ld(&bar[XB_TMO])) break; if (sp > XB_SPIN_CAP) { atomicAdd(&bar[XB_TMO], 1u); break; } }
    }
    nloc = mine > 0u ? mine : 1u; nx = cnt > 0u ? cnt : 1u;
}

__device__ __forceinline__ void xcd_barrier(const XcdBarrier& b) {
    asm volatile("s_waitcnt vmcnt(0)" ::: "memory");
    __syncthreads();
    if (threadIdx.x == 0) {
        unsigned* bar = b.bar;
        __builtin_amdgcn_s_waitcnt(0);
        unsigned nloc = b.st[0], nx = b.st[1];
        if (nloc == 0u) { xcd_barrier_complete(bar, b.x, nloc, nx); b.st[0] = nloc; b.st[1] = nx; }
        const unsigned old = xb_add(&bar[XB_XSUB(b.x)], 1u);
        const unsigned gen = old / nloc;
        if (old + 1u == (gen + 1u) * nloc) {
            __builtin_amdgcn_fence(__ATOMIC_RELEASE, "agent");
            asm volatile("s_waitcnt vmcnt(0)" ::: "memory");
            const unsigned og = xb_add(&bar[XB_TOP], 1u);
            const unsigned tg = og / nx;
            if (og + 1u == (tg + 1u) * nx) xb_add(&bar[XB_TOPGEN], 1u);
            else XB_SPIN(xb_ld(&bar[XB_TOPGEN]) == tg, bar);
            __builtin_amdgcn_fence(__ATOMIC_ACQUIRE, "agent");
            xb_add(&bar[XB_XGEN(b.x)], 1u);
            asm volatile("s_waitcnt vmcnt(0)" ::: "memory");
        } else {
            XB_SPIN(xb_ld(&bar[XB_XGEN(b.x)]) == gen, bar);
            __builtin_amdgcn_fence(__ATOMIC_ACQUIRE, "agent");
            asm volatile("s_waitcnt vmcnt(0)" ::: "memory");
        }
    }
    __syncthreads();
}
typedef unsigned short bf16_t;
typedef short bf16x8 __attribute__((ext_vector_type(8)));
typedef float f32x4 __attribute__((ext_vector_type(4)));
typedef float f32x16 __attribute__((ext_vector_type(16)));
typedef unsigned u32x4 __attribute__((ext_vector_type(4)));
typedef unsigned u32x2 __attribute__((ext_vector_type(2)));
using pg8::cvt_pk_bf16;

constexpr int DM = 2048, TP = 16384, NSB = 32, TSQ = 32, NTOK = TP + NSB * TSQ, NSEQ = 33, PAST = 4096, NLAYER = 2;
constexpr int NU = 15104;
constexpr int U_AVAL = 0, U_AGATE = 512, U_ASG = 1024, U_Q = 1536, U_K = 2048, U_V = 2560, U_BSG = 3072, U_XC = 3584, U_CSG = 5248, U_DIN = 5760, U_DSG = 6272, U_G = 6784, U_F = 14976;
constexpr int IN_W = 14984, SHIFT_W = 1664;
constexpr float LOG2E = 1.4426950408889634f;
enum { I_XP = 0, I_XS, I_CK, I_CV, I_CLF, I_SCONV, I_SSHIFT, I_SWKV, I_SPOOL, I_CP, I_CS, I_NORMG, I_WADA, I_BADA, I_WIN, I_BF, I_CONVW, I_CONVB, I_CLNG, I_CLNB, I_MU, I_W0, I_W2, I_A0, I_A2,
       I_KK, I_KA, I_RK, I_GNG, I_GNB, I_POOLW, I_POOLB, I_POOLS, I_WBR, I_WOUT, I_FING, N_IN };
constexpr size_t O_YP = 0, O_YS = O_YP + (size_t)TP * DM, O_PK = O_YS + (size_t)1024 * DM, O_PV = O_PK + (size_t)2 * TP * 512, O_PLF = O_PV + (size_t)2 * TP * 512, O_PCONV = O_PLF + (size_t)2 * TP * 8,
                 O_PSHIFT = O_PCONV + 2 * 30 * 512, O_PWKV = O_PSHIFT + 2 * 1664, O_PPOOL = O_PWKV + 2 * 8 * 64 * 64, O_SK = O_PPOOL + 2 * 15 * 512, O_SV = O_SK + (size_t)2 * 1024 * 512,
                 O_SLF = O_SV + (size_t)2 * 1024 * 512, O_SCONV = O_SLF + 2 * 1024 * 8, O_SSHIFT = O_SCONV + (size_t)2 * 32 * 30 * 512, O_SWKV = O_SSHIFT + 2 * 32 * 1664,
                 O_SPOOL = O_SWKV + (size_t)2 * 32 * 8 * 64 * 64, O_END = O_SPOOL + (size_t)2 * 32 * 15 * 512;
static_assert(O_END == 75374848, "output size");
constexpr size_t al256(size_t x) { return (x + 255) & ~(size_t)255; }
constexpr int NCU_CH = 288, NRU = NCU_CH * 8;
constexpr size_t WS_CTL = 0, CTL_BYTES = 512 * 1024;
constexpr size_t WS_WIN = CTL_BYTES;
constexpr size_t WS_WBR = al256(WS_WIN + (size_t)2 * NU * 2048 * 2);
constexpr size_t WS_WOUT = al256(WS_WBR + (size_t)2 * 4 * 2048 * 512 * 2);
constexpr size_t WS_POOLW = al256(WS_WOUT + (size_t)2 * 2048 * 2048 * 2);
constexpr size_t WS_ADA = al256(WS_POOLW + (size_t)2 * 4 * 128 * 128 * 2);
constexpr size_t WS_H = al256(WS_ADA + (size_t)2 * 33 * 6144 * 4);
constexpr size_t WS_U = al256(WS_H + (size_t)NTOK * 2048 * 2);
constexpr size_t WS_XBUF = al256(WS_U + (size_t)NTOK * NU * 2);
constexpr size_t WS_OCAT = al256(WS_XBUF + (size_t)NTOK * 2048 * 4);
constexpr size_t WS_Z = al256(WS_OCAT + (size_t)4 * NTOK * 512 * 2);
constexpr size_t WS_MERGED = al256(WS_Z + (size_t)4 * NTOK * 2048 * 2);
constexpr size_t WS_FP = al256(WS_MERGED + (size_t)NTOK * 2048 * 2);
constexpr int GS_LEN = PAST + TSQ;
constexpr size_t WS_GS = al256(WS_FP + (size_t)8 * TP * 4);
constexpr size_t WS_VT = al256(WS_GS + (size_t)32 * 8 * GS_LEN * 4);
constexpr size_t WS_TQ = al256(WS_VT + (size_t)8 * 64 * TP * 2);
constexpr size_t WS_GM = al256(WS_TQ + (size_t)NRU * 4096 * 4);
constexpr size_t WS_ET = al256(WS_GM + (size_t)NRU * 4096 * 4);
constexpr size_t WS_Y0T = al256(WS_ET + (size_t)NRU * 4096 * 4);
constexpr size_t WS_SC = al256(WS_Y0T + (size_t)NRU * 4096 * 4);
constexpr size_t WS_BONUS = al256(WS_SC + (size_t)NRU * 4096 * 4);
constexpr size_t WS_GG = al256(WS_BONUS + (size_t)NRU * 64 * 4);
constexpr size_t WS_TG = al256(WS_GG + (size_t)16 * 8 * 4096 * 4);
constexpr size_t WS_SG = al256(WS_TG + (size_t)16 * 8 * 4096 * 4);
constexpr size_t WS_END = al256(WS_SG + (size_t)16 * 8 * 4096 * 4);
static_assert(WS_END < (size_t)2100 * 1024 * 1024, "workspace map exceeds the guaranteed d_ws size");
constexpr int CW_BAR = 0;
constexpr int CW_QUEUE = 16 * 3456 + 64;
constexpr int CW_KMAX = CW_QUEUE + 64 * 8;
static_assert((CW_KMAX + 64) * 4 <= (int)CTL_BYTES, "ctl");
constexpr int LDS_BYTES = 163840 - 256;
constexpr int LDS_XB_OFF = LDS_BYTES - 16;
constexpr int SLOT_F = 64 * 65;

struct Params { const float* in[N_IN]; float* out; unsigned char* ws; int ph_lo, ph_hi, li, pad; };
typedef const __attribute__((address_space(4))) Params* KP;
__device__ __forceinline__ KP kp_fresh(KP k) { asm volatile("" : "+s"(k)); return k; }

__device__ __forceinline__ float bf2f(unsigned short b) { return __uint_as_float(((unsigned)b) << 16); }
__device__ __forceinline__ float bflo(unsigned w) { return __uint_as_float(w << 16); }
__device__ __forceinline__ float bfhi(unsigned w) { return __uint_as_float(w & 0xffff0000u); }
__device__ __forceinline__ unsigned short f2bf(float f) { return (unsigned short)(cvt_pk_bf16(f, 0.f) & 0xffffu); }
__device__ __forceinline__ float sigmoidf_(float x) { return 1.f / (1.f + __expf(-x)); }
__device__ __forceinline__ float siluf_(float x) { return x / (1.f + __expf(-x)); }
__device__ __forceinline__ float log_sigmoidf_(float z) { return fminf(z, 0.f) - log1pf(expf(-fabsf(z))); }
template <int CTRL> __device__ __forceinline__ float dpp_mov(float v) { return __int_as_float(__builtin_amdgcn_update_dpp(0, __float_as_int(v), CTRL, 0xF, 0xF, true)); }
__device__ __forceinline__ float wave_sum(float v) {
    v += dpp_mov<0xB1>(v); v += dpp_mov<0x4E>(v); v += dpp_mov<0x141>(v); v += dpp_mov<0x140>(v);
    const float r0 = __int_as_float(__builtin_amdgcn_readlane(__float_as_int(v), 0)), r1 = __int_as_float(__builtin_amdgcn_readlane(__float_as_int(v), 16));
    const float r2 = __int_as_float(__builtin_amdgcn_readlane(__float_as_int(v), 32)), r3 = __int_as_float(__builtin_amdgcn_readlane(__float_as_int(v), 48));
    return (r0 + r1) + (r2 + r3);
}
__device__ __forceinline__ float wave_max(float v) {
    v = fmaxf(v, dpp_mov<0xB1>(v)); v = fmaxf(v, dpp_mov<0x4E>(v)); v = fmaxf(v, dpp_mov<0x141>(v)); v = fmaxf(v, dpp_mov<0x140>(v));
    const float r0 = __int_as_float(__builtin_amdgcn_readlane(__float_as_int(v), 0)), r1 = __int_as_float(__builtin_amdgcn_readlane(__float_as_int(v), 16));
    const float r2 = __int_as_float(__builtin_amdgcn_readlane(__float_as_int(v), 32)), r3 = __int_as_float(__builtin_amdgcn_readlane(__float_as_int(v), 48));
    return fmaxf(fmaxf(r0, r1), fmaxf(r2, r3));
}
__device__ __forceinline__ float wave_min(float v) { return -wave_max(-v); }
__device__ __forceinline__ float xhalf_max(float m) { const auto rr = __builtin_amdgcn_permlane32_swap(__float_as_uint(m), __float_as_uint(m), false, false); return fmaxf(__uint_as_float(rr[0]), __uint_as_float(rr[1])); }
__device__ __forceinline__ float xhalf_sum(float m) { const auto rr = __builtin_amdgcn_permlane32_swap(__float_as_uint(m), __float_as_uint(m), false, false); return __uint_as_float(rr[0]) + __uint_as_float(rr[1]); }
__device__ __forceinline__ bf16x8 pack8f(const f32x4 a, const f32x4 b) { u32x4 w; w.x = cvt_pk_bf16(a[0], a[1]); w.y = cvt_pk_bf16(a[2], a[3]); w.z = cvt_pk_bf16(b[0], b[1]); w.w = cvt_pk_bf16(b[2], b[3]); return __builtin_bit_cast(bf16x8, w); }
__device__ __forceinline__ float fast_tanh(float x) { const float e = __expf(-2.f * fabsf(x)); const float t = (1.f - e) * __builtin_amdgcn_rcpf(1.f + e); return x < 0.f ? -t : t; }
__device__ __forceinline__ void tr_tile(const float* __restrict__ src, size_t ld, int k0, int c0, int nvalid, bf16_t* __restrict__ dst, int K, LAS float* scr, int lane) {
#pragma unroll 8
    for (int kk = 0; kk < 64; ++kk) scr[kk * 65 + lane] = (lane < nvalid) ? src[(size_t)(k0 + kk) * ld + c0 + lane] : 0.f;
    const int k2 = (lane & 31) * 2, nh = lane >> 5;
#pragma unroll 8
    for (int it = 0; it < 32; ++it) { const int nn = 2 * it + nh; *(unsigned*)(dst + (size_t)nn * K + k0 + k2) = cvt_pk_bf16(scr[k2 * 65 + nn], scr[(k2 + 1) * 65 + nn]); }
}
__device__ __forceinline__ void p0_weights(KP p, LAS unsigned char* lds, int gw, int ngw, int wave, int lane) {
    LAS float* scr = (LAS float*)lds + wave * SLOT_F;
    constexpr int T_WIN = (NU / 64) * 32, T_WBR = 4 * 32 * 8, T_WOUT = 32 * 32, T_POOL = 4 * 2 * 2, T_L = T_WIN + T_WBR + T_WOUT + T_POOL;
    for (int it = gw; it < 2 * T_L; it += ngw) {
        const int l = it / T_L; int r = it % T_L;
        if (r < T_WIN) {
            const int nt = r / 32, kt = r % 32, m0 = nt * 64;
            int c0, nvalid = 64;
            if (m0 < 3072) c0 = m0; else if (m0 < U_F) c0 = m0 + 8; else if (m0 == U_F) { c0 = 3072; nvalid = 8; } else { c0 = 0; nvalid = 0; }
            tr_tile(p->in[I_WIN] + (size_t)l * 2048 * IN_W, IN_W, kt * 64, c0, nvalid, (bf16_t*)(p->ws + WS_WIN) + ((size_t)l * NU + m0) * 2048, 2048, scr, lane);
            continue; }
        r -= T_WIN;
        if (r < T_WBR) {
            const int n = r / 256, q = r % 256, nt = q / 8, kt = q % 8;
            tr_tile(p->in[I_WBR] + ((size_t)(l * 4 + n) * 512) * 2048, 2048, kt * 64, nt * 64, 64, (bf16_t*)(p->ws + WS_WBR) + ((size_t)(l * 4 + n) * 2048 + nt * 64) * 512, 512, scr, lane);
            continue; }
        r -= T_WBR;
        if (r < T_WOUT) {
            const int nt = r / 32, kt = r % 32;
            tr_tile(p->in[I_WOUT] + (size_t)l * 2048 * 2048, 2048, kt * 64, nt * 64, 64, (bf16_t*)(p->ws + WS_WOUT) + ((size_t)l * 2048 + nt * 64) * 2048, 2048, scr, lane);
            continue; }
        r -= T_WOUT;
        {
            const int g = r / 4, q = r % 4, nt = q / 2, kt = q % 2;
            tr_tile(p->in[I_POOLW] + (size_t)(l * 4 + g) * 128 * 128, 128, kt * 64, nt * 64, 64, (bf16_t*)(p->ws + WS_POOLW) + ((size_t)(l * 4 + g) * 128 + nt * 64) * 128, 128, scr, lane);
        }
    }
}
__device__ __forceinline__ void ada_unit(KP p, int unit, LAS unsigned char* lds, int tid) {
    const int wave = tid >> 6, lane = tid & 63, l = unit / 96, n0 = (unit % 96) * 64;
    LAS float* cs = (LAS float*)lds + wave * (33 * 64);
    LAS float* red = (LAS float*)lds + 8 * 33 * 64;
    const float* W = p->in[I_WADA] + (size_t)l * 2048 * 6144;
    const float* cp = p->in[I_CP]; const float* csm = p->in[I_CS];
    float acc[33];
#pragma unroll
    for (int s = 0; s < 33; ++s) acc[s] = 0.f;
    for (int ch = 0; ch < 4; ++ch) {
        const int k0 = wave * 256 + ch * 64;
#pragma unroll
        for (int s = 0; s < 33; ++s) { const float c = (s == 0) ? cp[k0 + lane] : csm[(size_t)(s - 1) * 2048 + k0 + lane]; cs[s * 64 + lane] = siluf_(c); }
        for (int kk = 0; kk < 64; kk += 4) {
            const float w0 = W[(size_t)(k0 + kk) * 6144 + n0 + lane], w1 = W[(size_t)(k0 + kk + 1) * 6144 + n0 + lane], w2 = W[(size_t)(k0 + kk + 2) * 6144 + n0 + lane], w3 = W[(size_t)(k0 + kk + 3) * 6144 + n0 + lane];
#pragma unroll
            for (int s = 0; s < 33; ++s) { const f32x4 c4 = *(const LAS f32x4*)(cs + s * 64 + kk); acc[s] += c4.x * w0 + c4.y * w1 + c4.z * w2 + c4.w * w3; }
        }
    }
#pragma unroll
    for (int s = 0; s < 33; ++s) red[(wave * 33 + s) * 64 + lane] = acc[s];
    __syncthreads();
    for (int idx = tid; idx < 33 * 64; idx += 512) { const int s = idx >> 6, n = idx & 63; float v = p->in[I_BADA][l * 6144 + n0 + n];
#pragma unroll
        for (int w = 0; w < 8; ++w) v += red[(w * 33 + s) * 64 + n];
        ((float*)(p->ws + WS_ADA))[((size_t)l * 33 + s) * 6144 + n0 + n] = v; }
    __syncthreads();
}
__device__ __forceinline__ const float* x_row(KP p, int l, int row) {
    return l == 0 ? (row < TP ? p->in[I_XP] + (size_t)row * DM : p->in[I_XS] + (size_t)(row - TP) * DM) : (const float*)(p->ws + WS_XBUF) + (size_t)row * DM;
}
__device__ __forceinline__ void p1_rows(KP p, int l, int gw, int ngw, int lane) {
    const f32x4* g4 = (const f32x4*)(p->in[I_NORMG] + l * DM) + lane;
    for (int row = gw; row < NTOK; row += ngw) {
        const f32x4* x4 = (const f32x4*)x_row(p, l, row) + lane;
        const int seq = row < TP ? 0 : 1 + ((row - TP) >> 5);
        const f32x4* sh4 = (const f32x4*)((const float*)(p->ws + WS_ADA) + ((size_t)l * 33 + seq) * 6144) + lane; const f32x4* sc4 = sh4 + 512;
        f32x4 v[8]; float ss = 0.f;
#pragma unroll
        for (int j = 0; j < 8; ++j) { v[j] = x4[64 * j]; ss += (v[j].x * v[j].x + v[j].y * v[j].y) + (v[j].z * v[j].z + v[j].w * v[j].w); }
        const float rstd = 1.f / sqrtf(wave_sum(ss) * (1.f / DM) + 1e-6f);
        u32x2* o = (u32x2*)((bf16_t*)(p->ws + WS_H) + (size_t)row * DM) + lane;
#pragma unroll
        for (int j = 0; j < 8; ++j) { const f32x4 g = g4[64 * j], sc = sc4[64 * j], sh = sh4[64 * j]; const f32x4 y = v[j] * rstd * g * (sc + 1.f) + sh;
            u32x2 w; w.x = cvt_pk_bf16(y.x, y.y); w.y = cvt_pk_bf16(y.z, y.w); o[64 * j] = w; }
    }
}
__device__ __forceinline__ void p_final_rows(KP p, int gw, int ngw, int lane) {
    const f32x4* g4 = (const f32x4*)p->in[I_FING] + lane;
    for (int row = gw; row < NTOK; row += ngw) {
        const f32x4* x4 = (const f32x4*)((const float*)(p->ws + WS_XBUF) + (size_t)row * DM) + lane;
        f32x4 v[8]; float ss = 0.f;
#pragma unroll
        for (int j = 0; j < 8; ++j) { v[j] = x4[64 * j]; ss += (v[j].x * v[j].x + v[j].y * v[j].y) + (v[j].z * v[j].z + v[j].w * v[j].w); }
        const float rstd = 1.f / sqrtf(wave_sum(ss) * (1.f / DM) + 1e-6f);
        f32x4* o = (f32x4*)(p->out + O_YP + (size_t)row * DM) + lane;
#pragma unroll
        for (int j = 0; j < 8; ++j) o[64 * j] = v[j] * rstd * g4[64 * j];
    }
}
struct EpiU {
    static constexpr bool PERM = true, AFTER_DRAIN = false;
    bf16_t* U; float* out; const float* bf; int l;
    __device__ __forceinline__ void operator()(const f32x4 (&acc)[2][2][4][2], const pg8::Unit& u, int wr, int wc, int fr, int fq) const {
        const int row0 = u.pm * 256 + wr * 64 + fr, col0 = u.pn * 256 + wc * 32 + 8 * fq;
#pragma unroll
        for (int ai = 0; ai < 2; ++ai)
#pragma unroll
            for (int m = 0; m < 4; ++m) { bf16_t* rowp = U + (size_t)(row0 + ai * 128 + m * 16) * NU + col0;
#pragma unroll
                for (int bj = 0; bj < 2; ++bj) { const f32x4 v0 = acc[ai][bj][m][0], v1 = acc[ai][bj][m][1];
                    u32x4 w; w.x = cvt_pk_bf16(v0[0], v0[1]); w.y = cvt_pk_bf16(v0[2], v0[3]); w.z = cvt_pk_bf16(v1[0], v1[1]); w.w = cvt_pk_bf16(v1[2], v1[3]);
                    *(u32x4*)(rowp + bj * 128) = w; } }
        if (u.pn >= 8 && u.pn < 12) {
            const bool isv = u.pn >= 10; const int cin = (u.pn - (isv ? 10 : 8)) * 256 + wc * 32 + 8 * fq;
#pragma unroll
            for (int ai = 0; ai < 2; ++ai)
#pragma unroll
                for (int m = 0; m < 4; ++m) { const int row = row0 + ai * 128 + m * 16;
                    float* dst = row < TP ? out + (isv ? O_PV : O_PK) + ((size_t)l * TP + row) * 512 : out + (isv ? O_SV : O_SK) + ((size_t)l * 1024 + (row - TP)) * 512;
#pragma unroll
                    for (int bj = 0; bj < 2; ++bj) { *(f32x4*)(dst + cin + bj * 128) = acc[ai][bj][m][0]; *(f32x4*)(dst + cin + bj * 128 + 4) = acc[ai][bj][m][1]; } }
        }
        if (u.pn == 58 && wc == 0 && fq == 0) {
            const f32x4 b0 = *(const f32x4*)(bf + l * 8), b1 = *(const f32x4*)(bf + l * 8 + 4);
#pragma unroll
            for (int ai = 0; ai < 2; ++ai)
#pragma unroll
                for (int m = 0; m < 4; ++m) { const int row = row0 + ai * 128 + m * 16;
                    float* dst = row < TP ? out + O_PLF + ((size_t)l * TP + row) * 8 : out + O_SLF + ((size_t)l * 1024 + (row - TP)) * 8;
                    const f32x4 z0 = acc[ai][1][m][0] + b0, z1 = acc[ai][1][m][1] + b1; f32x4 o0, o1;
#pragma unroll
                    for (int e = 0; e < 4; ++e) { o0[e] = log_sigmoidf_(z0[e]); o1[e] = log_sigmoidf_(z1[e]); }
                    *(f32x4*)dst = o0; *(f32x4*)(dst + 4) = o1; }
        }
    }
};
struct BranchOrder {
    int G, c;
    __device__ __forceinline__ bool next(int i, pg8::Unit& u) const { const int L = i * G + c; if (L >= 4 * 544) return false; const int n = L / 544, t = L - n * 544; u.pm = n * 68 + (t >> 3); u.pn = n * 8 + (t & 7); return true; }
    __device__ __forceinline__ void a_ready(const pg8::Unit&) const {}
    __device__ __forceinline__ void done(const pg8::Unit&) const {}
};
struct EpiZ {
    static constexpr bool PERM = true, AFTER_DRAIN = false;
    bf16_t* Z;
    __device__ __forceinline__ void operator()(const f32x4 (&acc)[2][2][4][2], const pg8::Unit& u, int wr, int wc, int fr, int fq) const {
        const int row0 = u.pm * 256 + wr * 64 + fr, col0 = (u.pn & 7) * 256 + wc * 32 + 8 * fq;
#pragma unroll
        for (int ai = 0; ai < 2; ++ai)
#pragma unroll
            for (int m = 0; m < 4; ++m) { bf16_t* rowp = Z + (size_t)(row0 + ai * 128 + m * 16) * DM + col0;
#pragma unroll
                for (int bj = 0; bj < 2; ++bj) { const f32x4 v0 = acc[ai][bj][m][0], v1 = acc[ai][bj][m][1];
                    u32x4 w; w.x = cvt_pk_bf16(v0[0], v0[1]); w.y = cvt_pk_bf16(v0[2], v0[3]); w.z = cvt_pk_bf16(v1[0], v1[1]); w.w = cvt_pk_bf16(v1[2], v1[3]);
                    *(u32x4*)(rowp + bj * 128) = w; } }
    }
};
__device__ __forceinline__ void merge_pass(KP p, int gtid, int ngt) {
    const bf16_t* U = (const bf16_t*)(p->ws + WS_U); const bf16_t* Z = (const bf16_t*)(p->ws + WS_Z); bf16_t* M = (bf16_t*)(p->ws + WS_MERGED);
    for (int it = gtid; it < NTOK * 256; it += ngt) { const int row = it >> 8, col = (it & 255) * 8;
        float s[8];
#pragma unroll
        for (int e = 0; e < 8; ++e) s[e] = 0.f;
#pragma unroll
        for (int n = 0; n < 4; ++n) { const u32x4 g = *(const u32x4*)(U + (size_t)row * NU + U_G + n * 2048 + col); const u32x4 z = *(const u32x4*)(Z + ((size_t)n * NTOK + row) * DM + col);
            s[0] += sigmoidf_(bflo(g.x)) * bflo(z.x); s[1] += sigmoidf_(bfhi(g.x)) * bfhi(z.x); s[2] += sigmoidf_(bflo(g.y)) * bflo(z.y); s[3] += sigmoidf_(bfhi(g.y)) * bfhi(z.y);
            s[4] += sigmoidf_(bflo(g.z)) * bflo(z.z); s[5] += sigmoidf_(bfhi(g.z)) * bfhi(z.z); s[6] += sigmoidf_(bflo(g.w)) * bflo(z.w); s[7] += sigmoidf_(bfhi(g.w)) * bfhi(z.w); }
        u32x4 w; w.x = cvt_pk_bf16(s[0], s[1]); w.y = cvt_pk_bf16(s[2], s[3]); w.z = cvt_pk_bf16(s[4], s[5]); w.w = cvt_pk_bf16(s[6], s[7]);
        *(u32x4*)(M + (size_t)row * DM + col) = w; }
}
struct EpiOut {
    static constexpr bool PERM = false, AFTER_DRAIN = false;
    const float* xp; const float* xs; const float* xb; const float* ada; float* xout; int l;
    __device__ __forceinline__ void operator()(const f32x4 (&acc)[2][2][4][2], const pg8::Unit& u, int wr, int wc, int fr, int fq) const {
        const int row0 = u.pm * 256 + wr * 64 + fr, col0 = u.pn * 256 + wc * 32 + 4 * fq;
#pragma unroll
        for (int ai = 0; ai < 2; ++ai)
#pragma unroll
            for (int m = 0; m < 4; ++m) { const int row = row0 + ai * 128 + m * 16;
                const float* base = l == 0 ? (row < TP ? xp + (size_t)row * DM : xs + (size_t)(row - TP) * DM) : xb + (size_t)row * DM;
                const int seq = row < TP ? 0 : 1 + ((row - TP) >> 5);
                const float* gate = ada + ((size_t)l * 33 + seq) * 6144 + 4096;
#pragma unroll
                for (int bj = 0; bj < 2; ++bj)
#pragma unroll
                    for (int n = 0; n < 2; ++n) { const int col = col0 + bj * 128 + n * 16;
                        *(f32x4*)(xout + (size_t)row * DM + col) = *(const f32x4*)(base + col) + *(const f32x4*)(gate + col) * acc[ai][bj][m][n]; } }
    }
};
__device__ __forceinline__ void conv_unit(KP p, int l, int tile, LAS unsigned char* lds, int tid) {
    const bf16_t* U = (const bf16_t*)(p->ws + WS_U);
    const int c = tid, wave = tid >> 6, lane = tid & 63;
    const bool samp = tile >= 512; const int b = tile - 512, row0 = samp ? TP + b * 32 : tile * 32;
    const bool last = samp || tile == 511;
    LAS float* red = (LAS float*)lds;
    LAS float* st = red + 8 * 32;
    const float cb = p->in[I_CONVB][l * 512 + c], lg = p->in[I_CLNG][l * 512 + c], lb = p->in[I_CLNB][l * 512 + c];
    bf16_t* oa = (bf16_t*)(p->ws + WS_OCAT);
#pragma unroll 1
    for (int half = 0; half < 2; ++half) {
        float z[46];
#pragma unroll
        for (int i = 0; i < 46; ++i) { const int rel = 16 * half + i - 30; float v;
            if (rel >= 0) { const size_t r = (size_t)(row0 + rel) * NU; v = bf2f(U[r + U_AVAL + c]) * sigmoidf_(bf2f(U[r + U_AGATE + c])); }
            else if (samp) v = p->in[I_SCONV][(((size_t)l * 32 + b) * 30 + (30 + rel)) * 512 + c];
            else if (row0 == 0) v = 0.f;
            else { const size_t r = (size_t)(row0 + rel) * NU; v = bf2f(U[r + U_AVAL + c]) * sigmoidf_(bf2f(U[r + U_AGATE + c])); }
            z[i] = v; }
        if (last) {
            float* dst = samp ? p->out + O_SCONV + (((size_t)l * 32 + b) * 30) * 512 + c : p->out + O_PCONV + ((size_t)l * 30) * 512 + c;
#pragma unroll
            for (int tt = 0; tt < 16; ++tt) { const int t = 16 * half + tt; if (t >= 2) dst[(size_t)(t - 2) * 512] = z[30 + tt]; }
        }
        float hv[16];
#pragma unroll
        for (int tt = 0; tt < 16; ++tt) hv[tt] = cb;
#pragma unroll
        for (int k = 0; k < 31; ++k) { const float w = p->in[I_CONVW][((size_t)l * 31 + k) * 512 + c];
#pragma unroll
            for (int tt = 0; tt < 16; ++tt) hv[tt] += z[tt + k] * w; }
#pragma unroll
        for (int tt = 0; tt < 16; ++tt) { const float s1 = wave_sum(hv[tt]), s2 = wave_sum(hv[tt] * hv[tt]); if (lane == 0) { red[(wave * 16 + tt) * 2] = s1; red[(wave * 16 + tt) * 2 + 1] = s2; } }
        __syncthreads();
        if (tid < 16) { float s1 = 0.f, s2 = 0.f;
#pragma unroll
            for (int w = 0; w < 8; ++w) { s1 += red[(w * 16 + tid) * 2]; s2 += red[(w * 16 + tid) * 2 + 1]; }
            const float mean = s1 * (1.f / 512.f), var = fmaxf(s2 * (1.f / 512.f) - mean * mean, 0.f);
            st[tid * 2] = mean; st[tid * 2 + 1] = 1.f / sqrtf(var + 1e-5f); }
        __syncthreads();
#pragma unroll
        for (int tt = 0; tt < 16; ++tt) { const float y = (hv[tt] - st[tt * 2]) * st[tt * 2 + 1] * lg + lb; const size_t r = (size_t)(row0 + 16 * half + tt);
            oa[r * 512 + c] = f2bf(siluf_(y) * siluf_(bf2f(U[r * NU + U_ASG + c]))); }
        __syncthreads();
    }
}
__device__ __forceinline__ void pool_unit(KP p, int l, int tile, LAS unsigned char* lds, int tid) {
    const bf16_t* U = (const bf16_t*)(p->ws + WS_U);
    const int c = tid, wave = tid >> 6, lane = tid & 63;
    const bool samp = tile >= 512; const int b = tile - 512, row0 = samp ? TP + b * 32 : tile * 32;
    constexpr int PST = 520;
    LAS bf16_t* pl = (LAS bf16_t*)lds;
    {
        float z[47];
#pragma unroll
        for (int i = 0; i < 15; ++i) {
            float v;
            if (samp) v = p->in[I_SPOOL][(((size_t)l * 32 + b) * 15 + i) * 512 + c];
            else if (row0 == 0) v = 0.f;
            else v = bf2f(U[(size_t)(row0 - 15 + i) * NU + U_DIN + c]);
            z[i] = v; }
#pragma unroll
        for (int t = 0; t < 32; ++t) z[15 + t] = bf2f(U[(size_t)(row0 + t) * NU + U_DIN + c]);
        if (samp || tile == 511) {
            float* dst = samp ? p->out + O_SPOOL + (((size_t)l * 32 + b) * 15) * 512 + c : p->out + O_PPOOL + ((size_t)l * 15) * 512 + c;
#pragma unroll
            for (int t = 17; t < 32; ++t) dst[(size_t)(t - 17) * 512] = z[15 + t];
        }
        const int w = 2 << (c >> 7);
#pragma unroll
        for (int t = 0; t < 32; ++t) { float s = 0.f;
#pragma unroll
            for (int i = 0; i < 16; ++i) s += (i < w) ? z[15 + t - i] : 0.f;
            const int pos = samp ? PAST + t : row0 + t; const int cnt = (pos + 1 < w) ? pos + 1 : w;
            pl[t * PST + c] = f2bf(s / (float)cnt - z[15 + t]); }
    }
    __syncthreads();
    {
        const int g = wave >> 1, fr = lane & 15, kq = lane >> 4;
        const bf16_t* WT = (const bf16_t*)(p->ws + WS_POOLW) + (size_t)(l * 4 + g) * 128 * 128;
        f32x4 acc[2][4];
#pragma unroll
        for (int mt = 0; mt < 2; ++mt)
#pragma unroll
            for (int nt = 0; nt < 4; ++nt) acc[mt][nt] = (f32x4){0.f, 0.f, 0.f, 0.f};
#pragma unroll
        for (int ks = 0; ks < 4; ++ks) {
            bf16x8 af[2];
#pragma unroll
            for (int mt = 0; mt < 2; ++mt) af[mt] = *(const LAS bf16x8*)(pl + (16 * mt + fr) * PST + g * 128 + 32 * ks + 8 * kq);
#pragma unroll
            for (int nt = 0; nt < 4; ++nt) { const int dl = (wave & 1) * 64 + 16 * nt + fr;
                const bf16x8 bfr = *(const bf16x8*)(WT + (size_t)dl * 128 + 32 * ks + 8 * kq);
#pragma unroll
                for (int mt = 0; mt < 2; ++mt) acc[mt][nt] = __builtin_amdgcn_mfma_f32_16x16x32_bf16(af[mt], bfr, acc[mt][nt], 0, 0, 0); }
        }
        bf16_t* od = (bf16_t*)(p->ws + WS_OCAT) + (size_t)3 * NTOK * 512;
#pragma unroll
        for (int nt = 0; nt < 4; ++nt) { const int d = wave * 64 + 16 * nt + fr; const float pb = p->in[I_POOLB][l * 512 + d], ps = p->in[I_POOLS][l * 512 + d];
#pragma unroll
            for (int mt = 0; mt < 2; ++mt)
#pragma unroll
                for (int r = 0; r < 4; ++r) { const size_t row = (size_t)(row0 + 16 * mt + 4 * kq + r);
                    od[row * 512 + d] = f2bf((acc[mt][nt][r] + pb) * ps * siluf_(bf2f(U[row * NU + U_DSG + d]))); } }
    }
    __syncthreads();
}
__device__ __forceinline__ void fp_unit(KP p, int l, int h, LAS unsigned char* lds, int tid) {
    const float* lf = p->out + O_PLF + (size_t)l * TP * 8 + h;
    LAS float* part = (LAS float*)lds;
    float v[32]; float s = 0.f;
#pragma unroll
    for (int i = 0; i < 32; ++i) { v[i] = lf[(size_t)(tid * 32 + i) * 8]; s += v[i]; }
    part[tid] = s;
    __syncthreads();
    float pre = 0.f;
    for (int j = 0; j < tid; ++j) pre += part[j];
    float* F = (float*)(p->ws + WS_FP) + (size_t)h * TP + tid * 32;
#pragma unroll
    for (int i = 0; i < 32; ++i) { pre += v[i]; F[i] = pre * LOG2E; }
    __syncthreads();
}
__device__ __forceinline__ void gs_unit(KP p, int l, int b, LAS unsigned char* lds, int tid) {
    const int h = tid & 7, ch = tid >> 3;
    const float* cl = p->in[I_CLF] + (((size_t)l * 32 + b) * PAST) * 8 + h;
    LAS float* part = (LAS float*)lds;
    float s = 0.f;
    for (int i = 0; i < 64; ++i) s += cl[(size_t)(ch * 64 + i) * 8];
    part[ch * 8 + h] = s;
    __syncthreads();
    float suf = 0.f;
    for (int j = ch + 1; j < 64; ++j) suf += part[j * 8 + h];
    float* G = (float*)(p->ws + WS_GS) + ((size_t)b * 8 + h) * GS_LEN;
    for (int i = 63; i >= 0; --i) { const int t = ch * 64 + i; G[t] = -suf * LOG2E; suf += cl[(size_t)t * 8]; }
    if (tid < 8) { const float* nl = p->out + O_SLF + ((size_t)l * 1024 + b * 32) * 8 + tid; float run = 0.f;
        for (int i = 0; i < 32; ++i) { run += nl[i * 8]; G[PAST + i] = run * LOG2E; } }
    __syncthreads();
}
__device__ __forceinline__ void vt_tile(KP p, int l, int tile, LAS unsigned char* lds, int wave, int lane) {
    const int h = tile >> 8, tb = tile & 255;
    const bf16_t* U = (const bf16_t*)(p->ws + WS_U);
    LAS unsigned* scr = (LAS unsigned*)lds + wave * SLOT_F;
#pragma unroll 8
    for (int tt = 0; tt < 64; ++tt) scr[tt * 65 + lane] = U[(size_t)(tb * 64 + tt) * NU + U_V + h * 64 + lane];
    {
        float mx = 0.f;
#pragma unroll 8
        for (int tt = 0; tt < 64; ++tt) { const float kv = bf2f(U[(size_t)(tb * 64 + tt) * NU + U_K + h * 64 + lane]); mx = fmaxf(mx, wave_sum(kv * kv)); }
        if (lane == 0) atomicMax((unsigned*)(p->ws + WS_CTL) + CW_KMAX + l * 8 + h, __float_as_uint(mx));
    }
    bf16_t* Vt = (bf16_t*)(p->ws + WS_VT);
    const int t2 = (lane & 31) * 2, dh = lane >> 5;
#pragma unroll 8
    for (int it = 0; it < 32; ++it) { const int d = 2 * it + dh; *(unsigned*)(Vt + ((size_t)h * 64 + d) * TP + tb * 64 + t2) = scr[t2 * 65 + d] | (scr[(t2 + 1) * 65 + d] << 16); }
}
__device__ __forceinline__ void shift_out(KP p, int l, int tid) {
    const bf16_t* U = (const bf16_t*)(p->ws + WS_U);
    for (int idx = tid; idx < NSEQ * SHIFT_W; idx += 512) { const int s = idx / SHIFT_W, j = idx - s * SHIFT_W;
        const int row = s == 0 ? TP - 1 : TP + (s - 1) * 32 + 31;
        float* dst = s == 0 ? p->out + O_PSHIFT + (size_t)l * SHIFT_W + j : p->out + O_SSHIFT + ((size_t)l * 32 + (s - 1)) * SHIFT_W + j;
        *dst = bf2f(U[(size_t)row * NU + U_XC + j]); }
}
template <bool AT, bool BT, bool NEGA>
__device__ __forceinline__ void mm32(f32x16& acc, const LAS float* Ap, int i0, const LAS float* Bp, int j0, int lane) {
    const int li = lane & 31, kh = lane >> 5;
    const LAS float* ap = AT ? Ap + (8 * kh) * 65 + i0 + li : Ap + (i0 + li) * 65 + 8 * kh;
    const LAS float* bp = BT ? Bp + (j0 + li) * 65 + 8 * kh : Bp + (8 * kh) * 65 + j0 + li;
#pragma unroll
    for (int s = 0; s < 4; ++s) {
        float a[8], b[8];
#pragma unroll
        for (int e = 0; e < 8; ++e) { a[e] = AT ? ap[(16 * s + e) * 65] : ap[16 * s + e]; b[e] = BT ? bp[16 * s + e] : bp[(16 * s + e) * 65]; }
        if (NEGA) {
#pragma unroll
            for (int e = 0; e < 8; ++e) a[e] = -a[e]; }
        const bf16x8 af = pack8f((f32x4){a[0], a[1], a[2], a[3]}, (f32x4){a[4], a[5], a[6], a[7]}), bfg = pack8f((f32x4){b[0], b[1], b[2], b[3]}, (f32x4){b[4], b[5], b[6], b[7]});
        acc = __builtin_amdgcn_mfma_f32_32x32x16_bf16(af, bfg, acc, 0, 0, 0);
    }
}
template <int MASK>
__device__ __forceinline__ void st_tile(LAS float* dst, const f32x16& acc, int i0, int j0, int lane) {
    const int li = lane & 31, hi = lane >> 5, j = j0 + li;
#pragma unroll
    for (int r = 0; r < 16; ++r) { const int i = i0 + (r & 3) + 8 * (r >> 2) + 4 * hi; float v = acc[r];
        if (MASK == 1 && !(i < j)) v = 0.f; if (MASK == 2 && !(i <= j)) v = 0.f; dst[i * 65 + j] = v; }
}
struct RwkvSeqInfo { int row0, ntok, prev_kind  , b; };
__device__ __forceinline__ RwkvSeqInfo rwkv_info(int cu) { RwkvSeqInfo s; if (cu < 256) { s.row0 = cu * 64; s.ntok = 64; s.prev_kind = cu == 0 ? 0 : 1; s.b = 0; } else { s.b = cu - 256; s.row0 = TP + s.b * 32; s.ntok = 32; s.prev_kind = 2; } return s; }

__device__ __forceinline__ void rwkv_r1(KP p, int l, int unit, LAS unsigned char* lds, int tid) {
    const int cu = unit >> 3, h = unit & 7, wave = tid >> 6, lane = tid & 63, li = lane & 31, hi = lane >> 5;
    const RwkvSeqInfo si = rwkv_info(cu);
    const bf16_t* U = (const bf16_t*)(p->ws + WS_U);
    LAS float* S0 = (LAS float*)lds; LAS float *S1 = S0 + SLOT_F, *S2 = S0 + 2 * SLOT_F, *S3 = S0 + 3 * SLOT_F, *S4 = S0 + 4 * SLOT_F, *S5 = S0 + 5 * SLOT_F, *S6 = S0 + 6 * SLOT_F, *S7 = S0 + 7 * SLOT_F, *S8 = S0 + 8 * SLOT_F;
    LAS float* gC = S0 + 9 * SLOT_F;
    const int q = wave >> 2, wq = wave & 3, i0 = (wq >> 1) * 32, j0 = (wq & 1) * 32;
    {
        const int j = tid & 63, tq = tid >> 6;
        const int offs[5] = {h * 64, 512 + h * 64, 1024 + h * 64, 1536, 1600};
#pragma unroll
        for (int cs = 0; cs < 5; ++cs) {
            const int xo = offs[cs] + j; const float mu = p->in[I_MU][l * SHIFT_W + xo];
            LAS float* dst = cs == 0 ? S0 : cs == 1 ? S1 : cs == 2 ? S2 : cs == 3 ? S3 : S4;
            const int t0 = tq * 8; float prev;
            if (t0 == 0) prev = si.prev_kind == 0 ? 0.f : si.prev_kind == 1 ? bf2f(U[(size_t)(si.row0 - 1) * NU + U_XC + xo]) : p->in[I_SSHIFT][((size_t)l * 32 + si.b) * SHIFT_W + xo];
            else prev = (t0 - 1 < si.ntok) ? bf2f(U[(size_t)(si.row0 + t0 - 1) * NU + U_XC + xo]) : 0.f;
#pragma unroll
            for (int tt = 0; tt < 8; ++tt) { const int t = t0 + tt; float xs = 0.f;
                if (t < si.ntok) { const float x = bf2f(U[(size_t)(si.row0 + t) * NU + U_XC + xo]); xs = x + (prev - x) * mu; prev = x; }
                if (cs == 3) xs = fast_tanh(xs);
                dst[t * 65 + j] = xs; }
        }
#pragma unroll
        for (int mm = 0; mm < 8; ++mm) { const int m = tq * 8 + mm;
            S5[m * 65 + j] = p->in[I_W2][((size_t)l * 64 + m) * 512 + h * 64 + j]; S6[m * 65 + j] = p->in[I_A2][((size_t)l * 64 + m) * 512 + h * 64 + j]; }
    }
    __syncthreads();
    {
        f32x16 acc = {};
        const int c = j0 + li;
        if (q == 0) { mm32<false, false, false>(acc, S3, i0, S5, j0, lane); const float w0 = p->in[I_W0][l * 512 + h * 64 + c];
#pragma unroll
            for (int r = 0; r < 16; ++r) { const int t = i0 + (r & 3) + 8 * (r >> 2) + 4 * hi; const float zz = acc[r] + w0;
                const float sp = fmaxf(-zz, 0.f) + __logf(1.f + __expf(-fabsf(zz)));
                S7[t * 65 + c] = (t < si.ntok) ? -__expf(-sp - 0.5f) : 0.f; } }
        else { mm32<false, false, false>(acc, S4, i0, S6, j0, lane); const float a0 = p->in[I_A0][l * 512 + h * 64 + c];
#pragma unroll
            for (int r = 0; r < 16; ++r) { const int t = i0 + (r & 3) + 8 * (r >> 2) + 4 * hi; S8[t * 65 + c] = __builtin_amdgcn_rcpf(1.f + __expf(-(acc[r] + a0))); } }
    }
    __syncthreads();
    if (wave == 0) { float run = 0.f;
#pragma unroll 8
        for (int t = 0; t < 64; ++t) { run += S7[t * 65 + lane]; S3[t * 65 + lane] = run; } }
    else { const int c = lane; const float kkw = p->in[I_KK][l * 512 + h * 64 + c], kaw = p->in[I_KA][l * 512 + h * 64 + c], rkw = p->in[I_RK][l * 512 + h * 64 + c];
        for (int t = wave - 1; t < 64; t += 7) { const float kr = S1[t * 65 + c], kv = kr * kkw; const float ss = wave_sum(kv * kv);
            const float kn = kv * (1.f / sqrtf(fmaxf(ss, 1e-24f))); const float a = S8[t * 65 + c]; const float km = kr * (1.f + (a - 1.f) * kaw);
            const float bon = wave_sum(S0[t * 65 + c] * km * rkw);
            S4[t * 65 + c] = kn; S1[t * 65 + c] = km; S8[t * 65 + c] = kn * a;
            if (lane == 0) ((float*)(p->ws + WS_BONUS))[(size_t)unit * 64 + t] = bon; } }
    __syncthreads();
    { const int c = tid & 63, tq = tid >> 6;
#pragma unroll
        for (int tt = 0; tt < 8; ++tt) { const int t = tq * 8 + tt, o = t * 65 + c; const float Lg = S3[o], lw = S7[o];
            const float g = __expf(Lg), gi = __expf(-Lg), gp = __expf(Lg - lw);
            S0[o] *= g; S1[o] *= gi; S8[o] *= gi; S4[o] *= gp; if (t == 63) gC[c] = g; } }
    __syncthreads();
    { f32x16 acc = {};
      if (q == 0) { mm32<false, true, false>(acc, S1, i0, S4, j0, lane); st_tile<1>(S3, acc, i0, j0, lane); }
      else { mm32<false, true, false>(acc, S8, i0, S4, j0, lane); st_tile<1>(S5, acc, i0, j0, lane); } }
    __syncthreads();
    { f32x16 acc = {};
      if (q == 0) { mm32<true, false, false>(acc, S2, i0, S3, j0, lane); st_tile<0>(S6, acc, i0, j0, lane); }
      else { mm32<false, true, false>(acc, S1, i0, S0, j0, lane); st_tile<2>(S7, acc, i0, j0, lane); } }
    __syncthreads();
    { float x[16]; const int r0 = (wave & 3) * 16;
      if (wave < 4) {
#pragma unroll
          for (int rr = 0; rr < 16; ++rr) x[rr] = S4[lane * 65 + r0 + rr]; }
      else {
#pragma unroll
          for (int rr = 0; rr < 16; ++rr) x[rr] = S6[(r0 + rr) * 65 + lane]; }
      __syncthreads();
#pragma unroll
      for (int s = 0; s < 63; ++s) { const float mrow = S5[s * 65 + lane]; float xs[16];
#pragma unroll
          for (int rr = 0; rr < 16; ++rr) xs[rr] = __builtin_bit_cast(float, __builtin_amdgcn_readlane(__builtin_bit_cast(int, x[rr]), s));
          __builtin_amdgcn_sched_barrier(0);
#pragma unroll
          for (int rr = 0; rr < 16; ++rr) x[rr] -= xs[rr] * mrow;
          __builtin_amdgcn_sched_barrier(0); }
      LAS float* dst = wave < 4 ? S3 : S6;
#pragma unroll
      for (int rr = 0; rr < 16; ++rr) dst[(r0 + rr) * 65 + lane] = x[rr]; }
    __syncthreads();
    { f32x16 acc = {};
      if (q == 1) { mm32<false, true, false>(acc, S8, i0, S0, j0, lane); st_tile<2>(S4, acc, i0, j0, lane); }
      else { mm32<false, false, false>(acc, S3, i0, S8, j0, lane);
          const int jc = j0 + li; const float gc = gC[jc]; float* TQ = (float*)(p->ws + WS_TQ) + (size_t)unit * 4096;
#pragma unroll
          for (int rg = 0; rg < 4; ++rg) { const int ab = i0 + 8 * rg + 4 * hi; f32x4 o;
#pragma unroll
              for (int e = 0; e < 4; ++e) o[e] = ((ab + e == jc) ? gc : 0.f) - acc[rg * 4 + e] * gc;
              *(f32x4*)(TQ + ((((jc >> 4) * 4 + (ab >> 4)) * 64 + ((ab & 15) >> 2) * 16 + (jc & 15)) * 4)) = o; } } }
    __syncthreads();
    { f32x16 acc = {};
      if (q == 0) { mm32<true, false, false>(acc, S2, i0, S1, j0, lane); mm32<false, false, true>(acc, S6, i0, S8, j0, lane);
          const int jc = j0 + li; const float gc = gC[jc]; float* GM = (float*)(p->ws + WS_GM) + (size_t)unit * 4096;
#pragma unroll
          for (int r = 0; r < 16; ++r) GM[(i0 + (r & 3) + 8 * (r >> 2) + 4 * hi) * 64 + jc] = acc[r] * gc; }
      else { mm32<true, false, false>(acc, S2, i0, S7, j0, lane); mm32<false, false, true>(acc, S6, i0, S4, j0, lane);
          float* Y0T = (float*)(p->ws + WS_Y0T) + (size_t)unit * 4096 + (j0 + li) * 64;
#pragma unroll
          for (int rg = 0; rg < 4; ++rg) *(f32x4*)(Y0T + i0 + 8 * rg + 4 * hi) = (f32x4){acc[rg * 4], acc[rg * 4 + 1], acc[rg * 4 + 2], acc[rg * 4 + 3]}; } }
    if (q == 0) { f32x16 acc;
#pragma unroll
        for (int r = 0; r < 16; ++r) acc[r] = S0[(j0 + li) * 65 + i0 + (r & 3) + 8 * (r >> 2) + 4 * hi];
        mm32<false, false, true>(acc, S3, i0, S4, j0, lane);
        float* ET = (float*)(p->ws + WS_ET) + (size_t)unit * 4096 + (j0 + li) * 64;
#pragma unroll
        for (int rg = 0; rg < 4; ++rg) *(f32x4*)(ET + i0 + 8 * rg + 4 * hi) = (f32x4){acc[rg * 4], acc[rg * 4 + 1], acc[rg * 4 + 2], acc[rg * 4 + 3]}; }
    __syncthreads();
}
__device__ __forceinline__ void chain_run(f32x4 (&st)[4], const float* TQ, const float* GM, float* SC, int nsteps, int i, int g, int lane) {
    constexpr size_t STRIDE = (size_t)8 * 4096;
    f32x4 tq[16], gm[4];
#pragma unroll
    for (int x = 0; x < 16; ++x) tq[x] = *(const f32x4*)(TQ + (x * 64 + lane) * 4);
#pragma unroll
    for (int tl = 0; tl < 4; ++tl) gm[tl] = GM ? *(const f32x4*)(GM + i * 64 + 16 * tl + 4 * g) : (f32x4){0.f, 0.f, 0.f, 0.f};
    for (int c = 0; c < nsteps; ++c) {
        if (SC) {
#pragma unroll
            for (int tl = 0; tl < 4; ++tl) *(f32x4*)(SC + c * STRIDE + i * 64 + 16 * tl + 4 * g) = st[tl]; }
        f32x4 tqn[16], gmn[4];
        const int cn = (c + 1 < nsteps) ? c + 1 : c;
#pragma unroll
        for (int x = 0; x < 16; ++x) tqn[x] = *(const f32x4*)(TQ + cn * STRIDE + (x * 64 + lane) * 4);
#pragma unroll
        for (int tl = 0; tl < 4; ++tl) gmn[tl] = GM ? *(const f32x4*)(GM + cn * STRIDE + i * 64 + 16 * tl + 4 * g) : (f32x4){0.f, 0.f, 0.f, 0.f};
        f32x4 acc[4];
#pragma unroll
        for (int tp = 0; tp < 4; ++tp) acc[tp] = gm[tp];
#pragma unroll
        for (int tl = 0; tl < 4; ++tl)
#pragma unroll
            for (int r = 0; r < 4; ++r)
#pragma unroll
                for (int tp = 0; tp < 4; ++tp) acc[tp] = __builtin_amdgcn_mfma_f32_16x16x4f32(tq[tp * 4 + tl][r], st[tl][r], acc[tp], 0, 0, 0);
#pragma unroll
        for (int tl = 0; tl < 4; ++tl) st[tl] = acc[tl];
#pragma unroll
        for (int x = 0; x < 16; ++x) tq[x] = tqn[x];
#pragma unroll
        for (int tl = 0; tl < 4; ++tl) gm[tl] = gmn[tl];
    }
}
__device__ __forceinline__ void rwkv_l1_task(KP p, int task, int lane) {
    const int iq = task & 3, kind = (task >> 2) & 1, h = (task >> 3) & 7, grp = task >> 6;
    const int fr = lane & 15, g = lane >> 4, i = iq * 16 + fr;
    const size_t u0 = ((size_t)(grp * 16) * 8 + h) * 4096;
    const float* TQ = (const float*)(p->ws + WS_TQ) + u0; const float* GM = (const float*)(p->ws + WS_GM) + u0;
    f32x4 st[4];
#pragma unroll
    for (int tl = 0; tl < 4; ++tl)
#pragma unroll
        for (int r = 0; r < 4; ++r) st[tl][r] = (kind == 1 && i == 16 * tl + 4 * g + r) ? 1.f : 0.f;
    chain_run(st, TQ, kind == 0 ? GM : nullptr, nullptr, 16, i, g, lane);
    const size_t gb = ((size_t)grp * 8 + h) * 4096;
    if (kind == 0) { float* GG = (float*)(p->ws + WS_GG) + gb;
#pragma unroll
        for (int tl = 0; tl < 4; ++tl) *(f32x4*)(GG + i * 64 + 16 * tl + 4 * g) = st[tl]; }
    else { float* TG = (float*)(p->ws + WS_TG) + gb;
#pragma unroll
        for (int tl = 0; tl < 4; ++tl)
#pragma unroll
            for (int r = 0; r < 4; ++r) TG[((tl * 4 + iq) * 64 + (fr >> 2) * 16 + 4 * g + r) * 4 + (fr & 3)] = st[tl][r]; }
}
__device__ __forceinline__ void rwkv_l2_task(KP p, int l, int task, int lane) {
    const int iq = task & 3, h = task >> 2, fr = lane & 15, g = lane >> 4, i = iq * 16 + fr;
    f32x4 st[4];
#pragma unroll
    for (int tl = 0; tl < 4; ++tl) st[tl] = (f32x4){0.f, 0.f, 0.f, 0.f};
    chain_run(st, (const float*)(p->ws + WS_TG) + (size_t)h * 4096, (const float*)(p->ws + WS_GG) + (size_t)h * 4096, (float*)(p->ws + WS_SG) + (size_t)h * 4096, 16, i, g, lane);
    float* dst = p->out + O_PWKV + (((size_t)l * 8 + h) * 64 + i) * 64;
#pragma unroll
    for (int tl = 0; tl < 4; ++tl) *(f32x4*)(dst + 16 * tl + 4 * g) = st[tl];
}
__device__ __forceinline__ void rwkv_l3_task(KP p, int l, int task, int lane) {
    const int fr = lane & 15, g = lane >> 4;
    f32x4 st[4];
    if (task < 512) { const int iq = task & 3, h = (task >> 2) & 7, grp = task >> 5, i = iq * 16 + fr;
        const float* s0 = (const float*)(p->ws + WS_SG) + ((size_t)grp * 8 + h) * 4096 + i * 64;
#pragma unroll
        for (int tl = 0; tl < 4; ++tl) st[tl] = *(const f32x4*)(s0 + 16 * tl + 4 * g);
        const size_t u0 = ((size_t)(grp * 16) * 8 + h) * 4096;
        chain_run(st, (const float*)(p->ws + WS_TQ) + u0, (const float*)(p->ws + WS_GM) + u0, (float*)(p->ws + WS_SC) + u0, 16, i, g, lane); }
    else { const int t2 = task - 512, iq = t2 & 3, h = (t2 >> 2) & 7, b = t2 >> 5, i = iq * 16 + fr;
        const float* s0 = p->in[I_SWKV] + ((((size_t)l * 32 + b) * 8 + h) * 64 + i) * 64;
#pragma unroll
        for (int tl = 0; tl < 4; ++tl) st[tl] = *(const f32x4*)(s0 + 16 * tl + 4 * g);
        const size_t u0 = ((size_t)(256 + b) * 8 + h) * 4096;
        chain_run(st, (const float*)(p->ws + WS_TQ) + u0, (const float*)(p->ws + WS_GM) + u0, (float*)(p->ws + WS_SC) + u0, 1, i, g, lane);
        float* dst = p->out + O_SWKV + ((((size_t)l * 32 + b) * 8 + h) * 64 + i) * 64;
#pragma unroll
        for (int tl = 0; tl < 4; ++tl) *(f32x4*)(dst + 16 * tl + 4 * g) = st[tl]; }
}
__device__ __forceinline__ void rwkv_r3_task(KP p, int l, int task, int lane) {
    const int unit = task >> 1, th = task & 1, cu = unit >> 3, h = unit & 7, li = lane & 31, hi = lane >> 5;
    const RwkvSeqInfo si = rwkv_info(cu);
    if (th * 32 >= si.ntok) return;
    const bf16_t* U = (const bf16_t*)(p->ws + WS_U);
    const size_t ub = (size_t)unit * 4096; const int t = th * 32 + li;
    const float* SC = (const float*)(p->ws + WS_SC) + ub; const float* ET = (const float*)(p->ws + WS_ET) + ub + t * 64 + 32 * hi; const float* Y0T = (const float*)(p->ws + WS_Y0T) + ub + t * 64;
    f32x16 acc[2];
#pragma unroll
    for (int ti = 0; ti < 2; ++ti)
#pragma unroll
        for (int rg = 0; rg < 4; ++rg) { const f32x4 y0 = *(const f32x4*)(Y0T + 32 * ti + 8 * rg + 4 * hi);
#pragma unroll
            for (int e = 0; e < 4; ++e) acc[ti][rg * 4 + e] = y0[e]; }
#pragma unroll
    for (int s4 = 0; s4 < 8; ++s4) {
        const f32x4 eb = *(const f32x4*)(ET + 4 * s4);
        const f32x4 sa0 = *(const f32x4*)(SC + (li) * 64 + 32 * hi + 4 * s4), sa1 = *(const f32x4*)(SC + (32 + li) * 64 + 32 * hi + 4 * s4);
#pragma unroll
        for (int e = 0; e < 4; ++e) { acc[0] = __builtin_amdgcn_mfma_f32_32x32x2f32(sa0[e], eb[e], acc[0], 0, 0, 0); acc[1] = __builtin_amdgcn_mfma_f32_32x32x2f32(sa1[e], eb[e], acc[1], 0, 0, 0); }
    }
    float s1 = 0.f;
#pragma unroll
    for (int ti = 0; ti < 2; ++ti)
#pragma unroll
        for (int r = 0; r < 16; ++r) s1 += acc[ti][r];
    s1 = xhalf_sum(s1); const float mean = s1 * (1.f / 64.f);
    float s2 = 0.f;
#pragma unroll
    for (int ti = 0; ti < 2; ++ti)
#pragma unroll
        for (int r = 0; r < 16; ++r) { const float d = acc[ti][r] - mean; s2 += d * d; }
    s2 = xhalf_sum(s2); const float rstd = 1.f / sqrtf(s2 * (1.f / 64.f) + 64e-5f);
    if (t >= si.ntok) return;
    const float bon = ((const float*)(p->ws + WS_BONUS))[(size_t)unit * 64 + t];
    const size_t row = (size_t)(si.row0 + t);
    bf16_t* oc = (bf16_t*)(p->ws + WS_OCAT) + (size_t)2 * NTOK * 512 + row * 512 + h * 64;
#pragma unroll
    for (int ti = 0; ti < 2; ++ti)
#pragma unroll
        for (int rg = 0; rg < 4; ++rg) { const int i = 32 * ti + 8 * rg + 4 * hi, c = h * 64 + i;
            const f32x4 gg = *(const f32x4*)(p->in[I_GNG] + l * 512 + c), gb = *(const f32x4*)(p->in[I_GNB] + l * 512 + c), mu = *(const f32x4*)(p->in[I_MU] + l * SHIFT_W + 1024 + c);
            const u32x2 vx = *(const u32x2*)(U + row * NU + U_XC + 1024 + c); const u32x2 sg = *(const u32x2*)(U + row * NU + U_CSG + c);
            f32x4 vc = (f32x4){bflo(vx.x), bfhi(vx.x), bflo(vx.y), bfhi(vx.y)}, vp;
            if (t > 0 || si.prev_kind == 1) { const u32x2 px = *(const u32x2*)(U + (row - 1) * NU + U_XC + 1024 + c); vp = (f32x4){bflo(px.x), bfhi(px.x), bflo(px.y), bfhi(px.y)}; }
            else if (si.prev_kind == 2) vp = *(const f32x4*)(p->in[I_SSHIFT] + ((size_t)l * 32 + si.b) * SHIFT_W + 1024 + c);
            else vp = (f32x4){0.f, 0.f, 0.f, 0.f};
            const f32x4 vs = vc + (vp - vc) * mu;
            const f32x4 sgf = (f32x4){bflo(sg.x), bfhi(sg.x), bflo(sg.y), bfhi(sg.y)};
            f32x4 o;
#pragma unroll
            for (int e = 0; e < 4; ++e) o[e] = (((acc[ti][rg * 4 + e] - mean) * rstd) * gg[e] + gb[e] + bon * vs[e]) * siluf_(sgf[e]);
            u32x2 w; w.x = cvt_pk_bf16(o[0], o[1]); w.y = cvt_pk_bf16(o[2], o[3]); *(u32x2*)(oc + i) = w; }
}
__device__ __forceinline__ int krow(int i) { return (i & 3) + 4 * ((i >> 3) & 1) + 8 * ((i >> 2) & 1) + 16 * (i >> 4); }
__device__ __forceinline__ bf16x8 pack8(const f32x16& v, int o) { u32x4 w; w.x = cvt_pk_bf16(v[o], v[o + 1]); w.y = cvt_pk_bf16(v[o + 2], v[o + 3]); w.z = cvt_pk_bf16(v[o + 4], v[o + 5]); w.w = cvt_pk_bf16(v[o + 6], v[o + 7]); return __builtin_bit_cast(bf16x8, w); }
constexpr float ATT_NEG = -1e30f;
template <bool HALF>
__device__ __forceinline__ void softmax_tile(f32x16& p0, f32x16& p1, float& m, float& lsum, f32x16 (&O)[2], bf16x8 (&pb)[4]) {
    float mx = p0[0];
#pragma unroll
    for (int r = 1; r < 16; ++r) mx = fmaxf(mx, p0[r]);
    if (!HALF) {
#pragma unroll
        for (int r = 0; r < 16; ++r) mx = fmaxf(mx, p1[r]); }
    mx = xhalf_max(mx);
    const float mn = fmaxf(m, mx), alpha = __builtin_amdgcn_exp2f(m - mn);
    m = mn;
    float s = 0.f;
#pragma unroll
    for (int r = 0; r < 16; ++r) { p0[r] = __builtin_amdgcn_exp2f(p0[r] - mn); s += p0[r]; }
    if (!HALF) {
#pragma unroll
        for (int r = 0; r < 16; ++r) { p1[r] = __builtin_amdgcn_exp2f(p1[r] - mn); s += p1[r]; } }
    lsum = lsum * alpha + s;
#pragma unroll
    for (int r = 0; r < 16; ++r) { O[0][r] *= alpha; O[1][r] *= alpha; }
    pb[0] = pack8(p0, 0); pb[1] = pack8(p0, 8);
    if (!HALF) { pb[2] = pack8(p1, 0); pb[3] = pack8(p1, 8); }
}
constexpr int AKS = 72;
constexpr int ATT_KB = 0, ATT_VB = 2 * 64 * AKS * 2, ATT_FB = 4 * 64 * AKS * 2, ATT_SC = ATT_FB + 2 * 64 * 4;
__device__ __forceinline__ void attn_prompt_unit(KP p, int l, int h, int qb, LAS unsigned char* lds, int tid) {
    const bf16_t* U = (const bf16_t*)(p->ws + WS_U); const bf16_t* Vt = (const bf16_t*)(p->ws + WS_VT) + (size_t)h * 64 * TP; const float* F = (const float*)(p->ws + WS_FP) + (size_t)h * TP;
    const int wave = tid >> 6, lane = tid & 63, li = lane & 31, hi = lane >> 5;
    const int q0 = qb * 256, q = q0 + wave * 32 + li;
    bf16x8 qf[4];
    { const float sc = 0.125f * LOG2E;
#pragma unroll
      for (int d0 = 0; d0 < 4; ++d0) { const u32x4 w = *(const u32x4*)(U + (size_t)q * NU + U_Q + h * 64 + 16 * d0 + 8 * hi);
          qf[d0] = pack8f((f32x4){bflo(w.x) * sc, bfhi(w.x) * sc, bflo(w.y) * sc, bfhi(w.y) * sc}, (f32x4){bflo(w.z) * sc, bfhi(w.z) * sc, bflo(w.w) * sc, bfhi(w.w) * sc}); } }
    const float fq = F[q];
    float m = ATT_NEG, lsum = 0.f; f32x16 O[2] = {};
    const int NT = (q0 + 256) / 64;
    LAS float* qmx = (LAS float*)(lds + ATT_SC); LAS float* mmv = qmx + 8;
    { float q2 = 0.f;
#pragma unroll
      for (int d0 = 0; d0 < 4; ++d0) { const u32x4 w = __builtin_bit_cast(u32x4, qf[d0]); q2 += bflo(w.x) * bflo(w.x) + bfhi(w.x) * bfhi(w.x) + bflo(w.y) * bflo(w.y) + bfhi(w.y) * bfhi(w.y) + bflo(w.z) * bflo(w.z) + bfhi(w.z) * bfhi(w.z) + bflo(w.w) * bflo(w.w) + bfhi(w.w) * bfhi(w.w); }
      q2 = wave_max(xhalf_sum(q2)); if (lane == 0) { qmx[wave] = q2; mmv[wave] = ATT_NEG; } }
    const float kmax2 = __uint_as_float(((const unsigned*)(p->ws + WS_CTL))[CW_KMAX + l * 8 + h]), fq0 = F[q0];
    const int srow = tid >> 3, sch = tid & 7;
    const bf16_t* kg = U + (size_t)srow * NU + U_K + h * 64 + 8 * sch; const bf16_t* vg = Vt + (size_t)srow * TP + 8 * sch;
    LAS unsigned char* kdst = lds + ATT_KB + (srow * AKS + 8 * sch) * 2; LAS unsigned char* vdst = lds + ATT_VB + (srow * AKS + 8 * sch) * 2;
    u32x4 kr = *(const u32x4*)(kg + (size_t)(NT - 1) * 64 * NU), vr = *(const u32x4*)(vg + (NT - 1) * 64); float fr = tid < 64 ? F[(NT - 1) * 64 + tid] : 0.f;
    *(LAS u32x4*)kdst = kr; *(LAS u32x4*)vdst = vr; if (tid < 64) ((LAS float*)(lds + ATT_FB))[tid] = fr;
    __syncthreads();
    const int ka = krow(li);
    float qkb; { float q2 = qmx[0];
#pragma unroll
      for (int w = 1; w < 8; ++w) q2 = fmaxf(q2, qmx[w]);
      qkb = 1.02f * sqrtf(q2 * kmax2) + fq0; }
    for (int t = NT - 1, buf = 0; t >= 0; --t, buf ^= 1) {
        { float mmin = mmv[0];
#pragma unroll
          for (int w = 1; w < 8; ++w) mmin = fminf(mmin, mmv[w]);
          if (qkb - ((const LAS float*)(lds + ATT_FB))[buf * 64 + 63] < mmin - 40.f) break; }
        if (t > 0) { kr = *(const u32x4*)(kg + (size_t)(t - 1) * 64 * NU); vr = *(const u32x4*)(vg + (t - 1) * 64); if (tid < 64) fr = F[(t - 1) * 64 + tid]; }
        if (64 * t <= q0 + wave * 32 + 31) {
            const LAS bf16_t* Kb = (const LAS bf16_t*)(lds + ATT_KB) + buf * 64 * AKS; const LAS bf16_t* Vb = (const LAS bf16_t*)(lds + ATT_VB) + buf * 64 * AKS; const LAS float* Fb = (const LAS float*)(lds + ATT_FB) + buf * 64;
            f32x16 p0, p1;
#pragma unroll
            for (int g2 = 0; g2 < 2; ++g2) { const f32x4 a = *(const LAS f32x4*)(Fb + 8 * hi + 16 * g2), b = *(const LAS f32x4*)(Fb + 8 * hi + 16 * g2 + 4), c = *(const LAS f32x4*)(Fb + 32 + 8 * hi + 16 * g2), d = *(const LAS f32x4*)(Fb + 32 + 8 * hi + 16 * g2 + 4);
#pragma unroll
                for (int e = 0; e < 4; ++e) { p0[8 * g2 + e] = fq - a[e]; p0[8 * g2 + 4 + e] = fq - b[e]; p1[8 * g2 + e] = fq - c[e]; p1[8 * g2 + 4 + e] = fq - d[e]; } }
#pragma unroll
            for (int d0 = 0; d0 < 4; ++d0) { const bf16x8 a0 = *(const LAS bf16x8*)(Kb + ka * AKS + 16 * d0 + 8 * hi), a1 = *(const LAS bf16x8*)(Kb + (ka + 32) * AKS + 16 * d0 + 8 * hi);
                p0 = __builtin_amdgcn_mfma_f32_32x32x16_bf16(a0, qf[d0], p0, 0, 0, 0); p1 = __builtin_amdgcn_mfma_f32_32x32x16_bf16(a1, qf[d0], p1, 0, 0, 0); }
            if (64 * t + 63 > q0 + wave * 32) {
#pragma unroll
                for (int r = 0; r < 16; ++r) { const int kv = 64 * t + 8 * hi + 16 * (r >> 3) + (r & 7); if (kv > q) p0[r] = -INFINITY; if (kv + 32 > q) p1[r] = -INFINITY; } }
            bf16x8 pb[4];
            softmax_tile<false>(p0, p1, m, lsum, O, pb);
#pragma unroll
            for (int dt = 0; dt < 2; ++dt)
#pragma unroll
                for (int s = 0; s < 4; ++s) { const bf16x8 a = *(const LAS bf16x8*)(Vb + (32 * dt + li) * AKS + 16 * (s & 1) + 32 * (s >> 1) + 8 * hi);
                    O[dt] = __builtin_amdgcn_mfma_f32_32x32x16_bf16(a, pb[s], O[dt], 0, 0, 0); }
        }
        { const float wm = wave_min(m); if (lane == 0) mmv[wave] = wm; }
        if (t > 0) { const int nb = buf ^ 1; *(LAS u32x4*)(kdst + nb * 64 * AKS * 2) = kr; *(LAS u32x4*)(vdst + nb * 64 * AKS * 2) = vr; if (tid < 64) ((LAS float*)(lds + ATT_FB))[nb * 64 + tid] = fr; }
        __syncthreads();
    }
    __syncthreads();
    const float inv = 1.f / xhalf_sum(lsum);
    bf16_t* ob = (bf16_t*)(p->ws + WS_OCAT) + (size_t)1 * NTOK * 512 + (size_t)q * 512 + h * 64;
#pragma unroll
    for (int dt = 0; dt < 2; ++dt)
#pragma unroll
        for (int rg = 0; rg < 4; ++rg) { const int d = 32 * dt + 8 * rg + 4 * hi; const u32x2 sg = *(const u32x2*)(U + (size_t)q * NU + U_BSG + h * 64 + d);
            u32x2 w; w.x = cvt_pk_bf16(O[dt][rg * 4] * inv * siluf_(bflo(sg.x)), O[dt][rg * 4 + 1] * inv * siluf_(bfhi(sg.x))); w.y = cvt_pk_bf16(O[dt][rg * 4 + 2] * inv * siluf_(bflo(sg.y)), O[dt][rg * 4 + 3] * inv * siluf_(bfhi(sg.y)));
            *(u32x2*)(ob + d) = w; }
}
__device__ __forceinline__ void attn_sample_unit(KP p, int l, int b, int h, LAS unsigned char* lds, int tid) {
    const bf16_t* U = (const bf16_t*)(p->ws + WS_U);
    const int wave = tid >> 6, lane = tid & 63, li = lane & 31, hi = lane >> 5;
    const size_t qrow = (size_t)TP + b * 32 + li;
    const float* G = (const float*)(p->ws + WS_GS) + ((size_t)b * 8 + h) * GS_LEN;
    bf16x8 qf[4];
    { const float sc = 0.125f * LOG2E;
#pragma unroll
      for (int d0 = 0; d0 < 4; ++d0) { const u32x4 w = *(const u32x4*)(U + qrow * NU + U_Q + h * 64 + 16 * d0 + 8 * hi);
          qf[d0] = pack8f((f32x4){bflo(w.x) * sc, bfhi(w.x) * sc, bflo(w.y) * sc, bfhi(w.y) * sc}, (f32x4){bflo(w.z) * sc, bfhi(w.z) * sc, bflo(w.w) * sc, bfhi(w.w) * sc}); } }
    const float fq = G[PAST + li];
    float m = ATT_NEG, lsum = 0.f; f32x16 O[2] = {};
    const float* CK = p->in[I_CK] + (((size_t)l * 32 + b) * PAST) * 512 + h * 64; const float* CV = p->in[I_CV] + (((size_t)l * 32 + b) * PAST) * 512 + h * 64;
    const int ka = krow(li);
    for (int tt = 0; tt < 8; ++tt) {
        const int key0 = (wave * 8 + tt) * 64;
        f32x16 p0, p1;
#pragma unroll
        for (int g2 = 0; g2 < 2; ++g2) { const float* gp = G + key0 + 8 * hi + 16 * g2; const f32x4 a = *(const f32x4*)gp, bq = *(const f32x4*)(gp + 4), c = *(const f32x4*)(gp + 32), d = *(const f32x4*)(gp + 36);
#pragma unroll
            for (int e = 0; e < 4; ++e) { p0[8 * g2 + e] = fq - a[e]; p0[8 * g2 + 4 + e] = fq - bq[e]; p1[8 * g2 + e] = fq - c[e]; p1[8 * g2 + 4 + e] = fq - d[e]; } }
#pragma unroll
        for (int d0 = 0; d0 < 4; ++d0) { const float* k0p = CK + (size_t)(key0 + ka) * 512 + 16 * d0 + 8 * hi; const float* k1p = k0p + (size_t)32 * 512;
            const bf16x8 a0 = pack8f(*(const f32x4*)k0p, *(const f32x4*)(k0p + 4)), a1 = pack8f(*(const f32x4*)k1p, *(const f32x4*)(k1p + 4));
            p0 = __builtin_amdgcn_mfma_f32_32x32x16_bf16(a0, qf[d0], p0, 0, 0, 0); p1 = __builtin_amdgcn_mfma_f32_32x32x16_bf16(a1, qf[d0], p1, 0, 0, 0); }
        bf16x8 pb[4];
        softmax_tile<false>(p0, p1, m, lsum, O, pb);
#pragma unroll
        for (int dt = 0; dt < 2; ++dt)
#pragma unroll
            for (int s = 0; s < 4; ++s) { const float* vp = CV + (size_t)(key0 + 16 * (s & 1) + 32 * (s >> 1) + 8 * hi) * 512 + 32 * dt + li;
                const bf16x8 a = pack8f((f32x4){vp[0], vp[512], vp[1024], vp[1536]}, (f32x4){vp[2048], vp[2560], vp[3072], vp[3584]});
                O[dt] = __builtin_amdgcn_mfma_f32_32x32x16_bf16(a, pb[s], O[dt], 0, 0, 0); }
    }
    if (wave == 7) {
        f32x16 p0, p1 = {};
#pragma unroll
        for (int g2 = 0; g2 < 2; ++g2) { const float* gp = G + PAST + 8 * hi + 16 * g2; const f32x4 a = *(const f32x4*)gp, bq = *(const f32x4*)(gp + 4);
#pragma unroll
            for (int e = 0; e < 4; ++e) { p0[8 * g2 + e] = fq - a[e]; p0[8 * g2 + 4 + e] = fq - bq[e]; } }
#pragma unroll
        for (int d0 = 0; d0 < 4; ++d0) { const bf16x8 a0 = *(const bf16x8*)(U + ((size_t)TP + b * 32 + ka) * NU + U_K + h * 64 + 16 * d0 + 8 * hi);
            p0 = __builtin_amdgcn_mfma_f32_32x32x16_bf16(a0, qf[d0], p0, 0, 0, 0); }
#pragma unroll
        for (int r = 0; r < 16; ++r) { const int kv = 8 * hi + 16 * (r >> 3) + (r & 7); if (kv > li) p0[r] = -INFINITY; }
        bf16x8 pb[4];
        softmax_tile<true>(p0, p1, m, lsum, O, pb);
#pragma unroll
        for (int dt = 0; dt < 2; ++dt)
#pragma unroll
            for (int s = 0; s < 2; ++s) { const bf16_t* vp = U + ((size_t)TP + b * 32 + 16 * s + 8 * hi) * NU + U_V + h * 64 + 32 * dt + li; u32x4 w;
                w.x = (unsigned)vp[0] | ((unsigned)vp[NU] << 16); w.y = (unsigned)vp[2 * NU] | ((unsigned)vp[3 * NU] << 16); w.z = (unsigned)vp[4 * NU] | ((unsigned)vp[5 * NU] << 16); w.w = (unsigned)vp[6 * NU] | ((unsigned)vp[7 * NU] << 16);
                O[dt] = __builtin_amdgcn_mfma_f32_32x32x16_bf16(__builtin_bit_cast(bf16x8, w), pb[s], O[dt], 0, 0, 0); }
    }
    LAS float* Ow = (LAS float*)lds;
    LAS float* ML = Ow + 8 * 32 * 64;
    lsum = xhalf_sum(lsum);
#pragma unroll
    for (int dt = 0; dt < 2; ++dt)
#pragma unroll
        for (int r = 0; r < 16; ++r) Ow[(wave * 32 + dt * 16 + r) * 64 + lane] = O[dt][r];
    if (hi == 0) { ML[(wave * 2) * 32 + li] = m; ML[(wave * 2 + 1) * 32 + li] = lsum; }
    __syncthreads();
    { const int qq = tid & 31, dg = tid >> 5; float M = ATT_NEG;
#pragma unroll
      for (int w = 0; w < 8; ++w) M = fmaxf(M, ML[(w * 2) * 32 + qq]);
      float L = 0.f; f32x4 o = {0.f, 0.f, 0.f, 0.f};
      const int d = 4 * dg, idx0 = (d >> 5) * 16 + ((d >> 3) & 3) * 4, ln = ((d >> 2) & 1) * 32 + qq;
#pragma unroll
      for (int w = 0; w < 8; ++w) { const float f = __builtin_amdgcn_exp2f(ML[(w * 2) * 32 + qq] - M); L += ML[(w * 2 + 1) * 32 + qq] * f;
#pragma unroll
          for (int e = 0; e < 4; ++e) o[e] += Ow[(w * 32 + idx0 + e) * 64 + ln] * f; }
      const float inv = 1.f / L; const size_t row = (size_t)TP + b * 32 + qq;
      const u32x2 sg = *(const u32x2*)(U + row * NU + U_BSG + h * 64 + d);
      u32x2 wv; wv.x = cvt_pk_bf16(o[0] * inv * siluf_(bflo(sg.x)), o[1] * inv * siluf_(bfhi(sg.x))); wv.y = cvt_pk_bf16(o[2] * inv * siluf_(bflo(sg.y)), o[3] * inv * siluf_(bfhi(sg.y)));
      *(u32x2*)((bf16_t*)(p->ws + WS_OCAT) + (size_t)1 * NTOK * 512 + row * 512 + h * 64 + d) = wv; }
    __syncthreads();
}
constexpr int NPHASE = 22;
__global__ void __launch_bounds__(512, 2) hse_fwd(Params p_) {
    const KP kp = (KP)__builtin_amdgcn_kernarg_segment_ptr();
    (void)p_;
    extern __shared__ __attribute__((aligned(16))) unsigned char lds_raw[];
    LAS unsigned char* lds = (LAS unsigned char*)lds_raw;
    const int tid0 = threadIdx.x;
    const int G = gridDim.x, bid = blockIdx.x, ngw = G * 8;
#define PH_LOCALS const KP p = kp_fresh(kp); int tid = tid0; asm volatile("" : "+v"(tid)); const int lane = tid & 63, wave = __builtin_amdgcn_readfirstlane(tid >> 6), gw = bid * 8 + wave; (void)lane; (void)gw; (void)p;
    if (tid0 < 4) ((LAS unsigned*)(lds + LDS_XB_OFF))[tid0] = 0u;
    __syncthreads();
    unsigned* ctl = (unsigned*)(kp->ws + WS_CTL);
    XcdBarrier bar = xcd_barrier_post(ctl + CW_BAR + kp->li * XCD_BAR_WORDS, (volatile LAS unsigned*)(lds + LDS_XB_OFF));
    const int lo = kp->ph_lo, hi = kp->ph_hi;
#define IN(k) (lo <= (k) && (k) < hi)
#ifndef DUP_MASK
#define DUP_MASK 0
#endif
#define NREP(k) (((DUP_MASK >> (k)) & 1) + 1)
#define SEAM(k) do { if (IN(k) && IN((k) + 1)) xcd_barrier(bar); } while (0)
    if (IN(0)) { PH_LOCALS
        for (int u = bid; u < 192; u += G) ada_unit(p, u, lds, tid);
        p0_weights(p, lds, gw, ngw, wave, lane);
    }
    SEAM(0);
    for (int l = 0; l < NLAYER; ++l) {
        const int pb = 1 + 10 * l;
        for (int rep = 0; rep < NREP(0); ++rep) { if (rep) xcd_barrier(bar);
        if (IN(pb)) { PH_LOCALS p1_rows(p, l, gw, ngw, lane); } }
        SEAM(pb);
        for (int rep = 0; rep < NREP(1); ++rep) { if (rep) xcd_barrier(bar);
        if (IN(pb + 1)) { PH_LOCALS
            pg8::Gemm g{(const bf16_t*)(p->ws + WS_H), (const bf16_t*)(p->ws + WS_WIN) + (size_t)l * NU * 2048, NTOK, NU, 2048};
            pg8::StaticOrder S; S.init(NTOK, NU, G, bid);
            EpiU E{(bf16_t*)(p->ws + WS_U), p->out, p->in[I_BF], l};
            pg8::gemm_phase<EpiU, pg8::StaticOrder>(lds, g, S, E, nullptr);
        }
        }
        SEAM(pb + 1);
        for (int rep = 0; rep < NREP(2); ++rep) { if (rep) xcd_barrier(bar);
        if (IN(pb + 2)) { PH_LOCALS
#ifndef DUP_SUB
#define DUP_SUB 0
#endif
            for (int u = bid; u < NRU * ((DUP_SUB & 1) + 1); u += G) rwkv_r1(p, l, u % NRU, lds, tid);
            for (int u = bid; u < 544 * (((DUP_SUB >> 1) & 1) + 1); u += G) conv_unit(p, l, u % 544, lds, tid);
            for (int u = bid; u < 544 * (((DUP_SUB >> 2) & 1) + 1); u += G) pool_unit(p, l, u % 544, lds, tid);
            for (int u = bid; u < 256; u += G) { vt_tile(p, l, u * 8 + wave, lds, wave, lane); }
            __syncthreads();
            for (int u = bid; u < 32; u += G) gs_unit(p, l, u, lds, tid);
            for (int u = G - 1 - bid; u < 8; u += G) fp_unit(p, l, u, lds, tid);
            if (bid == G / 2) shift_out(p, l, tid);
        }
        }
        SEAM(pb + 2);
        for (int rep = 0; rep < NREP(3); ++rep) { if (rep) xcd_barrier(bar);
        if (IN(pb + 3)) { PH_LOCALS
            if (wave < 4) for (int tk = bid * 4 + wave; tk < 1024; tk += G * 4) rwkv_l1_task(p, tk, lane);
            __syncthreads();
            LAS int* qslot = (LAS int*)(lds + LDS_XB_OFF - 16);
            for (;;) {
                if (tid == 0) *qslot = (int)atomicAdd(ctl + CW_QUEUE + 64 * (2 * l + 4 * rep), 1u);
                __syncthreads();
                const int item = *qslot;
                __syncthreads();
                if (item >= 512) break;
                attn_prompt_unit(p, l, item & 7, 63 - (item >> 3), lds, tid);
            }
            for (;;) {
                if (tid == 0) *qslot = (int)atomicAdd(ctl + CW_QUEUE + 64 * (2 * l + 1 + 4 * rep), 1u);
                __syncthreads();
                const int item = *qslot;
                __syncthreads();
                if (item >= 256) break;
                attn_sample_unit(p, l, item >> 3, item & 7, lds, tid);
            }
        }
        }
        SEAM(pb + 3);
        if (IN(pb + 4)) { PH_LOCALS if (wave == 0 && bid < 32) rwkv_l2_task(p, l, bid, lane); }
        SEAM(pb + 4);
        if (IN(pb + 5)) { PH_LOCALS for (int tk = (wave * G + bid); tk < 512 + 1024; tk += ngw) rwkv_l3_task(p, l, tk, lane); }
        SEAM(pb + 5);
        if (IN(pb + 6)) { PH_LOCALS for (int tk = gw; tk < NRU * 2; tk += ngw) rwkv_r3_task(p, l, tk, lane); }
        SEAM(pb + 6);
        for (int rep = 0; rep < NREP(7); ++rep) { if (rep) xcd_barrier(bar);
        if (IN(pb + 7)) { PH_LOCALS
            pg8::Gemm g{(const bf16_t*)(p->ws + WS_OCAT), (const bf16_t*)(p->ws + WS_WBR) + (size_t)l * 4 * 2048 * 512, 4 * NTOK, 4 * 2048, 512};
            BranchOrder S{G, bid};
            EpiZ E{(bf16_t*)(p->ws + WS_Z)};
            pg8::gemm_phase<EpiZ, BranchOrder>(lds, g, S, E, nullptr);
        }
        }
        SEAM(pb + 7);
        if (IN(pb + 8)) { PH_LOCALS merge_pass(p, bid * 512 + tid, G * 512); }
        SEAM(pb + 8);
        if (IN(pb + 9)) { PH_LOCALS
            pg8::Gemm g{(const bf16_t*)(p->ws + WS_MERGED), (const bf16_t*)(p->ws + WS_WOUT) + (size_t)l * 2048 * 2048, NTOK, 2048, 2048};
            pg8::StaticOrder S; S.init(NTOK, 2048, G, bid);
            EpiOut E{p->in[I_XP], p->in[I_XS], (const float*)(p->ws + WS_XBUF), (const float*)(p->ws + WS_ADA), (float*)(p->ws + WS_XBUF), l};
            pg8::gemm_phase<EpiOut, pg8::StaticOrder>(lds, g, S, E, nullptr);
        }
        SEAM(pb + 9);
    }
    if (IN(21)) { PH_LOCALS p_final_rows(p, gw, ngw, lane); }
#undef IN
#undef SEAM
}
#ifndef MK_SPLIT
#define MK_SPLIT 0
#endif
extern "C" void kernel_launch(void* const* d_in, const int* in_sizes, int n_in, void* d_out, int out_size, void* d_ws, size_t ws_size, hipStream_t stream) {
    static int grid = 0;
    if (grid == 0) {
        if (n_in != N_IN || (size_t)out_size != O_END || ws_size < WS_END) { fprintf(stderr, "kernel_launch: unexpected shapes (n_in %d, out %d, ws %zu)\n", n_in, out_size, ws_size); grid = -1; return; }
        int dev = 0, cus = 0, per_cu = 0;
        if (hipGetDevice(&dev) != hipSuccess || hipDeviceGetAttribute(&cus, hipDeviceAttributeMultiprocessorCount, dev) != hipSuccess) { grid = -1; return; }
        if (hipFuncSetAttribute((const void*)hse_fwd, hipFuncAttributeMaxDynamicSharedMemorySize, LDS_BYTES) != hipSuccess) { fprintf(stderr, "kernel_launch: hipFuncSetAttribute failed\n"); grid = -1; return; }
        if (hipOccupancyMaxActiveBlocksPerMultiprocessor(&per_cu, (const void*)hse_fwd, 512, LDS_BYTES) != hipSuccess || per_cu < 1) fprintf(stderr, "kernel_launch: occupancy query reports %d\n", per_cu);
        (void)hipGetLastError();
        grid = cus;
    }
    if (grid < 0) return;
    if (hipMemsetAsync((char*)d_ws + WS_CTL, 0, CTL_BYTES, stream) != hipSuccess) return;
    Params a{};
    for (int i = 0; i < N_IN; ++i) a.in[i] = (const float*)d_in[i];
    a.out = (float*)d_out; a.ws = (unsigned char*)d_ws;
#if MK_SPLIT
    for (int ph = 0; ph < NPHASE; ++ph) { a.ph_lo = ph; a.ph_hi = ph + 1; a.li = ph; hipLaunchKernelGGL(hse_fwd, dim3(grid), dim3(512), LDS_BYTES, stream, a); }
#else
    a.ph_lo = 0; a.ph_hi = NPHASE; a.li = 0;
    hipLaunchKernelGGL(hse_fwd, dim3(grid), dim3(512), LDS_BYTES, stream, a);
#endif
    const hipError_t le = hipPeekAtLastError();
    if (le != hipSuccess) fprintf(stderr, "kernel_launch: launch failed: %s\n", hipGetErrorName(le));
}
```

```cpp
#include <hip/hip_runtime.h>
#include <cstdio>
#include <cstdint>
namespace pg8 {
#define PG8_LAS __attribute__((address_space(3)))
typedef unsigned short bf16_t;
typedef short bf16x8 __attribute__((ext_vector_type(8)));
typedef float f32x4 __attribute__((ext_vector_type(4)));
typedef unsigned u32x4 __attribute__((ext_vector_type(4)));
constexpr int BM = 256, BK = 64, HALF = 128, HTB = HALF * BK * 2  , STAGE_BYTES = 8 * HTB, NXCD = 8, WGM = 8;

__host__ __device__ __forceinline__ int lds_byte(int r, int c) { const int st = (r >> 4) * 2 + (c >> 5), rr = r & 15, cc = c & 31, ob = rr * 64 + cc * 2; return st * 1024 + (ob ^ (((ob >> 9) & 1) << 5)); }
__host__ __device__ __forceinline__ void stage_rc(int b, int& R, int& C) { const int st = b / 1024, sb = b % 1024, swz = sb ^ (((sb >> 9) & 1) << 5); R = (st >> 1) * 16 + swz / 64; C = (st & 1) * 32 + (swz % 64) / 2; }
__host__ __device__ __forceinline__ int perm32(int rho) { const int n = rho >> 4, i = rho & 15; return 8 * (i >> 2) + 4 * n + (i & 3); }

struct Unit { int pm, pn; };
struct Gemm { const bf16_t* A; const bf16_t* Bt; int M, N, K; };

struct StaticOrder {
    int nM, nN, nwg, G, c;
    __host__ __device__ void init(int M, int N, int G_, int c_) { nM = M / BM; nN = N / BM; nwg = nM * nN; G = G_; c = c_; }
    __host__ __device__ bool next(int i, Unit& u) const {
        const long L = (long)i * G + c; if (L >= nwg) return false;
        int wgid = (int)L; { const int q = nwg / NXCD, r = nwg % NXCD, xcd = wgid % NXCD, off = wgid / NXCD; wgid = (xcd < r ? xcd * (q + 1) : r * (q + 1) + (xcd - r) * q) + off; }
        const int nig = WGM * nN, gid = wgid / nig, fm = gid * WGM, gsz = (nM - fm) < WGM ? (nM - fm) : WGM;
        u.pm = fm + ((wgid % nig) % gsz); u.pn = (wgid % nig) / gsz; return true;
    }
    __device__ __forceinline__ void a_ready(const Unit&) const {}
    __device__ __forceinline__ void done(const Unit&) const {}
};
__device__ __forceinline__ unsigned cvt_pk_bf16(float lo, float hi) { unsigned r; asm volatile("v_cvt_pk_bf16_f32 %0, %1, %2" : "=v"(r) : "v"(lo), "v"(hi)); return r; }
typedef float f32x2 __attribute__((ext_vector_type(2)));
template <class Epi, class Sched, bool STAMP = false>
__device__ __forceinline__ void gemm_phase(PG8_LAS unsigned char* lds, const Gemm g, const Sched& S, const Epi& E, unsigned long long* stamps) {
    int tid = threadIdx.x; asm volatile("" : "+v"(tid));
    const int wid = __builtin_amdgcn_readfirstlane(tid >> 6), lane = tid & 63, wr = wid >> 2, wc = wid & 3, fr = lane & 15, fq = lane >> 4;
    const int K = g.K, nt = K / BK;
    int ts_lo = 0, ts_hi = 0, nts = 0; const unsigned long long rt_entry = STAMP ? (unsigned long long)wall_clock64() : 0ull;
#define PG8_STAMP() do { if (STAMP && wid == 0 && nts < 64) { const unsigned long long _c = (unsigned long long)clock64(); \
        ts_lo = (lane == nts) ? (int)(unsigned)_c : ts_lo; ts_hi = (lane == nts) ? (int)(unsigned)(_c >> 32) : ts_hi; ++nts; } } while (0)
    PG8_STAMP();
    unsigned voffA[2], voffB[2];
#pragma unroll
    for (int i = 0; i < 2; ++i) { int R, C; stage_rc(tid * 16 + i * 8192, R, C); const int Rb = Epi::PERM ? ((R & ~31) + perm32(R & 31)) : R;
        voffA[i] = (unsigned)(R * K + C) * 2u; voffB[i] = (unsigned)(Rb * K + C) * 2u; }
    const size_t kstep = (size_t)(BK * 2);
    const size_t hstep = (size_t)HALF * K * 2;
    const size_t tstep = 2 * hstep;
    const unsigned ldsw = (unsigned)wid * 1024u;
    const int aoff = lds_byte(wr * 64 + fr, fq * 8), boff = lds_byte(wc * 32 + fr, fq * 8);
#define PG8_SA(b, h) (((b) * 2 + (h)) * HTB)
#define PG8_SB(b, h) ((4 + (b) * 2 + (h)) * HTB)
#define PG8_STAGE(bufoff, gbase, voff) do { _Pragma("unroll") for (int _i = 0; _i < 2; ++_i) \
        __builtin_amdgcn_global_load_lds((const unsigned*)((const char*)(gbase) + (voff)[_i]), (PG8_LAS unsigned*)(lds + (bufoff) + ldsw + _i * 8192), 16, 0, 0); } while (0)
#define PG8_LDA(dst, b, h) do { _Pragma("unroll") for (int m = 0; m < 4; ++m) _Pragma("unroll") for (int k = 0; k < 2; ++k) dst[m][k] = *(const PG8_LAS bf16x8*)(lds + PG8_SA(b, h) + aoff + m * 2048 + k * 1024); } while (0)
#define PG8_LDB(dst, b, h) do { _Pragma("unroll") for (int n = 0; n < 2; ++n) _Pragma("unroll") for (int k = 0; k < 2; ++k) dst[n][k] = *(const PG8_LAS bf16x8*)(lds + PG8_SB(b, h) + boff + n * 2048 + k * 1024); } while (0)
#define PG8_MMA(ai, bj, At, Bt) do { __builtin_amdgcn_s_setprio(1); _Pragma("unroll") for (int m = 0; m < 4; ++m) _Pragma("unroll") for (int n = 0; n < 2; ++n) _Pragma("unroll") for (int k = 0; k < 2; ++k) \
        acc[ai][bj][m][n] = __builtin_amdgcn_mfma_f32_16x16x32_bf16(Bt[n][k], At[m][k], acc[ai][bj][m][n], 0, 0, 0); __builtin_amdgcn_s_setprio(0); } while (0)
#define PG8_WAIT_V(n) asm volatile("s_waitcnt vmcnt(" #n ")" ::: "memory")
#define PG8_WAIT_L(n) asm volatile("s_waitcnt lgkmcnt(" #n ")" ::: "memory")
#define PG8_BAR __builtin_amdgcn_s_barrier()
#define PG8_SCHED __builtin_amdgcn_sched_barrier(0)
    Unit cur, nxt; int ui = 0;
    if (!S.next(0, cur)) return;
    f32x4 acc[2][2][4][2];
#pragma unroll
    for (int a = 0; a < 2; ++a)
#pragma unroll
        for (int b = 0; b < 2; ++b)
#pragma unroll
            for (int m = 0; m < 4; ++m)
#pragma unroll
                for (int n = 0; n < 2; ++n) acc[a][b][m][n] = (f32x4){0.f, 0.f, 0.f, 0.f};
    bf16x8 At[4][2], B0[2][2], B1[2][2];
    const char* cA = (const char*)g.A + (size_t)cur.pm * tstep; const char* cB = (const char*)g.Bt + (size_t)cur.pn * tstep;
    S.a_ready(cur);
    PG8_STAGE(PG8_SB(0, 0), cB, voffB); PG8_STAGE(PG8_SA(0, 0), cA, voffA); PG8_STAGE(PG8_SB(0, 1), cB + hstep, voffB); PG8_STAGE(PG8_SA(0, 1), cA + hstep, voffA);
    if (wr == 1) PG8_BAR;
    PG8_WAIT_V(4); PG8_BAR;
    PG8_STAGE(PG8_SB(1, 0), cB + kstep, voffB); PG8_STAGE(PG8_SA(1, 0), cA + kstep, voffA); PG8_STAGE(PG8_SB(1, 1), cB + hstep + kstep, voffB);
    PG8_WAIT_V(6); PG8_BAR;
    PG8_STAMP();
    for (;;) {
        const bool has_next = S.next(ui + 1, nxt);
        const char* nA = has_next ? (const char*)g.A + (size_t)nxt.pm * tstep : cA; const char* nB = has_next ? (const char*)g.Bt + (size_t)nxt.pn * tstep : cB;
        for (int t = 0; t < nt; t += 2) {
            const bool last = (t == nt - 2);
            const char* a1 = cA + (size_t)(t + 1) * kstep;
            const char* a2 = last ? nA : cA + (size_t)(t + 2) * kstep; const char* b2 = last ? nB : cB + (size_t)(t + 2) * kstep;
            const char* a3 = a2 + kstep; const char* b3 = b2 + kstep;
            if (last && has_next) S.a_ready(nxt);
            PG8_LDB(B0, 0, 0); PG8_SCHED; PG8_LDA(At, 0, 0); PG8_STAGE(PG8_SA(1, 1), a1 + hstep, voffA);
            PG8_WAIT_L(8); PG8_BAR; PG8_WAIT_L(0); PG8_MMA(0, 0, At, B0); PG8_BAR; PG8_SCHED;
            PG8_LDB(B1, 0, 1); PG8_STAGE(PG8_SB(0, 0), b2, voffB);
            PG8_BAR; PG8_WAIT_L(0); PG8_MMA(0, 1, At, B1); PG8_BAR;
            PG8_LDA(At, 0, 1); PG8_STAGE(PG8_SA(0, 0), a2, voffA);
            PG8_BAR; PG8_WAIT_L(0); PG8_MMA(1, 0, At, B0); PG8_BAR; PG8_SCHED;
            PG8_STAGE(PG8_SB(0, 1), b2 + hstep, voffB);
            PG8_WAIT_V(6); PG8_BAR; PG8_MMA(1, 1, At, B1); PG8_BAR;
            PG8_LDB(B0, 1, 0); PG8_SCHED; PG8_LDA(At, 1, 0); PG8_STAGE(PG8_SA(0, 1), a2 + hstep, voffA);
            PG8_WAIT_L(8); PG8_BAR; PG8_WAIT_L(0); PG8_MMA(0, 0, At, B0); PG8_BAR; PG8_SCHED;
            PG8_LDB(B1, 1, 1); PG8_STAGE(PG8_SB(1, 0), b3, voffB);
            PG8_BAR; PG8_WAIT_L(0); PG8_MMA(0, 1, At, B1); PG8_BAR;
            PG8_LDA(At, 1, 1); PG8_STAGE(PG8_SA(1, 0), a3, voffA);
            PG8_BAR; PG8_WAIT_L(0); PG8_MMA(1, 0, At, B0); PG8_BAR; PG8_SCHED;
            PG8_STAGE(PG8_SB(1, 1), b3 + hstep, voffB);
            PG8_WAIT_V(6); PG8_BAR; PG8_MMA(1, 1, At, B1); PG8_BAR;
        }
        PG8_STAMP();
        if constexpr (!Epi::AFTER_DRAIN) { E(acc, cur, wr, wc, fr, fq); S.done(cur); }
        PG8_STAMP();
        if (!has_next) break;
#pragma unroll
        for (int a = 0; a < 2; ++a)
#pragma unroll
            for (int b = 0; b < 2; ++b)
#pragma unroll
                for (int m = 0; m < 4; ++m)
#pragma unroll
                    for (int n = 0; n < 2; ++n) acc[a][b][m][n] = (f32x4){0.f, 0.f, 0.f, 0.f};
        cur = nxt; cA = nA; cB = nB; ++ui;
    }
    PG8_WAIT_V(0);
    if (wr == 0) PG8_BAR;
    PG8_BAR;
    if constexpr (Epi::AFTER_DRAIN) { E.fused(acc, cur, wr, wc, fr, fq, lds, wid, lane); S.done(cur); }
    PG8_STAMP();
    if (STAMP && wid == 0) { stamps[lane] = lane < nts ? (((unsigned long long)(unsigned)ts_hi << 32) | (unsigned)ts_lo) : 0ull;
        if (lane == 62) stamps[62] = rt_entry; if (lane == 63) stamps[63] = (unsigned long long)wall_clock64(); }
#undef PG8_STAMP
#undef PG8_SA
#undef PG8_SB
#undef PG8_STAGE
#undef PG8_LDA
#undef PG8_LDB
#undef PG8_MMA
#undef PG8_WAIT_V
#undef PG8_WAIT_L
#undef PG8_BAR
#undef PG8_SCHED
}
}
#define XB_TMO      128
#define XB_XCNT(j)  (256  + 64 * (j))
#define XB_XSUB(j)  (1280 + 64 * (j))
#define XB_XGEN(j)  (2304 + 64 * (j))
#define XB_TOP      3328
#define XB_TOPGEN   3392
#define XCD_BAR_WORDS 3456
#define XB_SPIN_CAP (1u << 18)
#define LAS __attribute__((address_space(3)))

__device__ __forceinline__ unsigned xb_ld(unsigned* p)              { return __hip_atomic_load(p, __ATOMIC_RELAXED, __HIP_MEMORY_SCOPE_AGENT); }
__device__ __forceinline__ unsigned xb_add(unsigned* p, unsigned v) { return __hip_atomic_fetch_add(p, v, __ATOMIC_RELAXED, __HIP_MEMORY_SCOPE_AGENT); }
__device__ __forceinline__ unsigned xb_xcc_id() { return (unsigned)__builtin_amdgcn_s_getreg((3 << 11) | 20) & 0xFu; }
#define XB_SPIN(cond, bar) do { unsigned _sp = 0; while (cond) { __builtin_amdgcn_s_sleep(1); \
    if ((++_sp & 255u) == 0u) { if (xb_ld(&(bar)[XB_TMO])) break; if (_sp > XB_SPIN_CAP) { atomicAdd(&(bar)[XB_TMO], 1u); break; } } } } while (0)

struct XcdBarrier {
    unsigned* bar; unsigned x;
    volatile LAS unsigned* st;
};

__device__ __forceinline__ XcdBarrier xcd_barrier_post(unsigned* bar, volatile LAS unsigned* st) {
    XcdBarrier b; b.bar = bar; b.x = xb_xcc_id(); b.st = st;
    if (threadIdx.x == 0) (void)xb_add(&bar[XB_XCNT(b.x)], 1u);
    return b;
}
__device__ __forceinline__ void xcd_barrier_complete(unsigned* bar, unsigned x, unsigned& nloc, unsigned& nx) {
    const unsigned G = gridDim.x * gridDim.y * gridDim.z;
    unsigned sum, cnt, mine, sp = 0u;
    for (;;) {
        sum = 0u; cnt = 0u; mine = 0u;
#pragma unroll
        for (unsigned j = 0; j < 16; ++j) { const unsigned c = xb_ld(&bar[XB_XCNT(j)]); sum += c; cnt += (c > 0u) ? 1u : 0u; mine = (j == x) ? c : mine; }
        if (sum == G) break;
        __builtin_amdgcn_s_sleep(1);
        if ((++sp & 255u) == 0u) { if (xb_ld(&bar[XB_TMO])) break; if (sp > XB_SPIN_CAP) { atomicAdd(&bar[XB_TMO], 1u); break; } }
    }
    nloc = mine > 0u ? mine : 1u; nx = cnt > 0u ? cnt : 1u;
}

__device__ __forceinline__ void xcd_barrier(const XcdBarrier& b) {
    asm volatile("s_waitcnt vmcnt(0)" ::: "memory");
    __syncthreads();
    if (threadIdx.x == 0) {
        unsigned* bar = b.bar;
        __builtin_amdgcn_s_waitcnt(0);
        unsigned nloc = b.st[0], nx = b.st[1];
        if (nloc == 0u) { xcd_barrier_complete(bar, b.x, nloc, nx); b.st[0] = nloc; b.st[1] = nx; }
        const unsigned old = xb_add(&bar[XB_XSUB(b.x)], 1u);
        const unsigned gen = old / nloc;
        if (old + 1u == (gen + 1u) * nloc) {
            __builtin_amdgcn_fence(__ATOMIC_RELEASE, "agent");
            asm volatile("s_waitcnt vmcnt(0)" ::: "memory");
            const unsigned og = xb_add(&bar[XB_TOP], 1u);
            const unsigned tg = og / nx;
            if (og + 1u == (tg + 1u) * nx) xb_add(&bar[XB_TOPGEN], 1u);
            else XB_SPIN(xb_ld(&bar[XB_TOPGEN]) == tg, bar);
            __builtin_amdgcn_fence(__ATOMIC_ACQUIRE, "agent");
            xb_add(&bar[XB_XGEN(b.x)], 1u);
            asm volatile("s_waitcnt vmcnt(0)" ::: "memory");
        } else {
            XB_SPIN(xb_ld(&bar[XB_XGEN(b.x)]) == gen, bar);
            __builtin_amdgcn_fence(__ATOMIC_ACQUIRE, "agent");
            asm volatile("s_waitcnt vmcnt(0)" ::: "memory");
        }
    }
    __syncthreads();
}
typedef unsigned short bf16_t;
typedef short bf16x8 __attribute__((ext_vector_type(8)));
typedef float f32x4 __attribute__((ext_vector_type(4)));
typedef float f32x16 __attribute__((ext_vector_type(16)));
typedef unsigned u32x4 __attribute__((ext_vector_type(4)));
typedef unsigned u32x2 __attribute__((ext_vector_type(2)));
using pg8::cvt_pk_bf16;

constexpr int DM = 2048, TP = 16384, NSB = 32, TSQ = 32, NTOK = TP + NSB * TSQ, NSEQ = 33, PAST = 4096, NLAYER = 2;
constexpr int NU = 15104;
constexpr int U_AVAL = 0, U_AGATE = 512, U_ASG = 1024, U_Q = 1536, U_K = 2048, U_V = 2560, U_BSG = 3072, U_XC = 3584, U_CSG = 5248, U_DIN = 5760, U_DSG = 6272, U_G = 6784, U_F = 14976;
constexpr int IN_W = 14984, SHIFT_W = 1664;
constexpr float LOG2E = 1.4426950408889634f;
enum { I_XP = 0, I_XS, I_CK, I_CV, I_CLF, I_SCONV, I_SSHIFT, I_SWKV, I_SPOOL, I_CP, I_CS, I_NORMG, I_WADA, I_BADA, I_WIN, I_BF, I_CONVW, I_CONVB, I_CLNG, I_CLNB, I_MU, I_W0, I_W2, I_A0, I_A2,
       I_KK, I_KA, I_RK, I_GNG, I_GNB, I_POOLW, I_POOLB, I_POOLS, I_WBR, I_WOUT, I_FING, N_IN };
constexpr size_t O_YP = 0, O_YS = O_YP + (size_t)TP * DM, O_PK = O_YS + (size_t)1024 * DM, O_PV = O_PK + (size_t)2 * TP * 512, O_PLF = O_PV + (size_t)2 * TP * 512, O_PCONV = O_PLF + (size_t)2 * TP * 8,
                 O_PSHIFT = O_PCONV + 2 * 30 * 512, O_PWKV = O_PSHIFT + 2 * 1664, O_PPOOL = O_PWKV + 2 * 8 * 64 * 64, O_SK = O_PPOOL + 2 * 15 * 512, O_SV = O_SK + (size_t)2 * 1024 * 512,
                 O_SLF = O_SV + (size_t)2 * 1024 * 512, O_SCONV = O_SLF + 2 * 1024 * 8, O_SSHIFT = O_SCONV + (size_t)2 * 32 * 30 * 512, O_SWKV = O_SSHIFT + 2 * 32 * 1664,
                 O_SPOOL = O_SWKV + (size_t)2 * 32 * 8 * 64 * 64, O_END = O_SPOOL + (size_t)2 * 32 * 15 * 512;
static_assert(O_END == 75374848, "output size");
constexpr size_t al256(size_t x) { return (x + 255) & ~(size_t)255; }
constexpr int NCU_CH = 288, NRU = NCU_CH * 8;
constexpr size_t WS_CTL = 0, CTL_BYTES = 512 * 1024;
constexpr size_t WS_WIN = CTL_BYTES;
constexpr size_t WS_WBR = al256(WS_WIN + (size_t)2 * NU * 2048 * 2);
constexpr size_t WS_WOUT = al256(WS_WBR + (size_t)2 * 4 * 2048 * 512 * 2);
constexpr size_t WS_POOLW = al256(WS_WOUT + (size_t)2 * 2048 * 2048 * 2);
constexpr size_t WS_ADA = al256(WS_POOLW + (size_t)2 * 4 * 128 * 128 * 2);
constexpr size_t WS_H = al256(WS_ADA + (size_t)2 * 33 * 6144 * 4);
constexpr size_t WS_U = al256(WS_H + (size_t)NTOK * 2048 * 2);
constexpr size_t WS_XBUF = al256(WS_U + (size_t)NTOK * NU * 2);
constexpr size_t WS_OCAT = al256(WS_XBUF + (size_t)NTOK * 2048 * 4);
constexpr size_t WS_Z = al256(WS_OCAT + (size_t)4 * NTOK * 512 * 2);
constexpr size_t WS_MERGED = al256(WS_Z + (size_t)4 * NTOK * 2048 * 2);
constexpr size_t WS_FP = al256(WS_MERGED + (size_t)NTOK * 2048 * 2);
constexpr int GS_LEN = PAST + TSQ;
constexpr size_t WS_GS = al256(WS_FP + (size_t)8 * TP * 4);
constexpr size_t WS_VT = al256(WS_GS + (size_t)32 * 8 * GS_LEN * 4);
constexpr size_t WS_TQ = al256(WS_VT + (size_t)8 * 64 * TP * 2);
constexpr size_t WS_GM = al256(WS_TQ + (size_t)NRU * 4096 * 4);
constexpr size_t WS_ET = al256(WS_GM + (size_t)NRU * 4096 * 4);
constexpr size_t WS_Y0T = al256(WS_ET + (size_t)NRU * 4096 * 4);
constexpr size_t WS_SC = al256(WS_Y0T + (size_t)NRU * 4096 * 4);
constexpr size_t WS_BONUS = al256(WS_SC + (size_t)NRU * 4096 * 4);
constexpr size_t WS_GG = al256(WS_BONUS + (size_t)NRU * 64 * 4);
constexpr size_t WS_TG = al256(WS_GG + (size_t)16 * 8 * 4096 * 4);
constexpr size_t WS_SG = al256(WS_TG + (size_t)16 * 8 * 4096 * 4);
constexpr size_t WS_END = al256(WS_SG + (size_t)16 * 8 * 4096 * 4);
static_assert(WS_END < (size_t)2100 * 1024 * 1024, "workspace map exceeds the guaranteed d_ws size");
constexpr int CW_BAR = 0;
constexpr int CW_QUEUE = 16 * 3456 + 64;
constexpr int CW_KMAX = CW_QUEUE + 64 * 8;
static_assert((CW_KMAX + 64) * 4 <= (int)CTL_BYTES, "ctl");
constexpr int LDS_BYTES = 163840 - 256;
constexpr int LDS_XB_OFF = LDS_BYTES - 16;
constexpr int SLOT_F = 64 * 65;

#ifndef PROBE_ID
#define PROBE_ID 0
#endif
#ifndef PROBE_K
#define PROBE_K 1
#endif
constexpr int LDS_PROBE_OFF = 163840 - 256 - 64;
#if PROBE_ID
#define PT0() unsigned long long _pt0 = (blockIdx.x == 0 && threadIdx.x == 0) ? __builtin_amdgcn_s_memrealtime() : 0ull
#define PT1(id) do { if ((id) == PROBE_ID && blockIdx.x == 0 && threadIdx.x == 0) { *(LAS unsigned long long*)(lds + LDS_PROBE_OFF) += __builtin_amdgcn_s_memrealtime() - _pt0; } _pt0 = (blockIdx.x == 0 && threadIdx.x == 0) ? __builtin_amdgcn_s_memrealtime() : 0ull; } while (0)
#else
#define PT0() do {} while (0)
#define PT1(id) do {} while (0)
#endif
struct Params { const float* in[N_IN]; float* out; unsigned char* ws; int ph_lo, ph_hi, li, pad; };
typedef const __attribute__((address_space(4))) Params* KP;
__device__ __forceinline__ KP kp_fresh(KP k) { asm volatile("" : "+s"(k)); return k; }

__device__ __forceinline__ float bf2f(unsigned short b) { return __uint_as_float(((unsigned)b) << 16); }
__device__ __forceinline__ float bflo(unsigned w) { return __uint_as_float(w << 16); }
__device__ __forceinline__ float bfhi(unsigned w) { return __uint_as_float(w & 0xffff0000u); }
__device__ __forceinline__ unsigned short f2bf(float f) { return (unsigned short)(cvt_pk_bf16(f, 0.f) & 0xffffu); }
__device__ __forceinline__ float sigmoidf_(float x) { return 1.f / (1.f + __expf(-x)); }
__device__ __forceinline__ float siluf_(float x) { return x / (1.f + __expf(-x)); }
__device__ __forceinline__ float log_sigmoidf_(float z) { return fminf(z, 0.f) - log1pf(expf(-fabsf(z))); }
template <int CTRL> __device__ __forceinline__ float dpp_mov(float v) { return __int_as_float(__builtin_amdgcn_update_dpp(0, __float_as_int(v), CTRL, 0xF, 0xF, true)); }
__device__ __forceinline__ float wave_sum(float v) {
    v += dpp_mov<0xB1>(v); v += dpp_mov<0x4E>(v); v += dpp_mov<0x141>(v); v += dpp_mov<0x140>(v);
    const float r0 = __int_as_float(__builtin_amdgcn_readlane(__float_as_int(v), 0)), r1 = __int_as_float(__builtin_amdgcn_readlane(__float_as_int(v), 16));
    const float r2 = __int_as_float(__builtin_amdgcn_readlane(__float_as_int(v), 32)), r3 = __int_as_float(__builtin_amdgcn_readlane(__float_as_int(v), 48));
    return (r0 + r1) + (r2 + r3);
}
__device__ __forceinline__ float wave_max(float v) {
    v = fmaxf(v, dpp_mov<0xB1>(v)); v = fmaxf(v, dpp_mov<0x4E>(v)); v = fmaxf(v, dpp_mov<0x141>(v)); v = fmaxf(v, dpp_mov<0x140>(v));
    const float r0 = __int_as_float(__builtin_amdgcn_readlane(__float_as_int(v), 0)), r1 = __int_as_float(__builtin_amdgcn_readlane(__float_as_int(v), 16));
    const float r2 = __int_as_float(__builtin_amdgcn_readlane(__float_as_int(v), 32)), r3 = __int_as_float(__builtin_amdgcn_readlane(__float_as_int(v), 48));
    return fmaxf(fmaxf(r0, r1), fmaxf(r2, r3));
}
__device__ __forceinline__ float wave_min(float v) { return -wave_max(-v); }
__device__ __forceinline__ float xhalf_max(float m) { const auto rr = __builtin_amdgcn_permlane32_swap(__float_as_uint(m), __float_as_uint(m), false, false); return fmaxf(__uint_as_float(rr[0]), __uint_as_float(rr[1])); }
__device__ __forceinline__ float xhalf_sum(float m) { const auto rr = __builtin_amdgcn_permlane32_swap(__float_as_uint(m), __float_as_uint(m), false, false); return __uint_as_float(rr[0]) + __uint_as_float(rr[1]); }
__device__ __forceinline__ bf16x8 pack8f(const f32x4 a, const f32x4 b) { u32x4 w; w.x = cvt_pk_bf16(a[0], a[1]); w.y = cvt_pk_bf16(a[2], a[3]); w.z = cvt_pk_bf16(b[0], b[1]); w.w = cvt_pk_bf16(b[2], b[3]); return __builtin_bit_cast(bf16x8, w); }
__device__ __forceinline__ float fast_tanh(float x) { const float e = __expf(-2.f * fabsf(x)); const float t = (1.f - e) * __builtin_amdgcn_rcpf(1.f + e); return x < 0.f ? -t : t; }
__device__ __forceinline__ void tr_tile(const float* __restrict__ src, size_t ld, int k0, int c0, int nvalid, bf16_t* __restrict__ dst, int K, LAS float* scr, int lane) {
#pragma unroll 8
    for (int kk = 0; kk < 64; ++kk) scr[kk * 65 + lane] = (lane < nvalid) ? src[(size_t)(k0 + kk) * ld + c0 + lane] : 0.f;
    const int k2 = (lane & 31) * 2, nh = lane >> 5;
#pragma unroll 8
    for (int it = 0; it < 32; ++it) { const int nn = 2 * it + nh; *(unsigned*)(dst + (size_t)nn * K + k0 + k2) = cvt_pk_bf16(scr[k2 * 65 + nn], scr[(k2 + 1) * 65 + nn]); }
}
__device__ __forceinline__ void p0_weights(KP p, LAS unsigned char* lds, int gw, int ngw, int wave, int lane) {
    LAS float* scr = (LAS float*)lds + wave * SLOT_F;
    constexpr int T_WIN = (NU / 64) * 32, T_WBR = 4 * 32 * 8, T_WOUT = 32 * 32, T_POOL = 4 * 2 * 2, T_L = T_WIN + T_WBR + T_WOUT + T_POOL;
    for (int it = gw; it < 2 * T_L; it += ngw) {
        const int l = it / T_L; int r = it % T_L;
        if (r < T_WIN) {
            const int nt = r / 32, kt = r % 32, m0 = nt * 64;
            int c0, nvalid = 64;
            if (m0 < 3072) c0 = m0; else if (m0 < U_F) c0 = m0 + 8; else if (m0 == U_F) { c0 = 3072; nvalid = 8; } else { c0 = 0; nvalid = 0; }
            tr_tile(p->in[I_WIN] + (size_t)l * 2048 * IN_W, IN_W, kt * 64, c0, nvalid, (bf16_t*)(p->ws + WS_WIN) + ((size_t)l * NU + m0) * 2048, 2048, scr, lane);
            continue; }
        r -= T_WIN;
        if (r < T_WBR) {
            const int n = r / 256, q = r % 256, nt = q / 8, kt = q % 8;
            tr_tile(p->in[I_WBR] + ((size_t)(l * 4 + n) * 512) * 2048, 2048, kt * 64, nt * 64, 64, (bf16_t*)(p->ws + WS_WBR) + ((size_t)(l * 4 + n) * 2048 + nt * 64) * 512, 512, scr, lane);
            continue; }
        r -= T_WBR;
        if (r < T_WOUT) {
            const int nt = r / 32, kt = r % 32;
            tr_tile(p->in[I_WOUT] + (size_t)l * 2048 * 2048, 2048, kt * 64, nt * 64, 64, (bf16_t*)(p->ws + WS_WOUT) + ((size_t)l * 2048 + nt * 64) * 2048, 2048, scr, lane);
            continue; }
        r -= T_WOUT;
        {
            const int g = r / 4, q = r % 4, nt = q / 2, kt = q % 2;
            tr_tile(p->in[I_POOLW] + (size_t)(l * 4 + g) * 128 * 128, 128, kt * 64, nt * 64, 64, (bf16_t*)(p->ws + WS_POOLW) + ((size_t)(l * 4 + g) * 128 + nt * 64) * 128, 128, scr, lane);
        }
    }
}
__device__ __forceinline__ void ada_unit(KP p, int unit, LAS unsigned char* lds, int tid) {
    const int wave = tid >> 6, lane = tid & 63, l = unit / 96, n0 = (unit % 96) * 64;
    LAS float* cs = (LAS float*)lds + wave * (33 * 64);
    LAS float* red = (LAS float*)lds + 8 * 33 * 64;
    const float* W = p->in[I_WADA] + (size_t)l * 2048 * 6144;
    const float* cp = p->in[I_CP]; const float* csm = p->in[I_CS];
    float acc[33];
#pragma unroll
    for (int s = 0; s < 33; ++s) acc[s] = 0.f;
    for (int ch = 0; ch < 4; ++ch) {
        const int k0 = wave * 256 + ch * 64;
#pragma unroll
        for (int s = 0; s < 33; ++s) { const float c = (s == 0) ? cp[k0 + lane] : csm[(size_t)(s - 1) * 2048 + k0 + lane]; cs[s * 64 + lane] = siluf_(c); }
        for (int kk = 0; kk < 64; kk += 4) {
            const float w0 = W[(size_t)(k0 + kk) * 6144 + n0 + lane], w1 = W[(size_t)(k0 + kk + 1) * 6144 + n0 + lane], w2 = W[(size_t)(k0 + kk + 2) * 6144 + n0 + lane], w3 = W[(size_t)(k0 + kk + 3) * 6144 + n0 + lane];
#pragma unroll
            for (int s = 0; s < 33; ++s) { const f32x4 c4 = *(const LAS f32x4*)(cs + s * 64 + kk); acc[s] += c4.x * w0 + c4.y * w1 + c4.z * w2 + c4.w * w3; }
        }
    }
#pragma unroll
    for (int s = 0; s < 33; ++s) red[(wave * 33 + s) * 64 + lane] = acc[s];
    __syncthreads();
    for (int idx = tid; idx < 33 * 64; idx += 512) { const int s = idx >> 6, n = idx & 63; float v = p->in[I_BADA][l * 6144 + n0 + n];
#pragma unroll
        for (int w = 0; w < 8; ++w) v += red[(w * 33 + s) * 64 + n];
        ((float*)(p->ws + WS_ADA))[((size_t)l * 33 + s) * 6144 + n0 + n] = v; }
    __syncthreads();
}
__device__ __forceinline__ const float* x_row(KP p, int l, int row) {
    return l == 0 ? (row < TP ? p->in[I_XP] + (size_t)row * DM : p->in[I_XS] + (size_t)(row - TP) * DM) : (const float*)(p->ws + WS_XBUF) + (size_t)row * DM;
}
__device__ __forceinline__ void p1_rows(KP p, int l, int gw, int ngw, int lane) {
    const f32x4* g4 = (const f32x4*)(p->in[I_NORMG] + l * DM) + lane;
    for (int row = gw; row < NTOK; row += ngw) {
        const f32x4* x4 = (const f32x4*)x_row(p, l, row) + lane;
        const int seq = row < TP ? 0 : 1 + ((row - TP) >> 5);
        const f32x4* sh4 = (const f32x4*)((const float*)(p->ws + WS_ADA) + ((size_t)l * 33 + seq) * 6144) + lane; const f32x4* sc4 = sh4 + 512;
        f32x4 v[8]; float ss = 0.f;
#pragma unroll
        for (int j = 0; j < 8; ++j) { v[j] = x4[64 * j]; ss += (v[j].x * v[j].x + v[j].y * v[j].y) + (v[j].z * v[j].z + v[j].w * v[j].w); }
        const float rstd = 1.f / sqrtf(wave_sum(ss) * (1.f / DM) + 1e-6f);
        u32x2* o = (u32x2*)((bf16_t*)(p->ws + WS_H) + (size_t)row * DM) + lane;
#pragma unroll
        for (int j = 0; j < 8; ++j) { const f32x4 g = g4[64 * j], sc = sc4[64 * j], sh = sh4[64 * j]; const f32x4 y = v[j] * rstd * g * (sc + 1.f) + sh;
            u32x2 w; w.x = cvt_pk_bf16(y.x, y.y); w.y = cvt_pk_bf16(y.z, y.w); o[64 * j] = w; }
    }
}
__device__ __forceinline__ void p_final_rows(KP p, int gw, int ngw, int lane) {
    const f32x4* g4 = (const f32x4*)p->in[I_FING] + lane;
    for (int row = gw; row < NTOK; row += ngw) {
        const f32x4* x4 = (const f32x4*)((const float*)(p->ws + WS_XBUF) + (size_t)row * DM) + lane;
        f32x4 v[8]; float ss = 0.f;
#pragma unroll
        for (int j = 0; j < 8; ++j) { v[j] = x4[64 * j]; ss += (v[j].x * v[j].x + v[j].y * v[j].y) + (v[j].z * v[j].z + v[j].w * v[j].w); }
        const float rstd = 1.f / sqrtf(wave_sum(ss) * (1.f / DM) + 1e-6f);
        f32x4* o = (f32x4*)(p->out + O_YP + (size_t)row * DM) + lane;
#pragma unroll
        for (int j = 0; j < 8; ++j) o[64 * j] = v[j] * rstd * g4[64 * j];
    }
}
struct EpiU {
    static constexpr bool PERM = true, AFTER_DRAIN = false;
    bf16_t* U; float* out; const float* bf; int l;
    __device__ __forceinline__ void operator()(const f32x4 (&acc)[2][2][4][2], const pg8::Unit& u, int wr, int wc, int fr, int fq) const {
        const int row0 = u.pm * 256 + wr * 64 + fr, col0 = u.pn * 256 + wc * 32 + 8 * fq;
#pragma unroll
        for (int ai = 0; ai < 2; ++ai)
#pragma unroll
            for (int m = 0; m < 4; ++m) { bf16_t* rowp = U + (size_t)(row0 + ai * 128 + m * 16) * NU + col0;
#pragma unroll
                for (int bj = 0; bj < 2; ++bj) { const f32x4 v0 = acc[ai][bj][m][0], v1 = acc[ai][bj][m][1];
                    u32x4 w; w.x = cvt_pk_bf16(v0[0], v0[1]); w.y = cvt_pk_bf16(v0[2], v0[3]); w.z = cvt_pk_bf16(v1[0], v1[1]); w.w = cvt_pk_bf16(v1[2], v1[3]);
                    *(u32x4*)(rowp + bj * 128) = w; } }
        if (u.pn >= 8 && u.pn < 12) {
            const bool isv = u.pn >= 10; const int cin = (u.pn - (isv ? 10 : 8)) * 256 + wc * 32 + 8 * fq;
#pragma unroll
            for (int ai = 0; ai < 2; ++ai)
#pragma unroll
                for (int m = 0; m < 4; ++m) { const int row = row0 + ai * 128 + m * 16;
                    float* dst = row < TP ? out + (isv ? O_PV : O_PK) + ((size_t)l * TP + row) * 512 : out + (isv ? O_SV : O_SK) + ((size_t)l * 1024 + (row - TP)) * 512;
#pragma unroll
                    for (int bj = 0; bj < 2; ++bj) { *(f32x4*)(dst + cin + bj * 128) = acc[ai][bj][m][0]; *(f32x4*)(dst + cin + bj * 128 + 4) = acc[ai][bj][m][1]; } }
        }
        if (u.pn == 58 && wc == 0 && fq == 0) {
            const f32x4 b0 = *(const f32x4*)(bf + l * 8), b1 = *(const f32x4*)(bf + l * 8 + 4);
#pragma unroll
            for (int ai = 0; ai < 2; ++ai)
#pragma unroll
                for (int m = 0; m < 4; ++m) { const int row = row0 + ai * 128 + m * 16;
                    float* dst = row < TP ? out + O_PLF + ((size_t)l * TP + row) * 8 : out + O_SLF + ((size_t)l * 1024 + (row - TP)) * 8;
                    const f32x4 z0 = acc[ai][1][m][0] + b0, z1 = acc[ai][1][m][1] + b1; f32x4 o0, o1;
#pragma unroll
                    for (int e = 0; e < 4; ++e) { o0[e] = log_sigmoidf_(z0[e]); o1[e] = log_sigmoidf_(z1[e]); }
                    *(f32x4*)dst = o0; *(f32x4*)(dst + 4) = o1; }
        }
    }
};
struct BranchOrder {
    int G, c;
    __device__ __forceinline__ bool next(int i, pg8::Unit& u) const { const int L = i * G + c; if (L >= 4 * 544) return false; const int n = L / 544, t = L - n * 544; u.pm = n * 68 + (t >> 3); u.pn = n * 8 + (t & 7); return true; }
    __device__ __forceinline__ void a_ready(const pg8::Unit&) const {}
    __device__ __forceinline__ void done(const pg8::Unit&) const {}
};
struct EpiZ {
    static constexpr bool PERM = true, AFTER_DRAIN = false;
    bf16_t* Z;
    __device__ __forceinline__ void operator()(const f32x4 (&acc)[2][2][4][2], const pg8::Unit& u, int wr, int wc, int fr, int fq) const {
        const int row0 = u.pm * 256 + wr * 64 + fr, col0 = (u.pn & 7) * 256 + wc * 32 + 8 * fq;
#pragma unroll
        for (int ai = 0; ai < 2; ++ai)
#pragma unroll
            for (int m = 0; m < 4; ++m) { bf16_t* rowp = Z + (size_t)(row0 + ai * 128 + m * 16) * DM + col0;
#pragma unroll
                for (int bj = 0; bj < 2; ++bj) { const f32x4 v0 = acc[ai][bj][m][0], v1 = acc[ai][bj][m][1];
                    u32x4 w; w.x = cvt_pk_bf16(v0[0], v0[1]); w.y = cvt_pk_bf16(v0[2], v0[3]); w.z = cvt_pk_bf16(v1[0], v1[1]); w.w = cvt_pk_bf16(v1[2], v1[3]);
                    *(u32x4*)(rowp + bj * 128) = w; } }
    }
};
__device__ __forceinline__ void merge_pass(KP p, int gtid, int ngt) {
    const bf16_t* U = (const bf16_t*)(p->ws + WS_U); const bf16_t* Z = (const bf16_t*)(p->ws + WS_Z); bf16_t* M = (bf16_t*)(p->ws + WS_MERGED);
    for (int it = gtid; it < NTOK * 256; it += ngt) { const int row = it >> 8, col = (it & 255) * 8;
        float s[8];
#pragma unroll
        for (int e = 0; e < 8; ++e) s[e] = 0.f;
#pragma unroll
        for (int n = 0; n < 4; ++n) { const u32x4 g = *(const u32x4*)(U + (size_t)row * NU + U_G + n * 2048 + col); const u32x4 z = *(const u32x4*)(Z + ((size_t)n * NTOK + row) * DM + col);
            s[0] += sigmoidf_(bflo(g.x)) * bflo(z.x); s[1] += sigmoidf_(bfhi(g.x)) * bfhi(z.x); s[2] += sigmoidf_(bflo(g.y)) * bflo(z.y); s[3] += sigmoidf_(bfhi(g.y)) * bfhi(z.y);
            s[4] += sigmoidf_(bflo(g.z)) * bflo(z.z); s[5] += sigmoidf_(bfhi(g.z)) * bfhi(z.z); s[6] += sigmoidf_(bflo(g.w)) * bflo(z.w); s[7] += sigmoidf_(bfhi(g.w)) * bfhi(z.w); }
        u32x4 w; w.x = cvt_pk_bf16(s[0], s[1]); w.y = cvt_pk_bf16(s[2], s[3]); w.z = cvt_pk_bf16(s[4], s[5]); w.w = cvt_pk_bf16(s[6], s[7]);
        *(u32x4*)(M + (size_t)row * DM + col) = w; }
}
struct EpiOut {
    static constexpr bool PERM = false, AFTER_DRAIN = false;
    const float* xp; const float* xs; const float* xb; const float* ada; float* xout; int l;
    __device__ __forceinline__ void operator()(const f32x4 (&acc)[2][2][4][2], const pg8::Unit& u, int wr, int wc, int fr, int fq) const {
        const int row0 = u.pm * 256 + wr * 64 + fr, col0 = u.pn * 256 + wc * 32 + 4 * fq;
#pragma unroll
        for (int ai = 0; ai < 2; ++ai)
#pragma unroll
            for (int m = 0; m < 4; ++m) { const int row = row0 + ai * 128 + m * 16;
                const float* base = l == 0 ? (row < TP ? xp + (size_t)row * DM : xs + (size_t)(row - TP) * DM) : xb + (size_t)row * DM;
                const int seq = row < TP ? 0 : 1 + ((row - TP) >> 5);
                const float* gate = ada + ((size_t)l * 33 + seq) * 6144 + 4096;
#pragma unroll
                for (int bj = 0; bj < 2; ++bj)
#pragma unroll
                    for (int n = 0; n < 2; ++n) { const int col = col0 + bj * 128 + n * 16;
                        *(f32x4*)(xout + (size_t)row * DM + col) = *(const f32x4*)(base + col) + *(const f32x4*)(gate + col) * acc[ai][bj][m][n]; } }
    }
};
__device__ __forceinline__ void conv_unit(KP p, int l, int tile, LAS unsigned char* lds, int tid) {
    const bf16_t* U = (const bf16_t*)(p->ws + WS_U);
    const int c = tid, wave = tid >> 6, lane = tid & 63;
    const bool samp = tile >= 512; const int b = tile - 512, row0 = samp ? TP + b * 32 : tile * 32;
    const bool last = samp || tile == 511;
    LAS float* red = (LAS float*)lds;
    LAS float* st = red + 8 * 32;
    const float cb = p->in[I_CONVB][l * 512 + c], lg = p->in[I_CLNG][l * 512 + c], lb = p->in[I_CLNB][l * 512 + c];
    bf16_t* oa = (bf16_t*)(p->ws + WS_OCAT);
#pragma unroll 1
    for (int half = 0; half < 2; ++half) {
        float z[46];
        if (!samp) {
#pragma unroll
            for (int i = 0; i < 46; ++i) { const int row = row0 + 16 * half + i - 30; const size_t r = (size_t)(row < 0 ? 0 : row) * NU;
                const float v = bf2f(U[r + U_AVAL + c]) * sigmoidf_(bf2f(U[r + U_AGATE + c])); z[i] = row < 0 ? 0.f : v; }
        } else {
            const float* hist = p->in[I_SCONV] + (((size_t)l * 32 + b) * 30) * 512 + c;
#pragma unroll
            for (int i = 0; i < 46; ++i) { const int rel = 16 * half + i - 30; const size_t r = (size_t)(row0 + (rel < 0 ? 0 : rel)) * NU;
                const float v = bf2f(U[r + U_AVAL + c]) * sigmoidf_(bf2f(U[r + U_AGATE + c]));
                if (i < 30) { const int hi_ = 16 * half + i; const float hv_ = hist[(size_t)(hi_ < 30 ? hi_ : 29) * 512]; z[i] = rel < 0 ? hv_ : v; } else z[i] = v; }
        }
        if (last) {
            float* dst = samp ? p->out + O_SCONV + (((size_t)l * 32 + b) * 30) * 512 + c : p->out + O_PCONV + ((size_t)l * 30) * 512 + c;
#pragma unroll
            for (int tt = 0; tt < 16; ++tt) { const int t = 16 * half + tt; if (t >= 2) dst[(size_t)(t - 2) * 512] = z[30 + tt]; }
        }
        float hv[16];
#pragma unroll
        for (int tt = 0; tt < 16; ++tt) hv[tt] = cb;
#pragma unroll
        for (int k = 0; k < 31; ++k) { const float w = p->in[I_CONVW][((size_t)l * 31 + k) * 512 + c];
#pragma unroll
            for (int tt = 0; tt < 16; ++tt) hv[tt] += z[tt + k] * w; }
#pragma unroll
        for (int tt = 0; tt < 16; ++tt) { const float s1 = wave_sum(hv[tt]), s2 = wave_sum(hv[tt] * hv[tt]); if (lane == 0) { red[(wave * 16 + tt) * 2] = s1; red[(wave * 16 + tt) * 2 + 1] = s2; } }
        __syncthreads();
        if (tid < 16) { float s1 = 0.f, s2 = 0.f;
#pragma unroll
            for (int w = 0; w < 8; ++w) { s1 += red[(w * 16 + tid) * 2]; s2 += red[(w * 16 + tid) * 2 + 1]; }
            const float mean = s1 * (1.f / 512.f), var = fmaxf(s2 * (1.f / 512.f) - mean * mean, 0.f);
            st[tid * 2] = mean; st[tid * 2 + 1] = 1.f / sqrtf(var + 1e-5f); }
        __syncthreads();
#pragma unroll
        for (int tt = 0; tt < 16; ++tt) { const float y = (hv[tt] - st[tt * 2]) * st[tt * 2 + 1] * lg + lb; const size_t r = (size_t)(row0 + 16 * half + tt);
            oa[r * 512 + c] = f2bf(siluf_(y) * siluf_(bf2f(U[r * NU + U_ASG + c]))); }
        __syncthreads();
    }
}
__device__ __forceinline__ void pool_unit(KP p, int l, int tile, LAS unsigned char* lds, int tid) {
    const bf16_t* U = (const bf16_t*)(p->ws + WS_U);
    const int c = tid, wave = tid >> 6, lane = tid & 63;
    const bool samp = tile >= 512; const int b = tile - 512, row0 = samp ? TP + b * 32 : tile * 32;
    constexpr int PST = 520;
    LAS bf16_t* pl = (LAS bf16_t*)lds;
    {
        float z[47];
        if (!samp) {
#pragma unroll
            for (int i = 0; i < 47; ++i) { const int row = row0 + i - 15; const float v = bf2f(U[(size_t)(row < 0 ? 0 : row) * NU + U_DIN + c]); z[i] = row < 0 ? 0.f : v; }
        } else {
#pragma unroll
            for (int i = 0; i < 15; ++i) z[i] = p->in[I_SPOOL][(((size_t)l * 32 + b) * 15 + i) * 512 + c];
#pragma unroll
            for (int t = 0; t < 32; ++t) z[15 + t] = bf2f(U[(size_t)(row0 + t) * NU + U_DIN + c]);
        }
        if (samp || tile == 511) {
            float* dst = samp ? p->out + O_SPOOL + (((size_t)l * 32 + b) * 15) * 512 + c : p->out + O_PPOOL + ((size_t)l * 15) * 512 + c;
#pragma unroll
            for (int t = 17; t < 32; ++t) dst[(size_t)(t - 17) * 512] = z[15 + t];
        }
        const int w = 2 << (c >> 7);
#pragma unroll
        for (int t = 0; t < 32; ++t) { float s = 0.f;
#pragma unroll
            for (int i = 0; i < 16; ++i) s += (i < w) ? z[15 + t - i] : 0.f;
            const int pos = samp ? PAST + t : row0 + t; const int cnt = (pos + 1 < w) ? pos + 1 : w;
            pl[t * PST + c] = f2bf(s / (float)cnt - z[15 + t]); }
    }
    __syncthreads();
    {
        const int g = wave >> 1, fr = lane & 15, kq = lane >> 4;
        const bf16_t* WT = (const bf16_t*)(p->ws + WS_POOLW) + (size_t)(l * 4 + g) * 128 * 128;
        f32x4 acc[2][4];
#pragma unroll
        for (int mt = 0; mt < 2; ++mt)
#pragma unroll
            for (int nt = 0; nt < 4; ++nt) acc[mt][nt] = (f32x4){0.f, 0.f, 0.f, 0.f};
#pragma unroll
        for (int ks = 0; ks < 4; ++ks) {
            bf16x8 af[2];
#pragma unroll
            for (int mt = 0; mt < 2; ++mt) af[mt] = *(const LAS bf16x8*)(pl + (16 * mt + fr) * PST + g * 128 + 32 * ks + 8 * kq);
#pragma unroll
            for (int nt = 0; nt < 4; ++nt) { const int dl = (wave & 1) * 64 + 16 * nt + fr;
                const bf16x8 bfr = *(const bf16x8*)(WT + (size_t)dl * 128 + 32 * ks + 8 * kq);
#pragma unroll
                for (int mt = 0; mt < 2; ++mt) acc[mt][nt] = __builtin_amdgcn_mfma_f32_16x16x32_bf16(af[mt], bfr, acc[mt][nt], 0, 0, 0); }
        }
        bf16_t* od = (bf16_t*)(p->ws + WS_OCAT) + (size_t)3 * NTOK * 512;
#pragma unroll
        for (int nt = 0; nt < 4; ++nt) { const int d = wave * 64 + 16 * nt + fr; const float pb = p->in[I_POOLB][l * 512 + d], ps = p->in[I_POOLS][l * 512 + d];
#pragma unroll
            for (int mt = 0; mt < 2; ++mt)
#pragma unroll
                for (int r = 0; r < 4; ++r) { const size_t row = (size_t)(row0 + 16 * mt + 4 * kq + r);
                    od[row * 512 + d] = f2bf((acc[mt][nt][r] + pb) * ps * siluf_(bf2f(U[row * NU + U_DSG + d]))); } }
    }
    __syncthreads();
}
__device__ __forceinline__ void fp_unit(KP p, int l, int h, LAS unsigned char* lds, int tid) {
    const float* lf = p->out + O_PLF + (size_t)l * TP * 8 + h;
    LAS float* part = (LAS float*)lds;
    float v[32]; float s = 0.f;
#pragma unroll
    for (int i = 0; i < 32; ++i) { v[i] = lf[(size_t)(tid * 32 + i) * 8]; s += v[i]; }
    part[tid] = s;
    __syncthreads();
    float pre = 0.f;
    for (int j = 0; j < tid; ++j) pre += part[j];
    float* F = (float*)(p->ws + WS_FP) + (size_t)h * TP + tid * 32;
#pragma unroll
    for (int i = 0; i < 32; ++i) { pre += v[i]; F[i] = pre * LOG2E; }
    __syncthreads();
}
__device__ __forceinline__ void gs_unit(KP p, int l, int b, LAS unsigned char* lds, int tid) {
    const int h = tid & 7, ch = tid >> 3;
    const float* cl = p->in[I_CLF] + (((size_t)l * 32 + b) * PAST) * 8 + h;
    LAS float* part = (LAS float*)lds;
    float s = 0.f;
    for (int i = 0; i < 64; ++i) s += cl[(size_t)(ch * 64 + i) * 8];
    part[ch * 8 + h] = s;
    __syncthreads();
    float suf = 0.f;
    for (int j = ch + 1; j < 64; ++j) suf += part[j * 8 + h];
    float* G = (float*)(p->ws + WS_GS) + ((size_t)b * 8 + h) * GS_LEN;
    for (int i = 63; i >= 0; --i) { const int t = ch * 64 + i; G[t] = -suf * LOG2E; suf += cl[(size_t)t * 8]; }
    if (tid < 8) { const float* nl = p->out + O_SLF + ((size_t)l * 1024 + b * 32) * 8 + tid; float run = 0.f;
        for (int i = 0; i < 32; ++i) { run += nl[i * 8]; G[PAST + i] = run * LOG2E; } }
    __syncthreads();
}
__device__ __forceinline__ void vt_tile(KP p, int l, int tile, LAS unsigned char* lds, int wave, int lane) {
    const int h = tile >> 8, tb = tile & 255;
    const bf16_t* U = (const bf16_t*)(p->ws + WS_U);
    LAS unsigned* scr = (LAS unsigned*)lds + wave * SLOT_F;
#pragma unroll 8
    for (int tt = 0; tt < 64; ++tt) scr[tt * 65 + lane] = U[(size_t)(tb * 64 + tt) * NU + U_V + h * 64 + lane];
    {
        float mx = 0.f;
#pragma unroll 8
        for (int tt = 0; tt < 64; ++tt) { const float kv = bf2f(U[(size_t)(tb * 64 + tt) * NU + U_K + h * 64 + lane]); mx = fmaxf(mx, wave_sum(kv * kv)); }
        if (lane == 0) atomicMax((unsigned*)(p->ws + WS_CTL) + CW_KMAX + l * 8 + h, __float_as_uint(mx));
    }
    bf16_t* Vt = (bf16_t*)(p->ws + WS_VT);
    const int t2 = (lane & 31) * 2, dh = lane >> 5;
#pragma unroll 8
    for (int it = 0; it < 32; ++it) { const int d = 2 * it + dh; *(unsigned*)(Vt + ((size_t)h * 64 + d) * TP + tb * 64 + t2) = scr[t2 * 65 + d] | (scr[(t2 + 1) * 65 + d] << 16); }
}
__device__ __forceinline__ void shift_out(KP p, int l, int tid) {
    const bf16_t* U = (const bf16_t*)(p->ws + WS_U);
    for (int idx = tid; idx < NSEQ * SHIFT_W; idx += 512) { const int s = idx / SHIFT_W, j = idx - s * SHIFT_W;
        const int row = s == 0 ? TP - 1 : TP + (s - 1) * 32 + 31;
        float* dst = s == 0 ? p->out + O_PSHIFT + (size_t)l * SHIFT_W + j : p->out + O_SSHIFT + ((size_t)l * 32 + (s - 1)) * SHIFT_W + j;
        *dst = bf2f(U[(size_t)row * NU + U_XC + j]); }
}
template <bool AT, bool BT, bool NEGA>
__device__ __forceinline__ void mm32(f32x16& acc, const LAS float* Ap, int i0, const LAS float* Bp, int j0, int lane) {
    const int li = lane & 31, kh = lane >> 5;
    const LAS float* ap = AT ? Ap + (8 * kh) * 65 + i0 + li : Ap + (i0 + li) * 65 + 8 * kh;
    const LAS float* bp = BT ? Bp + (j0 + li) * 65 + 8 * kh : Bp + (8 * kh) * 65 + j0 + li;
#pragma unroll
    for (int s = 0; s < 4; ++s) {
        float a[8], b[8];
#pragma unroll
        for (int e = 0; e < 8; ++e) { a[e] = AT ? ap[(16 * s + e) * 65] : ap[16 * s + e]; b[e] = BT ? bp[16 * s + e] : bp[(16 * s + e) * 65]; }
        if (NEGA) {
#pragma unroll
            for (int e = 0; e < 8; ++e) a[e] = -a[e]; }
        const bf16x8 af = pack8f((f32x4){a[0], a[1], a[2], a[3]}, (f32x4){a[4], a[5], a[6], a[7]}), bfg = pack8f((f32x4){b[0], b[1], b[2], b[3]}, (f32x4){b[4], b[5], b[6], b[7]});
        acc = __builtin_amdgcn_mfma_f32_32x32x16_bf16(af, bfg, acc, 0, 0, 0);
    }
}
template <int MASK>
__device__ __forceinline__ void st_tile(LAS float* dst, const f32x16& acc, int i0, int j0, int lane) {
    const int li = lane & 31, hi = lane >> 5, j = j0 + li;
#pragma unroll
    for (int r = 0; r < 16; ++r) { const int i = i0 + (r & 3) + 8 * (r >> 2) + 4 * hi; float v = acc[r];
        if (MASK == 1 && !(i < j)) v = 0.f; if (MASK == 2 && !(i <= j)) v = 0.f; dst[i * 65 + j] = v; }
}
struct RwkvSeqInfo { int row0, ntok, prev_kind  , b; };
__device__ __forceinline__ RwkvSeqInfo rwkv_info(int cu) { RwkvSeqInfo s; if (cu < 256) { s.row0 = cu * 64; s.ntok = 64; s.prev_kind = cu == 0 ? 0 : 1; s.b = 0; } else { s.b = cu - 256; s.row0 = TP + s.b * 32; s.ntok = 32; s.prev_kind = 2; } return s; }

__device__ __forceinline__ void rwkv_r1(KP p, int l, int unit, LAS unsigned char* lds, int tid) {
    const int cu = unit >> 3, h = unit & 7, wave = tid >> 6, lane = tid & 63, li = lane & 31, hi = lane >> 5;
    const RwkvSeqInfo si = rwkv_info(cu);
    const bf16_t* U = (const bf16_t*)(p->ws + WS_U);
    LAS float* S0 = (LAS float*)lds; LAS float *S1 = S0 + SLOT_F, *S2 = S0 + 2 * SLOT_F, *S3 = S0 + 3 * SLOT_F, *S4 = S0 + 4 * SLOT_F, *S5 = S0 + 5 * SLOT_F, *S6 = S0 + 6 * SLOT_F, *S7 = S0 + 7 * SLOT_F, *S8 = S0 + 8 * SLOT_F;
    LAS float* gC = S0 + 9 * SLOT_F;
    const int q = wave >> 2, wq = wave & 3, i0 = (wq >> 1) * 32, j0 = (wq & 1) * 32;
    PT0();
    {
        const int j = tid & 63, tq = tid >> 6, t0 = tq * 8;
        const int offs[5] = {h * 64, 512 + h * 64, 1024 + h * 64, 1536, 1600};
        unsigned short raw[5][9];
#pragma unroll
        for (int cs = 0; cs < 5; ++cs) {
            const int xo = offs[cs] + j;
#pragma unroll
            for (int tt = 0; tt < 9; ++tt) { int t = t0 + tt - 1; t = t < 0 ? (si.prev_kind == 1 ? -1 : 0) : (t < si.ntok ? t : si.ntok - 1);
                raw[cs][tt] = U[(size_t)(si.row0 + t) * NU + U_XC + xo]; }
        }
#pragma unroll
        for (int cs = 0; cs < 5; ++cs) {
            const int xo = offs[cs] + j; const float mu = p->in[I_MU][l * SHIFT_W + xo];
            LAS float* dst = cs == 0 ? S0 : cs == 1 ? S1 : cs == 2 ? S2 : cs == 3 ? S3 : S4;
            float prev = bf2f(raw[cs][0]);
            if (t0 == 0) { if (si.prev_kind == 0) prev = 0.f; else if (si.prev_kind == 2) prev = p->in[I_SSHIFT][((size_t)l * 32 + si.b) * SHIFT_W + xo]; }
#pragma unroll
            for (int tt = 0; tt < 8; ++tt) { const int t = t0 + tt; const float x = bf2f(raw[cs][tt + 1]); float xs = (t < si.ntok) ? x + (prev - x) * mu : 0.f; prev = x;
                if (cs == 3) xs = fast_tanh(xs);
                dst[t * 65 + j] = xs; }
        }
#pragma unroll
        for (int mm = 0; mm < 8; ++mm) { const int m = tq * 8 + mm;
            S5[m * 65 + j] = p->in[I_W2][((size_t)l * 64 + m) * 512 + h * 64 + j]; S6[m * 65 + j] = p->in[I_A2][((size_t)l * 64 + m) * 512 + h * 64 + j]; }
    }
    __syncthreads();
    PT1(1);
    {
        f32x16 acc = {};
        const int c = j0 + li;
        if (q == 0) { mm32<false, false, false>(acc, S3, i0, S5, j0, lane); const float w0 = p->in[I_W0][l * 512 + h * 64 + c];
#pragma unroll
            for (int r = 0; r < 16; ++r) { const int t = i0 + (r & 3) + 8 * (r >> 2) + 4 * hi; const float zz = acc[r] + w0;
                const float sp = fmaxf(-zz, 0.f) + __logf(1.f + __expf(-fabsf(zz)));
                S7[t * 65 + c] = (t < si.ntok) ? -__expf(-sp - 0.5f) : 0.f; } }
        else { mm32<false, false, false>(acc, S4, i0, S6, j0, lane); const float a0 = p->in[I_A0][l * 512 + h * 64 + c];
#pragma unroll
            for (int r = 0; r < 16; ++r) { const int t = i0 + (r & 3) + 8 * (r >> 2) + 4 * hi; S8[t * 65 + c] = __builtin_amdgcn_rcpf(1.f + __expf(-(acc[r] + a0))); } }
    }
    __syncthreads();
    PT1(2);
    if (wave == 0) { float run = 0.f;
#pragma unroll 8
        for (int t = 0; t < 64; ++t) { run += S7[t * 65 + lane]; S3[t * 65 + lane] = run; } }
    else { const int c = lane; const float kkw = p->in[I_KK][l * 512 + h * 64 + c], kaw = p->in[I_KA][l * 512 + h * 64 + c], rkw = p->in[I_RK][l * 512 + h * 64 + c];
        for (int t = wave - 1; t < 64; t += 7) { const float kr = S1[t * 65 + c], kv = kr * kkw; const float ss = wave_sum(kv * kv);
            const float kn = kv * (1.f / sqrtf(fmaxf(ss, 1e-24f))); const float a = S8[t * 65 + c]; const float km = kr * (1.f + (a - 1.f) * kaw);
            const float bon = wave_sum(S0[t * 65 + c] * km * rkw);
            S4[t * 65 + c] = kn; S1[t * 65 + c] = km; S8[t * 65 + c] = kn * a;
            if (lane == 0) ((float*)(p->ws + WS_BONUS))[(size_t)unit * 64 + t] = bon; } }
    __syncthreads();
    { const int c = tid & 63, tq = tid >> 6;
#pragma unroll
        for (int tt = 0; tt < 8; ++tt) { const int t = tq * 8 + tt, o = t * 65 + c; const float Lg = S3[o], lw = S7[o];
            const float g = __expf(Lg), gi = __expf(-Lg), gp = __expf(Lg - lw);
            S0[o] *= g; S1[o] *= gi; S8[o] *= gi; S4[o] *= gp; if (t == 63) gC[c] = g; } }
    __syncthreads();
    PT1(3);
    { f32x16 acc = {};
      if (q == 0) { mm32<false, true, false>(acc, S1, i0, S4, j0, lane); st_tile<1>(S3, acc, i0, j0, lane); }
      else { mm32<false, true, false>(acc, S8, i0, S4, j0, lane); st_tile<1>(S5, acc, i0, j0, lane); } }
    __syncthreads();
    { f32x16 acc = {};
      if (q == 0) { mm32<true, false, false>(acc, S2, i0, S3, j0, lane); st_tile<0>(S6, acc, i0, j0, lane); }
      else { mm32<false, true, false>(acc, S1, i0, S0, j0, lane); st_tile<2>(S7, acc, i0, j0, lane); } }
    __syncthreads();
    PT1(4);
    { float x[16]; const int r0 = (wave & 3) * 16;
      if (wave < 4) {
#pragma unroll
          for (int rr = 0; rr < 16; ++rr) x[rr] = S4[lane * 65 + r0 + rr]; }
      else {
#pragma unroll
          for (int rr = 0; rr < 16; ++rr) x[rr] = S6[(r0 + rr) * 65 + lane]; }
      __syncthreads();
#pragma unroll
      for (int sb = 0; sb < 4; ++sb) {
          float mreg[16];
#pragma unroll
          for (int s = 0; s < 16; ++s) mreg[s] = S5[(sb * 16 + (s < 15 || sb < 3 ? s : 14)) * 65 + lane];
          __builtin_amdgcn_sched_barrier(0);
#pragma unroll
          for (int s = 0; s < 16; ++s) { if (sb * 16 + s < 63) { const float mrow = mreg[s]; float xs[16];
#pragma unroll
              for (int rr = 0; rr < 16; ++rr) xs[rr] = __builtin_bit_cast(float, __builtin_amdgcn_readlane(__builtin_bit_cast(int, x[rr]), sb * 16 + s));
              __builtin_amdgcn_sched_barrier(0);
#pragma unroll
              for (int rr = 0; rr < 16; ++rr) x[rr] -= xs[rr] * mrow;
              __builtin_amdgcn_sched_barrier(0); } }
      }
      LAS float* dst = wave < 4 ? S3 : S6;
#pragma unroll
      for (int rr = 0; rr < 16; ++rr) dst[(r0 + rr) * 65 + lane] = x[rr]; }
    __syncthreads();
    PT1(5);
    { f32x16 acc = {};
      if (q == 1) { mm32<false, true, false>(acc, S8, i0, S0, j0, lane); st_tile<2>(S4, acc, i0, j0, lane); }
      else { mm32<false, false, false>(acc, S3, i0, S8, j0, lane);
          const int jc = j0 + li; const float gc = gC[jc]; float* TQ = (float*)(p->ws + WS_TQ) + (size_t)unit * 4096;
#pragma unroll
          for (int rg = 0; rg < 4; ++rg) { const int ab = i0 + 8 * rg + 4 * hi; f32x4 o;
#pragma unroll
              for (int e = 0; e < 4; ++e) o[e] = ((ab + e == jc) ? gc : 0.f) - acc[rg * 4 + e] * gc;
              *(f32x4*)(TQ + ((((jc >> 4) * 4 + (ab >> 4)) * 64 + ((ab & 15) >> 2) * 16 + (jc & 15)) * 4)) = o; } } }
    __syncthreads();
    { f32x16 acc = {};
      if (q == 0) { mm32<true, false, false>(acc, S2, i0, S1, j0, lane); mm32<false, false, true>(acc, S6, i0, S8, j0, lane);
          const int jc = j0 + li; const float gc = gC[jc]; float* GM = (float*)(p->ws + WS_GM) + (size_t)unit * 4096;
#pragma unroll
          for (int r = 0; r < 16; ++r) GM[(i0 + (r & 3) + 8 * (r >> 2) + 4 * hi) * 64 + jc] = acc[r] * gc; }
      else { mm32<true, false, false>(acc, S2, i0, S7, j0, lane); mm32<false, false, true>(acc, S6, i0, S4, j0, lane);
          float* Y0T = (float*)(p->ws + WS_Y0T) + (size_t)unit * 4096 + (j0 + li) * 64;
#pragma unroll
          for (int rg = 0; rg < 4; ++rg) *(f32x4*)(Y0T + i0 + 8 * rg + 4 * hi) = (f32x4){acc[rg * 4], acc[rg * 4 + 1], acc[rg * 4 + 2], acc[rg * 4 + 3]}; } }
    if (q == 0) { f32x16 acc;
#pragma unroll
        for (int r = 0; r < 16; ++r) acc[r] = S0[(j0 + li) * 65 + i0 + (r & 3) + 8 * (r >> 2) + 4 * hi];
        mm32<false, false, true>(acc, S3, i0, S4, j0, lane);
        float* ET = (float*)(p->ws + WS_ET) + (size_t)unit * 4096 + (j0 + li) * 64;
#pragma unroll
        for (int rg = 0; rg < 4; ++rg) *(f32x4*)(ET + i0 + 8 * rg + 4 * hi) = (f32x4){acc[rg * 4], acc[rg * 4 + 1], acc[rg * 4 + 2], acc[rg * 4 + 3]}; }
    __syncthreads();
    PT1(6);
}
__device__ __forceinline__ void chain_run(f32x4 (&st)[4], const float* TQ, const float* GM, float* SC, int nsteps, int i, int g, int lane) {
    constexpr size_t STRIDE = (size_t)8 * 4096;
    f32x4 tq[16], gm[4];
#pragma unroll
    for (int x = 0; x < 16; ++x) tq[x] = *(const f32x4*)(TQ + (x * 64 + lane) * 4);
#pragma unroll
    for (int tl = 0; tl < 4; ++tl) gm[tl] = GM ? *(const f32x4*)(GM + i * 64 + 16 * tl + 4 * g) : (f32x4){0.f, 0.f, 0.f, 0.f};
    for (int c = 0; c < nsteps; ++c) {
        if (SC) {
#pragma unroll
            for (int tl = 0; tl < 4; ++tl) *(f32x4*)(SC + c * STRIDE + i * 64 + 16 * tl + 4 * g) = st[tl]; }
        f32x4 tqn[16], gmn[4];
        const int cn = (c + 1 < nsteps) ? c + 1 : c;
#pragma unroll
        for (int x = 0; x < 16; ++x) tqn[x] = *(const f32x4*)(TQ + cn * STRIDE + (x * 64 + lane) * 4);
#pragma unroll
        for (int tl = 0; tl < 4; ++tl) gmn[tl] = GM ? *(const f32x4*)(GM + cn * STRIDE + i * 64 + 16 * tl + 4 * g) : (f32x4){0.f, 0.f, 0.f, 0.f};
        f32x4 acc[4];
#pragma unroll
        for (int tp = 0; tp < 4; ++tp) acc[tp] = gm[tp];
#pragma unroll
        for (int tl = 0; tl < 4; ++tl)
#pragma unroll
            for (int r = 0; r < 4; ++r)
#pragma unroll
                for (int tp = 0; tp < 4; ++tp) acc[tp] = __builtin_amdgcn_mfma_f32_16x16x4f32(tq[tp * 4 + tl][r], st[tl][r], acc[tp], 0, 0, 0);
#pragma unroll
        for (int tl = 0; tl < 4; ++tl) st[tl] = acc[tl];
#pragma unroll
        for (int x = 0; x < 16; ++x) tq[x] = tqn[x];
#pragma unroll
        for (int tl = 0; tl < 4; ++tl) gm[tl] = gmn[tl];
    }
}
__device__ __forceinline__ void rwkv_l1_task(KP p, int task, int lane) {
    const int iq = task & 3, kind = (task >> 2) & 1, h = (task >> 3) & 7, grp = task >> 6;
    const int fr = lane & 15, g = lane >> 4, i = iq * 16 + fr;
    const size_t u0 = ((size_t)(grp * 16) * 8 + h) * 4096;
    const float* TQ = (const float*)(p->ws + WS_TQ) + u0; const float* GM = (const float*)(p->ws + WS_GM) + u0;
    f32x4 st[4];
#pragma unroll
    for (int tl = 0; tl < 4; ++tl)
#pragma unroll
        for (int r = 0; r < 4; ++r) st[tl][r] = (kind == 1 && i == 16 * tl + 4 * g + r) ? 1.f : 0.f;
    chain_run(st, TQ, kind == 0 ? GM : nullptr, nullptr, 16, i, g, lane);
    const size_t gb = ((size_t)grp * 8 + h) * 4096;
    if (kind == 0) { float* GG = (float*)(p->ws + WS_GG) + gb;
#pragma unroll
        for (int tl = 0; tl < 4; ++tl) *(f32x4*)(GG + i * 64 + 16 * tl + 4 * g) = st[tl]; }
    else { float* TG = (float*)(p->ws + WS_TG) + gb;
#pragma unroll
        for (int tl = 0; tl < 4; ++tl)
#pragma unroll
            for (int r = 0; r < 4; ++r) TG[((tl * 4 + iq) * 64 + (fr >> 2) * 16 + 4 * g + r) * 4 + (fr & 3)] = st[tl][r]; }
}
__device__ __forceinline__ void rwkv_l2_task(KP p, int l, int task, int lane) {
    const int iq = task & 3, h = task >> 2, fr = lane & 15, g = lane >> 4, i = iq * 16 + fr;
    f32x4 st[4];
#pragma unroll
    for (int tl = 0; tl < 4; ++tl) st[tl] = (f32x4){0.f, 0.f, 0.f, 0.f};
    chain_run(st, (const float*)(p->ws + WS_TG) + (size_t)h * 4096, (const float*)(p->ws + WS_GG) + (size_t)h * 4096, (float*)(p->ws + WS_SG) + (size_t)h * 4096, 16, i, g, lane);
    float* dst = p->out + O_PWKV + (((size_t)l * 8 + h) * 64 + i) * 64;
#pragma unroll
    for (int tl = 0; tl < 4; ++tl) *(f32x4*)(dst + 16 * tl + 4 * g) = st[tl];
}
__device__ __forceinline__ void rwkv_l3_task(KP p, int l, int task, int lane) {
    const int fr = lane & 15, g = lane >> 4;
    f32x4 st[4];
    if (task < 512) { const int iq = task & 3, h = (task >> 2) & 7, grp = task >> 5, i = iq * 16 + fr;
        const float* s0 = (const float*)(p->ws + WS_SG) + ((size_t)grp * 8 + h) * 4096 + i * 64;
#pragma unroll
        for (int tl = 0; tl < 4; ++tl) st[tl] = *(const f32x4*)(s0 + 16 * tl + 4 * g);
        const size_t u0 = ((size_t)(grp * 16) * 8 + h) * 4096;
        chain_run(st, (const float*)(p->ws + WS_TQ) + u0, (const float*)(p->ws + WS_GM) + u0, (float*)(p->ws + WS_SC) + u0, 16, i, g, lane); }
    else { const int t2 = task - 512, iq = t2 & 3, h = (t2 >> 2) & 7, b = t2 >> 5, i = iq * 16 + fr;
        const float* s0 = p->in[I_SWKV] + ((((size_t)l * 32 + b) * 8 + h) * 64 + i) * 64;
#pragma unroll
        for (int tl = 0; tl < 4; ++tl) st[tl] = *(const f32x4*)(s0 + 16 * tl + 4 * g);
        const size_t u0 = ((size_t)(256 + b) * 8 + h) * 4096;
        chain_run(st, (const float*)(p->ws + WS_TQ) + u0, (const float*)(p->ws + WS_GM) + u0, (float*)(p->ws + WS_SC) + u0, 1, i, g, lane);
        float* dst = p->out + O_SWKV + ((((size_t)l * 32 + b) * 8 + h) * 64 + i) * 64;
#pragma unroll
        for (int tl = 0; tl < 4; ++tl) *(f32x4*)(dst + 16 * tl + 4 * g) = st[tl]; }
}
__device__ __forceinline__ void rwkv_r3_task(KP p, int l, int task, int lane) {
    const int unit = task >> 1, th = task & 1, cu = unit >> 3, h = unit & 7, li = lane & 31, hi = lane >> 5;
    const RwkvSeqInfo si = rwkv_info(cu);
    if (th * 32 >= si.ntok) return;
    const bf16_t* U = (const bf16_t*)(p->ws + WS_U);
    const size_t ub = (size_t)unit * 4096; const int t = th * 32 + li;
    const float* SC = (const float*)(p->ws + WS_SC) + ub; const float* ET = (const float*)(p->ws + WS_ET) + ub + t * 64 + 32 * hi; const float* Y0T = (const float*)(p->ws + WS_Y0T) + ub + t * 64;
    f32x16 acc[2];
#pragma unroll
    for (int ti = 0; ti < 2; ++ti)
#pragma unroll
        for (int rg = 0; rg < 4; ++rg) { const f32x4 y0 = *(const f32x4*)(Y0T + 32 * ti + 8 * rg + 4 * hi);
#pragma unroll
            for (int e = 0; e < 4; ++e) acc[ti][rg * 4 + e] = y0[e]; }
#pragma unroll
    for (int s4 = 0; s4 < 8; ++s4) {
        const f32x4 eb = *(const f32x4*)(ET + 4 * s4);
        const f32x4 sa0 = *(const f32x4*)(SC + (li) * 64 + 32 * hi + 4 * s4), sa1 = *(const f32x4*)(SC + (32 + li) * 64 + 32 * hi + 4 * s4);
#pragma unroll
        for (int e = 0; e < 4; ++e) { acc[0] = __builtin_amdgcn_mfma_f32_32x32x2f32(sa0[e], eb[e], acc[0], 0, 0, 0); acc[1] = __builtin_amdgcn_mfma_f32_32x32x2f32(sa1[e], eb[e], acc[1], 0, 0, 0); }
    }
    float s1 = 0.f;
#pragma unroll
    for (int ti = 0; ti < 2; ++ti)
#pragma unroll
        for (int r = 0; r < 16; ++r) s1 += acc[ti][r];
    s1 = xhalf_sum(s1); const float mean = s1 * (1.f / 64.f);
    float s2 = 0.f;
#pragma unroll
    for (int ti = 0; ti < 2; ++ti)
#pragma unroll
        for (int r = 0; r < 16; ++r) { const float d = acc[ti][r] - mean; s2 += d * d; }
    s2 = xhalf_sum(s2); const float rstd = 1.f / sqrtf(s2 * (1.f / 64.f) + 64e-5f);
    if (t >= si.ntok) return;
    const float bon = ((const float*)(p->ws + WS_BONUS))[(size_t)unit * 64 + t];
    const size_t row = (size_t)(si.row0 + t);
    bf16_t* oc = (bf16_t*)(p->ws + WS_OCAT) + (size_t)2 * NTOK * 512 + row * 512 + h * 64;
#pragma unroll
    for (int ti = 0; ti < 2; ++ti)
#pragma unroll
        for (int rg = 0; rg < 4; ++rg) { const int i = 32 * ti + 8 * rg + 4 * hi, c = h * 64 + i;
            const f32x4 gg = *(const f32x4*)(p->in[I_GNG] + l * 512 + c), gb = *(const f32x4*)(p->in[I_GNB] + l * 512 + c), mu = *(const f32x4*)(p->in[I_MU] + l * SHIFT_W + 1024 + c);
            const u32x2 vx = *(const u32x2*)(U + row * NU + U_XC + 1024 + c); const u32x2 sg = *(const u32x2*)(U + row * NU + U_CSG + c);
            f32x4 vc = (f32x4){bflo(vx.x), bfhi(vx.x), bflo(vx.y), bfhi(vx.y)}, vp;
            if (t > 0 || si.prev_kind == 1) { const u32x2 px = *(const u32x2*)(U + (row - 1) * NU + U_XC + 1024 + c); vp = (f32x4){bflo(px.x), bfhi(px.x), bflo(px.y), bfhi(px.y)}; }
            else if (si.prev_kind == 2) vp = *(const f32x4*)(p->in[I_SSHIFT] + ((size_t)l * 32 + si.b) * SHIFT_W + 1024 + c);
            else vp = (f32x4){0.f, 0.f, 0.f, 0.f};
            const f32x4 vs = vc + (vp - vc) * mu;
            const f32x4 sgf = (f32x4){bflo(sg.x), bfhi(sg.x), bflo(sg.y), bfhi(sg.y)};
            f32x4 o;
#pragma unroll
            for (int e = 0; e < 4; ++e) o[e] = (((acc[ti][rg * 4 + e] - mean) * rstd) * gg[e] + gb[e] + bon * vs[e]) * siluf_(sgf[e]);
            u32x2 w; w.x = cvt_pk_bf16(o[0], o[1]); w.y = cvt_pk_bf16(o[2], o[3]); *(u32x2*)(oc + i) = w; }
}
__device__ __forceinline__ int krow(int i) { return (i & 3) + 4 * ((i >> 3) & 1) + 8 * ((i >> 2) & 1) + 16 * (i >> 4); }
__device__ __forceinline__ bf16x8 pack8(const f32x16& v, int o) { u32x4 w; w.x = cvt_pk_bf16(v[o], v[o + 1]); w.y = cvt_pk_bf16(v[o + 2], v[o + 3]); w.z = cvt_pk_bf16(v[o + 4], v[o + 5]); w.w = cvt_pk_bf16(v[o + 6], v[o + 7]); return __builtin_bit_cast(bf16x8, w); }
constexpr float ATT_NEG = -1e30f;
template <bool HALF>
__device__ __forceinline__ void softmax_tile(f32x16& p0, f32x16& p1, float& m, float& lsum, f32x16 (&O)[2], bf16x8 (&pb)[4]) {
    float mx = p0[0];
#pragma unroll
    for (int r = 1; r < 16; ++r) mx = fmaxf(mx, p0[r]);
    if (!HALF) {
#pragma unroll
        for (int r = 0; r < 16; ++r) mx = fmaxf(mx, p1[r]); }
    mx = xhalf_max(mx);
    const float mn = fmaxf(m, mx), alpha = __builtin_amdgcn_exp2f(m - mn);
    m = mn;
    float s = 0.f;
#pragma unroll
    for (int r = 0; r < 16; ++r) { p0[r] = __builtin_amdgcn_exp2f(p0[r] - mn); s += p0[r]; }
    if (!HALF) {
#pragma unroll
        for (int r = 0; r < 16; ++r) { p1[r] = __builtin_amdgcn_exp2f(p1[r] - mn); s += p1[r]; } }
    lsum = lsum * alpha + s;
#pragma unroll
    for (int r = 0; r < 16; ++r) { O[0][r] *= alpha; O[1][r] *= alpha; }
    pb[0] = pack8(p0, 0); pb[1] = pack8(p0, 8);
    if (!HALF) { pb[2] = pack8(p1, 0); pb[3] = pack8(p1, 8); }
}
constexpr int AKS = 72;
constexpr int ATT_KB = 0, ATT_VB = 2 * 64 * AKS * 2, ATT_FB = 4 * 64 * AKS * 2, ATT_SC = ATT_FB + 2 * 64 * 4;
__device__ __forceinline__ void attn_prompt_unit(KP p, int l, int h, int qb, LAS unsigned char* lds, int tid) {
    const bf16_t* U = (const bf16_t*)(p->ws + WS_U); const bf16_t* Vt = (const bf16_t*)(p->ws + WS_VT) + (size_t)h * 64 * TP; const float* F = (const float*)(p->ws + WS_FP) + (size_t)h * TP;
    const int wave = tid >> 6, lane = tid & 63, li = lane & 31, hi = lane >> 5;
    const int q0 = qb * 256, q = q0 + wave * 32 + li;
    bf16x8 qf[4];
    { const float sc = 0.125f * LOG2E;
#pragma unroll
      for (int d0 = 0; d0 < 4; ++d0) { const u32x4 w = *(const u32x4*)(U + (size_t)q * NU + U_Q + h * 64 + 16 * d0 + 8 * hi);
          qf[d0] = pack8f((f32x4){bflo(w.x) * sc, bfhi(w.x) * sc, bflo(w.y) * sc, bfhi(w.y) * sc}, (f32x4){bflo(w.z) * sc, bfhi(w.z) * sc, bflo(w.w) * sc, bfhi(w.w) * sc}); } }
    const float fq = F[q];
    float m = ATT_NEG, lsum = 0.f; f32x16 O[2] = {};
    const int NT = (q0 + 256) / 64;
    LAS float* qmx = (LAS float*)(lds + ATT_SC); LAS float* mmv = qmx + 8;
    { float q2 = 0.f;
#pragma unroll
      for (int d0 = 0; d0 < 4; ++d0) { const u32x4 w = __builtin_bit_cast(u32x4, qf[d0]); q2 += bflo(w.x) * bflo(w.x) + bfhi(w.x) * bfhi(w.x) + bflo(w.y) * bflo(w.y) + bfhi(w.y) * bfhi(w.y) + bflo(w.z) * bflo(w.z) + bfhi(w.z) * bfhi(w.z) + bflo(w.w) * bflo(w.w) + bfhi(w.w) * bfhi(w.w); }
      q2 = wave_max(xhalf_sum(q2)); if (lane == 0) { qmx[wave] = q2; mmv[wave] = ATT_NEG; } }
    const float kmax2 = __uint_as_float(((const unsigned*)(p->ws + WS_CTL))[CW_KMAX + l * 8 + h]), fq0 = F[q0];
    const int srow = tid >> 3, sch = tid & 7;
    const bf16_t* kg = U + (size_t)srow * NU + U_K + h * 64 + 8 * sch; const bf16_t* vg = Vt + (size_t)srow * TP + 8 * sch;
    LAS unsigned char* kdst = lds + ATT_KB + (srow * AKS + 8 * sch) * 2; LAS unsigned char* vdst = lds + ATT_VB + (srow * AKS + 8 * sch) * 2;
    u32x4 kr = *(const u32x4*)(kg + (size_t)(NT - 1) * 64 * NU), vr = *(const u32x4*)(vg + (NT - 1) * 64); float fr = tid < 64 ? F[(NT - 1) * 64 + tid] : 0.f;
    *(LAS u32x4*)kdst = kr; *(LAS u32x4*)vdst = vr; if (tid < 64) ((LAS float*)(lds + ATT_FB))[tid] = fr;
    __syncthreads();
    const int ka = krow(li);
    float qkb; { float q2 = qmx[0];
#pragma unroll
      for (int w = 1; w < 8; ++w) q2 = fmaxf(q2, qmx[w]);
      qkb = 1.02f * sqrtf(q2 * kmax2) + fq0; }
    for (int t = NT - 1, buf = 0; t >= 0; --t, buf ^= 1) {
        { float mmin = mmv[0];
#pragma unroll
          for (int w = 1; w < 8; ++w) mmin = fminf(mmin, mmv[w]);
          if (qkb - ((const LAS float*)(lds + ATT_FB))[buf * 64 + 63] < mmin - 40.f) break; }
        if (t > 0) { kr = *(const u32x4*)(kg + (size_t)(t - 1) * 64 * NU); vr = *(const u32x4*)(vg + (t - 1) * 64); if (tid < 64) fr = F[(t - 1) * 64 + tid]; }
        if (64 * t <= q0 + wave * 32 + 31) {
            const LAS bf16_t* Kb = (const LAS bf16_t*)(lds + ATT_KB) + buf * 64 * AKS; const LAS bf16_t* Vb = (const LAS bf16_t*)(lds + ATT_VB) + buf * 64 * AKS; const LAS float* Fb = (const LAS float*)(lds + ATT_FB) + buf * 64;
            f32x16 p0, p1;
#pragma unroll
            for (int g2 = 0; g2 < 2; ++g2) { const f32x4 a = *(const LAS f32x4*)(Fb + 8 * hi + 16 * g2), b = *(const LAS f32x4*)(Fb + 8 * hi + 16 * g2 + 4), c = *(const LAS f32x4*)(Fb + 32 + 8 * hi + 16 * g2), d = *(const LAS f32x4*)(Fb + 32 + 8 * hi + 16 * g2 + 4);
#pragma unroll
                for (int e = 0; e < 4; ++e) { p0[8 * g2 + e] = fq - a[e]; p0[8 * g2 + 4 + e] = fq - b[e]; p1[8 * g2 + e] = fq - c[e]; p1[8 * g2 + 4 + e] = fq - d[e]; } }
#pragma unroll
            for (int d0 = 0; d0 < 4; ++d0) { const bf16x8 a0 = *(const LAS bf16x8*)(Kb + ka * AKS + 16 * d0 + 8 * hi), a1 = *(const LAS bf16x8*)(Kb + (ka + 32) * AKS + 16 * d0 + 8 * hi);
                p0 = __builtin_amdgcn_mfma_f32_32x32x16_bf16(a0, qf[d0], p0, 0, 0, 0); p1 = __builtin_amdgcn_mfma_f32_32x32x16_bf16(a1, qf[d0], p1, 0, 0, 0); }
            if (64 * t + 63 > q0 + wave * 32) {
#pragma unroll
                for (int r = 0; r < 16; ++r) { const int kv = 64 * t + 8 * hi + 16 * (r >> 3) + (r & 7); if (kv > q) p0[r] = -INFINITY; if (kv + 32 > q) p1[r] = -INFINITY; } }
            bf16x8 pb[4];
            softmax_tile<false>(p0, p1, m, lsum, O, pb);
#pragma unroll
            for (int dt = 0; dt < 2; ++dt)
#pragma unroll
                for (int s = 0; s < 4; ++s) { const bf16x8 a = *(const LAS bf16x8*)(Vb + (32 * dt + li) * AKS + 16 * (s & 1) + 32 * (s >> 1) + 8 * hi);
                    O[dt] = __builtin_amdgcn_mfma_f32_32x32x16_bf16(a, pb[s], O[dt], 0, 0, 0); }
        }
        { const float wm = wave_min(m); if (lane == 0) mmv[wave] = wm; }
        if (t > 0) { const int nb = buf ^ 1; *(LAS u32x4*)(kdst + nb * 64 * AKS * 2) = kr; *(LAS u32x4*)(vdst + nb * 64 * AKS * 2) = vr; if (tid < 64) ((LAS float*)(lds + ATT_FB))[nb * 64 + tid] = fr; }
        __syncthreads();
    }
    __syncthreads();
    const float inv = 1.f / xhalf_sum(lsum);
    bf16_t* ob = (bf16_t*)(p->ws + WS_OCAT) + (size_t)1 * NTOK * 512 + (size_t)q * 512 + h * 64;
#pragma unroll
    for (int dt = 0; dt < 2; ++dt)
#pragma unroll
        for (int rg = 0; rg < 4; ++rg) { const int d = 32 * dt + 8 * rg + 4 * hi; const u32x2 sg = *(const u32x2*)(U + (size_t)q * NU + U_BSG + h * 64 + d);
            u32x2 w; w.x = cvt_pk_bf16(O[dt][rg * 4] * inv * siluf_(bflo(sg.x)), O[dt][rg * 4 + 1] * inv * siluf_(bfhi(sg.x))); w.y = cvt_pk_bf16(O[dt][rg * 4 + 2] * inv * siluf_(bflo(sg.y)), O[dt][rg * 4 + 3] * inv * siluf_(bfhi(sg.y)));
            *(u32x2*)(ob + d) = w; }
}
__device__ __forceinline__ void attn_sample_unit(KP p, int l, int b, int h, LAS unsigned char* lds, int tid) {
    const bf16_t* U = (const bf16_t*)(p->ws + WS_U);
    const int wave = tid >> 6, lane = tid & 63, li = lane & 31, hi = lane >> 5;
    const size_t qrow = (size_t)TP + b * 32 + li;
    const float* G = (const float*)(p->ws + WS_GS) + ((size_t)b * 8 + h) * GS_LEN;
    bf16x8 qf[4];
    { const float sc = 0.125f * LOG2E;
#pragma unroll
      for (int d0 = 0; d0 < 4; ++d0) { const u32x4 w = *(const u32x4*)(U + qrow * NU + U_Q + h * 64 + 16 * d0 + 8 * hi);
          qf[d0] = pack8f((f32x4){bflo(w.x) * sc, bfhi(w.x) * sc, bflo(w.y) * sc, bfhi(w.y) * sc}, (f32x4){bflo(w.z) * sc, bfhi(w.z) * sc, bflo(w.w) * sc, bfhi(w.w) * sc}); } }
    const float fq = G[PAST + li];
    float m = ATT_NEG, lsum = 0.f; f32x16 O[2] = {};
    const float* CK = p->in[I_CK] + (((size_t)l * 32 + b) * PAST) * 512 + h * 64; const float* CV = p->in[I_CV] + (((size_t)l * 32 + b) * PAST) * 512 + h * 64;
    const int ka = krow(li);
    for (int tt = 0; tt < 8; ++tt) {
        const int key0 = (wave * 8 + tt) * 64;
        f32x16 p0, p1;
#pragma unroll
        for (int g2 = 0; g2 < 2; ++g2) { const float* gp = G + key0 + 8 * hi + 16 * g2; const f32x4 a = *(const f32x4*)gp, bq = *(const f32x4*)(gp + 4), c = *(const f32x4*)(gp + 32), d = *(const f32x4*)(gp + 36);
#pragma unroll
            for (int e = 0; e < 4; ++e) { p0[8 * g2 + e] = fq - a[e]; p0[8 * g2 + 4 + e] = fq - bq[e]; p1[8 * g2 + e] = fq - c[e]; p1[8 * g2 + 4 + e] = fq - d[e]; } }
#pragma unroll
        for (int d0 = 0; d0 < 4; ++d0) { const float* k0p = CK + (size_t)(key0 + ka) * 512 + 16 * d0 + 8 * hi; const float* k1p = k0p + (size_t)32 * 512;
            const bf16x8 a0 = pack8f(*(const f32x4*)k0p, *(const f32x4*)(k0p + 4)), a1 = pack8f(*(const f32x4*)k1p, *(const f32x4*)(k1p + 4));
            p0 = __builtin_amdgcn_mfma_f32_32x32x16_bf16(a0, qf[d0], p0, 0, 0, 0); p1 = __builtin_amdgcn_mfma_f32_32x32x16_bf16(a1, qf[d0], p1, 0, 0, 0); }
        bf16x8 pb[4];
        softmax_tile<false>(p0, p1, m, lsum, O, pb);
#pragma unroll
        for (int dt = 0; dt < 2; ++dt)
#pragma unroll
            for (int s = 0; s < 4; ++s) { const float* vp = CV + (size_t)(key0 + 16 * (s & 1) + 32 * (s >> 1) + 8 * hi) * 512 + 32 * dt + li;
                const bf16x8 a = pack8f((f32x4){vp[0], vp[512], vp[1024], vp[1536]}, (f32x4){vp[2048], vp[2560], vp[3072], vp[3584]});
                O[dt] = __builtin_amdgcn_mfma_f32_32x32x16_bf16(a, pb[s], O[dt], 0, 0, 0); }
    }
    if (wave == 7) {
        f32x16 p0, p1 = {};
#pragma unroll
        for (int g2 = 0; g2 < 2; ++g2) { const float* gp = G + PAST + 8 * hi + 16 * g2; const f32x4 a = *(const f32x4*)gp, bq = *(const f32x4*)(gp + 4);
#pragma unroll
            for (int e = 0; e < 4; ++e) { p0[8 * g2 + e] = fq - a[e]; p0[8 * g2 + 4 + e] = fq - bq[e]; } }
#pragma unroll
        for (int d0 = 0; d0 < 4; ++d0) { const bf16x8 a0 = *(const bf16x8*)(U + ((size_t)TP + b * 32 + ka) * NU + U_K + h * 64 + 16 * d0 + 8 * hi);
            p0 = __builtin_amdgcn_mfma_f32_32x32x16_bf16(a0, qf[d0], p0, 0, 0, 0); }
#pragma unroll
        for (int r = 0; r < 16; ++r) { const int kv = 8 * hi + 16 * (r >> 3) + (r & 7); if (kv > li) p0[r] = -INFINITY; }
        bf16x8 pb[4];
        softmax_tile<true>(p0, p1, m, lsum, O, pb);
#pragma unroll
        for (int dt = 0; dt < 2; ++dt)
#pragma unroll
            for (int s = 0; s < 2; ++s) { const bf16_t* vp = U + ((size_t)TP + b * 32 + 16 * s + 8 * hi) * NU + U_V + h * 64 + 32 * dt + li; u32x4 w;
                w.x = (unsigned)vp[0] | ((unsigned)vp[NU] << 16); w.y = (unsigned)vp[2 * NU] | ((unsigned)vp[3 * NU] << 16); w.z = (unsigned)vp[4 * NU] | ((unsigned)vp[5 * NU] << 16); w.w = (unsigned)vp[6 * NU] | ((unsigned)vp[7 * NU] << 16);
                O[dt] = __builtin_amdgcn_mfma_f32_32x32x16_bf16(__builtin_bit_cast(bf16x8, w), pb[s], O[dt], 0, 0, 0); }
    }
    LAS float* Ow = (LAS float*)lds;
    LAS float* ML = Ow + 8 * 32 * 64;
    lsum = xhalf_sum(lsum);
#pragma unroll
    for (int dt = 0; dt < 2; ++dt)
#pragma unroll
        for (int r = 0; r < 16; ++r) Ow[(wave * 32 + dt * 16 + r) * 64 + lane] = O[dt][r];
    if (hi == 0) { ML[(wave * 2) * 32 + li] = m; ML[(wave * 2 + 1) * 32 + li] = lsum; }
    __syncthreads();
    { const int qq = tid & 31, dg = tid >> 5; float M = ATT_NEG;
#pragma unroll
      for (int w = 0; w < 8; ++w) M = fmaxf(M, ML[(w * 2) * 32 + qq]);
      float L = 0.f; f32x4 o = {0.f, 0.f, 0.f, 0.f};
      const int d = 4 * dg, idx0 = (d >> 5) * 16 + ((d >> 3) & 3) * 4, ln = ((d >> 2) & 1) * 32 + qq;
#pragma unroll
      for (int w = 0; w < 8; ++w) { const float f = __builtin_amdgcn_exp2f(ML[(w * 2) * 32 + qq] - M); L += ML[(w * 2 + 1) * 32 + qq] * f;
#pragma unroll
          for (int e = 0; e < 4; ++e) o[e] += Ow[(w * 32 + idx0 + e) * 64 + ln] * f; }
      const float inv = 1.f / L; const size_t row = (size_t)TP + b * 32 + qq;
      const u32x2 sg = *(const u32x2*)(U + row * NU + U_BSG + h * 64 + d);
      u32x2 wv; wv.x = cvt_pk_bf16(o[0] * inv * siluf_(bflo(sg.x)), o[1] * inv * siluf_(bfhi(sg.x))); wv.y = cvt_pk_bf16(o[2] * inv * siluf_(bflo(sg.y)), o[3] * inv * siluf_(bfhi(sg.y)));
      *(u32x2*)((bf16_t*)(p->ws + WS_OCAT) + (size_t)1 * NTOK * 512 + row * 512 + h * 64 + d) = wv; }
    __syncthreads();
}
constexpr int NPHASE = 22;
__global__ void __launch_bounds__(512, 2) hse_fwd(Params p_) {
    const KP kp = (KP)__builtin_amdgcn_kernarg_segment_ptr();
    (void)p_;
    extern __shared__ __attribute__((aligned(16))) unsigned char lds_raw[];
    LAS unsigned char* lds = (LAS unsigned char*)lds_raw;
    const int tid0 = threadIdx.x;
    const int G = gridDim.x, bid = blockIdx.x, ngw = G * 8;
#define PH_LOCALS const KP p = kp_fresh(kp); int tid = tid0; asm volatile("" : "+v"(tid)); const int lane = tid & 63, wave = __builtin_amdgcn_readfirstlane(tid >> 6), gw = bid * 8 + wave; (void)lane; (void)gw; (void)p;
    if (tid0 < 4) ((LAS unsigned*)(lds + LDS_XB_OFF))[tid0] = 0u;
#if PROBE_ID
    if (tid0 == 0) *(LAS unsigned long long*)(lds + LDS_PROBE_OFF) = 0ull;
#endif
    __syncthreads();
    unsigned* ctl = (unsigned*)(kp->ws + WS_CTL);
    XcdBarrier bar = xcd_barrier_post(ctl + CW_BAR + kp->li * XCD_BAR_WORDS, (volatile LAS unsigned*)(lds + LDS_XB_OFF));
    const int lo = kp->ph_lo, hi = kp->ph_hi;
#define IN(k) (lo <= (k) && (k) < hi)
#ifndef DUP_MASK
#define DUP_MASK 0
#endif
#define NREP(k) (((DUP_MASK >> (k)) & 1) + 1)
#define SEAM(k) do { if (IN(k) && IN((k) + 1)) xcd_barrier(bar); } while (0)
    if (IN(0)) { PH_LOCALS
        for (int u = bid; u < 192; u += G) ada_unit(p, u, lds, tid);
        p0_weights(p, lds, gw, ngw, wave, lane);
    }
    SEAM(0);
    for (int l = 0; l < NLAYER; ++l) {
        const int pb = 1 + 10 * l;
        for (int rep = 0; rep < NREP(0); ++rep) { if (rep) xcd_barrier(bar);
        if (IN(pb)) { PH_LOCALS p1_rows(p, l, gw, ngw, lane); } }
        SEAM(pb);
        for (int rep = 0; rep < NREP(1); ++rep) { if (rep) xcd_barrier(bar);
        if (IN(pb + 1)) { PH_LOCALS
            pg8::Gemm g{(const bf16_t*)(p->ws + WS_H), (const bf16_t*)(p->ws + WS_WIN) + (size_t)l * NU * 2048, NTOK, NU, 2048};
            pg8::StaticOrder S; S.init(NTOK, NU, G, bid);
            EpiU E{(bf16_t*)(p->ws + WS_U), p->out, p->in[I_BF], l};
            pg8::gemm_phase<EpiU, pg8::StaticOrder>(lds, g, S, E, nullptr);
        }
        }
        SEAM(pb + 1);
        for (int rep = 0; rep < NREP(2); ++rep) { if (rep) xcd_barrier(bar);
        if (IN(pb + 2)) { PH_LOCALS
#ifndef DUP_SUB
#define DUP_SUB 0
#endif
            for (int u = bid; u < NRU * ((DUP_SUB & 1) + 1); u += G) rwkv_r1(p, l, u % NRU, lds, tid);
            for (int u = bid; u < 544 * (((DUP_SUB >> 1) & 1) + 1); u += G) conv_unit(p, l, u % 544, lds, tid);
            for (int u = bid; u < 544 * (((DUP_SUB >> 2) & 1) + 1); u += G) pool_unit(p, l, u % 544, lds, tid);
            for (int u = bid; u < 256; u += G) { vt_tile(p, l, u * 8 + wave, lds, wave, lane); }
            __syncthreads();
            for (int u = bid; u < 32; u += G) gs_unit(p, l, u, lds, tid);
            for (int u = G - 1 - bid; u < 8; u += G) fp_unit(p, l, u, lds, tid);
            if (bid == G / 2) shift_out(p, l, tid);
        }
        }
        SEAM(pb + 2);
        for (int rep = 0; rep < NREP(3); ++rep) { if (rep) xcd_barrier(bar);
        if (IN(pb + 3)) { PH_LOCALS
            if (wave < 4) for (int tk = bid * 4 + wave; tk < 1024; tk += G * 4) rwkv_l1_task(p, tk, lane);
            __syncthreads();
            LAS int* qslot = (LAS int*)(lds + LDS_XB_OFF - 16);
            for (;;) {
                if (tid == 0) *qslot = (int)atomicAdd(ctl + CW_QUEUE + 64 * (2 * l + 4 * rep), 1u);
                __syncthreads();
                const int item = *qslot;
                __syncthreads();
                if (item >= 512) break;
                attn_prompt_unit(p, l, item & 7, 63 - (item >> 3), lds, tid);
            }
            for (;;) {
                if (tid == 0) *qslot = (int)atomicAdd(ctl + CW_QUEUE + 64 * (2 * l + 1 + 4 * rep), 1u);
                __syncthreads();
                const int item = *qslot;
                __syncthreads();
                if (item >= 256) break;
                attn_sample_unit(p, l, item >> 3, item & 7, lds, tid);
            }
        }
        }
        SEAM(pb + 3);
        if (IN(pb + 4)) { PH_LOCALS if (wave == 0 && bid < 32) rwkv_l2_task(p, l, bid, lane); }
        SEAM(pb + 4);
        if (IN(pb + 5)) { PH_LOCALS for (int tk = (wave * G + bid); tk < 512 + 1024; tk += ngw) rwkv_l3_task(p, l, tk, lane); }
        SEAM(pb + 5);
        if (IN(pb + 6)) { PH_LOCALS for (int tk = gw; tk < NRU * 2; tk += ngw) rwkv_r3_task(p, l, tk, lane); }
        SEAM(pb + 6);
        for (int rep = 0; rep < NREP(7); ++rep) { if (rep) xcd_barrier(bar);
        if (IN(pb + 7)) { PH_LOCALS
            pg8::Gemm g{(const bf16_t*)(p->ws + WS_OCAT), (const bf16_t*)(p->ws + WS_WBR) + (size_t)l * 4 * 2048 * 512, 4 * NTOK, 4 * 2048, 512};
            BranchOrder S{G, bid};
            EpiZ E{(bf16_t*)(p->ws + WS_Z)};
            pg8::gemm_phase<EpiZ, BranchOrder>(lds, g, S, E, nullptr);
        }
        }
        SEAM(pb + 7);
        if (IN(pb + 8)) { PH_LOCALS merge_pass(p, bid * 512 + tid, G * 512); }
        SEAM(pb + 8);
        if (IN(pb + 9)) { PH_LOCALS
            pg8::Gemm g{(const bf16_t*)(p->ws + WS_MERGED), (const bf16_t*)(p->ws + WS_WOUT) + (size_t)l * 2048 * 2048, NTOK, 2048, 2048};
            pg8::StaticOrder S; S.init(NTOK, 2048, G, bid);
            EpiOut E{p->in[I_XP], p->in[I_XS], (const float*)(p->ws + WS_XBUF), (const float*)(p->ws + WS_ADA), (float*)(p->ws + WS_XBUF), l};
            pg8::gemm_phase<EpiOut, pg8::StaticOrder>(lds, g, S, E, nullptr);
        }
        SEAM(pb + 9);
    }
    if (IN(21)) { PH_LOCALS p_final_rows(p, gw, ngw, lane); }
#if PROBE_ID
    if (bid == 0 && tid0 == 0) { const unsigned long long w = *(LAS unsigned long long*)(lds + LDS_PROBE_OFF) * PROBE_K, t0 = __builtin_amdgcn_s_memrealtime(); while (__builtin_amdgcn_s_memrealtime() - t0 < w) __builtin_amdgcn_s_sleep(8); }
#endif
#undef IN
#undef SEAM
}
#ifndef MK_SPLIT
#define MK_SPLIT 0
#endif
extern "C" void kernel_launch(void* const* d_in, const int* in_sizes, int n_in, void* d_out, int out_size, void* d_ws, size_t ws_size, hipStream_t stream) {
    static int grid = 0;
    if (grid == 0) {
        if (n_in != N_IN || (size_t)out_size != O_END || ws_size < WS_END) { fprintf(stderr, "kernel_launch: unexpected shapes (n_in %d, out %d, ws %zu)\n", n_in, out_size, ws_size); grid = -1; return; }
        int dev = 0, cus = 0, per_cu = 0;
        if (hipGetDevice(&dev) != hipSuccess || hipDeviceGetAttribute(&cus, hipDeviceAttributeMultiprocessorCount, dev) != hipSuccess) { grid = -1; return; }
        if (hipFuncSetAttribute((const void*)hse_fwd, hipFuncAttributeMaxDynamicSharedMemorySize, LDS_BYTES) != hipSuccess) { fprintf(stderr, "kernel_launch: hipFuncSetAttribute failed\n"); grid = -1; return; }
        if (hipOccupancyMaxActiveBlocksPerMultiprocessor(&per_cu, (const void*)hse_fwd, 512, LDS_BYTES) != hipSuccess || per_cu < 1) fprintf(stderr, "kernel_launch: occupancy query reports %d\n", per_cu);
        (void)hipGetLastError();
        grid = cus;
    }
    if (grid < 0) return;
    if (hipMemsetAsync((char*)d_ws + WS_CTL, 0, CTL_BYTES, stream) != hipSuccess) return;
    Params a{};
    for (int i = 0; i < N_IN; ++i) a.in[i] = (const float*)d_in[i];
    a.out = (float*)d_out; a.ws = (unsigned char*)d_ws;
#if MK_SPLIT
    for (int ph = 0; ph < NPHASE; ++ph) { a.ph_lo = ph; a.ph_hi = ph + 1; a.li = ph; hipLaunchKernelGGL(hse_fwd, dim3(grid), dim3(512), LDS_BYTES, stream, a); }
#else
    a.ph_lo = 0; a.ph_hi = NPHASE; a.li = 0;
    hipLaunchKernelGGL(hse_fwd, dim3(grid), dim3(512), LDS_BYTES, stream, a);
#endif
    const hipError_t le = hipPeekAtLastError();
    if (le != hipSuccess) fprintf(stderr, "kernel_launch: launch failed: %s\n", hipGetErrorName(le));
}
```

```cpp
#include <hip/hip_runtime.h>
#include <cstdio>
#include <cstdint>
namespace pg8 {
#define PG8_LAS __attribute__((address_space(3)))
typedef unsigned short bf16_t;
typedef short bf16x8 __attribute__((ext_vector_type(8)));
typedef float f32x4 __attribute__((ext_vector_type(4)));
typedef unsigned u32x4 __attribute__((ext_vector_type(4)));
constexpr int BM = 256, BK = 64, HALF = 128, HTB = HALF * BK * 2  , STAGE_BYTES = 8 * HTB, NXCD = 8, WGM = 8;

__host__ __device__ __forceinline__ int lds_byte(int r, int c) { const int st = (r >> 4) * 2 + (c >> 5), rr = r & 15, cc = c & 31, ob = rr * 64 + cc * 2; return st * 1024 + (ob ^ (((ob >> 9) & 1) << 5)); }
__host__ __device__ __forceinline__ void stage_rc(int b, int& R, int& C) { const int st = b / 1024, sb = b % 1024, swz = sb ^ (((sb >> 9) & 1) << 5); R = (st >> 1) * 16 + swz / 64; C = (st & 1) * 32 + (swz % 64) / 2; }
__host__ __device__ __forceinline__ int perm32(int rho) { const int n = rho >> 4, i = rho & 15; return 8 * (i >> 2) + 4 * n + (i & 3); }

struct Unit { int pm, pn; };
struct Gemm { const bf16_t* A; const bf16_t* Bt; int M, N, K; };

struct StaticOrder {
    int nM, nN, nwg, G, c;
    __host__ __device__ void init(int M, int N, int G_, int c_) { nM = M / BM; nN = N / BM; nwg = nM * nN; G = G_; c = c_; }
    __host__ __device__ bool next(int i, Unit& u) const {
        const long L = (long)i * G + c; if (L >= nwg) return false;
        int wgid = (int)L; { const int q = nwg / NXCD, r = nwg % NXCD, xcd = wgid % NXCD, off = wgid / NXCD; wgid = (xcd < r ? xcd * (q + 1) : r * (q + 1) + (xcd - r) * q) + off; }
        const int nig = WGM * nN, gid = wgid / nig, fm = gid * WGM, gsz = (nM - fm) < WGM ? (nM - fm) : WGM;
        u.pm = fm + ((wgid % nig) % gsz); u.pn = (wgid % nig) / gsz; return true;
    }
    __device__ __forceinline__ void a_ready(const Unit&) const {}
    __device__ __forceinline__ void done(const Unit&) const {}
};
__device__ __forceinline__ unsigned cvt_pk_bf16(float lo, float hi) { unsigned r; asm volatile("v_cvt_pk_bf16_f32 %0, %1, %2" : "=v"(r) : "v"(lo), "v"(hi)); return r; }
typedef float f32x2 __attribute__((ext_vector_type(2)));
template <class Epi, class Sched, bool STAMP = false>
__device__ __forceinline__ void gemm_phase(PG8_LAS unsigned char* lds, const Gemm g, const Sched& S, const Epi& E, unsigned long long* stamps) {
    int tid = threadIdx.x; asm volatile("" : "+v"(tid));
    const int wid = __builtin_amdgcn_readfirstlane(tid >> 6), lane = tid & 63, wr = wid >> 2, wc = wid & 3, fr = lane & 15, fq = lane >> 4;
    const int K = g.K, nt = K / BK;
    int ts_lo = 0, ts_hi = 0, nts = 0; const unsigned long long rt_entry = STAMP ? (unsigned long long)wall_clock64() : 0ull;
#define PG8_STAMP() do { if (STAMP && wid == 0 && nts < 64) { const unsigned long long _c = (unsigned long long)clock64(); \
        ts_lo = (lane == nts) ? (int)(unsigned)_c : ts_lo; ts_hi = (lane == nts) ? (int)(unsigned)(_c >> 32) : ts_hi; ++nts; } } while (0)
    PG8_STAMP();
    unsigned voffA[2], voffB[2];
#pragma unroll
    for (int i = 0; i < 2; ++i) { int R, C; stage_rc(tid * 16 + i * 8192, R, C); const int Rb = Epi::PERM ? ((R & ~31) + perm32(R & 31)) : R;
        voffA[i] = (unsigned)(R * K + C) * 2u; voffB[i] = (unsigned)(Rb * K + C) * 2u; }
    const size_t kstep = (size_t)(BK * 2);
    const size_t hstep = (size_t)HALF * K * 2;
    const size_t tstep = 2 * hstep;
    const unsigned ldsw = (unsigned)wid * 1024u;
    const int aoff = lds_byte(wr * 64 + fr, fq * 8), boff = lds_byte(wc * 32 + fr, fq * 8);
#define PG8_SA(b, h) (((b) * 2 + (h)) * HTB)
#define PG8_SB(b, h) ((4 + (b) * 2 + (h)) * HTB)
#define PG8_STAGE(bufoff, gbase, voff) do { _Pragma("unroll") for (int _i = 0; _i < 2; ++_i) \
        __builtin_amdgcn_global_load_lds((const unsigned*)((const char*)(gbase) + (voff)[_i]), (PG8_LAS unsigned*)(lds + (bufoff) + ldsw + _i * 8192), 16, 0, 0); } while (0)
#define PG8_LDA(dst, b, h) do { _Pragma("unroll") for (int m = 0; m < 4; ++m) _Pragma("unroll") for (int k = 0; k < 2; ++k) dst[m][k] = *(const PG8_LAS bf16x8*)(lds + PG8_SA(b, h) + aoff + m * 2048 + k * 1024); } while (0)
#define PG8_LDB(dst, b, h) do { _Pragma("unroll") for (int n = 0; n < 2; ++n) _Pragma("unroll") for (int k = 0; k < 2; ++k) dst[n][k] = *(const PG8_LAS bf16x8*)(lds + PG8_SB(b, h) + boff + n * 2048 + k * 1024); } while (0)
#define PG8_MMA(ai, bj, At, Bt) do { __builtin_amdgcn_s_setprio(1); _Pragma("unroll") for (int m = 0; m < 4; ++m) _Pragma("unroll") for (int n = 0; n < 2; ++n) _Pragma("unroll") for (int k = 0; k < 2; ++k) \
        acc[ai][bj][m][n] = __builtin_amdgcn_mfma_f32_16x16x32_bf16(Bt[n][k], At[m][k], acc[ai][bj][m][n], 0, 0, 0); __builtin_amdgcn_s_setprio(0); } while (0)
#define PG8_WAIT_V(n) asm volatile("s_waitcnt vmcnt(" #n ")" ::: "memory")
#define PG8_WAIT_L(n) asm volatile("s_waitcnt lgkmcnt(" #n ")" ::: "memory")
#define PG8_BAR __builtin_amdgcn_s_barrier()
#define PG8_SCHED __builtin_amdgcn_sched_barrier(0)
    Unit cur, nxt; int ui = 0;
    if (!S.next(0, cur)) return;
    f32x4 acc[2][2][4][2];
#pragma unroll
    for (int a = 0; a < 2; ++a)
#pragma unroll
        for (int b = 0; b < 2; ++b)
#pragma unroll
            for (int m = 0; m < 4; ++m)
#pragma unroll
                for (int n = 0; n < 2; ++n) acc[a][b][m][n] = (f32x4){0.f, 0.f, 0.f, 0.f};
    bf16x8 At[4][2], B0[2][2], B1[2][2];
    const char* cA = (const char*)g.A + (size_t)cur.pm * tstep; const char* cB = (const char*)g.Bt + (size_t)cur.pn * tstep;
    S.a_ready(cur);
    PG8_STAGE(PG8_SB(0, 0), cB, voffB); PG8_STAGE(PG8_SA(0, 0), cA, voffA); PG8_STAGE(PG8_SB(0, 1), cB + hstep, voffB); PG8_STAGE(PG8_SA(0, 1), cA + hstep, voffA);
    if (wr == 1) PG8_BAR;
    PG8_WAIT_V(4); PG8_BAR;
    PG8_STAGE(PG8_SB(1, 0), cB + kstep, voffB); PG8_STAGE(PG8_SA(1, 0), cA + kstep, voffA); PG8_STAGE(PG8_SB(1, 1), cB + hstep + kstep, voffB);
    PG8_WAIT_V(6); PG8_BAR;
    PG8_STAMP();
    for (;;) {
        const bool has_next = S.next(ui + 1, nxt);
        const char* nA = has_next ? (const char*)g.A + (size_t)nxt.pm * tstep : cA; const char* nB = has_next ? (const char*)g.Bt + (size_t)nxt.pn * tstep : cB;
        for (int t = 0; t < nt; t += 2) {
            const bool last = (t == nt - 2);
            const char* a1 = cA + (size_t)(t + 1) * kstep;
            const char* a2 = last ? nA : cA + (size_t)(t + 2) * kstep; const char* b2 = last ? nB : cB + (size_t)(t + 2) * kstep;
            const char* a3 = a2 + kstep; const char* b3 = b2 + kstep;
            if (last && has_next) S.a_ready(nxt);
            PG8_LDB(B0, 0, 0); PG8_SCHED; PG8_LDA(At, 0, 0); PG8_STAGE(PG8_SA(1, 1), a1 + hstep, voffA);
            PG8_WAIT_L(8); PG8_BAR; PG8_WAIT_L(0); PG8_MMA(0, 0, At, B0); PG8_BAR; PG8_SCHED;
            PG8_LDB(B1, 0, 1); PG8_STAGE(PG8_SB(0, 0), b2, voffB);
            PG8_BAR; PG8_WAIT_L(0); PG8_MMA(0, 1, At, B1); PG8_BAR;
            PG8_LDA(At, 0, 1); PG8_STAGE(PG8_SA(0, 0), a2, voffA);
            PG8_BAR; PG8_WAIT_L(0); PG8_MMA(1, 0, At, B0); PG8_BAR; PG8_SCHED;
            PG8_STAGE(PG8_SB(0, 1), b2 + hstep, voffB);
            PG8_WAIT_V(6); PG8_BAR; PG8_MMA(1, 1, At, B1); PG8_BAR;
            PG8_LDB(B0, 1, 0); PG8_SCHED; PG8_LDA(At, 1, 0); PG8_STAGE(PG8_SA(0, 1), a2 + hstep, voffA);
            PG8_WAIT_L(8); PG8_BAR; PG8_WAIT_L(0); PG8_MMA(0, 0, At, B0); PG8_BAR; PG8_SCHED;
            PG8_LDB(B1, 1, 1); PG8_STAGE(PG8_SB(1, 0), b3, voffB);
            PG8_BAR; PG8_WAIT_L(0); PG8_MMA(0, 1, At, B1); PG8_BAR;
            PG8_LDA(At, 1, 1); PG8_STAGE(PG8_SA(1, 0), a3, voffA);
            PG8_BAR; PG8_WAIT_L(0); PG8_MMA(1, 0, At, B0); PG8_BAR; PG8_SCHED;
            PG8_STAGE(PG8_SB(1, 1), b3 + hstep, voffB);
            PG8_WAIT_V(6); PG8_BAR; PG8_MMA(1, 1, At, B1); PG8_BAR;
        }
        PG8_STAMP();
        if constexpr (!Epi::AFTER_DRAIN) { E(acc, cur, wr, wc, fr, fq); S.done(cur); }
        PG8_STAMP();
        if (!has_next) break;
#pragma unroll
        for (int a = 0; a < 2; ++a)
#pragma unroll
            for (int b = 0; b < 2; ++b)
#pragma unroll
                for (int m = 0; m < 4; ++m)
#pragma unroll
                    for (int n = 0; n < 2; ++n) acc[a][b][m][n] = (f32x4){0.f, 0.f, 0.f, 0.f};
        cur = nxt; cA = nA; cB = nB; ++ui;
    }
    PG8_WAIT_V(0);
    if (wr == 0) PG8_BAR;
    PG8_BAR;
    if constexpr (Epi::AFTER_DRAIN) { E.fused(acc, cur, wr, wc, fr, fq, lds, wid, lane); S.done(cur); }
    PG8_STAMP();
    if (STAMP && wid == 0) { stamps[lane] = lane < nts ? (((unsigned long long)(unsigned)ts_hi << 32) | (unsigned)ts_lo) : 0ull;
        if (lane == 62) stamps[62] = rt_entry; if (lane == 63) stamps[63] = (unsigned long long)wall_clock64(); }
#undef PG8_STAMP
#undef PG8_SA
#undef PG8_SB
#undef PG8_STAGE
#undef PG8_LDA
#undef PG8_LDB
#undef PG8_MMA
#undef PG8_WAIT_V
#undef PG8_WAIT_L
#undef PG8_BAR
#undef PG8_SCHED
}
}
#define XB_TMO      128
#define XB_XCNT(j)  (256  + 64 * (j))
#define XB_XSUB(j)  (1280 + 64 * (j))
#define XB_XGEN(j)  (2304 + 64 * (j))
#define XB_TOP      3328
#define XB_TOPGEN   3392
#define XCD_BAR_WORDS 3456
#define XB_SPIN_CAP (1u << 18)
#define LAS __attribute__((address_space(3)))

__device__ __forceinline__ unsigned xb_ld(unsigned* p)              { return __hip_atomic_load(p, __ATOMIC_RELAXED, __HIP_MEMORY_SCOPE_AGENT); }
__device__ __forceinline__ unsigned xb_add(unsigned* p, unsigned v) { return __hip_atomic_fetch_add(p, v, __ATOMIC_RELAXED, __HIP_MEMORY_SCOPE_AGENT); }
__device__ __forceinline__ unsigned xb_xcc_id() { return (unsigned)__builtin_amdgcn_s_getreg((3 << 11) | 20) & 0xFu; }
#define XB_SPIN(cond, bar) do { unsigned _sp = 0; while (cond) { __builtin_amdgcn_s_sleep(1); \
    if ((++_sp & 255u) == 0u) { if (xb_ld(&(bar)[XB_TMO])) break; if (_sp > XB_SPIN_CAP) { atomicAdd(&(bar)[XB_TMO], 1u); break; } } } } while (0)

struct XcdBarrier {
    unsigned* bar; unsigned x;
    volatile LAS unsigned* st;
};

__device__ __forceinline__ XcdBarrier xcd_barrier_post(unsigned* bar, volatile LAS unsigned* st) {
    XcdBarrier b; b.bar = bar; b.x = xb_xcc_id(); b.st = st;
    if (threadIdx.x == 0) (void)xb_add(&bar[XB_XCNT(b.x)], 1u);
    return b;
}
__device__ __forceinline__ void xcd_barrier_complete(unsigned* bar, unsigned x, unsigned& nloc, unsigned& nx) {
    const unsigned G = gridDim.x * gridDim.y * gridDim.z;
    unsigned sum, cnt, mine, sp = 0u;
    for (;;) {
        sum = 0u; cnt = 0u; mine = 0u;
#pragma unroll
        for (unsigned j = 0; j < 16; ++j) { const unsigned c = xb_ld(&bar[XB_XCNT(j)]); sum += c; cnt += (c > 0u) ? 1u : 0u; mine = (j == x) ? c : mine; }
        if (sum == G) break;
        __builtin_amdgcn_s_sleep(1);
        if ((++sp & 255u) == 0u) { if (xb_ld(&bar[XB_TMO])) break; if (sp > XB_SPIN_CAP) { atomicAdd(&bar[XB_TMO], 1u); break; } }
    }
    nloc = mine > 0u ? mine : 1u; nx = cnt > 0u ? cnt : 1u;
}

__device__ __forceinline__ void xcd_barrier(const XcdBarrier& b) {
    asm volatile("s_waitcnt vmcnt(0)" ::: "memory");
    __syncthreads();
    if (threadIdx.x == 0) {
        unsigned* bar = b.bar;
        __builtin_amdgcn_s_waitcnt(0);
        unsigned nloc = b.st[0], nx = b.st[1];
        if (nloc == 0u) { xcd_barrier_complete(bar, b.x, nloc, nx); b.st[0] = nloc; b.st[1] = nx; }
        const unsigned old = xb_add(&bar[XB_XSUB(b.x)], 1u);
        const unsigned gen = old / nloc;
        if (old + 1u == (gen + 1u) * nloc) {
            __builtin_amdgcn_fence(__ATOMIC_RELEASE, "agent");
            asm volatile("s_waitcnt vmcnt(0)" ::: "memory");
            const unsigned og = xb_add(&bar[XB_TOP], 1u);
            const unsigned tg = og / nx;
            if (og + 1u == (tg + 1u) * nx) xb_add(&bar[XB_TOPGEN], 1u);
            else XB_SPIN(xb_ld(&bar[XB_TOPGEN]) == tg, bar);
            __builtin_amdgcn_fence(__ATOMIC_ACQUIRE, "agent");
            xb_add(&bar[XB_XGEN(b.x)], 1u);
            asm volatile("s_waitcnt vmcnt(0)" ::: "memory");
        } else {
            XB_SPIN(xb_ld(&bar[XB_XGEN(b.x)]) == gen, bar);
            __builtin_amdgcn_fence(__ATOMIC_ACQUIRE, "agent");
            asm volatile("s_waitcnt vmcnt(0)" ::: "memory");
        }
    }
    __syncthreads();
}
typedef unsigned short bf16_t;
typedef short bf16x8 __attribute__((ext_vector_type(8)));
typedef float f32x4 __attribute__((ext_vector_type(4)));
typedef float f32x16 __attribute__((ext_vector_type(16)));
typedef unsigned u32x4 __attribute__((ext_vector_type(4)));
typedef unsigned u32x2 __attribute__((ext_vector_type(2)));
using pg8::cvt_pk_bf16;

constexpr int DM = 2048, TP = 16384, NSB = 32, TSQ = 32, NTOK = TP + NSB * TSQ, NSEQ = 33, PAST = 4096, NLAYER = 2;
constexpr int NU = 15104;
constexpr int U_AVAL = 0, U_AGATE = 512, U_ASG = 1024, U_Q = 1536, U_K = 2048, U_V = 2560, U_BSG = 3072, U_XC = 3584, U_CSG = 5248, U_DIN = 5760, U_DSG = 6272, U_G = 6784, U_F = 14976;
constexpr int IN_W = 14984, SHIFT_W = 1664;
constexpr float LOG2E = 1.4426950408889634f;
enum { I_XP = 0, I_XS, I_CK, I_CV, I_CLF, I_SCONV, I_SSHIFT, I_SWKV, I_SPOOL, I_CP, I_CS, I_NORMG, I_WADA, I_BADA, I_WIN, I_BF, I_CONVW, I_CONVB, I_CLNG, I_CLNB, I_MU, I_W0, I_W2, I_A0, I_A2,
       I_KK, I_KA, I_RK, I_GNG, I_GNB, I_POOLW, I_POOLB, I_POOLS, I_WBR, I_WOUT, I_FING, N_IN };
constexpr size_t O_YP = 0, O_YS = O_YP + (size_t)TP * DM, O_PK = O_YS + (size_t)1024 * DM, O_PV = O_PK + (size_t)2 * TP * 512, O_PLF = O_PV + (size_t)2 * TP * 512, O_PCONV = O_PLF + (size_t)2 * TP * 8,
                 O_PSHIFT = O_PCONV + 2 * 30 * 512, O_PWKV = O_PSHIFT + 2 * 1664, O_PPOOL = O_PWKV + 2 * 8 * 64 * 64, O_SK = O_PPOOL + 2 * 15 * 512, O_SV = O_SK + (size_t)2 * 1024 * 512,
                 O_SLF = O_SV + (size_t)2 * 1024 * 512, O_SCONV = O_SLF + 2 * 1024 * 8, O_SSHIFT = O_SCONV + (size_t)2 * 32 * 30 * 512, O_SWKV = O_SSHIFT + 2 * 32 * 1664,
                 O_SPOOL = O_SWKV + (size_t)2 * 32 * 8 * 64 * 64, O_END = O_SPOOL + (size_t)2 * 32 * 15 * 512;
static_assert(O_END == 75374848, "output size");
constexpr size_t al256(size_t x) { return (x + 255) & ~(size_t)255; }
constexpr int NCU_CH = 288, NRU = NCU_CH * 8;
constexpr size_t WS_CTL = 0, CTL_BYTES = 512 * 1024;
constexpr size_t WS_WIN = CTL_BYTES;
constexpr size_t WS_WBR = al256(WS_WIN + (size_t)2 * NU * 2048 * 2);
constexpr size_t WS_WOUT = al256(WS_WBR + (size_t)2 * 4 * 2048 * 512 * 2);
constexpr size_t WS_POOLW = al256(WS_WOUT + (size_t)2 * 2048 * 2048 * 2);
constexpr size_t WS_ADA = al256(WS_POOLW + (size_t)2 * 4 * 128 * 128 * 2);
constexpr size_t WS_H = al256(WS_ADA + (size_t)2 * 33 * 6144 * 4);
constexpr size_t WS_U = al256(WS_H + (size_t)NTOK * 2048 * 2);
constexpr size_t WS_XBUF = al256(WS_U + (size_t)NTOK * NU * 2);
constexpr size_t WS_OCAT = al256(WS_XBUF + (size_t)NTOK * 2048 * 4);
constexpr size_t WS_Z = al256(WS_OCAT + (size_t)4 * NTOK * 512 * 2);
constexpr size_t WS_MERGED = al256(WS_Z + (size_t)4 * NTOK * 2048 * 2);
constexpr size_t WS_FP = al256(WS_MERGED + (size_t)NTOK * 2048 * 2);
constexpr int GS_LEN = PAST + TSQ;
constexpr size_t WS_GS = al256(WS_FP + (size_t)8 * TP * 4);
constexpr size_t WS_VT = al256(WS_GS + (size_t)32 * 8 * GS_LEN * 4);
constexpr size_t WS_TQ = al256(WS_VT + (size_t)8 * 64 * TP * 2);
constexpr size_t WS_GM = al256(WS_TQ + (size_t)NRU * 4096 * 4);
constexpr size_t WS_ET = al256(WS_GM + (size_t)NRU * 4096 * 4);
constexpr size_t WS_Y0T = al256(WS_ET + (size_t)NRU * 4096 * 4);
constexpr size_t WS_SC = al256(WS_Y0T + (size_t)NRU * 4096 * 4);
constexpr size_t WS_BONUS = al256(WS_SC + (size_t)NRU * 4096 * 4);
constexpr size_t WS_GG = al256(WS_BONUS + (size_t)NRU * 64 * 4);
constexpr size_t WS_TG = al256(WS_GG + (size_t)16 * 8 * 4096 * 4);
constexpr size_t WS_SG = al256(WS_TG + (size_t)16 * 8 * 4096 * 4);
constexpr size_t WS_END = al256(WS_SG + (size_t)16 * 8 * 4096 * 4);
static_assert(WS_END < (size_t)2100 * 1024 * 1024, "workspace map exceeds the guaranteed d_ws size");
constexpr int CW_BAR = 0;
constexpr int CW_QUEUE = 16 * 3456 + 64;
constexpr int CW_KMAX = CW_QUEUE + 64 * 8;
static_assert((CW_KMAX + 64) * 4 <= (int)CTL_BYTES, "ctl");
constexpr int LDS_BYTES = 163840 - 256;
constexpr int LDS_XB_OFF = LDS_BYTES - 16;
constexpr int SLOT_F = 64 * 65;

#ifndef PROBE_ID
#define PROBE_ID 0
#endif
#ifndef PROBE_K
#define PROBE_K 1
#endif
constexpr int LDS_PROBE_OFF = 163840 - 256 - 64;
#if PROBE_ID
#define PT0() unsigned long long _pt0 = (blockIdx.x == 0 && threadIdx.x == 0) ? __builtin_amdgcn_s_memrealtime() : 0ull
#define PT1(id) do { if ((id) == PROBE_ID && blockIdx.x == 0 && threadIdx.x == 0) { *(LAS unsigned long long*)(lds + LDS_PROBE_OFF) += __builtin_amdgcn_s_memrealtime() - _pt0; } _pt0 = (blockIdx.x == 0 && threadIdx.x == 0) ? __builtin_amdgcn_s_memrealtime() : 0ull; } while (0)
#else
#define PT0() do {} while (0)
#define PT1(id) do {} while (0)
#endif
struct Params { const float* in[N_IN]; float* out; unsigned char* ws; int ph_lo, ph_hi, li, pad; };
typedef const __attribute__((address_space(4))) Params* KP;
__device__ __forceinline__ KP kp_fresh(KP k) { asm volatile("" : "+s"(k)); return k; }

__device__ __forceinline__ float bf2f(unsigned short b) { return __uint_as_float(((unsigned)b) << 16); }
__device__ __forceinline__ float bflo(unsigned w) { return __uint_as_float(w << 16); }
__device__ __forceinline__ float bfhi(unsigned w) { return __uint_as_float(w & 0xffff0000u); }
__device__ __forceinline__ unsigned short f2bf(float f) { return (unsigned short)(cvt_pk_bf16(f, 0.f) & 0xffffu); }
__device__ __forceinline__ float sigmoidf_(float x) { return 1.f / (1.f + __expf(-x)); }
__device__ __forceinline__ float siluf_(float x) { return x / (1.f + __expf(-x)); }
__device__ __forceinline__ float log_sigmoidf_(float z) { return fminf(z, 0.f) - log1pf(expf(-fabsf(z))); }
template <int CTRL> __device__ __forceinline__ float dpp_mov(float v) { return __int_as_float(__builtin_amdgcn_update_dpp(0, __float_as_int(v), CTRL, 0xF, 0xF, true)); }
__device__ __forceinline__ float wave_sum(float v) {
    v += dpp_mov<0xB1>(v); v += dpp_mov<0x4E>(v); v += dpp_mov<0x141>(v); v += dpp_mov<0x140>(v);
    const float r0 = __int_as_float(__builtin_amdgcn_readlane(__float_as_int(v), 0)), r1 = __int_as_float(__builtin_amdgcn_readlane(__float_as_int(v), 16));
    const float r2 = __int_as_float(__builtin_amdgcn_readlane(__float_as_int(v), 32)), r3 = __int_as_float(__builtin_amdgcn_readlane(__float_as_int(v), 48));
    return (r0 + r1) + (r2 + r3);
}
__device__ __forceinline__ float wave_max(float v) {
    v = fmaxf(v, dpp_mov<0xB1>(v)); v = fmaxf(v, dpp_mov<0x4E>(v)); v = fmaxf(v, dpp_mov<0x141>(v)); v = fmaxf(v, dpp_mov<0x140>(v));
    const float r0 = __int_as_float(__builtin_amdgcn_readlane(__float_as_int(v), 0)), r1 = __int_as_float(__builtin_amdgcn_readlane(__float_as_int(v), 16));
    const float r2 = __int_as_float(__builtin_amdgcn_readlane(__float_as_int(v), 32)), r3 = __int_as_float(__builtin_amdgcn_readlane(__float_as_int(v), 48));
    return fmaxf(fmaxf(r0, r1), fmaxf(r2, r3));
}
__device__ __forceinline__ float wave_min(float v) { return -wave_max(-v); }
__device__ __forceinline__ float xhalf_max(float m) { const auto rr = __builtin_amdgcn_permlane32_swap(__float_as_uint(m), __float_as_uint(m), false, false); return fmaxf(__uint_as_float(rr[0]), __uint_as_float(rr[1])); }
__device__ __forceinline__ float xhalf_sum(float m) { const auto rr = __builtin_amdgcn_permlane32_swap(__float_as_uint(m), __float_as_uint(m), false, false); return __uint_as_float(rr[0]) + __uint_as_float(rr[1]); }
__device__ __forceinline__ bf16x8 pack8f(const f32x4 a, const f32x4 b) { u32x4 w; w.x = cvt_pk_bf16(a[0], a[1]); w.y = cvt_pk_bf16(a[2], a[3]); w.z = cvt_pk_bf16(b[0], b[1]); w.w = cvt_pk_bf16(b[2], b[3]); return __builtin_bit_cast(bf16x8, w); }
__device__ __forceinline__ float fast_tanh(float x) { const float e = __expf(-2.f * fabsf(x)); const float t = (1.f - e) * __builtin_amdgcn_rcpf(1.f + e); return x < 0.f ? -t : t; }
__device__ __forceinline__ void tr_tile(const float* __restrict__ src, size_t ld, int k0, int c0, int nvalid, bf16_t* __restrict__ dst, int K, LAS float* scr, int lane) {
    float tv[64];
#pragma unroll
    for (int kk = 0; kk < 64; ++kk) tv[kk] = src[(size_t)(k0 + kk) * ld + c0 + (lane < nvalid ? lane : 0)];
#pragma unroll
    for (int kk = 0; kk < 64; ++kk) scr[kk * 65 + lane] = (lane < nvalid) ? tv[kk] : 0.f;
    const int k2 = (lane & 31) * 2, nh = lane >> 5;
#pragma unroll 8
    for (int it = 0; it < 32; ++it) { const int nn = 2 * it + nh; *(unsigned*)(dst + (size_t)nn * K + k0 + k2) = cvt_pk_bf16(scr[k2 * 65 + nn], scr[(k2 + 1) * 65 + nn]); }
}
__device__ __forceinline__ void p0_weights(KP p, LAS unsigned char* lds, int gw, int ngw, int wave, int lane) {
    LAS float* scr = (LAS float*)lds + wave * SLOT_F;
    constexpr int T_WIN = (NU / 64) * 32, T_WBR = 4 * 32 * 8, T_WOUT = 32 * 32, T_POOL = 4 * 2 * 2, T_L = T_WIN + T_WBR + T_WOUT + T_POOL;
    for (int it = gw; it < 2 * T_L; it += ngw) {
        const int l = it / T_L; int r = it % T_L;
        if (r < T_WIN) {
            const int nt = r / 32, kt = r % 32, m0 = nt * 64;
            int c0, nvalid = 64;
            if (m0 < 3072) c0 = m0; else if (m0 < U_F) c0 = m0 + 8; else if (m0 == U_F) { c0 = 3072; nvalid = 8; } else { c0 = 0; nvalid = 0; }
            tr_tile(p->in[I_WIN] + (size_t)l * 2048 * IN_W, IN_W, kt * 64, c0, nvalid, (bf16_t*)(p->ws + WS_WIN) + ((size_t)l * NU + m0) * 2048, 2048, scr, lane);
            continue; }
        r -= T_WIN;
        if (r < T_WBR) {
            const int n = r / 256, q = r % 256, nt = q / 8, kt = q % 8;
            tr_tile(p->in[I_WBR] + ((size_t)(l * 4 + n) * 512) * 2048, 2048, kt * 64, nt * 64, 64, (bf16_t*)(p->ws + WS_WBR) + ((size_t)(l * 4 + n) * 2048 + nt * 64) * 512, 512, scr, lane);
            continue; }
        r -= T_WBR;
        if (r < T_WOUT) {
            const int nt = r / 32, kt = r % 32;
            tr_tile(p->in[I_WOUT] + (size_t)l * 2048 * 2048, 2048, kt * 64, nt * 64, 64, (bf16_t*)(p->ws + WS_WOUT) + ((size_t)l * 2048 + nt * 64) * 2048, 2048, scr, lane);
            continue; }
        r -= T_WOUT;
        {
            const int g = r / 4, q = r % 4, nt = q / 2, kt = q % 2;
            tr_tile(p->in[I_POOLW] + (size_t)(l * 4 + g) * 128 * 128, 128, kt * 64, nt * 64, 64, (bf16_t*)(p->ws + WS_POOLW) + ((size_t)(l * 4 + g) * 128 + nt * 64) * 128, 128, scr, lane);
        }
    }
}
__device__ __forceinline__ void ada_unit(KP p, int unit, LAS unsigned char* lds, int tid) {
    const int wave = tid >> 6, lane = tid & 63, l = unit / 96, n0 = (unit % 96) * 64;
    LAS float* cs = (LAS float*)lds + wave * (33 * 64);
    LAS float* red = (LAS float*)lds + 8 * 33 * 64;
    const float* W = p->in[I_WADA] + (size_t)l * 2048 * 6144;
    const float* cp = p->in[I_CP]; const float* csm = p->in[I_CS];
    float acc[33];
#pragma unroll
    for (int s = 0; s < 33; ++s) acc[s] = 0.f;
    float wv[16];
#pragma unroll
    for (int j = 0; j < 16; ++j) wv[j] = W[(size_t)(wave * 256 + j) * 6144 + n0 + lane];
#pragma unroll 1
    for (int step = 0; step < 16; ++step) {
        const int k0 = wave * 256 + step * 16, kn = wave * 256 + (step < 15 ? step + 1 : step) * 16;
        float wn[16];
#pragma unroll
        for (int j = 0; j < 16; ++j) wn[j] = W[(size_t)(kn + j) * 6144 + n0 + lane];
        if ((step & 3) == 0) {
#pragma unroll
            for (int s = 0; s < 33; ++s) { const float c = (s == 0) ? cp[k0 + lane] : csm[(size_t)(s - 1) * 2048 + k0 + lane]; cs[s * 64 + lane] = siluf_(c); } }
        const int kk0 = (step & 3) * 16;
#pragma unroll
        for (int q4 = 0; q4 < 4; ++q4) {
#pragma unroll
            for (int s = 0; s < 33; ++s) { const f32x4 c4 = *(const LAS f32x4*)(cs + s * 64 + kk0 + 4 * q4); acc[s] += c4.x * wv[4 * q4] + c4.y * wv[4 * q4 + 1] + c4.z * wv[4 * q4 + 2] + c4.w * wv[4 * q4 + 3]; } }
#pragma unroll
        for (int j = 0; j < 16; ++j) wv[j] = wn[j];
    }
#pragma unroll
    for (int s = 0; s < 33; ++s) red[(wave * 33 + s) * 64 + lane] = acc[s];
    __syncthreads();
    for (int idx = tid; idx < 33 * 64; idx += 512) { const int s = idx >> 6, n = idx & 63; float v = p->in[I_BADA][l * 6144 + n0 + n];
#pragma unroll
        for (int w = 0; w < 8; ++w) v += red[(w * 33 + s) * 64 + n];
        ((float*)(p->ws + WS_ADA))[((size_t)l * 33 + s) * 6144 + n0 + n] = v; }
    __syncthreads();
}
__device__ __forceinline__ const float* x_row(KP p, int l, int row) {
    return l == 0 ? (row < TP ? p->in[I_XP] + (size_t)row * DM : p->in[I_XS] + (size_t)(row - TP) * DM) : (const float*)(p->ws + WS_XBUF) + (size_t)row * DM;
}
__device__ __forceinline__ void p1_rows(KP p, int l, int gw, int ngw, int lane) {
    const f32x4* g4 = (const f32x4*)(p->in[I_NORMG] + l * DM) + lane;
    for (int row = gw; row < NTOK; row += ngw) {
        const f32x4* x4 = (const f32x4*)x_row(p, l, row) + lane;
        const int seq = row < TP ? 0 : 1 + ((row - TP) >> 5);
        const f32x4* sh4 = (const f32x4*)((const float*)(p->ws + WS_ADA) + ((size_t)l * 33 + seq) * 6144) + lane; const f32x4* sc4 = sh4 + 512;
        f32x4 v[8]; float ss = 0.f;
#pragma unroll
        for (int j = 0; j < 8; ++j) { v[j] = x4[64 * j]; ss += (v[j].x * v[j].x + v[j].y * v[j].y) + (v[j].z * v[j].z + v[j].w * v[j].w); }
        const float rstd = 1.f / sqrtf(wave_sum(ss) * (1.f / DM) + 1e-6f);
        u32x2* o = (u32x2*)((bf16_t*)(p->ws + WS_H) + (size_t)row * DM) + lane;
#pragma unroll
        for (int j = 0; j < 8; ++j) { const f32x4 g = g4[64 * j], sc = sc4[64 * j], sh = sh4[64 * j]; const f32x4 y = v[j] * rstd * g * (sc + 1.f) + sh;
            u32x2 w; w.x = cvt_pk_bf16(y.x, y.y); w.y = cvt_pk_bf16(y.z, y.w); o[64 * j] = w; }
    }
}
__device__ __forceinline__ void p_final_rows(KP p, int gw, int ngw, int lane) {
    const f32x4* g4 = (const f32x4*)p->in[I_FING] + lane;
    for (int row = gw; row < NTOK; row += ngw) {
        const f32x4* x4 = (const f32x4*)((const float*)(p->ws + WS_XBUF) + (size_t)row * DM) + lane;
        f32x4 v[8]; float ss = 0.f;
#pragma unroll
        for (int j = 0; j < 8; ++j) { v[j] = x4[64 * j]; ss += (v[j].x * v[j].x + v[j].y * v[j].y) + (v[j].z * v[j].z + v[j].w * v[j].w); }
        const float rstd = 1.f / sqrtf(wave_sum(ss) * (1.f / DM) + 1e-6f);
        f32x4* o = (f32x4*)(p->out + O_YP + (size_t)row * DM) + lane;
#pragma unroll
        for (int j = 0; j < 8; ++j) o[64 * j] = v[j] * rstd * g4[64 * j];
    }
}
struct EpiU {
    static constexpr bool PERM = true, AFTER_DRAIN = false;
    bf16_t* U; float* out; const float* bf; int l;
    __device__ __forceinline__ void operator()(const f32x4 (&acc)[2][2][4][2], const pg8::Unit& u, int wr, int wc, int fr, int fq) const {
        const int row0 = u.pm * 256 + wr * 64 + fr, col0 = u.pn * 256 + wc * 32 + 8 * fq;
#pragma unroll
        for (int ai = 0; ai < 2; ++ai)
#pragma unroll
            for (int m = 0; m < 4; ++m) { bf16_t* rowp = U + (size_t)(row0 + ai * 128 + m * 16) * NU + col0;
#pragma unroll
                for (int bj = 0; bj < 2; ++bj) { const f32x4 v0 = acc[ai][bj][m][0], v1 = acc[ai][bj][m][1];
                    u32x4 w; w.x = cvt_pk_bf16(v0[0], v0[1]); w.y = cvt_pk_bf16(v0[2], v0[3]); w.z = cvt_pk_bf16(v1[0], v1[1]); w.w = cvt_pk_bf16(v1[2], v1[3]);
                    *(u32x4*)(rowp + bj * 128) = w; } }
        if (u.pn >= 8 && u.pn < 12) {
            const bool isv = u.pn >= 10; const int cin = (u.pn - (isv ? 10 : 8)) * 256 + wc * 32 + 8 * fq;
#pragma unroll
            for (int ai = 0; ai < 2; ++ai)
#pragma unroll
                for (int m = 0; m < 4; ++m) { const int row = row0 + ai * 128 + m * 16;
                    float* dst = row < TP ? out + (isv ? O_PV : O_PK) + ((size_t)l * TP + row) * 512 : out + (isv ? O_SV : O_SK) + ((size_t)l * 1024 + (row - TP)) * 512;
#pragma unroll
                    for (int bj = 0; bj < 2; ++bj) { *(f32x4*)(dst + cin + bj * 128) = acc[ai][bj][m][0]; *(f32x4*)(dst + cin + bj * 128 + 4) = acc[ai][bj][m][1]; } }
        }
        if (u.pn == 58 && wc == 0 && fq == 0) {
            const f32x4 b0 = *(const f32x4*)(bf + l * 8), b1 = *(const f32x4*)(bf + l * 8 + 4);
#pragma unroll
            for (int ai = 0; ai < 2; ++ai)
#pragma unroll
                for (int m = 0; m < 4; ++m) { const int row = row0 + ai * 128 + m * 16;
                    float* dst = row < TP ? out + O_PLF + ((size_t)l * TP + row) * 8 : out + O_SLF + ((size_t)l * 1024 + (row - TP)) * 8;
                    const f32x4 z0 = acc[ai][1][m][0] + b0, z1 = acc[ai][1][m][1] + b1; f32x4 o0, o1;
#pragma unroll
                    for (int e = 0; e < 4; ++e) { o0[e] = log_sigmoidf_(z0[e]); o1[e] = log_sigmoidf_(z1[e]); }
                    *(f32x4*)dst = o0; *(f32x4*)(dst + 4) = o1; }
        }
    }
};
struct BranchOrder {
    int G, c;
    __device__ __forceinline__ bool next(int i, pg8::Unit& u) const { const int L = i * G + c; if (L >= 4 * 544) return false; const int n = L / 544, t = L - n * 544; u.pm = n * 68 + (t >> 3); u.pn = n * 8 + (t & 7); return true; }
    __device__ __forceinline__ void a_ready(const pg8::Unit&) const {}
    __device__ __forceinline__ void done(const pg8::Unit&) const {}
};
struct EpiZ {
    static constexpr bool PERM = true, AFTER_DRAIN = false;
    bf16_t* Z;
    __device__ __forceinline__ void operator()(const f32x4 (&acc)[2][2][4][2], const pg8::Unit& u, int wr, int wc, int fr, int fq) const {
        const int row0 = u.pm * 256 + wr * 64 + fr, col0 = (u.pn & 7) * 256 + wc * 32 + 8 * fq;
#pragma unroll
        for (int ai = 0; ai < 2; ++ai)
#pragma unroll
            for (int m = 0; m < 4; ++m) { bf16_t* rowp = Z + (size_t)(row0 + ai * 128 + m * 16) * DM + col0;
#pragma unroll
                for (int bj = 0; bj < 2; ++bj) { const f32x4 v0 = acc[ai][bj][m][0], v1 = acc[ai][bj][m][1];
                    u32x4 w; w.x = cvt_pk_bf16(v0[0], v0[1]); w.y = cvt_pk_bf16(v0[2], v0[3]); w.z = cvt_pk_bf16(v1[0], v1[1]); w.w = cvt_pk_bf16(v1[2], v1[3]);
                    *(u32x4*)(rowp + bj * 128) = w; } }
    }
};
__device__ __forceinline__ void merge_pass(KP p, int gtid, int ngt) {
    const bf16_t* U = (const bf16_t*)(p->ws + WS_U); const bf16_t* Z = (const bf16_t*)(p->ws + WS_Z); bf16_t* M = (bf16_t*)(p->ws + WS_MERGED);
    for (int it0 = gtid; it0 < NTOK * 256; it0 += 2 * ngt) {
        u32x4 gv[2][4], zv[2][4];
#pragma unroll
        for (int k = 0; k < 2; ++k) { const int it = it0 + k * ngt < NTOK * 256 ? it0 + k * ngt : it0; const int row = it >> 8, col = (it & 255) * 8;
#pragma unroll
            for (int n = 0; n < 4; ++n) { gv[k][n] = *(const u32x4*)(U + (size_t)row * NU + U_G + n * 2048 + col); zv[k][n] = *(const u32x4*)(Z + ((size_t)n * NTOK + row) * DM + col); } }
#pragma unroll
        for (int k = 0; k < 2; ++k) { const int it = it0 + k * ngt; if (it < NTOK * 256) { const int row = it >> 8, col = (it & 255) * 8;
            float s[8];
#pragma unroll
            for (int e = 0; e < 8; ++e) s[e] = 0.f;
#pragma unroll
            for (int n = 0; n < 4; ++n) { const u32x4 g = gv[k][n], z = zv[k][n];
                s[0] += sigmoidf_(bflo(g.x)) * bflo(z.x); s[1] += sigmoidf_(bfhi(g.x)) * bfhi(z.x); s[2] += sigmoidf_(bflo(g.y)) * bflo(z.y); s[3] += sigmoidf_(bfhi(g.y)) * bfhi(z.y);
                s[4] += sigmoidf_(bflo(g.z)) * bflo(z.z); s[5] += sigmoidf_(bfhi(g.z)) * bfhi(z.z); s[6] += sigmoidf_(bflo(g.w)) * bflo(z.w); s[7] += sigmoidf_(bfhi(g.w)) * bfhi(z.w); }
            u32x4 w; w.x = cvt_pk_bf16(s[0], s[1]); w.y = cvt_pk_bf16(s[2], s[3]); w.z = cvt_pk_bf16(s[4], s[5]); w.w = cvt_pk_bf16(s[6], s[7]);
            *(u32x4*)(M + (size_t)row * DM + col) = w; } }
    }
}
struct EpiOut {
    static constexpr bool PERM = false, AFTER_DRAIN = false;
    const float* xp; const float* xs; const float* xb; const float* ada; float* xout; int l;
    __device__ __forceinline__ void operator()(const f32x4 (&acc)[2][2][4][2], const pg8::Unit& u, int wr, int wc, int fr, int fq) const {
        const int row0 = u.pm * 256 + wr * 64 + fr, col0 = u.pn * 256 + wc * 32 + 4 * fq;
#pragma unroll
        for (int ai = 0; ai < 2; ++ai)
#pragma unroll
            for (int m = 0; m < 4; ++m) { const int row = row0 + ai * 128 + m * 16;
                const float* base = l == 0 ? (row < TP ? xp + (size_t)row * DM : xs + (size_t)(row - TP) * DM) : xb + (size_t)row * DM;
                const int seq = row < TP ? 0 : 1 + ((row - TP) >> 5);
                const float* gate = ada + ((size_t)l * 33 + seq) * 6144 + 4096;
#pragma unroll
                for (int bj = 0; bj < 2; ++bj)
#pragma unroll
                    for (int n = 0; n < 2; ++n) { const int col = col0 + bj * 128 + n * 16;
                        *(f32x4*)(xout + (size_t)row * DM + col) = *(const f32x4*)(base + col) + *(const f32x4*)(gate + col) * acc[ai][bj][m][n]; } }
    }
};
__device__ __forceinline__ void conv_unit(KP p, int l, int tile, LAS unsigned char* lds, int tid) {
    const bf16_t* U = (const bf16_t*)(p->ws + WS_U);
    const int c = tid, wave = tid >> 6, lane = tid & 63;
    const bool samp = tile >= 512; const int b = tile - 512, row0 = samp ? TP + b * 32 : tile * 32;
    const bool last = samp || tile == 511;
    LAS float* red = (LAS float*)lds;
    LAS float* st = red + 8 * 32;
    const float cb = p->in[I_CONVB][l * 512 + c], lg = p->in[I_CLNG][l * 512 + c], lb = p->in[I_CLNB][l * 512 + c];
    bf16_t* oa = (bf16_t*)(p->ws + WS_OCAT);
#pragma unroll 1
    for (int half = 0; half < 2; ++half) {
        float z[46];
        if (!samp) {
#pragma unroll
            for (int i = 0; i < 46; ++i) { const int row = row0 + 16 * half + i - 30; const size_t r = (size_t)(row < 0 ? 0 : row) * NU;
                const float v = bf2f(U[r + U_AVAL + c]) * sigmoidf_(bf2f(U[r + U_AGATE + c])); z[i] = row < 0 ? 0.f : v; }
        } else {
            const float* hist = p->in[I_SCONV] + (((size_t)l * 32 + b) * 30) * 512 + c;
#pragma unroll
            for (int i = 0; i < 46; ++i) { const int rel = 16 * half + i - 30; const size_t r = (size_t)(row0 + (rel < 0 ? 0 : rel)) * NU;
                const float v = bf2f(U[r + U_AVAL + c]) * sigmoidf_(bf2f(U[r + U_AGATE + c]));
                if (i < 30) { const int hi_ = 16 * half + i; const float hv_ = hist[(size_t)(hi_ < 30 ? hi_ : 29) * 512]; z[i] = rel < 0 ? hv_ : v; } else z[i] = v; }
        }
        if (last) {
            float* dst = samp ? p->out + O_SCONV + (((size_t)l * 32 + b) * 30) * 512 + c : p->out + O_PCONV + ((size_t)l * 30) * 512 + c;
#pragma unroll
            for (int tt = 0; tt < 16; ++tt) { const int t = 16 * half + tt; if (t >= 2) dst[(size_t)(t - 2) * 512] = z[30 + tt]; }
        }
        float hv[16];
#pragma unroll
        for (int tt = 0; tt < 16; ++tt) hv[tt] = cb;
#pragma unroll
        for (int k = 0; k < 31; ++k) { const float w = p->in[I_CONVW][((size_t)l * 31 + k) * 512 + c];
#pragma unroll
            for (int tt = 0; tt < 16; ++tt) hv[tt] += z[tt + k] * w; }
#pragma unroll
        for (int tt = 0; tt < 16; ++tt) { const float s1 = wave_sum(hv[tt]), s2 = wave_sum(hv[tt] * hv[tt]); if (lane == 0) { red[(wave * 16 + tt) * 2] = s1; red[(wave * 16 + tt) * 2 + 1] = s2; } }
        __syncthreads();
        if (tid < 16) { float s1 = 0.f, s2 = 0.f;
#pragma unroll
            for (int w = 0; w < 8; ++w) { s1 += red[(w * 16 + tid) * 2]; s2 += red[(w * 16 + tid) * 2 + 1]; }
            const float mean = s1 * (1.f / 512.f), var = fmaxf(s2 * (1.f / 512.f) - mean * mean, 0.f);
            st[tid * 2] = mean; st[tid * 2 + 1] = 1.f / sqrtf(var + 1e-5f); }
        __syncthreads();
#pragma unroll
        for (int tt = 0; tt < 16; ++tt) { const float y = (hv[tt] - st[tt * 2]) * st[tt * 2 + 1] * lg + lb; const size_t r = (size_t)(row0 + 16 * half + tt);
            oa[r * 512 + c] = f2bf(siluf_(y) * siluf_(bf2f(U[r * NU + U_ASG + c]))); }
        __syncthreads();
    }
}
__device__ __forceinline__ void pool_unit(KP p, int l, int tile, LAS unsigned char* lds, int tid) {
    const bf16_t* U = (const bf16_t*)(p->ws + WS_U);
    const int c = tid, wave = tid >> 6, lane = tid & 63;
    const bool samp = tile >= 512; const int b = tile - 512, row0 = samp ? TP + b * 32 : tile * 32;
    constexpr int PST = 520;
    LAS bf16_t* pl = (LAS bf16_t*)lds;
    {
        float z[47];
        if (!samp) {
#pragma unroll
            for (int i = 0; i < 47; ++i) { const int row = row0 + i - 15; const float v = bf2f(U[(size_t)(row < 0 ? 0 : row) * NU + U_DIN + c]); z[i] = row < 0 ? 0.f : v; }
        } else {
#pragma unroll
            for (int i = 0; i < 15; ++i) z[i] = p->in[I_SPOOL][(((size_t)l * 32 + b) * 15 + i) * 512 + c];
#pragma unroll
            for (int t = 0; t < 32; ++t) z[15 + t] = bf2f(U[(size_t)(row0 + t) * NU + U_DIN + c]);
        }
        if (samp || tile == 511) {
            float* dst = samp ? p->out + O_SPOOL + (((size_t)l * 32 + b) * 15) * 512 + c : p->out + O_PPOOL + ((size_t)l * 15) * 512 + c;
#pragma unroll
            for (int t = 17; t < 32; ++t) dst[(size_t)(t - 17) * 512] = z[15 + t];
        }
        const int w = 2 << (c >> 7);
#pragma unroll
        for (int t = 0; t < 32; ++t) { float s = 0.f;
#pragma unroll
            for (int i = 0; i < 16; ++i) s += (i < w) ? z[15 + t - i] : 0.f;
            const int pos = samp ? PAST + t : row0 + t; const int cnt = (pos + 1 < w) ? pos + 1 : w;
            pl[t * PST + c] = f2bf(s / (float)cnt - z[15 + t]); }
    }
    __syncthreads();
    {
        const int g = wave >> 1, fr = lane & 15, kq = lane >> 4;
        const bf16_t* WT = (const bf16_t*)(p->ws + WS_POOLW) + (size_t)(l * 4 + g) * 128 * 128;
        f32x4 acc[2][4];
#pragma unroll
        for (int mt = 0; mt < 2; ++mt)
#pragma unroll
            for (int nt = 0; nt < 4; ++nt) acc[mt][nt] = (f32x4){0.f, 0.f, 0.f, 0.f};
#pragma unroll
        for (int ks = 0; ks < 4; ++ks) {
            bf16x8 af[2];
#pragma unroll
            for (int mt = 0; mt < 2; ++mt) af[mt] = *(const LAS bf16x8*)(pl + (16 * mt + fr) * PST + g * 128 + 32 * ks + 8 * kq);
#pragma unroll
            for (int nt = 0; nt < 4; ++nt) { const int dl = (wave & 1) * 64 + 16 * nt + fr;
                const bf16x8 bfr = *(const bf16x8*)(WT + (size_t)dl * 128 + 32 * ks + 8 * kq);
#pragma unroll
                for (int mt = 0; mt < 2; ++mt) acc[mt][nt] = __builtin_amdgcn_mfma_f32_16x16x32_bf16(af[mt], bfr, acc[mt][nt], 0, 0, 0); }
        }
        bf16_t* od = (bf16_t*)(p->ws + WS_OCAT) + (size_t)3 * NTOK * 512;
#pragma unroll
        for (int nt = 0; nt < 4; ++nt) { const int d = wave * 64 + 16 * nt + fr; const float pb = p->in[I_POOLB][l * 512 + d], ps = p->in[I_POOLS][l * 512 + d];
#pragma unroll
            for (int mt = 0; mt < 2; ++mt)
#pragma unroll
                for (int r = 0; r < 4; ++r) { const size_t row = (size_t)(row0 + 16 * mt + 4 * kq + r);
                    od[row * 512 + d] = f2bf((acc[mt][nt][r] + pb) * ps * siluf_(bf2f(U[row * NU + U_DSG + d]))); } }
    }
    __syncthreads();
}
__device__ __forceinline__ void fp_unit(KP p, int l, int h, LAS unsigned char* lds, int tid) {
    const float* lf = p->out + O_PLF + (size_t)l * TP * 8 + h;
    LAS float* part = (LAS float*)lds;
    float v[32]; float s = 0.f;
#pragma unroll
    for (int i = 0; i < 32; ++i) { v[i] = lf[(size_t)(tid * 32 + i) * 8]; s += v[i]; }
    part[tid] = s;
    __syncthreads();
    float pre = 0.f;
    for (int j = 0; j < tid; ++j) pre += part[j];
    float* F = (float*)(p->ws + WS_FP) + (size_t)h * TP + tid * 32;
#pragma unroll
    for (int i = 0; i < 32; ++i) { pre += v[i]; F[i] = pre * LOG2E; }
    __syncthreads();
}
__device__ __forceinline__ void gs_unit(KP p, int l, int b, LAS unsigned char* lds, int tid) {
    const int h = tid & 7, ch = tid >> 3;
    const float* cl = p->in[I_CLF] + (((size_t)l * 32 + b) * PAST + ch * 64) * 8 + h;
    LAS float* part = (LAS float*)lds;
    float v[64]; float s = 0.f;
#pragma unroll
    for (int i = 0; i < 64; ++i) v[i] = cl[(size_t)i * 8];
#pragma unroll
    for (int i = 0; i < 64; ++i) s += v[i];
    part[ch * 8 + h] = s;
    __syncthreads();
    float suf = 0.f;
    for (int j = ch + 1; j < 64; ++j) suf += part[j * 8 + h];
    float* G = (float*)(p->ws + WS_GS) + ((size_t)b * 8 + h) * GS_LEN + ch * 64;
#pragma unroll
    for (int i = 63; i >= 0; --i) { G[i] = -suf * LOG2E; suf += v[i]; }
    if (tid < 8) { const float* nl = p->out + O_SLF + ((size_t)l * 1024 + b * 32) * 8 + tid; float* Gn = (float*)(p->ws + WS_GS) + ((size_t)b * 8 + tid) * GS_LEN + PAST; float w[32]; float run = 0.f;
#pragma unroll
        for (int i = 0; i < 32; ++i) w[i] = nl[i * 8];
#pragma unroll
        for (int i = 0; i < 32; ++i) { run += w[i]; Gn[i] = run * LOG2E; } }
    __syncthreads();
}
__device__ __forceinline__ void vt_tile(KP p, int l, int tile, LAS unsigned char* lds, int wave, int lane) {
    const int h = tile >> 8, tb = tile & 255;
    const bf16_t* U = (const bf16_t*)(p->ws + WS_U);
    LAS unsigned* scr = (LAS unsigned*)lds + wave * SLOT_F;
#pragma unroll 8
    for (int tt = 0; tt < 64; ++tt) scr[tt * 65 + lane] = U[(size_t)(tb * 64 + tt) * NU + U_V + h * 64 + lane];
    {
        float mx = 0.f;
#pragma unroll 8
        for (int tt = 0; tt < 64; ++tt) { const float kv = bf2f(U[(size_t)(tb * 64 + tt) * NU + U_K + h * 64 + lane]); mx = fmaxf(mx, wave_sum(kv * kv)); }
        if (lane == 0) atomicMax((unsigned*)(p->ws + WS_CTL) + CW_KMAX + l * 8 + h, __float_as_uint(mx));
    }
    bf16_t* Vt = (bf16_t*)(p->ws + WS_VT);
    const int t2 = (lane & 31) * 2, dh = lane >> 5;
#pragma unroll 8
    for (int it = 0; it < 32; ++it) { const int d = 2 * it + dh; *(unsigned*)(Vt + ((size_t)h * 64 + d) * TP + tb * 64 + t2) = scr[t2 * 65 + d] | (scr[(t2 + 1) * 65 + d] << 16); }
}
__device__ __forceinline__ void shift_out(KP p, int l, int tid) {
    const bf16_t* U = (const bf16_t*)(p->ws + WS_U);
    for (int idx = tid; idx < NSEQ * SHIFT_W; idx += 512) { const int s = idx / SHIFT_W, j = idx - s * SHIFT_W;
        const int row = s == 0 ? TP - 1 : TP + (s - 1) * 32 + 31;
        float* dst = s == 0 ? p->out + O_PSHIFT + (size_t)l * SHIFT_W + j : p->out + O_SSHIFT + ((size_t)l * 32 + (s - 1)) * SHIFT_W + j;
        *dst = bf2f(U[(size_t)row * NU + U_XC + j]); }
}
template <bool AT, bool BT, bool NEGA>
__device__ __forceinline__ void mm32(f32x16& acc, const LAS float* Ap, int i0, const LAS float* Bp, int j0, int lane) {
    const int li = lane & 31, kh = lane >> 5;
    const LAS float* ap = AT ? Ap + (8 * kh) * 65 + i0 + li : Ap + (i0 + li) * 65 + 8 * kh;
    const LAS float* bp = BT ? Bp + (j0 + li) * 65 + 8 * kh : Bp + (8 * kh) * 65 + j0 + li;
#pragma unroll
    for (int s = 0; s < 4; ++s) {
        float a[8], b[8];
#pragma unroll
        for (int e = 0; e < 8; ++e) { a[e] = AT ? ap[(16 * s + e) * 65] : ap[16 * s + e]; b[e] = BT ? bp[16 * s + e] : bp[(16 * s + e) * 65]; }
        if (NEGA) {
#pragma unroll
            for (int e = 0; e < 8; ++e) a[e] = -a[e]; }
        const bf16x8 af = pack8f((f32x4){a[0], a[1], a[2], a[3]}, (f32x4){a[4], a[5], a[6], a[7]}), bfg = pack8f((f32x4){b[0], b[1], b[2], b[3]}, (f32x4){b[4], b[5], b[6], b[7]});
        acc = __builtin_amdgcn_mfma_f32_32x32x16_bf16(af, bfg, acc, 0, 0, 0);
    }
}
template <int MASK>
__device__ __forceinline__ void st_tile(LAS float* dst, const f32x16& acc, int i0, int j0, int lane) {
    const int li = lane & 31, hi = lane >> 5, j = j0 + li;
#pragma unroll
    for (int r = 0; r < 16; ++r) { const int i = i0 + (r & 3) + 8 * (r >> 2) + 4 * hi; float v = acc[r];
        if (MASK == 1 && !(i < j)) v = 0.f; if (MASK == 2 && !(i <= j)) v = 0.f; dst[i * 65 + j] = v; }
}
struct RwkvSeqInfo { int row0, ntok, prev_kind  , b; };
__device__ __forceinline__ RwkvSeqInfo rwkv_info(int cu) { RwkvSeqInfo s; if (cu < 256) { s.row0 = cu * 64; s.ntok = 64; s.prev_kind = cu == 0 ? 0 : 1; s.b = 0; } else { s.b = cu - 256; s.row0 = TP + s.b * 32; s.ntok = 32; s.prev_kind = 2; } return s; }

__device__ __forceinline__ void rwkv_r1(KP p, int l, int unit, LAS unsigned char* lds, int tid) {
    const int cu = unit >> 3, h = unit & 7, wave = tid >> 6, lane = tid & 63, li = lane & 31, hi = lane >> 5;
    const RwkvSeqInfo si = rwkv_info(cu);
    const bf16_t* U = (const bf16_t*)(p->ws + WS_U);
    LAS float* S0 = (LAS float*)lds; LAS float *S1 = S0 + SLOT_F, *S2 = S0 + 2 * SLOT_F, *S3 = S0 + 3 * SLOT_F, *S4 = S0 + 4 * SLOT_F, *S5 = S0 + 5 * SLOT_F, *S6 = S0 + 6 * SLOT_F, *S7 = S0 + 7 * SLOT_F, *S8 = S0 + 8 * SLOT_F;
    LAS float* gC = S0 + 9 * SLOT_F;
    const int q = wave >> 2, wq = wave & 3, i0 = (wq >> 1) * 32, j0 = (wq & 1) * 32;
    PT0();
    {
        const int j = tid & 63, tq = tid >> 6, t0 = tq * 8;
        const int offs[5] = {h * 64, 512 + h * 64, 1024 + h * 64, 1536, 1600};
        unsigned short raw[5][9];
#pragma unroll
        for (int cs = 0; cs < 5; ++cs) {
            const int xo = offs[cs] + j;
#pragma unroll
            for (int tt = 0; tt < 9; ++tt) { int t = t0 + tt - 1; t = t < 0 ? (si.prev_kind == 1 ? -1 : 0) : (t < si.ntok ? t : si.ntok - 1);
                raw[cs][tt] = U[(size_t)(si.row0 + t) * NU + U_XC + xo]; }
        }
#pragma unroll
        for (int cs = 0; cs < 5; ++cs) {
            const int xo = offs[cs] + j; const float mu = p->in[I_MU][l * SHIFT_W + xo];
            LAS float* dst = cs == 0 ? S0 : cs == 1 ? S1 : cs == 2 ? S2 : cs == 3 ? S3 : S4;
            float prev = bf2f(raw[cs][0]);
            if (t0 == 0) { if (si.prev_kind == 0) prev = 0.f; else if (si.prev_kind == 2) prev = p->in[I_SSHIFT][((size_t)l * 32 + si.b) * SHIFT_W + xo]; }
#pragma unroll
            for (int tt = 0; tt < 8; ++tt) { const int t = t0 + tt; const float x = bf2f(raw[cs][tt + 1]); float xs = (t < si.ntok) ? x + (prev - x) * mu : 0.f; prev = x;
                if (cs == 3) xs = fast_tanh(xs);
                dst[t * 65 + j] = xs; }
        }
#pragma unroll
        for (int mm = 0; mm < 8; ++mm) { const int m = tq * 8 + mm;
            S5[m * 65 + j] = p->in[I_W2][((size_t)l * 64 + m) * 512 + h * 64 + j]; S6[m * 65 + j] = p->in[I_A2][((size_t)l * 64 + m) * 512 + h * 64 + j]; }
    }
    __syncthreads();
    PT1(1);
    {
        f32x16 acc = {};
        const int c = j0 + li;
        if (q == 0) { mm32<false, false, false>(acc, S3, i0, S5, j0, lane); const float w0 = p->in[I_W0][l * 512 + h * 64 + c];
#pragma unroll
            for (int r = 0; r < 16; ++r) { const int t = i0 + (r & 3) + 8 * (r >> 2) + 4 * hi; const float zz = acc[r] + w0;
                const float sp = fmaxf(-zz, 0.f) + __logf(1.f + __expf(-fabsf(zz)));
                S7[t * 65 + c] = (t < si.ntok) ? -__expf(-sp - 0.5f) : 0.f; } }
        else { mm32<false, false, false>(acc, S4, i0, S6, j0, lane); const float a0 = p->in[I_A0][l * 512 + h * 64 + c];
#pragma unroll
            for (int r = 0; r < 16; ++r) { const int t = i0 + (r & 3) + 8 * (r >> 2) + 4 * hi; S8[t * 65 + c] = __builtin_amdgcn_rcpf(1.f + __expf(-(acc[r] + a0))); } }
    }
    __syncthreads();
    PT1(2);
    if (wave == 0) { float run = 0.f;
#pragma unroll 8
        for (int t = 0; t < 64; ++t) { run += S7[t * 65 + lane]; S3[t * 65 + lane] = run; } }
    else { const int c = lane; const float kkw = p->in[I_KK][l * 512 + h * 64 + c], kaw = p->in[I_KA][l * 512 + h * 64 + c], rkw = p->in[I_RK][l * 512 + h * 64 + c];
        for (int t = wave - 1; t < 64; t += 7) { const float kr = S1[t * 65 + c], kv = kr * kkw; const float ss = wave_sum(kv * kv);
            const float kn = kv * (1.f / sqrtf(fmaxf(ss, 1e-24f))); const float a = S8[t * 65 + c]; const float km = kr * (1.f + (a - 1.f) * kaw);
            const float bon = wave_sum(S0[t * 65 + c] * km * rkw);
            S4[t * 65 + c] = kn; S1[t * 65 + c] = km; S8[t * 65 + c] = kn * a;
            if (lane == 0) ((float*)(p->ws + WS_BONUS))[(size_t)unit * 64 + t] = bon; } }
    __syncthreads();
    { const int c = tid & 63, tq = tid >> 6;
#pragma unroll
        for (int tt = 0; tt < 8; ++tt) { const int t = tq * 8 + tt, o = t * 65 + c; const float Lg = S3[o], lw = S7[o];
            const float g = __expf(Lg), gi = __expf(-Lg), gp = __expf(Lg - lw);
            S0[o] *= g; S1[o] *= gi; S8[o] *= gi; S4[o] *= gp; if (t == 63) gC[c] = g; } }
    __syncthreads();
    PT1(3);
    { f32x16 acc = {};
      if (q == 0) { mm32<false, true, false>(acc, S1, i0, S4, j0, lane); st_tile<1>(S3, acc, i0, j0, lane); }
      else { mm32<false, true, false>(acc, S8, i0, S4, j0, lane); st_tile<1>(S5, acc, i0, j0, lane); } }
    __syncthreads();
    { f32x16 acc = {};
      if (q == 0) { mm32<true, false, false>(acc, S2, i0, S3, j0, lane); st_tile<0>(S6, acc, i0, j0, lane); }
      else { mm32<false, true, false>(acc, S1, i0, S0, j0, lane); st_tile<2>(S7, acc, i0, j0, lane); } }
    __syncthreads();
    PT1(4);
    { float x[16]; const int r0 = (wave & 3) * 16;
      if (wave < 4) {
#pragma unroll
          for (int rr = 0; rr < 16; ++rr) x[rr] = S4[lane * 65 + r0 + rr]; }
      else {
#pragma unroll
          for (int rr = 0; rr < 16; ++rr) x[rr] = S6[(r0 + rr) * 65 + lane]; }
      __syncthreads();
#pragma unroll
      for (int sb = 0; sb < 4; ++sb) {
          float mreg[16];
#pragma unroll
          for (int s = 0; s < 16; ++s) mreg[s] = S5[(sb * 16 + (s < 15 || sb < 3 ? s : 14)) * 65 + lane];
          __builtin_amdgcn_sched_barrier(0);
#pragma unroll
          for (int s = 0; s < 16; ++s) { if (sb * 16 + s < 63) { const float mrow = mreg[s]; float xs[16];
#pragma unroll
              for (int rr = 0; rr < 16; ++rr) xs[rr] = __builtin_bit_cast(float, __builtin_amdgcn_readlane(__builtin_bit_cast(int, x[rr]), sb * 16 + s));
              __builtin_amdgcn_sched_barrier(0);
#pragma unroll
              for (int rr = 0; rr < 16; ++rr) x[rr] -= xs[rr] * mrow;
              __builtin_amdgcn_sched_barrier(0); } }
      }
      LAS float* dst = wave < 4 ? S3 : S6;
#pragma unroll
      for (int rr = 0; rr < 16; ++rr) dst[(r0 + rr) * 65 + lane] = x[rr]; }
    __syncthreads();
    PT1(5);
    { f32x16 acc = {};
      if (q == 1) { mm32<false, true, false>(acc, S8, i0, S0, j0, lane); st_tile<2>(S4, acc, i0, j0, lane); }
      else { mm32<false, false, false>(acc, S3, i0, S8, j0, lane);
          const int jc = j0 + li; const float gc = gC[jc]; float* TQ = (float*)(p->ws + WS_TQ) + (size_t)unit * 4096;
#pragma unroll
          for (int rg = 0; rg < 4; ++rg) { const int ab = i0 + 8 * rg + 4 * hi; f32x4 o;
#pragma unroll
              for (int e = 0; e < 4; ++e) o[e] = ((ab + e == jc) ? gc : 0.f) - acc[rg * 4 + e] * gc;
              *(f32x4*)(TQ + ((((jc >> 4) * 4 + (ab >> 4)) * 64 + ((ab & 15) >> 2) * 16 + (jc & 15)) * 4)) = o; } } }
    __syncthreads();
    { f32x16 acc = {};
      if (q == 0) { mm32<true, false, false>(acc, S2, i0, S1, j0, lane); mm32<false, false, true>(acc, S6, i0, S8, j0, lane);
          const int jc = j0 + li; const float gc = gC[jc]; float* GM = (float*)(p->ws + WS_GM) + (size_t)unit * 4096;
#pragma unroll
          for (int r = 0; r < 16; ++r) GM[(i0 + (r & 3) + 8 * (r >> 2) + 4 * hi) * 64 + jc] = acc[r] * gc; }
      else { mm32<true, false, false>(acc, S2, i0, S7, j0, lane); mm32<false, false, true>(acc, S6, i0, S4, j0, lane);
          float* Y0T = (float*)(p->ws + WS_Y0T) + (size_t)unit * 4096 + (j0 + li) * 64;
#pragma unroll
          for (int rg = 0; rg < 4; ++rg) *(f32x4*)(Y0T + i0 + 8 * rg + 4 * hi) = (f32x4){acc[rg * 4], acc[rg * 4 + 1], acc[rg * 4 + 2], acc[rg * 4 + 3]}; } }
    if (q == 0) { f32x16 acc;
#pragma unroll
        for (int r = 0; r < 16; ++r) acc[r] = S0[(j0 + li) * 65 + i0 + (r & 3) + 8 * (r >> 2) + 4 * hi];
        mm32<false, false, true>(acc, S3, i0, S4, j0, lane);
        float* ET = (float*)(p->ws + WS_ET) + (size_t)unit * 4096 + (j0 + li) * 64;
#pragma unroll
        for (int rg = 0; rg < 4; ++rg) *(f32x4*)(ET + i0 + 8 * rg + 4 * hi) = (f32x4){acc[rg * 4], acc[rg * 4 + 1], acc[rg * 4 + 2], acc[rg * 4 + 3]}; }
    __syncthreads();
    PT1(6);
}
__device__ __forceinline__ void chain_run(f32x4 (&st)[4], const float* TQ, const float* GM, float* SC, int nsteps, int i, int g, int lane) {
    constexpr size_t STRIDE = (size_t)8 * 4096;
    f32x4 tq[16], gm[4];
#pragma unroll
    for (int x = 0; x < 16; ++x) tq[x] = *(const f32x4*)(TQ + (x * 64 + lane) * 4);
#pragma unroll
    for (int tl = 0; tl < 4; ++tl) gm[tl] = GM ? *(const f32x4*)(GM + i * 64 + 16 * tl + 4 * g) : (f32x4){0.f, 0.f, 0.f, 0.f};
    for (int c = 0; c < nsteps; ++c) {
        if (SC) {
#pragma unroll
            for (int tl = 0; tl < 4; ++tl) *(f32x4*)(SC + c * STRIDE + i * 64 + 16 * tl + 4 * g) = st[tl]; }
        f32x4 tqn[16], gmn[4];
        const int cn = (c + 1 < nsteps) ? c + 1 : c;
#pragma unroll
        for (int x = 0; x < 16; ++x) tqn[x] = *(const f32x4*)(TQ + cn * STRIDE + (x * 64 + lane) * 4);
#pragma unroll
        for (int tl = 0; tl < 4; ++tl) gmn[tl] = GM ? *(const f32x4*)(GM + cn * STRIDE + i * 64 + 16 * tl + 4 * g) : (f32x4){0.f, 0.f, 0.f, 0.f};
        f32x4 acc[4];
#pragma unroll
        for (int tp = 0; tp < 4; ++tp) acc[tp] = gm[tp];
#pragma unroll
        for (int tl = 0; tl < 4; ++tl)
#pragma unroll
            for (int r = 0; r < 4; ++r)
#pragma unroll
                for (int tp = 0; tp < 4; ++tp) acc[tp] = __builtin_amdgcn_mfma_f32_16x16x4f32(tq[tp * 4 + tl][r], st[tl][r], acc[tp], 0, 0, 0);
#pragma unroll
        for (int tl = 0; tl < 4; ++tl) st[tl] = acc[tl];
#pragma unroll
        for (int x = 0; x < 16; ++x) tq[x] = tqn[x];
#pragma unroll
        for (int tl = 0; tl < 4; ++tl) gm[tl] = gmn[tl];
    }
}
__device__ __forceinline__ void rwkv_l1_task(KP p, int task, int lane) {
    const int iq = task & 3, kind = (task >> 2) & 1, h = (task >> 3) & 7, grp = task >> 6;
    const int fr = lane & 15, g = lane >> 4, i = iq * 16 + fr;
    const size_t u0 = ((size_t)(grp * 16) * 8 + h) * 4096;
    const float* TQ = (const float*)(p->ws + WS_TQ) + u0; const float* GM = (const float*)(p->ws + WS_GM) + u0;
    f32x4 st[4];
#pragma unroll
    for (int tl = 0; tl < 4; ++tl)
#pragma unroll
        for (int r = 0; r < 4; ++r) st[tl][r] = (kind == 1 && i == 16 * tl + 4 * g + r) ? 1.f : 0.f;
    chain_run(st, TQ, kind == 0 ? GM : nullptr, nullptr, 16, i, g, lane);
    const size_t gb = ((size_t)grp * 8 + h) * 4096;
    if (kind == 0) { float* GG = (float*)(p->ws + WS_GG) + gb;
#pragma unroll
        for (int tl = 0; tl < 4; ++tl) *(f32x4*)(GG + i * 64 + 16 * tl + 4 * g) = st[tl]; }
    else { float* TG = (float*)(p->ws + WS_TG) + gb;
#pragma unroll
        for (int tl = 0; tl < 4; ++tl)
#pragma unroll
            for (int r = 0; r < 4; ++r) TG[((tl * 4 + iq) * 64 + (fr >> 2) * 16 + 4 * g + r) * 4 + (fr & 3)] = st[tl][r]; }
}
__device__ __forceinline__ void rwkv_l2_task(KP p, int l, int task, int lane) {
    const int iq = task & 3, h = task >> 2, fr = lane & 15, g = lane >> 4, i = iq * 16 + fr;
    f32x4 st[4];
#pragma unroll
    for (int tl = 0; tl < 4; ++tl) st[tl] = (f32x4){0.f, 0.f, 0.f, 0.f};
    chain_run(st, (const float*)(p->ws + WS_TG) + (size_t)h * 4096, (const float*)(p->ws + WS_GG) + (size_t)h * 4096, (float*)(p->ws + WS_SG) + (size_t)h * 4096, 16, i, g, lane);
    float* dst = p->out + O_PWKV + (((size_t)l * 8 + h) * 64 + i) * 64;
#pragma unroll
    for (int tl = 0; tl < 4; ++tl) *(f32x4*)(dst + 16 * tl + 4 * g) = st[tl];
}
__device__ __forceinline__ void rwkv_l3_task(KP p, int l, int task, int lane) {
    const int fr = lane & 15, g = lane >> 4;
    f32x4 st[4];
    if (task < 512) { const int iq = task & 3, h = (task >> 2) & 7, grp = task >> 5, i = iq * 16 + fr;
        const float* s0 = (const float*)(p->ws + WS_SG) + ((size_t)grp * 8 + h) * 4096 + i * 64;
#pragma unroll
        for (int tl = 0; tl < 4; ++tl) st[tl] = *(const f32x4*)(s0 + 16 * tl + 4 * g);
        const size_t u0 = ((size_t)(grp * 16) * 8 + h) * 4096;
        chain_run(st, (const float*)(p->ws + WS_TQ) + u0, (const float*)(p->ws + WS_GM) + u0, (float*)(p->ws + WS_SC) + u0, 16, i, g, lane); }
    else { const int t2 = task - 512, iq = t2 & 3, h = (t2 >> 2) & 7, b = t2 >> 5, i = iq * 16 + fr;
        const float* s0 = p->in[I_SWKV] + ((((size_t)l * 32 + b) * 8 + h) * 64 + i) * 64;
#pragma unroll
        for (int tl = 0; tl < 4; ++tl) st[tl] = *(const f32x4*)(s0 + 16 * tl + 4 * g);
        const size_t u0 = ((size_t)(256 + b) * 8 + h) * 4096;
        chain_run(st, (const float*)(p->ws + WS_TQ) + u0, (const float*)(p->ws + WS_GM) + u0, (float*)(p->ws + WS_SC) + u0, 1, i, g, lane);
        float* dst = p->out + O_SWKV + ((((size_t)l * 32 + b) * 8 + h) * 64 + i) * 64;
#pragma unroll
        for (int tl = 0; tl < 4; ++tl) *(f32x4*)(dst + 16 * tl + 4 * g) = st[tl]; }
}
__device__ __forceinline__ void rwkv_r3_task(KP p, int l, int task, int lane) {
    const int unit = task >> 1, th = task & 1, cu = unit >> 3, h = unit & 7, li = lane & 31, hi = lane >> 5;
    const RwkvSeqInfo si = rwkv_info(cu);
    if (th * 32 >= si.ntok) return;
    const bf16_t* U = (const bf16_t*)(p->ws + WS_U);
    const size_t ub = (size_t)unit * 4096; const int t = th * 32 + li;
    const float* SC = (const float*)(p->ws + WS_SC) + ub; const float* ET = (const float*)(p->ws + WS_ET) + ub + t * 64 + 32 * hi; const float* Y0T = (const float*)(p->ws + WS_Y0T) + ub + t * 64;
    f32x16 acc[2];
#pragma unroll
    for (int ti = 0; ti < 2; ++ti)
#pragma unroll
        for (int rg = 0; rg < 4; ++rg) { const f32x4 y0 = *(const f32x4*)(Y0T + 32 * ti + 8 * rg + 4 * hi);
#pragma unroll
            for (int e = 0; e < 4; ++e) acc[ti][rg * 4 + e] = y0[e]; }
#pragma unroll
    for (int s4 = 0; s4 < 8; ++s4) {
        const f32x4 eb = *(const f32x4*)(ET + 4 * s4);
        const f32x4 sa0 = *(const f32x4*)(SC + (li) * 64 + 32 * hi + 4 * s4), sa1 = *(const f32x4*)(SC + (32 + li) * 64 + 32 * hi + 4 * s4);
#pragma unroll
        for (int e = 0; e < 4; ++e) { acc[0] = __builtin_amdgcn_mfma_f32_32x32x2f32(sa0[e], eb[e], acc[0], 0, 0, 0); acc[1] = __builtin_amdgcn_mfma_f32_32x32x2f32(sa1[e], eb[e], acc[1], 0, 0, 0); }
    }
    float s1 = 0.f;
#pragma unroll
    for (int ti = 0; ti < 2; ++ti)
#pragma unroll
        for (int r = 0; r < 16; ++r) s1 += acc[ti][r];
    s1 = xhalf_sum(s1); const float mean = s1 * (1.f / 64.f);
    float s2 = 0.f;
#pragma unroll
    for (int ti = 0; ti < 2; ++ti)
#pragma unroll
        for (int r = 0; r < 16; ++r) { const float d = acc[ti][r] - mean; s2 += d * d; }
    s2 = xhalf_sum(s2); const float rstd = 1.f / sqrtf(s2 * (1.f / 64.f) + 64e-5f);
    if (t >= si.ntok) return;
    const float bon = ((const float*)(p->ws + WS_BONUS))[(size_t)unit * 64 + t];
    const size_t row = (size_t)(si.row0 + t);
    bf16_t* oc = (bf16_t*)(p->ws + WS_OCAT) + (size_t)2 * NTOK * 512 + row * 512 + h * 64;
#pragma unroll
    for (int ti = 0; ti < 2; ++ti)
#pragma unroll
        for (int rg = 0; rg < 4; ++rg) { const int i = 32 * ti + 8 * rg + 4 * hi, c = h * 64 + i;
            const f32x4 gg = *(const f32x4*)(p->in[I_GNG] + l * 512 + c), gb = *(const f32x4*)(p->in[I_GNB] + l * 512 + c), mu = *(const f32x4*)(p->in[I_MU] + l * SHIFT_W + 1024 + c);
            const u32x2 vx = *(const u32x2*)(U + row * NU + U_XC + 1024 + c); const u32x2 sg = *(const u32x2*)(U + row * NU + U_CSG + c);
            f32x4 vc = (f32x4){bflo(vx.x), bfhi(vx.x), bflo(vx.y), bfhi(vx.y)}, vp;
            {
                const u32x2 px = *(const u32x2*)(U + (row > 0 ? row - 1 : 0) * NU + U_XC + 1024 + c); const f32x4 ss = *(const f32x4*)(p->in[I_SSHIFT] + ((size_t)l * 32 + si.b) * SHIFT_W + 1024 + c);
                const f32x4 up = (f32x4){bflo(px.x), bfhi(px.x), bflo(px.y), bfhi(px.y)};
                vp = (t > 0 || si.prev_kind == 1) ? up : (si.prev_kind == 2 ? ss : (f32x4){0.f, 0.f, 0.f, 0.f}); }
            const f32x4 vs = vc + (vp - vc) * mu;
            const f32x4 sgf = (f32x4){bflo(sg.x), bfhi(sg.x), bflo(sg.y), bfhi(sg.y)};
            f32x4 o;
#pragma unroll
            for (int e = 0; e < 4; ++e) o[e] = (((acc[ti][rg * 4 + e] - mean) * rstd) * gg[e] + gb[e] + bon * vs[e]) * siluf_(sgf[e]);
            u32x2 w; w.x = cvt_pk_bf16(o[0], o[1]); w.y = cvt_pk_bf16(o[2], o[3]); *(u32x2*)(oc + i) = w; }
}
__device__ __forceinline__ int krow(int i) { return (i & 3) + 4 * ((i >> 3) & 1) + 8 * ((i >> 2) & 1) + 16 * (i >> 4); }
__device__ __forceinline__ bf16x8 pack8(const f32x16& v, int o) { u32x4 w; w.x = cvt_pk_bf16(v[o], v[o + 1]); w.y = cvt_pk_bf16(v[o + 2], v[o + 3]); w.z = cvt_pk_bf16(v[o + 4], v[o + 5]); w.w = cvt_pk_bf16(v[o + 6], v[o + 7]); return __builtin_bit_cast(bf16x8, w); }
constexpr float ATT_NEG = -1e30f;
template <bool HALF>
__device__ __forceinline__ void softmax_tile(f32x16& p0, f32x16& p1, float& m, float& lsum, f32x16 (&O)[2], bf16x8 (&pb)[4]) {
    float mx = p0[0];
#pragma unroll
    for (int r = 1; r < 16; ++r) mx = fmaxf(mx, p0[r]);
    if (!HALF) {
#pragma unroll
        for (int r = 0; r < 16; ++r) mx = fmaxf(mx, p1[r]); }
    mx = xhalf_max(mx);
    const float mn = fmaxf(m, mx), alpha = __builtin_amdgcn_exp2f(m - mn);
    m = mn;
    float s = 0.f;
#pragma unroll
    for (int r = 0; r < 16; ++r) { p0[r] = __builtin_amdgcn_exp2f(p0[r] - mn); s += p0[r]; }
    if (!HALF) {
#pragma unroll
        for (int r = 0; r < 16; ++r) { p1[r] = __builtin_amdgcn_exp2f(p1[r] - mn); s += p1[r]; } }
    lsum = lsum * alpha + s;
#pragma unroll
    for (int r = 0; r < 16; ++r) { O[0][r] *= alpha; O[1][r] *= alpha; }
    pb[0] = pack8(p0, 0); pb[1] = pack8(p0, 8);
    if (!HALF) { pb[2] = pack8(p1, 0); pb[3] = pack8(p1, 8); }
}
constexpr int AKS = 72;
constexpr int ATT_KB = 0, ATT_VB = 2 * 64 * AKS * 2, ATT_FB = 4 * 64 * AKS * 2, ATT_SC = ATT_FB + 2 * 64 * 4;
__device__ __forceinline__ void attn_prompt_unit(KP p, int l, int h, int qb, LAS unsigned char* lds, int tid) {
    const bf16_t* U = (const bf16_t*)(p->ws + WS_U); const bf16_t* Vt = (const bf16_t*)(p->ws + WS_VT) + (size_t)h * 64 * TP; const float* F = (const float*)(p->ws + WS_FP) + (size_t)h * TP;
    const int wave = tid >> 6, lane = tid & 63, li = lane & 31, hi = lane >> 5;
    const int q0 = qb * 256, q = q0 + wave * 32 + li;
    bf16x8 qf[4];
    { const float sc = 0.125f * LOG2E;
#pragma unroll
      for (int d0 = 0; d0 < 4; ++d0) { const u32x4 w = *(const u32x4*)(U + (size_t)q * NU + U_Q + h * 64 + 16 * d0 + 8 * hi);
          qf[d0] = pack8f((f32x4){bflo(w.x) * sc, bfhi(w.x) * sc, bflo(w.y) * sc, bfhi(w.y) * sc}, (f32x4){bflo(w.z) * sc, bfhi(w.z) * sc, bflo(w.w) * sc, bfhi(w.w) * sc}); } }
    const float fq = F[q];
    float m = ATT_NEG, lsum = 0.f; f32x16 O[2] = {};
    const int NT = (q0 + 256) / 64;
    LAS float* qmx = (LAS float*)(lds + ATT_SC); LAS float* mmv = qmx + 8;
    { float q2 = 0.f;
#pragma unroll
      for (int d0 = 0; d0 < 4; ++d0) { const u32x4 w = __builtin_bit_cast(u32x4, qf[d0]); q2 += bflo(w.x) * bflo(w.x) + bfhi(w.x) * bfhi(w.x) + bflo(w.y) * bflo(w.y) + bfhi(w.y) * bfhi(w.y) + bflo(w.z) * bflo(w.z) + bfhi(w.z) * bfhi(w.z) + bflo(w.w) * bflo(w.w) + bfhi(w.w) * bfhi(w.w); }
      q2 = wave_max(xhalf_sum(q2)); if (lane == 0) { qmx[wave] = q2; mmv[wave] = ATT_NEG; } }
    const float kmax2 = __uint_as_float(((const unsigned*)(p->ws + WS_CTL))[CW_KMAX + l * 8 + h]), fq0 = F[q0];
    const int srow = tid >> 3, sch = tid & 7;
    const bf16_t* kg = U + (size_t)srow * NU + U_K + h * 64 + 8 * sch; const bf16_t* vg = Vt + (size_t)srow * TP + 8 * sch;
    LAS unsigned char* kdst = lds + ATT_KB + (srow * AKS + 8 * sch) * 2; LAS unsigned char* vdst = lds + ATT_VB + (srow * AKS + 8 * sch) * 2;
    u32x4 kr = *(const u32x4*)(kg + (size_t)(NT - 1) * 64 * NU), vr = *(const u32x4*)(vg + (NT - 1) * 64); float fr = tid < 64 ? F[(NT - 1) * 64 + tid] : 0.f;
    *(LAS u32x4*)kdst = kr; *(LAS u32x4*)vdst = vr; if (tid < 64) ((LAS float*)(lds + ATT_FB))[tid] = fr;
    __syncthreads();
    const int ka = krow(li);
    float qkb; { float q2 = qmx[0];
#pragma unroll
      for (int w = 1; w < 8; ++w) q2 = fmaxf(q2, qmx[w]);
      qkb = 1.02f * sqrtf(q2 * kmax2) + fq0; }
    for (int t = NT - 1, buf = 0; t >= 0; --t, buf ^= 1) {
        { float mmin = mmv[0];
#pragma unroll
          for (int w = 1; w < 8; ++w) mmin = fminf(mmin, mmv[w]);
          if (qkb - ((const LAS float*)(lds + ATT_FB))[buf * 64 + 63] < mmin - 40.f) break; }
        if (t > 0) { kr = *(const u32x4*)(kg + (size_t)(t - 1) * 64 * NU); vr = *(const u32x4*)(vg + (t - 1) * 64); if (tid < 64) fr = F[(t - 1) * 64 + tid]; }
        if (64 * t <= q0 + wave * 32 + 31) {
            const LAS bf16_t* Kb = (const LAS bf16_t*)(lds + ATT_KB) + buf * 64 * AKS; const LAS bf16_t* Vb = (const LAS bf16_t*)(lds + ATT_VB) + buf * 64 * AKS; const LAS float* Fb = (const LAS float*)(lds + ATT_FB) + buf * 64;
            f32x16 p0, p1;
#pragma unroll
            for (int g2 = 0; g2 < 2; ++g2) { const f32x4 a = *(const LAS f32x4*)(Fb + 8 * hi + 16 * g2), b = *(const LAS f32x4*)(Fb + 8 * hi + 16 * g2 + 4), c = *(const LAS f32x4*)(Fb + 32 + 8 * hi + 16 * g2), d = *(const LAS f32x4*)(Fb + 32 + 8 * hi + 16 * g2 + 4);
#pragma unroll
                for (int e = 0; e < 4; ++e) { p0[8 * g2 + e] = fq - a[e]; p0[8 * g2 + 4 + e] = fq - b[e]; p1[8 * g2 + e] = fq - c[e]; p1[8 * g2 + 4 + e] = fq - d[e]; } }
#pragma unroll
            for (int d0 = 0; d0 < 4; ++d0) { const bf16x8 a0 = *(const LAS bf16x8*)(Kb + ka * AKS + 16 * d0 + 8 * hi), a1 = *(const LAS bf16x8*)(Kb + (ka + 32) * AKS + 16 * d0 + 8 * hi);
                p0 = __builtin_amdgcn_mfma_f32_32x32x16_bf16(a0, qf[d0], p0, 0, 0, 0); p1 = __builtin_amdgcn_mfma_f32_32x32x16_bf16(a1, qf[d0], p1, 0, 0, 0); }
            if (64 * t + 63 > q0 + wave * 32) {
#pragma unroll
                for (int r = 0; r < 16; ++r) { const int kv = 64 * t + 8 * hi + 16 * (r >> 3) + (r & 7); if (kv > q) p0[r] = -INFINITY; if (kv + 32 > q) p1[r] = -INFINITY; } }
            bf16x8 pb[4];
            softmax_tile<false>(p0, p1, m, lsum, O, pb);
#pragma unroll
            for (int dt = 0; dt < 2; ++dt)
#pragma unroll
                for (int s = 0; s < 4; ++s) { const bf16x8 a = *(const LAS bf16x8*)(Vb + (32 * dt + li) * AKS + 16 * (s & 1) + 32 * (s >> 1) + 8 * hi);
                    O[dt] = __builtin_amdgcn_mfma_f32_32x32x16_bf16(a, pb[s], O[dt], 0, 0, 0); }
        }
        { const float wm = wave_min(m); if (lane == 0) mmv[wave] = wm; }
        if (t > 0) { const int nb = buf ^ 1; *(LAS u32x4*)(kdst + nb * 64 * AKS * 2) = kr; *(LAS u32x4*)(vdst + nb * 64 * AKS * 2) = vr; if (tid < 64) ((LAS float*)(lds + ATT_FB))[nb * 64 + tid] = fr; }
        __syncthreads();
    }
    __syncthreads();
    const float inv = 1.f / xhalf_sum(lsum);
    bf16_t* ob = (bf16_t*)(p->ws + WS_OCAT) + (size_t)1 * NTOK * 512 + (size_t)q * 512 + h * 64;
#pragma unroll
    for (int dt = 0; dt < 2; ++dt)
#pragma unroll
        for (int rg = 0; rg < 4; ++rg) { const int d = 32 * dt + 8 * rg + 4 * hi; const u32x2 sg = *(const u32x2*)(U + (size_t)q * NU + U_BSG + h * 64 + d);
            u32x2 w; w.x = cvt_pk_bf16(O[dt][rg * 4] * inv * siluf_(bflo(sg.x)), O[dt][rg * 4 + 1] * inv * siluf_(bfhi(sg.x))); w.y = cvt_pk_bf16(O[dt][rg * 4 + 2] * inv * siluf_(bflo(sg.y)), O[dt][rg * 4 + 3] * inv * siluf_(bfhi(sg.y)));
            *(u32x2*)(ob + d) = w; }
}
__device__ __forceinline__ void attn_sample_unit(KP p, int l, int b, int h, LAS unsigned char* lds, int tid) {
    const bf16_t* U = (const bf16_t*)(p->ws + WS_U);
    const int wave = tid >> 6, lane = tid & 63, li = lane & 31, hi = lane >> 5;
    const size_t qrow = (size_t)TP + b * 32 + li;
    const float* G = (const float*)(p->ws + WS_GS) + ((size_t)b * 8 + h) * GS_LEN;
    bf16x8 qf[4];
    { const float sc = 0.125f * LOG2E;
#pragma unroll
      for (int d0 = 0; d0 < 4; ++d0) { const u32x4 w = *(const u32x4*)(U + qrow * NU + U_Q + h * 64 + 16 * d0 + 8 * hi);
          qf[d0] = pack8f((f32x4){bflo(w.x) * sc, bfhi(w.x) * sc, bflo(w.y) * sc, bfhi(w.y) * sc}, (f32x4){bflo(w.z) * sc, bfhi(w.z) * sc, bflo(w.w) * sc, bfhi(w.w) * sc}); } }
    const float fq = G[PAST + li];
    float m = ATT_NEG, lsum = 0.f; f32x16 O[2] = {};
    const float* CK = p->in[I_CK] + (((size_t)l * 32 + b) * PAST) * 512 + h * 64; const float* CV = p->in[I_CV] + (((size_t)l * 32 + b) * PAST) * 512 + h * 64;
    const int ka = krow(li);
    for (int tt = 0; tt < 8; ++tt) {
        const int key0 = (wave * 8 + tt) * 64;
        f32x16 p0, p1;
#pragma unroll
        for (int g2 = 0; g2 < 2; ++g2) { const float* gp = G + key0 + 8 * hi + 16 * g2; const f32x4 a = *(const f32x4*)gp, bq = *(const f32x4*)(gp + 4), c = *(const f32x4*)(gp + 32), d = *(const f32x4*)(gp + 36);
#pragma unroll
            for (int e = 0; e < 4; ++e) { p0[8 * g2 + e] = fq - a[e]; p0[8 * g2 + 4 + e] = fq - bq[e]; p1[8 * g2 + e] = fq - c[e]; p1[8 * g2 + 4 + e] = fq - d[e]; } }
#pragma unroll
        for (int d0 = 0; d0 < 4; ++d0) { const float* k0p = CK + (size_t)(key0 + ka) * 512 + 16 * d0 + 8 * hi; const float* k1p = k0p + (size_t)32 * 512;
            const bf16x8 a0 = pack8f(*(const f32x4*)k0p, *(const f32x4*)(k0p + 4)), a1 = pack8f(*(const f32x4*)k1p, *(const f32x4*)(k1p + 4));
            p0 = __builtin_amdgcn_mfma_f32_32x32x16_bf16(a0, qf[d0], p0, 0, 0, 0); p1 = __builtin_amdgcn_mfma_f32_32x32x16_bf16(a1, qf[d0], p1, 0, 0, 0); }
        bf16x8 pb[4];
        softmax_tile<false>(p0, p1, m, lsum, O, pb);
#pragma unroll
        for (int dt = 0; dt < 2; ++dt)
#pragma unroll
            for (int s = 0; s < 4; ++s) { const float* vp = CV + (size_t)(key0 + 16 * (s & 1) + 32 * (s >> 1) + 8 * hi) * 512 + 32 * dt + li;
                const bf16x8 a = pack8f((f32x4){vp[0], vp[512], vp[1024], vp[1536]}, (f32x4){vp[2048], vp[2560], vp[3072], vp[3584]});
                O[dt] = __builtin_amdgcn_mfma_f32_32x32x16_bf16(a, pb[s], O[dt], 0, 0, 0); }
    }
    if (wave == 7) {
        f32x16 p0, p1 = {};
#pragma unroll
        for (int g2 = 0; g2 < 2; ++g2) { const float* gp = G + PAST + 8 * hi + 16 * g2; const f32x4 a = *(const f32x4*)gp, bq = *(const f32x4*)(gp + 4);
#pragma unroll
            for (int e = 0; e < 4; ++e) { p0[8 * g2 + e] = fq - a[e]; p0[8 * g2 + 4 + e] = fq - bq[e]; } }
#pragma unroll
        for (int d0 = 0; d0 < 4; ++d0) { const bf16x8 a0 = *(const bf16x8*)(U + ((size_t)TP + b * 32 + ka) * NU + U_K + h * 64 + 16 * d0 + 8 * hi);
            p0 = __builtin_amdgcn_mfma_f32_32x32x16_bf16(a0, qf[d0], p0, 0, 0, 0); }
#pragma unroll
        for (int r = 0; r < 16; ++r) { const int kv = 8 * hi + 16 * (r >> 3) + (r & 7); if (kv > li) p0[r] = -INFINITY; }
        bf16x8 pb[4];
        softmax_tile<true>(p0, p1, m, lsum, O, pb);
#pragma unroll
        for (int dt = 0; dt < 2; ++dt)
#pragma unroll
            for (int s = 0; s < 2; ++s) { const bf16_t* vp = U + ((size_t)TP + b * 32 + 16 * s + 8 * hi) * NU + U_V + h * 64 + 32 * dt + li; u32x4 w;
                w.x = (unsigned)vp[0] | ((unsigned)vp[NU] << 16); w.y = (unsigned)vp[2 * NU] | ((unsigned)vp[3 * NU] << 16); w.z = (unsigned)vp[4 * NU] | ((unsigned)vp[5 * NU] << 16); w.w = (unsigned)vp[6 * NU] | ((unsigned)vp[7 * NU] << 16);
                O[dt] = __builtin_amdgcn_mfma_f32_32x32x16_bf16(__builtin_bit_cast(bf16x8, w), pb[s], O[dt], 0, 0, 0); }
    }
    LAS float* Ow = (LAS float*)lds;
    LAS float* ML = Ow + 8 * 32 * 64;
    lsum = xhalf_sum(lsum);
#pragma unroll
    for (int dt = 0; dt < 2; ++dt)
#pragma unroll
        for (int r = 0; r < 16; ++r) Ow[(wave * 32 + dt * 16 + r) * 64 + lane] = O[dt][r];
    if (hi == 0) { ML[(wave * 2) * 32 + li] = m; ML[(wave * 2 + 1) * 32 + li] = lsum; }
    __syncthreads();
    { const int qq = tid & 31, dg = tid >> 5; float M = ATT_NEG;
#pragma unroll
      for (int w = 0; w < 8; ++w) M = fmaxf(M, ML[(w * 2) * 32 + qq]);
      float L = 0.f; f32x4 o = {0.f, 0.f, 0.f, 0.f};
      const int d = 4 * dg, idx0 = (d >> 5) * 16 + ((d >> 3) & 3) * 4, ln = ((d >> 2) & 1) * 32 + qq;
#pragma unroll
      for (int w = 0; w < 8; ++w) { const float f = __builtin_amdgcn_exp2f(ML[(w * 2) * 32 + qq] - M); L += ML[(w * 2 + 1) * 32 + qq] * f;
#pragma unroll
          for (int e = 0; e < 4; ++e) o[e] += Ow[(w * 32 + idx0 + e) * 64 + ln] * f; }
      const float inv = 1.f / L; const size_t row = (size_t)TP + b * 32 + qq;
      const u32x2 sg = *(const u32x2*)(U + row * NU + U_BSG + h * 64 + d);
      u32x2 wv; wv.x = cvt_pk_bf16(o[0] * inv * siluf_(bflo(sg.x)), o[1] * inv * siluf_(bfhi(sg.x))); wv.y = cvt_pk_bf16(o[2] * inv * siluf_(bflo(sg.y)), o[3] * inv * siluf_(bfhi(sg.y)));
      *(u32x2*)((bf16_t*)(p->ws + WS_OCAT) + (size_t)1 * NTOK * 512 + row * 512 + h * 64 + d) = wv; }
    __syncthreads();
}
constexpr int NPHASE = 22;
__global__ void __launch_bounds__(512, 2) hse_fwd(Params p_) {
    const KP kp = (KP)__builtin_amdgcn_kernarg_segment_ptr();
    (void)p_;
    extern __shared__ __attribute__((aligned(16))) unsigned char lds_raw[];
    LAS unsigned char* lds = (LAS unsigned char*)lds_raw;
    const int tid0 = threadIdx.x;
    const int G = gridDim.x, bid = blockIdx.x, ngw = G * 8;
#define PH_LOCALS const KP p = kp_fresh(kp); int tid = tid0; asm volatile("" : "+v"(tid)); const int lane = tid & 63, wave = __builtin_amdgcn_readfirstlane(tid >> 6), gw = bid * 8 + wave; (void)lane; (void)gw; (void)p;
    if (tid0 < 4) ((LAS unsigned*)(lds + LDS_XB_OFF))[tid0] = 0u;
#if PROBE_ID
    if (tid0 == 0) *(LAS unsigned long long*)(lds + LDS_PROBE_OFF) = 0ull;
#endif
    __syncthreads();
    unsigned* ctl = (unsigned*)(kp->ws + WS_CTL);
    XcdBarrier bar = xcd_barrier_post(ctl + CW_BAR + kp->li * XCD_BAR_WORDS, (volatile LAS unsigned*)(lds + LDS_XB_OFF));
    const int lo = kp->ph_lo, hi = kp->ph_hi;
#define IN(k) (lo <= (k) && (k) < hi)
#ifndef DUP_MASK
#define DUP_MASK 0
#endif
#define NREP(k) (((DUP_MASK >> (k)) & 1) + 1)
#define SEAM(k) do { if (IN(k) && IN((k) + 1)) xcd_barrier(bar); } while (0)
    PT0();
    if (IN(0)) { PH_LOCALS
        for (int u = bid; u < 192; u += G) ada_unit(p, u, lds, tid);
        p0_weights(p, lds, gw, ngw, wave, lane);
    }
    SEAM(0);
    PT1(9);
    for (int l = 0; l < NLAYER; ++l) {
        const int pb = 1 + 10 * l;
        for (int rep = 0; rep < NREP(0); ++rep) { if (rep) xcd_barrier(bar);
        if (IN(pb)) { PH_LOCALS p1_rows(p, l, gw, ngw, lane); } }
        SEAM(pb);
        PT1(10);
        for (int rep = 0; rep < NREP(1); ++rep) { if (rep) xcd_barrier(bar);
        if (IN(pb + 1)) { PH_LOCALS
            pg8::Gemm g{(const bf16_t*)(p->ws + WS_H), (const bf16_t*)(p->ws + WS_WIN) + (size_t)l * NU * 2048, NTOK, NU, 2048};
            pg8::StaticOrder S; S.init(NTOK, NU, G, bid);
            EpiU E{(bf16_t*)(p->ws + WS_U), p->out, p->in[I_BF], l};
            pg8::gemm_phase<EpiU, pg8::StaticOrder>(lds, g, S, E, nullptr);
        }
        }
        SEAM(pb + 1);
        PT1(11);
        for (int rep = 0; rep < NREP(2); ++rep) { if (rep) xcd_barrier(bar);
        if (IN(pb + 2)) { PH_LOCALS
#ifndef DUP_SUB
#define DUP_SUB 0
#endif
            { PT0();
            for (int u = bid; u < NRU * ((DUP_SUB & 1) + 1); u += G) rwkv_r1(p, l, u % NRU, lds, tid);
            PT1(31);
            for (int u = bid; u < 544 * (((DUP_SUB >> 1) & 1) + 1); u += G) conv_unit(p, l, u % 544, lds, tid);
            PT1(32);
            for (int u = bid; u < 544 * (((DUP_SUB >> 2) & 1) + 1); u += G) pool_unit(p, l, u % 544, lds, tid);
            PT1(33);
            for (int u = bid; u < 256; u += G) { vt_tile(p, l, u * 8 + wave, lds, wave, lane); }
            __syncthreads();
            for (int u = bid; u < 32; u += G) gs_unit(p, l, u, lds, tid);
            for (int u = G - 1 - bid; u < 8; u += G) fp_unit(p, l, u, lds, tid);
            if (bid == G / 2) shift_out(p, l, tid);
            PT1(34); }
        }
        }
        SEAM(pb + 2);
        PT1(12);
        for (int rep = 0; rep < NREP(3); ++rep) { if (rep) xcd_barrier(bar);
        if (IN(pb + 3)) { PH_LOCALS
            if (wave < 4) for (int tk = bid * 4 + wave; tk < 1024; tk += G * 4) rwkv_l1_task(p, tk, lane);
            __syncthreads();
            LAS int* qslot = (LAS int*)(lds + LDS_XB_OFF - 16);
            for (;;) {
                if (tid == 0) *qslot = (int)atomicAdd(ctl + CW_QUEUE + 64 * (2 * l + 4 * rep), 1u);
                __syncthreads();
                const int item = *qslot;
                __syncthreads();
                if (item >= 512) break;
                attn_prompt_unit(p, l, item & 7, 63 - (item >> 3), lds, tid);
            }
            for (;;) {
                if (tid == 0) *qslot = (int)atomicAdd(ctl + CW_QUEUE + 64 * (2 * l + 1 + 4 * rep), 1u);
                __syncthreads();
                const int item = *qslot;
                __syncthreads();
                if (item >= 256) break;
                attn_sample_unit(p, l, item >> 3, item & 7, lds, tid);
            }
        }
        }
        SEAM(pb + 3);
        PT1(13);
        if (IN(pb + 4)) { PH_LOCALS if (wave == 0 && bid < 32) rwkv_l2_task(p, l, bid, lane); }
        SEAM(pb + 4);
        PT1(14);
        if (IN(pb + 5)) { PH_LOCALS for (int tk = (wave * G + bid); tk < 512 + 1024; tk += ngw) rwkv_l3_task(p, l, tk, lane); }
        SEAM(pb + 5);
        PT1(15);
        if (IN(pb + 6)) { PH_LOCALS for (int tk = gw; tk < NRU * 2; tk += ngw) rwkv_r3_task(p, l, tk, lane); }
        SEAM(pb + 6);
        PT1(16);
        for (int rep = 0; rep < NREP(7); ++rep) { if (rep) xcd_barrier(bar);
        if (IN(pb + 7)) { PH_LOCALS
            pg8::Gemm g{(const bf16_t*)(p->ws + WS_OCAT), (const bf16_t*)(p->ws + WS_WBR) + (size_t)l * 4 * 2048 * 512, 4 * NTOK, 4 * 2048, 512};
            BranchOrder S{G, bid};
            EpiZ E{(bf16_t*)(p->ws + WS_Z)};
            pg8::gemm_phase<EpiZ, BranchOrder>(lds, g, S, E, nullptr);
        }
        }
        SEAM(pb + 7);
        PT1(17);
        if (IN(pb + 8)) { PH_LOCALS merge_pass(p, bid * 512 + tid, G * 512); }
        SEAM(pb + 8);
        PT1(18);
        if (IN(pb + 9)) { PH_LOCALS
            pg8::Gemm g{(const bf16_t*)(p->ws + WS_MERGED), (const bf16_t*)(p->ws + WS_WOUT) + (size_t)l * 2048 * 2048, NTOK, 2048, 2048};
            pg8::StaticOrder S; S.init(NTOK, 2048, G, bid);
            EpiOut E{p->in[I_XP], p->in[I_XS], (const float*)(p->ws + WS_XBUF), (const float*)(p->ws + WS_ADA), (float*)(p->ws + WS_XBUF), l};
            pg8::gemm_phase<EpiOut, pg8::StaticOrder>(lds, g, S, E, nullptr);
        }
        SEAM(pb + 9);
        PT1(19);
    }
    if (IN(21)) { PH_LOCALS p_final_rows(p, gw, ngw, lane); }
    PT1(20);
#if PROBE_ID
    if (bid == 0 && tid0 == 0) { const unsigned long long w = *(LAS unsigned long long*)(lds + LDS_PROBE_OFF) * PROBE_K, t0 = __builtin_amdgcn_s_memrealtime(); while (__builtin_amdgcn_s_memrealtime() - t0 < w) __builtin_amdgcn_s_sleep(8); }
#endif
#undef IN
#undef SEAM
}
#ifndef MK_SPLIT
#define MK_SPLIT 0
#endif
extern "C" void kernel_launch(void* const* d_in, const int* in_sizes, int n_in, void* d_out, int out_size, void* d_ws, size_t ws_size, hipStream_t stream) {
    static int grid = 0;
    if (grid == 0) {
        if (n_in != N_IN || (size_t)out_size != O_END || ws_size < WS_END) { fprintf(stderr, "kernel_launch: unexpected shapes (n_in %d, out %d, ws %zu)\n", n_in, out_size, ws_size); grid = -1; return; }
        int dev = 0, cus = 0, per_cu = 0;
        if (hipGetDevice(&dev) != hipSuccess || hipDeviceGetAttribute(&cus, hipDeviceAttributeMultiprocessorCount, dev) != hipSuccess) { grid = -1; return; }
        if (hipFuncSetAttribute((const void*)hse_fwd, hipFuncAttributeMaxDynamicSharedMemorySize, LDS_BYTES) != hipSuccess) { fprintf(stderr, "kernel_launch: hipFuncSetAttribute failed\n"); grid = -1; return; }
        if (hipOccupancyMaxActiveBlocksPerMultiprocessor(&per_cu, (const void*)hse_fwd, 512, LDS_BYTES) != hipSuccess || per_cu < 1) fprintf(stderr, "kernel_launch: occupancy query reports %d\n", per_cu);
        (void)hipGetLastError();
        grid = cus;
    }
    if (grid < 0) return;
    if (hipMemsetAsync((char*)d_ws + WS_CTL, 0, CTL_BYTES, stream) != hipSuccess) return;
    Params a{};
    for (int i = 0; i < N_IN; ++i) a.in[i] = (const float*)d_in[i];
    a.out = (float*)d_out; a.ws = (unsigned char*)d_ws;
#if MK_SPLIT
    for (int ph = 0; ph < NPHASE; ++ph) { a.ph_lo = ph; a.ph_hi = ph + 1; a.li = ph; hipLaunchKernelGGL(hse_fwd, dim3(grid), dim3(512), LDS_BYTES, stream, a); }
#else
    a.ph_lo = 0; a.ph_hi = NPHASE; a.li = 0;
    hipLaunchKernelGGL(hse_fwd, dim3(grid), dim3(512), LDS_BYTES, stream, a);
#endif
    const hipError_t le = hipPeekAtLastError();
    if (le != hipSuccess) fprintf(stderr, "kernel_launch: launch failed: %s\n", hipGetErrorName(le));
}
```

```cpp
#include <hip/hip_runtime.h>
#include <cstdio>
#include <cstdint>
namespace pg8 {
#define PG8_LAS __attribute__((address_space(3)))
typedef unsigned short bf16_t;
typedef short bf16x8 __attribute__((ext_vector_type(8)));
typedef float f32x4 __attribute__((ext_vector_type(4)));
typedef unsigned u32x4 __attribute__((ext_vector_type(4)));
constexpr int BM = 256, BK = 64, HALF = 128, HTB = HALF * BK * 2  , STAGE_BYTES = 8 * HTB, NXCD = 8, WGM = 8;

__host__ __device__ __forceinline__ int lds_byte(int r, int c) { const int st = (r >> 4) * 2 + (c >> 5), rr = r & 15, cc = c & 31, ob = rr * 64 + cc * 2; return st * 1024 + (ob ^ (((ob >> 9) & 1) << 5)); }
__host__ __device__ __forceinline__ void stage_rc(int b, int& R, int& C) { const int st = b / 1024, sb = b % 1024, swz = sb ^ (((sb >> 9) & 1) << 5); R = (st >> 1) * 16 + swz / 64; C = (st & 1) * 32 + (swz % 64) / 2; }
__host__ __device__ __forceinline__ int perm32(int rho) { const int n = rho >> 4, i = rho & 15; return 8 * (i >> 2) + 4 * n + (i & 3); }

struct Unit { int pm, pn; };
struct Gemm { const bf16_t* A; const bf16_t* Bt; int M, N, K; };

struct StaticOrder {
    int nM, nN, nwg, G, c;
    __host__ __device__ void init(int M, int N, int G_, int c_) { nM = M / BM; nN = N / BM; nwg = nM * nN; G = G_; c = c_; }
    __host__ __device__ bool next(int i, Unit& u) const {
        const long L = (long)i * G + c; if (L >= nwg) return false;
        int wgid = (int)L; { const int q = nwg / NXCD, r = nwg % NXCD, xcd = wgid % NXCD, off = wgid / NXCD; wgid = (xcd < r ? xcd * (q + 1) : r * (q + 1) + (xcd - r) * q) + off; }
        const int nig = WGM * nN, gid = wgid / nig, fm = gid * WGM, gsz = (nM - fm) < WGM ? (nM - fm) : WGM;
        u.pm = fm + ((wgid % nig) % gsz); u.pn = (wgid % nig) / gsz; return true;
    }
    __device__ __forceinline__ void a_ready(const Unit&) const {}
    __device__ __forceinline__ void done(const Unit&) const {}
};
__device__ __forceinline__ unsigned cvt_pk_bf16(float lo, float hi) { unsigned r; asm volatile("v_cvt_pk_bf16_f32 %0, %1, %2" : "=v"(r) : "v"(lo), "v"(hi)); return r; }
typedef float f32x2 __attribute__((ext_vector_type(2)));
template <class Epi, class Sched, bool STAMP = false>
__device__ __forceinline__ void gemm_phase(PG8_LAS unsigned char* lds, const Gemm g, const Sched& S, const Epi& E, unsigned long long* stamps) {
    int tid = threadIdx.x; asm volatile("" : "+v"(tid));
    const int wid = __builtin_amdgcn_readfirstlane(tid >> 6), lane = tid & 63, wr = wid >> 2, wc = wid & 3, fr = lane & 15, fq = lane >> 4;
    const int K = g.K, nt = K / BK;
    int ts_lo = 0, ts_hi = 0, nts = 0; const unsigned long long rt_entry = STAMP ? (unsigned long long)wall_clock64() : 0ull;
#define PG8_STAMP() do { if (STAMP && wid == 0 && nts < 64) { const unsigned long long _c = (unsigned long long)clock64(); \
        ts_lo = (lane == nts) ? (int)(unsigned)_c : ts_lo; ts_hi = (lane == nts) ? (int)(unsigned)(_c >> 32) : ts_hi; ++nts; } } while (0)
    PG8_STAMP();
    unsigned voffA[2], voffB[2];
#pragma unroll
    for (int i = 0; i < 2; ++i) { int R, C; stage_rc(tid * 16 + i * 8192, R, C); const int Rb = Epi::PERM ? ((R & ~31) + perm32(R & 31)) : R;
        voffA[i] = (unsigned)(R * K + C) * 2u; voffB[i] = (unsigned)(Rb * K + C) * 2u; }
    const size_t kstep = (size_t)(BK * 2);
    const size_t hstep = (size_t)HALF * K * 2;
    const size_t tstep = 2 * hstep;
    const unsigned ldsw = (unsigned)wid * 1024u;
    const int aoff = lds_byte(wr * 64 + fr, fq * 8), boff = lds_byte(wc * 32 + fr, fq * 8);
#define PG8_SA(b, h) (((b) * 2 + (h)) * HTB)
#define PG8_SB(b, h) ((4 + (b) * 2 + (h)) * HTB)
#define PG8_STAGE(bufoff, gbase, voff) do { _Pragma("unroll") for (int _i = 0; _i < 2; ++_i) \
        __builtin_amdgcn_global_load_lds((const unsigned*)((const char*)(gbase) + (voff)[_i]), (PG8_LAS unsigned*)(lds + (bufoff) + ldsw + _i * 8192), 16, 0, 0); } while (0)
#define PG8_LDA(dst, b, h) do { _Pragma("unroll") for (int m = 0; m < 4; ++m) _Pragma("unroll") for (int k = 0; k < 2; ++k) dst[m][k] = *(const PG8_LAS bf16x8*)(lds + PG8_SA(b, h) + aoff + m * 2048 + k * 1024); } while (0)
#define PG8_LDB(dst, b, h) do { _Pragma("unroll") for (int n = 0; n < 2; ++n) _Pragma("unroll") for (int k = 0; k < 2; ++k) dst[n][k] = *(const PG8_LAS bf16x8*)(lds + PG8_SB(b, h) + boff + n * 2048 + k * 1024); } while (0)
#define PG8_MMA(ai, bj, At, Bt) do { __builtin_amdgcn_s_setprio(1); _Pragma("unroll") for (int m = 0; m < 4; ++m) _Pragma("unroll") for (int n = 0; n < 2; ++n) _Pragma("unroll") for (int k = 0; k < 2; ++k) \
        acc[ai][bj][m][n] = __builtin_amdgcn_mfma_f32_16x16x32_bf16(Bt[n][k], At[m][k], acc[ai][bj][m][n], 0, 0, 0); __builtin_amdgcn_s_setprio(0); } while (0)
#define PG8_WAIT_V(n) asm volatile("s_waitcnt vmcnt(" #n ")" ::: "memory")
#define PG8_WAIT_L(n) asm volatile("s_waitcnt lgkmcnt(" #n ")" ::: "memory")
#define PG8_BAR __builtin_amdgcn_s_barrier()
#define PG8_SCHED __builtin_amdgcn_sched_barrier(0)
    Unit cur, nxt; int ui = 0;
    if (!S.next(0, cur)) return;
    f32x4 acc[2][2][4][2];
#pragma unroll
    for (int a = 0; a < 2; ++a)
#pragma unroll
        for (int b = 0; b < 2; ++b)
#pragma unroll
            for (int m = 0; m < 4; ++m)
#pragma unroll
                for (int n = 0; n < 2; ++n) acc[a][b][m][n] = (f32x4){0.f, 0.f, 0.f, 0.f};
    bf16x8 At[4][2], B0[2][2], B1[2][2];
    const char* cA = (const char*)g.A + (size_t)cur.pm * tstep; const char* cB = (const char*)g.Bt + (size_t)cur.pn * tstep;
    S.a_ready(cur);
    PG8_STAGE(PG8_SB(0, 0), cB, voffB); PG8_STAGE(PG8_SA(0, 0), cA, voffA); PG8_STAGE(PG8_SB(0, 1), cB + hstep, voffB); PG8_STAGE(PG8_SA(0, 1), cA + hstep, voffA);
    if (wr == 1) PG8_BAR;
    PG8_WAIT_V(4); PG8_BAR;
    PG8_STAGE(PG8_SB(1, 0), cB + kstep, voffB); PG8_STAGE(PG8_SA(1, 0), cA + kstep, voffA); PG8_STAGE(PG8_SB(1, 1), cB + hstep + kstep, voffB);
    PG8_WAIT_V(6); PG8_BAR;
    PG8_STAMP();
    for (;;) {
        const bool has_next = S.next(ui + 1, nxt);
        const char* nA = has_next ? (const char*)g.A + (size_t)nxt.pm * tstep : cA; const char* nB = has_next ? (const char*)g.Bt + (size_t)nxt.pn * tstep : cB;
        for (int t = 0; t < nt; t += 2) {
            const bool last = (t == nt - 2);
            const char* a1 = cA + (size_t)(t + 1) * kstep;
            const char* a2 = last ? nA : cA + (size_t)(t + 2) * kstep; const char* b2 = last ? nB : cB + (size_t)(t + 2) * kstep;
            const char* a3 = a2 + kstep; const char* b3 = b2 + kstep;
            if (last && has_next) S.a_ready(nxt);
            PG8_LDB(B0, 0, 0); PG8_SCHED; PG8_LDA(At, 0, 0); PG8_STAGE(PG8_SA(1, 1), a1 + hstep, voffA);
            PG8_WAIT_L(8); PG8_BAR; PG8_WAIT_L(0); PG8_MMA(0, 0, At, B0); PG8_BAR; PG8_SCHED;
            PG8_LDB(B1, 0, 1); PG8_STAGE(PG8_SB(0, 0), b2, voffB);
            PG8_BAR; PG8_WAIT_L(0); PG8_MMA(0, 1, At, B1); PG8_BAR;
            PG8_LDA(At, 0, 1); PG8_STAGE(PG8_SA(0, 0), a2, voffA);
            PG8_BAR; PG8_WAIT_L(0); PG8_MMA(1, 0, At, B0); PG8_BAR; PG8_SCHED;
            PG8_STAGE(PG8_SB(0, 1), b2 + hstep, voffB);
            PG8_WAIT_V(6); PG8_BAR; PG8_MMA(1, 1, At, B1); PG8_BAR;
            PG8_LDB(B0, 1, 0); PG8_SCHED; PG8_LDA(At, 1, 0); PG8_STAGE(PG8_SA(0, 1), a2 + hstep, voffA);
            PG8_WAIT_L(8); PG8_BAR; PG8_WAIT_L(0); PG8_MMA(0, 0, At, B0); PG8_BAR; PG8_SCHED;
            PG8_LDB(B1, 1, 1); PG8_STAGE(PG8_SB(1, 0), b3, voffB);
            PG8_BAR; PG8_WAIT_L(0); PG8_MMA(0, 1, At, B1); PG8_BAR;
            PG8_LDA(At, 1, 1); PG8_STAGE(PG8_SA(1, 0), a3, voffA);
            PG8_BAR; PG8_WAIT_L(0); PG8_MMA(1, 0, At, B0); PG8_BAR; PG8_SCHED;
            PG8_STAGE(PG8_SB(1, 1), b3 + hstep, voffB);
            PG8_WAIT_V(6); PG8_BAR; PG8_MMA(1, 1, At, B1); PG8_BAR;
        }
        PG8_STAMP();
        if constexpr (!Epi::AFTER_DRAIN) { E(acc, cur, wr, wc, fr, fq); S.done(cur); }
        PG8_STAMP();
        if (!has_next) break;
#pragma unroll
        for (int a = 0; a < 2; ++a)
#pragma unroll
            for (int b = 0; b < 2; ++b)
#pragma unroll
                for (int m = 0; m < 4; ++m)
#pragma unroll
                    for (int n = 0; n < 2; ++n) acc[a][b][m][n] = (f32x4){0.f, 0.f, 0.f, 0.f};
        cur = nxt; cA = nA; cB = nB; ++ui;
    }
    PG8_WAIT_V(0);
    if (wr == 0) PG8_BAR;
    PG8_BAR;
    if constexpr (Epi::AFTER_DRAIN) { E.fused(acc, cur, wr, wc, fr, fq, lds, wid, lane); S.done(cur); }
    PG8_STAMP();
    if (STAMP && wid == 0) { stamps[lane] = lane < nts ? (((unsigned long long)(unsigned)ts_hi << 32) | (unsigned)ts_lo) : 0ull;
        if (lane == 62) stamps[62] = rt_entry; if (lane == 63) stamps[63] = (unsigned long long)wall_clock64(); }
#undef PG8_STAMP
#undef PG8_SA
#undef PG8_SB
#undef PG8_STAGE
#undef PG8_LDA
#undef PG8_LDB
#undef PG8_MMA
#undef PG8_WAIT_V
#undef PG8_WAIT_L
#undef PG8_BAR
#undef PG8_SCHED
}
}
#define XB_TMO      128
#define XB_XCNT(j)  (256  + 64 * (j))
#define XB_XSUB(j)  (1280 + 64 * (j))
#define XB_XGEN(j)  (2304 + 64 * (j))
#define XB_TOP      3328
#define XB_TOPGEN   3392
#define XCD_BAR_WORDS 3456
#define XB_SPIN_CAP (1u << 18)
#define LAS __attribute__((address_space(3)))

__device__ __forceinline__ unsigned xb_ld(unsigned* p)              { return __hip_atomic_load(p, __ATOMIC_RELAXED, __HIP_MEMORY_SCOPE_AGENT); }
__device__ __forceinline__ unsigned xb_add(unsigned* p, unsigned v) { return __hip_atomic_fetch_add(p, v, __ATOMIC_RELAXED, __HIP_MEMORY_SCOPE_AGENT); }
__device__ __forceinline__ unsigned xb_xcc_id() { return (unsigned)__builtin_amdgcn_s_getreg((3 << 11) | 20) & 0xFu; }
#define XB_SPIN(cond, bar) do { unsigned _sp = 0; while (cond) { __builtin_amdgcn_s_sleep(1); \
    if ((++_sp & 255u) == 0u) { if (xb_ld(&(bar)[XB_TMO])) break; if (_sp > XB_SPIN_CAP) { atomicAdd(&(bar)[XB_TMO], 1u); break; } } } } while (0)

struct XcdBarrier {
    unsigned* bar; unsigned x;
    volatile LAS unsigned* st;
};

__device__ __forceinline__ XcdBarrier xcd_barrier_post(unsigned* bar, volatile LAS unsigned* st) {
    XcdBarrier b; b.bar = bar; b.x = xb_xcc_id(); b.st = st;
    if (threadIdx.x == 0) (void)xb_add(&bar[XB_XCNT(b.x)], 1u);
    return b;
}
__device__ __forceinline__ void xcd_barrier_complete(unsigned* bar, unsigned x, unsigned& nloc, unsigned& nx) {
    const unsigned G = gridDim.x * gridDim.y * gridDim.z;
    unsigned sum, cnt, mine, sp = 0u;
    for (;;) {
        sum = 0u; cnt = 0u; mine = 0u;
#pragma unroll
        for (unsigned j = 0; j < 16; ++j) { const unsigned c = xb_ld(&bar[XB_XCNT(j)]); sum += c; cnt += (c > 0u) ? 1u : 0u; mine = (j == x) ? c : mine; }
        if (sum == G) break;
        __builtin_amdgcn_s_sleep(1);
        if ((++sp & 255u) == 0u) { if (xb_ld(&bar[XB_TMO])) break; if (sp > XB_SPIN_CAP) { atomicAdd(&bar[XB_TMO], 1u); break; } }
    }
    nloc = mine > 0u ? mine : 1u; nx = cnt > 0u ? cnt : 1u;
}

__device__ __forceinline__ void xcd_barrier(const XcdBarrier& b) {
    asm volatile("s_waitcnt vmcnt(0)" ::: "memory");
    __syncthreads();
    if (threadIdx.x == 0) {
        unsigned* bar = b.bar;
        __builtin_amdgcn_s_waitcnt(0);
        unsigned nloc = b.st[0], nx = b.st[1];
        if (nloc == 0u) { xcd_barrier_complete(bar, b.x, nloc, nx); b.st[0] = nloc; b.st[1] = nx; }
        const unsigned old = xb_add(&bar[XB_XSUB(b.x)], 1u);
        const unsigned gen = old / nloc;
        if (old + 1u == (gen + 1u) * nloc) {
            __builtin_amdgcn_fence(__ATOMIC_RELEASE, "agent");
            asm volatile("s_waitcnt vmcnt(0)" ::: "memory");
            const unsigned og = xb_add(&bar[XB_TOP], 1u);
            const unsigned tg = og / nx;
            if (og + 1u == (tg + 1u) * nx) xb_add(&bar[XB_TOPGEN], 1u);
            else XB_SPIN(xb_ld(&bar[XB_TOPGEN]) == tg, bar);
            __builtin_amdgcn_fence(__ATOMIC_ACQUIRE, "agent");
            xb_add(&bar[XB_XGEN(b.x)], 1u);
            asm volatile("s_waitcnt vmcnt(0)" ::: "memory");
        } else {
            XB_SPIN(xb_ld(&bar[XB_XGEN(b.x)]) == gen, bar);
            __builtin_amdgcn_fence(__ATOMIC_ACQUIRE, "agent");
            asm volatile("s_waitcnt vmcnt(0)" ::: "memory");
        }
    }
    __syncthreads();
}
typedef unsigned short bf16_t;
typedef short bf16x8 __attribute__((ext_vector_type(8)));
typedef float f32x4 __attribute__((ext_vector_type(4)));
typedef float f32x16 __attribute__((ext_vector_type(16)));
typedef unsigned u32x4 __attribute__((ext_vector_type(4)));
typedef unsigned u32x2 __attribute__((ext_vector_type(2)));
using pg8::cvt_pk_bf16;

constexpr int DM = 2048, TP = 16384, NSB = 32, TSQ = 32, NTOK = TP + NSB * TSQ, NSEQ = 33, PAST = 4096, NLAYER = 2;
constexpr int NU = 15104;
constexpr int U_AVAL = 0, U_AGATE = 512, U_ASG = 1024, U_Q = 1536, U_K = 2048, U_V = 2560, U_BSG = 3072, U_XC = 3584, U_CSG = 5248, U_DIN = 5760, U_DSG = 6272, U_G = 6784, U_F = 14976;
constexpr int IN_W = 14984, SHIFT_W = 1664;
constexpr float LOG2E = 1.4426950408889634f;
enum { I_XP = 0, I_XS, I_CK, I_CV, I_CLF, I_SCONV, I_SSHIFT, I_SWKV, I_SPOOL, I_CP, I_CS, I_NORMG, I_WADA, I_BADA, I_WIN, I_BF, I_CONVW, I_CONVB, I_CLNG, I_CLNB, I_MU, I_W0, I_W2, I_A0, I_A2,
       I_KK, I_KA, I_RK, I_GNG, I_GNB, I_POOLW, I_POOLB, I_POOLS, I_WBR, I_WOUT, I_FING, N_IN };
constexpr size_t O_YP = 0, O_YS = O_YP + (size_t)TP * DM, O_PK = O_YS + (size_t)1024 * DM, O_PV = O_PK + (size_t)2 * TP * 512, O_PLF = O_PV + (size_t)2 * TP * 512, O_PCONV = O_PLF + (size_t)2 * TP * 8,
                 O_PSHIFT = O_PCONV + 2 * 30 * 512, O_PWKV = O_PSHIFT + 2 * 1664, O_PPOOL = O_PWKV + 2 * 8 * 64 * 64, O_SK = O_PPOOL + 2 * 15 * 512, O_SV = O_SK + (size_t)2 * 1024 * 512,
                 O_SLF = O_SV + (size_t)2 * 1024 * 512, O_SCONV = O_SLF + 2 * 1024 * 8, O_SSHIFT = O_SCONV + (size_t)2 * 32 * 30 * 512, O_SWKV = O_SSHIFT + 2 * 32 * 1664,
                 O_SPOOL = O_SWKV + (size_t)2 * 32 * 8 * 64 * 64, O_END = O_SPOOL + (size_t)2 * 32 * 15 * 512;
static_assert(O_END == 75374848, "output size");
constexpr size_t al256(size_t x) { return (x + 255) & ~(size_t)255; }
constexpr int NCU_CH = 288, NRU = NCU_CH * 8;
constexpr size_t WS_CTL = 0, CTL_BYTES = 512 * 1024;
constexpr size_t WS_WIN = CTL_BYTES;
constexpr size_t WS_WBR = al256(WS_WIN + (size_t)2 * NU * 2048 * 2);
constexpr size_t WS_WOUT = al256(WS_WBR + (size_t)2 * 4 * 2048 * 512 * 2);
constexpr size_t WS_POOLW = al256(WS_WOUT + (size_t)2 * 2048 * 2048 * 2);
constexpr size_t WS_ADA = al256(WS_POOLW + (size_t)2 * 4 * 128 * 128 * 2);
constexpr size_t WS_H = al256(WS_ADA + (size_t)2 * 33 * 6144 * 4);
constexpr size_t WS_U = al256(WS_H + (size_t)NTOK * 2048 * 2);
constexpr size_t WS_XBUF = al256(WS_U + (size_t)NTOK * NU * 2);
constexpr size_t WS_OCAT = al256(WS_XBUF + (size_t)NTOK * 2048 * 4);
constexpr size_t WS_Z = al256(WS_OCAT + (size_t)4 * NTOK * 512 * 2);
constexpr size_t WS_MERGED = al256(WS_Z + (size_t)4 * NTOK * 2048 * 2);
constexpr size_t WS_FP = al256(WS_MERGED + (size_t)NTOK * 2048 * 2);
constexpr int GS_LEN = PAST + TSQ;
constexpr size_t WS_GS = al256(WS_FP + (size_t)8 * TP * 4);
constexpr size_t WS_VT = al256(WS_GS + (size_t)32 * 8 * GS_LEN * 4);
constexpr size_t WS_TQ = al256(WS_VT + (size_t)8 * 64 * TP * 2);
constexpr size_t WS_GM = al256(WS_TQ + (size_t)NRU * 4096 * 4);
constexpr size_t WS_ET = al256(WS_GM + (size_t)NRU * 4096 * 4);
constexpr size_t WS_Y0T = al256(WS_ET + (size_t)NRU * 4096 * 4);
constexpr size_t WS_SC = al256(WS_Y0T + (size_t)NRU * 4096 * 4);
constexpr size_t WS_BONUS = al256(WS_SC + (size_t)NRU * 4096 * 4);
constexpr size_t WS_GG = al256(WS_BONUS + (size_t)NRU * 64 * 4);
constexpr size_t WS_TG = al256(WS_GG + (size_t)16 * 8 * 4096 * 4);
constexpr size_t WS_SG = al256(WS_TG + (size_t)16 * 8 * 4096 * 4);
constexpr size_t WS_END = al256(WS_SG + (size_t)16 * 8 * 4096 * 4);
static_assert(WS_END < (size_t)2100 * 1024 * 1024, "workspace map exceeds the guaranteed d_ws size");
constexpr int CW_BAR = 0;
constexpr int CW_QUEUE = 16 * 3456 + 64;
constexpr int CW_KMAX = CW_QUEUE + 64 * 8;
static_assert((CW_KMAX + 64) * 4 <= (int)CTL_BYTES, "ctl");
constexpr int LDS_BYTES = 163840 - 256;
constexpr int LDS_XB_OFF = LDS_BYTES - 16;
constexpr int SLOT_F = 64 * 65;

#ifndef PROBE_ID
#define PROBE_ID 0
#endif
#ifndef PROBE_K
#define PROBE_K 1
#endif
constexpr int LDS_PROBE_OFF = 163840 - 256 - 64;
#if PROBE_ID
#define PT0() unsigned long long _pt0 = (blockIdx.x == 0 && threadIdx.x == 0) ? __builtin_amdgcn_s_memrealtime() : 0ull
#define PT1(id) do { if ((id) == PROBE_ID && blockIdx.x == 0 && threadIdx.x == 0) { *(LAS unsigned long long*)(lds + LDS_PROBE_OFF) += __builtin_amdgcn_s_memrealtime() - _pt0; } _pt0 = (blockIdx.x == 0 && threadIdx.x == 0) ? __builtin_amdgcn_s_memrealtime() : 0ull; } while (0)
#else
#define PT0() do {} while (0)
#define PT1(id) do {} while (0)
#endif
struct Params { const float* in[N_IN]; float* out; unsigned char* ws; int ph_lo, ph_hi, li, pad; };
typedef const __attribute__((address_space(4))) Params* KP;
__device__ __forceinline__ KP kp_fresh(KP k) { asm volatile("" : "+s"(k)); return k; }

__device__ __forceinline__ float bf2f(unsigned short b) { return __uint_as_float(((unsigned)b) << 16); }
__device__ __forceinline__ float bflo(unsigned w) { return __uint_as_float(w << 16); }
__device__ __forceinline__ float bfhi(unsigned w) { return __uint_as_float(w & 0xffff0000u); }
__device__ __forceinline__ unsigned short f2bf(float f) { return (unsigned short)(cvt_pk_bf16(f, 0.f) & 0xffffu); }
__device__ __forceinline__ float sigmoidf_(float x) { return 1.f / (1.f + __expf(-x)); }
__device__ __forceinline__ float siluf_(float x) { return x / (1.f + __expf(-x)); }
__device__ __forceinline__ float log_sigmoidf_(float z) { return fminf(z, 0.f) - log1pf(expf(-fabsf(z))); }
template <int CTRL> __device__ __forceinline__ float dpp_mov(float v) { return __int_as_float(__builtin_amdgcn_update_dpp(0, __float_as_int(v), CTRL, 0xF, 0xF, true)); }
__device__ __forceinline__ float wave_sum(float v) {
    v += dpp_mov<0xB1>(v); v += dpp_mov<0x4E>(v); v += dpp_mov<0x141>(v); v += dpp_mov<0x140>(v);
    const float r0 = __int_as_float(__builtin_amdgcn_readlane(__float_as_int(v), 0)), r1 = __int_as_float(__builtin_amdgcn_readlane(__float_as_int(v), 16));
    const float r2 = __int_as_float(__builtin_amdgcn_readlane(__float_as_int(v), 32)), r3 = __int_as_float(__builtin_amdgcn_readlane(__float_as_int(v), 48));
    return (r0 + r1) + (r2 + r3);
}
__device__ __forceinline__ float wave_max(float v) {
    v = fmaxf(v, dpp_mov<0xB1>(v)); v = fmaxf(v, dpp_mov<0x4E>(v)); v = fmaxf(v, dpp_mov<0x141>(v)); v = fmaxf(v, dpp_mov<0x140>(v));
    const float r0 = __int_as_float(__builtin_amdgcn_readlane(__float_as_int(v), 0)), r1 = __int_as_float(__builtin_amdgcn_readlane(__float_as_int(v), 16));
    const float r2 = __int_as_float(__builtin_amdgcn_readlane(__float_as_int(v), 32)), r3 = __int_as_float(__builtin_amdgcn_readlane(__float_as_int(v), 48));
    return fmaxf(fmaxf(r0, r1), fmaxf(r2, r3));
}
__device__ __forceinline__ float wave_min(float v) { return -wave_max(-v); }
__device__ __forceinline__ float xhalf_max(float m) { const auto rr = __builtin_amdgcn_permlane32_swap(__float_as_uint(m), __float_as_uint(m), false, false); return fmaxf(__uint_as_float(rr[0]), __uint_as_float(rr[1])); }
__device__ __forceinline__ float xhalf_sum(float m) { const auto rr = __builtin_amdgcn_permlane32_swap(__float_as_uint(m), __float_as_uint(m), false, false); return __uint_as_float(rr[0]) + __uint_as_float(rr[1]); }
__device__ __forceinline__ bf16x8 pack8f(const f32x4 a, const f32x4 b) { u32x4 w; w.x = cvt_pk_bf16(a[0], a[1]); w.y = cvt_pk_bf16(a[2], a[3]); w.z = cvt_pk_bf16(b[0], b[1]); w.w = cvt_pk_bf16(b[2], b[3]); return __builtin_bit_cast(bf16x8, w); }
__device__ __forceinline__ float fast_tanh(float x) { const float e = __expf(-2.f * fabsf(x)); const float t = (1.f - e) * __builtin_amdgcn_rcpf(1.f + e); return x < 0.f ? -t : t; }
__device__ __forceinline__ void tr_tile(const float* __restrict__ src, size_t ld, int k0, int c0, int nvalid, bf16_t* __restrict__ dst, int K, LAS float* scr, int lane) {
    float tv[64];
#pragma unroll
    for (int kk = 0; kk < 64; ++kk) tv[kk] = src[(size_t)(k0 + kk) * ld + c0 + (lane < nvalid ? lane : 0)];
#pragma unroll
    for (int kk = 0; kk < 64; ++kk) scr[kk * 65 + lane] = (lane < nvalid) ? tv[kk] : 0.f;
    const int k2 = (lane & 31) * 2, nh = lane >> 5;
#pragma unroll 8
    for (int it = 0; it < 32; ++it) { const int nn = 2 * it + nh; *(unsigned*)(dst + (size_t)nn * K + k0 + k2) = cvt_pk_bf16(scr[k2 * 65 + nn], scr[(k2 + 1) * 65 + nn]); }
}
__device__ __forceinline__ void p0_weights(KP p, LAS unsigned char* lds, int gw, int ngw, int wave, int lane) {
    LAS float* scr = (LAS float*)lds + wave * SLOT_F;
    constexpr int T_WIN = (NU / 64) * 32, T_WBR = 4 * 32 * 8, T_WOUT = 32 * 32, T_POOL = 4 * 2 * 2, T_L = T_WIN + T_WBR + T_WOUT + T_POOL;
    for (int it = gw; it < 2 * T_L; it += ngw) {
        const int l = it / T_L; int r = it % T_L;
        if (r < T_WIN) {
            const int nt = r / 32, kt = r % 32, m0 = nt * 64;
            int c0, nvalid = 64;
            if (m0 < 3072) c0 = m0; else if (m0 < U_F) c0 = m0 + 8; else if (m0 == U_F) { c0 = 3072; nvalid = 8; } else { c0 = 0; nvalid = 0; }
            tr_tile(p->in[I_WIN] + (size_t)l * 2048 * IN_W, IN_W, kt * 64, c0, nvalid, (bf16_t*)(p->ws + WS_WIN) + ((size_t)l * NU + m0) * 2048, 2048, scr, lane);
            continue; }
        r -= T_WIN;
        if (r < T_WBR) {
            const int n = r / 256, q = r % 256, nt = q / 8, kt = q % 8;
            tr_tile(p->in[I_WBR] + ((size_t)(l * 4 + n) * 512) * 2048, 2048, kt * 64, nt * 64, 64, (bf16_t*)(p->ws + WS_WBR) + ((size_t)(l * 4 + n) * 2048 + nt * 64) * 512, 512, scr, lane);
            continue; }
        r -= T_WBR;
        if (r < T_WOUT) {
            const int nt = r / 32, kt = r % 32;
            tr_tile(p->in[I_WOUT] + (size_t)l * 2048 * 2048, 2048, kt * 64, nt * 64, 64, (bf16_t*)(p->ws + WS_WOUT) + ((size_t)l * 2048 + nt * 64) * 2048, 2048, scr, lane);
            continue; }
        r -= T_WOUT;
        {
            const int g = r / 4, q = r % 4, nt = q / 2, kt = q % 2;
            tr_tile(p->in[I_POOLW] + (size_t)(l * 4 + g) * 128 * 128, 128, kt * 64, nt * 64, 64, (bf16_t*)(p->ws + WS_POOLW) + ((size_t)(l * 4 + g) * 128 + nt * 64) * 128, 128, scr, lane);
        }
    }
}
__device__ __forceinline__ void ada_unit(KP p, int unit, LAS unsigned char* lds, int tid) {
    const int wave = tid >> 6, lane = tid & 63, l = unit / 96, n0 = (unit % 96) * 64;
    LAS float* cs = (LAS float*)lds + wave * (33 * 64);
    LAS float* red = (LAS float*)lds + 8 * 33 * 64;
    const float* W = p->in[I_WADA] + (size_t)l * 2048 * 6144;
    const float* cp = p->in[I_CP]; const float* csm = p->in[I_CS];
    float acc[33];
#pragma unroll
    for (int s = 0; s < 33; ++s) acc[s] = 0.f;
    float wv[16];
#pragma unroll
    for (int j = 0; j < 16; ++j) wv[j] = W[(size_t)(wave * 256 + j) * 6144 + n0 + lane];
#pragma unroll 1
    for (int step = 0; step < 16; ++step) {
        const int k0 = wave * 256 + step * 16, kn = wave * 256 + (step < 15 ? step + 1 : step) * 16;
        float wn[16];
#pragma unroll
        for (int j = 0; j < 16; ++j) wn[j] = W[(size_t)(kn + j) * 6144 + n0 + lane];
        if ((step & 3) == 0) {
#pragma unroll
            for (int s = 0; s < 33; ++s) { const float c = (s == 0) ? cp[k0 + lane] : csm[(size_t)(s - 1) * 2048 + k0 + lane]; cs[s * 64 + lane] = siluf_(c); } }
        const int kk0 = (step & 3) * 16;
#pragma unroll
        for (int q4 = 0; q4 < 4; ++q4) {
#pragma unroll
            for (int s = 0; s < 33; ++s) { const f32x4 c4 = *(const LAS f32x4*)(cs + s * 64 + kk0 + 4 * q4); acc[s] += c4.x * wv[4 * q4] + c4.y * wv[4 * q4 + 1] + c4.z * wv[4 * q4 + 2] + c4.w * wv[4 * q4 + 3]; } }
#pragma unroll
        for (int j = 0; j < 16; ++j) wv[j] = wn[j];
    }
#pragma unroll
    for (int s = 0; s < 33; ++s) red[(wave * 33 + s) * 64 + lane] = acc[s];
    __syncthreads();
    for (int idx = tid; idx < 33 * 64; idx += 512) { const int s = idx >> 6, n = idx & 63; float v = p->in[I_BADA][l * 6144 + n0 + n];
#pragma unroll
        for (int w = 0; w < 8; ++w) v += red[(w * 33 + s) * 64 + n];
        ((float*)(p->ws + WS_ADA))[((size_t)l * 33 + s) * 6144 + n0 + n] = v; }
    __syncthreads();
}
__device__ __forceinline__ const float* x_row(KP p, int l, int row) {
    return l == 0 ? (row < TP ? p->in[I_XP] + (size_t)row * DM : p->in[I_XS] + (size_t)(row - TP) * DM) : (const float*)(p->ws + WS_XBUF) + (size_t)row * DM;
}
__device__ __forceinline__ void p1_rows(KP p, int l, int gw, int ngw, int lane) {
    const f32x4* g4 = (const f32x4*)(p->in[I_NORMG] + l * DM) + lane;
    for (int row = gw; row < NTOK; row += ngw) {
        const f32x4* x4 = (const f32x4*)x_row(p, l, row) + lane;
        const int seq = row < TP ? 0 : 1 + ((row - TP) >> 5);
        const f32x4* sh4 = (const f32x4*)((const float*)(p->ws + WS_ADA) + ((size_t)l * 33 + seq) * 6144) + lane; const f32x4* sc4 = sh4 + 512;
        f32x4 v[8]; float ss = 0.f;
#pragma unroll
        for (int j = 0; j < 8; ++j) { v[j] = x4[64 * j]; ss += (v[j].x * v[j].x + v[j].y * v[j].y) + (v[j].z * v[j].z + v[j].w * v[j].w); }
        const float rstd = 1.f / sqrtf(wave_sum(ss) * (1.f / DM) + 1e-6f);
        u32x2* o = (u32x2*)((bf16_t*)(p->ws + WS_H) + (size_t)row * DM) + lane;
#pragma unroll
        for (int j = 0; j < 8; ++j) { const f32x4 g = g4[64 * j], sc = sc4[64 * j], sh = sh4[64 * j]; const f32x4 y = v[j] * rstd * g * (sc + 1.f) + sh;
            u32x2 w; w.x = cvt_pk_bf16(y.x, y.y); w.y = cvt_pk_bf16(y.z, y.w); o[64 * j] = w; }
    }
}
__device__ __forceinline__ void p_final_rows(KP p, int gw, int ngw, int lane) {
    const f32x4* g4 = (const f32x4*)p->in[I_FING] + lane;
    for (int row = gw; row < NTOK; row += ngw) {
        const f32x4* x4 = (const f32x4*)((const float*)(p->ws + WS_XBUF) + (size_t)row * DM) + lane;
        f32x4 v[8]; float ss = 0.f;
#pragma unroll
        for (int j = 0; j < 8; ++j) { v[j] = x4[64 * j]; ss += (v[j].x * v[j].x + v[j].y * v[j].y) + (v[j].z * v[j].z + v[j].w * v[j].w); }
        const float rstd = 1.f / sqrtf(wave_sum(ss) * (1.f / DM) + 1e-6f);
        f32x4* o = (f32x4*)(p->out + O_YP + (size_t)row * DM) + lane;
#pragma unroll
        for (int j = 0; j < 8; ++j) o[64 * j] = v[j] * rstd * g4[64 * j];
    }
}
struct EpiU {
    static constexpr bool PERM = true, AFTER_DRAIN = false;
    bf16_t* U; float* out; const float* bf; int l;
    __device__ __forceinline__ void operator()(const f32x4 (&acc)[2][2][4][2], const pg8::Unit& u, int wr, int wc, int fr, int fq) const {
        const int row0 = u.pm * 256 + wr * 64 + fr, col0 = u.pn * 256 + wc * 32 + 8 * fq;
#pragma unroll
        for (int ai = 0; ai < 2; ++ai)
#pragma unroll
            for (int m = 0; m < 4; ++m) { bf16_t* rowp = U + (size_t)(row0 + ai * 128 + m * 16) * NU + col0;
#pragma unroll
                for (int bj = 0; bj < 2; ++bj) { const f32x4 v0 = acc[ai][bj][m][0], v1 = acc[ai][bj][m][1];
                    u32x4 w; w.x = cvt_pk_bf16(v0[0], v0[1]); w.y = cvt_pk_bf16(v0[2], v0[3]); w.z = cvt_pk_bf16(v1[0], v1[1]); w.w = cvt_pk_bf16(v1[2], v1[3]);
                    *(u32x4*)(rowp + bj * 128) = w; } }
        if (u.pn >= 8 && u.pn < 12) {
            const bool isv = u.pn >= 10; const int cin = (u.pn - (isv ? 10 : 8)) * 256 + wc * 32 + 8 * fq;
#pragma unroll
            for (int ai = 0; ai < 2; ++ai)
#pragma unroll
                for (int m = 0; m < 4; ++m) { const int row = row0 + ai * 128 + m * 16;
                    float* dst = row < TP ? out + (isv ? O_PV : O_PK) + ((size_t)l * TP + row) * 512 : out + (isv ? O_SV : O_SK) + ((size_t)l * 1024 + (row - TP)) * 512;
#pragma unroll
                    for (int bj = 0; bj < 2; ++bj) { *(f32x4*)(dst + cin + bj * 128) = acc[ai][bj][m][0]; *(f32x4*)(dst + cin + bj * 128 + 4) = acc[ai][bj][m][1]; } }
        }
        if (u.pn == 58 && wc == 0 && fq == 0) {
            const f32x4 b0 = *(const f32x4*)(bf + l * 8), b1 = *(const f32x4*)(bf + l * 8 + 4);
#pragma unroll
            for (int ai = 0; ai < 2; ++ai)
#pragma unroll
                for (int m = 0; m < 4; ++m) { const int row = row0 + ai * 128 + m * 16;
                    float* dst = row < TP ? out + O_PLF + ((size_t)l * TP + row) * 8 : out + O_SLF + ((size_t)l * 1024 + (row - TP)) * 8;
                    const f32x4 z0 = acc[ai][1][m][0] + b0, z1 = acc[ai][1][m][1] + b1; f32x4 o0, o1;
#pragma unroll
                    for (int e = 0; e < 4; ++e) { o0[e] = log_sigmoidf_(z0[e]); o1[e] = log_sigmoidf_(z1[e]); }
                    *(f32x4*)dst = o0; *(f32x4*)(dst + 4) = o1; }
        }
    }
};
struct BranchOrder {
    int G, c;
    __device__ __forceinline__ bool next(int i, pg8::Unit& u) const { const int L = i * G + c; if (L >= 4 * 544) return false; const int n = L / 544, t = L - n * 544; u.pm = n * 68 + (t >> 3); u.pn = n * 8 + (t & 7); return true; }
    __device__ __forceinline__ void a_ready(const pg8::Unit&) const {}
    __device__ __forceinline__ void done(const pg8::Unit&) const {}
};
struct EpiZ {
    static constexpr bool PERM = true, AFTER_DRAIN = false;
    bf16_t* Z;
    __device__ __forceinline__ void operator()(const f32x4 (&acc)[2][2][4][2], const pg8::Unit& u, int wr, int wc, int fr, int fq) const {
        const int row0 = u.pm * 256 + wr * 64 + fr, col0 = (u.pn & 7) * 256 + wc * 32 + 8 * fq;
#pragma unroll
        for (int ai = 0; ai < 2; ++ai)
#pragma unroll
            for (int m = 0; m < 4; ++m) { bf16_t* rowp = Z + (size_t)(row0 + ai * 128 + m * 16) * DM + col0;
#pragma unroll
                for (int bj = 0; bj < 2; ++bj) { const f32x4 v0 = acc[ai][bj][m][0], v1 = acc[ai][bj][m][1];
                    u32x4 w; w.x = cvt_pk_bf16(v0[0], v0[1]); w.y = cvt_pk_bf16(v0[2], v0[3]); w.z = cvt_pk_bf16(v1[0], v1[1]); w.w = cvt_pk_bf16(v1[2], v1[3]);
                    *(u32x4*)(rowp + bj * 128) = w; } }
    }
};
__device__ __forceinline__ void merge_pass(KP p, int gtid, int ngt) {
    const bf16_t* U = (const bf16_t*)(p->ws + WS_U); const bf16_t* Z = (const bf16_t*)(p->ws + WS_Z); bf16_t* M = (bf16_t*)(p->ws + WS_MERGED);
    for (int it0 = gtid; it0 < NTOK * 256; it0 += 2 * ngt) {
        u32x4 gv[2][4], zv[2][4];
#pragma unroll
        for (int k = 0; k < 2; ++k) { const int it = it0 + k * ngt < NTOK * 256 ? it0 + k * ngt : it0; const int row = it >> 8, col = (it & 255) * 8;
#pragma unroll
            for (int n = 0; n < 4; ++n) { gv[k][n] = *(const u32x4*)(U + (size_t)row * NU + U_G + n * 2048 + col); zv[k][n] = *(const u32x4*)(Z + ((size_t)n * NTOK + row) * DM + col); } }
#pragma unroll
        for (int k = 0; k < 2; ++k) { const int it = it0 + k * ngt; if (it < NTOK * 256) { const int row = it >> 8, col = (it & 255) * 8;
            float s[8];
#pragma unroll
            for (int e = 0; e < 8; ++e) s[e] = 0.f;
#pragma unroll
            for (int n = 0; n < 4; ++n) { const u32x4 g = gv[k][n], z = zv[k][n];
                s[0] += sigmoidf_(bflo(g.x)) * bflo(z.x); s[1] += sigmoidf_(bfhi(g.x)) * bfhi(z.x); s[2] += sigmoidf_(bflo(g.y)) * bflo(z.y); s[3] += sigmoidf_(bfhi(g.y)) * bfhi(z.y);
                s[4] += sigmoidf_(bflo(g.z)) * bflo(z.z); s[5] += sigmoidf_(bfhi(g.z)) * bfhi(z.z); s[6] += sigmoidf_(bflo(g.w)) * bflo(z.w); s[7] += sigmoidf_(bfhi(g.w)) * bfhi(z.w); }
            u32x4 w; w.x = cvt_pk_bf16(s[0], s[1]); w.y = cvt_pk_bf16(s[2], s[3]); w.z = cvt_pk_bf16(s[4], s[5]); w.w = cvt_pk_bf16(s[6], s[7]);
            *(u32x4*)(M + (size_t)row * DM + col) = w; } }
    }
}
struct EpiOut {
    static constexpr bool PERM = false, AFTER_DRAIN = false;
    const float* xp; const float* xs; const float* xb; const float* ada; float* xout; int l;
    __device__ __forceinline__ void operator()(const f32x4 (&acc)[2][2][4][2], const pg8::Unit& u, int wr, int wc, int fr, int fq) const {
        const int row0 = u.pm * 256 + wr * 64 + fr, col0 = u.pn * 256 + wc * 32 + 4 * fq;
#pragma unroll
        for (int ai = 0; ai < 2; ++ai)
#pragma unroll
            for (int m = 0; m < 4; ++m) { const int row = row0 + ai * 128 + m * 16;
                const float* base = l == 0 ? (row < TP ? xp + (size_t)row * DM : xs + (size_t)(row - TP) * DM) : xb + (size_t)row * DM;
                const int seq = row < TP ? 0 : 1 + ((row - TP) >> 5);
                const float* gate = ada + ((size_t)l * 33 + seq) * 6144 + 4096;
#pragma unroll
                for (int bj = 0; bj < 2; ++bj)
#pragma unroll
                    for (int n = 0; n < 2; ++n) { const int col = col0 + bj * 128 + n * 16;
                        *(f32x4*)(xout + (size_t)row * DM + col) = *(const f32x4*)(base + col) + *(const f32x4*)(gate + col) * acc[ai][bj][m][n]; } }
    }
};
__device__ __forceinline__ void conv_unit(KP p, int l, int tile, LAS unsigned char* lds, int tid) {
    const bf16_t* U = (const bf16_t*)(p->ws + WS_U);
    const int c = tid, wave = tid >> 6, lane = tid & 63;
    const bool samp = tile >= 512; const int b = tile - 512, row0 = samp ? TP + b * 32 : tile * 32;
    const bool last = samp || tile == 511;
    LAS float* red = (LAS float*)lds;
    LAS float* st = red + 8 * 32;
    const float cb = p->in[I_CONVB][l * 512 + c], lg = p->in[I_CLNG][l * 512 + c], lb = p->in[I_CLNB][l * 512 + c];
    bf16_t* oa = (bf16_t*)(p->ws + WS_OCAT);
#pragma unroll 1
    for (int half = 0; half < 2; ++half) {
        float z[46];
        if (!samp) {
#pragma unroll
            for (int i = 0; i < 46; ++i) { const int row = row0 + 16 * half + i - 30; const size_t r = (size_t)(row < 0 ? 0 : row) * NU;
                const float v = bf2f(U[r + U_AVAL + c]) * sigmoidf_(bf2f(U[r + U_AGATE + c])); z[i] = row < 0 ? 0.f : v; }
        } else {
            const float* hist = p->in[I_SCONV] + (((size_t)l * 32 + b) * 30) * 512 + c;
#pragma unroll
            for (int i = 0; i < 46; ++i) { const int rel = 16 * half + i - 30; const size_t r = (size_t)(row0 + (rel < 0 ? 0 : rel)) * NU;
                const float v = bf2f(U[r + U_AVAL + c]) * sigmoidf_(bf2f(U[r + U_AGATE + c]));
                if (i < 30) { const int hi_ = 16 * half + i; const float hv_ = hist[(size_t)(hi_ < 30 ? hi_ : 29) * 512]; z[i] = rel < 0 ? hv_ : v; } else z[i] = v; }
        }
        unsigned short sgr[16];
#pragma unroll
        for (int tt = 0; tt < 16; ++tt) sgr[tt] = U[(size_t)(row0 + 16 * half + tt) * NU + U_ASG + c];
        float hv[16];
#pragma unroll
        for (int tt = 0; tt < 16; ++tt) hv[tt] = cb;
#pragma unroll
        for (int k = 0; k < 31; ++k) { const float w = p->in[I_CONVW][((size_t)l * 31 + k) * 512 + c];
#pragma unroll
            for (int tt = 0; tt < 16; ++tt) hv[tt] += z[tt + k] * w; }
        if (last) {
            float* dst = samp ? p->out + O_SCONV + (((size_t)l * 32 + b) * 30) * 512 + c : p->out + O_PCONV + ((size_t)l * 30) * 512 + c;
#pragma unroll
            for (int tt = 0; tt < 16; ++tt) { const int t = 16 * half + tt; if (t >= 2) dst[(size_t)(t - 2) * 512] = z[30 + tt]; }
        }
#pragma unroll
        for (int tt = 0; tt < 16; ++tt) { const float s1 = wave_sum(hv[tt]), s2 = wave_sum(hv[tt] * hv[tt]); if (lane == 0) { red[(wave * 16 + tt) * 2] = s1; red[(wave * 16 + tt) * 2 + 1] = s2; } }
        __syncthreads();
        if (tid < 16) { float s1 = 0.f, s2 = 0.f;
#pragma unroll
            for (int w = 0; w < 8; ++w) { s1 += red[(w * 16 + tid) * 2]; s2 += red[(w * 16 + tid) * 2 + 1]; }
            const float mean = s1 * (1.f / 512.f), var = fmaxf(s2 * (1.f / 512.f) - mean * mean, 0.f);
            st[tid * 2] = mean; st[tid * 2 + 1] = 1.f / sqrtf(var + 1e-5f); }
        __syncthreads();
#pragma unroll
        for (int tt = 0; tt < 16; ++tt) { const float y = (hv[tt] - st[tt * 2]) * st[tt * 2 + 1] * lg + lb; const size_t r = (size_t)(row0 + 16 * half + tt);
            oa[r * 512 + c] = f2bf(siluf_(y) * siluf_(bf2f(sgr[tt]))); }
        __syncthreads();
    }
}
__device__ __forceinline__ void pool_unit(KP p, int l, int tile, LAS unsigned char* lds, int tid) {
    const bf16_t* U = (const bf16_t*)(p->ws + WS_U);
    const int c = tid, wave = tid >> 6, lane = tid & 63;
    const bool samp = tile >= 512; const int b = tile - 512, row0 = samp ? TP + b * 32 : tile * 32;
    constexpr int PST = 520;
    LAS bf16_t* pl = (LAS bf16_t*)lds;
    {
        float z[47];
        if (!samp) {
#pragma unroll
            for (int i = 0; i < 47; ++i) { const int row = row0 + i - 15; const float v = bf2f(U[(size_t)(row < 0 ? 0 : row) * NU + U_DIN + c]); z[i] = row < 0 ? 0.f : v; }
        } else {
#pragma unroll
            for (int i = 0; i < 15; ++i) z[i] = p->in[I_SPOOL][(((size_t)l * 32 + b) * 15 + i) * 512 + c];
#pragma unroll
            for (int t = 0; t < 32; ++t) z[15 + t] = bf2f(U[(size_t)(row0 + t) * NU + U_DIN + c]);
        }
        if (samp || tile == 511) {
            float* dst = samp ? p->out + O_SPOOL + (((size_t)l * 32 + b) * 15) * 512 + c : p->out + O_PPOOL + ((size_t)l * 15) * 512 + c;
#pragma unroll
            for (int t = 17; t < 32; ++t) dst[(size_t)(t - 17) * 512] = z[15 + t];
        }
        const int w = 2 << (c >> 7);
#pragma unroll
        for (int t = 0; t < 32; ++t) { float s = 0.f;
#pragma unroll
            for (int i = 0; i < 16; ++i) s += (i < w) ? z[15 + t - i] : 0.f;
            const int pos = samp ? PAST + t : row0 + t; const int cnt = (pos + 1 < w) ? pos + 1 : w;
            pl[t * PST + c] = f2bf(s / (float)cnt - z[15 + t]); }
    }
    __syncthreads();
    {
        const int g = wave >> 1, fr = lane & 15, kq = lane >> 4;
        const bf16_t* WT = (const bf16_t*)(p->ws + WS_POOLW) + (size_t)(l * 4 + g) * 128 * 128;
        f32x4 acc[2][4];
#pragma unroll
        for (int mt = 0; mt < 2; ++mt)
#pragma unroll
            for (int nt = 0; nt < 4; ++nt) acc[mt][nt] = (f32x4){0.f, 0.f, 0.f, 0.f};
#pragma unroll
        for (int ks = 0; ks < 4; ++ks) {
            bf16x8 af[2];
#pragma unroll
            for (int mt = 0; mt < 2; ++mt) af[mt] = *(const LAS bf16x8*)(pl + (16 * mt + fr) * PST + g * 128 + 32 * ks + 8 * kq);
#pragma unroll
            for (int nt = 0; nt < 4; ++nt) { const int dl = (wave & 1) * 64 + 16 * nt + fr;
                const bf16x8 bfr = *(const bf16x8*)(WT + (size_t)dl * 128 + 32 * ks + 8 * kq);
#pragma unroll
                for (int mt = 0; mt < 2; ++mt) acc[mt][nt] = __builtin_amdgcn_mfma_f32_16x16x32_bf16(af[mt], bfr, acc[mt][nt], 0, 0, 0); }
        }
        bf16_t* od = (bf16_t*)(p->ws + WS_OCAT) + (size_t)3 * NTOK * 512;
        unsigned short sg[4][2][4]; float pbv[4], psv[4];
#pragma unroll
        for (int nt = 0; nt < 4; ++nt) { const int d = wave * 64 + 16 * nt + fr; pbv[nt] = p->in[I_POOLB][l * 512 + d]; psv[nt] = p->in[I_POOLS][l * 512 + d];
#pragma unroll
            for (int mt = 0; mt < 2; ++mt)
#pragma unroll
                for (int r = 0; r < 4; ++r) sg[nt][mt][r] = U[(size_t)(row0 + 16 * mt + 4 * kq + r) * NU + U_DSG + d]; }
#pragma unroll
        for (int nt = 0; nt < 4; ++nt) { const int d = wave * 64 + 16 * nt + fr;
#pragma unroll
            for (int mt = 0; mt < 2; ++mt)
#pragma unroll
                for (int r = 0; r < 4; ++r) { const size_t row = (size_t)(row0 + 16 * mt + 4 * kq + r);
                    od[row * 512 + d] = f2bf((acc[mt][nt][r] + pbv[nt]) * psv[nt] * siluf_(bf2f(sg[nt][mt][r]))); } }
    }
    __syncthreads();
}
__device__ __forceinline__ void fp_unit(KP p, int l, int h, LAS unsigned char* lds, int tid) {
    const float* lf = p->out + O_PLF + (size_t)l * TP * 8 + h;
    LAS float* part = (LAS float*)lds;
    float v[32]; float s = 0.f;
#pragma unroll
    for (int i = 0; i < 32; ++i) { v[i] = lf[(size_t)(tid * 32 + i) * 8]; s += v[i]; }
    part[tid] = s;
    __syncthreads();
    float pre = 0.f;
    for (int j = 0; j < tid; ++j) pre += part[j];
    float* F = (float*)(p->ws + WS_FP) + (size_t)h * TP + tid * 32;
#pragma unroll
    for (int i = 0; i < 32; ++i) { pre += v[i]; F[i] = pre * LOG2E; }
    __syncthreads();
}
__device__ __forceinline__ void gs_unit(KP p, int l, int b, LAS unsigned char* lds, int tid) {
    const int h = tid & 7, ch = tid >> 3;
    const float* cl = p->in[I_CLF] + (((size_t)l * 32 + b) * PAST + ch * 64) * 8 + h;
    LAS float* part = (LAS float*)lds;
    float v[64]; float s = 0.f;
#pragma unroll
    for (int i = 0; i < 64; ++i) v[i] = cl[(size_t)i * 8];
#pragma unroll
    for (int i = 0; i < 64; ++i) s += v[i];
    part[ch * 8 + h] = s;
    __syncthreads();
    float suf = 0.f;
    for (int j = ch + 1; j < 64; ++j) suf += part[j * 8 + h];
    float* G = (float*)(p->ws + WS_GS) + ((size_t)b * 8 + h) * GS_LEN + ch * 64;
#pragma unroll
    for (int i = 63; i >= 0; --i) { G[i] = -suf * LOG2E; suf += v[i]; }
    if (tid < 8) { const float* nl = p->out + O_SLF + ((size_t)l * 1024 + b * 32) * 8 + tid; float* Gn = (float*)(p->ws + WS_GS) + ((size_t)b * 8 + tid) * GS_LEN + PAST; float w[32]; float run = 0.f;
#pragma unroll
        for (int i = 0; i < 32; ++i) w[i] = nl[i * 8];
#pragma unroll
        for (int i = 0; i < 32; ++i) { run += w[i]; Gn[i] = run * LOG2E; } }
    __syncthreads();
}
__device__ __forceinline__ void vt_tile(KP p, int l, int tile, LAS unsigned char* lds, int wave, int lane) {
    const int h = tile >> 8, tb = tile & 255;
    const bf16_t* U = (const bf16_t*)(p->ws + WS_U);
    LAS unsigned* scr = (LAS unsigned*)lds + wave * SLOT_F;
#pragma unroll 8
    for (int tt = 0; tt < 64; ++tt) scr[tt * 65 + lane] = U[(size_t)(tb * 64 + tt) * NU + U_V + h * 64 + lane];
    {
        float mx = 0.f;
#pragma unroll 8
        for (int tt = 0; tt < 64; ++tt) { const float kv = bf2f(U[(size_t)(tb * 64 + tt) * NU + U_K + h * 64 + lane]); mx = fmaxf(mx, wave_sum(kv * kv)); }
        if (lane == 0) atomicMax((unsigned*)(p->ws + WS_CTL) + CW_KMAX + l * 8 + h, __float_as_uint(mx));
    }
    bf16_t* Vt = (bf16_t*)(p->ws + WS_VT);
    const int t2 = (lane & 31) * 2, dh = lane >> 5;
#pragma unroll 8
    for (int it = 0; it < 32; ++it) { const int d = 2 * it + dh; *(unsigned*)(Vt + ((size_t)h * 64 + d) * TP + tb * 64 + t2) = scr[t2 * 65 + d] | (scr[(t2 + 1) * 65 + d] << 16); }
}
__device__ __forceinline__ void shift_out(KP p, int l, int tid) {
    const bf16_t* U = (const bf16_t*)(p->ws + WS_U);
    for (int base = tid; base < NSEQ * SHIFT_W; base += 512 * 8) {
        unsigned short v[8];
#pragma unroll
        for (int k = 0; k < 8; ++k) { const int idx = base + k * 512 < NSEQ * SHIFT_W ? base + k * 512 : tid; const int s = idx / SHIFT_W, j = idx - s * SHIFT_W; const int row = s == 0 ? TP - 1 : TP + (s - 1) * 32 + 31; v[k] = U[(size_t)row * NU + U_XC + j]; }
#pragma unroll
        for (int k = 0; k < 8; ++k) { const int idx = base + k * 512; if (idx < NSEQ * SHIFT_W) { const int s = idx / SHIFT_W, j = idx - s * SHIFT_W;
            float* dst = s == 0 ? p->out + O_PSHIFT + (size_t)l * SHIFT_W + j : p->out + O_SSHIFT + ((size_t)l * 32 + (s - 1)) * SHIFT_W + j; *dst = bf2f(v[k]); } }
    }
}
template <bool AT, bool BT, bool NEGA>
__device__ __forceinline__ void mm32(f32x16& acc, const LAS float* Ap, int i0, const LAS float* Bp, int j0, int lane) {
    const int li = lane & 31, kh = lane >> 5;
    const LAS float* ap = AT ? Ap + (8 * kh) * 65 + i0 + li : Ap + (i0 + li) * 65 + 8 * kh;
    const LAS float* bp = BT ? Bp + (j0 + li) * 65 + 8 * kh : Bp + (8 * kh) * 65 + j0 + li;
#pragma unroll
    for (int s = 0; s < 4; ++s) {
        float a[8], b[8];
#pragma unroll
        for (int e = 0; e < 8; ++e) { a[e] = AT ? ap[(16 * s + e) * 65] : ap[16 * s + e]; b[e] = BT ? bp[16 * s + e] : bp[(16 * s + e) * 65]; }
        if (NEGA) {
#pragma unroll
            for (int e = 0; e < 8; ++e) a[e] = -a[e]; }
        const bf16x8 af = pack8f((f32x4){a[0], a[1], a[2], a[3]}, (f32x4){a[4], a[5], a[6], a[7]}), bfg = pack8f((f32x4){b[0], b[1], b[2], b[3]}, (f32x4){b[4], b[5], b[6], b[7]});
        acc = __builtin_amdgcn_mfma_f32_32x32x16_bf16(af, bfg, acc, 0, 0, 0);
    }
}
template <int MASK>
__device__ __forceinline__ void st_tile(LAS float* dst, const f32x16& acc, int i0, int j0, int lane) {
    const int li = lane & 31, hi = lane >> 5, j = j0 + li;
#pragma unroll
    for (int r = 0; r < 16; ++r) { const int i = i0 + (r & 3) + 8 * (r >> 2) + 4 * hi; float v = acc[r];
        if (MASK == 1 && !(i < j)) v = 0.f; if (MASK == 2 && !(i <= j)) v = 0.f; dst[i * 65 + j] = v; }
}
struct RwkvSeqInfo { int row0, ntok, prev_kind  , b; };
__device__ __forceinline__ RwkvSeqInfo rwkv_info(int cu) { RwkvSeqInfo s; if (cu < 256) { s.row0 = cu * 64; s.ntok = 64; s.prev_kind = cu == 0 ? 0 : 1; s.b = 0; } else { s.b = cu - 256; s.row0 = TP + s.b * 32; s.ntok = 32; s.prev_kind = 2; } return s; }

__device__ __forceinline__ void rwkv_r1(KP p, int l, int unit, LAS unsigned char* lds, int tid) {
    const int cu = unit >> 3, h = unit & 7, wave = tid >> 6, lane = tid & 63, li = lane & 31, hi = lane >> 5;
    const RwkvSeqInfo si = rwkv_info(cu);
    const bf16_t* U = (const bf16_t*)(p->ws + WS_U);
    LAS float* S0 = (LAS float*)lds; LAS float *S1 = S0 + SLOT_F, *S2 = S0 + 2 * SLOT_F, *S3 = S0 + 3 * SLOT_F, *S4 = S0 + 4 * SLOT_F, *S5 = S0 + 5 * SLOT_F, *S6 = S0 + 6 * SLOT_F, *S7 = S0 + 7 * SLOT_F, *S8 = S0 + 8 * SLOT_F;
    LAS float* gC = S0 + 9 * SLOT_F;
    const int q = wave >> 2, wq = wave & 3, i0 = (wq >> 1) * 32, j0 = (wq & 1) * 32;
    PT0();
    {
        const int j = tid & 63, tq = tid >> 6, t0 = tq * 8;
        const int offs[5] = {h * 64, 512 + h * 64, 1024 + h * 64, 1536, 1600};
        unsigned short raw[5][9];
#pragma unroll
        for (int cs = 0; cs < 5; ++cs) {
            const int xo = offs[cs] + j;
#pragma unroll
            for (int tt = 0; tt < 9; ++tt) { int t = t0 + tt - 1; t = t < 0 ? (si.prev_kind == 1 ? -1 : 0) : (t < si.ntok ? t : si.ntok - 1);
                raw[cs][tt] = U[(size_t)(si.row0 + t) * NU + U_XC + xo]; }
        }
#pragma unroll
        for (int cs = 0; cs < 5; ++cs) {
            const int xo = offs[cs] + j; const float mu = p->in[I_MU][l * SHIFT_W + xo];
            LAS float* dst = cs == 0 ? S0 : cs == 1 ? S1 : cs == 2 ? S2 : cs == 3 ? S3 : S4;
            float prev = bf2f(raw[cs][0]);
            if (t0 == 0) { if (si.prev_kind == 0) prev = 0.f; else if (si.prev_kind == 2) prev = p->in[I_SSHIFT][((size_t)l * 32 + si.b) * SHIFT_W + xo]; }
#pragma unroll
            for (int tt = 0; tt < 8; ++tt) { const int t = t0 + tt; const float x = bf2f(raw[cs][tt + 1]); float xs = (t < si.ntok) ? x + (prev - x) * mu : 0.f; prev = x;
                if (cs == 3) xs = fast_tanh(xs);
                dst[t * 65 + j] = xs; }
        }
#pragma unroll
        for (int mm = 0; mm < 8; ++mm) { const int m = tq * 8 + mm;
            S5[m * 65 + j] = p->in[I_W2][((size_t)l * 64 + m) * 512 + h * 64 + j]; S6[m * 65 + j] = p->in[I_A2][((size_t)l * 64 + m) * 512 + h * 64 + j]; }
    }
    __syncthreads();
    PT1(1);
    {
        f32x16 acc = {};
        const int c = j0 + li;
        if (q == 0) { mm32<false, false, false>(acc, S3, i0, S5, j0, lane); const float w0 = p->in[I_W0][l * 512 + h * 64 + c];
#pragma unroll
            for (int r = 0; r < 16; ++r) { const int t = i0 + (r & 3) + 8 * (r >> 2) + 4 * hi; const float zz = acc[r] + w0;
                const float sp = fmaxf(-zz, 0.f) + __logf(1.f + __expf(-fabsf(zz)));
                S7[t * 65 + c] = (t < si.ntok) ? -__expf(-sp - 0.5f) : 0.f; } }
        else { mm32<false, false, false>(acc, S4, i0, S6, j0, lane); const float a0 = p->in[I_A0][l * 512 + h * 64 + c];
#pragma unroll
            for (int r = 0; r < 16; ++r) { const int t = i0 + (r & 3) + 8 * (r >> 2) + 4 * hi; S8[t * 65 + c] = __builtin_amdgcn_rcpf(1.f + __expf(-(acc[r] + a0))); } }
    }
    __syncthreads();
    PT1(2);
    if (wave == 0) { float run = 0.f;
#pragma unroll 8
        for (int t = 0; t < 64; ++t) { run += S7[t * 65 + lane]; S3[t * 65 + lane] = run; } }
    else { const int c = lane; const float kkw = p->in[I_KK][l * 512 + h * 64 + c], kaw = p->in[I_KA][l * 512 + h * 64 + c], rkw = p->in[I_RK][l * 512 + h * 64 + c];
        for (int t = wave - 1; t < 64; t += 7) { const float kr = S1[t * 65 + c], kv = kr * kkw; const float ss = wave_sum(kv * kv);
            const float kn = kv * (1.f / sqrtf(fmaxf(ss, 1e-24f))); const float a = S8[t * 65 + c]; const float km = kr * (1.f + (a - 1.f) * kaw);
            const float bon = wave_sum(S0[t * 65 + c] * km * rkw);
            S4[t * 65 + c] = kn; S1[t * 65 + c] = km; S8[t * 65 + c] = kn * a;
            if (lane == 0) ((float*)(p->ws + WS_BONUS))[(size_t)unit * 64 + t] = bon; } }
    __syncthreads();
    { const int c = tid & 63, tq = tid >> 6;
#pragma unroll
        for (int tt = 0; tt < 8; ++tt) { const int t = tq * 8 + tt, o = t * 65 + c; const float Lg = S3[o], lw = S7[o];
            const float g = __expf(Lg), gi = __expf(-Lg), gp = __expf(Lg - lw);
            S0[o] *= g; S1[o] *= gi; S8[o] *= gi; S4[o] *= gp; if (t == 63) gC[c] = g; } }
    __syncthreads();
    PT1(3);
    { f32x16 acc = {};
      if (q == 0) { mm32<false, true, false>(acc, S1, i0, S4, j0, lane); st_tile<1>(S3, acc, i0, j0, lane); }
      else { mm32<false, true, false>(acc, S8, i0, S4, j0, lane); st_tile<1>(S5, acc, i0, j0, lane); } }
    __syncthreads();
    { f32x16 acc = {};
      if (q == 0) { mm32<true, false, false>(acc, S2, i0, S3, j0, lane); st_tile<0>(S6, acc, i0, j0, lane); }
      else { mm32<false, true, false>(acc, S1, i0, S0, j0, lane); st_tile<2>(S7, acc, i0, j0, lane); } }
    __syncthreads();
    PT1(4);
    { float x[16]; const int r0 = (wave & 3) * 16;
      if (wave < 4) {
#pragma unroll
          for (int rr = 0; rr < 16; ++rr) x[rr] = S4[lane * 65 + r0 + rr]; }
      else {
#pragma unroll
          for (int rr = 0; rr < 16; ++rr) x[rr] = S6[(r0 + rr) * 65 + lane]; }
      __syncthreads();
#pragma unroll
      for (int sb = 0; sb < 4; ++sb) {
          float mreg[16];
#pragma unroll
          for (int s = 0; s < 16; ++s) mreg[s] = S5[(sb * 16 + (s < 15 || sb < 3 ? s : 14)) * 65 + lane];
          __builtin_amdgcn_sched_barrier(0);
#pragma unroll
          for (int s = 0; s < 16; ++s) { if (sb * 16 + s < 63) { const float mrow = mreg[s]; float xs[16];
#pragma unroll
              for (int rr = 0; rr < 16; ++rr) xs[rr] = __builtin_bit_cast(float, __builtin_amdgcn_readlane(__builtin_bit_cast(int, x[rr]), sb * 16 + s));
              __builtin_amdgcn_sched_barrier(0);
#pragma unroll
              for (int rr = 0; rr < 16; ++rr) x[rr] -= xs[rr] * mrow;
              __builtin_amdgcn_sched_barrier(0); } }
      }
      LAS float* dst = wave < 4 ? S3 : S6;
#pragma unroll
      for (int rr = 0; rr < 16; ++rr) dst[(r0 + rr) * 65 + lane] = x[rr]; }
    __syncthreads();
    PT1(5);
    { f32x16 acc = {};
      if (q == 1) { mm32<false, true, false>(acc, S8, i0, S0, j0, lane); st_tile<2>(S4, acc, i0, j0, lane); }
      else { mm32<false, false, false>(acc, S3, i0, S8, j0, lane);
          const int jc = j0 + li; const float gc = gC[jc]; float* TQ = (float*)(p->ws + WS_TQ) + (size_t)unit * 4096;
#pragma unroll
          for (int rg = 0; rg < 4; ++rg) { const int ab = i0 + 8 * rg + 4 * hi; f32x4 o;
#pragma unroll
              for (int e = 0; e < 4; ++e) o[e] = ((ab + e == jc) ? gc : 0.f) - acc[rg * 4 + e] * gc;
              *(f32x4*)(TQ + ((((jc >> 4) * 4 + (ab >> 4)) * 64 + ((ab & 15) >> 2) * 16 + (jc & 15)) * 4)) = o; } } }
    __syncthreads();
    { f32x16 acc = {};
      if (q == 0) { mm32<true, false, false>(acc, S2, i0, S1, j0, lane); mm32<false, false, true>(acc, S6, i0, S8, j0, lane);
          const int jc = j0 + li; const float gc = gC[jc]; float* GM = (float*)(p->ws + WS_GM) + (size_t)unit * 4096;
#pragma unroll
          for (int r = 0; r < 16; ++r) GM[(i0 + (r & 3) + 8 * (r >> 2) + 4 * hi) * 64 + jc] = acc[r] * gc; }
      else { mm32<true, false, false>(acc, S2, i0, S7, j0, lane); mm32<false, false, true>(acc, S6, i0, S4, j0, lane);
          float* Y0T = (float*)(p->ws + WS_Y0T) + (size_t)unit * 4096 + (j0 + li) * 64;
#pragma unroll
          for (int rg = 0; rg < 4; ++rg) *(f32x4*)(Y0T + i0 + 8 * rg + 4 * hi) = (f32x4){acc[rg * 4], acc[rg * 4 + 1], acc[rg * 4 + 2], acc[rg * 4 + 3]}; } }
    if (q == 0) { f32x16 acc;
#pragma unroll
        for (int r = 0; r < 16; ++r) acc[r] = S0[(j0 + li) * 65 + i0 + (r & 3) + 8 * (r >> 2) + 4 * hi];
        mm32<false, false, true>(acc, S3, i0, S4, j0, lane);
        float* ET = (float*)(p->ws + WS_ET) + (size_t)unit * 4096 + (j0 + li) * 64;
#pragma unroll
        for (int rg = 0; rg < 4; ++rg) *(f32x4*)(ET + i0 + 8 * rg + 4 * hi) = (f32x4){acc[rg * 4], acc[rg * 4 + 1], acc[rg * 4 + 2], acc[rg * 4 + 3]}; }
    __syncthreads();
    PT1(6);
}
__device__ __forceinline__ void chain_run(f32x4 (&st)[4], const float* TQ, const float* GM, float* SC, int nsteps, int i, int g, int lane) {
    constexpr size_t STRIDE = (size_t)8 * 4096;
    f32x4 tq[16], gm[4];
#pragma unroll
    for (int x = 0; x < 16; ++x) tq[x] = *(const f32x4*)(TQ + (x * 64 + lane) * 4);
#pragma unroll
    for (int tl = 0; tl < 4; ++tl) gm[tl] = GM ? *(const f32x4*)(GM + i * 64 + 16 * tl + 4 * g) : (f32x4){0.f, 0.f, 0.f, 0.f};
    for (int c = 0; c < nsteps; ++c) {
        if (SC) {
#pragma unroll
            for (int tl = 0; tl < 4; ++tl) *(f32x4*)(SC + c * STRIDE + i * 64 + 16 * tl + 4 * g) = st[tl]; }
        f32x4 tqn[16], gmn[4];
        const int cn = (c + 1 < nsteps) ? c + 1 : c;
#pragma unroll
        for (int x = 0; x < 16; ++x) tqn[x] = *(const f32x4*)(TQ + cn * STRIDE + (x * 64 + lane) * 4);
#pragma unroll
        for (int tl = 0; tl < 4; ++tl) gmn[tl] = GM ? *(const f32x4*)(GM + cn * STRIDE + i * 64 + 16 * tl + 4 * g) : (f32x4){0.f, 0.f, 0.f, 0.f};
        f32x4 acc[4];
#pragma unroll
        for (int tp = 0; tp < 4; ++tp) acc[tp] = gm[tp];
#pragma unroll
        for (int tl = 0; tl < 4; ++tl)
#pragma unroll
            for (int r = 0; r < 4; ++r)
#pragma unroll
                for (int tp = 0; tp < 4; ++tp) acc[tp] = __builtin_amdgcn_mfma_f32_16x16x4f32(tq[tp * 4 + tl][r], st[tl][r], acc[tp], 0, 0, 0);
#pragma unroll
        for (int tl = 0; tl < 4; ++tl) st[tl] = acc[tl];
#pragma unroll
        for (int x = 0; x < 16; ++x) tq[x] = tqn[x];
#pragma unroll
        for (int tl = 0; tl < 4; ++tl) gm[tl] = gmn[tl];
    }
}
__device__ __forceinline__ void rwkv_l1_task(KP p, int task, int lane) {
    const int iq = task & 3, kind = (task >> 2) & 1, h = (task >> 3) & 7, grp = task >> 6;
    const int fr = lane & 15, g = lane >> 4, i = iq * 16 + fr;
    const size_t u0 = ((size_t)(grp * 16) * 8 + h) * 4096;
    const float* TQ = (const float*)(p->ws + WS_TQ) + u0; const float* GM = (const float*)(p->ws + WS_GM) + u0;
    f32x4 st[4];
#pragma unroll
    for (int tl = 0; tl < 4; ++tl)
#pragma unroll
        for (int r = 0; r < 4; ++r) st[tl][r] = (kind == 1 && i == 16 * tl + 4 * g + r) ? 1.f : 0.f;
    chain_run(st, TQ, kind == 0 ? GM : nullptr, nullptr, 16, i, g, lane);
    const size_t gb = ((size_t)grp * 8 + h) * 4096;
    if (kind == 0) { float* GG = (float*)(p->ws + WS_GG) + gb;
#pragma unroll
        for (int tl = 0; tl < 4; ++tl) *(f32x4*)(GG + i * 64 + 16 * tl + 4 * g) = st[tl]; }
    else { float* TG = (float*)(p->ws + WS_TG) + gb;
#pragma unroll
        for (int tl = 0; tl < 4; ++tl)
#pragma unroll
            for (int r = 0; r < 4; ++r) TG[((tl * 4 + iq) * 64 + (fr >> 2) * 16 + 4 * g + r) * 4 + (fr & 3)] = st[tl][r]; }
}
__device__ __forceinline__ void rwkv_l2_task(KP p, int l, int task, int lane) {
    const int iq = task & 3, h = task >> 2, fr = lane & 15, g = lane >> 4, i = iq * 16 + fr;
    f32x4 st[4];
#pragma unroll
    for (int tl = 0; tl < 4; ++tl) st[tl] = (f32x4){0.f, 0.f, 0.f, 0.f};
    chain_run(st, (const float*)(p->ws + WS_TG) + (size_t)h * 4096, (const float*)(p->ws + WS_GG) + (size_t)h * 4096, (float*)(p->ws + WS_SG) + (size_t)h * 4096, 16, i, g, lane);
    float* dst = p->out + O_PWKV + (((size_t)l * 8 + h) * 64 + i) * 64;
#pragma unroll
    for (int tl = 0; tl < 4; ++tl) *(f32x4*)(dst + 16 * tl + 4 * g) = st[tl];
}
__device__ __forceinline__ void rwkv_l3_task(KP p, int l, int task, int lane) {
    const int fr = lane & 15, g = lane >> 4;
    f32x4 st[4];
    if (task < 512) { const int iq = task & 3, h = (task >> 2) & 7, grp = task >> 5, i = iq * 16 + fr;
        const float* s0 = (const float*)(p->ws + WS_SG) + ((size_t)grp * 8 + h) * 4096 + i * 64;
#pragma unroll
        for (int tl = 0; tl < 4; ++tl) st[tl] = *(const f32x4*)(s0 + 16 * tl + 4 * g);
        const size_t u0 = ((size_t)(grp * 16) * 8 + h) * 4096;
        chain_run(st, (const float*)(p->ws + WS_TQ) + u0, (const float*)(p->ws + WS_GM) + u0, (float*)(p->ws + WS_SC) + u0, 16, i, g, lane); }
    else { const int t2 = task - 512, iq = t2 & 3, h = (t2 >> 2) & 7, b = t2 >> 5, i = iq * 16 + fr;
        const float* s0 = p->in[I_SWKV] + ((((size_t)l * 32 + b) * 8 + h) * 64 + i) * 64;
#pragma unroll
        for (int tl = 0; tl < 4; ++tl) st[tl] = *(const f32x4*)(s0 + 16 * tl + 4 * g);
        const size_t u0 = ((size_t)(256 + b) * 8 + h) * 4096;
        chain_run(st, (const float*)(p->ws + WS_TQ) + u0, (const float*)(p->ws + WS_GM) + u0, (float*)(p->ws + WS_SC) + u0, 1, i, g, lane);
        float* dst = p->out + O_SWKV + ((((size_t)l * 32 + b) * 8 + h) * 64 + i) * 64;
#pragma unroll
        for (int tl = 0; tl < 4; ++tl) *(f32x4*)(dst + 16 * tl + 4 * g) = st[tl]; }
}
__device__ __forceinline__ void rwkv_r3_task(KP p, int l, int task, int lane) {
    const int unit = task >> 1, th = task & 1, cu = unit >> 3, h = unit & 7, li = lane & 31, hi = lane >> 5;
    const RwkvSeqInfo si = rwkv_info(cu);
    if (th * 32 >= si.ntok) return;
    const bf16_t* U = (const bf16_t*)(p->ws + WS_U);
    const size_t ub = (size_t)unit * 4096; const int t = th * 32 + li;
    const float* SC = (const float*)(p->ws + WS_SC) + ub; const float* ET = (const float*)(p->ws + WS_ET) + ub + t * 64 + 32 * hi; const float* Y0T = (const float*)(p->ws + WS_Y0T) + ub + t * 64;
    f32x16 acc[2];
#pragma unroll
    for (int ti = 0; ti < 2; ++ti)
#pragma unroll
        for (int rg = 0; rg < 4; ++rg) { const f32x4 y0 = *(const f32x4*)(Y0T + 32 * ti + 8 * rg + 4 * hi);
#pragma unroll
            for (int e = 0; e < 4; ++e) acc[ti][rg * 4 + e] = y0[e]; }
#pragma unroll
    for (int s4 = 0; s4 < 8; ++s4) {
        const f32x4 eb = *(const f32x4*)(ET + 4 * s4);
        const f32x4 sa0 = *(const f32x4*)(SC + (li) * 64 + 32 * hi + 4 * s4), sa1 = *(const f32x4*)(SC + (32 + li) * 64 + 32 * hi + 4 * s4);
#pragma unroll
        for (int e = 0; e < 4; ++e) { acc[0] = __builtin_amdgcn_mfma_f32_32x32x2f32(sa0[e], eb[e], acc[0], 0, 0, 0); acc[1] = __builtin_amdgcn_mfma_f32_32x32x2f32(sa1[e], eb[e], acc[1], 0, 0, 0); }
    }
    float s1 = 0.f;
#pragma unroll
    for (int ti = 0; ti < 2; ++ti)
#pragma unroll
        for (int r = 0; r < 16; ++r) s1 += acc[ti][r];
    s1 = xhalf_sum(s1); const float mean = s1 * (1.f / 64.f);
    float s2 = 0.f;
#pragma unroll
    for (int ti = 0; ti < 2; ++ti)
#pragma unroll
        for (int r = 0; r < 16; ++r) { const float d = acc[ti][r] - mean; s2 += d * d; }
    s2 = xhalf_sum(s2); const float rstd = 1.f / sqrtf(s2 * (1.f / 64.f) + 64e-5f);
    if (t >= si.ntok) return;
    const float bon = ((const float*)(p->ws + WS_BONUS))[(size_t)unit * 64 + t];
    const size_t row = (size_t)(si.row0 + t);
    bf16_t* oc = (bf16_t*)(p->ws + WS_OCAT) + (size_t)2 * NTOK * 512 + row * 512 + h * 64;
    u32x2 wout[2][4];
#pragma unroll
    for (int ti = 0; ti < 2; ++ti)
#pragma unroll
        for (int rg = 0; rg < 4; ++rg) { const int i = 32 * ti + 8 * rg + 4 * hi, c = h * 64 + i;
            const f32x4 gg = *(const f32x4*)(p->in[I_GNG] + l * 512 + c), gb = *(const f32x4*)(p->in[I_GNB] + l * 512 + c), mu = *(const f32x4*)(p->in[I_MU] + l * SHIFT_W + 1024 + c);
            const u32x2 vx = *(const u32x2*)(U + row * NU + U_XC + 1024 + c); const u32x2 sg = *(const u32x2*)(U + row * NU + U_CSG + c);
            f32x4 vc = (f32x4){bflo(vx.x), bfhi(vx.x), bflo(vx.y), bfhi(vx.y)}, vp;
            {
                const u32x2 px = *(const u32x2*)(U + (row > 0 ? row - 1 : 0) * NU + U_XC + 1024 + c); const f32x4 ss = *(const f32x4*)(p->in[I_SSHIFT] + ((size_t)l * 32 + si.b) * SHIFT_W + 1024 + c);
                const f32x4 up = (f32x4){bflo(px.x), bfhi(px.x), bflo(px.y), bfhi(px.y)};
                vp = (t > 0 || si.prev_kind == 1) ? up : (si.prev_kind == 2 ? ss : (f32x4){0.f, 0.f, 0.f, 0.f}); }
            const f32x4 vs = vc + (vp - vc) * mu;
            const f32x4 sgf = (f32x4){bflo(sg.x), bfhi(sg.x), bflo(sg.y), bfhi(sg.y)};
            f32x4 o;
#pragma unroll
            for (int e = 0; e < 4; ++e) o[e] = (((acc[ti][rg * 4 + e] - mean) * rstd) * gg[e] + gb[e] + bon * vs[e]) * siluf_(sgf[e]);
            wout[ti][rg].x = cvt_pk_bf16(o[0], o[1]); wout[ti][rg].y = cvt_pk_bf16(o[2], o[3]); }
#pragma unroll
    for (int ti = 0; ti < 2; ++ti)
#pragma unroll
        for (int rg = 0; rg < 4; ++rg) *(u32x2*)(oc + 32 * ti + 8 * rg + 4 * hi) = wout[ti][rg];
}
__device__ __forceinline__ int krow(int i) { return (i & 3) + 4 * ((i >> 3) & 1) + 8 * ((i >> 2) & 1) + 16 * (i >> 4); }
__device__ __forceinline__ bf16x8 pack8(const f32x16& v, int o) { u32x4 w; w.x = cvt_pk_bf16(v[o], v[o + 1]); w.y = cvt_pk_bf16(v[o + 2], v[o + 3]); w.z = cvt_pk_bf16(v[o + 4], v[o + 5]); w.w = cvt_pk_bf16(v[o + 6], v[o + 7]); return __builtin_bit_cast(bf16x8, w); }
constexpr float ATT_NEG = -1e30f;
template <bool HALF>
__device__ __forceinline__ void softmax_tile(f32x16& p0, f32x16& p1, float& m, float& lsum, f32x16 (&O)[2], bf16x8 (&pb)[4]) {
    float mx = p0[0];
#pragma unroll
    for (int r = 1; r < 16; ++r) mx = fmaxf(mx, p0[r]);
    if (!HALF) {
#pragma unroll
        for (int r = 0; r < 16; ++r) mx = fmaxf(mx, p1[r]); }
    mx = xhalf_max(mx);
    const float mn = fmaxf(m, mx), alpha = __builtin_amdgcn_exp2f(m - mn);
    m = mn;
    float s = 0.f;
#pragma unroll
    for (int r = 0; r < 16; ++r) { p0[r] = __builtin_amdgcn_exp2f(p0[r] - mn); s += p0[r]; }
    if (!HALF) {
#pragma unroll
        for (int r = 0; r < 16; ++r) { p1[r] = __builtin_amdgcn_exp2f(p1[r] - mn); s += p1[r]; } }
    lsum = lsum * alpha + s;
#pragma unroll
    for (int r = 0; r < 16; ++r) { O[0][r] *= alpha; O[1][r] *= alpha; }
    pb[0] = pack8(p0, 0); pb[1] = pack8(p0, 8);
    if (!HALF) { pb[2] = pack8(p1, 0); pb[3] = pack8(p1, 8); }
}
constexpr int AKS = 72;
constexpr int ATT_KB = 0, ATT_VB = 2 * 64 * AKS * 2, ATT_FB = 4 * 64 * AKS * 2, ATT_SC = ATT_FB + 2 * 64 * 4;
__device__ __forceinline__ void attn_prompt_unit(KP p, int l, int h, int qb, LAS unsigned char* lds, int tid) {
    const bf16_t* U = (const bf16_t*)(p->ws + WS_U); const bf16_t* Vt = (const bf16_t*)(p->ws + WS_VT) + (size_t)h * 64 * TP; const float* F = (const float*)(p->ws + WS_FP) + (size_t)h * TP;
    const int wave = tid >> 6, lane = tid & 63, li = lane & 31, hi = lane >> 5;
    const int q0 = qb * 256, q = q0 + wave * 32 + li;
    bf16x8 qf[4];
    { const float sc = 0.125f * LOG2E;
#pragma unroll
      for (int d0 = 0; d0 < 4; ++d0) { const u32x4 w = *(const u32x4*)(U + (size_t)q * NU + U_Q + h * 64 + 16 * d0 + 8 * hi);
          qf[d0] = pack8f((f32x4){bflo(w.x) * sc, bfhi(w.x) * sc, bflo(w.y) * sc, bfhi(w.y) * sc}, (f32x4){bflo(w.z) * sc, bfhi(w.z) * sc, bflo(w.w) * sc, bfhi(w.w) * sc}); } }
    const float fq = F[q];
    float m = ATT_NEG, lsum = 0.f; f32x16 O[2] = {};
    const int NT = (q0 + 256) / 64;
    LAS float* qmx = (LAS float*)(lds + ATT_SC); LAS float* mmv = qmx + 8;
    { float q2 = 0.f;
#pragma unroll
      for (int d0 = 0; d0 < 4; ++d0) { const u32x4 w = __builtin_bit_cast(u32x4, qf[d0]); q2 += bflo(w.x) * bflo(w.x) + bfhi(w.x) * bfhi(w.x) + bflo(w.y) * bflo(w.y) + bfhi(w.y) * bfhi(w.y) + bflo(w.z) * bflo(w.z) + bfhi(w.z) * bfhi(w.z) + bflo(w.w) * bflo(w.w) + bfhi(w.w) * bfhi(w.w); }
      q2 = wave_max(xhalf_sum(q2)); if (lane == 0) { qmx[wave] = q2; mmv[wave] = ATT_NEG; } }
    const float kmax2 = __uint_as_float(((const unsigned*)(p->ws + WS_CTL))[CW_KMAX + l * 8 + h]), fq0 = F[q0];
    const int srow = tid >> 3, sch = tid & 7;
    const bf16_t* kg = U + (size_t)srow * NU + U_K + h * 64 + 8 * sch; const bf16_t* vg = Vt + (size_t)srow * TP + 8 * sch;
    LAS unsigned char* kdst = lds + ATT_KB + (srow * AKS + 8 * sch) * 2; LAS unsigned char* vdst = lds + ATT_VB + (srow * AKS + 8 * sch) * 2;
    u32x4 kr = *(const u32x4*)(kg + (size_t)(NT - 1) * 64 * NU), vr = *(const u32x4*)(vg + (NT - 1) * 64); float fr = tid < 64 ? F[(NT - 1) * 64 + tid] : 0.f;
    *(LAS u32x4*)kdst = kr; *(LAS u32x4*)vdst = vr; if (tid < 64) ((LAS float*)(lds + ATT_FB))[tid] = fr;
    __syncthreads();
    const int ka = krow(li);
    float qkb; { float q2 = qmx[0];
#pragma unroll
      for (int w = 1; w < 8; ++w) q2 = fmaxf(q2, qmx[w]);
      qkb = 1.02f * sqrtf(q2 * kmax2) + fq0; }
    for (int t = NT - 1, buf = 0; t >= 0; --t, buf ^= 1) {
        { float mmin = mmv[0];
#pragma unroll
          for (int w = 1; w < 8; ++w) mmin = fminf(mmin, mmv[w]);
          if (qkb - ((const LAS float*)(lds + ATT_FB))[buf * 64 + 63] < mmin - 40.f) break; }
        if (t > 0) { kr = *(const u32x4*)(kg + (size_t)(t - 1) * 64 * NU); vr = *(const u32x4*)(vg + (t - 1) * 64); if (tid < 64) fr = F[(t - 1) * 64 + tid]; }
        if (64 * t <= q0 + wave * 32 + 31) {
            const LAS bf16_t* Kb = (const LAS bf16_t*)(lds + ATT_KB) + buf * 64 * AKS; const LAS bf16_t* Vb = (const LAS bf16_t*)(lds + ATT_VB) + buf * 64 * AKS; const LAS float* Fb = (const LAS float*)(lds + ATT_FB) + buf * 64;
            f32x16 p0, p1;
#pragma unroll
            for (int g2 = 0; g2 < 2; ++g2) { const f32x4 a = *(const LAS f32x4*)(Fb + 8 * hi + 16 * g2), b = *(const LAS f32x4*)(Fb + 8 * hi + 16 * g2 + 4), c = *(const LAS f32x4*)(Fb + 32 + 8 * hi + 16 * g2), d = *(const LAS f32x4*)(Fb + 32 + 8 * hi + 16 * g2 + 4);
#pragma unroll
                for (int e = 0; e < 4; ++e) { p0[8 * g2 + e] = fq - a[e]; p0[8 * g2 + 4 + e] = fq - b[e]; p1[8 * g2 + e] = fq - c[e]; p1[8 * g2 + 4 + e] = fq - d[e]; } }
#pragma unroll
            for (int d0 = 0; d0 < 4; ++d0) { const bf16x8 a0 = *(const LAS bf16x8*)(Kb + ka * AKS + 16 * d0 + 8 * hi), a1 = *(const LAS bf16x8*)(Kb + (ka + 32) * AKS + 16 * d0 + 8 * hi);
                p0 = __builtin_amdgcn_mfma_f32_32x32x16_bf16(a0, qf[d0], p0, 0, 0, 0); p1 = __builtin_amdgcn_mfma_f32_32x32x16_bf16(a1, qf[d0], p1, 0, 0, 0); }
            if (64 * t + 63 > q0 + wave * 32) {
#pragma unroll
                for (int r = 0; r < 16; ++r) { const int kv = 64 * t + 8 * hi + 16 * (r >> 3) + (r & 7); if (kv > q) p0[r] = -INFINITY; if (kv + 32 > q) p1[r] = -INFINITY; } }
            bf16x8 pb[4];
            softmax_tile<false>(p0, p1, m, lsum, O, pb);
#pragma unroll
            for (int dt = 0; dt < 2; ++dt)
#pragma unroll
                for (int s = 0; s < 4; ++s) { const bf16x8 a = *(const LAS bf16x8*)(Vb + (32 * dt + li) * AKS + 16 * (s & 1) + 32 * (s >> 1) + 8 * hi);
                    O[dt] = __builtin_amdgcn_mfma_f32_32x32x16_bf16(a, pb[s], O[dt], 0, 0, 0); }
        }
        { const float wm = wave_min(m); if (lane == 0) mmv[wave] = wm; }
        if (t > 0) { const int nb = buf ^ 1; *(LAS u32x4*)(kdst + nb * 64 * AKS * 2) = kr; *(LAS u32x4*)(vdst + nb * 64 * AKS * 2) = vr; if (tid < 64) ((LAS float*)(lds + ATT_FB))[nb * 64 + tid] = fr; }
        __syncthreads();
    }
    __syncthreads();
    const float inv = 1.f / xhalf_sum(lsum);
    bf16_t* ob = (bf16_t*)(p->ws + WS_OCAT) + (size_t)1 * NTOK * 512 + (size_t)q * 512 + h * 64;
    u32x2 sgv[2][4];
#pragma unroll
    for (int dt = 0; dt < 2; ++dt)
#pragma unroll
        for (int rg = 0; rg < 4; ++rg) sgv[dt][rg] = *(const u32x2*)(U + (size_t)q * NU + U_BSG + h * 64 + 32 * dt + 8 * rg + 4 * hi);
#pragma unroll
    for (int dt = 0; dt < 2; ++dt)
#pragma unroll
        for (int rg = 0; rg < 4; ++rg) { const int d = 32 * dt + 8 * rg + 4 * hi; const u32x2 sg = sgv[dt][rg];
            u32x2 w; w.x = cvt_pk_bf16(O[dt][rg * 4] * inv * siluf_(bflo(sg.x)), O[dt][rg * 4 + 1] * inv * siluf_(bfhi(sg.x))); w.y = cvt_pk_bf16(O[dt][rg * 4 + 2] * inv * siluf_(bflo(sg.y)), O[dt][rg * 4 + 3] * inv * siluf_(bfhi(sg.y)));
            *(u32x2*)(ob + d) = w; }
}
__device__ __forceinline__ void attn_sample_unit(KP p, int l, int b, int h, LAS unsigned char* lds, int tid) {
    const bf16_t* U = (const bf16_t*)(p->ws + WS_U);
    const int wave = tid >> 6, lane = tid & 63, li = lane & 31, hi = lane >> 5;
    const size_t qrow = (size_t)TP + b * 32 + li;
    const float* G = (const float*)(p->ws + WS_GS) + ((size_t)b * 8 + h) * GS_LEN;
    bf16x8 qf[4];
    { const float sc = 0.125f * LOG2E;
#pragma unroll
      for (int d0 = 0; d0 < 4; ++d0) { const u32x4 w = *(const u32x4*)(U + qrow * NU + U_Q + h * 64 + 16 * d0 + 8 * hi);
          qf[d0] = pack8f((f32x4){bflo(w.x) * sc, bfhi(w.x) * sc, bflo(w.y) * sc, bfhi(w.y) * sc}, (f32x4){bflo(w.z) * sc, bfhi(w.z) * sc, bflo(w.w) * sc, bfhi(w.w) * sc}); } }
    const float fq = G[PAST + li];
    float m = ATT_NEG, lsum = 0.f; f32x16 O[2] = {};
    const float* CK = p->in[I_CK] + (((size_t)l * 32 + b) * PAST) * 512 + h * 64; const float* CV = p->in[I_CV] + (((size_t)l * 32 + b) * PAST) * 512 + h * 64;
    const int ka = krow(li);
    for (int tt = 0; tt < 8; ++tt) {
        const int key0 = (wave * 8 + tt) * 64;
        f32x16 p0, p1;
#pragma unroll
        for (int g2 = 0; g2 < 2; ++g2) { const float* gp = G + key0 + 8 * hi + 16 * g2; const f32x4 a = *(const f32x4*)gp, bq = *(const f32x4*)(gp + 4), c = *(const f32x4*)(gp + 32), d = *(const f32x4*)(gp + 36);
#pragma unroll
            for (int e = 0; e < 4; ++e) { p0[8 * g2 + e] = fq - a[e]; p0[8 * g2 + 4 + e] = fq - bq[e]; p1[8 * g2 + e] = fq - c[e]; p1[8 * g2 + 4 + e] = fq - d[e]; } }
#pragma unroll
        for (int d0 = 0; d0 < 4; ++d0) { const float* k0p = CK + (size_t)(key0 + ka) * 512 + 16 * d0 + 8 * hi; const float* k1p = k0p + (size_t)32 * 512;
            const bf16x8 a0 = pack8f(*(const f32x4*)k0p, *(const f32x4*)(k0p + 4)), a1 = pack8f(*(const f32x4*)k1p, *(const f32x4*)(k1p + 4));
            p0 = __builtin_amdgcn_mfma_f32_32x32x16_bf16(a0, qf[d0], p0, 0, 0, 0); p1 = __builtin_amdgcn_mfma_f32_32x32x16_bf16(a1, qf[d0], p1, 0, 0, 0); }
        bf16x8 pb[4];
        softmax_tile<false>(p0, p1, m, lsum, O, pb);
#pragma unroll
        for (int dt = 0; dt < 2; ++dt)
#pragma unroll
            for (int s = 0; s < 4; ++s) { const float* vp = CV + (size_t)(key0 + 16 * (s & 1) + 32 * (s >> 1) + 8 * hi) * 512 + 32 * dt + li;
                const bf16x8 a = pack8f((f32x4){vp[0], vp[512], vp[1024], vp[1536]}, (f32x4){vp[2048], vp[2560], vp[3072], vp[3584]});
                O[dt] = __builtin_amdgcn_mfma_f32_32x32x16_bf16(a, pb[s], O[dt], 0, 0, 0); }
    }
    if (wave == 7) {
        f32x16 p0, p1 = {};
#pragma unroll
        for (int g2 = 0; g2 < 2; ++g2) { const float* gp = G + PAST + 8 * hi + 16 * g2; const f32x4 a = *(const f32x4*)gp, bq = *(const f32x4*)(gp + 4);
#pragma unroll
            for (int e = 0; e < 4; ++e) { p0[8 * g2 + e] = fq - a[e]; p0[8 * g2 + 4 + e] = fq - bq[e]; } }
#pragma unroll
        for (int d0 = 0; d0 < 4; ++d0) { const bf16x8 a0 = *(const bf16x8*)(U + ((size_t)TP + b * 32 + ka) * NU + U_K + h * 64 + 16 * d0 + 8 * hi);
            p0 = __builtin_amdgcn_mfma_f32_32x32x16_bf16(a0, qf[d0], p0, 0, 0, 0); }
#pragma unroll
        for (int r = 0; r < 16; ++r) { const int kv = 8 * hi + 16 * (r >> 3) + (r & 7); if (kv > li) p0[r] = -INFINITY; }
        bf16x8 pb[4];
        softmax_tile<true>(p0, p1, m, lsum, O, pb);
#pragma unroll
        for (int dt = 0; dt < 2; ++dt)
#pragma unroll
            for (int s = 0; s < 2; ++s) { const bf16_t* vp = U + ((size_t)TP + b * 32 + 16 * s + 8 * hi) * NU + U_V + h * 64 + 32 * dt + li; u32x4 w;
                w.x = (unsigned)vp[0] | ((unsigned)vp[NU] << 16); w.y = (unsigned)vp[2 * NU] | ((unsigned)vp[3 * NU] << 16); w.z = (unsigned)vp[4 * NU] | ((unsigned)vp[5 * NU] << 16); w.w = (unsigned)vp[6 * NU] | ((unsigned)vp[7 * NU] << 16);
                O[dt] = __builtin_amdgcn_mfma_f32_32x32x16_bf16(__builtin_bit_cast(bf16x8, w), pb[s], O[dt], 0, 0, 0); }
    }
    LAS float* Ow = (LAS float*)lds;
    LAS float* ML = Ow + 8 * 32 * 64;
    lsum = xhalf_sum(lsum);
#pragma unroll
    for (int dt = 0; dt < 2; ++dt)
#pragma unroll
        for (int r = 0; r < 16; ++r) Ow[(wave * 32 + dt * 16 + r) * 64 + lane] = O[dt][r];
    if (hi == 0) { ML[(wave * 2) * 32 + li] = m; ML[(wave * 2 + 1) * 32 + li] = lsum; }
    __syncthreads();
    { const int qq = tid & 31, dg = tid >> 5; float M = ATT_NEG;
#pragma unroll
      for (int w = 0; w < 8; ++w) M = fmaxf(M, ML[(w * 2) * 32 + qq]);
      float L = 0.f; f32x4 o = {0.f, 0.f, 0.f, 0.f};
      const int d = 4 * dg, idx0 = (d >> 5) * 16 + ((d >> 3) & 3) * 4, ln = ((d >> 2) & 1) * 32 + qq;
#pragma unroll
      for (int w = 0; w < 8; ++w) { const float f = __builtin_amdgcn_exp2f(ML[(w * 2) * 32 + qq] - M); L += ML[(w * 2 + 1) * 32 + qq] * f;
#pragma unroll
          for (int e = 0; e < 4; ++e) o[e] += Ow[(w * 32 + idx0 + e) * 64 + ln] * f; }
      const float inv = 1.f / L; const size_t row = (size_t)TP + b * 32 + qq;
      const u32x2 sg = *(const u32x2*)(U + row * NU + U_BSG + h * 64 + d);
      u32x2 wv; wv.x = cvt_pk_bf16(o[0] * inv * siluf_(bflo(sg.x)), o[1] * inv * siluf_(bfhi(sg.x))); wv.y = cvt_pk_bf16(o[2] * inv * siluf_(bflo(sg.y)), o[3] * inv * siluf_(bfhi(sg.y)));
      *(u32x2*)((bf16_t*)(p->ws + WS_OCAT) + (size_t)1 * NTOK * 512 + row * 512 + h * 64 + d) = wv; }
    __syncthreads();
}
constexpr int NPHASE = 22;
__global__ void __launch_bounds__(512, 2) hse_fwd(Params p_) {
    const KP kp = (KP)__builtin_amdgcn_kernarg_segment_ptr();
    (void)p_;
    extern __shared__ __attribute__((aligned(16))) unsigned char lds_raw[];
    LAS unsigned char* lds = (LAS unsigned char*)lds_raw;
    const int tid0 = threadIdx.x;
    const int G = gridDim.x, bid = blockIdx.x, ngw = G * 8;
#define PH_LOCALS const KP p = kp_fresh(kp); int tid = tid0; asm volatile("" : "+v"(tid)); const int lane = tid & 63, wave = __builtin_amdgcn_readfirstlane(tid >> 6), gw = bid * 8 + wave; (void)lane; (void)gw; (void)p;
    if (tid0 < 4) ((LAS unsigned*)(lds + LDS_XB_OFF))[tid0] = 0u;
#if PROBE_ID
    if (tid0 == 0) *(LAS unsigned long long*)(lds + LDS_PROBE_OFF) = 0ull;
#endif
    __syncthreads();
    unsigned* ctl = (unsigned*)(kp->ws + WS_CTL);
    XcdBarrier bar = xcd_barrier_post(ctl + CW_BAR + kp->li * XCD_BAR_WORDS, (volatile LAS unsigned*)(lds + LDS_XB_OFF));
    const int lo = kp->ph_lo, hi = kp->ph_hi;
#define IN(k) (lo <= (k) && (k) < hi)
#ifndef DUP_MASK
#define DUP_MASK 0
#endif
#define NREP(k) (((DUP_MASK >> (k)) & 1) + 1)
#define SEAM(k) do { if (IN(k) && IN((k) + 1)) xcd_barrier(bar); } while (0)
    PT0();
    if (IN(0)) { PH_LOCALS
        for (int u = bid; u < 192; u += G) ada_unit(p, u, lds, tid);
        p0_weights(p, lds, gw, ngw, wave, lane);
    }
    SEAM(0);
    PT1(9);
    for (int l = 0; l < NLAYER; ++l) {
        const int pb = 1 + 10 * l;
        for (int rep = 0; rep < NREP(0); ++rep) { if (rep) xcd_barrier(bar);
        if (IN(pb)) { PH_LOCALS p1_rows(p, l, gw, ngw, lane); } }
        SEAM(pb);
        PT1(10);
        for (int rep = 0; rep < NREP(1); ++rep) { if (rep) xcd_barrier(bar);
        if (IN(pb + 1)) { PH_LOCALS
            pg8::Gemm g{(const bf16_t*)(p->ws + WS_H), (const bf16_t*)(p->ws + WS_WIN) + (size_t)l * NU * 2048, NTOK, NU, 2048};
            pg8::StaticOrder S; S.init(NTOK, NU, G, bid);
            EpiU E{(bf16_t*)(p->ws + WS_U), p->out, p->in[I_BF], l};
            pg8::gemm_phase<EpiU, pg8::StaticOrder>(lds, g, S, E, nullptr);
        }
        }
        SEAM(pb + 1);
        PT1(11);
        for (int rep = 0; rep < NREP(2); ++rep) { if (rep) xcd_barrier(bar);
        if (IN(pb + 2)) { PH_LOCALS
#ifndef DUP_SUB
#define DUP_SUB 0
#endif
            { PT0();
            for (int u = bid; u < NRU * ((DUP_SUB & 1) + 1); u += G) rwkv_r1(p, l, u % NRU, lds, tid);
            PT1(31);
            for (int u = bid; u < 544 * (((DUP_SUB >> 1) & 1) + 1); u += G) conv_unit(p, l, u % 544, lds, tid);
            PT1(32);
            for (int u = bid; u < 544 * (((DUP_SUB >> 2) & 1) + 1); u += G) pool_unit(p, l, u % 544, lds, tid);
            PT1(33);
            for (int u = bid; u < 256; u += G) { vt_tile(p, l, u * 8 + wave, lds, wave, lane); }
            __syncthreads();
            for (int u = bid; u < 32; u += G) gs_unit(p, l, u, lds, tid);
            for (int u = G - 1 - bid; u < 8; u += G) fp_unit(p, l, u, lds, tid);
            if (bid == G / 2) shift_out(p, l, tid);
            PT1(34); }
        }
        }
        SEAM(pb + 2);
        PT1(12);
        for (int rep = 0; rep < NREP(3); ++rep) { if (rep) xcd_barrier(bar);
        if (IN(pb + 3)) { PH_LOCALS
            if (wave < 4) for (int tk = bid * 4 + wave; tk < 1024; tk += G * 4) rwkv_l1_task(p, tk, lane);
            __syncthreads();
            LAS int* qslot = (LAS int*)(lds + LDS_XB_OFF - 16);
            for (;;) {
                if (tid == 0) *qslot = (int)atomicAdd(ctl + CW_QUEUE + 64 * (2 * l + 4 * rep), 1u);
                __syncthreads();
                const int item = *qslot;
                __syncthreads();
                if (item >= 512) break;
                attn_prompt_unit(p, l, item & 7, 63 - (item >> 3), lds, tid);
            }
            for (;;) {
                if (tid == 0) *qslot = (int)atomicAdd(ctl + CW_QUEUE + 64 * (2 * l + 1 + 4 * rep), 1u);
                __syncthreads();
                const int item = *qslot;
                __syncthreads();
                if (item >= 256) break;
                attn_sample_unit(p, l, item >> 3, item & 7, lds, tid);
            }
        }
        }
        SEAM(pb + 3);
        PT1(13);
        if (IN(pb + 4)) { PH_LOCALS if (wave == 0 && bid < 32) rwkv_l2_task(p, l, bid, lane); }
        SEAM(pb + 4);
        PT1(14);
        if (IN(pb + 5)) { PH_LOCALS for (int tk = (wave * G + bid); tk < 512 + 1024; tk += ngw) rwkv_l3_task(p, l, tk, lane); }
        SEAM(pb + 5);
        PT1(15);
        if (IN(pb + 6)) { PH_LOCALS for (int tk = gw; tk < NRU * 2; tk += ngw) rwkv_r3_task(p, l, tk, lane); }
        SEAM(pb + 6);
        PT1(16);
        for (int rep = 0; rep < NREP(7); ++rep) { if (rep) xcd_barrier(bar);
        if (IN(pb + 7)) { PH_LOCALS
            pg8::Gemm g{(const bf16_t*)(p->ws + WS_OCAT), (const bf16_t*)(p->ws + WS_WBR) + (size_t)l * 4 * 2048 * 512, 4 * NTOK, 4 * 2048, 512};
            BranchOrder S{G, bid};
            EpiZ E{(bf16_t*)(p->ws + WS_Z)};
            pg8::gemm_phase<EpiZ, BranchOrder>(lds, g, S, E, nullptr);
        }
        }
        SEAM(pb + 7);
        PT1(17);
        if (IN(pb + 8)) { PH_LOCALS merge_pass(p, bid * 512 + tid, G * 512); }
        SEAM(pb + 8);
        PT1(18);
        if (IN(pb + 9)) { PH_LOCALS
            pg8::Gemm g{(const bf16_t*)(p->ws + WS_MERGED), (const bf16_t*)(p->ws + WS_WOUT) + (size_t)l * 2048 * 2048, NTOK, 2048, 2048};
            pg8::StaticOrder S; S.init(NTOK, 2048, G, bid);
            EpiOut E{p->in[I_XP], p->in[I_XS], (const float*)(p->ws + WS_XBUF), (const float*)(p->ws + WS_ADA), (float*)(p->ws + WS_XBUF), l};
            pg8::gemm_phase<EpiOut, pg8::StaticOrder>(lds, g, S, E, nullptr);
        }
        SEAM(pb + 9);
        PT1(19);
    }
    if (IN(21)) { PH_LOCALS p_final_rows(p, gw, ngw, lane); }
    PT1(20);
#if PROBE_ID
    if (bid == 0 && tid0 == 0) { const unsigned long long w = *(LAS unsigned long long*)(lds + LDS_PROBE_OFF) * PROBE_K, t0 = __builtin_amdgcn_s_memrealtime(); while (__builtin_amdgcn_s_memrealtime() - t0 < w) __builtin_amdgcn_s_sleep(8); }
#endif
#undef IN
#undef SEAM
}
#ifndef MK_SPLIT
#define MK_SPLIT 0
#endif
extern "C" void kernel_launch(void* const* d_in, const int* in_sizes, int n_in, void* d_out, int out_size, void* d_ws, size_t ws_size, hipStream_t stream) {
    static int grid = 0;
    if (grid == 0) {
        if (n_in != N_IN || (size_t)out_size != O_END || ws_size < WS_END) { fprintf(stderr, "kernel_launch: unexpected shapes (n_in %d, out %d, ws %zu)\n", n_in, out_size, ws_size); grid = -1; return; }
        int dev = 0, cus = 0, per_cu = 0;
        if (hipGetDevice(&dev) != hipSuccess || hipDeviceGetAttribute(&cus, hipDeviceAttributeMultiprocessorCount, dev) != hipSuccess) { grid = -1; return; }
        if (hipFuncSetAttribute((const void*)hse_fwd, hipFuncAttributeMaxDynamicSharedMemorySize, LDS_BYTES) != hipSuccess) { fprintf(stderr, "kernel_launch: hipFuncSetAttribute failed\n"); grid = -1; return; }
        if (hipOccupancyMaxActiveBlocksPerMultiprocessor(&per_cu, (const void*)hse_fwd, 512, LDS_BYTES) != hipSuccess || per_cu < 1) fprintf(stderr, "kernel_launch: occupancy query reports %d\n", per_cu);
        (void)hipGetLastError();
        grid = cus;
    }
    if (grid < 0) return;
    if (hipMemsetAsync((char*)d_ws + WS_CTL, 0, CTL_BYTES, stream) != hipSuccess) return;
    Params a{};
    for (int i = 0; i < N_IN; ++i) a.in[i] = (const float*)d_in[i];
    a.out = (float*)d_out; a.ws = (unsigned char*)d_ws;
#if MK_SPLIT
    for (int ph = 0; ph < NPHASE; ++ph) { a.ph_lo = ph; a.ph_hi = ph + 1; a.li = ph; hipLaunchKernelGGL(hse_fwd, dim3(grid), dim3(512), LDS_BYTES, stream, a); }
#else
    a.ph_lo = 0; a.ph_hi = NPHASE; a.li = 0;
    hipLaunchKernelGGL(hse_fwd, dim3(grid), dim3(512), LDS_BYTES, stream, a);
#endif
    const hipError_t le = hipPeekAtLastError();
    if (le != hipSuccess) fprintf(stderr, "kernel_launch: launch failed: %s\n", hipGetErrorName(le));
}
```

```cpp
#include <hip/hip_runtime.h>
#include <cstdio>
#include <cstdint>
namespace pg8 {
#define PG8_LAS __attribute__((address_space(3)))
typedef unsigned short bf16_t;
typedef short bf16x8 __attribute__((ext_vector_type(8)));
typedef float f32x4 __attribute__((ext_vector_type(4)));
typedef unsigned u32x4 __attribute__((ext_vector_type(4)));
constexpr int BM = 256, BK = 64, HALF = 128, HTB = HALF * BK * 2  , STAGE_BYTES = 8 * HTB, NXCD = 8, WGM = 8;

__host__ __device__ __forceinline__ int lds_byte(int r, int c) { const int st = (r >> 4) * 2 + (c >> 5), rr = r & 15, cc = c & 31, ob = rr * 64 + cc * 2; return st * 1024 + (ob ^ (((ob >> 9) & 1) << 5)); }
__host__ __device__ __forceinline__ void stage_rc(int b, int& R, int& C) { const int st = b / 1024, sb = b % 1024, swz = sb ^ (((sb >> 9) & 1) << 5); R = (st >> 1) * 16 + swz / 64; C = (st & 1) * 32 + (swz % 64) / 2; }
__host__ __device__ __forceinline__ int perm32(int rho) { const int n = rho >> 4, i = rho & 15; return 8 * (i >> 2) + 4 * n + (i & 3); }

struct Unit { int pm, pn; };
struct Gemm { const bf16_t* A; const bf16_t* Bt; int M, N, K; };

struct StaticOrder {
    int nM, nN, nwg, G, c;
    __host__ __device__ void init(int M, int N, int G_, int c_) { nM = M / BM; nN = N / BM; nwg = nM * nN; G = G_; c = c_; }
    __host__ __device__ bool next(int i, Unit& u) const {
        const long L = (long)i * G + c; if (L >= nwg) return false;
        int wgid = (int)L; { const int q = nwg / NXCD, r = nwg % NXCD, xcd = wgid % NXCD, off = wgid / NXCD; wgid = (xcd < r ? xcd * (q + 1) : r * (q + 1) + (xcd - r) * q) + off; }
        const int nig = WGM * nN, gid = wgid / nig, fm = gid * WGM, gsz = (nM - fm) < WGM ? (nM - fm) : WGM;
        u.pm = fm + ((wgid % nig) % gsz); u.pn = (wgid % nig) / gsz; return true;
    }
    __device__ __forceinline__ void a_ready(const Unit&) const {}
    __device__ __forceinline__ void done(const Unit&) const {}
};
__device__ __forceinline__ unsigned cvt_pk_bf16(float lo, float hi) { unsigned r; asm volatile("v_cvt_pk_bf16_f32 %0, %1, %2" : "=v"(r) : "v"(lo), "v"(hi)); return r; }
typedef float f32x2 __attribute__((ext_vector_type(2)));
template <class Epi, class Sched, bool STAMP = false>
__device__ __forceinline__ void gemm_phase(PG8_LAS unsigned char* lds, const Gemm g, const Sched& S, const Epi& E, unsigned long long* stamps) {
    int tid = threadIdx.x; asm volatile("" : "+v"(tid));
    const int wid = __builtin_amdgcn_readfirstlane(tid >> 6), lane = tid & 63, wr = wid >> 2, wc = wid & 3, fr = lane & 15, fq = lane >> 4;
    const int K = g.K, nt = K / BK;
    int ts_lo = 0, ts_hi = 0, nts = 0; const unsigned long long rt_entry = STAMP ? (unsigned long long)wall_clock64() : 0ull;
#define PG8_STAMP() do { if (STAMP && wid == 0 && nts < 64) { const unsigned long long _c = (unsigned long long)clock64(); \
        ts_lo = (lane == nts) ? (int)(unsigned)_c : ts_lo; ts_hi = (lane == nts) ? (int)(unsigned)(_c >> 32) : ts_hi; ++nts; } } while (0)
    PG8_STAMP();
    unsigned voffA[2], voffB[2];
#pragma unroll
    for (int i = 0; i < 2; ++i) { int R, C; stage_rc(tid * 16 + i * 8192, R, C); const int Rb = Epi::PERM ? ((R & ~31) + perm32(R & 31)) : R;
        voffA[i] = (unsigned)(R * K + C) * 2u; voffB[i] = (unsigned)(Rb * K + C) * 2u; }
    const size_t kstep = (size_t)(BK * 2);
    const size_t hstep = (size_t)HALF * K * 2;
    const size_t tstep = 2 * hstep;
    const unsigned ldsw = (unsigned)wid * 1024u;
    const int aoff = lds_byte(wr * 64 + fr, fq * 8), boff = lds_byte(wc * 32 + fr, fq * 8);
#define PG8_SA(b, h) (((b) * 2 + (h)) * HTB)
#define PG8_SB(b, h) ((4 + (b) * 2 + (h)) * HTB)
#define PG8_STAGE(bufoff, gbase, voff) do { _Pragma("unroll") for (int _i = 0; _i < 2; ++_i) \
        __builtin_amdgcn_global_load_lds((const unsigned*)((const char*)(gbase) + (voff)[_i]), (PG8_LAS unsigned*)(lds + (bufoff) + ldsw + _i * 8192), 16, 0, 0); } while (0)
#define PG8_LDA(dst, b, h) do { _Pragma("unroll") for (int m = 0; m < 4; ++m) _Pragma("unroll") for (int k = 0; k < 2; ++k) dst[m][k] = *(const PG8_LAS bf16x8*)(lds + PG8_SA(b, h) + aoff + m * 2048 + k * 1024); } while (0)
#define PG8_LDB(dst, b, h) do { _Pragma("unroll") for (int n = 0; n < 2; ++n) _Pragma("unroll") for (int k = 0; k < 2; ++k) dst[n][k] = *(const PG8_LAS bf16x8*)(lds + PG8_SB(b, h) + boff + n * 2048 + k * 1024); } while (0)
#define PG8_MMA(ai, bj, At, Bt) do { __builtin_amdgcn_s_setprio(1); _Pragma("unroll") for (int m = 0; m < 4; ++m) _Pragma("unroll") for (int n = 0; n < 2; ++n) _Pragma("unroll") for (int k = 0; k < 2; ++k) \
        acc[ai][bj][m][n] = __builtin_amdgcn_mfma_f32_16x16x32_bf16(Bt[n][k], At[m][k], acc[ai][bj][m][n], 0, 0, 0); __builtin_amdgcn_s_setprio(0); } while (0)
#define PG8_WAIT_V(n) asm volatile("s_waitcnt vmcnt(" #n ")" ::: "memory")
#define PG8_WAIT_L(n) asm volatile("s_waitcnt lgkmcnt(" #n ")" ::: "memory")
#define PG8_BAR __builtin_amdgcn_s_barrier()
#define PG8_SCHED __builtin_amdgcn_sched_barrier(0)
    Unit cur, nxt; int ui = 0;
    if (!S.next(0, cur)) return;
    f32x4 acc[2][2][4][2];
#pragma unroll
    for (int a = 0; a < 2; ++a)
#pragma unroll
        for (int b = 0; b < 2; ++b)
#pragma unroll
            for (int m = 0; m < 4; ++m)
#pragma unroll
                for (int n = 0; n < 2; ++n) acc[a][b][m][n] = (f32x4){0.f, 0.f, 0.f, 0.f};
    bf16x8 At[4][2], B0[2][2], B1[2][2];
    const char* cA = (const char*)g.A + (size_t)cur.pm * tstep; const char* cB = (const char*)g.Bt + (size_t)cur.pn * tstep;
    S.a_ready(cur);
    PG8_STAGE(PG8_SB(0, 0), cB, voffB); PG8_STAGE(PG8_SA(0, 0), cA, voffA); PG8_STAGE(PG8_SB(0, 1), cB + hstep, voffB); PG8_STAGE(PG8_SA(0, 1), cA + hstep, voffA);
    if (wr == 1) PG8_BAR;
    PG8_WAIT_V(4); PG8_BAR;
    PG8_STAGE(PG8_SB(1, 0), cB + kstep, voffB); PG8_STAGE(PG8_SA(1, 0), cA + kstep, voffA); PG8_STAGE(PG8_SB(1, 1), cB + hstep + kstep, voffB);
    PG8_WAIT_V(6); PG8_BAR;
    PG8_STAMP();
    for (;;) {
        const bool has_next = S.next(ui + 1, nxt);
        const char* nA = has_next ? (const char*)g.A + (size_t)nxt.pm * tstep : cA; const char* nB = has_next ? (const char*)g.Bt + (size_t)nxt.pn * tstep : cB;
        for (int t = 0; t < nt; t += 2) {
            const bool last = (t == nt - 2);
            const char* a1 = cA + (size_t)(t + 1) * kstep;
            const char* a2 = last ? nA : cA + (size_t)(t + 2) * kstep; const char* b2 = last ? nB : cB + (size_t)(t + 2) * kstep;
            const char* a3 = a2 + kstep; const char* b3 = b2 + kstep;
            if (last && has_next) S.a_ready(nxt);
            PG8_LDB(B0, 0, 0); PG8_SCHED; PG8_LDA(At, 0, 0); PG8_STAGE(PG8_SA(1, 1), a1 + hstep, voffA);
            PG8_WAIT_L(8); PG8_BAR; PG8_WAIT_L(0); PG8_MMA(0, 0, At, B0); PG8_BAR; PG8_SCHED;
            PG8_LDB(B1, 0, 1); PG8_STAGE(PG8_SB(0, 0), b2, voffB);
            PG8_BAR; PG8_WAIT_L(0); PG8_MMA(0, 1, At, B1); PG8_BAR;
            PG8_LDA(At, 0, 1); PG8_STAGE(PG8_SA(0, 0), a2, voffA);
            PG8_BAR; PG8_WAIT_L(0); PG8_MMA(1, 0, At, B0); PG8_BAR; PG8_SCHED;
            PG8_STAGE(PG8_SB(0, 1), b2 + hstep, voffB);
            PG8_WAIT_V(6); PG8_BAR; PG8_MMA(1, 1, At, B1); PG8_BAR;
            PG8_LDB(B0, 1, 0); PG8_SCHED; PG8_LDA(At, 1, 0); PG8_STAGE(PG8_SA(0, 1), a2 + hstep, voffA);
            PG8_WAIT_L(8); PG8_BAR; PG8_WAIT_L(0); PG8_MMA(0, 0, At, B0); PG8_BAR; PG8_SCHED;
            PG8_LDB(B1, 1, 1); PG8_STAGE(PG8_SB(1, 0), b3, voffB);
            PG8_BAR; PG8_WAIT_L(0); PG8_MMA(0, 1, At, B1); PG8_BAR;
            PG8_LDA(At, 1, 1); PG8_STAGE(PG8_SA(1, 0), a3, voffA);
            PG8_BAR; PG8_WAIT_L(0); PG8_MMA(1, 0, At, B0); PG8_BAR; PG8_SCHED;
            PG8_STAGE(PG8_SB(1, 1), b3 + hstep, voffB);
            PG8_WAIT_V(6); PG8_BAR; PG8_MMA(1, 1, At, B1); PG8_BAR;
        }
        PG8_STAMP();
        if constexpr (!Epi::AFTER_DRAIN) { E(acc, cur, wr, wc, fr, fq); S.done(cur); }
        PG8_STAMP();
        if (!has_next) break;
#pragma unroll
        for (int a = 0; a < 2; ++a)
#pragma unroll
            for (int b = 0; b < 2; ++b)
#pragma unroll
                for (int m = 0; m < 4; ++m)
#pragma unroll
                    for (int n = 0; n < 2; ++n) acc[a][b][m][n] = (f32x4){0.f, 0.f, 0.f, 0.f};
        cur = nxt; cA = nA; cB = nB; ++ui;
    }
    PG8_WAIT_V(0);
    if (wr == 0) PG8_BAR;
    PG8_BAR;
    if constexpr (Epi::AFTER_DRAIN) { E.fused(acc, cur, wr, wc, fr, fq, lds, wid, lane); S.done(cur); }
    PG8_STAMP();
    if (STAMP && wid == 0) { stamps[lane] = lane < nts ? (((unsigned long long)(unsigned)ts_hi << 32) | (unsigned)ts_lo) : 0ull;
        if (lane == 62) stamps[62] = rt_entry; if (lane == 63) stamps[63] = (unsigned long long)wall_clock64(); }
#undef PG8_STAMP
#undef PG8_SA
#undef PG8_SB
#undef PG8_STAGE
#undef PG8_LDA
#undef PG8_LDB
#undef PG8_MMA
#undef PG8_WAIT_V
#undef PG8_WAIT_L
#undef PG8_BAR
#undef PG8_SCHED
}
}
#define XB_TMO      128
#define XB_XCNT(j)  (256  + 64 * (j))
#define XB_XSUB(j)  (1280 + 64 * (j))
#define XB_XGEN(j)  (2304 + 64 * (j))
#define XB_TOP      3328
#define XB_TOPGEN   3392
#define XCD_BAR_WORDS 3456
#define XB_SPIN_CAP (1u << 18)
#define LAS __attribute__((address_space(3)))

__device__ __forceinline__ unsigned xb_ld(unsigned* p)              { return __hip_atomic_load(p, __ATOMIC_RELAXED, __HIP_MEMORY_SCOPE_AGENT); }
__device__ __forceinline__ unsigned xb_add(unsigned* p, unsigned v) { return __hip_atomic_fetch_add(p, v, __ATOMIC_RELAXED, __HIP_MEMORY_SCOPE_AGENT); }
__device__ __forceinline__ unsigned xb_xcc_id() { return (unsigned)__builtin_amdgcn_s_getreg((3 << 11) | 20) & 0xFu; }
#define XB_SPIN(cond, bar) do { unsigned _sp = 0; while (cond) { __builtin_amdgcn_s_sleep(1); \
    if ((++_sp & 255u) == 0u) { if (xb_ld(&(bar)[XB_TMO])) break; if (_sp > XB_SPIN_CAP) { atomicAdd(&(bar)[XB_TMO], 1u); break; } } } } while (0)

struct XcdBarrier {
    unsigned* bar; unsigned x;
    volatile LAS unsigned* st;
};

__device__ __forceinline__ XcdBarrier xcd_barrier_post(unsigned* bar, volatile LAS unsigned* st) {
    XcdBarrier b; b.bar = bar; b.x = xb_xcc_id(); b.st = st;
    if (threadIdx.x == 0) (void)xb_add(&bar[XB_XCNT(b.x)], 1u);
    return b;
}
__device__ __forceinline__ void xcd_barrier_complete(unsigned* bar, unsigned x, unsigned& nloc, unsigned& nx) {
    const unsigned G = gridDim.x * gridDim.y * gridDim.z;
    unsigned sum, cnt, mine, sp = 0u;
    for (;;) {
        sum = 0u; cnt = 0u; mine = 0u;
#pragma unroll
        for (unsigned j = 0; j < 16; ++j) { const unsigned c = xb_ld(&bar[XB_XCNT(j)]); sum += c; cnt += (c > 0u) ? 1u : 0u; mine = (j == x) ? c : mine; }
        if (sum == G) break;
        __builtin_amdgcn_s_sleep(1);
        if ((++sp & 255u) == 0u) { if (xb_ld(&bar[XB_TMO])) break; if (sp > XB_SPIN_CAP) { atomicAdd(&bar[XB_TMO], 1u); break; } }
    }
    nloc = mine > 0u ? mine : 1u; nx = cnt > 0u ? cnt : 1u;
}

__device__ __forceinline__ void xcd_barrier(const XcdBarrier& b) {
    asm volatile("s_waitcnt vmcnt(0)" ::: "memory");
    __syncthreads();
    if (threadIdx.x == 0) {
        unsigned* bar = b.bar;
        __builtin_amdgcn_s_waitcnt(0);
        unsigned nloc = b.st[0], nx = b.st[1];
        if (nloc == 0u) { xcd_barrier_complete(bar, b.x, nloc, nx); b.st[0] = nloc; b.st[1] = nx; }
        const unsigned old = xb_add(&bar[XB_XSUB(b.x)], 1u);
        const unsigned gen = old / nloc;
        if (old + 1u == (gen + 1u) * nloc) {
            __builtin_amdgcn_fence(__ATOMIC_RELEASE, "agent");
            asm volatile("s_waitcnt vmcnt(0)" ::: "memory");
            const unsigned og = xb_add(&bar[XB_TOP], 1u);
            const unsigned tg = og / nx;
            if (og + 1u == (tg + 1u) * nx) xb_add(&bar[XB_TOPGEN], 1u);
            else XB_SPIN(xb_ld(&bar[XB_TOPGEN]) == tg, bar);
            __builtin_amdgcn_fence(__ATOMIC_ACQUIRE, "agent");
            xb_add(&bar[XB_XGEN(b.x)], 1u);
            asm volatile("s_waitcnt vmcnt(0)" ::: "memory");
        } else {
            XB_SPIN(xb_ld(&bar[XB_XGEN(b.x)]) == gen, bar);
            __builtin_amdgcn_fence(__ATOMIC_ACQUIRE, "agent");
            asm volatile("s_waitcnt vmcnt(0)" ::: "memory");
        }
    }
    __syncthreads();
}
typedef unsigned short bf16_t;
typedef short bf16x8 __attribute__((ext_vector_type(8)));
typedef float f32x4 __attribute__((ext_vector_type(4)));
typedef float f32x16 __attribute__((ext_vector_type(16)));
typedef unsigned u32x4 __attribute__((ext_vector_type(4)));
typedef unsigned u32x2 __attribute__((ext_vector_type(2)));
using pg8::cvt_pk_bf16;

constexpr int DM = 2048, TP = 16384, NSB = 32, TSQ = 32, NTOK = TP + NSB * TSQ, NSEQ = 33, PAST = 4096, NLAYER = 2;
constexpr int NU = 15104;
constexpr int U_AVAL = 0, U_AGATE = 512, U_ASG = 1024, U_Q = 1536, U_K = 2048, U_V = 2560, U_BSG = 3072, U_XC = 3584, U_CSG = 5248, U_DIN = 5760, U_DSG = 6272, U_G = 6784, U_F = 14976;
constexpr int IN_W = 14984, SHIFT_W = 1664;
constexpr float LOG2E = 1.4426950408889634f;
enum { I_XP = 0, I_XS, I_CK, I_CV, I_CLF, I_SCONV, I_SSHIFT, I_SWKV, I_SPOOL, I_CP, I_CS, I_NORMG, I_WADA, I_BADA, I_WIN, I_BF, I_CONVW, I_CONVB, I_CLNG, I_CLNB, I_MU, I_W0, I_W2, I_A0, I_A2,
       I_KK, I_KA, I_RK, I_GNG, I_GNB, I_POOLW, I_POOLB, I_POOLS, I_WBR, I_WOUT, I_FING, N_IN };
constexpr size_t O_YP = 0, O_YS = O_YP + (size_t)TP * DM, O_PK = O_YS + (size_t)1024 * DM, O_PV = O_PK + (size_t)2 * TP * 512, O_PLF = O_PV + (size_t)2 * TP * 512, O_PCONV = O_PLF + (size_t)2 * TP * 8,
                 O_PSHIFT = O_PCONV + 2 * 30 * 512, O_PWKV = O_PSHIFT + 2 * 1664, O_PPOOL = O_PWKV + 2 * 8 * 64 * 64, O_SK = O_PPOOL + 2 * 15 * 512, O_SV = O_SK + (size_t)2 * 1024 * 512,
                 O_SLF = O_SV + (size_t)2 * 1024 * 512, O_SCONV = O_SLF + 2 * 1024 * 8, O_SSHIFT = O_SCONV + (size_t)2 * 32 * 30 * 512, O_SWKV = O_SSHIFT + 2 * 32 * 1664,
                 O_SPOOL = O_SWKV + (size_t)2 * 32 * 8 * 64 * 64, O_END = O_SPOOL + (size_t)2 * 32 * 15 * 512;
static_assert(O_END == 75374848, "output size");
constexpr size_t al256(size_t x) { return (x + 255) & ~(size_t)255; }
constexpr int NCU_CH = 288, NRU = NCU_CH * 8;
constexpr size_t WS_CTL = 0, CTL_BYTES = 512 * 1024;
constexpr size_t WS_WIN = CTL_BYTES;
constexpr size_t WS_WBR = al256(WS_WIN + (size_t)2 * NU * 2048 * 2);
constexpr size_t WS_WOUT = al256(WS_WBR + (size_t)2 * 4 * 2048 * 512 * 2);
constexpr size_t WS_POOLW = al256(WS_WOUT + (size_t)2 * 2048 * 2048 * 2);
constexpr size_t WS_ADA = al256(WS_POOLW + (size_t)2 * 4 * 128 * 128 * 2);
constexpr size_t WS_H = al256(WS_ADA + (size_t)2 * 33 * 6144 * 4);
constexpr size_t WS_U = al256(WS_H + (size_t)NTOK * 2048 * 2);
constexpr size_t WS_XBUF = al256(WS_U + (size_t)NTOK * NU * 2);
constexpr size_t WS_OCAT = al256(WS_XBUF + (size_t)NTOK * 2048 * 4);
constexpr size_t WS_Z = al256(WS_OCAT + (size_t)4 * NTOK * 512 * 2);
constexpr size_t WS_MERGED = al256(WS_Z + (size_t)4 * NTOK * 2048 * 2);
constexpr size_t WS_FP = al256(WS_MERGED + (size_t)NTOK * 2048 * 2);
constexpr int GS_LEN = PAST + TSQ;
constexpr size_t WS_GS = al256(WS_FP + (size_t)8 * TP * 4);
constexpr size_t WS_VT = al256(WS_GS + (size_t)32 * 8 * GS_LEN * 4);
constexpr size_t WS_TQ = al256(WS_VT + (size_t)8 * 64 * TP * 2);
constexpr size_t WS_GM = al256(WS_TQ + (size_t)NRU * 4096 * 4);
constexpr size_t WS_ET = al256(WS_GM + (size_t)NRU * 4096 * 4);
constexpr size_t WS_Y0T = al256(WS_ET + (size_t)NRU * 4096 * 4);
constexpr size_t WS_SC = al256(WS_Y0T + (size_t)NRU * 4096 * 4);
constexpr size_t WS_BONUS = al256(WS_SC + (size_t)NRU * 4096 * 4);
constexpr size_t WS_GG = al256(WS_BONUS + (size_t)NRU * 64 * 4);
constexpr size_t WS_TG = al256(WS_GG + (size_t)16 * 8 * 4096 * 4);
constexpr size_t WS_SG = al256(WS_TG + (size_t)16 * 8 * 4096 * 4);
constexpr size_t WS_END = al256(WS_SG + (size_t)16 * 8 * 4096 * 4);
static_assert(WS_END < (size_t)2100 * 1024 * 1024, "workspace map exceeds the guaranteed d_ws size");
constexpr int CW_BAR = 0;
constexpr int CW_QUEUE = 16 * 3456 + 64;
constexpr int CW_KMAX = CW_QUEUE + 64 * 8;
static_assert((CW_KMAX + 64) * 4 <= (int)CTL_BYTES, "ctl");
constexpr int LDS_BYTES = 163840 - 256;
constexpr int LDS_XB_OFF = LDS_BYTES - 16;
constexpr int SLOT_F = 64 * 65;

#ifndef PROBE_ID
#define PROBE_ID 0
#endif
#ifndef PROBE_K
#define PROBE_K 1
#endif
constexpr int LDS_PROBE_OFF = 163840 - 256 - 64;
#if PROBE_ID
#define PT0() unsigned long long _pt0 = (blockIdx.x == 0 && threadIdx.x == 0) ? __builtin_amdgcn_s_memrealtime() : 0ull
#define PT1(id) do { if ((id) == PROBE_ID && blockIdx.x == 0 && threadIdx.x == 0) { *(LAS unsigned long long*)(lds + LDS_PROBE_OFF) += __builtin_amdgcn_s_memrealtime() - _pt0; } _pt0 = (blockIdx.x == 0 && threadIdx.x == 0) ? __builtin_amdgcn_s_memrealtime() : 0ull; } while (0)
#else
#define PT0() do {} while (0)
#define PT1(id) do {} while (0)
#endif
struct Params { const float* in[N_IN]; float* out; unsigned char* ws; int ph_lo, ph_hi, li, pad; };
typedef const __attribute__((address_space(4))) Params* KP;
__device__ __forceinline__ KP kp_fresh(KP k) { asm volatile("" : "+s"(k)); return k; }

__device__ __forceinline__ float bf2f(unsigned short b) { return __uint_as_float(((unsigned)b) << 16); }
__device__ __forceinline__ float bflo(unsigned w) { return __uint_as_float(w << 16); }
__device__ __forceinline__ float bfhi(unsigned w) { return __uint_as_float(w & 0xffff0000u); }
__device__ __forceinline__ unsigned short f2bf(float f) { return (unsigned short)(cvt_pk_bf16(f, 0.f) & 0xffffu); }
__device__ __forceinline__ float sigmoidf_(float x) { return 1.f / (1.f + __expf(-x)); }
__device__ __forceinline__ float siluf_(float x) { return x / (1.f + __expf(-x)); }
__device__ __forceinline__ float log_sigmoidf_(float z) { return fminf(z, 0.f) - log1pf(expf(-fabsf(z))); }
template <int CTRL> __device__ __forceinline__ float dpp_mov(float v) { return __int_as_float(__builtin_amdgcn_update_dpp(0, __float_as_int(v), CTRL, 0xF, 0xF, true)); }
__device__ __forceinline__ float wave_sum(float v) {
    v += dpp_mov<0xB1>(v); v += dpp_mov<0x4E>(v); v += dpp_mov<0x141>(v); v += dpp_mov<0x140>(v);
    const float r0 = __int_as_float(__builtin_amdgcn_readlane(__float_as_int(v), 0)), r1 = __int_as_float(__builtin_amdgcn_readlane(__float_as_int(v), 16));
    const float r2 = __int_as_float(__builtin_amdgcn_readlane(__float_as_int(v), 32)), r3 = __int_as_float(__builtin_amdgcn_readlane(__float_as_int(v), 48));
    return (r0 + r1) + (r2 + r3);
}
__device__ __forceinline__ float wave_max(float v) {
    v = fmaxf(v, dpp_mov<0xB1>(v)); v = fmaxf(v, dpp_mov<0x4E>(v)); v = fmaxf(v, dpp_mov<0x141>(v)); v = fmaxf(v, dpp_mov<0x140>(v));
    const float r0 = __int_as_float(__builtin_amdgcn_readlane(__float_as_int(v), 0)), r1 = __int_as_float(__builtin_amdgcn_readlane(__float_as_int(v), 16));
    const float r2 = __int_as_float(__builtin_amdgcn_readlane(__float_as_int(v), 32)), r3 = __int_as_float(__builtin_amdgcn_readlane(__float_as_int(v), 48));
    return fmaxf(fmaxf(r0, r1), fmaxf(r2, r3));
}
__device__ __forceinline__ float wave_min(float v) { return -wave_max(-v); }
__device__ __forceinline__ float xhalf_max(float m) { const auto rr = __builtin_amdgcn_permlane32_swap(__float_as_uint(m), __float_as_uint(m), false, false); return fmaxf(__uint_as_float(rr[0]), __uint_as_float(rr[1])); }
__device__ __forceinline__ float xhalf_sum(float m) { const auto rr = __builtin_amdgcn_permlane32_swap(__float_as_uint(m), __float_as_uint(m), false, false); return __uint_as_float(rr[0]) + __uint_as_float(rr[1]); }
__device__ __forceinline__ bf16x8 pack8f(const f32x4 a, const f32x4 b) { u32x4 w; w.x = cvt_pk_bf16(a[0], a[1]); w.y = cvt_pk_bf16(a[2], a[3]); w.z = cvt_pk_bf16(b[0], b[1]); w.w = cvt_pk_bf16(b[2], b[3]); return __builtin_bit_cast(bf16x8, w); }
__device__ __forceinline__ float fast_tanh(float x) { const float e = __expf(-2.f * fabsf(x)); const float t = (1.f - e) * __builtin_amdgcn_rcpf(1.f + e); return x < 0.f ? -t : t; }
__device__ __forceinline__ void tr_tile(const float* __restrict__ src, size_t ld, int k0, int c0, int nvalid, bf16_t* __restrict__ dst, int K, LAS float* scr, int lane) {
    float tv[64];
#pragma unroll
    for (int kk = 0; kk < 64; ++kk) tv[kk] = src[(size_t)(k0 + kk) * ld + c0 + (lane < nvalid ? lane : 0)];
#pragma unroll
    for (int kk = 0; kk < 64; ++kk) scr[kk * 65 + lane] = (lane < nvalid) ? tv[kk] : 0.f;
    const int k2 = (lane & 31) * 2, nh = lane >> 5;
#pragma unroll 8
    for (int it = 0; it < 32; ++it) { const int nn = 2 * it + nh; *(unsigned*)(dst + (size_t)nn * K + k0 + k2) = cvt_pk_bf16(scr[k2 * 65 + nn], scr[(k2 + 1) * 65 + nn]); }
}
__device__ __forceinline__ void p0_weights(KP p, LAS unsigned char* lds, int gw, int ngw, int wave, int lane) {
    LAS float* scr = (LAS float*)lds + wave * SLOT_F;
    constexpr int T_WIN = (NU / 64) * 32, T_WBR = 4 * 32 * 8, T_WOUT = 32 * 32, T_POOL = 4 * 2 * 2, T_L = T_WIN + T_WBR + T_WOUT + T_POOL;
    for (int it = gw; it < 2 * T_L; it += ngw) {
        const int l = it / T_L; int r = it % T_L;
        if (r < T_WIN) {
            const int nt = r / 32, kt = r % 32, m0 = nt * 64;
            int c0, nvalid = 64;
            if (m0 < 3072) c0 = m0; else if (m0 < U_F) c0 = m0 + 8; else if (m0 == U_F) { c0 = 3072; nvalid = 8; } else { c0 = 0; nvalid = 0; }
            tr_tile(p->in[I_WIN] + (size_t)l * 2048 * IN_W, IN_W, kt * 64, c0, nvalid, (bf16_t*)(p->ws + WS_WIN) + ((size_t)l * NU + m0) * 2048, 2048, scr, lane);
            continue; }
        r -= T_WIN;
        if (r < T_WBR) {
            const int n = r / 256, q = r % 256, nt = q / 8, kt = q % 8;
            tr_tile(p->in[I_WBR] + ((size_t)(l * 4 + n) * 512) * 2048, 2048, kt * 64, nt * 64, 64, (bf16_t*)(p->ws + WS_WBR) + ((size_t)(l * 4 + n) * 2048 + nt * 64) * 512, 512, scr, lane);
            continue; }
        r -= T_WBR;
        if (r < T_WOUT) {
            const int nt = r / 32, kt = r % 32;
            tr_tile(p->in[I_WOUT] + (size_t)l * 2048 * 2048, 2048, kt * 64, nt * 64, 64, (bf16_t*)(p->ws + WS_WOUT) + ((size_t)l * 2048 + nt * 64) * 2048, 2048, scr, lane);
            continue; }
        r -= T_WOUT;
        {
            const int g = r / 4, q = r % 4, nt = q / 2, kt = q % 2;
            tr_tile(p->in[I_POOLW] + (size_t)(l * 4 + g) * 128 * 128, 128, kt * 64, nt * 64, 64, (bf16_t*)(p->ws + WS_POOLW) + ((size_t)(l * 4 + g) * 128 + nt * 64) * 128, 128, scr, lane);
        }
    }
}
__device__ __forceinline__ void ada_unit(KP p, int unit, LAS unsigned char* lds, int tid) {
    const int wave = tid >> 6, lane = tid & 63, l = unit / 96, n0 = (unit % 96) * 64;
    LAS float* cs = (LAS float*)lds + wave * (33 * 64);
    LAS float* red = (LAS float*)lds + 8 * 33 * 64;
    const float* W = p->in[I_WADA] + (size_t)l * 2048 * 6144;
    const float* cp = p->in[I_CP]; const float* csm = p->in[I_CS];
    float acc[33];
#pragma unroll
    for (int s = 0; s < 33; ++s) acc[s] = 0.f;
    float wv[16];
#pragma unroll
    for (int j = 0; j < 16; ++j) wv[j] = W[(size_t)(wave * 256 + j) * 6144 + n0 + lane];
#pragma unroll 1
    for (int step = 0; step < 16; ++step) {
        const int k0 = wave * 256 + step * 16, kn = wave * 256 + (step < 15 ? step + 1 : step) * 16;
        float wn[16];
#pragma unroll
        for (int j = 0; j < 16; ++j) wn[j] = W[(size_t)(kn + j) * 6144 + n0 + lane];
        if ((step & 3) == 0) {
#pragma unroll
            for (int s = 0; s < 33; ++s) { const float c = (s == 0) ? cp[k0 + lane] : csm[(size_t)(s - 1) * 2048 + k0 + lane]; cs[s * 64 + lane] = siluf_(c); } }
        const int kk0 = (step & 3) * 16;
#pragma unroll
        for (int q4 = 0; q4 < 4; ++q4) {
#pragma unroll
            for (int s = 0; s < 33; ++s) { const f32x4 c4 = *(const LAS f32x4*)(cs + s * 64 + kk0 + 4 * q4); acc[s] += c4.x * wv[4 * q4] + c4.y * wv[4 * q4 + 1] + c4.z * wv[4 * q4 + 2] + c4.w * wv[4 * q4 + 3]; } }
#pragma unroll
        for (int j = 0; j < 16; ++j) wv[j] = wn[j];
    }
#pragma unroll
    for (int s = 0; s < 33; ++s) red[(wave * 33 + s) * 64 + lane] = acc[s];
    __syncthreads();
    for (int idx = tid; idx < 33 * 64; idx += 512) { const int s = idx >> 6, n = idx & 63; float v = p->in[I_BADA][l * 6144 + n0 + n];
#pragma unroll
        for (int w = 0; w < 8; ++w) v += red[(w * 33 + s) * 64 + n];
        ((float*)(p->ws + WS_ADA))[((size_t)l * 33 + s) * 6144 + n0 + n] = v; }
    __syncthreads();
}
__device__ __forceinline__ const float* x_row(KP p, int l, int row) {
    return l == 0 ? (row < TP ? p->in[I_XP] + (size_t)row * DM : p->in[I_XS] + (size_t)(row - TP) * DM) : (const float*)(p->ws + WS_XBUF) + (size_t)row * DM;
}
__device__ __forceinline__ void p1_rows(KP p, int l, int gw, int ngw, int lane) {
    const f32x4* g4 = (const f32x4*)(p->in[I_NORMG] + l * DM) + lane;
    for (int row = gw; row < NTOK; row += ngw) {
        const f32x4* x4 = (const f32x4*)x_row(p, l, row) + lane;
        const int seq = row < TP ? 0 : 1 + ((row - TP) >> 5);
        const f32x4* sh4 = (const f32x4*)((const float*)(p->ws + WS_ADA) + ((size_t)l * 33 + seq) * 6144) + lane; const f32x4* sc4 = sh4 + 512;
        f32x4 v[8]; float ss = 0.f;
#pragma unroll
        for (int j = 0; j < 8; ++j) { v[j] = x4[64 * j]; ss += (v[j].x * v[j].x + v[j].y * v[j].y) + (v[j].z * v[j].z + v[j].w * v[j].w); }
        const float rstd = 1.f / sqrtf(wave_sum(ss) * (1.f / DM) + 1e-6f);
        u32x2* o = (u32x2*)((bf16_t*)(p->ws + WS_H) + (size_t)row * DM) + lane;
#pragma unroll
        for (int j = 0; j < 8; ++j) { const f32x4 g = g4[64 * j], sc = sc4[64 * j], sh = sh4[64 * j]; const f32x4 y = v[j] * rstd * g * (sc + 1.f) + sh;
            u32x2 w; w.x = cvt_pk_bf16(y.x, y.y); w.y = cvt_pk_bf16(y.z, y.w); o[64 * j] = w; }
    }
}
__device__ __forceinline__ void p_final_rows(KP p, int gw, int ngw, int lane) {
    const f32x4* g4 = (const f32x4*)p->in[I_FING] + lane;
    for (int row = gw; row < NTOK; row += ngw) {
        const f32x4* x4 = (const f32x4*)((const float*)(p->ws + WS_XBUF) + (size_t)row * DM) + lane;
        f32x4 v[8]; float ss = 0.f;
#pragma unroll
        for (int j = 0; j < 8; ++j) { v[j] = x4[64 * j]; ss += (v[j].x * v[j].x + v[j].y * v[j].y) + (v[j].z * v[j].z + v[j].w * v[j].w); }
        const float rstd = 1.f / sqrtf(wave_sum(ss) * (1.f / DM) + 1e-6f);
        f32x4* o = (f32x4*)(p->out + O_YP + (size_t)row * DM) + lane;
#pragma unroll
        for (int j = 0; j < 8; ++j) o[64 * j] = v[j] * rstd * g4[64 * j];
    }
}
struct EpiU {
    static constexpr bool PERM = true, AFTER_DRAIN = false;
    bf16_t* U; float* out; const float* bf; int l;
    __device__ __forceinline__ void operator()(const f32x4 (&acc)[2][2][4][2], const pg8::Unit& u, int wr, int wc, int fr, int fq) const {
        const int row0 = u.pm * 256 + wr * 64 + fr, col0 = u.pn * 256 + wc * 32 + 8 * fq;
#pragma unroll
        for (int ai = 0; ai < 2; ++ai)
#pragma unroll
            for (int m = 0; m < 4; ++m) { bf16_t* rowp = U + (size_t)(row0 + ai * 128 + m * 16) * NU + col0;
#pragma unroll
                for (int bj = 0; bj < 2; ++bj) { const f32x4 v0 = acc[ai][bj][m][0], v1 = acc[ai][bj][m][1];
                    u32x4 w; w.x = cvt_pk_bf16(v0[0], v0[1]); w.y = cvt_pk_bf16(v0[2], v0[3]); w.z = cvt_pk_bf16(v1[0], v1[1]); w.w = cvt_pk_bf16(v1[2], v1[3]);
                    *(u32x4*)(rowp + bj * 128) = w; } }
        if (u.pn >= 8 && u.pn < 12) {
            const bool isv = u.pn >= 10; const int cin = (u.pn - (isv ? 10 : 8)) * 256 + wc * 32 + 8 * fq;
#pragma unroll
            for (int ai = 0; ai < 2; ++ai)
#pragma unroll
                for (int m = 0; m < 4; ++m) { const int row = row0 + ai * 128 + m * 16;
                    float* dst = row < TP ? out + (isv ? O_PV : O_PK) + ((size_t)l * TP + row) * 512 : out + (isv ? O_SV : O_SK) + ((size_t)l * 1024 + (row - TP)) * 512;
#pragma unroll
                    for (int bj = 0; bj < 2; ++bj) { *(f32x4*)(dst + cin + bj * 128) = acc[ai][bj][m][0]; *(f32x4*)(dst + cin + bj * 128 + 4) = acc[ai][bj][m][1]; } }
        }
        if (u.pn == 58 && wc == 0 && fq == 0) {
            const f32x4 b0 = *(const f32x4*)(bf + l * 8), b1 = *(const f32x4*)(bf + l * 8 + 4);
#pragma unroll
            for (int ai = 0; ai < 2; ++ai)
#pragma unroll
                for (int m = 0; m < 4; ++m) { const int row = row0 + ai * 128 + m * 16;
                    float* dst = row < TP ? out + O_PLF + ((size_t)l * TP + row) * 8 : out + O_SLF + ((size_t)l * 1024 + (row - TP)) * 8;
                    const f32x4 z0 = acc[ai][1][m][0] + b0, z1 = acc[ai][1][m][1] + b1; f32x4 o0, o1;
#pragma unroll
                    for (int e = 0; e < 4; ++e) { o0[e] = log_sigmoidf_(z0[e]); o1[e] = log_sigmoidf_(z1[e]); }
                    *(f32x4*)dst = o0; *(f32x4*)(dst + 4) = o1; }
        }
    }
};
struct BranchOrder {
    int G, c;
    __device__ __forceinline__ bool next(int i, pg8::Unit& u) const { const int L = i * G + c; if (L >= 4 * 544) return false; const int n = L / 544, t = L - n * 544; u.pm = n * 68 + (t >> 3); u.pn = n * 8 + (t & 7); return true; }
    __device__ __forceinline__ void a_ready(const pg8::Unit&) const {}
    __device__ __forceinline__ void done(const pg8::Unit&) const {}
};
struct EpiZ {
    static constexpr bool PERM = true, AFTER_DRAIN = false;
    bf16_t* Z;
    __device__ __forceinline__ void operator()(const f32x4 (&acc)[2][2][4][2], const pg8::Unit& u, int wr, int wc, int fr, int fq) const {
        const int row0 = u.pm * 256 + wr * 64 + fr, col0 = (u.pn & 7) * 256 + wc * 32 + 8 * fq;
#pragma unroll
        for (int ai = 0; ai < 2; ++ai)
#pragma unroll
            for (int m = 0; m < 4; ++m) { bf16_t* rowp = Z + (size_t)(row0 + ai * 128 + m * 16) * DM + col0;
#pragma unroll
                for (int bj = 0; bj < 2; ++bj) { const f32x4 v0 = acc[ai][bj][m][0], v1 = acc[ai][bj][m][1];
                    u32x4 w; w.x = cvt_pk_bf16(v0[0], v0[1]); w.y = cvt_pk_bf16(v0[2], v0[3]); w.z = cvt_pk_bf16(v1[0], v1[1]); w.w = cvt_pk_bf16(v1[2], v1[3]);
                    *(u32x4*)(rowp + bj * 128) = w; } }
    }
};
__device__ __forceinline__ void merge_pass(KP p, int gtid, int ngt) {
    const bf16_t* U = (const bf16_t*)(p->ws + WS_U); const bf16_t* Z = (const bf16_t*)(p->ws + WS_Z); bf16_t* M = (bf16_t*)(p->ws + WS_MERGED);
    for (int it0 = gtid; it0 < NTOK * 256; it0 += 2 * ngt) {
        u32x4 gv[2][4], zv[2][4];
#pragma unroll
        for (int k = 0; k < 2; ++k) { const int it = it0 + k * ngt < NTOK * 256 ? it0 + k * ngt : it0; const int row = it >> 8, col = (it & 255) * 8;
#pragma unroll
            for (int n = 0; n < 4; ++n) { gv[k][n] = *(const u32x4*)(U + (size_t)row * NU + U_G + n * 2048 + col); zv[k][n] = *(const u32x4*)(Z + ((size_t)n * NTOK + row) * DM + col); } }
#pragma unroll
        for (int k = 0; k < 2; ++k) { const int it = it0 + k * ngt; if (it < NTOK * 256) { const int row = it >> 8, col = (it & 255) * 8;
            float s[8];
#pragma unroll
            for (int e = 0; e < 8; ++e) s[e] = 0.f;
#pragma unroll
            for (int n = 0; n < 4; ++n) { const u32x4 g = gv[k][n], z = zv[k][n];
                s[0] += sigmoidf_(bflo(g.x)) * bflo(z.x); s[1] += sigmoidf_(bfhi(g.x)) * bfhi(z.x); s[2] += sigmoidf_(bflo(g.y)) * bflo(z.y); s[3] += sigmoidf_(bfhi(g.y)) * bfhi(z.y);
                s[4] += sigmoidf_(bflo(g.z)) * bflo(z.z); s[5] += sigmoidf_(bfhi(g.z)) * bfhi(z.z); s[6] += sigmoidf_(bflo(g.w)) * bflo(z.w); s[7] += sigmoidf_(bfhi(g.w)) * bfhi(z.w); }
            u32x4 w; w.x = cvt_pk_bf16(s[0], s[1]); w.y = cvt_pk_bf16(s[2], s[3]); w.z = cvt_pk_bf16(s[4], s[5]); w.w = cvt_pk_bf16(s[6], s[7]);
            *(u32x4*)(M + (size_t)row * DM + col) = w; } }
    }
}
struct EpiOut {
    static constexpr bool PERM = false, AFTER_DRAIN = false;
    const float* xp; const float* xs; const float* xb; const float* ada; float* xout; int l;
    __device__ __forceinline__ void operator()(const f32x4 (&acc)[2][2][4][2], const pg8::Unit& u, int wr, int wc, int fr, int fq) const {
        const int row0 = u.pm * 256 + wr * 64 + fr, col0 = u.pn * 256 + wc * 32 + 4 * fq;
#pragma unroll
        for (int ai = 0; ai < 2; ++ai)
#pragma unroll
            for (int m = 0; m < 4; ++m) { const int row = row0 + ai * 128 + m * 16;
                const float* base = l == 0 ? (row < TP ? xp + (size_t)row * DM : xs + (size_t)(row - TP) * DM) : xb + (size_t)row * DM;
                const int seq = row < TP ? 0 : 1 + ((row - TP) >> 5);
                const float* gate = ada + ((size_t)l * 33 + seq) * 6144 + 4096;
#pragma unroll
                for (int bj = 0; bj < 2; ++bj)
#pragma unroll
                    for (int n = 0; n < 2; ++n) { const int col = col0 + bj * 128 + n * 16;
                        *(f32x4*)(xout + (size_t)row * DM + col) = *(const f32x4*)(base + col) + *(const f32x4*)(gate + col) * acc[ai][bj][m][n]; } }
    }
};
constexpr int CGS = 516;
__device__ __forceinline__ void conv_unit(KP p, int l, int tile, LAS unsigned char* lds, int tid) {
    const bf16_t* U = (const bf16_t*)(p->ws + WS_U);
    const int c = tid, wave = tid >> 6, lane = tid & 63;
    const bool samp = tile >= 512; const int b = tile - 512, row0 = samp ? TP + b * 32 : tile * 32;
    const bool last = samp || tile == 511;
    LAS float* gl = (LAS float*)lds;
    LAS bf16_t* sgl = (LAS bf16_t*)(lds + 62 * CGS * 4);
    LAS float* red = (LAS float*)(lds + 62 * CGS * 4 + 32 * 512 * 2);
    LAS float* st = red + 8 * 32;
#pragma unroll
    for (int k = 0; k < 8; ++k) { const int task = tid + 512 * k; if (task < 62 * 64) { const int i = task >> 6, ch = task & 63; f32x4 o0, o1;
        const int rel = i - 30;
        if (rel < 0 && samp) { const float* hp = p->in[I_SCONV] + (((size_t)l * 32 + b) * 30 + i) * 512 + 8 * ch; o0 = *(const f32x4*)hp; o1 = *(const f32x4*)(hp + 4); }
        else if (row0 + rel < 0) { o0 = (f32x4){0.f, 0.f, 0.f, 0.f}; o1 = o0; }
        else { const bf16_t* up = U + (size_t)(row0 + rel) * NU + 8 * ch; const u32x4 v = *(const u32x4*)(up + U_AVAL), g = *(const u32x4*)(up + U_AGATE);
            o0 = (f32x4){bflo(v.x) * sigmoidf_(bflo(g.x)), bfhi(v.x) * sigmoidf_(bfhi(g.x)), bflo(v.y) * sigmoidf_(bflo(g.y)), bfhi(v.y) * sigmoidf_(bfhi(g.y))};
            o1 = (f32x4){bflo(v.z) * sigmoidf_(bflo(g.z)), bfhi(v.z) * sigmoidf_(bfhi(g.z)), bflo(v.w) * sigmoidf_(bflo(g.w)), bfhi(v.w) * sigmoidf_(bfhi(g.w))}; }
        *(LAS f32x4*)(gl + i * CGS + 8 * ch) = o0; *(LAS f32x4*)(gl + i * CGS + 8 * ch + 4) = o1; } }
#pragma unroll
    for (int k = 0; k < 4; ++k) { const int task = tid + 512 * k, t = task >> 6, ch = task & 63; const u32x4 s = *(const u32x4*)(U + (size_t)(row0 + t) * NU + U_ASG + 8 * ch);
        u32x4 w; w.x = cvt_pk_bf16(siluf_(bflo(s.x)), siluf_(bfhi(s.x))); w.y = cvt_pk_bf16(siluf_(bflo(s.y)), siluf_(bfhi(s.y))); w.z = cvt_pk_bf16(siluf_(bflo(s.z)), siluf_(bfhi(s.z))); w.w = cvt_pk_bf16(siluf_(bflo(s.w)), siluf_(bfhi(s.w)));
        *(LAS u32x4*)(sgl + t * 512 + 8 * ch) = w; }
    const float cb = p->in[I_CONVB][l * 512 + c], lg = p->in[I_CLNG][l * 512 + c], lb = p->in[I_CLNB][l * 512 + c];
    float wk[31];
#pragma unroll
    for (int k = 0; k < 31; ++k) wk[k] = p->in[I_CONVW][((size_t)l * 31 + k) * 512 + c];
    __syncthreads();
    if (last) {
        float* dst = samp ? p->out + O_SCONV + (((size_t)l * 32 + b) * 30) * 512 + c : p->out + O_PCONV + ((size_t)l * 30) * 512 + c;
#pragma unroll
        for (int t = 2; t < 32; ++t) dst[(size_t)(t - 2) * 512] = gl[(30 + t) * CGS + c];
    }
    bf16_t* oa = (bf16_t*)(p->ws + WS_OCAT);
#pragma unroll 1
    for (int half = 0; half < 2; ++half) {
        float z[46];
#pragma unroll
        for (int i = 0; i < 46; ++i) z[i] = gl[(16 * half + i) * CGS + c];
        float hv[16];
#pragma unroll
        for (int tt = 0; tt < 16; ++tt) hv[tt] = cb;
#pragma unroll
        for (int k = 0; k < 31; ++k) {
#pragma unroll
            for (int tt = 0; tt < 16; ++tt) hv[tt] += z[tt + k] * wk[k]; }
#pragma unroll
        for (int tt = 0; tt < 16; ++tt) { const float s1 = wave_sum(hv[tt]), s2 = wave_sum(hv[tt] * hv[tt]); if (lane == 0) { red[(wave * 16 + tt) * 2] = s1; red[(wave * 16 + tt) * 2 + 1] = s2; } }
        __syncthreads();
        if (tid < 16) { float s1 = 0.f, s2 = 0.f;
#pragma unroll
            for (int w = 0; w < 8; ++w) { s1 += red[(w * 16 + tid) * 2]; s2 += red[(w * 16 + tid) * 2 + 1]; }
            const float mean = s1 * (1.f / 512.f), var = fmaxf(s2 * (1.f / 512.f) - mean * mean, 0.f);
            st[tid * 2] = mean; st[tid * 2 + 1] = 1.f / sqrtf(var + 1e-5f); }
        __syncthreads();
#pragma unroll
        for (int tt = 0; tt < 16; ++tt) { const float y = (hv[tt] - st[tt * 2]) * st[tt * 2 + 1] * lg + lb; const int t = 16 * half + tt;
            oa[(size_t)(row0 + t) * 512 + c] = f2bf(siluf_(y) * bf2f(sgl[t * 512 + c])); }
    }
    __syncthreads();
}
__device__ __forceinline__ void pool_unit(KP p, int l, int tile, LAS unsigned char* lds, int tid) {
    const bf16_t* U = (const bf16_t*)(p->ws + WS_U);
    const int c = tid, wave = tid >> 6, lane = tid & 63;
    const bool samp = tile >= 512; const int b = tile - 512, row0 = samp ? TP + b * 32 : tile * 32;
    constexpr int PST = 520;
    LAS float* zl = (LAS float*)lds;
    LAS bf16_t* pl = (LAS bf16_t*)(lds + 47 * CGS * 4);
#pragma unroll
    for (int k = 0; k < 6; ++k) { const int task = tid + 512 * k; if (task < 47 * 64) { const int i = task >> 6, ch = task & 63; f32x4 o0, o1; const int rel = i - 15;
        if (rel < 0 && samp) { const float* hp = p->in[I_SPOOL] + (((size_t)l * 32 + b) * 15 + i) * 512 + 8 * ch; o0 = *(const f32x4*)hp; o1 = *(const f32x4*)(hp + 4); }
        else if (row0 + rel < 0) { o0 = (f32x4){0.f, 0.f, 0.f, 0.f}; o1 = o0; }
        else { const u32x4 v = *(const u32x4*)(U + (size_t)(row0 + rel) * NU + U_DIN + 8 * ch); o0 = (f32x4){bflo(v.x), bfhi(v.x), bflo(v.y), bfhi(v.y)}; o1 = (f32x4){bflo(v.z), bfhi(v.z), bflo(v.w), bfhi(v.w)}; }
        *(LAS f32x4*)(zl + i * CGS + 8 * ch) = o0; *(LAS f32x4*)(zl + i * CGS + 8 * ch + 4) = o1; } }
    u32x4 sgv[4];
#pragma unroll
    for (int k = 0; k < 4; ++k) { const int task = tid + 512 * k; sgv[k] = *(const u32x4*)(U + (size_t)(row0 + (task >> 6)) * NU + U_DSG + 8 * (task & 63)); }
    __syncthreads();
    {
        float z[47];
#pragma unroll
        for (int i = 0; i < 47; ++i) z[i] = zl[i * CGS + c];
        if (samp || tile == 511) {
            float* dst = samp ? p->out + O_SPOOL + (((size_t)l * 32 + b) * 15) * 512 + c : p->out + O_PPOOL + ((size_t)l * 15) * 512 + c;
#pragma unroll
            for (int t = 17; t < 32; ++t) dst[(size_t)(t - 17) * 512] = z[15 + t];
        }
        const int w = 2 << (c >> 7);
#pragma unroll
        for (int t = 0; t < 32; ++t) { float s = 0.f;
#pragma unroll
            for (int i = 0; i < 16; ++i) s += (i < w) ? z[15 + t - i] : 0.f;
            const int pos = samp ? PAST + t : row0 + t; const int cnt = (pos + 1 < w) ? pos + 1 : w;
            pl[t * PST + c] = f2bf(s / (float)cnt - z[15 + t]); }
    }
    __syncthreads();
    LAS bf16_t* sl = (LAS bf16_t*)lds;
    LAS bf16_t* ol = sl + 32 * PST;
#pragma unroll
    for (int k = 0; k < 4; ++k) { const int task = tid + 512 * k, t = task >> 6, ch = task & 63; const u32x4 s = sgv[k];
        u32x4 w; w.x = cvt_pk_bf16(siluf_(bflo(s.x)), siluf_(bfhi(s.x))); w.y = cvt_pk_bf16(siluf_(bflo(s.y)), siluf_(bfhi(s.y))); w.z = cvt_pk_bf16(siluf_(bflo(s.z)), siluf_(bfhi(s.z))); w.w = cvt_pk_bf16(siluf_(bflo(s.w)), siluf_(bfhi(s.w)));
        *(LAS u32x4*)(sl + t * PST + 8 * ch) = w; }
    __syncthreads();
    {
        const int g = wave >> 1, fr = lane & 15, kq = lane >> 4;
        const bf16_t* WT = (const bf16_t*)(p->ws + WS_POOLW) + (size_t)(l * 4 + g) * 128 * 128;
        f32x4 acc[2][4];
#pragma unroll
        for (int mt = 0; mt < 2; ++mt)
#pragma unroll
            for (int nt = 0; nt < 4; ++nt) acc[mt][nt] = (f32x4){0.f, 0.f, 0.f, 0.f};
#pragma unroll
        for (int ks = 0; ks < 4; ++ks) {
            bf16x8 af[2];
#pragma unroll
            for (int mt = 0; mt < 2; ++mt) af[mt] = *(const LAS bf16x8*)(pl + (16 * mt + fr) * PST + g * 128 + 32 * ks + 8 * kq);
#pragma unroll
            for (int nt = 0; nt < 4; ++nt) { const int dl = (wave & 1) * 64 + 16 * nt + fr;
                const bf16x8 bfr = *(const bf16x8*)(WT + (size_t)dl * 128 + 32 * ks + 8 * kq);
#pragma unroll
                for (int mt = 0; mt < 2; ++mt) acc[mt][nt] = __builtin_amdgcn_mfma_f32_16x16x32_bf16(af[mt], bfr, acc[mt][nt], 0, 0, 0); }
        }
#pragma unroll
        for (int nt = 0; nt < 4; ++nt) { const int d = wave * 64 + 16 * nt + fr; const float pb = p->in[I_POOLB][l * 512 + d], ps = p->in[I_POOLS][l * 512 + d];
#pragma unroll
            for (int mt = 0; mt < 2; ++mt)
#pragma unroll
                for (int r = 0; r < 4; ++r) { const int t = 16 * mt + 4 * kq + r; ol[t * PST + d] = f2bf((acc[mt][nt][r] + pb) * ps * bf2f(sl[t * PST + d])); } }
    }
    __syncthreads();
    bf16_t* od = (bf16_t*)(p->ws + WS_OCAT) + (size_t)3 * NTOK * 512;
#pragma unroll
    for (int k = 0; k < 4; ++k) { const int task = tid + 512 * k, t = task >> 6, ch = task & 63; *(u32x4*)(od + (size_t)(row0 + t) * 512 + 8 * ch) = *(const LAS u32x4*)(ol + t * PST + 8 * ch); }
    __syncthreads();
}
__device__ __forceinline__ void fp_unit(KP p, int l, int h, LAS unsigned char* lds, int tid) {
    const float* lf = p->out + O_PLF + (size_t)l * TP * 8 + h;
    LAS float* part = (LAS float*)lds;
    float v[32]; float s = 0.f;
#pragma unroll
    for (int i = 0; i < 32; ++i) { v[i] = lf[(size_t)(tid * 32 + i) * 8]; s += v[i]; }
    part[tid] = s;
    __syncthreads();
    float pre = 0.f;
    for (int j = 0; j < tid; ++j) pre += part[j];
    float* F = (float*)(p->ws + WS_FP) + (size_t)h * TP + tid * 32;
#pragma unroll
    for (int i = 0; i < 32; ++i) { pre += v[i]; F[i] = pre * LOG2E; }
    __syncthreads();
}
__device__ __forceinline__ void gs_unit(KP p, int l, int b, LAS unsigned char* lds, int tid) {
    const int h = tid & 7, ch = tid >> 3;
    const float* cl = p->in[I_CLF] + (((size_t)l * 32 + b) * PAST + ch * 64) * 8 + h;
    LAS float* part = (LAS float*)lds;
    float v[64]; float s = 0.f;
#pragma unroll
    for (int i = 0; i < 64; ++i) v[i] = cl[(size_t)i * 8];
#pragma unroll
    for (int i = 0; i < 64; ++i) s += v[i];
    part[ch * 8 + h] = s;
    __syncthreads();
    float suf = 0.f;
    for (int j = ch + 1; j < 64; ++j) suf += part[j * 8 + h];
    float* G = (float*)(p->ws + WS_GS) + ((size_t)b * 8 + h) * GS_LEN + ch * 64;
#pragma unroll
    for (int i = 63; i >= 0; --i) { G[i] = -suf * LOG2E; suf += v[i]; }
    if (tid < 8) { const float* nl = p->out + O_SLF + ((size_t)l * 1024 + b * 32) * 8 + tid; float* Gn = (float*)(p->ws + WS_GS) + ((size_t)b * 8 + tid) * GS_LEN + PAST; float w[32]; float run = 0.f;
#pragma unroll
        for (int i = 0; i < 32; ++i) w[i] = nl[i * 8];
#pragma unroll
        for (int i = 0; i < 32; ++i) { run += w[i]; Gn[i] = run * LOG2E; } }
    __syncthreads();
}
__device__ __forceinline__ void vt_tile(KP p, int l, int tile, LAS unsigned char* lds, int wave, int lane) {
    const int h = tile >> 8, tb = tile & 255;
    const bf16_t* U = (const bf16_t*)(p->ws + WS_U);
    LAS unsigned* scr = (LAS unsigned*)lds + wave * SLOT_F;
#pragma unroll 8
    for (int tt = 0; tt < 64; ++tt) scr[tt * 65 + lane] = U[(size_t)(tb * 64 + tt) * NU + U_V + h * 64 + lane];
    {
        float mx = 0.f;
#pragma unroll 8
        for (int tt = 0; tt < 64; ++tt) { const float kv = bf2f(U[(size_t)(tb * 64 + tt) * NU + U_K + h * 64 + lane]); mx = fmaxf(mx, wave_sum(kv * kv)); }
        if (lane == 0) atomicMax((unsigned*)(p->ws + WS_CTL) + CW_KMAX + l * 8 + h, __float_as_uint(mx));
    }
    bf16_t* Vt = (bf16_t*)(p->ws + WS_VT);
    const int t2 = (lane & 31) * 2, dh = lane >> 5;
#pragma unroll 8
    for (int it = 0; it < 32; ++it) { const int d = 2 * it + dh; *(unsigned*)(Vt + ((size_t)h * 64 + d) * TP + tb * 64 + t2) = scr[t2 * 65 + d] | (scr[(t2 + 1) * 65 + d] << 16); }
}
__device__ __forceinline__ void shift_out(KP p, int l, int tid) {
    const bf16_t* U = (const bf16_t*)(p->ws + WS_U);
    for (int base = tid; base < NSEQ * SHIFT_W; base += 512 * 8) {
        unsigned short v[8];
#pragma unroll
        for (int k = 0; k < 8; ++k) { const int idx = base + k * 512 < NSEQ * SHIFT_W ? base + k * 512 : tid; const int s = idx / SHIFT_W, j = idx - s * SHIFT_W; const int row = s == 0 ? TP - 1 : TP + (s - 1) * 32 + 31; v[k] = U[(size_t)row * NU + U_XC + j]; }
#pragma unroll
        for (int k = 0; k < 8; ++k) { const int idx = base + k * 512; if (idx < NSEQ * SHIFT_W) { const int s = idx / SHIFT_W, j = idx - s * SHIFT_W;
            float* dst = s == 0 ? p->out + O_PSHIFT + (size_t)l * SHIFT_W + j : p->out + O_SSHIFT + ((size_t)l * 32 + (s - 1)) * SHIFT_W + j; *dst = bf2f(v[k]); } }
    }
}
template <bool AT, bool BT, bool NEGA>
__device__ __forceinline__ void mm32(f32x16& acc, const LAS float* Ap, int i0, const LAS float* Bp, int j0, int lane) {
    const int li = lane & 31, kh = lane >> 5;
    const LAS float* ap = AT ? Ap + (8 * kh) * 65 + i0 + li : Ap + (i0 + li) * 65 + 8 * kh;
    const LAS float* bp = BT ? Bp + (j0 + li) * 65 + 8 * kh : Bp + (8 * kh) * 65 + j0 + li;
#pragma unroll 2
    for (int s = 0; s < 4; ++s) {
        float a[8], b[8];
#pragma unroll
        for (int e = 0; e < 8; ++e) { a[e] = AT ? ap[(16 * s + e) * 65] : ap[16 * s + e]; b[e] = BT ? bp[16 * s + e] : bp[(16 * s + e) * 65]; }
        if (NEGA) {
#pragma unroll
            for (int e = 0; e < 8; ++e) a[e] = -a[e]; }
        const bf16x8 af = pack8f((f32x4){a[0], a[1], a[2], a[3]}, (f32x4){a[4], a[5], a[6], a[7]}), bfg = pack8f((f32x4){b[0], b[1], b[2], b[3]}, (f32x4){b[4], b[5], b[6], b[7]});
        acc = __builtin_amdgcn_mfma_f32_32x32x16_bf16(af, bfg, acc, 0, 0, 0);
    }
}
template <int MASK>
__device__ __forceinline__ void st_tile(LAS float* dst, const f32x16& acc, int i0, int j0, int lane) {
    const int li = lane & 31, hi = lane >> 5, j = j0 + li;
#pragma unroll
    for (int r = 0; r < 16; ++r) { const int i = i0 + (r & 3) + 8 * (r >> 2) + 4 * hi; float v = acc[r];
        if (MASK == 1 && !(i < j)) v = 0.f; if (MASK == 2 && !(i <= j)) v = 0.f; dst[i * 65 + j] = v; }
}
struct RwkvSeqInfo { int row0, ntok, prev_kind  , b; };
__device__ __forceinline__ RwkvSeqInfo rwkv_info(int cu) { RwkvSeqInfo s; if (cu < 256) { s.row0 = cu * 64; s.ntok = 64; s.prev_kind = cu == 0 ? 0 : 1; s.b = 0; } else { s.b = cu - 256; s.row0 = TP + s.b * 32; s.ntok = 32; s.prev_kind = 2; } return s; }

__device__ __forceinline__ void rwkv_r1(KP p, int l, int unit, LAS unsigned char* lds, int tid) {
    const int cu = unit >> 3, h = unit & 7, wave = tid >> 6, lane = tid & 63, li = lane & 31, hi = lane >> 5;
    const RwkvSeqInfo si = rwkv_info(cu);
    const bf16_t* U = (const bf16_t*)(p->ws + WS_U);
    LAS float* S0 = (LAS float*)lds; LAS float *S1 = S0 + SLOT_F, *S2 = S0 + 2 * SLOT_F, *S3 = S0 + 3 * SLOT_F, *S4 = S0 + 4 * SLOT_F, *S5 = S0 + 5 * SLOT_F, *S6 = S0 + 6 * SLOT_F, *S7 = S0 + 7 * SLOT_F, *S8 = S0 + 8 * SLOT_F;
    LAS float* gC = S0 + 9 * SLOT_F;
    const int q = wave >> 2, wq = wave & 3, i0 = (wq >> 1) * 32, j0 = (wq & 1) * 32;
    PT0();
    {
        const int j = tid & 63, tq = tid >> 6;
        const int tl = lane >> 3, q8 = (lane & 7) * 8;
#pragma unroll
        for (int kb = 0; kb < 5; kb += 3) {
        u32x4 cur[5], prv[5];
#pragma unroll
        for (int k = kb; k < (kb + 3 < 5 ? kb + 3 : 5); ++k) { const int pid = wave * 5 + k, s = pid >> 3, tb = pid & 7, t = tb * 8 + tl;
            const int xo = (s < 3 ? s * 512 + h * 64 : 1536 + (s - 3) * 64) + q8;
            const int tc = t < si.ntok ? t : si.ntok - 1, tp = tc > 0 ? tc - 1 : (si.prev_kind == 1 ? -1 : 0);
            cur[k] = *(const u32x4*)(U + (size_t)(si.row0 + tc) * NU + U_XC + xo); prv[k] = *(const u32x4*)(U + (size_t)(si.row0 + tp) * NU + U_XC + xo); }
#pragma unroll
        for (int k = kb; k < (kb + 3 < 5 ? kb + 3 : 5); ++k) { const int pid = wave * 5 + k, s = pid >> 3, tb = pid & 7, t = tb * 8 + tl;
            const int xo = (s < 3 ? s * 512 + h * 64 : 1536 + (s - 3) * 64) + q8;
            LAS float* dst = (s == 0 ? S0 : s == 1 ? S1 : s == 2 ? S2 : s == 3 ? S3 : S4) + t * 65 + q8;
            const f32x4 m0 = *(const f32x4*)(p->in[I_MU] + l * SHIFT_W + xo), m1 = *(const f32x4*)(p->in[I_MU] + l * SHIFT_W + xo + 4);
            float x[8] = {bflo(cur[k].x), bfhi(cur[k].x), bflo(cur[k].y), bfhi(cur[k].y), bflo(cur[k].z), bfhi(cur[k].z), bflo(cur[k].w), bfhi(cur[k].w)};
            float pv[8] = {bflo(prv[k].x), bfhi(prv[k].x), bflo(prv[k].y), bfhi(prv[k].y), bflo(prv[k].z), bfhi(prv[k].z), bflo(prv[k].w), bfhi(prv[k].w)};
            if (t == 0 && si.prev_kind != 1) {
                if (si.prev_kind == 2) { const float* sp = p->in[I_SSHIFT] + ((size_t)l * 32 + si.b) * SHIFT_W + xo;
#pragma unroll
                    for (int e = 0; e < 8; ++e) pv[e] = sp[e]; }
                else {
#pragma unroll
                    for (int e = 0; e < 8; ++e) pv[e] = 0.f; } }
#pragma unroll
            for (int e = 0; e < 8; ++e) { const float mu = e < 4 ? m0[e] : m1[e - 4]; float xs = (t < si.ntok) ? x[e] + (pv[e] - x[e]) * mu : 0.f; if (s == 3) xs = fast_tanh(xs); dst[e] = xs; }
        }
        }
#pragma unroll
        for (int mm = 0; mm < 8; ++mm) { const int m = tq * 8 + mm;
            S5[m * 65 + j] = p->in[I_W2][((size_t)l * 64 + m) * 512 + h * 64 + j]; S6[m * 65 + j] = p->in[I_A2][((size_t)l * 64 + m) * 512 + h * 64 + j]; }
    }
    __syncthreads();
    PT1(1);
    {
        f32x16 acc = {};
        const int c = j0 + li;
        if (q == 0) { mm32<false, false, false>(acc, S3, i0, S5, j0, lane); const float w0 = p->in[I_W0][l * 512 + h * 64 + c];
#pragma unroll
            for (int r = 0; r < 16; ++r) { const int t = i0 + (r & 3) + 8 * (r >> 2) + 4 * hi; const float zz = acc[r] + w0;
                const float sp = fmaxf(-zz, 0.f) + __logf(1.f + __expf(-fabsf(zz)));
                S7[t * 65 + c] = (t < si.ntok) ? -__expf(-sp - 0.5f) : 0.f; } }
        else { mm32<false, false, false>(acc, S4, i0, S6, j0, lane); const float a0 = p->in[I_A0][l * 512 + h * 64 + c];
#pragma unroll
            for (int r = 0; r < 16; ++r) { const int t = i0 + (r & 3) + 8 * (r >> 2) + 4 * hi; S8[t * 65 + c] = __builtin_amdgcn_rcpf(1.f + __expf(-(acc[r] + a0))); } }
    }
    __syncthreads();
    PT1(2);
    if (wave == 0) { float run = 0.f;
#pragma unroll 8
        for (int t = 0; t < 64; ++t) { run += S7[t * 65 + lane]; S3[t * 65 + lane] = run; } }
    else { const int c = lane; const float kkw = p->in[I_KK][l * 512 + h * 64 + c], kaw = p->in[I_KA][l * 512 + h * 64 + c], rkw = p->in[I_RK][l * 512 + h * 64 + c];
        for (int t = wave - 1; t < 64; t += 7) { const float kr = S1[t * 65 + c], kv = kr * kkw; const float ss = wave_sum(kv * kv);
            const float kn = kv * (1.f / sqrtf(fmaxf(ss, 1e-24f))); const float a = S8[t * 65 + c]; const float km = kr * (1.f + (a - 1.f) * kaw);
            const float bon = wave_sum(S0[t * 65 + c] * km * rkw);
            S4[t * 65 + c] = kn; S1[t * 65 + c] = km; S8[t * 65 + c] = kn * a;
            if (lane == 0) ((float*)(p->ws + WS_BONUS))[(size_t)unit * 64 + t] = bon; } }
    __syncthreads();
    { const int c = tid & 63, tq = tid >> 6;
#pragma unroll
        for (int tt = 0; tt < 8; ++tt) { const int t = tq * 8 + tt, o = t * 65 + c; const float Lg = S3[o], lw = S7[o];
            const float g = __expf(Lg), gi = __expf(-Lg), gp = __expf(Lg - lw);
            S0[o] *= g; S1[o] *= gi; S8[o] *= gi; S4[o] *= gp; if (t == 63) gC[c] = g; } }
    __syncthreads();
    PT1(3);
    { f32x16 acc = {};
      if (q == 0) { mm32<false, true, false>(acc, S1, i0, S4, j0, lane); st_tile<1>(S3, acc, i0, j0, lane); }
      else { mm32<false, true, false>(acc, S8, i0, S4, j0, lane); st_tile<1>(S5, acc, i0, j0, lane); } }
    __syncthreads();
    { f32x16 acc = {};
      if (q == 0) { mm32<true, false, false>(acc, S2, i0, S3, j0, lane); st_tile<0>(S6, acc, i0, j0, lane); }
      else { mm32<false, true, false>(acc, S1, i0, S0, j0, lane); st_tile<2>(S7, acc, i0, j0, lane); } }
    __syncthreads();
    PT1(4);
    { float x[16]; const int r0 = (wave & 3) * 16;
      if (wave < 4) {
#pragma unroll
          for (int rr = 0; rr < 16; ++rr) x[rr] = S4[lane * 65 + r0 + rr]; }
      else {
#pragma unroll
          for (int rr = 0; rr < 16; ++rr) x[rr] = S6[(r0 + rr) * 65 + lane]; }
      __syncthreads();
#pragma unroll
      for (int sb = 0; sb < 4; ++sb) {
          float mreg[16];
#pragma unroll
          for (int s = 0; s < 16; ++s) mreg[s] = S5[(sb * 16 + (s < 15 || sb < 3 ? s : 14)) * 65 + lane];
          __builtin_amdgcn_sched_barrier(0);
#pragma unroll
          for (int s = 0; s < 16; ++s) { if (sb * 16 + s < 63) { const float mrow = mreg[s]; float xs[16];
#pragma unroll
              for (int rr = 0; rr < 16; ++rr) xs[rr] = __builtin_bit_cast(float, __builtin_amdgcn_readlane(__builtin_bit_cast(int, x[rr]), sb * 16 + s));
              __builtin_amdgcn_sched_barrier(0);
#pragma unroll
              for (int rr = 0; rr < 16; ++rr) x[rr] -= xs[rr] * mrow;
              __builtin_amdgcn_sched_barrier(0); } }
      }
      LAS float* dst = wave < 4 ? S3 : S6;
#pragma unroll
      for (int rr = 0; rr < 16; ++rr) dst[(r0 + rr) * 65 + lane] = x[rr]; }
    __syncthreads();
    PT1(5);
    { f32x16 acc = {};
      if (q == 1) { mm32<false, true, false>(acc, S8, i0, S0, j0, lane); st_tile<2>(S4, acc, i0, j0, lane); }
      else { mm32<false, false, false>(acc, S3, i0, S8, j0, lane);
          const int jc = j0 + li; const float gc = gC[jc]; float* TQ = (float*)(p->ws + WS_TQ) + (size_t)unit * 4096;
#pragma unroll
          for (int rg = 0; rg < 4; ++rg) { const int ab = i0 + 8 * rg + 4 * hi; f32x4 o;
#pragma unroll
              for (int e = 0; e < 4; ++e) o[e] = ((ab + e == jc) ? gc : 0.f) - acc[rg * 4 + e] * gc;
              *(f32x4*)(TQ + ((((jc >> 4) * 4 + (ab >> 4)) * 64 + ((ab & 15) >> 2) * 16 + (jc & 15)) * 4)) = o; } } }
    __syncthreads();
    { f32x16 acc = {};
      if (q == 0) { mm32<true, false, false>(acc, S2, i0, S1, j0, lane); mm32<false, false, true>(acc, S6, i0, S8, j0, lane);
          const int jc = j0 + li; const float gc = gC[jc]; float* GM = (float*)(p->ws + WS_GM) + (size_t)unit * 4096;
#pragma unroll
          for (int r = 0; r < 16; ++r) GM[(i0 + (r & 3) + 8 * (r >> 2) + 4 * hi) * 64 + jc] = acc[r] * gc; }
      else { mm32<true, false, false>(acc, S2, i0, S7, j0, lane); mm32<false, false, true>(acc, S6, i0, S4, j0, lane);
          float* Y0T = (float*)(p->ws + WS_Y0T) + (size_t)unit * 4096;
#pragma unroll
          for (int rg = 0; rg < 4; ++rg) *(f32x4*)(Y0T + (((((j0 >> 5) * 2 + (i0 >> 5)) * 4 + rg) * 2 + hi) * 32 + li) * 4) = (f32x4){acc[rg * 4], acc[rg * 4 + 1], acc[rg * 4 + 2], acc[rg * 4 + 3]}; } }
    if (q == 0) { f32x16 acc;
#pragma unroll
        for (int r = 0; r < 16; ++r) acc[r] = S0[(j0 + li) * 65 + i0 + (r & 3) + 8 * (r >> 2) + 4 * hi];
        mm32<false, false, true>(acc, S3, i0, S4, j0, lane);
        float* ET = (float*)(p->ws + WS_ET) + (size_t)unit * 4096;
#pragma unroll
        for (int rg = 0; rg < 4; ++rg) *(f32x4*)(ET + ((((j0 >> 5) * 2 + (i0 >> 5)) * 8 + 2 * rg + hi) * 32 + li) * 4) = (f32x4){acc[rg * 4], acc[rg * 4 + 1], acc[rg * 4 + 2], acc[rg * 4 + 3]}; }
    __syncthreads();
    PT1(6);
}
template <bool SCQ>
__device__ __forceinline__ void chain_run(f32x4 (&st)[4], const float* TQ, const float* GM, float* SC, int nsteps, int i, int g, int lane) {
    constexpr size_t STRIDE = (size_t)8 * 4096;
    f32x4 tq[16], gm[4];
#pragma unroll
    for (int x = 0; x < 16; ++x) tq[x] = *(const f32x4*)(TQ + (x * 64 + lane) * 4);
#pragma unroll
    for (int tl = 0; tl < 4; ++tl) gm[tl] = GM ? *(const f32x4*)(GM + i * 64 + 16 * tl + 4 * g) : (f32x4){0.f, 0.f, 0.f, 0.f};
    for (int c = 0; c < nsteps; ++c) {
        if (SC) {
            if (SCQ) {
#pragma unroll
                for (int tl = 0; tl < 4; ++tl) *(f32x4*)(SC + c * STRIDE + ((((i >> 5) * 2 + (tl >> 1)) * 8 + 4 * (tl & 1) + g) * 32 + (i & 31)) * 4) = st[tl]; }
            else {
#pragma unroll
                for (int tl = 0; tl < 4; ++tl) *(f32x4*)(SC + c * STRIDE + i * 64 + 16 * tl + 4 * g) = st[tl]; } }
        f32x4 tqn[16], gmn[4];
        const int cn = (c + 1 < nsteps) ? c + 1 : c;
#pragma unroll
        for (int x = 0; x < 16; ++x) tqn[x] = *(const f32x4*)(TQ + cn * STRIDE + (x * 64 + lane) * 4);
#pragma unroll
        for (int tl = 0; tl < 4; ++tl) gmn[tl] = GM ? *(const f32x4*)(GM + cn * STRIDE + i * 64 + 16 * tl + 4 * g) : (f32x4){0.f, 0.f, 0.f, 0.f};
        f32x4 acc[4];
#pragma unroll
        for (int tp = 0; tp < 4; ++tp) acc[tp] = gm[tp];
#pragma unroll
        for (int tl = 0; tl < 4; ++tl)
#pragma unroll
            for (int r = 0; r < 4; ++r)
#pragma unroll
                for (int tp = 0; tp < 4; ++tp) acc[tp] = __builtin_amdgcn_mfma_f32_16x16x4f32(tq[tp * 4 + tl][r], st[tl][r], acc[tp], 0, 0, 0);
#pragma unroll
        for (int tl = 0; tl < 4; ++tl) st[tl] = acc[tl];
#pragma unroll
        for (int x = 0; x < 16; ++x) tq[x] = tqn[x];
#pragma unroll
        for (int tl = 0; tl < 4; ++tl) gm[tl] = gmn[tl];
    }
}
__device__ __forceinline__ void rwkv_l1_task(KP p, int task, int lane) {
    const int iq = task & 3, kind = (task >> 2) & 1, h = (task >> 3) & 7, grp = task >> 6;
    const int fr = lane & 15, g = lane >> 4, i = iq * 16 + fr;
    const size_t u0 = ((size_t)(grp * 16) * 8 + h) * 4096;
    const float* TQ = (const float*)(p->ws + WS_TQ) + u0; const float* GM = (const float*)(p->ws + WS_GM) + u0;
    f32x4 st[4];
#pragma unroll
    for (int tl = 0; tl < 4; ++tl)
#pragma unroll
        for (int r = 0; r < 4; ++r) st[tl][r] = (kind == 1 && i == 16 * tl + 4 * g + r) ? 1.f : 0.f;
    chain_run<false>(st, TQ, kind == 0 ? GM : nullptr, nullptr, 16, i, g, lane);
    const size_t gb = ((size_t)grp * 8 + h) * 4096;
    if (kind == 0) { float* GG = (float*)(p->ws + WS_GG) + gb;
#pragma unroll
        for (int tl = 0; tl < 4; ++tl) *(f32x4*)(GG + i * 64 + 16 * tl + 4 * g) = st[tl]; }
    else { float* TG = (float*)(p->ws + WS_TG) + gb;
#pragma unroll
        for (int tl = 0; tl < 4; ++tl)
#pragma unroll
            for (int r = 0; r < 4; ++r) TG[((tl * 4 + iq) * 64 + (fr >> 2) * 16 + 4 * g + r) * 4 + (fr & 3)] = st[tl][r]; }
}
__device__ __forceinline__ void rwkv_l2_task(KP p, int l, int task, int lane) {
    const int iq = task & 3, h = task >> 2, fr = lane & 15, g = lane >> 4, i = iq * 16 + fr;
    f32x4 st[4];
#pragma unroll
    for (int tl = 0; tl < 4; ++tl) st[tl] = (f32x4){0.f, 0.f, 0.f, 0.f};
    chain_run<false>(st, (const float*)(p->ws + WS_TG) + (size_t)h * 4096, (const float*)(p->ws + WS_GG) + (size_t)h * 4096, (float*)(p->ws + WS_SG) + (size_t)h * 4096, 16, i, g, lane);
    float* dst = p->out + O_PWKV + (((size_t)l * 8 + h) * 64 + i) * 64;
#pragma unroll
    for (int tl = 0; tl < 4; ++tl) *(f32x4*)(dst + 16 * tl + 4 * g) = st[tl];
}
__device__ __forceinline__ void rwkv_l3_task(KP p, int l, int task, int lane) {
    const int fr = lane & 15, g = lane >> 4;
    f32x4 st[4];
    if (task < 512) { const int iq = task & 3, h = (task >> 2) & 7, grp = task >> 5, i = iq * 16 + fr;
        const float* s0 = (const float*)(p->ws + WS_SG) + ((size_t)grp * 8 + h) * 4096 + i * 64;
#pragma unroll
        for (int tl = 0; tl < 4; ++tl) st[tl] = *(const f32x4*)(s0 + 16 * tl + 4 * g);
        const size_t u0 = ((size_t)(grp * 16) * 8 + h) * 4096;
        chain_run<true>(st, (const float*)(p->ws + WS_TQ) + u0, (const float*)(p->ws + WS_GM) + u0, (float*)(p->ws + WS_SC) + u0, 16, i, g, lane); }
    else { const int t2 = task - 512, iq = t2 & 3, h = (t2 >> 2) & 7, b = t2 >> 5, i = iq * 16 + fr;
        const float* s0 = p->in[I_SWKV] + ((((size_t)l * 32 + b) * 8 + h) * 64 + i) * 64;
#pragma unroll
        for (int tl = 0; tl < 4; ++tl) st[tl] = *(const f32x4*)(s0 + 16 * tl + 4 * g);
        const size_t u0 = ((size_t)(256 + b) * 8 + h) * 4096;
        chain_run<true>(st, (const float*)(p->ws + WS_TQ) + u0, (const float*)(p->ws + WS_GM) + u0, (float*)(p->ws + WS_SC) + u0, 1, i, g, lane);
        float* dst = p->out + O_SWKV + ((((size_t)l * 32 + b) * 8 + h) * 64 + i) * 64;
#pragma unroll
        for (int tl = 0; tl < 4; ++tl) *(f32x4*)(dst + 16 * tl + 4 * g) = st[tl]; }
}
__device__ __forceinline__ void rwkv_r3_task(KP p, int l, int task, int lane) {
    const int unit = task >> 1, th = task & 1, cu = unit >> 3, h = unit & 7, li = lane & 31, hi = lane >> 5;
    const RwkvSeqInfo si = rwkv_info(cu);
    if (th * 32 >= si.ntok) return;
    const bf16_t* U = (const bf16_t*)(p->ws + WS_U);
    const size_t ub = (size_t)unit * 4096; const int t = th * 32 + li;
    const float* SC = (const float*)(p->ws + WS_SC) + ub; const float* ET = (const float*)(p->ws + WS_ET) + ub; const float* Y0T = (const float*)(p->ws + WS_Y0T) + ub;
    f32x16 acc[2];
#pragma unroll
    for (int ti = 0; ti < 2; ++ti)
#pragma unroll
        for (int rg = 0; rg < 4; ++rg) { const f32x4 y0 = *(const f32x4*)(Y0T + ((((th * 2 + ti) * 4 + rg) * 2 + hi) * 32 + li) * 4);
#pragma unroll
            for (int e = 0; e < 4; ++e) acc[ti][rg * 4 + e] = y0[e]; }
    f32x4 eb[8], sa0[8], sa1[8];
#pragma unroll
    for (int s4 = 0; s4 < 8; ++s4) { eb[s4] = *(const f32x4*)(ET + (((th * 2 + hi) * 8 + s4) * 32 + li) * 4); sa0[s4] = *(const f32x4*)(SC + (((0 * 2 + hi) * 8 + s4) * 32 + li) * 4); sa1[s4] = *(const f32x4*)(SC + (((1 * 2 + hi) * 8 + s4) * 32 + li) * 4); }
#pragma unroll
    for (int s4 = 0; s4 < 8; ++s4) {
#pragma unroll
        for (int e = 0; e < 4; ++e) { acc[0] = __builtin_amdgcn_mfma_f32_32x32x2f32(sa0[s4][e], eb[s4][e], acc[0], 0, 0, 0); acc[1] = __builtin_amdgcn_mfma_f32_32x32x2f32(sa1[s4][e], eb[s4][e], acc[1], 0, 0, 0); }
    }
    float s1 = 0.f;
#pragma unroll
    for (int ti = 0; ti < 2; ++ti)
#pragma unroll
        for (int r = 0; r < 16; ++r) s1 += acc[ti][r];
    s1 = xhalf_sum(s1); const float mean = s1 * (1.f / 64.f);
    float s2 = 0.f;
#pragma unroll
    for (int ti = 0; ti < 2; ++ti)
#pragma unroll
        for (int r = 0; r < 16; ++r) { const float d = acc[ti][r] - mean; s2 += d * d; }
    s2 = xhalf_sum(s2); const float rstd = 1.f / sqrtf(s2 * (1.f / 64.f) + 64e-5f);
    if (t >= si.ntok) return;
    const float bon = ((const float*)(p->ws + WS_BONUS))[(size_t)unit * 64 + t];
    const size_t row = (size_t)(si.row0 + t);
    bf16_t* oc = (bf16_t*)(p->ws + WS_OCAT) + (size_t)2 * NTOK * 512 + row * 512 + h * 64;
    u32x2 wout[2][4];
#pragma unroll
    for (int ti = 0; ti < 2; ++ti)
#pragma unroll
        for (int rg = 0; rg < 4; ++rg) { const int i = 32 * ti + 8 * rg + 4 * hi, c = h * 64 + i;
            const f32x4 gg = *(const f32x4*)(p->in[I_GNG] + l * 512 + c), gb = *(const f32x4*)(p->in[I_GNB] + l * 512 + c), mu = *(const f32x4*)(p->in[I_MU] + l * SHIFT_W + 1024 + c);
            const u32x2 vx = *(const u32x2*)(U + row * NU + U_XC + 1024 + c); const u32x2 sg = *(const u32x2*)(U + row * NU + U_CSG + c);
            f32x4 vc = (f32x4){bflo(vx.x), bfhi(vx.x), bflo(vx.y), bfhi(vx.y)}, vp;
            {
                const u32x2 px = *(const u32x2*)(U + (row > 0 ? row - 1 : 0) * NU + U_XC + 1024 + c); const f32x4 ss = *(const f32x4*)(p->in[I_SSHIFT] + ((size_t)l * 32 + si.b) * SHIFT_W + 1024 + c);
                const f32x4 up = (f32x4){bflo(px.x), bfhi(px.x), bflo(px.y), bfhi(px.y)};
                vp = (t > 0 || si.prev_kind == 1) ? up : (si.prev_kind == 2 ? ss : (f32x4){0.f, 0.f, 0.f, 0.f}); }
            const f32x4 vs = vc + (vp - vc) * mu;
            const f32x4 sgf = (f32x4){bflo(sg.x), bfhi(sg.x), bflo(sg.y), bfhi(sg.y)};
            f32x4 o;
#pragma unroll
            for (int e = 0; e < 4; ++e) o[e] = (((acc[ti][rg * 4 + e] - mean) * rstd) * gg[e] + gb[e] + bon * vs[e]) * siluf_(sgf[e]);
            wout[ti][rg].x = cvt_pk_bf16(o[0], o[1]); wout[ti][rg].y = cvt_pk_bf16(o[2], o[3]); }
#pragma unroll
    for (int ti = 0; ti < 2; ++ti)
#pragma unroll
        for (int rg = 0; rg < 4; ++rg) *(u32x2*)(oc + 32 * ti + 8 * rg + 4 * hi) = wout[ti][rg];
}
__device__ __forceinline__ int krow(int i) { return (i & 3) + 4 * ((i >> 3) & 1) + 8 * ((i >> 2) & 1) + 16 * (i >> 4); }
__device__ __forceinline__ bf16x8 pack8(const f32x16& v, int o) { u32x4 w; w.x = cvt_pk_bf16(v[o], v[o + 1]); w.y = cvt_pk_bf16(v[o + 2], v[o + 3]); w.z = cvt_pk_bf16(v[o + 4], v[o + 5]); w.w = cvt_pk_bf16(v[o + 6], v[o + 7]); return __builtin_bit_cast(bf16x8, w); }
constexpr float ATT_NEG = -1e30f;
template <bool HALF>
__device__ __forceinline__ void softmax_tile(f32x16& p0, f32x16& p1, float& m, float& lsum, f32x16 (&O)[2], bf16x8 (&pb)[4]) {
    float mx = p0[0];
#pragma unroll
    for (int r = 1; r < 16; ++r) mx = fmaxf(mx, p0[r]);
    if (!HALF) {
#pragma unroll
        for (int r = 0; r < 16; ++r) mx = fmaxf(mx, p1[r]); }
    mx = xhalf_max(mx);
    const float mn = fmaxf(m, mx), alpha = __builtin_amdgcn_exp2f(m - mn);
    m = mn;
    float s = 0.f;
#pragma unroll
    for (int r = 0; r < 16; ++r) { p0[r] = __builtin_amdgcn_exp2f(p0[r] - mn); s += p0[r]; }
    if (!HALF) {
#pragma unroll
        for (int r = 0; r < 16; ++r) { p1[r] = __builtin_amdgcn_exp2f(p1[r] - mn); s += p1[r]; } }
    lsum = lsum * alpha + s;
#pragma unroll
    for (int r = 0; r < 16; ++r) { O[0][r] *= alpha; O[1][r] *= alpha; }
    pb[0] = pack8(p0, 0); pb[1] = pack8(p0, 8);
    if (!HALF) { pb[2] = pack8(p1, 0); pb[3] = pack8(p1, 8); }
}
constexpr int AKS = 72;
constexpr int ATT_KB = 0, ATT_VB = 2 * 64 * AKS * 2, ATT_FB = 4 * 64 * AKS * 2, ATT_SC = ATT_FB + 2 * 64 * 4;
__device__ __forceinline__ void attn_prompt_unit(KP p, int l, int h, int qb, LAS unsigned char* lds, int tid) {
    const bf16_t* U = (const bf16_t*)(p->ws + WS_U); const bf16_t* Vt = (const bf16_t*)(p->ws + WS_VT) + (size_t)h * 64 * TP; const float* F = (const float*)(p->ws + WS_FP) + (size_t)h * TP;
    const int wave = tid >> 6, lane = tid & 63, li = lane & 31, hi = lane >> 5;
    const int q0 = qb * 256, q = q0 + wave * 32 + li;
    bf16x8 qf[4];
    { const float sc = 0.125f * LOG2E;
#pragma unroll
      for (int d0 = 0; d0 < 4; ++d0) { const u32x4 w = *(const u32x4*)(U + (size_t)q * NU + U_Q + h * 64 + 16 * d0 + 8 * hi);
          qf[d0] = pack8f((f32x4){bflo(w.x) * sc, bfhi(w.x) * sc, bflo(w.y) * sc, bfhi(w.y) * sc}, (f32x4){bflo(w.z) * sc, bfhi(w.z) * sc, bflo(w.w) * sc, bfhi(w.w) * sc}); } }
    const float fq = F[q];
    float m = ATT_NEG, lsum = 0.f; f32x16 O[2] = {};
    const int NT = (q0 + 256) / 64;
    LAS float* qmx = (LAS float*)(lds + ATT_SC); LAS float* mmv = qmx + 8;
    { float q2 = 0.f;
#pragma unroll
      for (int d0 = 0; d0 < 4; ++d0) { const u32x4 w = __builtin_bit_cast(u32x4, qf[d0]); q2 += bflo(w.x) * bflo(w.x) + bfhi(w.x) * bfhi(w.x) + bflo(w.y) * bflo(w.y) + bfhi(w.y) * bfhi(w.y) + bflo(w.z) * bflo(w.z) + bfhi(w.z) * bfhi(w.z) + bflo(w.w) * bflo(w.w) + bfhi(w.w) * bfhi(w.w); }
      q2 = wave_max(xhalf_sum(q2)); if (lane == 0) { qmx[wave] = q2; mmv[wave] = ATT_NEG; } }
    const float kmax2 = __uint_as_float(((const unsigned*)(p->ws + WS_CTL))[CW_KMAX + l * 8 + h]), fq0 = F[q0];
    const int srow = tid >> 3, sch = tid & 7;
    const bf16_t* kg = U + (size_t)srow * NU + U_K + h * 64 + 8 * sch; const bf16_t* vg = Vt + (size_t)srow * TP + 8 * sch;
    LAS unsigned char* kdst = lds + ATT_KB + (srow * AKS + 8 * sch) * 2; LAS unsigned char* vdst = lds + ATT_VB + (srow * AKS + 8 * sch) * 2;
    u32x4 kr = *(const u32x4*)(kg + (size_t)(NT - 1) * 64 * NU), vr = *(const u32x4*)(vg + (NT - 1) * 64); float fr = tid < 64 ? F[(NT - 1) * 64 + tid] : 0.f;
    *(LAS u32x4*)kdst = kr; *(LAS u32x4*)vdst = vr; if (tid < 64) ((LAS float*)(lds + ATT_FB))[tid] = fr;
    __syncthreads();
    const int ka = krow(li);
    float qkb; { float q2 = qmx[0];
#pragma unroll
      for (int w = 1; w < 8; ++w) q2 = fmaxf(q2, qmx[w]);
      qkb = 1.02f * sqrtf(q2 * kmax2) + fq0; }
    for (int t = NT - 1, buf = 0; t >= 0; --t, buf ^= 1) {
        { float mmin = mmv[0];
#pragma unroll
          for (int w = 1; w < 8; ++w) mmin = fminf(mmin, mmv[w]);
          if (qkb - ((const LAS float*)(lds + ATT_FB))[buf * 64 + 63] < mmin - 40.f) break; }
        if (t > 0) { kr = *(const u32x4*)(kg + (size_t)(t - 1) * 64 * NU); vr = *(const u32x4*)(vg + (t - 1) * 64); if (tid < 64) fr = F[(t - 1) * 64 + tid]; }
        if (64 * t <= q0 + wave * 32 + 31) {
            const LAS bf16_t* Kb = (const LAS bf16_t*)(lds + ATT_KB) + buf * 64 * AKS; const LAS bf16_t* Vb = (const LAS bf16_t*)(lds + ATT_VB) + buf * 64 * AKS; const LAS float* Fb = (const LAS float*)(lds + ATT_FB) + buf * 64;
            f32x16 p0, p1;
#pragma unroll
            for (int g2 = 0; g2 < 2; ++g2) { const f32x4 a = *(const LAS f32x4*)(Fb + 8 * hi + 16 * g2), b = *(const LAS f32x4*)(Fb + 8 * hi + 16 * g2 + 4), c = *(const LAS f32x4*)(Fb + 32 + 8 * hi + 16 * g2), d = *(const LAS f32x4*)(Fb + 32 + 8 * hi + 16 * g2 + 4);
#pragma unroll
                for (int e = 0; e < 4; ++e) { p0[8 * g2 + e] = fq - a[e]; p0[8 * g2 + 4 + e] = fq - b[e]; p1[8 * g2 + e] = fq - c[e]; p1[8 * g2 + 4 + e] = fq - d[e]; } }
#pragma unroll
            for (int d0 = 0; d0 < 4; ++d0) { const bf16x8 a0 = *(const LAS bf16x8*)(Kb + ka * AKS + 16 * d0 + 8 * hi), a1 = *(const LAS bf16x8*)(Kb + (ka + 32) * AKS + 16 * d0 + 8 * hi);
                p0 = __builtin_amdgcn_mfma_f32_32x32x16_bf16(a0, qf[d0], p0, 0, 0, 0); p1 = __builtin_amdgcn_mfma_f32_32x32x16_bf16(a1, qf[d0], p1, 0, 0, 0); }
            if (64 * t + 63 > q0 + wave * 32) {
#pragma unroll
                for (int r = 0; r < 16; ++r) { const int kv = 64 * t + 8 * hi + 16 * (r >> 3) + (r & 7); if (kv > q) p0[r] = -INFINITY; if (kv + 32 > q) p1[r] = -INFINITY; } }
            bf16x8 pb[4];
            softmax_tile<false>(p0, p1, m, lsum, O, pb);
#pragma unroll
            for (int dt = 0; dt < 2; ++dt)
#pragma unroll
                for (int s = 0; s < 4; ++s) { const bf16x8 a = *(const LAS bf16x8*)(Vb + (32 * dt + li) * AKS + 16 * (s & 1) + 32 * (s >> 1) + 8 * hi);
                    O[dt] = __builtin_amdgcn_mfma_f32_32x32x16_bf16(a, pb[s], O[dt], 0, 0, 0); }
        }
        { const float wm = wave_min(m); if (lane == 0) mmv[wave] = wm; }
        if (t > 0) { const int nb = buf ^ 1; *(LAS u32x4*)(kdst + nb * 64 * AKS * 2) = kr; *(LAS u32x4*)(vdst + nb * 64 * AKS * 2) = vr; if (tid < 64) ((LAS float*)(lds + ATT_FB))[nb * 64 + tid] = fr; }
        __syncthreads();
    }
    __syncthreads();
    const float inv = 1.f / xhalf_sum(lsum);
    bf16_t* ob = (bf16_t*)(p->ws + WS_OCAT) + (size_t)1 * NTOK * 512 + (size_t)q * 512 + h * 64;
    u32x2 sgv[2][4];
#pragma unroll
    for (int dt = 0; dt < 2; ++dt)
#pragma unroll
        for (int rg = 0; rg < 4; ++rg) sgv[dt][rg] = *(const u32x2*)(U + (size_t)q * NU + U_BSG + h * 64 + 32 * dt + 8 * rg + 4 * hi);
#pragma unroll
    for (int dt = 0; dt < 2; ++dt)
#pragma unroll
        for (int rg = 0; rg < 4; ++rg) { const int d = 32 * dt + 8 * rg + 4 * hi; const u32x2 sg = sgv[dt][rg];
            u32x2 w; w.x = cvt_pk_bf16(O[dt][rg * 4] * inv * siluf_(bflo(sg.x)), O[dt][rg * 4 + 1] * inv * siluf_(bfhi(sg.x))); w.y = cvt_pk_bf16(O[dt][rg * 4 + 2] * inv * siluf_(bflo(sg.y)), O[dt][rg * 4 + 3] * inv * siluf_(bfhi(sg.y)));
            *(u32x2*)(ob + d) = w; }
}
__device__ __forceinline__ void attn_sample_unit(KP p, int l, int b, int h, LAS unsigned char* lds, int tid) {
    const bf16_t* U = (const bf16_t*)(p->ws + WS_U);
    const int wave = tid >> 6, lane = tid & 63, li = lane & 31, hi = lane >> 5;
    const size_t qrow = (size_t)TP + b * 32 + li;
    const float* G = (const float*)(p->ws + WS_GS) + ((size_t)b * 8 + h) * GS_LEN;
    bf16x8 qf[4];
    { const float sc = 0.125f * LOG2E;
#pragma unroll
      for (int d0 = 0; d0 < 4; ++d0) { const u32x4 w = *(const u32x4*)(U + qrow * NU + U_Q + h * 64 + 16 * d0 + 8 * hi);
          qf[d0] = pack8f((f32x4){bflo(w.x) * sc, bfhi(w.x) * sc, bflo(w.y) * sc, bfhi(w.y) * sc}, (f32x4){bflo(w.z) * sc, bfhi(w.z) * sc, bflo(w.w) * sc, bfhi(w.w) * sc}); } }
    const float fq = G[PAST + li];
    float m = ATT_NEG, lsum = 0.f; f32x16 O[2] = {};
    const float* CK = p->in[I_CK] + (((size_t)l * 32 + b) * PAST) * 512 + h * 64; const float* CV = p->in[I_CV] + (((size_t)l * 32 + b) * PAST) * 512 + h * 64;
    const int ka = krow(li);
    for (int tt = 0; tt < 8; ++tt) {
        const int key0 = (wave * 8 + tt) * 64;
        f32x16 p0, p1;
#pragma unroll
        for (int g2 = 0; g2 < 2; ++g2) { const float* gp = G + key0 + 8 * hi + 16 * g2; const f32x4 a = *(const f32x4*)gp, bq = *(const f32x4*)(gp + 4), c = *(const f32x4*)(gp + 32), d = *(const f32x4*)(gp + 36);
#pragma unroll
            for (int e = 0; e < 4; ++e) { p0[8 * g2 + e] = fq - a[e]; p0[8 * g2 + 4 + e] = fq - bq[e]; p1[8 * g2 + e] = fq - c[e]; p1[8 * g2 + 4 + e] = fq - d[e]; } }
#pragma unroll
        for (int d0 = 0; d0 < 4; ++d0) { const float* k0p = CK + (size_t)(key0 + ka) * 512 + 16 * d0 + 8 * hi; const float* k1p = k0p + (size_t)32 * 512;
            const bf16x8 a0 = pack8f(*(const f32x4*)k0p, *(const f32x4*)(k0p + 4)), a1 = pack8f(*(const f32x4*)k1p, *(const f32x4*)(k1p + 4));
            p0 = __builtin_amdgcn_mfma_f32_32x32x16_bf16(a0, qf[d0], p0, 0, 0, 0); p1 = __builtin_amdgcn_mfma_f32_32x32x16_bf16(a1, qf[d0], p1, 0, 0, 0); }
        bf16x8 pb[4];
        softmax_tile<false>(p0, p1, m, lsum, O, pb);
#pragma unroll
        for (int dt = 0; dt < 2; ++dt)
#pragma unroll
            for (int s = 0; s < 4; ++s) { const float* vp = CV + (size_t)(key0 + 16 * (s & 1) + 32 * (s >> 1) + 8 * hi) * 512 + 32 * dt + li;
                const bf16x8 a = pack8f((f32x4){vp[0], vp[512], vp[1024], vp[1536]}, (f32x4){vp[2048], vp[2560], vp[3072], vp[3584]});
                O[dt] = __builtin_amdgcn_mfma_f32_32x32x16_bf16(a, pb[s], O[dt], 0, 0, 0); }
    }
    if (wave == 7) {
        f32x16 p0, p1 = {};
#pragma unroll
        for (int g2 = 0; g2 < 2; ++g2) { const float* gp = G + PAST + 8 * hi + 16 * g2; const f32x4 a = *(const f32x4*)gp, bq = *(const f32x4*)(gp + 4);
#pragma unroll
            for (int e = 0; e < 4; ++e) { p0[8 * g2 + e] = fq - a[e]; p0[8 * g2 + 4 + e] = fq - bq[e]; } }
#pragma unroll
        for (int d0 = 0; d0 < 4; ++d0) { const bf16x8 a0 = *(const bf16x8*)(U + ((size_t)TP + b * 32 + ka) * NU + U_K + h * 64 + 16 * d0 + 8 * hi);
            p0 = __builtin_amdgcn_mfma_f32_32x32x16_bf16(a0, qf[d0], p0, 0, 0, 0); }
#pragma unroll
        for (int r = 0; r < 16; ++r) { const int kv = 8 * hi + 16 * (r >> 3) + (r & 7); if (kv > li) p0[r] = -INFINITY; }
        bf16x8 pb[4];
        softmax_tile<true>(p0, p1, m, lsum, O, pb);
#pragma unroll
        for (int dt = 0; dt < 2; ++dt)
#pragma unroll
            for (int s = 0; s < 2; ++s) { const bf16_t* vp = U + ((size_t)TP + b * 32 + 16 * s + 8 * hi) * NU + U_V + h * 64 + 32 * dt + li; u32x4 w;
                w.x = (unsigned)vp[0] | ((unsigned)vp[NU] << 16); w.y = (unsigned)vp[2 * NU] | ((unsigned)vp[3 * NU] << 16); w.z = (unsigned)vp[4 * NU] | ((unsigned)vp[5 * NU] << 16); w.w = (unsigned)vp[6 * NU] | ((unsigned)vp[7 * NU] << 16);
                O[dt] = __builtin_amdgcn_mfma_f32_32x32x16_bf16(__builtin_bit_cast(bf16x8, w), pb[s], O[dt], 0, 0, 0); }
    }
    LAS float* Ow = (LAS float*)lds;
    LAS float* ML = Ow + 8 * 32 * 64;
    lsum = xhalf_sum(lsum);
#pragma unroll
    for (int dt = 0; dt < 2; ++dt)
#pragma unroll
        for (int r = 0; r < 16; ++r) Ow[(wave * 32 + dt * 16 + r) * 64 + lane] = O[dt][r];
    if (hi == 0) { ML[(wave * 2) * 32 + li] = m; ML[(wave * 2 + 1) * 32 + li] = lsum; }
    __syncthreads();
    { const int qq = tid & 31, dg = tid >> 5; float M = ATT_NEG;
#pragma unroll
      for (int w = 0; w < 8; ++w) M = fmaxf(M, ML[(w * 2) * 32 + qq]);
      float L = 0.f; f32x4 o = {0.f, 0.f, 0.f, 0.f};
      const int d = 4 * dg, idx0 = (d >> 5) * 16 + ((d >> 3) & 3) * 4, ln = ((d >> 2) & 1) * 32 + qq;
#pragma unroll
      for (int w = 0; w < 8; ++w) { const float f = __builtin_amdgcn_exp2f(ML[(w * 2) * 32 + qq] - M); L += ML[(w * 2 + 1) * 32 + qq] * f;
#pragma unroll
          for (int e = 0; e < 4; ++e) o[e] += Ow[(w * 32 + idx0 + e) * 64 + ln] * f; }
      const float inv = 1.f / L; const size_t row = (size_t)TP + b * 32 + qq;
      const u32x2 sg = *(const u32x2*)(U + row * NU + U_BSG + h * 64 + d);
      u32x2 wv; wv.x = cvt_pk_bf16(o[0] * inv * siluf_(bflo(sg.x)), o[1] * inv * siluf_(bfhi(sg.x))); wv.y = cvt_pk_bf16(o[2] * inv * siluf_(bflo(sg.y)), o[3] * inv * siluf_(bfhi(sg.y)));
      *(u32x2*)((bf16_t*)(p->ws + WS_OCAT) + (size_t)1 * NTOK * 512 + row * 512 + h * 64 + d) = wv; }
    __syncthreads();
}
constexpr int NPHASE = 22;
__global__ void __launch_bounds__(512, 2) hse_fwd(Params p_) {
    const KP kp = (KP)__builtin_amdgcn_kernarg_segment_ptr();
    (void)p_;
    extern __shared__ __attribute__((aligned(16))) unsigned char lds_raw[];
    LAS unsigned char* lds = (LAS unsigned char*)lds_raw;
    const int tid0 = threadIdx.x;
    const int wave0 = __builtin_amdgcn_readfirstlane(tid0 >> 6);
    const int G = gridDim.x, bid = blockIdx.x, ngw = G * 8;
#define PH_LOCALS const KP p = kp_fresh(kp); int tid = wave0 * 64 + (int)__builtin_amdgcn_mbcnt_hi(~0u, __builtin_amdgcn_mbcnt_lo(~0u, 0u)); asm volatile("" : "+v"(tid)); const int lane = tid & 63, wave = __builtin_amdgcn_readfirstlane(tid >> 6), gw = bid * 8 + wave; (void)lane; (void)gw; (void)p;
    if (tid0 < 4) ((LAS unsigned*)(lds + LDS_XB_OFF))[tid0] = 0u;
#if PROBE_ID
    if (tid0 == 0) *(LAS unsigned long long*)(lds + LDS_PROBE_OFF) = 0ull;
#endif
    __syncthreads();
    unsigned* ctl = (unsigned*)(kp->ws + WS_CTL);
    XcdBarrier bar = xcd_barrier_post(ctl + CW_BAR + kp->li * XCD_BAR_WORDS, (volatile LAS unsigned*)(lds + LDS_XB_OFF));
    const int lo = kp->ph_lo, hi = kp->ph_hi;
#define IN(k) (lo <= (k) && (k) < hi)
#ifndef DUP_MASK
#define DUP_MASK 0
#endif
#define NREP(k) (((DUP_MASK >> (k)) & 1) + 1)
#define SEAM(k) do { if (IN(k) && IN((k) + 1)) xcd_barrier(bar); } while (0)
    PT0();
    if (IN(0)) { PH_LOCALS
        for (int u = bid; u < 192; u += G) ada_unit(p, u, lds, tid);
        p0_weights(p, lds, gw, ngw, wave, lane);
    }
    SEAM(0);
    PT1(9);
    for (int l = 0; l < NLAYER; ++l) {
        const int pb = 1 + 10 * l;
        for (int rep = 0; rep < NREP(0); ++rep) { if (rep) xcd_barrier(bar);
        if (IN(pb)) { PH_LOCALS p1_rows(p, l, gw, ngw, lane); } }
        SEAM(pb);
        PT1(10);
        for (int rep = 0; rep < NREP(1); ++rep) { if (rep) xcd_barrier(bar);
        if (IN(pb + 1)) { PH_LOCALS
            pg8::Gemm g{(const bf16_t*)(p->ws + WS_H), (const bf16_t*)(p->ws + WS_WIN) + (size_t)l * NU * 2048, NTOK, NU, 2048};
            pg8::StaticOrder S; S.init(NTOK, NU, G, bid);
            EpiU E{(bf16_t*)(p->ws + WS_U), p->out, p->in[I_BF], l};
            pg8::gemm_phase<EpiU, pg8::StaticOrder>(lds, g, S, E, nullptr);
        }
        }
        SEAM(pb + 1);
        PT1(11);
        for (int rep = 0; rep < NREP(2); ++rep) { if (rep) xcd_barrier(bar);
        if (IN(pb + 2)) { PH_LOCALS
#ifndef DUP_SUB
#define DUP_SUB 0
#endif
            { PT0();
            for (int u = bid; u < NRU * ((DUP_SUB & 1) + 1); u += G) rwkv_r1(p, l, u % NRU, lds, tid);
            PT1(31);
            for (int u = bid; u < 544 * (((DUP_SUB >> 1) & 1) + 1); u += G) conv_unit(p, l, u % 544, lds, tid);
            PT1(32);
            for (int u = bid; u < 544 * (((DUP_SUB >> 2) & 1) + 1); u += G) pool_unit(p, l, u % 544, lds, tid);
            PT1(33);
            for (int u = bid; u < 256; u += G) { vt_tile(p, l, u * 8 + wave, lds, wave, lane); }
            __syncthreads();
            for (int u = bid; u < 32; u += G) gs_unit(p, l, u, lds, tid);
            for (int u = G - 1 - bid; u < 8; u += G) fp_unit(p, l, u, lds, tid);
            if (bid == G / 2) shift_out(p, l, tid);
            PT1(34); }
        }
        }
        SEAM(pb + 2);
        PT1(12);
        for (int rep = 0; rep < NREP(3); ++rep) { if (rep) xcd_barrier(bar);
        if (IN(pb + 3)) { PH_LOCALS
            if (wave < 4) for (int tk = bid * 4 + wave; tk < 1024; tk += G * 4) rwkv_l1_task(p, tk, lane);
            __syncthreads();
            LAS int* qslot = (LAS int*)(lds + LDS_XB_OFF - 16);
            for (;;) {
                if (tid == 0) *qslot = (int)atomicAdd(ctl + CW_QUEUE + 64 * (2 * l + 4 * rep), 1u);
                __syncthreads();
                const int item = *qslot;
                __syncthreads();
                if (item >= 512) break;
                attn_prompt_unit(p, l, item & 7, 63 - (item >> 3), lds, tid);
            }
            for (;;) {
                if (tid == 0) *qslot = (int)atomicAdd(ctl + CW_QUEUE + 64 * (2 * l + 1 + 4 * rep), 1u);
                __syncthreads();
                const int item = *qslot;
                __syncthreads();
                if (item >= 256) break;
                attn_sample_unit(p, l, item >> 3, item & 7, lds, tid);
            }
        }
        }
        SEAM(pb + 3);
        PT1(13);
        if (IN(pb + 4)) { PH_LOCALS if (wave == 0 && bid < 32) rwkv_l2_task(p, l, bid, lane); }
        SEAM(pb + 4);
        PT1(14);
        if (IN(pb + 5)) { PH_LOCALS for (int tk = (wave * G + bid); tk < 512 + 1024; tk += ngw) rwkv_l3_task(p, l, tk, lane); }
        SEAM(pb + 5);
        PT1(15);
        if (IN(pb + 6)) { PH_LOCALS for (int tk = gw; tk < NRU * 2; tk += ngw) rwkv_r3_task(p, l, tk, lane); }
        SEAM(pb + 6);
        PT1(16);
        for (int rep = 0; rep < NREP(7); ++rep) { if (rep) xcd_barrier(bar);
        if (IN(pb + 7)) { PH_LOCALS
            pg8::Gemm g{(const bf16_t*)(p->ws + WS_OCAT), (const bf16_t*)(p->ws + WS_WBR) + (size_t)l * 4 * 2048 * 512, 4 * NTOK, 4 * 2048, 512};
            BranchOrder S{G, bid};
            EpiZ E{(bf16_t*)(p->ws + WS_Z)};
            pg8::gemm_phase<EpiZ, BranchOrder>(lds, g, S, E, nullptr);
        }
        }
        SEAM(pb + 7);
        PT1(17);
        if (IN(pb + 8)) { PH_LOCALS merge_pass(p, bid * 512 + tid, G * 512); }
        SEAM(pb + 8);
        PT1(18);
        if (IN(pb + 9)) { PH_LOCALS
            pg8::Gemm g{(const bf16_t*)(p->ws + WS_MERGED), (const bf16_t*)(p->ws + WS_WOUT) + (size_t)l * 2048 * 2048, NTOK, 2048, 2048};
            pg8::StaticOrder S; S.init(NTOK, 2048, G, bid);
            EpiOut E{p->in[I_XP], p->in[I_XS], (const float*)(p->ws + WS_XBUF), (const float*)(p->ws + WS_ADA), (float*)(p->ws + WS_XBUF), l};
            pg8::gemm_phase<EpiOut, pg8::StaticOrder>(lds, g, S, E, nullptr);
        }
        SEAM(pb + 9);
        PT1(19);
    }
    if (IN(21)) { PH_LOCALS p_final_rows(p, gw, ngw, lane); }
    PT1(20);
#if PROBE_ID
    if (bid == 0 && tid0 == 0) { const unsigned long long w = *(LAS unsigned long long*)(lds + LDS_PROBE_OFF) * PROBE_K, t0 = __builtin_amdgcn_s_memrealtime(); while (__builtin_amdgcn_s_memrealtime() - t0 < w) __builtin_amdgcn_s_sleep(8); }
#endif
#undef IN
#undef SEAM
}
#ifndef MK_SPLIT
#define MK_SPLIT 0
#endif
extern "C" void kernel_launch(void* const* d_in, const int* in_sizes, int n_in, void* d_out, int out_size, void* d_ws, size_t ws_size, hipStream_t stream) {
    static int grid = 0;
    if (grid == 0) {
        if (n_in != N_IN || (size_t)out_size != O_END || ws_size < WS_END) { fprintf(stderr, "kernel_launch: unexpected shapes (n_in %d, out %d, ws %zu)\n", n_in, out_size, ws_size); grid = -1; return; }
        int dev = 0, cus = 0, per_cu = 0;
        if (hipGetDevice(&dev) != hipSuccess || hipDeviceGetAttribute(&cus, hipDeviceAttributeMultiprocessorCount, dev) != hipSuccess) { grid = -1; return; }
        if (hipFuncSetAttribute((const void*)hse_fwd, hipFuncAttributeMaxDynamicSharedMemorySize, LDS_BYTES) != hipSuccess) { fprintf(stderr, "kernel_launch: hipFuncSetAttribute failed\n"); grid = -1; return; }
        if (hipOccupancyMaxActiveBlocksPerMultiprocessor(&per_cu, (const void*)hse_fwd, 512, LDS_BYTES) != hipSuccess || per_cu < 1) fprintf(stderr, "kernel_launch: occupancy query reports %d\n", per_cu);
        (void)hipGetLastError();
        grid = cus;
    }
    if (grid < 0) return;
    if (hipMemsetAsync((char*)d_ws + WS_CTL, 0, CTL_BYTES, stream) != hipSuccess) return;
    Params a{};
    for (int i = 0; i < N_IN; ++i) a.in[i] = (const float*)d_in[i];
    a.out = (float*)d_out; a.ws = (unsigned char*)d_ws;
#if MK_SPLIT
    for (int ph = 0; ph < NPHASE; ++ph) { a.ph_lo = ph; a.ph_hi = ph + 1; a.li = ph; hipLaunchKernelGGL(hse_fwd, dim3(grid), dim3(512), LDS_BYTES, stream, a); }
#else
    a.ph_lo = 0; a.ph_hi = NPHASE; a.li = 0;
    hipLaunchKernelGGL(hse_fwd, dim3(grid), dim3(512), LDS_BYTES, stream, a);
#endif
    const hipError_t le = hipPeekAtLastError();
    if (le != hipSuccess) fprintf(stderr, "kernel_launch: launch failed: %s\n", hipGetErrorName(le));
}
```

```cpp
#include <hip/hip_runtime.h>
#include <cstdio>
#include <cstdint>
namespace pg8 {
#define PG8_LAS __attribute__((address_space(3)))
typedef unsigned short bf16_t;
typedef short bf16x8 __attribute__((ext_vector_type(8)));
typedef float f32x4 __attribute__((ext_vector_type(4)));
typedef unsigned u32x4 __attribute__((ext_vector_type(4)));
constexpr int BM = 256, BK = 64, HALF = 128, HTB = HALF * BK * 2  , STAGE_BYTES = 8 * HTB, NXCD = 8, WGM = 8;

__host__ __device__ __forceinline__ int lds_byte(int r, int c) { const int st = (r >> 4) * 2 + (c >> 5), rr = r & 15, cc = c & 31, ob = rr * 64 + cc * 2; return st * 1024 + (ob ^ (((ob >> 9) & 1) << 5)); }
__host__ __device__ __forceinline__ void stage_rc(int b, int& R, int& C) { const int st = b / 1024, sb = b % 1024, swz = sb ^ (((sb >> 9) & 1) << 5); R = (st >> 1) * 16 + swz / 64; C = (st & 1) * 32 + (swz % 64) / 2; }
__host__ __device__ __forceinline__ int perm32(int rho) { const int n = rho >> 4, i = rho & 15; return 8 * (i >> 2) + 4 * n + (i & 3); }

struct Unit { int pm, pn; };
struct Gemm { const bf16_t* A; const bf16_t* Bt; int M, N, K; };

struct StaticOrder {
    int nM, nN, nwg, G, c;
    __host__ __device__ void init(int M, int N, int G_, int c_) { nM = M / BM; nN = N / BM; nwg = nM * nN; G = G_; c = c_; }
    __host__ __device__ bool next(int i, Unit& u) const {
        const long L = (long)i * G + c; if (L >= nwg) return false;
        int wgid = (int)L; { const int q = nwg / NXCD, r = nwg % NXCD, xcd = wgid % NXCD, off = wgid / NXCD; wgid = (xcd < r ? xcd * (q + 1) : r * (q + 1) + (xcd - r) * q) + off; }
        const int nig = WGM * nN, gid = wgid / nig, fm = gid * WGM, gsz = (nM - fm) < WGM ? (nM - fm) : WGM;
        u.pm = fm + ((wgid % nig) % gsz); u.pn = (wgid % nig) / gsz; return true;
    }
    __device__ __forceinline__ void a_ready(const Unit&) const {}
    __device__ __forceinline__ void done(const Unit&) const {}
};
__device__ __forceinline__ unsigned cvt_pk_bf16(float lo, float hi) { unsigned r; asm volatile("v_cvt_pk_bf16_f32 %0, %1, %2" : "=v"(r) : "v"(lo), "v"(hi)); return r; }
typedef float f32x2 __attribute__((ext_vector_type(2)));
template <class Epi, class Sched, bool STAMP = false>
__device__ __forceinline__ void gemm_phase(PG8_LAS unsigned char* lds, const Gemm g, const Sched& S, const Epi& E, unsigned long long* stamps) {
    int tid = threadIdx.x; asm volatile("" : "+v"(tid));
    const int wid = __builtin_amdgcn_readfirstlane(tid >> 6), lane = tid & 63, wr = wid >> 2, wc = wid & 3, fr = lane & 15, fq = lane >> 4;
    const int K = g.K, nt = K / BK;
    int ts_lo = 0, ts_hi = 0, nts = 0; const unsigned long long rt_entry = STAMP ? (unsigned long long)wall_clock64() : 0ull;
#define PG8_STAMP() do { if (STAMP && wid == 0 && nts < 64) { const unsigned long long _c = (unsigned long long)clock64(); \
        ts_lo = (lane == nts) ? (int)(unsigned)_c : ts_lo; ts_hi = (lane == nts) ? (int)(unsigned)(_c >> 32) : ts_hi; ++nts; } } while (0)
    PG8_STAMP();
    unsigned voffA[2], voffB[2];
#pragma unroll
    for (int i = 0; i < 2; ++i) { int R, C; stage_rc(tid * 16 + i * 8192, R, C); const int Rb = Epi::PERM ? ((R & ~31) + perm32(R & 31)) : R;
        voffA[i] = (unsigned)(R * K + C) * 2u; voffB[i] = (unsigned)(Rb * K + C) * 2u; }
    const size_t kstep = (size_t)(BK * 2);
    const size_t hstep = (size_t)HALF * K * 2;
    const size_t tstep = 2 * hstep;
    const unsigned ldsw = (unsigned)wid * 1024u;
    const int aoff = lds_byte(wr * 64 + fr, fq * 8), boff = lds_byte(wc * 32 + fr, fq * 8);
#define PG8_SA(b, h) (((b) * 2 + (h)) * HTB)
#define PG8_SB(b, h) ((4 + (b) * 2 + (h)) * HTB)
#define PG8_STAGE(bufoff, gbase, voff) do { _Pragma("unroll") for (int _i = 0; _i < 2; ++_i) \
        __builtin_amdgcn_global_load_lds((const unsigned*)((const char*)(gbase) + (voff)[_i]), (PG8_LAS unsigned*)(lds + (bufoff) + ldsw + _i * 8192), 16, 0, 0); } while (0)
#define PG8_LDA(dst, b, h) do { _Pragma("unroll") for (int m = 0; m < 4; ++m) _Pragma("unroll") for (int k = 0; k < 2; ++k) dst[m][k] = *(const PG8_LAS bf16x8*)(lds + PG8_SA(b, h) + aoff + m * 2048 + k * 1024); } while (0)
#define PG8_LDB(dst, b, h) do { _Pragma("unroll") for (int n = 0; n < 2; ++n) _Pragma("unroll") for (int k = 0; k < 2; ++k) dst[n][k] = *(const PG8_LAS bf16x8*)(lds + PG8_SB(b, h) + boff + n * 2048 + k * 1024); } while (0)
#define PG8_MMA(ai, bj, At, Bt) do { __builtin_amdgcn_s_setprio(1); _Pragma("unroll") for (int m = 0; m < 4; ++m) _Pragma("unroll") for (int n = 0; n < 2; ++n) _Pragma("unroll") for (int k = 0; k < 2; ++k) \
        acc[ai][bj][m][n] = __builtin_amdgcn_mfma_f32_16x16x32_bf16(Bt[n][k], At[m][k], acc[ai][bj][m][n], 0, 0, 0); __builtin_amdgcn_s_setprio(0); } while (0)
#define PG8_WAIT_V(n) asm volatile("s_waitcnt vmcnt(" #n ")" ::: "memory")
#define PG8_WAIT_L(n) asm volatile("s_waitcnt lgkmcnt(" #n ")" ::: "memory")
#define PG8_BAR __builtin_amdgcn_s_barrier()
#define PG8_SCHED __builtin_amdgcn_sched_barrier(0)
    Unit cur, nxt; int ui = 0;
    if (!S.next(0, cur)) return;
    f32x4 acc[2][2][4][2];
#pragma unroll
    for (int a = 0; a < 2; ++a)
#pragma unroll
        for (int b = 0; b < 2; ++b)
#pragma unroll
            for (int m = 0; m < 4; ++m)
#pragma unroll
                for (int n = 0; n < 2; ++n) acc[a][b][m][n] = (f32x4){0.f, 0.f, 0.f, 0.f};
    bf16x8 At[4][2], B0[2][2], B1[2][2];
    const char* cA = (const char*)g.A + (size_t)cur.pm * tstep; const char* cB = (const char*)g.Bt + (size_t)cur.pn * tstep;
    S.a_ready(cur);
    PG8_STAGE(PG8_SB(0, 0), cB, voffB); PG8_STAGE(PG8_SA(0, 0), cA, voffA); PG8_STAGE(PG8_SB(0, 1), cB + hstep, voffB); PG8_STAGE(PG8_SA(0, 1), cA + hstep, voffA);
    if (wr == 1) PG8_BAR;
    PG8_WAIT_V(4); PG8_BAR;
    PG8_STAGE(PG8_SB(1, 0), cB + kstep, voffB); PG8_STAGE(PG8_SA(1, 0), cA + kstep, voffA); PG8_STAGE(PG8_SB(1, 1), cB + hstep + kstep, voffB);
    PG8_WAIT_V(6); PG8_BAR;
    PG8_STAMP();
    for (;;) {
        const bool has_next = S.next(ui + 1, nxt);
        const char* nA = has_next ? (const char*)g.A + (size_t)nxt.pm * tstep : cA; const char* nB = has_next ? (const char*)g.Bt + (size_t)nxt.pn * tstep : cB;
        for (int t = 0; t < nt; t += 2) {
            const bool last = (t == nt - 2);
            const char* a1 = cA + (size_t)(t + 1) * kstep;
            const char* a2 = last ? nA : cA + (size_t)(t + 2) * kstep; const char* b2 = last ? nB : cB + (size_t)(t + 2) * kstep;
            const char* a3 = a2 + kstep; const char* b3 = b2 + kstep;
            if (last && has_next) S.a_ready(nxt);
            PG8_LDB(B0, 0, 0); PG8_SCHED; PG8_LDA(At, 0, 0); PG8_STAGE(PG8_SA(1, 1), a1 + hstep, voffA);
            PG8_WAIT_L(8); PG8_BAR; PG8_WAIT_L(0); PG8_MMA(0, 0, At, B0); PG8_BAR; PG8_SCHED;
            PG8_LDB(B1, 0, 1); PG8_STAGE(PG8_SB(0, 0), b2, voffB);
            PG8_BAR; PG8_WAIT_L(0); PG8_MMA(0, 1, At, B1); PG8_BAR;
            PG8_LDA(At, 0, 1); PG8_STAGE(PG8_SA(0, 0), a2, voffA);
            PG8_BAR; PG8_WAIT_L(0); PG8_MMA(1, 0, At, B0); PG8_BAR; PG8_SCHED;
            PG8_STAGE(PG8_SB(0, 1), b2 + hstep, voffB);
            PG8_WAIT_V(6); PG8_BAR; PG8_MMA(1, 1, At, B1); PG8_BAR;
            PG8_LDB(B0, 1, 0); PG8_SCHED; PG8_LDA(At, 1, 0); PG8_STAGE(PG8_SA(0, 1), a2 + hstep, voffA);
            PG8_WAIT_L(8); PG8_BAR; PG8_WAIT_L(0); PG8_MMA(0, 0, At, B0); PG8_BAR; PG8_SCHED;
            PG8_LDB(B1, 1, 1); PG8_STAGE(PG8_SB(1, 0), b3, voffB);
            PG8_BAR; PG8_WAIT_L(0); PG8_MMA(0, 1, At, B1); PG8_BAR;
            PG8_LDA(At, 1, 1); PG8_STAGE(PG8_SA(1, 0), a3, voffA);
            PG8_BAR; PG8_WAIT_L(0); PG8_MMA(1, 0, At, B0); PG8_BAR; PG8_SCHED;
            PG8_STAGE(PG8_SB(1, 1), b3 + hstep, voffB);
            PG8_WAIT_V(6); PG8_BAR; PG8_MMA(1, 1, At, B1); PG8_BAR;
        }
        PG8_STAMP();
        if constexpr (!Epi::AFTER_DRAIN) { E(acc, cur, wr, wc, fr, fq); S.done(cur); }
        PG8_STAMP();
        if (!has_next) break;
#pragma unroll
        for (int a = 0; a < 2; ++a)
#pragma unroll
            for (int b = 0; b < 2; ++b)
#pragma unroll
                for (int m = 0; m < 4; ++m)
#pragma unroll
                    for (int n = 0; n < 2; ++n) acc[a][b][m][n] = (f32x4){0.f, 0.f, 0.f, 0.f};
        cur = nxt; cA = nA; cB = nB; ++ui;
    }
    PG8_WAIT_V(0);
    if (wr == 0) PG8_BAR;
    PG8_BAR;
    if constexpr (Epi::AFTER_DRAIN) { E.fused(acc, cur, wr, wc, fr, fq, lds, wid, lane); S.done(cur); }
    PG8_STAMP();
    if (STAMP && wid == 0) { stamps[lane] = lane < nts ? (((unsigned long long)(unsigned)ts_hi << 32) | (unsigned)ts_lo) : 0ull;
        if (lane == 62) stamps[62] = rt_entry; if (lane == 63) stamps[63] = (unsigned long long)wall_clock64(); }
#undef PG8_STAMP
#undef PG8_SA
#undef PG8_SB
#undef PG8_STAGE
#undef PG8_LDA
#undef PG8_LDB
#undef PG8_MMA
#undef PG8_WAIT_V
#undef PG8_WAIT_L
#undef PG8_BAR
#undef PG8_SCHED
}
}
#define XB_TMO      128
#define XB_XCNT(j)  (256  + 64 * (j))
#define XB_XSUB(j)  (1280 + 64 * (j))
#define XB_XGEN(j)  (2304 + 64 * (j))
#define XB_TOP      3328
#define XB_TOPGEN   3392
#define XCD_BAR_WORDS 3456
#define XB_SPIN_CAP (1u << 18)
#define LAS __attribute__((address_space(3)))

__device__ __forceinline__ unsigned xb_ld(unsigned* p)              { return __hip_atomic_load(p, __ATOMIC_RELAXED, __HIP_MEMORY_SCOPE_AGENT); }
__device__ __forceinline__ unsigned xb_add(unsigned* p, unsigned v) { return __hip_atomic_fetch_add(p, v, __ATOMIC_RELAXED, __HIP_MEMORY_SCOPE_AGENT); }
__device__ __forceinline__ unsigned xb_xcc_id() { return (unsigned)__builtin_amdgcn_s_getreg((3 << 11) | 20) & 0xFu; }
#define XB_SPIN(cond, bar) do { unsigned _sp = 0; while (cond) { __builtin_amdgcn_s_sleep(1); \
    if ((++_sp & 255u) == 0u) { if (xb_ld(&(bar)[XB_TMO])) break; if (_sp > XB_SPIN_CAP) { atomicAdd(&(bar)[XB_TMO], 1u); break; } } } } while (0)

struct XcdBarrier {
    unsigned* bar; unsigned x;
    volatile LAS unsigned* st;
};

__device__ __forceinline__ XcdBarrier xcd_barrier_post(unsigned* bar, volatile LAS unsigned* st) {
    XcdBarrier b; b.bar = bar; b.x = xb_xcc_id(); b.st = st;
    if (threadIdx.x == 0) (void)xb_add(&bar[XB_XCNT(b.x)], 1u);
    return b;
}
__device__ __forceinline__ void xcd_barrier_complete(unsigned* bar, unsigned x, unsigned& nloc, unsigned& nx) {
    const unsigned G = gridDim.x * gridDim.y * gridDim.z;
    unsigned sum, cnt, mine, sp = 0u;
    for (;;) {
        sum = 0u; cnt = 0u; mine = 0u;
#pragma unroll
        for (unsigned j = 0; j < 16; ++j) { const unsigned c = xb_ld(&bar[XB_XCNT(j)]); sum += c; cnt += (c > 0u) ? 1u : 0u; mine = (j == x) ? c : mine; }
        if (sum == G) break;
        __builtin_amdgcn_s_sleep(1);
        if ((++sp & 255u) == 0u) { if (xb_ld(&bar[XB_TMO])) break; if (sp > XB_SPIN_CAP) { atomicAdd(&bar[XB_TMO], 1u); break; } }
    }
    nloc = mine > 0u ? mine : 1u; nx = cnt > 0u ? cnt : 1u;
}

__device__ __forceinline__ void xcd_barrier(const XcdBarrier& b) {
    asm volatile("s_waitcnt vmcnt(0)" ::: "memory");
    __syncthreads();
    if (threadIdx.x == 0) {
        unsigned* bar = b.bar;
        __builtin_amdgcn_s_waitcnt(0);
        unsigned nloc = b.st[0], nx = b.st[1];
        if (nloc == 0u) { xcd_barrier_complete(bar, b.x, nloc, nx); b.st[0] = nloc; b.st[1] = nx; }
        const unsigned old = xb_add(&bar[XB_XSUB(b.x)], 1u);
        const unsigned gen = old / nloc;
        if (old + 1u == (gen + 1u) * nloc) {
            __builtin_amdgcn_fence(__ATOMIC_RELEASE, "agent");
            asm volatile("s_waitcnt vmcnt(0)" ::: "memory");
            const unsigned og = xb_add(&bar[XB_TOP], 1u);
            const unsigned tg = og / nx;
            if (og + 1u == (tg + 1u) * nx) xb_add(&bar[XB_TOPGEN], 1u);
            else XB_SPIN(xb_ld(&bar[XB_TOPGEN]) == tg, bar);
            __builtin_amdgcn_fence(__ATOMIC_ACQUIRE, "agent");
            xb_add(&bar[XB_XGEN(b.x)], 1u);
            asm volatile("s_waitcnt vmcnt(0)" ::: "memory");
        } else {
            XB_SPIN(xb_ld(&bar[XB_XGEN(b.x)]) == gen, bar);
            __builtin_amdgcn_fence(__ATOMIC_ACQUIRE, "agent");
            asm volatile("s_waitcnt vmcnt(0)" ::: "memory");
        }
    }
    __syncthreads();
}
typedef unsigned short bf16_t;
typedef short bf16x8 __attribute__((ext_vector_type(8)));
typedef float f32x4 __attribute__((ext_vector_type(4)));
typedef float f32x16 __attribute__((ext_vector_type(16)));
typedef unsigned u32x4 __attribute__((ext_vector_type(4)));
typedef unsigned u32x2 __attribute__((ext_vector_type(2)));
using pg8::cvt_pk_bf16;

constexpr int DM = 2048, TP = 16384, NSB = 32, TSQ = 32, NTOK = TP + NSB * TSQ, NSEQ = 33, PAST = 4096, NLAYER = 2;
constexpr int NU = 15104;
constexpr int U_AVAL = 0, U_AGATE = 512, U_ASG = 1024, U_Q = 1536, U_K = 2048, U_V = 2560, U_BSG = 3072, U_XC = 3584, U_CSG = 5248, U_DIN = 5760, U_DSG = 6272, U_G = 6784, U_F = 14976;
constexpr int IN_W = 14984, SHIFT_W = 1664;
constexpr float LOG2E = 1.4426950408889634f;
enum { I_XP = 0, I_XS, I_CK, I_CV, I_CLF, I_SCONV, I_SSHIFT, I_SWKV, I_SPOOL, I_CP, I_CS, I_NORMG, I_WADA, I_BADA, I_WIN, I_BF, I_CONVW, I_CONVB, I_CLNG, I_CLNB, I_MU, I_W0, I_W2, I_A0, I_A2,
       I_KK, I_KA, I_RK, I_GNG, I_GNB, I_POOLW, I_POOLB, I_POOLS, I_WBR, I_WOUT, I_FING, N_IN };
constexpr size_t O_YP = 0, O_YS = O_YP + (size_t)TP * DM, O_PK = O_YS + (size_t)1024 * DM, O_PV = O_PK + (size_t)2 * TP * 512, O_PLF = O_PV + (size_t)2 * TP * 512, O_PCONV = O_PLF + (size_t)2 * TP * 8,
                 O_PSHIFT = O_PCONV + 2 * 30 * 512, O_PWKV = O_PSHIFT + 2 * 1664, O_PPOOL = O_PWKV + 2 * 8 * 64 * 64, O_SK = O_PPOOL + 2 * 15 * 512, O_SV = O_SK + (size_t)2 * 1024 * 512,
                 O_SLF = O_SV + (size_t)2 * 1024 * 512, O_SCONV = O_SLF + 2 * 1024 * 8, O_SSHIFT = O_SCONV + (size_t)2 * 32 * 30 * 512, O_SWKV = O_SSHIFT + 2 * 32 * 1664,
                 O_SPOOL = O_SWKV + (size_t)2 * 32 * 8 * 64 * 64, O_END = O_SPOOL + (size_t)2 * 32 * 15 * 512;
static_assert(O_END == 75374848, "output size");
constexpr size_t al256(size_t x) { return (x + 255) & ~(size_t)255; }
constexpr int NCU_CH = 288, NRU = NCU_CH * 8;
constexpr size_t WS_CTL = 0, CTL_BYTES = 512 * 1024;
constexpr size_t WS_WIN = CTL_BYTES;
constexpr size_t WS_WBR = al256(WS_WIN + (size_t)2 * NU * 2048 * 2);
constexpr size_t WS_WOUT = al256(WS_WBR + (size_t)2 * 4 * 2048 * 512 * 2);
constexpr size_t WS_POOLW = al256(WS_WOUT + (size_t)2 * 2048 * 2048 * 2);
constexpr size_t WS_ADA = al256(WS_POOLW + (size_t)2 * 4 * 128 * 128 * 2);
constexpr size_t WS_H = al256(WS_ADA + (size_t)2 * 33 * 6144 * 4);
constexpr size_t WS_U = al256(WS_H + (size_t)NTOK * 2048 * 2);
constexpr size_t WS_XBUF = al256(WS_U + (size_t)NTOK * NU * 2);
constexpr size_t WS_OCAT = al256(WS_XBUF + (size_t)NTOK * 2048 * 4);
constexpr size_t WS_Z = al256(WS_OCAT + (size_t)4 * NTOK * 512 * 2);
constexpr size_t WS_MERGED = al256(WS_Z + (size_t)4 * NTOK * 2048 * 2);
constexpr size_t WS_FP = al256(WS_MERGED + (size_t)NTOK * 2048 * 2);
constexpr int GS_LEN = PAST + TSQ;
constexpr size_t WS_GS = al256(WS_FP + (size_t)8 * TP * 4);
constexpr size_t WS_VT = al256(WS_GS + (size_t)32 * 8 * GS_LEN * 4);
constexpr size_t WS_TQ = al256(WS_VT + (size_t)8 * 64 * TP * 2);
constexpr size_t WS_GM = al256(WS_TQ + (size_t)NRU * 4096 * 4);
constexpr size_t WS_ET = al256(WS_GM + (size_t)NRU * 4096 * 4);
constexpr size_t WS_Y0T = al256(WS_ET + (size_t)NRU * 4096 * 4);
constexpr size_t WS_SC = al256(WS_Y0T + (size_t)NRU * 4096 * 4);
constexpr size_t WS_BONUS = al256(WS_SC + (size_t)NRU * 4096 * 4);
constexpr size_t WS_GG = al256(WS_BONUS + (size_t)NRU * 64 * 4);
constexpr size_t WS_TG = al256(WS_GG + (size_t)16 * 8 * 4096 * 4);
constexpr size_t WS_SG = al256(WS_TG + (size_t)16 * 8 * 4096 * 4);
constexpr size_t WS_END = al256(WS_SG + (size_t)16 * 8 * 4096 * 4);
static_assert(WS_END < (size_t)2100 * 1024 * 1024, "workspace map exceeds the guaranteed d_ws size");
constexpr int CW_BAR = 0;
constexpr int CW_QUEUE = 16 * 3456 + 64;
constexpr int CW_KMAX = CW_QUEUE + 64 * 8;
static_assert((CW_KMAX + 64) * 4 <= (int)CTL_BYTES, "ctl");
constexpr int LDS_BYTES = 163840 - 256;
constexpr int LDS_XB_OFF = LDS_BYTES - 16;
constexpr int SLOT_F = 64 * 65;

#ifndef PROBE_ID
#define PROBE_ID 0
#endif
#ifndef PROBE_K
#define PROBE_K 1
#endif
constexpr int LDS_PROBE_OFF = 163840 - 256 - 64;
#if PROBE_ID
#define PT0() unsigned long long _pt0 = (blockIdx.x == 0 && threadIdx.x == 0) ? __builtin_amdgcn_s_memrealtime() : 0ull
#define PT1(id) do { if ((id) == PROBE_ID && blockIdx.x == 0 && threadIdx.x == 0) { *(LAS unsigned long long*)(lds + LDS_PROBE_OFF) += __builtin_amdgcn_s_memrealtime() - _pt0; } _pt0 = (blockIdx.x == 0 && threadIdx.x == 0) ? __builtin_amdgcn_s_memrealtime() : 0ull; } while (0)
#else
#define PT0() do {} while (0)
#define PT1(id) do {} while (0)
#endif
struct Params { const float* in[N_IN]; float* out; unsigned char* ws; int ph_lo, ph_hi, li, pad; };
typedef const __attribute__((address_space(4))) Params* KP;
__device__ __forceinline__ KP kp_fresh(KP k) { asm volatile("" : "+s"(k)); return k; }

__device__ __forceinline__ float bf2f(unsigned short b) { return __uint_as_float(((unsigned)b) << 16); }
__device__ __forceinline__ float bflo(unsigned w) { return __uint_as_float(w << 16); }
__device__ __forceinline__ float bfhi(unsigned w) { return __uint_as_float(w & 0xffff0000u); }
__device__ __forceinline__ unsigned short f2bf(float f) { return (unsigned short)(cvt_pk_bf16(f, 0.f) & 0xffffu); }
__device__ __forceinline__ float sigmoidf_(float x) { return 1.f / (1.f + __expf(-x)); }
__device__ __forceinline__ float siluf_(float x) { return x / (1.f + __expf(-x)); }
__device__ __forceinline__ float log_sigmoidf_(float z) { return fminf(z, 0.f) - log1pf(expf(-fabsf(z))); }
template <int CTRL> __device__ __forceinline__ float dpp_mov(float v) { return __int_as_float(__builtin_amdgcn_update_dpp(0, __float_as_int(v), CTRL, 0xF, 0xF, true)); }
__device__ __forceinline__ float wave_sum(float v) {
    v += dpp_mov<0xB1>(v); v += dpp_mov<0x4E>(v); v += dpp_mov<0x141>(v); v += dpp_mov<0x140>(v);
    const float r0 = __int_as_float(__builtin_amdgcn_readlane(__float_as_int(v), 0)), r1 = __int_as_float(__builtin_amdgcn_readlane(__float_as_int(v), 16));
    const float r2 = __int_as_float(__builtin_amdgcn_readlane(__float_as_int(v), 32)), r3 = __int_as_float(__builtin_amdgcn_readlane(__float_as_int(v), 48));
    return (r0 + r1) + (r2 + r3);
}
__device__ __forceinline__ float wave_max(float v) {
    v = fmaxf(v, dpp_mov<0xB1>(v)); v = fmaxf(v, dpp_mov<0x4E>(v)); v = fmaxf(v, dpp_mov<0x141>(v)); v = fmaxf(v, dpp_mov<0x140>(v));
    const float r0 = __int_as_float(__builtin_amdgcn_readlane(__float_as_int(v), 0)), r1 = __int_as_float(__builtin_amdgcn_readlane(__float_as_int(v), 16));
    const float r2 = __int_as_float(__builtin_amdgcn_readlane(__float_as_int(v), 32)), r3 = __int_as_float(__builtin_amdgcn_readlane(__float_as_int(v), 48));
    return fmaxf(fmaxf(r0, r1), fmaxf(r2, r3));
}
__device__ __forceinline__ float wave_min(float v) { return -wave_max(-v); }
__device__ __forceinline__ float xhalf_max(float m) { const auto rr = __builtin_amdgcn_permlane32_swap(__float_as_uint(m), __float_as_uint(m), false, false); return fmaxf(__uint_as_float(rr[0]), __uint_as_float(rr[1])); }
__device__ __forceinline__ float xhalf_sum(float m) { const auto rr = __builtin_amdgcn_permlane32_swap(__float_as_uint(m), __float_as_uint(m), false, false); return __uint_as_float(rr[0]) + __uint_as_float(rr[1]); }
__device__ __forceinline__ bf16x8 pack8f(const f32x4 a, const f32x4 b) { u32x4 w; w.x = cvt_pk_bf16(a[0], a[1]); w.y = cvt_pk_bf16(a[2], a[3]); w.z = cvt_pk_bf16(b[0], b[1]); w.w = cvt_pk_bf16(b[2], b[3]); return __builtin_bit_cast(bf16x8, w); }
__device__ __forceinline__ float fast_tanh(float x) { const float e = __expf(-2.f * fabsf(x)); const float t = (1.f - e) * __builtin_amdgcn_rcpf(1.f + e); return x < 0.f ? -t : t; }
__device__ __forceinline__ void tr_tile(const float* __restrict__ src, size_t ld, int k0, int c0, int nvalid, bf16_t* __restrict__ dst, int K, LAS float* scr, int lane) {
    float tv[64];
#pragma unroll
    for (int kk = 0; kk < 64; ++kk) tv[kk] = src[(size_t)(k0 + kk) * ld + c0 + (lane < nvalid ? lane : 0)];
#pragma unroll
    for (int kk = 0; kk < 64; ++kk) scr[kk * 65 + lane] = (lane < nvalid) ? tv[kk] : 0.f;
    const int k2 = (lane & 31) * 2, nh = lane >> 5;
#pragma unroll 8
    for (int it = 0; it < 32; ++it) { const int nn = 2 * it + nh; *(unsigned*)(dst + (size_t)nn * K + k0 + k2) = cvt_pk_bf16(scr[k2 * 65 + nn], scr[(k2 + 1) * 65 + nn]); }
}
__device__ __forceinline__ void p0_weights(KP p, LAS unsigned char* lds, int gw, int ngw, int wave, int lane) {
    LAS float* scr = (LAS float*)lds + wave * SLOT_F;
    constexpr int T_WIN = (NU / 64) * 32, T_WBR = 4 * 32 * 8, T_WOUT = 32 * 32, T_POOL = 4 * 2 * 2, T_L = T_WIN + T_WBR + T_WOUT + T_POOL;
    for (int it = gw; it < 2 * T_L; it += ngw) {
        const int l = it / T_L; int r = it % T_L;
        if (r < T_WIN) {
            const int nt = r / 32, kt = r % 32, m0 = nt * 64;
            int c0, nvalid = 64;
            if (m0 < 3072) c0 = m0; else if (m0 < U_F) c0 = m0 + 8; else if (m0 == U_F) { c0 = 3072; nvalid = 8; } else { c0 = 0; nvalid = 0; }
            tr_tile(p->in[I_WIN] + (size_t)l * 2048 * IN_W, IN_W, kt * 64, c0, nvalid, (bf16_t*)(p->ws + WS_WIN) + ((size_t)l * NU + m0) * 2048, 2048, scr, lane);
            continue; }
        r -= T_WIN;
        if (r < T_WBR) {
            const int n = r / 256, q = r % 256, nt = q / 8, kt = q % 8;
            tr_tile(p->in[I_WBR] + ((size_t)(l * 4 + n) * 512) * 2048, 2048, kt * 64, nt * 64, 64, (bf16_t*)(p->ws + WS_WBR) + ((size_t)(l * 4 + n) * 2048 + nt * 64) * 512, 512, scr, lane);
            continue; }
        r -= T_WBR;
        if (r < T_WOUT) {
            const int nt = r / 32, kt = r % 32;
            tr_tile(p->in[I_WOUT] + (size_t)l * 2048 * 2048, 2048, kt * 64, nt * 64, 64, (bf16_t*)(p->ws + WS_WOUT) + ((size_t)l * 2048 + nt * 64) * 2048, 2048, scr, lane);
            continue; }
        r -= T_WOUT;
        {
            const int g = r / 4, q = r % 4, nt = q / 2, kt = q % 2;
            tr_tile(p->in[I_POOLW] + (size_t)(l * 4 + g) * 128 * 128, 128, kt * 64, nt * 64, 64, (bf16_t*)(p->ws + WS_POOLW) + ((size_t)(l * 4 + g) * 128 + nt * 64) * 128, 128, scr, lane);
        }
    }
}
__device__ __forceinline__ void ada_unit(KP p, int unit, LAS unsigned char* lds, int tid) {
    const int wave = tid >> 6, lane = tid & 63, l = unit / 96, n0 = (unit % 96) * 64;
    LAS float* cs = (LAS float*)lds + wave * (33 * 64);
    LAS float* red = (LAS float*)lds + 8 * 33 * 64;
    const float* W = p->in[I_WADA] + (size_t)l * 2048 * 6144;
    const float* cp = p->in[I_CP]; const float* csm = p->in[I_CS];
    float acc[33];
#pragma unroll
    for (int s = 0; s < 33; ++s) acc[s] = 0.f;
    float wv[16];
#pragma unroll
    for (int j = 0; j < 16; ++j) wv[j] = W[(size_t)(wave * 256 + j) * 6144 + n0 + lane];
#pragma unroll 1
    for (int step = 0; step < 16; ++step) {
        const int k0 = wave * 256 + step * 16, kn = wave * 256 + (step < 15 ? step + 1 : step) * 16;
        float wn[16];
#pragma unroll
        for (int j = 0; j < 16; ++j) wn[j] = W[(size_t)(kn + j) * 6144 + n0 + lane];
        if ((step & 3) == 0) {
#pragma unroll
            for (int s = 0; s < 33; ++s) { const float c = (s == 0) ? cp[k0 + lane] : csm[(size_t)(s - 1) * 2048 + k0 + lane]; cs[s * 64 + lane] = siluf_(c); } }
        const int kk0 = (step & 3) * 16;
#pragma unroll
        for (int q4 = 0; q4 < 4; ++q4) {
#pragma unroll
            for (int s = 0; s < 33; ++s) { const f32x4 c4 = *(const LAS f32x4*)(cs + s * 64 + kk0 + 4 * q4); acc[s] += c4.x * wv[4 * q4] + c4.y * wv[4 * q4 + 1] + c4.z * wv[4 * q4 + 2] + c4.w * wv[4 * q4 + 3]; } }
#pragma unroll
        for (int j = 0; j < 16; ++j) wv[j] = wn[j];
    }
#pragma unroll
    for (int s = 0; s < 33; ++s) red[(wave * 33 + s) * 64 + lane] = acc[s];
    __syncthreads();
    for (int idx = tid; idx < 33 * 64; idx += 512) { const int s = idx >> 6, n = idx & 63; float v = p->in[I_BADA][l * 6144 + n0 + n];
#pragma unroll
        for (int w = 0; w < 8; ++w) v += red[(w * 33 + s) * 64 + n];
        ((float*)(p->ws + WS_ADA))[((size_t)l * 33 + s) * 6144 + n0 + n] = v; }
    __syncthreads();
}
__device__ __forceinline__ const float* x_row(KP p, int l, int row) {
    return l == 0 ? (row < TP ? p->in[I_XP] + (size_t)row * DM : p->in[I_XS] + (size_t)(row - TP) * DM) : (const float*)(p->ws + WS_XBUF) + (size_t)row * DM;
}
__device__ __forceinline__ void p1_rows(KP p, int l, int gw, int ngw, int lane) {
    const f32x4* g4 = (const f32x4*)(p->in[I_NORMG] + l * DM) + lane;
    f32x4 a[8], sh[8]; int cur_seq = -1;
    for (int row = gw; row < NTOK; row += ngw) {
        const f32x4* x4 = (const f32x4*)x_row(p, l, row) + lane;
        const int seq = row < TP ? 0 : 1 + ((row - TP) >> 5);
        f32x4 v[8]; float ss = 0.f;
#pragma unroll
        for (int j = 0; j < 8; ++j) { v[j] = x4[64 * j]; ss += (v[j].x * v[j].x + v[j].y * v[j].y) + (v[j].z * v[j].z + v[j].w * v[j].w); }
        if (seq != cur_seq) { cur_seq = seq;
            const f32x4* sh4 = (const f32x4*)((const float*)(p->ws + WS_ADA) + ((size_t)l * 33 + seq) * 6144) + lane; const f32x4* sc4 = sh4 + 512;
#pragma unroll
            for (int j = 0; j < 8; ++j) { a[j] = g4[64 * j] * (sc4[64 * j] + 1.f); sh[j] = sh4[64 * j]; } }
        const float rstd = 1.f / sqrtf(wave_sum(ss) * (1.f / DM) + 1e-6f);
        u32x2* o = (u32x2*)((bf16_t*)(p->ws + WS_H) + (size_t)row * DM) + lane;
#pragma unroll
        for (int j = 0; j < 8; ++j) { const f32x4 y = v[j] * rstd * a[j] + sh[j];
            u32x2 w; w.x = cvt_pk_bf16(y.x, y.y); w.y = cvt_pk_bf16(y.z, y.w); o[64 * j] = w; }
    }
}
__device__ __forceinline__ void p_final_rows(KP p, int gw, int ngw, int lane) {
    const f32x4* g4 = (const f32x4*)p->in[I_FING] + lane;
    for (int row = gw; row < NTOK; row += ngw) {
        const f32x4* x4 = (const f32x4*)((const float*)(p->ws + WS_XBUF) + (size_t)row * DM) + lane;
        f32x4 v[8]; float ss = 0.f;
#pragma unroll
        for (int j = 0; j < 8; ++j) { v[j] = x4[64 * j]; ss += (v[j].x * v[j].x + v[j].y * v[j].y) + (v[j].z * v[j].z + v[j].w * v[j].w); }
        const float rstd = 1.f / sqrtf(wave_sum(ss) * (1.f / DM) + 1e-6f);
        f32x4* o = (f32x4*)(p->out + O_YP + (size_t)row * DM) + lane;
#pragma unroll
        for (int j = 0; j < 8; ++j) o[64 * j] = v[j] * rstd * g4[64 * j];
    }
}
struct EpiU {
    static constexpr bool PERM = true, AFTER_DRAIN = false;
    bf16_t* U; float* out; const float* bf; int l;
    __device__ __forceinline__ void operator()(const f32x4 (&acc)[2][2][4][2], const pg8::Unit& u, int wr, int wc, int fr, int fq) const {
        const int row0 = u.pm * 256 + wr * 64 + fr, col0 = u.pn * 256 + wc * 32 + 8 * fq;
#pragma unroll
        for (int ai = 0; ai < 2; ++ai)
#pragma unroll
            for (int m = 0; m < 4; ++m) { bf16_t* rowp = U + (size_t)(row0 + ai * 128 + m * 16) * NU + col0;
#pragma unroll
                for (int bj = 0; bj < 2; ++bj) { const f32x4 v0 = acc[ai][bj][m][0], v1 = acc[ai][bj][m][1];
                    u32x4 w; w.x = cvt_pk_bf16(v0[0], v0[1]); w.y = cvt_pk_bf16(v0[2], v0[3]); w.z = cvt_pk_bf16(v1[0], v1[1]); w.w = cvt_pk_bf16(v1[2], v1[3]);
                    *(u32x4*)(rowp + bj * 128) = w; } }
        if (u.pn >= 8 && u.pn < 12) {
            const bool isv = u.pn >= 10; const int cin = (u.pn - (isv ? 10 : 8)) * 256 + wc * 32 + 8 * fq;
#pragma unroll
            for (int ai = 0; ai < 2; ++ai)
#pragma unroll
                for (int m = 0; m < 4; ++m) { const int row = row0 + ai * 128 + m * 16;
                    float* dst = row < TP ? out + (isv ? O_PV : O_PK) + ((size_t)l * TP + row) * 512 : out + (isv ? O_SV : O_SK) + ((size_t)l * 1024 + (row - TP)) * 512;
#pragma unroll
                    for (int bj = 0; bj < 2; ++bj) { *(f32x4*)(dst + cin + bj * 128) = acc[ai][bj][m][0]; *(f32x4*)(dst + cin + bj * 128 + 4) = acc[ai][bj][m][1]; } }
        }
        if (u.pn == 58 && wc == 0 && fq == 0) {
            const f32x4 b0 = *(const f32x4*)(bf + l * 8), b1 = *(const f32x4*)(bf + l * 8 + 4);
#pragma unroll
            for (int ai = 0; ai < 2; ++ai)
#pragma unroll
                for (int m = 0; m < 4; ++m) { const int row = row0 + ai * 128 + m * 16;
                    float* dst = row < TP ? out + O_PLF + ((size_t)l * TP + row) * 8 : out + O_SLF + ((size_t)l * 1024 + (row - TP)) * 8;
                    const f32x4 z0 = acc[ai][1][m][0] + b0, z1 = acc[ai][1][m][1] + b1; f32x4 o0, o1;
#pragma unroll
                    for (int e = 0; e < 4; ++e) { o0[e] = log_sigmoidf_(z0[e]); o1[e] = log_sigmoidf_(z1[e]); }
                    *(f32x4*)dst = o0; *(f32x4*)(dst + 4) = o1; }
        }
    }
};
struct BranchOrder {
    int G, c;
    __device__ __forceinline__ bool next(int i, pg8::Unit& u) const { const int L = i * G + c; if (L >= 4 * 544) return false; const int n = L / 544, t = L - n * 544; u.pm = n * 68 + (t >> 3); u.pn = n * 8 + (t & 7); return true; }
    __device__ __forceinline__ void a_ready(const pg8::Unit&) const {}
    __device__ __forceinline__ void done(const pg8::Unit&) const {}
};
struct EpiZ {
    static constexpr bool PERM = true, AFTER_DRAIN = false;
    bf16_t* Z;
    __device__ __forceinline__ void operator()(const f32x4 (&acc)[2][2][4][2], const pg8::Unit& u, int wr, int wc, int fr, int fq) const {
        const int row0 = u.pm * 256 + wr * 64 + fr, col0 = (u.pn & 7) * 256 + wc * 32 + 8 * fq;
#pragma unroll
        for (int ai = 0; ai < 2; ++ai)
#pragma unroll
            for (int m = 0; m < 4; ++m) { bf16_t* rowp = Z + (size_t)(row0 + ai * 128 + m * 16) * DM + col0;
#pragma unroll
                for (int bj = 0; bj < 2; ++bj) { const f32x4 v0 = acc[ai][bj][m][0], v1 = acc[ai][bj][m][1];
                    u32x4 w; w.x = cvt_pk_bf16(v0[0], v0[1]); w.y = cvt_pk_bf16(v0[2], v0[3]); w.z = cvt_pk_bf16(v1[0], v1[1]); w.w = cvt_pk_bf16(v1[2], v1[3]);
                    *(u32x4*)(rowp + bj * 128) = w; } }
    }
};
__device__ __forceinline__ void merge_pass(KP p, int gtid, int ngt) {
    const bf16_t* U = (const bf16_t*)(p->ws + WS_U); const bf16_t* Z = (const bf16_t*)(p->ws + WS_Z); bf16_t* M = (bf16_t*)(p->ws + WS_MERGED);
    for (int it0 = gtid; it0 < NTOK * 256; it0 += 4 * ngt) {
        u32x4 gv[4][4], zv[4][4];
#pragma unroll
        for (int k = 0; k < 4; ++k) { const int it = it0 + k * ngt < NTOK * 256 ? it0 + k * ngt : it0; const int row = it >> 8, col = (it & 255) * 8;
#pragma unroll
            for (int n = 0; n < 4; ++n) { gv[k][n] = *(const u32x4*)(U + (size_t)row * NU + U_G + n * 2048 + col); zv[k][n] = *(const u32x4*)(Z + ((size_t)n * NTOK + row) * DM + col); } }
#pragma unroll
        for (int k = 0; k < 4; ++k) { const int it = it0 + k * ngt; if (it < NTOK * 256) { const int row = it >> 8, col = (it & 255) * 8;
            float s[8];
#pragma unroll
            for (int e = 0; e < 8; ++e) s[e] = 0.f;
#pragma unroll
            for (int n = 0; n < 4; ++n) { const u32x4 g = gv[k][n], z = zv[k][n];
                s[0] += sigmoidf_(bflo(g.x)) * bflo(z.x); s[1] += sigmoidf_(bfhi(g.x)) * bfhi(z.x); s[2] += sigmoidf_(bflo(g.y)) * bflo(z.y); s[3] += sigmoidf_(bfhi(g.y)) * bfhi(z.y);
                s[4] += sigmoidf_(bflo(g.z)) * bflo(z.z); s[5] += sigmoidf_(bfhi(g.z)) * bfhi(z.z); s[6] += sigmoidf_(bflo(g.w)) * bflo(z.w); s[7] += sigmoidf_(bfhi(g.w)) * bfhi(z.w); }
            u32x4 w; w.x = cvt_pk_bf16(s[0], s[1]); w.y = cvt_pk_bf16(s[2], s[3]); w.z = cvt_pk_bf16(s[4], s[5]); w.w = cvt_pk_bf16(s[6], s[7]);
            *(u32x4*)(M + (size_t)row * DM + col) = w; } }
    }
}
struct EpiOut {
    static constexpr bool PERM = false, AFTER_DRAIN = false;
    const float* xp; const float* xs; const float* xb; const float* ada; float* xout; int l;
    __device__ __forceinline__ void operator()(const f32x4 (&acc)[2][2][4][2], const pg8::Unit& u, int wr, int wc, int fr, int fq) const {
        const int row0 = u.pm * 256 + wr * 64 + fr, col0 = u.pn * 256 + wc * 32 + 4 * fq;
#pragma unroll
        for (int ai = 0; ai < 2; ++ai)
#pragma unroll
            for (int m = 0; m < 4; ++m) { const int row = row0 + ai * 128 + m * 16;
                const float* base = l == 0 ? (row < TP ? xp + (size_t)row * DM : xs + (size_t)(row - TP) * DM) : xb + (size_t)row * DM;
                const int seq = row < TP ? 0 : 1 + ((row - TP) >> 5);
                const float* gate = ada + ((size_t)l * 33 + seq) * 6144 + 4096;
#pragma unroll
                for (int bj = 0; bj < 2; ++bj)
#pragma unroll
                    for (int n = 0; n < 2; ++n) { const int col = col0 + bj * 128 + n * 16;
                        *(f32x4*)(xout + (size_t)row * DM + col) = *(const f32x4*)(base + col) + *(const f32x4*)(gate + col) * acc[ai][bj][m][n]; } }
    }
};
constexpr int CGS = 516;
__device__ __forceinline__ void conv_unit(KP p, int l, int tile, LAS unsigned char* lds, int tid) {
    const bf16_t* U = (const bf16_t*)(p->ws + WS_U);
    const int c = tid, wave = tid >> 6, lane = tid & 63;
    const bool samp = tile >= 512; const int b = tile - 512, row0 = samp ? TP + b * 32 : tile * 32;
    const bool last = samp || tile == 511;
    LAS float* gl = (LAS float*)lds;
    LAS bf16_t* sgl = (LAS bf16_t*)(lds + 62 * CGS * 4);
    LAS float* red = (LAS float*)(lds + 62 * CGS * 4 + 32 * 512 * 2);
    LAS float* st = red + 8 * 32;
#pragma unroll
    for (int k = 0; k < 8; ++k) { const int task = tid + 512 * k; if (task < 62 * 64) { const int i = task >> 6, ch = task & 63; f32x4 o0, o1;
        const int rel = i - 30;
        if (rel < 0 && samp) { const float* hp = p->in[I_SCONV] + (((size_t)l * 32 + b) * 30 + i) * 512 + 8 * ch; o0 = *(const f32x4*)hp; o1 = *(const f32x4*)(hp + 4); }
        else if (row0 + rel < 0) { o0 = (f32x4){0.f, 0.f, 0.f, 0.f}; o1 = o0; }
        else { const bf16_t* up = U + (size_t)(row0 + rel) * NU + 8 * ch; const u32x4 v = *(const u32x4*)(up + U_AVAL), g = *(const u32x4*)(up + U_AGATE);
            o0 = (f32x4){bflo(v.x) * sigmoidf_(bflo(g.x)), bfhi(v.x) * sigmoidf_(bfhi(g.x)), bflo(v.y) * sigmoidf_(bflo(g.y)), bfhi(v.y) * sigmoidf_(bfhi(g.y))};
            o1 = (f32x4){bflo(v.z) * sigmoidf_(bflo(g.z)), bfhi(v.z) * sigmoidf_(bfhi(g.z)), bflo(v.w) * sigmoidf_(bflo(g.w)), bfhi(v.w) * sigmoidf_(bfhi(g.w))}; }
        *(LAS f32x4*)(gl + i * CGS + 8 * ch) = o0; *(LAS f32x4*)(gl + i * CGS + 8 * ch + 4) = o1; } }
#pragma unroll
    for (int k = 0; k < 4; ++k) { const int task = tid + 512 * k, t = task >> 6, ch = task & 63; const u32x4 s = *(const u32x4*)(U + (size_t)(row0 + t) * NU + U_ASG + 8 * ch);
        u32x4 w; w.x = cvt_pk_bf16(siluf_(bflo(s.x)), siluf_(bfhi(s.x))); w.y = cvt_pk_bf16(siluf_(bflo(s.y)), siluf_(bfhi(s.y))); w.z = cvt_pk_bf16(siluf_(bflo(s.z)), siluf_(bfhi(s.z))); w.w = cvt_pk_bf16(siluf_(bflo(s.w)), siluf_(bfhi(s.w)));
        *(LAS u32x4*)(sgl + t * 512 + 8 * ch) = w; }
    const float cb = p->in[I_CONVB][l * 512 + c], lg = p->in[I_CLNG][l * 512 + c], lb = p->in[I_CLNB][l * 512 + c];
    float wk[31];
#pragma unroll
    for (int k = 0; k < 31; ++k) wk[k] = p->in[I_CONVW][((size_t)l * 31 + k) * 512 + c];
    __syncthreads();
    if (last) {
        float* dst = samp ? p->out + O_SCONV + (((size_t)l * 32 + b) * 30) * 512 + c : p->out + O_PCONV + ((size_t)l * 30) * 512 + c;
#pragma unroll
        for (int t = 2; t < 32; ++t) dst[(size_t)(t - 2) * 512] = gl[(30 + t) * CGS + c];
    }
    bf16_t* oa = (bf16_t*)(p->ws + WS_OCAT);
#pragma unroll 1
    for (int half = 0; half < 2; ++half) {
        float z[46];
#pragma unroll
        for (int i = 0; i < 46; ++i) z[i] = gl[(16 * half + i) * CGS + c];
        float hv[16];
#pragma unroll
        for (int tt = 0; tt < 16; ++tt) hv[tt] = cb;
#pragma unroll
        for (int k = 0; k < 31; ++k) {
#pragma unroll
            for (int tt = 0; tt < 16; ++tt) hv[tt] += z[tt + k] * wk[k]; }
#pragma unroll
        for (int tt = 0; tt < 16; ++tt) { const float s1 = wave_sum(hv[tt]), s2 = wave_sum(hv[tt] * hv[tt]); if (lane == 0) { red[(wave * 16 + tt) * 2] = s1; red[(wave * 16 + tt) * 2 + 1] = s2; } }
        __syncthreads();
        if (tid < 16) { float s1 = 0.f, s2 = 0.f;
#pragma unroll
            for (int w = 0; w < 8; ++w) { s1 += red[(w * 16 + tid) * 2]; s2 += red[(w * 16 + tid) * 2 + 1]; }
            const float mean = s1 * (1.f / 512.f), var = fmaxf(s2 * (1.f / 512.f) - mean * mean, 0.f);
            st[tid * 2] = mean; st[tid * 2 + 1] = 1.f / sqrtf(var + 1e-5f); }
        __syncthreads();
#pragma unroll
        for (int tt = 0; tt < 16; ++tt) { const float y = (hv[tt] - st[tt * 2]) * st[tt * 2 + 1] * lg + lb; const int t = 16 * half + tt;
            oa[(size_t)(row0 + t) * 512 + c] = f2bf(siluf_(y) * bf2f(sgl[t * 512 + c])); }
    }
    __syncthreads();
}
__device__ __forceinline__ void pool_unit(KP p, int l, int tile, LAS unsigned char* lds, int tid) {
    const bf16_t* U = (const bf16_t*)(p->ws + WS_U);
    const int c = tid, wave = tid >> 6, lane = tid & 63;
    const bool samp = tile >= 512; const int b = tile - 512, row0 = samp ? TP + b * 32 : tile * 32;
    constexpr int PST = 520;
    LAS float* zl = (LAS float*)lds;
    LAS bf16_t* pl = (LAS bf16_t*)(lds + 47 * CGS * 4);
#pragma unroll
    for (int k = 0; k < 6; ++k) { const int task = tid + 512 * k; if (task < 47 * 64) { const int i = task >> 6, ch = task & 63; f32x4 o0, o1; const int rel = i - 15;
        if (rel < 0 && samp) { const float* hp = p->in[I_SPOOL] + (((size_t)l * 32 + b) * 15 + i) * 512 + 8 * ch; o0 = *(const f32x4*)hp; o1 = *(const f32x4*)(hp + 4); }
        else if (row0 + rel < 0) { o0 = (f32x4){0.f, 0.f, 0.f, 0.f}; o1 = o0; }
        else { const u32x4 v = *(const u32x4*)(U + (size_t)(row0 + rel) * NU + U_DIN + 8 * ch); o0 = (f32x4){bflo(v.x), bfhi(v.x), bflo(v.y), bfhi(v.y)}; o1 = (f32x4){bflo(v.z), bfhi(v.z), bflo(v.w), bfhi(v.w)}; }
        *(LAS f32x4*)(zl + i * CGS + 8 * ch) = o0; *(LAS f32x4*)(zl + i * CGS + 8 * ch + 4) = o1; } }
    u32x4 sgv[4];
#pragma unroll
    for (int k = 0; k < 4; ++k) { const int task = tid + 512 * k; sgv[k] = *(const u32x4*)(U + (size_t)(row0 + (task >> 6)) * NU + U_DSG + 8 * (task & 63)); }
    __syncthreads();
    {
        float z[47];
#pragma unroll
        for (int i = 0; i < 47; ++i) z[i] = zl[i * CGS + c];
        if (samp || tile == 511) {
            float* dst = samp ? p->out + O_SPOOL + (((size_t)l * 32 + b) * 15) * 512 + c : p->out + O_PPOOL + ((size_t)l * 15) * 512 + c;
#pragma unroll
            for (int t = 17; t < 32; ++t) dst[(size_t)(t - 17) * 512] = z[15 + t];
        }
        const int w = 2 << (c >> 7);
#pragma unroll
        for (int t = 0; t < 32; ++t) { float s = 0.f;
#pragma unroll
            for (int i = 0; i < 16; ++i) s += (i < w) ? z[15 + t - i] : 0.f;
            const int pos = samp ? PAST + t : row0 + t; const int cnt = (pos + 1 < w) ? pos + 1 : w;
            pl[t * PST + c] = f2bf(s / (float)cnt - z[15 + t]); }
    }
    __syncthreads();
    LAS bf16_t* sl = (LAS bf16_t*)lds;
    LAS bf16_t* ol = sl + 32 * PST;
#pragma unroll
    for (int k = 0; k < 4; ++k) { const int task = tid + 512 * k, t = task >> 6, ch = task & 63; const u32x4 s = sgv[k];
        u32x4 w; w.x = cvt_pk_bf16(siluf_(bflo(s.x)), siluf_(bfhi(s.x))); w.y = cvt_pk_bf16(siluf_(bflo(s.y)), siluf_(bfhi(s.y))); w.z = cvt_pk_bf16(siluf_(bflo(s.z)), siluf_(bfhi(s.z))); w.w = cvt_pk_bf16(siluf_(bflo(s.w)), siluf_(bfhi(s.w)));
        *(LAS u32x4*)(sl + t * PST + 8 * ch) = w; }
    __syncthreads();
    {
        const int g = wave >> 1, fr = lane & 15, kq = lane >> 4;
        const bf16_t* WT = (const bf16_t*)(p->ws + WS_POOLW) + (size_t)(l * 4 + g) * 128 * 128;
        f32x4 acc[2][4];
#pragma unroll
        for (int mt = 0; mt < 2; ++mt)
#pragma unroll
            for (int nt = 0; nt < 4; ++nt) acc[mt][nt] = (f32x4){0.f, 0.f, 0.f, 0.f};
#pragma unroll
        for (int ks = 0; ks < 4; ++ks) {
            bf16x8 af[2];
#pragma unroll
            for (int mt = 0; mt < 2; ++mt) af[mt] = *(const LAS bf16x8*)(pl + (16 * mt + fr) * PST + g * 128 + 32 * ks + 8 * kq);
#pragma unroll
            for (int nt = 0; nt < 4; ++nt) { const int dl = (wave & 1) * 64 + 16 * nt + fr;
                const bf16x8 bfr = *(const bf16x8*)(WT + (size_t)dl * 128 + 32 * ks + 8 * kq);
#pragma unroll
                for (int mt = 0; mt < 2; ++mt) acc[mt][nt] = __builtin_amdgcn_mfma_f32_16x16x32_bf16(af[mt], bfr, acc[mt][nt], 0, 0, 0); }
        }
#pragma unroll
        for (int nt = 0; nt < 4; ++nt) { const int d = wave * 64 + 16 * nt + fr; const float pb = p->in[I_POOLB][l * 512 + d], ps = p->in[I_POOLS][l * 512 + d];
#pragma unroll
            for (int mt = 0; mt < 2; ++mt)
#pragma unroll
                for (int r = 0; r < 4; ++r) { const int t = 16 * mt + 4 * kq + r; ol[t * PST + d] = f2bf((acc[mt][nt][r] + pb) * ps * bf2f(sl[t * PST + d])); } }
    }
    __syncthreads();
    bf16_t* od = (bf16_t*)(p->ws + WS_OCAT) + (size_t)3 * NTOK * 512;
#pragma unroll
    for (int k = 0; k < 4; ++k) { const int task = tid + 512 * k, t = task >> 6, ch = task & 63; *(u32x4*)(od + (size_t)(row0 + t) * 512 + 8 * ch) = *(const LAS u32x4*)(ol + t * PST + 8 * ch); }
    __syncthreads();
}
__device__ __forceinline__ void fp_unit(KP p, int l, int h, LAS unsigned char* lds, int tid) {
    const float* lf = p->out + O_PLF + (size_t)l * TP * 8 + h;
    LAS float* part = (LAS float*)lds;
    float v[32]; float s = 0.f;
#pragma unroll
    for (int i = 0; i < 32; ++i) { v[i] = lf[(size_t)(tid * 32 + i) * 8]; s += v[i]; }
    part[tid] = s;
    __syncthreads();
    float pre = 0.f;
    for (int j = 0; j < tid; ++j) pre += part[j];
    float* F = (float*)(p->ws + WS_FP) + (size_t)h * TP + tid * 32;
#pragma unroll
    for (int i = 0; i < 32; ++i) { pre += v[i]; F[i] = pre * LOG2E; }
    __syncthreads();
}
__device__ __forceinline__ void gs_unit(KP p, int l, int b, LAS unsigned char* lds, int tid) {
    const int h = tid & 7, ch = tid >> 3;
    const float* cl = p->in[I_CLF] + (((size_t)l * 32 + b) * PAST + ch * 64) * 8 + h;
    LAS float* part = (LAS float*)lds;
    float v[64]; float s = 0.f;
#pragma unroll
    for (int i = 0; i < 64; ++i) v[i] = cl[(size_t)i * 8];
#pragma unroll
    for (int i = 0; i < 64; ++i) s += v[i];
    part[ch * 8 + h] = s;
    __syncthreads();
    float suf = 0.f;
    for (int j = ch + 1; j < 64; ++j) suf += part[j * 8 + h];
    float* G = (float*)(p->ws + WS_GS) + ((size_t)b * 8 + h) * GS_LEN + ch * 64;
#pragma unroll
    for (int i = 63; i >= 0; --i) { G[i] = -suf * LOG2E; suf += v[i]; }
    if (tid < 8) { const float* nl = p->out + O_SLF + ((size_t)l * 1024 + b * 32) * 8 + tid; float* Gn = (float*)(p->ws + WS_GS) + ((size_t)b * 8 + tid) * GS_LEN + PAST; float w[32]; float run = 0.f;
#pragma unroll
        for (int i = 0; i < 32; ++i) w[i] = nl[i * 8];
#pragma unroll
        for (int i = 0; i < 32; ++i) { run += w[i]; Gn[i] = run * LOG2E; } }
    __syncthreads();
}
__device__ __forceinline__ void vt_tile(KP p, int l, int tile, LAS unsigned char* lds, int wave, int lane) {
    const int h = tile >> 8, tb = tile & 255;
    const bf16_t* U = (const bf16_t*)(p->ws + WS_U);
    LAS unsigned* scr = (LAS unsigned*)lds + wave * SLOT_F;
#pragma unroll 8
    for (int tt = 0; tt < 64; ++tt) scr[tt * 65 + lane] = U[(size_t)(tb * 64 + tt) * NU + U_V + h * 64 + lane];
    {
        float mx = 0.f;
#pragma unroll 8
        for (int tt = 0; tt < 64; ++tt) { const float kv = bf2f(U[(size_t)(tb * 64 + tt) * NU + U_K + h * 64 + lane]); mx = fmaxf(mx, wave_sum(kv * kv)); }
        if (lane == 0) atomicMax((unsigned*)(p->ws + WS_CTL) + CW_KMAX + l * 8 + h, __float_as_uint(mx));
    }
    bf16_t* Vt = (bf16_t*)(p->ws + WS_VT);
    const int t2 = (lane & 31) * 2, dh = lane >> 5;
#pragma unroll 8
    for (int it = 0; it < 32; ++it) { const int d = 2 * it + dh; *(unsigned*)(Vt + ((size_t)h * 64 + d) * TP + tb * 64 + t2) = scr[t2 * 65 + d] | (scr[(t2 + 1) * 65 + d] << 16); }
}
__device__ __forceinline__ void shift_out(KP p, int l, int tid) {
    const bf16_t* U = (const bf16_t*)(p->ws + WS_U);
    for (int base = tid; base < NSEQ * SHIFT_W; base += 512 * 8) {
        unsigned short v[8];
#pragma unroll
        for (int k = 0; k < 8; ++k) { const int idx = base + k * 512 < NSEQ * SHIFT_W ? base + k * 512 : tid; const int s = idx / SHIFT_W, j = idx - s * SHIFT_W; const int row = s == 0 ? TP - 1 : TP + (s - 1) * 32 + 31; v[k] = U[(size_t)row * NU + U_XC + j]; }
#pragma unroll
        for (int k = 0; k < 8; ++k) { const int idx = base + k * 512; if (idx < NSEQ * SHIFT_W) { const int s = idx / SHIFT_W, j = idx - s * SHIFT_W;
            float* dst = s == 0 ? p->out + O_PSHIFT + (size_t)l * SHIFT_W + j : p->out + O_SSHIFT + ((size_t)l * 32 + (s - 1)) * SHIFT_W + j; *dst = bf2f(v[k]); } }
    }
}
template <bool AT, bool BT, bool NEGA>
__device__ __forceinline__ void mm32(f32x16& acc, const LAS float* Ap, int i0, const LAS float* Bp, int j0, int lane) {
    const int li = lane & 31, kh = lane >> 5;
    const LAS float* ap = AT ? Ap + (8 * kh) * 65 + i0 + li : Ap + (i0 + li) * 65 + 8 * kh;
    const LAS float* bp = BT ? Bp + (j0 + li) * 65 + 8 * kh : Bp + (8 * kh) * 65 + j0 + li;
#pragma unroll 2
    for (int s = 0; s < 4; ++s) {
        float a[8], b[8];
#pragma unroll
        for (int e = 0; e < 8; ++e) { a[e] = AT ? ap[(16 * s + e) * 65] : ap[16 * s + e]; b[e] = BT ? bp[16 * s + e] : bp[(16 * s + e) * 65]; }
        if (NEGA) {
#pragma unroll
            for (int e = 0; e < 8; ++e) a[e] = -a[e]; }
        const bf16x8 af = pack8f((f32x4){a[0], a[1], a[2], a[3]}, (f32x4){a[4], a[5], a[6], a[7]}), bfg = pack8f((f32x4){b[0], b[1], b[2], b[3]}, (f32x4){b[4], b[5], b[6], b[7]});
        acc = __builtin_amdgcn_mfma_f32_32x32x16_bf16(af, bfg, acc, 0, 0, 0);
    }
}
template <int MASK>
__device__ __forceinline__ void st_tile(LAS float* dst, const f32x16& acc, int i0, int j0, int lane) {
    const int li = lane & 31, hi = lane >> 5, j = j0 + li;
#pragma unroll
    for (int r = 0; r < 16; ++r) { const int i = i0 + (r & 3) + 8 * (r >> 2) + 4 * hi; float v = acc[r];
        if (MASK == 1 && !(i < j)) v = 0.f; if (MASK == 2 && !(i <= j)) v = 0.f; dst[i * 65 + j] = v; }
}
struct RwkvSeqInfo { int row0, ntok, prev_kind  , b; };
__device__ __forceinline__ RwkvSeqInfo rwkv_info(int cu) { RwkvSeqInfo s; if (cu < 256) { s.row0 = cu * 64; s.ntok = 64; s.prev_kind = cu == 0 ? 0 : 1; s.b = 0; } else { s.b = cu - 256; s.row0 = TP + s.b * 32; s.ntok = 32; s.prev_kind = 2; } return s; }

__device__ __forceinline__ void rwkv_r1(KP p, int l, int unit, LAS unsigned char* lds, int tid) {
    const int cu = unit >> 3, h = unit & 7, wave = tid >> 6, lane = tid & 63, li = lane & 31, hi = lane >> 5;
    const RwkvSeqInfo si = rwkv_info(cu);
    const bf16_t* U = (const bf16_t*)(p->ws + WS_U);
    LAS float* S0 = (LAS float*)lds; LAS float *S1 = S0 + SLOT_F, *S2 = S0 + 2 * SLOT_F, *S3 = S0 + 3 * SLOT_F, *S4 = S0 + 4 * SLOT_F, *S5 = S0 + 5 * SLOT_F, *S6 = S0 + 6 * SLOT_F, *S7 = S0 + 7 * SLOT_F, *S8 = S0 + 8 * SLOT_F;
    LAS float* gC = S0 + 9 * SLOT_F;
    const int q = wave >> 2, wq = wave & 3, i0 = (wq >> 1) * 32, j0 = (wq & 1) * 32;
    PT0();
    {
        const int j = tid & 63, tq = tid >> 6;
        const int tl = lane >> 3, q8 = (lane & 7) * 8;
#pragma unroll
        for (int kb = 0; kb < 5; kb += 3) {
        u32x4 cur[5], prv[5];
#pragma unroll
        for (int k = kb; k < (kb + 3 < 5 ? kb + 3 : 5); ++k) { const int pid = wave * 5 + k, s = pid >> 3, tb = pid & 7, t = tb * 8 + tl;
            const int xo = (s < 3 ? s * 512 + h * 64 : 1536 + (s - 3) * 64) + q8;
            const int tc = t < si.ntok ? t : si.ntok - 1, tp = tc > 0 ? tc - 1 : (si.prev_kind == 1 ? -1 : 0);
            cur[k] = *(const u32x4*)(U + (size_t)(si.row0 + tc) * NU + U_XC + xo); prv[k] = *(const u32x4*)(U + (size_t)(si.row0 + tp) * NU + U_XC + xo); }
#pragma unroll
        for (int k = kb; k < (kb + 3 < 5 ? kb + 3 : 5); ++k) { const int pid = wave * 5 + k, s = pid >> 3, tb = pid & 7, t = tb * 8 + tl;
            const int xo = (s < 3 ? s * 512 + h * 64 : 1536 + (s - 3) * 64) + q8;
            LAS float* dst = (s == 0 ? S0 : s == 1 ? S1 : s == 2 ? S2 : s == 3 ? S3 : S4) + t * 65 + q8;
            const f32x4 m0 = *(const f32x4*)(p->in[I_MU] + l * SHIFT_W + xo), m1 = *(const f32x4*)(p->in[I_MU] + l * SHIFT_W + xo + 4);
            float x[8] = {bflo(cur[k].x), bfhi(cur[k].x), bflo(cur[k].y), bfhi(cur[k].y), bflo(cur[k].z), bfhi(cur[k].z), bflo(cur[k].w), bfhi(cur[k].w)};
            float pv[8] = {bflo(prv[k].x), bfhi(prv[k].x), bflo(prv[k].y), bfhi(prv[k].y), bflo(prv[k].z), bfhi(prv[k].z), bflo(prv[k].w), bfhi(prv[k].w)};
            if (t == 0 && si.prev_kind != 1) {
                if (si.prev_kind == 2) { const float* sp = p->in[I_SSHIFT] + ((size_t)l * 32 + si.b) * SHIFT_W + xo;
#pragma unroll
                    for (int e = 0; e < 8; ++e) pv[e] = sp[e]; }
                else {
#pragma unroll
                    for (int e = 0; e < 8; ++e) pv[e] = 0.f; } }
#pragma unroll
            for (int e = 0; e < 8; ++e) { const float mu = e < 4 ? m0[e] : m1[e - 4]; float xs = (t < si.ntok) ? x[e] + (pv[e] - x[e]) * mu : 0.f; if (s == 3) xs = fast_tanh(xs); dst[e] = xs; }
        }
        }
#pragma unroll
        for (int mm = 0; mm < 8; ++mm) { const int m = tq * 8 + mm;
            S5[m * 65 + j] = p->in[I_W2][((size_t)l * 64 + m) * 512 + h * 64 + j]; S6[m * 65 + j] = p->in[I_A2][((size_t)l * 64 + m) * 512 + h * 64 + j]; }
    }
    __syncthreads();
    PT1(1);
    {
        f32x16 acc = {};
        const int c = j0 + li;
        if (q == 0) { mm32<false, false, false>(acc, S3, i0, S5, j0, lane); const float w0 = p->in[I_W0][l * 512 + h * 64 + c];
#pragma unroll
            for (int r = 0; r < 16; ++r) { const int t = i0 + (r & 3) + 8 * (r >> 2) + 4 * hi; const float zz = acc[r] + w0;
                const float sp = fmaxf(-zz, 0.f) + __logf(1.f + __expf(-fabsf(zz)));
                S7[t * 65 + c] = (t < si.ntok) ? -__expf(-sp - 0.5f) : 0.f; } }
        else { mm32<false, false, false>(acc, S4, i0, S6, j0, lane); const float a0 = p->in[I_A0][l * 512 + h * 64 + c];
#pragma unroll
            for (int r = 0; r < 16; ++r) { const int t = i0 + (r & 3) + 8 * (r >> 2) + 4 * hi; S8[t * 65 + c] = __builtin_amdgcn_rcpf(1.f + __expf(-(acc[r] + a0))); } }
    }
    __syncthreads();
    PT1(2);
    if (wave == 0) { float run = 0.f;
#pragma unroll 8
        for (int t = 0; t < 64; ++t) { run += S7[t * 65 + lane]; S3[t * 65 + lane] = run; } }
    else { const int c = lane; const float kkw = p->in[I_KK][l * 512 + h * 64 + c], kaw = p->in[I_KA][l * 512 + h * 64 + c], rkw = p->in[I_RK][l * 512 + h * 64 + c];
        for (int t = wave - 1; t < 64; t += 7) { const float kr = S1[t * 65 + c], kv = kr * kkw; const float ss = wave_sum(kv * kv);
            const float kn = kv * (1.f / sqrtf(fmaxf(ss, 1e-24f))); const float a = S8[t * 65 + c]; const float km = kr * (1.f + (a - 1.f) * kaw);
            const float bon = wave_sum(S0[t * 65 + c] * km * rkw);
            S4[t * 65 + c] = kn; S1[t * 65 + c] = km; S8[t * 65 + c] = kn * a;
            if (lane == 0) ((float*)(p->ws + WS_BONUS))[(size_t)unit * 64 + t] = bon; } }
    __syncthreads();
    { const int c = tid & 63, tq = tid >> 6;
#pragma unroll
        for (int tt = 0; tt < 8; ++tt) { const int t = tq * 8 + tt, o = t * 65 + c; const float Lg = S3[o], lw = S7[o];
            const float g = __expf(Lg), gi = __expf(-Lg), gp = __expf(Lg - lw);
            S0[o] *= g; S1[o] *= gi; S8[o] *= gi; S4[o] *= gp; if (t == 63) gC[c] = g; } }
    __syncthreads();
    PT1(3);
    { f32x16 acc = {};
      if (q == 0) { mm32<false, true, false>(acc, S1, i0, S4, j0, lane); st_tile<1>(S3, acc, i0, j0, lane); }
      else { mm32<false, true, false>(acc, S8, i0, S4, j0, lane); st_tile<1>(S5, acc, i0, j0, lane); } }
    __syncthreads();
    { f32x16 acc = {};
      if (q == 0) { mm32<true, false, false>(acc, S2, i0, S3, j0, lane); st_tile<0>(S6, acc, i0, j0, lane); }
      else { mm32<false, true, false>(acc, S1, i0, S0, j0, lane); st_tile<2>(S7, acc, i0, j0, lane); } }
    __syncthreads();
    PT1(4);
    { float x[16]; const int r0 = (wave & 3) * 16;
      if (wave < 4) {
#pragma unroll
          for (int rr = 0; rr < 16; ++rr) x[rr] = S4[lane * 65 + r0 + rr]; }
      else {
#pragma unroll
          for (int rr = 0; rr < 16; ++rr) x[rr] = S6[(r0 + rr) * 65 + lane]; }
      __syncthreads();
#pragma unroll
      for (int sb = 0; sb < 4; ++sb) {
          float mreg[16];
#pragma unroll
          for (int s = 0; s < 16; ++s) mreg[s] = S5[(sb * 16 + (s < 15 || sb < 3 ? s : 14)) * 65 + lane];
          __builtin_amdgcn_sched_barrier(0);
#pragma unroll
          for (int s = 0; s < 16; ++s) { if (sb * 16 + s < 63) { const float mrow = mreg[s]; float xs[16];
#pragma unroll
              for (int rr = 0; rr < 16; ++rr) xs[rr] = __builtin_bit_cast(float, __builtin_amdgcn_readlane(__builtin_bit_cast(int, x[rr]), sb * 16 + s));
              __builtin_amdgcn_sched_barrier(0);
#pragma unroll
              for (int rr = 0; rr < 16; ++rr) x[rr] -= xs[rr] * mrow;
              __builtin_amdgcn_sched_barrier(0); } }
      }
      LAS float* dst = wave < 4 ? S3 : S6;
#pragma unroll
      for (int rr = 0; rr < 16; ++rr) dst[(r0 + rr) * 65 + lane] = x[rr]; }
    __syncthreads();
    PT1(5);
    { f32x16 acc = {};
      if (q == 1) { mm32<false, true, false>(acc, S8, i0, S0, j0, lane); st_tile<2>(S4, acc, i0, j0, lane); }
      else { mm32<false, false, false>(acc, S3, i0, S8, j0, lane);
          const int jc = j0 + li; const float gc = gC[jc]; float* TQ = (float*)(p->ws + WS_TQ) + (size_t)unit * 4096;
#pragma unroll
          for (int rg = 0; rg < 4; ++rg) { const int ab = i0 + 8 * rg + 4 * hi; f32x4 o;
#pragma unroll
              for (int e = 0; e < 4; ++e) o[e] = ((ab + e == jc) ? gc : 0.f) - acc[rg * 4 + e] * gc;
              *(f32x4*)(TQ + ((((jc >> 4) * 4 + (ab >> 4)) * 64 + ((ab & 15) >> 2) * 16 + (jc & 15)) * 4)) = o; } } }
    __syncthreads();
    { f32x16 acc = {};
      if (q == 0) { mm32<true, false, false>(acc, S2, i0, S1, j0, lane); mm32<false, false, true>(acc, S6, i0, S8, j0, lane);
          const int jc = j0 + li; const float gc = gC[jc]; float* GM = (float*)(p->ws + WS_GM) + (size_t)unit * 4096;
#pragma unroll
          for (int r = 0; r < 16; ++r) GM[(i0 + (r & 3) + 8 * (r >> 2) + 4 * hi) * 64 + jc] = acc[r] * gc; }
      else { mm32<true, false, false>(acc, S2, i0, S7, j0, lane); mm32<false, false, true>(acc, S6, i0, S4, j0, lane);
          float* Y0T = (float*)(p->ws + WS_Y0T) + (size_t)unit * 4096;
#pragma unroll
          for (int rg = 0; rg < 4; ++rg) *(f32x4*)(Y0T + (((((j0 >> 5) * 2 + (i0 >> 5)) * 4 + rg) * 2 + hi) * 32 + li) * 4) = (f32x4){acc[rg * 4], acc[rg * 4 + 1], acc[rg * 4 + 2], acc[rg * 4 + 3]}; } }
    if (q == 0) { f32x16 acc;
#pragma unroll
        for (int r = 0; r < 16; ++r) acc[r] = S0[(j0 + li) * 65 + i0 + (r & 3) + 8 * (r >> 2) + 4 * hi];
        mm32<false, false, true>(acc, S3, i0, S4, j0, lane);
        float* ET = (float*)(p->ws + WS_ET) + (size_t)unit * 4096;
#pragma unroll
        for (int rg = 0; rg < 4; ++rg) *(f32x4*)(ET + ((((j0 >> 5) * 2 + (i0 >> 5)) * 8 + 2 * rg + hi) * 32 + li) * 4) = (f32x4){acc[rg * 4], acc[rg * 4 + 1], acc[rg * 4 + 2], acc[rg * 4 + 3]}; }
    __syncthreads();
    PT1(6);
}
template <bool SCQ>
__device__ __forceinline__ void chain_run(f32x4 (&st)[4], const float* TQ, const float* GM, float* SC, int nsteps, int i, int g, int lane) {
    constexpr size_t STRIDE = (size_t)8 * 4096;
    f32x4 tq[16], gm[4];
#pragma unroll
    for (int x = 0; x < 16; ++x) tq[x] = *(const f32x4*)(TQ + (x * 64 + lane) * 4);
#pragma unroll
    for (int tl = 0; tl < 4; ++tl) gm[tl] = GM ? *(const f32x4*)(GM + i * 64 + 16 * tl + 4 * g) : (f32x4){0.f, 0.f, 0.f, 0.f};
    for (int c = 0; c < nsteps; ++c) {
        if (SC) {
            if (SCQ) {
#pragma unroll
                for (int tl = 0; tl < 4; ++tl) *(f32x4*)(SC + c * STRIDE + ((((i >> 5) * 2 + (tl >> 1)) * 8 + 4 * (tl & 1) + g) * 32 + (i & 31)) * 4) = st[tl]; }
            else {
#pragma unroll
                for (int tl = 0; tl < 4; ++tl) *(f32x4*)(SC + c * STRIDE + i * 64 + 16 * tl + 4 * g) = st[tl]; } }
        f32x4 tqn[16], gmn[4];
        const int cn = (c + 1 < nsteps) ? c + 1 : c;
#pragma unroll
        for (int x = 0; x < 16; ++x) tqn[x] = *(const f32x4*)(TQ + cn * STRIDE + (x * 64 + lane) * 4);
#pragma unroll
        for (int tl = 0; tl < 4; ++tl) gmn[tl] = GM ? *(const f32x4*)(GM + cn * STRIDE + i * 64 + 16 * tl + 4 * g) : (f32x4){0.f, 0.f, 0.f, 0.f};
        f32x4 acc[4];
#pragma unroll
        for (int tp = 0; tp < 4; ++tp) acc[tp] = gm[tp];
#pragma unroll
        for (int tl = 0; tl < 4; ++tl)
#pragma unroll
            for (int r = 0; r < 4; ++r)
#pragma unroll
                for (int tp = 0; tp < 4; ++tp) acc[tp] = __builtin_amdgcn_mfma_f32_16x16x4f32(tq[tp * 4 + tl][r], st[tl][r], acc[tp], 0, 0, 0);
#pragma unroll
        for (int tl = 0; tl < 4; ++tl) st[tl] = acc[tl];
#pragma unroll
        for (int x = 0; x < 16; ++x) tq[x] = tqn[x];
#pragma unroll
        for (int tl = 0; tl < 4; ++tl) gm[tl] = gmn[tl];
    }
}
__device__ __forceinline__ void rwkv_l1_task(KP p, int task, int lane) {
    const int iq = task & 3, kind = (task >> 2) & 1, h = (task >> 3) & 7, grp = task >> 6;
    const int fr = lane & 15, g = lane >> 4, i = iq * 16 + fr;
    const size_t u0 = ((size_t)(grp * 16) * 8 + h) * 4096;
    const float* TQ = (const float*)(p->ws + WS_TQ) + u0; const float* GM = (const float*)(p->ws + WS_GM) + u0;
    f32x4 st[4];
#pragma unroll
    for (int tl = 0; tl < 4; ++tl)
#pragma unroll
        for (int r = 0; r < 4; ++r) st[tl][r] = (kind == 1 && i == 16 * tl + 4 * g + r) ? 1.f : 0.f;
    chain_run<false>(st, TQ, kind == 0 ? GM : nullptr, nullptr, 16, i, g, lane);
    const size_t gb = ((size_t)grp * 8 + h) * 4096;
    if (kind == 0) { float* GG = (float*)(p->ws + WS_GG) + gb;
#pragma unroll
        for (int tl = 0; tl < 4; ++tl) *(f32x4*)(GG + i * 64 + 16 * tl + 4 * g) = st[tl]; }
    else { float* TG = (float*)(p->ws + WS_TG) + gb;
#pragma unroll
        for (int tl = 0; tl < 4; ++tl)
#pragma unroll
            for (int r = 0; r < 4; ++r) TG[((tl * 4 + iq) * 64 + (fr >> 2) * 16 + 4 * g + r) * 4 + (fr & 3)] = st[tl][r]; }
}
__device__ __forceinline__ void rwkv_l2_task(KP p, int l, int task, int lane) {
    const int iq = task & 3, h = task >> 2, fr = lane & 15, g = lane >> 4, i = iq * 16 + fr;
    f32x4 st[4];
#pragma unroll
    for (int tl = 0; tl < 4; ++tl) st[tl] = (f32x4){0.f, 0.f, 0.f, 0.f};
    chain_run<false>(st, (const float*)(p->ws + WS_TG) + (size_t)h * 4096, (const float*)(p->ws + WS_GG) + (size_t)h * 4096, (float*)(p->ws + WS_SG) + (size_t)h * 4096, 16, i, g, lane);
    float* dst = p->out + O_PWKV + (((size_t)l * 8 + h) * 64 + i) * 64;
#pragma unroll
    for (int tl = 0; tl < 4; ++tl) *(f32x4*)(dst + 16 * tl + 4 * g) = st[tl];
}
__device__ __forceinline__ void rwkv_l3_task(KP p, int l, int task, int lane) {
    const int fr = lane & 15, g = lane >> 4;
    f32x4 st[4];
    if (task < 512) { const int iq = task & 3, h = (task >> 2) & 7, grp = task >> 5, i = iq * 16 + fr;
        const float* s0 = (const float*)(p->ws + WS_SG) + ((size_t)grp * 8 + h) * 4096 + i * 64;
#pragma unroll
        for (int tl = 0; tl < 4; ++tl) st[tl] = *(const f32x4*)(s0 + 16 * tl + 4 * g);
        const size_t u0 = ((size_t)(grp * 16) * 8 + h) * 4096;
        chain_run<true>(st, (const float*)(p->ws + WS_TQ) + u0, (const float*)(p->ws + WS_GM) + u0, (float*)(p->ws + WS_SC) + u0, 16, i, g, lane); }
    else { const int t2 = task - 512, iq = t2 & 3, h = (t2 >> 2) & 7, b = t2 >> 5, i = iq * 16 + fr;
        const float* s0 = p->in[I_SWKV] + ((((size_t)l * 32 + b) * 8 + h) * 64 + i) * 64;
#pragma unroll
        for (int tl = 0; tl < 4; ++tl) st[tl] = *(const f32x4*)(s0 + 16 * tl + 4 * g);
        const size_t u0 = ((size_t)(256 + b) * 8 + h) * 4096;
        chain_run<true>(st, (const float*)(p->ws + WS_TQ) + u0, (const float*)(p->ws + WS_GM) + u0, (float*)(p->ws + WS_SC) + u0, 1, i, g, lane);
        float* dst = p->out + O_SWKV + ((((size_t)l * 32 + b) * 8 + h) * 64 + i) * 64;
#pragma unroll
        for (int tl = 0; tl < 4; ++tl) *(f32x4*)(dst + 16 * tl + 4 * g) = st[tl]; }
}
__device__ __forceinline__ void rwkv_r3_task(KP p, int l, int task, int lane) {
    const int unit = task >> 1, th = task & 1, cu = unit >> 3, h = unit & 7, li = lane & 31, hi = lane >> 5;
    const RwkvSeqInfo si = rwkv_info(cu);
    if (th * 32 >= si.ntok) return;
    const bf16_t* U = (const bf16_t*)(p->ws + WS_U);
    const size_t ub = (size_t)unit * 4096; const int t = th * 32 + li;
    const float* SC = (const float*)(p->ws + WS_SC) + ub; const float* ET = (const float*)(p->ws + WS_ET) + ub; const float* Y0T = (const float*)(p->ws + WS_Y0T) + ub;
    f32x16 acc[2];
#pragma unroll
    for (int ti = 0; ti < 2; ++ti)
#pragma unroll
        for (int rg = 0; rg < 4; ++rg) { const f32x4 y0 = *(const f32x4*)(Y0T + ((((th * 2 + ti) * 4 + rg) * 2 + hi) * 32 + li) * 4);
#pragma unroll
            for (int e = 0; e < 4; ++e) acc[ti][rg * 4 + e] = y0[e]; }
    f32x4 eb[8], sa0[8], sa1[8];
#pragma unroll
    for (int s4 = 0; s4 < 8; ++s4) { eb[s4] = *(const f32x4*)(ET + (((th * 2 + hi) * 8 + s4) * 32 + li) * 4); sa0[s4] = *(const f32x4*)(SC + (((0 * 2 + hi) * 8 + s4) * 32 + li) * 4); sa1[s4] = *(const f32x4*)(SC + (((1 * 2 + hi) * 8 + s4) * 32 + li) * 4); }
#pragma unroll
    for (int s4 = 0; s4 < 8; ++s4) {
#pragma unroll
        for (int e = 0; e < 4; ++e) { acc[0] = __builtin_amdgcn_mfma_f32_32x32x2f32(sa0[s4][e], eb[s4][e], acc[0], 0, 0, 0); acc[1] = __builtin_amdgcn_mfma_f32_32x32x2f32(sa1[s4][e], eb[s4][e], acc[1], 0, 0, 0); }
    }
    float s1 = 0.f;
#pragma unroll
    for (int ti = 0; ti < 2; ++ti)
#pragma unroll
        for (int r = 0; r < 16; ++r) s1 += acc[ti][r];
    s1 = xhalf_sum(s1); const float mean = s1 * (1.f / 64.f);
    float s2 = 0.f;
#pragma unroll
    for (int ti = 0; ti < 2; ++ti)
#pragma unroll
        for (int r = 0; r < 16; ++r) { const float d = acc[ti][r] - mean; s2 += d * d; }
    s2 = xhalf_sum(s2); const float rstd = 1.f / sqrtf(s2 * (1.f / 64.f) + 64e-5f);
    if (t >= si.ntok) return;
    const float bon = ((const float*)(p->ws + WS_BONUS))[(size_t)unit * 64 + t];
    const size_t row = (size_t)(si.row0 + t);
    bf16_t* oc = (bf16_t*)(p->ws + WS_OCAT) + (size_t)2 * NTOK * 512 + row * 512 + h * 64;
    u32x2 wout[2][4];
#pragma unroll
    for (int ti = 0; ti < 2; ++ti)
#pragma unroll
        for (int rg = 0; rg < 4; ++rg) { const int i = 32 * ti + 8 * rg + 4 * hi, c = h * 64 + i;
            const f32x4 gg = *(const f32x4*)(p->in[I_GNG] + l * 512 + c), gb = *(const f32x4*)(p->in[I_GNB] + l * 512 + c), mu = *(const f32x4*)(p->in[I_MU] + l * SHIFT_W + 1024 + c);
            const u32x2 vx = *(const u32x2*)(U + row * NU + U_XC + 1024 + c); const u32x2 sg = *(const u32x2*)(U + row * NU + U_CSG + c);
            f32x4 vc = (f32x4){bflo(vx.x), bfhi(vx.x), bflo(vx.y), bfhi(vx.y)}, vp;
            {
                const u32x2 px = *(const u32x2*)(U + (row > 0 ? row - 1 : 0) * NU + U_XC + 1024 + c); const f32x4 ss = *(const f32x4*)(p->in[I_SSHIFT] + ((size_t)l * 32 + si.b) * SHIFT_W + 1024 + c);
                const f32x4 up = (f32x4){bflo(px.x), bfhi(px.x), bflo(px.y), bfhi(px.y)};
                vp = (t > 0 || si.prev_kind == 1) ? up : (si.prev_kind == 2 ? ss : (f32x4){0.f, 0.f, 0.f, 0.f}); }
            const f32x4 vs = vc + (vp - vc) * mu;
            const f32x4 sgf = (f32x4){bflo(sg.x), bfhi(sg.x), bflo(sg.y), bfhi(sg.y)};
            f32x4 o;
#pragma unroll
            for (int e = 0; e < 4; ++e) o[e] = (((acc[ti][rg * 4 + e] - mean) * rstd) * gg[e] + gb[e] + bon * vs[e]) * siluf_(sgf[e]);
            wout[ti][rg].x = cvt_pk_bf16(o[0], o[1]); wout[ti][rg].y = cvt_pk_bf16(o[2], o[3]); }
#pragma unroll
    for (int ti = 0; ti < 2; ++ti)
#pragma unroll
        for (int rg = 0; rg < 4; ++rg) *(u32x2*)(oc + 32 * ti + 8 * rg + 4 * hi) = wout[ti][rg];
}
__device__ __forceinline__ int krow(int i) { return (i & 3) + 4 * ((i >> 3) & 1) + 8 * ((i >> 2) & 1) + 16 * (i >> 4); }
__device__ __forceinline__ bf16x8 pack8(const f32x16& v, int o) { u32x4 w; w.x = cvt_pk_bf16(v[o], v[o + 1]); w.y = cvt_pk_bf16(v[o + 2], v[o + 3]); w.z = cvt_pk_bf16(v[o + 4], v[o + 5]); w.w = cvt_pk_bf16(v[o + 6], v[o + 7]); return __builtin_bit_cast(bf16x8, w); }
constexpr float ATT_NEG = -1e30f;
template <bool HALF>
__device__ __forceinline__ void softmax_tile(f32x16& p0, f32x16& p1, float& m, float& lsum, f32x16 (&O)[2], bf16x8 (&pb)[4]) {
    float mx = p0[0];
#pragma unroll
    for (int r = 1; r < 16; ++r) mx = fmaxf(mx, p0[r]);
    if (!HALF) {
#pragma unroll
        for (int r = 0; r < 16; ++r) mx = fmaxf(mx, p1[r]); }
    mx = xhalf_max(mx);
    const float mn = fmaxf(m, mx), alpha = __builtin_amdgcn_exp2f(m - mn);
    m = mn;
    float s = 0.f;
#pragma unroll
    for (int r = 0; r < 16; ++r) { p0[r] = __builtin_amdgcn_exp2f(p0[r] - mn); s += p0[r]; }
    if (!HALF) {
#pragma unroll
        for (int r = 0; r < 16; ++r) { p1[r] = __builtin_amdgcn_exp2f(p1[r] - mn); s += p1[r]; } }
    lsum = lsum * alpha + s;
#pragma unroll
    for (int r = 0; r < 16; ++r) { O[0][r] *= alpha; O[1][r] *= alpha; }
    pb[0] = pack8(p0, 0); pb[1] = pack8(p0, 8);
    if (!HALF) { pb[2] = pack8(p1, 0); pb[3] = pack8(p1, 8); }
}
constexpr int AKS = 72;
constexpr int ATT_KB = 0, ATT_VB = 2 * 64 * AKS * 2, ATT_FB = 4 * 64 * AKS * 2, ATT_SC = ATT_FB + 2 * 64 * 4;
__device__ __forceinline__ void attn_prompt_unit(KP p, int l, int h, int qb, LAS unsigned char* lds, int tid) {
    const bf16_t* U = (const bf16_t*)(p->ws + WS_U); const bf16_t* Vt = (const bf16_t*)(p->ws + WS_VT) + (size_t)h * 64 * TP; const float* F = (const float*)(p->ws + WS_FP) + (size_t)h * TP;
    const int wave = tid >> 6, lane = tid & 63, li = lane & 31, hi = lane >> 5;
    const int q0 = qb * 256, q = q0 + wave * 32 + li;
    bf16x8 qf[4];
    { const float sc = 0.125f * LOG2E;
#pragma unroll
      for (int d0 = 0; d0 < 4; ++d0) { const u32x4 w = *(const u32x4*)(U + (size_t)q * NU + U_Q + h * 64 + 16 * d0 + 8 * hi);
          qf[d0] = pack8f((f32x4){bflo(w.x) * sc, bfhi(w.x) * sc, bflo(w.y) * sc, bfhi(w.y) * sc}, (f32x4){bflo(w.z) * sc, bfhi(w.z) * sc, bflo(w.w) * sc, bfhi(w.w) * sc}); } }
    const float fq = F[q];
    float m = ATT_NEG, lsum = 0.f; f32x16 O[2] = {};
    const int NT = (q0 + 256) / 64;
    LAS float* qmx = (LAS float*)(lds + ATT_SC); LAS float* mmv = qmx + 8;
    { float q2 = 0.f;
#pragma unroll
      for (int d0 = 0; d0 < 4; ++d0) { const u32x4 w = __builtin_bit_cast(u32x4, qf[d0]); q2 += bflo(w.x) * bflo(w.x) + bfhi(w.x) * bfhi(w.x) + bflo(w.y) * bflo(w.y) + bfhi(w.y) * bfhi(w.y) + bflo(w.z) * bflo(w.z) + bfhi(w.z) * bfhi(w.z) + bflo(w.w) * bflo(w.w) + bfhi(w.w) * bfhi(w.w); }
      q2 = wave_max(xhalf_sum(q2)); if (lane == 0) { qmx[wave] = q2; mmv[wave] = ATT_NEG; } }
    const float kmax2 = __uint_as_float(((const unsigned*)(p->ws + WS_CTL))[CW_KMAX + l * 8 + h]), fq0 = F[q0];
    const int srow = tid >> 3, sch = tid & 7;
    const bf16_t* kg = U + (size_t)srow * NU + U_K + h * 64 + 8 * sch; const bf16_t* vg = Vt + (size_t)srow * TP + 8 * sch;
    LAS unsigned char* kdst = lds + ATT_KB + (srow * AKS + 8 * sch) * 2; LAS unsigned char* vdst = lds + ATT_VB + (srow * AKS + 8 * sch) * 2;
    u32x4 kr = *(const u32x4*)(kg + (size_t)(NT - 1) * 64 * NU), vr = *(const u32x4*)(vg + (NT - 1) * 64); float fr = tid < 64 ? F[(NT - 1) * 64 + tid] : 0.f;
    *(LAS u32x4*)kdst = kr; *(LAS u32x4*)vdst = vr; if (tid < 64) ((LAS float*)(lds + ATT_FB))[tid] = fr;
    __syncthreads();
    const int ka = krow(li);
    float qkb; { float q2 = qmx[0];
#pragma unroll
      for (int w = 1; w < 8; ++w) q2 = fmaxf(q2, qmx[w]);
      qkb = 1.02f * sqrtf(q2 * kmax2) + fq0; }
    for (int t = NT - 1, buf = 0; t >= 0; --t, buf ^= 1) {
        { float mmin = mmv[0];
#pragma unroll
          for (int w = 1; w < 8; ++w) mmin = fminf(mmin, mmv[w]);
          if (qkb - ((const LAS float*)(lds + ATT_FB))[buf * 64 + 63] < mmin - 40.f) break; }
        if (t > 0) { kr = *(const u32x4*)(kg + (size_t)(t - 1) * 64 * NU); vr = *(const u32x4*)(vg + (t - 1) * 64); if (tid < 64) fr = F[(t - 1) * 64 + tid]; }
        if (64 * t <= q0 + wave * 32 + 31) {
            const LAS bf16_t* Kb = (const LAS bf16_t*)(lds + ATT_KB) + buf * 64 * AKS; const LAS bf16_t* Vb = (const LAS bf16_t*)(lds + ATT_VB) + buf * 64 * AKS; const LAS float* Fb = (const LAS float*)(lds + ATT_FB) + buf * 64;
            f32x16 p0, p1;
#pragma unroll
            for (int g2 = 0; g2 < 2; ++g2) { const f32x4 a = *(const LAS f32x4*)(Fb + 8 * hi + 16 * g2), b = *(const LAS f32x4*)(Fb + 8 * hi + 16 * g2 + 4), c = *(const LAS f32x4*)(Fb + 32 + 8 * hi + 16 * g2), d = *(const LAS f32x4*)(Fb + 32 + 8 * hi + 16 * g2 + 4);
#pragma unroll
                for (int e = 0; e < 4; ++e) { p0[8 * g2 + e] = fq - a[e]; p0[8 * g2 + 4 + e] = fq - b[e]; p1[8 * g2 + e] = fq - c[e]; p1[8 * g2 + 4 + e] = fq - d[e]; } }
#pragma unroll
            for (int d0 = 0; d0 < 4; ++d0) { const bf16x8 a0 = *(const LAS bf16x8*)(Kb + ka * AKS + 16 * d0 + 8 * hi), a1 = *(const LAS bf16x8*)(Kb + (ka + 32) * AKS + 16 * d0 + 8 * hi);
                p0 = __builtin_amdgcn_mfma_f32_32x32x16_bf16(a0, qf[d0], p0, 0, 0, 0); p1 = __builtin_amdgcn_mfma_f32_32x32x16_bf16(a1, qf[d0], p1, 0, 0, 0); }
            if (64 * t + 63 > q0 + wave * 32) {
#pragma unroll
                for (int r = 0; r < 16; ++r) { const int kv = 64 * t + 8 * hi + 16 * (r >> 3) + (r & 7); if (kv > q) p0[r] = -INFINITY; if (kv + 32 > q) p1[r] = -INFINITY; } }
            bf16x8 pb[4];
            softmax_tile<false>(p0, p1, m, lsum, O, pb);
#pragma unroll
            for (int dt = 0; dt < 2; ++dt)
#pragma unroll
                for (int s = 0; s < 4; ++s) { const bf16x8 a = *(const LAS bf16x8*)(Vb + (32 * dt + li) * AKS + 16 * (s & 1) + 32 * (s >> 1) + 8 * hi);
                    O[dt] = __builtin_amdgcn_mfma_f32_32x32x16_bf16(a, pb[s], O[dt], 0, 0, 0); }
        }
        { const float wm = wave_min(m); if (lane == 0) mmv[wave] = wm; }
        if (t > 0) { const int nb = buf ^ 1; *(LAS u32x4*)(kdst + nb * 64 * AKS * 2) = kr; *(LAS u32x4*)(vdst + nb * 64 * AKS * 2) = vr; if (tid < 64) ((LAS float*)(lds + ATT_FB))[nb * 64 + tid] = fr; }
        __syncthreads();
    }
    __syncthreads();
    const float inv = 1.f / xhalf_sum(lsum);
    bf16_t* ob = (bf16_t*)(p->ws + WS_OCAT) + (size_t)1 * NTOK * 512 + (size_t)q * 512 + h * 64;
    u32x2 sgv[2][4];
#pragma unroll
    for (int dt = 0; dt < 2; ++dt)
#pragma unroll
        for (int rg = 0; rg < 4; ++rg) sgv[dt][rg] = *(const u32x2*)(U + (size_t)q * NU + U_BSG + h * 64 + 32 * dt + 8 * rg + 4 * hi);
#pragma unroll
    for (int dt = 0; dt < 2; ++dt)
#pragma unroll
        for (int rg = 0; rg < 4; ++rg) { const int d = 32 * dt + 8 * rg + 4 * hi; const u32x2 sg = sgv[dt][rg];
            u32x2 w; w.x = cvt_pk_bf16(O[dt][rg * 4] * inv * siluf_(bflo(sg.x)), O[dt][rg * 4 + 1] * inv * siluf_(bfhi(sg.x))); w.y = cvt_pk_bf16(O[dt][rg * 4 + 2] * inv * siluf_(bflo(sg.y)), O[dt][rg * 4 + 3] * inv * siluf_(bfhi(sg.y)));
            *(u32x2*)(ob + d) = w; }
}
__device__ __forceinline__ void attn_sample_unit(KP p, int l, int b, int h, LAS unsigned char* lds, int tid) {
    const bf16_t* U = (const bf16_t*)(p->ws + WS_U);
    const int wave = tid >> 6, lane = tid & 63, li = lane & 31, hi = lane >> 5;
    const size_t qrow = (size_t)TP + b * 32 + li;
    const float* G = (const float*)(p->ws + WS_GS) + ((size_t)b * 8 + h) * GS_LEN;
    bf16x8 qf[4];
    { const float sc = 0.125f * LOG2E;
#pragma unroll
      for (int d0 = 0; d0 < 4; ++d0) { const u32x4 w = *(const u32x4*)(U + qrow * NU + U_Q + h * 64 + 16 * d0 + 8 * hi);
          qf[d0] = pack8f((f32x4){bflo(w.x) * sc, bfhi(w.x) * sc, bflo(w.y) * sc, bfhi(w.y) * sc}, (f32x4){bflo(w.z) * sc, bfhi(w.z) * sc, bflo(w.w) * sc, bfhi(w.w) * sc}); } }
    const float fq = G[PAST + li];
    float m = ATT_NEG, lsum = 0.f; f32x16 O[2] = {};
    const float* CK = p->in[I_CK] + (((size_t)l * 32 + b) * PAST) * 512 + h * 64; const float* CV = p->in[I_CV] + (((size_t)l * 32 + b) * PAST) * 512 + h * 64;
    const int ka = krow(li);
    for (int tt = 0; tt < 8; ++tt) {
        const int key0 = (wave * 8 + tt) * 64;
        f32x16 p0, p1;
#pragma unroll
        for (int g2 = 0; g2 < 2; ++g2) { const float* gp = G + key0 + 8 * hi + 16 * g2; const f32x4 a = *(const f32x4*)gp, bq = *(const f32x4*)(gp + 4), c = *(const f32x4*)(gp + 32), d = *(const f32x4*)(gp + 36);
#pragma unroll
            for (int e = 0; e < 4; ++e) { p0[8 * g2 + e] = fq - a[e]; p0[8 * g2 + 4 + e] = fq - bq[e]; p1[8 * g2 + e] = fq - c[e]; p1[8 * g2 + 4 + e] = fq - d[e]; } }
#pragma unroll
        for (int d0 = 0; d0 < 4; ++d0) { const float* k0p = CK + (size_t)(key0 + ka) * 512 + 16 * d0 + 8 * hi; const float* k1p = k0p + (size_t)32 * 512;
            const bf16x8 a0 = pack8f(*(const f32x4*)k0p, *(const f32x4*)(k0p + 4)), a1 = pack8f(*(const f32x4*)k1p, *(const f32x4*)(k1p + 4));
            p0 = __builtin_amdgcn_mfma_f32_32x32x16_bf16(a0, qf[d0], p0, 0, 0, 0); p1 = __builtin_amdgcn_mfma_f32_32x32x16_bf16(a1, qf[d0], p1, 0, 0, 0); }
        bf16x8 pb[4];
        softmax_tile<false>(p0, p1, m, lsum, O, pb);
#pragma unroll
        for (int dt = 0; dt < 2; ++dt)
#pragma unroll
            for (int s = 0; s < 4; ++s) { const float* vp = CV + (size_t)(key0 + 16 * (s & 1) + 32 * (s >> 1) + 8 * hi) * 512 + 32 * dt + li;
                const bf16x8 a = pack8f((f32x4){vp[0], vp[512], vp[1024], vp[1536]}, (f32x4){vp[2048], vp[2560], vp[3072], vp[3584]});
                O[dt] = __builtin_amdgcn_mfma_f32_32x32x16_bf16(a, pb[s], O[dt], 0, 0, 0); }
    }
    if (wave == 7) {
        f32x16 p0, p1 = {};
#pragma unroll
        for (int g2 = 0; g2 < 2; ++g2) { const float* gp = G + PAST + 8 * hi + 16 * g2; const f32x4 a = *(const f32x4*)gp, bq = *(const f32x4*)(gp + 4);
#pragma unroll
            for (int e = 0; e < 4; ++e) { p0[8 * g2 + e] = fq - a[e]; p0[8 * g2 + 4 + e] = fq - bq[e]; } }
#pragma unroll
        for (int d0 = 0; d0 < 4; ++d0) { const bf16x8 a0 = *(const bf16x8*)(U + ((size_t)TP + b * 32 + ka) * NU + U_K + h * 64 + 16 * d0 + 8 * hi);
            p0 = __builtin_amdgcn_mfma_f32_32x32x16_bf16(a0, qf[d0], p0, 0, 0, 0); }
#pragma unroll
        for (int r = 0; r < 16; ++r) { const int kv = 8 * hi + 16 * (r >> 3) + (r & 7); if (kv > li) p0[r] = -INFINITY; }
        bf16x8 pb[4];
        softmax_tile<true>(p0, p1, m, lsum, O, pb);
#pragma unroll
        for (int dt = 0; dt < 2; ++dt)
#pragma unroll
            for (int s = 0; s < 2; ++s) { const bf16_t* vp = U + ((size_t)TP + b * 32 + 16 * s + 8 * hi) * NU + U_V + h * 64 + 32 * dt + li; u32x4 w;
                w.x = (unsigned)vp[0] | ((unsigned)vp[NU] << 16); w.y = (unsigned)vp[2 * NU] | ((unsigned)vp[3 * NU] << 16); w.z = (unsigned)vp[4 * NU] | ((unsigned)vp[5 * NU] << 16); w.w = (unsigned)vp[6 * NU] | ((unsigned)vp[7 * NU] << 16);
                O[dt] = __builtin_amdgcn_mfma_f32_32x32x16_bf16(__builtin_bit_cast(bf16x8, w), pb[s], O[dt], 0, 0, 0); }
    }
    LAS float* Ow = (LAS float*)lds;
    LAS float* ML = Ow + 8 * 32 * 64;
    lsum = xhalf_sum(lsum);
#pragma unroll
    for (int dt = 0; dt < 2; ++dt)
#pragma unroll
        for (int r = 0; r < 16; ++r) Ow[(wave * 32 + dt * 16 + r) * 64 + lane] = O[dt][r];
    if (hi == 0) { ML[(wave * 2) * 32 + li] = m; ML[(wave * 2 + 1) * 32 + li] = lsum; }
    __syncthreads();
    { const int qq = tid & 31, dg = tid >> 5; float M = ATT_NEG;
#pragma unroll
      for (int w = 0; w < 8; ++w) M = fmaxf(M, ML[(w * 2) * 32 + qq]);
      float L = 0.f; f32x4 o = {0.f, 0.f, 0.f, 0.f};
      const int d = 4 * dg, idx0 = (d >> 5) * 16 + ((d >> 3) & 3) * 4, ln = ((d >> 2) & 1) * 32 + qq;
#pragma unroll
      for (int w = 0; w < 8; ++w) { const float f = __builtin_amdgcn_exp2f(ML[(w * 2) * 32 + qq] - M); L += ML[(w * 2 + 1) * 32 + qq] * f;
#pragma unroll
          for (int e = 0; e < 4; ++e) o[e] += Ow[(w * 32 + idx0 + e) * 64 + ln] * f; }
      const float inv = 1.f / L; const size_t row = (size_t)TP + b * 32 + qq;
      const u32x2 sg = *(const u32x2*)(U + row * NU + U_BSG + h * 64 + d);
      u32x2 wv; wv.x = cvt_pk_bf16(o[0] * inv * siluf_(bflo(sg.x)), o[1] * inv * siluf_(bfhi(sg.x))); wv.y = cvt_pk_bf16(o[2] * inv * siluf_(bflo(sg.y)), o[3] * inv * siluf_(bfhi(sg.y)));
      *(u32x2*)((bf16_t*)(p->ws + WS_OCAT) + (size_t)1 * NTOK * 512 + row * 512 + h * 64 + d) = wv; }
    __syncthreads();
}
constexpr int NPHASE = 22;
__global__ void __launch_bounds__(512, 2) hse_fwd(Params p_) {
    const KP kp = (KP)__builtin_amdgcn_kernarg_segment_ptr();
    (void)p_;
    extern __shared__ __attribute__((aligned(16))) unsigned char lds_raw[];
    LAS unsigned char* lds = (LAS unsigned char*)lds_raw;
    const int tid0 = threadIdx.x;
    const int wave0 = __builtin_amdgcn_readfirstlane(tid0 >> 6);
    const int G = gridDim.x, bid = blockIdx.x, ngw = G * 8;
#define PH_LOCALS const KP p = kp_fresh(kp); int tid = wave0 * 64 + (int)__builtin_amdgcn_mbcnt_hi(~0u, __builtin_amdgcn_mbcnt_lo(~0u, 0u)); asm volatile("" : "+v"(tid)); const int lane = tid & 63, wave = __builtin_amdgcn_readfirstlane(tid >> 6), gw = bid * 8 + wave; (void)lane; (void)gw; (void)p;
    if (tid0 < 4) ((LAS unsigned*)(lds + LDS_XB_OFF))[tid0] = 0u;
#if PROBE_ID
    if (tid0 == 0) *(LAS unsigned long long*)(lds + LDS_PROBE_OFF) = 0ull;
#endif
    __syncthreads();
    unsigned* ctl = (unsigned*)(kp->ws + WS_CTL);
    XcdBarrier bar = xcd_barrier_post(ctl + CW_BAR + kp->li * XCD_BAR_WORDS, (volatile LAS unsigned*)(lds + LDS_XB_OFF));
    const int lo = kp->ph_lo, hi = kp->ph_hi;
#define IN(k) (lo <= (k) && (k) < hi)
#ifndef DUP_MASK
#define DUP_MASK 0
#endif
#define NREP(k) (((DUP_MASK >> (k)) & 1) + 1)
#define SEAM(k) do { if (IN(k) && IN((k) + 1)) xcd_barrier(bar); } while (0)
    PT0();
    if (IN(0)) { PH_LOCALS
        for (int u = bid; u < 192; u += G) ada_unit(p, u, lds, tid);
        p0_weights(p, lds, gw, ngw, wave, lane);
    }
    SEAM(0);
    PT1(9);
    for (int l = 0; l < NLAYER; ++l) {
        const int pb = 1 + 10 * l;
        for (int rep = 0; rep < NREP(0); ++rep) { if (rep) xcd_barrier(bar);
        if (IN(pb)) { PH_LOCALS p1_rows(p, l, gw, ngw, lane); } }
        SEAM(pb);
        PT1(10);
        for (int rep = 0; rep < NREP(1); ++rep) { if (rep) xcd_barrier(bar);
        if (IN(pb + 1)) { PH_LOCALS
            pg8::Gemm g{(const bf16_t*)(p->ws + WS_H), (const bf16_t*)(p->ws + WS_WIN) + (size_t)l * NU * 2048, NTOK, NU, 2048};
            pg8::StaticOrder S; S.init(NTOK, NU, G, bid);
            EpiU E{(bf16_t*)(p->ws + WS_U), p->out, p->in[I_BF], l};
            pg8::gemm_phase<EpiU, pg8::StaticOrder>(lds, g, S, E, nullptr);
        }
        }
        SEAM(pb + 1);
        PT1(11);
        for (int rep = 0; rep < NREP(2); ++rep) { if (rep) xcd_barrier(bar);
        if (IN(pb + 2)) { PH_LOCALS
#ifndef DUP_SUB
#define DUP_SUB 0
#endif
            { PT0();
            for (int u = bid; u < NRU * ((DUP_SUB & 1) + 1); u += G) rwkv_r1(p, l, u % NRU, lds, tid);
            PT1(31);
            for (int u = (bid + G - 32) % G; u < 544 * (((DUP_SUB >> 1) & 1) + 1); u += G) conv_unit(p, l, u % 544, lds, tid);
            PT1(32);
            for (int u = (bid + G - 64) % G; u < 544 * (((DUP_SUB >> 2) & 1) + 1); u += G) pool_unit(p, l, u % 544, lds, tid);
            PT1(33);
            for (int u = bid; u < 256; u += G) { vt_tile(p, l, u * 8 + wave, lds, wave, lane); }
            __syncthreads();
            for (int u = (bid + G - 96) % G; u < 32; u += G) gs_unit(p, l, u, lds, tid);
            for (int u = G - 1 - bid; u < 8; u += G) fp_unit(p, l, u, lds, tid);
            if (bid == G / 2) shift_out(p, l, tid);
            PT1(34); }
        }
        }
        SEAM(pb + 2);
        PT1(12);
        for (int rep = 0; rep < NREP(3); ++rep) { if (rep) xcd_barrier(bar);
        if (IN(pb + 3)) { PH_LOCALS
            if (wave < 4) for (int tk = bid * 4 + wave; tk < 1024; tk += G * 4) rwkv_l1_task(p, tk, lane);
            __syncthreads();
            LAS int* qslot = (LAS int*)(lds + LDS_XB_OFF - 16);
            for (;;) {
                if (tid == 0) *qslot = (int)atomicAdd(ctl + CW_QUEUE + 64 * (2 * l + 4 * rep), 1u);
                __syncthreads();
                const int item = *qslot;
                __syncthreads();
                if (item >= 512) break;
                attn_prompt_unit(p, l, item & 7, 63 - (item >> 3), lds, tid);
            }
            for (;;) {
                if (tid == 0) *qslot = (int)atomicAdd(ctl + CW_QUEUE + 64 * (2 * l + 1 + 4 * rep), 1u);
                __syncthreads();
                const int item = *qslot;
                __syncthreads();
                if (item >= 256) break;
                attn_sample_unit(p, l, item >> 3, item & 7, lds, tid);
            }
        }
        }
        SEAM(pb + 3);
        PT1(13);
        if (IN(pb + 4)) { PH_LOCALS if (wave == 0 && bid < 32) rwkv_l2_task(p, l, bid, lane); }
        SEAM(pb + 4);
        PT1(14);
        if (IN(pb + 5)) { PH_LOCALS for (int tk = (wave * G + bid); tk < 512 + 1024; tk += ngw) rwkv_l3_task(p, l, tk, lane); }
        SEAM(pb + 5);
        PT1(15);
        if (IN(pb + 6)) { PH_LOCALS for (int tk = gw; tk < NRU * 2; tk += ngw) rwkv_r3_task(p, l, tk, lane); }
        SEAM(pb + 6);
        PT1(16);
        for (int rep = 0; rep < NREP(7); ++rep) { if (rep) xcd_barrier(bar);
        if (IN(pb + 7)) { PH_LOCALS
            pg8::Gemm g{(const bf16_t*)(p->ws + WS_OCAT), (const bf16_t*)(p->ws + WS_WBR) + (size_t)l * 4 * 2048 * 512, 4 * NTOK, 4 * 2048, 512};
            BranchOrder S{G, bid};
            EpiZ E{(bf16_t*)(p->ws + WS_Z)};
            pg8::gemm_phase<EpiZ, BranchOrder>(lds, g, S, E, nullptr);
        }
        }
        SEAM(pb + 7);
        PT1(17);
        if (IN(pb + 8)) { PH_LOCALS merge_pass(p, bid * 512 + tid, G * 512); }
        SEAM(pb + 8);
        PT1(18);
        if (IN(pb + 9)) { PH_LOCALS
            pg8::Gemm g{(const bf16_t*)(p->ws + WS_MERGED), (const bf16_t*)(p->ws + WS_WOUT) + (size_t)l * 2048 * 2048, NTOK, 2048, 2048};
            pg8::StaticOrder S; S.init(NTOK, 2048, G, bid);
            EpiOut E{p->in[I_XP], p->in[I_XS], (const float*)(p->ws + WS_XBUF), (const float*)(p->ws + WS_ADA), (float*)(p->ws + WS_XBUF), l};
            pg8::gemm_phase<EpiOut, pg8::StaticOrder>(lds, g, S, E, nullptr);
        }
        SEAM(pb + 9);
        PT1(19);
    }
    if (IN(21)) { PH_LOCALS p_final_rows(p, gw, ngw, lane); }
    PT1(20);
#if PROBE_ID
    if (bid == 0 && tid0 == 0) { const unsigned long long w = *(LAS unsigned long long*)(lds + LDS_PROBE_OFF) * PROBE_K, t0 = __builtin_amdgcn_s_memrealtime(); while (__builtin_amdgcn_s_memrealtime() - t0 < w) __builtin_amdgcn_s_sleep(8); }
#endif
#undef IN
#undef SEAM
}
#ifndef MK_SPLIT
#define MK_SPLIT 0
#endif
extern "C" void kernel_launch(void* const* d_in, const int* in_sizes, int n_in, void* d_out, int out_size, void* d_ws, size_t ws_size, hipStream_t stream) {
    static int grid = 0;
    if (grid == 0) {
        if (n_in != N_IN || (size_t)out_size != O_END || ws_size < WS_END) { fprintf(stderr, "kernel_launch: unexpected shapes (n_in %d, out %d, ws %zu)\n", n_in, out_size, ws_size); grid = -1; return; }
        int dev = 0, cus = 0, per_cu = 0;
        if (hipGetDevice(&dev) != hipSuccess || hipDeviceGetAttribute(&cus, hipDeviceAttributeMultiprocessorCount, dev) != hipSuccess) { grid = -1; return; }
        if (hipFuncSetAttribute((const void*)hse_fwd, hipFuncAttributeMaxDynamicSharedMemorySize, LDS_BYTES) != hipSuccess) { fprintf(stderr, "kernel_launch: hipFuncSetAttribute failed\n"); grid = -1; return; }
        if (hipOccupancyMaxActiveBlocksPerMultiprocessor(&per_cu, (const void*)hse_fwd, 512, LDS_BYTES) != hipSuccess || per_cu < 1) fprintf(stderr, "kernel_launch: occupancy query reports %d\n", per_cu);
        (void)hipGetLastError();
        grid = cus;
    }
    if (grid < 0) return;
    if (hipMemsetAsync((char*)d_ws + WS_CTL, 0, CTL_BYTES, stream) != hipSuccess) return;
    Params a{};
    for (int i = 0; i < N_IN; ++i) a.in[i] = (const float*)d_in[i];
    a.out = (float*)d_out; a.ws = (unsigned char*)d_ws;
#if MK_SPLIT
    for (int ph = 0; ph < NPHASE; ++ph) { a.ph_lo = ph; a.ph_hi = ph + 1; a.li = ph; hipLaunchKernelGGL(hse_fwd, dim3(grid), dim3(512), LDS_BYTES, stream, a); }
#else
    a.ph_lo = 0; a.ph_hi = NPHASE; a.li = 0;
    hipLaunchKernelGGL(hse_fwd, dim3(grid), dim3(512), LDS_BYTES, stream, a);
#endif
    const hipError_t le = hipPeekAtLastError();
    if (le != hipSuccess) fprintf(stderr, "kernel_launch: launch failed: %s\n", hipGetErrorName(le));
}
```

```cpp
#include <hip/hip_runtime.h>
#include <cstdio>
#include <cstdint>
namespace pg8 {
#define PG8_LAS __attribute__((address_space(3)))
typedef unsigned short bf16_t;
typedef short bf16x8 __attribute__((ext_vector_type(8)));
typedef float f32x4 __attribute__((ext_vector_type(4)));
typedef unsigned u32x4 __attribute__((ext_vector_type(4)));
constexpr int BM = 256, BK = 64, HALF = 128, HTB = HALF * BK * 2  , STAGE_BYTES = 8 * HTB, NXCD = 8, WGM = 8;

__host__ __device__ __forceinline__ int lds_byte(int r, int c) { const int st = (r >> 4) * 2 + (c >> 5), rr = r & 15, cc = c & 31, ob = rr * 64 + cc * 2; return st * 1024 + (ob ^ (((ob >> 9) & 1) << 5)); }
__host__ __device__ __forceinline__ void stage_rc(int b, int& R, int& C) { const int st = b / 1024, sb = b % 1024, swz = sb ^ (((sb >> 9) & 1) << 5); R = (st >> 1) * 16 + swz / 64; C = (st & 1) * 32 + (swz % 64) / 2; }
__host__ __device__ __forceinline__ int perm32(int rho) { const int n = rho >> 4, i = rho & 15; return 8 * (i >> 2) + 4 * n + (i & 3); }

struct Unit { int pm, pn; };
struct Gemm { const bf16_t* A; const bf16_t* Bt; int M, N, K, ld; };

struct StaticOrder {
    int nM, nN, nwg, G, c;
    __host__ __device__ void init(int M, int N, int G_, int c_) { nM = M / BM; nN = N / BM; nwg = nM * nN; G = G_; c = c_; }
    __host__ __device__ bool next(int i, Unit& u) const {
        const long L = (long)i * G + c; if (L >= nwg) return false;
        int wgid = (int)L; { const int q = nwg / NXCD, r = nwg % NXCD, xcd = wgid % NXCD, off = wgid / NXCD; wgid = (xcd < r ? xcd * (q + 1) : r * (q + 1) + (xcd - r) * q) + off; }
        const int nig = WGM * nN, gid = wgid / nig, fm = gid * WGM, gsz = (nM - fm) < WGM ? (nM - fm) : WGM;
        u.pm = fm + ((wgid % nig) % gsz); u.pn = (wgid % nig) / gsz; return true;
    }
    __device__ __forceinline__ void a_ready(const Unit&) const {}
    __device__ __forceinline__ void done(const Unit&) const {}
};
__device__ __forceinline__ unsigned cvt_pk_bf16(float lo, float hi) { unsigned r; asm volatile("v_cvt_pk_bf16_f32 %0, %1, %2" : "=v"(r) : "v"(lo), "v"(hi)); return r; }
typedef float f32x2 __attribute__((ext_vector_type(2)));
template <class Epi, class Sched, bool STAMP = false>
__device__ __forceinline__ void gemm_phase(PG8_LAS unsigned char* lds, const Gemm g, const Sched& S, const Epi& E, unsigned long long* stamps, int tid_in) {
    int tid = tid_in; asm volatile("" : "+v"(tid));
    const int wid = __builtin_amdgcn_readfirstlane(tid >> 6), lane = tid & 63, wr = wid >> 2, wc = wid & 3, fr = lane & 15, fq = lane >> 4;
    const int K = g.ld, nt = g.K / BK;
    int ts_lo = 0, ts_hi = 0, nts = 0; const unsigned long long rt_entry = STAMP ? (unsigned long long)wall_clock64() : 0ull;
#define PG8_STAMP() do { if (STAMP && wid == 0 && nts < 64) { const unsigned long long _c = (unsigned long long)clock64(); \
        ts_lo = (lane == nts) ? (int)(unsigned)_c : ts_lo; ts_hi = (lane == nts) ? (int)(unsigned)(_c >> 32) : ts_hi; ++nts; } } while (0)
    PG8_STAMP();
    unsigned voffA[2], voffB[2];
#pragma unroll
    for (int i = 0; i < 2; ++i) { int R, C; stage_rc(tid * 16 + i * 8192, R, C); const int Rb = Epi::PERM ? ((R & ~31) + perm32(R & 31)) : R;
        voffA[i] = (unsigned)(R * K + C) * 2u; voffB[i] = (unsigned)(Rb * K + C) * 2u; }
    const size_t kstep = (size_t)(BK * 2);
    const size_t hstep = (size_t)HALF * K * 2;
    const size_t tstep = 2 * hstep;
    const unsigned ldsw = (unsigned)wid * 1024u;
    const int aoff = lds_byte(wr * 64 + fr, fq * 8), boff = lds_byte(wc * 32 + fr, fq * 8);
#define PG8_SA(b, h) (((b) * 2 + (h)) * HTB)
#define PG8_SB(b, h) ((4 + (b) * 2 + (h)) * HTB)
#define PG8_STAGE(bufoff, gbase, voff) do { _Pragma("unroll") for (int _i = 0; _i < 2; ++_i) \
        __builtin_amdgcn_global_load_lds((const unsigned*)((const char*)(gbase) + (voff)[_i]), (PG8_LAS unsigned*)(lds + (bufoff) + ldsw + _i * 8192), 16, 0, 0); } while (0)
#define PG8_LDA(dst, b, h) do { _Pragma("unroll") for (int m = 0; m < 4; ++m) _Pragma("unroll") for (int k = 0; k < 2; ++k) dst[m][k] = *(const PG8_LAS bf16x8*)(lds + PG8_SA(b, h) + aoff + m * 2048 + k * 1024); } while (0)
#define PG8_LDB(dst, b, h) do { _Pragma("unroll") for (int n = 0; n < 2; ++n) _Pragma("unroll") for (int k = 0; k < 2; ++k) dst[n][k] = *(const PG8_LAS bf16x8*)(lds + PG8_SB(b, h) + boff + n * 2048 + k * 1024); } while (0)
#define PG8_MMA(ai, bj, At, Bt) do { __builtin_amdgcn_s_setprio(1); _Pragma("unroll") for (int m = 0; m < 4; ++m) _Pragma("unroll") for (int n = 0; n < 2; ++n) _Pragma("unroll") for (int k = 0; k < 2; ++k) \
        acc[ai][bj][m][n] = __builtin_amdgcn_mfma_f32_16x16x32_bf16(Bt[n][k], At[m][k], acc[ai][bj][m][n], 0, 0, 0); __builtin_amdgcn_s_setprio(0); } while (0)
#define PG8_WAIT_V(n) asm volatile("s_waitcnt vmcnt(" #n ")" ::: "memory")
#define PG8_WAIT_L(n) asm volatile("s_waitcnt lgkmcnt(" #n ")" ::: "memory")
#define PG8_BAR __builtin_amdgcn_s_barrier()
#define PG8_SCHED __builtin_amdgcn_sched_barrier(0)
    Unit cur, nxt; int ui = 0;
    if (!S.next(0, cur)) return;
    f32x4 acc[2][2][4][2];
#pragma unroll
    for (int a = 0; a < 2; ++a)
#pragma unroll
        for (int b = 0; b < 2; ++b)
#pragma unroll
            for (int m = 0; m < 4; ++m)
#pragma unroll
                for (int n = 0; n < 2; ++n) acc[a][b][m][n] = (f32x4){0.f, 0.f, 0.f, 0.f};
    bf16x8 At[4][2], B0[2][2], B1[2][2];
    const char* cA = (const char*)g.A + (size_t)cur.pm * tstep; const char* cB = (const char*)g.Bt + (size_t)cur.pn * tstep;
    S.a_ready(cur);
    PG8_STAGE(PG8_SB(0, 0), cB, voffB); PG8_STAGE(PG8_SA(0, 0), cA, voffA); PG8_STAGE(PG8_SB(0, 1), cB + hstep, voffB); PG8_STAGE(PG8_SA(0, 1), cA + hstep, voffA);
    if (wr == 1) PG8_BAR;
    PG8_WAIT_V(4); PG8_BAR;
    PG8_STAGE(PG8_SB(1, 0), cB + kstep, voffB); PG8_STAGE(PG8_SA(1, 0), cA + kstep, voffA); PG8_STAGE(PG8_SB(1, 1), cB + hstep + kstep, voffB);
    PG8_WAIT_V(6); PG8_BAR;
    PG8_STAMP();
    for (;;) {
        const bool has_next = S.next(ui + 1, nxt);
        const char* nA = has_next ? (const char*)g.A + (size_t)nxt.pm * tstep : cA; const char* nB = has_next ? (const char*)g.Bt + (size_t)nxt.pn * tstep : cB;
        for (int t = 0; t < nt; t += 2) {
            const bool last = (t == nt - 2);
            const char* a1 = cA + (size_t)(t + 1) * kstep;
            const char* a2 = last ? nA : cA + (size_t)(t + 2) * kstep; const char* b2 = last ? nB : cB + (size_t)(t + 2) * kstep;
            const char* a3 = a2 + kstep; const char* b3 = b2 + kstep;
            if (last && has_next) S.a_ready(nxt);
            PG8_LDB(B0, 0, 0); PG8_SCHED; PG8_LDA(At, 0, 0); PG8_STAGE(PG8_SA(1, 1), a1 + hstep, voffA);
            PG8_WAIT_L(8); PG8_BAR; PG8_WAIT_L(0); PG8_MMA(0, 0, At, B0); PG8_BAR; PG8_SCHED;
            PG8_LDB(B1, 0, 1); PG8_STAGE(PG8_SB(0, 0), b2, voffB);
            PG8_BAR; PG8_WAIT_L(0); PG8_MMA(0, 1, At, B1); PG8_BAR;
            PG8_LDA(At, 0, 1); PG8_STAGE(PG8_SA(0, 0), a2, voffA);
            PG8_BAR; PG8_WAIT_L(0); PG8_MMA(1, 0, At, B0); PG8_BAR; PG8_SCHED;
            PG8_STAGE(PG8_SB(0, 1), b2 + hstep, voffB);
            PG8_WAIT_V(6); PG8_BAR; PG8_MMA(1, 1, At, B1); PG8_BAR;
            PG8_LDB(B0, 1, 0); PG8_SCHED; PG8_LDA(At, 1, 0); PG8_STAGE(PG8_SA(0, 1), a2 + hstep, voffA);
            PG8_WAIT_L(8); PG8_BAR; PG8_WAIT_L(0); PG8_MMA(0, 0, At, B0); PG8_BAR; PG8_SCHED;
            PG8_LDB(B1, 1, 1); PG8_STAGE(PG8_SB(1, 0), b3, voffB);
            PG8_BAR; PG8_WAIT_L(0); PG8_MMA(0, 1, At, B1); PG8_BAR;
            PG8_LDA(At, 1, 1); PG8_STAGE(PG8_SA(1, 0), a3, voffA);
            PG8_BAR; PG8_WAIT_L(0); PG8_MMA(1, 0, At, B0); PG8_BAR; PG8_SCHED;
            PG8_STAGE(PG8_SB(1, 1), b3 + hstep, voffB);
            PG8_WAIT_V(6); PG8_BAR; PG8_MMA(1, 1, At, B1); PG8_BAR;
        }
        PG8_STAMP();
        if constexpr (!Epi::AFTER_DRAIN) { E(acc, cur, wr, wc, fr, fq); S.done(cur); }
        PG8_STAMP();
        if (!has_next) break;
#pragma unroll
        for (int a = 0; a < 2; ++a)
#pragma unroll
            for (int b = 0; b < 2; ++b)
#pragma unroll
                for (int m = 0; m < 4; ++m)
#pragma unroll
                    for (int n = 0; n < 2; ++n) acc[a][b][m][n] = (f32x4){0.f, 0.f, 0.f, 0.f};
        cur = nxt; cA = nA; cB = nB; ++ui;
    }
    PG8_WAIT_V(0);
    if (wr == 0) PG8_BAR;
    PG8_BAR;
    if constexpr (Epi::AFTER_DRAIN) { E.fused(acc, cur, wr, wc, fr, fq, lds, wid, lane); S.done(cur); }
    PG8_STAMP();
    if (STAMP && wid == 0) { stamps[lane] = lane < nts ? (((unsigned long long)(unsigned)ts_hi << 32) | (unsigned)ts_lo) : 0ull;
        if (lane == 62) stamps[62] = rt_entry; if (lane == 63) stamps[63] = (unsigned long long)wall_clock64(); }
#undef PG8_STAMP
#undef PG8_SA
#undef PG8_SB
#undef PG8_STAGE
#undef PG8_LDA
#undef PG8_LDB
#undef PG8_MMA
#undef PG8_WAIT_V
#undef PG8_WAIT_L
#undef PG8_BAR
#undef PG8_SCHED
}
}
#define XB_TMO      128
#define XB_XCNT(j)  (256  + 64 * (j))
#define XB_XSUB(j)  (1280 + 64 * (j))
#define XB_XGEN(j)  (2304 + 64 * (j))
#define XB_TOP      3328
#define XB_TOPGEN   3392
#define XCD_BAR_WORDS 3456
#define XB_SPIN_CAP (1u << 18)
#define LAS __attribute__((address_space(3)))

__device__ __forceinline__ unsigned xb_ld(unsigned* p)              { return __hip_atomic_load(p, __ATOMIC_RELAXED, __HIP_MEMORY_SCOPE_AGENT); }
__device__ __forceinline__ unsigned xb_add(unsigned* p, unsigned v) { return __hip_atomic_fetch_add(p, v, __ATOMIC_RELAXED, __HIP_MEMORY_SCOPE_AGENT); }
__device__ __forceinline__ unsigned xb_xcc_id() { return (unsigned)__builtin_amdgcn_s_getreg((3 << 11) | 20) & 0xFu; }
#define XB_SPIN(cond, bar) do { unsigned _sp = 0; while (cond) { __builtin_amdgcn_s_sleep(1); \
    if ((++_sp & 255u) == 0u) { if (xb_ld(&(bar)[XB_TMO])) break; if (_sp > XB_SPIN_CAP) { atomicAdd(&(bar)[XB_TMO], 1u); break; } } } } while (0)

struct XcdBarrier {
    unsigned* bar; unsigned x;
    volatile LAS unsigned* st;
};

__device__ __forceinline__ XcdBarrier xcd_barrier_post(unsigned* bar, volatile LAS unsigned* st) {
    XcdBarrier b; b.bar = bar; b.x = xb_xcc_id(); b.st = st;
    if (threadIdx.x == 0) (void)xb_add(&bar[XB_XCNT(b.x)], 1u);
    return b;
}
__device__ __forceinline__ void xcd_barrier_complete(unsigned* bar, unsigned x, unsigned& nloc, unsigned& nx) {
    const unsigned G = gridDim.x * gridDim.y * gridDim.z;
    unsigned sum, cnt, mine, sp = 0u;
    for (;;) {
        sum = 0u; cnt = 0u; mine = 0u;
#pragma unroll
        for (unsigned j = 0; j < 16; ++j) { const unsigned c = xb_ld(&bar[XB_XCNT(j)]); sum += c; cnt += (c > 0u) ? 1u : 0u; mine = (j == x) ? c : mine; }
        if (sum == G) break;
        __builtin_amdgcn_s_sleep(1);
        if ((++sp & 255u) == 0u) { if (xb_ld(&bar[XB_TMO])) break; if (sp > XB_SPIN_CAP) { atomicAdd(&bar[XB_TMO], 1u); break; } }
    }
    nloc = mine > 0u ? mine : 1u; nx = cnt > 0u ? cnt : 1u;
}

__device__ __forceinline__ void xcd_barrier(const XcdBarrier& b) {
    asm volatile("s_waitcnt vmcnt(0)" ::: "memory");
    __syncthreads();
    if (threadIdx.x == 0) {
        unsigned* bar = b.bar;
        __builtin_amdgcn_s_waitcnt(0);
        unsigned nloc = b.st[0], nx = b.st[1];
        if (nloc == 0u) { xcd_barrier_complete(bar, b.x, nloc, nx); b.st[0] = nloc; b.st[1] = nx; }
        const unsigned old = xb_add(&bar[XB_XSUB(b.x)], 1u);
        const unsigned gen = old / nloc;
        if (old + 1u == (gen + 1u) * nloc) {
            __builtin_amdgcn_fence(__ATOMIC_RELEASE, "agent");
            asm volatile("s_waitcnt vmcnt(0)" ::: "memory");
            const unsigned og = xb_add(&bar[XB_TOP], 1u);
            const unsigned tg = og / nx;
            if (og + 1u == (tg + 1u) * nx) xb_add(&bar[XB_TOPGEN], 1u);
            else XB_SPIN(xb_ld(&bar[XB_TOPGEN]) == tg, bar);
            __builtin_amdgcn_fence(__ATOMIC_ACQUIRE, "agent");
            xb_add(&bar[XB_XGEN(b.x)], 1u);
            asm volatile("s_waitcnt vmcnt(0)" ::: "memory");
        } else {
            XB_SPIN(xb_ld(&bar[XB_XGEN(b.x)]) == gen, bar);
            __builtin_amdgcn_fence(__ATOMIC_ACQUIRE, "agent");
            asm volatile("s_waitcnt vmcnt(0)" ::: "memory");
        }
    }
    __syncthreads();
}
typedef unsigned short bf16_t;
typedef short bf16x8 __attribute__((ext_vector_type(8)));
typedef float f32x4 __attribute__((ext_vector_type(4)));
typedef float f32x16 __attribute__((ext_vector_type(16)));
typedef unsigned u32x4 __attribute__((ext_vector_type(4)));
typedef unsigned u32x2 __attribute__((ext_vector_type(2)));
using pg8::cvt_pk_bf16;

constexpr int DM = 2048, TP = 16384, NSB = 32, TSQ = 32, NTOK = TP + NSB * TSQ, NSEQ = 33, PAST = 4096, NLAYER = 2;
constexpr int NU = 15104;
constexpr int U_AVAL = 0, U_AGATE = 512, U_ASG = 1024, U_Q = 1536, U_K = 2048, U_V = 2560, U_BSG = 3072, U_XC = 3584, U_CSG = 5248, U_DIN = 5760, U_DSG = 6272, U_G = 6784, U_F = 14976;
constexpr int IN_W = 14984, SHIFT_W = 1664;
constexpr float LOG2E = 1.4426950408889634f;
enum { I_XP = 0, I_XS, I_CK, I_CV, I_CLF, I_SCONV, I_SSHIFT, I_SWKV, I_SPOOL, I_CP, I_CS, I_NORMG, I_WADA, I_BADA, I_WIN, I_BF, I_CONVW, I_CONVB, I_CLNG, I_CLNB, I_MU, I_W0, I_W2, I_A0, I_A2,
       I_KK, I_KA, I_RK, I_GNG, I_GNB, I_POOLW, I_POOLB, I_POOLS, I_WBR, I_WOUT, I_FING, N_IN };
constexpr size_t O_YP = 0, O_YS = O_YP + (size_t)TP * DM, O_PK = O_YS + (size_t)1024 * DM, O_PV = O_PK + (size_t)2 * TP * 512, O_PLF = O_PV + (size_t)2 * TP * 512, O_PCONV = O_PLF + (size_t)2 * TP * 8,
                 O_PSHIFT = O_PCONV + 2 * 30 * 512, O_PWKV = O_PSHIFT + 2 * 1664, O_PPOOL = O_PWKV + 2 * 8 * 64 * 64, O_SK = O_PPOOL + 2 * 15 * 512, O_SV = O_SK + (size_t)2 * 1024 * 512,
                 O_SLF = O_SV + (size_t)2 * 1024 * 512, O_SCONV = O_SLF + 2 * 1024 * 8, O_SSHIFT = O_SCONV + (size_t)2 * 32 * 30 * 512, O_SWKV = O_SSHIFT + 2 * 32 * 1664,
                 O_SPOOL = O_SWKV + (size_t)2 * 32 * 8 * 64 * 64, O_END = O_SPOOL + (size_t)2 * 32 * 15 * 512;
static_assert(O_END == 75374848, "output size");
constexpr size_t al256(size_t x) { return (x + 255) & ~(size_t)255; }
constexpr int NCU_CH = 288, NRU = NCU_CH * 8;
constexpr size_t WS_CTL = 0, CTL_BYTES = 512 * 1024;
constexpr size_t WS_WIN = CTL_BYTES;
constexpr size_t WS_WBR = al256(WS_WIN + (size_t)2 * NU * 2048 * 2);
constexpr size_t WS_WOUT = al256(WS_WBR + (size_t)2 * 4 * 2048 * 512 * 2);
constexpr size_t WS_POOLW = al256(WS_WOUT + (size_t)2 * 2048 * 2048 * 2);
constexpr size_t WS_ADA = al256(WS_POOLW + (size_t)2 * 4 * 128 * 128 * 2);
constexpr size_t WS_H = al256(WS_ADA + (size_t)2 * 33 * 6144 * 4);
constexpr size_t WS_U = al256(WS_H + (size_t)NTOK * 2048 * 2);
constexpr size_t WS_XBUF = al256(WS_U + (size_t)NTOK * NU * 2);
constexpr size_t WS_OCAT = al256(WS_XBUF + (size_t)NTOK * 2048 * 4);
constexpr size_t WS_Z = al256(WS_OCAT + (size_t)4 * NTOK * 512 * 2);
constexpr size_t WS_MERGED = al256(WS_Z + (size_t)4 * NTOK * 2048 * 2);
constexpr size_t WS_FP = al256(WS_MERGED + (size_t)NTOK * 2048 * 2);
constexpr int GS_LEN = PAST + TSQ;
constexpr size_t WS_GS = al256(WS_FP + (size_t)8 * TP * 4);
constexpr size_t WS_VT = al256(WS_GS + (size_t)32 * 8 * GS_LEN * 4);
constexpr size_t WS_TQ = al256(WS_VT + (size_t)8 * 64 * TP * 2);
constexpr size_t WS_GM = al256(WS_TQ + (size_t)NRU * 4096 * 4);
constexpr size_t WS_ET = al256(WS_GM + (size_t)NRU * 4096 * 4);
constexpr size_t WS_Y0T = al256(WS_ET + (size_t)NRU * 4096 * 4);
constexpr size_t WS_SC = al256(WS_Y0T + (size_t)NRU * 4096 * 4);
constexpr size_t WS_BONUS = al256(WS_SC + (size_t)NRU * 4096 * 4);
constexpr size_t WS_GG = al256(WS_BONUS + (size_t)NRU * 64 * 4);
constexpr size_t WS_TG = al256(WS_GG + (size_t)16 * 8 * 4096 * 4);
constexpr size_t WS_SG = al256(WS_TG + (size_t)16 * 8 * 4096 * 4);
constexpr size_t WS_XPART = al256(WS_SG + (size_t)16 * 8 * 4096 * 4);
constexpr size_t WS_END = al256(WS_XPART + (size_t)2 * 8 * 1024 * 2048 * 4);
static_assert(WS_END < (size_t)2100 * 1024 * 1024, "workspace map exceeds the guaranteed d_ws size");
constexpr int CW_BAR = 0;
constexpr int CW_QUEUE = 16 * 3456 + 64;
constexpr int CW_KMAX = CW_QUEUE + 64 * 8;
static_assert((CW_KMAX + 64) * 4 <= (int)CTL_BYTES, "ctl");
constexpr int LDS_BYTES = 163840 - 256;
constexpr int LDS_XB_OFF = LDS_BYTES - 16;
constexpr int SLOT_F = 64 * 65;

#ifndef PROBE_ID
#define PROBE_ID 0
#endif
#ifndef PROBE_K
#define PROBE_K 1
#endif
constexpr int LDS_PROBE_OFF = 163840 - 256 - 64;
#if PROBE_ID
#define PT0() unsigned long long _pt0 = (blockIdx.x == 0 && threadIdx.x == 0) ? __builtin_amdgcn_s_memrealtime() : 0ull
#define PT1(id) do { if ((id) == PROBE_ID && blockIdx.x == 0 && threadIdx.x == 0) { *(LAS unsigned long long*)(lds + LDS_PROBE_OFF) += __builtin_amdgcn_s_memrealtime() - _pt0; } _pt0 = (blockIdx.x == 0 && threadIdx.x == 0) ? __builtin_amdgcn_s_memrealtime() : 0ull; } while (0)
#else
#define PT0() do {} while (0)
#define PT1(id) do {} while (0)
#endif
struct Params { const float* in[N_IN]; float* out; unsigned char* ws; int ph_lo, ph_hi, li, pad; };
typedef const __attribute__((address_space(4))) Params* KP;
__device__ __forceinline__ KP kp_fresh(KP k) { asm volatile("" : "+s"(k)); return k; }

__device__ __forceinline__ float bf2f(unsigned short b) { return __uint_as_float(((unsigned)b) << 16); }
__device__ __forceinline__ float bflo(unsigned w) { return __uint_as_float(w << 16); }
__device__ __forceinline__ float bfhi(unsigned w) { return __uint_as_float(w & 0xffff0000u); }
__device__ __forceinline__ unsigned short f2bf(float f) { return (unsigned short)(cvt_pk_bf16(f, 0.f) & 0xffffu); }
__device__ __forceinline__ float sigmoidf_(float x) { return 1.f / (1.f + __expf(-x)); }
__device__ __forceinline__ float siluf_(float x) { return x / (1.f + __expf(-x)); }
__device__ __forceinline__ float log_sigmoidf_(float z) { return fminf(z, 0.f) - log1pf(expf(-fabsf(z))); }
template <int CTRL> __device__ __forceinline__ float dpp_mov(float v) { return __int_as_float(__builtin_amdgcn_update_dpp(0, __float_as_int(v), CTRL, 0xF, 0xF, true)); }
__device__ __forceinline__ float wave_sum(float v) {
    v += dpp_mov<0xB1>(v); v += dpp_mov<0x4E>(v); v += dpp_mov<0x141>(v); v += dpp_mov<0x140>(v);
    const float r0 = __int_as_float(__builtin_amdgcn_readlane(__float_as_int(v), 0)), r1 = __int_as_float(__builtin_amdgcn_readlane(__float_as_int(v), 16));
    const float r2 = __int_as_float(__builtin_amdgcn_readlane(__float_as_int(v), 32)), r3 = __int_as_float(__builtin_amdgcn_readlane(__float_as_int(v), 48));
    return (r0 + r1) + (r2 + r3);
}
__device__ __forceinline__ float wave_max(float v) {
    v = fmaxf(v, dpp_mov<0xB1>(v)); v = fmaxf(v, dpp_mov<0x4E>(v)); v = fmaxf(v, dpp_mov<0x141>(v)); v = fmaxf(v, dpp_mov<0x140>(v));
    const float r0 = __int_as_float(__builtin_amdgcn_readlane(__float_as_int(v), 0)), r1 = __int_as_float(__builtin_amdgcn_readlane(__float_as_int(v), 16));
    const float r2 = __int_as_float(__builtin_amdgcn_readlane(__float_as_int(v), 32)), r3 = __int_as_float(__builtin_amdgcn_readlane(__float_as_int(v), 48));
    return fmaxf(fmaxf(r0, r1), fmaxf(r2, r3));
}
__device__ __forceinline__ float wave_min(float v) { return -wave_max(-v); }
__device__ __forceinline__ float xhalf_max(float m) { const auto rr = __builtin_amdgcn_permlane32_swap(__float_as_uint(m), __float_as_uint(m), false, false); return fmaxf(__uint_as_float(rr[0]), __uint_as_float(rr[1])); }
__device__ __forceinline__ float xhalf_sum(float m) { const auto rr = __builtin_amdgcn_permlane32_swap(__float_as_uint(m), __float_as_uint(m), false, false); return __uint_as_float(rr[0]) + __uint_as_float(rr[1]); }
__device__ __forceinline__ bf16x8 pack8f(const f32x4 a, const f32x4 b) { u32x4 w; w.x = cvt_pk_bf16(a[0], a[1]); w.y = cvt_pk_bf16(a[2], a[3]); w.z = cvt_pk_bf16(b[0], b[1]); w.w = cvt_pk_bf16(b[2], b[3]); return __builtin_bit_cast(bf16x8, w); }
__device__ __forceinline__ float fast_tanh(float x) { const float e = __expf(-2.f * fabsf(x)); const float t = (1.f - e) * __builtin_amdgcn_rcpf(1.f + e); return x < 0.f ? -t : t; }
__device__ __forceinline__ void tr_tile(const float* __restrict__ src, size_t ld, int k0, int c0, int nvalid, bf16_t* __restrict__ dst, int K, LAS float* scr, int lane) {
    float tv[64];
#pragma unroll
    for (int kk = 0; kk < 64; ++kk) tv[kk] = src[(size_t)(k0 + kk) * ld + c0 + (lane < nvalid ? lane : 0)];
#pragma unroll
    for (int kk = 0; kk < 64; ++kk) scr[kk * 65 + lane] = (lane < nvalid) ? tv[kk] : 0.f;
    const int k2 = (lane & 31) * 2, nh = lane >> 5;
#pragma unroll 8
    for (int it = 0; it < 32; ++it) { const int nn = 2 * it + nh; *(unsigned*)(dst + (size_t)nn * K + k0 + k2) = cvt_pk_bf16(scr[k2 * 65 + nn], scr[(k2 + 1) * 65 + nn]); }
}
__device__ __forceinline__ void p0_weights(KP p, LAS unsigned char* lds, int gw, int ngw, int wave, int lane) {
    LAS float* scr = (LAS float*)lds + wave * SLOT_F;
    constexpr int T_WIN = (NU / 64) * 32, T_WBR = 4 * 32 * 8, T_WOUT = 32 * 32, T_POOL = 4 * 2 * 2, T_L = T_WIN + T_WBR + T_WOUT + T_POOL;
    for (int it = gw; it < 2 * T_L; it += ngw) {
        const int l = it / T_L; int r = it % T_L;
        if (r < T_WIN) {
            const int nt = r / 32, kt = r % 32, m0 = nt * 64;
            int c0, nvalid = 64;
            if (m0 < 3072) c0 = m0; else if (m0 < U_F) c0 = m0 + 8; else if (m0 == U_F) { c0 = 3072; nvalid = 8; } else { c0 = 0; nvalid = 0; }
            tr_tile(p->in[I_WIN] + (size_t)l * 2048 * IN_W, IN_W, kt * 64, c0, nvalid, (bf16_t*)(p->ws + WS_WIN) + ((size_t)l * NU + m0) * 2048, 2048, scr, lane);
            continue; }
        r -= T_WIN;
        if (r < T_WBR) {
            const int n = r / 256, q = r % 256, nt = q / 8, kt = q % 8;
            tr_tile(p->in[I_WBR] + ((size_t)(l * 4 + n) * 512) * 2048, 2048, kt * 64, nt * 64, 64, (bf16_t*)(p->ws + WS_WBR) + ((size_t)(l * 4 + n) * 2048 + nt * 64) * 512, 512, scr, lane);
            continue; }
        r -= T_WBR;
        if (r < T_WOUT) {
            const int nt = r / 32, kt = r % 32;
            tr_tile(p->in[I_WOUT] + (size_t)l * 2048 * 2048, 2048, kt * 64, nt * 64, 64, (bf16_t*)(p->ws + WS_WOUT) + ((size_t)l * 2048 + nt * 64) * 2048, 2048, scr, lane);
            continue; }
        r -= T_WOUT;
        {
            const int g = r / 4, q = r % 4, nt = q / 2, kt = q % 2;
            tr_tile(p->in[I_POOLW] + (size_t)(l * 4 + g) * 128 * 128, 128, kt * 64, nt * 64, 64, (bf16_t*)(p->ws + WS_POOLW) + ((size_t)(l * 4 + g) * 128 + nt * 64) * 128, 128, scr, lane);
        }
    }
}
__device__ __forceinline__ void ada_unit(KP p, int unit, LAS unsigned char* lds, int tid) {
    const int wave = tid >> 6, lane = tid & 63, l = unit / 96, n0 = (unit % 96) * 64;
    LAS float* cs = (LAS float*)lds + wave * (33 * 64);
    LAS float* red = (LAS float*)lds + 8 * 33 * 64;
    const float* W = p->in[I_WADA] + (size_t)l * 2048 * 6144;
    const float* cp = p->in[I_CP]; const float* csm = p->in[I_CS];
    float acc[33];
#pragma unroll
    for (int s = 0; s < 33; ++s) acc[s] = 0.f;
    float wv[16];
#pragma unroll
    for (int j = 0; j < 16; ++j) wv[j] = W[(size_t)(wave * 256 + j) * 6144 + n0 + lane];
#pragma unroll 1
    for (int step = 0; step < 16; ++step) {
        const int k0 = wave * 256 + step * 16, kn = wave * 256 + (step < 15 ? step + 1 : step) * 16;
        float wn[16];
#pragma unroll
        for (int j = 0; j < 16; ++j) wn[j] = W[(size_t)(kn + j) * 6144 + n0 + lane];
        if ((step & 3) == 0) {
#pragma unroll
            for (int s = 0; s < 33; ++s) { const float c = (s == 0) ? cp[k0 + lane] : csm[(size_t)(s - 1) * 2048 + k0 + lane]; cs[s * 64 + lane] = siluf_(c); } }
        const int kk0 = (step & 3) * 16;
#pragma unroll
        for (int q4 = 0; q4 < 4; ++q4) {
#pragma unroll
            for (int s = 0; s < 33; ++s) { const f32x4 c4 = *(const LAS f32x4*)(cs + s * 64 + kk0 + 4 * q4); acc[s] += c4.x * wv[4 * q4] + c4.y * wv[4 * q4 + 1] + c4.z * wv[4 * q4 + 2] + c4.w * wv[4 * q4 + 3]; } }
#pragma unroll
        for (int j = 0; j < 16; ++j) wv[j] = wn[j];
    }
#pragma unroll
    for (int s = 0; s < 33; ++s) red[(wave * 33 + s) * 64 + lane] = acc[s];
    __syncthreads();
    for (int idx = tid; idx < 33 * 64; idx += 512) { const int s = idx >> 6, n = idx & 63; float v = p->in[I_BADA][l * 6144 + n0 + n];
#pragma unroll
        for (int w = 0; w < 8; ++w) v += red[(w * 33 + s) * 64 + n];
        ((float*)(p->ws + WS_ADA))[((size_t)l * 33 + s) * 6144 + n0 + n] = v; }
    __syncthreads();
}
__device__ __forceinline__ void load_x8(KP p, int l, int row, int lane, f32x4 (&v)[8]) {
    if (row < TP) { const f32x4* x4 = (const f32x4*)(l == 0 ? p->in[I_XP] + (size_t)row * DM : (const float*)(p->ws + WS_XBUF) + (size_t)row * DM) + lane;
#pragma unroll
        for (int j = 0; j < 8; ++j) v[j] = x4[64 * j]; }
    else { const int r = row - TP; const f32x4* x4 = (const f32x4*)(p->in[I_XS] + (size_t)r * DM) + lane;
#pragma unroll
        for (int j = 0; j < 8; ++j) v[j] = x4[64 * j];
        for (int s = 0; s < 8 * l; ++s) { const f32x4* q4 = (const f32x4*)((const float*)(p->ws + WS_XPART) + ((size_t)s * 1024 + r) * DM) + lane;
#pragma unroll
            for (int j = 0; j < 8; ++j) v[j] += q4[64 * j]; } }
}
__device__ __forceinline__ void p1_rows(KP p, int l, int gw, int ngw, int lane) {
    const f32x4* g4 = (const f32x4*)(p->in[I_NORMG] + l * DM) + lane;
    f32x4 a[8], sh[8]; int cur_seq = -1;
    for (int row = gw; row < NTOK; row += ngw) {
        const int seq = row < TP ? 0 : 1 + ((row - TP) >> 5);
        f32x4 v[8]; float ss = 0.f; load_x8(p, l, row, lane, v);
#pragma unroll
        for (int j = 0; j < 8; ++j) { ss += (v[j].x * v[j].x + v[j].y * v[j].y) + (v[j].z * v[j].z + v[j].w * v[j].w); }
        if (seq != cur_seq) { cur_seq = seq;
            const f32x4* sh4 = (const f32x4*)((const float*)(p->ws + WS_ADA) + ((size_t)l * 33 + seq) * 6144) + lane; const f32x4* sc4 = sh4 + 512;
#pragma unroll
            for (int j = 0; j < 8; ++j) { a[j] = g4[64 * j] * (sc4[64 * j] + 1.f); sh[j] = sh4[64 * j]; } }
        const float rstd = 1.f / sqrtf(wave_sum(ss) * (1.f / DM) + 1e-6f);
        u32x2* o = (u32x2*)((bf16_t*)(p->ws + WS_H) + (size_t)row * DM) + lane;
#pragma unroll
        for (int j = 0; j < 8; ++j) { const f32x4 y = v[j] * rstd * a[j] + sh[j];
            u32x2 w; w.x = cvt_pk_bf16(y.x, y.y); w.y = cvt_pk_bf16(y.z, y.w); o[64 * j] = w; }
    }
}
__device__ __forceinline__ void p_final_rows(KP p, int gw, int ngw, int lane) {
    const f32x4* g4 = (const f32x4*)p->in[I_FING] + lane;
    for (int row = gw; row < NTOK; row += ngw) {
        f32x4 v[8]; float ss = 0.f; load_x8(p, 2, row, lane, v);
#pragma unroll
        for (int j = 0; j < 8; ++j) { ss += (v[j].x * v[j].x + v[j].y * v[j].y) + (v[j].z * v[j].z + v[j].w * v[j].w); }
        const float rstd = 1.f / sqrtf(wave_sum(ss) * (1.f / DM) + 1e-6f);
        f32x4* o = (f32x4*)(p->out + O_YP + (size_t)row * DM) + lane;
#pragma unroll
        for (int j = 0; j < 8; ++j) o[64 * j] = v[j] * rstd * g4[64 * j];
    }
}
struct EpiU {
    static constexpr bool PERM = true, AFTER_DRAIN = false;
    bf16_t* U; float* out; const float* bf; int l;
    __device__ __forceinline__ void operator()(const f32x4 (&acc)[2][2][4][2], const pg8::Unit& u, int wr, int wc, int fr, int fq) const {
        const int row0 = u.pm * 256 + wr * 64 + fr, col0 = u.pn * 256 + wc * 32 + 8 * fq;
#pragma unroll
        for (int ai = 0; ai < 2; ++ai)
#pragma unroll
            for (int m = 0; m < 4; ++m) { bf16_t* rowp = U + (size_t)(row0 + ai * 128 + m * 16) * NU + col0;
#pragma unroll
                for (int bj = 0; bj < 2; ++bj) { const f32x4 v0 = acc[ai][bj][m][0], v1 = acc[ai][bj][m][1];
                    u32x4 w; w.x = cvt_pk_bf16(v0[0], v0[1]); w.y = cvt_pk_bf16(v0[2], v0[3]); w.z = cvt_pk_bf16(v1[0], v1[1]); w.w = cvt_pk_bf16(v1[2], v1[3]);
                    *(u32x4*)(rowp + bj * 128) = w; } }
        if (u.pn >= 8 && u.pn < 12) {
            const bool isv = u.pn >= 10; const int cin = (u.pn - (isv ? 10 : 8)) * 256 + wc * 32 + 8 * fq;
#pragma unroll
            for (int ai = 0; ai < 2; ++ai)
#pragma unroll
                for (int m = 0; m < 4; ++m) { const int row = row0 + ai * 128 + m * 16;
                    float* dst = row < TP ? out + (isv ? O_PV : O_PK) + ((size_t)l * TP + row) * 512 : out + (isv ? O_SV : O_SK) + ((size_t)l * 1024 + (row - TP)) * 512;
#pragma unroll
                    for (int bj = 0; bj < 2; ++bj) { *(f32x4*)(dst + cin + bj * 128) = acc[ai][bj][m][0]; *(f32x4*)(dst + cin + bj * 128 + 4) = acc[ai][bj][m][1]; } }
        }
        if (u.pn == 58 && wc == 0 && fq == 0) {
            const f32x4 b0 = *(const f32x4*)(bf + l * 8), b1 = *(const f32x4*)(bf + l * 8 + 4);
#pragma unroll
            for (int ai = 0; ai < 2; ++ai)
#pragma unroll
                for (int m = 0; m < 4; ++m) { const int row = row0 + ai * 128 + m * 16;
                    float* dst = row < TP ? out + O_PLF + ((size_t)l * TP + row) * 8 : out + O_SLF + ((size_t)l * 1024 + (row - TP)) * 8;
                    const f32x4 z0 = acc[ai][1][m][0] + b0, z1 = acc[ai][1][m][1] + b1; f32x4 o0, o1;
#pragma unroll
                    for (int e = 0; e < 4; ++e) { o0[e] = log_sigmoidf_(z0[e]); o1[e] = log_sigmoidf_(z1[e]); }
                    *(f32x4*)dst = o0; *(f32x4*)(dst + 4) = o1; }
        }
    }
};
struct BranchOrder {
    int G, c;
    __device__ __forceinline__ bool next(int i, pg8::Unit& u) const { const int L = i * G + c; if (L >= 4 * 544) return false; const int n = L / 544, t = L - n * 544; u.pm = n * 68 + (t >> 3); u.pn = n * 8 + (t & 7); return true; }
    __device__ __forceinline__ void a_ready(const pg8::Unit&) const {}
    __device__ __forceinline__ void done(const pg8::Unit&) const {}
};
struct EpiZ {
    static constexpr bool PERM = true, AFTER_DRAIN = false;
    bf16_t* Z; const bf16_t* U;
    __device__ __forceinline__ void operator()(const f32x4 (&acc)[2][2][4][2], const pg8::Unit& u, int wr, int wc, int fr, int fq) const {
        const int row0 = u.pm * 256 + wr * 64 + fr, col0 = (u.pn & 7) * 256 + wc * 32 + 8 * fq;
#pragma unroll
        for (int ai = 0; ai < 2; ++ai)
#pragma unroll
            for (int m = 0; m < 4; ++m) { bf16_t* rowp = Z + (size_t)(row0 + ai * 128 + m * 16) * DM + col0;
#pragma unroll
                for (int bj = 0; bj < 2; ++bj) { const f32x4 v0 = acc[ai][bj][m][0], v1 = acc[ai][bj][m][1];
                    u32x4 w; w.x = cvt_pk_bf16(v0[0], v0[1]); w.y = cvt_pk_bf16(v0[2], v0[3]); w.z = cvt_pk_bf16(v1[0], v1[1]); w.w = cvt_pk_bf16(v1[2], v1[3]);
                    *(u32x4*)(rowp + bj * 128) = w; } }
    }
};
__device__ __forceinline__ void merge_pass(KP p, int l, int gtid, int ngt) {
    const bf16_t* U = (const bf16_t*)(p->ws + WS_U); const bf16_t* Z = (const bf16_t*)(p->ws + WS_Z); bf16_t* M = (bf16_t*)(p->ws + WS_MERGED);
    for (int it0 = gtid; it0 < NTOK * 256; it0 += 3 * ngt) {
        u32x4 gv[3][4], zv[3][4];
#pragma unroll
        for (int k = 0; k < 3; ++k) { const int it = it0 + k * ngt < NTOK * 256 ? it0 + k * ngt : it0; const int row = it >> 8, col = (it & 255) * 8;
#pragma unroll
            for (int n = 0; n < 4; ++n) { gv[k][n] = *(const u32x4*)(U + (size_t)row * NU + U_G + n * 2048 + col); zv[k][n] = *(const u32x4*)(Z + ((size_t)n * NTOK + row) * DM + col); } }
#pragma unroll
        for (int k = 0; k < 3; ++k) { const int it = it0 + k * ngt; if (it < NTOK * 256) { const int row = it >> 8, col = (it & 255) * 8;
            float s[8];
#pragma unroll
            for (int e = 0; e < 8; ++e) s[e] = 0.f;
#pragma unroll
            for (int n = 0; n < 4; ++n) { const u32x4 g = gv[k][n], z = zv[k][n];
                s[0] += sigmoidf_(bflo(g.x)) * bflo(z.x); s[1] += sigmoidf_(bfhi(g.x)) * bfhi(z.x); s[2] += sigmoidf_(bflo(g.y)) * bflo(z.y); s[3] += sigmoidf_(bfhi(g.y)) * bfhi(z.y);
                s[4] += sigmoidf_(bflo(g.z)) * bflo(z.z); s[5] += sigmoidf_(bfhi(g.z)) * bfhi(z.z); s[6] += sigmoidf_(bflo(g.w)) * bflo(z.w); s[7] += sigmoidf_(bfhi(g.w)) * bfhi(z.w); }
            u32x4 w; w.x = cvt_pk_bf16(s[0], s[1]); w.y = cvt_pk_bf16(s[2], s[3]); w.z = cvt_pk_bf16(s[4], s[5]); w.w = cvt_pk_bf16(s[6], s[7]);
            *(u32x4*)(M + (size_t)row * DM + col) = w; } }
    }
}
struct EpiOut {
    static constexpr bool PERM = false, AFTER_DRAIN = false;
    const float* xp; const float* xs; const float* xb; const float* ada; float* xout; int l;
    __device__ __forceinline__ void operator()(const f32x4 (&acc)[2][2][4][2], const pg8::Unit& u, int wr, int wc, int fr, int fq) const {
        const int row0 = u.pm * 256 + wr * 64 + fr, col0 = u.pn * 256 + wc * 32 + 4 * fq;
        f32x4 gt[2][2];
#pragma unroll
        for (int ai = 0; ai < 2; ++ai)
#pragma unroll
            for (int mp = 0; mp < 4; mp += 2) {
                f32x4 bs[2][2][2], gv[2][2][2];
#pragma unroll
                for (int mm = 0; mm < 2; ++mm) { const int row = row0 + ai * 128 + (mp + mm) * 16;
                    const float* base = l == 0 ? (row < TP ? xp + (size_t)row * DM : xs + (size_t)(row - TP) * DM) : xb + (size_t)row * DM;
                    const float* gate = ada + ((size_t)l * 33 + (row < TP ? 0 : 1 + ((row - TP) >> 5))) * 6144 + 4096;
#pragma unroll
                    for (int bj = 0; bj < 2; ++bj)
#pragma unroll
                        for (int n = 0; n < 2; ++n) { const int col = col0 + bj * 128 + n * 16; bs[mm][bj][n] = *(const f32x4*)(base + col); gv[mm][bj][n] = *(const f32x4*)(gate + col); } }
#pragma unroll
                for (int mm = 0; mm < 2; ++mm) { const int row = row0 + ai * 128 + (mp + mm) * 16;
#pragma unroll
                    for (int bj = 0; bj < 2; ++bj)
#pragma unroll
                        for (int n = 0; n < 2; ++n) { const int col = col0 + bj * 128 + n * 16; *(f32x4*)(xout + (size_t)row * DM + col) = bs[mm][bj][n] + gv[mm][bj][n] * acc[ai][bj][mp + mm][n]; } }
            }
        (void)gt;
    }
};
struct OneUnit {
    int pm, pn; bool valid;
    __device__ __forceinline__ bool next(int i, pg8::Unit& u) const { if (i > 0 || !valid) return false; u.pm = pm; u.pn = pn; return true; }
    __device__ __forceinline__ void a_ready(const pg8::Unit&) const {}
    __device__ __forceinline__ void done(const pg8::Unit&) const {}
};
struct EpiOutPart {
    static constexpr bool PERM = false, AFTER_DRAIN = false;
    const float* ada; float* part; int l;
    __device__ __forceinline__ void operator()(const f32x4 (&acc)[2][2][4][2], const pg8::Unit& u, int wr, int wc, int fr, int fq) const {
        const int row0 = u.pm * 256 + wr * 64 + fr - TP, col0 = u.pn * 256 + wc * 32 + 4 * fq;
#pragma unroll
        for (int ai = 0; ai < 2; ++ai)
#pragma unroll
            for (int m = 0; m < 4; ++m) { const int r = row0 + ai * 128 + m * 16;
                const float* gate = ada + ((size_t)l * 33 + 1 + (r >> 5)) * 6144 + 4096;
#pragma unroll
                for (int bj = 0; bj < 2; ++bj)
#pragma unroll
                    for (int n = 0; n < 2; ++n) { const int col = col0 + bj * 128 + n * 16; *(f32x4*)(part + (size_t)r * DM + col) = *(const f32x4*)(gate + col) * acc[ai][bj][m][n]; } }
    }
};
constexpr int CGS = 516;
__device__ __forceinline__ void conv_unit(KP p, int l, int tile, LAS unsigned char* lds, int tid) {
    const bf16_t* U = (const bf16_t*)(p->ws + WS_U);
    const int c = tid, wave = tid >> 6, lane = tid & 63;
    const bool samp = tile >= 512; const int b = tile - 512, row0 = samp ? TP + b * 32 : tile * 32;
    const bool last = samp || tile == 511;
    LAS float* gl = (LAS float*)lds;
    LAS bf16_t* sgl = (LAS bf16_t*)(lds + 62 * CGS * 4);
    LAS float* red = (LAS float*)(lds + 62 * CGS * 4 + 32 * 512 * 2);
    LAS float* st = red + 8 * 32;
#pragma unroll
    for (int k = 0; k < 8; ++k) { const int task = tid + 512 * k; if (task < 62 * 64) { const int i = task >> 6, ch = task & 63; f32x4 o0, o1;
        const int rel = i - 30;
        if (rel < 0 && samp) { const float* hp = p->in[I_SCONV] + (((size_t)l * 32 + b) * 30 + i) * 512 + 8 * ch; o0 = *(const f32x4*)hp; o1 = *(const f32x4*)(hp + 4); }
        else if (row0 + rel < 0) { o0 = (f32x4){0.f, 0.f, 0.f, 0.f}; o1 = o0; }
        else { const bf16_t* up = U + (size_t)(row0 + rel) * NU + 8 * ch; const u32x4 v = *(const u32x4*)(up + U_AVAL), g = *(const u32x4*)(up + U_AGATE);
            o0 = (f32x4){bflo(v.x) * sigmoidf_(bflo(g.x)), bfhi(v.x) * sigmoidf_(bfhi(g.x)), bflo(v.y) * sigmoidf_(bflo(g.y)), bfhi(v.y) * sigmoidf_(bfhi(g.y))};
            o1 = (f32x4){bflo(v.z) * sigmoidf_(bflo(g.z)), bfhi(v.z) * sigmoidf_(bfhi(g.z)), bflo(v.w) * sigmoidf_(bflo(g.w)), bfhi(v.w) * sigmoidf_(bfhi(g.w))}; }
        *(LAS f32x4*)(gl + i * CGS + 8 * ch) = o0; *(LAS f32x4*)(gl + i * CGS + 8 * ch + 4) = o1; } }
#pragma unroll
    for (int k = 0; k < 4; ++k) { const int task = tid + 512 * k, t = task >> 6, ch = task & 63; const u32x4 s = *(const u32x4*)(U + (size_t)(row0 + t) * NU + U_ASG + 8 * ch);
        u32x4 w; w.x = cvt_pk_bf16(siluf_(bflo(s.x)), siluf_(bfhi(s.x))); w.y = cvt_pk_bf16(siluf_(bflo(s.y)), siluf_(bfhi(s.y))); w.z = cvt_pk_bf16(siluf_(bflo(s.z)), siluf_(bfhi(s.z))); w.w = cvt_pk_bf16(siluf_(bflo(s.w)), siluf_(bfhi(s.w)));
        *(LAS u32x4*)(sgl + t * 512 + 8 * ch) = w; }
    const float cb = p->in[I_CONVB][l * 512 + c], lg = p->in[I_CLNG][l * 512 + c], lb = p->in[I_CLNB][l * 512 + c];
    float wk[31];
#pragma unroll
    for (int k = 0; k < 31; ++k) wk[k] = p->in[I_CONVW][((size_t)l * 31 + k) * 512 + c];
    __syncthreads();
    if (last) {
        float* dst = samp ? p->out + O_SCONV + (((size_t)l * 32 + b) * 30) * 512 + c : p->out + O_PCONV + ((size_t)l * 30) * 512 + c;
#pragma unroll
        for (int t = 2; t < 32; ++t) dst[(size_t)(t - 2) * 512] = gl[(30 + t) * CGS + c];
    }
    bf16_t* oa = (bf16_t*)(p->ws + WS_OCAT);
#pragma unroll 1
    for (int half = 0; half < 2; ++half) {
        float z[46];
#pragma unroll
        for (int i = 0; i < 46; ++i) z[i] = gl[(16 * half + i) * CGS + c];
        float hv[16];
#pragma unroll
        for (int tt = 0; tt < 16; ++tt) hv[tt] = cb;
#pragma unroll
        for (int k = 0; k < 31; ++k) {
#pragma unroll
            for (int tt = 0; tt < 16; ++tt) hv[tt] += z[tt + k] * wk[k]; }
#pragma unroll
        for (int tt = 0; tt < 16; ++tt) { const float s1 = wave_sum(hv[tt]), s2 = wave_sum(hv[tt] * hv[tt]); if (lane == 0) { red[(wave * 16 + tt) * 2] = s1; red[(wave * 16 + tt) * 2 + 1] = s2; } }
        __syncthreads();
        if (tid < 16) { float s1 = 0.f, s2 = 0.f;
#pragma unroll
            for (int w = 0; w < 8; ++w) { s1 += red[(w * 16 + tid) * 2]; s2 += red[(w * 16 + tid) * 2 + 1]; }
            const float mean = s1 * (1.f / 512.f), var = fmaxf(s2 * (1.f / 512.f) - mean * mean, 0.f);
            st[tid * 2] = mean; st[tid * 2 + 1] = 1.f / sqrtf(var + 1e-5f); }
        __syncthreads();
#pragma unroll
        for (int tt = 0; tt < 16; ++tt) { const float y = (hv[tt] - st[tt * 2]) * st[tt * 2 + 1] * lg + lb; const int t = 16 * half + tt;
            oa[(size_t)(row0 + t) * 512 + c] = f2bf(siluf_(y) * bf2f(sgl[t * 512 + c])); }
    }
    __syncthreads();
}
__device__ __forceinline__ void pool_unit(KP p, int l, int tile, LAS unsigned char* lds, int tid) {
    const bf16_t* U = (const bf16_t*)(p->ws + WS_U);
    const int c = tid, wave = tid >> 6, lane = tid & 63;
    const bool samp = tile >= 512; const int b = tile - 512, row0 = samp ? TP + b * 32 : tile * 32;
    constexpr int PST = 520;
    LAS float* zl = (LAS float*)lds;
    LAS bf16_t* pl = (LAS bf16_t*)(lds + 47 * CGS * 4);
#pragma unroll
    for (int k = 0; k < 6; ++k) { const int task = tid + 512 * k; if (task < 47 * 64) { const int i = task >> 6, ch = task & 63; f32x4 o0, o1; const int rel = i - 15;
        if (rel < 0 && samp) { const float* hp = p->in[I_SPOOL] + (((size_t)l * 32 + b) * 15 + i) * 512 + 8 * ch; o0 = *(const f32x4*)hp; o1 = *(const f32x4*)(hp + 4); }
        else if (row0 + rel < 0) { o0 = (f32x4){0.f, 0.f, 0.f, 0.f}; o1 = o0; }
        else { const u32x4 v = *(const u32x4*)(U + (size_t)(row0 + rel) * NU + U_DIN + 8 * ch); o0 = (f32x4){bflo(v.x), bfhi(v.x), bflo(v.y), bfhi(v.y)}; o1 = (f32x4){bflo(v.z), bfhi(v.z), bflo(v.w), bfhi(v.w)}; }
        *(LAS f32x4*)(zl + i * CGS + 8 * ch) = o0; *(LAS f32x4*)(zl + i * CGS + 8 * ch + 4) = o1; } }
    u32x4 sgv[4];
#pragma unroll
    for (int k = 0; k < 4; ++k) { const int task = tid + 512 * k; sgv[k] = *(const u32x4*)(U + (size_t)(row0 + (task >> 6)) * NU + U_DSG + 8 * (task & 63)); }
    __syncthreads();
    {
        float z[47];
#pragma unroll
        for (int i = 0; i < 47; ++i) z[i] = zl[i * CGS + c];
        if (samp || tile == 511) {
            float* dst = samp ? p->out + O_SPOOL + (((size_t)l * 32 + b) * 15) * 512 + c : p->out + O_PPOOL + ((size_t)l * 15) * 512 + c;
#pragma unroll
            for (int t = 17; t < 32; ++t) dst[(size_t)(t - 17) * 512] = z[15 + t];
        }
        const int w = 2 << (c >> 7);
#pragma unroll
        for (int t = 0; t < 32; ++t) { float s = 0.f;
#pragma unroll
            for (int i = 0; i < 16; ++i) s += (i < w) ? z[15 + t - i] : 0.f;
            const int pos = samp ? PAST + t : row0 + t; const int cnt = (pos + 1 < w) ? pos + 1 : w;
            pl[t * PST + c] = f2bf(s / (float)cnt - z[15 + t]); }
    }
    __syncthreads();
    LAS bf16_t* sl = (LAS bf16_t*)lds;
    LAS bf16_t* ol = sl + 32 * PST;
#pragma unroll
    for (int k = 0; k < 4; ++k) { const int task = tid + 512 * k, t = task >> 6, ch = task & 63; const u32x4 s = sgv[k];
        u32x4 w; w.x = cvt_pk_bf16(siluf_(bflo(s.x)), siluf_(bfhi(s.x))); w.y = cvt_pk_bf16(siluf_(bflo(s.y)), siluf_(bfhi(s.y))); w.z = cvt_pk_bf16(siluf_(bflo(s.z)), siluf_(bfhi(s.z))); w.w = cvt_pk_bf16(siluf_(bflo(s.w)), siluf_(bfhi(s.w)));
        *(LAS u32x4*)(sl + t * PST + 8 * ch) = w; }
    __syncthreads();
    {
        const int g = wave >> 1, fr = lane & 15, kq = lane >> 4;
        const bf16_t* WT = (const bf16_t*)(p->ws + WS_POOLW) + (size_t)(l * 4 + g) * 128 * 128;
        f32x4 acc[2][4];
#pragma unroll
        for (int mt = 0; mt < 2; ++mt)
#pragma unroll
            for (int nt = 0; nt < 4; ++nt) acc[mt][nt] = (f32x4){0.f, 0.f, 0.f, 0.f};
#pragma unroll
        for (int ks = 0; ks < 4; ++ks) {
            bf16x8 af[2];
#pragma unroll
            for (int mt = 0; mt < 2; ++mt) af[mt] = *(const LAS bf16x8*)(pl + (16 * mt + fr) * PST + g * 128 + 32 * ks + 8 * kq);
#pragma unroll
            for (int nt = 0; nt < 4; ++nt) { const int dl = (wave & 1) * 64 + 16 * nt + fr;
                const bf16x8 bfr = *(const bf16x8*)(WT + (size_t)dl * 128 + 32 * ks + 8 * kq);
#pragma unroll
                for (int mt = 0; mt < 2; ++mt) acc[mt][nt] = __builtin_amdgcn_mfma_f32_16x16x32_bf16(af[mt], bfr, acc[mt][nt], 0, 0, 0); }
        }
#pragma unroll
        for (int nt = 0; nt < 4; ++nt) { const int d = wave * 64 + 16 * nt + fr; const float pb = p->in[I_POOLB][l * 512 + d], ps = p->in[I_POOLS][l * 512 + d];
#pragma unroll
            for (int mt = 0; mt < 2; ++mt)
#pragma unroll
                for (int r = 0; r < 4; ++r) { const int t = 16 * mt + 4 * kq + r; ol[t * PST + d] = f2bf((acc[mt][nt][r] + pb) * ps * bf2f(sl[t * PST + d])); } }
    }
    __syncthreads();
    bf16_t* od = (bf16_t*)(p->ws + WS_OCAT) + (size_t)3 * NTOK * 512;
#pragma unroll
    for (int k = 0; k < 4; ++k) { const int task = tid + 512 * k, t = task >> 6, ch = task & 63; *(u32x4*)(od + (size_t)(row0 + t) * 512 + 8 * ch) = *(const LAS u32x4*)(ol + t * PST + 8 * ch); }
    __syncthreads();
}
__device__ __forceinline__ void fp_unit(KP p, int l, int h, LAS unsigned char* lds, int tid) {
    const float* lf = p->out + O_PLF + (size_t)l * TP * 8 + h;
    LAS float* part = (LAS float*)lds;
    float v[32]; float s = 0.f;
#pragma unroll
    for (int i = 0; i < 32; ++i) { v[i] = lf[(size_t)(tid * 32 + i) * 8]; s += v[i]; }
    part[tid] = s;
    __syncthreads();
    float pre = 0.f;
    for (int j = 0; j < tid; ++j) pre += part[j];
    float* F = (float*)(p->ws + WS_FP) + (size_t)h * TP + tid * 32;
#pragma unroll
    for (int i = 0; i < 32; ++i) { pre += v[i]; F[i] = pre * LOG2E; }
    __syncthreads();
}
__device__ __forceinline__ void gs_unit(KP p, int l, int b, LAS unsigned char* lds, int tid) {
    const int h = tid & 7, ch = tid >> 3;
    const float* cl = p->in[I_CLF] + (((size_t)l * 32 + b) * PAST + ch * 64) * 8 + h;
    LAS float* part = (LAS float*)lds;
    float v[64]; float s = 0.f;
#pragma unroll
    for (int i = 0; i < 64; ++i) v[i] = cl[(size_t)i * 8];
#pragma unroll
    for (int i = 0; i < 64; ++i) s += v[i];
    part[ch * 8 + h] = s;
    __syncthreads();
    float suf = 0.f;
    for (int j = ch + 1; j < 64; ++j) suf += part[j * 8 + h];
    float* G = (float*)(p->ws + WS_GS) + ((size_t)b * 8 + h) * GS_LEN + ch * 64;
#pragma unroll
    for (int i = 63; i >= 0; --i) { G[i] = -suf * LOG2E; suf += v[i]; }
    if (tid < 8) { const float* nl = p->out + O_SLF + ((size_t)l * 1024 + b * 32) * 8 + tid; float* Gn = (float*)(p->ws + WS_GS) + ((size_t)b * 8 + tid) * GS_LEN + PAST; float w[32]; float run = 0.f;
#pragma unroll
        for (int i = 0; i < 32; ++i) w[i] = nl[i * 8];
#pragma unroll
        for (int i = 0; i < 32; ++i) { run += w[i]; Gn[i] = run * LOG2E; } }
    __syncthreads();
}
__device__ __forceinline__ void vt_tile(KP p, int l, int tile, LAS unsigned char* lds, int wave, int lane) {
    const int h = tile >> 8, tb = tile & 255;
    const bf16_t* U = (const bf16_t*)(p->ws + WS_U);
    LAS unsigned* scr = (LAS unsigned*)lds + wave * SLOT_F;
#pragma unroll 8
    for (int tt = 0; tt < 64; ++tt) scr[tt * 65 + lane] = U[(size_t)(tb * 64 + tt) * NU + U_V + h * 64 + lane];
    {
        float mx = 0.f;
#pragma unroll 8
        for (int tt = 0; tt < 64; ++tt) { const float kv = bf2f(U[(size_t)(tb * 64 + tt) * NU + U_K + h * 64 + lane]); mx = fmaxf(mx, wave_sum(kv * kv)); }
        if (lane == 0) atomicMax((unsigned*)(p->ws + WS_CTL) + CW_KMAX + l * 8 + h, __float_as_uint(mx));
    }
    bf16_t* Vt = (bf16_t*)(p->ws + WS_VT);
    const int t2 = (lane & 31) * 2, dh = lane >> 5;
#pragma unroll 8
    for (int it = 0; it < 32; ++it) { const int d = 2 * it + dh; *(unsigned*)(Vt + ((size_t)h * 64 + d) * TP + tb * 64 + t2) = scr[t2 * 65 + d] | (scr[(t2 + 1) * 65 + d] << 16); }
}
__device__ __forceinline__ void shift_out(KP p, int l, int tid) {
    const bf16_t* U = (const bf16_t*)(p->ws + WS_U);
    for (int base = tid; base < NSEQ * SHIFT_W; base += 512 * 8) {
        unsigned short v[8];
#pragma unroll
        for (int k = 0; k < 8; ++k) { const int idx = base + k * 512 < NSEQ * SHIFT_W ? base + k * 512 : tid; const int s = idx / SHIFT_W, j = idx - s * SHIFT_W; const int row = s == 0 ? TP - 1 : TP + (s - 1) * 32 + 31; v[k] = U[(size_t)row * NU + U_XC + j]; }
#pragma unroll
        for (int k = 0; k < 8; ++k) { const int idx = base + k * 512; if (idx < NSEQ * SHIFT_W) { const int s = idx / SHIFT_W, j = idx - s * SHIFT_W;
            float* dst = s == 0 ? p->out + O_PSHIFT + (size_t)l * SHIFT_W + j : p->out + O_SSHIFT + ((size_t)l * 32 + (s - 1)) * SHIFT_W + j; *dst = bf2f(v[k]); } }
    }
}
template <bool AT, bool BT, bool NEGA>
__device__ __forceinline__ void mm32(f32x16& acc, const LAS float* Ap, int i0, const LAS float* Bp, int j0, int lane) {
    const int li = lane & 31, kh = lane >> 5;
    const LAS float* ap = AT ? Ap + (8 * kh) * 65 + i0 + li : Ap + (i0 + li) * 65 + 8 * kh;
    const LAS float* bp = BT ? Bp + (j0 + li) * 65 + 8 * kh : Bp + (8 * kh) * 65 + j0 + li;
#pragma unroll 2
    for (int s = 0; s < 4; ++s) {
        float a[8], b[8];
#pragma unroll
        for (int e = 0; e < 8; ++e) { a[e] = AT ? ap[(16 * s + e) * 65] : ap[16 * s + e]; b[e] = BT ? bp[16 * s + e] : bp[(16 * s + e) * 65]; }
        if (NEGA) {
#pragma unroll
            for (int e = 0; e < 8; ++e) a[e] = -a[e]; }
        const bf16x8 af = pack8f((f32x4){a[0], a[1], a[2], a[3]}, (f32x4){a[4], a[5], a[6], a[7]}), bfg = pack8f((f32x4){b[0], b[1], b[2], b[3]}, (f32x4){b[4], b[5], b[6], b[7]});
        acc = __builtin_amdgcn_mfma_f32_32x32x16_bf16(af, bfg, acc, 0, 0, 0);
    }
}
template <int MASK>
__device__ __forceinline__ void st_tile(LAS float* dst, const f32x16& acc, int i0, int j0, int lane) {
    const int li = lane & 31, hi = lane >> 5, j = j0 + li;
#pragma unroll
    for (int r = 0; r < 16; ++r) { const int i = i0 + (r & 3) + 8 * (r >> 2) + 4 * hi; float v = acc[r];
        if (MASK == 1 && !(i < j)) v = 0.f; if (MASK == 2 && !(i <= j)) v = 0.f; dst[i * 65 + j] = v; }
}
struct RwkvSeqInfo { int row0, ntok, prev_kind  , b; };
__device__ __forceinline__ RwkvSeqInfo rwkv_info(int cu) { RwkvSeqInfo s; if (cu < 256) { s.row0 = cu * 64; s.ntok = 64; s.prev_kind = cu == 0 ? 0 : 1; s.b = 0; } else { s.b = cu - 256; s.row0 = TP + s.b * 32; s.ntok = 32; s.prev_kind = 2; } return s; }

__device__ __forceinline__ void rwkv_r1(KP p, int l, int unit, LAS unsigned char* lds, int tid) {
    const int cu = unit >> 3, h = unit & 7, wave = tid >> 6, lane = tid & 63, li = lane & 31, hi = lane >> 5;
    const RwkvSeqInfo si = rwkv_info(cu);
    const bf16_t* U = (const bf16_t*)(p->ws + WS_U);
    LAS float* S0 = (LAS float*)lds; LAS float *S1 = S0 + SLOT_F, *S2 = S0 + 2 * SLOT_F, *S3 = S0 + 3 * SLOT_F, *S4 = S0 + 4 * SLOT_F, *S5 = S0 + 5 * SLOT_F, *S6 = S0 + 6 * SLOT_F, *S7 = S0 + 7 * SLOT_F, *S8 = S0 + 8 * SLOT_F;
    LAS float* gC = S0 + 9 * SLOT_F;
    const int q = wave >> 2, wq = wave & 3, i0 = (wq >> 1) * 32, j0 = (wq & 1) * 32;
    PT0();
    {
        const int j = tid & 63, tq = tid >> 6;
        const int tl = lane >> 3, q8 = (lane & 7) * 8;
#pragma unroll
        for (int kb = 0; kb < 5; kb += 3) {
        u32x4 cur[5], prv[5];
#pragma unroll
        for (int k = kb; k < (kb + 3 < 5 ? kb + 3 : 5); ++k) { const int pid = wave * 5 + k, s = pid >> 3, tb = pid & 7, t = tb * 8 + tl;
            const int xo = (s < 3 ? s * 512 + h * 64 : 1536 + (s - 3) * 64) + q8;
            const int tc = t < si.ntok ? t : si.ntok - 1, tp = tc > 0 ? tc - 1 : (si.prev_kind == 1 ? -1 : 0);
            cur[k] = *(const u32x4*)(U + (size_t)(si.row0 + tc) * NU + U_XC + xo); prv[k] = *(const u32x4*)(U + (size_t)(si.row0 + tp) * NU + U_XC + xo); }
#pragma unroll
        for (int k = kb; k < (kb + 3 < 5 ? kb + 3 : 5); ++k) { const int pid = wave * 5 + k, s = pid >> 3, tb = pid & 7, t = tb * 8 + tl;
            const int xo = (s < 3 ? s * 512 + h * 64 : 1536 + (s - 3) * 64) + q8;
            LAS float* dst = (s == 0 ? S0 : s == 1 ? S1 : s == 2 ? S2 : s == 3 ? S3 : S4) + t * 65 + q8;
            const f32x4 m0 = *(const f32x4*)(p->in[I_MU] + l * SHIFT_W + xo), m1 = *(const f32x4*)(p->in[I_MU] + l * SHIFT_W + xo + 4);
            float x[8] = {bflo(cur[k].x), bfhi(cur[k].x), bflo(cur[k].y), bfhi(cur[k].y), bflo(cur[k].z), bfhi(cur[k].z), bflo(cur[k].w), bfhi(cur[k].w)};
            float pv[8] = {bflo(prv[k].x), bfhi(prv[k].x), bflo(prv[k].y), bfhi(prv[k].y), bflo(prv[k].z), bfhi(prv[k].z), bflo(prv[k].w), bfhi(prv[k].w)};
            if (t == 0 && si.prev_kind != 1) {
                if (si.prev_kind == 2) { const float* sp = p->in[I_SSHIFT] + ((size_t)l * 32 + si.b) * SHIFT_W + xo;
#pragma unroll
                    for (int e = 0; e < 8; ++e) pv[e] = sp[e]; }
                else {
#pragma unroll
                    for (int e = 0; e < 8; ++e) pv[e] = 0.f; } }
#pragma unroll
            for (int e = 0; e < 8; ++e) { const float mu = e < 4 ? m0[e] : m1[e - 4]; float xs = (t < si.ntok) ? x[e] + (pv[e] - x[e]) * mu : 0.f; if (s == 3) xs = fast_tanh(xs); dst[e] = xs; }
        }
        }
#pragma unroll
        for (int mm = 0; mm < 8; ++mm) { const int m = tq * 8 + mm;
            S5[m * 65 + j] = p->in[I_W2][((size_t)l * 64 + m) * 512 + h * 64 + j]; S6[m * 65 + j] = p->in[I_A2][((size_t)l * 64 + m) * 512 + h * 64 + j]; }
    }
    __syncthreads();
    PT1(1);
    {
        f32x16 acc = {};
        const int c = j0 + li;
        if (q == 0) { mm32<false, false, false>(acc, S3, i0, S5, j0, lane); const float w0 = p->in[I_W0][l * 512 + h * 64 + c];
#pragma unroll
            for (int r = 0; r < 16; ++r) { const int t = i0 + (r & 3) + 8 * (r >> 2) + 4 * hi; const float zz = acc[r] + w0;
                const float sp = fmaxf(-zz, 0.f) + __logf(1.f + __expf(-fabsf(zz)));
                S7[t * 65 + c] = (t < si.ntok) ? -__expf(-sp - 0.5f) : 0.f; } }
        else { mm32<false, false, false>(acc, S4, i0, S6, j0, lane); const float a0 = p->in[I_A0][l * 512 + h * 64 + c];
#pragma unroll
            for (int r = 0; r < 16; ++r) { const int t = i0 + (r & 3) + 8 * (r >> 2) + 4 * hi; S8[t * 65 + c] = __builtin_amdgcn_rcpf(1.f + __expf(-(acc[r] + a0))); } }
    }
    __syncthreads();
    PT1(2);
    if (wave == 0) { float run = 0.f;
#pragma unroll 8
        for (int t = 0; t < 64; ++t) { run += S7[t * 65 + lane]; S3[t * 65 + lane] = run; } }
    else { const int c = lane; const float kkw = p->in[I_KK][l * 512 + h * 64 + c], kaw = p->in[I_KA][l * 512 + h * 64 + c], rkw = p->in[I_RK][l * 512 + h * 64 + c];
        for (int t = wave - 1; t < 64; t += 7) { const float kr = S1[t * 65 + c], kv = kr * kkw; const float ss = wave_sum(kv * kv);
            const float kn = kv * (1.f / sqrtf(fmaxf(ss, 1e-24f))); const float a = S8[t * 65 + c]; const float km = kr * (1.f + (a - 1.f) * kaw);
            const float bon = wave_sum(S0[t * 65 + c] * km * rkw);
            S4[t * 65 + c] = kn; S1[t * 65 + c] = km; S8[t * 65 + c] = kn * a;
            if (lane == 0) ((float*)(p->ws + WS_BONUS))[(size_t)unit * 64 + t] = bon; } }
    __syncthreads();
    { const int c = tid & 63, tq = tid >> 6;
#pragma unroll
        for (int tt = 0; tt < 8; ++tt) { const int t = tq * 8 + tt, o = t * 65 + c; const float Lg = S3[o], lw = S7[o];
            const float g = __expf(Lg), gi = __expf(-Lg), gp = __expf(Lg - lw);
            S0[o] *= g; S1[o] *= gi; S8[o] *= gi; S4[o] *= gp; if (t == 63) gC[c] = g; } }
    __syncthreads();
    PT1(3);
    { f32x16 acc = {};
      if (q == 0) { mm32<false, true, false>(acc, S1, i0, S4, j0, lane); st_tile<1>(S3, acc, i0, j0, lane); }
      else { mm32<false, true, false>(acc, S8, i0, S4, j0, lane); st_tile<1>(S5, acc, i0, j0, lane); } }
    __syncthreads();
    { f32x16 acc = {};
      if (q == 0) { mm32<true, false, false>(acc, S2, i0, S3, j0, lane); st_tile<0>(S6, acc, i0, j0, lane); }
      else { mm32<false, true, false>(acc, S1, i0, S0, j0, lane); st_tile<2>(S7, acc, i0, j0, lane); } }
    __syncthreads();
    PT1(4);
    { float x[16]; const int r0 = (wave & 3) * 16;
      if (wave < 4) {
#pragma unroll
          for (int rr = 0; rr < 16; ++rr) x[rr] = S4[lane * 65 + r0 + rr]; }
      else {
#pragma unroll
          for (int rr = 0; rr < 16; ++rr) x[rr] = S6[(r0 + rr) * 65 + lane]; }
      __syncthreads();
#pragma unroll
      for (int sb = 0; sb < 4; ++sb) {
          float mreg[16];
#pragma unroll
          for (int s = 0; s < 16; ++s) mreg[s] = S5[(sb * 16 + (s < 15 || sb < 3 ? s : 14)) * 65 + lane];
          __builtin_amdgcn_sched_barrier(0);
#pragma unroll
          for (int s = 0; s < 16; ++s) { if (sb * 16 + s < 63) { const float mrow = mreg[s]; float xs[16];
#pragma unroll
              for (int rr = 0; rr < 16; ++rr) xs[rr] = __builtin_bit_cast(float, __builtin_amdgcn_readlane(__builtin_bit_cast(int, x[rr]), sb * 16 + s));
              __builtin_amdgcn_sched_barrier(0);
#pragma unroll
              for (int rr = 0; rr < 16; ++rr) x[rr] -= xs[rr] * mrow;
              __builtin_amdgcn_sched_barrier(0); } }
      }
      LAS float* dst = wave < 4 ? S3 : S6;
#pragma unroll
      for (int rr = 0; rr < 16; ++rr) dst[(r0 + rr) * 65 + lane] = x[rr]; }
    __syncthreads();
    PT1(5);
    { f32x16 acc = {};
      if (q == 1) { mm32<false, true, false>(acc, S8, i0, S0, j0, lane); st_tile<2>(S4, acc, i0, j0, lane); }
      else { mm32<false, false, false>(acc, S3, i0, S8, j0, lane);
          const int jc = j0 + li; const float gc = gC[jc]; float* TQ = (float*)(p->ws + WS_TQ) + (size_t)unit * 4096;
#pragma unroll
          for (int rg = 0; rg < 4; ++rg) { const int ab = i0 + 8 * rg + 4 * hi; f32x4 o;
#pragma unroll
              for (int e = 0; e < 4; ++e) o[e] = ((ab + e == jc) ? gc : 0.f) - acc[rg * 4 + e] * gc;
              *(f32x4*)(TQ + ((((jc >> 4) * 4 + (ab >> 4)) * 64 + ((ab & 15) >> 2) * 16 + (jc & 15)) * 4)) = o; } } }
    __syncthreads();
    { f32x16 acc = {};
      if (q == 0) { mm32<true, false, false>(acc, S2, i0, S1, j0, lane); mm32<false, false, true>(acc, S6, i0, S8, j0, lane);
          const int jc = j0 + li; const float gc = gC[jc]; float* GM = (float*)(p->ws + WS_GM) + (size_t)unit * 4096;
#pragma unroll
          for (int r = 0; r < 16; ++r) GM[(i0 + (r & 3) + 8 * (r >> 2) + 4 * hi) * 64 + jc] = acc[r] * gc; }
      else { mm32<true, false, false>(acc, S2, i0, S7, j0, lane); mm32<false, false, true>(acc, S6, i0, S4, j0, lane);
          float* Y0T = (float*)(p->ws + WS_Y0T) + (size_t)unit * 4096;
#pragma unroll
          for (int rg = 0; rg < 4; ++rg) *(f32x4*)(Y0T + (((((j0 >> 5) * 2 + (i0 >> 5)) * 4 + rg) * 2 + hi) * 32 + li) * 4) = (f32x4){acc[rg * 4], acc[rg * 4 + 1], acc[rg * 4 + 2], acc[rg * 4 + 3]}; } }
    if (q == 0) { f32x16 acc;
#pragma unroll
        for (int r = 0; r < 16; ++r) acc[r] = S0[(j0 + li) * 65 + i0 + (r & 3) + 8 * (r >> 2) + 4 * hi];
        mm32<false, false, true>(acc, S3, i0, S4, j0, lane);
        float* ET = (float*)(p->ws + WS_ET) + (size_t)unit * 4096;
#pragma unroll
        for (int rg = 0; rg < 4; ++rg) *(f32x4*)(ET + ((((j0 >> 5) * 2 + (i0 >> 5)) * 8 + 2 * rg + hi) * 32 + li) * 4) = (f32x4){acc[rg * 4], acc[rg * 4 + 1], acc[rg * 4 + 2], acc[rg * 4 + 3]}; }
    __syncthreads();
    PT1(6);
}
template <bool SCQ>
__device__ __forceinline__ void chain_run(f32x4 (&st)[4], const float* TQ, const float* GM, float* SC, int nsteps, int i, int g, int lane) {
    constexpr size_t STRIDE = (size_t)8 * 4096;
    f32x4 tq[16], gm[4];
#pragma unroll
    for (int x = 0; x < 16; ++x) tq[x] = *(const f32x4*)(TQ + (x * 64 + lane) * 4);
#pragma unroll
    for (int tl = 0; tl < 4; ++tl) gm[tl] = GM ? *(const f32x4*)(GM + i * 64 + 16 * tl + 4 * g) : (f32x4){0.f, 0.f, 0.f, 0.f};
    for (int c = 0; c < nsteps; ++c) {
        if (SC) {
            if (SCQ) {
#pragma unroll
                for (int tl = 0; tl < 4; ++tl) *(f32x4*)(SC + c * STRIDE + ((((i >> 5) * 2 + (tl >> 1)) * 8 + 4 * (tl & 1) + g) * 32 + (i & 31)) * 4) = st[tl]; }
            else {
#pragma unroll
                for (int tl = 0; tl < 4; ++tl) *(f32x4*)(SC + c * STRIDE + i * 64 + 16 * tl + 4 * g) = st[tl]; } }
        f32x4 tqn[16], gmn[4];
        const int cn = (c + 1 < nsteps) ? c + 1 : c;
#pragma unroll
        for (int x = 0; x < 16; ++x) tqn[x] = *(const f32x4*)(TQ + cn * STRIDE + (x * 64 + lane) * 4);
#pragma unroll
        for (int tl = 0; tl < 4; ++tl) gmn[tl] = GM ? *(const f32x4*)(GM + cn * STRIDE + i * 64 + 16 * tl + 4 * g) : (f32x4){0.f, 0.f, 0.f, 0.f};
        f32x4 acc[4];
#pragma unroll
        for (int tp = 0; tp < 4; ++tp) acc[tp] = gm[tp];
#pragma unroll
        for (int tl = 0; tl < 4; ++tl)
#pragma unroll
            for (int r = 0; r < 4; ++r)
#pragma unroll
                for (int tp = 0; tp < 4; ++tp) acc[tp] = __builtin_amdgcn_mfma_f32_16x16x4f32(tq[tp * 4 + tl][r], st[tl][r], acc[tp], 0, 0, 0);
#pragma unroll
        for (int tl = 0; tl < 4; ++tl) st[tl] = acc[tl];
#pragma unroll
        for (int x = 0; x < 16; ++x) tq[x] = tqn[x];
#pragma unroll
        for (int tl = 0; tl < 4; ++tl) gm[tl] = gmn[tl];
    }
}
__device__ __forceinline__ void rwkv_l1_task(KP p, int task, int lane) {
    const int iq = task & 3, kind = (task >> 2) & 1, h = (task >> 3) & 7, grp = task >> 6;
    const int fr = lane & 15, g = lane >> 4, i = iq * 16 + fr;
    const size_t u0 = ((size_t)(grp * 16) * 8 + h) * 4096;
    const float* TQ = (const float*)(p->ws + WS_TQ) + u0; const float* GM = (const float*)(p->ws + WS_GM) + u0;
    f32x4 st[4];
#pragma unroll
    for (int tl = 0; tl < 4; ++tl)
#pragma unroll
        for (int r = 0; r < 4; ++r) st[tl][r] = (kind == 1 && i == 16 * tl + 4 * g + r) ? 1.f : 0.f;
    chain_run<false>(st, TQ, kind == 0 ? GM : nullptr, nullptr, 16, i, g, lane);
    const size_t gb = ((size_t)grp * 8 + h) * 4096;
    if (kind == 0) { float* GG = (float*)(p->ws + WS_GG) + gb;
#pragma unroll
        for (int tl = 0; tl < 4; ++tl) *(f32x4*)(GG + i * 64 + 16 * tl + 4 * g) = st[tl]; }
    else { float* TG = (float*)(p->ws + WS_TG) + gb;
#pragma unroll
        for (int tl = 0; tl < 4; ++tl)
#pragma unroll
            for (int r = 0; r < 4; ++r) TG[((tl * 4 + iq) * 64 + (fr >> 2) * 16 + 4 * g + r) * 4 + (fr & 3)] = st[tl][r]; }
}
__device__ __forceinline__ void rwkv_l2_task(KP p, int l, int task, int lane) {
    const int iq = task & 3, h = task >> 2, fr = lane & 15, g = lane >> 4, i = iq * 16 + fr;
    f32x4 st[4];
#pragma unroll
    for (int tl = 0; tl < 4; ++tl) st[tl] = (f32x4){0.f, 0.f, 0.f, 0.f};
    chain_run<false>(st, (const float*)(p->ws + WS_TG) + (size_t)h * 4096, (const float*)(p->ws + WS_GG) + (size_t)h * 4096, (float*)(p->ws + WS_SG) + (size_t)h * 4096, 16, i, g, lane);
    float* dst = p->out + O_PWKV + (((size_t)l * 8 + h) * 64 + i) * 64;
#pragma unroll
    for (int tl = 0; tl < 4; ++tl) *(f32x4*)(dst + 16 * tl + 4 * g) = st[tl];
}
__device__ __forceinline__ void rwkv_l3_task(KP p, int l, int task, int lane) {
    const int fr = lane & 15, g = lane >> 4;
    f32x4 st[4];
    if (task < 512) { const int iq = task & 3, h = (task >> 2) & 7, grp = task >> 5, i = iq * 16 + fr;
        const float* s0 = (const float*)(p->ws + WS_SG) + ((size_t)grp * 8 + h) * 4096 + i * 64;
#pragma unroll
        for (int tl = 0; tl < 4; ++tl) st[tl] = *(const f32x4*)(s0 + 16 * tl + 4 * g);
        const size_t u0 = ((size_t)(grp * 16) * 8 + h) * 4096;
        chain_run<true>(st, (const float*)(p->ws + WS_TQ) + u0, (const float*)(p->ws + WS_GM) + u0, (float*)(p->ws + WS_SC) + u0, 16, i, g, lane); }
    else { const int t2 = task - 512, iq = t2 & 3, h = (t2 >> 2) & 7, b = t2 >> 5, i = iq * 16 + fr;
        const float* s0 = p->in[I_SWKV] + ((((size_t)l * 32 + b) * 8 + h) * 64 + i) * 64;
#pragma unroll
        for (int tl = 0; tl < 4; ++tl) st[tl] = *(const f32x4*)(s0 + 16 * tl + 4 * g);
        const size_t u0 = ((size_t)(256 + b) * 8 + h) * 4096;
        chain_run<true>(st, (const float*)(p->ws + WS_TQ) + u0, (const float*)(p->ws + WS_GM) + u0, (float*)(p->ws + WS_SC) + u0, 1, i, g, lane);
        float* dst = p->out + O_SWKV + ((((size_t)l * 32 + b) * 8 + h) * 64 + i) * 64;
#pragma unroll
        for (int tl = 0; tl < 4; ++tl) *(f32x4*)(dst + 16 * tl + 4 * g) = st[tl]; }
}
__device__ __forceinline__ void rwkv_r3_task(KP p, int l, int task, int lane) {
    const int unit = task >> 1, th = task & 1, cu = unit >> 3, h = unit & 7, li = lane & 31, hi = lane >> 5;
    const RwkvSeqInfo si = rwkv_info(cu);
    if (th * 32 >= si.ntok) return;
    const bf16_t* U = (const bf16_t*)(p->ws + WS_U);
    const size_t ub = (size_t)unit * 4096; const int t = th * 32 + li;
    const float* SC = (const float*)(p->ws + WS_SC) + ub; const float* ET = (const float*)(p->ws + WS_ET) + ub; const float* Y0T = (const float*)(p->ws + WS_Y0T) + ub;
    f32x16 acc[2];
#pragma unroll
    for (int ti = 0; ti < 2; ++ti)
#pragma unroll
        for (int rg = 0; rg < 4; ++rg) { const f32x4 y0 = *(const f32x4*)(Y0T + ((((th * 2 + ti) * 4 + rg) * 2 + hi) * 32 + li) * 4);
#pragma unroll
            for (int e = 0; e < 4; ++e) acc[ti][rg * 4 + e] = y0[e]; }
    f32x4 eb[8], sa0[8], sa1[8];
#pragma unroll
    for (int s4 = 0; s4 < 8; ++s4) { eb[s4] = *(const f32x4*)(ET + (((th * 2 + hi) * 8 + s4) * 32 + li) * 4); sa0[s4] = *(const f32x4*)(SC + (((0 * 2 + hi) * 8 + s4) * 32 + li) * 4); sa1[s4] = *(const f32x4*)(SC + (((1 * 2 + hi) * 8 + s4) * 32 + li) * 4); }
#pragma unroll
    for (int s4 = 0; s4 < 8; ++s4) {
#pragma unroll
        for (int e = 0; e < 4; ++e) { acc[0] = __builtin_amdgcn_mfma_f32_32x32x2f32(sa0[s4][e], eb[s4][e], acc[0], 0, 0, 0); acc[1] = __builtin_amdgcn_mfma_f32_32x32x2f32(sa1[s4][e], eb[s4][e], acc[1], 0, 0, 0); }
    }
    float s1 = 0.f;
#pragma unroll
    for (int ti = 0; ti < 2; ++ti)
#pragma unroll
        for (int r = 0; r < 16; ++r) s1 += acc[ti][r];
    s1 = xhalf_sum(s1); const float mean = s1 * (1.f / 64.f);
    float s2 = 0.f;
#pragma unroll
    for (int ti = 0; ti < 2; ++ti)
#pragma unroll
        for (int r = 0; r < 16; ++r) { const float d = acc[ti][r] - mean; s2 += d * d; }
    s2 = xhalf_sum(s2); const float rstd = 1.f / sqrtf(s2 * (1.f / 64.f) + 64e-5f);
    if (t >= si.ntok) return;
    const float bon = ((const float*)(p->ws + WS_BONUS))[(size_t)unit * 64 + t];
    const size_t row = (size_t)(si.row0 + t);
    bf16_t* oc = (bf16_t*)(p->ws + WS_OCAT) + (size_t)2 * NTOK * 512 + row * 512 + h * 64;
    u32x2 wout[2][4];
#pragma unroll
    for (int ti = 0; ti < 2; ++ti)
#pragma unroll
        for (int rg = 0; rg < 4; ++rg) { const int i = 32 * ti + 8 * rg + 4 * hi, c = h * 64 + i;
            const f32x4 gg = *(const f32x4*)(p->in[I_GNG] + l * 512 + c), gb = *(const f32x4*)(p->in[I_GNB] + l * 512 + c), mu = *(const f32x4*)(p->in[I_MU] + l * SHIFT_W + 1024 + c);
            const u32x2 vx = *(const u32x2*)(U + row * NU + U_XC + 1024 + c); const u32x2 sg = *(const u32x2*)(U + row * NU + U_CSG + c);
            f32x4 vc = (f32x4){bflo(vx.x), bfhi(vx.x), bflo(vx.y), bfhi(vx.y)}, vp;
            {
                const u32x2 px = *(const u32x2*)(U + (row > 0 ? row - 1 : 0) * NU + U_XC + 1024 + c); const f32x4 ss = *(const f32x4*)(p->in[I_SSHIFT] + ((size_t)l * 32 + si.b) * SHIFT_W + 1024 + c);
                const f32x4 up = (f32x4){bflo(px.x), bfhi(px.x), bflo(px.y), bfhi(px.y)};
                vp = (t > 0 || si.prev_kind == 1) ? up : (si.prev_kind == 2 ? ss : (f32x4){0.f, 0.f, 0.f, 0.f}); }
            const f32x4 vs = vc + (vp - vc) * mu;
            const f32x4 sgf = (f32x4){bflo(sg.x), bfhi(sg.x), bflo(sg.y), bfhi(sg.y)};
            f32x4 o;
#pragma unroll
            for (int e = 0; e < 4; ++e) o[e] = (((acc[ti][rg * 4 + e] - mean) * rstd) * gg[e] + gb[e] + bon * vs[e]) * siluf_(sgf[e]);
            wout[ti][rg].x = cvt_pk_bf16(o[0], o[1]); wout[ti][rg].y = cvt_pk_bf16(o[2], o[3]); }
#pragma unroll
    for (int ti = 0; ti < 2; ++ti)
#pragma unroll
        for (int rg = 0; rg < 4; ++rg) *(u32x2*)(oc + 32 * ti + 8 * rg + 4 * hi) = wout[ti][rg];
}
__device__ __forceinline__ int krow(int i) { return (i & 3) + 4 * ((i >> 3) & 1) + 8 * ((i >> 2) & 1) + 16 * (i >> 4); }
__device__ __forceinline__ bf16x8 pack8(const f32x16& v, int o) { u32x4 w; w.x = cvt_pk_bf16(v[o], v[o + 1]); w.y = cvt_pk_bf16(v[o + 2], v[o + 3]); w.z = cvt_pk_bf16(v[o + 4], v[o + 5]); w.w = cvt_pk_bf16(v[o + 6], v[o + 7]); return __builtin_bit_cast(bf16x8, w); }
constexpr float ATT_NEG = -1e30f;
template <bool HALF>
__device__ __forceinline__ void softmax_tile(f32x16& p0, f32x16& p1, float& m, float& lsum, f32x16 (&O)[2], bf16x8 (&pb)[4]) {
    float mx = p0[0];
#pragma unroll
    for (int r = 1; r < 16; ++r) mx = fmaxf(mx, p0[r]);
    if (!HALF) {
#pragma unroll
        for (int r = 0; r < 16; ++r) mx = fmaxf(mx, p1[r]); }
    mx = xhalf_max(mx);
    const float mn = fmaxf(m, mx), alpha = __builtin_amdgcn_exp2f(m - mn);
    m = mn;
    float s = 0.f;
#pragma unroll
    for (int r = 0; r < 16; ++r) { p0[r] = __builtin_amdgcn_exp2f(p0[r] - mn); s += p0[r]; }
    if (!HALF) {
#pragma unroll
        for (int r = 0; r < 16; ++r) { p1[r] = __builtin_amdgcn_exp2f(p1[r] - mn); s += p1[r]; } }
    lsum = lsum * alpha + s;
#pragma unroll
    for (int r = 0; r < 16; ++r) { O[0][r] *= alpha; O[1][r] *= alpha; }
    pb[0] = pack8(p0, 0); pb[1] = pack8(p0, 8);
    if (!HALF) { pb[2] = pack8(p1, 0); pb[3] = pack8(p1, 8); }
}
constexpr int AKS = 72;
constexpr int ATT_KB = 0, ATT_VB = 2 * 64 * AKS * 2, ATT_FB = 4 * 64 * AKS * 2, ATT_SC = ATT_FB + 2 * 64 * 4;
__device__ __forceinline__ void attn_prompt_unit(KP p, int l, int h, int qb, LAS unsigned char* lds, int tid) {
    const bf16_t* U = (const bf16_t*)(p->ws + WS_U); const bf16_t* Vt = (const bf16_t*)(p->ws + WS_VT) + (size_t)h * 64 * TP; const float* F = (const float*)(p->ws + WS_FP) + (size_t)h * TP;
    const int wave = tid >> 6, lane = tid & 63, li = lane & 31, hi = lane >> 5;
    const int q0 = qb * 256, q = q0 + wave * 32 + li;
    bf16x8 qf[4];
    { const float sc = 0.125f * LOG2E;
#pragma unroll
      for (int d0 = 0; d0 < 4; ++d0) { const u32x4 w = *(const u32x4*)(U + (size_t)q * NU + U_Q + h * 64 + 16 * d0 + 8 * hi);
          qf[d0] = pack8f((f32x4){bflo(w.x) * sc, bfhi(w.x) * sc, bflo(w.y) * sc, bfhi(w.y) * sc}, (f32x4){bflo(w.z) * sc, bfhi(w.z) * sc, bflo(w.w) * sc, bfhi(w.w) * sc}); } }
    const float fq = F[q];
    float m = ATT_NEG, lsum = 0.f; f32x16 O[2] = {};
    const int NT = (q0 + 256) / 64;
    LAS float* qmx = (LAS float*)(lds + ATT_SC); LAS float* mmv = qmx + 8;
    { float q2 = 0.f;
#pragma unroll
      for (int d0 = 0; d0 < 4; ++d0) { const u32x4 w = __builtin_bit_cast(u32x4, qf[d0]); q2 += bflo(w.x) * bflo(w.x) + bfhi(w.x) * bfhi(w.x) + bflo(w.y) * bflo(w.y) + bfhi(w.y) * bfhi(w.y) + bflo(w.z) * bflo(w.z) + bfhi(w.z) * bfhi(w.z) + bflo(w.w) * bflo(w.w) + bfhi(w.w) * bfhi(w.w); }
      q2 = wave_max(xhalf_sum(q2)); if (lane == 0) { qmx[wave] = q2; mmv[wave] = ATT_NEG; } }
    const float kmax2 = __uint_as_float(((const unsigned*)(p->ws + WS_CTL))[CW_KMAX + l * 8 + h]), fq0 = F[q0];
    const int srow = tid >> 3, sch = tid & 7;
    const bf16_t* kg = U + (size_t)srow * NU + U_K + h * 64 + 8 * sch; const bf16_t* vg = Vt + (size_t)srow * TP + 8 * sch;
    LAS unsigned char* kdst = lds + ATT_KB + (srow * AKS + 8 * sch) * 2; LAS unsigned char* vdst = lds + ATT_VB + (srow * AKS + 8 * sch) * 2;
    u32x4 kr = *(const u32x4*)(kg + (size_t)(NT - 1) * 64 * NU), vr = *(const u32x4*)(vg + (NT - 1) * 64); float fr = tid < 64 ? F[(NT - 1) * 64 + tid] : 0.f;
    *(LAS u32x4*)kdst = kr; *(LAS u32x4*)vdst = vr; if (tid < 64) ((LAS float*)(lds + ATT_FB))[tid] = fr;
    __syncthreads();
    const int ka = krow(li);
    float qkb; { float q2 = qmx[0];
#pragma unroll
      for (int w = 1; w < 8; ++w) q2 = fmaxf(q2, qmx[w]);
      qkb = 1.02f * sqrtf(q2 * kmax2) + fq0; }
    for (int t = NT - 1, buf = 0; t >= 0; --t, buf ^= 1) {
        { float mmin = mmv[0];
#pragma unroll
          for (int w = 1; w < 8; ++w) mmin = fminf(mmin, mmv[w]);
          if (qkb - ((const LAS float*)(lds + ATT_FB))[buf * 64 + 63] < mmin - 40.f) break; }
        if (t > 0) { kr = *(const u32x4*)(kg + (size_t)(t - 1) * 64 * NU); vr = *(const u32x4*)(vg + (t - 1) * 64); if (tid < 64) fr = F[(t - 1) * 64 + tid]; }
        if (64 * t <= q0 + wave * 32 + 31) {
            const LAS bf16_t* Kb = (const LAS bf16_t*)(lds + ATT_KB) + buf * 64 * AKS; const LAS bf16_t* Vb = (const LAS bf16_t*)(lds + ATT_VB) + buf * 64 * AKS; const LAS float* Fb = (const LAS float*)(lds + ATT_FB) + buf * 64;
            f32x16 p0, p1;
#pragma unroll
            for (int g2 = 0; g2 < 2; ++g2) { const f32x4 a = *(const LAS f32x4*)(Fb + 8 * hi + 16 * g2), b = *(const LAS f32x4*)(Fb + 8 * hi + 16 * g2 + 4), c = *(const LAS f32x4*)(Fb + 32 + 8 * hi + 16 * g2), d = *(const LAS f32x4*)(Fb + 32 + 8 * hi + 16 * g2 + 4);
#pragma unroll
                for (int e = 0; e < 4; ++e) { p0[8 * g2 + e] = fq - a[e]; p0[8 * g2 + 4 + e] = fq - b[e]; p1[8 * g2 + e] = fq - c[e]; p1[8 * g2 + 4 + e] = fq - d[e]; } }
#pragma unroll
            for (int d0 = 0; d0 < 4; ++d0) { const bf16x8 a0 = *(const LAS bf16x8*)(Kb + ka * AKS + 16 * d0 + 8 * hi), a1 = *(const LAS bf16x8*)(Kb + (ka + 32) * AKS + 16 * d0 + 8 * hi);
                p0 = __builtin_amdgcn_mfma_f32_32x32x16_bf16(a0, qf[d0], p0, 0, 0, 0); p1 = __builtin_amdgcn_mfma_f32_32x32x16_bf16(a1, qf[d0], p1, 0, 0, 0); }
            if (64 * t + 63 > q0 + wave * 32) {
#pragma unroll
                for (int r = 0; r < 16; ++r) { const int kv = 64 * t + 8 * hi + 16 * (r >> 3) + (r & 7); if (kv > q) p0[r] = -INFINITY; if (kv + 32 > q) p1[r] = -INFINITY; } }
            bf16x8 pb[4];
            softmax_tile<false>(p0, p1, m, lsum, O, pb);
#pragma unroll
            for (int dt = 0; dt < 2; ++dt)
#pragma unroll
                for (int s = 0; s < 4; ++s) { const bf16x8 a = *(const LAS bf16x8*)(Vb + (32 * dt + li) * AKS + 16 * (s & 1) + 32 * (s >> 1) + 8 * hi);
                    O[dt] = __builtin_amdgcn_mfma_f32_32x32x16_bf16(a, pb[s], O[dt], 0, 0, 0); }
        }
        { const float wm = wave_min(m); if (lane == 0) mmv[wave] = wm; }
        if (t > 0) { const int nb = buf ^ 1; *(LAS u32x4*)(kdst + nb * 64 * AKS * 2) = kr; *(LAS u32x4*)(vdst + nb * 64 * AKS * 2) = vr; if (tid < 64) ((LAS float*)(lds + ATT_FB))[nb * 64 + tid] = fr; }
        __syncthreads();
    }
    __syncthreads();
    const float inv = 1.f / xhalf_sum(lsum);
    bf16_t* ob = (bf16_t*)(p->ws + WS_OCAT) + (size_t)1 * NTOK * 512 + (size_t)q * 512 + h * 64;
    u32x2 sgv[2][4];
#pragma unroll
    for (int dt = 0; dt < 2; ++dt)
#pragma unroll
        for (int rg = 0; rg < 4; ++rg) sgv[dt][rg] = *(const u32x2*)(U + (size_t)q * NU + U_BSG + h * 64 + 32 * dt + 8 * rg + 4 * hi);
#pragma unroll
    for (int dt = 0; dt < 2; ++dt)
#pragma unroll
        for (int rg = 0; rg < 4; ++rg) { const int d = 32 * dt + 8 * rg + 4 * hi; const u32x2 sg = sgv[dt][rg];
            u32x2 w; w.x = cvt_pk_bf16(O[dt][rg * 4] * inv * siluf_(bflo(sg.x)), O[dt][rg * 4 + 1] * inv * siluf_(bfhi(sg.x))); w.y = cvt_pk_bf16(O[dt][rg * 4 + 2] * inv * siluf_(bflo(sg.y)), O[dt][rg * 4 + 3] * inv * siluf_(bfhi(sg.y)));
            *(u32x2*)(ob + d) = w; }
}
__device__ __forceinline__ void attn_sample_unit(KP p, int l, int b, int h, LAS unsigned char* lds, int tid) {
    const bf16_t* U = (const bf16_t*)(p->ws + WS_U);
    const int wave = tid >> 6, lane = tid & 63, li = lane & 31, hi = lane >> 5;
    const size_t qrow = (size_t)TP + b * 32 + li;
    const float* G = (const float*)(p->ws + WS_GS) + ((size_t)b * 8 + h) * GS_LEN;
    bf16x8 qf[4];
    { const float sc = 0.125f * LOG2E;
#pragma unroll
      for (int d0 = 0; d0 < 4; ++d0) { const u32x4 w = *(const u32x4*)(U + qrow * NU + U_Q + h * 64 + 16 * d0 + 8 * hi);
          qf[d0] = pack8f((f32x4){bflo(w.x) * sc, bfhi(w.x) * sc, bflo(w.y) * sc, bfhi(w.y) * sc}, (f32x4){bflo(w.z) * sc, bfhi(w.z) * sc, bflo(w.w) * sc, bfhi(w.w) * sc}); } }
    const float fq = G[PAST + li];
    float m = ATT_NEG, lsum = 0.f; f32x16 O[2] = {};
    const float* CK = p->in[I_CK] + (((size_t)l * 32 + b) * PAST) * 512 + h * 64; const float* CV = p->in[I_CV] + (((size_t)l * 32 + b) * PAST) * 512 + h * 64;
    const int ka = krow(li);
    for (int tt = 0; tt < 8; ++tt) {
        const int key0 = (wave * 8 + tt) * 64;
        f32x16 p0, p1;
#pragma unroll
        for (int g2 = 0; g2 < 2; ++g2) { const float* gp = G + key0 + 8 * hi + 16 * g2; const f32x4 a = *(const f32x4*)gp, bq = *(const f32x4*)(gp + 4), c = *(const f32x4*)(gp + 32), d = *(const f32x4*)(gp + 36);
#pragma unroll
            for (int e = 0; e < 4; ++e) { p0[8 * g2 + e] = fq - a[e]; p0[8 * g2 + 4 + e] = fq - bq[e]; p1[8 * g2 + e] = fq - c[e]; p1[8 * g2 + 4 + e] = fq - d[e]; } }
#pragma unroll
        for (int d0 = 0; d0 < 4; ++d0) { const float* k0p = CK + (size_t)(key0 + ka) * 512 + 16 * d0 + 8 * hi; const float* k1p = k0p + (size_t)32 * 512;
            const bf16x8 a0 = pack8f(*(const f32x4*)k0p, *(const f32x4*)(k0p + 4)), a1 = pack8f(*(const f32x4*)k1p, *(const f32x4*)(k1p + 4));
            p0 = __builtin_amdgcn_mfma_f32_32x32x16_bf16(a0, qf[d0], p0, 0, 0, 0); p1 = __builtin_amdgcn_mfma_f32_32x32x16_bf16(a1, qf[d0], p1, 0, 0, 0); }
        bf16x8 pb[4];
        softmax_tile<false>(p0, p1, m, lsum, O, pb);
#pragma unroll
        for (int dt = 0; dt < 2; ++dt)
#pragma unroll
            for (int s = 0; s < 4; ++s) { const float* vp = CV + (size_t)(key0 + 16 * (s & 1) + 32 * (s >> 1) + 8 * hi) * 512 + 32 * dt + li;
                const bf16x8 a = pack8f((f32x4){vp[0], vp[512], vp[1024], vp[1536]}, (f32x4){vp[2048], vp[2560], vp[3072], vp[3584]});
                O[dt] = __builtin_amdgcn_mfma_f32_32x32x16_bf16(a, pb[s], O[dt], 0, 0, 0); }
    }
    if (wave == 7) {
        f32x16 p0, p1 = {};
#pragma unroll
        for (int g2 = 0; g2 < 2; ++g2) { const float* gp = G + PAST + 8 * hi + 16 * g2; const f32x4 a = *(const f32x4*)gp, bq = *(const f32x4*)(gp + 4);
#pragma unroll
            for (int e = 0; e < 4; ++e) { p0[8 * g2 + e] = fq - a[e]; p0[8 * g2 + 4 + e] = fq - bq[e]; } }
#pragma unroll
        for (int d0 = 0; d0 < 4; ++d0) { const bf16x8 a0 = *(const bf16x8*)(U + ((size_t)TP + b * 32 + ka) * NU + U_K + h * 64 + 16 * d0 + 8 * hi);
            p0 = __builtin_amdgcn_mfma_f32_32x32x16_bf16(a0, qf[d0], p0, 0, 0, 0); }
#pragma unroll
        for (int r = 0; r < 16; ++r) { const int kv = 8 * hi + 16 * (r >> 3) + (r & 7); if (kv > li) p0[r] = -INFINITY; }
        bf16x8 pb[4];
        softmax_tile<true>(p0, p1, m, lsum, O, pb);
#pragma unroll
        for (int dt = 0; dt < 2; ++dt)
#pragma unroll
            for (int s = 0; s < 2; ++s) { const bf16_t* vp = U + ((size_t)TP + b * 32 + 16 * s + 8 * hi) * NU + U_V + h * 64 + 32 * dt + li; u32x4 w;
                w.x = (unsigned)vp[0] | ((unsigned)vp[NU] << 16); w.y = (unsigned)vp[2 * NU] | ((unsigned)vp[3 * NU] << 16); w.z = (unsigned)vp[4 * NU] | ((unsigned)vp[5 * NU] << 16); w.w = (unsigned)vp[6 * NU] | ((unsigned)vp[7 * NU] << 16);
                O[dt] = __builtin_amdgcn_mfma_f32_32x32x16_bf16(__builtin_bit_cast(bf16x8, w), pb[s], O[dt], 0, 0, 0); }
    }
    LAS float* Ow = (LAS float*)lds;
    LAS float* ML = Ow + 8 * 32 * 64;
    lsum = xhalf_sum(lsum);
#pragma unroll
    for (int dt = 0; dt < 2; ++dt)
#pragma unroll
        for (int r = 0; r < 16; ++r) Ow[(wave * 32 + dt * 16 + r) * 64 + lane] = O[dt][r];
    if (hi == 0) { ML[(wave * 2) * 32 + li] = m; ML[(wave * 2 + 1) * 32 + li] = lsum; }
    __syncthreads();
    { const int qq = tid & 31, dg = tid >> 5; float M = ATT_NEG;
#pragma unroll
      for (int w = 0; w < 8; ++w) M = fmaxf(M, ML[(w * 2) * 32 + qq]);
      float L = 0.f; f32x4 o = {0.f, 0.f, 0.f, 0.f};
      const int d = 4 * dg, idx0 = (d >> 5) * 16 + ((d >> 3) & 3) * 4, ln = ((d >> 2) & 1) * 32 + qq;
#pragma unroll
      for (int w = 0; w < 8; ++w) { const float f = __builtin_amdgcn_exp2f(ML[(w * 2) * 32 + qq] - M); L += ML[(w * 2 + 1) * 32 + qq] * f;
#pragma unroll
          for (int e = 0; e < 4; ++e) o[e] += Ow[(w * 32 + idx0 + e) * 64 + ln] * f; }
      const float inv = 1.f / L; const size_t row = (size_t)TP + b * 32 + qq;
      const u32x2 sg = *(const u32x2*)(U + row * NU + U_BSG + h * 64 + d);
      u32x2 wv; wv.x = cvt_pk_bf16(o[0] * inv * siluf_(bflo(sg.x)), o[1] * inv * siluf_(bfhi(sg.x))); wv.y = cvt_pk_bf16(o[2] * inv * siluf_(bflo(sg.y)), o[3] * inv * siluf_(bfhi(sg.y)));
      *(u32x2*)((bf16_t*)(p->ws + WS_OCAT) + (size_t)1 * NTOK * 512 + row * 512 + h * 64 + d) = wv; }
    __syncthreads();
}
constexpr int NPHASE = 22;
__global__ void __launch_bounds__(512, 2) hse_fwd(Params p_) {
    const KP kp = (KP)__builtin_amdgcn_kernarg_segment_ptr();
    (void)p_;
    extern __shared__ __attribute__((aligned(16))) unsigned char lds_raw[];
    LAS unsigned char* lds = (LAS unsigned char*)lds_raw;
    const int tid0 = threadIdx.x;
    const int wave0 = __builtin_amdgcn_readfirstlane(tid0 >> 6);
    const int G = gridDim.x, bid = blockIdx.x, ngw = G * 8;
#define PH_LOCALS const KP p = kp_fresh(kp); int tid = wave0 * 64 + (int)__builtin_amdgcn_mbcnt_hi(~0u, __builtin_amdgcn_mbcnt_lo(~0u, 0u)); asm volatile("" : "+v"(tid)); const int lane = tid & 63, wave = __builtin_amdgcn_readfirstlane(tid >> 6), gw = bid * 8 + wave; (void)lane; (void)gw; (void)p;
    if (tid0 < 4) ((LAS unsigned*)(lds + LDS_XB_OFF))[tid0] = 0u;
#if PROBE_ID
    if (tid0 == 0) *(LAS unsigned long long*)(lds + LDS_PROBE_OFF) = 0ull;
#endif
    __syncthreads();
    unsigned* ctl = (unsigned*)(kp->ws + WS_CTL);
    XcdBarrier bar = xcd_barrier_post(ctl + CW_BAR + kp->li * XCD_BAR_WORDS, (volatile LAS unsigned*)(lds + LDS_XB_OFF));
    const int lo = kp->ph_lo, hi = kp->ph_hi;
#define IN(k) (lo <= (k) && (k) < hi)
#ifndef DUP_MASK
#define DUP_MASK 0
#endif
#define NREP(k) (((DUP_MASK >> (k)) & 1) + 1)
#define SEAM(k) do { if (IN(k) && IN((k) + 1)) xcd_barrier(bar); } while (0)
    PT0();
    if (IN(0)) { PH_LOCALS
        for (int u = bid; u < 192; u += G) ada_unit(p, u, lds, tid);
        p0_weights(p, lds, gw, ngw, wave, lane);
    }
    SEAM(0);
    PT1(9);
    for (int l = 0; l < NLAYER; ++l) {
        const int pb = 1 + 10 * l;
        for (int rep = 0; rep < NREP(0); ++rep) { if (rep) xcd_barrier(bar);
        if (IN(pb)) { PH_LOCALS p1_rows(p, l, gw, ngw, lane); } }
        SEAM(pb);
        PT1(10);
        for (int rep = 0; rep < NREP(1); ++rep) { if (rep) xcd_barrier(bar);
        if (IN(pb + 1)) { PH_LOCALS
            pg8::Gemm g{(const bf16_t*)(p->ws + WS_H), (const bf16_t*)(p->ws + WS_WIN) + (size_t)l * NU * 2048, NTOK, NU, 2048, 2048};
            pg8::StaticOrder S; S.init(NTOK, NU, G, bid);
            EpiU E{(bf16_t*)(p->ws + WS_U), p->out, p->in[I_BF], l};
            pg8::gemm_phase<EpiU, pg8::StaticOrder>(lds, g, S, E, nullptr, tid);
        }
        }
        SEAM(pb + 1);
        PT1(11);
        for (int rep = 0; rep < NREP(2); ++rep) { if (rep) xcd_barrier(bar);
        if (IN(pb + 2)) { PH_LOCALS
#ifndef DUP_SUB
#define DUP_SUB 0
#endif
            { PT0();
            for (int u = bid; u < NRU * ((DUP_SUB & 1) + 1); u += G) rwkv_r1(p, l, u % NRU, lds, tid);
            PT1(31);
            for (int u = (bid + G - 32) % G; u < 544 * (((DUP_SUB >> 1) & 1) + 1); u += G) conv_unit(p, l, u % 544, lds, tid);
            PT1(32);
            for (int u = (bid + G - 64) % G; u < 544 * (((DUP_SUB >> 2) & 1) + 1); u += G) pool_unit(p, l, u % 544, lds, tid);
            PT1(33);
            for (int u = bid; u < 256; u += G) { vt_tile(p, l, u * 8 + wave, lds, wave, lane); }
            __syncthreads();
            for (int u = (bid + G - 96) % G; u < 32; u += G) gs_unit(p, l, u, lds, tid);
            for (int u = G - 1 - bid; u < 8; u += G) fp_unit(p, l, u, lds, tid);
            if (bid == G / 2) shift_out(p, l, tid);
            PT1(34); }
        }
        }
        SEAM(pb + 2);
        PT1(12);
        for (int rep = 0; rep < NREP(3); ++rep) { if (rep) xcd_barrier(bar);
        if (IN(pb + 3)) { PH_LOCALS
            if (wave < 4) for (int tk = bid * 4 + wave; tk < 1024; tk += G * 4) rwkv_l1_task(p, tk, lane);
            __syncthreads();
            LAS int* qslot = (LAS int*)(lds + LDS_XB_OFF - 16);
            for (;;) {
                if (tid == 0) *qslot = (int)atomicAdd(ctl + CW_QUEUE + 64 * (2 * l + 4 * rep), 1u);
                __syncthreads();
                const int item = *qslot;
                __syncthreads();
                if (item >= 512) break;
                attn_prompt_unit(p, l, item & 7, 63 - (item >> 3), lds, tid);
            }
            for (;;) {
                if (tid == 0) *qslot = (int)atomicAdd(ctl + CW_QUEUE + 64 * (2 * l + 1 + 4 * rep), 1u);
                __syncthreads();
                const int item = *qslot;
                __syncthreads();
                if (item >= 256) break;
                attn_sample_unit(p, l, item >> 3, item & 7, lds, tid);
            }
        }
        }
        SEAM(pb + 3);
        PT1(13);
        if (IN(pb + 4)) { PH_LOCALS if (wave == 0 && bid < 32) rwkv_l2_task(p, l, bid, lane); }
        SEAM(pb + 4);
        PT1(14);
        if (IN(pb + 5)) { PH_LOCALS for (int tk = (wave * G + bid); tk < 512 + 1024; tk += ngw) rwkv_l3_task(p, l, tk, lane); }
        SEAM(pb + 5);
        PT1(15);
        if (IN(pb + 6)) { PH_LOCALS for (int tk = gw; tk < NRU * 2; tk += ngw) rwkv_r3_task(p, l, tk, lane); }
        SEAM(pb + 6);
        PT1(16);
        for (int rep = 0; rep < NREP(7); ++rep) { if (rep) xcd_barrier(bar);
        if (IN(pb + 7)) { PH_LOCALS
            pg8::Gemm g{(const bf16_t*)(p->ws + WS_OCAT), (const bf16_t*)(p->ws + WS_WBR) + (size_t)l * 4 * 2048 * 512, 4 * NTOK, 4 * 2048, 512, 512};
            BranchOrder S{G, bid};
            EpiZ E{(bf16_t*)(p->ws + WS_Z), (const bf16_t*)(p->ws + WS_U)};
            pg8::gemm_phase<EpiZ, BranchOrder>(lds, g, S, E, nullptr, tid);
        }
        }
        SEAM(pb + 7);
        PT1(17);
        if (IN(pb + 8)) { PH_LOCALS merge_pass(p, l, bid * 512 + tid, G * 512); }
        SEAM(pb + 8);
        PT1(18);
        if (IN(pb + 9)) { PH_LOCALS
            {
                pg8::Gemm g{(const bf16_t*)(p->ws + WS_MERGED), (const bf16_t*)(p->ws + WS_WOUT) + (size_t)l * 2048 * 2048, TP, 2048, 2048, 2048};
                pg8::StaticOrder S; S.init(TP, 2048, G, bid);
                EpiOut E{p->in[I_XP], p->in[I_XS], (const float*)(p->ws + WS_XBUF), (const float*)(p->ws + WS_ADA), (float*)(p->ws + WS_XBUF), l};
                pg8::gemm_phase<EpiOut, pg8::StaticOrder>(lds, g, S, E, nullptr, tid); }
            {
                const int tile = bid >> 3, ks = bid & 7;
                pg8::Gemm g{(const bf16_t*)(p->ws + WS_MERGED) + ks * 256, (const bf16_t*)(p->ws + WS_WOUT) + (size_t)l * 2048 * 2048 + ks * 256, NTOK, 2048, 256, 2048};
                OneUnit S{64 + (tile >> 3), tile & 7, bid < 256};
                EpiOutPart E{(const float*)(p->ws + WS_ADA), (float*)(p->ws + WS_XPART) + ((size_t)(l * 8 + ks) * 1024) * DM, l};
                pg8::gemm_phase<EpiOutPart, OneUnit>(lds, g, S, E, nullptr, tid); }
        }
        SEAM(pb + 9);
        PT1(19);
    }
    if (IN(21)) { PH_LOCALS p_final_rows(p, gw, ngw, lane); }
    PT1(20);
#if PROBE_ID
    if (bid == 0 && tid0 == 0) { const unsigned long long w = *(LAS unsigned long long*)(lds + LDS_PROBE_OFF) * PROBE_K, t0 = __builtin_amdgcn_s_memrealtime(); while (__builtin_amdgcn_s_memrealtime() - t0 < w) __builtin_amdgcn_s_sleep(8); }
#endif
#undef IN
#undef SEAM
}
#ifndef MK_SPLIT
#define MK_SPLIT 0
#endif
extern "C" void kernel_launch(void* const* d_in, const int* in_sizes, int n_in, void* d_out, int out_size, void* d_ws, size_t ws_size, hipStream_t stream) {
    static int grid = 0;
    if (grid == 0) {
        if (n_in != N_IN || (size_t)out_size != O_END || ws_size < WS_END) { fprintf(stderr, "kernel_launch: unexpected shapes (n_in %d, out %d, ws %zu)\n", n_in, out_size, ws_size); grid = -1; return; }
        int dev = 0, cus = 0, per_cu = 0;
        if (hipGetDevice(&dev) != hipSuccess || hipDeviceGetAttribute(&cus, hipDeviceAttributeMultiprocessorCount, dev) != hipSuccess) { grid = -1; return; }
        if (hipFuncSetAttribute((const void*)hse_fwd, hipFuncAttributeMaxDynamicSharedMemorySize, LDS_BYTES) != hipSuccess) { fprintf(stderr, "kernel_launch: hipFuncSetAttribute failed\n"); grid = -1; return; }
        if (hipOccupancyMaxActiveBlocksPerMultiprocessor(&per_cu, (const void*)hse_fwd, 512, LDS_BYTES) != hipSuccess || per_cu < 1) fprintf(stderr, "kernel_launch: occupancy query reports %d\n", per_cu);
        (void)hipGetLastError();
        grid = cus;
    }
    if (grid < 0) return;
    if (hipMemsetAsync((char*)d_ws + WS_CTL, 0, CTL_BYTES, stream) != hipSuccess) return;
    Params a{};
    for (int i = 0; i < N_IN; ++i) a.in[i] = (const float*)d_in[i];
    a.out = (float*)d_out; a.ws = (unsigned char*)d_ws;
#if MK_SPLIT
    for (int ph = 0; ph < NPHASE; ++ph) { a.ph_lo = ph; a.ph_hi = ph + 1; a.li = ph; hipLaunchKernelGGL(hse_fwd, dim3(grid), dim3(512), LDS_BYTES, stream, a); }
#else
    a.ph_lo = 0; a.ph_hi = NPHASE; a.li = 0;
    hipLaunchKernelGGL(hse_fwd, dim3(grid), dim3(512), LDS_BYTES, stream, a);
#endif
    const hipError_t le = hipPeekAtLastError();
    if (le != hipSuccess) fprintf(stderr, "kernel_launch: launch failed: %s\n", hipGetErrorName(le));
}
```

```cpp
#include <hip/hip_runtime.h>
#include <cstdio>
#include <cstdint>
namespace pg8 {
#define PG8_LAS __attribute__((address_space(3)))
typedef unsigned short bf16_t;
typedef short bf16x8 __attribute__((ext_vector_type(8)));
typedef float f32x4 __attribute__((ext_vector_type(4)));
typedef unsigned u32x4 __attribute__((ext_vector_type(4)));
constexpr int BM = 256, BK = 64, HALF = 128, HTB = HALF * BK * 2  , STAGE_BYTES = 8 * HTB, NXCD = 8, WGM = 8;

__host__ __device__ __forceinline__ int lds_byte(int r, int c) { const int st = (r >> 4) * 2 + (c >> 5), rr = r & 15, cc = c & 31, ob = rr * 64 + cc * 2; return st * 1024 + (ob ^ (((ob >> 9) & 1) << 5)); }
__host__ __device__ __forceinline__ void stage_rc(int b, int& R, int& C) { const int st = b / 1024, sb = b % 1024, swz = sb ^ (((sb >> 9) & 1) << 5); R = (st >> 1) * 16 + swz / 64; C = (st & 1) * 32 + (swz % 64) / 2; }
__host__ __device__ __forceinline__ int perm32(int rho) { const int n = rho >> 4, i = rho & 15; return 8 * (i >> 2) + 4 * n + (i & 3); }

struct Unit { int pm, pn; };
struct Gemm { const bf16_t* A; const bf16_t* Bt; int M, N, K, ld; };

struct StaticOrder {
    int nM, nN, nwg, G, c;
    __host__ __device__ void init(int M, int N, int G_, int c_) { nM = M / BM; nN = N / BM; nwg = nM * nN; G = G_; c = c_; }
    __host__ __device__ bool next(int i, Unit& u) const {
        const long L = (long)i * G + c; if (L >= nwg) return false;
        int wgid = (int)L; { const int q = nwg / NXCD, r = nwg % NXCD, xcd = wgid % NXCD, off = wgid / NXCD; wgid = (xcd < r ? xcd * (q + 1) : r * (q + 1) + (xcd - r) * q) + off; }
        const int nig = WGM * nN, gid = wgid / nig, fm = gid * WGM, gsz = (nM - fm) < WGM ? (nM - fm) : WGM;
        u.pm = fm + ((wgid % nig) % gsz); u.pn = (wgid % nig) / gsz; return true;
    }
    __device__ __forceinline__ void a_ready(const Unit&) const {}
    __device__ __forceinline__ void done(const Unit&) const {}
};
__device__ __forceinline__ unsigned cvt_pk_bf16(float lo, float hi) { unsigned r; asm volatile("v_cvt_pk_bf16_f32 %0, %1, %2" : "=v"(r) : "v"(lo), "v"(hi)); return r; }
typedef float f32x2 __attribute__((ext_vector_type(2)));
template <class Epi, class Sched, bool STAMP = false>
__device__ __forceinline__ void gemm_phase(PG8_LAS unsigned char* lds, const Gemm g, const Sched& S, const Epi& E, unsigned long long* stamps, int tid_in) {
    int tid = tid_in; asm volatile("" : "+v"(tid));
    const int wid = __builtin_amdgcn_readfirstlane(tid >> 6), lane = tid & 63, wr = wid >> 2, wc = wid & 3, fr = lane & 15, fq = lane >> 4;
    const int K = g.ld, nt = g.K / BK;
    int ts_lo = 0, ts_hi = 0, nts = 0; const unsigned long long rt_entry = STAMP ? (unsigned long long)wall_clock64() : 0ull;
#define PG8_STAMP() do { if (STAMP && wid == 0 && nts < 64) { const unsigned long long _c = (unsigned long long)clock64(); \
        ts_lo = (lane == nts) ? (int)(unsigned)_c : ts_lo; ts_hi = (lane == nts) ? (int)(unsigned)(_c >> 32) : ts_hi; ++nts; } } while (0)
    PG8_STAMP();
    unsigned voffA[2], voffB[2];
#pragma unroll
    for (int i = 0; i < 2; ++i) { int R, C; stage_rc(tid * 16 + i * 8192, R, C); const int Rb = Epi::PERM ? ((R & ~31) + perm32(R & 31)) : R;
        voffA[i] = (unsigned)(R * K + C) * 2u; voffB[i] = (unsigned)(Rb * K + C) * 2u; }
    const size_t kstep = (size_t)(BK * 2);
    const size_t hstep = (size_t)HALF * K * 2;
    const size_t tstep = 2 * hstep;
    const unsigned ldsw = (unsigned)wid * 1024u;
    const int aoff = lds_byte(wr * 64 + fr, fq * 8), boff = lds_byte(wc * 32 + fr, fq * 8);
#define PG8_SA(b, h) (((b) * 2 + (h)) * HTB)
#define PG8_SB(b, h) ((4 + (b) * 2 + (h)) * HTB)
#define PG8_STAGE(bufoff, gbase, voff) do { _Pragma("unroll") for (int _i = 0; _i < 2; ++_i) \
        __builtin_amdgcn_global_load_lds((const unsigned*)((const char*)(gbase) + (voff)[_i]), (PG8_LAS unsigned*)(lds + (bufoff) + ldsw + _i * 8192), 16, 0, 0); } while (0)
#define PG8_LDA(dst, b, h) do { _Pragma("unroll") for (int m = 0; m < 4; ++m) _Pragma("unroll") for (int k = 0; k < 2; ++k) dst[m][k] = *(const PG8_LAS bf16x8*)(lds + PG8_SA(b, h) + aoff + m * 2048 + k * 1024); } while (0)
#define PG8_LDB(dst, b, h) do { _Pragma("unroll") for (int n = 0; n < 2; ++n) _Pragma("unroll") for (int k = 0; k < 2; ++k) dst[n][k] = *(const PG8_LAS bf16x8*)(lds + PG8_SB(b, h) + boff + n * 2048 + k * 1024); } while (0)
#define PG8_MMA(ai, bj, At, Bt) do { __builtin_amdgcn_s_setprio(1); _Pragma("unroll") for (int m = 0; m < 4; ++m) _Pragma("unroll") for (int n = 0; n < 2; ++n) _Pragma("unroll") for (int k = 0; k < 2; ++k) \
        acc[ai][bj][m][n] = __builtin_amdgcn_mfma_f32_16x16x32_bf16(Bt[n][k], At[m][k], acc[ai][bj][m][n], 0, 0, 0); __builtin_amdgcn_s_setprio(0); } while (0)
#define PG8_WAIT_V(n) asm volatile("s_waitcnt vmcnt(" #n ")" ::: "memory")
#define PG8_WAIT_L(n) asm volatile("s_waitcnt lgkmcnt(" #n ")" ::: "memory")
#define PG8_BAR __builtin_amdgcn_s_barrier()
#define PG8_SCHED __builtin_amdgcn_sched_barrier(0)
    Unit cur, nxt; int ui = 0;
    if (!S.next(0, cur)) return;
    f32x4 acc[2][2][4][2];
#pragma unroll
    for (int a = 0; a < 2; ++a)
#pragma unroll
        for (int b = 0; b < 2; ++b)
#pragma unroll
            for (int m = 0; m < 4; ++m)
#pragma unroll
                for (int n = 0; n < 2; ++n) acc[a][b][m][n] = (f32x4){0.f, 0.f, 0.f, 0.f};
    bf16x8 At[4][2], B0[2][2], B1[2][2];
    const char* cA = (const char*)g.A + (size_t)cur.pm * tstep; const char* cB = (const char*)g.Bt + (size_t)cur.pn * tstep;
    S.a_ready(cur);
    PG8_STAGE(PG8_SB(0, 0), cB, voffB); PG8_STAGE(PG8_SA(0, 0), cA, voffA); PG8_STAGE(PG8_SB(0, 1), cB + hstep, voffB); PG8_STAGE(PG8_SA(0, 1), cA + hstep, voffA);
    if (wr == 1) PG8_BAR;
    PG8_WAIT_V(4); PG8_BAR;
    PG8_STAGE(PG8_SB(1, 0), cB + kstep, voffB); PG8_STAGE(PG8_SA(1, 0), cA + kstep, voffA); PG8_STAGE(PG8_SB(1, 1), cB + hstep + kstep, voffB);
    PG8_WAIT_V(6); PG8_BAR;
    PG8_STAMP();
    for (;;) {
        const bool has_next = S.next(ui + 1, nxt);
        const char* nA = has_next ? (const char*)g.A + (size_t)nxt.pm * tstep : cA; const char* nB = has_next ? (const char*)g.Bt + (size_t)nxt.pn * tstep : cB;
        for (int t = 0; t < nt; t += 2) {
            const bool last = (t == nt - 2);
            const char* a1 = cA + (size_t)(t + 1) * kstep;
            const char* a2 = last ? nA : cA + (size_t)(t + 2) * kstep; const char* b2 = last ? nB : cB + (size_t)(t + 2) * kstep;
            const char* a3 = a2 + kstep; const char* b3 = b2 + kstep;
            if (last && has_next) S.a_ready(nxt);
            PG8_LDB(B0, 0, 0); PG8_SCHED; PG8_LDA(At, 0, 0); PG8_STAGE(PG8_SA(1, 1), a1 + hstep, voffA);
            PG8_WAIT_L(8); PG8_BAR; PG8_WAIT_L(0); PG8_MMA(0, 0, At, B0); PG8_BAR; PG8_SCHED;
            PG8_LDB(B1, 0, 1); PG8_STAGE(PG8_SB(0, 0), b2, voffB);
            PG8_BAR; PG8_WAIT_L(0); PG8_MMA(0, 1, At, B1); PG8_BAR;
            PG8_LDA(At, 0, 1); PG8_STAGE(PG8_SA(0, 0), a2, voffA);
            PG8_BAR; PG8_WAIT_L(0); PG8_MMA(1, 0, At, B0); PG8_BAR; PG8_SCHED;
            PG8_STAGE(PG8_SB(0, 1), b2 + hstep, voffB);
            PG8_WAIT_V(6); PG8_BAR; PG8_MMA(1, 1, At, B1); PG8_BAR;
            PG8_LDB(B0, 1, 0); PG8_SCHED; PG8_LDA(At, 1, 0); PG8_STAGE(PG8_SA(0, 1), a2 + hstep, voffA);
            PG8_WAIT_L(8); PG8_BAR; PG8_WAIT_L(0); PG8_MMA(0, 0, At, B0); PG8_BAR; PG8_SCHED;
            PG8_LDB(B1, 1, 1); PG8_STAGE(PG8_SB(1, 0), b3, voffB);
            PG8_BAR; PG8_WAIT_L(0); PG8_MMA(0, 1, At, B1); PG8_BAR;
            PG8_LDA(At, 1, 1); PG8_STAGE(PG8_SA(1, 0), a3, voffA);
            PG8_BAR; PG8_WAIT_L(0); PG8_MMA(1, 0, At, B0); PG8_BAR; PG8_SCHED;
            PG8_STAGE(PG8_SB(1, 1), b3 + hstep, voffB);
            PG8_WAIT_V(6); PG8_BAR; PG8_MMA(1, 1, At, B1); PG8_BAR;
        }
        PG8_STAMP();
        if constexpr (!Epi::AFTER_DRAIN) { E(acc, cur, wr, wc, fr, fq); S.done(cur); }
        PG8_STAMP();
        if (!has_next) break;
#pragma unroll
        for (int a = 0; a < 2; ++a)
#pragma unroll
            for (int b = 0; b < 2; ++b)
#pragma unroll
                for (int m = 0; m < 4; ++m)
#pragma unroll
                    for (int n = 0; n < 2; ++n) acc[a][b][m][n] = (f32x4){0.f, 0.f, 0.f, 0.f};
        cur = nxt; cA = nA; cB = nB; ++ui;
    }
    PG8_WAIT_V(0);
    if (wr == 0) PG8_BAR;
    PG8_BAR;
    if constexpr (Epi::AFTER_DRAIN) { E.fused(acc, cur, wr, wc, fr, fq, lds, wid, lane); S.done(cur); }
    PG8_STAMP();
    if (STAMP && wid == 0) { stamps[lane] = lane < nts ? (((unsigned long long)(unsigned)ts_hi << 32) | (unsigned)ts_lo) : 0ull;
        if (lane == 62) stamps[62] = rt_entry; if (lane == 63) stamps[63] = (unsigned long long)wall_clock64(); }
#undef PG8_STAMP
#undef PG8_SA
#undef PG8_SB
#undef PG8_STAGE
#undef PG8_LDA
#undef PG8_LDB
#undef PG8_MMA
#undef PG8_WAIT_V
#undef PG8_WAIT_L
#undef PG8_BAR
#undef PG8_SCHED
}
}
#define XB_TMO      128
#define XB_XCNT(j)  (256  + 64 * (j))
#define XB_XSUB(j)  (1280 + 64 * (j))
#define XB_XGEN(j)  (2304 + 64 * (j))
#define XB_TOP      3328
#define XB_TOPGEN   3392
#define XCD_BAR_WORDS 3456
#define XB_SPIN_CAP (1u << 18)
#define LAS __attribute__((address_space(3)))

__device__ __forceinline__ unsigned xb_ld(unsigned* p)              { return __hip_atomic_load(p, __ATOMIC_RELAXED, __HIP_MEMORY_SCOPE_AGENT); }
__device__ __forceinline__ unsigned xb_add(unsigned* p, unsigned v) { return __hip_atomic_fetch_add(p, v, __ATOMIC_RELAXED, __HIP_MEMORY_SCOPE_AGENT); }
__device__ __forceinline__ unsigned xb_xcc_id() { return (unsigned)__builtin_amdgcn_s_getreg((3 << 11) | 20) & 0xFu; }
#define XB_SPIN(cond, bar) do { unsigned _sp = 0; while (cond) { __builtin_amdgcn_s_sleep(1); \
    if ((++_sp & 255u) == 0u) { if (xb_ld(&(bar)[XB_TMO])) break; if (_sp > XB_SPIN_CAP) { atomicAdd(&(bar)[XB_TMO], 1u); break; } } } } while (0)

struct XcdBarrier {
    unsigned* bar; unsigned x;
    volatile LAS unsigned* st;
};

__device__ __forceinline__ XcdBarrier xcd_barrier_post(unsigned* bar, volatile LAS unsigned* st) {
    XcdBarrier b; b.bar = bar; b.x = xb_xcc_id(); b.st = st;
    if (threadIdx.x == 0) (void)xb_add(&bar[XB_XCNT(b.x)], 1u);
    return b;
}
__device__ __forceinline__ void xcd_barrier_complete(unsigned* bar, unsigned x, unsigned& nloc, unsigned& nx) {
    const unsigned G = gridDim.x * gridDim.y * gridDim.z;
    unsigned sum, cnt, mine, sp = 0u;
    for (;;) {
        sum = 0u; cnt = 0u; mine = 0u;
#pragma unroll
        for (unsigned j = 0; j < 16; ++j) { const unsigned c = xb_ld(&bar[XB_XCNT(j)]); sum += c; cnt += (c > 0u) ? 1u : 0u; mine = (j == x) ? c : mine; }
        if (sum == G) break;
        __builtin_amdgcn_s_sleep(1);
        if ((++sp & 255u) == 0u) { if (xb_ld(&bar[XB_TMO])) break; if (sp > XB_SPIN_CAP) { atomicAdd(&bar[XB_TMO], 1u); break; } }
    }
    nloc = mine > 0u ? mine : 1u; nx = cnt > 0u ? cnt : 1u;
}

__device__ __forceinline__ void xcd_barrier(const XcdBarrier& b) {
    asm volatile("s_waitcnt vmcnt(0)" ::: "memory");
    __syncthreads();
    if (threadIdx.x == 0) {
        unsigned* bar = b.bar;
        __builtin_amdgcn_s_waitcnt(0);
        unsigned nloc = b.st[0], nx = b.st[1];
        if (nloc == 0u) { xcd_barrier_complete(bar, b.x, nloc, nx); b.st[0] = nloc; b.st[1] = nx; }
        const unsigned old = xb_add(&bar[XB_XSUB(b.x)], 1u);
        const unsigned gen = old / nloc;
        if (old + 1u == (gen + 1u) * nloc) {
            __builtin_amdgcn_fence(__ATOMIC_RELEASE, "agent");
            asm volatile("s_waitcnt vmcnt(0)" ::: "memory");
            const unsigned og = xb_add(&bar[XB_TOP], 1u);
            const unsigned tg = og / nx;
            if (og + 1u == (tg + 1u) * nx) xb_add(&bar[XB_TOPGEN], 1u);
            else XB_SPIN(xb_ld(&bar[XB_TOPGEN]) == tg, bar);
            __builtin_amdgcn_fence(__ATOMIC_ACQUIRE, "agent");
            xb_add(&bar[XB_XGEN(b.x)], 1u);
            asm volatile("s_waitcnt vmcnt(0)" ::: "memory");
        } else {
            XB_SPIN(xb_ld(&bar[XB_XGEN(b.x)]) == gen, bar);
            __builtin_amdgcn_fence(__ATOMIC_ACQUIRE, "agent");
            asm volatile("s_waitcnt vmcnt(0)" ::: "memory");
        }
    }
    __syncthreads();
}
typedef unsigned short bf16_t;
typedef short bf16x8 __attribute__((ext_vector_type(8)));
typedef float f32x4 __attribute__((ext_vector_type(4)));
typedef float f32x16 __attribute__((ext_vector_type(16)));
typedef unsigned u32x4 __attribute__((ext_vector_type(4)));
typedef unsigned u32x2 __attribute__((ext_vector_type(2)));
using pg8::cvt_pk_bf16;

constexpr int DM = 2048, TP = 16384, NSB = 32, TSQ = 32, NTOK = TP + NSB * TSQ, NSEQ = 33, PAST = 4096, NLAYER = 2;
constexpr int NU = 15104;
constexpr int U_AVAL = 0, U_AGATE = 512, U_ASG = 1024, U_Q = 1536, U_K = 2048, U_V = 2560, U_BSG = 3072, U_XC = 3584, U_CSG = 5248, U_DIN = 5760, U_DSG = 6272, U_G = 6784, U_F = 14976;
constexpr int IN_W = 14984, SHIFT_W = 1664;
constexpr float LOG2E = 1.4426950408889634f;
enum { I_XP = 0, I_XS, I_CK, I_CV, I_CLF, I_SCONV, I_SSHIFT, I_SWKV, I_SPOOL, I_CP, I_CS, I_NORMG, I_WADA, I_BADA, I_WIN, I_BF, I_CONVW, I_CONVB, I_CLNG, I_CLNB, I_MU, I_W0, I_W2, I_A0, I_A2,
       I_KK, I_KA, I_RK, I_GNG, I_GNB, I_POOLW, I_POOLB, I_POOLS, I_WBR, I_WOUT, I_FING, N_IN };
constexpr size_t O_YP = 0, O_YS = O_YP + (size_t)TP * DM, O_PK = O_YS + (size_t)1024 * DM, O_PV = O_PK + (size_t)2 * TP * 512, O_PLF = O_PV + (size_t)2 * TP * 512, O_PCONV = O_PLF + (size_t)2 * TP * 8,
                 O_PSHIFT = O_PCONV + 2 * 30 * 512, O_PWKV = O_PSHIFT + 2 * 1664, O_PPOOL = O_PWKV + 2 * 8 * 64 * 64, O_SK = O_PPOOL + 2 * 15 * 512, O_SV = O_SK + (size_t)2 * 1024 * 512,
                 O_SLF = O_SV + (size_t)2 * 1024 * 512, O_SCONV = O_SLF + 2 * 1024 * 8, O_SSHIFT = O_SCONV + (size_t)2 * 32 * 30 * 512, O_SWKV = O_SSHIFT + 2 * 32 * 1664,
                 O_SPOOL = O_SWKV + (size_t)2 * 32 * 8 * 64 * 64, O_END = O_SPOOL + (size_t)2 * 32 * 15 * 512;
static_assert(O_END == 75374848, "output size");
constexpr size_t al256(size_t x) { return (x + 255) & ~(size_t)255; }
constexpr int NCU_CH = 288, NRU = NCU_CH * 8;
constexpr size_t WS_CTL = 0, CTL_BYTES = 512 * 1024;
constexpr size_t WS_WIN = CTL_BYTES;
constexpr size_t WS_WBR = al256(WS_WIN + (size_t)2 * NU * 2048 * 2);
constexpr size_t WS_WOUT = al256(WS_WBR + (size_t)2 * 4 * 2048 * 512 * 2);
constexpr size_t WS_POOLW = al256(WS_WOUT + (size_t)2 * 2048 * 2048 * 2);
constexpr size_t WS_ADA = al256(WS_POOLW + (size_t)2 * 4 * 128 * 128 * 2);
constexpr size_t WS_H = al256(WS_ADA + (size_t)2 * 33 * 6144 * 4);
constexpr size_t WS_U = al256(WS_H + (size_t)NTOK * 2048 * 2);
constexpr size_t WS_XBUF = al256(WS_U + (size_t)NTOK * NU * 2);
constexpr size_t WS_OCAT = al256(WS_XBUF + (size_t)NTOK * 2048 * 4);
constexpr size_t WS_Z = al256(WS_OCAT + (size_t)4 * NTOK * 512 * 2);
constexpr size_t WS_MERGED = al256(WS_Z + (size_t)4 * NTOK * 2048 * 2);
constexpr size_t WS_FP = al256(WS_MERGED + (size_t)NTOK * 2048 * 2);
constexpr int GS_LEN = PAST + TSQ;
constexpr size_t WS_GS = al256(WS_FP + (size_t)8 * TP * 4);
constexpr size_t WS_VT = al256(WS_GS + (size_t)32 * 8 * GS_LEN * 4);
constexpr size_t WS_TQ = al256(WS_VT + (size_t)8 * 64 * TP * 2);
constexpr size_t WS_GM = al256(WS_TQ + (size_t)NRU * 4096 * 4);
constexpr size_t WS_ET = al256(WS_GM + (size_t)NRU * 4096 * 4);
constexpr size_t WS_Y0T = al256(WS_ET + (size_t)NRU * 4096 * 4);
constexpr size_t WS_SC = al256(WS_Y0T + (size_t)NRU * 4096 * 4);
constexpr size_t WS_BONUS = al256(WS_SC + (size_t)NRU * 4096 * 4);
constexpr size_t WS_GG = al256(WS_BONUS + (size_t)NRU * 64 * 4);
constexpr size_t WS_TG = al256(WS_GG + (size_t)16 * 8 * 4096 * 4);
constexpr size_t WS_SG = al256(WS_TG + (size_t)16 * 8 * 4096 * 4);
constexpr size_t WS_XPART = al256(WS_SG + (size_t)16 * 8 * 4096 * 4);
constexpr size_t WS_END = al256(WS_XPART + (size_t)2 * 8 * 1024 * 2048 * 4);
static_assert(WS_END < (size_t)2100 * 1024 * 1024, "workspace map exceeds the guaranteed d_ws size");
constexpr int CW_BAR = 0;
constexpr int CW_QUEUE = 16 * 3456 + 64;
constexpr int CW_KMAX = CW_QUEUE + 64 * 8;
static_assert((CW_KMAX + 64) * 4 <= (int)CTL_BYTES, "ctl");
constexpr int LDS_BYTES = 163840 - 256;
constexpr int LDS_XB_OFF = LDS_BYTES - 16;
constexpr int SLOT_F = 64 * 65;

#ifndef PROBE_ID
#define PROBE_ID 0
#endif
#ifndef PROBE_K
#define PROBE_K 1
#endif
constexpr int LDS_PROBE_OFF = 163840 - 256 - 64;
#if PROBE_ID
#define PT0() unsigned long long _pt0 = (blockIdx.x == 0 && threadIdx.x == 0) ? __builtin_amdgcn_s_memrealtime() : 0ull
#define PT1(id) do { if ((id) == PROBE_ID && blockIdx.x == 0 && threadIdx.x == 0) { *(LAS unsigned long long*)(lds + LDS_PROBE_OFF) += __builtin_amdgcn_s_memrealtime() - _pt0; } _pt0 = (blockIdx.x == 0 && threadIdx.x == 0) ? __builtin_amdgcn_s_memrealtime() : 0ull; } while (0)
#else
#define PT0() do {} while (0)
#define PT1(id) do {} while (0)
#endif
struct Params { const float* in[N_IN]; float* out; unsigned char* ws; int ph_lo, ph_hi, li, pad; };
typedef const __attribute__((address_space(4))) Params* KP;
__device__ __forceinline__ KP kp_fresh(KP k) { asm volatile("" : "+s"(k)); return k; }

__device__ __forceinline__ float bf2f(unsigned short b) { return __uint_as_float(((unsigned)b) << 16); }
__device__ __forceinline__ float bflo(unsigned w) { return __uint_as_float(w << 16); }
__device__ __forceinline__ float bfhi(unsigned w) { return __uint_as_float(w & 0xffff0000u); }
__device__ __forceinline__ unsigned short f2bf(float f) { return (unsigned short)(cvt_pk_bf16(f, 0.f) & 0xffffu); }
__device__ __forceinline__ float sigmoidf_(float x) { return 1.f / (1.f + __expf(-x)); }
__device__ __forceinline__ float siluf_(float x) { return x / (1.f + __expf(-x)); }
__device__ __forceinline__ float log_sigmoidf_(float z) { return fminf(z, 0.f) - log1pf(expf(-fabsf(z))); }
template <int CTRL> __device__ __forceinline__ float dpp_mov(float v) { return __int_as_float(__builtin_amdgcn_update_dpp(0, __float_as_int(v), CTRL, 0xF, 0xF, true)); }
__device__ __forceinline__ float wave_sum(float v) {
    v += dpp_mov<0xB1>(v); v += dpp_mov<0x4E>(v); v += dpp_mov<0x141>(v); v += dpp_mov<0x140>(v);
    const float r0 = __int_as_float(__builtin_amdgcn_readlane(__float_as_int(v), 0)), r1 = __int_as_float(__builtin_amdgcn_readlane(__float_as_int(v), 16));
    const float r2 = __int_as_float(__builtin_amdgcn_readlane(__float_as_int(v), 32)), r3 = __int_as_float(__builtin_amdgcn_readlane(__float_as_int(v), 48));
    return (r0 + r1) + (r2 + r3);
}
__device__ __forceinline__ float wave_max(float v) {
    v = fmaxf(v, dpp_mov<0xB1>(v)); v = fmaxf(v, dpp_mov<0x4E>(v)); v = fmaxf(v, dpp_mov<0x141>(v)); v = fmaxf(v, dpp_mov<0x140>(v));
    const float r0 = __int_as_float(__builtin_amdgcn_readlane(__float_as_int(v), 0)), r1 = __int_as_float(__builtin_amdgcn_readlane(__float_as_int(v), 16));
    const float r2 = __int_as_float(__builtin_amdgcn_readlane(__float_as_int(v), 32)), r3 = __int_as_float(__builtin_amdgcn_readlane(__float_as_int(v), 48));
    return fmaxf(fmaxf(r0, r1), fmaxf(r2, r3));
}
__device__ __forceinline__ float wave_min(float v) { return -wave_max(-v); }
__device__ __forceinline__ float xhalf_max(float m) { const auto rr = __builtin_amdgcn_permlane32_swap(__float_as_uint(m), __float_as_uint(m), false, false); return fmaxf(__uint_as_float(rr[0]), __uint_as_float(rr[1])); }
__device__ __forceinline__ float xhalf_sum(float m) { const auto rr = __builtin_amdgcn_permlane32_swap(__float_as_uint(m), __float_as_uint(m), false, false); return __uint_as_float(rr[0]) + __uint_as_float(rr[1]); }
__device__ __forceinline__ bf16x8 pack8f(const f32x4 a, const f32x4 b) { u32x4 w; w.x = cvt_pk_bf16(a[0], a[1]); w.y = cvt_pk_bf16(a[2], a[3]); w.z = cvt_pk_bf16(b[0], b[1]); w.w = cvt_pk_bf16(b[2], b[3]); return __builtin_bit_cast(bf16x8, w); }
__device__ __forceinline__ float fast_tanh(float x) { const float e = __expf(-2.f * fabsf(x)); const float t = (1.f - e) * __builtin_amdgcn_rcpf(1.f + e); return x < 0.f ? -t : t; }
__device__ __forceinline__ void tr_tile(const float* __restrict__ src, size_t ld, int k0, int c0, int nvalid, bf16_t* __restrict__ dst, int K, LAS float* scr, int lane) {
    float tv[64];
#pragma unroll
    for (int kk = 0; kk < 64; ++kk) tv[kk] = src[(size_t)(k0 + kk) * ld + c0 + (lane < nvalid ? lane : 0)];
#pragma unroll
    for (int kk = 0; kk < 64; ++kk) scr[kk * 65 + lane] = (lane < nvalid) ? tv[kk] : 0.f;
    const int k2 = (lane & 31) * 2, nh = lane >> 5;
#pragma unroll 8
    for (int it = 0; it < 32; ++it) { const int nn = 2 * it + nh; *(unsigned*)(dst + (size_t)nn * K + k0 + k2) = cvt_pk_bf16(scr[k2 * 65 + nn], scr[(k2 + 1) * 65 + nn]); }
}
__device__ __forceinline__ void p0_weights(KP p, LAS unsigned char* lds, int gw, int ngw, int wave, int lane) {
    LAS float* scr = (LAS float*)lds + wave * SLOT_F;
    constexpr int T_WIN = (NU / 64) * 32, T_WBR = 4 * 32 * 8, T_WOUT = 32 * 32, T_POOL = 4 * 2 * 2, T_L = T_WIN + T_WBR + T_WOUT + T_POOL;
    for (int it = gw; it < 2 * T_L; it += ngw) {
        const int l = it / T_L; int r = it % T_L;
        if (r < T_WIN) {
            const int nt = r / 32, kt = r % 32, m0 = nt * 64;
            int c0, nvalid = 64;
            if (m0 < 3072) c0 = m0; else if (m0 < U_F) c0 = m0 + 8; else if (m0 == U_F) { c0 = 3072; nvalid = 8; } else { c0 = 0; nvalid = 0; }
            tr_tile(p->in[I_WIN] + (size_t)l * 2048 * IN_W, IN_W, kt * 64, c0, nvalid, (bf16_t*)(p->ws + WS_WIN) + ((size_t)l * NU + m0) * 2048, 2048, scr, lane);
            continue; }
        r -= T_WIN;
        if (r < T_WBR) {
            const int n = r / 256, q = r % 256, nt = q / 8, kt = q % 8;
            tr_tile(p->in[I_WBR] + ((size_t)(l * 4 + n) * 512) * 2048, 2048, kt * 64, nt * 64, 64, (bf16_t*)(p->ws + WS_WBR) + ((size_t)(l * 4 + n) * 2048 + nt * 64) * 512, 512, scr, lane);
            continue; }
        r -= T_WBR;
        if (r < T_WOUT) {
            const int nt = r / 32, kt = r % 32;
            tr_tile(p->in[I_WOUT] + (size_t)l * 2048 * 2048, 2048, kt * 64, nt * 64, 64, (bf16_t*)(p->ws + WS_WOUT) + ((size_t)l * 2048 + nt * 64) * 2048, 2048, scr, lane);
            continue; }
        r -= T_WOUT;
        {
            const int g = r / 4, q = r % 4, nt = q / 2, kt = q % 2;
            tr_tile(p->in[I_POOLW] + (size_t)(l * 4 + g) * 128 * 128, 128, kt * 64, nt * 64, 64, (bf16_t*)(p->ws + WS_POOLW) + ((size_t)(l * 4 + g) * 128 + nt * 64) * 128, 128, scr, lane);
        }
    }
}
__device__ __forceinline__ void ada_unit(KP p, int unit, LAS unsigned char* lds, int tid) {
    const int wave = tid >> 6, lane = tid & 63, l = unit / 96, n0 = (unit % 96) * 64;
    LAS float* cs = (LAS float*)lds + wave * (33 * 64);
    LAS float* red = (LAS float*)lds + 8 * 33 * 64;
    const float* W = p->in[I_WADA] + (size_t)l * 2048 * 6144;
    const float* cp = p->in[I_CP]; const float* csm = p->in[I_CS];
    float acc[33];
#pragma unroll
    for (int s = 0; s < 33; ++s) acc[s] = 0.f;
    float wv[16];
#pragma unroll
    for (int j = 0; j < 16; ++j) wv[j] = W[(size_t)(wave * 256 + j) * 6144 + n0 + lane];
#pragma unroll 1
    for (int step = 0; step < 16; ++step) {
        const int k0 = wave * 256 + step * 16, kn = wave * 256 + (step < 15 ? step + 1 : step) * 16;
        float wn[16];
#pragma unroll
        for (int j = 0; j < 16; ++j) wn[j] = W[(size_t)(kn + j) * 6144 + n0 + lane];
        if ((step & 3) == 0) {
#pragma unroll
            for (int s = 0; s < 33; ++s) { const float c = (s == 0) ? cp[k0 + lane] : csm[(size_t)(s - 1) * 2048 + k0 + lane]; cs[s * 64 + lane] = siluf_(c); } }
        const int kk0 = (step & 3) * 16;
#pragma unroll
        for (int q4 = 0; q4 < 4; ++q4) {
#pragma unroll
            for (int s = 0; s < 33; ++s) { const f32x4 c4 = *(const LAS f32x4*)(cs + s * 64 + kk0 + 4 * q4); acc[s] += c4.x * wv[4 * q4] + c4.y * wv[4 * q4 + 1] + c4.z * wv[4 * q4 + 2] + c4.w * wv[4 * q4 + 3]; } }
#pragma unroll
        for (int j = 0; j < 16; ++j) wv[j] = wn[j];
    }
#pragma unroll
    for (int s = 0; s < 33; ++s) red[(wave * 33 + s) * 64 + lane] = acc[s];
    __syncthreads();
    for (int idx = tid; idx < 33 * 64; idx += 512) { const int s = idx >> 6, n = idx & 63; float v = p->in[I_BADA][l * 6144 + n0 + n];
#pragma unroll
        for (int w = 0; w < 8; ++w) v += red[(w * 33 + s) * 64 + n];
        ((float*)(p->ws + WS_ADA))[((size_t)l * 33 + s) * 6144 + n0 + n] = v; }
    __syncthreads();
}
__device__ __forceinline__ void load_x8(KP p, int l, int row, int lane, f32x4 (&v)[8]) {
    if (row < TP) { const f32x4* x4 = (const f32x4*)(l == 0 ? p->in[I_XP] + (size_t)row * DM : (const float*)(p->ws + WS_XBUF) + (size_t)row * DM) + lane;
#pragma unroll
        for (int j = 0; j < 8; ++j) v[j] = x4[64 * j]; }
    else { const int r = row - TP; const f32x4* x4 = (const f32x4*)(p->in[I_XS] + (size_t)r * DM) + lane;
#pragma unroll
        for (int j = 0; j < 8; ++j) v[j] = x4[64 * j];
        for (int s = 0; s < 8 * l; ++s) { const f32x4* q4 = (const f32x4*)((const float*)(p->ws + WS_XPART) + ((size_t)s * 1024 + r) * DM) + lane;
#pragma unroll
            for (int j = 0; j < 8; ++j) v[j] += q4[64 * j]; } }
}
__device__ __forceinline__ void p1_rows(KP p, int l, int gw, int ngw, int lane) {
    const f32x4* g4 = (const f32x4*)(p->in[I_NORMG] + l * DM) + lane;
    f32x4 a[8], sh[8]; int cur_seq = -1;
    for (int row = gw; row < NTOK; row += ngw) {
        const int seq = row < TP ? 0 : 1 + ((row - TP) >> 5);
        f32x4 v[8]; float ss = 0.f; load_x8(p, l, row, lane, v);
#pragma unroll
        for (int j = 0; j < 8; ++j) { ss += (v[j].x * v[j].x + v[j].y * v[j].y) + (v[j].z * v[j].z + v[j].w * v[j].w); }
        if (seq != cur_seq) { cur_seq = seq;
            const f32x4* sh4 = (const f32x4*)((const float*)(p->ws + WS_ADA) + ((size_t)l * 33 + seq) * 6144) + lane; const f32x4* sc4 = sh4 + 512;
#pragma unroll
            for (int j = 0; j < 8; ++j) { a[j] = g4[64 * j] * (sc4[64 * j] + 1.f); sh[j] = sh4[64 * j]; } }
        const float rstd = 1.f / sqrtf(wave_sum(ss) * (1.f / DM) + 1e-6f);
        u32x2* o = (u32x2*)((bf16_t*)(p->ws + WS_H) + (size_t)row * DM) + lane;
#pragma unroll
        for (int j = 0; j < 8; ++j) { const f32x4 y = v[j] * rstd * a[j] + sh[j];
            u32x2 w; w.x = cvt_pk_bf16(y.x, y.y); w.y = cvt_pk_bf16(y.z, y.w); o[64 * j] = w; }
    }
}
__device__ __forceinline__ void p_final_rows(KP p, int gw, int ngw, int lane) {
    const f32x4* g4 = (const f32x4*)p->in[I_FING] + lane;
    for (int row = gw; row < NTOK; row += ngw) {
        f32x4 v[8]; float ss = 0.f; load_x8(p, 2, row, lane, v);
#pragma unroll
        for (int j = 0; j < 8; ++j) { ss += (v[j].x * v[j].x + v[j].y * v[j].y) + (v[j].z * v[j].z + v[j].w * v[j].w); }
        const float rstd = 1.f / sqrtf(wave_sum(ss) * (1.f / DM) + 1e-6f);
        f32x4* o = (f32x4*)(p->out + O_YP + (size_t)row * DM) + lane;
#pragma unroll
        for (int j = 0; j < 8; ++j) o[64 * j] = v[j] * rstd * g4[64 * j];
    }
}
struct EpiU {
    static constexpr bool PERM = true, AFTER_DRAIN = false;
    bf16_t* U; float* out; const float* bf; int l;
    __device__ __forceinline__ void operator()(const f32x4 (&acc)[2][2][4][2], const pg8::Unit& u, int wr, int wc, int fr, int fq) const {
        const int row0 = u.pm * 256 + wr * 64 + fr, col0 = u.pn * 256 + wc * 32 + 8 * fq;
#pragma unroll
        for (int ai = 0; ai < 2; ++ai)
#pragma unroll
            for (int m = 0; m < 4; ++m) { bf16_t* rowp = U + (size_t)(row0 + ai * 128 + m * 16) * NU + col0;
#pragma unroll
                for (int bj = 0; bj < 2; ++bj) { const f32x4 v0 = acc[ai][bj][m][0], v1 = acc[ai][bj][m][1];
                    u32x4 w; w.x = cvt_pk_bf16(v0[0], v0[1]); w.y = cvt_pk_bf16(v0[2], v0[3]); w.z = cvt_pk_bf16(v1[0], v1[1]); w.w = cvt_pk_bf16(v1[2], v1[3]);
                    *(u32x4*)(rowp + bj * 128) = w; } }
        if (u.pn >= 8 && u.pn < 12) {
            const bool isv = u.pn >= 10; const int cin = (u.pn - (isv ? 10 : 8)) * 256 + wc * 32 + 8 * fq;
#pragma unroll
            for (int ai = 0; ai < 2; ++ai)
#pragma unroll
                for (int m = 0; m < 4; ++m) { const int row = row0 + ai * 128 + m * 16;
                    float* dst = row < TP ? out + (isv ? O_PV : O_PK) + ((size_t)l * TP + row) * 512 : out + (isv ? O_SV : O_SK) + ((size_t)l * 1024 + (row - TP)) * 512;
#pragma unroll
                    for (int bj = 0; bj < 2; ++bj) { *(f32x4*)(dst + cin + bj * 128) = acc[ai][bj][m][0]; *(f32x4*)(dst + cin + bj * 128 + 4) = acc[ai][bj][m][1]; } }
        }
        if (u.pn == 58 && wc == 0 && fq == 0) {
            const f32x4 b0 = *(const f32x4*)(bf + l * 8), b1 = *(const f32x4*)(bf + l * 8 + 4);
#pragma unroll
            for (int ai = 0; ai < 2; ++ai)
#pragma unroll
                for (int m = 0; m < 4; ++m) { const int row = row0 + ai * 128 + m * 16;
                    float* dst = row < TP ? out + O_PLF + ((size_t)l * TP + row) * 8 : out + O_SLF + ((size_t)l * 1024 + (row - TP)) * 8;
                    const f32x4 z0 = acc[ai][1][m][0] + b0, z1 = acc[ai][1][m][1] + b1; f32x4 o0, o1;
#pragma unroll
                    for (int e = 0; e < 4; ++e) { o0[e] = log_sigmoidf_(z0[e]); o1[e] = log_sigmoidf_(z1[e]); }
                    *(f32x4*)dst = o0; *(f32x4*)(dst + 4) = o1; }
        }
    }
};
struct BranchOrder {
    int G, c;
    __device__ __forceinline__ bool next(int i, pg8::Unit& u) const { const int L = i * G + c; if (L >= 4 * 544) return false; const int n = L / 544, t = L - n * 544; u.pm = n * 68 + (t >> 3); u.pn = n * 8 + (t & 7); return true; }
    __device__ __forceinline__ void a_ready(const pg8::Unit&) const {}
    __device__ __forceinline__ void done(const pg8::Unit&) const {}
};
struct EpiZ {
    static constexpr bool PERM = true, AFTER_DRAIN = false;
    bf16_t* Z; const bf16_t* U;
    __device__ __forceinline__ void operator()(const f32x4 (&acc)[2][2][4][2], const pg8::Unit& u, int wr, int wc, int fr, int fq) const {
        const int row0 = u.pm * 256 + wr * 64 + fr, col0 = (u.pn & 7) * 256 + wc * 32 + 8 * fq;
#pragma unroll
        for (int ai = 0; ai < 2; ++ai)
#pragma unroll
            for (int m = 0; m < 4; ++m) { bf16_t* rowp = Z + (size_t)(row0 + ai * 128 + m * 16) * DM + col0;
#pragma unroll
                for (int bj = 0; bj < 2; ++bj) { const f32x4 v0 = acc[ai][bj][m][0], v1 = acc[ai][bj][m][1];
                    u32x4 w; w.x = cvt_pk_bf16(v0[0], v0[1]); w.y = cvt_pk_bf16(v0[2], v0[3]); w.z = cvt_pk_bf16(v1[0], v1[1]); w.w = cvt_pk_bf16(v1[2], v1[3]);
                    *(u32x4*)(rowp + bj * 128) = w; } }
    }
};
__device__ __forceinline__ void merge_pass(KP p, int l, int gtid, int ngt) {
    const bf16_t* U = (const bf16_t*)(p->ws + WS_U); const bf16_t* Z = (const bf16_t*)(p->ws + WS_Z); bf16_t* M = (bf16_t*)(p->ws + WS_MERGED);
    for (int it0 = gtid; it0 < NTOK * 256; it0 += 3 * ngt) {
        u32x4 gv[3][4], zv[3][4];
#pragma unroll
        for (int k = 0; k < 3; ++k) { const int it = it0 + k * ngt < NTOK * 256 ? it0 + k * ngt : it0; const int row = it >> 8, col = (it & 255) * 8;
#pragma unroll
            for (int n = 0; n < 4; ++n) { gv[k][n] = *(const u32x4*)(U + (size_t)row * NU + U_G + n * 2048 + col); zv[k][n] = *(const u32x4*)(Z + ((size_t)n * NTOK + row) * DM + col); } }
#pragma unroll
        for (int k = 0; k < 3; ++k) { const int it = it0 + k * ngt; if (it < NTOK * 256) { const int row = it >> 8, col = (it & 255) * 8;
            float s[8];
#pragma unroll
            for (int e = 0; e < 8; ++e) s[e] = 0.f;
#pragma unroll
            for (int n = 0; n < 4; ++n) { const u32x4 g = gv[k][n], z = zv[k][n];
                s[0] += sigmoidf_(bflo(g.x)) * bflo(z.x); s[1] += sigmoidf_(bfhi(g.x)) * bfhi(z.x); s[2] += sigmoidf_(bflo(g.y)) * bflo(z.y); s[3] += sigmoidf_(bfhi(g.y)) * bfhi(z.y);
                s[4] += sigmoidf_(bflo(g.z)) * bflo(z.z); s[5] += sigmoidf_(bfhi(g.z)) * bfhi(z.z); s[6] += sigmoidf_(bflo(g.w)) * bflo(z.w); s[7] += sigmoidf_(bfhi(g.w)) * bfhi(z.w); }
            u32x4 w; w.x = cvt_pk_bf16(s[0], s[1]); w.y = cvt_pk_bf16(s[2], s[3]); w.z = cvt_pk_bf16(s[4], s[5]); w.w = cvt_pk_bf16(s[6], s[7]);
            *(u32x4*)(M + (size_t)row * DM + col) = w; } }
    }
}
struct EpiOut {
    static constexpr bool PERM = false, AFTER_DRAIN = false;
    const float* xp; const float* xs; const float* xb; const float* ada; float* xout; int l;
    __device__ __forceinline__ void operator()(const f32x4 (&acc)[2][2][4][2], const pg8::Unit& u, int wr, int wc, int fr, int fq) const {
        const int row0 = u.pm * 256 + wr * 64 + fr, col0 = u.pn * 256 + wc * 32 + 4 * fq;
        f32x4 gt[2][2];
#pragma unroll
        for (int ai = 0; ai < 2; ++ai)
#pragma unroll
            for (int mp = 0; mp < 4; mp += 2) {
                f32x4 bs[2][2][2], gv[2][2][2];
#pragma unroll
                for (int mm = 0; mm < 2; ++mm) { const int row = row0 + ai * 128 + (mp + mm) * 16;
                    const float* base = l == 0 ? (row < TP ? xp + (size_t)row * DM : xs + (size_t)(row - TP) * DM) : xb + (size_t)row * DM;
                    const float* gate = ada + ((size_t)l * 33 + (row < TP ? 0 : 1 + ((row - TP) >> 5))) * 6144 + 4096;
#pragma unroll
                    for (int bj = 0; bj < 2; ++bj)
#pragma unroll
                        for (int n = 0; n < 2; ++n) { const int col = col0 + bj * 128 + n * 16; bs[mm][bj][n] = *(const f32x4*)(base + col); gv[mm][bj][n] = *(const f32x4*)(gate + col); } }
#pragma unroll
                for (int mm = 0; mm < 2; ++mm) { const int row = row0 + ai * 128 + (mp + mm) * 16;
#pragma unroll
                    for (int bj = 0; bj < 2; ++bj)
#pragma unroll
                        for (int n = 0; n < 2; ++n) { const int col = col0 + bj * 128 + n * 16; *(f32x4*)(xout + (size_t)row * DM + col) = bs[mm][bj][n] + gv[mm][bj][n] * acc[ai][bj][mp + mm][n]; } }
            }
        (void)gt;
    }
};
struct OneUnit {
    int pm, pn; bool valid;
    __device__ __forceinline__ bool next(int i, pg8::Unit& u) const { if (i > 0 || !valid) return false; u.pm = pm; u.pn = pn; return true; }
    __device__ __forceinline__ void a_ready(const pg8::Unit&) const {}
    __device__ __forceinline__ void done(const pg8::Unit&) const {}
};
struct EpiOutPart {
    static constexpr bool PERM = false, AFTER_DRAIN = false;
    const float* ada; float* part; int l;
    __device__ __forceinline__ void operator()(const f32x4 (&acc)[2][2][4][2], const pg8::Unit& u, int wr, int wc, int fr, int fq) const {
        const int row0 = u.pm * 256 + wr * 64 + fr - TP, col0 = u.pn * 256 + wc * 32 + 4 * fq;
#pragma unroll
        for (int ai = 0; ai < 2; ++ai)
#pragma unroll
            for (int m = 0; m < 4; ++m) { const int r = row0 + ai * 128 + m * 16;
                const float* gate = ada + ((size_t)l * 33 + 1 + (r >> 5)) * 6144 + 4096;
#pragma unroll
                for (int bj = 0; bj < 2; ++bj)
#pragma unroll
                    for (int n = 0; n < 2; ++n) { const int col = col0 + bj * 128 + n * 16; *(f32x4*)(part + (size_t)r * DM + col) = *(const f32x4*)(gate + col) * acc[ai][bj][m][n]; } }
    }
};
constexpr int CGS = 516;
__device__ __forceinline__ void conv_unit(KP p, int l, int tile, LAS unsigned char* lds, int tid) {
    const bf16_t* U = (const bf16_t*)(p->ws + WS_U);
    const int c = tid, wave = tid >> 6, lane = tid & 63;
    const bool samp = tile >= 512; const int b = tile - 512, row0 = samp ? TP + b * 32 : tile * 32;
    const bool last = samp || tile == 511;
    LAS float* gl = (LAS float*)lds;
    LAS bf16_t* sgl = (LAS bf16_t*)(lds + 62 * CGS * 4);
    LAS float* red = (LAS float*)(lds + 62 * CGS * 4 + 32 * 512 * 2);
    LAS float* st = red + 8 * 32;
#pragma unroll
    for (int k = 0; k < 8; ++k) { const int task = tid + 512 * k; if (task < 62 * 64) { const int i = task >> 6, ch = task & 63; f32x4 o0, o1;
        const int rel = i - 30;
        if (rel < 0 && samp) { const float* hp = p->in[I_SCONV] + (((size_t)l * 32 + b) * 30 + i) * 512 + 8 * ch; o0 = *(const f32x4*)hp; o1 = *(const f32x4*)(hp + 4); }
        else if (row0 + rel < 0) { o0 = (f32x4){0.f, 0.f, 0.f, 0.f}; o1 = o0; }
        else { const bf16_t* up = U + (size_t)(row0 + rel) * NU + 8 * ch; const u32x4 v = *(const u32x4*)(up + U_AVAL), g = *(const u32x4*)(up + U_AGATE);
            o0 = (f32x4){bflo(v.x) * sigmoidf_(bflo(g.x)), bfhi(v.x) * sigmoidf_(bfhi(g.x)), bflo(v.y) * sigmoidf_(bflo(g.y)), bfhi(v.y) * sigmoidf_(bfhi(g.y))};
            o1 = (f32x4){bflo(v.z) * sigmoidf_(bflo(g.z)), bfhi(v.z) * sigmoidf_(bfhi(g.z)), bflo(v.w) * sigmoidf_(bflo(g.w)), bfhi(v.w) * sigmoidf_(bfhi(g.w))}; }
        *(LAS f32x4*)(gl + i * CGS + 8 * ch) = o0; *(LAS f32x4*)(gl + i * CGS + 8 * ch + 4) = o1; } }
#pragma unroll
    for (int k = 0; k < 4; ++k) { const int task = tid + 512 * k, t = task >> 6, ch = task & 63; const u32x4 s = *(const u32x4*)(U + (size_t)(row0 + t) * NU + U_ASG + 8 * ch);
        u32x4 w; w.x = cvt_pk_bf16(siluf_(bflo(s.x)), siluf_(bfhi(s.x))); w.y = cvt_pk_bf16(siluf_(bflo(s.y)), siluf_(bfhi(s.y))); w.z = cvt_pk_bf16(siluf_(bflo(s.z)), siluf_(bfhi(s.z))); w.w = cvt_pk_bf16(siluf_(bflo(s.w)), siluf_(bfhi(s.w)));
        *(LAS u32x4*)(sgl + t * 512 + 8 * ch) = w; }
    const float cb = p->in[I_CONVB][l * 512 + c], lg = p->in[I_CLNG][l * 512 + c], lb = p->in[I_CLNB][l * 512 + c];
    float wk[31];
#pragma unroll
    for (int k = 0; k < 31; ++k) wk[k] = p->in[I_CONVW][((size_t)l * 31 + k) * 512 + c];
    __syncthreads();
    if (last) {
        float* dst = samp ? p->out + O_SCONV + (((size_t)l * 32 + b) * 30) * 512 + c : p->out + O_PCONV + ((size_t)l * 30) * 512 + c;
#pragma unroll
        for (int t = 2; t < 32; ++t) dst[(size_t)(t - 2) * 512] = gl[(30 + t) * CGS + c];
    }
    bf16_t* oa = (bf16_t*)(p->ws + WS_OCAT);
#pragma unroll 1
    for (int half = 0; half < 2; ++half) {
        float z[46];
#pragma unroll
        for (int i = 0; i < 46; ++i) z[i] = gl[(16 * half + i) * CGS + c];
        float hv[16];
#pragma unroll
        for (int tt = 0; tt < 16; ++tt) hv[tt] = cb;
#pragma unroll
        for (int k = 0; k < 31; ++k) {
#pragma unroll
            for (int tt = 0; tt < 16; ++tt) hv[tt] += z[tt + k] * wk[k]; }
#pragma unroll
        for (int tt = 0; tt < 16; ++tt) { const float s1 = wave_sum(hv[tt]), s2 = wave_sum(hv[tt] * hv[tt]); if (lane == 0) { red[(wave * 16 + tt) * 2] = s1; red[(wave * 16 + tt) * 2 + 1] = s2; } }
        __syncthreads();
        if (tid < 16) { float s1 = 0.f, s2 = 0.f;
#pragma unroll
            for (int w = 0; w < 8; ++w) { s1 += red[(w * 16 + tid) * 2]; s2 += red[(w * 16 + tid) * 2 + 1]; }
            const float mean = s1 * (1.f / 512.f), var = fmaxf(s2 * (1.f / 512.f) - mean * mean, 0.f);
            st[tid * 2] = mean; st[tid * 2 + 1] = 1.f / sqrtf(var + 1e-5f); }
        __syncthreads();
#pragma unroll
        for (int tt = 0; tt < 16; ++tt) { const float y = (hv[tt] - st[tt * 2]) * st[tt * 2 + 1] * lg + lb; const int t = 16 * half + tt;
            oa[(size_t)(row0 + t) * 512 + c] = f2bf(siluf_(y) * bf2f(sgl[t * 512 + c])); }
    }
    __syncthreads();
}
__device__ __forceinline__ void pool_unit(KP p, int l, int tile, LAS unsigned char* lds, int tid) {
    const bf16_t* U = (const bf16_t*)(p->ws + WS_U);
    const int c = tid, wave = tid >> 6, lane = tid & 63;
    const bool samp = tile >= 512; const int b = tile - 512, row0 = samp ? TP + b * 32 : tile * 32;
    constexpr int PST = 520;
    LAS float* zl = (LAS float*)lds;
    LAS bf16_t* pl = (LAS bf16_t*)(lds + 47 * CGS * 4);
#pragma unroll
    for (int k = 0; k < 6; ++k) { const int task = tid + 512 * k; if (task < 47 * 64) { const int i = task >> 6, ch = task & 63; f32x4 o0, o1; const int rel = i - 15;
        if (rel < 0 && samp) { const float* hp = p->in[I_SPOOL] + (((size_t)l * 32 + b) * 15 + i) * 512 + 8 * ch; o0 = *(const f32x4*)hp; o1 = *(const f32x4*)(hp + 4); }
        else if (row0 + rel < 0) { o0 = (f32x4){0.f, 0.f, 0.f, 0.f}; o1 = o0; }
        else { const u32x4 v = *(const u32x4*)(U + (size_t)(row0 + rel) * NU + U_DIN + 8 * ch); o0 = (f32x4){bflo(v.x), bfhi(v.x), bflo(v.y), bfhi(v.y)}; o1 = (f32x4){bflo(v.z), bfhi(v.z), bflo(v.w), bfhi(v.w)}; }
        *(LAS f32x4*)(zl + i * CGS + 8 * ch) = o0; *(LAS f32x4*)(zl + i * CGS + 8 * ch + 4) = o1; } }
    u32x4 sgv[4];
#pragma unroll
    for (int k = 0; k < 4; ++k) { const int task = tid + 512 * k; sgv[k] = *(const u32x4*)(U + (size_t)(row0 + (task >> 6)) * NU + U_DSG + 8 * (task & 63)); }
    __syncthreads();
    {
        float z[47];
#pragma unroll
        for (int i = 0; i < 47; ++i) z[i] = zl[i * CGS + c];
        if (samp || tile == 511) {
            float* dst = samp ? p->out + O_SPOOL + (((size_t)l * 32 + b) * 15) * 512 + c : p->out + O_PPOOL + ((size_t)l * 15) * 512 + c;
#pragma unroll
            for (int t = 17; t < 32; ++t) dst[(size_t)(t - 17) * 512] = z[15 + t];
        }
        const int w = 2 << (c >> 7);
#pragma unroll
        for (int t = 0; t < 32; ++t) { float s = 0.f;
#pragma unroll
            for (int i = 0; i < 16; ++i) s += (i < w) ? z[15 + t - i] : 0.f;
            const int pos = samp ? PAST + t : row0 + t; const int cnt = (pos + 1 < w) ? pos + 1 : w;
            pl[t * PST + c] = f2bf(s / (float)cnt - z[15 + t]); }
    }
    __syncthreads();
    LAS bf16_t* sl = (LAS bf16_t*)lds;
    LAS bf16_t* ol = sl + 32 * PST;
#pragma unroll
    for (int k = 0; k < 4; ++k) { const int task = tid + 512 * k, t = task >> 6, ch = task & 63; const u32x4 s = sgv[k];
        u32x4 w; w.x = cvt_pk_bf16(siluf_(bflo(s.x)), siluf_(bfhi(s.x))); w.y = cvt_pk_bf16(siluf_(bflo(s.y)), siluf_(bfhi(s.y))); w.z = cvt_pk_bf16(siluf_(bflo(s.z)), siluf_(bfhi(s.z))); w.w = cvt_pk_bf16(siluf_(bflo(s.w)), siluf_(bfhi(s.w)));
        *(LAS u32x4*)(sl + t * PST + 8 * ch) = w; }
    __syncthreads();
    {
        const int g = wave >> 1, fr = lane & 15, kq = lane >> 4;
        const bf16_t* WT = (const bf16_t*)(p->ws + WS_POOLW) + (size_t)(l * 4 + g) * 128 * 128;
        f32x4 acc[2][4];
#pragma unroll
        for (int mt = 0; mt < 2; ++mt)
#pragma unroll
            for (int nt = 0; nt < 4; ++nt) acc[mt][nt] = (f32x4){0.f, 0.f, 0.f, 0.f};
#pragma unroll
        for (int ks = 0; ks < 4; ++ks) {
            bf16x8 af[2];
#pragma unroll
            for (int mt = 0; mt < 2; ++mt) af[mt] = *(const LAS bf16x8*)(pl + (16 * mt + fr) * PST + g * 128 + 32 * ks + 8 * kq);
#pragma unroll
            for (int nt = 0; nt < 4; ++nt) { const int dl = (wave & 1) * 64 + 16 * nt + fr;
                const bf16x8 bfr = *(const bf16x8*)(WT + (size_t)dl * 128 + 32 * ks + 8 * kq);
#pragma unroll
                for (int mt = 0; mt < 2; ++mt) acc[mt][nt] = __builtin_amdgcn_mfma_f32_16x16x32_bf16(af[mt], bfr, acc[mt][nt], 0, 0, 0); }
        }
#pragma unroll
        for (int nt = 0; nt < 4; ++nt) { const int d = wave * 64 + 16 * nt + fr; const float pb = p->in[I_POOLB][l * 512 + d], ps = p->in[I_POOLS][l * 512 + d];
#pragma unroll
            for (int mt = 0; mt < 2; ++mt)
#pragma unroll
                for (int r = 0; r < 4; ++r) { const int t = 16 * mt + 4 * kq + r; ol[t * PST + d] = f2bf((acc[mt][nt][r] + pb) * ps * bf2f(sl[t * PST + d])); } }
    }
    __syncthreads();
    bf16_t* od = (bf16_t*)(p->ws + WS_OCAT) + (size_t)3 * NTOK * 512;
#pragma unroll
    for (int k = 0; k < 4; ++k) { const int task = tid + 512 * k, t = task >> 6, ch = task & 63; *(u32x4*)(od + (size_t)(row0 + t) * 512 + 8 * ch) = *(const LAS u32x4*)(ol + t * PST + 8 * ch); }
    __syncthreads();
}
__device__ __forceinline__ void fp_unit(KP p, int l, int h, LAS unsigned char* lds, int tid) {
    const float* lf = p->out + O_PLF + (size_t)l * TP * 8 + h;
    LAS float* part = (LAS float*)lds;
    float v[32]; float s = 0.f;
#pragma unroll
    for (int i = 0; i < 32; ++i) { v[i] = lf[(size_t)(tid * 32 + i) * 8]; s += v[i]; }
    part[tid] = s;
    __syncthreads();
    float pre = 0.f;
    for (int j = 0; j < tid; ++j) pre += part[j];
    float* F = (float*)(p->ws + WS_FP) + (size_t)h * TP + tid * 32;
#pragma unroll
    for (int i = 0; i < 32; ++i) { pre += v[i]; F[i] = pre * LOG2E; }
    __syncthreads();
}
__device__ __forceinline__ void gs_unit(KP p, int l, int b, LAS unsigned char* lds, int tid) {
    const int h = tid & 7, ch = tid >> 3;
    const float* cl = p->in[I_CLF] + (((size_t)l * 32 + b) * PAST + ch * 64) * 8 + h;
    LAS float* part = (LAS float*)lds;
    float v[64]; float s = 0.f;
#pragma unroll
    for (int i = 0; i < 64; ++i) v[i] = cl[(size_t)i * 8];
#pragma unroll
    for (int i = 0; i < 64; ++i) s += v[i];
    part[ch * 8 + h] = s;
    __syncthreads();
    float suf = 0.f;
    for (int j = ch + 1; j < 64; ++j) suf += part[j * 8 + h];
    float* G = (float*)(p->ws + WS_GS) + ((size_t)b * 8 + h) * GS_LEN + ch * 64;
#pragma unroll
    for (int i = 63; i >= 0; --i) { G[i] = -suf * LOG2E; suf += v[i]; }
    if (tid < 8) { const float* nl = p->out + O_SLF + ((size_t)l * 1024 + b * 32) * 8 + tid; float* Gn = (float*)(p->ws + WS_GS) + ((size_t)b * 8 + tid) * GS_LEN + PAST; float w[32]; float run = 0.f;
#pragma unroll
        for (int i = 0; i < 32; ++i) w[i] = nl[i * 8];
#pragma unroll
        for (int i = 0; i < 32; ++i) { run += w[i]; Gn[i] = run * LOG2E; } }
    __syncthreads();
}
__device__ __forceinline__ void vt_tile(KP p, int l, int tile, LAS unsigned char* lds, int wave, int lane) {
    const int h = tile >> 8, tb = tile & 255;
    const bf16_t* U = (const bf16_t*)(p->ws + WS_U);
    LAS unsigned* scr = (LAS unsigned*)lds + wave * SLOT_F;
#pragma unroll 8
    for (int tt = 0; tt < 64; ++tt) scr[tt * 65 + lane] = U[(size_t)(tb * 64 + tt) * NU + U_V + h * 64 + lane];
    {
        float mx = 0.f;
#pragma unroll 8
        for (int tt = 0; tt < 64; ++tt) { const float kv = bf2f(U[(size_t)(tb * 64 + tt) * NU + U_K + h * 64 + lane]); mx = fmaxf(mx, wave_sum(kv * kv)); }
        if (lane == 0) atomicMax((unsigned*)(p->ws + WS_CTL) + CW_KMAX + l * 8 + h, __float_as_uint(mx));
    }
    bf16_t* Vt = (bf16_t*)(p->ws + WS_VT);
    const int t2 = (lane & 31) * 2, dh = lane >> 5;
#pragma unroll 8
    for (int it = 0; it < 32; ++it) { const int d = 2 * it + dh; *(unsigned*)(Vt + ((size_t)h * 64 + d) * TP + tb * 64 + t2) = scr[t2 * 65 + d] | (scr[(t2 + 1) * 65 + d] << 16); }
}
__device__ __forceinline__ void shift_out(KP p, int l, int tid) {
    const bf16_t* U = (const bf16_t*)(p->ws + WS_U);
    for (int base = tid; base < NSEQ * SHIFT_W; base += 512 * 8) {
        unsigned short v[8];
#pragma unroll
        for (int k = 0; k < 8; ++k) { const int idx = base + k * 512 < NSEQ * SHIFT_W ? base + k * 512 : tid; const int s = idx / SHIFT_W, j = idx - s * SHIFT_W; const int row = s == 0 ? TP - 1 : TP + (s - 1) * 32 + 31; v[k] = U[(size_t)row * NU + U_XC + j]; }
#pragma unroll
        for (int k = 0; k < 8; ++k) { const int idx = base + k * 512; if (idx < NSEQ * SHIFT_W) { const int s = idx / SHIFT_W, j = idx - s * SHIFT_W;
            float* dst = s == 0 ? p->out + O_PSHIFT + (size_t)l * SHIFT_W + j : p->out + O_SSHIFT + ((size_t)l * 32 + (s - 1)) * SHIFT_W + j; *dst = bf2f(v[k]); } }
    }
}
template <bool AT, bool BT, bool NEGA>
__device__ __forceinline__ void mm32(f32x16& acc, const LAS float* Ap, int i0, const LAS float* Bp, int j0, int lane) {
    const int li = lane & 31, kh = lane >> 5;
    const LAS float* ap = AT ? Ap + (8 * kh) * 65 + i0 + li : Ap + (i0 + li) * 65 + 8 * kh;
    const LAS float* bp = BT ? Bp + (j0 + li) * 65 + 8 * kh : Bp + (8 * kh) * 65 + j0 + li;
#pragma unroll 2
    for (int s = 0; s < 4; ++s) {
        float a[8], b[8];
#pragma unroll
        for (int e = 0; e < 8; ++e) { a[e] = AT ? ap[(16 * s + e) * 65] : ap[16 * s + e]; b[e] = BT ? bp[16 * s + e] : bp[(16 * s + e) * 65]; }
        if (NEGA) {
#pragma unroll
            for (int e = 0; e < 8; ++e) a[e] = -a[e]; }
        const bf16x8 af = pack8f((f32x4){a[0], a[1], a[2], a[3]}, (f32x4){a[4], a[5], a[6], a[7]}), bfg = pack8f((f32x4){b[0], b[1], b[2], b[3]}, (f32x4){b[4], b[5], b[6], b[7]});
        acc = __builtin_amdgcn_mfma_f32_32x32x16_bf16(af, bfg, acc, 0, 0, 0);
    }
}
template <int MASK>
__device__ __forceinline__ void st_tile(LAS float* dst, const f32x16& acc, int i0, int j0, int lane) {
    const int li = lane & 31, hi = lane >> 5, j = j0 + li;
#pragma unroll
    for (int r = 0; r < 16; ++r) { const int i = i0 + (r & 3) + 8 * (r >> 2) + 4 * hi; float v = acc[r];
        if (MASK == 1 && !(i < j)) v = 0.f; if (MASK == 2 && !(i <= j)) v = 0.f; dst[i * 65 + j] = v; }
}
struct RwkvSeqInfo { int row0, ntok, prev_kind  , b; };
__device__ __forceinline__ RwkvSeqInfo rwkv_info(int cu) { RwkvSeqInfo s; if (cu < 256) { s.row0 = cu * 64; s.ntok = 64; s.prev_kind = cu == 0 ? 0 : 1; s.b = 0; } else { s.b = cu - 256; s.row0 = TP + s.b * 32; s.ntok = 32; s.prev_kind = 2; } return s; }

__device__ __forceinline__ void rwkv_r1(KP p, int l, int unit, LAS unsigned char* lds, int tid) {
    const int cu = unit >> 3, h = unit & 7, wave = tid >> 6, lane = tid & 63, li = lane & 31, hi = lane >> 5;
    const RwkvSeqInfo si = rwkv_info(cu);
    const bf16_t* U = (const bf16_t*)(p->ws + WS_U);
    LAS float* S0 = (LAS float*)lds; LAS float *S1 = S0 + SLOT_F, *S2 = S0 + 2 * SLOT_F, *S3 = S0 + 3 * SLOT_F, *S4 = S0 + 4 * SLOT_F, *S5 = S0 + 5 * SLOT_F, *S6 = S0 + 6 * SLOT_F, *S7 = S0 + 7 * SLOT_F, *S8 = S0 + 8 * SLOT_F;
    LAS float* gC = S0 + 9 * SLOT_F;
    const int q = wave >> 2, wq = wave & 3, i0 = (wq >> 1) * 32, j0 = (wq & 1) * 32;
    PT0();
    {
        const int j = tid & 63, tq = tid >> 6;
        const int tl = lane >> 3, q8 = (lane & 7) * 8;
#pragma unroll
        for (int kb = 0; kb < 5; kb += 3) {
        u32x4 cur[5], prv[5];
#pragma unroll
        for (int k = kb; k < (kb + 3 < 5 ? kb + 3 : 5); ++k) { const int pid = wave * 5 + k, s = pid >> 3, tb = pid & 7, t = tb * 8 + tl;
            const int xo = (s < 3 ? s * 512 + h * 64 : 1536 + (s - 3) * 64) + q8;
            const int tc = t < si.ntok ? t : si.ntok - 1, tp = tc > 0 ? tc - 1 : (si.prev_kind == 1 ? -1 : 0);
            cur[k] = *(const u32x4*)(U + (size_t)(si.row0 + tc) * NU + U_XC + xo); prv[k] = *(const u32x4*)(U + (size_t)(si.row0 + tp) * NU + U_XC + xo); }
#pragma unroll
        for (int k = kb; k < (kb + 3 < 5 ? kb + 3 : 5); ++k) { const int pid = wave * 5 + k, s = pid >> 3, tb = pid & 7, t = tb * 8 + tl;
            const int xo = (s < 3 ? s * 512 + h * 64 : 1536 + (s - 3) * 64) + q8;
            LAS float* dst = (s == 0 ? S0 : s == 1 ? S1 : s == 2 ? S2 : s == 3 ? S3 : S4) + t * 65 + q8;
            const f32x4 m0 = *(const f32x4*)(p->in[I_MU] + l * SHIFT_W + xo), m1 = *(const f32x4*)(p->in[I_MU] + l * SHIFT_W + xo + 4);
            float x[8] = {bflo(cur[k].x), bfhi(cur[k].x), bflo(cur[k].y), bfhi(cur[k].y), bflo(cur[k].z), bfhi(cur[k].z), bflo(cur[k].w), bfhi(cur[k].w)};
            float pv[8] = {bflo(prv[k].x), bfhi(prv[k].x), bflo(prv[k].y), bfhi(prv[k].y), bflo(prv[k].z), bfhi(prv[k].z), bflo(prv[k].w), bfhi(prv[k].w)};
            if (t == 0 && si.prev_kind != 1) {
                if (si.prev_kind == 2) { const float* sp = p->in[I_SSHIFT] + ((size_t)l * 32 + si.b) * SHIFT_W + xo;
#pragma unroll
                    for (int e = 0; e < 8; ++e) pv[e] = sp[e]; }
                else {
#pragma unroll
                    for (int e = 0; e < 8; ++e) pv[e] = 0.f; } }
#pragma unroll
            for (int e = 0; e < 8; ++e) { const float mu = e < 4 ? m0[e] : m1[e - 4]; float xs = (t < si.ntok) ? x[e] + (pv[e] - x[e]) * mu : 0.f; if (s == 3) xs = fast_tanh(xs); dst[e] = xs; }
        }
        }
#pragma unroll
        for (int mm = 0; mm < 8; ++mm) { const int m = tq * 8 + mm;
            S5[m * 65 + j] = p->in[I_W2][((size_t)l * 64 + m) * 512 + h * 64 + j]; S6[m * 65 + j] = p->in[I_A2][((size_t)l * 64 + m) * 512 + h * 64 + j]; }
    }
    __syncthreads();
    PT1(1);
    {
        f32x16 acc = {};
        const int c = j0 + li;
        if (q == 0) { mm32<false, false, false>(acc, S3, i0, S5, j0, lane); const float w0 = p->in[I_W0][l * 512 + h * 64 + c];
#pragma unroll
            for (int r = 0; r < 16; ++r) { const int t = i0 + (r & 3) + 8 * (r >> 2) + 4 * hi; const float zz = acc[r] + w0;
                const float sp = fmaxf(-zz, 0.f) + __logf(1.f + __expf(-fabsf(zz)));
                S7[t * 65 + c] = (t < si.ntok) ? -__expf(-sp - 0.5f) : 0.f; } }
        else { mm32<false, false, false>(acc, S4, i0, S6, j0, lane); const float a0 = p->in[I_A0][l * 512 + h * 64 + c];
#pragma unroll
            for (int r = 0; r < 16; ++r) { const int t = i0 + (r & 3) + 8 * (r >> 2) + 4 * hi; S8[t * 65 + c] = __builtin_amdgcn_rcpf(1.f + __expf(-(acc[r] + a0))); } }
    }
    __syncthreads();
    PT1(2);
    if (wave == 0) { float run = 0.f;
#pragma unroll 8
        for (int t = 0; t < 64; ++t) { run += S7[t * 65 + lane]; S3[t * 65 + lane] = run; } }
    else { const int c = lane; const float kkw = p->in[I_KK][l * 512 + h * 64 + c], kaw = p->in[I_KA][l * 512 + h * 64 + c], rkw = p->in[I_RK][l * 512 + h * 64 + c];
        for (int t = wave - 1; t < 64; t += 7) { const float kr = S1[t * 65 + c], kv = kr * kkw; const float ss = wave_sum(kv * kv);
            const float kn = kv * (1.f / sqrtf(fmaxf(ss, 1e-24f))); const float a = S8[t * 65 + c]; const float km = kr * (1.f + (a - 1.f) * kaw);
            const float bon = wave_sum(S0[t * 65 + c] * km * rkw);
            S4[t * 65 + c] = kn; S1[t * 65 + c] = km; S8[t * 65 + c] = kn * a;
            if (lane == 0) ((float*)(p->ws + WS_BONUS))[(size_t)unit * 64 + t] = bon; } }
    __syncthreads();
    { const int c = tid & 63, tq = tid >> 6;
#pragma unroll
        for (int tt = 0; tt < 8; ++tt) { const int t = tq * 8 + tt, o = t * 65 + c; const float Lg = S3[o], lw = S7[o];
            const float g = __expf(Lg), gi = __expf(-Lg), gp = __expf(Lg - lw);
            S0[o] *= g; S1[o] *= gi; S8[o] *= gi; S4[o] *= gp; if (t == 63) gC[c] = g; } }
    __syncthreads();
    PT1(3);
    { f32x16 acc = {};
      if (q == 0) { mm32<false, true, false>(acc, S1, i0, S4, j0, lane); st_tile<1>(S3, acc, i0, j0, lane); }
      else { mm32<false, true, false>(acc, S8, i0, S4, j0, lane); st_tile<1>(S5, acc, i0, j0, lane); } }
    __syncthreads();
    { f32x16 acc = {};
      if (q == 0) { mm32<true, false, false>(acc, S2, i0, S3, j0, lane); st_tile<0>(S6, acc, i0, j0, lane); }
      else { mm32<false, true, false>(acc, S1, i0, S0, j0, lane); st_tile<2>(S7, acc, i0, j0, lane); } }
    __syncthreads();
    PT1(4);
    { float x[16]; const int r0 = (wave & 3) * 16;
      if (wave < 4) {
#pragma unroll
          for (int rr = 0; rr < 16; ++rr) x[rr] = S4[lane * 65 + r0 + rr]; }
      else {
#pragma unroll
          for (int rr = 0; rr < 16; ++rr) x[rr] = S6[(r0 + rr) * 65 + lane]; }
      __syncthreads();
#pragma unroll
      for (int sb = 0; sb < 4; ++sb) {
          float mreg[16];
#pragma unroll
          for (int s = 0; s < 16; ++s) mreg[s] = S5[(sb * 16 + (s < 15 || sb < 3 ? s : 14)) * 65 + lane];
          __builtin_amdgcn_sched_barrier(0);
#pragma unroll
          for (int s = 0; s < 16; ++s) { if (sb * 16 + s < 63) { const float mrow = mreg[s]; float xs[16];
#pragma unroll
              for (int rr = 0; rr < 16; ++rr) xs[rr] = __builtin_bit_cast(float, __builtin_amdgcn_readlane(__builtin_bit_cast(int, x[rr]), sb * 16 + s));
              __builtin_amdgcn_sched_barrier(0);
#pragma unroll
              for (int rr = 0; rr < 16; ++rr) x[rr] -= xs[rr] * mrow;
              __builtin_amdgcn_sched_barrier(0); } }
      }
      LAS float* dst = wave < 4 ? S3 : S6;
#pragma unroll
      for (int rr = 0; rr < 16; ++rr) dst[(r0 + rr) * 65 + lane] = x[rr]; }
    __syncthreads();
    PT1(5);
    { f32x16 acc = {};
      if (q == 1) { mm32<false, true, false>(acc, S8, i0, S0, j0, lane); st_tile<2>(S4, acc, i0, j0, lane); }
      else { mm32<false, false, false>(acc, S3, i0, S8, j0, lane);
          const int jc = j0 + li; const float gc = gC[jc]; float* TQ = (float*)(p->ws + WS_TQ) + (size_t)unit * 4096;
#pragma unroll
          for (int rg = 0; rg < 4; ++rg) { const int ab = i0 + 8 * rg + 4 * hi; f32x4 o;
#pragma unroll
              for (int e = 0; e < 4; ++e) o[e] = ((ab + e == jc) ? gc : 0.f) - acc[rg * 4 + e] * gc;
              *(f32x4*)(TQ + ((((jc >> 4) * 4 + (ab >> 4)) * 64 + ((ab & 15) >> 2) * 16 + (jc & 15)) * 4)) = o; } } }
    __syncthreads();
    { f32x16 acc = {};
      if (q == 0) { mm32<true, false, false>(acc, S2, i0, S1, j0, lane); mm32<false, false, true>(acc, S6, i0, S8, j0, lane);
          const int jc = j0 + li; const float gc = gC[jc]; float* GM = (float*)(p->ws + WS_GM) + (size_t)unit * 4096;
#pragma unroll
          for (int r = 0; r < 16; ++r) GM[(i0 + (r & 3) + 8 * (r >> 2) + 4 * hi) * 64 + jc] = acc[r] * gc; }
      else { mm32<true, false, false>(acc, S2, i0, S7, j0, lane); mm32<false, false, true>(acc, S6, i0, S4, j0, lane);
          float* Y0T = (float*)(p->ws + WS_Y0T) + (size_t)unit * 4096;
#pragma unroll
          for (int rg = 0; rg < 4; ++rg) *(f32x4*)(Y0T + (((((j0 >> 5) * 2 + (i0 >> 5)) * 4 + rg) * 2 + hi) * 32 + li) * 4) = (f32x4){acc[rg * 4], acc[rg * 4 + 1], acc[rg * 4 + 2], acc[rg * 4 + 3]}; } }
    if (q == 0) { f32x16 acc;
#pragma unroll
        for (int r = 0; r < 16; ++r) acc[r] = S0[(j0 + li) * 65 + i0 + (r & 3) + 8 * (r >> 2) + 4 * hi];
        mm32<false, false, true>(acc, S3, i0, S4, j0, lane);
        float* ET = (float*)(p->ws + WS_ET) + (size_t)unit * 4096;
#pragma unroll
        for (int rg = 0; rg < 4; ++rg) *(f32x4*)(ET + ((((j0 >> 5) * 2 + (i0 >> 5)) * 8 + 2 * rg + hi) * 32 + li) * 4) = (f32x4){acc[rg * 4], acc[rg * 4 + 1], acc[rg * 4 + 2], acc[rg * 4 + 3]}; }
    __syncthreads();
    PT1(6);
}
template <bool SCQ>
__device__ __forceinline__ void chain_run(f32x4 (&st)[4], const float* TQ, const float* GM, float* SC, int nsteps, int i, int g, int lane) {
    constexpr size_t STRIDE = (size_t)8 * 4096;
    f32x4 tq[16], gm[4];
#pragma unroll
    for (int x = 0; x < 16; ++x) tq[x] = *(const f32x4*)(TQ + (x * 64 + lane) * 4);
#pragma unroll
    for (int tl = 0; tl < 4; ++tl) gm[tl] = GM ? *(const f32x4*)(GM + i * 64 + 16 * tl + 4 * g) : (f32x4){0.f, 0.f, 0.f, 0.f};
    for (int c = 0; c < nsteps; ++c) {
        if (SC) {
            if (SCQ) {
#pragma unroll
                for (int tl = 0; tl < 4; ++tl) *(f32x4*)(SC + c * STRIDE + ((((i >> 5) * 2 + (tl >> 1)) * 8 + 4 * (tl & 1) + g) * 32 + (i & 31)) * 4) = st[tl]; }
            else {
#pragma unroll
                for (int tl = 0; tl < 4; ++tl) *(f32x4*)(SC + c * STRIDE + i * 64 + 16 * tl + 4 * g) = st[tl]; } }
        f32x4 tqn[16], gmn[4];
        const int cn = (c + 1 < nsteps) ? c + 1 : c;
#pragma unroll
        for (int x = 0; x < 16; ++x) tqn[x] = *(const f32x4*)(TQ + cn * STRIDE + (x * 64 + lane) * 4);
#pragma unroll
        for (int tl = 0; tl < 4; ++tl) gmn[tl] = GM ? *(const f32x4*)(GM + cn * STRIDE + i * 64 + 16 * tl + 4 * g) : (f32x4){0.f, 0.f, 0.f, 0.f};
        f32x4 acc[4];
#pragma unroll
        for (int tp = 0; tp < 4; ++tp) acc[tp] = gm[tp];
#pragma unroll
        for (int tl = 0; tl < 4; ++tl)
#pragma unroll
            for (int r = 0; r < 4; ++r)
#pragma unroll
                for (int tp = 0; tp < 4; ++tp) acc[tp] = __builtin_amdgcn_mfma_f32_16x16x4f32(tq[tp * 4 + tl][r], st[tl][r], acc[tp], 0, 0, 0);
#pragma unroll
        for (int tl = 0; tl < 4; ++tl) st[tl] = acc[tl];
#pragma unroll
        for (int x = 0; x < 16; ++x) tq[x] = tqn[x];
#pragma unroll
        for (int tl = 0; tl < 4; ++tl) gm[tl] = gmn[tl];
    }
}
constexpr int CH_SLOT = 32768;
#define CH_LD(R, STEP) do { const int s_ = (STEP) < nsteps ? (STEP) : nsteps - 1; _Pragma("unroll") for (int k = 0; k < 4; ++k) { R[k] = *(const f32x4*)(TQ + (size_t)s_ * STRIDE + (k * 256 + ll) * 4); \
        R[4 + k] = GM ? *(const f32x4*)(GM + (size_t)s_ * STRIDE + (k * 256 + ll) * 4) : (f32x4){0.f, 0.f, 0.f, 0.f}; } } while (0)
#define CH_WR(R, SLOT) do { LAS float* d_ = (LAS float*)(lds + (SLOT) * CH_SLOT); _Pragma("unroll") for (int k = 0; k < 4; ++k) { *(LAS f32x4*)(d_ + (k * 256 + ll) * 4) = R[k]; *(LAS f32x4*)(d_ + 4096 + (k * 256 + ll) * 4) = R[4 + k]; } } while (0)
template <bool SCQ>
__device__ __forceinline__ void chain_block(f32x4 (&st)[4], const float* TQ, const float* GM, float* SC, int nsteps, LAS unsigned char* lds, int wave, int lane) {
    constexpr size_t STRIDE = (size_t)8 * 4096;
    if (wave >= 4) {
        const int ll = (wave - 4) * 64 + lane;
        f32x4 r0[8], r1[8], r2[8];
        CH_LD(r0, 0); CH_LD(r1, 1); CH_LD(r2, 2);
        CH_WR(r0, 0);
        __syncthreads();
        for (int c = 0; c < nsteps; c += 3) {
            CH_WR(r1, (c + 1) & 1); CH_LD(r0, c + 3); __syncthreads();
            if (c + 1 < nsteps) { CH_WR(r2, (c + 2) & 1); CH_LD(r1, c + 4); __syncthreads(); }
            if (c + 2 < nsteps) { CH_WR(r0, (c + 3) & 1); CH_LD(r2, c + 5); __syncthreads(); }
        }
    } else {
        const int fr = lane & 15, g = lane >> 4, i = wave * 16 + fr;
        __syncthreads();
        for (int c = 0; c < nsteps; ++c) {
            if (SC) {
                if (SCQ) {
#pragma unroll
                    for (int tl = 0; tl < 4; ++tl) *(f32x4*)(SC + c * STRIDE + ((((i >> 5) * 2 + (tl >> 1)) * 8 + 4 * (tl & 1) + g) * 32 + (i & 31)) * 4) = st[tl]; }
                else {
#pragma unroll
                    for (int tl = 0; tl < 4; ++tl) *(f32x4*)(SC + c * STRIDE + i * 64 + 16 * tl + 4 * g) = st[tl]; } }
            const LAS float* sl = (const LAS float*)(lds + (c & 1) * CH_SLOT);
            f32x4 acc[4];
#pragma unroll
            for (int tp = 0; tp < 4; ++tp) acc[tp] = *(const LAS f32x4*)(sl + 4096 + i * 64 + 16 * tp + 4 * g);
#pragma unroll
            for (int tl = 0; tl < 4; ++tl) { f32x4 tq[4];
#pragma unroll
                for (int tp = 0; tp < 4; ++tp) tq[tp] = *(const LAS f32x4*)(sl + ((tp * 4 + tl) * 64 + lane) * 4);
#pragma unroll
                for (int r = 0; r < 4; ++r)
#pragma unroll
                    for (int tp = 0; tp < 4; ++tp) acc[tp] = __builtin_amdgcn_mfma_f32_16x16x4f32(tq[tp][r], st[tl][r], acc[tp], 0, 0, 0); }
#pragma unroll
            for (int tl = 0; tl < 4; ++tl) st[tl] = acc[tl];
            __syncthreads();
        }
    }
}
__device__ __forceinline__ void rwkv_l1_block(KP p, int task, LAS unsigned char* lds, int wave, int lane) {
    const int kind = task & 1, h = (task >> 1) & 7, grp = task >> 4, iq = wave & 3;
    const int fr = lane & 15, g = lane >> 4, i = iq * 16 + fr;
    const size_t u0 = ((size_t)(grp * 16) * 8 + h) * 4096;
    f32x4 st[4];
#pragma unroll
    for (int tl = 0; tl < 4; ++tl)
#pragma unroll
        for (int r = 0; r < 4; ++r) st[tl][r] = (kind == 1 && i == 16 * tl + 4 * g + r) ? 1.f : 0.f;
    chain_block<false>(st, (const float*)(p->ws + WS_TQ) + u0, kind == 0 ? (const float*)(p->ws + WS_GM) + u0 : nullptr, nullptr, 16, lds, wave, lane);
    if (wave < 4) { const size_t gb = ((size_t)grp * 8 + h) * 4096;
        if (kind == 0) { float* GG = (float*)(p->ws + WS_GG) + gb;
#pragma unroll
            for (int tl = 0; tl < 4; ++tl) *(f32x4*)(GG + i * 64 + 16 * tl + 4 * g) = st[tl]; }
        else { float* TG = (float*)(p->ws + WS_TG) + gb;
#pragma unroll
            for (int tl = 0; tl < 4; ++tl)
#pragma unroll
                for (int r = 0; r < 4; ++r) TG[((tl * 4 + iq) * 64 + (fr >> 2) * 16 + 4 * g + r) * 4 + (fr & 3)] = st[tl][r]; } }
    __syncthreads();
}
__device__ __forceinline__ void rwkv_l2_block(KP p, int l, int h, LAS unsigned char* lds, int wave, int lane) {
    const int iq = wave & 3, fr = lane & 15, g = lane >> 4, i = iq * 16 + fr;
    f32x4 st[4];
#pragma unroll
    for (int tl = 0; tl < 4; ++tl) st[tl] = (f32x4){0.f, 0.f, 0.f, 0.f};
    chain_block<false>(st, (const float*)(p->ws + WS_TG) + (size_t)h * 4096, (const float*)(p->ws + WS_GG) + (size_t)h * 4096, (float*)(p->ws + WS_SG) + (size_t)h * 4096, 16, lds, wave, lane);
    if (wave < 4) { float* dst = p->out + O_PWKV + (((size_t)l * 8 + h) * 64 + i) * 64;
#pragma unroll
        for (int tl = 0; tl < 4; ++tl) *(f32x4*)(dst + 16 * tl + 4 * g) = st[tl]; }
    __syncthreads();
}
__device__ __forceinline__ void rwkv_l3_block(KP p, int task, LAS unsigned char* lds, int wave, int lane) {
    const int h = task & 7, grp = task >> 3, iq = wave & 3, fr = lane & 15, g = lane >> 4, i = iq * 16 + fr;
    f32x4 st[4];
    const float* s0 = (const float*)(p->ws + WS_SG) + ((size_t)grp * 8 + h) * 4096 + i * 64;
#pragma unroll
    for (int tl = 0; tl < 4; ++tl) st[tl] = *(const f32x4*)(s0 + 16 * tl + 4 * g);
    const size_t u0 = ((size_t)(grp * 16) * 8 + h) * 4096;
    chain_block<true>(st, (const float*)(p->ws + WS_TQ) + u0, (const float*)(p->ws + WS_GM) + u0, (float*)(p->ws + WS_SC) + u0, 16, lds, wave, lane);
    __syncthreads();
}
__device__ __forceinline__ void rwkv_samp_task(KP p, int l, int t2, int lane) {
    const int fr = lane & 15, g = lane >> 4, iq = t2 & 3, h = (t2 >> 2) & 7, b = t2 >> 5, i = iq * 16 + fr;
    f32x4 st[4];
    const float* s0 = p->in[I_SWKV] + ((((size_t)l * 32 + b) * 8 + h) * 64 + i) * 64;
#pragma unroll
    for (int tl = 0; tl < 4; ++tl) st[tl] = *(const f32x4*)(s0 + 16 * tl + 4 * g);
    const size_t u0 = ((size_t)(256 + b) * 8 + h) * 4096;
    chain_run<true>(st, (const float*)(p->ws + WS_TQ) + u0, (const float*)(p->ws + WS_GM) + u0, (float*)(p->ws + WS_SC) + u0, 1, i, g, lane);
    float* dst = p->out + O_SWKV + ((((size_t)l * 32 + b) * 8 + h) * 64 + i) * 64;
#pragma unroll
    for (int tl = 0; tl < 4; ++tl) *(f32x4*)(dst + 16 * tl + 4 * g) = st[tl];
}
__device__ __forceinline__ void rwkv_r3_task(KP p, int l, int task, int lane) {
    const int unit = task >> 1, th = task & 1, cu = unit >> 3, h = unit & 7, li = lane & 31, hi = lane >> 5;
    const RwkvSeqInfo si = rwkv_info(cu);
    if (th * 32 >= si.ntok) return;
    const bf16_t* U = (const bf16_t*)(p->ws + WS_U);
    const size_t ub = (size_t)unit * 4096; const int t = th * 32 + li;
    const float* SC = (const float*)(p->ws + WS_SC) + ub; const float* ET = (const float*)(p->ws + WS_ET) + ub; const float* Y0T = (const float*)(p->ws + WS_Y0T) + ub;
    f32x16 acc[2];
#pragma unroll
    for (int ti = 0; ti < 2; ++ti)
#pragma unroll
        for (int rg = 0; rg < 4; ++rg) { const f32x4 y0 = *(const f32x4*)(Y0T + ((((th * 2 + ti) * 4 + rg) * 2 + hi) * 32 + li) * 4);
#pragma unroll
            for (int e = 0; e < 4; ++e) acc[ti][rg * 4 + e] = y0[e]; }
    f32x4 eb[8], sa0[8], sa1[8];
#pragma unroll
    for (int s4 = 0; s4 < 8; ++s4) { eb[s4] = *(const f32x4*)(ET + (((th * 2 + hi) * 8 + s4) * 32 + li) * 4); sa0[s4] = *(const f32x4*)(SC + (((0 * 2 + hi) * 8 + s4) * 32 + li) * 4); sa1[s4] = *(const f32x4*)(SC + (((1 * 2 + hi) * 8 + s4) * 32 + li) * 4); }
#pragma unroll
    for (int s4 = 0; s4 < 8; ++s4) {
#pragma unroll
        for (int e = 0; e < 4; ++e) { acc[0] = __builtin_amdgcn_mfma_f32_32x32x2f32(sa0[s4][e], eb[s4][e], acc[0], 0, 0, 0); acc[1] = __builtin_amdgcn_mfma_f32_32x32x2f32(sa1[s4][e], eb[s4][e], acc[1], 0, 0, 0); }
    }
    float s1 = 0.f;
#pragma unroll
    for (int ti = 0; ti < 2; ++ti)
#pragma unroll
        for (int r = 0; r < 16; ++r) s1 += acc[ti][r];
    s1 = xhalf_sum(s1); const float mean = s1 * (1.f / 64.f);
    float s2 = 0.f;
#pragma unroll
    for (int ti = 0; ti < 2; ++ti)
#pragma unroll
        for (int r = 0; r < 16; ++r) { const float d = acc[ti][r] - mean; s2 += d * d; }
    s2 = xhalf_sum(s2); const float rstd = 1.f / sqrtf(s2 * (1.f / 64.f) + 64e-5f);
    if (t >= si.ntok) return;
    const float bon = ((const float*)(p->ws + WS_BONUS))[(size_t)unit * 64 + t];
    const size_t row = (size_t)(si.row0 + t);
    bf16_t* oc = (bf16_t*)(p->ws + WS_OCAT) + (size_t)2 * NTOK * 512 + row * 512 + h * 64;
    u32x2 wout[2][4];
#pragma unroll
    for (int ti = 0; ti < 2; ++ti)
#pragma unroll
        for (int rg = 0; rg < 4; ++rg) { const int i = 32 * ti + 8 * rg + 4 * hi, c = h * 64 + i;
            const f32x4 gg = *(const f32x4*)(p->in[I_GNG] + l * 512 + c), gb = *(const f32x4*)(p->in[I_GNB] + l * 512 + c), mu = *(const f32x4*)(p->in[I_MU] + l * SHIFT_W + 1024 + c);
            const u32x2 vx = *(const u32x2*)(U + row * NU + U_XC + 1024 + c); const u32x2 sg = *(const u32x2*)(U + row * NU + U_CSG + c);
            f32x4 vc = (f32x4){bflo(vx.x), bfhi(vx.x), bflo(vx.y), bfhi(vx.y)}, vp;
            {
                const u32x2 px = *(const u32x2*)(U + (row > 0 ? row - 1 : 0) * NU + U_XC + 1024 + c); const f32x4 ss = *(const f32x4*)(p->in[I_SSHIFT] + ((size_t)l * 32 + si.b) * SHIFT_W + 1024 + c);
                const f32x4 up = (f32x4){bflo(px.x), bfhi(px.x), bflo(px.y), bfhi(px.y)};
                vp = (t > 0 || si.prev_kind == 1) ? up : (si.prev_kind == 2 ? ss : (f32x4){0.f, 0.f, 0.f, 0.f}); }
            const f32x4 vs = vc + (vp - vc) * mu;
            const f32x4 sgf = (f32x4){bflo(sg.x), bfhi(sg.x), bflo(sg.y), bfhi(sg.y)};
            f32x4 o;
#pragma unroll
            for (int e = 0; e < 4; ++e) o[e] = (((acc[ti][rg * 4 + e] - mean) * rstd) * gg[e] + gb[e] + bon * vs[e]) * siluf_(sgf[e]);
            wout[ti][rg].x = cvt_pk_bf16(o[0], o[1]); wout[ti][rg].y = cvt_pk_bf16(o[2], o[3]); }
#pragma unroll
    for (int ti = 0; ti < 2; ++ti)
#pragma unroll
        for (int rg = 0; rg < 4; ++rg) *(u32x2*)(oc + 32 * ti + 8 * rg + 4 * hi) = wout[ti][rg];
}
__device__ __forceinline__ int krow(int i) { return (i & 3) + 4 * ((i >> 3) & 1) + 8 * ((i >> 2) & 1) + 16 * (i >> 4); }
__device__ __forceinline__ bf16x8 pack8(const f32x16& v, int o) { u32x4 w; w.x = cvt_pk_bf16(v[o], v[o + 1]); w.y = cvt_pk_bf16(v[o + 2], v[o + 3]); w.z = cvt_pk_bf16(v[o + 4], v[o + 5]); w.w = cvt_pk_bf16(v[o + 6], v[o + 7]); return __builtin_bit_cast(bf16x8, w); }
constexpr float ATT_NEG = -1e30f;
template <bool HALF>
__device__ __forceinline__ void softmax_tile(f32x16& p0, f32x16& p1, float& m, float& lsum, f32x16 (&O)[2], bf16x8 (&pb)[4]) {
    float mx = p0[0];
#pragma unroll
    for (int r = 1; r < 16; ++r) mx = fmaxf(mx, p0[r]);
    if (!HALF) {
#pragma unroll
        for (int r = 0; r < 16; ++r) mx = fmaxf(mx, p1[r]); }
    mx = xhalf_max(mx);
    const float mn = fmaxf(m, mx), alpha = __builtin_amdgcn_exp2f(m - mn);
    m = mn;
    float s = 0.f;
#pragma unroll
    for (int r = 0; r < 16; ++r) { p0[r] = __builtin_amdgcn_exp2f(p0[r] - mn); s += p0[r]; }
    if (!HALF) {
#pragma unroll
        for (int r = 0; r < 16; ++r) { p1[r] = __builtin_amdgcn_exp2f(p1[r] - mn); s += p1[r]; } }
    lsum = lsum * alpha + s;
#pragma unroll
    for (int r = 0; r < 16; ++r) { O[0][r] *= alpha; O[1][r] *= alpha; }
    pb[0] = pack8(p0, 0); pb[1] = pack8(p0, 8);
    if (!HALF) { pb[2] = pack8(p1, 0); pb[3] = pack8(p1, 8); }
}
constexpr int AKS = 72;
constexpr int ATT_KB = 0, ATT_VB = 2 * 64 * AKS * 2, ATT_FB = 4 * 64 * AKS * 2, ATT_SC = ATT_FB + 2 * 64 * 4;
__device__ __forceinline__ void attn_prompt_unit(KP p, int l, int h, int qb, LAS unsigned char* lds, int tid) {
    const bf16_t* U = (const bf16_t*)(p->ws + WS_U); const bf16_t* Vt = (const bf16_t*)(p->ws + WS_VT) + (size_t)h * 64 * TP; const float* F = (const float*)(p->ws + WS_FP) + (size_t)h * TP;
    const int wave = tid >> 6, lane = tid & 63, li = lane & 31, hi = lane >> 5;
    const int q0 = qb * 256, q = q0 + wave * 32 + li;
    bf16x8 qf[4];
    { const float sc = 0.125f * LOG2E;
#pragma unroll
      for (int d0 = 0; d0 < 4; ++d0) { const u32x4 w = *(const u32x4*)(U + (size_t)q * NU + U_Q + h * 64 + 16 * d0 + 8 * hi);
          qf[d0] = pack8f((f32x4){bflo(w.x) * sc, bfhi(w.x) * sc, bflo(w.y) * sc, bfhi(w.y) * sc}, (f32x4){bflo(w.z) * sc, bfhi(w.z) * sc, bflo(w.w) * sc, bfhi(w.w) * sc}); } }
    const float fq = F[q];
    float m = ATT_NEG, lsum = 0.f; f32x16 O[2] = {};
    const int NT = (q0 + 256) / 64;
    LAS float* qmx = (LAS float*)(lds + ATT_SC); LAS float* mmv = qmx + 8;
    { float q2 = 0.f;
#pragma unroll
      for (int d0 = 0; d0 < 4; ++d0) { const u32x4 w = __builtin_bit_cast(u32x4, qf[d0]); q2 += bflo(w.x) * bflo(w.x) + bfhi(w.x) * bfhi(w.x) + bflo(w.y) * bflo(w.y) + bfhi(w.y) * bfhi(w.y) + bflo(w.z) * bflo(w.z) + bfhi(w.z) * bfhi(w.z) + bflo(w.w) * bflo(w.w) + bfhi(w.w) * bfhi(w.w); }
      q2 = wave_max(xhalf_sum(q2)); if (lane == 0) { qmx[wave] = q2; mmv[wave] = ATT_NEG; } }
    const float kmax2 = __uint_as_float(((const unsigned*)(p->ws + WS_CTL))[CW_KMAX + l * 8 + h]), fq0 = F[q0];
    const int srow = tid >> 3, sch = tid & 7;
    const bf16_t* kg = U + (size_t)srow * NU + U_K + h * 64 + 8 * sch; const bf16_t* vg = Vt + (size_t)srow * TP + 8 * sch;
    LAS unsigned char* kdst = lds + ATT_KB + (srow * AKS + 8 * sch) * 2; LAS unsigned char* vdst = lds + ATT_VB + (srow * AKS + 8 * sch) * 2;
    u32x4 kr = *(const u32x4*)(kg + (size_t)(NT - 1) * 64 * NU), vr = *(const u32x4*)(vg + (NT - 1) * 64); float fr = tid < 64 ? F[(NT - 1) * 64 + tid] : 0.f;
    *(LAS u32x4*)kdst = kr; *(LAS u32x4*)vdst = vr; if (tid < 64) ((LAS float*)(lds + ATT_FB))[tid] = fr;
    __syncthreads();
    const int ka = krow(li);
    float qkb; { float q2 = qmx[0];
#pragma unroll
      for (int w = 1; w < 8; ++w) q2 = fmaxf(q2, qmx[w]);
      qkb = 1.02f * sqrtf(q2 * kmax2) + fq0; }
    for (int t = NT - 1, buf = 0; t >= 0; --t, buf ^= 1) {
        { float mmin = mmv[0];
#pragma unroll
          for (int w = 1; w < 8; ++w) mmin = fminf(mmin, mmv[w]);
          if (qkb - ((const LAS float*)(lds + ATT_FB))[buf * 64 + 63] < mmin - 40.f) break; }
        if (t > 0) { kr = *(const u32x4*)(kg + (size_t)(t - 1) * 64 * NU); vr = *(const u32x4*)(vg + (t - 1) * 64); if (tid < 64) fr = F[(t - 1) * 64 + tid]; }
        if (64 * t <= q0 + wave * 32 + 31) {
            const LAS bf16_t* Kb = (const LAS bf16_t*)(lds + ATT_KB) + buf * 64 * AKS; const LAS bf16_t* Vb = (const LAS bf16_t*)(lds + ATT_VB) + buf * 64 * AKS; const LAS float* Fb = (const LAS float*)(lds + ATT_FB) + buf * 64;
            f32x16 p0, p1;
#pragma unroll
            for (int g2 = 0; g2 < 2; ++g2) { const f32x4 a = *(const LAS f32x4*)(Fb + 8 * hi + 16 * g2), b = *(const LAS f32x4*)(Fb + 8 * hi + 16 * g2 + 4), c = *(const LAS f32x4*)(Fb + 32 + 8 * hi + 16 * g2), d = *(const LAS f32x4*)(Fb + 32 + 8 * hi + 16 * g2 + 4);
#pragma unroll
                for (int e = 0; e < 4; ++e) { p0[8 * g2 + e] = fq - a[e]; p0[8 * g2 + 4 + e] = fq - b[e]; p1[8 * g2 + e] = fq - c[e]; p1[8 * g2 + 4 + e] = fq - d[e]; } }
#pragma unroll
            for (int d0 = 0; d0 < 4; ++d0) { const bf16x8 a0 = *(const LAS bf16x8*)(Kb + ka * AKS + 16 * d0 + 8 * hi), a1 = *(const LAS bf16x8*)(Kb + (ka + 32) * AKS + 16 * d0 + 8 * hi);
                p0 = __builtin_amdgcn_mfma_f32_32x32x16_bf16(a0, qf[d0], p0, 0, 0, 0); p1 = __builtin_amdgcn_mfma_f32_32x32x16_bf16(a1, qf[d0], p1, 0, 0, 0); }
            if (64 * t + 63 > q0 + wave * 32) {
#pragma unroll
                for (int r = 0; r < 16; ++r) { const int kv = 64 * t + 8 * hi + 16 * (r >> 3) + (r & 7); if (kv > q) p0[r] = -INFINITY; if (kv + 32 > q) p1[r] = -INFINITY; } }
            bf16x8 pb[4];
            softmax_tile<false>(p0, p1, m, lsum, O, pb);
#pragma unroll
            for (int dt = 0; dt < 2; ++dt)
#pragma unroll
                for (int s = 0; s < 4; ++s) { const bf16x8 a = *(const LAS bf16x8*)(Vb + (32 * dt + li) * AKS + 16 * (s & 1) + 32 * (s >> 1) + 8 * hi);
                    O[dt] = __builtin_amdgcn_mfma_f32_32x32x16_bf16(a, pb[s], O[dt], 0, 0, 0); }
        }
        { const float wm = wave_min(m); if (lane == 0) mmv[wave] = wm; }
        if (t > 0) { const int nb = buf ^ 1; *(LAS u32x4*)(kdst + nb * 64 * AKS * 2) = kr; *(LAS u32x4*)(vdst + nb * 64 * AKS * 2) = vr; if (tid < 64) ((LAS float*)(lds + ATT_FB))[nb * 64 + tid] = fr; }
        __syncthreads();
    }
    __syncthreads();
    const float inv = 1.f / xhalf_sum(lsum);
    bf16_t* ob = (bf16_t*)(p->ws + WS_OCAT) + (size_t)1 * NTOK * 512 + (size_t)q * 512 + h * 64;
    u32x2 sgv[2][4];
#pragma unroll
    for (int dt = 0; dt < 2; ++dt)
#pragma unroll
        for (int rg = 0; rg < 4; ++rg) sgv[dt][rg] = *(const u32x2*)(U + (size_t)q * NU + U_BSG + h * 64 + 32 * dt + 8 * rg + 4 * hi);
#pragma unroll
    for (int dt = 0; dt < 2; ++dt)
#pragma unroll
        for (int rg = 0; rg < 4; ++rg) { const int d = 32 * dt + 8 * rg + 4 * hi; const u32x2 sg = sgv[dt][rg];
            u32x2 w; w.x = cvt_pk_bf16(O[dt][rg * 4] * inv * siluf_(bflo(sg.x)), O[dt][rg * 4 + 1] * inv * siluf_(bfhi(sg.x))); w.y = cvt_pk_bf16(O[dt][rg * 4 + 2] * inv * siluf_(bflo(sg.y)), O[dt][rg * 4 + 3] * inv * siluf_(bfhi(sg.y)));
            *(u32x2*)(ob + d) = w; }
}
__device__ __forceinline__ void attn_sample_unit(KP p, int l, int b, int h, LAS unsigned char* lds, int tid) {
    const bf16_t* U = (const bf16_t*)(p->ws + WS_U);
    const int wave = tid >> 6, lane = tid & 63, li = lane & 31, hi = lane >> 5;
    const size_t qrow = (size_t)TP + b * 32 + li;
    const float* G = (const float*)(p->ws + WS_GS) + ((size_t)b * 8 + h) * GS_LEN;
    bf16x8 qf[4];
    { const float sc = 0.125f * LOG2E;
#pragma unroll
      for (int d0 = 0; d0 < 4; ++d0) { const u32x4 w = *(const u32x4*)(U + qrow * NU + U_Q + h * 64 + 16 * d0 + 8 * hi);
          qf[d0] = pack8f((f32x4){bflo(w.x) * sc, bfhi(w.x) * sc, bflo(w.y) * sc, bfhi(w.y) * sc}, (f32x4){bflo(w.z) * sc, bfhi(w.z) * sc, bflo(w.w) * sc, bfhi(w.w) * sc}); } }
    const float fq = G[PAST + li];
    float m = ATT_NEG, lsum = 0.f; f32x16 O[2] = {};
    const float* CK = p->in[I_CK] + (((size_t)l * 32 + b) * PAST) * 512 + h * 64; const float* CV = p->in[I_CV] + (((size_t)l * 32 + b) * PAST) * 512 + h * 64;
    const int ka = krow(li);
    float kmax2;
    { float mx = 0.f; const f32x4* kp4 = (const f32x4*)CK + (tid & 15);
#pragma unroll 1
      for (int it = 0; it < 8; ++it) { f32x4 kv[16];
#pragma unroll
          for (int j = 0; j < 16; ++j) kv[j] = kp4[(size_t)((it * 16 + j) * 32 + (tid >> 4)) * 128];
#pragma unroll
          for (int j = 0; j < 16; ++j) { float s = kv[j][0] * kv[j][0] + kv[j][1] * kv[j][1] + kv[j][2] * kv[j][2] + kv[j][3] * kv[j][3];
              s += dpp_mov<0xB1>(s); s += dpp_mov<0x4E>(s); s += dpp_mov<0x141>(s); s += dpp_mov<0x140>(s); mx = fmaxf(mx, s); } }
      mx = wave_max(mx); LAS float* kml = (LAS float*)lds;
      if (lane == 0) kml[wave] = mx;
      __syncthreads();
      kmax2 = kml[0];
#pragma unroll
      for (int w = 1; w < 8; ++w) kmax2 = fmaxf(kmax2, kml[w]);
      __syncthreads(); }
    float qkb;
    { float q2 = 0.f;
#pragma unroll
      for (int d0 = 0; d0 < 4; ++d0) { const u32x4 w = __builtin_bit_cast(u32x4, qf[d0]); q2 += bflo(w.x) * bflo(w.x) + bfhi(w.x) * bfhi(w.x) + bflo(w.y) * bflo(w.y) + bfhi(w.y) * bfhi(w.y) + bflo(w.z) * bflo(w.z) + bfhi(w.z) * bfhi(w.z) + bflo(w.w) * bflo(w.w) + bfhi(w.w) * bfhi(w.w); }
      q2 = wave_max(xhalf_sum(q2)); qkb = 1.02f * sqrtf(q2 * kmax2) + G[PAST]; }
    {
        f32x16 p0, p1 = {};
#pragma unroll
        for (int g2 = 0; g2 < 2; ++g2) { const float* gp = G + PAST + 8 * hi + 16 * g2; const f32x4 a = *(const f32x4*)gp, bq = *(const f32x4*)(gp + 4);
#pragma unroll
            for (int e = 0; e < 4; ++e) { p0[8 * g2 + e] = fq - a[e]; p0[8 * g2 + 4 + e] = fq - bq[e]; } }
#pragma unroll
        for (int d0 = 0; d0 < 4; ++d0) { const bf16x8 a0 = *(const bf16x8*)(U + ((size_t)TP + b * 32 + ka) * NU + U_K + h * 64 + 16 * d0 + 8 * hi);
            p0 = __builtin_amdgcn_mfma_f32_32x32x16_bf16(a0, qf[d0], p0, 0, 0, 0); }
#pragma unroll
        for (int r = 0; r < 16; ++r) { const int kv = 8 * hi + 16 * (r >> 3) + (r & 7); if (kv > li) p0[r] = -INFINITY; }
        bf16x8 pb[4];
        softmax_tile<true>(p0, p1, m, lsum, O, pb);
        if (wave == 7) {
#pragma unroll
            for (int dt = 0; dt < 2; ++dt)
#pragma unroll
                for (int s = 0; s < 2; ++s) { const bf16_t* vp = U + ((size_t)TP + b * 32 + 16 * s + 8 * hi) * NU + U_V + h * 64 + 32 * dt + li; u32x4 w;
                    w.x = (unsigned)vp[0] | ((unsigned)vp[NU] << 16); w.y = (unsigned)vp[2 * NU] | ((unsigned)vp[3 * NU] << 16); w.z = (unsigned)vp[4 * NU] | ((unsigned)vp[5 * NU] << 16); w.w = (unsigned)vp[6 * NU] | ((unsigned)vp[7 * NU] << 16);
                    O[dt] = __builtin_amdgcn_mfma_f32_32x32x16_bf16(__builtin_bit_cast(bf16x8, w), pb[s], O[dt], 0, 0, 0); } }
        else lsum = 0.f;
    }
    const float mmin = wave_min(m);
    for (int tt = 0; tt < 8; ++tt) {
        const int key0 = (63 - wave - 8 * tt) * 64;
        if (qkb - G[key0 + 63] < mmin - 40.f) break;
        f32x16 p0, p1;
#pragma unroll
        for (int g2 = 0; g2 < 2; ++g2) { const float* gp = G + key0 + 8 * hi + 16 * g2; const f32x4 a = *(const f32x4*)gp, bq = *(const f32x4*)(gp + 4), c = *(const f32x4*)(gp + 32), d = *(const f32x4*)(gp + 36);
#pragma unroll
            for (int e = 0; e < 4; ++e) { p0[8 * g2 + e] = fq - a[e]; p0[8 * g2 + 4 + e] = fq - bq[e]; p1[8 * g2 + e] = fq - c[e]; p1[8 * g2 + 4 + e] = fq - d[e]; } }
#pragma unroll
        for (int d0 = 0; d0 < 4; ++d0) { const float* k0p = CK + (size_t)(key0 + ka) * 512 + 16 * d0 + 8 * hi; const float* k1p = k0p + (size_t)32 * 512;
            const bf16x8 a0 = pack8f(*(const f32x4*)k0p, *(const f32x4*)(k0p + 4)), a1 = pack8f(*(const f32x4*)k1p, *(const f32x4*)(k1p + 4));
            p0 = __builtin_amdgcn_mfma_f32_32x32x16_bf16(a0, qf[d0], p0, 0, 0, 0); p1 = __builtin_amdgcn_mfma_f32_32x32x16_bf16(a1, qf[d0], p1, 0, 0, 0); }
        bf16x8 pb[4];
        softmax_tile<false>(p0, p1, m, lsum, O, pb);
#pragma unroll
        for (int dt = 0; dt < 2; ++dt)
#pragma unroll
            for (int s = 0; s < 4; ++s) { const float* vp = CV + (size_t)(key0 + 16 * (s & 1) + 32 * (s >> 1) + 8 * hi) * 512 + 32 * dt + li;
                const bf16x8 a = pack8f((f32x4){vp[0], vp[512], vp[1024], vp[1536]}, (f32x4){vp[2048], vp[2560], vp[3072], vp[3584]});
                O[dt] = __builtin_amdgcn_mfma_f32_32x32x16_bf16(a, pb[s], O[dt], 0, 0, 0); }
    }
    LAS float* Ow = (LAS float*)lds;
    LAS float* ML = Ow + 8 * 32 * 64;
    lsum = xhalf_sum(lsum);
#pragma unroll
    for (int dt = 0; dt < 2; ++dt)
#pragma unroll
        for (int r = 0; r < 16; ++r) Ow[(wave * 32 + dt * 16 + r) * 64 + lane] = O[dt][r];
    if (hi == 0) { ML[(wave * 2) * 32 + li] = m; ML[(wave * 2 + 1) * 32 + li] = lsum; }
    __syncthreads();
    { const int qq = tid & 31, dg = tid >> 5; float M = ATT_NEG;
#pragma unroll
      for (int w = 0; w < 8; ++w) M = fmaxf(M, ML[(w * 2) * 32 + qq]);
      float L = 0.f; f32x4 o = {0.f, 0.f, 0.f, 0.f};
      const int d = 4 * dg, idx0 = (d >> 5) * 16 + ((d >> 3) & 3) * 4, ln = ((d >> 2) & 1) * 32 + qq;
#pragma unroll
      for (int w = 0; w < 8; ++w) { const float f = __builtin_amdgcn_exp2f(ML[(w * 2) * 32 + qq] - M); L += ML[(w * 2 + 1) * 32 + qq] * f;
#pragma unroll
          for (int e = 0; e < 4; ++e) o[e] += Ow[(w * 32 + idx0 + e) * 64 + ln] * f; }
      const float inv = 1.f / L; const size_t row = (size_t)TP + b * 32 + qq;
      const u32x2 sg = *(const u32x2*)(U + row * NU + U_BSG + h * 64 + d);
      u32x2 wv; wv.x = cvt_pk_bf16(o[0] * inv * siluf_(bflo(sg.x)), o[1] * inv * siluf_(bfhi(sg.x))); wv.y = cvt_pk_bf16(o[2] * inv * siluf_(bflo(sg.y)), o[3] * inv * siluf_(bfhi(sg.y)));
      *(u32x2*)((bf16_t*)(p->ws + WS_OCAT) + (size_t)1 * NTOK * 512 + row * 512 + h * 64 + d) = wv; }
    __syncthreads();
}
constexpr int NPHASE = 22;
__global__ void __launch_bounds__(512, 2) hse_fwd(Params p_) {
    const KP kp = (KP)__builtin_amdgcn_kernarg_segment_ptr();
    (void)p_;
    extern __shared__ __attribute__((aligned(16))) unsigned char lds_raw[];
    LAS unsigned char* lds = (LAS unsigned char*)lds_raw;
    const int tid0 = threadIdx.x;
    const int wave0 = __builtin_amdgcn_readfirstlane(tid0 >> 6);
    const int G = gridDim.x, bid = blockIdx.x, ngw = G * 8;
#define PH_LOCALS const KP p = kp_fresh(kp); int tid = wave0 * 64 + (int)__builtin_amdgcn_mbcnt_hi(~0u, __builtin_amdgcn_mbcnt_lo(~0u, 0u)); asm volatile("" : "+v"(tid)); const int lane = tid & 63, wave = __builtin_amdgcn_readfirstlane(tid >> 6), gw = bid * 8 + wave; (void)lane; (void)gw; (void)p;
    if (tid0 < 4) ((LAS unsigned*)(lds + LDS_XB_OFF))[tid0] = 0u;
#if PROBE_ID
    if (tid0 == 0) *(LAS unsigned long long*)(lds + LDS_PROBE_OFF) = 0ull;
#endif
    __syncthreads();
    unsigned* ctl = (unsigned*)(kp->ws + WS_CTL);
    XcdBarrier bar = xcd_barrier_post(ctl + CW_BAR + kp->li * XCD_BAR_WORDS, (volatile LAS unsigned*)(lds + LDS_XB_OFF));
    const int lo = kp->ph_lo, hi = kp->ph_hi;
#define IN(k) (lo <= (k) && (k) < hi)
#ifndef DUP_MASK
#define DUP_MASK 0
#endif
#define NREP(k) (((DUP_MASK >> (k)) & 1) + 1)
#define SEAM(k) do { if (IN(k) && IN((k) + 1)) xcd_barrier(bar); } while (0)
    PT0();
    if (IN(0)) { PH_LOCALS
        for (int u = bid; u < 192; u += G) ada_unit(p, u, lds, tid);
        p0_weights(p, lds, gw, ngw, wave, lane);
    }
    SEAM(0);
    PT1(9);
    for (int l = 0; l < NLAYER; ++l) {
        const int pb = 1 + 10 * l;
        for (int rep = 0; rep < NREP(0); ++rep) { if (rep) xcd_barrier(bar);
        if (IN(pb)) { PH_LOCALS p1_rows(p, l, gw, ngw, lane); } }
        SEAM(pb);
        PT1(10);
        for (int rep = 0; rep < NREP(1); ++rep) { if (rep) xcd_barrier(bar);
        if (IN(pb + 1)) { PH_LOCALS
            pg8::Gemm g{(const bf16_t*)(p->ws + WS_H), (const bf16_t*)(p->ws + WS_WIN) + (size_t)l * NU * 2048, NTOK, NU, 2048, 2048};
            pg8::StaticOrder S; S.init(NTOK, NU, G, bid);
            EpiU E{(bf16_t*)(p->ws + WS_U), p->out, p->in[I_BF], l};
            pg8::gemm_phase<EpiU, pg8::StaticOrder>(lds, g, S, E, nullptr, tid);
        }
        }
        SEAM(pb + 1);
        PT1(11);
        for (int rep = 0; rep < NREP(2); ++rep) { if (rep) xcd_barrier(bar);
        if (IN(pb + 2)) { PH_LOCALS
#ifndef DUP_SUB
#define DUP_SUB 0
#endif
            { PT0();
            for (int u = bid; u < NRU * ((DUP_SUB & 1) + 1); u += G) rwkv_r1(p, l, u % NRU, lds, tid);
            PT1(31);
            for (int u = (bid + G - 32) % G; u < 544 * (((DUP_SUB >> 1) & 1) + 1); u += G) conv_unit(p, l, u % 544, lds, tid);
            PT1(32);
            for (int u = (bid + G - 64) % G; u < 544 * (((DUP_SUB >> 2) & 1) + 1); u += G) pool_unit(p, l, u % 544, lds, tid);
            PT1(33);
            for (int u = bid; u < 256; u += G) { vt_tile(p, l, u * 8 + wave, lds, wave, lane); }
            __syncthreads();
            for (int u = (bid + G - 96) % G; u < 32; u += G) gs_unit(p, l, u, lds, tid);
            for (int u = G - 1 - bid; u < 8; u += G) fp_unit(p, l, u, lds, tid);
            if (bid == G / 2) shift_out(p, l, tid);
            PT1(34); }
        }
        }
        SEAM(pb + 2);
        PT1(12);
        for (int rep = 0; rep < NREP(3); ++rep) { if (rep) xcd_barrier(bar);
        if (IN(pb + 3)) { PH_LOCALS
            for (int tk = bid; tk < 256; tk += G) rwkv_l1_block(p, tk, lds, wave, lane);
            LAS int* qslot = (LAS int*)(lds + LDS_XB_OFF - 16);
            for (;;) {
                if (tid == 0) *qslot = (int)atomicAdd(ctl + CW_QUEUE + 64 * (2 * l + 4 * rep), 1u);
                __syncthreads();
                const int item = *qslot;
                __syncthreads();
                if (item >= 512) break;
                attn_prompt_unit(p, l, item & 7, 63 - (item >> 3), lds, tid);
            }
            for (;;) {
                if (tid == 0) *qslot = (int)atomicAdd(ctl + CW_QUEUE + 64 * (2 * l + 1 + 4 * rep), 1u);
                __syncthreads();
                const int item = *qslot;
                __syncthreads();
                if (item >= 256) break;
                attn_sample_unit(p, l, item >> 3, item & 7, lds, tid);
            }
        }
        }
        SEAM(pb + 3);
        PT1(13);
        if (IN(pb + 4)) { PH_LOCALS for (int tk = bid; tk < 8; tk += G) rwkv_l2_block(p, l, tk, lds, wave, lane); }
        SEAM(pb + 4);
        PT1(14);
        if (IN(pb + 5)) { PH_LOCALS
            for (int tk = bid; tk < 128; tk += G) rwkv_l3_block(p, tk, lds, wave, lane);
            for (int tk = ((bid + G - 128) % G) * 8 + wave; tk < 1024; tk += ngw) rwkv_samp_task(p, l, tk, lane);
        }
        SEAM(pb + 5);
        PT1(15);
        if (IN(pb + 6)) { PH_LOCALS for (int tk = gw; tk < NRU * 2; tk += ngw) rwkv_r3_task(p, l, tk, lane); }
        SEAM(pb + 6);
        PT1(16);
        for (int rep = 0; rep < NREP(7); ++rep) { if (rep) xcd_barrier(bar);
        if (IN(pb + 7)) { PH_LOCALS
            pg8::Gemm g{(const bf16_t*)(p->ws + WS_OCAT), (const bf16_t*)(p->ws + WS_WBR) + (size_t)l * 4 * 2048 * 512, 4 * NTOK, 4 * 2048, 512, 512};
            BranchOrder S{G, bid};
            EpiZ E{(bf16_t*)(p->ws + WS_Z), (const bf16_t*)(p->ws + WS_U)};
            pg8::gemm_phase<EpiZ, BranchOrder>(lds, g, S, E, nullptr, tid);
        }
        }
        SEAM(pb + 7);
        PT1(17);
        if (IN(pb + 8)) { PH_LOCALS merge_pass(p, l, bid * 512 + tid, G * 512); }
        SEAM(pb + 8);
        PT1(18);
        if (IN(pb + 9)) { PH_LOCALS
            {
                pg8::Gemm g{(const bf16_t*)(p->ws + WS_MERGED), (const bf16_t*)(p->ws + WS_WOUT) + (size_t)l * 2048 * 2048, TP, 2048, 2048, 2048};
                pg8::StaticOrder S; S.init(TP, 2048, G, bid);
                EpiOut E{p->in[I_XP], p->in[I_XS], (const float*)(p->ws + WS_XBUF), (const float*)(p->ws + WS_ADA), (float*)(p->ws + WS_XBUF), l};
                pg8::gemm_phase<EpiOut, pg8::StaticOrder>(lds, g, S, E, nullptr, tid); }
            {
                const int tile = bid >> 3, ks = bid & 7;
                pg8::Gemm g{(const bf16_t*)(p->ws + WS_MERGED) + ks * 256, (const bf16_t*)(p->ws + WS_WOUT) + (size_t)l * 2048 * 2048 + ks * 256, NTOK, 2048, 256, 2048};
                OneUnit S{64 + (tile >> 3), tile & 7, bid < 256};
                EpiOutPart E{(const float*)(p->ws + WS_ADA), (float*)(p->ws + WS_XPART) + ((size_t)(l * 8 + ks) * 1024) * DM, l};
                pg8::gemm_phase<EpiOutPart, OneUnit>(lds, g, S, E, nullptr, tid); }
        }
        SEAM(pb + 9);
        PT1(19);
    }
    if (IN(21)) { PH_LOCALS p_final_rows(p, gw, ngw, lane); }
    PT1(20);
#if PROBE_ID
    if (bid == 0 && tid0 == 0) { const unsigned long long w = *(LAS unsigned long long*)(lds + LDS_PROBE_OFF) * PROBE_K, t0 = __builtin_amdgcn_s_memrealtime(); while (__builtin_amdgcn_s_memrealtime() - t0 < w) __builtin_amdgcn_s_sleep(8); }
#endif
#undef IN
#undef SEAM
}
#ifndef MK_SPLIT
#define MK_SPLIT 0
#endif
extern "C" void kernel_launch(void* const* d_in, const int* in_sizes, int n_in, void* d_out, int out_size, void* d_ws, size_t ws_size, hipStream_t stream) {
    static int grid = 0;
    if (grid == 0) {
        if (n_in != N_IN || (size_t)out_size != O_END || ws_size < WS_END) { fprintf(stderr, "kernel_launch: unexpected shapes (n_in %d, out %d, ws %zu)\n", n_in, out_size, ws_size); grid = -1; return; }
        int dev = 0, cus = 0, per_cu = 0;
        if (hipGetDevice(&dev) != hipSuccess || hipDeviceGetAttribute(&cus, hipDeviceAttributeMultiprocessorCount, dev) != hipSuccess) { grid = -1; return; }
        if (hipFuncSetAttribute((const void*)hse_fwd, hipFuncAttributeMaxDynamicSharedMemorySize, LDS_BYTES) != hipSuccess) { fprintf(stderr, "kernel_launch: hipFuncSetAttribute failed\n"); grid = -1; return; }
        if (hipOccupancyMaxActiveBlocksPerMultiprocessor(&per_cu, (const void*)hse_fwd, 512, LDS_BYTES) != hipSuccess || per_cu < 1) fprintf(stderr, "kernel_launch: occupancy query reports %d\n", per_cu);
        (void)hipGetLastError();
        grid = cus;
    }
    if (grid < 0) return;
    if (hipMemsetAsync((char*)d_ws + WS_CTL, 0, CTL_BYTES, stream) != hipSuccess) return;
    Params a{};
    for (int i = 0; i < N_IN; ++i) a.in[i] = (const float*)d_in[i];
    a.out = (float*)d_out; a.ws = (unsigned char*)d_ws;
#if MK_SPLIT
    for (int ph = 0; ph < NPHASE; ++ph) { a.ph_lo = ph; a.ph_hi = ph + 1; a.li = ph; hipLaunchKernelGGL(hse_fwd, dim3(grid), dim3(512), LDS_BYTES, stream, a); }
#else
    a.ph_lo = 0; a.ph_hi = NPHASE; a.li = 0;
    hipLaunchKernelGGL(hse_fwd, dim3(grid), dim3(512), LDS_BYTES, stream, a);
#endif
    const hipError_t le = hipPeekAtLastError();
    if (le != hipSuccess) fprintf(stderr, "kernel_launch: launch failed: %s\n", hipGetErrorName(le));
}
```

```cpp
#include <hip/hip_runtime.h>
#include <cstdio>
#include <cstdint>
namespace pg8 {
#define PG8_LAS __attribute__((address_space(3)))
typedef unsigned short bf16_t;
typedef short bf16x8 __attribute__((ext_vector_type(8)));
typedef float f32x4 __attribute__((ext_vector_type(4)));
typedef unsigned u32x4 __attribute__((ext_vector_type(4)));
constexpr int BM = 256, BK = 64, HALF = 128, HTB = HALF * BK * 2  , STAGE_BYTES = 8 * HTB, NXCD = 8, WGM = 8;

__host__ __device__ __forceinline__ int lds_byte(int r, int c) { const int st = (r >> 4) * 2 + (c >> 5), rr = r & 15, cc = c & 31, ob = rr * 64 + cc * 2; return st * 1024 + (ob ^ (((ob >> 9) & 1) << 5)); }
__host__ __device__ __forceinline__ void stage_rc(int b, int& R, int& C) { const int st = b / 1024, sb = b % 1024, swz = sb ^ (((sb >> 9) & 1) << 5); R = (st >> 1) * 16 + swz / 64; C = (st & 1) * 32 + (swz % 64) / 2; }
__host__ __device__ __forceinline__ int perm32(int rho) { const int n = rho >> 4, i = rho & 15; return 8 * (i >> 2) + 4 * n + (i & 3); }

struct Unit { int pm, pn; };
struct Gemm { const bf16_t* A; const bf16_t* Bt; int M, N, K, ld; };

struct StaticOrder {
    int nM, nN, nwg, G, c;
    __host__ __device__ void init(int M, int N, int G_, int c_) { nM = M / BM; nN = N / BM; nwg = nM * nN; G = G_; c = c_; }
    __host__ __device__ bool next(int i, Unit& u) const {
        const long L = (long)i * G + c; if (L >= nwg) return false;
        int wgid = (int)L; { const int q = nwg / NXCD, r = nwg % NXCD, xcd = wgid % NXCD, off = wgid / NXCD; wgid = (xcd < r ? xcd * (q + 1) : r * (q + 1) + (xcd - r) * q) + off; }
        const int nig = WGM * nN, gid = wgid / nig, fm = gid * WGM, gsz = (nM - fm) < WGM ? (nM - fm) : WGM;
        u.pm = fm + ((wgid % nig) % gsz); u.pn = (wgid % nig) / gsz; return true;
    }
    __device__ __forceinline__ void a_ready(const Unit&) const {}
    __device__ __forceinline__ void done(const Unit&) const {}
};
__device__ __forceinline__ unsigned cvt_pk_bf16(float lo, float hi) { unsigned r; asm volatile("v_cvt_pk_bf16_f32 %0, %1, %2" : "=v"(r) : "v"(lo), "v"(hi)); return r; }
typedef float f32x2 __attribute__((ext_vector_type(2)));
template <class Epi, class Sched, bool STAMP = false>
__device__ __forceinline__ void gemm_phase(PG8_LAS unsigned char* lds, const Gemm g, const Sched& S, const Epi& E, unsigned long long* stamps, int tid_in) {
    int tid = tid_in; asm volatile("" : "+v"(tid));
    const int wid = __builtin_amdgcn_readfirstlane(tid >> 6), lane = tid & 63, wr = wid >> 2, wc = wid & 3, fr = lane & 15, fq = lane >> 4;
    const int K = g.ld, nt = g.K / BK;
    int ts_lo = 0, ts_hi = 0, nts = 0; const unsigned long long rt_entry = STAMP ? (unsigned long long)wall_clock64() : 0ull;
#define PG8_STAMP() do { if (STAMP && wid == 0 && nts < 64) { const unsigned long long _c = (unsigned long long)clock64(); \
        ts_lo = (lane == nts) ? (int)(unsigned)_c : ts_lo; ts_hi = (lane == nts) ? (int)(unsigned)(_c >> 32) : ts_hi; ++nts; } } while (0)
    PG8_STAMP();
    unsigned voffA[2], voffB[2];
#pragma unroll
    for (int i = 0; i < 2; ++i) { int R, C; stage_rc(tid * 16 + i * 8192, R, C); const int Rb = Epi::PERM ? ((R & ~31) + perm32(R & 31)) : R;
        voffA[i] = (unsigned)(R * K + C) * 2u; voffB[i] = (unsigned)(Rb * K + C) * 2u; }
    const size_t kstep = (size_t)(BK * 2);
    const size_t hstep = (size_t)HALF * K * 2;
    const size_t tstep = 2 * hstep;
    const unsigned ldsw = (unsigned)wid * 1024u;
    const int aoff = lds_byte(wr * 64 + fr, fq * 8), boff = lds_byte(wc * 32 + fr, fq * 8);
#define PG8_SA(b, h) (((b) * 2 + (h)) * HTB)
#define PG8_SB(b, h) ((4 + (b) * 2 + (h)) * HTB)
#define PG8_STAGE(bufoff, gbase, voff) do { _Pragma("unroll") for (int _i = 0; _i < 2; ++_i) \
        __builtin_amdgcn_global_load_lds((const unsigned*)((const char*)(gbase) + (voff)[_i]), (PG8_LAS unsigned*)(lds + (bufoff) + ldsw + _i * 8192), 16, 0, 0); } while (0)
#define PG8_LDA(dst, b, h) do { _Pragma("unroll") for (int m = 0; m < 4; ++m) _Pragma("unroll") for (int k = 0; k < 2; ++k) dst[m][k] = *(const PG8_LAS bf16x8*)(lds + PG8_SA(b, h) + aoff + m * 2048 + k * 1024); } while (0)
#define PG8_LDB(dst, b, h) do { _Pragma("unroll") for (int n = 0; n < 2; ++n) _Pragma("unroll") for (int k = 0; k < 2; ++k) dst[n][k] = *(const PG8_LAS bf16x8*)(lds + PG8_SB(b, h) + boff + n * 2048 + k * 1024); } while (0)
#define PG8_MMA(ai, bj, At, Bt) do { __builtin_amdgcn_s_setprio(1); _Pragma("unroll") for (int m = 0; m < 4; ++m) _Pragma("unroll") for (int n = 0; n < 2; ++n) _Pragma("unroll") for (int k = 0; k < 2; ++k) \
        acc[ai][bj][m][n] = __builtin_amdgcn_mfma_f32_16x16x32_bf16(Bt[n][k], At[m][k], acc[ai][bj][m][n], 0, 0, 0); __builtin_amdgcn_s_setprio(0); } while (0)
#define PG8_WAIT_V(n) asm volatile("s_waitcnt vmcnt(" #n ")" ::: "memory")
#define PG8_WAIT_L(n) asm volatile("s_waitcnt lgkmcnt(" #n ")" ::: "memory")
#define PG8_BAR __builtin_amdgcn_s_barrier()
#define PG8_SCHED __builtin_amdgcn_sched_barrier(0)
    Unit cur, nxt; int ui = 0;
    if (!S.next(0, cur)) return;
    f32x4 acc[2][2][4][2];
#pragma unroll
    for (int a = 0; a < 2; ++a)
#pragma unroll
        for (int b = 0; b < 2; ++b)
#pragma unroll
            for (int m = 0; m < 4; ++m)
#pragma unroll
                for (int n = 0; n < 2; ++n) acc[a][b][m][n] = (f32x4){0.f, 0.f, 0.f, 0.f};
    bf16x8 At[4][2], B0[2][2], B1[2][2];
    const char* cA = (const char*)g.A + (size_t)cur.pm * tstep; const char* cB = (const char*)g.Bt + (size_t)cur.pn * tstep;
    S.a_ready(cur);
    PG8_STAGE(PG8_SB(0, 0), cB, voffB); PG8_STAGE(PG8_SA(0, 0), cA, voffA); PG8_STAGE(PG8_SB(0, 1), cB + hstep, voffB); PG8_STAGE(PG8_SA(0, 1), cA + hstep, voffA);
    if (wr == 1) PG8_BAR;
    PG8_WAIT_V(4); PG8_BAR;
    PG8_STAGE(PG8_SB(1, 0), cB + kstep, voffB); PG8_STAGE(PG8_SA(1, 0), cA + kstep, voffA); PG8_STAGE(PG8_SB(1, 1), cB + hstep + kstep, voffB);
    PG8_WAIT_V(6); PG8_BAR;
    PG8_STAMP();
    for (;;) {
        const bool has_next = S.next(ui + 1, nxt);
        const char* nA = has_next ? (const char*)g.A + (size_t)nxt.pm * tstep : cA; const char* nB = has_next ? (const char*)g.Bt + (size_t)nxt.pn * tstep : cB;
        for (int t = 0; t < nt; t += 2) {
            const bool last = (t == nt - 2);
            const char* a1 = cA + (size_t)(t + 1) * kstep;
            const char* a2 = last ? nA : cA + (size_t)(t + 2) * kstep; const char* b2 = last ? nB : cB + (size_t)(t + 2) * kstep;
            const char* a3 = a2 + kstep; const char* b3 = b2 + kstep;
            if (last && has_next) S.a_ready(nxt);
            PG8_LDB(B0, 0, 0); PG8_SCHED; PG8_LDA(At, 0, 0); PG8_STAGE(PG8_SA(1, 1), a1 + hstep, voffA);
            PG8_WAIT_L(8); PG8_BAR; PG8_WAIT_L(0); PG8_MMA(0, 0, At, B0); PG8_BAR; PG8_SCHED;
            PG8_LDB(B1, 0, 1); PG8_STAGE(PG8_SB(0, 0), b2, voffB);
            PG8_BAR; PG8_WAIT_L(0); PG8_MMA(0, 1, At, B1); PG8_BAR;
            PG8_LDA(At, 0, 1); PG8_STAGE(PG8_SA(0, 0), a2, voffA);
            PG8_BAR; PG8_WAIT_L(0); PG8_MMA(1, 0, At, B0); PG8_BAR; PG8_SCHED;
            PG8_STAGE(PG8_SB(0, 1), b2 + hstep, voffB);
            PG8_WAIT_V(6); PG8_BAR; PG8_MMA(1, 1, At, B1); PG8_BAR;
            PG8_LDB(B0, 1, 0); PG8_SCHED; PG8_LDA(At, 1, 0); PG8_STAGE(PG8_SA(0, 1), a2 + hstep, voffA);
            PG8_WAIT_L(8); PG8_BAR; PG8_WAIT_L(0); PG8_MMA(0, 0, At, B0); PG8_BAR; PG8_SCHED;
            PG8_LDB(B1, 1, 1); PG8_STAGE(PG8_SB(1, 0), b3, voffB);
            PG8_BAR; PG8_WAIT_L(0); PG8_MMA(0, 1, At, B1); PG8_BAR;
            PG8_LDA(At, 1, 1); PG8_STAGE(PG8_SA(1, 0), a3, voffA);
            PG8_BAR; PG8_WAIT_L(0); PG8_MMA(1, 0, At, B0); PG8_BAR; PG8_SCHED;
            PG8_STAGE(PG8_SB(1, 1), b3 + hstep, voffB);
            PG8_WAIT_V(6); PG8_BAR; PG8_MMA(1, 1, At, B1); PG8_BAR;
        }
        PG8_STAMP();
        if constexpr (!Epi::AFTER_DRAIN) { E(acc, cur, wr, wc, fr, fq); S.done(cur); }
        PG8_STAMP();
        if (!has_next) break;
#pragma unroll
        for (int a = 0; a < 2; ++a)
#pragma unroll
            for (int b = 0; b < 2; ++b)
#pragma unroll
                for (int m = 0; m < 4; ++m)
#pragma unroll
                    for (int n = 0; n < 2; ++n) acc[a][b][m][n] = (f32x4){0.f, 0.f, 0.f, 0.f};
        cur = nxt; cA = nA; cB = nB; ++ui;
    }
    PG8_WAIT_V(0);
    if (wr == 0) PG8_BAR;
    PG8_BAR;
    if constexpr (Epi::AFTER_DRAIN) { E.fused(acc, cur, wr, wc, fr, fq, lds, wid, lane); S.done(cur); }
    PG8_STAMP();
    if (STAMP && wid == 0) { stamps[lane] = lane < nts ? (((unsigned long long)(unsigned)ts_hi << 32) | (unsigned)ts_lo) : 0ull;
        if (lane == 62) stamps[62] = rt_entry; if (lane == 63) stamps[63] = (unsigned long long)wall_clock64(); }
#undef PG8_STAMP
#undef PG8_SA
#undef PG8_SB
#undef PG8_STAGE
#undef PG8_LDA
#undef PG8_LDB
#undef PG8_MMA
#undef PG8_WAIT_V
#undef PG8_WAIT_L
#undef PG8_BAR
#undef PG8_SCHED
}
}
#define XB_TMO      128
#define XB_XCNT(j)  (256  + 64 * (j))
#define XB_XSUB(j)  (1280 + 64 * (j))
#define XB_XGEN(j)  (2304 + 64 * (j))
#define XB_TOP      3328
#define XB_TOPGEN   3392
#define XCD_BAR_WORDS 3456
#define XB_SPIN_CAP (1u << 18)
#define LAS __attribute__((address_space(3)))

__device__ __forceinline__ unsigned xb_ld(unsigned* p)              { return __hip_atomic_load(p, __ATOMIC_RELAXED, __HIP_MEMORY_SCOPE_AGENT); }
__device__ __forceinline__ unsigned xb_add(unsigned* p, unsigned v) { return __hip_atomic_fetch_add(p, v, __ATOMIC_RELAXED, __HIP_MEMORY_SCOPE_AGENT); }
__device__ __forceinline__ unsigned xb_xcc_id() { return (unsigned)__builtin_amdgcn_s_getreg((3 << 11) | 20) & 0xFu; }
#define XB_SPIN(cond, bar) do { unsigned _sp = 0; while (cond) { __builtin_amdgcn_s_sleep(1); \
    if ((++_sp & 255u) == 0u) { if (xb_ld(&(bar)[XB_TMO])) break; if (_sp > XB_SPIN_CAP) { atomicAdd(&(bar)[XB_TMO], 1u); break; } } } } while (0)

struct XcdBarrier {
    unsigned* bar; unsigned x;
    volatile LAS unsigned* st;
};

__device__ __forceinline__ XcdBarrier xcd_barrier_post(unsigned* bar, volatile LAS unsigned* st) {
    XcdBarrier b; b.bar = bar; b.x = xb_xcc_id(); b.st = st;
    if (threadIdx.x == 0) (void)xb_add(&bar[XB_XCNT(b.x)], 1u);
    return b;
}
__device__ __forceinline__ void xcd_barrier_complete(unsigned* bar, unsigned x, unsigned& nloc, unsigned& nx) {
    const unsigned G = gridDim.x * gridDim.y * gridDim.z;
    unsigned sum, cnt, mine, sp = 0u;
    for (;;) {
        sum = 0u; cnt = 0u; mine = 0u;
#pragma unroll
        for (unsigned j = 0; j < 16; ++j) { const unsigned c = xb_ld(&bar[XB_XCNT(j)]); sum += c; cnt += (c > 0u) ? 1u : 0u; mine = (j == x) ? c : mine; }
        if (sum == G) break;
        __builtin_amdgcn_s_sleep(1);
        if ((++sp & 255u) == 0u) { if (xb_ld(&bar[XB_TMO])) break; if (sp > XB_SPIN_CAP) { atomicAdd(&bar[XB_TMO], 1u); break; } }
    }
    nloc = mine > 0u ? mine : 1u; nx = cnt > 0u ? cnt : 1u;
}

__device__ __forceinline__ void xcd_barrier(const XcdBarrier& b) {
    asm volatile("s_waitcnt vmcnt(0)" ::: "memory");
    __syncthreads();
    if (threadIdx.x == 0) {
        unsigned* bar = b.bar;
        __builtin_amdgcn_s_waitcnt(0);
        unsigned nloc = b.st[0], nx = b.st[1];
        if (nloc == 0u) { xcd_barrier_complete(bar, b.x, nloc, nx); b.st[0] = nloc; b.st[1] = nx; }
        const unsigned old = xb_add(&bar[XB_XSUB(b.x)], 1u);
        const unsigned gen = old / nloc;
        if (old + 1u == (gen + 1u) * nloc) {
            __builtin_amdgcn_fence(__ATOMIC_RELEASE, "agent");
            asm volatile("s_waitcnt vmcnt(0)" ::: "memory");
            const unsigned og = xb_add(&bar[XB_TOP], 1u);
            const unsigned tg = og / nx;
            if (og + 1u == (tg + 1u) * nx) xb_add(&bar[XB_TOPGEN], 1u);
            else XB_SPIN(xb_ld(&bar[XB_TOPGEN]) == tg, bar);
            __builtin_amdgcn_fence(__ATOMIC_ACQUIRE, "agent");
            xb_add(&bar[XB_XGEN(b.x)], 1u);
            asm volatile("s_waitcnt vmcnt(0)" ::: "memory");
        } else {
            XB_SPIN(xb_ld(&bar[XB_XGEN(b.x)]) == gen, bar);
            __builtin_amdgcn_fence(__ATOMIC_ACQUIRE, "agent");
            asm volatile("s_waitcnt vmcnt(0)" ::: "memory");
        }
    }
    __syncthreads();
}
typedef unsigned short bf16_t;
typedef short bf16x8 __attribute__((ext_vector_type(8)));
typedef float f32x4 __attribute__((ext_vector_type(4)));
typedef float f32x16 __attribute__((ext_vector_type(16)));
typedef unsigned u32x4 __attribute__((ext_vector_type(4)));
typedef unsigned u32x2 __attribute__((ext_vector_type(2)));
using pg8::cvt_pk_bf16;

constexpr int DM = 2048, TP = 16384, NSB = 32, TSQ = 32, NTOK = TP + NSB * TSQ, NSEQ = 33, PAST = 4096, NLAYER = 2;
constexpr int NU = 15104;
constexpr int U_AVAL = 0, U_AGATE = 512, U_ASG = 1024, U_Q = 1536, U_K = 2048, U_V = 2560, U_BSG = 3072, U_XC = 3584, U_CSG = 5248, U_DIN = 5760, U_DSG = 6272, U_G = 6784, U_F = 14976;
constexpr int IN_W = 14984, SHIFT_W = 1664;
constexpr float LOG2E = 1.4426950408889634f;
enum { I_XP = 0, I_XS, I_CK, I_CV, I_CLF, I_SCONV, I_SSHIFT, I_SWKV, I_SPOOL, I_CP, I_CS, I_NORMG, I_WADA, I_BADA, I_WIN, I_BF, I_CONVW, I_CONVB, I_CLNG, I_CLNB, I_MU, I_W0, I_W2, I_A0, I_A2,
       I_KK, I_KA, I_RK, I_GNG, I_GNB, I_POOLW, I_POOLB, I_POOLS, I_WBR, I_WOUT, I_FING, N_IN };
constexpr size_t O_YP = 0, O_YS = O_YP + (size_t)TP * DM, O_PK = O_YS + (size_t)1024 * DM, O_PV = O_PK + (size_t)2 * TP * 512, O_PLF = O_PV + (size_t)2 * TP * 512, O_PCONV = O_PLF + (size_t)2 * TP * 8,
                 O_PSHIFT = O_PCONV + 2 * 30 * 512, O_PWKV = O_PSHIFT + 2 * 1664, O_PPOOL = O_PWKV + 2 * 8 * 64 * 64, O_SK = O_PPOOL + 2 * 15 * 512, O_SV = O_SK + (size_t)2 * 1024 * 512,
                 O_SLF = O_SV + (size_t)2 * 1024 * 512, O_SCONV = O_SLF + 2 * 1024 * 8, O_SSHIFT = O_SCONV + (size_t)2 * 32 * 30 * 512, O_SWKV = O_SSHIFT + 2 * 32 * 1664,
                 O_SPOOL = O_SWKV + (size_t)2 * 32 * 8 * 64 * 64, O_END = O_SPOOL + (size_t)2 * 32 * 15 * 512;
static_assert(O_END == 75374848, "output size");
constexpr size_t al256(size_t x) { return (x + 255) & ~(size_t)255; }
constexpr int NCU_CH = 288, NRU = NCU_CH * 8;
constexpr size_t WS_CTL = 0, CTL_BYTES = 512 * 1024;
constexpr size_t WS_WIN = CTL_BYTES;
constexpr size_t WS_WBR = al256(WS_WIN + (size_t)2 * NU * 2048 * 2);
constexpr size_t WS_WOUT = al256(WS_WBR + (size_t)2 * 4 * 2048 * 512 * 2);
constexpr size_t WS_POOLW = al256(WS_WOUT + (size_t)2 * 2048 * 2048 * 2);
constexpr size_t WS_ADA = al256(WS_POOLW + (size_t)2 * 4 * 128 * 128 * 2);
constexpr size_t WS_H = al256(WS_ADA + (size_t)2 * 33 * 6144 * 4);
constexpr size_t WS_U = al256(WS_H + (size_t)NTOK * 2048 * 2);
constexpr size_t WS_XBUF = al256(WS_U + (size_t)NTOK * NU * 2);
constexpr size_t WS_OCAT = al256(WS_XBUF + (size_t)NTOK * 2048 * 4);
constexpr size_t WS_Z = al256(WS_OCAT + (size_t)4 * NTOK * 512 * 2);
constexpr size_t WS_MERGED = al256(WS_Z + (size_t)4 * NTOK * 2048 * 2);
constexpr size_t WS_FP = al256(WS_MERGED + (size_t)NTOK * 2048 * 2);
constexpr int GS_LEN = PAST + TSQ;
constexpr size_t WS_GS = al256(WS_FP + (size_t)8 * TP * 4);
constexpr size_t WS_VT = al256(WS_GS + (size_t)32 * 8 * GS_LEN * 4);
constexpr size_t WS_TQ = al256(WS_VT + (size_t)8 * 64 * TP * 2);
constexpr size_t WS_GM = al256(WS_TQ + (size_t)NRU * 4096 * 4);
constexpr size_t WS_ET = al256(WS_GM + (size_t)NRU * 4096 * 4);
constexpr size_t WS_Y0T = al256(WS_ET + (size_t)NRU * 4096 * 4);
constexpr size_t WS_SC = al256(WS_Y0T + (size_t)NRU * 4096 * 4);
constexpr size_t WS_BONUS = al256(WS_SC + (size_t)NRU * 4096 * 4);
constexpr size_t WS_GG = al256(WS_BONUS + (size_t)NRU * 64 * 4);
constexpr size_t WS_TG = al256(WS_GG + (size_t)16 * 8 * 4096 * 4);
constexpr size_t WS_SG = al256(WS_TG + (size_t)16 * 8 * 4096 * 4);
constexpr size_t WS_XPART = al256(WS_SG + (size_t)16 * 8 * 4096 * 4);
constexpr size_t WS_END = al256(WS_XPART + (size_t)2 * 8 * 1024 * 2048 * 4);
static_assert(WS_END < (size_t)2100 * 1024 * 1024, "workspace map exceeds the guaranteed d_ws size");
constexpr int CW_BAR = 0;
constexpr int CW_QUEUE = 16 * 3456 + 64;
constexpr int CW_KMAX = CW_QUEUE + 64 * 8;
static_assert((CW_KMAX + 64) * 4 <= (int)CTL_BYTES, "ctl");
constexpr int LDS_BYTES = 163840 - 256;
constexpr int LDS_XB_OFF = LDS_BYTES - 16;
constexpr int SLOT_F = 64 * 65;

#ifndef PROBE_ID
#define PROBE_ID 0
#endif
#ifndef PROBE_K
#define PROBE_K 1
#endif
constexpr int LDS_PROBE_OFF = 163840 - 256 - 64;
#if PROBE_ID
#define PT0() unsigned long long _pt0 = (blockIdx.x == 0 && threadIdx.x == 0) ? __builtin_amdgcn_s_memrealtime() : 0ull
#define PT1(id) do { if ((id) == PROBE_ID && blockIdx.x == 0 && threadIdx.x == 0) { *(LAS unsigned long long*)(lds + LDS_PROBE_OFF) += __builtin_amdgcn_s_memrealtime() - _pt0; } _pt0 = (blockIdx.x == 0 && threadIdx.x == 0) ? __builtin_amdgcn_s_memrealtime() : 0ull; } while (0)
#else
#define PT0() do {} while (0)
#define PT1(id) do {} while (0)
#endif
struct Params { const float* in[N_IN]; float* out; unsigned char* ws; int ph_lo, ph_hi, li, pad; };
typedef const __attribute__((address_space(4))) Params* KP;
__device__ __forceinline__ KP kp_fresh(KP k) { asm volatile("" : "+s"(k)); return k; }

__device__ __forceinline__ float bf2f(unsigned short b) { return __uint_as_float(((unsigned)b) << 16); }
__device__ __forceinline__ float bflo(unsigned w) { return __uint_as_float(w << 16); }
__device__ __forceinline__ float bfhi(unsigned w) { return __uint_as_float(w & 0xffff0000u); }
__device__ __forceinline__ unsigned short f2bf(float f) { return (unsigned short)(cvt_pk_bf16(f, 0.f) & 0xffffu); }
__device__ __forceinline__ float sigmoidf_(float x) { return 1.f / (1.f + __expf(-x)); }
__device__ __forceinline__ float siluf_(float x) { return x / (1.f + __expf(-x)); }
__device__ __forceinline__ float log_sigmoidf_(float z) { return fminf(z, 0.f) - log1pf(expf(-fabsf(z))); }
template <int CTRL> __device__ __forceinline__ float dpp_mov(float v) { return __int_as_float(__builtin_amdgcn_update_dpp(0, __float_as_int(v), CTRL, 0xF, 0xF, true)); }
__device__ __forceinline__ float wave_sum(float v) {
    v += dpp_mov<0xB1>(v); v += dpp_mov<0x4E>(v); v += dpp_mov<0x141>(v); v += dpp_mov<0x140>(v);
    const float r0 = __int_as_float(__builtin_amdgcn_readlane(__float_as_int(v), 0)), r1 = __int_as_float(__builtin_amdgcn_readlane(__float_as_int(v), 16));
    const float r2 = __int_as_float(__builtin_amdgcn_readlane(__float_as_int(v), 32)), r3 = __int_as_float(__builtin_amdgcn_readlane(__float_as_int(v), 48));
    return (r0 + r1) + (r2 + r3);
}
__device__ __forceinline__ float wave_max(float v) {
    v = fmaxf(v, dpp_mov<0xB1>(v)); v = fmaxf(v, dpp_mov<0x4E>(v)); v = fmaxf(v, dpp_mov<0x141>(v)); v = fmaxf(v, dpp_mov<0x140>(v));
    const float r0 = __int_as_float(__builtin_amdgcn_readlane(__float_as_int(v), 0)), r1 = __int_as_float(__builtin_amdgcn_readlane(__float_as_int(v), 16));
    const float r2 = __int_as_float(__builtin_amdgcn_readlane(__float_as_int(v), 32)), r3 = __int_as_float(__builtin_amdgcn_readlane(__float_as_int(v), 48));
    return fmaxf(fmaxf(r0, r1), fmaxf(r2, r3));
}
__device__ __forceinline__ float wave_min(float v) { return -wave_max(-v); }
__device__ __forceinline__ float xhalf_max(float m) { const auto rr = __builtin_amdgcn_permlane32_swap(__float_as_uint(m), __float_as_uint(m), false, false); return fmaxf(__uint_as_float(rr[0]), __uint_as_float(rr[1])); }
__device__ __forceinline__ float xhalf_sum(float m) { const auto rr = __builtin_amdgcn_permlane32_swap(__float_as_uint(m), __float_as_uint(m), false, false); return __uint_as_float(rr[0]) + __uint_as_float(rr[1]); }
__device__ __forceinline__ bf16x8 pack8f(const f32x4 a, const f32x4 b) { u32x4 w; w.x = cvt_pk_bf16(a[0], a[1]); w.y = cvt_pk_bf16(a[2], a[3]); w.z = cvt_pk_bf16(b[0], b[1]); w.w = cvt_pk_bf16(b[2], b[3]); return __builtin_bit_cast(bf16x8, w); }
__device__ __forceinline__ float fast_tanh(float x) { const float e = __expf(-2.f * fabsf(x)); const float t = (1.f - e) * __builtin_amdgcn_rcpf(1.f + e); return x < 0.f ? -t : t; }
__device__ __forceinline__ void tr_tile(const float* __restrict__ src, size_t ld, int k0, int c0, int nvalid, bf16_t* __restrict__ dst, int K, LAS float* scr, int lane) {
    float tv[64];
#pragma unroll
    for (int kk = 0; kk < 64; ++kk) tv[kk] = src[(size_t)(k0 + kk) * ld + c0 + (lane < nvalid ? lane : 0)];
#pragma unroll
    for (int kk = 0; kk < 64; ++kk) scr[kk * 65 + lane] = (lane < nvalid) ? tv[kk] : 0.f;
    const int nl = lane >> 3, kc8 = (lane & 7) * 8;
#pragma unroll
    for (int it = 0; it < 8; ++it) { const int nn = 8 * it + nl; const LAS float* s = scr + kc8 * 65 + nn;
        u32x4 w; w.x = cvt_pk_bf16(s[0], s[65]); w.y = cvt_pk_bf16(s[130], s[195]); w.z = cvt_pk_bf16(s[260], s[325]); w.w = cvt_pk_bf16(s[390], s[455]);
        *(u32x4*)(dst + (size_t)nn * K + k0 + kc8) = w; }
}
__device__ __forceinline__ void p0_weights(KP p, LAS unsigned char* lds, int gw, int ngw, int wave, int lane) {
    LAS float* scr = (LAS float*)lds + wave * SLOT_F;
    constexpr int T_WIN = (NU / 64) * 32, T_WBR = 4 * 32 * 8, T_WOUT = 32 * 32, T_POOL = 4 * 2 * 2, T_L = T_WIN + T_WBR + T_WOUT + T_POOL;
    for (int it = gw; it < 2 * T_L; it += ngw) {
        const int l = it / T_L; int r = it % T_L;
        if (r < T_WIN) {
            const int nt = r / 32, kt = r % 32, m0 = nt * 64;
            int c0, nvalid = 64;
            if (m0 < 3072) c0 = m0; else if (m0 < U_F) c0 = m0 + 8; else if (m0 == U_F) { c0 = 3072; nvalid = 8; } else { c0 = 0; nvalid = 0; }
            tr_tile(p->in[I_WIN] + (size_t)l * 2048 * IN_W, IN_W, kt * 64, c0, nvalid, (bf16_t*)(p->ws + WS_WIN) + ((size_t)l * NU + m0) * 2048, 2048, scr, lane);
            continue; }
        r -= T_WIN;
        if (r < T_WBR) {
            const int n = r / 256, q = r % 256, nt = q / 8, kt = q % 8;
            tr_tile(p->in[I_WBR] + ((size_t)(l * 4 + n) * 512) * 2048, 2048, kt * 64, nt * 64, 64, (bf16_t*)(p->ws + WS_WBR) + ((size_t)(l * 4 + n) * 2048 + nt * 64) * 512, 512, scr, lane);
            continue; }
        r -= T_WBR;
        if (r < T_WOUT) {
            const int nt = r / 32, kt = r % 32;
            tr_tile(p->in[I_WOUT] + (size_t)l * 2048 * 2048, 2048, kt * 64, nt * 64, 64, (bf16_t*)(p->ws + WS_WOUT) + ((size_t)l * 2048 + nt * 64) * 2048, 2048, scr, lane);
            continue; }
        r -= T_WOUT;
        {
            const int g = r / 4, q = r % 4, nt = q / 2, kt = q % 2;
            tr_tile(p->in[I_POOLW] + (size_t)(l * 4 + g) * 128 * 128, 128, kt * 64, nt * 64, 64, (bf16_t*)(p->ws + WS_POOLW) + ((size_t)(l * 4 + g) * 128 + nt * 64) * 128, 128, scr, lane);
        }
    }
}
__device__ __forceinline__ void ada_unit(KP p, int unit, LAS unsigned char* lds, int tid) {
    const int wave = tid >> 6, lane = tid & 63, l = unit / 96, n0 = (unit % 96) * 64;
    LAS float* cs = (LAS float*)lds + wave * (33 * 64);
    LAS float* red = (LAS float*)lds + 8 * 33 * 64;
    const float* W = p->in[I_WADA] + (size_t)l * 2048 * 6144;
    const float* cp = p->in[I_CP]; const float* csm = p->in[I_CS];
    float acc[33];
#pragma unroll
    for (int s = 0; s < 33; ++s) acc[s] = 0.f;
    float wv[16];
#pragma unroll
    for (int j = 0; j < 16; ++j) wv[j] = W[(size_t)(wave * 256 + j) * 6144 + n0 + lane];
#pragma unroll 1
    for (int step = 0; step < 16; ++step) {
        const int k0 = wave * 256 + step * 16, kn = wave * 256 + (step < 15 ? step + 1 : step) * 16;
        float wn[16];
#pragma unroll
        for (int j = 0; j < 16; ++j) wn[j] = W[(size_t)(kn + j) * 6144 + n0 + lane];
        if ((step & 3) == 0) {
#pragma unroll
            for (int s = 0; s < 33; ++s) { const float c = (s == 0) ? cp[k0 + lane] : csm[(size_t)(s - 1) * 2048 + k0 + lane]; cs[s * 64 + lane] = siluf_(c); } }
        const int kk0 = (step & 3) * 16;
#pragma unroll
        for (int q4 = 0; q4 < 4; ++q4) {
#pragma unroll
            for (int s = 0; s < 33; ++s) { const f32x4 c4 = *(const LAS f32x4*)(cs + s * 64 + kk0 + 4 * q4); acc[s] += c4.x * wv[4 * q4] + c4.y * wv[4 * q4 + 1] + c4.z * wv[4 * q4 + 2] + c4.w * wv[4 * q4 + 3]; } }
#pragma unroll
        for (int j = 0; j < 16; ++j) wv[j] = wn[j];
    }
#pragma unroll
    for (int s = 0; s < 33; ++s) red[(wave * 33 + s) * 64 + lane] = acc[s];
    __syncthreads();
    for (int idx = tid; idx < 33 * 64; idx += 512) { const int s = idx >> 6, n = idx & 63; float v = p->in[I_BADA][l * 6144 + n0 + n];
#pragma unroll
        for (int w = 0; w < 8; ++w) v += red[(w * 33 + s) * 64 + n];
        ((float*)(p->ws + WS_ADA))[((size_t)l * 33 + s) * 6144 + n0 + n] = v; }
    __syncthreads();
}
__device__ __forceinline__ void load_x8(KP p, int l, int row, int lane, f32x4 (&v)[8]) {
    if (row < TP) { const f32x4* x4 = (const f32x4*)(l == 0 ? p->in[I_XP] + (size_t)row * DM : (const float*)(p->ws + WS_XBUF) + (size_t)row * DM) + lane;
#pragma unroll
        for (int j = 0; j < 8; ++j) v[j] = x4[64 * j]; }
    else { const int r = row - TP; const f32x4* x4 = (const f32x4*)(p->in[I_XS] + (size_t)r * DM) + lane;
#pragma unroll
        for (int j = 0; j < 8; ++j) v[j] = x4[64 * j];
        for (int s = 0; s < 8 * l; ++s) { const f32x4* q4 = (const f32x4*)((const float*)(p->ws + WS_XPART) + ((size_t)s * 1024 + r) * DM) + lane;
#pragma unroll
            for (int j = 0; j < 8; ++j) v[j] += q4[64 * j]; } }
}
__device__ __forceinline__ void p1_rows(KP p, int l, int gw, int ngw, int lane) {
    const f32x4* g4 = (const f32x4*)(p->in[I_NORMG] + l * DM) + lane;
    f32x4 a[8], sh[8]; int cur_seq = -1;
    for (int row = gw; row < NTOK; row += ngw) {
        const int seq = row < TP ? 0 : 1 + ((row - TP) >> 5);
        f32x4 v[8]; float ss = 0.f; load_x8(p, l, row, lane, v);
#pragma unroll
        for (int j = 0; j < 8; ++j) { ss += (v[j].x * v[j].x + v[j].y * v[j].y) + (v[j].z * v[j].z + v[j].w * v[j].w); }
        if (seq != cur_seq) { cur_seq = seq;
            const f32x4* sh4 = (const f32x4*)((const float*)(p->ws + WS_ADA) + ((size_t)l * 33 + seq) * 6144) + lane; const f32x4* sc4 = sh4 + 512;
#pragma unroll
            for (int j = 0; j < 8; ++j) { a[j] = g4[64 * j] * (sc4[64 * j] + 1.f); sh[j] = sh4[64 * j]; } }
        const float rstd = 1.f / sqrtf(wave_sum(ss) * (1.f / DM) + 1e-6f);
        u32x2* o = (u32x2*)((bf16_t*)(p->ws + WS_H) + (size_t)row * DM) + lane;
#pragma unroll
        for (int j = 0; j < 8; ++j) { const f32x4 y = v[j] * rstd * a[j] + sh[j];
            u32x2 w; w.x = cvt_pk_bf16(y.x, y.y); w.y = cvt_pk_bf16(y.z, y.w); o[64 * j] = w; }
    }
}
__device__ __forceinline__ void p_final_rows(KP p, int gw, int ngw, int lane) {
    const f32x4* g4 = (const f32x4*)p->in[I_FING] + lane;
    for (int row = gw; row < NTOK; row += ngw) {
        f32x4 v[8]; float ss = 0.f; load_x8(p, 2, row, lane, v);
#pragma unroll
        for (int j = 0; j < 8; ++j) { ss += (v[j].x * v[j].x + v[j].y * v[j].y) + (v[j].z * v[j].z + v[j].w * v[j].w); }
        const float rstd = 1.f / sqrtf(wave_sum(ss) * (1.f / DM) + 1e-6f);
        f32x4* o = (f32x4*)(p->out + O_YP + (size_t)row * DM) + lane;
#pragma unroll
        for (int j = 0; j < 8; ++j) o[64 * j] = v[j] * rstd * g4[64 * j];
    }
}
struct EpiU {
    static constexpr bool PERM = true, AFTER_DRAIN = false;
    bf16_t* U; float* out; const float* bf; int l;
    __device__ __forceinline__ void operator()(const f32x4 (&acc)[2][2][4][2], const pg8::Unit& u, int wr, int wc, int fr, int fq) const {
        const int row0 = u.pm * 256 + wr * 64 + fr, col0 = u.pn * 256 + wc * 32 + 8 * fq;
#pragma unroll
        for (int ai = 0; ai < 2; ++ai)
#pragma unroll
            for (int m = 0; m < 4; ++m) { bf16_t* rowp = U + (size_t)(row0 + ai * 128 + m * 16) * NU + col0;
#pragma unroll
                for (int bj = 0; bj < 2; ++bj) { const f32x4 v0 = acc[ai][bj][m][0], v1 = acc[ai][bj][m][1];
                    u32x4 w; w.x = cvt_pk_bf16(v0[0], v0[1]); w.y = cvt_pk_bf16(v0[2], v0[3]); w.z = cvt_pk_bf16(v1[0], v1[1]); w.w = cvt_pk_bf16(v1[2], v1[3]);
                    *(u32x4*)(rowp + bj * 128) = w; } }
        if (u.pn >= 8 && u.pn < 12) {
            const bool isv = u.pn >= 10; const int cin = (u.pn - (isv ? 10 : 8)) * 256 + wc * 32 + 8 * fq;
#pragma unroll
            for (int ai = 0; ai < 2; ++ai)
#pragma unroll
                for (int m = 0; m < 4; ++m) { const int row = row0 + ai * 128 + m * 16;
                    float* dst = row < TP ? out + (isv ? O_PV : O_PK) + ((size_t)l * TP + row) * 512 : out + (isv ? O_SV : O_SK) + ((size_t)l * 1024 + (row - TP)) * 512;
#pragma unroll
                    for (int bj = 0; bj < 2; ++bj) { *(f32x4*)(dst + cin + bj * 128) = acc[ai][bj][m][0]; *(f32x4*)(dst + cin + bj * 128 + 4) = acc[ai][bj][m][1]; } }
        }
        if (u.pn == 58 && wc == 0 && fq == 0) {
            const f32x4 b0 = *(const f32x4*)(bf + l * 8), b1 = *(const f32x4*)(bf + l * 8 + 4);
#pragma unroll
            for (int ai = 0; ai < 2; ++ai)
#pragma unroll
                for (int m = 0; m < 4; ++m) { const int row = row0 + ai * 128 + m * 16;
                    float* dst = row < TP ? out + O_PLF + ((size_t)l * TP + row) * 8 : out + O_SLF + ((size_t)l * 1024 + (row - TP)) * 8;
                    const f32x4 z0 = acc[ai][1][m][0] + b0, z1 = acc[ai][1][m][1] + b1; f32x4 o0, o1;
#pragma unroll
                    for (int e = 0; e < 4; ++e) { o0[e] = log_sigmoidf_(z0[e]); o1[e] = log_sigmoidf_(z1[e]); }
                    *(f32x4*)dst = o0; *(f32x4*)(dst + 4) = o1; }
        }
    }
};
struct BranchOrder {
    int G, c;
    __device__ __forceinline__ bool next(int i, pg8::Unit& u) const { const int L = i * G + c; if (L >= 4 * 544) return false; const int n = L / 544, t = L - n * 544; u.pm = n * 68 + (t >> 3); u.pn = n * 8 + (t & 7); return true; }
    __device__ __forceinline__ void a_ready(const pg8::Unit&) const {}
    __device__ __forceinline__ void done(const pg8::Unit&) const {}
};
struct EpiZ {
    static constexpr bool PERM = true, AFTER_DRAIN = false;
    bf16_t* Z; const bf16_t* U;
    __device__ __forceinline__ void operator()(const f32x4 (&acc)[2][2][4][2], const pg8::Unit& u, int wr, int wc, int fr, int fq) const {
        const int row0 = u.pm * 256 + wr * 64 + fr, col0 = (u.pn & 7) * 256 + wc * 32 + 8 * fq;
#pragma unroll
        for (int ai = 0; ai < 2; ++ai)
#pragma unroll
            for (int m = 0; m < 4; ++m) { bf16_t* rowp = Z + (size_t)(row0 + ai * 128 + m * 16) * DM + col0;
#pragma unroll
                for (int bj = 0; bj < 2; ++bj) { const f32x4 v0 = acc[ai][bj][m][0], v1 = acc[ai][bj][m][1];
                    u32x4 w; w.x = cvt_pk_bf16(v0[0], v0[1]); w.y = cvt_pk_bf16(v0[2], v0[3]); w.z = cvt_pk_bf16(v1[0], v1[1]); w.w = cvt_pk_bf16(v1[2], v1[3]);
                    *(u32x4*)(rowp + bj * 128) = w; } }
    }
};
__device__ __forceinline__ void merge_pass(KP p, int l, int gtid, int ngt) {
    const bf16_t* U = (const bf16_t*)(p->ws + WS_U); const bf16_t* Z = (const bf16_t*)(p->ws + WS_Z); bf16_t* M = (bf16_t*)(p->ws + WS_MERGED);
    for (int it0 = gtid; it0 < NTOK * 256; it0 += 3 * ngt) {
        u32x4 gv[3][4], zv[3][4];
#pragma unroll
        for (int k = 0; k < 3; ++k) { const int it = it0 + k * ngt < NTOK * 256 ? it0 + k * ngt : it0; const int row = it >> 8, col = (it & 255) * 8;
#pragma unroll
            for (int n = 0; n < 4; ++n) { gv[k][n] = *(const u32x4*)(U + (size_t)row * NU + U_G + n * 2048 + col); zv[k][n] = *(const u32x4*)(Z + ((size_t)n * NTOK + row) * DM + col); } }
#pragma unroll
        for (int k = 0; k < 3; ++k) { const int it = it0 + k * ngt; if (it < NTOK * 256) { const int row = it >> 8, col = (it & 255) * 8;
            float s[8];
#pragma unroll
            for (int e = 0; e < 8; ++e) s[e] = 0.f;
#pragma unroll
            for (int n = 0; n < 4; ++n) { const u32x4 g = gv[k][n], z = zv[k][n];
                s[0] += sigmoidf_(bflo(g.x)) * bflo(z.x); s[1] += sigmoidf_(bfhi(g.x)) * bfhi(z.x); s[2] += sigmoidf_(bflo(g.y)) * bflo(z.y); s[3] += sigmoidf_(bfhi(g.y)) * bfhi(z.y);
                s[4] += sigmoidf_(bflo(g.z)) * bflo(z.z); s[5] += sigmoidf_(bfhi(g.z)) * bfhi(z.z); s[6] += sigmoidf_(bflo(g.w)) * bflo(z.w); s[7] += sigmoidf_(bfhi(g.w)) * bfhi(z.w); }
            u32x4 w; w.x = cvt_pk_bf16(s[0], s[1]); w.y = cvt_pk_bf16(s[2], s[3]); w.z = cvt_pk_bf16(s[4], s[5]); w.w = cvt_pk_bf16(s[6], s[7]);
            *(u32x4*)(M + (size_t)row * DM + col) = w; } }
    }
}
struct EpiOut {
    static constexpr bool PERM = false, AFTER_DRAIN = false;
    const float* xp; const float* xs; const float* xb; const float* ada; float* xout; int l;
    __device__ __forceinline__ void operator()(const f32x4 (&acc)[2][2][4][2], const pg8::Unit& u, int wr, int wc, int fr, int fq) const {
        const int row0 = u.pm * 256 + wr * 64 + fr, col0 = u.pn * 256 + wc * 32 + 4 * fq;
        f32x4 gt[2][2];
#pragma unroll
        for (int ai = 0; ai < 2; ++ai)
#pragma unroll
            for (int mp = 0; mp < 4; mp += 2) {
                f32x4 bs[2][2][2], gv[2][2][2];
#pragma unroll
                for (int mm = 0; mm < 2; ++mm) { const int row = row0 + ai * 128 + (mp + mm) * 16;
                    const float* base = l == 0 ? (row < TP ? xp + (size_t)row * DM : xs + (size_t)(row - TP) * DM) : xb + (size_t)row * DM;
                    const float* gate = ada + ((size_t)l * 33 + (row < TP ? 0 : 1 + ((row - TP) >> 5))) * 6144 + 4096;
#pragma unroll
                    for (int bj = 0; bj < 2; ++bj)
#pragma unroll
                        for (int n = 0; n < 2; ++n) { const int col = col0 + bj * 128 + n * 16; bs[mm][bj][n] = *(const f32x4*)(base + col); gv[mm][bj][n] = *(const f32x4*)(gate + col); } }
#pragma unroll
                for (int mm = 0; mm < 2; ++mm) { const int row = row0 + ai * 128 + (mp + mm) * 16;
#pragma unroll
                    for (int bj = 0; bj < 2; ++bj)
#pragma unroll
                        for (int n = 0; n < 2; ++n) { const int col = col0 + bj * 128 + n * 16; *(f32x4*)(xout + (size_t)row * DM + col) = bs[mm][bj][n] + gv[mm][bj][n] * acc[ai][bj][mp + mm][n]; } }
            }
        (void)gt;
    }
};
struct OneUnit {
    int pm, pn; bool valid;
    __device__ __forceinline__ bool next(int i, pg8::Unit& u) const { if (i > 0 || !valid) return false; u.pm = pm; u.pn = pn; return true; }
    __device__ __forceinline__ void a_ready(const pg8::Unit&) const {}
    __device__ __forceinline__ void done(const pg8::Unit&) const {}
};
struct EpiOutPart {
    static constexpr bool PERM = false, AFTER_DRAIN = false;
    const float* ada; float* part; int l;
    __device__ __forceinline__ void operator()(const f32x4 (&acc)[2][2][4][2], const pg8::Unit& u, int wr, int wc, int fr, int fq) const {
        const int row0 = u.pm * 256 + wr * 64 + fr - TP, col0 = u.pn * 256 + wc * 32 + 4 * fq;
#pragma unroll
        for (int ai = 0; ai < 2; ++ai)
#pragma unroll
            for (int m = 0; m < 4; ++m) { const int r = row0 + ai * 128 + m * 16;
                const float* gate = ada + ((size_t)l * 33 + 1 + (r >> 5)) * 6144 + 4096;
#pragma unroll
                for (int bj = 0; bj < 2; ++bj)
#pragma unroll
                    for (int n = 0; n < 2; ++n) { const int col = col0 + bj * 128 + n * 16; *(f32x4*)(part + (size_t)r * DM + col) = *(const f32x4*)(gate + col) * acc[ai][bj][m][n]; } }
    }
};
constexpr int CGS = 516;
__device__ __forceinline__ void conv_unit(KP p, int l, int tile, LAS unsigned char* lds, int tid) {
    const bf16_t* U = (const bf16_t*)(p->ws + WS_U);
    const int c = tid, wave = tid >> 6, lane = tid & 63;
    const bool samp = tile >= 512; const int b = tile - 512, row0 = samp ? TP + b * 32 : tile * 32;
    const bool last = samp || tile == 511;
    LAS float* gl = (LAS float*)lds;
    LAS bf16_t* sgl = (LAS bf16_t*)(lds + 62 * CGS * 4);
    LAS float* red = (LAS float*)(lds + 62 * CGS * 4 + 32 * 512 * 2);
    LAS float* st = red + 8 * 32;
#pragma unroll
    for (int k = 0; k < 8; ++k) { const int task = tid + 512 * k; if (task < 62 * 64) { const int i = task >> 6, ch = task & 63; f32x4 o0, o1;
        const int rel = i - 30;
        if (rel < 0 && samp) { const float* hp = p->in[I_SCONV] + (((size_t)l * 32 + b) * 30 + i) * 512 + 8 * ch; o0 = *(const f32x4*)hp; o1 = *(const f32x4*)(hp + 4); }
        else if (row0 + rel < 0) { o0 = (f32x4){0.f, 0.f, 0.f, 0.f}; o1 = o0; }
        else { const bf16_t* up = U + (size_t)(row0 + rel) * NU + 8 * ch; const u32x4 v = *(const u32x4*)(up + U_AVAL), g = *(const u32x4*)(up + U_AGATE);
            o0 = (f32x4){bflo(v.x) * sigmoidf_(bflo(g.x)), bfhi(v.x) * sigmoidf_(bfhi(g.x)), bflo(v.y) * sigmoidf_(bflo(g.y)), bfhi(v.y) * sigmoidf_(bfhi(g.y))};
            o1 = (f32x4){bflo(v.z) * sigmoidf_(bflo(g.z)), bfhi(v.z) * sigmoidf_(bfhi(g.z)), bflo(v.w) * sigmoidf_(bflo(g.w)), bfhi(v.w) * sigmoidf_(bfhi(g.w))}; }
        *(LAS f32x4*)(gl + i * CGS + 8 * ch) = o0; *(LAS f32x4*)(gl + i * CGS + 8 * ch + 4) = o1; } }
#pragma unroll
    for (int k = 0; k < 4; ++k) { const int task = tid + 512 * k, t = task >> 6, ch = task & 63; const u32x4 s = *(const u32x4*)(U + (size_t)(row0 + t) * NU + U_ASG + 8 * ch);
        u32x4 w; w.x = cvt_pk_bf16(siluf_(bflo(s.x)), siluf_(bfhi(s.x))); w.y = cvt_pk_bf16(siluf_(bflo(s.y)), siluf_(bfhi(s.y))); w.z = cvt_pk_bf16(siluf_(bflo(s.z)), siluf_(bfhi(s.z))); w.w = cvt_pk_bf16(siluf_(bflo(s.w)), siluf_(bfhi(s.w)));
        *(LAS u32x4*)(sgl + t * 512 + 8 * ch) = w; }
    const float cb = p->in[I_CONVB][l * 512 + c], lg = p->in[I_CLNG][l * 512 + c], lb = p->in[I_CLNB][l * 512 + c];
    float wk[31];
#pragma unroll
    for (int k = 0; k < 31; ++k) wk[k] = p->in[I_CONVW][((size_t)l * 31 + k) * 512 + c];
    __syncthreads();
    if (last) {
        float* dst = samp ? p->out + O_SCONV + (((size_t)l * 32 + b) * 30) * 512 + c : p->out + O_PCONV + ((size_t)l * 30) * 512 + c;
#pragma unroll
        for (int t = 2; t < 32; ++t) dst[(size_t)(t - 2) * 512] = gl[(30 + t) * CGS + c];
    }
    bf16_t* oa = (bf16_t*)(p->ws + WS_OCAT);
#pragma unroll 1
    for (int half = 0; half < 2; ++half) {
        float z[46];
#pragma unroll
        for (int i = 0; i < 46; ++i) z[i] = gl[(16 * half + i) * CGS + c];
        float hv[16];
#pragma unroll
        for (int tt = 0; tt < 16; ++tt) hv[tt] = cb;
#pragma unroll
        for (int k = 0; k < 31; ++k) {
#pragma unroll
            for (int tt = 0; tt < 16; ++tt) hv[tt] += z[tt + k] * wk[k]; }
#pragma unroll
        for (int tt = 0; tt < 16; ++tt) { const float s1 = wave_sum(hv[tt]), s2 = wave_sum(hv[tt] * hv[tt]); if (lane == 0) { red[(wave * 16 + tt) * 2] = s1; red[(wave * 16 + tt) * 2 + 1] = s2; } }
        __syncthreads();
        if (tid < 16) { float s1 = 0.f, s2 = 0.f;
#pragma unroll
            for (int w = 0; w < 8; ++w) { s1 += red[(w * 16 + tid) * 2]; s2 += red[(w * 16 + tid) * 2 + 1]; }
            const float mean = s1 * (1.f / 512.f), var = fmaxf(s2 * (1.f / 512.f) - mean * mean, 0.f);
            st[tid * 2] = mean; st[tid * 2 + 1] = 1.f / sqrtf(var + 1e-5f); }
        __syncthreads();
#pragma unroll
        for (int tt = 0; tt < 16; ++tt) { const float y = (hv[tt] - st[tt * 2]) * st[tt * 2 + 1] * lg + lb; const int t = 16 * half + tt;
            oa[(size_t)(row0 + t) * 512 + c] = f2bf(siluf_(y) * bf2f(sgl[t * 512 + c])); }
    }
    __syncthreads();
}
__device__ __forceinline__ void pool_unit(KP p, int l, int tile, LAS unsigned char* lds, int tid) {
    const bf16_t* U = (const bf16_t*)(p->ws + WS_U);
    const int c = tid, wave = tid >> 6, lane = tid & 63;
    const bool samp = tile >= 512; const int b = tile - 512, row0 = samp ? TP + b * 32 : tile * 32;
    constexpr int PST = 520;
    LAS float* zl = (LAS float*)lds;
    LAS bf16_t* pl = (LAS bf16_t*)(lds + 47 * CGS * 4);
#pragma unroll
    for (int k = 0; k < 6; ++k) { const int task = tid + 512 * k; if (task < 47 * 64) { const int i = task >> 6, ch = task & 63; f32x4 o0, o1; const int rel = i - 15;
        if (rel < 0 && samp) { const float* hp = p->in[I_SPOOL] + (((size_t)l * 32 + b) * 15 + i) * 512 + 8 * ch; o0 = *(const f32x4*)hp; o1 = *(const f32x4*)(hp + 4); }
        else if (row0 + rel < 0) { o0 = (f32x4){0.f, 0.f, 0.f, 0.f}; o1 = o0; }
        else { const u32x4 v = *(const u32x4*)(U + (size_t)(row0 + rel) * NU + U_DIN + 8 * ch); o0 = (f32x4){bflo(v.x), bfhi(v.x), bflo(v.y), bfhi(v.y)}; o1 = (f32x4){bflo(v.z), bfhi(v.z), bflo(v.w), bfhi(v.w)}; }
        *(LAS f32x4*)(zl + i * CGS + 8 * ch) = o0; *(LAS f32x4*)(zl + i * CGS + 8 * ch + 4) = o1; } }
    u32x4 sgv[4];
#pragma unroll
    for (int k = 0; k < 4; ++k) { const int task = tid + 512 * k; sgv[k] = *(const u32x4*)(U + (size_t)(row0 + (task >> 6)) * NU + U_DSG + 8 * (task & 63)); }
    __syncthreads();
    {
        float z[47];
#pragma unroll
        for (int i = 0; i < 47; ++i) z[i] = zl[i * CGS + c];
        if (samp || tile == 511) {
            float* dst = samp ? p->out + O_SPOOL + (((size_t)l * 32 + b) * 15) * 512 + c : p->out + O_PPOOL + ((size_t)l * 15) * 512 + c;
#pragma unroll
            for (int t = 17; t < 32; ++t) dst[(size_t)(t - 17) * 512] = z[15 + t];
        }
        const int w = 2 << (c >> 7);
#pragma unroll
        for (int t = 0; t < 32; ++t) { float s = 0.f;
#pragma unroll
            for (int i = 0; i < 16; ++i) s += (i < w) ? z[15 + t - i] : 0.f;
            const int pos = samp ? PAST + t : row0 + t; const int cnt = (pos + 1 < w) ? pos + 1 : w;
            pl[t * PST + c] = f2bf(s / (float)cnt - z[15 + t]); }
    }
    __syncthreads();
    LAS bf16_t* sl = (LAS bf16_t*)lds;
    LAS bf16_t* ol = sl + 32 * PST;
#pragma unroll
    for (int k = 0; k < 4; ++k) { const int task = tid + 512 * k, t = task >> 6, ch = task & 63; const u32x4 s = sgv[k];
        u32x4 w; w.x = cvt_pk_bf16(siluf_(bflo(s.x)), siluf_(bfhi(s.x))); w.y = cvt_pk_bf16(siluf_(bflo(s.y)), siluf_(bfhi(s.y))); w.z = cvt_pk_bf16(siluf_(bflo(s.z)), siluf_(bfhi(s.z))); w.w = cvt_pk_bf16(siluf_(bflo(s.w)), siluf_(bfhi(s.w)));
        *(LAS u32x4*)(sl + t * PST + 8 * ch) = w; }
    __syncthreads();
    {
        const int g = wave >> 1, fr = lane & 15, kq = lane >> 4;
        const bf16_t* WT = (const bf16_t*)(p->ws + WS_POOLW) + (size_t)(l * 4 + g) * 128 * 128;
        f32x4 acc[2][4];
#pragma unroll
        for (int mt = 0; mt < 2; ++mt)
#pragma unroll
            for (int nt = 0; nt < 4; ++nt) acc[mt][nt] = (f32x4){0.f, 0.f, 0.f, 0.f};
#pragma unroll
        for (int ks = 0; ks < 4; ++ks) {
            bf16x8 af[2];
#pragma unroll
            for (int mt = 0; mt < 2; ++mt) af[mt] = *(const LAS bf16x8*)(pl + (16 * mt + fr) * PST + g * 128 + 32 * ks + 8 * kq);
#pragma unroll
            for (int nt = 0; nt < 4; ++nt) { const int dl = (wave & 1) * 64 + 16 * nt + fr;
                const bf16x8 bfr = *(const bf16x8*)(WT + (size_t)dl * 128 + 32 * ks + 8 * kq);
#pragma unroll
                for (int mt = 0; mt < 2; ++mt) acc[mt][nt] = __builtin_amdgcn_mfma_f32_16x16x32_bf16(af[mt], bfr, acc[mt][nt], 0, 0, 0); }
        }
#pragma unroll
        for (int nt = 0; nt < 4; ++nt) { const int d = wave * 64 + 16 * nt + fr; const float pb = p->in[I_POOLB][l * 512 + d], ps = p->in[I_POOLS][l * 512 + d];
#pragma unroll
            for (int mt = 0; mt < 2; ++mt)
#pragma unroll
                for (int r = 0; r < 4; ++r) { const int t = 16 * mt + 4 * kq + r; ol[t * PST + d] = f2bf((acc[mt][nt][r] + pb) * ps * bf2f(sl[t * PST + d])); } }
    }
    __syncthreads();
    bf16_t* od = (bf16_t*)(p->ws + WS_OCAT) + (size_t)3 * NTOK * 512;
#pragma unroll
    for (int k = 0; k < 4; ++k) { const int task = tid + 512 * k, t = task >> 6, ch = task & 63; *(u32x4*)(od + (size_t)(row0 + t) * 512 + 8 * ch) = *(const LAS u32x4*)(ol + t * PST + 8 * ch); }
    __syncthreads();
}
__device__ __forceinline__ void fp_unit(KP p, int l, int h, LAS unsigned char* lds, int tid) {
    const float* lf = p->out + O_PLF + (size_t)l * TP * 8 + h;
    LAS float* part = (LAS float*)lds;
    float v[32]; float s = 0.f;
#pragma unroll
    for (int i = 0; i < 32; ++i) { v[i] = lf[(size_t)(tid * 32 + i) * 8]; s += v[i]; }
    part[tid] = s;
    __syncthreads();
    float pre = 0.f;
    for (int j = 0; j < tid; ++j) pre += part[j];
    float* F = (float*)(p->ws + WS_FP) + (size_t)h * TP + tid * 32;
#pragma unroll
    for (int i = 0; i < 32; ++i) { pre += v[i]; F[i] = pre * LOG2E; }
    __syncthreads();
}
__device__ __forceinline__ void gs_unit(KP p, int l, int b, LAS unsigned char* lds, int tid) {
    const int h = tid & 7, ch = tid >> 3;
    const float* cl = p->in[I_CLF] + (((size_t)l * 32 + b) * PAST + ch * 64) * 8 + h;
    LAS float* part = (LAS float*)lds;
    float v[64]; float s = 0.f;
#pragma unroll
    for (int i = 0; i < 64; ++i) v[i] = cl[(size_t)i * 8];
#pragma unroll
    for (int i = 0; i < 64; ++i) s += v[i];
    part[ch * 8 + h] = s;
    __syncthreads();
    float suf = 0.f;
    for (int j = ch + 1; j < 64; ++j) suf += part[j * 8 + h];
    float* G = (float*)(p->ws + WS_GS) + ((size_t)b * 8 + h) * GS_LEN + ch * 64;
#pragma unroll
    for (int i = 63; i >= 0; --i) { G[i] = -suf * LOG2E; suf += v[i]; }
    if (tid < 8) { const float* nl = p->out + O_SLF + ((size_t)l * 1024 + b * 32) * 8 + tid; float* Gn = (float*)(p->ws + WS_GS) + ((size_t)b * 8 + tid) * GS_LEN + PAST; float w[32]; float run = 0.f;
#pragma unroll
        for (int i = 0; i < 32; ++i) w[i] = nl[i * 8];
#pragma unroll
        for (int i = 0; i < 32; ++i) { run += w[i]; Gn[i] = run * LOG2E; } }
    __syncthreads();
}
__device__ __forceinline__ void vt_tile(KP p, int l, int tile, LAS unsigned char* lds, int wave, int lane) {
    const int h = tile >> 8, tb = tile & 255, tl = lane >> 3, q8 = (lane & 7) * 8;
    const bf16_t* U = (const bf16_t*)(p->ws + WS_U);
    LAS unsigned short* scr = (LAS unsigned short*)(lds + wave * (64 * 72 * 2));
    u32x4 kv[8], vv[8];
#pragma unroll
    for (int i = 0; i < 8; ++i) { const bf16_t* rp = U + (size_t)(tb * 64 + 8 * i + tl) * NU + h * 64 + q8; kv[i] = *(const u32x4*)(rp + U_K); vv[i] = *(const u32x4*)(rp + U_V); }
    float mx = 0.f;
#pragma unroll
    for (int i = 0; i < 8; ++i) { const u32x4 w = kv[i];
        float s = bflo(w.x) * bflo(w.x) + bfhi(w.x) * bfhi(w.x) + bflo(w.y) * bflo(w.y) + bfhi(w.y) * bfhi(w.y) + bflo(w.z) * bflo(w.z) + bfhi(w.z) * bfhi(w.z) + bflo(w.w) * bflo(w.w) + bfhi(w.w) * bfhi(w.w);
        s += dpp_mov<0xB1>(s); s += dpp_mov<0x4E>(s); s += dpp_mov<0x141>(s); mx = fmaxf(mx, s); }
    mx = wave_max(mx);
    if (lane == 0) atomicMax((unsigned*)(p->ws + WS_CTL) + CW_KMAX + l * 8 + h, __float_as_uint(mx));
#pragma unroll
    for (int i = 0; i < 8; ++i) { const int t = 8 * i + tl; const u32x4 w = vv[i];
        scr[(q8 + 0) * 72 + t] = (unsigned short)(w.x & 0xffffu); scr[(q8 + 1) * 72 + t] = (unsigned short)(w.x >> 16); scr[(q8 + 2) * 72 + t] = (unsigned short)(w.y & 0xffffu); scr[(q8 + 3) * 72 + t] = (unsigned short)(w.y >> 16);
        scr[(q8 + 4) * 72 + t] = (unsigned short)(w.z & 0xffffu); scr[(q8 + 5) * 72 + t] = (unsigned short)(w.z >> 16); scr[(q8 + 6) * 72 + t] = (unsigned short)(w.w & 0xffffu); scr[(q8 + 7) * 72 + t] = (unsigned short)(w.w >> 16); }
    bf16_t* Vt = (bf16_t*)(p->ws + WS_VT) + ((size_t)h * 64 + lane) * TP + tb * 64;
#pragma unroll
    for (int j = 0; j < 8; ++j) *(u32x4*)(Vt + 8 * j) = *(const LAS u32x4*)(scr + lane * 72 + 8 * j);
}
__device__ __forceinline__ void shift_out(KP p, int l, int tid) {
    const bf16_t* U = (const bf16_t*)(p->ws + WS_U);
    for (int base = tid; base < NSEQ * SHIFT_W; base += 512 * 8) {
        unsigned short v[8];
#pragma unroll
        for (int k = 0; k < 8; ++k) { const int idx = base + k * 512 < NSEQ * SHIFT_W ? base + k * 512 : tid; const int s = idx / SHIFT_W, j = idx - s * SHIFT_W; const int row = s == 0 ? TP - 1 : TP + (s - 1) * 32 + 31; v[k] = U[(size_t)row * NU + U_XC + j]; }
#pragma unroll
        for (int k = 0; k < 8; ++k) { const int idx = base + k * 512; if (idx < NSEQ * SHIFT_W) { const int s = idx / SHIFT_W, j = idx - s * SHIFT_W;
            float* dst = s == 0 ? p->out + O_PSHIFT + (size_t)l * SHIFT_W + j : p->out + O_SSHIFT + ((size_t)l * 32 + (s - 1)) * SHIFT_W + j; *dst = bf2f(v[k]); } }
    }
}
template <bool AT, bool BT, bool NEGA>
__device__ __forceinline__ void mm32(f32x16& acc, const LAS float* Ap, int i0, const LAS float* Bp, int j0, int lane) {
    const int li = lane & 31, kh = lane >> 5;
    const LAS float* ap = AT ? Ap + (8 * kh) * 65 + i0 + li : Ap + (i0 + li) * 65 + 8 * kh;
    const LAS float* bp = BT ? Bp + (j0 + li) * 65 + 8 * kh : Bp + (8 * kh) * 65 + j0 + li;
#pragma unroll 2
    for (int s = 0; s < 4; ++s) {
        float a[8], b[8];
#pragma unroll
        for (int e = 0; e < 8; ++e) { a[e] = AT ? ap[(16 * s + e) * 65] : ap[16 * s + e]; b[e] = BT ? bp[16 * s + e] : bp[(16 * s + e) * 65]; }
        if (NEGA) {
#pragma unroll
            for (int e = 0; e < 8; ++e) a[e] = -a[e]; }
        const bf16x8 af = pack8f((f32x4){a[0], a[1], a[2], a[3]}, (f32x4){a[4], a[5], a[6], a[7]}), bfg = pack8f((f32x4){b[0], b[1], b[2], b[3]}, (f32x4){b[4], b[5], b[6], b[7]});
        acc = __builtin_amdgcn_mfma_f32_32x32x16_bf16(af, bfg, acc, 0, 0, 0);
    }
}
template <int MASK>
__device__ __forceinline__ void st_tile(LAS float* dst, const f32x16& acc, int i0, int j0, int lane) {
    const int li = lane & 31, hi = lane >> 5, j = j0 + li;
#pragma unroll
    for (int r = 0; r < 16; ++r) { const int i = i0 + (r & 3) + 8 * (r >> 2) + 4 * hi; float v = acc[r];
        if (MASK == 1 && !(i < j)) v = 0.f; if (MASK == 2 && !(i <= j)) v = 0.f; dst[i * 65 + j] = v; }
}
struct RwkvSeqInfo { int row0, ntok, prev_kind  , b; };
__device__ __forceinline__ RwkvSeqInfo rwkv_info(int cu) { RwkvSeqInfo s; if (cu < 256) { s.row0 = cu * 64; s.ntok = 64; s.prev_kind = cu == 0 ? 0 : 1; s.b = 0; } else { s.b = cu - 256; s.row0 = TP + s.b * 32; s.ntok = 32; s.prev_kind = 2; } return s; }

__device__ __forceinline__ void rwkv_r1(KP p, int l, int unit, LAS unsigned char* lds, int tid) {
    const int cu = unit >> 3, h = unit & 7, wave = tid >> 6, lane = tid & 63, li = lane & 31, hi = lane >> 5;
    const RwkvSeqInfo si = rwkv_info(cu);
    const bf16_t* U = (const bf16_t*)(p->ws + WS_U);
    LAS float* S0 = (LAS float*)lds; LAS float *S1 = S0 + SLOT_F, *S2 = S0 + 2 * SLOT_F, *S3 = S0 + 3 * SLOT_F, *S4 = S0 + 4 * SLOT_F, *S5 = S0 + 5 * SLOT_F, *S6 = S0 + 6 * SLOT_F, *S7 = S0 + 7 * SLOT_F, *S8 = S0 + 8 * SLOT_F;
    LAS float* gC = S0 + 9 * SLOT_F;
    const int q = wave >> 2, wq = wave & 3, i0 = (wq >> 1) * 32, j0 = (wq & 1) * 32;
    PT0();
    {
        const int j = tid & 63, tq = tid >> 6;
        const int tl = lane >> 3, q8 = (lane & 7) * 8;
#pragma unroll
        for (int kb = 0; kb < 5; kb += 3) {
        u32x4 cur[5], prv[5];
#pragma unroll
        for (int k = kb; k < (kb + 3 < 5 ? kb + 3 : 5); ++k) { const int pid = wave * 5 + k, s = pid >> 3, tb = pid & 7, t = tb * 8 + tl;
            const int xo = (s < 3 ? s * 512 + h * 64 : 1536 + (s - 3) * 64) + q8;
            const int tc = t < si.ntok ? t : si.ntok - 1, tp = tc > 0 ? tc - 1 : (si.prev_kind == 1 ? -1 : 0);
            cur[k] = *(const u32x4*)(U + (size_t)(si.row0 + tc) * NU + U_XC + xo); prv[k] = *(const u32x4*)(U + (size_t)(si.row0 + tp) * NU + U_XC + xo); }
#pragma unroll
        for (int k = kb; k < (kb + 3 < 5 ? kb + 3 : 5); ++k) { const int pid = wave * 5 + k, s = pid >> 3, tb = pid & 7, t = tb * 8 + tl;
            const int xo = (s < 3 ? s * 512 + h * 64 : 1536 + (s - 3) * 64) + q8;
            LAS float* dst = (s == 0 ? S0 : s == 1 ? S1 : s == 2 ? S2 : s == 3 ? S3 : S4) + t * 65 + q8;
            const f32x4 m0 = *(const f32x4*)(p->in[I_MU] + l * SHIFT_W + xo), m1 = *(const f32x4*)(p->in[I_MU] + l * SHIFT_W + xo + 4);
            float x[8] = {bflo(cur[k].x), bfhi(cur[k].x), bflo(cur[k].y), bfhi(cur[k].y), bflo(cur[k].z), bfhi(cur[k].z), bflo(cur[k].w), bfhi(cur[k].w)};
            float pv[8] = {bflo(prv[k].x), bfhi(prv[k].x), bflo(prv[k].y), bfhi(prv[k].y), bflo(prv[k].z), bfhi(prv[k].z), bflo(prv[k].w), bfhi(prv[k].w)};
            if (t == 0 && si.prev_kind != 1) {
                if (si.prev_kind == 2) { const float* sp = p->in[I_SSHIFT] + ((size_t)l * 32 + si.b) * SHIFT_W + xo;
#pragma unroll
                    for (int e = 0; e < 8; ++e) pv[e] = sp[e]; }
                else {
#pragma unroll
                    for (int e = 0; e < 8; ++e) pv[e] = 0.f; } }
#pragma unroll
            for (int e = 0; e < 8; ++e) { const float mu = e < 4 ? m0[e] : m1[e - 4]; float xs = (t < si.ntok) ? x[e] + (pv[e] - x[e]) * mu : 0.f; if (s == 3) xs = fast_tanh(xs); dst[e] = xs; }
        }
        }
#pragma unroll
        for (int mm = 0; mm < 8; ++mm) { const int m = tq * 8 + mm;
            S5[m * 65 + j] = p->in[I_W2][((size_t)l * 64 + m) * 512 + h * 64 + j]; S6[m * 65 + j] = p->in[I_A2][((size_t)l * 64 + m) * 512 + h * 64 + j]; }
    }
    __syncthreads();
    PT1(1);
    {
        f32x16 acc = {};
        const int c = j0 + li;
        if (q == 0) { mm32<false, false, false>(acc, S3, i0, S5, j0, lane); const float w0 = p->in[I_W0][l * 512 + h * 64 + c];
#pragma unroll
            for (int r = 0; r < 16; ++r) { const int t = i0 + (r & 3) + 8 * (r >> 2) + 4 * hi; const float zz = acc[r] + w0;
                const float sp = fmaxf(-zz, 0.f) + __logf(1.f + __expf(-fabsf(zz)));
                S7[t * 65 + c] = (t < si.ntok) ? -__expf(-sp - 0.5f) : 0.f; } }
        else { mm32<false, false, false>(acc, S4, i0, S6, j0, lane); const float a0 = p->in[I_A0][l * 512 + h * 64 + c];
#pragma unroll
            for (int r = 0; r < 16; ++r) { const int t = i0 + (r & 3) + 8 * (r >> 2) + 4 * hi; S8[t * 65 + c] = __builtin_amdgcn_rcpf(1.f + __expf(-(acc[r] + a0))); } }
    }
    __syncthreads();
    PT1(2);
    if (wave == 0) { float run = 0.f;
#pragma unroll 8
        for (int t = 0; t < 64; ++t) { run += S7[t * 65 + lane]; S3[t * 65 + lane] = run; } }
    else { const int c = lane; const float kkw = p->in[I_KK][l * 512 + h * 64 + c], kaw = p->in[I_KA][l * 512 + h * 64 + c], rkw = p->in[I_RK][l * 512 + h * 64 + c];
        for (int t = wave - 1; t < 64; t += 7) { const float kr = S1[t * 65 + c], kv = kr * kkw; const float ss = wave_sum(kv * kv);
            const float kn = kv * (1.f / sqrtf(fmaxf(ss, 1e-24f))); const float a = S8[t * 65 + c]; const float km = kr * (1.f + (a - 1.f) * kaw);
            const float bon = wave_sum(S0[t * 65 + c] * km * rkw);
            S4[t * 65 + c] = kn; S1[t * 65 + c] = km; S8[t * 65 + c] = kn * a;
            if (lane == 0) ((float*)(p->ws + WS_BONUS))[(size_t)unit * 64 + t] = bon; } }
    __syncthreads();
    { const int c = tid & 63, tq = tid >> 6;
#pragma unroll
        for (int tt = 0; tt < 8; ++tt) { const int t = tq * 8 + tt, o = t * 65 + c; const float Lg = S3[o], lw = S7[o];
            const float g = __expf(Lg), gi = __expf(-Lg), gp = __expf(Lg - lw);
            S0[o] *= g; S1[o] *= gi; S8[o] *= gi; S4[o] *= gp; if (t == 63) gC[c] = g; } }
    __syncthreads();
    PT1(3);
    { f32x16 acc = {};
      if (q == 0) { mm32<false, true, false>(acc, S1, i0, S4, j0, lane); st_tile<1>(S3, acc, i0, j0, lane); }
      else { mm32<false, true, false>(acc, S8, i0, S4, j0, lane); st_tile<1>(S5, acc, i0, j0, lane); } }
    __syncthreads();
    { f32x16 acc = {};
      if (q == 0) { mm32<true, false, false>(acc, S2, i0, S3, j0, lane); st_tile<0>(S6, acc, i0, j0, lane); }
      else { mm32<false, true, false>(acc, S1, i0, S0, j0, lane); st_tile<2>(S7, acc, i0, j0, lane); } }
    __syncthreads();
    PT1(4);
    { float x[16]; const int r0 = (wave & 3) * 16;
      if (wave < 4) {
#pragma unroll
          for (int rr = 0; rr < 16; ++rr) x[rr] = S4[lane * 65 + r0 + rr]; }
      else {
#pragma unroll
          for (int rr = 0; rr < 16; ++rr) x[rr] = S6[(r0 + rr) * 65 + lane]; }
      __syncthreads();
#pragma unroll
      for (int sb = 0; sb < 4; ++sb) {
          float mreg[16];
#pragma unroll
          for (int s = 0; s < 16; ++s) mreg[s] = S5[(sb * 16 + (s < 15 || sb < 3 ? s : 14)) * 65 + lane];
          __builtin_amdgcn_sched_barrier(0);
#pragma unroll
          for (int s = 0; s < 16; ++s) { if (sb * 16 + s < 63) { const float mrow = mreg[s]; float xs[16];
#pragma unroll
              for (int rr = 0; rr < 16; ++rr) xs[rr] = __builtin_bit_cast(float, __builtin_amdgcn_readlane(__builtin_bit_cast(int, x[rr]), sb * 16 + s));
              __builtin_amdgcn_sched_barrier(0);
#pragma unroll
              for (int rr = 0; rr < 16; ++rr) x[rr] -= xs[rr] * mrow;
              __builtin_amdgcn_sched_barrier(0); } }
      }
      LAS float* dst = wave < 4 ? S3 : S6;
#pragma unroll
      for (int rr = 0; rr < 16; ++rr) dst[(r0 + rr) * 65 + lane] = x[rr]; }
    __syncthreads();
    PT1(5);
    { f32x16 acc = {};
      if (q == 1) { mm32<false, true, false>(acc, S8, i0, S0, j0, lane); st_tile<2>(S4, acc, i0, j0, lane); }
      else { mm32<false, false, false>(acc, S3, i0, S8, j0, lane);
          const int jc = j0 + li; const float gc = gC[jc]; float* TQ = (float*)(p->ws + WS_TQ) + (size_t)unit * 4096;
#pragma unroll
          for (int rg = 0; rg < 4; ++rg) { const int ab = i0 + 8 * rg + 4 * hi; f32x4 o;
#pragma unroll
              for (int e = 0; e < 4; ++e) o[e] = ((ab + e == jc) ? gc : 0.f) - acc[rg * 4 + e] * gc;
              *(f32x4*)(TQ + ((((jc >> 4) * 4 + (ab >> 4)) * 64 + ((ab & 15) >> 2) * 16 + (jc & 15)) * 4)) = o; } } }
    __syncthreads();
    { f32x16 acc = {};
      if (q == 0) { mm32<true, false, false>(acc, S2, i0, S1, j0, lane); mm32<false, false, true>(acc, S6, i0, S8, j0, lane);
          const int jc = j0 + li; const float gc = gC[jc]; float* GM = (float*)(p->ws + WS_GM) + (size_t)unit * 4096;
#pragma unroll
          for (int r = 0; r < 16; ++r) GM[(i0 + (r & 3) + 8 * (r >> 2) + 4 * hi) * 64 + jc] = acc[r] * gc; }
      else { mm32<true, false, false>(acc, S2, i0, S7, j0, lane); mm32<false, false, true>(acc, S6, i0, S4, j0, lane);
          float* Y0T = (float*)(p->ws + WS_Y0T) + (size_t)unit * 4096;
#pragma unroll
          for (int rg = 0; rg < 4; ++rg) *(f32x4*)(Y0T + (((((j0 >> 5) * 2 + (i0 >> 5)) * 4 + rg) * 2 + hi) * 32 + li) * 4) = (f32x4){acc[rg * 4], acc[rg * 4 + 1], acc[rg * 4 + 2], acc[rg * 4 + 3]}; } }
    if (q == 0) { f32x16 acc;
#pragma unroll
        for (int r = 0; r < 16; ++r) acc[r] = S0[(j0 + li) * 65 + i0 + (r & 3) + 8 * (r >> 2) + 4 * hi];
        mm32<false, false, true>(acc, S3, i0, S4, j0, lane);
        float* ET = (float*)(p->ws + WS_ET) + (size_t)unit * 4096;
#pragma unroll
        for (int rg = 0; rg < 4; ++rg) *(f32x4*)(ET + ((((j0 >> 5) * 2 + (i0 >> 5)) * 8 + 2 * rg + hi) * 32 + li) * 4) = (f32x4){acc[rg * 4], acc[rg * 4 + 1], acc[rg * 4 + 2], acc[rg * 4 + 3]}; }
    __syncthreads();
    PT1(6);
}
template <bool SCQ>
__device__ __forceinline__ void chain_run(f32x4 (&st)[4], const float* TQ, const float* GM, float* SC, int nsteps, int i, int g, int lane) {
    constexpr size_t STRIDE = (size_t)8 * 4096;
    f32x4 tq[16], gm[4];
#pragma unroll
    for (int x = 0; x < 16; ++x) tq[x] = *(const f32x4*)(TQ + (x * 64 + lane) * 4);
#pragma unroll
    for (int tl = 0; tl < 4; ++tl) gm[tl] = GM ? *(const f32x4*)(GM + i * 64 + 16 * tl + 4 * g) : (f32x4){0.f, 0.f, 0.f, 0.f};
    for (int c = 0; c < nsteps; ++c) {
        if (SC) {
            if (SCQ) {
#pragma unroll
                for (int tl = 0; tl < 4; ++tl) *(f32x4*)(SC + c * STRIDE + ((((i >> 5) * 2 + (tl >> 1)) * 8 + 4 * (tl & 1) + g) * 32 + (i & 31)) * 4) = st[tl]; }
            else {
#pragma unroll
                for (int tl = 0; tl < 4; ++tl) *(f32x4*)(SC + c * STRIDE + i * 64 + 16 * tl + 4 * g) = st[tl]; } }
        f32x4 tqn[16], gmn[4];
        const int cn = (c + 1 < nsteps) ? c + 1 : c;
#pragma unroll
        for (int x = 0; x < 16; ++x) tqn[x] = *(const f32x4*)(TQ + cn * STRIDE + (x * 64 + lane) * 4);
#pragma unroll
        for (int tl = 0; tl < 4; ++tl) gmn[tl] = GM ? *(const f32x4*)(GM + cn * STRIDE + i * 64 + 16 * tl + 4 * g) : (f32x4){0.f, 0.f, 0.f, 0.f};
        f32x4 acc[4];
#pragma unroll
        for (int tp = 0; tp < 4; ++tp) acc[tp] = gm[tp];
#pragma unroll
        for (int tl = 0; tl < 4; ++tl)
#pragma unroll
            for (int r = 0; r < 4; ++r)
#pragma unroll
                for (int tp = 0; tp < 4; ++tp) acc[tp] = __builtin_amdgcn_mfma_f32_16x16x4f32(tq[tp * 4 + tl][r], st[tl][r], acc[tp], 0, 0, 0);
#pragma unroll
        for (int tl = 0; tl < 4; ++tl) st[tl] = acc[tl];
#pragma unroll
        for (int x = 0; x < 16; ++x) tq[x] = tqn[x];
#pragma unroll
        for (int tl = 0; tl < 4; ++tl) gm[tl] = gmn[tl];
    }
}
constexpr int CH_SLOT = 32768;
#define CH_LD(R, STEP) do { const int s_ = (STEP) < nsteps ? (STEP) : nsteps - 1; _Pragma("unroll") for (int k = 0; k < 4; ++k) { R[k] = *(const f32x4*)(TQ + (size_t)s_ * STRIDE + (k * 256 + ll) * 4); \
        R[4 + k] = GM ? *(const f32x4*)(GM + (size_t)s_ * STRIDE + (k * 256 + ll) * 4) : (f32x4){0.f, 0.f, 0.f, 0.f}; } } while (0)
#define CH_WR(R, SLOT) do { LAS float* d_ = (LAS float*)(lds + (SLOT) * CH_SLOT); _Pragma("unroll") for (int k = 0; k < 4; ++k) { *(LAS f32x4*)(d_ + (k * 256 + ll) * 4) = R[k]; *(LAS f32x4*)(d_ + 4096 + (k * 256 + ll) * 4) = R[4 + k]; } } while (0)
template <bool SCQ>
__device__ __forceinline__ void chain_block(f32x4 (&st)[4], const float* TQ, const float* GM, float* SC, int nsteps, LAS unsigned char* lds, int wave, int lane) {
    constexpr size_t STRIDE = (size_t)8 * 4096;
    if (wave >= 4) {
        const int ll = (wave - 4) * 64 + lane;
        f32x4 r0[8], r1[8], r2[8];
        CH_LD(r0, 0); CH_LD(r1, 1); CH_LD(r2, 2);
        CH_WR(r0, 0);
        __syncthreads();
        for (int c = 0; c < nsteps; c += 3) {
            CH_WR(r1, (c + 1) & 1); CH_LD(r0, c + 3); __syncthreads();
            if (c + 1 < nsteps) { CH_WR(r2, (c + 2) & 1); CH_LD(r1, c + 4); __syncthreads(); }
            if (c + 2 < nsteps) { CH_WR(r0, (c + 3) & 1); CH_LD(r2, c + 5); __syncthreads(); }
        }
    } else {
        const int fr = lane & 15, g = lane >> 4, i = wave * 16 + fr;
        __syncthreads();
        for (int c = 0; c < nsteps; ++c) {
            if (SC) {
                if (SCQ) {
#pragma unroll
                    for (int tl = 0; tl < 4; ++tl) *(f32x4*)(SC + c * STRIDE + ((((i >> 5) * 2 + (tl >> 1)) * 8 + 4 * (tl & 1) + g) * 32 + (i & 31)) * 4) = st[tl]; }
                else {
#pragma unroll
                    for (int tl = 0; tl < 4; ++tl) *(f32x4*)(SC + c * STRIDE + i * 64 + 16 * tl + 4 * g) = st[tl]; } }
            const LAS float* sl = (const LAS float*)(lds + (c & 1) * CH_SLOT);
            f32x4 acc[4];
#pragma unroll
            for (int tp = 0; tp < 4; ++tp) acc[tp] = *(const LAS f32x4*)(sl + 4096 + i * 64 + 16 * tp + 4 * g);
#pragma unroll
            for (int tl = 0; tl < 4; ++tl) { f32x4 tq[4];
#pragma unroll
                for (int tp = 0; tp < 4; ++tp) tq[tp] = *(const LAS f32x4*)(sl + ((tp * 4 + tl) * 64 + lane) * 4);
#pragma unroll
                for (int r = 0; r < 4; ++r)
#pragma unroll
                    for (int tp = 0; tp < 4; ++tp) acc[tp] = __builtin_amdgcn_mfma_f32_16x16x4f32(tq[tp][r], st[tl][r], acc[tp], 0, 0, 0); }
#pragma unroll
            for (int tl = 0; tl < 4; ++tl) st[tl] = acc[tl];
            __syncthreads();
        }
    }
}
__device__ __forceinline__ void rwkv_l1_block(KP p, int task, LAS unsigned char* lds, int wave, int lane) {
    const int kind = task & 1, h = (task >> 1) & 7, grp = task >> 4, iq = wave & 3;
    const int fr = lane & 15, g = lane >> 4, i = iq * 16 + fr;
    const size_t u0 = ((size_t)(grp * 16) * 8 + h) * 4096;
    f32x4 st[4];
#pragma unroll
    for (int tl = 0; tl < 4; ++tl)
#pragma unroll
        for (int r = 0; r < 4; ++r) st[tl][r] = (kind == 1 && i == 16 * tl + 4 * g + r) ? 1.f : 0.f;
    chain_block<false>(st, (const float*)(p->ws + WS_TQ) + u0, kind == 0 ? (const float*)(p->ws + WS_GM) + u0 : nullptr, nullptr, 16, lds, wave, lane);
    if (wave < 4) { const size_t gb = ((size_t)grp * 8 + h) * 4096;
        if (kind == 0) { float* GG = (float*)(p->ws + WS_GG) + gb;
#pragma unroll
            for (int tl = 0; tl < 4; ++tl) *(f32x4*)(GG + i * 64 + 16 * tl + 4 * g) = st[tl]; }
        else { float* TG = (float*)(p->ws + WS_TG) + gb;
#pragma unroll
            for (int tl = 0; tl < 4; ++tl)
#pragma unroll
                for (int r = 0; r < 4; ++r) TG[((tl * 4 + iq) * 64 + (fr >> 2) * 16 + 4 * g + r) * 4 + (fr & 3)] = st[tl][r]; } }
    __syncthreads();
}
__device__ __forceinline__ void rwkv_l2_block(KP p, int l, int h, LAS unsigned char* lds, int wave, int lane) {
    const int iq = wave & 3, fr = lane & 15, g = lane >> 4, i = iq * 16 + fr;
    f32x4 st[4];
#pragma unroll
    for (int tl = 0; tl < 4; ++tl) st[tl] = (f32x4){0.f, 0.f, 0.f, 0.f};
    chain_block<false>(st, (const float*)(p->ws + WS_TG) + (size_t)h * 4096, (const float*)(p->ws + WS_GG) + (size_t)h * 4096, (float*)(p->ws + WS_SG) + (size_t)h * 4096, 16, lds, wave, lane);
    if (wave < 4) { float* dst = p->out + O_PWKV + (((size_t)l * 8 + h) * 64 + i) * 64;
#pragma unroll
        for (int tl = 0; tl < 4; ++tl) *(f32x4*)(dst + 16 * tl + 4 * g) = st[tl]; }
    __syncthreads();
}
__device__ __forceinline__ void rwkv_l3_block(KP p, int task, LAS unsigned char* lds, int wave, int lane) {
    const int h = task & 7, grp = task >> 3, iq = wave & 3, fr = lane & 15, g = lane >> 4, i = iq * 16 + fr;
    f32x4 st[4];
    const float* s0 = (const float*)(p->ws + WS_SG) + ((size_t)grp * 8 + h) * 4096 + i * 64;
#pragma unroll
    for (int tl = 0; tl < 4; ++tl) st[tl] = *(const f32x4*)(s0 + 16 * tl + 4 * g);
    const size_t u0 = ((size_t)(grp * 16) * 8 + h) * 4096;
    chain_block<true>(st, (const float*)(p->ws + WS_TQ) + u0, (const float*)(p->ws + WS_GM) + u0, (float*)(p->ws + WS_SC) + u0, 16, lds, wave, lane);
    __syncthreads();
}
__device__ __forceinline__ void rwkv_samp_task(KP p, int l, int t2, int lane) {
    const int fr = lane & 15, g = lane >> 4, iq = t2 & 3, h = (t2 >> 2) & 7, b = t2 >> 5, i = iq * 16 + fr;
    f32x4 st[4];
    const float* s0 = p->in[I_SWKV] + ((((size_t)l * 32 + b) * 8 + h) * 64 + i) * 64;
#pragma unroll
    for (int tl = 0; tl < 4; ++tl) st[tl] = *(const f32x4*)(s0 + 16 * tl + 4 * g);
    const size_t u0 = ((size_t)(256 + b) * 8 + h) * 4096;
    chain_run<true>(st, (const float*)(p->ws + WS_TQ) + u0, (const float*)(p->ws + WS_GM) + u0, (float*)(p->ws + WS_SC) + u0, 1, i, g, lane);
    float* dst = p->out + O_SWKV + ((((size_t)l * 32 + b) * 8 + h) * 64 + i) * 64;
#pragma unroll
    for (int tl = 0; tl < 4; ++tl) *(f32x4*)(dst + 16 * tl + 4 * g) = st[tl];
}
__device__ __forceinline__ void rwkv_r3_task(KP p, int l, int task, int lane) {
    const int unit = task >> 1, th = task & 1, cu = unit >> 3, h = unit & 7, li = lane & 31, hi = lane >> 5;
    const RwkvSeqInfo si = rwkv_info(cu);
    if (th * 32 >= si.ntok) return;
    const bf16_t* U = (const bf16_t*)(p->ws + WS_U);
    const size_t ub = (size_t)unit * 4096; const int t = th * 32 + li;
    const float* SC = (const float*)(p->ws + WS_SC) + ub; const float* ET = (const float*)(p->ws + WS_ET) + ub; const float* Y0T = (const float*)(p->ws + WS_Y0T) + ub;
    f32x16 acc[2];
#pragma unroll
    for (int ti = 0; ti < 2; ++ti)
#pragma unroll
        for (int rg = 0; rg < 4; ++rg) { const f32x4 y0 = *(const f32x4*)(Y0T + ((((th * 2 + ti) * 4 + rg) * 2 + hi) * 32 + li) * 4);
#pragma unroll
            for (int e = 0; e < 4; ++e) acc[ti][rg * 4 + e] = y0[e]; }
    f32x4 eb[8], sa0[8], sa1[8];
#pragma unroll
    for (int s4 = 0; s4 < 8; ++s4) { eb[s4] = *(const f32x4*)(ET + (((th * 2 + hi) * 8 + s4) * 32 + li) * 4); sa0[s4] = *(const f32x4*)(SC + (((0 * 2 + hi) * 8 + s4) * 32 + li) * 4); sa1[s4] = *(const f32x4*)(SC + (((1 * 2 + hi) * 8 + s4) * 32 + li) * 4); }
#pragma unroll
    for (int s4 = 0; s4 < 8; ++s4) {
#pragma unroll
        for (int e = 0; e < 4; ++e) { acc[0] = __builtin_amdgcn_mfma_f32_32x32x2f32(sa0[s4][e], eb[s4][e], acc[0], 0, 0, 0); acc[1] = __builtin_amdgcn_mfma_f32_32x32x2f32(sa1[s4][e], eb[s4][e], acc[1], 0, 0, 0); }
    }
    float s1 = 0.f;
#pragma unroll
    for (int ti = 0; ti < 2; ++ti)
#pragma unroll
        for (int r = 0; r < 16; ++r) s1 += acc[ti][r];
    s1 = xhalf_sum(s1); const float mean = s1 * (1.f / 64.f);
    float s2 = 0.f;
#pragma unroll
    for (int ti = 0; ti < 2; ++ti)
#pragma unroll
        for (int r = 0; r < 16; ++r) { const float d = acc[ti][r] - mean; s2 += d * d; }
    s2 = xhalf_sum(s2); const float rstd = 1.f / sqrtf(s2 * (1.f / 64.f) + 64e-5f);
    if (t >= si.ntok) return;
    const float bon = ((const float*)(p->ws + WS_BONUS))[(size_t)unit * 64 + t];
    const size_t row = (size_t)(si.row0 + t);
    bf16_t* oc = (bf16_t*)(p->ws + WS_OCAT) + (size_t)2 * NTOK * 512 + row * 512 + h * 64;
    u32x2 wout[2][4];
#pragma unroll
    for (int ti = 0; ti < 2; ++ti)
#pragma unroll
        for (int rg = 0; rg < 4; ++rg) { const int i = 32 * ti + 8 * rg + 4 * hi, c = h * 64 + i;
            const f32x4 gg = *(const f32x4*)(p->in[I_GNG] + l * 512 + c), gb = *(const f32x4*)(p->in[I_GNB] + l * 512 + c), mu = *(const f32x4*)(p->in[I_MU] + l * SHIFT_W + 1024 + c);
            const u32x2 vx = *(const u32x2*)(U + row * NU + U_XC + 1024 + c); const u32x2 sg = *(const u32x2*)(U + row * NU + U_CSG + c);
            f32x4 vc = (f32x4){bflo(vx.x), bfhi(vx.x), bflo(vx.y), bfhi(vx.y)}, vp;
            {
                const u32x2 px = *(const u32x2*)(U + (row > 0 ? row - 1 : 0) * NU + U_XC + 1024 + c); const f32x4 ss = *(const f32x4*)(p->in[I_SSHIFT] + ((size_t)l * 32 + si.b) * SHIFT_W + 1024 + c);
                const f32x4 up = (f32x4){bflo(px.x), bfhi(px.x), bflo(px.y), bfhi(px.y)};
                vp = (t > 0 || si.prev_kind == 1) ? up : (si.prev_kind == 2 ? ss : (f32x4){0.f, 0.f, 0.f, 0.f}); }
            const f32x4 vs = vc + (vp - vc) * mu;
            const f32x4 sgf = (f32x4){bflo(sg.x), bfhi(sg.x), bflo(sg.y), bfhi(sg.y)};
            f32x4 o;
#pragma unroll
            for (int e = 0; e < 4; ++e) o[e] = (((acc[ti][rg * 4 + e] - mean) * rstd) * gg[e] + gb[e] + bon * vs[e]) * siluf_(sgf[e]);
            wout[ti][rg].x = cvt_pk_bf16(o[0], o[1]); wout[ti][rg].y = cvt_pk_bf16(o[2], o[3]); }
#pragma unroll
    for (int ti = 0; ti < 2; ++ti)
#pragma unroll
        for (int rg = 0; rg < 4; ++rg) *(u32x2*)(oc + 32 * ti + 8 * rg + 4 * hi) = wout[ti][rg];
}
__device__ __forceinline__ int krow(int i) { return (i & 3) + 4 * ((i >> 3) & 1) + 8 * ((i >> 2) & 1) + 16 * (i >> 4); }
__device__ __forceinline__ bf16x8 pack8(const f32x16& v, int o) { u32x4 w; w.x = cvt_pk_bf16(v[o], v[o + 1]); w.y = cvt_pk_bf16(v[o + 2], v[o + 3]); w.z = cvt_pk_bf16(v[o + 4], v[o + 5]); w.w = cvt_pk_bf16(v[o + 6], v[o + 7]); return __builtin_bit_cast(bf16x8, w); }
constexpr float ATT_NEG = -1e30f;
template <bool HALF>
__device__ __forceinline__ void softmax_tile(f32x16& p0, f32x16& p1, float& m, float& lsum, f32x16 (&O)[2], bf16x8 (&pb)[4]) {
    float mx = p0[0];
#pragma unroll
    for (int r = 1; r < 16; ++r) mx = fmaxf(mx, p0[r]);
    if (!HALF) {
#pragma unroll
        for (int r = 0; r < 16; ++r) mx = fmaxf(mx, p1[r]); }
    mx = xhalf_max(mx);
    const float mn = fmaxf(m, mx), alpha = __builtin_amdgcn_exp2f(m - mn);
    m = mn;
    float s = 0.f;
#pragma unroll
    for (int r = 0; r < 16; ++r) { p0[r] = __builtin_amdgcn_exp2f(p0[r] - mn); s += p0[r]; }
    if (!HALF) {
#pragma unroll
        for (int r = 0; r < 16; ++r) { p1[r] = __builtin_amdgcn_exp2f(p1[r] - mn); s += p1[r]; } }
    lsum = lsum * alpha + s;
#pragma unroll
    for (int r = 0; r < 16; ++r) { O[0][r] *= alpha; O[1][r] *= alpha; }
    pb[0] = pack8(p0, 0); pb[1] = pack8(p0, 8);
    if (!HALF) { pb[2] = pack8(p1, 0); pb[3] = pack8(p1, 8); }
}
constexpr int AKS = 72;
constexpr int ATT_KB = 0, ATT_VB = 2 * 64 * AKS * 2, ATT_FB = 4 * 64 * AKS * 2, ATT_SC = ATT_FB + 2 * 64 * 4;
__device__ __forceinline__ void attn_prompt_unit(KP p, int l, int h, int qb, LAS unsigned char* lds, int tid) {
    const bf16_t* U = (const bf16_t*)(p->ws + WS_U); const bf16_t* Vt = (const bf16_t*)(p->ws + WS_VT) + (size_t)h * 64 * TP; const float* F = (const float*)(p->ws + WS_FP) + (size_t)h * TP;
    const int wave = tid >> 6, lane = tid & 63, li = lane & 31, hi = lane >> 5;
    const int q0 = qb * 256, q = q0 + wave * 32 + li;
    bf16x8 qf[4];
    { const float sc = 0.125f * LOG2E;
#pragma unroll
      for (int d0 = 0; d0 < 4; ++d0) { const u32x4 w = *(const u32x4*)(U + (size_t)q * NU + U_Q + h * 64 + 16 * d0 + 8 * hi);
          qf[d0] = pack8f((f32x4){bflo(w.x) * sc, bfhi(w.x) * sc, bflo(w.y) * sc, bfhi(w.y) * sc}, (f32x4){bflo(w.z) * sc, bfhi(w.z) * sc, bflo(w.w) * sc, bfhi(w.w) * sc}); } }
    const float fq = F[q];
    float m = ATT_NEG, lsum = 0.f; f32x16 O[2] = {};
    const int NT = (q0 + 256) / 64;
    LAS float* qmx = (LAS float*)(lds + ATT_SC); LAS float* mmv = qmx + 8;
    { float q2 = 0.f;
#pragma unroll
      for (int d0 = 0; d0 < 4; ++d0) { const u32x4 w = __builtin_bit_cast(u32x4, qf[d0]); q2 += bflo(w.x) * bflo(w.x) + bfhi(w.x) * bfhi(w.x) + bflo(w.y) * bflo(w.y) + bfhi(w.y) * bfhi(w.y) + bflo(w.z) * bflo(w.z) + bfhi(w.z) * bfhi(w.z) + bflo(w.w) * bflo(w.w) + bfhi(w.w) * bfhi(w.w); }
      q2 = wave_max(xhalf_sum(q2)); if (lane == 0) { qmx[wave] = q2; mmv[wave] = ATT_NEG; } }
    const float kmax2 = __uint_as_float(((const unsigned*)(p->ws + WS_CTL))[CW_KMAX + l * 8 + h]), fq0 = F[q0];
    const int srow = tid >> 3, sch = tid & 7;
    const bf16_t* kg = U + (size_t)srow * NU + U_K + h * 64 + 8 * sch; const bf16_t* vg = Vt + (size_t)srow * TP + 8 * sch;
    LAS unsigned char* kdst = lds + ATT_KB + (srow * AKS + 8 * sch) * 2; LAS unsigned char* vdst = lds + ATT_VB + (srow * AKS + 8 * sch) * 2;
    u32x4 kr = *(const u32x4*)(kg + (size_t)(NT - 1) * 64 * NU), vr = *(const u32x4*)(vg + (NT - 1) * 64); float fr = tid < 64 ? F[(NT - 1) * 64 + tid] : 0.f;
    *(LAS u32x4*)kdst = kr; *(LAS u32x4*)vdst = vr; if (tid < 64) ((LAS float*)(lds + ATT_FB))[tid] = fr;
    __syncthreads();
    const int ka = krow(li);
    float qkb; { float q2 = qmx[0];
#pragma unroll
      for (int w = 1; w < 8; ++w) q2 = fmaxf(q2, qmx[w]);
      qkb = 1.02f * sqrtf(q2 * kmax2) + fq0; }
    for (int t = NT - 1, buf = 0; t >= 0; --t, buf ^= 1) {
        { float mmin = mmv[0];
#pragma unroll
          for (int w = 1; w < 8; ++w) mmin = fminf(mmin, mmv[w]);
          if (qkb - ((const LAS float*)(lds + ATT_FB))[buf * 64 + 63] < mmin - 40.f) break; }
        if (t > 0) { kr = *(const u32x4*)(kg + (size_t)(t - 1) * 64 * NU); vr = *(const u32x4*)(vg + (t - 1) * 64); if (tid < 64) fr = F[(t - 1) * 64 + tid]; }
        if (64 * t <= q0 + wave * 32 + 31) {
            const LAS bf16_t* Kb = (const LAS bf16_t*)(lds + ATT_KB) + buf * 64 * AKS; const LAS bf16_t* Vb = (const LAS bf16_t*)(lds + ATT_VB) + buf * 64 * AKS; const LAS float* Fb = (const LAS float*)(lds + ATT_FB) + buf * 64;
            f32x16 p0, p1;
#pragma unroll
            for (int g2 = 0; g2 < 2; ++g2) { const f32x4 a = *(const LAS f32x4*)(Fb + 8 * hi + 16 * g2), b = *(const LAS f32x4*)(Fb + 8 * hi + 16 * g2 + 4), c = *(const LAS f32x4*)(Fb + 32 + 8 * hi + 16 * g2), d = *(const LAS f32x4*)(Fb + 32 + 8 * hi + 16 * g2 + 4);
#pragma unroll
                for (int e = 0; e < 4; ++e) { p0[8 * g2 + e] = fq - a[e]; p0[8 * g2 + 4 + e] = fq - b[e]; p1[8 * g2 + e] = fq - c[e]; p1[8 * g2 + 4 + e] = fq - d[e]; } }
#pragma unroll
            for (int d0 = 0; d0 < 4; ++d0) { const bf16x8 a0 = *(const LAS bf16x8*)(Kb + ka * AKS + 16 * d0 + 8 * hi), a1 = *(const LAS bf16x8*)(Kb + (ka + 32) * AKS + 16 * d0 + 8 * hi);
                p0 = __builtin_amdgcn_mfma_f32_32x32x16_bf16(a0, qf[d0], p0, 0, 0, 0); p1 = __builtin_amdgcn_mfma_f32_32x32x16_bf16(a1, qf[d0], p1, 0, 0, 0); }
            if (64 * t + 63 > q0 + wave * 32) {
#pragma unroll
                for (int r = 0; r < 16; ++r) { const int kv = 64 * t + 8 * hi + 16 * (r >> 3) + (r & 7); if (kv > q) p0[r] = -INFINITY; if (kv + 32 > q) p1[r] = -INFINITY; } }
            bf16x8 pb[4];
            softmax_tile<false>(p0, p1, m, lsum, O, pb);
#pragma unroll
            for (int dt = 0; dt < 2; ++dt)
#pragma unroll
                for (int s = 0; s < 4; ++s) { const bf16x8 a = *(const LAS bf16x8*)(Vb + (32 * dt + li) * AKS + 16 * (s & 1) + 32 * (s >> 1) + 8 * hi);
                    O[dt] = __builtin_amdgcn_mfma_f32_32x32x16_bf16(a, pb[s], O[dt], 0, 0, 0); }
        }
        { const float wm = wave_min(m); if (lane == 0) mmv[wave] = wm; }
        if (t > 0) { const int nb = buf ^ 1; *(LAS u32x4*)(kdst + nb * 64 * AKS * 2) = kr; *(LAS u32x4*)(vdst + nb * 64 * AKS * 2) = vr; if (tid < 64) ((LAS float*)(lds + ATT_FB))[nb * 64 + tid] = fr; }
        __syncthreads();
    }
    __syncthreads();
    const float inv = 1.f / xhalf_sum(lsum);
    bf16_t* ob = (bf16_t*)(p->ws + WS_OCAT) + (size_t)1 * NTOK * 512 + (size_t)q * 512 + h * 64;
    u32x2 sgv[2][4];
#pragma unroll
    for (int dt = 0; dt < 2; ++dt)
#pragma unroll
        for (int rg = 0; rg < 4; ++rg) sgv[dt][rg] = *(const u32x2*)(U + (size_t)q * NU + U_BSG + h * 64 + 32 * dt + 8 * rg + 4 * hi);
#pragma unroll
    for (int dt = 0; dt < 2; ++dt)
#pragma unroll
        for (int rg = 0; rg < 4; ++rg) { const int d = 32 * dt + 8 * rg + 4 * hi; const u32x2 sg = sgv[dt][rg];
            u32x2 w; w.x = cvt_pk_bf16(O[dt][rg * 4] * inv * siluf_(bflo(sg.x)), O[dt][rg * 4 + 1] * inv * siluf_(bfhi(sg.x))); w.y = cvt_pk_bf16(O[dt][rg * 4 + 2] * inv * siluf_(bflo(sg.y)), O[dt][rg * 4 + 3] * inv * siluf_(bfhi(sg.y)));
            *(u32x2*)(ob + d) = w; }
}
__device__ __forceinline__ void attn_sample_unit(KP p, int l, int b, int h, LAS unsigned char* lds, int tid) {
    const bf16_t* U = (const bf16_t*)(p->ws + WS_U);
    const int wave = tid >> 6, lane = tid & 63, li = lane & 31, hi = lane >> 5;
    const size_t qrow = (size_t)TP + b * 32 + li;
    const float* G = (const float*)(p->ws + WS_GS) + ((size_t)b * 8 + h) * GS_LEN;
    bf16x8 qf[4];
    { const float sc = 0.125f * LOG2E;
#pragma unroll
      for (int d0 = 0; d0 < 4; ++d0) { const u32x4 w = *(const u32x4*)(U + qrow * NU + U_Q + h * 64 + 16 * d0 + 8 * hi);
          qf[d0] = pack8f((f32x4){bflo(w.x) * sc, bfhi(w.x) * sc, bflo(w.y) * sc, bfhi(w.y) * sc}, (f32x4){bflo(w.z) * sc, bfhi(w.z) * sc, bflo(w.w) * sc, bfhi(w.w) * sc}); } }
    const float fq = G[PAST + li];
    float m = ATT_NEG, lsum = 0.f; f32x16 O[2] = {};
    const float* CK = p->in[I_CK] + (((size_t)l * 32 + b) * PAST) * 512 + h * 64; const float* CV = p->in[I_CV] + (((size_t)l * 32 + b) * PAST) * 512 + h * 64;
    const int ka = krow(li);
    float kmax2;
    { float mx = 0.f; const f32x4* kp4 = (const f32x4*)CK + (tid & 15);
#pragma unroll 1
      for (int it = 0; it < 8; ++it) { f32x4 kv[16];
#pragma unroll
          for (int j = 0; j < 16; ++j) kv[j] = kp4[(size_t)((it * 16 + j) * 32 + (tid >> 4)) * 128];
#pragma unroll
          for (int j = 0; j < 16; ++j) { float s = kv[j][0] * kv[j][0] + kv[j][1] * kv[j][1] + kv[j][2] * kv[j][2] + kv[j][3] * kv[j][3];
              s += dpp_mov<0xB1>(s); s += dpp_mov<0x4E>(s); s += dpp_mov<0x141>(s); s += dpp_mov<0x140>(s); mx = fmaxf(mx, s); } }
      mx = wave_max(mx); LAS float* kml = (LAS float*)lds;
      if (lane == 0) kml[wave] = mx;
      __syncthreads();
      kmax2 = kml[0];
#pragma unroll
      for (int w = 1; w < 8; ++w) kmax2 = fmaxf(kmax2, kml[w]);
      __syncthreads(); }
    float qkb;
    { float q2 = 0.f;
#pragma unroll
      for (int d0 = 0; d0 < 4; ++d0) { const u32x4 w = __builtin_bit_cast(u32x4, qf[d0]); q2 += bflo(w.x) * bflo(w.x) + bfhi(w.x) * bfhi(w.x) + bflo(w.y) * bflo(w.y) + bfhi(w.y) * bfhi(w.y) + bflo(w.z) * bflo(w.z) + bfhi(w.z) * bfhi(w.z) + bflo(w.w) * bflo(w.w) + bfhi(w.w) * bfhi(w.w); }
      q2 = wave_max(xhalf_sum(q2)); qkb = 1.02f * sqrtf(q2 * kmax2) + G[PAST]; }
    {
        f32x16 p0, p1 = {};
#pragma unroll
        for (int g2 = 0; g2 < 2; ++g2) { const float* gp = G + PAST + 8 * hi + 16 * g2; const f32x4 a = *(const f32x4*)gp, bq = *(const f32x4*)(gp + 4);
#pragma unroll
            for (int e = 0; e < 4; ++e) { p0[8 * g2 + e] = fq - a[e]; p0[8 * g2 + 4 + e] = fq - bq[e]; } }
#pragma unroll
        for (int d0 = 0; d0 < 4; ++d0) { const bf16x8 a0 = *(const bf16x8*)(U + ((size_t)TP + b * 32 + ka) * NU + U_K + h * 64 + 16 * d0 + 8 * hi);
            p0 = __builtin_amdgcn_mfma_f32_32x32x16_bf16(a0, qf[d0], p0, 0, 0, 0); }
#pragma unroll
        for (int r = 0; r < 16; ++r) { const int kv = 8 * hi + 16 * (r >> 3) + (r & 7); if (kv > li) p0[r] = -INFINITY; }
        bf16x8 pb[4];
        softmax_tile<true>(p0, p1, m, lsum, O, pb);
        if (wave == 7) {
#pragma unroll
            for (int dt = 0; dt < 2; ++dt)
#pragma unroll
                for (int s = 0; s < 2; ++s) { const bf16_t* vp = U + ((size_t)TP + b * 32 + 16 * s + 8 * hi) * NU + U_V + h * 64 + 32 * dt + li; u32x4 w;
                    w.x = (unsigned)vp[0] | ((unsigned)vp[NU] << 16); w.y = (unsigned)vp[2 * NU] | ((unsigned)vp[3 * NU] << 16); w.z = (unsigned)vp[4 * NU] | ((unsigned)vp[5 * NU] << 16); w.w = (unsigned)vp[6 * NU] | ((unsigned)vp[7 * NU] << 16);
                    O[dt] = __builtin_amdgcn_mfma_f32_32x32x16_bf16(__builtin_bit_cast(bf16x8, w), pb[s], O[dt], 0, 0, 0); } }
        else lsum = 0.f;
    }
    const float mmin = wave_min(m);
    for (int tt = 0; tt < 8; ++tt) {
        const int key0 = (63 - wave - 8 * tt) * 64;
        if (qkb - G[key0 + 63] < mmin - 40.f) break;
        f32x16 p0, p1;
#pragma unroll
        for (int g2 = 0; g2 < 2; ++g2) { const float* gp = G + key0 + 8 * hi + 16 * g2; const f32x4 a = *(const f32x4*)gp, bq = *(const f32x4*)(gp + 4), c = *(const f32x4*)(gp + 32), d = *(const f32x4*)(gp + 36);
#pragma unroll
            for (int e = 0; e < 4; ++e) { p0[8 * g2 + e] = fq - a[e]; p0[8 * g2 + 4 + e] = fq - bq[e]; p1[8 * g2 + e] = fq - c[e]; p1[8 * g2 + 4 + e] = fq - d[e]; } }
#pragma unroll
        for (int d0 = 0; d0 < 4; ++d0) { const float* k0p = CK + (size_t)(key0 + ka) * 512 + 16 * d0 + 8 * hi; const float* k1p = k0p + (size_t)32 * 512;
            const bf16x8 a0 = pack8f(*(const f32x4*)k0p, *(const f32x4*)(k0p + 4)), a1 = pack8f(*(const f32x4*)k1p, *(const f32x4*)(k1p + 4));
            p0 = __builtin_amdgcn_mfma_f32_32x32x16_bf16(a0, qf[d0], p0, 0, 0, 0); p1 = __builtin_amdgcn_mfma_f32_32x32x16_bf16(a1, qf[d0], p1, 0, 0, 0); }
        bf16x8 pb[4];
        softmax_tile<false>(p0, p1, m, lsum, O, pb);
#pragma unroll
        for (int dt = 0; dt < 2; ++dt)
#pragma unroll
            for (int s = 0; s < 4; ++s) { const float* vp = CV + (size_t)(key0 + 16 * (s & 1) + 32 * (s >> 1) + 8 * hi) * 512 + 32 * dt + li;
                const bf16x8 a = pack8f((f32x4){vp[0], vp[512], vp[1024], vp[1536]}, (f32x4){vp[2048], vp[2560], vp[3072], vp[3584]});
                O[dt] = __builtin_amdgcn_mfma_f32_32x32x16_bf16(a, pb[s], O[dt], 0, 0, 0); }
    }
    LAS float* Ow = (LAS float*)lds;
    LAS float* ML = Ow + 8 * 32 * 64;
    lsum = xhalf_sum(lsum);
#pragma unroll
    for (int dt = 0; dt < 2; ++dt)
#pragma unroll
        for (int r = 0; r < 16; ++r) Ow[(wave * 32 + dt * 16 + r) * 64 + lane] = O[dt][r];
    if (hi == 0) { ML[(wave * 2) * 32 + li] = m; ML[(wave * 2 + 1) * 32 + li] = lsum; }
    __syncthreads();
    { const int qq = tid & 31, dg = tid >> 5; float M = ATT_NEG;
#pragma unroll
      for (int w = 0; w < 8; ++w) M = fmaxf(M, ML[(w * 2) * 32 + qq]);
      float L = 0.f; f32x4 o = {0.f, 0.f, 0.f, 0.f};
      const int d = 4 * dg, idx0 = (d >> 5) * 16 + ((d >> 3) & 3) * 4, ln = ((d >> 2) & 1) * 32 + qq;
#pragma unroll
      for (int w = 0; w < 8; ++w) { const float f = __builtin_amdgcn_exp2f(ML[(w * 2) * 32 + qq] - M); L += ML[(w * 2 + 1) * 32 + qq] * f;
#pragma unroll
          for (int e = 0; e < 4; ++e) o[e] += Ow[(w * 32 + idx0 + e) * 64 + ln] * f; }
      const float inv = 1.f / L; const size_t row = (size_t)TP + b * 32 + qq;
      const u32x2 sg = *(const u32x2*)(U + row * NU + U_BSG + h * 64 + d);
      u32x2 wv; wv.x = cvt_pk_bf16(o[0] * inv * siluf_(bflo(sg.x)), o[1] * inv * siluf_(bfhi(sg.x))); wv.y = cvt_pk_bf16(o[2] * inv * siluf_(bflo(sg.y)), o[3] * inv * siluf_(bfhi(sg.y)));
      *(u32x2*)((bf16_t*)(p->ws + WS_OCAT) + (size_t)1 * NTOK * 512 + row * 512 + h * 64 + d) = wv; }
    __syncthreads();
}
constexpr int NPHASE = 22;
__global__ void __launch_bounds__(512, 2) hse_fwd(Params p_) {
    const KP kp = (KP)__builtin_amdgcn_kernarg_segment_ptr();
    (void)p_;
    extern __shared__ __attribute__((aligned(16))) unsigned char lds_raw[];
    LAS unsigned char* lds = (LAS unsigned char*)lds_raw;
    const int tid0 = threadIdx.x;
    const int wave0 = __builtin_amdgcn_readfirstlane(tid0 >> 6);
    const int G = gridDim.x, bid = blockIdx.x, ngw = G * 8;
#define PH_LOCALS const KP p = kp_fresh(kp); int tid = wave0 * 64 + (int)__builtin_amdgcn_mbcnt_hi(~0u, __builtin_amdgcn_mbcnt_lo(~0u, 0u)); asm volatile("" : "+v"(tid)); const int lane = tid & 63, wave = __builtin_amdgcn_readfirstlane(tid >> 6), gw = bid * 8 + wave; (void)lane; (void)gw; (void)p;
    if (tid0 < 4) ((LAS unsigned*)(lds + LDS_XB_OFF))[tid0] = 0u;
#if PROBE_ID
    if (tid0 == 0) *(LAS unsigned long long*)(lds + LDS_PROBE_OFF) = 0ull;
#endif
    __syncthreads();
    unsigned* ctl = (unsigned*)(kp->ws + WS_CTL);
    XcdBarrier bar = xcd_barrier_post(ctl + CW_BAR + kp->li * XCD_BAR_WORDS, (volatile LAS unsigned*)(lds + LDS_XB_OFF));
    const int lo = kp->ph_lo, hi = kp->ph_hi;
#define IN(k) (lo <= (k) && (k) < hi)
#ifndef DUP_MASK
#define DUP_MASK 0
#endif
#define NREP(k) (((DUP_MASK >> (k)) & 1) + 1)
#define SEAM(k) do { if (IN(k) && IN((k) + 1)) xcd_barrier(bar); } while (0)
    PT0();
    if (IN(0)) { PH_LOCALS
        for (int u = bid; u < 192; u += G) ada_unit(p, u, lds, tid);
        p0_weights(p, lds, gw, ngw, wave, lane);
    }
    SEAM(0);
    PT1(9);
    for (int l = 0; l < NLAYER; ++l) {
        const int pb = 1 + 10 * l;
        for (int rep = 0; rep < NREP(0); ++rep) { if (rep) xcd_barrier(bar);
        if (IN(pb)) { PH_LOCALS p1_rows(p, l, gw, ngw, lane); } }
        SEAM(pb);
        PT1(10);
        for (int rep = 0; rep < NREP(1); ++rep) { if (rep) xcd_barrier(bar);
        if (IN(pb + 1)) { PH_LOCALS
            pg8::Gemm g{(const bf16_t*)(p->ws + WS_H), (const bf16_t*)(p->ws + WS_WIN) + (size_t)l * NU * 2048, NTOK, NU, 2048, 2048};
            pg8::StaticOrder S; S.init(NTOK, NU, G, bid);
            EpiU E{(bf16_t*)(p->ws + WS_U), p->out, p->in[I_BF], l};
            pg8::gemm_phase<EpiU, pg8::StaticOrder>(lds, g, S, E, nullptr, tid);
        }
        }
        SEAM(pb + 1);
        PT1(11);
        for (int rep = 0; rep < NREP(2); ++rep) { if (rep) xcd_barrier(bar);
        if (IN(pb + 2)) { PH_LOCALS
#ifndef DUP_SUB
#define DUP_SUB 0
#endif
            { PT0();
            for (int u = bid; u < NRU * ((DUP_SUB & 1) + 1); u += G) rwkv_r1(p, l, u % NRU, lds, tid);
            PT1(31);
            for (int u = (bid + G - 32) % G; u < 544 * (((DUP_SUB >> 1) & 1) + 1); u += G) conv_unit(p, l, u % 544, lds, tid);
            PT1(32);
            for (int u = (bid + G - 64) % G; u < 544 * (((DUP_SUB >> 2) & 1) + 1); u += G) pool_unit(p, l, u % 544, lds, tid);
            PT1(33);
            for (int u = bid; u < 256; u += G) { vt_tile(p, l, u * 8 + wave, lds, wave, lane); }
            __syncthreads();
            for (int u = (bid + G - 96) % G; u < 32; u += G) gs_unit(p, l, u, lds, tid);
            for (int u = G - 1 - bid; u < 8; u += G) fp_unit(p, l, u, lds, tid);
            if (bid == G / 2) shift_out(p, l, tid);
            PT1(34); }
        }
        }
        SEAM(pb + 2);
        PT1(12);
        for (int rep = 0; rep < NREP(3); ++rep) { if (rep) xcd_barrier(bar);
        if (IN(pb + 3)) { PH_LOCALS
            for (int tk = bid; tk < 256; tk += G) rwkv_l1_block(p, tk, lds, wave, lane);
            LAS int* qslot = (LAS int*)(lds + LDS_XB_OFF - 16);
            for (;;) {
                if (tid == 0) *qslot = (int)atomicAdd(ctl + CW_QUEUE + 64 * (2 * l + 4 * rep), 1u);
                __syncthreads();
                const int item = *qslot;
                __syncthreads();
                if (item >= 512) break;
                attn_prompt_unit(p, l, item & 7, 63 - (item >> 3), lds, tid);
            }
            for (;;) {
                if (tid == 0) *qslot = (int)atomicAdd(ctl + CW_QUEUE + 64 * (2 * l + 1 + 4 * rep), 1u);
                __syncthreads();
                const int item = *qslot;
                __syncthreads();
                if (item >= 256) break;
                attn_sample_unit(p, l, item >> 3, item & 7, lds, tid);
            }
        }
        }
        SEAM(pb + 3);
        PT1(13);
        if (IN(pb + 4)) { PH_LOCALS for (int tk = bid; tk < 8; tk += G) rwkv_l2_block(p, l, tk, lds, wave, lane); }
        SEAM(pb + 4);
        PT1(14);
        if (IN(pb + 5)) { PH_LOCALS
            for (int tk = bid; tk < 128; tk += G) rwkv_l3_block(p, tk, lds, wave, lane);
            for (int tk = ((bid + G - 128) % G) * 8 + wave; tk < 1024; tk += ngw) rwkv_samp_task(p, l, tk, lane);
        }
        SEAM(pb + 5);
        PT1(15);
        if (IN(pb + 6)) { PH_LOCALS for (int tk = gw; tk < NRU * 2; tk += ngw) rwkv_r3_task(p, l, tk, lane); }
        SEAM(pb + 6);
        PT1(16);
        for (int rep = 0; rep < NREP(7); ++rep) { if (rep) xcd_barrier(bar);
        if (IN(pb + 7)) { PH_LOCALS
            pg8::Gemm g{(const bf16_t*)(p->ws + WS_OCAT), (const bf16_t*)(p->ws + WS_WBR) + (size_t)l * 4 * 2048 * 512, 4 * NTOK, 4 * 2048, 512, 512};
            BranchOrder S{G, bid};
            EpiZ E{(bf16_t*)(p->ws + WS_Z), (const bf16_t*)(p->ws + WS_U)};
            pg8::gemm_phase<EpiZ, BranchOrder>(lds, g, S, E, nullptr, tid);
        }
        }
        SEAM(pb + 7);
        PT1(17);
        if (IN(pb + 8)) { PH_LOCALS merge_pass(p, l, bid * 512 + tid, G * 512); }
        SEAM(pb + 8);
        PT1(18);
        if (IN(pb + 9)) { PH_LOCALS
            {
                pg8::Gemm g{(const bf16_t*)(p->ws + WS_MERGED), (const bf16_t*)(p->ws + WS_WOUT) + (size_t)l * 2048 * 2048, TP, 2048, 2048, 2048};
                pg8::StaticOrder S; S.init(TP, 2048, G, bid);
                EpiOut E{p->in[I_XP], p->in[I_XS], (const float*)(p->ws + WS_XBUF), (const float*)(p->ws + WS_ADA), (float*)(p->ws + WS_XBUF), l};
                pg8::gemm_phase<EpiOut, pg8::StaticOrder>(lds, g, S, E, nullptr, tid); }
            {
                const int tile = bid >> 3, ks = bid & 7;
                pg8::Gemm g{(const bf16_t*)(p->ws + WS_MERGED) + ks * 256, (const bf16_t*)(p->ws + WS_WOUT) + (size_t)l * 2048 * 2048 + ks * 256, NTOK, 2048, 256, 2048};
                OneUnit S{64 + (tile >> 3), tile & 7, bid < 256};
                EpiOutPart E{(const float*)(p->ws + WS_ADA), (float*)(p->ws + WS_XPART) + ((size_t)(l * 8 + ks) * 1024) * DM, l};
                pg8::gemm_phase<EpiOutPart, OneUnit>(lds, g, S, E, nullptr, tid); }
        }
        SEAM(pb + 9);
        PT1(19);
    }
    if (IN(21)) { PH_LOCALS p_final_rows(p, gw, ngw, lane); }
    PT1(20);
#if PROBE_ID
    if (bid == 0 && tid0 == 0) { const unsigned long long w = *(LAS unsigned long long*)(lds + LDS_PROBE_OFF) * PROBE_K, t0 = __builtin_amdgcn_s_memrealtime(); while (__builtin_amdgcn_s_memrealtime() - t0 < w) __builtin_amdgcn_s_sleep(8); }
#endif
#undef IN
#undef SEAM
}
#ifndef MK_SPLIT
#define MK_SPLIT 0
#endif
extern "C" void kernel_launch(void* const* d_in, const int* in_sizes, int n_in, void* d_out, int out_size, void* d_ws, size_t ws_size, hipStream_t stream) {
    static int grid = 0;
    if (grid == 0) {
        if (n_in != N_IN || (size_t)out_size != O_END || ws_size < WS_END) { fprintf(stderr, "kernel_launch: unexpected shapes (n_in %d, out %d, ws %zu)\n", n_in, out_size, ws_size); grid = -1; return; }
        int dev = 0, cus = 0, per_cu = 0;
        if (hipGetDevice(&dev) != hipSuccess || hipDeviceGetAttribute(&cus, hipDeviceAttributeMultiprocessorCount, dev) != hipSuccess) { grid = -1; return; }
        if (hipFuncSetAttribute((const void*)hse_fwd, hipFuncAttributeMaxDynamicSharedMemorySize, LDS_BYTES) != hipSuccess) { fprintf(stderr, "kernel_launch: hipFuncSetAttribute failed\n"); grid = -1; return; }
        if (hipOccupancyMaxActiveBlocksPerMultiprocessor(&per_cu, (const void*)hse_fwd, 512, LDS_BYTES) != hipSuccess || per_cu < 1) fprintf(stderr, "kernel_launch: occupancy query reports %d\n", per_cu);
        (void)hipGetLastError();
        grid = cus;
    }
    if (grid < 0) return;
    if (hipMemsetAsync((char*)d_ws + WS_CTL, 0, CTL_BYTES, stream) != hipSuccess) return;
    Params a{};
    for (int i = 0; i < N_IN; ++i) a.in[i] = (const float*)d_in[i];
    a.out = (float*)d_out; a.ws = (unsigned char*)d_ws;
#if MK_SPLIT
    for (int ph = 0; ph < NPHASE; ++ph) { a.ph_lo = ph; a.ph_hi = ph + 1; a.li = ph; hipLaunchKernelGGL(hse_fwd, dim3(grid), dim3(512), LDS_BYTES, stream, a); }
#else
    a.ph_lo = 0; a.ph_hi = NPHASE; a.li = 0;
    hipLaunchKernelGGL(hse_fwd, dim3(grid), dim3(512), LDS_BYTES, stream, a);
#endif
    const hipError_t le = hipPeekAtLastError();
    if (le != hipSuccess) fprintf(stderr, "kernel_launch: launch failed: %s\n", hipGetErrorName(le));
}
```

```cpp
#include <hip/hip_runtime.h>
#include <cstdio>
#include <cstdint>
namespace pg8 {
#define PG8_LAS __attribute__((address_space(3)))
typedef unsigned short bf16_t;
typedef short bf16x8 __attribute__((ext_vector_type(8)));
typedef float f32x4 __attribute__((ext_vector_type(4)));
typedef unsigned u32x4 __attribute__((ext_vector_type(4)));
constexpr int BM = 256, BK = 64, HALF = 128, HTB = HALF * BK * 2  , STAGE_BYTES = 8 * HTB, NXCD = 8, WGM = 8;

__host__ __device__ __forceinline__ int lds_byte(int r, int c) { const int st = (r >> 4) * 2 + (c >> 5), rr = r & 15, cc = c & 31, ob = rr * 64 + cc * 2; return st * 1024 + (ob ^ (((ob >> 9) & 1) << 5)); }
__host__ __device__ __forceinline__ void stage_rc(int b, int& R, int& C) { const int st = b / 1024, sb = b % 1024, swz = sb ^ (((sb >> 9) & 1) << 5); R = (st >> 1) * 16 + swz / 64; C = (st & 1) * 32 + (swz % 64) / 2; }
__host__ __device__ __forceinline__ int perm32(int rho) { const int n = rho >> 4, i = rho & 15; return 8 * (i >> 2) + 4 * n + (i & 3); }

struct Unit { int pm, pn; };
struct Gemm { const bf16_t* A; const bf16_t* Bt; int M, N, K, ld; };

struct StaticOrder {
    int nM, nN, nwg, G, c;
    __host__ __device__ void init(int M, int N, int G_, int c_) { nM = M / BM; nN = N / BM; nwg = nM * nN; G = G_; c = c_; }
    __host__ __device__ bool next(int i, Unit& u) const {
        const long L = (long)i * G + c; if (L >= nwg) return false;
        int wgid = (int)L; { const int q = nwg / NXCD, r = nwg % NXCD, xcd = wgid % NXCD, off = wgid / NXCD; wgid = (xcd < r ? xcd * (q + 1) : r * (q + 1) + (xcd - r) * q) + off; }
        const int nig = WGM * nN, gid = wgid / nig, fm = gid * WGM, gsz = (nM - fm) < WGM ? (nM - fm) : WGM;
        u.pm = fm + ((wgid % nig) % gsz); u.pn = (wgid % nig) / gsz; return true;
    }
    __device__ __forceinline__ void a_ready(const Unit&) const {}
    __device__ __forceinline__ void done(const Unit&) const {}
};
__device__ __forceinline__ unsigned cvt_pk_bf16(float lo, float hi) { unsigned r; asm volatile("v_cvt_pk_bf16_f32 %0, %1, %2" : "=v"(r) : "v"(lo), "v"(hi)); return r; }
typedef float f32x2 __attribute__((ext_vector_type(2)));
template <class Epi, class Sched, bool STAMP = false>
__device__ __forceinline__ void gemm_phase(PG8_LAS unsigned char* lds, const Gemm g, const Sched& S, const Epi& E, unsigned long long* stamps, int tid_in) {
    int tid = tid_in; asm volatile("" : "+v"(tid));
    const int wid = __builtin_amdgcn_readfirstlane(tid >> 6), lane = tid & 63, wr = wid >> 2, wc = wid & 3, fr = lane & 15, fq = lane >> 4;
    const int K = g.ld, nt = g.K / BK;
    int ts_lo = 0, ts_hi = 0, nts = 0; const unsigned long long rt_entry = STAMP ? (unsigned long long)wall_clock64() : 0ull;
#define PG8_STAMP() do { if (STAMP && wid == 0 && nts < 64) { const unsigned long long _c = (unsigned long long)clock64(); \
        ts_lo = (lane == nts) ? (int)(unsigned)_c : ts_lo; ts_hi = (lane == nts) ? (int)(unsigned)(_c >> 32) : ts_hi; ++nts; } } while (0)
    PG8_STAMP();
    unsigned voffA[2], voffB[2];
#pragma unroll
    for (int i = 0; i < 2; ++i) { int R, C; stage_rc(tid * 16 + i * 8192, R, C); const int Rb = Epi::PERM ? ((R & ~31) + perm32(R & 31)) : R;
        voffA[i] = (unsigned)(R * K + C) * 2u; voffB[i] = (unsigned)(Rb * K + C) * 2u; }
    const size_t kstep = (size_t)(BK * 2);
    const size_t hstep = (size_t)HALF * K * 2;
    const size_t tstep = 2 * hstep;
    const unsigned ldsw = (unsigned)wid * 1024u;
    const int aoff = lds_byte(wr * 64 + fr, fq * 8), boff = lds_byte(wc * 32 + fr, fq * 8);
#define PG8_SA(b, h) (((b) * 2 + (h)) * HTB)
#define PG8_SB(b, h) ((4 + (b) * 2 + (h)) * HTB)
#define PG8_STAGE(bufoff, gbase, voff) do { _Pragma("unroll") for (int _i = 0; _i < 2; ++_i) \
        __builtin_amdgcn_global_load_lds((const unsigned*)((const char*)(gbase) + (voff)[_i]), (PG8_LAS unsigned*)(lds + (bufoff) + ldsw + _i * 8192), 16, 0, 0); } while (0)
#define PG8_LDA(dst, b, h) do { _Pragma("unroll") for (int m = 0; m < 4; ++m) _Pragma("unroll") for (int k = 0; k < 2; ++k) dst[m][k] = *(const PG8_LAS bf16x8*)(lds + PG8_SA(b, h) + aoff + m * 2048 + k * 1024); } while (0)
#define PG8_LDB(dst, b, h) do { _Pragma("unroll") for (int n = 0; n < 2; ++n) _Pragma("unroll") for (int k = 0; k < 2; ++k) dst[n][k] = *(const PG8_LAS bf16x8*)(lds + PG8_SB(b, h) + boff + n * 2048 + k * 1024); } while (0)
#define PG8_MMA(ai, bj, At, Bt) do { __builtin_amdgcn_s_setprio(1); _Pragma("unroll") for (int m = 0; m < 4; ++m) _Pragma("unroll") for (int n = 0; n < 2; ++n) _Pragma("unroll") for (int k = 0; k < 2; ++k) \
        acc[ai][bj][m][n] = __builtin_amdgcn_mfma_f32_16x16x32_bf16(Bt[n][k], At[m][k], acc[ai][bj][m][n], 0, 0, 0); __builtin_amdgcn_s_setprio(0); } while (0)
#define PG8_WAIT_V(n) asm volatile("s_waitcnt vmcnt(" #n ")" ::: "memory")
#define PG8_WAIT_L(n) asm volatile("s_waitcnt lgkmcnt(" #n ")" ::: "memory")
#define PG8_BAR __builtin_amdgcn_s_barrier()
#define PG8_SCHED __builtin_amdgcn_sched_barrier(0)
    Unit cur, nxt; int ui = 0;
    if (!S.next(0, cur)) return;
    f32x4 acc[2][2][4][2];
#pragma unroll
    for (int a = 0; a < 2; ++a)
#pragma unroll
        for (int b = 0; b < 2; ++b)
#pragma unroll
            for (int m = 0; m < 4; ++m)
#pragma unroll
                for (int n = 0; n < 2; ++n) acc[a][b][m][n] = (f32x4){0.f, 0.f, 0.f, 0.f};
    bf16x8 At[4][2], B0[2][2], B1[2][2];
    const char* cA = (const char*)g.A + (size_t)cur.pm * tstep; const char* cB = (const char*)g.Bt + (size_t)cur.pn * tstep;
    S.a_ready(cur);
    PG8_STAGE(PG8_SB(0, 0), cB, voffB); PG8_STAGE(PG8_SA(0, 0), cA, voffA); PG8_STAGE(PG8_SB(0, 1), cB + hstep, voffB); PG8_STAGE(PG8_SA(0, 1), cA + hstep, voffA);
    if (wr == 1) PG8_BAR;
    PG8_WAIT_V(4); PG8_BAR;
    PG8_STAGE(PG8_SB(1, 0), cB + kstep, voffB); PG8_STAGE(PG8_SA(1, 0), cA + kstep, voffA); PG8_STAGE(PG8_SB(1, 1), cB + hstep + kstep, voffB);
    PG8_WAIT_V(6); PG8_BAR;
    PG8_STAMP();
    for (;;) {
        const bool has_next = S.next(ui + 1, nxt);
        const char* nA = has_next ? (const char*)g.A + (size_t)nxt.pm * tstep : cA; const char* nB = has_next ? (const char*)g.Bt + (size_t)nxt.pn * tstep : cB;
        for (int t = 0; t < nt; t += 2) {
            const bool last = (t == nt - 2);
            const char* a1 = cA + (size_t)(t + 1) * kstep;
            const char* a2 = last ? nA : cA + (size_t)(t + 2) * kstep; const char* b2 = last ? nB : cB + (size_t)(t + 2) * kstep;
            const char* a3 = a2 + kstep; const char* b3 = b2 + kstep;
            if (last && has_next) S.a_ready(nxt);
            PG8_LDB(B0, 0, 0); PG8_SCHED; PG8_LDA(At, 0, 0); PG8_STAGE(PG8_SA(1, 1), a1 + hstep, voffA);
            PG8_WAIT_L(8); PG8_BAR; PG8_WAIT_L(0); PG8_MMA(0, 0, At, B0); PG8_BAR; PG8_SCHED;
            PG8_LDB(B1, 0, 1); PG8_STAGE(PG8_SB(0, 0), b2, voffB);
            PG8_BAR; PG8_WAIT_L(0); PG8_MMA(0, 1, At, B1); PG8_BAR;
            PG8_LDA(At, 0, 1); PG8_STAGE(PG8_SA(0, 0), a2, voffA);
            PG8_BAR; PG8_WAIT_L(0); PG8_MMA(1, 0, At, B0); PG8_BAR; PG8_SCHED;
            PG8_STAGE(PG8_SB(0, 1), b2 + hstep, voffB);
            PG8_WAIT_V(6); PG8_BAR; PG8_MMA(1, 1, At, B1); PG8_BAR;
            PG8_LDB(B0, 1, 0); PG8_SCHED; PG8_LDA(At, 1, 0); PG8_STAGE(PG8_SA(0, 1), a2 + hstep, voffA);
            PG8_WAIT_L(8); PG8_BAR; PG8_WAIT_L(0); PG8_MMA(0, 0, At, B0); PG8_BAR; PG8_SCHED;
            PG8_LDB(B1, 1, 1); PG8_STAGE(PG8_SB(1, 0), b3, voffB);
            PG8_BAR; PG8_WAIT_L(0); PG8_MMA(0, 1, At, B1); PG8_BAR;
            PG8_LDA(At, 1, 1); PG8_STAGE(PG8_SA(1, 0), a3, voffA);
            PG8_BAR; PG8_WAIT_L(0); PG8_MMA(1, 0, At, B0); PG8_BAR; PG8_SCHED;
            PG8_STAGE(PG8_SB(1, 1), b3 + hstep, voffB);
            PG8_WAIT_V(6); PG8_BAR; PG8_MMA(1, 1, At, B1); PG8_BAR;
        }
        PG8_STAMP();
        if constexpr (!Epi::AFTER_DRAIN) { E(acc, cur, wr, wc, fr, fq); S.done(cur); }
        PG8_STAMP();
        if (!has_next) break;
#pragma unroll
        for (int a = 0; a < 2; ++a)
#pragma unroll
            for (int b = 0; b < 2; ++b)
#pragma unroll
                for (int m = 0; m < 4; ++m)
#pragma unroll
                    for (int n = 0; n < 2; ++n) acc[a][b][m][n] = (f32x4){0.f, 0.f, 0.f, 0.f};
        cur = nxt; cA = nA; cB = nB; ++ui;
    }
    PG8_WAIT_V(0);
    if (wr == 0) PG8_BAR;
    PG8_BAR;
    if constexpr (Epi::AFTER_DRAIN) { E.fused(acc, cur, wr, wc, fr, fq, lds, wid, lane); S.done(cur); }
    PG8_STAMP();
    if (STAMP && wid == 0) { stamps[lane] = lane < nts ? (((unsigned long long)(unsigned)ts_hi << 32) | (unsigned)ts_lo) : 0ull;
        if (lane == 62) stamps[62] = rt_entry; if (lane == 63) stamps[63] = (unsigned long long)wall_clock64(); }
#undef PG8_STAMP
#undef PG8_SA
#undef PG8_SB
#undef PG8_STAGE
#undef PG8_LDA
#undef PG8_LDB
#undef PG8_MMA
#undef PG8_WAIT_V
#undef PG8_WAIT_L
#undef PG8_BAR
#undef PG8_SCHED
}
}
#define XB_TMO      128
#define XB_XCNT(j)  (256  + 64 * (j))
#define XB_XSUB(j)  (1280 + 64 * (j))
#define XB_XGEN(j)  (2304 + 64 * (j))
#define XB_TOP      3328
#define XB_TOPGEN   3392
#define XCD_BAR_WORDS 3456
#define XB_SPIN_CAP (1u << 18)
#define LAS __attribute__((address_space(3)))

__device__ __forceinline__ unsigned xb_ld(unsigned* p)              { return __hip_atomic_load(p, __ATOMIC_RELAXED, __HIP_MEMORY_SCOPE_AGENT); }
__device__ __forceinline__ unsigned xb_add(unsigned* p, unsigned v) { return __hip_atomic_fetch_add(p, v, __ATOMIC_RELAXED, __HIP_MEMORY_SCOPE_AGENT); }
__device__ __forceinline__ unsigned xb_xcc_id() { return (unsigned)__builtin_amdgcn_s_getreg((3 << 11) | 20) & 0xFu; }
#define XB_SPIN(cond, bar) do { unsigned _sp = 0; while (cond) { __builtin_amdgcn_s_sleep(1); \
    if ((++_sp & 255u) == 0u) { if (xb_ld(&(bar)[XB_TMO])) break; if (_sp > XB_SPIN_CAP) { atomicAdd(&(bar)[XB_TMO], 1u); break; } } } } while (0)

struct XcdBarrier {
    unsigned* bar; unsigned x;
    volatile LAS unsigned* st;
};

__device__ __forceinline__ XcdBarrier xcd_barrier_post(unsigned* bar, volatile LAS unsigned* st) {
    XcdBarrier b; b.bar = bar; b.x = xb_xcc_id(); b.st = st;
    if (threadIdx.x == 0) (void)xb_add(&bar[XB_XCNT(b.x)], 1u);
    return b;
}
__device__ __forceinline__ void xcd_barrier_complete(unsigned* bar, unsigned x, unsigned& nloc, unsigned& nx) {
    const unsigned G = gridDim.x * gridDim.y * gridDim.z;
    unsigned sum, cnt, mine, sp = 0u;
    for (;;) {
        sum = 0u; cnt = 0u; mine = 0u;
#pragma unroll
        for (unsigned j = 0; j < 16; ++j) { const unsigned c = xb_ld(&bar[XB_XCNT(j)]); sum += c; cnt += (c > 0u) ? 1u : 0u; mine = (j == x) ? c : mine; }
        if (sum == G) break;
        __builtin_amdgcn_s_sleep(1);
        if ((++sp & 255u) == 0u) { if (xb_ld(&bar[XB_TMO])) break; if (sp > XB_SPIN_CAP) { atomicAdd(&bar[XB_TMO], 1u); break; } }
    }
    nloc = mine > 0u ? mine : 1u; nx = cnt > 0u ? cnt : 1u;
}

__device__ __forceinline__ void xcd_barrier(const XcdBarrier& b, const bool is_t0) {
    asm volatile("s_waitcnt vmcnt(0)" ::: "memory");
    __syncthreads();
    if (is_t0) {
        unsigned* bar = b.bar;
        __builtin_amdgcn_s_waitcnt(0);
        unsigned nloc = b.st[0], nx = b.st[1];
        if (nloc == 0u) { xcd_barrier_complete(bar, b.x, nloc, nx); b.st[0] = nloc; b.st[1] = nx; }
        const unsigned old = xb_add(&bar[XB_XSUB(b.x)], 1u);
        const unsigned gen = old / nloc;
        if (old + 1u == (gen + 1u) * nloc) {
            __builtin_amdgcn_fence(__ATOMIC_RELEASE, "agent");
            asm volatile("s_waitcnt vmcnt(0)" ::: "memory");
            const unsigned og = xb_add(&bar[XB_TOP], 1u);
            const unsigned tg = og / nx;
            if (og + 1u == (tg + 1u) * nx) xb_add(&bar[XB_TOPGEN], 1u);
            else XB_SPIN(xb_ld(&bar[XB_TOPGEN]) == tg, bar);
            __builtin_amdgcn_fence(__ATOMIC_ACQUIRE, "agent");
            xb_add(&bar[XB_XGEN(b.x)], 1u);
            asm volatile("s_waitcnt vmcnt(0)" ::: "memory");
        } else {
            XB_SPIN(xb_ld(&bar[XB_XGEN(b.x)]) == gen, bar);
            __builtin_amdgcn_fence(__ATOMIC_ACQUIRE, "agent");
            asm volatile("s_waitcnt vmcnt(0)" ::: "memory");
        }
    }
    __syncthreads();
}
typedef unsigned short bf16_t;
typedef short bf16x8 __attribute__((ext_vector_type(8)));
typedef float f32x4 __attribute__((ext_vector_type(4)));
typedef float f32x16 __attribute__((ext_vector_type(16)));
typedef unsigned u32x4 __attribute__((ext_vector_type(4)));
typedef unsigned u32x2 __attribute__((ext_vector_type(2)));
using pg8::cvt_pk_bf16;

constexpr int DM = 2048, TP = 16384, NSB = 32, TSQ = 32, NTOK = TP + NSB * TSQ, NSEQ = 33, PAST = 4096, NLAYER = 2;
constexpr int NU = 15104;
constexpr int U_AVAL = 0, U_AGATE = 512, U_ASG = 1024, U_Q = 1536, U_K = 2048, U_V = 2560, U_BSG = 3072, U_XC = 3584, U_CSG = 5248, U_DIN = 5760, U_DSG = 6272, U_G = 6784, U_F = 14976;
constexpr int IN_W = 14984, SHIFT_W = 1664;
constexpr float LOG2E = 1.4426950408889634f;
enum { I_XP = 0, I_XS, I_CK, I_CV, I_CLF, I_SCONV, I_SSHIFT, I_SWKV, I_SPOOL, I_CP, I_CS, I_NORMG, I_WADA, I_BADA, I_WIN, I_BF, I_CONVW, I_CONVB, I_CLNG, I_CLNB, I_MU, I_W0, I_W2, I_A0, I_A2,
       I_KK, I_KA, I_RK, I_GNG, I_GNB, I_POOLW, I_POOLB, I_POOLS, I_WBR, I_WOUT, I_FING, N_IN };
constexpr size_t O_YP = 0, O_YS = O_YP + (size_t)TP * DM, O_PK = O_YS + (size_t)1024 * DM, O_PV = O_PK + (size_t)2 * TP * 512, O_PLF = O_PV + (size_t)2 * TP * 512, O_PCONV = O_PLF + (size_t)2 * TP * 8,
                 O_PSHIFT = O_PCONV + 2 * 30 * 512, O_PWKV = O_PSHIFT + 2 * 1664, O_PPOOL = O_PWKV + 2 * 8 * 64 * 64, O_SK = O_PPOOL + 2 * 15 * 512, O_SV = O_SK + (size_t)2 * 1024 * 512,
                 O_SLF = O_SV + (size_t)2 * 1024 * 512, O_SCONV = O_SLF + 2 * 1024 * 8, O_SSHIFT = O_SCONV + (size_t)2 * 32 * 30 * 512, O_SWKV = O_SSHIFT + 2 * 32 * 1664,
                 O_SPOOL = O_SWKV + (size_t)2 * 32 * 8 * 64 * 64, O_END = O_SPOOL + (size_t)2 * 32 * 15 * 512;
static_assert(O_END == 75374848, "output size");
constexpr size_t al256(size_t x) { return (x + 255) & ~(size_t)255; }
constexpr int NCU_CH = 288, NRU = NCU_CH * 8;
constexpr size_t WS_CTL = 0, CTL_BYTES = 512 * 1024;
constexpr size_t WS_WIN = CTL_BYTES;
constexpr size_t WS_WBR = al256(WS_WIN + (size_t)2 * NU * 2048 * 2);
constexpr size_t WS_WOUT = al256(WS_WBR + (size_t)2 * 4 * 2048 * 512 * 2);
constexpr size_t WS_POOLW = al256(WS_WOUT + (size_t)2 * 2048 * 2048 * 2);
constexpr size_t WS_ADA = al256(WS_POOLW + (size_t)2 * 4 * 128 * 128 * 2);
constexpr size_t WS_H = al256(WS_ADA + (size_t)2 * 33 * 6144 * 4);
constexpr size_t WS_U = al256(WS_H + (size_t)NTOK * 2048 * 2);
constexpr size_t WS_XBUF = al256(WS_U + (size_t)NTOK * NU * 2);
constexpr size_t WS_OCAT = al256(WS_XBUF + (size_t)NTOK * 2048 * 4);
constexpr size_t WS_Z = al256(WS_OCAT + (size_t)4 * NTOK * 512 * 2);
constexpr size_t WS_MERGED = al256(WS_Z + (size_t)4 * NTOK * 2048 * 2);
constexpr size_t WS_FP = al256(WS_MERGED + (size_t)NTOK * 2048 * 2);
constexpr int GS_LEN = PAST + TSQ;
constexpr size_t WS_GS = al256(WS_FP + (size_t)8 * TP * 4);
constexpr size_t WS_VT = al256(WS_GS + (size_t)32 * 8 * GS_LEN * 4);
constexpr size_t WS_TQ = al256(WS_VT + (size_t)8 * 64 * TP * 2);
constexpr size_t WS_GM = al256(WS_TQ + (size_t)NRU * 4096 * 4);
constexpr size_t WS_ET = al256(WS_GM + (size_t)NRU * 4096 * 4);
constexpr size_t WS_Y0T = al256(WS_ET + (size_t)NRU * 4096 * 4);
constexpr size_t WS_SC = al256(WS_Y0T + (size_t)NRU * 4096 * 4);
constexpr size_t WS_BONUS = al256(WS_SC + (size_t)NRU * 4096 * 4);
constexpr size_t WS_GG = al256(WS_BONUS + (size_t)NRU * 64 * 4);
constexpr size_t WS_TG = al256(WS_GG + (size_t)16 * 8 * 4096 * 4);
constexpr size_t WS_SG = al256(WS_TG + (size_t)16 * 8 * 4096 * 4);
constexpr size_t WS_XPART = al256(WS_SG + (size_t)16 * 8 * 4096 * 4);
constexpr size_t WS_END = al256(WS_XPART + (size_t)2 * 8 * 1024 * 2048 * 4);
static_assert(WS_END < (size_t)2100 * 1024 * 1024, "workspace map exceeds the guaranteed d_ws size");
constexpr int CW_BAR = 0;
constexpr int CW_QUEUE = 16 * 3456 + 64;
constexpr int CW_KMAX = CW_QUEUE + 64 * 8;
static_assert((CW_KMAX + 64) * 4 <= (int)CTL_BYTES, "ctl");
constexpr int LDS_BYTES = 163840 - 256;
constexpr int LDS_XB_OFF = LDS_BYTES - 16;
constexpr int SLOT_F = 64 * 65;

#ifndef PROBE_ID
#define PROBE_ID 0
#endif
#ifndef PROBE_K
#define PROBE_K 1
#endif
constexpr int LDS_PROBE_OFF = 163840 - 256 - 64;
#if PROBE_ID
#define PT0() unsigned long long _pt0 = (blockIdx.x == 0 && threadIdx.x == 0) ? __builtin_amdgcn_s_memrealtime() : 0ull
#define PT1(id) do { if ((id) == PROBE_ID && blockIdx.x == 0 && threadIdx.x == 0) { *(LAS unsigned long long*)(lds + LDS_PROBE_OFF) += __builtin_amdgcn_s_memrealtime() - _pt0; } _pt0 = (blockIdx.x == 0 && threadIdx.x == 0) ? __builtin_amdgcn_s_memrealtime() : 0ull; } while (0)
#else
#define PT0() do {} while (0)
#define PT1(id) do {} while (0)
#endif
struct Params { const float* in[N_IN]; float* out; unsigned char* ws; int ph_lo, ph_hi, li, pad; };
typedef const __attribute__((address_space(4))) Params* KP;
__device__ __forceinline__ KP kp_fresh(KP k) { asm volatile("" : "+s"(k)); return k; }

__device__ __forceinline__ float bf2f(unsigned short b) { return __uint_as_float(((unsigned)b) << 16); }
__device__ __forceinline__ float bflo(unsigned w) { return __uint_as_float(w << 16); }
__device__ __forceinline__ float bfhi(unsigned w) { return __uint_as_float(w & 0xffff0000u); }
__device__ __forceinline__ unsigned short f2bf(float f) { return (unsigned short)(cvt_pk_bf16(f, 0.f) & 0xffffu); }
__device__ __forceinline__ float sigmoidf_(float x) { return 1.f / (1.f + __expf(-x)); }
__device__ __forceinline__ float siluf_(float x) { return x / (1.f + __expf(-x)); }
__device__ __forceinline__ float log_sigmoidf_(float z) { return fminf(z, 0.f) - log1pf(expf(-fabsf(z))); }
template <int CTRL> __device__ __forceinline__ float dpp_mov(float v) { return __int_as_float(__builtin_amdgcn_update_dpp(0, __float_as_int(v), CTRL, 0xF, 0xF, true)); }
__device__ __forceinline__ float wave_sum(float v) {
    v += dpp_mov<0xB1>(v); v += dpp_mov<0x4E>(v); v += dpp_mov<0x141>(v); v += dpp_mov<0x140>(v);
    const float r0 = __int_as_float(__builtin_amdgcn_readlane(__float_as_int(v), 0)), r1 = __int_as_float(__builtin_amdgcn_readlane(__float_as_int(v), 16));
    const float r2 = __int_as_float(__builtin_amdgcn_readlane(__float_as_int(v), 32)), r3 = __int_as_float(__builtin_amdgcn_readlane(__float_as_int(v), 48));
    return (r0 + r1) + (r2 + r3);
}
__device__ __forceinline__ float wave_max(float v) {
    v = fmaxf(v, dpp_mov<0xB1>(v)); v = fmaxf(v, dpp_mov<0x4E>(v)); v = fmaxf(v, dpp_mov<0x141>(v)); v = fmaxf(v, dpp_mov<0x140>(v));
    const float r0 = __int_as_float(__builtin_amdgcn_readlane(__float_as_int(v), 0)), r1 = __int_as_float(__builtin_amdgcn_readlane(__float_as_int(v), 16));
    const float r2 = __int_as_float(__builtin_amdgcn_readlane(__float_as_int(v), 32)), r3 = __int_as_float(__builtin_amdgcn_readlane(__float_as_int(v), 48));
    return fmaxf(fmaxf(r0, r1), fmaxf(r2, r3));
}
__device__ __forceinline__ float wave_min(float v) { return -wave_max(-v); }
__device__ __forceinline__ float xhalf_max(float m) { const auto rr = __builtin_amdgcn_permlane32_swap(__float_as_uint(m), __float_as_uint(m), false, false); return fmaxf(__uint_as_float(rr[0]), __uint_as_float(rr[1])); }
__device__ __forceinline__ float xhalf_sum(float m) { const auto rr = __builtin_amdgcn_permlane32_swap(__float_as_uint(m), __float_as_uint(m), false, false); return __uint_as_float(rr[0]) + __uint_as_float(rr[1]); }
__device__ __forceinline__ bf16x8 pack8f(const f32x4 a, const f32x4 b) { u32x4 w; w.x = cvt_pk_bf16(a[0], a[1]); w.y = cvt_pk_bf16(a[2], a[3]); w.z = cvt_pk_bf16(b[0], b[1]); w.w = cvt_pk_bf16(b[2], b[3]); return __builtin_bit_cast(bf16x8, w); }
__device__ __forceinline__ float fast_tanh(float x) { const float e = __expf(-2.f * fabsf(x)); const float t = (1.f - e) * __builtin_amdgcn_rcpf(1.f + e); return x < 0.f ? -t : t; }
__device__ __forceinline__ void tr_tile(const float* __restrict__ src, size_t ld, int k0, int c0, int nvalid, bf16_t* __restrict__ dst, int K, LAS float* scr, int lane) {
    float tv[64];
#pragma unroll
    for (int kk = 0; kk < 64; ++kk) tv[kk] = src[(size_t)(k0 + kk) * ld + c0 + (lane < nvalid ? lane : 0)];
#pragma unroll
    for (int kk = 0; kk < 64; ++kk) scr[kk * 65 + lane] = (lane < nvalid) ? tv[kk] : 0.f;
    const int nl = lane >> 3, kc8 = (lane & 7) * 8;
#pragma unroll
    for (int it = 0; it < 8; ++it) { const int nn = 8 * it + nl; const LAS float* s = scr + kc8 * 65 + nn;
        u32x4 w; w.x = cvt_pk_bf16(s[0], s[65]); w.y = cvt_pk_bf16(s[130], s[195]); w.z = cvt_pk_bf16(s[260], s[325]); w.w = cvt_pk_bf16(s[390], s[455]);
        *(u32x4*)(dst + (size_t)nn * K + k0 + kc8) = w; }
}
__device__ __forceinline__ void p0_weights(KP p, LAS unsigned char* lds, int gw, int ngw, int wave, int lane) {
    LAS float* scr = (LAS float*)lds + wave * SLOT_F;
    constexpr int T_WIN = (NU / 64) * 32, T_WBR = 4 * 32 * 8, T_WOUT = 32 * 32, T_POOL = 4 * 2 * 2, T_L = T_WIN + T_WBR + T_WOUT + T_POOL;
    for (int it = gw; it < 2 * T_L; it += ngw) {
        const int l = it / T_L; int r = it % T_L;
        if (r < T_WIN) {
            const int nt = r / 32, kt = r % 32, m0 = nt * 64;
            int c0, nvalid = 64;
            if (m0 < 3072) c0 = m0; else if (m0 < U_F) c0 = m0 + 8; else if (m0 == U_F) { c0 = 3072; nvalid = 8; } else { c0 = 0; nvalid = 0; }
            tr_tile(p->in[I_WIN] + (size_t)l * 2048 * IN_W, IN_W, kt * 64, c0, nvalid, (bf16_t*)(p->ws + WS_WIN) + ((size_t)l * NU + m0) * 2048, 2048, scr, lane);
            continue; }
        r -= T_WIN;
        if (r < T_WBR) {
            const int n = r / 256, q = r % 256, nt = q / 8, kt = q % 8;
            tr_tile(p->in[I_WBR] + ((size_t)(l * 4 + n) * 512) * 2048, 2048, kt * 64, nt * 64, 64, (bf16_t*)(p->ws + WS_WBR) + ((size_t)(l * 4 + n) * 2048 + nt * 64) * 512, 512, scr, lane);
            continue; }
        r -= T_WBR;
        if (r < T_WOUT) {
            const int nt = r / 32, kt = r % 32;
            tr_tile(p->in[I_WOUT] + (size_t)l * 2048 * 2048, 2048, kt * 64, nt * 64, 64, (bf16_t*)(p->ws + WS_WOUT) + ((size_t)l * 2048 + nt * 64) * 2048, 2048, scr, lane);
            continue; }
        r -= T_WOUT;
        {
            const int g = r / 4, q = r % 4, nt = q / 2, kt = q % 2;
            tr_tile(p->in[I_POOLW] + (size_t)(l * 4 + g) * 128 * 128, 128, kt * 64, nt * 64, 64, (bf16_t*)(p->ws + WS_POOLW) + ((size_t)(l * 4 + g) * 128 + nt * 64) * 128, 128, scr, lane);
        }
    }
}
__device__ __forceinline__ void ada_unit(KP p, int unit, LAS unsigned char* lds, int tid) {
    const int wave = tid >> 6, lane = tid & 63, l = unit / 96, n0 = (unit % 96) * 64;
    LAS float* cs = (LAS float*)lds + wave * (33 * 64);
    LAS float* red = (LAS float*)lds + 8 * 33 * 64;
    const float* W = p->in[I_WADA] + (size_t)l * 2048 * 6144;
    const float* cp = p->in[I_CP]; const float* csm = p->in[I_CS];
    float acc[33];
#pragma unroll
    for (int s = 0; s < 33; ++s) acc[s] = 0.f;
    float wv[16];
#pragma unroll
    for (int j = 0; j < 16; ++j) wv[j] = W[(size_t)(wave * 256 + j) * 6144 + n0 + lane];
#pragma unroll 1
    for (int step = 0; step < 16; ++step) {
        const int k0 = wave * 256 + step * 16, kn = wave * 256 + (step < 15 ? step + 1 : step) * 16;
        float wn[16];
#pragma unroll
        for (int j = 0; j < 16; ++j) wn[j] = W[(size_t)(kn + j) * 6144 + n0 + lane];
        if ((step & 3) == 0) {
#pragma unroll
            for (int s = 0; s < 33; ++s) { const float c = (s == 0) ? cp[k0 + lane] : csm[(size_t)(s - 1) * 2048 + k0 + lane]; cs[s * 64 + lane] = siluf_(c); } }
        const int kk0 = (step & 3) * 16;
#pragma unroll
        for (int q4 = 0; q4 < 4; ++q4) {
#pragma unroll
            for (int s = 0; s < 33; ++s) { const f32x4 c4 = *(const LAS f32x4*)(cs + s * 64 + kk0 + 4 * q4); acc[s] += c4.x * wv[4 * q4] + c4.y * wv[4 * q4 + 1] + c4.z * wv[4 * q4 + 2] + c4.w * wv[4 * q4 + 3]; } }
#pragma unroll
        for (int j = 0; j < 16; ++j) wv[j] = wn[j];
    }
#pragma unroll
    for (int s = 0; s < 33; ++s) red[(wave * 33 + s) * 64 + lane] = acc[s];
    __syncthreads();
    for (int idx = tid; idx < 33 * 64; idx += 512) { const int s = idx >> 6, n = idx & 63; float v = p->in[I_BADA][l * 6144 + n0 + n];
#pragma unroll
        for (int w = 0; w < 8; ++w) v += red[(w * 33 + s) * 64 + n];
        ((float*)(p->ws + WS_ADA))[((size_t)l * 33 + s) * 6144 + n0 + n] = v; }
    __syncthreads();
}
__device__ __forceinline__ void load_x8(KP p, int l, int row, int lane, f32x4 (&v)[8]) {
    if (row < TP) { const f32x4* x4 = (const f32x4*)(l == 0 ? p->in[I_XP] + (size_t)row * DM : (const float*)(p->ws + WS_XBUF) + (size_t)row * DM) + lane;
#pragma unroll
        for (int j = 0; j < 8; ++j) v[j] = x4[64 * j]; }
    else { const int r = row - TP; const f32x4* x4 = (const f32x4*)(p->in[I_XS] + (size_t)r * DM) + lane;
#pragma unroll
        for (int j = 0; j < 8; ++j) v[j] = x4[64 * j];
        for (int s = 0; s < 8 * l; ++s) { const f32x4* q4 = (const f32x4*)((const float*)(p->ws + WS_XPART) + ((size_t)s * 1024 + r) * DM) + lane;
#pragma unroll
            for (int j = 0; j < 8; ++j) v[j] += q4[64 * j]; } }
}
__device__ __forceinline__ void p1_rows(KP p, int l, int gw, int ngw, int lane) {
    const f32x4* g4 = (const f32x4*)(p->in[I_NORMG] + l * DM) + lane;
    f32x4 a[8], sh[8]; int cur_seq = -1;
    for (int row = gw; row < NTOK; row += ngw) {
        const int seq = row < TP ? 0 : 1 + ((row - TP) >> 5);
        f32x4 v[8]; float ss = 0.f; load_x8(p, l, row, lane, v);
#pragma unroll
        for (int j = 0; j < 8; ++j) { ss += (v[j].x * v[j].x + v[j].y * v[j].y) + (v[j].z * v[j].z + v[j].w * v[j].w); }
        if (seq != cur_seq) { cur_seq = seq;
            const f32x4* sh4 = (const f32x4*)((const float*)(p->ws + WS_ADA) + ((size_t)l * 33 + seq) * 6144) + lane; const f32x4* sc4 = sh4 + 512;
#pragma unroll
            for (int j = 0; j < 8; ++j) { a[j] = g4[64 * j] * (sc4[64 * j] + 1.f); sh[j] = sh4[64 * j]; } }
        const float rstd = 1.f / sqrtf(wave_sum(ss) * (1.f / DM) + 1e-6f);
        u32x2* o = (u32x2*)((bf16_t*)(p->ws + WS_H) + (size_t)row * DM) + lane;
#pragma unroll
        for (int j = 0; j < 8; ++j) { const f32x4 y = v[j] * rstd * a[j] + sh[j];
            u32x2 w; w.x = cvt_pk_bf16(y.x, y.y); w.y = cvt_pk_bf16(y.z, y.w); o[64 * j] = w; }
    }
}
__device__ __forceinline__ void p_final_rows(KP p, int gw, int ngw, int lane) {
    const f32x4* g4 = (const f32x4*)p->in[I_FING] + lane;
    for (int row = gw; row < NTOK; row += ngw) {
        f32x4 v[8]; float ss = 0.f; load_x8(p, 2, row, lane, v);
#pragma unroll
        for (int j = 0; j < 8; ++j) { ss += (v[j].x * v[j].x + v[j].y * v[j].y) + (v[j].z * v[j].z + v[j].w * v[j].w); }
        const float rstd = 1.f / sqrtf(wave_sum(ss) * (1.f / DM) + 1e-6f);
        f32x4* o = (f32x4*)(p->out + O_YP + (size_t)row * DM) + lane;
#pragma unroll
        for (int j = 0; j < 8; ++j) o[64 * j] = v[j] * rstd * g4[64 * j];
    }
}
struct EpiU {
    static constexpr bool PERM = true, AFTER_DRAIN = false;
    bf16_t* U; float* out; const float* bf; int l;
    __device__ __forceinline__ void operator()(const f32x4 (&acc)[2][2][4][2], const pg8::Unit& u, int wr, int wc, int fr, int fq) const {
        const int row0 = u.pm * 256 + wr * 64 + fr, col0 = u.pn * 256 + wc * 32 + 8 * fq;
#pragma unroll
        for (int ai = 0; ai < 2; ++ai)
#pragma unroll
            for (int m = 0; m < 4; ++m) { bf16_t* rowp = U + (size_t)(row0 + ai * 128 + m * 16) * NU + col0;
#pragma unroll
                for (int bj = 0; bj < 2; ++bj) { const f32x4 v0 = acc[ai][bj][m][0], v1 = acc[ai][bj][m][1];
                    u32x4 w; w.x = cvt_pk_bf16(v0[0], v0[1]); w.y = cvt_pk_bf16(v0[2], v0[3]); w.z = cvt_pk_bf16(v1[0], v1[1]); w.w = cvt_pk_bf16(v1[2], v1[3]);
                    *(u32x4*)(rowp + bj * 128) = w; } }
        if (u.pn >= 8 && u.pn < 12) {
            const bool isv = u.pn >= 10; const int cin = (u.pn - (isv ? 10 : 8)) * 256 + wc * 32 + 8 * fq;
#pragma unroll
            for (int ai = 0; ai < 2; ++ai)
#pragma unroll
                for (int m = 0; m < 4; ++m) { const int row = row0 + ai * 128 + m * 16;
                    float* dst = row < TP ? out + (isv ? O_PV : O_PK) + ((size_t)l * TP + row) * 512 : out + (isv ? O_SV : O_SK) + ((size_t)l * 1024 + (row - TP)) * 512;
#pragma unroll
                    for (int bj = 0; bj < 2; ++bj) { *(f32x4*)(dst + cin + bj * 128) = acc[ai][bj][m][0]; *(f32x4*)(dst + cin + bj * 128 + 4) = acc[ai][bj][m][1]; } }
        }
        if (u.pn == 58 && wc == 0 && fq == 0) {
            const f32x4 b0 = *(const f32x4*)(bf + l * 8), b1 = *(const f32x4*)(bf + l * 8 + 4);
#pragma unroll
            for (int ai = 0; ai < 2; ++ai)
#pragma unroll
                for (int m = 0; m < 4; ++m) { const int row = row0 + ai * 128 + m * 16;
                    float* dst = row < TP ? out + O_PLF + ((size_t)l * TP + row) * 8 : out + O_SLF + ((size_t)l * 1024 + (row - TP)) * 8;
                    const f32x4 z0 = acc[ai][1][m][0] + b0, z1 = acc[ai][1][m][1] + b1; f32x4 o0, o1;
#pragma unroll
                    for (int e = 0; e < 4; ++e) { o0[e] = log_sigmoidf_(z0[e]); o1[e] = log_sigmoidf_(z1[e]); }
                    *(f32x4*)dst = o0; *(f32x4*)(dst + 4) = o1; }
        }
    }
};
struct BranchOrder {
    int G, c;
    __device__ __forceinline__ bool next(int i, pg8::Unit& u) const { const int L = i * G + c; if (L >= 4 * 544) return false; const int n = L / 544, t = L - n * 544; u.pm = n * 68 + (t >> 3); u.pn = n * 8 + (t & 7); return true; }
    __device__ __forceinline__ void a_ready(const pg8::Unit&) const {}
    __device__ __forceinline__ void done(const pg8::Unit&) const {}
};
struct EpiZ {
    static constexpr bool PERM = true, AFTER_DRAIN = false;
    bf16_t* Z; const bf16_t* U;
    __device__ __forceinline__ void operator()(const f32x4 (&acc)[2][2][4][2], const pg8::Unit& u, int wr, int wc, int fr, int fq) const {
        const int row0 = u.pm * 256 + wr * 64 + fr, col0 = (u.pn & 7) * 256 + wc * 32 + 8 * fq;
#pragma unroll
        for (int ai = 0; ai < 2; ++ai)
#pragma unroll
            for (int m = 0; m < 4; ++m) { bf16_t* rowp = Z + (size_t)(row0 + ai * 128 + m * 16) * DM + col0;
#pragma unroll
                for (int bj = 0; bj < 2; ++bj) { const f32x4 v0 = acc[ai][bj][m][0], v1 = acc[ai][bj][m][1];
                    u32x4 w; w.x = cvt_pk_bf16(v0[0], v0[1]); w.y = cvt_pk_bf16(v0[2], v0[3]); w.z = cvt_pk_bf16(v1[0], v1[1]); w.w = cvt_pk_bf16(v1[2], v1[3]);
                    *(u32x4*)(rowp + bj * 128) = w; } }
    }
};
__device__ __forceinline__ void merge_pass(KP p, int l, int gtid, int ngt) {
    const bf16_t* U = (const bf16_t*)(p->ws + WS_U); const bf16_t* Z = (const bf16_t*)(p->ws + WS_Z); bf16_t* M = (bf16_t*)(p->ws + WS_MERGED);
    for (int it0 = gtid; it0 < NTOK * 256; it0 += 3 * ngt) {
        u32x4 gv[3][4], zv[3][4];
#pragma unroll
        for (int k = 0; k < 3; ++k) { const int it = it0 + k * ngt < NTOK * 256 ? it0 + k * ngt : it0; const int row = it >> 8, col = (it & 255) * 8;
#pragma unroll
            for (int n = 0; n < 4; ++n) { gv[k][n] = *(const u32x4*)(U + (size_t)row * NU + U_G + n * 2048 + col); zv[k][n] = *(const u32x4*)(Z + ((size_t)n * NTOK + row) * DM + col); } }
#pragma unroll
        for (int k = 0; k < 3; ++k) { const int it = it0 + k * ngt; if (it < NTOK * 256) { const int row = it >> 8, col = (it & 255) * 8;
            float s[8];
#pragma unroll
            for (int e = 0; e < 8; ++e) s[e] = 0.f;
#pragma unroll
            for (int n = 0; n < 4; ++n) { const u32x4 g = gv[k][n], z = zv[k][n];
                s[0] += sigmoidf_(bflo(g.x)) * bflo(z.x); s[1] += sigmoidf_(bfhi(g.x)) * bfhi(z.x); s[2] += sigmoidf_(bflo(g.y)) * bflo(z.y); s[3] += sigmoidf_(bfhi(g.y)) * bfhi(z.y);
                s[4] += sigmoidf_(bflo(g.z)) * bflo(z.z); s[5] += sigmoidf_(bfhi(g.z)) * bfhi(z.z); s[6] += sigmoidf_(bflo(g.w)) * bflo(z.w); s[7] += sigmoidf_(bfhi(g.w)) * bfhi(z.w); }
            u32x4 w; w.x = cvt_pk_bf16(s[0], s[1]); w.y = cvt_pk_bf16(s[2], s[3]); w.z = cvt_pk_bf16(s[4], s[5]); w.w = cvt_pk_bf16(s[6], s[7]);
            *(u32x4*)(M + (size_t)row * DM + col) = w; } }
    }
}
struct EpiOut {
    static constexpr bool PERM = false, AFTER_DRAIN = false;
    const float* xp; const float* xs; const float* xb; const float* ada; float* xout; int l;
    __device__ __forceinline__ void operator()(const f32x4 (&acc)[2][2][4][2], const pg8::Unit& u, int wr, int wc, int fr, int fq) const {
        const int row0 = u.pm * 256 + wr * 64 + fr, col0 = u.pn * 256 + wc * 32 + 4 * fq;
        f32x4 gt[2][2];
#pragma unroll
        for (int ai = 0; ai < 2; ++ai)
#pragma unroll
            for (int mp = 0; mp < 4; mp += 2) {
                f32x4 bs[2][2][2], gv[2][2][2];
#pragma unroll
                for (int mm = 0; mm < 2; ++mm) { const int row = row0 + ai * 128 + (mp + mm) * 16;
                    const float* base = l == 0 ? (row < TP ? xp + (size_t)row * DM : xs + (size_t)(row - TP) * DM) : xb + (size_t)row * DM;
                    const float* gate = ada + ((size_t)l * 33 + (row < TP ? 0 : 1 + ((row - TP) >> 5))) * 6144 + 4096;
#pragma unroll
                    for (int bj = 0; bj < 2; ++bj)
#pragma unroll
                        for (int n = 0; n < 2; ++n) { const int col = col0 + bj * 128 + n * 16; bs[mm][bj][n] = *(const f32x4*)(base + col); gv[mm][bj][n] = *(const f32x4*)(gate + col); } }
#pragma unroll
                for (int mm = 0; mm < 2; ++mm) { const int row = row0 + ai * 128 + (mp + mm) * 16;
#pragma unroll
                    for (int bj = 0; bj < 2; ++bj)
#pragma unroll
                        for (int n = 0; n < 2; ++n) { const int col = col0 + bj * 128 + n * 16; *(f32x4*)(xout + (size_t)row * DM + col) = bs[mm][bj][n] + gv[mm][bj][n] * acc[ai][bj][mp + mm][n]; } }
            }
        (void)gt;
    }
};
struct OneUnit {
    int pm, pn; bool valid;
    __device__ __forceinline__ bool next(int i, pg8::Unit& u) const { if (i > 0 || !valid) return false; u.pm = pm; u.pn = pn; return true; }
    __device__ __forceinline__ void a_ready(const pg8::Unit&) const {}
    __device__ __forceinline__ void done(const pg8::Unit&) const {}
};
struct EpiOutPart {
    static constexpr bool PERM = false, AFTER_DRAIN = false;
    const float* ada; float* part; int l;
    __device__ __forceinline__ void operator()(const f32x4 (&acc)[2][2][4][2], const pg8::Unit& u, int wr, int wc, int fr, int fq) const {
        const int row0 = u.pm * 256 + wr * 64 + fr - TP, col0 = u.pn * 256 + wc * 32 + 4 * fq;
#pragma unroll
        for (int ai = 0; ai < 2; ++ai)
#pragma unroll
            for (int m = 0; m < 4; ++m) { const int r = row0 + ai * 128 + m * 16;
                const float* gate = ada + ((size_t)l * 33 + 1 + (r >> 5)) * 6144 + 4096;
#pragma unroll
                for (int bj = 0; bj < 2; ++bj)
#pragma unroll
                    for (int n = 0; n < 2; ++n) { const int col = col0 + bj * 128 + n * 16; *(f32x4*)(part + (size_t)r * DM + col) = *(const f32x4*)(gate + col) * acc[ai][bj][m][n]; } }
    }
};
constexpr int CGS = 516;
__device__ __forceinline__ void conv_unit(KP p, int l, int tile, LAS unsigned char* lds, int tid) {
    const bf16_t* U = (const bf16_t*)(p->ws + WS_U);
    const int c = tid, wave = tid >> 6, lane = tid & 63;
    const bool samp = tile >= 512; const int b = tile - 512, row0 = samp ? TP + b * 32 : tile * 32;
    const bool last = samp || tile == 511;
    LAS float* gl = (LAS float*)lds;
    LAS bf16_t* sgl = (LAS bf16_t*)(lds + 62 * CGS * 4);
    LAS float* red = (LAS float*)(lds + 62 * CGS * 4 + 32 * 512 * 2);
    LAS float* st = red + 8 * 32;
#pragma unroll
    for (int k = 0; k < 8; ++k) { const int task = tid + 512 * k; if (task < 62 * 64) { const int i = task >> 6, ch = task & 63; f32x4 o0, o1;
        const int rel = i - 30;
        if (rel < 0 && samp) { const float* hp = p->in[I_SCONV] + (((size_t)l * 32 + b) * 30 + i) * 512 + 8 * ch; o0 = *(const f32x4*)hp; o1 = *(const f32x4*)(hp + 4); }
        else if (row0 + rel < 0) { o0 = (f32x4){0.f, 0.f, 0.f, 0.f}; o1 = o0; }
        else { const bf16_t* up = U + (size_t)(row0 + rel) * NU + 8 * ch; const u32x4 v = *(const u32x4*)(up + U_AVAL), g = *(const u32x4*)(up + U_AGATE);
            o0 = (f32x4){bflo(v.x) * sigmoidf_(bflo(g.x)), bfhi(v.x) * sigmoidf_(bfhi(g.x)), bflo(v.y) * sigmoidf_(bflo(g.y)), bfhi(v.y) * sigmoidf_(bfhi(g.y))};
            o1 = (f32x4){bflo(v.z) * sigmoidf_(bflo(g.z)), bfhi(v.z) * sigmoidf_(bfhi(g.z)), bflo(v.w) * sigmoidf_(bflo(g.w)), bfhi(v.w) * sigmoidf_(bfhi(g.w))}; }
        *(LAS f32x4*)(gl + i * CGS + 8 * ch) = o0; *(LAS f32x4*)(gl + i * CGS + 8 * ch + 4) = o1; } }
#pragma unroll
    for (int k = 0; k < 4; ++k) { const int task = tid + 512 * k, t = task >> 6, ch = task & 63; const u32x4 s = *(const u32x4*)(U + (size_t)(row0 + t) * NU + U_ASG + 8 * ch);
        u32x4 w; w.x = cvt_pk_bf16(siluf_(bflo(s.x)), siluf_(bfhi(s.x))); w.y = cvt_pk_bf16(siluf_(bflo(s.y)), siluf_(bfhi(s.y))); w.z = cvt_pk_bf16(siluf_(bflo(s.z)), siluf_(bfhi(s.z))); w.w = cvt_pk_bf16(siluf_(bflo(s.w)), siluf_(bfhi(s.w)));
        *(LAS u32x4*)(sgl + t * 512 + 8 * ch) = w; }
    const float cb = p->in[I_CONVB][l * 512 + c], lg = p->in[I_CLNG][l * 512 + c], lb = p->in[I_CLNB][l * 512 + c];
    float wk[31];
#pragma unroll
    for (int k = 0; k < 31; ++k) wk[k] = p->in[I_CONVW][((size_t)l * 31 + k) * 512 + c];
    __syncthreads();
    if (last) {
        float* dst = samp ? p->out + O_SCONV + (((size_t)l * 32 + b) * 30) * 512 + c : p->out + O_PCONV + ((size_t)l * 30) * 512 + c;
#pragma unroll
        for (int t = 2; t < 32; ++t) dst[(size_t)(t - 2) * 512] = gl[(30 + t) * CGS + c];
    }
    bf16_t* oa = (bf16_t*)(p->ws + WS_OCAT);
#pragma unroll 1
    for (int half = 0; half < 2; ++half) {
        float z[46];
#pragma unroll
        for (int i = 0; i < 46; ++i) z[i] = gl[(16 * half + i) * CGS + c];
        float hv[16];
#pragma unroll
        for (int tt = 0; tt < 16; ++tt) hv[tt] = cb;
#pragma unroll
        for (int k = 0; k < 31; ++k) {
#pragma unroll
            for (int tt = 0; tt < 16; ++tt) hv[tt] += z[tt + k] * wk[k]; }
#pragma unroll
        for (int tt = 0; tt < 16; ++tt) { const float s1 = wave_sum(hv[tt]), s2 = wave_sum(hv[tt] * hv[tt]); if (lane == 0) { red[(wave * 16 + tt) * 2] = s1; red[(wave * 16 + tt) * 2 + 1] = s2; } }
        __syncthreads();
        if (tid < 16) { float s1 = 0.f, s2 = 0.f;
#pragma unroll
            for (int w = 0; w < 8; ++w) { s1 += red[(w * 16 + tid) * 2]; s2 += red[(w * 16 + tid) * 2 + 1]; }
            const float mean = s1 * (1.f / 512.f), var = fmaxf(s2 * (1.f / 512.f) - mean * mean, 0.f);
            st[tid * 2] = mean; st[tid * 2 + 1] = 1.f / sqrtf(var + 1e-5f); }
        __syncthreads();
#pragma unroll
        for (int tt = 0; tt < 16; ++tt) { const float y = (hv[tt] - st[tt * 2]) * st[tt * 2 + 1] * lg + lb; const int t = 16 * half + tt;
            oa[(size_t)(row0 + t) * 512 + c] = f2bf(siluf_(y) * bf2f(sgl[t * 512 + c])); }
    }
    __syncthreads();
}
__device__ __forceinline__ void pool_unit(KP p, int l, int tile, LAS unsigned char* lds, int tid) {
    const bf16_t* U = (const bf16_t*)(p->ws + WS_U);
    const int c = tid, wave = tid >> 6, lane = tid & 63;
    const bool samp = tile >= 512; const int b = tile - 512, row0 = samp ? TP + b * 32 : tile * 32;
    constexpr int PST = 520;
    LAS float* zl = (LAS float*)lds;
    LAS bf16_t* pl = (LAS bf16_t*)(lds + 47 * CGS * 4);
#pragma unroll
    for (int k = 0; k < 6; ++k) { const int task = tid + 512 * k; if (task < 47 * 64) { const int i = task >> 6, ch = task & 63; f32x4 o0, o1; const int rel = i - 15;
        if (rel < 0 && samp) { const float* hp = p->in[I_SPOOL] + (((size_t)l * 32 + b) * 15 + i) * 512 + 8 * ch; o0 = *(const f32x4*)hp; o1 = *(const f32x4*)(hp + 4); }
        else if (row0 + rel < 0) { o0 = (f32x4){0.f, 0.f, 0.f, 0.f}; o1 = o0; }
        else { const u32x4 v = *(const u32x4*)(U + (size_t)(row0 + rel) * NU + U_DIN + 8 * ch); o0 = (f32x4){bflo(v.x), bfhi(v.x), bflo(v.y), bfhi(v.y)}; o1 = (f32x4){bflo(v.z), bfhi(v.z), bflo(v.w), bfhi(v.w)}; }
        *(LAS f32x4*)(zl + i * CGS + 8 * ch) = o0; *(LAS f32x4*)(zl + i * CGS + 8 * ch + 4) = o1; } }
    u32x4 sgv[4];
#pragma unroll
    for (int k = 0; k < 4; ++k) { const int task = tid + 512 * k; sgv[k] = *(const u32x4*)(U + (size_t)(row0 + (task >> 6)) * NU + U_DSG + 8 * (task & 63)); }
    __syncthreads();
    {
        float z[47];
#pragma unroll
        for (int i = 0; i < 47; ++i) z[i] = zl[i * CGS + c];
        if (samp || tile == 511) {
            float* dst = samp ? p->out + O_SPOOL + (((size_t)l * 32 + b) * 15) * 512 + c : p->out + O_PPOOL + ((size_t)l * 15) * 512 + c;
#pragma unroll
            for (int t = 17; t < 32; ++t) dst[(size_t)(t - 17) * 512] = z[15 + t];
        }
        const int w = 2 << (c >> 7);
#pragma unroll
        for (int t = 0; t < 32; ++t) { float s = 0.f;
#pragma unroll
            for (int i = 0; i < 16; ++i) s += (i < w) ? z[15 + t - i] : 0.f;
            const int pos = samp ? PAST + t : row0 + t; const int cnt = (pos + 1 < w) ? pos + 1 : w;
            pl[t * PST + c] = f2bf(s / (float)cnt - z[15 + t]); }
    }
    __syncthreads();
    LAS bf16_t* sl = (LAS bf16_t*)lds;
    LAS bf16_t* ol = sl + 32 * PST;
#pragma unroll
    for (int k = 0; k < 4; ++k) { const int task = tid + 512 * k, t = task >> 6, ch = task & 63; const u32x4 s = sgv[k];
        u32x4 w; w.x = cvt_pk_bf16(siluf_(bflo(s.x)), siluf_(bfhi(s.x))); w.y = cvt_pk_bf16(siluf_(bflo(s.y)), siluf_(bfhi(s.y))); w.z = cvt_pk_bf16(siluf_(bflo(s.z)), siluf_(bfhi(s.z))); w.w = cvt_pk_bf16(siluf_(bflo(s.w)), siluf_(bfhi(s.w)));
        *(LAS u32x4*)(sl + t * PST + 8 * ch) = w; }
    __syncthreads();
    {
        const int g = wave >> 1, fr = lane & 15, kq = lane >> 4;
        const bf16_t* WT = (const bf16_t*)(p->ws + WS_POOLW) + (size_t)(l * 4 + g) * 128 * 128;
        f32x4 acc[2][4];
#pragma unroll
        for (int mt = 0; mt < 2; ++mt)
#pragma unroll
            for (int nt = 0; nt < 4; ++nt) acc[mt][nt] = (f32x4){0.f, 0.f, 0.f, 0.f};
#pragma unroll
        for (int ks = 0; ks < 4; ++ks) {
            bf16x8 af[2];
#pragma unroll
            for (int mt = 0; mt < 2; ++mt) af[mt] = *(const LAS bf16x8*)(pl + (16 * mt + fr) * PST + g * 128 + 32 * ks + 8 * kq);
#pragma unroll
            for (int nt = 0; nt < 4; ++nt) { const int dl = (wave & 1) * 64 + 16 * nt + fr;
                const bf16x8 bfr = *(const bf16x8*)(WT + (size_t)dl * 128 + 32 * ks + 8 * kq);
#pragma unroll
                for (int mt = 0; mt < 2; ++mt) acc[mt][nt] = __builtin_amdgcn_mfma_f32_16x16x32_bf16(af[mt], bfr, acc[mt][nt], 0, 0, 0); }
        }
#pragma unroll
        for (int nt = 0; nt < 4; ++nt) { const int d = wave * 64 + 16 * nt + fr; const float pb = p->in[I_POOLB][l * 512 + d], ps = p->in[I_POOLS][l * 512 + d];
#pragma unroll
            for (int mt = 0; mt < 2; ++mt)
#pragma unroll
                for (int r = 0; r < 4; ++r) { const int t = 16 * mt + 4 * kq + r; ol[t * PST + d] = f2bf((acc[mt][nt][r] + pb) * ps * bf2f(sl[t * PST + d])); } }
    }
    __syncthreads();
    bf16_t* od = (bf16_t*)(p->ws + WS_OCAT) + (size_t)3 * NTOK * 512;
#pragma unroll
    for (int k = 0; k < 4; ++k) { const int task = tid + 512 * k, t = task >> 6, ch = task & 63; *(u32x4*)(od + (size_t)(row0 + t) * 512 + 8 * ch) = *(const LAS u32x4*)(ol + t * PST + 8 * ch); }
    __syncthreads();
}
__device__ __forceinline__ void fp_unit(KP p, int l, int h, LAS unsigned char* lds, int tid) {
    const float* lf = p->out + O_PLF + (size_t)l * TP * 8 + h;
    LAS float* part = (LAS float*)lds;
    float v[32]; float s = 0.f;
#pragma unroll
    for (int i = 0; i < 32; ++i) { v[i] = lf[(size_t)(tid * 32 + i) * 8]; s += v[i]; }
    part[tid] = s;
    __syncthreads();
    float pre = 0.f;
    for (int j = 0; j < tid; ++j) pre += part[j];
    float* F = (float*)(p->ws + WS_FP) + (size_t)h * TP + tid * 32;
#pragma unroll
    for (int i = 0; i < 32; ++i) { pre += v[i]; F[i] = pre * LOG2E; }
    __syncthreads();
}
__device__ __forceinline__ void gs_unit(KP p, int l, int b, LAS unsigned char* lds, int tid) {
    const int h = tid & 7, ch = tid >> 3;
    const float* cl = p->in[I_CLF] + (((size_t)l * 32 + b) * PAST + ch * 64) * 8 + h;
    LAS float* part = (LAS float*)lds;
    float v[64]; float s = 0.f;
#pragma unroll
    for (int i = 0; i < 64; ++i) v[i] = cl[(size_t)i * 8];
#pragma unroll
    for (int i = 0; i < 64; ++i) s += v[i];
    part[ch * 8 + h] = s;
    __syncthreads();
    float suf = 0.f;
    for (int j = ch + 1; j < 64; ++j) suf += part[j * 8 + h];
    float* G = (float*)(p->ws + WS_GS) + ((size_t)b * 8 + h) * GS_LEN + ch * 64;
#pragma unroll
    for (int i = 63; i >= 0; --i) { G[i] = -suf * LOG2E; suf += v[i]; }
    if (tid < 8) { const float* nl = p->out + O_SLF + ((size_t)l * 1024 + b * 32) * 8 + tid; float* Gn = (float*)(p->ws + WS_GS) + ((size_t)b * 8 + tid) * GS_LEN + PAST; float w[32]; float run = 0.f;
#pragma unroll
        for (int i = 0; i < 32; ++i) w[i] = nl[i * 8];
#pragma unroll
        for (int i = 0; i < 32; ++i) { run += w[i]; Gn[i] = run * LOG2E; } }
    __syncthreads();
}
__device__ __forceinline__ void vt_tile(KP p, int l, int tile, LAS unsigned char* lds, int wave, int lane) {
    const int h = tile >> 8, tb = tile & 255, tl = lane >> 3, q8 = (lane & 7) * 8;
    const bf16_t* U = (const bf16_t*)(p->ws + WS_U);
    LAS unsigned short* scr = (LAS unsigned short*)(lds + wave * (64 * 72 * 2));
    u32x4 kv[8], vv[8];
#pragma unroll
    for (int i = 0; i < 8; ++i) { const bf16_t* rp = U + (size_t)(tb * 64 + 8 * i + tl) * NU + h * 64 + q8; kv[i] = *(const u32x4*)(rp + U_K); vv[i] = *(const u32x4*)(rp + U_V); }
    float mx = 0.f;
#pragma unroll
    for (int i = 0; i < 8; ++i) { const u32x4 w = kv[i];
        float s = bflo(w.x) * bflo(w.x) + bfhi(w.x) * bfhi(w.x) + bflo(w.y) * bflo(w.y) + bfhi(w.y) * bfhi(w.y) + bflo(w.z) * bflo(w.z) + bfhi(w.z) * bfhi(w.z) + bflo(w.w) * bflo(w.w) + bfhi(w.w) * bfhi(w.w);
        s += dpp_mov<0xB1>(s); s += dpp_mov<0x4E>(s); s += dpp_mov<0x141>(s); mx = fmaxf(mx, s); }
    mx = wave_max(mx);
    if (lane == 0) atomicMax((unsigned*)(p->ws + WS_CTL) + CW_KMAX + l * 8 + h, __float_as_uint(mx));
#pragma unroll
    for (int i = 0; i < 8; ++i) { const int t = 8 * i + tl; const u32x4 w = vv[i];
        scr[(q8 + 0) * 72 + t] = (unsigned short)(w.x & 0xffffu); scr[(q8 + 1) * 72 + t] = (unsigned short)(w.x >> 16); scr[(q8 + 2) * 72 + t] = (unsigned short)(w.y & 0xffffu); scr[(q8 + 3) * 72 + t] = (unsigned short)(w.y >> 16);
        scr[(q8 + 4) * 72 + t] = (unsigned short)(w.z & 0xffffu); scr[(q8 + 5) * 72 + t] = (unsigned short)(w.z >> 16); scr[(q8 + 6) * 72 + t] = (unsigned short)(w.w & 0xffffu); scr[(q8 + 7) * 72 + t] = (unsigned short)(w.w >> 16); }
    bf16_t* Vt = (bf16_t*)(p->ws + WS_VT) + ((size_t)h * 64 + lane) * TP + tb * 64;
#pragma unroll
    for (int j = 0; j < 8; ++j) *(u32x4*)(Vt + 8 * j) = *(const LAS u32x4*)(scr + lane * 72 + 8 * j);
}
__device__ __forceinline__ void shift_out(KP p, int l, int tid) {
    const bf16_t* U = (const bf16_t*)(p->ws + WS_U);
    for (int base = tid; base < NSEQ * SHIFT_W; base += 512 * 8) {
        unsigned short v[8];
#pragma unroll
        for (int k = 0; k < 8; ++k) { const int idx = base + k * 512 < NSEQ * SHIFT_W ? base + k * 512 : tid; const int s = idx / SHIFT_W, j = idx - s * SHIFT_W; const int row = s == 0 ? TP - 1 : TP + (s - 1) * 32 + 31; v[k] = U[(size_t)row * NU + U_XC + j]; }
#pragma unroll
        for (int k = 0; k < 8; ++k) { const int idx = base + k * 512; if (idx < NSEQ * SHIFT_W) { const int s = idx / SHIFT_W, j = idx - s * SHIFT_W;
            float* dst = s == 0 ? p->out + O_PSHIFT + (size_t)l * SHIFT_W + j : p->out + O_SSHIFT + ((size_t)l * 32 + (s - 1)) * SHIFT_W + j; *dst = bf2f(v[k]); } }
    }
}
template <bool AT, bool BT, bool NEGA>
__device__ __forceinline__ void mm32(f32x16& acc, const LAS float* Ap, int i0, const LAS float* Bp, int j0, int lane) {
    const int li = lane & 31, kh = lane >> 5;
    const LAS float* ap = AT ? Ap + (8 * kh) * 65 + i0 + li : Ap + (i0 + li) * 65 + 8 * kh;
    const LAS float* bp = BT ? Bp + (j0 + li) * 65 + 8 * kh : Bp + (8 * kh) * 65 + j0 + li;
#pragma unroll 1
    for (int s = 0; s < 4; ++s) {
        float a[8], b[8];
#pragma unroll
        for (int e = 0; e < 8; ++e) { a[e] = AT ? ap[(16 * s + e) * 65] : ap[16 * s + e]; b[e] = BT ? bp[16 * s + e] : bp[(16 * s + e) * 65]; }
        if (NEGA) {
#pragma unroll
            for (int e = 0; e < 8; ++e) a[e] = -a[e]; }
        const bf16x8 af = pack8f((f32x4){a[0], a[1], a[2], a[3]}, (f32x4){a[4], a[5], a[6], a[7]}), bfg = pack8f((f32x4){b[0], b[1], b[2], b[3]}, (f32x4){b[4], b[5], b[6], b[7]});
        acc = __builtin_amdgcn_mfma_f32_32x32x16_bf16(af, bfg, acc, 0, 0, 0);
    }
}
template <int MASK>
__device__ __forceinline__ void st_tile(LAS float* dst, const f32x16& acc, int i0, int j0, int lane) {
    const int li = lane & 31, hi = lane >> 5, j = j0 + li;
#pragma unroll
    for (int r = 0; r < 16; ++r) { const int i = i0 + (r & 3) + 8 * (r >> 2) + 4 * hi; float v = acc[r];
        if (MASK == 1 && !(i < j)) v = 0.f; if (MASK == 2 && !(i <= j)) v = 0.f; dst[i * 65 + j] = v; }
}
struct RwkvSeqInfo { int row0, ntok, prev_kind  , b; };
__device__ __forceinline__ RwkvSeqInfo rwkv_info(int cu) { RwkvSeqInfo s; if (cu < 256) { s.row0 = cu * 64; s.ntok = 64; s.prev_kind = cu == 0 ? 0 : 1; s.b = 0; } else { s.b = cu - 256; s.row0 = TP + s.b * 32; s.ntok = 32; s.prev_kind = 2; } return s; }

__device__ __forceinline__ void rwkv_r1(KP p, int l, int unit, LAS unsigned char* lds, int tid) {
    const int cu = unit >> 3, h = unit & 7, wave = tid >> 6, lane = tid & 63, li = lane & 31, hi = lane >> 5;
    const RwkvSeqInfo si = rwkv_info(cu);
    const bf16_t* U = (const bf16_t*)(p->ws + WS_U);
    LAS float* S0 = (LAS float*)lds; LAS float *S1 = S0 + SLOT_F, *S2 = S0 + 2 * SLOT_F, *S3 = S0 + 3 * SLOT_F, *S4 = S0 + 4 * SLOT_F, *S5 = S0 + 5 * SLOT_F, *S6 = S0 + 6 * SLOT_F, *S7 = S0 + 7 * SLOT_F, *S8 = S0 + 8 * SLOT_F;
    LAS float* gC = S0 + 9 * SLOT_F;
    const int q = wave >> 2, wq = wave & 3, i0 = (wq >> 1) * 32, j0 = (wq & 1) * 32;
    PT0();
    {
        const int j = tid & 63, tq = tid >> 6;
        const int tl = lane >> 3, q8 = (lane & 7) * 8;
#pragma unroll
        for (int kb = 0; kb < 5; kb += 3) {
        u32x4 cur[5], prv[5];
#pragma unroll
        for (int k = kb; k < (kb + 3 < 5 ? kb + 3 : 5); ++k) { const int pid = wave * 5 + k, s = pid >> 3, tb = pid & 7, t = tb * 8 + tl;
            const int xo = (s < 3 ? s * 512 + h * 64 : 1536 + (s - 3) * 64) + q8;
            const int tc = t < si.ntok ? t : si.ntok - 1, tp = tc > 0 ? tc - 1 : (si.prev_kind == 1 ? -1 : 0);
            cur[k] = *(const u32x4*)(U + (size_t)(si.row0 + tc) * NU + U_XC + xo); prv[k] = *(const u32x4*)(U + (size_t)(si.row0 + tp) * NU + U_XC + xo); }
#pragma unroll
        for (int k = kb; k < (kb + 3 < 5 ? kb + 3 : 5); ++k) { const int pid = wave * 5 + k, s = pid >> 3, tb = pid & 7, t = tb * 8 + tl;
            const int xo = (s < 3 ? s * 512 + h * 64 : 1536 + (s - 3) * 64) + q8;
            LAS float* dst = (s == 0 ? S0 : s == 1 ? S1 : s == 2 ? S2 : s == 3 ? S3 : S4) + t * 65 + q8;
            const f32x4 m0 = *(const f32x4*)(p->in[I_MU] + l * SHIFT_W + xo), m1 = *(const f32x4*)(p->in[I_MU] + l * SHIFT_W + xo + 4);
            float x[8] = {bflo(cur[k].x), bfhi(cur[k].x), bflo(cur[k].y), bfhi(cur[k].y), bflo(cur[k].z), bfhi(cur[k].z), bflo(cur[k].w), bfhi(cur[k].w)};
            float pv[8] = {bflo(prv[k].x), bfhi(prv[k].x), bflo(prv[k].y), bfhi(prv[k].y), bflo(prv[k].z), bfhi(prv[k].z), bflo(prv[k].w), bfhi(prv[k].w)};
            if (t == 0 && si.prev_kind != 1) {
                if (si.prev_kind == 2) { const float* sp = p->in[I_SSHIFT] + ((size_t)l * 32 + si.b) * SHIFT_W + xo;
#pragma unroll
                    for (int e = 0; e < 8; ++e) pv[e] = sp[e]; }
                else {
#pragma unroll
                    for (int e = 0; e < 8; ++e) pv[e] = 0.f; } }
#pragma unroll
            for (int e = 0; e < 8; ++e) { const float mu = e < 4 ? m0[e] : m1[e - 4]; float xs = (t < si.ntok) ? x[e] + (pv[e] - x[e]) * mu : 0.f; if (s == 3) xs = fast_tanh(xs); dst[e] = xs; }
        }
        }
#pragma unroll
        for (int mm = 0; mm < 8; ++mm) { const int m = tq * 8 + mm;
            S5[m * 65 + j] = p->in[I_W2][((size_t)l * 64 + m) * 512 + h * 64 + j]; S6[m * 65 + j] = p->in[I_A2][((size_t)l * 64 + m) * 512 + h * 64 + j]; }
    }
    __syncthreads();
    PT1(1);
    {
        f32x16 acc = {};
        const int c = j0 + li;
        if (q == 0) { mm32<false, false, false>(acc, S3, i0, S5, j0, lane); const float w0 = p->in[I_W0][l * 512 + h * 64 + c];
#pragma unroll
            for (int r = 0; r < 16; ++r) { const int t = i0 + (r & 3) + 8 * (r >> 2) + 4 * hi; const float zz = acc[r] + w0;
                const float sp = fmaxf(-zz, 0.f) + __logf(1.f + __expf(-fabsf(zz)));
                S7[t * 65 + c] = (t < si.ntok) ? -__expf(-sp - 0.5f) : 0.f; } }
        else { mm32<false, false, false>(acc, S4, i0, S6, j0, lane); const float a0 = p->in[I_A0][l * 512 + h * 64 + c];
#pragma unroll
            for (int r = 0; r < 16; ++r) { const int t = i0 + (r & 3) + 8 * (r >> 2) + 4 * hi; S8[t * 65 + c] = __builtin_amdgcn_rcpf(1.f + __expf(-(acc[r] + a0))); } }
    }
    __syncthreads();
    PT1(2);
    if (wave == 0) { float run = 0.f;
#pragma unroll 8
        for (int t = 0; t < 64; ++t) { run += S7[t * 65 + lane]; S3[t * 65 + lane] = run; } }
    else { const int c = lane; const float kkw = p->in[I_KK][l * 512 + h * 64 + c], kaw = p->in[I_KA][l * 512 + h * 64 + c], rkw = p->in[I_RK][l * 512 + h * 64 + c];
        for (int t = wave - 1; t < 64; t += 7) { const float kr = S1[t * 65 + c], kv = kr * kkw; const float ss = wave_sum(kv * kv);
            const float kn = kv * (1.f / sqrtf(fmaxf(ss, 1e-24f))); const float a = S8[t * 65 + c]; const float km = kr * (1.f + (a - 1.f) * kaw);
            const float bon = wave_sum(S0[t * 65 + c] * km * rkw);
            S4[t * 65 + c] = kn; S1[t * 65 + c] = km; S8[t * 65 + c] = kn * a;
            if (lane == 0) ((float*)(p->ws + WS_BONUS))[(size_t)unit * 64 + t] = bon; } }
    __syncthreads();
    { const int c = tid & 63, tq = tid >> 6;
#pragma unroll
        for (int tt = 0; tt < 8; ++tt) { const int t = tq * 8 + tt, o = t * 65 + c; const float Lg = S3[o], lw = S7[o];
            const float g = __expf(Lg), gi = __expf(-Lg), gp = __expf(Lg - lw);
            S0[o] *= g; S1[o] *= gi; S8[o] *= gi; S4[o] *= gp; if (t == 63) gC[c] = g; } }
    __syncthreads();
    PT1(3);
    { f32x16 acc = {};
      if (q == 0) { mm32<false, true, false>(acc, S1, i0, S4, j0, lane); st_tile<1>(S3, acc, i0, j0, lane); }
      else { mm32<false, true, false>(acc, S8, i0, S4, j0, lane); st_tile<1>(S5, acc, i0, j0, lane); } }
    __syncthreads();
    { f32x16 acc = {};
      if (q == 0) { mm32<true, false, false>(acc, S2, i0, S3, j0, lane); st_tile<0>(S6, acc, i0, j0, lane); }
      else { mm32<false, true, false>(acc, S1, i0, S0, j0, lane); st_tile<2>(S7, acc, i0, j0, lane); } }
    __syncthreads();
    PT1(4);
    { float xa[4], xb[4]; const int ra = 4 * wave, rb = 60 - 4 * wave;
#pragma unroll
      for (int k = 0; k < 4; ++k) { xa[k] = (lane == ra + k) ? 1.f : 0.f; xb[k] = (lane == rb + k) ? 1.f : 0.f; }
      for (int s = ra; s < rb; ++s) { const float mrow = S5[s * 65 + lane];
#pragma unroll
          for (int k = 0; k < 4; ++k) xa[k] -= __builtin_bit_cast(float, __builtin_amdgcn_readlane(__builtin_bit_cast(int, xa[k]), s)) * mrow; }
      for (int s = rb; s < 63; ++s) { const float mrow = S5[s * 65 + lane]; float ya[4], yb[4];
#pragma unroll
          for (int k = 0; k < 4; ++k) { ya[k] = __builtin_bit_cast(float, __builtin_amdgcn_readlane(__builtin_bit_cast(int, xa[k]), s)); yb[k] = __builtin_bit_cast(float, __builtin_amdgcn_readlane(__builtin_bit_cast(int, xb[k]), s)); }
#pragma unroll
          for (int k = 0; k < 4; ++k) { xa[k] -= ya[k] * mrow; xb[k] -= yb[k] * mrow; } }
#pragma unroll
      for (int k = 0; k < 4; ++k) { S3[(ra + k) * 65 + lane] = xa[k]; S3[(rb + k) * 65 + lane] = xb[k]; } }
    __syncthreads();
    { f32x16 acc = {};
      if (q == 0) mm32<true, false, false>(acc, S4, i0, S3, j0, lane); else mm32<false, false, false>(acc, S6, i0, S3, j0, lane);
      __syncthreads();
      st_tile<0>(q == 0 ? S3 : S6, acc, i0, j0, lane); }
    __syncthreads();
    PT1(5);
    { f32x16 acc = {};
      if (q == 1) { mm32<false, true, false>(acc, S8, i0, S0, j0, lane); st_tile<2>(S4, acc, i0, j0, lane); }
      else { mm32<false, false, false>(acc, S3, i0, S8, j0, lane);
          const int jc = j0 + li; const float gc = gC[jc]; float* TQ = (float*)(p->ws + WS_TQ) + (size_t)unit * 4096;
#pragma unroll
          for (int rg = 0; rg < 4; ++rg) { const int ab = i0 + 8 * rg + 4 * hi; f32x4 o;
#pragma unroll
              for (int e = 0; e < 4; ++e) o[e] = ((ab + e == jc) ? gc : 0.f) - acc[rg * 4 + e] * gc;
              *(f32x4*)(TQ + ((((jc >> 4) * 4 + (ab >> 4)) * 64 + ((ab & 15) >> 2) * 16 + (jc & 15)) * 4)) = o; } } }
    __syncthreads();
    { f32x16 acc = {};
      if (q == 0) { mm32<true, false, false>(acc, S2, i0, S1, j0, lane); mm32<false, false, true>(acc, S6, i0, S8, j0, lane);
          const int jc = j0 + li; const float gc = gC[jc]; float* GM = (float*)(p->ws + WS_GM) + (size_t)unit * 4096;
#pragma unroll
          for (int r = 0; r < 16; ++r) GM[(i0 + (r & 3) + 8 * (r >> 2) + 4 * hi) * 64 + jc] = acc[r] * gc; }
      else { mm32<true, false, false>(acc, S2, i0, S7, j0, lane); mm32<false, false, true>(acc, S6, i0, S4, j0, lane);
          float* Y0T = (float*)(p->ws + WS_Y0T) + (size_t)unit * 4096;
#pragma unroll
          for (int rg = 0; rg < 4; ++rg) *(f32x4*)(Y0T + (((((j0 >> 5) * 2 + (i0 >> 5)) * 4 + rg) * 2 + hi) * 32 + li) * 4) = (f32x4){acc[rg * 4], acc[rg * 4 + 1], acc[rg * 4 + 2], acc[rg * 4 + 3]}; } }
    if (q == 0) { f32x16 acc;
#pragma unroll
        for (int r = 0; r < 16; ++r) acc[r] = S0[(j0 + li) * 65 + i0 + (r & 3) + 8 * (r >> 2) + 4 * hi];
        mm32<false, false, true>(acc, S3, i0, S4, j0, lane);
        float* ET = (float*)(p->ws + WS_ET) + (size_t)unit * 4096;
#pragma unroll
        for (int rg = 0; rg < 4; ++rg) *(f32x4*)(ET + ((((j0 >> 5) * 2 + (i0 >> 5)) * 8 + 2 * rg + hi) * 32 + li) * 4) = (f32x4){acc[rg * 4], acc[rg * 4 + 1], acc[rg * 4 + 2], acc[rg * 4 + 3]}; }
    __syncthreads();
    PT1(6);
}
template <bool SCQ>
__device__ __forceinline__ void chain_run(f32x4 (&st)[4], const float* TQ, const float* GM, float* SC, int nsteps, int i, int g, int lane) {
    constexpr size_t STRIDE = (size_t)8 * 4096;
    f32x4 tq[16], gm[4];
#pragma unroll
    for (int x = 0; x < 16; ++x) tq[x] = *(const f32x4*)(TQ + (x * 64 + lane) * 4);
#pragma unroll
    for (int tl = 0; tl < 4; ++tl) gm[tl] = GM ? *(const f32x4*)(GM + i * 64 + 16 * tl + 4 * g) : (f32x4){0.f, 0.f, 0.f, 0.f};
    for (int c = 0; c < nsteps; ++c) {
        if (SC) {
            if (SCQ) {
#pragma unroll
                for (int tl = 0; tl < 4; ++tl) *(f32x4*)(SC + c * STRIDE + ((((i >> 5) * 2 + (tl >> 1)) * 8 + 4 * (tl & 1) + g) * 32 + (i & 31)) * 4) = st[tl]; }
            else {
#pragma unroll
                for (int tl = 0; tl < 4; ++tl) *(f32x4*)(SC + c * STRIDE + i * 64 + 16 * tl + 4 * g) = st[tl]; } }
        f32x4 tqn[16], gmn[4];
        const int cn = (c + 1 < nsteps) ? c + 1 : c;
#pragma unroll
        for (int x = 0; x < 16; ++x) tqn[x] = *(const f32x4*)(TQ + cn * STRIDE + (x * 64 + lane) * 4);
#pragma unroll
        for (int tl = 0; tl < 4; ++tl) gmn[tl] = GM ? *(const f32x4*)(GM + cn * STRIDE + i * 64 + 16 * tl + 4 * g) : (f32x4){0.f, 0.f, 0.f, 0.f};
        f32x4 acc[4];
#pragma unroll
        for (int tp = 0; tp < 4; ++tp) acc[tp] = gm[tp];
#pragma unroll
        for (int tl = 0; tl < 4; ++tl)
#pragma unroll
            for (int r = 0; r < 4; ++r)
#pragma unroll
                for (int tp = 0; tp < 4; ++tp) acc[tp] = __builtin_amdgcn_mfma_f32_16x16x4f32(tq[tp * 4 + tl][r], st[tl][r], acc[tp], 0, 0, 0);
#pragma unroll
        for (int tl = 0; tl < 4; ++tl) st[tl] = acc[tl];
#pragma unroll
        for (int x = 0; x < 16; ++x) tq[x] = tqn[x];
#pragma unroll
        for (int tl = 0; tl < 4; ++tl) gm[tl] = gmn[tl];
    }
}
constexpr int CH_SLOT = 32768;
#define CH_LD(R, STEP) do { const int s_ = (STEP) < nsteps ? (STEP) : nsteps - 1; _Pragma("unroll") for (int k = 0; k < 4; ++k) { R[k] = *(const f32x4*)(TQ + (size_t)s_ * STRIDE + (k * 256 + ll) * 4); \
        R[4 + k] = GM ? *(const f32x4*)(GM + (size_t)s_ * STRIDE + (k * 256 + ll) * 4) : (f32x4){0.f, 0.f, 0.f, 0.f}; } } while (0)
#define CH_WR(R, SLOT) do { LAS float* d_ = (LAS float*)(lds + (SLOT) * CH_SLOT); _Pragma("unroll") for (int k = 0; k < 4; ++k) { *(LAS f32x4*)(d_ + (k * 256 + ll) * 4) = R[k]; *(LAS f32x4*)(d_ + 4096 + (k * 256 + ll) * 4) = R[4 + k]; } } while (0)
template <bool SCQ>
__device__ __forceinline__ void chain_block(f32x4 (&st)[4], const float* TQ, const float* GM, float* SC, int nsteps, LAS unsigned char* lds, int wave, int lane) {
    constexpr size_t STRIDE = (size_t)8 * 4096;
    if (wave >= 4) {
        const int ll = (wave - 4) * 64 + lane;
        f32x4 r0[8], r1[8], r2[8];
        CH_LD(r0, 0); CH_LD(r1, 1); CH_LD(r2, 2);
        CH_WR(r0, 0);
        __syncthreads();
        for (int c = 0; c < nsteps; c += 3) {
            CH_WR(r1, (c + 1) & 1); CH_LD(r0, c + 3); __syncthreads();
            if (c + 1 < nsteps) { CH_WR(r2, (c + 2) & 1); CH_LD(r1, c + 4); __syncthreads(); }
            if (c + 2 < nsteps) { CH_WR(r0, (c + 3) & 1); CH_LD(r2, c + 5); __syncthreads(); }
        }
    } else {
        const int fr = lane & 15, g = lane >> 4, i = wave * 16 + fr;
        __syncthreads();
        for (int c = 0; c < nsteps; ++c) {
            if (SC) {
                if (SCQ) {
#pragma unroll
                    for (int tl = 0; tl < 4; ++tl) *(f32x4*)(SC + c * STRIDE + ((((i >> 5) * 2 + (tl >> 1)) * 8 + 4 * (tl & 1) + g) * 32 + (i & 31)) * 4) = st[tl]; }
                else {
#pragma unroll
                    for (int tl = 0; tl < 4; ++tl) *(f32x4*)(SC + c * STRIDE + i * 64 + 16 * tl + 4 * g) = st[tl]; } }
            const LAS float* sl = (const LAS float*)(lds + (c & 1) * CH_SLOT);
            f32x4 acc[4];
#pragma unroll
            for (int tp = 0; tp < 4; ++tp) acc[tp] = *(const LAS f32x4*)(sl + 4096 + i * 64 + 16 * tp + 4 * g);
#pragma unroll
            for (int tl = 0; tl < 4; ++tl) { f32x4 tq[4];
#pragma unroll
                for (int tp = 0; tp < 4; ++tp) tq[tp] = *(const LAS f32x4*)(sl + ((tp * 4 + tl) * 64 + lane) * 4);
#pragma unroll
                for (int r = 0; r < 4; ++r)
#pragma unroll
                    for (int tp = 0; tp < 4; ++tp) acc[tp] = __builtin_amdgcn_mfma_f32_16x16x4f32(tq[tp][r], st[tl][r], acc[tp], 0, 0, 0); }
#pragma unroll
            for (int tl = 0; tl < 4; ++tl) st[tl] = acc[tl];
            __syncthreads();
        }
    }
}
__device__ __forceinline__ void rwkv_l1_block(KP p, int task, LAS unsigned char* lds, int wave, int lane) {
    const int kind = task & 1, h = (task >> 1) & 7, grp = task >> 4, iq = wave & 3;
    const int fr = lane & 15, g = lane >> 4, i = iq * 16 + fr;
    const size_t u0 = ((size_t)(grp * 16) * 8 + h) * 4096;
    f32x4 st[4];
#pragma unroll
    for (int tl = 0; tl < 4; ++tl)
#pragma unroll
        for (int r = 0; r < 4; ++r) st[tl][r] = (kind == 1 && i == 16 * tl + 4 * g + r) ? 1.f : 0.f;
    chain_block<false>(st, (const float*)(p->ws + WS_TQ) + u0, kind == 0 ? (const float*)(p->ws + WS_GM) + u0 : nullptr, nullptr, 16, lds, wave, lane);
    if (wave < 4) { const size_t gb = ((size_t)grp * 8 + h) * 4096;
        if (kind == 0) { float* GG = (float*)(p->ws + WS_GG) + gb;
#pragma unroll
            for (int tl = 0; tl < 4; ++tl) *(f32x4*)(GG + i * 64 + 16 * tl + 4 * g) = st[tl]; }
        else { float* TG = (float*)(p->ws + WS_TG) + gb;
#pragma unroll
            for (int tl = 0; tl < 4; ++tl)
#pragma unroll
                for (int r = 0; r < 4; ++r) TG[((tl * 4 + iq) * 64 + (fr >> 2) * 16 + 4 * g + r) * 4 + (fr & 3)] = st[tl][r]; } }
    __syncthreads();
}
__device__ __forceinline__ void rwkv_l2_block(KP p, int l, int h, LAS unsigned char* lds, int wave, int lane) {
    const int iq = wave & 3, fr = lane & 15, g = lane >> 4, i = iq * 16 + fr;
    f32x4 st[4];
#pragma unroll
    for (int tl = 0; tl < 4; ++tl) st[tl] = (f32x4){0.f, 0.f, 0.f, 0.f};
    chain_block<false>(st, (const float*)(p->ws + WS_TG) + (size_t)h * 4096, (const float*)(p->ws + WS_GG) + (size_t)h * 4096, (float*)(p->ws + WS_SG) + (size_t)h * 4096, 16, lds, wave, lane);
    if (wave < 4) { float* dst = p->out + O_PWKV + (((size_t)l * 8 + h) * 64 + i) * 64;
#pragma unroll
        for (int tl = 0; tl < 4; ++tl) *(f32x4*)(dst + 16 * tl + 4 * g) = st[tl]; }
    __syncthreads();
}
__device__ __forceinline__ void rwkv_l3_block(KP p, int task, LAS unsigned char* lds, int wave, int lane) {
    const int h = task & 7, grp = task >> 3, iq = wave & 3, fr = lane & 15, g = lane >> 4, i = iq * 16 + fr;
    f32x4 st[4];
    const float* s0 = (const float*)(p->ws + WS_SG) + ((size_t)grp * 8 + h) * 4096 + i * 64;
#pragma unroll
    for (int tl = 0; tl < 4; ++tl) st[tl] = *(const f32x4*)(s0 + 16 * tl + 4 * g);
    const size_t u0 = ((size_t)(grp * 16) * 8 + h) * 4096;
    chain_block<true>(st, (const float*)(p->ws + WS_TQ) + u0, (const float*)(p->ws + WS_GM) + u0, (float*)(p->ws + WS_SC) + u0, 16, lds, wave, lane);
    __syncthreads();
}
__device__ __forceinline__ void rwkv_samp_task(KP p, int l, int t2, int lane) {
    const int fr = lane & 15, g = lane >> 4, iq = t2 & 3, h = (t2 >> 2) & 7, b = t2 >> 5, i = iq * 16 + fr;
    f32x4 st[4];
    const float* s0 = p->in[I_SWKV] + ((((size_t)l * 32 + b) * 8 + h) * 64 + i) * 64;
#pragma unroll
    for (int tl = 0; tl < 4; ++tl) st[tl] = *(const f32x4*)(s0 + 16 * tl + 4 * g);
    const size_t u0 = ((size_t)(256 + b) * 8 + h) * 4096;
    chain_run<true>(st, (const float*)(p->ws + WS_TQ) + u0, (const float*)(p->ws + WS_GM) + u0, (float*)(p->ws + WS_SC) + u0, 1, i, g, lane);
    float* dst = p->out + O_SWKV + ((((size_t)l * 32 + b) * 8 + h) * 64 + i) * 64;
#pragma unroll
    for (int tl = 0; tl < 4; ++tl) *(f32x4*)(dst + 16 * tl + 4 * g) = st[tl];
}
__device__ __forceinline__ void rwkv_r3_task(KP p, int l, int task, int lane) {
    const int unit = task >> 1, th = task & 1, cu = unit >> 3, h = unit & 7, li = lane & 31, hi = lane >> 5;
    const RwkvSeqInfo si = rwkv_info(cu);
    if (th * 32 >= si.ntok) return;
    const bf16_t* U = (const bf16_t*)(p->ws + WS_U);
    const size_t ub = (size_t)unit * 4096; const int t = th * 32 + li;
    const float* SC = (const float*)(p->ws + WS_SC) + ub; const float* ET = (const float*)(p->ws + WS_ET) + ub; const float* Y0T = (const float*)(p->ws + WS_Y0T) + ub;
    f32x16 acc[2];
#pragma unroll
    for (int ti = 0; ti < 2; ++ti)
#pragma unroll
        for (int rg = 0; rg < 4; ++rg) { const f32x4 y0 = *(const f32x4*)(Y0T + ((((th * 2 + ti) * 4 + rg) * 2 + hi) * 32 + li) * 4);
#pragma unroll
            for (int e = 0; e < 4; ++e) acc[ti][rg * 4 + e] = y0[e]; }
    f32x4 eb[8], sa0[8], sa1[8];
#pragma unroll
    for (int s4 = 0; s4 < 8; ++s4) { eb[s4] = *(const f32x4*)(ET + (((th * 2 + hi) * 8 + s4) * 32 + li) * 4); sa0[s4] = *(const f32x4*)(SC + (((0 * 2 + hi) * 8 + s4) * 32 + li) * 4); sa1[s4] = *(const f32x4*)(SC + (((1 * 2 + hi) * 8 + s4) * 32 + li) * 4); }
#pragma unroll
    for (int s4 = 0; s4 < 8; ++s4) {
#pragma unroll
        for (int e = 0; e < 4; ++e) { acc[0] = __builtin_amdgcn_mfma_f32_32x32x2f32(sa0[s4][e], eb[s4][e], acc[0], 0, 0, 0); acc[1] = __builtin_amdgcn_mfma_f32_32x32x2f32(sa1[s4][e], eb[s4][e], acc[1], 0, 0, 0); }
    }
    float s1 = 0.f;
#pragma unroll
    for (int ti = 0; ti < 2; ++ti)
#pragma unroll
        for (int r = 0; r < 16; ++r) s1 += acc[ti][r];
    s1 = xhalf_sum(s1); const float mean = s1 * (1.f / 64.f);
    float s2 = 0.f;
#pragma unroll
    for (int ti = 0; ti < 2; ++ti)
#pragma unroll
        for (int r = 0; r < 16; ++r) { const float d = acc[ti][r] - mean; s2 += d * d; }
    s2 = xhalf_sum(s2); const float rstd = 1.f / sqrtf(s2 * (1.f / 64.f) + 64e-5f);
    if (t >= si.ntok) return;
    const float bon = ((const float*)(p->ws + WS_BONUS))[(size_t)unit * 64 + t];
    const size_t row = (size_t)(si.row0 + t);
    bf16_t* oc = (bf16_t*)(p->ws + WS_OCAT) + (size_t)2 * NTOK * 512 + row * 512 + h * 64;
    u32x2 wout[2][4];
#pragma unroll
    for (int ti = 0; ti < 2; ++ti)
#pragma unroll
        for (int rg = 0; rg < 4; ++rg) { const int i = 32 * ti + 8 * rg + 4 * hi, c = h * 64 + i;
            const f32x4 gg = *(const f32x4*)(p->in[I_GNG] + l * 512 + c), gb = *(const f32x4*)(p->in[I_GNB] + l * 512 + c), mu = *(const f32x4*)(p->in[I_MU] + l * SHIFT_W + 1024 + c);
            const u32x2 vx = *(const u32x2*)(U + row * NU + U_XC + 1024 + c); const u32x2 sg = *(const u32x2*)(U + row * NU + U_CSG + c);
            f32x4 vc = (f32x4){bflo(vx.x), bfhi(vx.x), bflo(vx.y), bfhi(vx.y)}, vp;
            {
                const u32x2 px = *(const u32x2*)(U + (row > 0 ? row - 1 : 0) * NU + U_XC + 1024 + c); const f32x4 ss = *(const f32x4*)(p->in[I_SSHIFT] + ((size_t)l * 32 + si.b) * SHIFT_W + 1024 + c);
                const f32x4 up = (f32x4){bflo(px.x), bfhi(px.x), bflo(px.y), bfhi(px.y)};
                vp = (t > 0 || si.prev_kind == 1) ? up : (si.prev_kind == 2 ? ss : (f32x4){0.f, 0.f, 0.f, 0.f}); }
            const f32x4 vs = vc + (vp - vc) * mu;
            const f32x4 sgf = (f32x4){bflo(sg.x), bfhi(sg.x), bflo(sg.y), bfhi(sg.y)};
            f32x4 o;
#pragma unroll
            for (int e = 0; e < 4; ++e) o[e] = (((acc[ti][rg * 4 + e] - mean) * rstd) * gg[e] + gb[e] + bon * vs[e]) * siluf_(sgf[e]);
            wout[ti][rg].x = cvt_pk_bf16(o[0], o[1]); wout[ti][rg].y = cvt_pk_bf16(o[2], o[3]); }
#pragma unroll
    for (int ti = 0; ti < 2; ++ti)
#pragma unroll
        for (int rg = 0; rg < 4; ++rg) *(u32x2*)(oc + 32 * ti + 8 * rg + 4 * hi) = wout[ti][rg];
}
__device__ __forceinline__ int krow(int i) { return (i & 3) + 4 * ((i >> 3) & 1) + 8 * ((i >> 2) & 1) + 16 * (i >> 4); }
__device__ __forceinline__ bf16x8 pack8(const f32x16& v, int o) { u32x4 w; w.x = cvt_pk_bf16(v[o], v[o + 1]); w.y = cvt_pk_bf16(v[o + 2], v[o + 3]); w.z = cvt_pk_bf16(v[o + 4], v[o + 5]); w.w = cvt_pk_bf16(v[o + 6], v[o + 7]); return __builtin_bit_cast(bf16x8, w); }
constexpr float ATT_NEG = -1e30f;
template <bool HALF>
__device__ __forceinline__ void softmax_tile(f32x16& p0, f32x16& p1, float& m, float& lsum, f32x16 (&O)[2], bf16x8 (&pb)[4]) {
    float mx = p0[0];
#pragma unroll
    for (int r = 1; r < 16; ++r) mx = fmaxf(mx, p0[r]);
    if (!HALF) {
#pragma unroll
        for (int r = 0; r < 16; ++r) mx = fmaxf(mx, p1[r]); }
    mx = xhalf_max(mx);
    const float mn = fmaxf(m, mx), alpha = __builtin_amdgcn_exp2f(m - mn);
    m = mn;
    float s = 0.f;
#pragma unroll
    for (int r = 0; r < 16; ++r) { p0[r] = __builtin_amdgcn_exp2f(p0[r] - mn); s += p0[r]; }
    if (!HALF) {
#pragma unroll
        for (int r = 0; r < 16; ++r) { p1[r] = __builtin_amdgcn_exp2f(p1[r] - mn); s += p1[r]; } }
    lsum = lsum * alpha + s;
#pragma unroll
    for (int r = 0; r < 16; ++r) { O[0][r] *= alpha; O[1][r] *= alpha; }
    pb[0] = pack8(p0, 0); pb[1] = pack8(p0, 8);
    if (!HALF) { pb[2] = pack8(p1, 0); pb[3] = pack8(p1, 8); }
}
constexpr int AKS = 72;
constexpr int ATT_KB = 0, ATT_VB = 2 * 64 * AKS * 2, ATT_FB = 4 * 64 * AKS * 2, ATT_SC = ATT_FB + 2 * 64 * 4;
__device__ __forceinline__ void attn_prompt_unit(KP p, int l, int h, int qb, LAS unsigned char* lds, int tid) {
    const bf16_t* U = (const bf16_t*)(p->ws + WS_U); const bf16_t* Vt = (const bf16_t*)(p->ws + WS_VT) + (size_t)h * 64 * TP; const float* F = (const float*)(p->ws + WS_FP) + (size_t)h * TP;
    const int wave = tid >> 6, lane = tid & 63, li = lane & 31, hi = lane >> 5;
    const int q0 = qb * 256, q = q0 + wave * 32 + li;
    bf16x8 qf[4];
    { const float sc = 0.125f * LOG2E;
#pragma unroll
      for (int d0 = 0; d0 < 4; ++d0) { const u32x4 w = *(const u32x4*)(U + (size_t)q * NU + U_Q + h * 64 + 16 * d0 + 8 * hi);
          qf[d0] = pack8f((f32x4){bflo(w.x) * sc, bfhi(w.x) * sc, bflo(w.y) * sc, bfhi(w.y) * sc}, (f32x4){bflo(w.z) * sc, bfhi(w.z) * sc, bflo(w.w) * sc, bfhi(w.w) * sc}); } }
    const float fq = F[q];
    float m = ATT_NEG, lsum = 0.f; f32x16 O[2] = {};
    const int NT = (q0 + 256) / 64;
    LAS float* qmx = (LAS float*)(lds + ATT_SC); LAS float* mmv = qmx + 8;
    { float q2 = 0.f;
#pragma unroll
      for (int d0 = 0; d0 < 4; ++d0) { const u32x4 w = __builtin_bit_cast(u32x4, qf[d0]); q2 += bflo(w.x) * bflo(w.x) + bfhi(w.x) * bfhi(w.x) + bflo(w.y) * bflo(w.y) + bfhi(w.y) * bfhi(w.y) + bflo(w.z) * bflo(w.z) + bfhi(w.z) * bfhi(w.z) + bflo(w.w) * bflo(w.w) + bfhi(w.w) * bfhi(w.w); }
      q2 = wave_max(xhalf_sum(q2)); if (lane == 0) { qmx[wave] = q2; mmv[wave] = ATT_NEG; } }
    const float kmax2 = __uint_as_float(((const unsigned*)(p->ws + WS_CTL))[CW_KMAX + l * 8 + h]), fq0 = F[q0];
    const int srow = tid >> 3, sch = tid & 7;
    const bf16_t* kg = U + (size_t)srow * NU + U_K + h * 64 + 8 * sch; const bf16_t* vg = Vt + (size_t)srow * TP + 8 * sch;
    LAS unsigned char* kdst = lds + ATT_KB + (srow * AKS + 8 * sch) * 2; LAS unsigned char* vdst = lds + ATT_VB + (srow * AKS + 8 * sch) * 2;
    u32x4 kr = *(const u32x4*)(kg + (size_t)(NT - 1) * 64 * NU), vr = *(const u32x4*)(vg + (NT - 1) * 64); float fr = tid < 64 ? F[(NT - 1) * 64 + tid] : 0.f;
    *(LAS u32x4*)kdst = kr; *(LAS u32x4*)vdst = vr; if (tid < 64) ((LAS float*)(lds + ATT_FB))[tid] = fr;
    __syncthreads();
    const int ka = krow(li);
    float qkb; { float q2 = qmx[0];
#pragma unroll
      for (int w = 1; w < 8; ++w) q2 = fmaxf(q2, qmx[w]);
      qkb = 1.02f * sqrtf(q2 * kmax2) + fq0; }
    for (int t = NT - 1, buf = 0; t >= 0; --t, buf ^= 1) {
        { float mmin = mmv[0];
#pragma unroll
          for (int w = 1; w < 8; ++w) mmin = fminf(mmin, mmv[w]);
          if (qkb - ((const LAS float*)(lds + ATT_FB))[buf * 64 + 63] < mmin - 40.f) break; }
        if (t > 0) { kr = *(const u32x4*)(kg + (size_t)(t - 1) * 64 * NU); vr = *(const u32x4*)(vg + (t - 1) * 64); if (tid < 64) fr = F[(t - 1) * 64 + tid]; }
        if (64 * t <= q0 + wave * 32 + 31) {
            const LAS bf16_t* Kb = (const LAS bf16_t*)(lds + ATT_KB) + buf * 64 * AKS; const LAS bf16_t* Vb = (const LAS bf16_t*)(lds + ATT_VB) + buf * 64 * AKS; const LAS float* Fb = (const LAS float*)(lds + ATT_FB) + buf * 64;
            f32x16 p0, p1;
#pragma unroll
            for (int g2 = 0; g2 < 2; ++g2) { const f32x4 a = *(const LAS f32x4*)(Fb + 8 * hi + 16 * g2), b = *(const LAS f32x4*)(Fb + 8 * hi + 16 * g2 + 4), c = *(const LAS f32x4*)(Fb + 32 + 8 * hi + 16 * g2), d = *(const LAS f32x4*)(Fb + 32 + 8 * hi + 16 * g2 + 4);
#pragma unroll
                for (int e = 0; e < 4; ++e) { p0[8 * g2 + e] = fq - a[e]; p0[8 * g2 + 4 + e] = fq - b[e]; p1[8 * g2 + e] = fq - c[e]; p1[8 * g2 + 4 + e] = fq - d[e]; } }
#pragma unroll
            for (int d0 = 0; d0 < 4; ++d0) { const bf16x8 a0 = *(const LAS bf16x8*)(Kb + ka * AKS + 16 * d0 + 8 * hi), a1 = *(const LAS bf16x8*)(Kb + (ka + 32) * AKS + 16 * d0 + 8 * hi);
                p0 = __builtin_amdgcn_mfma_f32_32x32x16_bf16(a0, qf[d0], p0, 0, 0, 0); p1 = __builtin_amdgcn_mfma_f32_32x32x16_bf16(a1, qf[d0], p1, 0, 0, 0); }
            if (64 * t + 63 > q0 + wave * 32) {
#pragma unroll
                for (int r = 0; r < 16; ++r) { const int kv = 64 * t + 8 * hi + 16 * (r >> 3) + (r & 7); if (kv > q) p0[r] = -INFINITY; if (kv + 32 > q) p1[r] = -INFINITY; } }
            bf16x8 pb[4];
            softmax_tile<false>(p0, p1, m, lsum, O, pb);
#pragma unroll
            for (int dt = 0; dt < 2; ++dt)
#pragma unroll
                for (int s = 0; s < 4; ++s) { const bf16x8 a = *(const LAS bf16x8*)(Vb + (32 * dt + li) * AKS + 16 * (s & 1) + 32 * (s >> 1) + 8 * hi);
                    O[dt] = __builtin_amdgcn_mfma_f32_32x32x16_bf16(a, pb[s], O[dt], 0, 0, 0); }
        }
        { const float wm = wave_min(m); if (lane == 0) mmv[wave] = wm; }
        if (t > 0) { const int nb = buf ^ 1; *(LAS u32x4*)(kdst + nb * 64 * AKS * 2) = kr; *(LAS u32x4*)(vdst + nb * 64 * AKS * 2) = vr; if (tid < 64) ((LAS float*)(lds + ATT_FB))[nb * 64 + tid] = fr; }
        __syncthreads();
    }
    __syncthreads();
    const float inv = 1.f / xhalf_sum(lsum);
    bf16_t* ob = (bf16_t*)(p->ws + WS_OCAT) + (size_t)1 * NTOK * 512 + (size_t)q * 512 + h * 64;
    u32x2 sgv[2][4];
#pragma unroll
    for (int dt = 0; dt < 2; ++dt)
#pragma unroll
        for (int rg = 0; rg < 4; ++rg) sgv[dt][rg] = *(const u32x2*)(U + (size_t)q * NU + U_BSG + h * 64 + 32 * dt + 8 * rg + 4 * hi);
#pragma unroll
    for (int dt = 0; dt < 2; ++dt)
#pragma unroll
        for (int rg = 0; rg < 4; ++rg) { const int d = 32 * dt + 8 * rg + 4 * hi; const u32x2 sg = sgv[dt][rg];
            u32x2 w; w.x = cvt_pk_bf16(O[dt][rg * 4] * inv * siluf_(bflo(sg.x)), O[dt][rg * 4 + 1] * inv * siluf_(bfhi(sg.x))); w.y = cvt_pk_bf16(O[dt][rg * 4 + 2] * inv * siluf_(bflo(sg.y)), O[dt][rg * 4 + 3] * inv * siluf_(bfhi(sg.y)));
            *(u32x2*)(ob + d) = w; }
}
__device__ __forceinline__ void attn_sample_unit(KP p, int l, int b, int h, LAS unsigned char* lds, int tid) {
    const bf16_t* U = (const bf16_t*)(p->ws + WS_U);
    const int wave = tid >> 6, lane = tid & 63, li = lane & 31, hi = lane >> 5;
    const size_t qrow = (size_t)TP + b * 32 + li;
    const float* G = (const float*)(p->ws + WS_GS) + ((size_t)b * 8 + h) * GS_LEN;
    bf16x8 qf[4];
    { const float sc = 0.125f * LOG2E;
#pragma unroll
      for (int d0 = 0; d0 < 4; ++d0) { const u32x4 w = *(const u32x4*)(U + qrow * NU + U_Q + h * 64 + 16 * d0 + 8 * hi);
          qf[d0] = pack8f((f32x4){bflo(w.x) * sc, bfhi(w.x) * sc, bflo(w.y) * sc, bfhi(w.y) * sc}, (f32x4){bflo(w.z) * sc, bfhi(w.z) * sc, bflo(w.w) * sc, bfhi(w.w) * sc}); } }
    const float fq = G[PAST + li];
    float m = ATT_NEG, lsum = 0.f; f32x16 O[2] = {};
    const float* CK = p->in[I_CK] + (((size_t)l * 32 + b) * PAST) * 512 + h * 64; const float* CV = p->in[I_CV] + (((size_t)l * 32 + b) * PAST) * 512 + h * 64;
    const int ka = krow(li);
    float kmax2;
    { float mx = 0.f; const f32x4* kp4 = (const f32x4*)CK + (tid & 15);
#pragma unroll 1
      for (int it = 0; it < 8; ++it) { f32x4 kv[16];
#pragma unroll
          for (int j = 0; j < 16; ++j) kv[j] = kp4[(size_t)((it * 16 + j) * 32 + (tid >> 4)) * 128];
#pragma unroll
          for (int j = 0; j < 16; ++j) { float s = kv[j][0] * kv[j][0] + kv[j][1] * kv[j][1] + kv[j][2] * kv[j][2] + kv[j][3] * kv[j][3];
              s += dpp_mov<0xB1>(s); s += dpp_mov<0x4E>(s); s += dpp_mov<0x141>(s); s += dpp_mov<0x140>(s); mx = fmaxf(mx, s); } }
      mx = wave_max(mx); LAS float* kml = (LAS float*)lds;
      if (lane == 0) kml[wave] = mx;
      __syncthreads();
      kmax2 = kml[0];
#pragma unroll
      for (int w = 1; w < 8; ++w) kmax2 = fmaxf(kmax2, kml[w]);
      __syncthreads(); }
    float qkb;
    { float q2 = 0.f;
#pragma unroll
      for (int d0 = 0; d0 < 4; ++d0) { const u32x4 w = __builtin_bit_cast(u32x4, qf[d0]); q2 += bflo(w.x) * bflo(w.x) + bfhi(w.x) * bfhi(w.x) + bflo(w.y) * bflo(w.y) + bfhi(w.y) * bfhi(w.y) + bflo(w.z) * bflo(w.z) + bfhi(w.z) * bfhi(w.z) + bflo(w.w) * bflo(w.w) + bfhi(w.w) * bfhi(w.w); }
      q2 = wave_max(xhalf_sum(q2)); qkb = 1.02f * sqrtf(q2 * kmax2) + G[PAST]; }
    {
        f32x16 p0, p1 = {};
#pragma unroll
        for (int g2 = 0; g2 < 2; ++g2) { const float* gp = G + PAST + 8 * hi + 16 * g2; const f32x4 a = *(const f32x4*)gp, bq = *(const f32x4*)(gp + 4);
#pragma unroll
            for (int e = 0; e < 4; ++e) { p0[8 * g2 + e] = fq - a[e]; p0[8 * g2 + 4 + e] = fq - bq[e]; } }
#pragma unroll
        for (int d0 = 0; d0 < 4; ++d0) { const bf16x8 a0 = *(const bf16x8*)(U + ((size_t)TP + b * 32 + ka) * NU + U_K + h * 64 + 16 * d0 + 8 * hi);
            p0 = __builtin_amdgcn_mfma_f32_32x32x16_bf16(a0, qf[d0], p0, 0, 0, 0); }
#pragma unroll
        for (int r = 0; r < 16; ++r) { const int kv = 8 * hi + 16 * (r >> 3) + (r & 7); if (kv > li) p0[r] = -INFINITY; }
        bf16x8 pb[4];
        softmax_tile<true>(p0, p1, m, lsum, O, pb);
        if (wave == 7) {
#pragma unroll
            for (int dt = 0; dt < 2; ++dt)
#pragma unroll
                for (int s = 0; s < 2; ++s) { const bf16_t* vp = U + ((size_t)TP + b * 32 + 16 * s + 8 * hi) * NU + U_V + h * 64 + 32 * dt + li; u32x4 w;
                    w.x = (unsigned)vp[0] | ((unsigned)vp[NU] << 16); w.y = (unsigned)vp[2 * NU] | ((unsigned)vp[3 * NU] << 16); w.z = (unsigned)vp[4 * NU] | ((unsigned)vp[5 * NU] << 16); w.w = (unsigned)vp[6 * NU] | ((unsigned)vp[7 * NU] << 16);
                    O[dt] = __builtin_amdgcn_mfma_f32_32x32x16_bf16(__builtin_bit_cast(bf16x8, w), pb[s], O[dt], 0, 0, 0); } }
        else lsum = 0.f;
    }
    const float mmin = wave_min(m);
    for (int tt = 0; tt < 8; ++tt) {
        const int key0 = (63 - wave - 8 * tt) * 64;
        if (qkb - G[key0 + 63] < mmin - 40.f) break;
        f32x16 p0, p1;
#pragma unroll
        for (int g2 = 0; g2 < 2; ++g2) { const float* gp = G + key0 + 8 * hi + 16 * g2; const f32x4 a = *(const f32x4*)gp, bq = *(const f32x4*)(gp + 4), c = *(const f32x4*)(gp + 32), d = *(const f32x4*)(gp + 36);
#pragma unroll
            for (int e = 0; e < 4; ++e) { p0[8 * g2 + e] = fq - a[e]; p0[8 * g2 + 4 + e] = fq - bq[e]; p1[8 * g2 + e] = fq - c[e]; p1[8 * g2 + 4 + e] = fq - d[e]; } }
#pragma unroll
        for (int d0 = 0; d0 < 4; ++d0) { const float* k0p = CK + (size_t)(key0 + ka) * 512 + 16 * d0 + 8 * hi; const float* k1p = k0p + (size_t)32 * 512;
            const bf16x8 a0 = pack8f(*(const f32x4*)k0p, *(const f32x4*)(k0p + 4)), a1 = pack8f(*(const f32x4*)k1p, *(const f32x4*)(k1p + 4));
            p0 = __builtin_amdgcn_mfma_f32_32x32x16_bf16(a0, qf[d0], p0, 0, 0, 0); p1 = __builtin_amdgcn_mfma_f32_32x32x16_bf16(a1, qf[d0], p1, 0, 0, 0); }
        bf16x8 pb[4];
        softmax_tile<false>(p0, p1, m, lsum, O, pb);
#pragma unroll
        for (int dt = 0; dt < 2; ++dt)
#pragma unroll
            for (int s = 0; s < 4; ++s) { const float* vp = CV + (size_t)(key0 + 16 * (s & 1) + 32 * (s >> 1) + 8 * hi) * 512 + 32 * dt + li;
                const bf16x8 a = pack8f((f32x4){vp[0], vp[512], vp[1024], vp[1536]}, (f32x4){vp[2048], vp[2560], vp[3072], vp[3584]});
                O[dt] = __builtin_amdgcn_mfma_f32_32x32x16_bf16(a, pb[s], O[dt], 0, 0, 0); }
    }
    LAS float* Ow = (LAS float*)lds;
    LAS float* ML = Ow + 8 * 32 * 64;
    lsum = xhalf_sum(lsum);
#pragma unroll
    for (int dt = 0; dt < 2; ++dt)
#pragma unroll
        for (int r = 0; r < 16; ++r) Ow[(wave * 32 + dt * 16 + r) * 64 + lane] = O[dt][r];
    if (hi == 0) { ML[(wave * 2) * 32 + li] = m; ML[(wave * 2 + 1) * 32 + li] = lsum; }
    __syncthreads();
    { const int qq = tid & 31, dg = tid >> 5; float M = ATT_NEG;
#pragma unroll
      for (int w = 0; w < 8; ++w) M = fmaxf(M, ML[(w * 2) * 32 + qq]);
      float L = 0.f; f32x4 o = {0.f, 0.f, 0.f, 0.f};
      const int d = 4 * dg, idx0 = (d >> 5) * 16 + ((d >> 3) & 3) * 4, ln = ((d >> 2) & 1) * 32 + qq;
#pragma unroll
      for (int w = 0; w < 8; ++w) { const float f = __builtin_amdgcn_exp2f(ML[(w * 2) * 32 + qq] - M); L += ML[(w * 2 + 1) * 32 + qq] * f;
#pragma unroll
          for (int e = 0; e < 4; ++e) o[e] += Ow[(w * 32 + idx0 + e) * 64 + ln] * f; }
      const float inv = 1.f / L; const size_t row = (size_t)TP + b * 32 + qq;
      const u32x2 sg = *(const u32x2*)(U + row * NU + U_BSG + h * 64 + d);
      u32x2 wv; wv.x = cvt_pk_bf16(o[0] * inv * siluf_(bflo(sg.x)), o[1] * inv * siluf_(bfhi(sg.x))); wv.y = cvt_pk_bf16(o[2] * inv * siluf_(bflo(sg.y)), o[3] * inv * siluf_(bfhi(sg.y)));
      *(u32x2*)((bf16_t*)(p->ws + WS_OCAT) + (size_t)1 * NTOK * 512 + row * 512 + h * 64 + d) = wv; }
    __syncthreads();
}
__device__ __forceinline__ bool xb_lane0() { unsigned ones_ = ~0u; asm volatile("" : "+s"(ones_)); return __builtin_amdgcn_mbcnt_hi(ones_, __builtin_amdgcn_mbcnt_lo(ones_, 0u)) == 0u; }
constexpr int NPHASE = 22;
__global__ void __launch_bounds__(512, 2) hse_fwd(Params p_) {
    const KP kp = (KP)__builtin_amdgcn_kernarg_segment_ptr();
    (void)p_;
    extern __shared__ __attribute__((aligned(16))) unsigned char lds_raw[];
    LAS unsigned char* lds = (LAS unsigned char*)lds_raw;
    const int tid0 = threadIdx.x;
    const int wave0 = __builtin_amdgcn_readfirstlane(tid0 >> 6);
    const int G = gridDim.x, bid = blockIdx.x, ngw = G * 8;
#define PH_LOCALS const KP p = kp_fresh(kp); unsigned ones_ = ~0u; asm volatile("" : "+s"(ones_)); int tid = wave0 * 64 + (int)__builtin_amdgcn_mbcnt_hi(ones_, __builtin_amdgcn_mbcnt_lo(ones_, 0u)); asm volatile("" : "+v"(tid)); const int lane = tid & 63, wave = __builtin_amdgcn_readfirstlane(tid >> 6), gw = bid * 8 + wave; (void)lane; (void)gw; (void)p;
    if (tid0 < 4) ((LAS unsigned*)(lds + LDS_XB_OFF))[tid0] = 0u;
#if PROBE_ID
    if (tid0 == 0) *(LAS unsigned long long*)(lds + LDS_PROBE_OFF) = 0ull;
#endif
    __syncthreads();
    unsigned* ctl = (unsigned*)(kp->ws + WS_CTL);
    XcdBarrier bar = xcd_barrier_post(ctl + CW_BAR + kp->li * XCD_BAR_WORDS, (volatile LAS unsigned*)(lds + LDS_XB_OFF));
    const int lo = kp->ph_lo, hi = kp->ph_hi;
#define IN(k) (lo <= (k) && (k) < hi)
#ifndef DUP_MASK
#define DUP_MASK 0
#endif
#define NREP(k) (((DUP_MASK >> (k)) & 1) + 1)
#define XB_T0 (wave0 == 0 && xb_lane0())
#define SEAM(k) do { if (IN(k) && IN((k) + 1)) xcd_barrier(bar, XB_T0); } while (0)
    PT0();
    if (IN(0)) { PH_LOCALS
        for (int u = bid; u < 192; u += G) ada_unit(p, u, lds, tid);
        p0_weights(p, lds, gw, ngw, wave, lane);
    }
    SEAM(0);
    PT1(9);
    for (int l = 0; l < NLAYER; ++l) {
        const int pb = 1 + 10 * l;
        for (int rep = 0; rep < NREP(0); ++rep) { if (rep) xcd_barrier(bar, XB_T0);
        if (IN(pb)) { PH_LOCALS p1_rows(p, l, gw, ngw, lane); } }
        SEAM(pb);
        PT1(10);
        for (int rep = 0; rep < NREP(1); ++rep) { if (rep) xcd_barrier(bar, XB_T0);
        if (IN(pb + 1)) { PH_LOCALS
            pg8::Gemm g{(const bf16_t*)(p->ws + WS_H), (const bf16_t*)(p->ws + WS_WIN) + (size_t)l * NU * 2048, NTOK, NU, 2048, 2048};
            pg8::StaticOrder S; S.init(NTOK, NU, G, bid);
            EpiU E{(bf16_t*)(p->ws + WS_U), p->out, p->in[I_BF], l};
            pg8::gemm_phase<EpiU, pg8::StaticOrder>(lds, g, S, E, nullptr, tid);
        }
        }
        SEAM(pb + 1);
        PT1(11);
        for (int rep = 0; rep < NREP(2); ++rep) { if (rep) xcd_barrier(bar, XB_T0);
        if (IN(pb + 2)) { PH_LOCALS
#ifndef DUP_SUB
#define DUP_SUB 0
#endif
            { PT0();
            for (int u = bid; u < NRU * ((DUP_SUB & 1) + 1); u += G) rwkv_r1(p, l, u % NRU, lds, tid);
            PT1(31);
            for (int u = (bid + G - 32) % G; u < 544 * (((DUP_SUB >> 1) & 1) + 1); u += G) conv_unit(p, l, u % 544, lds, tid);
            PT1(32);
            for (int u = (bid + G - 64) % G; u < 544 * (((DUP_SUB >> 2) & 1) + 1); u += G) pool_unit(p, l, u % 544, lds, tid);
            PT1(33);
            for (int u = bid; u < 256; u += G) { vt_tile(p, l, u * 8 + wave, lds, wave, lane); }
            __syncthreads();
            for (int u = (bid + G - 96) % G; u < 32; u += G) gs_unit(p, l, u, lds, tid);
            for (int u = G - 1 - bid; u < 8; u += G) fp_unit(p, l, u, lds, tid);
            if (bid == G / 2) shift_out(p, l, tid);
            PT1(34); }
        }
        }
        SEAM(pb + 2);
        PT1(12);
        for (int rep = 0; rep < NREP(3); ++rep) { if (rep) xcd_barrier(bar, XB_T0);
        if (IN(pb + 3)) { PH_LOCALS
            for (int tk = bid; tk < 256; tk += G) rwkv_l1_block(p, tk, lds, wave, lane);
            LAS int* qslot = (LAS int*)(lds + LDS_XB_OFF - 16);
            for (;;) {
                if (tid == 0) *qslot = (int)atomicAdd(ctl + CW_QUEUE + 64 * (2 * l + 4 * rep), 1u);
                __syncthreads();
                const int item = *qslot;
                __syncthreads();
                if (item >= 512) break;
                attn_prompt_unit(p, l, item & 7, 63 - (item >> 3), lds, tid);
            }
            for (;;) {
                if (tid == 0) *qslot = (int)atomicAdd(ctl + CW_QUEUE + 64 * (2 * l + 1 + 4 * rep), 1u);
                __syncthreads();
                const int item = *qslot;
                __syncthreads();
                if (item >= 256) break;
                attn_sample_unit(p, l, item >> 3, item & 7, lds, tid);
            }
        }
        }
        SEAM(pb + 3);
        PT1(13);
        if (IN(pb + 4)) { PH_LOCALS for (int tk = bid; tk < 8; tk += G) rwkv_l2_block(p, l, tk, lds, wave, lane); }
        SEAM(pb + 4);
        PT1(14);
        if (IN(pb + 5)) { PH_LOCALS
            for (int tk = bid; tk < 128; tk += G) rwkv_l3_block(p, tk, lds, wave, lane);
            for (int tk = ((bid + G - 128) % G) * 8 + wave; tk < 1024; tk += ngw) rwkv_samp_task(p, l, tk, lane);
        }
        SEAM(pb + 5);
        PT1(15);
        if (IN(pb + 6)) { PH_LOCALS for (int tk = gw; tk < NRU * 2; tk += ngw) rwkv_r3_task(p, l, tk, lane); }
        SEAM(pb + 6);
        PT1(16);
        for (int rep = 0; rep < NREP(7); ++rep) { if (rep) xcd_barrier(bar, XB_T0);
        if (IN(pb + 7)) { PH_LOCALS
            pg8::Gemm g{(const bf16_t*)(p->ws + WS_OCAT), (const bf16_t*)(p->ws + WS_WBR) + (size_t)l * 4 * 2048 * 512, 4 * NTOK, 4 * 2048, 512, 512};
            BranchOrder S{G, bid};
            EpiZ E{(bf16_t*)(p->ws + WS_Z), (const bf16_t*)(p->ws + WS_U)};
            pg8::gemm_phase<EpiZ, BranchOrder>(lds, g, S, E, nullptr, tid);
        }
        }
        SEAM(pb + 7);
        PT1(17);
        if (IN(pb + 8)) { PH_LOCALS merge_pass(p, l, bid * 512 + tid, G * 512); }
        SEAM(pb + 8);
        PT1(18);
        if (IN(pb + 9)) { PH_LOCALS
            {
                pg8::Gemm g{(const bf16_t*)(p->ws + WS_MERGED), (const bf16_t*)(p->ws + WS_WOUT) + (size_t)l * 2048 * 2048, TP, 2048, 2048, 2048};
                pg8::StaticOrder S; S.init(TP, 2048, G, bid);
                EpiOut E{p->in[I_XP], p->in[I_XS], (const float*)(p->ws + WS_XBUF), (const float*)(p->ws + WS_ADA), (float*)(p->ws + WS_XBUF), l};
                pg8::gemm_phase<EpiOut, pg8::StaticOrder>(lds, g, S, E, nullptr, tid); }
            {
                const int tile = bid >> 3, ks = bid & 7;
                pg8::Gemm g{(const bf16_t*)(p->ws + WS_MERGED) + ks * 256, (const bf16_t*)(p->ws + WS_WOUT) + (size_t)l * 2048 * 2048 + ks * 256, NTOK, 2048, 256, 2048};
                OneUnit S{64 + (tile >> 3), tile & 7, bid < 256};
                EpiOutPart E{(const float*)(p->ws + WS_ADA), (float*)(p->ws + WS_XPART) + ((size_t)(l * 8 + ks) * 1024) * DM, l};
                pg8::gemm_phase<EpiOutPart, OneUnit>(lds, g, S, E, nullptr, tid); }
        }
        SEAM(pb + 9);
        PT1(19);
    }
    if (IN(21)) { PH_LOCALS p_final_rows(p, gw, ngw, lane); }
    PT1(20);
#if PROBE_ID
    if (bid == 0 && tid0 == 0) { const unsigned long long w = *(LAS unsigned long long*)(lds + LDS_PROBE_OFF) * PROBE_K, t0 = __builtin_amdgcn_s_memrealtime(); while (__builtin_amdgcn_s_memrealtime() - t0 < w) __builtin_amdgcn_s_sleep(8); }
#endif
#undef IN
#undef SEAM
}
#ifndef MK_SPLIT
#define MK_SPLIT 0
#endif
extern "C" void kernel_launch(void* const* d_in, const int* in_sizes, int n_in, void* d_out, int out_size, void* d_ws, size_t ws_size, hipStream_t stream) {
    static int grid = 0;
    if (grid == 0) {
        if (n_in != N_IN || (size_t)out_size != O_END || ws_size < WS_END) { fprintf(stderr, "kernel_launch: unexpected shapes (n_in %d, out %d, ws %zu)\n", n_in, out_size, ws_size); grid = -1; return; }
        int dev = 0, cus = 0, per_cu = 0;
        if (hipGetDevice(&dev) != hipSuccess || hipDeviceGetAttribute(&cus, hipDeviceAttributeMultiprocessorCount, dev) != hipSuccess) { grid = -1; return; }
        if (hipFuncSetAttribute((const void*)hse_fwd, hipFuncAttributeMaxDynamicSharedMemorySize, LDS_BYTES) != hipSuccess) { fprintf(stderr, "kernel_launch: hipFuncSetAttribute failed\n"); grid = -1; return; }
        if (hipOccupancyMaxActiveBlocksPerMultiprocessor(&per_cu, (const void*)hse_fwd, 512, LDS_BYTES) != hipSuccess || per_cu < 1) fprintf(stderr, "kernel_launch: occupancy query reports %d\n", per_cu);
        (void)hipGetLastError();
        grid = cus;
    }
    if (grid < 0) return;
    if (hipMemsetAsync((char*)d_ws + WS_CTL, 0, CTL_BYTES, stream) != hipSuccess) return;
    Params a{};
    for (int i = 0; i < N_IN; ++i) a.in[i] = (const float*)d_in[i];
    a.out = (float*)d_out; a.ws = (unsigned char*)d_ws;
#if MK_SPLIT
    for (int ph = 0; ph < NPHASE; ++ph) { a.ph_lo = ph; a.ph_hi = ph + 1; a.li = ph; hipLaunchKernelGGL(hse_fwd, dim3(grid), dim3(512), LDS_BYTES, stream, a); }
#else
    a.ph_lo = 0; a.ph_hi = NPHASE; a.li = 0;
    hipLaunchKernelGGL(hse_fwd, dim3(grid), dim3(512), LDS_BYTES, stream, a);
#endif
    const hipError_t le = hipPeekAtLastError();
    if (le != hipSuccess) fprintf(stderr, "kernel_launch: launch failed: %s\n", hipGetErrorName(le));
}
```

```cpp
#include <hip/hip_runtime.h>
#include <cstdio>
#include <cstdint>
namespace pg8 {
#define PG8_LAS __attribute__((address_space(3)))
typedef unsigned short bf16_t;
typedef short bf16x8 __attribute__((ext_vector_type(8)));
typedef float f32x4 __attribute__((ext_vector_type(4)));
typedef unsigned u32x4 __attribute__((ext_vector_type(4)));
constexpr int BM = 256, BK = 64, HALF = 128, HTB = HALF * BK * 2  , STAGE_BYTES = 8 * HTB, NXCD = 8, WGM = 8;

__host__ __device__ __forceinline__ int lds_byte(int r, int c) { const int st = (r >> 4) * 2 + (c >> 5), rr = r & 15, cc = c & 31, ob = rr * 64 + cc * 2; return st * 1024 + (ob ^ (((ob >> 9) & 1) << 5)); }
__host__ __device__ __forceinline__ void stage_rc(int b, int& R, int& C) { const int st = b / 1024, sb = b % 1024, swz = sb ^ (((sb >> 9) & 1) << 5); R = (st >> 1) * 16 + swz / 64; C = (st & 1) * 32 + (swz % 64) / 2; }
__host__ __device__ __forceinline__ int perm32(int rho) { const int n = rho >> 4, i = rho & 15; return 8 * (i >> 2) + 4 * n + (i & 3); }

struct Unit { int pm, pn; };
struct Gemm { const bf16_t* A; const bf16_t* Bt; int M, N, K, ld; };

struct StaticOrder {
    int nM, nN, nwg, G, c;
    __host__ __device__ void init(int M, int N, int G_, int c_) { nM = M / BM; nN = N / BM; nwg = nM * nN; G = G_; c = c_; }
    __host__ __device__ bool next(int i, Unit& u) const {
        const long L = (long)i * G + c; if (L >= nwg) return false;
        int wgid = (int)L; { const int q = nwg / NXCD, r = nwg % NXCD, xcd = wgid % NXCD, off = wgid / NXCD; wgid = (xcd < r ? xcd * (q + 1) : r * (q + 1) + (xcd - r) * q) + off; }
        const int nig = WGM * nN, gid = wgid / nig, fm = gid * WGM, gsz = (nM - fm) < WGM ? (nM - fm) : WGM;
        u.pm = fm + ((wgid % nig) % gsz); u.pn = (wgid % nig) / gsz; return true;
    }
    __device__ __forceinline__ void a_ready(const Unit&) const {}
    __device__ __forceinline__ void done(const Unit&) const {}
};
__device__ __forceinline__ unsigned cvt_pk_bf16(float lo, float hi) { unsigned r; asm volatile("v_cvt_pk_bf16_f32 %0, %1, %2" : "=v"(r) : "v"(lo), "v"(hi)); return r; }
typedef float f32x2 __attribute__((ext_vector_type(2)));
template <class Epi, class Sched, bool STAMP = false>
__device__ __forceinline__ void gemm_phase(PG8_LAS unsigned char* lds, const Gemm g, const Sched& S, const Epi& E, unsigned long long* stamps, int tid_in) {
    int tid = tid_in; asm volatile("" : "+v"(tid));
    const int wid = __builtin_amdgcn_readfirstlane(tid >> 6), lane = tid & 63, wr = wid >> 2, wc = wid & 3, fr = lane & 15, fq = lane >> 4;
    const int K = g.ld, nt = g.K / BK;
    int ts_lo = 0, ts_hi = 0, nts = 0; const unsigned long long rt_entry = STAMP ? (unsigned long long)wall_clock64() : 0ull;
#define PG8_STAMP() do { if (STAMP && wid == 0 && nts < 64) { const unsigned long long _c = (unsigned long long)clock64(); \
        ts_lo = (lane == nts) ? (int)(unsigned)_c : ts_lo; ts_hi = (lane == nts) ? (int)(unsigned)(_c >> 32) : ts_hi; ++nts; } } while (0)
    PG8_STAMP();
    unsigned voffA[2], voffB[2];
#pragma unroll
    for (int i = 0; i < 2; ++i) { int R, C; stage_rc(tid * 16 + i * 8192, R, C); const int Rb = Epi::PERM ? ((R & ~31) + perm32(R & 31)) : R;
        voffA[i] = (unsigned)(R * K + C) * 2u; voffB[i] = (unsigned)(Rb * K + C) * 2u; }
    const size_t kstep = (size_t)(BK * 2);
    const size_t hstep = (size_t)HALF * K * 2;
    const size_t tstep = 2 * hstep;
    const unsigned ldsw = (unsigned)wid * 1024u;
    const int aoff = lds_byte(wr * 64 + fr, fq * 8), boff = lds_byte(wc * 32 + fr, fq * 8);
#define PG8_SA(b, h) (((b) * 2 + (h)) * HTB)
#define PG8_SB(b, h) ((4 + (b) * 2 + (h)) * HTB)
#define PG8_STAGE(bufoff, gbase, voff) do { _Pragma("unroll") for (int _i = 0; _i < 2; ++_i) \
        __builtin_amdgcn_global_load_lds((const unsigned*)((const char*)(gbase) + (voff)[_i]), (PG8_LAS unsigned*)(lds + (bufoff) + ldsw + _i * 8192), 16, 0, 0); } while (0)
#define PG8_LDA(dst, b, h) do { _Pragma("unroll") for (int m = 0; m < 4; ++m) _Pragma("unroll") for (int k = 0; k < 2; ++k) dst[m][k] = *(const PG8_LAS bf16x8*)(lds + PG8_SA(b, h) + aoff + m * 2048 + k * 1024); } while (0)
#define PG8_LDB(dst, b, h) do { _Pragma("unroll") for (int n = 0; n < 2; ++n) _Pragma("unroll") for (int k = 0; k < 2; ++k) dst[n][k] = *(const PG8_LAS bf16x8*)(lds + PG8_SB(b, h) + boff + n * 2048 + k * 1024); } while (0)
#define PG8_MMA(ai, bj, At, Bt) do { __builtin_amdgcn_s_setprio(1); _Pragma("unroll") for (int m = 0; m < 4; ++m) _Pragma("unroll") for (int n = 0; n < 2; ++n) _Pragma("unroll") for (int k = 0; k < 2; ++k) \
        acc[ai][bj][m][n] = __builtin_amdgcn_mfma_f32_16x16x32_bf16(Bt[n][k], At[m][k], acc[ai][bj][m][n], 0, 0, 0); __builtin_amdgcn_s_setprio(0); } while (0)
#define PG8_WAIT_V(n) asm volatile("s_waitcnt vmcnt(" #n ")" ::: "memory")
#define PG8_WAIT_L(n) asm volatile("s_waitcnt lgkmcnt(" #n ")" ::: "memory")
#define PG8_BAR __builtin_amdgcn_s_barrier()
#define PG8_SCHED __builtin_amdgcn_sched_barrier(0)
    Unit cur, nxt; int ui = 0;
    if (!S.next(0, cur)) return;
    f32x4 acc[2][2][4][2];
#pragma unroll
    for (int a = 0; a < 2; ++a)
#pragma unroll
        for (int b = 0; b < 2; ++b)
#pragma unroll
            for (int m = 0; m < 4; ++m)
#pragma unroll
                for (int n = 0; n < 2; ++n) acc[a][b][m][n] = (f32x4){0.f, 0.f, 0.f, 0.f};
    bf16x8 At[4][2], B0[2][2], B1[2][2];
    const char* cA = (const char*)g.A + (size_t)cur.pm * tstep; const char* cB = (const char*)g.Bt + (size_t)cur.pn * tstep;
    S.a_ready(cur);
    PG8_STAGE(PG8_SB(0, 0), cB, voffB); PG8_STAGE(PG8_SA(0, 0), cA, voffA); PG8_STAGE(PG8_SB(0, 1), cB + hstep, voffB); PG8_STAGE(PG8_SA(0, 1), cA + hstep, voffA);
    if (wr == 1) PG8_BAR;
    PG8_WAIT_V(4); PG8_BAR;
    PG8_STAGE(PG8_SB(1, 0), cB + kstep, voffB); PG8_STAGE(PG8_SA(1, 0), cA + kstep, voffA); PG8_STAGE(PG8_SB(1, 1), cB + hstep + kstep, voffB);
    PG8_WAIT_V(6); PG8_BAR;
    PG8_STAMP();
    for (;;) {
        const bool has_next = S.next(ui + 1, nxt);
        const char* nA = has_next ? (const char*)g.A + (size_t)nxt.pm * tstep : cA; const char* nB = has_next ? (const char*)g.Bt + (size_t)nxt.pn * tstep : cB;
        for (int t = 0; t < nt; t += 2) {
            const bool last = (t == nt - 2);
            const char* a1 = cA + (size_t)(t + 1) * kstep;
            const char* a2 = last ? nA : cA + (size_t)(t + 2) * kstep; const char* b2 = last ? nB : cB + (size_t)(t + 2) * kstep;
            const char* a3 = a2 + kstep; const char* b3 = b2 + kstep;
            if (last && has_next) S.a_ready(nxt);
            PG8_LDB(B0, 0, 0); PG8_SCHED; PG8_LDA(At, 0, 0); PG8_STAGE(PG8_SA(1, 1), a1 + hstep, voffA);
            PG8_WAIT_L(8); PG8_BAR; PG8_WAIT_L(0); PG8_MMA(0, 0, At, B0); PG8_BAR; PG8_SCHED;
            PG8_LDB(B1, 0, 1); PG8_STAGE(PG8_SB(0, 0), b2, voffB);
            PG8_BAR; PG8_WAIT_L(0); PG8_MMA(0, 1, At, B1); PG8_BAR;
            PG8_LDA(At, 0, 1); PG8_STAGE(PG8_SA(0, 0), a2, voffA);
            PG8_BAR; PG8_WAIT_L(0); PG8_MMA(1, 0, At, B0); PG8_BAR; PG8_SCHED;
            PG8_STAGE(PG8_SB(0, 1), b2 + hstep, voffB);
            PG8_WAIT_V(6); PG8_BAR; PG8_MMA(1, 1, At, B1); PG8_BAR;
            PG8_LDB(B0, 1, 0); PG8_SCHED; PG8_LDA(At, 1, 0); PG8_STAGE(PG8_SA(0, 1), a2 + hstep, voffA);
            PG8_WAIT_L(8); PG8_BAR; PG8_WAIT_L(0); PG8_MMA(0, 0, At, B0); PG8_BAR; PG8_SCHED;
            PG8_LDB(B1, 1, 1); PG8_STAGE(PG8_SB(1, 0), b3, voffB);
            PG8_BAR; PG8_WAIT_L(0); PG8_MMA(0, 1, At, B1); PG8_BAR;
            PG8_LDA(At, 1, 1); PG8_STAGE(PG8_SA(1, 0), a3, voffA);
            PG8_BAR; PG8_WAIT_L(0); PG8_MMA(1, 0, At, B0); PG8_BAR; PG8_SCHED;
            PG8_STAGE(PG8_SB(1, 1), b3 + hstep, voffB);
            PG8_WAIT_V(6); PG8_BAR; PG8_MMA(1, 1, At, B1); PG8_BAR;
        }
        PG8_STAMP();
        if constexpr (!Epi::AFTER_DRAIN) { E(acc, cur, wr, wc, fr, fq); S.done(cur); }
        PG8_STAMP();
        if (!has_next) break;
#pragma unroll
        for (int a = 0; a < 2; ++a)
#pragma unroll
            for (int b = 0; b < 2; ++b)
#pragma unroll
                for (int m = 0; m < 4; ++m)
#pragma unroll
                    for (int n = 0; n < 2; ++n) acc[a][b][m][n] = (f32x4){0.f, 0.f, 0.f, 0.f};
        cur = nxt; cA = nA; cB = nB; ++ui;
    }
    PG8_WAIT_V(0);
    if (wr == 0) PG8_BAR;
    PG8_BAR;
    if constexpr (Epi::AFTER_DRAIN) { E.fused(acc, cur, wr, wc, fr, fq, lds, wid, lane); S.done(cur); }
    PG8_STAMP();
    if (STAMP && wid == 0) { stamps[lane] = lane < nts ? (((unsigned long long)(unsigned)ts_hi << 32) | (unsigned)ts_lo) : 0ull;
        if (lane == 62) stamps[62] = rt_entry; if (lane == 63) stamps[63] = (unsigned long long)wall_clock64(); }
#undef PG8_STAMP
#undef PG8_SA
#undef PG8_SB
#undef PG8_STAGE
#undef PG8_LDA
#undef PG8_LDB
#undef PG8_MMA
#undef PG8_WAIT_V
#undef PG8_WAIT_L
#undef PG8_BAR
#undef PG8_SCHED
}
}
#define XB_TMO      128
#define XB_XCNT(j)  (256  + 64 * (j))
#define XB_XSUB(j)  (1280 + 64 * (j))
#define XB_XGEN(j)  (2304 + 64 * (j))
#define XB_TOP      3328
#define XB_TOPGEN   3392
#define XCD_BAR_WORDS 3456
#define XB_SPIN_CAP (1u << 18)
#define LAS __attribute__((address_space(3)))

__device__ __forceinline__ unsigned xb_ld(unsigned* p)              { return __hip_atomic_load(p, __ATOMIC_RELAXED, __HIP_MEMORY_SCOPE_AGENT); }
__device__ __forceinline__ unsigned xb_add(unsigned* p, unsigned v) { return __hip_atomic_fetch_add(p, v, __ATOMIC_RELAXED, __HIP_MEMORY_SCOPE_AGENT); }
__device__ __forceinline__ unsigned xb_xcc_id() { return (unsigned)__builtin_amdgcn_s_getreg((3 << 11) | 20) & 0xFu; }
#define XB_SPIN(cond, bar) do { unsigned _sp = 0; while (cond) { __builtin_amdgcn_s_sleep(1); \
    if ((++_sp & 255u) == 0u) { if (xb_ld(&(bar)[XB_TMO])) break; if (_sp > XB_SPIN_CAP) { atomicAdd(&(bar)[XB_TMO], 1u); break; } } } } while (0)

struct XcdBarrier {
    unsigned* bar; unsigned x;
    volatile LAS unsigned* st;
};

__device__ __forceinline__ XcdBarrier xcd_barrier_post(unsigned* bar, volatile LAS unsigned* st) {
    XcdBarrier b; b.bar = bar; b.x = xb_xcc_id(); b.st = st;
    if (threadIdx.x == 0) (void)xb_add(&bar[XB_XCNT(b.x)], 1u);
    return b;
}
__device__ __forceinline__ void xcd_barrier_complete(unsigned* bar, unsigned x, unsigned& nloc, unsigned& nx) {
    const unsigned G = gridDim.x * gridDim.y * gridDim.z;
    unsigned sum, cnt, mine, sp = 0u;
    for (;;) {
        sum = 0u; cnt = 0u; mine = 0u;
#pragma unroll
        for (unsigned j = 0; j < 16; ++j) { const unsigned c = xb_ld(&bar[XB_XCNT(j)]); sum += c; cnt += (c > 0u) ? 1u : 0u; mine = (j == x) ? c : mine; }
        if (sum == G) break;
        __builtin_amdgcn_s_sleep(1);
        if ((++sp & 255u) == 0u) { if (xb_ld(&bar[XB_TMO])) break; if (sp > XB_SPIN_CAP) { atomicAdd(&bar[XB_TMO], 1u); break; } }
    }
    nloc = mine > 0u ? mine : 1u; nx = cnt > 0u ? cnt : 1u;
}

__device__ __forceinline__ void xcd_barrier(const XcdBarrier& b, const bool is_t0) {
    asm volatile("s_waitcnt vmcnt(0)" ::: "memory");
    __syncthreads();
    if (is_t0) {
        unsigned* bar = b.bar;
        __builtin_amdgcn_s_waitcnt(0);
        unsigned nloc = b.st[0], nx = b.st[1];
        if (nloc == 0u) { xcd_barrier_complete(bar, b.x, nloc, nx); b.st[0] = nloc; b.st[1] = nx; }
        const unsigned old = xb_add(&bar[XB_XSUB(b.x)], 1u);
        const unsigned gen = old / nloc;
        if (old + 1u == (gen + 1u) * nloc) {
            __builtin_amdgcn_fence(__ATOMIC_RELEASE, "agent");
            asm volatile("s_waitcnt vmcnt(0)" ::: "memory");
            const unsigned og = xb_add(&bar[XB_TOP], 1u);
            const unsigned tg = og / nx;
            if (og + 1u == (tg + 1u) * nx) xb_add(&bar[XB_TOPGEN], 1u);
            else XB_SPIN(xb_ld(&bar[XB_TOPGEN]) == tg, bar);
            __builtin_amdgcn_fence(__ATOMIC_ACQUIRE, "agent");
            xb_add(&bar[XB_XGEN(b.x)], 1u);
            asm volatile("s_waitcnt vmcnt(0)" ::: "memory");
        } else {
            XB_SPIN(xb_ld(&bar[XB_XGEN(b.x)]) == gen, bar);
            __builtin_amdgcn_fence(__ATOMIC_ACQUIRE, "agent");
            asm volatile("s_waitcnt vmcnt(0)" ::: "memory");
        }
    }
    __syncthreads();
}
typedef unsigned short bf16_t;
typedef short bf16x8 __attribute__((ext_vector_type(8)));
typedef float f32x4 __attribute__((ext_vector_type(4)));
typedef float f32x16 __attribute__((ext_vector_type(16)));
typedef unsigned u32x4 __attribute__((ext_vector_type(4)));
typedef unsigned u32x2 __attribute__((ext_vector_type(2)));
using pg8::cvt_pk_bf16;

constexpr int DM = 2048, TP = 16384, NSB = 32, TSQ = 32, NTOK = TP + NSB * TSQ, NSEQ = 33, PAST = 4096, NLAYER = 2;
constexpr int NU = 15104;
constexpr int U_AVAL = 0, U_AGATE = 512, U_ASG = 1024, U_Q = 1536, U_K = 2048, U_V = 2560, U_BSG = 3072, U_XC = 3584, U_CSG = 5248, U_DIN = 5760, U_DSG = 6272, U_G = 6784, U_F = 14976;
constexpr int IN_W = 14984, SHIFT_W = 1664;
constexpr float LOG2E = 1.4426950408889634f;
enum { I_XP = 0, I_XS, I_CK, I_CV, I_CLF, I_SCONV, I_SSHIFT, I_SWKV, I_SPOOL, I_CP, I_CS, I_NORMG, I_WADA, I_BADA, I_WIN, I_BF, I_CONVW, I_CONVB, I_CLNG, I_CLNB, I_MU, I_W0, I_W2, I_A0, I_A2,
       I_KK, I_KA, I_RK, I_GNG, I_GNB, I_POOLW, I_POOLB, I_POOLS, I_WBR, I_WOUT, I_FING, N_IN };
constexpr size_t O_YP = 0, O_YS = O_YP + (size_t)TP * DM, O_PK = O_YS + (size_t)1024 * DM, O_PV = O_PK + (size_t)2 * TP * 512, O_PLF = O_PV + (size_t)2 * TP * 512, O_PCONV = O_PLF + (size_t)2 * TP * 8,
                 O_PSHIFT = O_PCONV + 2 * 30 * 512, O_PWKV = O_PSHIFT + 2 * 1664, O_PPOOL = O_PWKV + 2 * 8 * 64 * 64, O_SK = O_PPOOL + 2 * 15 * 512, O_SV = O_SK + (size_t)2 * 1024 * 512,
                 O_SLF = O_SV + (size_t)2 * 1024 * 512, O_SCONV = O_SLF + 2 * 1024 * 8, O_SSHIFT = O_SCONV + (size_t)2 * 32 * 30 * 512, O_SWKV = O_SSHIFT + 2 * 32 * 1664,
                 O_SPOOL = O_SWKV + (size_t)2 * 32 * 8 * 64 * 64, O_END = O_SPOOL + (size_t)2 * 32 * 15 * 512;
static_assert(O_END == 75374848, "output size");
constexpr size_t al256(size_t x) { return (x + 255) & ~(size_t)255; }
constexpr int NCU_CH = 288, NRU = NCU_CH * 8;
constexpr size_t WS_CTL = 0, CTL_BYTES = 512 * 1024;
constexpr size_t WS_WIN = CTL_BYTES;
constexpr size_t WS_WBR = al256(WS_WIN + (size_t)2 * NU * 2048 * 2);
constexpr size_t WS_WOUT = al256(WS_WBR + (size_t)2 * 4 * 2048 * 512 * 2);
constexpr size_t WS_POOLW = al256(WS_WOUT + (size_t)2 * 2048 * 2048 * 2);
constexpr size_t WS_ADA = al256(WS_POOLW + (size_t)2 * 4 * 128 * 128 * 2);
constexpr size_t WS_H = al256(WS_ADA + (size_t)2 * 33 * 6144 * 4);
constexpr size_t WS_U = al256(WS_H + (size_t)NTOK * 2048 * 2);
constexpr size_t WS_XBUF = al256(WS_U + (size_t)NTOK * NU * 2);
constexpr size_t WS_OCAT = al256(WS_XBUF + (size_t)NTOK * 2048 * 4);
constexpr size_t WS_Z = al256(WS_OCAT + (size_t)4 * NTOK * 512 * 2);
constexpr size_t WS_MERGED = al256(WS_Z + (size_t)4 * NTOK * 2048 * 2);
constexpr size_t WS_FP = al256(WS_MERGED + (size_t)NTOK * 2048 * 2);
constexpr int GS_LEN = PAST + TSQ;
constexpr size_t WS_GS = al256(WS_FP + (size_t)8 * TP * 4);
constexpr size_t WS_VT = al256(WS_GS + (size_t)32 * 8 * GS_LEN * 4);
constexpr size_t WS_TQ = al256(WS_VT + (size_t)8 * 64 * TP * 2);
constexpr size_t WS_GM = al256(WS_TQ + (size_t)NRU * 4096 * 4);
constexpr size_t WS_ET = al256(WS_GM + (size_t)NRU * 4096 * 4);
constexpr size_t WS_Y0T = al256(WS_ET + (size_t)NRU * 4096 * 4);
constexpr size_t WS_SC = al256(WS_Y0T + (size_t)NRU * 4096 * 4);
constexpr size_t WS_BONUS = al256(WS_SC + (size_t)NRU * 4096 * 4);
constexpr size_t WS_GG = al256(WS_BONUS + (size_t)NRU * 64 * 4);
constexpr size_t WS_TG = al256(WS_GG + (size_t)16 * 8 * 4096 * 4);
constexpr size_t WS_SG = al256(WS_TG + (size_t)16 * 8 * 4096 * 4);
constexpr size_t WS_XPART = al256(WS_SG + (size_t)16 * 8 * 4096 * 4);
constexpr size_t WS_END = al256(WS_XPART + (size_t)2 * 8 * 1024 * 2048 * 4);
static_assert(WS_END < (size_t)2100 * 1024 * 1024, "workspace map exceeds the guaranteed d_ws size");
constexpr int CW_BAR = 0;
constexpr int CW_QUEUE = 16 * 3456 + 64;
constexpr int CW_KMAX = CW_QUEUE + 64 * 8;
static_assert((CW_KMAX + 64) * 4 <= (int)CTL_BYTES, "ctl");
constexpr int LDS_BYTES = 163840 - 256;
constexpr int LDS_XB_OFF = LDS_BYTES - 16;
constexpr int SLOT_F = 64 * 65;

#ifndef PROBE_ID
#define PROBE_ID 0
#endif
#ifndef PROBE_K
#define PROBE_K 1
#endif
constexpr int LDS_PROBE_OFF = 163840 - 256 - 64;
#if PROBE_ID
#define PT0() unsigned long long _pt0 = (blockIdx.x == 0 && threadIdx.x == 0) ? __builtin_amdgcn_s_memrealtime() : 0ull
#define PT1(id) do { if ((id) == PROBE_ID && blockIdx.x == 0 && threadIdx.x == 0) { *(LAS unsigned long long*)(lds + LDS_PROBE_OFF) += __builtin_amdgcn_s_memrealtime() - _pt0; } _pt0 = (blockIdx.x == 0 && threadIdx.x == 0) ? __builtin_amdgcn_s_memrealtime() : 0ull; } while (0)
#else
#define PT0() do {} while (0)
#define PT1(id) do {} while (0)
#endif
struct Params { const float* in[N_IN]; float* out; unsigned char* ws; int ph_lo, ph_hi, li, pad; };
typedef const __attribute__((address_space(4))) Params* KP;
__device__ __forceinline__ KP kp_fresh(KP k) { asm volatile("" : "+s"(k)); return k; }

__device__ __forceinline__ float bf2f(unsigned short b) { return __uint_as_float(((unsigned)b) << 16); }
__device__ __forceinline__ float bflo(unsigned w) { return __uint_as_float(w << 16); }
__device__ __forceinline__ float bfhi(unsigned w) { return __uint_as_float(w & 0xffff0000u); }
__device__ __forceinline__ unsigned short f2bf(float f) { return (unsigned short)(cvt_pk_bf16(f, 0.f) & 0xffffu); }
__device__ __forceinline__ float sigmoidf_(float x) { return 1.f / (1.f + __expf(-x)); }
__device__ __forceinline__ float siluf_(float x) { return x / (1.f + __expf(-x)); }
__device__ __forceinline__ float log_sigmoidf_(float z) { return fminf(z, 0.f) - log1pf(expf(-fabsf(z))); }
template <int CTRL> __device__ __forceinline__ float dpp_mov(float v) { return __int_as_float(__builtin_amdgcn_update_dpp(0, __float_as_int(v), CTRL, 0xF, 0xF, true)); }
__device__ __forceinline__ float wave_sum(float v) {
    v += dpp_mov<0xB1>(v); v += dpp_mov<0x4E>(v); v += dpp_mov<0x141>(v); v += dpp_mov<0x140>(v);
    const float r0 = __int_as_float(__builtin_amdgcn_readlane(__float_as_int(v), 0)), r1 = __int_as_float(__builtin_amdgcn_readlane(__float_as_int(v), 16));
    const float r2 = __int_as_float(__builtin_amdgcn_readlane(__float_as_int(v), 32)), r3 = __int_as_float(__builtin_amdgcn_readlane(__float_as_int(v), 48));
    return (r0 + r1) + (r2 + r3);
}
__device__ __forceinline__ float wave_max(float v) {
    v = fmaxf(v, dpp_mov<0xB1>(v)); v = fmaxf(v, dpp_mov<0x4E>(v)); v = fmaxf(v, dpp_mov<0x141>(v)); v = fmaxf(v, dpp_mov<0x140>(v));
    const float r0 = __int_as_float(__builtin_amdgcn_readlane(__float_as_int(v), 0)), r1 = __int_as_float(__builtin_amdgcn_readlane(__float_as_int(v), 16));
    const float r2 = __int_as_float(__builtin_amdgcn_readlane(__float_as_int(v), 32)), r3 = __int_as_float(__builtin_amdgcn_readlane(__float_as_int(v), 48));
    return fmaxf(fmaxf(r0, r1), fmaxf(r2, r3));
}
__device__ __forceinline__ float wave_min(float v) { return -wave_max(-v); }
__device__ __forceinline__ float xhalf_max(float m) { const auto rr = __builtin_amdgcn_permlane32_swap(__float_as_uint(m), __float_as_uint(m), false, false); return fmaxf(__uint_as_float(rr[0]), __uint_as_float(rr[1])); }
__device__ __forceinline__ float xhalf_sum(float m) { const auto rr = __builtin_amdgcn_permlane32_swap(__float_as_uint(m), __float_as_uint(m), false, false); return __uint_as_float(rr[0]) + __uint_as_float(rr[1]); }
__device__ __forceinline__ bf16x8 pack8f(const f32x4 a, const f32x4 b) { u32x4 w; w.x = cvt_pk_bf16(a[0], a[1]); w.y = cvt_pk_bf16(a[2], a[3]); w.z = cvt_pk_bf16(b[0], b[1]); w.w = cvt_pk_bf16(b[2], b[3]); return __builtin_bit_cast(bf16x8, w); }
__device__ __forceinline__ float fast_tanh(float x) { const float e = __expf(-2.f * fabsf(x)); const float t = (1.f - e) * __builtin_amdgcn_rcpf(1.f + e); return x < 0.f ? -t : t; }
__device__ __forceinline__ void tr_tile(const float* __restrict__ src, size_t ld, int k0, int c0, int nvalid, bf16_t* __restrict__ dst, int K, LAS float* scr, int lane) {
    float tv[64];
#pragma unroll
    for (int kk = 0; kk < 64; ++kk) tv[kk] = src[(size_t)(k0 + kk) * ld + c0 + (lane < nvalid ? lane : 0)];
#pragma unroll
    for (int kk = 0; kk < 64; ++kk) scr[kk * 65 + lane] = (lane < nvalid) ? tv[kk] : 0.f;
    const int nl = lane >> 3, kc8 = (lane & 7) * 8;
#pragma unroll
    for (int it = 0; it < 8; ++it) { const int nn = 8 * it + nl; const LAS float* s = scr + kc8 * 65 + nn;
        u32x4 w; w.x = cvt_pk_bf16(s[0], s[65]); w.y = cvt_pk_bf16(s[130], s[195]); w.z = cvt_pk_bf16(s[260], s[325]); w.w = cvt_pk_bf16(s[390], s[455]);
        *(u32x4*)(dst + (size_t)nn * K + k0 + kc8) = w; }
}
__device__ __forceinline__ void p0_weights(KP p, LAS unsigned char* lds, int gw, int ngw, int wave, int lane) {
    LAS float* scr = (LAS float*)lds + wave * SLOT_F;
    constexpr int T_WIN = (NU / 64) * 32, T_WBR = 4 * 32 * 8, T_WOUT = 32 * 32, T_POOL = 4 * 2 * 2, T_L = T_WIN + T_WBR + T_WOUT + T_POOL;
    for (int it = gw; it < 2 * T_L; it += ngw) {
        const int l = it / T_L; int r = it % T_L;
        if (r < T_WIN) {
            const int nt = r / 32, kt = r % 32, m0 = nt * 64;
            int c0, nvalid = 64;
            if (m0 < 3072) c0 = m0; else if (m0 < U_F) c0 = m0 + 8; else if (m0 == U_F) { c0 = 3072; nvalid = 8; } else { c0 = 0; nvalid = 0; }
            tr_tile(p->in[I_WIN] + (size_t)l * 2048 * IN_W, IN_W, kt * 64, c0, nvalid, (bf16_t*)(p->ws + WS_WIN) + ((size_t)l * NU + m0) * 2048, 2048, scr, lane);
            continue; }
        r -= T_WIN;
        if (r < T_WBR) {
            const int n = r / 256, q = r % 256, nt = q / 8, kt = q % 8;
            tr_tile(p->in[I_WBR] + ((size_t)(l * 4 + n) * 512) * 2048, 2048, kt * 64, nt * 64, 64, (bf16_t*)(p->ws + WS_WBR) + ((size_t)(l * 4 + n) * 2048 + nt * 64) * 512, 512, scr, lane);
            continue; }
        r -= T_WBR;
        if (r < T_WOUT) {
            const int nt = r / 32, kt = r % 32;
            tr_tile(p->in[I_WOUT] + (size_t)l * 2048 * 2048, 2048, kt * 64, nt * 64, 64, (bf16_t*)(p->ws + WS_WOUT) + ((size_t)l * 2048 + nt * 64) * 2048, 2048, scr, lane);
            continue; }
        r -= T_WOUT;
        {
            const int g = r / 4, q = r % 4, nt = q / 2, kt = q % 2;
            tr_tile(p->in[I_POOLW] + (size_t)(l * 4 + g) * 128 * 128, 128, kt * 64, nt * 64, 64, (bf16_t*)(p->ws + WS_POOLW) + ((size_t)(l * 4 + g) * 128 + nt * 64) * 128, 128, scr, lane);
        }
    }
}
__device__ __forceinline__ void ada_unit(KP p, int unit, LAS unsigned char* lds, int tid) {
    const int wave = tid >> 6, lane = tid & 63, l = unit / 96, n0 = (unit % 96) * 64;
    LAS float* cs = (LAS float*)lds + wave * (33 * 64);
    LAS float* red = (LAS float*)lds + 8 * 33 * 64;
    const float* W = p->in[I_WADA] + (size_t)l * 2048 * 6144;
    const float* cp = p->in[I_CP]; const float* csm = p->in[I_CS];
    float acc[33];
#pragma unroll
    for (int s = 0; s < 33; ++s) acc[s] = 0.f;
    float wv[16];
#pragma unroll
    for (int j = 0; j < 16; ++j) wv[j] = W[(size_t)(wave * 256 + j) * 6144 + n0 + lane];
#pragma unroll 1
    for (int step = 0; step < 16; ++step) {
        const int k0 = wave * 256 + step * 16, kn = wave * 256 + (step < 15 ? step + 1 : step) * 16;
        float wn[16];
#pragma unroll
        for (int j = 0; j < 16; ++j) wn[j] = W[(size_t)(kn + j) * 6144 + n0 + lane];
        if ((step & 3) == 0) {
#pragma unroll
            for (int s = 0; s < 33; ++s) { const float c = (s == 0) ? cp[k0 + lane] : csm[(size_t)(s - 1) * 2048 + k0 + lane]; cs[s * 64 + lane] = siluf_(c); } }
        const int kk0 = (step & 3) * 16;
#pragma unroll
        for (int q4 = 0; q4 < 4; ++q4) {
#pragma unroll
            for (int s = 0; s < 33; ++s) { const f32x4 c4 = *(const LAS f32x4*)(cs + s * 64 + kk0 + 4 * q4); acc[s] += c4.x * wv[4 * q4] + c4.y * wv[4 * q4 + 1] + c4.z * wv[4 * q4 + 2] + c4.w * wv[4 * q4 + 3]; } }
#pragma unroll
        for (int j = 0; j < 16; ++j) wv[j] = wn[j];
    }
#pragma unroll
    for (int s = 0; s < 33; ++s) red[(wave * 33 + s) * 64 + lane] = acc[s];
    __syncthreads();
    for (int idx = tid; idx < 33 * 64; idx += 512) { const int s = idx >> 6, n = idx & 63; float v = p->in[I_BADA][l * 6144 + n0 + n];
#pragma unroll
        for (int w = 0; w < 8; ++w) v += red[(w * 33 + s) * 64 + n];
        ((float*)(p->ws + WS_ADA))[((size_t)l * 33 + s) * 6144 + n0 + n] = v; }
    __syncthreads();
}
__device__ __forceinline__ void load_x8(KP p, int l, int row, int lane, f32x4 (&v)[8]) {
    if (row < TP) { const f32x4* x4 = (const f32x4*)(l == 0 ? p->in[I_XP] + (size_t)row * DM : (const float*)(p->ws + WS_XBUF) + (size_t)row * DM) + lane;
#pragma unroll
        for (int j = 0; j < 8; ++j) v[j] = x4[64 * j]; }
    else { const int r = row - TP; const f32x4* x4 = (const f32x4*)(p->in[I_XS] + (size_t)r * DM) + lane;
#pragma unroll
        for (int j = 0; j < 8; ++j) v[j] = x4[64 * j];
        for (int s = 0; s < 8 * l; ++s) { const f32x4* q4 = (const f32x4*)((const float*)(p->ws + WS_XPART) + ((size_t)s * 1024 + r) * DM) + lane;
#pragma unroll
            for (int j = 0; j < 8; ++j) v[j] += q4[64 * j]; } }
}
__device__ __forceinline__ void p1_rows(KP p, int l, int gw, int ngw, int lane) {
    const f32x4* g4 = (const f32x4*)(p->in[I_NORMG] + l * DM) + lane;
    f32x4 a[8], sh[8]; int cur_seq = -1;
    for (int row = gw; row < NTOK; row += ngw) {
        const int seq = row < TP ? 0 : 1 + ((row - TP) >> 5);
        f32x4 v[8]; float ss = 0.f; load_x8(p, l, row, lane, v);
#pragma unroll
        for (int j = 0; j < 8; ++j) { ss += (v[j].x * v[j].x + v[j].y * v[j].y) + (v[j].z * v[j].z + v[j].w * v[j].w); }
        if (seq != cur_seq) { cur_seq = seq;
            const f32x4* sh4 = (const f32x4*)((const float*)(p->ws + WS_ADA) + ((size_t)l * 33 + seq) * 6144) + lane; const f32x4* sc4 = sh4 + 512;
#pragma unroll
            for (int j = 0; j < 8; ++j) { a[j] = g4[64 * j] * (sc4[64 * j] + 1.f); sh[j] = sh4[64 * j]; } }
        const float rstd = 1.f / sqrtf(wave_sum(ss) * (1.f / DM) + 1e-6f);
        u32x2* o = (u32x2*)((bf16_t*)(p->ws + WS_H) + (size_t)row * DM) + lane;
#pragma unroll
        for (int j = 0; j < 8; ++j) { const f32x4 y = v[j] * rstd * a[j] + sh[j];
            u32x2 w; w.x = cvt_pk_bf16(y.x, y.y); w.y = cvt_pk_bf16(y.z, y.w); o[64 * j] = w; }
    }
}
__device__ __forceinline__ void p_final_rows(KP p, int gw, int ngw, int lane) {
    const f32x4* g4 = (const f32x4*)p->in[I_FING] + lane;
    for (int row = gw; row < NTOK; row += ngw) {
        f32x4 v[8]; float ss = 0.f; load_x8(p, 2, row, lane, v);
#pragma unroll
        for (int j = 0; j < 8; ++j) { ss += (v[j].x * v[j].x + v[j].y * v[j].y) + (v[j].z * v[j].z + v[j].w * v[j].w); }
        const float rstd = 1.f / sqrtf(wave_sum(ss) * (1.f / DM) + 1e-6f);
        f32x4* o = (f32x4*)(p->out + O_YP + (size_t)row * DM) + lane;
#pragma unroll
        for (int j = 0; j < 8; ++j) o[64 * j] = v[j] * rstd * g4[64 * j];
    }
}
struct EpiU {
    static constexpr bool PERM = true, AFTER_DRAIN = false;
    bf16_t* U; float* out; const float* bf; int l;
    __device__ __forceinline__ void operator()(const f32x4 (&acc)[2][2][4][2], const pg8::Unit& u, int wr, int wc, int fr, int fq) const {
        const int row0 = u.pm * 256 + wr * 64 + fr, col0 = u.pn * 256 + wc * 32 + 8 * fq;
#pragma unroll
        for (int ai = 0; ai < 2; ++ai)
#pragma unroll
            for (int m = 0; m < 4; ++m) { bf16_t* rowp = U + (size_t)(row0 + ai * 128 + m * 16) * NU + col0;
#pragma unroll
                for (int bj = 0; bj < 2; ++bj) { const f32x4 v0 = acc[ai][bj][m][0], v1 = acc[ai][bj][m][1];
                    u32x4 w; w.x = cvt_pk_bf16(v0[0], v0[1]); w.y = cvt_pk_bf16(v0[2], v0[3]); w.z = cvt_pk_bf16(v1[0], v1[1]); w.w = cvt_pk_bf16(v1[2], v1[3]);
                    *(u32x4*)(rowp + bj * 128) = w; } }
        if (u.pn >= 8 && u.pn < 12) {
            const bool isv = u.pn >= 10; const int cin = (u.pn - (isv ? 10 : 8)) * 256 + wc * 32 + 8 * fq;
#pragma unroll
            for (int ai = 0; ai < 2; ++ai)
#pragma unroll
                for (int m = 0; m < 4; ++m) { const int row = row0 + ai * 128 + m * 16;
                    float* dst = row < TP ? out + (isv ? O_PV : O_PK) + ((size_t)l * TP + row) * 512 : out + (isv ? O_SV : O_SK) + ((size_t)l * 1024 + (row - TP)) * 512;
#pragma unroll
                    for (int bj = 0; bj < 2; ++bj) { *(f32x4*)(dst + cin + bj * 128) = acc[ai][bj][m][0]; *(f32x4*)(dst + cin + bj * 128 + 4) = acc[ai][bj][m][1]; } }
        }
        if (u.pn == 58 && wc == 0 && fq == 0) {
            const f32x4 b0 = *(const f32x4*)(bf + l * 8), b1 = *(const f32x4*)(bf + l * 8 + 4);
#pragma unroll
            for (int ai = 0; ai < 2; ++ai)
#pragma unroll
                for (int m = 0; m < 4; ++m) { const int row = row0 + ai * 128 + m * 16;
                    float* dst = row < TP ? out + O_PLF + ((size_t)l * TP + row) * 8 : out + O_SLF + ((size_t)l * 1024 + (row - TP)) * 8;
                    const f32x4 z0 = acc[ai][1][m][0] + b0, z1 = acc[ai][1][m][1] + b1; f32x4 o0, o1;
#pragma unroll
                    for (int e = 0; e < 4; ++e) { o0[e] = log_sigmoidf_(z0[e]); o1[e] = log_sigmoidf_(z1[e]); }
                    *(f32x4*)dst = o0; *(f32x4*)(dst + 4) = o1; }
        }
    }
};
struct BranchOrder {
    int G, c;
    __device__ __forceinline__ bool next(int i, pg8::Unit& u) const { const int L = i * G + c; if (L >= 4 * 544) return false; const int n = L / 544, t = L - n * 544; u.pm = n * 68 + (t >> 3); u.pn = n * 8 + (t & 7); return true; }
    __device__ __forceinline__ void a_ready(const pg8::Unit&) const {}
    __device__ __forceinline__ void done(const pg8::Unit&) const {}
};
struct EpiZ {
    static constexpr bool PERM = true, AFTER_DRAIN = false;
    bf16_t* Z; const bf16_t* U;
    __device__ __forceinline__ void operator()(const f32x4 (&acc)[2][2][4][2], const pg8::Unit& u, int wr, int wc, int fr, int fq) const {
        const int row0 = u.pm * 256 + wr * 64 + fr, col0 = (u.pn & 7) * 256 + wc * 32 + 8 * fq;
#pragma unroll
        for (int ai = 0; ai < 2; ++ai)
#pragma unroll
            for (int m = 0; m < 4; ++m) { bf16_t* rowp = Z + (size_t)(row0 + ai * 128 + m * 16) * DM + col0;
#pragma unroll
                for (int bj = 0; bj < 2; ++bj) { const f32x4 v0 = acc[ai][bj][m][0], v1 = acc[ai][bj][m][1];
                    u32x4 w; w.x = cvt_pk_bf16(v0[0], v0[1]); w.y = cvt_pk_bf16(v0[2], v0[3]); w.z = cvt_pk_bf16(v1[0], v1[1]); w.w = cvt_pk_bf16(v1[2], v1[3]);
                    *(u32x4*)(rowp + bj * 128) = w; } }
    }
};
__device__ __forceinline__ void merge_pass(KP p, int l, int gtid, int ngt) {
    const bf16_t* U = (const bf16_t*)(p->ws + WS_U); const bf16_t* Z = (const bf16_t*)(p->ws + WS_Z); bf16_t* M = (bf16_t*)(p->ws + WS_MERGED);
    for (int it0 = gtid; it0 < NTOK * 256; it0 += 3 * ngt) {
        u32x4 gv[3][4], zv[3][4];
#pragma unroll
        for (int k = 0; k < 3; ++k) { const int it = it0 + k * ngt < NTOK * 256 ? it0 + k * ngt : it0; const int row = it >> 8, col = (it & 255) * 8;
#pragma unroll
            for (int n = 0; n < 4; ++n) { gv[k][n] = *(const u32x4*)(U + (size_t)row * NU + U_G + n * 2048 + col); zv[k][n] = *(const u32x4*)(Z + ((size_t)n * NTOK + row) * DM + col); } }
#pragma unroll
        for (int k = 0; k < 3; ++k) { const int it = it0 + k * ngt; if (it < NTOK * 256) { const int row = it >> 8, col = (it & 255) * 8;
            float s[8];
#pragma unroll
            for (int e = 0; e < 8; ++e) s[e] = 0.f;
#pragma unroll
            for (int n = 0; n < 4; ++n) { const u32x4 g = gv[k][n], z = zv[k][n];
                s[0] += sigmoidf_(bflo(g.x)) * bflo(z.x); s[1] += sigmoidf_(bfhi(g.x)) * bfhi(z.x); s[2] += sigmoidf_(bflo(g.y)) * bflo(z.y); s[3] += sigmoidf_(bfhi(g.y)) * bfhi(z.y);
                s[4] += sigmoidf_(bflo(g.z)) * bflo(z.z); s[5] += sigmoidf_(bfhi(g.z)) * bfhi(z.z); s[6] += sigmoidf_(bflo(g.w)) * bflo(z.w); s[7] += sigmoidf_(bfhi(g.w)) * bfhi(z.w); }
            u32x4 w; w.x = cvt_pk_bf16(s[0], s[1]); w.y = cvt_pk_bf16(s[2], s[3]); w.z = cvt_pk_bf16(s[4], s[5]); w.w = cvt_pk_bf16(s[6], s[7]);
            *(u32x4*)(M + (size_t)row * DM + col) = w; } }
    }
}
struct EpiOut {
    static constexpr bool PERM = false, AFTER_DRAIN = false;
    const float* xp; const float* xs; const float* xb; const float* ada; float* xout; int l;
    __device__ __forceinline__ void operator()(const f32x4 (&acc)[2][2][4][2], const pg8::Unit& u, int wr, int wc, int fr, int fq) const {
        const int row0 = u.pm * 256 + wr * 64 + fr, col0 = u.pn * 256 + wc * 32 + 4 * fq;
        f32x4 gt[2][2];
#pragma unroll
        for (int ai = 0; ai < 2; ++ai)
#pragma unroll
            for (int mp = 0; mp < 4; mp += 2) {
                f32x4 bs[2][2][2], gv[2][2][2];
#pragma unroll
                for (int mm = 0; mm < 2; ++mm) { const int row = row0 + ai * 128 + (mp + mm) * 16;
                    const float* base = l == 0 ? (row < TP ? xp + (size_t)row * DM : xs + (size_t)(row - TP) * DM) : xb + (size_t)row * DM;
                    const float* gate = ada + ((size_t)l * 33 + (row < TP ? 0 : 1 + ((row - TP) >> 5))) * 6144 + 4096;
#pragma unroll
                    for (int bj = 0; bj < 2; ++bj)
#pragma unroll
                        for (int n = 0; n < 2; ++n) { const int col = col0 + bj * 128 + n * 16; bs[mm][bj][n] = *(const f32x4*)(base + col); gv[mm][bj][n] = *(const f32x4*)(gate + col); } }
#pragma unroll
                for (int mm = 0; mm < 2; ++mm) { const int row = row0 + ai * 128 + (mp + mm) * 16;
#pragma unroll
                    for (int bj = 0; bj < 2; ++bj)
#pragma unroll
                        for (int n = 0; n < 2; ++n) { const int col = col0 + bj * 128 + n * 16; *(f32x4*)(xout + (size_t)row * DM + col) = bs[mm][bj][n] + gv[mm][bj][n] * acc[ai][bj][mp + mm][n]; } }
            }
        (void)gt;
    }
};
struct OneUnit {
    int pm, pn; bool valid;
    __device__ __forceinline__ bool next(int i, pg8::Unit& u) const { if (i > 0 || !valid) return false; u.pm = pm; u.pn = pn; return true; }
    __device__ __forceinline__ void a_ready(const pg8::Unit&) const {}
    __device__ __forceinline__ void done(const pg8::Unit&) const {}
};
struct EpiOutPart {
    static constexpr bool PERM = false, AFTER_DRAIN = false;
    const float* ada; float* part; int l;
    __device__ __forceinline__ void operator()(const f32x4 (&acc)[2][2][4][2], const pg8::Unit& u, int wr, int wc, int fr, int fq) const {
        const int row0 = u.pm * 256 + wr * 64 + fr - TP, col0 = u.pn * 256 + wc * 32 + 4 * fq;
#pragma unroll
        for (int ai = 0; ai < 2; ++ai)
#pragma unroll
            for (int m = 0; m < 4; ++m) { const int r = row0 + ai * 128 + m * 16;
                const float* gate = ada + ((size_t)l * 33 + 1 + (r >> 5)) * 6144 + 4096;
#pragma unroll
                for (int bj = 0; bj < 2; ++bj)
#pragma unroll
                    for (int n = 0; n < 2; ++n) { const int col = col0 + bj * 128 + n * 16; *(f32x4*)(part + (size_t)r * DM + col) = *(const f32x4*)(gate + col) * acc[ai][bj][m][n]; } }
    }
};
constexpr int CGS = 516;
__device__ __forceinline__ void conv_unit(KP p, int l, int tile, LAS unsigned char* lds, int tid) {
    const bf16_t* U = (const bf16_t*)(p->ws + WS_U);
    const int c = tid, wave = tid >> 6, lane = tid & 63;
    const bool samp = tile >= 512; const int b = tile - 512, row0 = samp ? TP + b * 32 : tile * 32;
    const bool last = samp || tile == 511;
    LAS float* gl = (LAS float*)lds;
    LAS bf16_t* sgl = (LAS bf16_t*)(lds + 62 * CGS * 4);
    LAS float* red = (LAS float*)(lds + 62 * CGS * 4 + 32 * 512 * 2);
    LAS float* st = red + 8 * 32;
#pragma unroll
    for (int k = 0; k < 8; ++k) { const int task = tid + 512 * k; if (task < 62 * 64) { const int i = task >> 6, ch = task & 63; f32x4 o0, o1;
        const int rel = i - 30;
        if (rel < 0 && samp) { const float* hp = p->in[I_SCONV] + (((size_t)l * 32 + b) * 30 + i) * 512 + 8 * ch; o0 = *(const f32x4*)hp; o1 = *(const f32x4*)(hp + 4); }
        else if (row0 + rel < 0) { o0 = (f32x4){0.f, 0.f, 0.f, 0.f}; o1 = o0; }
        else { const bf16_t* up = U + (size_t)(row0 + rel) * NU + 8 * ch; const u32x4 v = *(const u32x4*)(up + U_AVAL), g = *(const u32x4*)(up + U_AGATE);
            o0 = (f32x4){bflo(v.x) * sigmoidf_(bflo(g.x)), bfhi(v.x) * sigmoidf_(bfhi(g.x)), bflo(v.y) * sigmoidf_(bflo(g.y)), bfhi(v.y) * sigmoidf_(bfhi(g.y))};
            o1 = (f32x4){bflo(v.z) * sigmoidf_(bflo(g.z)), bfhi(v.z) * sigmoidf_(bfhi(g.z)), bflo(v.w) * sigmoidf_(bflo(g.w)), bfhi(v.w) * sigmoidf_(bfhi(g.w))}; }
        *(LAS f32x4*)(gl + i * CGS + 8 * ch) = o0; *(LAS f32x4*)(gl + i * CGS + 8 * ch + 4) = o1; } }
#pragma unroll
    for (int k = 0; k < 4; ++k) { const int task = tid + 512 * k, t = task >> 6, ch = task & 63; const u32x4 s = *(const u32x4*)(U + (size_t)(row0 + t) * NU + U_ASG + 8 * ch);
        u32x4 w; w.x = cvt_pk_bf16(siluf_(bflo(s.x)), siluf_(bfhi(s.x))); w.y = cvt_pk_bf16(siluf_(bflo(s.y)), siluf_(bfhi(s.y))); w.z = cvt_pk_bf16(siluf_(bflo(s.z)), siluf_(bfhi(s.z))); w.w = cvt_pk_bf16(siluf_(bflo(s.w)), siluf_(bfhi(s.w)));
        *(LAS u32x4*)(sgl + t * 512 + 8 * ch) = w; }
    const float cb = p->in[I_CONVB][l * 512 + c], lg = p->in[I_CLNG][l * 512 + c], lb = p->in[I_CLNB][l * 512 + c];
    float wk[31];
#pragma unroll
    for (int k = 0; k < 31; ++k) wk[k] = p->in[I_CONVW][((size_t)l * 31 + k) * 512 + c];
    __syncthreads();
    if (last) {
        float* dst = samp ? p->out + O_SCONV + (((size_t)l * 32 + b) * 30) * 512 + c : p->out + O_PCONV + ((size_t)l * 30) * 512 + c;
#pragma unroll
        for (int t = 2; t < 32; ++t) dst[(size_t)(t - 2) * 512] = gl[(30 + t) * CGS + c];
    }
    bf16_t* oa = (bf16_t*)(p->ws + WS_OCAT);
#pragma unroll 1
    for (int half = 0; half < 2; ++half) {
        float z[46];
#pragma unroll
        for (int i = 0; i < 46; ++i) z[i] = gl[(16 * half + i) * CGS + c];
        float hv[16];
#pragma unroll
        for (int tt = 0; tt < 16; ++tt) hv[tt] = cb;
#pragma unroll
        for (int k = 0; k < 31; ++k) {
#pragma unroll
            for (int tt = 0; tt < 16; ++tt) hv[tt] += z[tt + k] * wk[k]; }
#pragma unroll
        for (int tt = 0; tt < 16; ++tt) { const float s1 = wave_sum(hv[tt]), s2 = wave_sum(hv[tt] * hv[tt]); if (lane == 0) { red[(wave * 16 + tt) * 2] = s1; red[(wave * 16 + tt) * 2 + 1] = s2; } }
        __syncthreads();
        if (tid < 16) { float s1 = 0.f, s2 = 0.f;
#pragma unroll
            for (int w = 0; w < 8; ++w) { s1 += red[(w * 16 + tid) * 2]; s2 += red[(w * 16 + tid) * 2 + 1]; }
            const float mean = s1 * (1.f / 512.f), var = fmaxf(s2 * (1.f / 512.f) - mean * mean, 0.f);
            st[tid * 2] = mean; st[tid * 2 + 1] = 1.f / sqrtf(var + 1e-5f); }
        __syncthreads();
#pragma unroll
        for (int tt = 0; tt < 16; ++tt) { const float y = (hv[tt] - st[tt * 2]) * st[tt * 2 + 1] * lg + lb; const int t = 16 * half + tt;
            oa[(size_t)(row0 + t) * 512 + c] = f2bf(siluf_(y) * bf2f(sgl[t * 512 + c])); }
    }
    __syncthreads();
}
__device__ __forceinline__ void pool_unit(KP p, int l, int tile, LAS unsigned char* lds, int tid) {
    const bf16_t* U = (const bf16_t*)(p->ws + WS_U);
    const int c = tid, wave = tid >> 6, lane = tid & 63;
    const bool samp = tile >= 512; const int b = tile - 512, row0 = samp ? TP + b * 32 : tile * 32;
    constexpr int PST = 520;
    LAS float* zl = (LAS float*)lds;
    LAS bf16_t* pl = (LAS bf16_t*)(lds + 47 * CGS * 4);
#pragma unroll
    for (int k = 0; k < 6; ++k) { const int task = tid + 512 * k; if (task < 47 * 64) { const int i = task >> 6, ch = task & 63; f32x4 o0, o1; const int rel = i - 15;
        if (rel < 0 && samp) { const float* hp = p->in[I_SPOOL] + (((size_t)l * 32 + b) * 15 + i) * 512 + 8 * ch; o0 = *(const f32x4*)hp; o1 = *(const f32x4*)(hp + 4); }
        else if (row0 + rel < 0) { o0 = (f32x4){0.f, 0.f, 0.f, 0.f}; o1 = o0; }
        else { const u32x4 v = *(const u32x4*)(U + (size_t)(row0 + rel) * NU + U_DIN + 8 * ch); o0 = (f32x4){bflo(v.x), bfhi(v.x), bflo(v.y), bfhi(v.y)}; o1 = (f32x4){bflo(v.z), bfhi(v.z), bflo(v.w), bfhi(v.w)}; }
        *(LAS f32x4*)(zl + i * CGS + 8 * ch) = o0; *(LAS f32x4*)(zl + i * CGS + 8 * ch + 4) = o1; } }
    u32x4 sgv[4];
#pragma unroll
    for (int k = 0; k < 4; ++k) { const int task = tid + 512 * k; sgv[k] = *(const u32x4*)(U + (size_t)(row0 + (task >> 6)) * NU + U_DSG + 8 * (task & 63)); }
    __syncthreads();
    {
        float z[47];
#pragma unroll
        for (int i = 0; i < 47; ++i) z[i] = zl[i * CGS + c];
        if (samp || tile == 511) {
            float* dst = samp ? p->out + O_SPOOL + (((size_t)l * 32 + b) * 15) * 512 + c : p->out + O_PPOOL + ((size_t)l * 15) * 512 + c;
#pragma unroll
            for (int t = 17; t < 32; ++t) dst[(size_t)(t - 17) * 512] = z[15 + t];
        }
        const int w = 2 << (c >> 7);
#pragma unroll
        for (int t = 0; t < 32; ++t) { float s = 0.f;
#pragma unroll
            for (int i = 0; i < 16; ++i) s += (i < w) ? z[15 + t - i] : 0.f;
            const int pos = samp ? PAST + t : row0 + t; const int cnt = (pos + 1 < w) ? pos + 1 : w;
            pl[t * PST + c] = f2bf(s / (float)cnt - z[15 + t]); }
    }
    __syncthreads();
    LAS bf16_t* sl = (LAS bf16_t*)lds;
    LAS bf16_t* ol = sl + 32 * PST;
#pragma unroll
    for (int k = 0; k < 4; ++k) { const int task = tid + 512 * k, t = task >> 6, ch = task & 63; const u32x4 s = sgv[k];
        u32x4 w; w.x = cvt_pk_bf16(siluf_(bflo(s.x)), siluf_(bfhi(s.x))); w.y = cvt_pk_bf16(siluf_(bflo(s.y)), siluf_(bfhi(s.y))); w.z = cvt_pk_bf16(siluf_(bflo(s.z)), siluf_(bfhi(s.z))); w.w = cvt_pk_bf16(siluf_(bflo(s.w)), siluf_(bfhi(s.w)));
        *(LAS u32x4*)(sl + t * PST + 8 * ch) = w; }
    __syncthreads();
    {
        const int g = wave >> 1, fr = lane & 15, kq = lane >> 4;
        const bf16_t* WT = (const bf16_t*)(p->ws + WS_POOLW) + (size_t)(l * 4 + g) * 128 * 128;
        f32x4 acc[2][4];
#pragma unroll
        for (int mt = 0; mt < 2; ++mt)
#pragma unroll
            for (int nt = 0; nt < 4; ++nt) acc[mt][nt] = (f32x4){0.f, 0.f, 0.f, 0.f};
#pragma unroll
        for (int ks = 0; ks < 4; ++ks) {
            bf16x8 af[2];
#pragma unroll
            for (int mt = 0; mt < 2; ++mt) af[mt] = *(const LAS bf16x8*)(pl + (16 * mt + fr) * PST + g * 128 + 32 * ks + 8 * kq);
#pragma unroll
            for (int nt = 0; nt < 4; ++nt) { const int dl = (wave & 1) * 64 + 16 * nt + fr;
                const bf16x8 bfr = *(const bf16x8*)(WT + (size_t)dl * 128 + 32 * ks + 8 * kq);
#pragma unroll
                for (int mt = 0; mt < 2; ++mt) acc[mt][nt] = __builtin_amdgcn_mfma_f32_16x16x32_bf16(af[mt], bfr, acc[mt][nt], 0, 0, 0); }
        }
#pragma unroll
        for (int nt = 0; nt < 4; ++nt) { const int d = wave * 64 + 16 * nt + fr; const float pb = p->in[I_POOLB][l * 512 + d], ps = p->in[I_POOLS][l * 512 + d];
#pragma unroll
            for (int mt = 0; mt < 2; ++mt)
#pragma unroll
                for (int r = 0; r < 4; ++r) { const int t = 16 * mt + 4 * kq + r; ol[t * PST + d] = f2bf((acc[mt][nt][r] + pb) * ps * bf2f(sl[t * PST + d])); } }
    }
    __syncthreads();
    bf16_t* od = (bf16_t*)(p->ws + WS_OCAT) + (size_t)3 * NTOK * 512;
#pragma unroll
    for (int k = 0; k < 4; ++k) { const int task = tid + 512 * k, t = task >> 6, ch = task & 63; *(u32x4*)(od + (size_t)(row0 + t) * 512 + 8 * ch) = *(const LAS u32x4*)(ol + t * PST + 8 * ch); }
    __syncthreads();
}
__device__ __forceinline__ void fp_unit(KP p, int l, int h, LAS unsigned char* lds, int tid) {
    const float* lf = p->out + O_PLF + (size_t)l * TP * 8 + h;
    LAS float* part = (LAS float*)lds;
    float v[32]; float s = 0.f;
#pragma unroll
    for (int i = 0; i < 32; ++i) { v[i] = lf[(size_t)(tid * 32 + i) * 8]; s += v[i]; }
    part[tid] = s;
    __syncthreads();
    float pre = 0.f;
    for (int j = 0; j < tid; ++j) pre += part[j];
    float* F = (float*)(p->ws + WS_FP) + (size_t)h * TP + tid * 32;
#pragma unroll
    for (int i = 0; i < 32; ++i) { pre += v[i]; F[i] = pre * LOG2E; }
    __syncthreads();
}
__device__ __forceinline__ void gs_unit(KP p, int l, int b, LAS unsigned char* lds, int tid) {
    const int h = tid & 7, ch = tid >> 3;
    const float* cl = p->in[I_CLF] + (((size_t)l * 32 + b) * PAST + ch * 64) * 8 + h;
    LAS float* part = (LAS float*)lds;
    float v[64]; float s = 0.f;
#pragma unroll
    for (int i = 0; i < 64; ++i) v[i] = cl[(size_t)i * 8];
#pragma unroll
    for (int i = 0; i < 64; ++i) s += v[i];
    part[ch * 8 + h] = s;
    __syncthreads();
    float suf = 0.f;
    for (int j = ch + 1; j < 64; ++j) suf += part[j * 8 + h];
    float* G = (float*)(p->ws + WS_GS) + ((size_t)b * 8 + h) * GS_LEN + ch * 64;
#pragma unroll
    for (int i = 63; i >= 0; --i) { G[i] = -suf * LOG2E; suf += v[i]; }
    if (tid < 8) { const float* nl = p->out + O_SLF + ((size_t)l * 1024 + b * 32) * 8 + tid; float* Gn = (float*)(p->ws + WS_GS) + ((size_t)b * 8 + tid) * GS_LEN + PAST; float w[32]; float run = 0.f;
#pragma unroll
        for (int i = 0; i < 32; ++i) w[i] = nl[i * 8];
#pragma unroll
        for (int i = 0; i < 32; ++i) { run += w[i]; Gn[i] = run * LOG2E; } }
    __syncthreads();
}
__device__ __forceinline__ void vt_tile(KP p, int l, int tile, LAS unsigned char* lds, int wave, int lane) {
    const int h = tile >> 8, tb = tile & 255, tl = lane >> 3, q8 = (lane & 7) * 8;
    const bf16_t* U = (const bf16_t*)(p->ws + WS_U);
    LAS unsigned short* scr = (LAS unsigned short*)(lds + wave * (64 * 72 * 2));
    u32x4 kv[8], vv[8];
#pragma unroll
    for (int i = 0; i < 8; ++i) { const bf16_t* rp = U + (size_t)(tb * 64 + 8 * i + tl) * NU + h * 64 + q8; kv[i] = *(const u32x4*)(rp + U_K); vv[i] = *(const u32x4*)(rp + U_V); }
    float mx = 0.f;
#pragma unroll
    for (int i = 0; i < 8; ++i) { const u32x4 w = kv[i];
        float s = bflo(w.x) * bflo(w.x) + bfhi(w.x) * bfhi(w.x) + bflo(w.y) * bflo(w.y) + bfhi(w.y) * bfhi(w.y) + bflo(w.z) * bflo(w.z) + bfhi(w.z) * bfhi(w.z) + bflo(w.w) * bflo(w.w) + bfhi(w.w) * bfhi(w.w);
        s += dpp_mov<0xB1>(s); s += dpp_mov<0x4E>(s); s += dpp_mov<0x141>(s); mx = fmaxf(mx, s); }
    mx = wave_max(mx);
    if (lane == 0) atomicMax((unsigned*)(p->ws + WS_CTL) + CW_KMAX + l * 8 + h, __float_as_uint(mx));
#pragma unroll
    for (int i = 0; i < 8; ++i) { const int t = 8 * i + tl; const u32x4 w = vv[i];
        scr[(q8 + 0) * 72 + t] = (unsigned short)(w.x & 0xffffu); scr[(q8 + 1) * 72 + t] = (unsigned short)(w.x >> 16); scr[(q8 + 2) * 72 + t] = (unsigned short)(w.y & 0xffffu); scr[(q8 + 3) * 72 + t] = (unsigned short)(w.y >> 16);
        scr[(q8 + 4) * 72 + t] = (unsigned short)(w.z & 0xffffu); scr[(q8 + 5) * 72 + t] = (unsigned short)(w.z >> 16); scr[(q8 + 6) * 72 + t] = (unsigned short)(w.w & 0xffffu); scr[(q8 + 7) * 72 + t] = (unsigned short)(w.w >> 16); }
    bf16_t* Vt = (bf16_t*)(p->ws + WS_VT) + ((size_t)h * 64 + lane) * TP + tb * 64;
#pragma unroll
    for (int j = 0; j < 8; ++j) *(u32x4*)(Vt + 8 * j) = *(const LAS u32x4*)(scr + lane * 72 + 8 * j);
}
__device__ __forceinline__ void shift_out(KP p, int l, int tid) {
    const bf16_t* U = (const bf16_t*)(p->ws + WS_U);
    for (int base = tid; base < NSEQ * SHIFT_W; base += 512 * 8) {
        unsigned short v[8];
#pragma unroll
        for (int k = 0; k < 8; ++k) { const int idx = base + k * 512 < NSEQ * SHIFT_W ? base + k * 512 : tid; const int s = idx / SHIFT_W, j = idx - s * SHIFT_W; const int row = s == 0 ? TP - 1 : TP + (s - 1) * 32 + 31; v[k] = U[(size_t)row * NU + U_XC + j]; }
#pragma unroll
        for (int k = 0; k < 8; ++k) { const int idx = base + k * 512; if (idx < NSEQ * SHIFT_W) { const int s = idx / SHIFT_W, j = idx - s * SHIFT_W;
            float* dst = s == 0 ? p->out + O_PSHIFT + (size_t)l * SHIFT_W + j : p->out + O_SSHIFT + ((size_t)l * 32 + (s - 1)) * SHIFT_W + j; *dst = bf2f(v[k]); } }
    }
}
template <bool AT, bool BT, bool NEGA>
__device__ __forceinline__ void mm32(f32x16& acc, const LAS float* Ap, int i0, const LAS float* Bp, int j0, int lane) {
    const int li = lane & 31, kh = lane >> 5;
    const LAS float* ap = AT ? Ap + (8 * kh) * 65 + i0 + li : Ap + (i0 + li) * 65 + 8 * kh;
    const LAS float* bp = BT ? Bp + (j0 + li) * 65 + 8 * kh : Bp + (8 * kh) * 65 + j0 + li;
#pragma unroll 1
    for (int s = 0; s < 4; ++s) {
        float a[8], b[8];
#pragma unroll
        for (int e = 0; e < 8; ++e) { a[e] = AT ? ap[(16 * s + e) * 65] : ap[16 * s + e]; b[e] = BT ? bp[16 * s + e] : bp[(16 * s + e) * 65]; }
        if (NEGA) {
#pragma unroll
            for (int e = 0; e < 8; ++e) a[e] = -a[e]; }
        const bf16x8 af = pack8f((f32x4){a[0], a[1], a[2], a[3]}, (f32x4){a[4], a[5], a[6], a[7]}), bfg = pack8f((f32x4){b[0], b[1], b[2], b[3]}, (f32x4){b[4], b[5], b[6], b[7]});
        acc = __builtin_amdgcn_mfma_f32_32x32x16_bf16(af, bfg, acc, 0, 0, 0);
    }
}
template <int MASK>
__device__ __forceinline__ void st_tile(LAS float* dst, const f32x16& acc, int i0, int j0, int lane) {
    const int li = lane & 31, hi = lane >> 5, j = j0 + li;
#pragma unroll
    for (int r = 0; r < 16; ++r) { const int i = i0 + (r & 3) + 8 * (r >> 2) + 4 * hi; float v = acc[r];
        if (MASK == 1 && !(i < j)) v = 0.f; if (MASK == 2 && !(i <= j)) v = 0.f; dst[i * 65 + j] = v; }
}
struct RwkvSeqInfo { int row0, ntok, prev_kind  , b; };
__device__ __forceinline__ RwkvSeqInfo rwkv_info(int cu) { RwkvSeqInfo s; if (cu < 256) { s.row0 = cu * 64; s.ntok = 64; s.prev_kind = cu == 0 ? 0 : 1; s.b = 0; } else { s.b = cu - 256; s.row0 = TP + s.b * 32; s.ntok = 32; s.prev_kind = 2; } return s; }

__device__ __forceinline__ void rwkv_r1(KP p, int l, int unit, LAS unsigned char* lds, int tid) {
    const int cu = unit >> 3, h = unit & 7, wave = tid >> 6, lane = tid & 63, li = lane & 31, hi = lane >> 5;
    const RwkvSeqInfo si = rwkv_info(cu);
    const bf16_t* U = (const bf16_t*)(p->ws + WS_U);
    LAS float* S0 = (LAS float*)lds; LAS float *S1 = S0 + SLOT_F, *S2 = S0 + 2 * SLOT_F, *S3 = S0 + 3 * SLOT_F, *S4 = S0 + 4 * SLOT_F, *S5 = S0 + 5 * SLOT_F, *S6 = S0 + 6 * SLOT_F, *S7 = S0 + 7 * SLOT_F, *S8 = S0 + 8 * SLOT_F;
    LAS float* gC = S0 + 9 * SLOT_F;
    const int q = wave >> 2, wq = wave & 3, i0 = (wq >> 1) * 32, j0 = (wq & 1) * 32;
    PT0();
    {
        const int j = tid & 63, tq = tid >> 6;
        const int tl = lane >> 3, q8 = (lane & 7) * 8;
#pragma unroll
        for (int kb = 0; kb < 5; kb += 3) {
        u32x4 cur[5], prv[5];
#pragma unroll
        for (int k = kb; k < (kb + 3 < 5 ? kb + 3 : 5); ++k) { const int pid = wave * 5 + k, s = pid >> 3, tb = pid & 7, t = tb * 8 + tl;
            const int xo = (s < 3 ? s * 512 + h * 64 : 1536 + (s - 3) * 64) + q8;
            const int tc = t < si.ntok ? t : si.ntok - 1, tp = tc > 0 ? tc - 1 : (si.prev_kind == 1 ? -1 : 0);
            cur[k] = *(const u32x4*)(U + (size_t)(si.row0 + tc) * NU + U_XC + xo); prv[k] = *(const u32x4*)(U + (size_t)(si.row0 + tp) * NU + U_XC + xo); }
#pragma unroll
        for (int k = kb; k < (kb + 3 < 5 ? kb + 3 : 5); ++k) { const int pid = wave * 5 + k, s = pid >> 3, tb = pid & 7, t = tb * 8 + tl;
            const int xo = (s < 3 ? s * 512 + h * 64 : 1536 + (s - 3) * 64) + q8;
            LAS float* dst = (s == 0 ? S0 : s == 1 ? S1 : s == 2 ? S2 : s == 3 ? S3 : S4) + t * 65 + q8;
            const f32x4 m0 = *(const f32x4*)(p->in[I_MU] + l * SHIFT_W + xo), m1 = *(const f32x4*)(p->in[I_MU] + l * SHIFT_W + xo + 4);
            float x[8] = {bflo(cur[k].x), bfhi(cur[k].x), bflo(cur[k].y), bfhi(cur[k].y), bflo(cur[k].z), bfhi(cur[k].z), bflo(cur[k].w), bfhi(cur[k].w)};
            float pv[8] = {bflo(prv[k].x), bfhi(prv[k].x), bflo(prv[k].y), bfhi(prv[k].y), bflo(prv[k].z), bfhi(prv[k].z), bflo(prv[k].w), bfhi(prv[k].w)};
            if (t == 0 && si.prev_kind != 1) {
                if (si.prev_kind == 2) { const float* sp = p->in[I_SSHIFT] + ((size_t)l * 32 + si.b) * SHIFT_W + xo;
#pragma unroll
                    for (int e = 0; e < 8; ++e) pv[e] = sp[e]; }
                else {
#pragma unroll
                    for (int e = 0; e < 8; ++e) pv[e] = 0.f; } }
#pragma unroll
            for (int e = 0; e < 8; ++e) { const float mu = e < 4 ? m0[e] : m1[e - 4]; float xs = (t < si.ntok) ? x[e] + (pv[e] - x[e]) * mu : 0.f; if (s == 3) xs = fast_tanh(xs); dst[e] = xs; }
        }
        }
#pragma unroll
        for (int mm = 0; mm < 8; ++mm) { const int m = tq * 8 + mm;
            S5[m * 65 + j] = p->in[I_W2][((size_t)l * 64 + m) * 512 + h * 64 + j]; S6[m * 65 + j] = p->in[I_A2][((size_t)l * 64 + m) * 512 + h * 64 + j]; }
    }
    __syncthreads();
    PT1(1);
    {
        f32x16 acc = {};
        const int c = j0 + li;
        if (q == 0) { mm32<false, false, false>(acc, S3, i0, S5, j0, lane); const float w0 = p->in[I_W0][l * 512 + h * 64 + c];
#pragma unroll
            for (int r = 0; r < 16; ++r) { const int t = i0 + (r & 3) + 8 * (r >> 2) + 4 * hi; const float zz = acc[r] + w0;
                const float sp = fmaxf(-zz, 0.f) + __logf(1.f + __expf(-fabsf(zz)));
                S7[t * 65 + c] = (t < si.ntok) ? -__expf(-sp - 0.5f) : 0.f; } }
        else { mm32<false, false, false>(acc, S4, i0, S6, j0, lane); const float a0 = p->in[I_A0][l * 512 + h * 64 + c];
#pragma unroll
            for (int r = 0; r < 16; ++r) { const int t = i0 + (r & 3) + 8 * (r >> 2) + 4 * hi; S8[t * 65 + c] = __builtin_amdgcn_rcpf(1.f + __expf(-(acc[r] + a0))); } }
    }
    __syncthreads();
    PT1(2);
    if (wave == 0) { float run = 0.f;
#pragma unroll 8
        for (int t = 0; t < 64; ++t) { run += S7[t * 65 + lane]; S3[t * 65 + lane] = run; } }
    else { const int c = lane; const float kkw = p->in[I_KK][l * 512 + h * 64 + c], kaw = p->in[I_KA][l * 512 + h * 64 + c], rkw = p->in[I_RK][l * 512 + h * 64 + c];
        for (int t = wave - 1; t < 64; t += 7) { const float kr = S1[t * 65 + c], kv = kr * kkw; const float ss = wave_sum(kv * kv);
            const float kn = kv * (1.f / sqrtf(fmaxf(ss, 1e-24f))); const float a = S8[t * 65 + c]; const float km = kr * (1.f + (a - 1.f) * kaw);
            const float bon = wave_sum(S0[t * 65 + c] * km * rkw);
            S4[t * 65 + c] = kn; S1[t * 65 + c] = km; S8[t * 65 + c] = kn * a;
            if (lane == 0) ((float*)(p->ws + WS_BONUS))[(size_t)unit * 64 + t] = bon; } }
    __syncthreads();
    { const int c = tid & 63, tq = tid >> 6;
#pragma unroll
        for (int tt = 0; tt < 8; ++tt) { const int t = tq * 8 + tt, o = t * 65 + c; const float Lg = S3[o], lw = S7[o];
            const float g = __expf(Lg), gi = __expf(-Lg), gp = __expf(Lg - lw);
            S0[o] *= g; S1[o] *= gi; S8[o] *= gi; S4[o] *= gp; if (t == 63) gC[c] = g; } }
    __syncthreads();
    PT1(3);
    { f32x16 acc = {};
      if (q == 0) { mm32<false, true, false>(acc, S1, i0, S4, j0, lane); st_tile<1>(S3, acc, i0, j0, lane); }
      else { mm32<false, true, false>(acc, S8, i0, S4, j0, lane); st_tile<1>(S5, acc, i0, j0, lane); } }
    __syncthreads();
    { f32x16 acc = {};
      if (q == 0) { mm32<true, false, false>(acc, S2, i0, S3, j0, lane); st_tile<0>(S6, acc, i0, j0, lane); }
      else { mm32<false, true, false>(acc, S1, i0, S0, j0, lane); st_tile<2>(S7, acc, i0, j0, lane); } }
    __syncthreads();
    PT1(4);
    { float xa[4], xb[4]; const int ra = 4 * wave, rb = 60 - 4 * wave;
#pragma unroll
      for (int k = 0; k < 4; ++k) { xa[k] = (lane == ra + k) ? 1.f : 0.f; xb[k] = (lane == rb + k) ? 1.f : 0.f; }
      for (int s = ra; s < rb; ++s) { const float mrow = S5[s * 65 + lane];
#pragma unroll
          for (int k = 0; k < 4; ++k) xa[k] -= __builtin_bit_cast(float, __builtin_amdgcn_readlane(__builtin_bit_cast(int, xa[k]), s)) * mrow; }
      for (int s = rb; s < 63; ++s) { const float mrow = S5[s * 65 + lane]; float ya[4], yb[4];
#pragma unroll
          for (int k = 0; k < 4; ++k) { ya[k] = __builtin_bit_cast(float, __builtin_amdgcn_readlane(__builtin_bit_cast(int, xa[k]), s)); yb[k] = __builtin_bit_cast(float, __builtin_amdgcn_readlane(__builtin_bit_cast(int, xb[k]), s)); }
#pragma unroll
          for (int k = 0; k < 4; ++k) { xa[k] -= ya[k] * mrow; xb[k] -= yb[k] * mrow; } }
#pragma unroll
      for (int k = 0; k < 4; ++k) { S3[(ra + k) * 65 + lane] = xa[k]; S3[(rb + k) * 65 + lane] = xb[k]; } }
    __syncthreads();
    { f32x16 acc = {};
      if (q == 0) mm32<true, false, false>(acc, S4, i0, S3, j0, lane); else mm32<false, false, false>(acc, S6, i0, S3, j0, lane);
      __syncthreads();
      st_tile<0>(q == 0 ? S3 : S6, acc, i0, j0, lane); }
    __syncthreads();
    PT1(5);
    { f32x16 acc = {};
      if (q == 1) { mm32<false, true, false>(acc, S8, i0, S0, j0, lane); st_tile<2>(S4, acc, i0, j0, lane); }
      else { mm32<false, false, false>(acc, S3, i0, S8, j0, lane);
          const int jc = j0 + li; const float gc = gC[jc]; float* TQ = (float*)(p->ws + WS_TQ) + (size_t)unit * 4096;
#pragma unroll
          for (int rg = 0; rg < 4; ++rg) { const int ab = i0 + 8 * rg + 4 * hi; f32x4 o;
#pragma unroll
              for (int e = 0; e < 4; ++e) o[e] = ((ab + e == jc) ? gc : 0.f) - acc[rg * 4 + e] * gc;
              *(f32x4*)(TQ + ((((jc >> 4) * 4 + (ab >> 4)) * 64 + ((ab & 15) >> 2) * 16 + (jc & 15)) * 4)) = o; } } }
    __syncthreads();
    { f32x16 acc = {};
      if (q == 0) { mm32<true, false, false>(acc, S2, i0, S1, j0, lane); mm32<false, false, true>(acc, S6, i0, S8, j0, lane);
          const int jc = j0 + li; const float gc = gC[jc]; float* GM = (float*)(p->ws + WS_GM) + (size_t)unit * 4096;
#pragma unroll
          for (int r = 0; r < 16; ++r) GM[(i0 + (r & 3) + 8 * (r >> 2) + 4 * hi) * 64 + jc] = acc[r] * gc; }
      else { mm32<true, false, false>(acc, S2, i0, S7, j0, lane); mm32<false, false, true>(acc, S6, i0, S4, j0, lane);
          float* Y0T = (float*)(p->ws + WS_Y0T) + (size_t)unit * 4096;
#pragma unroll
          for (int rg = 0; rg < 4; ++rg) *(f32x4*)(Y0T + (((((j0 >> 5) * 2 + (i0 >> 5)) * 4 + rg) * 2 + hi) * 32 + li) * 4) = (f32x4){acc[rg * 4], acc[rg * 4 + 1], acc[rg * 4 + 2], acc[rg * 4 + 3]}; } }
    if (q == 0) { f32x16 acc;
#pragma unroll
        for (int r = 0; r < 16; ++r) acc[r] = S0[(j0 + li) * 65 + i0 + (r & 3) + 8 * (r >> 2) + 4 * hi];
        mm32<false, false, true>(acc, S3, i0, S4, j0, lane);
        float* ET = (float*)(p->ws + WS_ET) + (size_t)unit * 4096;
#pragma unroll
        for (int rg = 0; rg < 4; ++rg) *(f32x4*)(ET + ((((j0 >> 5) * 2 + (i0 >> 5)) * 8 + 2 * rg + hi) * 32 + li) * 4) = (f32x4){acc[rg * 4], acc[rg * 4 + 1], acc[rg * 4 + 2], acc[rg * 4 + 3]}; }
    __syncthreads();
    PT1(6);
}
template <bool SCQ>
__device__ __forceinline__ void chain_run(f32x4 (&st)[4], const float* TQ, const float* GM, float* SC, int nsteps, int i, int g, int lane) {
    constexpr size_t STRIDE = (size_t)8 * 4096;
    f32x4 tq[16], gm[4];
#pragma unroll
    for (int x = 0; x < 16; ++x) tq[x] = *(const f32x4*)(TQ + (x * 64 + lane) * 4);
#pragma unroll
    for (int tl = 0; tl < 4; ++tl) gm[tl] = GM ? *(const f32x4*)(GM + i * 64 + 16 * tl + 4 * g) : (f32x4){0.f, 0.f, 0.f, 0.f};
    for (int c = 0; c < nsteps; ++c) {
        if (SC) {
            if (SCQ) {
#pragma unroll
                for (int tl = 0; tl < 4; ++tl) *(f32x4*)(SC + c * STRIDE + ((((i >> 5) * 2 + (tl >> 1)) * 8 + 4 * (tl & 1) + g) * 32 + (i & 31)) * 4) = st[tl]; }
            else {
#pragma unroll
                for (int tl = 0; tl < 4; ++tl) *(f32x4*)(SC + c * STRIDE + i * 64 + 16 * tl + 4 * g) = st[tl]; } }
        f32x4 tqn[16], gmn[4];
        const int cn = (c + 1 < nsteps) ? c + 1 : c;
#pragma unroll
        for (int x = 0; x < 16; ++x) tqn[x] = *(const f32x4*)(TQ + cn * STRIDE + (x * 64 + lane) * 4);
#pragma unroll
        for (int tl = 0; tl < 4; ++tl) gmn[tl] = GM ? *(const f32x4*)(GM + cn * STRIDE + i * 64 + 16 * tl + 4 * g) : (f32x4){0.f, 0.f, 0.f, 0.f};
        f32x4 acc[4];
#pragma unroll
        for (int tp = 0; tp < 4; ++tp) acc[tp] = gm[tp];
#pragma unroll
        for (int tl = 0; tl < 4; ++tl)
#pragma unroll
            for (int r = 0; r < 4; ++r)
#pragma unroll
                for (int tp = 0; tp < 4; ++tp) acc[tp] = __builtin_amdgcn_mfma_f32_16x16x4f32(tq[tp * 4 + tl][r], st[tl][r], acc[tp], 0, 0, 0);
#pragma unroll
        for (int tl = 0; tl < 4; ++tl) st[tl] = acc[tl];
#pragma unroll
        for (int x = 0; x < 16; ++x) tq[x] = tqn[x];
#pragma unroll
        for (int tl = 0; tl < 4; ++tl) gm[tl] = gmn[tl];
    }
}
constexpr int CH_SLOT = 32768;
#define CH_LD(R, STEP) do { const int s_ = (STEP) < nsteps ? (STEP) : nsteps - 1; _Pragma("unroll") for (int k = 0; k < 4; ++k) { R[k] = *(const f32x4*)(TQ + (size_t)s_ * STRIDE + (k * 256 + ll) * 4); \
        R[4 + k] = GM ? *(const f32x4*)(GM + (size_t)s_ * STRIDE + (k * 256 + ll) * 4) : (f32x4){0.f, 0.f, 0.f, 0.f}; } } while (0)
#define CH_WR(R, SLOT) do { LAS float* d_ = (LAS float*)(lds + (SLOT) * CH_SLOT); _Pragma("unroll") for (int k = 0; k < 4; ++k) { *(LAS f32x4*)(d_ + (k * 256 + ll) * 4) = R[k]; *(LAS f32x4*)(d_ + 4096 + (k * 256 + ll) * 4) = R[4 + k]; } } while (0)
template <bool SCQ>
__device__ __forceinline__ void chain_block(f32x4 (&st)[4], const float* TQ, const float* GM, float* SC, int nsteps, LAS unsigned char* lds, int wave, int lane) {
    constexpr size_t STRIDE = (size_t)8 * 4096;
    if (wave >= 4) {
        const int ll = (wave - 4) * 64 + lane;
        f32x4 r0[8], r1[8], r2[8];
        CH_LD(r0, 0); CH_LD(r1, 1); CH_LD(r2, 2);
        CH_WR(r0, 0);
        __syncthreads();
        for (int c = 0; c < nsteps; c += 3) {
            CH_WR(r1, (c + 1) & 1); CH_LD(r0, c + 3); __syncthreads();
            if (c + 1 < nsteps) { CH_WR(r2, (c + 2) & 1); CH_LD(r1, c + 4); __syncthreads(); }
            if (c + 2 < nsteps) { CH_WR(r0, (c + 3) & 1); CH_LD(r2, c + 5); __syncthreads(); }
        }
    } else {
        const int fr = lane & 15, g = lane >> 4, i = wave * 16 + fr;
        __syncthreads();
        for (int c = 0; c < nsteps; ++c) {
            if (SC) {
                if (SCQ) {
#pragma unroll
                    for (int tl = 0; tl < 4; ++tl) *(f32x4*)(SC + c * STRIDE + ((((i >> 5) * 2 + (tl >> 1)) * 8 + 4 * (tl & 1) + g) * 32 + (i & 31)) * 4) = st[tl]; }
                else {
#pragma unroll
                    for (int tl = 0; tl < 4; ++tl) *(f32x4*)(SC + c * STRIDE + i * 64 + 16 * tl + 4 * g) = st[tl]; } }
            const LAS float* sl = (const LAS float*)(lds + (c & 1) * CH_SLOT);
            f32x4 acc[4];
#pragma unroll
            for (int tp = 0; tp < 4; ++tp) acc[tp] = *(const LAS f32x4*)(sl + 4096 + i * 64 + 16 * tp + 4 * g);
#pragma unroll
            for (int tl = 0; tl < 4; ++tl) { f32x4 tq[4];
#pragma unroll
                for (int tp = 0; tp < 4; ++tp) tq[tp] = *(const LAS f32x4*)(sl + ((tp * 4 + tl) * 64 + lane) * 4);
#pragma unroll
                for (int r = 0; r < 4; ++r)
#pragma unroll
                    for (int tp = 0; tp < 4; ++tp) acc[tp] = __builtin_amdgcn_mfma_f32_16x16x4f32(tq[tp][r], st[tl][r], acc[tp], 0, 0, 0); }
#pragma unroll
            for (int tl = 0; tl < 4; ++tl) st[tl] = acc[tl];
            __syncthreads();
        }
    }
}
__device__ __forceinline__ void rwkv_l1_block(KP p, int task, LAS unsigned char* lds, int wave, int lane) {
    const int kind = task & 1, h = (task >> 1) & 7, grp = task >> 4, iq = wave & 3;
    const int fr = lane & 15, g = lane >> 4, i = iq * 16 + fr;
    const size_t u0 = ((size_t)(grp * 16) * 8 + h) * 4096;
    f32x4 st[4];
#pragma unroll
    for (int tl = 0; tl < 4; ++tl)
#pragma unroll
        for (int r = 0; r < 4; ++r) st[tl][r] = (kind == 1 && i == 16 * tl + 4 * g + r) ? 1.f : 0.f;
    chain_block<false>(st, (const float*)(p->ws + WS_TQ) + u0, kind == 0 ? (const float*)(p->ws + WS_GM) + u0 : nullptr, nullptr, 16, lds, wave, lane);
    if (wave < 4) { const size_t gb = ((size_t)grp * 8 + h) * 4096;
        if (kind == 0) { float* GG = (float*)(p->ws + WS_GG) + gb;
#pragma unroll
            for (int tl = 0; tl < 4; ++tl) *(f32x4*)(GG + i * 64 + 16 * tl + 4 * g) = st[tl]; }
        else { float* TG = (float*)(p->ws + WS_TG) + gb;
#pragma unroll
            for (int tl = 0; tl < 4; ++tl)
#pragma unroll
                for (int r = 0; r < 4; ++r) TG[((tl * 4 + iq) * 64 + (fr >> 2) * 16 + 4 * g + r) * 4 + (fr & 3)] = st[tl][r]; } }
    __syncthreads();
}
__device__ __forceinline__ void rwkv_l2_block(KP p, int l, int h, LAS unsigned char* lds, int wave, int lane) {
    const int iq = wave & 3, fr = lane & 15, g = lane >> 4, i = iq * 16 + fr;
    f32x4 st[4];
#pragma unroll
    for (int tl = 0; tl < 4; ++tl) st[tl] = (f32x4){0.f, 0.f, 0.f, 0.f};
    chain_block<false>(st, (const float*)(p->ws + WS_TG) + (size_t)h * 4096, (const float*)(p->ws + WS_GG) + (size_t)h * 4096, (float*)(p->ws + WS_SG) + (size_t)h * 4096, 16, lds, wave, lane);
    if (wave < 4) { float* dst = p->out + O_PWKV + (((size_t)l * 8 + h) * 64 + i) * 64;
#pragma unroll
        for (int tl = 0; tl < 4; ++tl) *(f32x4*)(dst + 16 * tl + 4 * g) = st[tl]; }
    __syncthreads();
}
__device__ __forceinline__ void rwkv_l3_block(KP p, int l, int task, LAS unsigned char* lds, int wave, int lane) {
    const int h = task & 7, grp = task >> 3, iq = wave & 3, fr = lane & 15, g = lane >> 4, i = iq * 16 + fr;
    f32x4 st[4];
#pragma unroll
    for (int tl = 0; tl < 4; ++tl) st[tl] = (f32x4){0.f, 0.f, 0.f, 0.f};
    if (grp > 0) chain_block<false>(st, (const float*)(p->ws + WS_TG) + (size_t)h * 4096, (const float*)(p->ws + WS_GG) + (size_t)h * 4096, nullptr, grp, lds, wave, lane);
    const size_t u0 = ((size_t)(grp * 16) * 8 + h) * 4096;
    chain_block<true>(st, (const float*)(p->ws + WS_TQ) + u0, (const float*)(p->ws + WS_GM) + u0, (float*)(p->ws + WS_SC) + u0, 16, lds, wave, lane);
    if (grp == 15 && wave < 4) { float* dst = p->out + O_PWKV + (((size_t)l * 8 + h) * 64 + i) * 64;
#pragma unroll
        for (int tl = 0; tl < 4; ++tl) *(f32x4*)(dst + 16 * tl + 4 * g) = st[tl]; }
    __syncthreads();
}
__device__ __forceinline__ void rwkv_samp_task(KP p, int l, int t2, int lane) {
    const int fr = lane & 15, g = lane >> 4, iq = t2 & 3, h = (t2 >> 2) & 7, b = t2 >> 5, i = iq * 16 + fr;
    f32x4 st[4];
    const float* s0 = p->in[I_SWKV] + ((((size_t)l * 32 + b) * 8 + h) * 64 + i) * 64;
#pragma unroll
    for (int tl = 0; tl < 4; ++tl) st[tl] = *(const f32x4*)(s0 + 16 * tl + 4 * g);
    const size_t u0 = ((size_t)(256 + b) * 8 + h) * 4096;
    chain_run<true>(st, (const float*)(p->ws + WS_TQ) + u0, (const float*)(p->ws + WS_GM) + u0, (float*)(p->ws + WS_SC) + u0, 1, i, g, lane);
    float* dst = p->out + O_SWKV + ((((size_t)l * 32 + b) * 8 + h) * 64 + i) * 64;
#pragma unroll
    for (int tl = 0; tl < 4; ++tl) *(f32x4*)(dst + 16 * tl + 4 * g) = st[tl];
}
__device__ __forceinline__ void rwkv_r3_task(KP p, int l, int task, int lane) {
    const int unit = task >> 1, th = task & 1, cu = unit >> 3, h = unit & 7, li = lane & 31, hi = lane >> 5;
    const RwkvSeqInfo si = rwkv_info(cu);
    if (th * 32 >= si.ntok) return;
    const bf16_t* U = (const bf16_t*)(p->ws + WS_U);
    const size_t ub = (size_t)unit * 4096; const int t = th * 32 + li;
    const float* SC = (const float*)(p->ws + WS_SC) + ub; const float* ET = (const float*)(p->ws + WS_ET) + ub; const float* Y0T = (const float*)(p->ws + WS_Y0T) + ub;
    f32x16 acc[2];
#pragma unroll
    for (int ti = 0; ti < 2; ++ti)
#pragma unroll
        for (int rg = 0; rg < 4; ++rg) { const f32x4 y0 = *(const f32x4*)(Y0T + ((((th * 2 + ti) * 4 + rg) * 2 + hi) * 32 + li) * 4);
#pragma unroll
            for (int e = 0; e < 4; ++e) acc[ti][rg * 4 + e] = y0[e]; }
    f32x4 eb[8], sa0[8], sa1[8];
#pragma unroll
    for (int s4 = 0; s4 < 8; ++s4) { eb[s4] = *(const f32x4*)(ET + (((th * 2 + hi) * 8 + s4) * 32 + li) * 4); sa0[s4] = *(const f32x4*)(SC + (((0 * 2 + hi) * 8 + s4) * 32 + li) * 4); sa1[s4] = *(const f32x4*)(SC + (((1 * 2 + hi) * 8 + s4) * 32 + li) * 4); }
#pragma unroll
    for (int s4 = 0; s4 < 8; ++s4) {
#pragma unroll
        for (int e = 0; e < 4; ++e) { acc[0] = __builtin_amdgcn_mfma_f32_32x32x2f32(sa0[s4][e], eb[s4][e], acc[0], 0, 0, 0); acc[1] = __builtin_amdgcn_mfma_f32_32x32x2f32(sa1[s4][e], eb[s4][e], acc[1], 0, 0, 0); }
    }
    float s1 = 0.f;
#pragma unroll
    for (int ti = 0; ti < 2; ++ti)
#pragma unroll
        for (int r = 0; r < 16; ++r) s1 += acc[ti][r];
    s1 = xhalf_sum(s1); const float mean = s1 * (1.f / 64.f);
    float s2 = 0.f;
#pragma unroll
    for (int ti = 0; ti < 2; ++ti)
#pragma unroll
        for (int r = 0; r < 16; ++r) { const float d = acc[ti][r] - mean; s2 += d * d; }
    s2 = xhalf_sum(s2); const float rstd = 1.f / sqrtf(s2 * (1.f / 64.f) + 64e-5f);
    if (t >= si.ntok) return;
    const float bon = ((const float*)(p->ws + WS_BONUS))[(size_t)unit * 64 + t];
    const size_t row = (size_t)(si.row0 + t);
    bf16_t* oc = (bf16_t*)(p->ws + WS_OCAT) + (size_t)2 * NTOK * 512 + row * 512 + h * 64;
    u32x2 wout[2][4];
#pragma unroll
    for (int ti = 0; ti < 2; ++ti)
#pragma unroll
        for (int rg = 0; rg < 4; ++rg) { const int i = 32 * ti + 8 * rg + 4 * hi, c = h * 64 + i;
            const f32x4 gg = *(const f32x4*)(p->in[I_GNG] + l * 512 + c), gb = *(const f32x4*)(p->in[I_GNB] + l * 512 + c), mu = *(const f32x4*)(p->in[I_MU] + l * SHIFT_W + 1024 + c);
            const u32x2 vx = *(const u32x2*)(U + row * NU + U_XC + 1024 + c); const u32x2 sg = *(const u32x2*)(U + row * NU + U_CSG + c);
            f32x4 vc = (f32x4){bflo(vx.x), bfhi(vx.x), bflo(vx.y), bfhi(vx.y)}, vp;
            {
                const u32x2 px = *(const u32x2*)(U + (row > 0 ? row - 1 : 0) * NU + U_XC + 1024 + c); const f32x4 ss = *(const f32x4*)(p->in[I_SSHIFT] + ((size_t)l * 32 + si.b) * SHIFT_W + 1024 + c);
                const f32x4 up = (f32x4){bflo(px.x), bfhi(px.x), bflo(px.y), bfhi(px.y)};
                vp = (t > 0 || si.prev_kind == 1) ? up : (si.prev_kind == 2 ? ss : (f32x4){0.f, 0.f, 0.f, 0.f}); }
            const f32x4 vs = vc + (vp - vc) * mu;
            const f32x4 sgf = (f32x4){bflo(sg.x), bfhi(sg.x), bflo(sg.y), bfhi(sg.y)};
            f32x4 o;
#pragma unroll
            for (int e = 0; e < 4; ++e) o[e] = (((acc[ti][rg * 4 + e] - mean) * rstd) * gg[e] + gb[e] + bon * vs[e]) * siluf_(sgf[e]);
            wout[ti][rg].x = cvt_pk_bf16(o[0], o[1]); wout[ti][rg].y = cvt_pk_bf16(o[2], o[3]); }
#pragma unroll
    for (int ti = 0; ti < 2; ++ti)
#pragma unroll
        for (int rg = 0; rg < 4; ++rg) *(u32x2*)(oc + 32 * ti + 8 * rg + 4 * hi) = wout[ti][rg];
}
__device__ __forceinline__ int krow(int i) { return (i & 3) + 4 * ((i >> 3) & 1) + 8 * ((i >> 2) & 1) + 16 * (i >> 4); }
__device__ __forceinline__ bf16x8 pack8(const f32x16& v, int o) { u32x4 w; w.x = cvt_pk_bf16(v[o], v[o + 1]); w.y = cvt_pk_bf16(v[o + 2], v[o + 3]); w.z = cvt_pk_bf16(v[o + 4], v[o + 5]); w.w = cvt_pk_bf16(v[o + 6], v[o + 7]); return __builtin_bit_cast(bf16x8, w); }
constexpr float ATT_NEG = -1e30f;
template <bool HALF>
__device__ __forceinline__ void softmax_tile(f32x16& p0, f32x16& p1, float& m, float& lsum, f32x16 (&O)[2], bf16x8 (&pb)[4]) {
    float mx = p0[0];
#pragma unroll
    for (int r = 1; r < 16; ++r) mx = fmaxf(mx, p0[r]);
    if (!HALF) {
#pragma unroll
        for (int r = 0; r < 16; ++r) mx = fmaxf(mx, p1[r]); }
    mx = xhalf_max(mx);
    const float mn = fmaxf(m, mx), alpha = __builtin_amdgcn_exp2f(m - mn);
    m = mn;
    float s = 0.f;
#pragma unroll
    for (int r = 0; r < 16; ++r) { p0[r] = __builtin_amdgcn_exp2f(p0[r] - mn); s += p0[r]; }
    if (!HALF) {
#pragma unroll
        for (int r = 0; r < 16; ++r) { p1[r] = __builtin_amdgcn_exp2f(p1[r] - mn); s += p1[r]; } }
    lsum = lsum * alpha + s;
#pragma unroll
    for (int r = 0; r < 16; ++r) { O[0][r] *= alpha; O[1][r] *= alpha; }
    pb[0] = pack8(p0, 0); pb[1] = pack8(p0, 8);
    if (!HALF) { pb[2] = pack8(p1, 0); pb[3] = pack8(p1, 8); }
}
constexpr int AKS = 72;
constexpr int ATT_KB = 0, ATT_VB = 2 * 64 * AKS * 2, ATT_FB = 4 * 64 * AKS * 2, ATT_SC = ATT_FB + 2 * 64 * 4;
__device__ __forceinline__ void attn_prompt_unit(KP p, int l, int h, int qb, LAS unsigned char* lds, int tid) {
    const bf16_t* U = (const bf16_t*)(p->ws + WS_U); const bf16_t* Vt = (const bf16_t*)(p->ws + WS_VT) + (size_t)h * 64 * TP; const float* F = (const float*)(p->ws + WS_FP) + (size_t)h * TP;
    const int wave = tid >> 6, lane = tid & 63, li = lane & 31, hi = lane >> 5;
    const int q0 = qb * 256, q = q0 + wave * 32 + li;
    bf16x8 qf[4];
    { const float sc = 0.125f * LOG2E;
#pragma unroll
      for (int d0 = 0; d0 < 4; ++d0) { const u32x4 w = *(const u32x4*)(U + (size_t)q * NU + U_Q + h * 64 + 16 * d0 + 8 * hi);
          qf[d0] = pack8f((f32x4){bflo(w.x) * sc, bfhi(w.x) * sc, bflo(w.y) * sc, bfhi(w.y) * sc}, (f32x4){bflo(w.z) * sc, bfhi(w.z) * sc, bflo(w.w) * sc, bfhi(w.w) * sc}); } }
    const float fq = F[q];
    float m = ATT_NEG, lsum = 0.f; f32x16 O[2] = {};
    const int NT = (q0 + 256) / 64;
    LAS float* qmx = (LAS float*)(lds + ATT_SC); LAS float* mmv = qmx + 8;
    { float q2 = 0.f;
#pragma unroll
      for (int d0 = 0; d0 < 4; ++d0) { const u32x4 w = __builtin_bit_cast(u32x4, qf[d0]); q2 += bflo(w.x) * bflo(w.x) + bfhi(w.x) * bfhi(w.x) + bflo(w.y) * bflo(w.y) + bfhi(w.y) * bfhi(w.y) + bflo(w.z) * bflo(w.z) + bfhi(w.z) * bfhi(w.z) + bflo(w.w) * bflo(w.w) + bfhi(w.w) * bfhi(w.w); }
      q2 = wave_max(xhalf_sum(q2)); if (lane == 0) { qmx[wave] = q2; mmv[wave] = ATT_NEG; } }
    const float kmax2 = __uint_as_float(((const unsigned*)(p->ws + WS_CTL))[CW_KMAX + l * 8 + h]), fq0 = F[q0];
    const int srow = tid >> 3, sch = tid & 7;
    const bf16_t* kg = U + (size_t)srow * NU + U_K + h * 64 + 8 * sch; const bf16_t* vg = Vt + (size_t)srow * TP + 8 * sch;
    LAS unsigned char* kdst = lds + ATT_KB + (srow * AKS + 8 * sch) * 2; LAS unsigned char* vdst = lds + ATT_VB + (srow * AKS + 8 * sch) * 2;
    u32x4 kr = *(const u32x4*)(kg + (size_t)(NT - 1) * 64 * NU), vr = *(const u32x4*)(vg + (NT - 1) * 64); float fr = tid < 64 ? F[(NT - 1) * 64 + tid] : 0.f;
    *(LAS u32x4*)kdst = kr; *(LAS u32x4*)vdst = vr; if (tid < 64) ((LAS float*)(lds + ATT_FB))[tid] = fr;
    __syncthreads();
    const int ka = krow(li);
    float qkb; { float q2 = qmx[0];
#pragma unroll
      for (int w = 1; w < 8; ++w) q2 = fmaxf(q2, qmx[w]);
      qkb = 1.02f * sqrtf(q2 * kmax2) + fq0; }
    for (int t = NT - 1, buf = 0; t >= 0; --t, buf ^= 1) {
        { float mmin = mmv[0];
#pragma unroll
          for (int w = 1; w < 8; ++w) mmin = fminf(mmin, mmv[w]);
          if (qkb - ((const LAS float*)(lds + ATT_FB))[buf * 64 + 63] < mmin - 40.f) break; }
        if (t > 0) { kr = *(const u32x4*)(kg + (size_t)(t - 1) * 64 * NU); vr = *(const u32x4*)(vg + (t - 1) * 64); if (tid < 64) fr = F[(t - 1) * 64 + tid]; }
        if (64 * t <= q0 + wave * 32 + 31) {
            const LAS bf16_t* Kb = (const LAS bf16_t*)(lds + ATT_KB) + buf * 64 * AKS; const LAS bf16_t* Vb = (const LAS bf16_t*)(lds + ATT_VB) + buf * 64 * AKS; const LAS float* Fb = (const LAS float*)(lds + ATT_FB) + buf * 64;
            f32x16 p0, p1;
#pragma unroll
            for (int g2 = 0; g2 < 2; ++g2) { const f32x4 a = *(const LAS f32x4*)(Fb + 8 * hi + 16 * g2), b = *(const LAS f32x4*)(Fb + 8 * hi + 16 * g2 + 4), c = *(const LAS f32x4*)(Fb + 32 + 8 * hi + 16 * g2), d = *(const LAS f32x4*)(Fb + 32 + 8 * hi + 16 * g2 + 4);
#pragma unroll
                for (int e = 0; e < 4; ++e) { p0[8 * g2 + e] = fq - a[e]; p0[8 * g2 + 4 + e] = fq - b[e]; p1[8 * g2 + e] = fq - c[e]; p1[8 * g2 + 4 + e] = fq - d[e]; } }
#pragma unroll
            for (int d0 = 0; d0 < 4; ++d0) { const bf16x8 a0 = *(const LAS bf16x8*)(Kb + ka * AKS + 16 * d0 + 8 * hi), a1 = *(const LAS bf16x8*)(Kb + (ka + 32) * AKS + 16 * d0 + 8 * hi);
                p0 = __builtin_amdgcn_mfma_f32_32x32x16_bf16(a0, qf[d0], p0, 0, 0, 0); p1 = __builtin_amdgcn_mfma_f32_32x32x16_bf16(a1, qf[d0], p1, 0, 0, 0); }
            if (64 * t + 63 > q0 + wave * 32) {
#pragma unroll
                for (int r = 0; r < 16; ++r) { const int kv = 64 * t + 8 * hi + 16 * (r >> 3) + (r & 7); if (kv > q) p0[r] = -INFINITY; if (kv + 32 > q) p1[r] = -INFINITY; } }
            bf16x8 pb[4];
            softmax_tile<false>(p0, p1, m, lsum, O, pb);
#pragma unroll
            for (int dt = 0; dt < 2; ++dt)
#pragma unroll
                for (int s = 0; s < 4; ++s) { const bf16x8 a = *(const LAS bf16x8*)(Vb + (32 * dt + li) * AKS + 16 * (s & 1) + 32 * (s >> 1) + 8 * hi);
                    O[dt] = __builtin_amdgcn_mfma_f32_32x32x16_bf16(a, pb[s], O[dt], 0, 0, 0); }
        }
        { const float wm = wave_min(m); if (lane == 0) mmv[wave] = wm; }
        if (t > 0) { const int nb = buf ^ 1; *(LAS u32x4*)(kdst + nb * 64 * AKS * 2) = kr; *(LAS u32x4*)(vdst + nb * 64 * AKS * 2) = vr; if (tid < 64) ((LAS float*)(lds + ATT_FB))[nb * 64 + tid] = fr; }
        __syncthreads();
    }
    __syncthreads();
    const float inv = 1.f / xhalf_sum(lsum);
    bf16_t* ob = (bf16_t*)(p->ws + WS_OCAT) + (size_t)1 * NTOK * 512 + (size_t)q * 512 + h * 64;
    u32x2 sgv[2][4];
#pragma unroll
    for (int dt = 0; dt < 2; ++dt)
#pragma unroll
        for (int rg = 0; rg < 4; ++rg) sgv[dt][rg] = *(const u32x2*)(U + (size_t)q * NU + U_BSG + h * 64 + 32 * dt + 8 * rg + 4 * hi);
#pragma unroll
    for (int dt = 0; dt < 2; ++dt)
#pragma unroll
        for (int rg = 0; rg < 4; ++rg) { const int d = 32 * dt + 8 * rg + 4 * hi; const u32x2 sg = sgv[dt][rg];
            u32x2 w; w.x = cvt_pk_bf16(O[dt][rg * 4] * inv * siluf_(bflo(sg.x)), O[dt][rg * 4 + 1] * inv * siluf_(bfhi(sg.x))); w.y = cvt_pk_bf16(O[dt][rg * 4 + 2] * inv * siluf_(bflo(sg.y)), O[dt][rg * 4 + 3] * inv * siluf_(bfhi(sg.y)));
            *(u32x2*)(ob + d) = w; }
}
__device__ __forceinline__ void attn_sample_unit(KP p, int l, int b, int h, LAS unsigned char* lds, int tid) {
    const bf16_t* U = (const bf16_t*)(p->ws + WS_U);
    const int wave = tid >> 6, lane = tid & 63, li = lane & 31, hi = lane >> 5;
    const size_t qrow = (size_t)TP + b * 32 + li;
    const float* G = (const float*)(p->ws + WS_GS) + ((size_t)b * 8 + h) * GS_LEN;
    bf16x8 qf[4];
    { const float sc = 0.125f * LOG2E;
#pragma unroll
      for (int d0 = 0; d0 < 4; ++d0) { const u32x4 w = *(const u32x4*)(U + qrow * NU + U_Q + h * 64 + 16 * d0 + 8 * hi);
          qf[d0] = pack8f((f32x4){bflo(w.x) * sc, bfhi(w.x) * sc, bflo(w.y) * sc, bfhi(w.y) * sc}, (f32x4){bflo(w.z) * sc, bfhi(w.z) * sc, bflo(w.w) * sc, bfhi(w.w) * sc}); } }
    const float fq = G[PAST + li];
    float m = ATT_NEG, lsum = 0.f; f32x16 O[2] = {};
    const float* CK = p->in[I_CK] + (((size_t)l * 32 + b) * PAST) * 512 + h * 64; const float* CV = p->in[I_CV] + (((size_t)l * 32 + b) * PAST) * 512 + h * 64;
    const int ka = krow(li);
    float kmax2;
    { float mx = 0.f; const f32x4* kp4 = (const f32x4*)CK + (tid & 15);
#pragma unroll 1
      for (int it = 0; it < 8; ++it) { f32x4 kv[16];
#pragma unroll
          for (int j = 0; j < 16; ++j) kv[j] = kp4[(size_t)((it * 16 + j) * 32 + (tid >> 4)) * 128];
#pragma unroll
          for (int j = 0; j < 16; ++j) { float s = kv[j][0] * kv[j][0] + kv[j][1] * kv[j][1] + kv[j][2] * kv[j][2] + kv[j][3] * kv[j][3];
              s += dpp_mov<0xB1>(s); s += dpp_mov<0x4E>(s); s += dpp_mov<0x141>(s); s += dpp_mov<0x140>(s); mx = fmaxf(mx, s); } }
      mx = wave_max(mx); LAS float* kml = (LAS float*)lds;
      if (lane == 0) kml[wave] = mx;
      __syncthreads();
      kmax2 = kml[0];
#pragma unroll
      for (int w = 1; w < 8; ++w) kmax2 = fmaxf(kmax2, kml[w]);
      __syncthreads(); }
    float qkb;
    { float q2 = 0.f;
#pragma unroll
      for (int d0 = 0; d0 < 4; ++d0) { const u32x4 w = __builtin_bit_cast(u32x4, qf[d0]); q2 += bflo(w.x) * bflo(w.x) + bfhi(w.x) * bfhi(w.x) + bflo(w.y) * bflo(w.y) + bfhi(w.y) * bfhi(w.y) + bflo(w.z) * bflo(w.z) + bfhi(w.z) * bfhi(w.z) + bflo(w.w) * bflo(w.w) + bfhi(w.w) * bfhi(w.w); }
      q2 = wave_max(xhalf_sum(q2)); qkb = 1.02f * sqrtf(q2 * kmax2) + G[PAST]; }
    {
        f32x16 p0, p1 = {};
#pragma unroll
        for (int g2 = 0; g2 < 2; ++g2) { const float* gp = G + PAST + 8 * hi + 16 * g2; const f32x4 a = *(const f32x4*)gp, bq = *(const f32x4*)(gp + 4);
#pragma unroll
            for (int e = 0; e < 4; ++e) { p0[8 * g2 + e] = fq - a[e]; p0[8 * g2 + 4 + e] = fq - bq[e]; } }
#pragma unroll
        for (int d0 = 0; d0 < 4; ++d0) { const bf16x8 a0 = *(const bf16x8*)(U + ((size_t)TP + b * 32 + ka) * NU + U_K + h * 64 + 16 * d0 + 8 * hi);
            p0 = __builtin_amdgcn_mfma_f32_32x32x16_bf16(a0, qf[d0], p0, 0, 0, 0); }
#pragma unroll
        for (int r = 0; r < 16; ++r) { const int kv = 8 * hi + 16 * (r >> 3) + (r & 7); if (kv > li) p0[r] = -INFINITY; }
        bf16x8 pb[4];
        softmax_tile<true>(p0, p1, m, lsum, O, pb);
        if (wave == 7) {
#pragma unroll
            for (int dt = 0; dt < 2; ++dt)
#pragma unroll
                for (int s = 0; s < 2; ++s) { const bf16_t* vp = U + ((size_t)TP + b * 32 + 16 * s + 8 * hi) * NU + U_V + h * 64 + 32 * dt + li; u32x4 w;
                    w.x = (unsigned)vp[0] | ((unsigned)vp[NU] << 16); w.y = (unsigned)vp[2 * NU] | ((unsigned)vp[3 * NU] << 16); w.z = (unsigned)vp[4 * NU] | ((unsigned)vp[5 * NU] << 16); w.w = (unsigned)vp[6 * NU] | ((unsigned)vp[7 * NU] << 16);
                    O[dt] = __builtin_amdgcn_mfma_f32_32x32x16_bf16(__builtin_bit_cast(bf16x8, w), pb[s], O[dt], 0, 0, 0); } }
        else lsum = 0.f;
    }
    const float mmin = wave_min(m);
    for (int tt = 0; tt < 8; ++tt) {
        const int key0 = (63 - wave - 8 * tt) * 64;
        if (qkb - G[key0 + 63] < mmin - 40.f) break;
        f32x16 p0, p1;
#pragma unroll
        for (int g2 = 0; g2 < 2; ++g2) { const float* gp = G + key0 + 8 * hi + 16 * g2; const f32x4 a = *(const f32x4*)gp, bq = *(const f32x4*)(gp + 4), c = *(const f32x4*)(gp + 32), d = *(const f32x4*)(gp + 36);
#pragma unroll
            for (int e = 0; e < 4; ++e) { p0[8 * g2 + e] = fq - a[e]; p0[8 * g2 + 4 + e] = fq - bq[e]; p1[8 * g2 + e] = fq - c[e]; p1[8 * g2 + 4 + e] = fq - d[e]; } }
#pragma unroll
        for (int d0 = 0; d0 < 4; ++d0) { const float* k0p = CK + (size_t)(key0 + ka) * 512 + 16 * d0 + 8 * hi; const float* k1p = k0p + (size_t)32 * 512;
            const bf16x8 a0 = pack8f(*(const f32x4*)k0p, *(const f32x4*)(k0p + 4)), a1 = pack8f(*(const f32x4*)k1p, *(const f32x4*)(k1p + 4));
            p0 = __builtin_amdgcn_mfma_f32_32x32x16_bf16(a0, qf[d0], p0, 0, 0, 0); p1 = __builtin_amdgcn_mfma_f32_32x32x16_bf16(a1, qf[d0], p1, 0, 0, 0); }
        bf16x8 pb[4];
        softmax_tile<false>(p0, p1, m, lsum, O, pb);
#pragma unroll
        for (int dt = 0; dt < 2; ++dt)
#pragma unroll
            for (int s = 0; s < 4; ++s) { const float* vp = CV + (size_t)(key0 + 16 * (s & 1) + 32 * (s >> 1) + 8 * hi) * 512 + 32 * dt + li;
                const bf16x8 a = pack8f((f32x4){vp[0], vp[512], vp[1024], vp[1536]}, (f32x4){vp[2048], vp[2560], vp[3072], vp[3584]});
                O[dt] = __builtin_amdgcn_mfma_f32_32x32x16_bf16(a, pb[s], O[dt], 0, 0, 0); }
    }
    LAS float* Ow = (LAS float*)lds;
    LAS float* ML = Ow + 8 * 32 * 64;
    lsum = xhalf_sum(lsum);
#pragma unroll
    for (int dt = 0; dt < 2; ++dt)
#pragma unroll
        for (int r = 0; r < 16; ++r) Ow[(wave * 32 + dt * 16 + r) * 64 + lane] = O[dt][r];
    if (hi == 0) { ML[(wave * 2) * 32 + li] = m; ML[(wave * 2 + 1) * 32 + li] = lsum; }
    __syncthreads();
    { const int qq = tid & 31, dg = tid >> 5; float M = ATT_NEG;
#pragma unroll
      for (int w = 0; w < 8; ++w) M = fmaxf(M, ML[(w * 2) * 32 + qq]);
      float L = 0.f; f32x4 o = {0.f, 0.f, 0.f, 0.f};
      const int d = 4 * dg, idx0 = (d >> 5) * 16 + ((d >> 3) & 3) * 4, ln = ((d >> 2) & 1) * 32 + qq;
#pragma unroll
      for (int w = 0; w < 8; ++w) { const float f = __builtin_amdgcn_exp2f(ML[(w * 2) * 32 + qq] - M); L += ML[(w * 2 + 1) * 32 + qq] * f;
#pragma unroll
          for (int e = 0; e < 4; ++e) o[e] += Ow[(w * 32 + idx0 + e) * 64 + ln] * f; }
      const float inv = 1.f / L; const size_t row = (size_t)TP + b * 32 + qq;
      const u32x2 sg = *(const u32x2*)(U + row * NU + U_BSG + h * 64 + d);
      u32x2 wv; wv.x = cvt_pk_bf16(o[0] * inv * siluf_(bflo(sg.x)), o[1] * inv * siluf_(bfhi(sg.x))); wv.y = cvt_pk_bf16(o[2] * inv * siluf_(bflo(sg.y)), o[3] * inv * siluf_(bfhi(sg.y)));
      *(u32x2*)((bf16_t*)(p->ws + WS_OCAT) + (size_t)1 * NTOK * 512 + row * 512 + h * 64 + d) = wv; }
    __syncthreads();
}
__device__ __forceinline__ bool xb_lane0() { unsigned ones_ = ~0u; asm volatile("" : "+s"(ones_)); return __builtin_amdgcn_mbcnt_hi(ones_, __builtin_amdgcn_mbcnt_lo(ones_, 0u)) == 0u; }
constexpr int NPHASE = 20;
__global__ void __launch_bounds__(512, 2) hse_fwd(Params p_) {
    const KP kp = (KP)__builtin_amdgcn_kernarg_segment_ptr();
    (void)p_;
    extern __shared__ __attribute__((aligned(16))) unsigned char lds_raw[];
    LAS unsigned char* lds = (LAS unsigned char*)lds_raw;
    const int tid0 = threadIdx.x;
    const int wave0 = __builtin_amdgcn_readfirstlane(tid0 >> 6);
    const int G = gridDim.x, bid = blockIdx.x, ngw = G * 8;
#define PH_LOCALS const KP p = kp_fresh(kp); unsigned ones_ = ~0u; asm volatile("" : "+s"(ones_)); int tid = wave0 * 64 + (int)__builtin_amdgcn_mbcnt_hi(ones_, __builtin_amdgcn_mbcnt_lo(ones_, 0u)); asm volatile("" : "+v"(tid)); const int lane = tid & 63, wave = __builtin_amdgcn_readfirstlane(tid >> 6), gw = bid * 8 + wave; (void)lane; (void)gw; (void)p;
    if (tid0 < 4) ((LAS unsigned*)(lds + LDS_XB_OFF))[tid0] = 0u;
#if PROBE_ID
    if (tid0 == 0) *(LAS unsigned long long*)(lds + LDS_PROBE_OFF) = 0ull;
#endif
    __syncthreads();
    unsigned* ctl = (unsigned*)(kp->ws + WS_CTL);
    XcdBarrier bar = xcd_barrier_post(ctl + CW_BAR + kp->li * XCD_BAR_WORDS, (volatile LAS unsigned*)(lds + LDS_XB_OFF));
    const int lo = kp->ph_lo, hi = kp->ph_hi;
#define IN(k) (lo <= (k) && (k) < hi)
#ifndef DUP_MASK
#define DUP_MASK 0
#endif
#define NREP(k) (((DUP_MASK >> (k)) & 1) + 1)
#define XB_T0 (wave0 == 0 && xb_lane0())
#define SEAM(k) do { if (IN(k) && IN((k) + 1)) xcd_barrier(bar, XB_T0); } while (0)
    PT0();
    if (IN(0)) { PH_LOCALS
        for (int u = bid; u < 192; u += G) ada_unit(p, u, lds, tid);
        p0_weights(p, lds, gw, ngw, wave, lane);
    }
    SEAM(0);
    PT1(9);
    for (int l = 0; l < NLAYER; ++l) {
        const int pb = 1 + 9 * l;
        for (int rep = 0; rep < NREP(0); ++rep) { if (rep) xcd_barrier(bar, XB_T0);
        if (IN(pb)) { PH_LOCALS p1_rows(p, l, gw, ngw, lane); } }
        SEAM(pb);
        PT1(10);
        for (int rep = 0; rep < NREP(1); ++rep) { if (rep) xcd_barrier(bar, XB_T0);
        if (IN(pb + 1)) { PH_LOCALS
            pg8::Gemm g{(const bf16_t*)(p->ws + WS_H), (const bf16_t*)(p->ws + WS_WIN) + (size_t)l * NU * 2048, NTOK, NU, 2048, 2048};
            pg8::StaticOrder S; S.init(NTOK, NU, G, bid);
            EpiU E{(bf16_t*)(p->ws + WS_U), p->out, p->in[I_BF], l};
            pg8::gemm_phase<EpiU, pg8::StaticOrder>(lds, g, S, E, nullptr, tid);
        }
        }
        SEAM(pb + 1);
        PT1(11);
        for (int rep = 0; rep < NREP(2); ++rep) { if (rep) xcd_barrier(bar, XB_T0);
        if (IN(pb + 2)) { PH_LOCALS
#ifndef DUP_SUB
#define DUP_SUB 0
#endif
            { PT0();
            for (int u = bid; u < NRU * ((DUP_SUB & 1) + 1); u += G) rwkv_r1(p, l, u % NRU, lds, tid);
            PT1(31);
            for (int u = (bid + G - 32) % G; u < 544 * (((DUP_SUB >> 1) & 1) + 1); u += G) conv_unit(p, l, u % 544, lds, tid);
            PT1(32);
            for (int u = (bid + G - 64) % G; u < 544 * (((DUP_SUB >> 2) & 1) + 1); u += G) pool_unit(p, l, u % 544, lds, tid);
            PT1(33);
            for (int u = bid; u < 256; u += G) { vt_tile(p, l, u * 8 + wave, lds, wave, lane); }
            __syncthreads();
            for (int u = (bid + G - 96) % G; u < 32; u += G) gs_unit(p, l, u, lds, tid);
            for (int u = G - 1 - bid; u < 8; u += G) fp_unit(p, l, u, lds, tid);
            if (bid == G / 2) shift_out(p, l, tid);
            PT1(34); }
        }
        }
        SEAM(pb + 2);
        PT1(12);
        for (int rep = 0; rep < NREP(3); ++rep) { if (rep) xcd_barrier(bar, XB_T0);
        if (IN(pb + 3)) { PH_LOCALS
            for (int tk = bid; tk < 256; tk += G) rwkv_l1_block(p, tk, lds, wave, lane);
            LAS int* qslot = (LAS int*)(lds + LDS_XB_OFF - 16);
            for (;;) {
                if (tid == 0) *qslot = (int)atomicAdd(ctl + CW_QUEUE + 64 * (2 * l + 4 * rep), 1u);
                __syncthreads();
                const int item = *qslot;
                __syncthreads();
                if (item >= 512) break;
                attn_prompt_unit(p, l, item & 7, 63 - (item >> 3), lds, tid);
            }
            for (;;) {
                if (tid == 0) *qslot = (int)atomicAdd(ctl + CW_QUEUE + 64 * (2 * l + 1 + 4 * rep), 1u);
                __syncthreads();
                const int item = *qslot;
                __syncthreads();
                if (item >= 256) break;
                attn_sample_unit(p, l, item >> 3, item & 7, lds, tid);
            }
        }
        }
        SEAM(pb + 3);
        PT1(13);
        if (IN(pb + 4)) { PH_LOCALS
            for (int tk = bid; tk < 128; tk += G) rwkv_l3_block(p, l, 127 - tk, lds, wave, lane);
            for (int tk = ((bid + G - 128) % G) * 8 + wave; tk < 1024; tk += ngw) rwkv_samp_task(p, l, tk, lane);
        }
        SEAM(pb + 4);
        PT1(14);
        if (IN(pb + 5)) { PH_LOCALS for (int tk = gw; tk < NRU * 2; tk += ngw) rwkv_r3_task(p, l, tk, lane); }
        SEAM(pb + 5);
        PT1(15);
        for (int rep = 0; rep < NREP(6); ++rep) { if (rep) xcd_barrier(bar, XB_T0);
        if (IN(pb + 6)) { PH_LOCALS
            pg8::Gemm g{(const bf16_t*)(p->ws + WS_OCAT), (const bf16_t*)(p->ws + WS_WBR) + (size_t)l * 4 * 2048 * 512, 4 * NTOK, 4 * 2048, 512, 512};
            BranchOrder S{G, bid};
            EpiZ E{(bf16_t*)(p->ws + WS_Z), (const bf16_t*)(p->ws + WS_U)};
            pg8::gemm_phase<EpiZ, BranchOrder>(lds, g, S, E, nullptr, tid);
        }
        }
        SEAM(pb + 6);
        PT1(16);
        if (IN(pb + 7)) { PH_LOCALS merge_pass(p, l, bid * 512 + tid, G * 512); }
        SEAM(pb + 7);
        PT1(17);
        if (IN(pb + 8)) { PH_LOCALS
            {
                pg8::Gemm g{(const bf16_t*)(p->ws + WS_MERGED), (const bf16_t*)(p->ws + WS_WOUT) + (size_t)l * 2048 * 2048, TP, 2048, 2048, 2048};
                pg8::StaticOrder S; S.init(TP, 2048, G, bid);
                EpiOut E{p->in[I_XP], p->in[I_XS], (const float*)(p->ws + WS_XBUF), (const float*)(p->ws + WS_ADA), (float*)(p->ws + WS_XBUF), l};
                pg8::gemm_phase<EpiOut, pg8::StaticOrder>(lds, g, S, E, nullptr, tid); }
            {
                const int tile = bid >> 3, ks = bid & 7;
                pg8::Gemm g{(const bf16_t*)(p->ws + WS_MERGED) + ks * 256, (const bf16_t*)(p->ws + WS_WOUT) + (size_t)l * 2048 * 2048 + ks * 256, NTOK, 2048, 256, 2048};
                OneUnit S{64 + (tile >> 3), tile & 7, bid < 256};
                EpiOutPart E{(const float*)(p->ws + WS_ADA), (float*)(p->ws + WS_XPART) + ((size_t)(l * 8 + ks) * 1024) * DM, l};
                pg8::gemm_phase<EpiOutPart, OneUnit>(lds, g, S, E, nullptr, tid); }
        }
        SEAM(pb + 8);
        PT1(18);
    }
    if (IN(19)) { PH_LOCALS p_final_rows(p, gw, ngw, lane); }
    PT1(20);
#if PROBE_ID
    if (bid == 0 && tid0 == 0) { const unsigned long long w = *(LAS unsigned long long*)(lds + LDS_PROBE_OFF) * PROBE_K, t0 = __builtin_amdgcn_s_memrealtime(); while (__builtin_amdgcn_s_memrealtime() - t0 < w) __builtin_amdgcn_s_sleep(8); }
#endif
#undef IN
#undef SEAM
}
#ifndef MK_SPLIT
#define MK_SPLIT 0
#endif
extern "C" void kernel_launch(void* const* d_in, const int* in_sizes, int n_in, void* d_out, int out_size, void* d_ws, size_t ws_size, hipStream_t stream) {
    static int grid = 0;
    if (grid == 0) {
        if (n_in != N_IN || (size_t)out_size != O_END || ws_size < WS_END) { fprintf(stderr, "kernel_launch: unexpected shapes (n_in %d, out %d, ws %zu)\n", n_in, out_size, ws_size); grid = -1; return; }
        int dev = 0, cus = 0, per_cu = 0;
        if (hipGetDevice(&dev) != hipSuccess || hipDeviceGetAttribute(&cus, hipDeviceAttributeMultiprocessorCount, dev) != hipSuccess) { grid = -1; return; }
        if (hipFuncSetAttribute((const void*)hse_fwd, hipFuncAttributeMaxDynamicSharedMemorySize, LDS_BYTES) != hipSuccess) { fprintf(stderr, "kernel_launch: hipFuncSetAttribute failed\n"); grid = -1; return; }
        if (hipOccupancyMaxActiveBlocksPerMultiprocessor(&per_cu, (const void*)hse_fwd, 512, LDS_BYTES) != hipSuccess || per_cu < 1) fprintf(stderr, "kernel_launch: occupancy query reports %d\n", per_cu);
        (void)hipGetLastError();
        grid = cus;
    }
    if (grid < 0) return;
    if (hipMemsetAsync((char*)d_ws + WS_CTL, 0, CTL_BYTES, stream) != hipSuccess) return;
    Params a{};
    for (int i = 0; i < N_IN; ++i) a.in[i] = (const float*)d_in[i];
    a.out = (float*)d_out; a.ws = (unsigned char*)d_ws;
#if MK_SPLIT
    for (int ph = 0; ph < NPHASE; ++ph) { a.ph_lo = ph; a.ph_hi = ph + 1; a.li = ph; hipLaunchKernelGGL(hse_fwd, dim3(grid), dim3(512), LDS_BYTES, stream, a); }
#else
    a.ph_lo = 0; a.ph_hi = NPHASE; a.li = 0;
    hipLaunchKernelGGL(hse_fwd, dim3(grid), dim3(512), LDS_BYTES, stream, a);
#endif
    const hipError_t le = hipPeekAtLastError();
    if (le != hipSuccess) fprintf(stderr, "kernel_launch: launch failed: %s\n", hipGetErrorName(le));
}
```

```cpp
#include <hip/hip_runtime.h>
#include <cstdio>
#include <cstdint>
namespace pg8 {
#define PG8_LAS __attribute__((address_space(3)))
typedef unsigned short bf16_t;
typedef short bf16x8 __attribute__((ext_vector_type(8)));
typedef float f32x4 __attribute__((ext_vector_type(4)));
typedef unsigned u32x4 __attribute__((ext_vector_type(4)));
constexpr int BM = 256, BK = 64, HALF = 128, HTB = HALF * BK * 2  , STAGE_BYTES = 8 * HTB, NXCD = 8, WGM = 8;

__host__ __device__ __forceinline__ int lds_byte(int r, int c) { const int st = (r >> 4) * 2 + (c >> 5), rr = r & 15, cc = c & 31, ob = rr * 64 + cc * 2; return st * 1024 + (ob ^ (((ob >> 9) & 1) << 5)); }
__host__ __device__ __forceinline__ void stage_rc(int b, int& R, int& C) { const int st = b / 1024, sb = b % 1024, swz = sb ^ (((sb >> 9) & 1) << 5); R = (st >> 1) * 16 + swz / 64; C = (st & 1) * 32 + (swz % 64) / 2; }
__host__ __device__ __forceinline__ int perm32(int rho) { const int n = rho >> 4, i = rho & 15; return 8 * (i >> 2) + 4 * n + (i & 3); }

struct Unit { int pm, pn; };
struct Gemm { const bf16_t* A; const bf16_t* Bt; int M, N, K, ld; };

struct StaticOrder {
    int nM, nN, nwg, G, c;
    __host__ __device__ void init(int M, int N, int G_, int c_) { nM = M / BM; nN = N / BM; nwg = nM * nN; G = G_; c = c_; }
    __host__ __device__ bool next(int i, Unit& u) const {
        const long L = (long)i * G + c; if (L >= nwg) return false;
        int wgid = (int)L; { const int q = nwg / NXCD, r = nwg % NXCD, xcd = wgid % NXCD, off = wgid / NXCD; wgid = (xcd < r ? xcd * (q + 1) : r * (q + 1) + (xcd - r) * q) + off; }
        const int nig = WGM * nN, gid = wgid / nig, fm = gid * WGM, gsz = (nM - fm) < WGM ? (nM - fm) : WGM;
        u.pm = fm + ((wgid % nig) % gsz); u.pn = (wgid % nig) / gsz; return true;
    }
    __device__ __forceinline__ void a_ready(const Unit&) const {}
    __device__ __forceinline__ void done(const Unit&) const {}
};
__device__ __forceinline__ unsigned cvt_pk_bf16(float lo, float hi) { unsigned r; asm volatile("v_cvt_pk_bf16_f32 %0, %1, %2" : "=v"(r) : "v"(lo), "v"(hi)); return r; }
typedef float f32x2 __attribute__((ext_vector_type(2)));
template <class Epi, class Sched, bool STAMP = false>
__device__ __forceinline__ void gemm_phase(PG8_LAS unsigned char* lds, const Gemm g, const Sched& S, const Epi& E, unsigned long long* stamps, int tid_in) {
    int tid = tid_in; asm volatile("" : "+v"(tid));
    const int wid = __builtin_amdgcn_readfirstlane(tid >> 6), lane = tid & 63, wr = wid >> 2, wc = wid & 3, fr = lane & 15, fq = lane >> 4;
    const int K = g.ld, nt = g.K / BK;
    int ts_lo = 0, ts_hi = 0, nts = 0; const unsigned long long rt_entry = STAMP ? (unsigned long long)wall_clock64() : 0ull;
#define PG8_STAMP() do { if (STAMP && wid == 0 && nts < 64) { const unsigned long long _c = (unsigned long long)clock64(); \
        ts_lo = (lane == nts) ? (int)(unsigned)_c : ts_lo; ts_hi = (lane == nts) ? (int)(unsigned)(_c >> 32) : ts_hi; ++nts; } } while (0)
    PG8_STAMP();
    unsigned voffA[2], voffB[2];
#pragma unroll
    for (int i = 0; i < 2; ++i) { int R, C; stage_rc(tid * 16 + i * 8192, R, C); const int Rb = Epi::PERM ? ((R & ~31) + perm32(R & 31)) : R;
        voffA[i] = (unsigned)(R * K + C) * 2u; voffB[i] = (unsigned)(Rb * K + C) * 2u; }
    const size_t kstep = (size_t)(BK * 2);
    const size_t hstep = (size_t)HALF * K * 2;
    const size_t tstep = 2 * hstep;
    const unsigned ldsw = (unsigned)wid * 1024u;
    const int aoff = lds_byte(wr * 64 + fr, fq * 8), boff = lds_byte(wc * 32 + fr, fq * 8);
#define PG8_SA(b, h) (((b) * 2 + (h)) * HTB)
#define PG8_SB(b, h) ((4 + (b) * 2 + (h)) * HTB)
#define PG8_STAGE(bufoff, gbase, voff) do { _Pragma("unroll") for (int _i = 0; _i < 2; ++_i) \
        __builtin_amdgcn_global_load_lds((const unsigned*)((const char*)(gbase) + (voff)[_i]), (PG8_LAS unsigned*)(lds + (bufoff) + ldsw + _i * 8192), 16, 0, 0); } while (0)
#define PG8_LDA(dst, b, h) do { _Pragma("unroll") for (int m = 0; m < 4; ++m) _Pragma("unroll") for (int k = 0; k < 2; ++k) dst[m][k] = *(const PG8_LAS bf16x8*)(lds + PG8_SA(b, h) + aoff + m * 2048 + k * 1024); } while (0)
#define PG8_LDB(dst, b, h) do { _Pragma("unroll") for (int n = 0; n < 2; ++n) _Pragma("unroll") for (int k = 0; k < 2; ++k) dst[n][k] = *(const PG8_LAS bf16x8*)(lds + PG8_SB(b, h) + boff + n * 2048 + k * 1024); } while (0)
#define PG8_MMA(ai, bj, At, Bt) do { __builtin_amdgcn_s_setprio(1); _Pragma("unroll") for (int m = 0; m < 4; ++m) _Pragma("unroll") for (int n = 0; n < 2; ++n) _Pragma("unroll") for (int k = 0; k < 2; ++k) \
        acc[ai][bj][m][n] = __builtin_amdgcn_mfma_f32_16x16x32_bf16(Bt[n][k], At[m][k], acc[ai][bj][m][n], 0, 0, 0); __builtin_amdgcn_s_setprio(0); } while (0)
#define PG8_WAIT_V(n) asm volatile("s_waitcnt vmcnt(" #n ")" ::: "memory")
#define PG8_WAIT_L(n) asm volatile("s_waitcnt lgkmcnt(" #n ")" ::: "memory")
#define PG8_BAR __builtin_amdgcn_s_barrier()
#define PG8_SCHED __builtin_amdgcn_sched_barrier(0)
    Unit cur, nxt; int ui = 0;
    if (!S.next(0, cur)) return;
    f32x4 acc[2][2][4][2];
#pragma unroll
    for (int a = 0; a < 2; ++a)
#pragma unroll
        for (int b = 0; b < 2; ++b)
#pragma unroll
            for (int m = 0; m < 4; ++m)
#pragma unroll
                for (int n = 0; n < 2; ++n) acc[a][b][m][n] = (f32x4){0.f, 0.f, 0.f, 0.f};
    bf16x8 At[4][2], B0[2][2], B1[2][2];
    const char* cA = (const char*)g.A + (size_t)cur.pm * tstep; const char* cB = (const char*)g.Bt + (size_t)cur.pn * tstep;
    S.a_ready(cur);
    PG8_STAGE(PG8_SB(0, 0), cB, voffB); PG8_STAGE(PG8_SA(0, 0), cA, voffA); PG8_STAGE(PG8_SB(0, 1), cB + hstep, voffB); PG8_STAGE(PG8_SA(0, 1), cA + hstep, voffA);
    if (wr == 1) PG8_BAR;
    PG8_WAIT_V(4); PG8_BAR;
    PG8_STAGE(PG8_SB(1, 0), cB + kstep, voffB); PG8_STAGE(PG8_SA(1, 0), cA + kstep, voffA); PG8_STAGE(PG8_SB(1, 1), cB + hstep + kstep, voffB);
    PG8_WAIT_V(6); PG8_BAR;
    PG8_STAMP();
    for (;;) {
        const bool has_next = S.next(ui + 1, nxt);
        const char* nA = has_next ? (const char*)g.A + (size_t)nxt.pm * tstep : cA; const char* nB = has_next ? (const char*)g.Bt + (size_t)nxt.pn * tstep : cB;
        for (int t = 0; t < nt; t += 2) {
            const bool last = (t == nt - 2);
            const char* a1 = cA + (size_t)(t + 1) * kstep;
            const char* a2 = last ? nA : cA + (size_t)(t + 2) * kstep; const char* b2 = last ? nB : cB + (size_t)(t + 2) * kstep;
            const char* a3 = a2 + kstep; const char* b3 = b2 + kstep;
            if (last && has_next) S.a_ready(nxt);
            PG8_LDB(B0, 0, 0); PG8_SCHED; PG8_LDA(At, 0, 0); PG8_STAGE(PG8_SA(1, 1), a1 + hstep, voffA);
            PG8_WAIT_L(8); PG8_BAR; PG8_WAIT_L(0); PG8_MMA(0, 0, At, B0); PG8_BAR; PG8_SCHED;
            PG8_LDB(B1, 0, 1); PG8_STAGE(PG8_SB(0, 0), b2, voffB);
            PG8_BAR; PG8_WAIT_L(0); PG8_MMA(0, 1, At, B1); PG8_BAR;
            PG8_LDA(At, 0, 1); PG8_STAGE(PG8_SA(0, 0), a2, voffA);
            PG8_BAR; PG8_WAIT_L(0); PG8_MMA(1, 0, At, B0); PG8_BAR; PG8_SCHED;
            PG8_STAGE(PG8_SB(0, 1), b2 + hstep, voffB);
            PG8_WAIT_V(6); PG8_BAR; PG8_MMA(1, 1, At, B1); PG8_BAR;
            PG8_LDB(B0, 1, 0); PG8_SCHED; PG8_LDA(At, 1, 0); PG8_STAGE(PG8_SA(0, 1), a2 + hstep, voffA);
            PG8_WAIT_L(8); PG8_BAR; PG8_WAIT_L(0); PG8_MMA(0, 0, At, B0); PG8_BAR; PG8_SCHED;
            PG8_LDB(B1, 1, 1); PG8_STAGE(PG8_SB(1, 0), b3, voffB);
            PG8_BAR; PG8_WAIT_L(0); PG8_MMA(0, 1, At, B1); PG8_BAR;
            PG8_LDA(At, 1, 1); PG8_STAGE(PG8_SA(1, 0), a3, voffA);
            PG8_BAR; PG8_WAIT_L(0); PG8_MMA(1, 0, At, B0); PG8_BAR; PG8_SCHED;
            PG8_STAGE(PG8_SB(1, 1), b3 + hstep, voffB);
            PG8_WAIT_V(6); PG8_BAR; PG8_MMA(1, 1, At, B1); PG8_BAR;
        }
        PG8_STAMP();
        if constexpr (!Epi::AFTER_DRAIN) { E(acc, cur, wr, wc, fr, fq); S.done(cur); }
        PG8_STAMP();
        if (!has_next) break;
#pragma unroll
        for (int a = 0; a < 2; ++a)
#pragma unroll
            for (int b = 0; b < 2; ++b)
#pragma unroll
                for (int m = 0; m < 4; ++m)
#pragma unroll
                    for (int n = 0; n < 2; ++n) acc[a][b][m][n] = (f32x4){0.f, 0.f, 0.f, 0.f};
        cur = nxt; cA = nA; cB = nB; ++ui;
    }
    PG8_WAIT_V(0);
    if (wr == 0) PG8_BAR;
    PG8_BAR;
    if constexpr (Epi::AFTER_DRAIN) { E.fused(acc, cur, wr, wc, fr, fq, lds, wid, lane); S.done(cur); }
    PG8_STAMP();
    if (STAMP && wid == 0) { stamps[lane] = lane < nts ? (((unsigned long long)(unsigned)ts_hi << 32) | (unsigned)ts_lo) : 0ull;
        if (lane == 62) stamps[62] = rt_entry; if (lane == 63) stamps[63] = (unsigned long long)wall_clock64(); }
#undef PG8_STAMP
#undef PG8_SA
#undef PG8_SB
#undef PG8_STAGE
#undef PG8_LDA
#undef PG8_LDB
#undef PG8_MMA
#undef PG8_WAIT_V
#undef PG8_WAIT_L
#undef PG8_BAR
#undef PG8_SCHED
}
}
#define XB_TMO      128
#define XB_XCNT(j)  (256  + 64 * (j))
#define XB_XSUB(j)  (1280 + 64 * (j))
#define XB_XGEN(j)  (2304 + 64 * (j))
#define XB_TOP      3328
#define XB_TOPGEN   3392
#define XCD_BAR_WORDS 3456
#define XB_SPIN_CAP (1u << 18)
#define LAS __attribute__((address_space(3)))

__device__ __forceinline__ unsigned xb_ld(unsigned* p)              { return __hip_atomic_load(p, __ATOMIC_RELAXED, __HIP_MEMORY_SCOPE_AGENT); }
__device__ __forceinline__ unsigned xb_add(unsigned* p, unsigned v) { return __hip_atomic_fetch_add(p, v, __ATOMIC_RELAXED, __HIP_MEMORY_SCOPE_AGENT); }
__device__ __forceinline__ unsigned xb_xcc_id() { return (unsigned)__builtin_amdgcn_s_getreg((3 << 11) | 20) & 0xFu; }
#define XB_SPIN(cond, bar) do { unsigned _sp = 0; while (cond) { __builtin_amdgcn_s_sleep(1); \
    if ((++_sp & 255u) == 0u) { if (xb_ld(&(bar)[XB_TMO])) break; if (_sp > XB_SPIN_CAP) { atomicAdd(&(bar)[XB_TMO], 1u); break; } } } } while (0)

struct XcdBarrier {
    unsigned* bar; unsigned x;
    volatile LAS unsigned* st;
};

__device__ __forceinline__ XcdBarrier xcd_barrier_post(unsigned* bar, volatile LAS unsigned* st) {
    XcdBarrier b; b.bar = bar; b.x = xb_xcc_id(); b.st = st;
    if (threadIdx.x == 0) (void)xb_add(&bar[XB_XCNT(b.x)], 1u);
    return b;
}
__device__ __forceinline__ void xcd_barrier_complete(unsigned* bar, unsigned x, unsigned& nloc, unsigned& nx) {
    const unsigned G = gridDim.x * gridDim.y * gridDim.z;
    unsigned sum, cnt, mine, sp = 0u;
    for (;;) {
        sum = 0u; cnt = 0u; mine = 0u;
#pragma unroll
        for (unsigned j = 0; j < 16; ++j) { const unsigned c = xb_ld(&bar[XB_XCNT(j)]); sum += c; cnt += (c > 0u) ? 1u : 0u; mine = (j == x) ? c : mine; }
        if (sum == G) break;
        __builtin_amdgcn_s_sleep(1);
        if ((++sp & 255u) == 0u) { if (xb_ld(&bar[XB_TMO])) break; if (sp > XB_SPIN_CAP) { atomicAdd(&bar[XB_TMO], 1u); break; } }
    }
    nloc = mine > 0u ? mine : 1u; nx = cnt > 0u ? cnt : 1u;
}

__device__ __forceinline__ void xcd_barrier(const XcdBarrier& b, const bool is_t0) {
    asm volatile("s_waitcnt vmcnt(0)" ::: "memory");
    __syncthreads();
    if (is_t0) {
        unsigned* bar = b.bar;
        __builtin_amdgcn_s_waitcnt(0);
        unsigned nloc = b.st[0], nx = b.st[1];
        if (nloc == 0u) { xcd_barrier_complete(bar, b.x, nloc, nx); b.st[0] = nloc; b.st[1] = nx; }
        const unsigned old = xb_add(&bar[XB_XSUB(b.x)], 1u);
        const unsigned gen = old / nloc;
        if (old + 1u == (gen + 1u) * nloc) {
            __builtin_amdgcn_fence(__ATOMIC_RELEASE, "agent");
            asm volatile("s_waitcnt vmcnt(0)" ::: "memory");
            const unsigned og = xb_add(&bar[XB_TOP], 1u);
            const unsigned tg = og / nx;
            if (og + 1u == (tg + 1u) * nx) xb_add(&bar[XB_TOPGEN], 1u);
            else XB_SPIN(xb_ld(&bar[XB_TOPGEN]) == tg, bar);
            __builtin_amdgcn_fence(__ATOMIC_ACQUIRE, "agent");
            xb_add(&bar[XB_XGEN(b.x)], 1u);
            asm volatile("s_waitcnt vmcnt(0)" ::: "memory");
        } else {
            XB_SPIN(xb_ld(&bar[XB_XGEN(b.x)]) == gen, bar);
            __builtin_amdgcn_fence(__ATOMIC_ACQUIRE, "agent");
            asm volatile("s_waitcnt vmcnt(0)" ::: "memory");
        }
    }
    __syncthreads();
}
typedef unsigned short bf16_t;
typedef short bf16x8 __attribute__((ext_vector_type(8)));
typedef float f32x4 __attribute__((ext_vector_type(4)));
typedef float f32x16 __attribute__((ext_vector_type(16)));
typedef unsigned u32x4 __attribute__((ext_vector_type(4)));
typedef unsigned u32x2 __attribute__((ext_vector_type(2)));
using pg8::cvt_pk_bf16;

constexpr int DM = 2048, TP = 16384, NSB = 32, TSQ = 32, NTOK = TP + NSB * TSQ, NSEQ = 33, PAST = 4096, NLAYER = 2;
constexpr int NU = 15104;
constexpr int U_AVAL = 0, U_AGATE = 512, U_ASG = 1024, U_Q = 1536, U_K = 2048, U_V = 2560, U_BSG = 3072, U_XC = 3584, U_CSG = 5248, U_DIN = 5760, U_DSG = 6272, U_G = 6784, U_F = 14976;
constexpr int IN_W = 14984, SHIFT_W = 1664;
constexpr float LOG2E = 1.4426950408889634f;
enum { I_XP = 0, I_XS, I_CK, I_CV, I_CLF, I_SCONV, I_SSHIFT, I_SWKV, I_SPOOL, I_CP, I_CS, I_NORMG, I_WADA, I_BADA, I_WIN, I_BF, I_CONVW, I_CONVB, I_CLNG, I_CLNB, I_MU, I_W0, I_W2, I_A0, I_A2,
       I_KK, I_KA, I_RK, I_GNG, I_GNB, I_POOLW, I_POOLB, I_POOLS, I_WBR, I_WOUT, I_FING, N_IN };
constexpr size_t O_YP = 0, O_YS = O_YP + (size_t)TP * DM, O_PK = O_YS + (size_t)1024 * DM, O_PV = O_PK + (size_t)2 * TP * 512, O_PLF = O_PV + (size_t)2 * TP * 512, O_PCONV = O_PLF + (size_t)2 * TP * 8,
                 O_PSHIFT = O_PCONV + 2 * 30 * 512, O_PWKV = O_PSHIFT + 2 * 1664, O_PPOOL = O_PWKV + 2 * 8 * 64 * 64, O_SK = O_PPOOL + 2 * 15 * 512, O_SV = O_SK + (size_t)2 * 1024 * 512,
                 O_SLF = O_SV + (size_t)2 * 1024 * 512, O_SCONV = O_SLF + 2 * 1024 * 8, O_SSHIFT = O_SCONV + (size_t)2 * 32 * 30 * 512, O_SWKV = O_SSHIFT + 2 * 32 * 1664,
                 O_SPOOL = O_SWKV + (size_t)2 * 32 * 8 * 64 * 64, O_END = O_SPOOL + (size_t)2 * 32 * 15 * 512;
static_assert(O_END == 75374848, "output size");
constexpr size_t al256(size_t x) { return (x + 255) & ~(size_t)255; }
constexpr int NCU_CH = 288, NRU = NCU_CH * 8;
constexpr size_t WS_CTL = 0, CTL_BYTES = 512 * 1024;
constexpr size_t WS_WIN = CTL_BYTES;
constexpr size_t WS_WBR = al256(WS_WIN + (size_t)2 * NU * 2048 * 2);
constexpr size_t WS_WOUT = al256(WS_WBR + (size_t)2 * 4 * 2048 * 512 * 2);
constexpr size_t WS_POOLW = al256(WS_WOUT + (size_t)2 * 2048 * 2048 * 2);
constexpr size_t WS_ADA = al256(WS_POOLW + (size_t)2 * 4 * 128 * 128 * 2);
constexpr size_t WS_H = al256(WS_ADA + (size_t)2 * 33 * 6144 * 4);
constexpr size_t WS_U = al256(WS_H + (size_t)NTOK * 2048 * 2);
constexpr size_t WS_XBUF = al256(WS_U + (size_t)NTOK * NU * 2);
constexpr size_t WS_OCAT = al256(WS_XBUF + (size_t)NTOK * 2048 * 4);
constexpr size_t WS_Z = al256(WS_OCAT + (size_t)4 * NTOK * 512 * 2);
constexpr size_t WS_MERGED = al256(WS_Z + (size_t)4 * NTOK * 2048 * 2);
constexpr size_t WS_FP = al256(WS_MERGED + (size_t)NTOK * 2048 * 2);
constexpr int GS_LEN = PAST + TSQ;
constexpr size_t WS_GS = al256(WS_FP + (size_t)8 * TP * 4);
constexpr size_t WS_VT = al256(WS_GS + (size_t)32 * 8 * GS_LEN * 4);
constexpr size_t WS_TQ = al256(WS_VT + (size_t)8 * 64 * TP * 2);
constexpr size_t WS_GM = al256(WS_TQ + (size_t)NRU * 4096 * 4);
constexpr size_t WS_ET = al256(WS_GM + (size_t)NRU * 4096 * 4);
constexpr size_t WS_Y0T = al256(WS_ET + (size_t)NRU * 4096 * 4);
constexpr size_t WS_SC = al256(WS_Y0T + (size_t)NRU * 4096 * 4);
constexpr size_t WS_BONUS = al256(WS_SC + (size_t)NRU * 4096 * 4);
constexpr size_t WS_GG = al256(WS_BONUS + (size_t)NRU * 64 * 4);
constexpr size_t WS_TG = al256(WS_GG + (size_t)16 * 8 * 4096 * 4);
constexpr size_t WS_SG = al256(WS_TG + (size_t)16 * 8 * 4096 * 4);
constexpr size_t WS_XPART = al256(WS_SG + (size_t)16 * 8 * 4096 * 4);
constexpr size_t WS_END = al256(WS_XPART + (size_t)2 * 8 * 1024 * 2048 * 4);
static_assert(WS_END < (size_t)2100 * 1024 * 1024, "workspace map exceeds the guaranteed d_ws size");
constexpr int CW_BAR = 0;
constexpr int CW_QUEUE = 16 * 3456 + 64;
constexpr int CW_KMAX = CW_QUEUE + 64 * 8;
static_assert((CW_KMAX + 64) * 4 <= (int)CTL_BYTES, "ctl");
constexpr int LDS_BYTES = 163840 - 256;
constexpr int LDS_XB_OFF = LDS_BYTES - 16;
constexpr int SLOT_F = 64 * 65;

#ifndef PROBE_ID
#define PROBE_ID 0
#endif
#ifndef PROBE_K
#define PROBE_K 1
#endif
constexpr int LDS_PROBE_OFF = 163840 - 256 - 64;
#if PROBE_ID
#define PT0() unsigned long long _pt0 = (blockIdx.x == 0 && threadIdx.x == 0) ? __builtin_amdgcn_s_memrealtime() : 0ull
#define PT1(id) do { if ((id) == PROBE_ID && blockIdx.x == 0 && threadIdx.x == 0) { *(LAS unsigned long long*)(lds + LDS_PROBE_OFF) += __builtin_amdgcn_s_memrealtime() - _pt0; } _pt0 = (blockIdx.x == 0 && threadIdx.x == 0) ? __builtin_amdgcn_s_memrealtime() : 0ull; } while (0)
#else
#define PT0() do {} while (0)
#define PT1(id) do {} while (0)
#endif
struct Params { const float* in[N_IN]; float* out; unsigned char* ws; int ph_lo, ph_hi, li, pad; };
typedef const __attribute__((address_space(4))) Params* KP;
__device__ __forceinline__ KP kp_fresh(KP k) { asm volatile("" : "+s"(k)); return k; }

__device__ __forceinline__ float bf2f(unsigned short b) { return __uint_as_float(((unsigned)b) << 16); }
__device__ __forceinline__ float bflo(unsigned w) { return __uint_as_float(w << 16); }
__device__ __forceinline__ float bfhi(unsigned w) { return __uint_as_float(w & 0xffff0000u); }
__device__ __forceinline__ unsigned short f2bf(float f) { return (unsigned short)(cvt_pk_bf16(f, 0.f) & 0xffffu); }
__device__ __forceinline__ float sigmoidf_(float x) { return 1.f / (1.f + __expf(-x)); }
__device__ __forceinline__ float siluf_(float x) { return x / (1.f + __expf(-x)); }
__device__ __forceinline__ float log_sigmoidf_(float z) { return fminf(z, 0.f) - log1pf(expf(-fabsf(z))); }
template <int CTRL> __device__ __forceinline__ float dpp_mov(float v) { return __int_as_float(__builtin_amdgcn_update_dpp(0, __float_as_int(v), CTRL, 0xF, 0xF, true)); }
__device__ __forceinline__ float wave_sum(float v) {
    v += dpp_mov<0xB1>(v); v += dpp_mov<0x4E>(v); v += dpp_mov<0x141>(v); v += dpp_mov<0x140>(v);
    const float r0 = __int_as_float(__builtin_amdgcn_readlane(__float_as_int(v), 0)), r1 = __int_as_float(__builtin_amdgcn_readlane(__float_as_int(v), 16));
    const float r2 = __int_as_float(__builtin_amdgcn_readlane(__float_as_int(v), 32)), r3 = __int_as_float(__builtin_amdgcn_readlane(__float_as_int(v), 48));
    return (r0 + r1) + (r2 + r3);
}
__device__ __forceinline__ float wave_max(float v) {
    v = fmaxf(v, dpp_mov<0xB1>(v)); v = fmaxf(v, dpp_mov<0x4E>(v)); v = fmaxf(v, dpp_mov<0x141>(v)); v = fmaxf(v, dpp_mov<0x140>(v));
    const float r0 = __int_as_float(__builtin_amdgcn_readlane(__float_as_int(v), 0)), r1 = __int_as_float(__builtin_amdgcn_readlane(__float_as_int(v), 16));
    const float r2 = __int_as_float(__builtin_amdgcn_readlane(__float_as_int(v), 32)), r3 = __int_as_float(__builtin_amdgcn_readlane(__float_as_int(v), 48));
    return fmaxf(fmaxf(r0, r1), fmaxf(r2, r3));
}
__device__ __forceinline__ float wave_min(float v) { return -wave_max(-v); }
__device__ __forceinline__ float xhalf_max(float m) { const auto rr = __builtin_amdgcn_permlane32_swap(__float_as_uint(m), __float_as_uint(m), false, false); return fmaxf(__uint_as_float(rr[0]), __uint_as_float(rr[1])); }
__device__ __forceinline__ float xhalf_sum(float m) { const auto rr = __builtin_amdgcn_permlane32_swap(__float_as_uint(m), __float_as_uint(m), false, false); return __uint_as_float(rr[0]) + __uint_as_float(rr[1]); }
__device__ __forceinline__ bf16x8 pack8f(const f32x4 a, const f32x4 b) { u32x4 w; w.x = cvt_pk_bf16(a[0], a[1]); w.y = cvt_pk_bf16(a[2], a[3]); w.z = cvt_pk_bf16(b[0], b[1]); w.w = cvt_pk_bf16(b[2], b[3]); return __builtin_bit_cast(bf16x8, w); }
__device__ __forceinline__ float fast_tanh(float x) { const float e = __expf(-2.f * fabsf(x)); const float t = (1.f - e) * __builtin_amdgcn_rcpf(1.f + e); return x < 0.f ? -t : t; }
__device__ __forceinline__ void tr_tile(const float* __restrict__ src, size_t ld, int k0, int c0, int nvalid, bf16_t* __restrict__ dst, int K, LAS float* scr, int lane) {
    float tv[64];
#pragma unroll
    for (int kk = 0; kk < 64; ++kk) tv[kk] = src[(size_t)(k0 + kk) * ld + c0 + (lane < nvalid ? lane : 0)];
#pragma unroll
    for (int kk = 0; kk < 64; ++kk) scr[kk * 65 + lane] = (lane < nvalid) ? tv[kk] : 0.f;
    const int nl = lane >> 3, kc8 = (lane & 7) * 8;
#pragma unroll
    for (int it = 0; it < 8; ++it) { const int nn = 8 * it + nl; const LAS float* s = scr + kc8 * 65 + nn;
        u32x4 w; w.x = cvt_pk_bf16(s[0], s[65]); w.y = cvt_pk_bf16(s[130], s[195]); w.z = cvt_pk_bf16(s[260], s[325]); w.w = cvt_pk_bf16(s[390], s[455]);
        *(u32x4*)(dst + (size_t)nn * K + k0 + kc8) = w; }
}
__device__ __forceinline__ void p0_weights(KP p, LAS unsigned char* lds, int gw, int ngw, int wave, int lane) {
    LAS float* scr = (LAS float*)lds + wave * SLOT_F;
    constexpr int T_WIN = (NU / 64) * 32, T_WBR = 4 * 32 * 8, T_WOUT = 32 * 32, T_POOL = 4 * 2 * 2, T_L = T_WIN + T_WBR + T_WOUT + T_POOL;
    for (int it = gw; it < 2 * T_L; it += ngw) {
        const int l = it / T_L; int r = it % T_L;
        if (r < T_WIN) {
            const int nt = r / 32, kt = r % 32, m0 = nt * 64;
            int c0, nvalid = 64;
            if (m0 < 3072) c0 = m0; else if (m0 < U_F) c0 = m0 + 8; else if (m0 == U_F) { c0 = 3072; nvalid = 8; } else { c0 = 0; nvalid = 0; }
            tr_tile(p->in[I_WIN] + (size_t)l * 2048 * IN_W, IN_W, kt * 64, c0, nvalid, (bf16_t*)(p->ws + WS_WIN) + ((size_t)l * NU + m0) * 2048, 2048, scr, lane);
            continue; }
        r -= T_WIN;
        if (r < T_WBR) {
            const int n = r / 256, q = r % 256, nt = q / 8, kt = q % 8;
            tr_tile(p->in[I_WBR] + ((size_t)(l * 4 + n) * 512) * 2048, 2048, kt * 64, nt * 64, 64, (bf16_t*)(p->ws + WS_WBR) + ((size_t)(l * 4 + n) * 2048 + nt * 64) * 512, 512, scr, lane);
            continue; }
        r -= T_WBR;
        if (r < T_WOUT) {
            const int nt = r / 32, kt = r % 32;
            tr_tile(p->in[I_WOUT] + (size_t)l * 2048 * 2048, 2048, kt * 64, nt * 64, 64, (bf16_t*)(p->ws + WS_WOUT) + ((size_t)l * 2048 + nt * 64) * 2048, 2048, scr, lane);
            continue; }
        r -= T_WOUT;
        {
            const int g = r / 4, q = r % 4, nt = q / 2, kt = q % 2;
            tr_tile(p->in[I_POOLW] + (size_t)(l * 4 + g) * 128 * 128, 128, kt * 64, nt * 64, 64, (bf16_t*)(p->ws + WS_POOLW) + ((size_t)(l * 4 + g) * 128 + nt * 64) * 128, 128, scr, lane);
        }
    }
}
__device__ __forceinline__ void ada_unit(KP p, int unit, LAS unsigned char* lds, int tid) {
    const int wave = tid >> 6, lane = tid & 63, l = unit / 96, n0 = (unit % 96) * 64;
    LAS float* cs = (LAS float*)lds + wave * (33 * 64);
    LAS float* red = (LAS float*)lds + 8 * 33 * 64;
    const float* W = p->in[I_WADA] + (size_t)l * 2048 * 6144;
    const float* cp = p->in[I_CP]; const float* csm = p->in[I_CS];
    float acc[33];
#pragma unroll
    for (int s = 0; s < 33; ++s) acc[s] = 0.f;
    float wv[16];
#pragma unroll
    for (int j = 0; j < 16; ++j) wv[j] = W[(size_t)(wave * 256 + j) * 6144 + n0 + lane];
#pragma unroll 1
    for (int step = 0; step < 16; ++step) {
        const int k0 = wave * 256 + step * 16, kn = wave * 256 + (step < 15 ? step + 1 : step) * 16;
        float wn[16];
#pragma unroll
        for (int j = 0; j < 16; ++j) wn[j] = W[(size_t)(kn + j) * 6144 + n0 + lane];
        if ((step & 3) == 0) {
#pragma unroll
            for (int s = 0; s < 33; ++s) { const float c = (s == 0) ? cp[k0 + lane] : csm[(size_t)(s - 1) * 2048 + k0 + lane]; cs[s * 64 + lane] = siluf_(c); } }
        const int kk0 = (step & 3) * 16;
#pragma unroll
        for (int q4 = 0; q4 < 4; ++q4) {
#pragma unroll
            for (int s = 0; s < 33; ++s) { const f32x4 c4 = *(const LAS f32x4*)(cs + s * 64 + kk0 + 4 * q4); acc[s] += c4.x * wv[4 * q4] + c4.y * wv[4 * q4 + 1] + c4.z * wv[4 * q4 + 2] + c4.w * wv[4 * q4 + 3]; } }
#pragma unroll
        for (int j = 0; j < 16; ++j) wv[j] = wn[j];
    }
#pragma unroll
    for (int s = 0; s < 33; ++s) red[(wave * 33 + s) * 64 + lane] = acc[s];
    __syncthreads();
    for (int idx = tid; idx < 33 * 64; idx += 512) { const int s = idx >> 6, n = idx & 63; float v = p->in[I_BADA][l * 6144 + n0 + n];
#pragma unroll
        for (int w = 0; w < 8; ++w) v += red[(w * 33 + s) * 64 + n];
        ((float*)(p->ws + WS_ADA))[((size_t)l * 33 + s) * 6144 + n0 + n] = v; }
    __syncthreads();
}
__device__ __forceinline__ void load_x8(KP p, int l, int row, int lane, f32x4 (&v)[8]) {
    if (row < TP) { const f32x4* x4 = (const f32x4*)(l == 0 ? p->in[I_XP] + (size_t)row * DM : (const float*)(p->ws + WS_XBUF) + (size_t)row * DM) + lane;
#pragma unroll
        for (int j = 0; j < 8; ++j) v[j] = x4[64 * j]; }
    else { const int r = row - TP; const f32x4* x4 = (const f32x4*)(p->in[I_XS] + (size_t)r * DM) + lane;
#pragma unroll
        for (int j = 0; j < 8; ++j) v[j] = x4[64 * j];
        for (int s = 0; s < 8 * l; ++s) { const f32x4* q4 = (const f32x4*)((const float*)(p->ws + WS_XPART) + ((size_t)s * 1024 + r) * DM) + lane;
#pragma unroll
            for (int j = 0; j < 8; ++j) v[j] += q4[64 * j]; } }
}
__device__ __forceinline__ void p1_rows(KP p, int l, int gw, int ngw, int lane) {
    const f32x4* g4 = (const f32x4*)(p->in[I_NORMG] + l * DM) + lane;
    f32x4 a[8], sh[8]; int cur_seq = -1;
    for (int row = gw; row < NTOK; row += ngw) {
        const int seq = row < TP ? 0 : 1 + ((row - TP) >> 5);
        f32x4 v[8]; float ss = 0.f; load_x8(p, l, row, lane, v);
#pragma unroll
        for (int j = 0; j < 8; ++j) { ss += (v[j].x * v[j].x + v[j].y * v[j].y) + (v[j].z * v[j].z + v[j].w * v[j].w); }
        if (seq != cur_seq) { cur_seq = seq;
            const f32x4* sh4 = (const f32x4*)((const float*)(p->ws + WS_ADA) + ((size_t)l * 33 + seq) * 6144) + lane; const f32x4* sc4 = sh4 + 512;
#pragma unroll
            for (int j = 0; j < 8; ++j) { a[j] = g4[64 * j] * (sc4[64 * j] + 1.f); sh[j] = sh4[64 * j]; } }
        const float rstd = 1.f / sqrtf(wave_sum(ss) * (1.f / DM) + 1e-6f);
        u32x2* o = (u32x2*)((bf16_t*)(p->ws + WS_H) + (size_t)row * DM) + lane;
#pragma unroll
        for (int j = 0; j < 8; ++j) { const f32x4 y = v[j] * rstd * a[j] + sh[j];
            u32x2 w; w.x = cvt_pk_bf16(y.x, y.y); w.y = cvt_pk_bf16(y.z, y.w); o[64 * j] = w; }
    }
}
__device__ __forceinline__ void p_final_rows(KP p, int gw, int ngw, int lane) {
    const f32x4* g4 = (const f32x4*)p->in[I_FING] + lane;
    for (int row = gw; row < NTOK; row += ngw) {
        f32x4 v[8]; float ss = 0.f; load_x8(p, 2, row, lane, v);
#pragma unroll
        for (int j = 0; j < 8; ++j) { ss += (v[j].x * v[j].x + v[j].y * v[j].y) + (v[j].z * v[j].z + v[j].w * v[j].w); }
        const float rstd = 1.f / sqrtf(wave_sum(ss) * (1.f / DM) + 1e-6f);
        f32x4* o = (f32x4*)(p->out + O_YP + (size_t)row * DM) + lane;
#pragma unroll
        for (int j = 0; j < 8; ++j) o[64 * j] = v[j] * rstd * g4[64 * j];
    }
}
struct EpiU {
    static constexpr bool PERM = true, AFTER_DRAIN = false;
    bf16_t* U; float* out; const float* bf; int l;
    __device__ __forceinline__ void operator()(const f32x4 (&acc)[2][2][4][2], const pg8::Unit& u, int wr, int wc, int fr, int fq) const {
        const int row0 = u.pm * 256 + wr * 64 + fr, col0 = u.pn * 256 + wc * 32 + 8 * fq;
#pragma unroll
        for (int ai = 0; ai < 2; ++ai)
#pragma unroll
            for (int m = 0; m < 4; ++m) { bf16_t* rowp = U + (size_t)(row0 + ai * 128 + m * 16) * NU + col0;
#pragma unroll
                for (int bj = 0; bj < 2; ++bj) { const f32x4 v0 = acc[ai][bj][m][0], v1 = acc[ai][bj][m][1];
                    u32x4 w; w.x = cvt_pk_bf16(v0[0], v0[1]); w.y = cvt_pk_bf16(v0[2], v0[3]); w.z = cvt_pk_bf16(v1[0], v1[1]); w.w = cvt_pk_bf16(v1[2], v1[3]);
                    *(u32x4*)(rowp + bj * 128) = w; } }
        if (u.pn >= 8 && u.pn < 12) {
            const bool isv = u.pn >= 10; const int cin = (u.pn - (isv ? 10 : 8)) * 256 + wc * 32 + 8 * fq;
#pragma unroll
            for (int ai = 0; ai < 2; ++ai)
#pragma unroll
                for (int m = 0; m < 4; ++m) { const int row = row0 + ai * 128 + m * 16;
                    float* dst = row < TP ? out + (isv ? O_PV : O_PK) + ((size_t)l * TP + row) * 512 : out + (isv ? O_SV : O_SK) + ((size_t)l * 1024 + (row - TP)) * 512;
#pragma unroll
                    for (int bj = 0; bj < 2; ++bj) { *(f32x4*)(dst + cin + bj * 128) = acc[ai][bj][m][0]; *(f32x4*)(dst + cin + bj * 128 + 4) = acc[ai][bj][m][1]; } }
        }
        if (u.pn == 58 && wc == 0 && fq == 0) {
            const f32x4 b0 = *(const f32x4*)(bf + l * 8), b1 = *(const f32x4*)(bf + l * 8 + 4);
#pragma unroll
            for (int ai = 0; ai < 2; ++ai)
#pragma unroll
                for (int m = 0; m < 4; ++m) { const int row = row0 + ai * 128 + m * 16;
                    float* dst = row < TP ? out + O_PLF + ((size_t)l * TP + row) * 8 : out + O_SLF + ((size_t)l * 1024 + (row - TP)) * 8;
                    const f32x4 z0 = acc[ai][1][m][0] + b0, z1 = acc[ai][1][m][1] + b1; f32x4 o0, o1;
#pragma unroll
                    for (int e = 0; e < 4; ++e) { o0[e] = log_sigmoidf_(z0[e]); o1[e] = log_sigmoidf_(z1[e]); }
                    *(f32x4*)dst = o0; *(f32x4*)(dst + 4) = o1; }
        }
    }
};
struct BranchOrder {
    int G, c;
    __device__ __forceinline__ bool next(int i, pg8::Unit& u) const { const int L = i * G + c; if (L >= 4 * 544) return false; const int n = L / 544, t = L - n * 544; u.pm = n * 68 + (t >> 3); u.pn = n * 8 + (t & 7); return true; }
    __device__ __forceinline__ void a_ready(const pg8::Unit&) const {}
    __device__ __forceinline__ void done(const pg8::Unit&) const {}
};
struct EpiZ {
    static constexpr bool PERM = true, AFTER_DRAIN = false;
    bf16_t* Z; const bf16_t* U;
    __device__ __forceinline__ void operator()(const f32x4 (&acc)[2][2][4][2], const pg8::Unit& u, int wr, int wc, int fr, int fq) const {
        const int row0 = u.pm * 256 + wr * 64 + fr, col0 = (u.pn & 7) * 256 + wc * 32 + 8 * fq;
#pragma unroll
        for (int ai = 0; ai < 2; ++ai)
#pragma unroll
            for (int m = 0; m < 4; ++m) { bf16_t* rowp = Z + (size_t)(row0 + ai * 128 + m * 16) * DM + col0;
#pragma unroll
                for (int bj = 0; bj < 2; ++bj) { const f32x4 v0 = acc[ai][bj][m][0], v1 = acc[ai][bj][m][1];
                    u32x4 w; w.x = cvt_pk_bf16(v0[0], v0[1]); w.y = cvt_pk_bf16(v0[2], v0[3]); w.z = cvt_pk_bf16(v1[0], v1[1]); w.w = cvt_pk_bf16(v1[2], v1[3]);
                    *(u32x4*)(rowp + bj * 128) = w; } }
    }
};
__device__ __forceinline__ void merge_pass(KP p, int l, int gtid, int ngt) {
    const bf16_t* U = (const bf16_t*)(p->ws + WS_U); const bf16_t* Z = (const bf16_t*)(p->ws + WS_Z); bf16_t* M = (bf16_t*)(p->ws + WS_MERGED);
    for (int it0 = gtid; it0 < NTOK * 256; it0 += 3 * ngt) {
        u32x4 gv[3][4], zv[3][4];
#pragma unroll
        for (int k = 0; k < 3; ++k) { const int it = it0 + k * ngt < NTOK * 256 ? it0 + k * ngt : it0; const int row = it >> 8, col = (it & 255) * 8;
#pragma unroll
            for (int n = 0; n < 4; ++n) { gv[k][n] = *(const u32x4*)(U + (size_t)row * NU + U_G + n * 2048 + col); zv[k][n] = *(const u32x4*)(Z + ((size_t)n * NTOK + row) * DM + col); } }
#pragma unroll
        for (int k = 0; k < 3; ++k) { const int it = it0 + k * ngt; if (it < NTOK * 256) { const int row = it >> 8, col = (it & 255) * 8;
            float s[8];
#pragma unroll
            for (int e = 0; e < 8; ++e) s[e] = 0.f;
#pragma unroll
            for (int n = 0; n < 4; ++n) { const u32x4 g = gv[k][n], z = zv[k][n];
                s[0] += sigmoidf_(bflo(g.x)) * bflo(z.x); s[1] += sigmoidf_(bfhi(g.x)) * bfhi(z.x); s[2] += sigmoidf_(bflo(g.y)) * bflo(z.y); s[3] += sigmoidf_(bfhi(g.y)) * bfhi(z.y);
                s[4] += sigmoidf_(bflo(g.z)) * bflo(z.z); s[5] += sigmoidf_(bfhi(g.z)) * bfhi(z.z); s[6] += sigmoidf_(bflo(g.w)) * bflo(z.w); s[7] += sigmoidf_(bfhi(g.w)) * bfhi(z.w); }
            u32x4 w; w.x = cvt_pk_bf16(s[0], s[1]); w.y = cvt_pk_bf16(s[2], s[3]); w.z = cvt_pk_bf16(s[4], s[5]); w.w = cvt_pk_bf16(s[6], s[7]);
            *(u32x4*)(M + (size_t)row * DM + col) = w; } }
    }
}
struct EpiOut {
    static constexpr bool PERM = false, AFTER_DRAIN = false;
    const float* xp; const float* xs; const float* xb; const float* ada; float* xout; int l;
    __device__ __forceinline__ void operator()(const f32x4 (&acc)[2][2][4][2], const pg8::Unit& u, int wr, int wc, int fr, int fq) const {
        const int row0 = u.pm * 256 + wr * 64 + fr, col0 = u.pn * 256 + wc * 32 + 4 * fq;
        f32x4 gt[2][2];
#pragma unroll
        for (int ai = 0; ai < 2; ++ai)
#pragma unroll
            for (int mp = 0; mp < 4; mp += 2) {
                f32x4 bs[2][2][2], gv[2][2][2];
#pragma unroll
                for (int mm = 0; mm < 2; ++mm) { const int row = row0 + ai * 128 + (mp + mm) * 16;
                    const float* base = l == 0 ? (row < TP ? xp + (size_t)row * DM : xs + (size_t)(row - TP) * DM) : xb + (size_t)row * DM;
                    const float* gate = ada + ((size_t)l * 33 + (row < TP ? 0 : 1 + ((row - TP) >> 5))) * 6144 + 4096;
#pragma unroll
                    for (int bj = 0; bj < 2; ++bj)
#pragma unroll
                        for (int n = 0; n < 2; ++n) { const int col = col0 + bj * 128 + n * 16; bs[mm][bj][n] = *(const f32x4*)(base + col); gv[mm][bj][n] = *(const f32x4*)(gate + col); } }
#pragma unroll
                for (int mm = 0; mm < 2; ++mm) { const int row = row0 + ai * 128 + (mp + mm) * 16;
#pragma unroll
                    for (int bj = 0; bj < 2; ++bj)
#pragma unroll
                        for (int n = 0; n < 2; ++n) { const int col = col0 + bj * 128 + n * 16; *(f32x4*)(xout + (size_t)row * DM + col) = bs[mm][bj][n] + gv[mm][bj][n] * acc[ai][bj][mp + mm][n]; } }
            }
        (void)gt;
    }
};
struct OneUnit {
    int pm, pn; bool valid;
    __device__ __forceinline__ bool next(int i, pg8::Unit& u) const { if (i > 0 || !valid) return false; u.pm = pm; u.pn = pn; return true; }
    __device__ __forceinline__ void a_ready(const pg8::Unit&) const {}
    __device__ __forceinline__ void done(const pg8::Unit&) const {}
};
struct EpiOutPart {
    static constexpr bool PERM = false, AFTER_DRAIN = false;
    const float* ada; float* part; int l;
    __device__ __forceinline__ void operator()(const f32x4 (&acc)[2][2][4][2], const pg8::Unit& u, int wr, int wc, int fr, int fq) const {
        const int row0 = u.pm * 256 + wr * 64 + fr - TP, col0 = u.pn * 256 + wc * 32 + 4 * fq;
#pragma unroll
        for (int ai = 0; ai < 2; ++ai)
#pragma unroll
            for (int m = 0; m < 4; ++m) { const int r = row0 + ai * 128 + m * 16;
                const float* gate = ada + ((size_t)l * 33 + 1 + (r >> 5)) * 6144 + 4096;
#pragma unroll
                for (int bj = 0; bj < 2; ++bj)
#pragma unroll
                    for (int n = 0; n < 2; ++n) { const int col = col0 + bj * 128 + n * 16; *(f32x4*)(part + (size_t)r * DM + col) = *(const f32x4*)(gate + col) * acc[ai][bj][m][n]; } }
    }
};
constexpr int CGS = 516;
__device__ __forceinline__ void conv_unit(KP p, int l, int tile, LAS unsigned char* lds, int tid) {
    const bf16_t* U = (const bf16_t*)(p->ws + WS_U);
    const int c = tid, wave = tid >> 6, lane = tid & 63;
    const bool samp = tile >= 512; const int b = tile - 512, row0 = samp ? TP + b * 32 : tile * 32;
    const bool last = samp || tile == 511;
    LAS float* gl = (LAS float*)lds;
    LAS bf16_t* sgl = (LAS bf16_t*)(lds + 62 * CGS * 4);
    LAS float* red = (LAS float*)(lds + 62 * CGS * 4 + 32 * 512 * 2);
    LAS float* st = red + 8 * 32;
#pragma unroll
    for (int k = 0; k < 8; ++k) { const int task = tid + 512 * k; if (task < 62 * 64) { const int i = task >> 6, ch = task & 63; f32x4 o0, o1;
        const int rel = i - 30;
        if (rel < 0 && samp) { const float* hp = p->in[I_SCONV] + (((size_t)l * 32 + b) * 30 + i) * 512 + 8 * ch; o0 = *(const f32x4*)hp; o1 = *(const f32x4*)(hp + 4); }
        else if (row0 + rel < 0) { o0 = (f32x4){0.f, 0.f, 0.f, 0.f}; o1 = o0; }
        else { const bf16_t* up = U + (size_t)(row0 + rel) * NU + 8 * ch; const u32x4 v = *(const u32x4*)(up + U_AVAL), g = *(const u32x4*)(up + U_AGATE);
            o0 = (f32x4){bflo(v.x) * sigmoidf_(bflo(g.x)), bfhi(v.x) * sigmoidf_(bfhi(g.x)), bflo(v.y) * sigmoidf_(bflo(g.y)), bfhi(v.y) * sigmoidf_(bfhi(g.y))};
            o1 = (f32x4){bflo(v.z) * sigmoidf_(bflo(g.z)), bfhi(v.z) * sigmoidf_(bfhi(g.z)), bflo(v.w) * sigmoidf_(bflo(g.w)), bfhi(v.w) * sigmoidf_(bfhi(g.w))}; }
        *(LAS f32x4*)(gl + i * CGS + 8 * ch) = o0; *(LAS f32x4*)(gl + i * CGS + 8 * ch + 4) = o1; } }
#pragma unroll
    for (int k = 0; k < 4; ++k) { const int task = tid + 512 * k, t = task >> 6, ch = task & 63; const u32x4 s = *(const u32x4*)(U + (size_t)(row0 + t) * NU + U_ASG + 8 * ch);
        u32x4 w; w.x = cvt_pk_bf16(siluf_(bflo(s.x)), siluf_(bfhi(s.x))); w.y = cvt_pk_bf16(siluf_(bflo(s.y)), siluf_(bfhi(s.y))); w.z = cvt_pk_bf16(siluf_(bflo(s.z)), siluf_(bfhi(s.z))); w.w = cvt_pk_bf16(siluf_(bflo(s.w)), siluf_(bfhi(s.w)));
        *(LAS u32x4*)(sgl + t * 512 + 8 * ch) = w; }
    const float cb = p->in[I_CONVB][l * 512 + c], lg = p->in[I_CLNG][l * 512 + c], lb = p->in[I_CLNB][l * 512 + c];
    float wk[31];
#pragma unroll
    for (int k = 0; k < 31; ++k) wk[k] = p->in[I_CONVW][((size_t)l * 31 + k) * 512 + c];
    __syncthreads();
    if (last) {
        float* dst = samp ? p->out + O_SCONV + (((size_t)l * 32 + b) * 30) * 512 + c : p->out + O_PCONV + ((size_t)l * 30) * 512 + c;
#pragma unroll
        for (int t = 2; t < 32; ++t) dst[(size_t)(t - 2) * 512] = gl[(30 + t) * CGS + c];
    }
    bf16_t* oa = (bf16_t*)(p->ws + WS_OCAT);
#pragma unroll 1
    for (int half = 0; half < 2; ++half) {
        float z[46];
#pragma unroll
        for (int i = 0; i < 46; ++i) z[i] = gl[(16 * half + i) * CGS + c];
        float hv[16];
#pragma unroll
        for (int tt = 0; tt < 16; ++tt) hv[tt] = cb;
#pragma unroll
        for (int k = 0; k < 31; ++k) {
#pragma unroll
            for (int tt = 0; tt < 16; ++tt) hv[tt] += z[tt + k] * wk[k]; }
#pragma unroll
        for (int tt = 0; tt < 16; ++tt) { const float s1 = wave_sum(hv[tt]), s2 = wave_sum(hv[tt] * hv[tt]); if (lane == 0) { red[(wave * 16 + tt) * 2] = s1; red[(wave * 16 + tt) * 2 + 1] = s2; } }
        __syncthreads();
        if (tid < 16) { float s1 = 0.f, s2 = 0.f;
#pragma unroll
            for (int w = 0; w < 8; ++w) { s1 += red[(w * 16 + tid) * 2]; s2 += red[(w * 16 + tid) * 2 + 1]; }
            const float mean = s1 * (1.f / 512.f), var = fmaxf(s2 * (1.f / 512.f) - mean * mean, 0.f);
            st[tid * 2] = mean; st[tid * 2 + 1] = 1.f / sqrtf(var + 1e-5f); }
        __syncthreads();
#pragma unroll
        for (int tt = 0; tt < 16; ++tt) { const float y = (hv[tt] - st[tt * 2]) * st[tt * 2 + 1] * lg + lb; const int t = 16 * half + tt;
            oa[(size_t)(row0 + t) * 512 + c] = f2bf(siluf_(y) * bf2f(sgl[t * 512 + c])); }
    }
    __syncthreads();
}
__device__ __forceinline__ void pool_unit(KP p, int l, int tile, LAS unsigned char* lds, int tid) {
    const bf16_t* U = (const bf16_t*)(p->ws + WS_U);
    const int c = tid, wave = tid >> 6, lane = tid & 63;
    const bool samp = tile >= 512; const int b = tile - 512, row0 = samp ? TP + b * 32 : tile * 32;
    constexpr int PST = 520;
    LAS float* zl = (LAS float*)lds;
    LAS bf16_t* pl = (LAS bf16_t*)(lds + 47 * CGS * 4);
#pragma unroll
    for (int k = 0; k < 6; ++k) { const int task = tid + 512 * k; if (task < 47 * 64) { const int i = task >> 6, ch = task & 63; f32x4 o0, o1; const int rel = i - 15;
        if (rel < 0 && samp) { const float* hp = p->in[I_SPOOL] + (((size_t)l * 32 + b) * 15 + i) * 512 + 8 * ch; o0 = *(const f32x4*)hp; o1 = *(const f32x4*)(hp + 4); }
        else if (row0 + rel < 0) { o0 = (f32x4){0.f, 0.f, 0.f, 0.f}; o1 = o0; }
        else { const u32x4 v = *(const u32x4*)(U + (size_t)(row0 + rel) * NU + U_DIN + 8 * ch); o0 = (f32x4){bflo(v.x), bfhi(v.x), bflo(v.y), bfhi(v.y)}; o1 = (f32x4){bflo(v.z), bfhi(v.z), bflo(v.w), bfhi(v.w)}; }
        *(LAS f32x4*)(zl + i * CGS + 8 * ch) = o0; *(LAS f32x4*)(zl + i * CGS + 8 * ch + 4) = o1; } }
    u32x4 sgv[4];
#pragma unroll
    for (int k = 0; k < 4; ++k) { const int task = tid + 512 * k; sgv[k] = *(const u32x4*)(U + (size_t)(row0 + (task >> 6)) * NU + U_DSG + 8 * (task & 63)); }
    __syncthreads();
    {
        float z[47];
#pragma unroll
        for (int i = 0; i < 47; ++i) z[i] = zl[i * CGS + c];
        if (samp || tile == 511) {
            float* dst = samp ? p->out + O_SPOOL + (((size_t)l * 32 + b) * 15) * 512 + c : p->out + O_PPOOL + ((size_t)l * 15) * 512 + c;
#pragma unroll
            for (int t = 17; t < 32; ++t) dst[(size_t)(t - 17) * 512] = z[15 + t];
        }
        const int w = 2 << (c >> 7);
#pragma unroll
        for (int t = 0; t < 32; ++t) { float s = 0.f;
#pragma unroll
            for (int i = 0; i < 16; ++i) s += (i < w) ? z[15 + t - i] : 0.f;
            const int pos = samp ? PAST + t : row0 + t; const int cnt = (pos + 1 < w) ? pos + 1 : w;
            pl[t * PST + c] = f2bf(s / (float)cnt - z[15 + t]); }
    }
    __syncthreads();
    LAS bf16_t* sl = (LAS bf16_t*)lds;
    LAS bf16_t* ol = sl + 32 * PST;
#pragma unroll
    for (int k = 0; k < 4; ++k) { const int task = tid + 512 * k, t = task >> 6, ch = task & 63; const u32x4 s = sgv[k];
        u32x4 w; w.x = cvt_pk_bf16(siluf_(bflo(s.x)), siluf_(bfhi(s.x))); w.y = cvt_pk_bf16(siluf_(bflo(s.y)), siluf_(bfhi(s.y))); w.z = cvt_pk_bf16(siluf_(bflo(s.z)), siluf_(bfhi(s.z))); w.w = cvt_pk_bf16(siluf_(bflo(s.w)), siluf_(bfhi(s.w)));
        *(LAS u32x4*)(sl + t * PST + 8 * ch) = w; }
    __syncthreads();
    {
        const int g = wave >> 1, fr = lane & 15, kq = lane >> 4;
        const bf16_t* WT = (const bf16_t*)(p->ws + WS_POOLW) + (size_t)(l * 4 + g) * 128 * 128;
        f32x4 acc[2][4];
#pragma unroll
        for (int mt = 0; mt < 2; ++mt)
#pragma unroll
            for (int nt = 0; nt < 4; ++nt) acc[mt][nt] = (f32x4){0.f, 0.f, 0.f, 0.f};
#pragma unroll
        for (int ks = 0; ks < 4; ++ks) {
            bf16x8 af[2];
#pragma unroll
            for (int mt = 0; mt < 2; ++mt) af[mt] = *(const LAS bf16x8*)(pl + (16 * mt + fr) * PST + g * 128 + 32 * ks + 8 * kq);
#pragma unroll
            for (int nt = 0; nt < 4; ++nt) { const int dl = (wave & 1) * 64 + 16 * nt + fr;
                const bf16x8 bfr = *(const bf16x8*)(WT + (size_t)dl * 128 + 32 * ks + 8 * kq);
#pragma unroll
                for (int mt = 0; mt < 2; ++mt) acc[mt][nt] = __builtin_amdgcn_mfma_f32_16x16x32_bf16(af[mt], bfr, acc[mt][nt], 0, 0, 0); }
        }
#pragma unroll
        for (int nt = 0; nt < 4; ++nt) { const int d = wave * 64 + 16 * nt + fr; const float pb = p->in[I_POOLB][l * 512 + d], ps = p->in[I_POOLS][l * 512 + d];
#pragma unroll
            for (int mt = 0; mt < 2; ++mt)
#pragma unroll
                for (int r = 0; r < 4; ++r) { const int t = 16 * mt + 4 * kq + r; ol[t * PST + d] = f2bf((acc[mt][nt][r] + pb) * ps * bf2f(sl[t * PST + d])); } }
    }
    __syncthreads();
    bf16_t* od = (bf16_t*)(p->ws + WS_OCAT) + (size_t)3 * NTOK * 512;
#pragma unroll
    for (int k = 0; k < 4; ++k) { const int task = tid + 512 * k, t = task >> 6, ch = task & 63; *(u32x4*)(od + (size_t)(row0 + t) * 512 + 8 * ch) = *(const LAS u32x4*)(ol + t * PST + 8 * ch); }
    __syncthreads();
}
__device__ __forceinline__ void fp_unit(KP p, int l, int h, LAS unsigned char* lds, int tid) {
    const float* lf = p->out + O_PLF + (size_t)l * TP * 8 + h;
    LAS float* part = (LAS float*)lds;
    float v[32]; float s = 0.f;
#pragma unroll
    for (int i = 0; i < 32; ++i) { v[i] = lf[(size_t)(tid * 32 + i) * 8]; s += v[i]; }
    part[tid] = s;
    __syncthreads();
    float pre = 0.f;
    for (int j = 0; j < tid; ++j) pre += part[j];
    float* F = (float*)(p->ws + WS_FP) + (size_t)h * TP + tid * 32;
#pragma unroll
    for (int i = 0; i < 32; ++i) { pre += v[i]; F[i] = pre * LOG2E; }
    __syncthreads();
}
__device__ __forceinline__ void gs_unit(KP p, int l, int b, LAS unsigned char* lds, int tid) {
    const int h = tid & 7, ch = tid >> 3;
    const float* cl = p->in[I_CLF] + (((size_t)l * 32 + b) * PAST + ch * 64) * 8 + h;
    LAS float* part = (LAS float*)lds;
    float v[64]; float s = 0.f;
#pragma unroll
    for (int i = 0; i < 64; ++i) v[i] = cl[(size_t)i * 8];
#pragma unroll
    for (int i = 0; i < 64; ++i) s += v[i];
    part[ch * 8 + h] = s;
    __syncthreads();
    float suf = 0.f;
    for (int j = ch + 1; j < 64; ++j) suf += part[j * 8 + h];
    float* G = (float*)(p->ws + WS_GS) + ((size_t)b * 8 + h) * GS_LEN + ch * 64;
#pragma unroll
    for (int i = 63; i >= 0; --i) { G[i] = -suf * LOG2E; suf += v[i]; }
    if (tid < 8) { const float* nl = p->out + O_SLF + ((size_t)l * 1024 + b * 32) * 8 + tid; float* Gn = (float*)(p->ws + WS_GS) + ((size_t)b * 8 + tid) * GS_LEN + PAST; float w[32]; float run = 0.f;
#pragma unroll
        for (int i = 0; i < 32; ++i) w[i] = nl[i * 8];
#pragma unroll
        for (int i = 0; i < 32; ++i) { run += w[i]; Gn[i] = run * LOG2E; } }
    __syncthreads();
}
__device__ __forceinline__ void vt_tile(KP p, int l, int tile, LAS unsigned char* lds, int wave, int lane) {
    const int h = tile >> 8, tb = tile & 255, tl = lane >> 3, q8 = (lane & 7) * 8;
    const bf16_t* U = (const bf16_t*)(p->ws + WS_U);
    LAS unsigned short* scr = (LAS unsigned short*)(lds + wave * (64 * 72 * 2));
    u32x4 kv[8], vv[8];
#pragma unroll
    for (int i = 0; i < 8; ++i) { const bf16_t* rp = U + (size_t)(tb * 64 + 8 * i + tl) * NU + h * 64 + q8; kv[i] = *(const u32x4*)(rp + U_K); vv[i] = *(const u32x4*)(rp + U_V); }
    float mx = 0.f;
#pragma unroll
    for (int i = 0; i < 8; ++i) { const u32x4 w = kv[i];
        float s = bflo(w.x) * bflo(w.x) + bfhi(w.x) * bfhi(w.x) + bflo(w.y) * bflo(w.y) + bfhi(w.y) * bfhi(w.y) + bflo(w.z) * bflo(w.z) + bfhi(w.z) * bfhi(w.z) + bflo(w.w) * bflo(w.w) + bfhi(w.w) * bfhi(w.w);
        s += dpp_mov<0xB1>(s); s += dpp_mov<0x4E>(s); s += dpp_mov<0x141>(s); mx = fmaxf(mx, s); }
    mx = wave_max(mx);
    if (lane == 0) atomicMax((unsigned*)(p->ws + WS_CTL) + CW_KMAX + l * 8 + h, __float_as_uint(mx));
#pragma unroll
    for (int i = 0; i < 8; ++i) { const int t = 8 * i + tl; const u32x4 w = vv[i];
        scr[(q8 + 0) * 72 + t] = (unsigned short)(w.x & 0xffffu); scr[(q8 + 1) * 72 + t] = (unsigned short)(w.x >> 16); scr[(q8 + 2) * 72 + t] = (unsigned short)(w.y & 0xffffu); scr[(q8 + 3) * 72 + t] = (unsigned short)(w.y >> 16);
        scr[(q8 + 4) * 72 + t] = (unsigned short)(w.z & 0xffffu); scr[(q8 + 5) * 72 + t] = (unsigned short)(w.z >> 16); scr[(q8 + 6) * 72 + t] = (unsigned short)(w.w & 0xffffu); scr[(q8 + 7) * 72 + t] = (unsigned short)(w.w >> 16); }
    bf16_t* Vt = (bf16_t*)(p->ws + WS_VT) + ((size_t)h * 64 + lane) * TP + tb * 64;
#pragma unroll
    for (int j = 0; j < 8; ++j) *(u32x4*)(Vt + 8 * j) = *(const LAS u32x4*)(scr + lane * 72 + 8 * j);
}
__device__ __forceinline__ void shift_out(KP p, int l, int tid) {
    const bf16_t* U = (const bf16_t*)(p->ws + WS_U);
    for (int base = tid; base < NSEQ * SHIFT_W; base += 512 * 8) {
        unsigned short v[8];
#pragma unroll
        for (int k = 0; k < 8; ++k) { const int idx = base + k * 512 < NSEQ * SHIFT_W ? base + k * 512 : tid; const int s = idx / SHIFT_W, j = idx - s * SHIFT_W; const int row = s == 0 ? TP - 1 : TP + (s - 1) * 32 + 31; v[k] = U[(size_t)row * NU + U_XC + j]; }
#pragma unroll
        for (int k = 0; k < 8; ++k) { const int idx = base + k * 512; if (idx < NSEQ * SHIFT_W) { const int s = idx / SHIFT_W, j = idx - s * SHIFT_W;
            float* dst = s == 0 ? p->out + O_PSHIFT + (size_t)l * SHIFT_W + j : p->out + O_SSHIFT + ((size_t)l * 32 + (s - 1)) * SHIFT_W + j; *dst = bf2f(v[k]); } }
    }
}
template <bool AT, bool BT, bool NEGA>
__device__ __forceinline__ void mm32(f32x16& acc, const LAS float* Ap, int i0, const LAS float* Bp, int j0, int lane) {
    const int li = lane & 31, kh = lane >> 5;
    const LAS float* ap = AT ? Ap + (8 * kh) * 65 + i0 + li : Ap + (i0 + li) * 65 + 8 * kh;
    const LAS float* bp = BT ? Bp + (j0 + li) * 65 + 8 * kh : Bp + (8 * kh) * 65 + j0 + li;
#pragma unroll 2
    for (int s = 0; s < 4; ++s) {
        float a[8], b[8];
#pragma unroll
        for (int e = 0; e < 8; ++e) { a[e] = AT ? ap[(16 * s + e) * 65] : ap[16 * s + e]; b[e] = BT ? bp[16 * s + e] : bp[(16 * s + e) * 65]; }
        if (NEGA) {
#pragma unroll
            for (int e = 0; e < 8; ++e) a[e] = -a[e]; }
        const bf16x8 af = pack8f((f32x4){a[0], a[1], a[2], a[3]}, (f32x4){a[4], a[5], a[6], a[7]}), bfg = pack8f((f32x4){b[0], b[1], b[2], b[3]}, (f32x4){b[4], b[5], b[6], b[7]});
        acc = __builtin_amdgcn_mfma_f32_32x32x16_bf16(af, bfg, acc, 0, 0, 0);
    }
}
template <int MASK>
__device__ __forceinline__ void st_tile(LAS float* dst, const f32x16& acc, int i0, int j0, int lane) {
    const int li = lane & 31, hi = lane >> 5, j = j0 + li;
#pragma unroll
    for (int r = 0; r < 16; ++r) { const int i = i0 + (r & 3) + 8 * (r >> 2) + 4 * hi; float v = acc[r];
        if (MASK == 1 && !(i < j)) v = 0.f; if (MASK == 2 && !(i <= j)) v = 0.f; dst[i * 65 + j] = v; }
}
struct RwkvSeqInfo { int row0, ntok, prev_kind  , b; };
__device__ __forceinline__ RwkvSeqInfo rwkv_info(int cu) { RwkvSeqInfo s; if (cu < 256) { s.row0 = cu * 64; s.ntok = 64; s.prev_kind = cu == 0 ? 0 : 1; s.b = 0; } else { s.b = cu - 256; s.row0 = TP + s.b * 32; s.ntok = 32; s.prev_kind = 2; } return s; }

__device__ __forceinline__ void rwkv_r1(KP p, int l, int unit, int unit_next, LAS unsigned char* lds, int tid) {
    const int cu = unit >> 3, h = unit & 7, wave = tid >> 6, lane = tid & 63, li = lane & 31, hi = lane >> 5;
    const RwkvSeqInfo si = rwkv_info(cu);
    const bf16_t* U = (const bf16_t*)(p->ws + WS_U);
    LAS float* S0 = (LAS float*)lds; LAS float *S1 = S0 + SLOT_F, *S2 = S0 + 2 * SLOT_F, *S3 = S0 + 3 * SLOT_F, *S4 = S0 + 4 * SLOT_F, *S5 = S0 + 5 * SLOT_F, *S6 = S0 + 6 * SLOT_F, *S7 = S0 + 7 * SLOT_F, *S8 = S0 + 8 * SLOT_F;
    LAS float* gC = S0 + 9 * SLOT_F;
    const int q = wave >> 2, wq = wave & 3, i0 = (wq >> 1) * 32, j0 = (wq & 1) * 32;
    PT0();
    {
        const int j = tid & 63, tq = tid >> 6;
        const int tl = lane >> 3, q8 = (lane & 7) * 8;
#pragma unroll
        for (int kb = 0; kb < 5; kb += 3) {
        u32x4 cur[5], prv[5];
#pragma unroll
        for (int k = kb; k < (kb + 3 < 5 ? kb + 3 : 5); ++k) { const int pid = wave * 5 + k, s = pid >> 3, tb = pid & 7, t = tb * 8 + tl;
            const int xo = (s < 3 ? s * 512 + h * 64 : 1536 + (s - 3) * 64) + q8;
            const int tc = t < si.ntok ? t : si.ntok - 1, tp = tc > 0 ? tc - 1 : (si.prev_kind == 1 ? -1 : 0);
            cur[k] = *(const u32x4*)(U + (size_t)(si.row0 + tc) * NU + U_XC + xo); prv[k] = *(const u32x4*)(U + (size_t)(si.row0 + tp) * NU + U_XC + xo); }
#pragma unroll
        for (int k = kb; k < (kb + 3 < 5 ? kb + 3 : 5); ++k) { const int pid = wave * 5 + k, s = pid >> 3, tb = pid & 7, t = tb * 8 + tl;
            const int xo = (s < 3 ? s * 512 + h * 64 : 1536 + (s - 3) * 64) + q8;
            LAS float* dst = (s == 0 ? S0 : s == 1 ? S1 : s == 2 ? S2 : s == 3 ? S3 : S4) + t * 65 + q8;
            const f32x4 m0 = *(const f32x4*)(p->in[I_MU] + l * SHIFT_W + xo), m1 = *(const f32x4*)(p->in[I_MU] + l * SHIFT_W + xo + 4);
            float x[8] = {bflo(cur[k].x), bfhi(cur[k].x), bflo(cur[k].y), bfhi(cur[k].y), bflo(cur[k].z), bfhi(cur[k].z), bflo(cur[k].w), bfhi(cur[k].w)};
            float pv[8] = {bflo(prv[k].x), bfhi(prv[k].x), bflo(prv[k].y), bfhi(prv[k].y), bflo(prv[k].z), bfhi(prv[k].z), bflo(prv[k].w), bfhi(prv[k].w)};
            if (t == 0 && si.prev_kind != 1) {
                if (si.prev_kind == 2) { const float* sp = p->in[I_SSHIFT] + ((size_t)l * 32 + si.b) * SHIFT_W + xo;
#pragma unroll
                    for (int e = 0; e < 8; ++e) pv[e] = sp[e]; }
                else {
#pragma unroll
                    for (int e = 0; e < 8; ++e) pv[e] = 0.f; } }
#pragma unroll
            for (int e = 0; e < 8; ++e) { const float mu = e < 4 ? m0[e] : m1[e - 4]; float xs = (t < si.ntok) ? x[e] + (pv[e] - x[e]) * mu : 0.f; if (s == 3) xs = fast_tanh(xs); dst[e] = xs; }
        }
        }
#pragma unroll
        for (int mm = 0; mm < 8; ++mm) { const int m = tq * 8 + mm;
            S5[m * 65 + j] = p->in[I_W2][((size_t)l * 64 + m) * 512 + h * 64 + j]; S6[m * 65 + j] = p->in[I_A2][((size_t)l * 64 + m) * 512 + h * 64 + j]; }
    }
    __syncthreads();
    PT1(1);
    {
        f32x16 acc = {};
        const int c = j0 + li;
        if (q == 0) { mm32<false, false, false>(acc, S3, i0, S5, j0, lane); const float w0 = p->in[I_W0][l * 512 + h * 64 + c];
#pragma unroll
            for (int r = 0; r < 16; ++r) { const int t = i0 + (r & 3) + 8 * (r >> 2) + 4 * hi; const float zz = acc[r] + w0;
                const float sp = fmaxf(-zz, 0.f) + __logf(1.f + __expf(-fabsf(zz)));
                S7[t * 65 + c] = (t < si.ntok) ? -__expf(-sp - 0.5f) : 0.f; } }
        else { mm32<false, false, false>(acc, S4, i0, S6, j0, lane); const float a0 = p->in[I_A0][l * 512 + h * 64 + c];
#pragma unroll
            for (int r = 0; r < 16; ++r) { const int t = i0 + (r & 3) + 8 * (r >> 2) + 4 * hi; S8[t * 65 + c] = __builtin_amdgcn_rcpf(1.f + __expf(-(acc[r] + a0))); } }
    }
    __syncthreads();
    PT1(2);
    if (wave == 0) { float run = 0.f;
#pragma unroll 8
        for (int t = 0; t < 64; ++t) { run += S7[t * 65 + lane]; S3[t * 65 + lane] = run; } }
    else { const int c = lane; const float kkw = p->in[I_KK][l * 512 + h * 64 + c], kaw = p->in[I_KA][l * 512 + h * 64 + c], rkw = p->in[I_RK][l * 512 + h * 64 + c];
        for (int t = wave - 1; t < 64; t += 7) { const float kr = S1[t * 65 + c], kv = kr * kkw; const float ss = wave_sum(kv * kv);
            const float kn = kv * (1.f / sqrtf(fmaxf(ss, 1e-24f))); const float a = S8[t * 65 + c]; const float km = kr * (1.f + (a - 1.f) * kaw);
            const float bon = wave_sum(S0[t * 65 + c] * km * rkw);
            S4[t * 65 + c] = kn; S1[t * 65 + c] = km; S8[t * 65 + c] = kn * a;
            if (lane == 0) ((float*)(p->ws + WS_BONUS))[(size_t)unit * 64 + t] = bon; } }
    __syncthreads();
    { const int c = tid & 63, tq = tid >> 6;
#pragma unroll
        for (int tt = 0; tt < 8; ++tt) { const int t = tq * 8 + tt, o = t * 65 + c; const float Lg = S3[o], lw = S7[o];
            const float g = __expf(Lg), gi = __expf(-Lg), gp = __expf(Lg - lw);
            S0[o] *= g; S1[o] *= gi; S8[o] *= gi; S4[o] *= gp; if (t == 63) gC[c] = g; } }
    __syncthreads();
    PT1(3);
    unsigned touch = 0u;
    if (unit_next < NRU && tid < 65 * 5) { const RwkvSeqInfo sn = rwkv_info(unit_next >> 3); const int hn = unit_next & 7, rr = tid / 5, ln = tid - rr * 5;
        const int trow = rr == 0 ? (sn.prev_kind == 1 ? -1 : 0) : (rr - 1 < sn.ntok ? rr - 1 : sn.ntok - 1);
        const int xo = ln < 3 ? ln * 512 + hn * 64 : 1536 + (ln - 3) * 64;
        touch = *(const unsigned*)(U + (size_t)(sn.row0 + trow) * NU + U_XC + xo); }
    { f32x16 acc = {};
      if (q == 0) { mm32<false, true, false>(acc, S1, i0, S4, j0, lane); st_tile<1>(S3, acc, i0, j0, lane); }
      else { mm32<false, true, false>(acc, S8, i0, S4, j0, lane); st_tile<1>(S5, acc, i0, j0, lane); } }
    __syncthreads();
    { f32x16 acc = {};
      if (q == 0) { mm32<true, false, false>(acc, S2, i0, S3, j0, lane); st_tile<0>(S6, acc, i0, j0, lane); }
      else { mm32<false, true, false>(acc, S1, i0, S0, j0, lane); st_tile<2>(S7, acc, i0, j0, lane); } }
    __syncthreads();
    asm volatile("" :: "v"(touch));
    PT1(4);
    { float xa[4], xb[4]; const int ra = 4 * wave, rb = 60 - 4 * wave;
#pragma unroll
      for (int k = 0; k < 4; ++k) { xa[k] = (lane == ra + k) ? 1.f : 0.f; xb[k] = (lane == rb + k) ? 1.f : 0.f; }
      for (int s = ra; s < rb; ++s) { const float mrow = S5[s * 65 + lane];
#pragma unroll
          for (int k = 0; k < 4; ++k) xa[k] -= __builtin_bit_cast(float, __builtin_amdgcn_readlane(__builtin_bit_cast(int, xa[k]), s)) * mrow; }
      for (int s = rb; s < 63; ++s) { const float mrow = S5[s * 65 + lane]; float ya[4], yb[4];
#pragma unroll
          for (int k = 0; k < 4; ++k) { ya[k] = __builtin_bit_cast(float, __builtin_amdgcn_readlane(__builtin_bit_cast(int, xa[k]), s)); yb[k] = __builtin_bit_cast(float, __builtin_amdgcn_readlane(__builtin_bit_cast(int, xb[k]), s)); }
#pragma unroll
          for (int k = 0; k < 4; ++k) { xa[k] -= ya[k] * mrow; xb[k] -= yb[k] * mrow; } }
#pragma unroll
      for (int k = 0; k < 4; ++k) { S3[(ra + k) * 65 + lane] = xa[k]; S3[(rb + k) * 65 + lane] = xb[k]; } }
    __syncthreads();
    { f32x16 acc = {};
      if (q == 0) mm32<true, false, false>(acc, S4, i0, S3, j0, lane); else mm32<false, false, false>(acc, S6, i0, S3, j0, lane);
      __syncthreads();
      st_tile<0>(q == 0 ? S3 : S6, acc, i0, j0, lane); }
    __syncthreads();
    PT1(5);
    { f32x16 acc = {};
      if (q == 1) { mm32<false, true, false>(acc, S8, i0, S0, j0, lane); st_tile<2>(S4, acc, i0, j0, lane); }
      else { mm32<false, false, false>(acc, S3, i0, S8, j0, lane);
          const int jc = j0 + li; const float gc = gC[jc]; float* TQ = (float*)(p->ws + WS_TQ) + (size_t)unit * 4096;
#pragma unroll
          for (int rg = 0; rg < 4; ++rg) { const int ab = i0 + 8 * rg + 4 * hi; f32x4 o;
#pragma unroll
              for (int e = 0; e < 4; ++e) o[e] = ((ab + e == jc) ? gc : 0.f) - acc[rg * 4 + e] * gc;
              *(f32x4*)(TQ + ((((jc >> 4) * 4 + (ab >> 4)) * 64 + ((ab & 15) >> 2) * 16 + (jc & 15)) * 4)) = o; } } }
    __syncthreads();
    { f32x16 acc = {};
      if (q == 0) { mm32<true, false, false>(acc, S2, i0, S1, j0, lane); mm32<false, false, true>(acc, S6, i0, S8, j0, lane);
          const int jc = j0 + li; const float gc = gC[jc]; float* GM = (float*)(p->ws + WS_GM) + (size_t)unit * 4096;
#pragma unroll
          for (int r = 0; r < 16; ++r) GM[(i0 + (r & 3) + 8 * (r >> 2) + 4 * hi) * 64 + jc] = acc[r] * gc; }
      else { mm32<true, false, false>(acc, S2, i0, S7, j0, lane); mm32<false, false, true>(acc, S6, i0, S4, j0, lane);
          float* Y0T = (float*)(p->ws + WS_Y0T) + (size_t)unit * 4096;
#pragma unroll
          for (int rg = 0; rg < 4; ++rg) *(f32x4*)(Y0T + (((((j0 >> 5) * 2 + (i0 >> 5)) * 4 + rg) * 2 + hi) * 32 + li) * 4) = (f32x4){acc[rg * 4], acc[rg * 4 + 1], acc[rg * 4 + 2], acc[rg * 4 + 3]}; } }
    if (q == 0) { f32x16 acc;
#pragma unroll
        for (int r = 0; r < 16; ++r) acc[r] = S0[(j0 + li) * 65 + i0 + (r & 3) + 8 * (r >> 2) + 4 * hi];
        mm32<false, false, true>(acc, S3, i0, S4, j0, lane);
        float* ET = (float*)(p->ws + WS_ET) + (size_t)unit * 4096;
#pragma unroll
        for (int rg = 0; rg < 4; ++rg) *(f32x4*)(ET + ((((j0 >> 5) * 2 + (i0 >> 5)) * 8 + 2 * rg + hi) * 32 + li) * 4) = (f32x4){acc[rg * 4], acc[rg * 4 + 1], acc[rg * 4 + 2], acc[rg * 4 + 3]}; }
    __syncthreads();
    PT1(6);
}
template <bool SCQ>
__device__ __forceinline__ void chain_run(f32x4 (&st)[4], const float* TQ, const float* GM, float* SC, int nsteps, int i, int g, int lane) {
    constexpr size_t STRIDE = (size_t)8 * 4096;
    f32x4 tq[16], gm[4];
#pragma unroll
    for (int x = 0; x < 16; ++x) tq[x] = *(const f32x4*)(TQ + (x * 64 + lane) * 4);
#pragma unroll
    for (int tl = 0; tl < 4; ++tl) gm[tl] = GM ? *(const f32x4*)(GM + i * 64 + 16 * tl + 4 * g) : (f32x4){0.f, 0.f, 0.f, 0.f};
    for (int c = 0; c < nsteps; ++c) {
        if (SC) {
            if (SCQ) {
#pragma unroll
                for (int tl = 0; tl < 4; ++tl) *(f32x4*)(SC + c * STRIDE + ((((i >> 5) * 2 + (tl >> 1)) * 8 + 4 * (tl & 1) + g) * 32 + (i & 31)) * 4) = st[tl]; }
            else {
#pragma unroll
                for (int tl = 0; tl < 4; ++tl) *(f32x4*)(SC + c * STRIDE + i * 64 + 16 * tl + 4 * g) = st[tl]; } }
        f32x4 tqn[16], gmn[4];
        const int cn = (c + 1 < nsteps) ? c + 1 : c;
#pragma unroll
        for (int x = 0; x < 16; ++x) tqn[x] = *(const f32x4*)(TQ + cn * STRIDE + (x * 64 + lane) * 4);
#pragma unroll
        for (int tl = 0; tl < 4; ++tl) gmn[tl] = GM ? *(const f32x4*)(GM + cn * STRIDE + i * 64 + 16 * tl + 4 * g) : (f32x4){0.f, 0.f, 0.f, 0.f};
        f32x4 acc[4];
#pragma unroll
        for (int tp = 0; tp < 4; ++tp) acc[tp] = gm[tp];
#pragma unroll
        for (int tl = 0; tl < 4; ++tl)
#pragma unroll
            for (int r = 0; r < 4; ++r)
#pragma unroll
                for (int tp = 0; tp < 4; ++tp) acc[tp] = __builtin_amdgcn_mfma_f32_16x16x4f32(tq[tp * 4 + tl][r], st[tl][r], acc[tp], 0, 0, 0);
#pragma unroll
        for (int tl = 0; tl < 4; ++tl) st[tl] = acc[tl];
#pragma unroll
        for (int x = 0; x < 16; ++x) tq[x] = tqn[x];
#pragma unroll
        for (int tl = 0; tl < 4; ++tl) gm[tl] = gmn[tl];
    }
}
constexpr int CH_SLOT = 32768;
#define CH_LD(R, STEP) do { const int s_ = (STEP) < nsteps ? (STEP) : nsteps - 1; _Pragma("unroll") for (int k = 0; k < 4; ++k) { R[k] = *(const f32x4*)(TQ + (size_t)s_ * STRIDE + (k * 256 + ll) * 4); \
        R[4 + k] = GM ? *(const f32x4*)(GM + (size_t)s_ * STRIDE + (k * 256 + ll) * 4) : (f32x4){0.f, 0.f, 0.f, 0.f}; } } while (0)
#define CH_WR(R, SLOT) do { LAS float* d_ = (LAS float*)(lds + (SLOT) * CH_SLOT); _Pragma("unroll") for (int k = 0; k < 4; ++k) { *(LAS f32x4*)(d_ + (k * 256 + ll) * 4) = R[k]; *(LAS f32x4*)(d_ + 4096 + (k * 256 + ll) * 4) = R[4 + k]; } } while (0)
template <bool SCQ>
__device__ __forceinline__ void chain_block(f32x4 (&st)[4], const float* TQ, const float* GM, float* SC, int nsteps, LAS unsigned char* lds, int wave, int lane) {
    constexpr size_t STRIDE = (size_t)8 * 4096;
    if (wave >= 4) {
        const int ll = (wave - 4) * 64 + lane;
        f32x4 r0[8], r1[8], r2[8];
        CH_LD(r0, 0); CH_LD(r1, 1); CH_LD(r2, 2);
        CH_WR(r0, 0);
        __syncthreads();
        for (int c = 0; c < nsteps; c += 3) {
            CH_WR(r1, (c + 1) & 1); CH_LD(r0, c + 3); __syncthreads();
            if (c + 1 < nsteps) { CH_WR(r2, (c + 2) & 1); CH_LD(r1, c + 4); __syncthreads(); }
            if (c + 2 < nsteps) { CH_WR(r0, (c + 3) & 1); CH_LD(r2, c + 5); __syncthreads(); }
        }
    } else {
        const int fr = lane & 15, g = lane >> 4, i = wave * 16 + fr;
        __syncthreads();
        for (int c = 0; c < nsteps; ++c) {
            if (SC) {
                if (SCQ) {
#pragma unroll
                    for (int tl = 0; tl < 4; ++tl) *(f32x4*)(SC + c * STRIDE + ((((i >> 5) * 2 + (tl >> 1)) * 8 + 4 * (tl & 1) + g) * 32 + (i & 31)) * 4) = st[tl]; }
                else {
#pragma unroll
                    for (int tl = 0; tl < 4; ++tl) *(f32x4*)(SC + c * STRIDE + i * 64 + 16 * tl + 4 * g) = st[tl]; } }
            const LAS float* sl = (const LAS float*)(lds + (c & 1) * CH_SLOT);
            f32x4 acc[4];
#pragma unroll
            for (int tp = 0; tp < 4; ++tp) acc[tp] = *(const LAS f32x4*)(sl + 4096 + i * 64 + 16 * tp + 4 * g);
#pragma unroll
            for (int tl = 0; tl < 4; ++tl) { f32x4 tq[4];
#pragma unroll
                for (int tp = 0; tp < 4; ++tp) tq[tp] = *(const LAS f32x4*)(sl + ((tp * 4 + tl) * 64 + lane) * 4);
#pragma unroll
                for (int r = 0; r < 4; ++r)
#pragma unroll
                    for (int tp = 0; tp < 4; ++tp) acc[tp] = __builtin_amdgcn_mfma_f32_16x16x4f32(tq[tp][r], st[tl][r], acc[tp], 0, 0, 0); }
#pragma unroll
            for (int tl = 0; tl < 4; ++tl) st[tl] = acc[tl];
            __syncthreads();
        }
    }
}
__device__ __forceinline__ void rwkv_l1_block(KP p, int task, LAS unsigned char* lds, int wave, int lane) {
    const int kind = task & 1, h = (task >> 1) & 7, grp = task >> 4, iq = wave & 3;
    const int fr = lane & 15, g = lane >> 4, i = iq * 16 + fr;
    const size_t u0 = ((size_t)(grp * 16) * 8 + h) * 4096;
    f32x4 st[4];
#pragma unroll
    for (int tl = 0; tl < 4; ++tl)
#pragma unroll
        for (int r = 0; r < 4; ++r) st[tl][r] = (kind == 1 && i == 16 * tl + 4 * g + r) ? 1.f : 0.f;
    chain_block<false>(st, (const float*)(p->ws + WS_TQ) + u0, kind == 0 ? (const float*)(p->ws + WS_GM) + u0 : nullptr, nullptr, 16, lds, wave, lane);
    if (wave < 4) { const size_t gb = ((size_t)grp * 8 + h) * 4096;
        if (kind == 0) { float* GG = (float*)(p->ws + WS_GG) + gb;
#pragma unroll
            for (int tl = 0; tl < 4; ++tl) *(f32x4*)(GG + i * 64 + 16 * tl + 4 * g) = st[tl]; }
        else { float* TG = (float*)(p->ws + WS_TG) + gb;
#pragma unroll
            for (int tl = 0; tl < 4; ++tl)
#pragma unroll
                for (int r = 0; r < 4; ++r) TG[((tl * 4 + iq) * 64 + (fr >> 2) * 16 + 4 * g + r) * 4 + (fr & 3)] = st[tl][r]; } }
    __syncthreads();
}
__device__ __forceinline__ void rwkv_l2_block(KP p, int l, int h, LAS unsigned char* lds, int wave, int lane) {
    const int iq = wave & 3, fr = lane & 15, g = lane >> 4, i = iq * 16 + fr;
    f32x4 st[4];
#pragma unroll
    for (int tl = 0; tl < 4; ++tl) st[tl] = (f32x4){0.f, 0.f, 0.f, 0.f};
    chain_block<false>(st, (const float*)(p->ws + WS_TG) + (size_t)h * 4096, (const float*)(p->ws + WS_GG) + (size_t)h * 4096, (float*)(p->ws + WS_SG) + (size_t)h * 4096, 16, lds, wave, lane);
    if (wave < 4) { float* dst = p->out + O_PWKV + (((size_t)l * 8 + h) * 64 + i) * 64;
#pragma unroll
        for (int tl = 0; tl < 4; ++tl) *(f32x4*)(dst + 16 * tl + 4 * g) = st[tl]; }
    __syncthreads();
}
__device__ __forceinline__ void rwkv_l3_block(KP p, int l, int task, LAS unsigned char* lds, int wave, int lane) {
    const int h = task & 7, grp = task >> 3, iq = wave & 3, fr = lane & 15, g = lane >> 4, i = iq * 16 + fr;
    f32x4 st[4];
#pragma unroll
    for (int tl = 0; tl < 4; ++tl) st[tl] = (f32x4){0.f, 0.f, 0.f, 0.f};
    if (grp > 0) chain_block<false>(st, (const float*)(p->ws + WS_TG) + (size_t)h * 4096, (const float*)(p->ws + WS_GG) + (size_t)h * 4096, nullptr, grp, lds, wave, lane);
    const size_t u0 = ((size_t)(grp * 16) * 8 + h) * 4096;
    chain_block<true>(st, (const float*)(p->ws + WS_TQ) + u0, (const float*)(p->ws + WS_GM) + u0, (float*)(p->ws + WS_SC) + u0, 16, lds, wave, lane);
    if (grp == 15 && wave < 4) { float* dst = p->out + O_PWKV + (((size_t)l * 8 + h) * 64 + i) * 64;
#pragma unroll
        for (int tl = 0; tl < 4; ++tl) *(f32x4*)(dst + 16 * tl + 4 * g) = st[tl]; }
    __syncthreads();
}
__device__ __forceinline__ void rwkv_samp_task(KP p, int l, int t2, int lane) {
    const int fr = lane & 15, g = lane >> 4, iq = t2 & 3, h = (t2 >> 2) & 7, b = t2 >> 5, i = iq * 16 + fr;
    f32x4 st[4];
    const float* s0 = p->in[I_SWKV] + ((((size_t)l * 32 + b) * 8 + h) * 64 + i) * 64;
#pragma unroll
    for (int tl = 0; tl < 4; ++tl) st[tl] = *(const f32x4*)(s0 + 16 * tl + 4 * g);
    const size_t u0 = ((size_t)(256 + b) * 8 + h) * 4096;
    chain_run<true>(st, (const float*)(p->ws + WS_TQ) + u0, (const float*)(p->ws + WS_GM) + u0, (float*)(p->ws + WS_SC) + u0, 1, i, g, lane);
    float* dst = p->out + O_SWKV + ((((size_t)l * 32 + b) * 8 + h) * 64 + i) * 64;
#pragma unroll
    for (int tl = 0; tl < 4; ++tl) *(f32x4*)(dst + 16 * tl + 4 * g) = st[tl];
}
__device__ __forceinline__ void rwkv_r3_task(KP p, int l, int task, int lane) {
    const int unit = task >> 1, th = task & 1, cu = unit >> 3, h = unit & 7, li = lane & 31, hi = lane >> 5;
    const RwkvSeqInfo si = rwkv_info(cu);
    if (th * 32 >= si.ntok) return;
    const bf16_t* U = (const bf16_t*)(p->ws + WS_U);
    const size_t ub = (size_t)unit * 4096; const int t = th * 32 + li;
    const float* SC = (const float*)(p->ws + WS_SC) + ub; const float* ET = (const float*)(p->ws + WS_ET) + ub; const float* Y0T = (const float*)(p->ws + WS_Y0T) + ub;
    f32x16 acc[2];
#pragma unroll
    for (int ti = 0; ti < 2; ++ti)
#pragma unroll
        for (int rg = 0; rg < 4; ++rg) { const f32x4 y0 = *(const f32x4*)(Y0T + ((((th * 2 + ti) * 4 + rg) * 2 + hi) * 32 + li) * 4);
#pragma unroll
            for (int e = 0; e < 4; ++e) acc[ti][rg * 4 + e] = y0[e]; }
    f32x4 eb[8], sa0[8], sa1[8];
#pragma unroll
    for (int s4 = 0; s4 < 8; ++s4) { eb[s4] = *(const f32x4*)(ET + (((th * 2 + hi) * 8 + s4) * 32 + li) * 4); sa0[s4] = *(const f32x4*)(SC + (((0 * 2 + hi) * 8 + s4) * 32 + li) * 4); sa1[s4] = *(const f32x4*)(SC + (((1 * 2 + hi) * 8 + s4) * 32 + li) * 4); }
#pragma unroll
    for (int s4 = 0; s4 < 8; ++s4) {
#pragma unroll
        for (int e = 0; e < 4; ++e) { acc[0] = __builtin_amdgcn_mfma_f32_32x32x2f32(sa0[s4][e], eb[s4][e], acc[0], 0, 0, 0); acc[1] = __builtin_amdgcn_mfma_f32_32x32x2f32(sa1[s4][e], eb[s4][e], acc[1], 0, 0, 0); }
    }
    float s1 = 0.f;
#pragma unroll
    for (int ti = 0; ti < 2; ++ti)
#pragma unroll
        for (int r = 0; r < 16; ++r) s1 += acc[ti][r];
    s1 = xhalf_sum(s1); const float mean = s1 * (1.f / 64.f);
    float s2 = 0.f;
#pragma unroll
    for (int ti = 0; ti < 2; ++ti)
#pragma unroll
        for (int r = 0; r < 16; ++r) { const float d = acc[ti][r] - mean; s2 += d * d; }
    s2 = xhalf_sum(s2); const float rstd = 1.f / sqrtf(s2 * (1.f / 64.f) + 64e-5f);
    if (t >= si.ntok) return;
    const float bon = ((const float*)(p->ws + WS_BONUS))[(size_t)unit * 64 + t];
    const size_t row = (size_t)(si.row0 + t);
    bf16_t* oc = (bf16_t*)(p->ws + WS_OCAT) + (size_t)2 * NTOK * 512 + row * 512 + h * 64;
    u32x2 wout[2][4];
#pragma unroll
    for (int ti = 0; ti < 2; ++ti)
#pragma unroll
        for (int rg = 0; rg < 4; ++rg) { const int i = 32 * ti + 8 * rg + 4 * hi, c = h * 64 + i;
            const f32x4 gg = *(const f32x4*)(p->in[I_GNG] + l * 512 + c), gb = *(const f32x4*)(p->in[I_GNB] + l * 512 + c), mu = *(const f32x4*)(p->in[I_MU] + l * SHIFT_W + 1024 + c);
            const u32x2 vx = *(const u32x2*)(U + row * NU + U_XC + 1024 + c); const u32x2 sg = *(const u32x2*)(U + row * NU + U_CSG + c);
            f32x4 vc = (f32x4){bflo(vx.x), bfhi(vx.x), bflo(vx.y), bfhi(vx.y)}, vp;
            {
                const u32x2 px = *(const u32x2*)(U + (row > 0 ? row - 1 : 0) * NU + U_XC + 1024 + c); const f32x4 ss = *(const f32x4*)(p->in[I_SSHIFT] + ((size_t)l * 32 + si.b) * SHIFT_W + 1024 + c);
                const f32x4 up = (f32x4){bflo(px.x), bfhi(px.x), bflo(px.y), bfhi(px.y)};
                vp = (t > 0 || si.prev_kind == 1) ? up : (si.prev_kind == 2 ? ss : (f32x4){0.f, 0.f, 0.f, 0.f}); }
            const f32x4 vs = vc + (vp - vc) * mu;
            const f32x4 sgf = (f32x4){bflo(sg.x), bfhi(sg.x), bflo(sg.y), bfhi(sg.y)};
            f32x4 o;
#pragma unroll
            for (int e = 0; e < 4; ++e) o[e] = (((acc[ti][rg * 4 + e] - mean) * rstd) * gg[e] + gb[e] + bon * vs[e]) * siluf_(sgf[e]);
            wout[ti][rg].x = cvt_pk_bf16(o[0], o[1]); wout[ti][rg].y = cvt_pk_bf16(o[2], o[3]); }
#pragma unroll
    for (int ti = 0; ti < 2; ++ti)
#pragma unroll
        for (int rg = 0; rg < 4; ++rg) *(u32x2*)(oc + 32 * ti + 8 * rg + 4 * hi) = wout[ti][rg];
}
__device__ __forceinline__ int krow(int i) { return (i & 3) + 4 * ((i >> 3) & 1) + 8 * ((i >> 2) & 1) + 16 * (i >> 4); }
__device__ __forceinline__ bf16x8 pack8(const f32x16& v, int o) { u32x4 w; w.x = cvt_pk_bf16(v[o], v[o + 1]); w.y = cvt_pk_bf16(v[o + 2], v[o + 3]); w.z = cvt_pk_bf16(v[o + 4], v[o + 5]); w.w = cvt_pk_bf16(v[o + 6], v[o + 7]); return __builtin_bit_cast(bf16x8, w); }
constexpr float ATT_NEG = -1e30f;
template <bool HALF>
__device__ __forceinline__ void softmax_tile(f32x16& p0, f32x16& p1, float& m, float& lsum, f32x16 (&O)[2], bf16x8 (&pb)[4]) {
    float mx = p0[0];
#pragma unroll
    for (int r = 1; r < 16; ++r) mx = fmaxf(mx, p0[r]);
    if (!HALF) {
#pragma unroll
        for (int r = 0; r < 16; ++r) mx = fmaxf(mx, p1[r]); }
    mx = xhalf_max(mx);
    const float mn = fmaxf(m, mx), alpha = __builtin_amdgcn_exp2f(m - mn);
    m = mn;
    float s = 0.f;
#pragma unroll
    for (int r = 0; r < 16; ++r) { p0[r] = __builtin_amdgcn_exp2f(p0[r] - mn); s += p0[r]; }
    if (!HALF) {
#pragma unroll
        for (int r = 0; r < 16; ++r) { p1[r] = __builtin_amdgcn_exp2f(p1[r] - mn); s += p1[r]; } }
    lsum = lsum * alpha + s;
#pragma unroll
    for (int r = 0; r < 16; ++r) { O[0][r] *= alpha; O[1][r] *= alpha; }
    pb[0] = pack8(p0, 0); pb[1] = pack8(p0, 8);
    if (!HALF) { pb[2] = pack8(p1, 0); pb[3] = pack8(p1, 8); }
}
constexpr int AKS = 72;
constexpr int ATT_KB = 0, ATT_VB = 2 * 64 * AKS * 2, ATT_FB = 4 * 64 * AKS * 2, ATT_SC = ATT_FB + 2 * 64 * 4;
__device__ __forceinline__ void attn_prompt_unit(KP p, int l, int h, int qb, LAS unsigned char* lds, int tid) {
    const bf16_t* U = (const bf16_t*)(p->ws + WS_U); const bf16_t* Vt = (const bf16_t*)(p->ws + WS_VT) + (size_t)h * 64 * TP; const float* F = (const float*)(p->ws + WS_FP) + (size_t)h * TP;
    const int wave = tid >> 6, lane = tid & 63, li = lane & 31, hi = lane >> 5;
    const int q0 = qb * 256, q = q0 + wave * 32 + li;
    bf16x8 qf[4];
    { const float sc = 0.125f * LOG2E;
#pragma unroll
      for (int d0 = 0; d0 < 4; ++d0) { const u32x4 w = *(const u32x4*)(U + (size_t)q * NU + U_Q + h * 64 + 16 * d0 + 8 * hi);
          qf[d0] = pack8f((f32x4){bflo(w.x) * sc, bfhi(w.x) * sc, bflo(w.y) * sc, bfhi(w.y) * sc}, (f32x4){bflo(w.z) * sc, bfhi(w.z) * sc, bflo(w.w) * sc, bfhi(w.w) * sc}); } }
    const float fq = F[q];
    float m = ATT_NEG, lsum = 0.f; f32x16 O[2] = {};
    const int NT = (q0 + 256) / 64;
    LAS float* qmx = (LAS float*)(lds + ATT_SC); LAS float* mmv = qmx + 8;
    { float q2 = 0.f;
#pragma unroll
      for (int d0 = 0; d0 < 4; ++d0) { const u32x4 w = __builtin_bit_cast(u32x4, qf[d0]); q2 += bflo(w.x) * bflo(w.x) + bfhi(w.x) * bfhi(w.x) + bflo(w.y) * bflo(w.y) + bfhi(w.y) * bfhi(w.y) + bflo(w.z) * bflo(w.z) + bfhi(w.z) * bfhi(w.z) + bflo(w.w) * bflo(w.w) + bfhi(w.w) * bfhi(w.w); }
      q2 = wave_max(xhalf_sum(q2)); if (lane == 0) { qmx[wave] = q2; mmv[wave] = ATT_NEG; } }
    const float kmax2 = __uint_as_float(((const unsigned*)(p->ws + WS_CTL))[CW_KMAX + l * 8 + h]), fq0 = F[q0];
    const int srow = tid >> 3, sch = tid & 7;
    const bf16_t* kg = U + (size_t)srow * NU + U_K + h * 64 + 8 * sch; const bf16_t* vg = Vt + (size_t)srow * TP + 8 * sch;
    LAS unsigned char* kdst = lds + ATT_KB + (srow * AKS + 8 * sch) * 2; LAS unsigned char* vdst = lds + ATT_VB + (srow * AKS + 8 * sch) * 2;
    u32x4 kr = *(const u32x4*)(kg + (size_t)(NT - 1) * 64 * NU), vr = *(const u32x4*)(vg + (NT - 1) * 64); float fr = tid < 64 ? F[(NT - 1) * 64 + tid] : 0.f;
    *(LAS u32x4*)kdst = kr; *(LAS u32x4*)vdst = vr; if (tid < 64) ((LAS float*)(lds + ATT_FB))[tid] = fr;
    __syncthreads();
    const int ka = krow(li);
    float qkb; { float q2 = qmx[0];
#pragma unroll
      for (int w = 1; w < 8; ++w) q2 = fmaxf(q2, qmx[w]);
      qkb = 1.02f * sqrtf(q2 * kmax2) + fq0; }
    for (int t = NT - 1, buf = 0; t >= 0; --t, buf ^= 1) {
        { float mmin = mmv[0];
#pragma unroll
          for (int w = 1; w < 8; ++w) mmin = fminf(mmin, mmv[w]);
          if (qkb - ((const LAS float*)(lds + ATT_FB))[buf * 64 + 63] < mmin - 40.f) break; }
        if (t > 0) { kr = *(const u32x4*)(kg + (size_t)(t - 1) * 64 * NU); vr = *(const u32x4*)(vg + (t - 1) * 64); if (tid < 64) fr = F[(t - 1) * 64 + tid]; }
        if (64 * t <= q0 + wave * 32 + 31) {
            const LAS bf16_t* Kb = (const LAS bf16_t*)(lds + ATT_KB) + buf * 64 * AKS; const LAS bf16_t* Vb = (const LAS bf16_t*)(lds + ATT_VB) + buf * 64 * AKS; const LAS float* Fb = (const LAS float*)(lds + ATT_FB) + buf * 64;
            f32x16 p0, p1;
#pragma unroll
            for (int g2 = 0; g2 < 2; ++g2) { const f32x4 a = *(const LAS f32x4*)(Fb + 8 * hi + 16 * g2), b = *(const LAS f32x4*)(Fb + 8 * hi + 16 * g2 + 4), c = *(const LAS f32x4*)(Fb + 32 + 8 * hi + 16 * g2), d = *(const LAS f32x4*)(Fb + 32 + 8 * hi + 16 * g2 + 4);
#pragma unroll
                for (int e = 0; e < 4; ++e) { p0[8 * g2 + e] = fq - a[e]; p0[8 * g2 + 4 + e] = fq - b[e]; p1[8 * g2 + e] = fq - c[e]; p1[8 * g2 + 4 + e] = fq - d[e]; } }
#pragma unroll
            for (int d0 = 0; d0 < 4; ++d0) { const bf16x8 a0 = *(const LAS bf16x8*)(Kb + ka * AKS + 16 * d0 + 8 * hi), a1 = *(const LAS bf16x8*)(Kb + (ka + 32) * AKS + 16 * d0 + 8 * hi);
                p0 = __builtin_amdgcn_mfma_f32_32x32x16_bf16(a0, qf[d0], p0, 0, 0, 0); p1 = __builtin_amdgcn_mfma_f32_32x32x16_bf16(a1, qf[d0], p1, 0, 0, 0); }
            if (64 * t + 63 > q0 + wave * 32) {
#pragma unroll
                for (int r = 0; r < 16; ++r) { const int kv = 64 * t + 8 * hi + 16 * (r >> 3) + (r & 7); if (kv > q) p0[r] = -INFINITY; if (kv + 32 > q) p1[r] = -INFINITY; } }
            bf16x8 pb[4];
            softmax_tile<false>(p0, p1, m, lsum, O, pb);
#pragma unroll
            for (int dt = 0; dt < 2; ++dt)
#pragma unroll
                for (int s = 0; s < 4; ++s) { const bf16x8 a = *(const LAS bf16x8*)(Vb + (32 * dt + li) * AKS + 16 * (s & 1) + 32 * (s >> 1) + 8 * hi);
                    O[dt] = __builtin_amdgcn_mfma_f32_32x32x16_bf16(a, pb[s], O[dt], 0, 0, 0); }
        }
        { const float wm = wave_min(m); if (lane == 0) mmv[wave] = wm; }
        if (t > 0) { const int nb = buf ^ 1; *(LAS u32x4*)(kdst + nb * 64 * AKS * 2) = kr; *(LAS u32x4*)(vdst + nb * 64 * AKS * 2) = vr; if (tid < 64) ((LAS float*)(lds + ATT_FB))[nb * 64 + tid] = fr; }
        __syncthreads();
    }
    __syncthreads();
    const float inv = 1.f / xhalf_sum(lsum);
    bf16_t* ob = (bf16_t*)(p->ws + WS_OCAT) + (size_t)1 * NTOK * 512 + (size_t)q * 512 + h * 64;
    u32x2 sgv[2][4];
#pragma unroll
    for (int dt = 0; dt < 2; ++dt)
#pragma unroll
        for (int rg = 0; rg < 4; ++rg) sgv[dt][rg] = *(const u32x2*)(U + (size_t)q * NU + U_BSG + h * 64 + 32 * dt + 8 * rg + 4 * hi);
#pragma unroll
    for (int dt = 0; dt < 2; ++dt)
#pragma unroll
        for (int rg = 0; rg < 4; ++rg) { const int d = 32 * dt + 8 * rg + 4 * hi; const u32x2 sg = sgv[dt][rg];
            u32x2 w; w.x = cvt_pk_bf16(O[dt][rg * 4] * inv * siluf_(bflo(sg.x)), O[dt][rg * 4 + 1] * inv * siluf_(bfhi(sg.x))); w.y = cvt_pk_bf16(O[dt][rg * 4 + 2] * inv * siluf_(bflo(sg.y)), O[dt][rg * 4 + 3] * inv * siluf_(bfhi(sg.y)));
            *(u32x2*)(ob + d) = w; }
}
__device__ __forceinline__ void attn_sample_unit(KP p, int l, int b, int h, LAS unsigned char* lds, int tid) {
    const bf16_t* U = (const bf16_t*)(p->ws + WS_U);
    const int wave = tid >> 6, lane = tid & 63, li = lane & 31, hi = lane >> 5;
    const size_t qrow = (size_t)TP + b * 32 + li;
    const float* G = (const float*)(p->ws + WS_GS) + ((size_t)b * 8 + h) * GS_LEN;
    bf16x8 qf[4];
    { const float sc = 0.125f * LOG2E;
#pragma unroll
      for (int d0 = 0; d0 < 4; ++d0) { const u32x4 w = *(const u32x4*)(U + qrow * NU + U_Q + h * 64 + 16 * d0 + 8 * hi);
          qf[d0] = pack8f((f32x4){bflo(w.x) * sc, bfhi(w.x) * sc, bflo(w.y) * sc, bfhi(w.y) * sc}, (f32x4){bflo(w.z) * sc, bfhi(w.z) * sc, bflo(w.w) * sc, bfhi(w.w) * sc}); } }
    const float fq = G[PAST + li];
    float m = ATT_NEG, lsum = 0.f; f32x16 O[2] = {};
    const float* CK = p->in[I_CK] + (((size_t)l * 32 + b) * PAST) * 512 + h * 64; const float* CV = p->in[I_CV] + (((size_t)l * 32 + b) * PAST) * 512 + h * 64;
    const int ka = krow(li);
    float kmax2;
    { float mx = 0.f; const f32x4* kp4 = (const f32x4*)CK + (tid & 15);
#pragma unroll 1
      for (int it = 0; it < 8; ++it) { f32x4 kv[16];
#pragma unroll
          for (int j = 0; j < 16; ++j) kv[j] = kp4[(size_t)((it * 16 + j) * 32 + (tid >> 4)) * 128];
#pragma unroll
          for (int j = 0; j < 16; ++j) { float s = kv[j][0] * kv[j][0] + kv[j][1] * kv[j][1] + kv[j][2] * kv[j][2] + kv[j][3] * kv[j][3];
              s += dpp_mov<0xB1>(s); s += dpp_mov<0x4E>(s); s += dpp_mov<0x141>(s); s += dpp_mov<0x140>(s); mx = fmaxf(mx, s); } }
      mx = wave_max(mx); LAS float* kml = (LAS float*)lds;
      if (lane == 0) kml[wave] = mx;
      __syncthreads();
      kmax2 = kml[0];
#pragma unroll
      for (int w = 1; w < 8; ++w) kmax2 = fmaxf(kmax2, kml[w]);
      __syncthreads(); }
    float qkb;
    { float q2 = 0.f;
#pragma unroll
      for (int d0 = 0; d0 < 4; ++d0) { const u32x4 w = __builtin_bit_cast(u32x4, qf[d0]); q2 += bflo(w.x) * bflo(w.x) + bfhi(w.x) * bfhi(w.x) + bflo(w.y) * bflo(w.y) + bfhi(w.y) * bfhi(w.y) + bflo(w.z) * bflo(w.z) + bfhi(w.z) * bfhi(w.z) + bflo(w.w) * bflo(w.w) + bfhi(w.w) * bfhi(w.w); }
      q2 = wave_max(xhalf_sum(q2)); qkb = 1.02f * sqrtf(q2 * kmax2) + G[PAST]; }
    {
        f32x16 p0, p1 = {};
#pragma unroll
        for (int g2 = 0; g2 < 2; ++g2) { const float* gp = G + PAST + 8 * hi + 16 * g2; const f32x4 a = *(const f32x4*)gp, bq = *(const f32x4*)(gp + 4);
#pragma unroll
            for (int e = 0; e < 4; ++e) { p0[8 * g2 + e] = fq - a[e]; p0[8 * g2 + 4 + e] = fq - bq[e]; } }
#pragma unroll
        for (int d0 = 0; d0 < 4; ++d0) { const bf16x8 a0 = *(const bf16x8*)(U + ((size_t)TP + b * 32 + ka) * NU + U_K + h * 64 + 16 * d0 + 8 * hi);
            p0 = __builtin_amdgcn_mfma_f32_32x32x16_bf16(a0, qf[d0], p0, 0, 0, 0); }
#pragma unroll
        for (int r = 0; r < 16; ++r) { const int kv = 8 * hi + 16 * (r >> 3) + (r & 7); if (kv > li) p0[r] = -INFINITY; }
        bf16x8 pb[4];
        softmax_tile<true>(p0, p1, m, lsum, O, pb);
        if (wave == 7) {
#pragma unroll
            for (int dt = 0; dt < 2; ++dt)
#pragma unroll
                for (int s = 0; s < 2; ++s) { const bf16_t* vp = U + ((size_t)TP + b * 32 + 16 * s + 8 * hi) * NU + U_V + h * 64 + 32 * dt + li; u32x4 w;
                    w.x = (unsigned)vp[0] | ((unsigned)vp[NU] << 16); w.y = (unsigned)vp[2 * NU] | ((unsigned)vp[3 * NU] << 16); w.z = (unsigned)vp[4 * NU] | ((unsigned)vp[5 * NU] << 16); w.w = (unsigned)vp[6 * NU] | ((unsigned)vp[7 * NU] << 16);
                    O[dt] = __builtin_amdgcn_mfma_f32_32x32x16_bf16(__builtin_bit_cast(bf16x8, w), pb[s], O[dt], 0, 0, 0); } }
        else lsum = 0.f;
    }
    const float mmin = wave_min(m);
    for (int tt = 0; tt < 8; ++tt) {
        const int key0 = (63 - wave - 8 * tt) * 64;
        if (qkb - G[key0 + 63] < mmin - 40.f) break;
        f32x16 p0, p1;
#pragma unroll
        for (int g2 = 0; g2 < 2; ++g2) { const float* gp = G + key0 + 8 * hi + 16 * g2; const f32x4 a = *(const f32x4*)gp, bq = *(const f32x4*)(gp + 4), c = *(const f32x4*)(gp + 32), d = *(const f32x4*)(gp + 36);
#pragma unroll
            for (int e = 0; e < 4; ++e) { p0[8 * g2 + e] = fq - a[e]; p0[8 * g2 + 4 + e] = fq - bq[e]; p1[8 * g2 + e] = fq - c[e]; p1[8 * g2 + 4 + e] = fq - d[e]; } }
#pragma unroll
        for (int d0 = 0; d0 < 4; ++d0) { const float* k0p = CK + (size_t)(key0 + ka) * 512 + 16 * d0 + 8 * hi; const float* k1p = k0p + (size_t)32 * 512;
            const bf16x8 a0 = pack8f(*(const f32x4*)k0p, *(const f32x4*)(k0p + 4)), a1 = pack8f(*(const f32x4*)k1p, *(const f32x4*)(k1p + 4));
            p0 = __builtin_amdgcn_mfma_f32_32x32x16_bf16(a0, qf[d0], p0, 0, 0, 0); p1 = __builtin_amdgcn_mfma_f32_32x32x16_bf16(a1, qf[d0], p1, 0, 0, 0); }
        bf16x8 pb[4];
        softmax_tile<false>(p0, p1, m, lsum, O, pb);
#pragma unroll
        for (int dt = 0; dt < 2; ++dt)
#pragma unroll
            for (int s = 0; s < 4; ++s) { const float* vp = CV + (size_t)(key0 + 16 * (s & 1) + 32 * (s >> 1) + 8 * hi) * 512 + 32 * dt + li;
                const bf16x8 a = pack8f((f32x4){vp[0], vp[512], vp[1024], vp[1536]}, (f32x4){vp[2048], vp[2560], vp[3072], vp[3584]});
                O[dt] = __builtin_amdgcn_mfma_f32_32x32x16_bf16(a, pb[s], O[dt], 0, 0, 0); }
    }
    LAS float* Ow = (LAS float*)lds;
    LAS float* ML = Ow + 8 * 32 * 64;
    lsum = xhalf_sum(lsum);
#pragma unroll
    for (int dt = 0; dt < 2; ++dt)
#pragma unroll
        for (int r = 0; r < 16; ++r) Ow[(wave * 32 + dt * 16 + r) * 64 + lane] = O[dt][r];
    if (hi == 0) { ML[(wave * 2) * 32 + li] = m; ML[(wave * 2 + 1) * 32 + li] = lsum; }
    __syncthreads();
    { const int qq = tid & 31, dg = tid >> 5; float M = ATT_NEG;
#pragma unroll
      for (int w = 0; w < 8; ++w) M = fmaxf(M, ML[(w * 2) * 32 + qq]);
      float L = 0.f; f32x4 o = {0.f, 0.f, 0.f, 0.f};
      const int d = 4 * dg, idx0 = (d >> 5) * 16 + ((d >> 3) & 3) * 4, ln = ((d >> 2) & 1) * 32 + qq;
#pragma unroll
      for (int w = 0; w < 8; ++w) { const float f = __builtin_amdgcn_exp2f(ML[(w * 2) * 32 + qq] - M); L += ML[(w * 2 + 1) * 32 + qq] * f;
#pragma unroll
          for (int e = 0; e < 4; ++e) o[e] += Ow[(w * 32 + idx0 + e) * 64 + ln] * f; }
      const float inv = 1.f / L; const size_t row = (size_t)TP + b * 32 + qq;
      const u32x2 sg = *(const u32x2*)(U + row * NU + U_BSG + h * 64 + d);
      u32x2 wv; wv.x = cvt_pk_bf16(o[0] * inv * siluf_(bflo(sg.x)), o[1] * inv * siluf_(bfhi(sg.x))); wv.y = cvt_pk_bf16(o[2] * inv * siluf_(bflo(sg.y)), o[3] * inv * siluf_(bfhi(sg.y)));
      *(u32x2*)((bf16_t*)(p->ws + WS_OCAT) + (size_t)1 * NTOK * 512 + row * 512 + h * 64 + d) = wv; }
    __syncthreads();
}
__device__ __forceinline__ bool xb_lane0() { unsigned ones_ = ~0u; asm volatile("" : "+s"(ones_)); return __builtin_amdgcn_mbcnt_hi(ones_, __builtin_amdgcn_mbcnt_lo(ones_, 0u)) == 0u; }
constexpr int NPHASE = 20;
__global__ void __launch_bounds__(512, 2) hse_fwd(Params p_) {
    const KP kp = (KP)__builtin_amdgcn_kernarg_segment_ptr();
    (void)p_;
    extern __shared__ __attribute__((aligned(16))) unsigned char lds_raw[];
    LAS unsigned char* lds = (LAS unsigned char*)lds_raw;
    const int tid0 = threadIdx.x;
    const int wave0 = __builtin_amdgcn_readfirstlane(tid0 >> 6);
    const int G = gridDim.x, bid = blockIdx.x, ngw = G * 8;
#define PH_LOCALS const KP p = kp_fresh(kp); unsigned ones_ = ~0u; asm volatile("" : "+s"(ones_)); int tid = wave0 * 64 + (int)__builtin_amdgcn_mbcnt_hi(ones_, __builtin_amdgcn_mbcnt_lo(ones_, 0u)); asm volatile("" : "+v"(tid)); const int lane = tid & 63, wave = __builtin_amdgcn_readfirstlane(tid >> 6), gw = bid * 8 + wave; (void)lane; (void)gw; (void)p;
    if (tid0 < 4) ((LAS unsigned*)(lds + LDS_XB_OFF))[tid0] = 0u;
#if PROBE_ID
    if (tid0 == 0) *(LAS unsigned long long*)(lds + LDS_PROBE_OFF) = 0ull;
#endif
    __syncthreads();
    unsigned* ctl = (unsigned*)(kp->ws + WS_CTL);
    XcdBarrier bar = xcd_barrier_post(ctl + CW_BAR + kp->li * XCD_BAR_WORDS, (volatile LAS unsigned*)(lds + LDS_XB_OFF));
    const int lo = kp->ph_lo, hi = kp->ph_hi;
#define IN(k) (lo <= (k) && (k) < hi)
#ifndef DUP_MASK
#define DUP_MASK 0
#endif
#define NREP(k) (((DUP_MASK >> (k)) & 1) + 1)
#define XB_T0 (wave0 == 0 && xb_lane0())
#define SEAM(k) do { if (IN(k) && IN((k) + 1)) xcd_barrier(bar, XB_T0); } while (0)
    PT0();
    if (IN(0)) { PH_LOCALS
        for (int u = bid; u < 192; u += G) ada_unit(p, u, lds, tid);
        p0_weights(p, lds, gw, ngw, wave, lane);
    }
    SEAM(0);
    PT1(9);
    for (int l = 0; l < NLAYER; ++l) {
        const int pb = 1 + 9 * l;
        for (int rep = 0; rep < NREP(0); ++rep) { if (rep) xcd_barrier(bar, XB_T0);
        if (IN(pb)) { PH_LOCALS p1_rows(p, l, gw, ngw, lane); } }
        SEAM(pb);
        PT1(10);
        for (int rep = 0; rep < NREP(1); ++rep) { if (rep) xcd_barrier(bar, XB_T0);
        if (IN(pb + 1)) { PH_LOCALS
            pg8::Gemm g{(const bf16_t*)(p->ws + WS_H), (const bf16_t*)(p->ws + WS_WIN) + (size_t)l * NU * 2048, NTOK, NU, 2048, 2048};
            pg8::StaticOrder S; S.init(NTOK, NU, G, bid);
            EpiU E{(bf16_t*)(p->ws + WS_U), p->out, p->in[I_BF], l};
            pg8::gemm_phase<EpiU, pg8::StaticOrder>(lds, g, S, E, nullptr, tid);
        }
        }
        SEAM(pb + 1);
        PT1(11);
        for (int rep = 0; rep < NREP(2); ++rep) { if (rep) xcd_barrier(bar, XB_T0);
        if (IN(pb + 2)) { PH_LOCALS
#ifndef DUP_SUB
#define DUP_SUB 0
#endif
            { PT0();
            { PH_LOCALS for (int u = bid; u < NRU * ((DUP_SUB & 1) + 1); u += G) rwkv_r1(p, l, u % NRU, u + G, lds, tid); }
            PT1(31);
            for (int u = (bid + G - 32) % G; u < 544 * (((DUP_SUB >> 1) & 1) + 1); u += G) conv_unit(p, l, u % 544, lds, tid);
            PT1(32);
            for (int u = (bid + G - 64) % G; u < 544 * (((DUP_SUB >> 2) & 1) + 1); u += G) pool_unit(p, l, u % 544, lds, tid);
            PT1(33);
            for (int u = bid; u < 256; u += G) { vt_tile(p, l, u * 8 + wave, lds, wave, lane); }
            __syncthreads();
            for (int u = (bid + G - 96) % G; u < 32; u += G) gs_unit(p, l, u, lds, tid);
            for (int u = G - 1 - bid; u < 8; u += G) fp_unit(p, l, u, lds, tid);
            if (bid == G / 2) shift_out(p, l, tid);
            PT1(34); }
        }
        }
        SEAM(pb + 2);
        PT1(12);
        for (int rep = 0; rep < NREP(3); ++rep) { if (rep) xcd_barrier(bar, XB_T0);
        if (IN(pb + 3)) { PH_LOCALS
            for (int tk = bid; tk < 256; tk += G) rwkv_l1_block(p, tk, lds, wave, lane);
            LAS int* qslot = (LAS int*)(lds + LDS_XB_OFF - 16);
            for (;;) {
                if (tid == 0) *qslot = (int)atomicAdd(ctl + CW_QUEUE + 64 * (2 * l + 4 * rep), 1u);
                __syncthreads();
                const int item = *qslot;
                __syncthreads();
                if (item >= 512) break;
                attn_prompt_unit(p, l, item & 7, 63 - (item >> 3), lds, tid);
            }
            for (;;) {
                if (tid == 0) *qslot = (int)atomicAdd(ctl + CW_QUEUE + 64 * (2 * l + 1 + 4 * rep), 1u);
                __syncthreads();
                const int item = *qslot;
                __syncthreads();
                if (item >= 256) break;
                attn_sample_unit(p, l, item >> 3, item & 7, lds, tid);
            }
        }
        }
        SEAM(pb + 3);
        PT1(13);
        if (IN(pb + 4)) { PH_LOCALS
            for (int tk = bid; tk < 128; tk += G) rwkv_l3_block(p, l, 127 - tk, lds, wave, lane);
            for (int tk = ((bid + G - 128) % G) * 8 + wave; tk < 1024; tk += ngw) rwkv_samp_task(p, l, tk, lane);
        }
        SEAM(pb + 4);
        PT1(14);
        if (IN(pb + 5)) { PH_LOCALS for (int tk = gw; tk < NRU * 2; tk += ngw) rwkv_r3_task(p, l, tk, lane); }
        SEAM(pb + 5);
        PT1(15);
        for (int rep = 0; rep < NREP(6); ++rep) { if (rep) xcd_barrier(bar, XB_T0);
        if (IN(pb + 6)) { PH_LOCALS
            pg8::Gemm g{(const bf16_t*)(p->ws + WS_OCAT), (const bf16_t*)(p->ws + WS_WBR) + (size_t)l * 4 * 2048 * 512, 4 * NTOK, 4 * 2048, 512, 512};
            BranchOrder S{G, bid};
            EpiZ E{(bf16_t*)(p->ws + WS_Z), (const bf16_t*)(p->ws + WS_U)};
            pg8::gemm_phase<EpiZ, BranchOrder>(lds, g, S, E, nullptr, tid);
        }
        }
        SEAM(pb + 6);
        PT1(16);
        if (IN(pb + 7)) { PH_LOCALS merge_pass(p, l, bid * 512 + tid, G * 512); }
        SEAM(pb + 7);
        PT1(17);
        if (IN(pb + 8)) { PH_LOCALS
            {
                pg8::Gemm g{(const bf16_t*)(p->ws + WS_MERGED), (const bf16_t*)(p->ws + WS_WOUT) + (size_t)l * 2048 * 2048, TP, 2048, 2048, 2048};
                pg8::StaticOrder S; S.init(TP, 2048, G, bid);
                EpiOut E{p->in[I_XP], p->in[I_XS], (const float*)(p->ws + WS_XBUF), (const float*)(p->ws + WS_ADA), (float*)(p->ws + WS_XBUF), l};
                pg8::gemm_phase<EpiOut, pg8::StaticOrder>(lds, g, S, E, nullptr, tid); }
            {
                const int tile = bid >> 3, ks = bid & 7;
                pg8::Gemm g{(const bf16_t*)(p->ws + WS_MERGED) + ks * 256, (const bf16_t*)(p->ws + WS_WOUT) + (size_t)l * 2048 * 2048 + ks * 256, NTOK, 2048, 256, 2048};
                OneUnit S{64 + (tile >> 3), tile & 7, bid < 256};
                EpiOutPart E{(const float*)(p->ws + WS_ADA), (float*)(p->ws + WS_XPART) + ((size_t)(l * 8 + ks) * 1024) * DM, l};
                pg8::gemm_phase<EpiOutPart, OneUnit>(lds, g, S, E, nullptr, tid); }
        }
        SEAM(pb + 8);
        PT1(18);
    }
    if (IN(19)) { PH_LOCALS p_final_rows(p, gw, ngw, lane); }
    PT1(20);
#if PROBE_ID
    if (bid == 0 && tid0 == 0) { const unsigned long long w = *(LAS unsigned long long*)(lds + LDS_PROBE_OFF) * PROBE_K, t0 = __builtin_amdgcn_s_memrealtime(); while (__builtin_amdgcn_s_memrealtime() - t0 < w) __builtin_amdgcn_s_sleep(8); }
#endif
#undef IN
#undef SEAM
}
#ifndef MK_SPLIT
#define MK_SPLIT 0
#endif
extern "C" void kernel_launch(void* const* d_in, const int* in_sizes, int n_in, void* d_out, int out_size, void* d_ws, size_t ws_size, hipStream_t stream) {
    static int grid = 0;
    if (grid == 0) {
        if (n_in != N_IN || (size_t)out_size != O_END || ws_size < WS_END) { fprintf(stderr, "kernel_launch: unexpected shapes (n_in %d, out %d, ws %zu)\n", n_in, out_size, ws_size); grid = -1; return; }
        int dev = 0, cus = 0, per_cu = 0;
        if (hipGetDevice(&dev) != hipSuccess || hipDeviceGetAttribute(&cus, hipDeviceAttributeMultiprocessorCount, dev) != hipSuccess) { grid = -1; return; }
        if (hipFuncSetAttribute((const void*)hse_fwd, hipFuncAttributeMaxDynamicSharedMemorySize, LDS_BYTES) != hipSuccess) { fprintf(stderr, "kernel_launch: hipFuncSetAttribute failed\n"); grid = -1; return; }
        if (hipOccupancyMaxActiveBlocksPerMultiprocessor(&per_cu, (const void*)hse_fwd, 512, LDS_BYTES) != hipSuccess || per_cu < 1) fprintf(stderr, "kernel_launch: occupancy query reports %d\n", per_cu);
        (void)hipGetLastError();
        grid = cus;
    }
    if (grid < 0) return;
    if (hipMemsetAsync((char*)d_ws + WS_CTL, 0, CTL_BYTES, stream) != hipSuccess) return;
    Params a{};
    for (int i = 0; i < N_IN; ++i) a.in[i] = (const float*)d_in[i];
    a.out = (float*)d_out; a.ws = (unsigned char*)d_ws;
#if MK_SPLIT
    for (int ph = 0; ph < NPHASE; ++ph) { a.ph_lo = ph; a.ph_hi = ph + 1; a.li = ph; hipLaunchKernelGGL(hse_fwd, dim3(grid), dim3(512), LDS_BYTES, stream, a); }
#else
    a.ph_lo = 0; a.ph_hi = NPHASE; a.li = 0;
    hipLaunchKernelGGL(hse_fwd, dim3(grid), dim3(512), LDS_BYTES, stream, a);
#endif
    const hipError_t le = hipPeekAtLastError();
    if (le != hipSuccess) fprintf(stderr, "kernel_launch: launch failed: %s\n", hipGetErrorName(le));
}
```

```cpp
#include <hip/hip_runtime.h>
#include <cstdio>
#include <cstdint>
namespace pg8 {
#define PG8_LAS __attribute__((address_space(3)))
typedef unsigned short bf16_t;
typedef short bf16x8 __attribute__((ext_vector_type(8)));
typedef float f32x4 __attribute__((ext_vector_type(4)));
typedef unsigned u32x4 __attribute__((ext_vector_type(4)));
constexpr int BM = 256, BK = 64, HALF = 128, HTB = HALF * BK * 2  , STAGE_BYTES = 8 * HTB, NXCD = 8, WGM = 4;

__host__ __device__ __forceinline__ int lds_byte(int r, int c) { const int st = (r >> 4) * 2 + (c >> 5), rr = r & 15, cc = c & 31, ob = rr * 64 + cc * 2; return st * 1024 + (ob ^ (((ob >> 9) & 1) << 5)); }
__host__ __device__ __forceinline__ void stage_rc(int b, int& R, int& C) { const int st = b / 1024, sb = b % 1024, swz = sb ^ (((sb >> 9) & 1) << 5); R = (st >> 1) * 16 + swz / 64; C = (st & 1) * 32 + (swz % 64) / 2; }
__host__ __device__ __forceinline__ int perm32(int rho) { const int n = rho >> 4, i = rho & 15; return 8 * (i >> 2) + 4 * n + (i & 3); }

struct Unit { int pm, pn; };
struct Gemm { const bf16_t* A; const bf16_t* Bt; int M, N, K, ld; };

struct StaticOrder {
    int nM, nN, nwg, G, c;
    __host__ __device__ void init(int M, int N, int G_, int c_) { nM = M / BM; nN = N / BM; nwg = nM * nN; G = G_; c = c_; }
    __host__ __device__ bool next(int i, Unit& u) const {
        const long L = (long)i * G + c; if (L >= nwg) return false;
        int wgid = (int)L; { const int q = nwg / NXCD, r = nwg % NXCD, xcd = wgid % NXCD, off = wgid / NXCD; wgid = (xcd < r ? xcd * (q + 1) : r * (q + 1) + (xcd - r) * q) + off; }
        const int nig = WGM * nN, gid = wgid / nig, fm = gid * WGM, gsz = (nM - fm) < WGM ? (nM - fm) : WGM;
        u.pm = fm + ((wgid % nig) % gsz); u.pn = (wgid % nig) / gsz; return true;
    }
    __device__ __forceinline__ void a_ready(const Unit&) const {}
    __device__ __forceinline__ void done(const Unit&) const {}
};
__device__ __forceinline__ unsigned cvt_pk_bf16(float lo, float hi) { unsigned r; asm volatile("v_cvt_pk_bf16_f32 %0, %1, %2" : "=v"(r) : "v"(lo), "v"(hi)); return r; }
typedef float f32x2 __attribute__((ext_vector_type(2)));
template <class Epi, class Sched, bool STAMP = false>
__device__ __forceinline__ void gemm_phase(PG8_LAS unsigned char* lds, const Gemm g, const Sched& S, const Epi& E, unsigned long long* stamps, int tid_in) {
    int tid = tid_in; asm volatile("" : "+v"(tid));
    const int wid = __builtin_amdgcn_readfirstlane(tid >> 6), lane = tid & 63, wr = wid >> 2, wc = wid & 3, fr = lane & 15, fq = lane >> 4;
    const int K = g.ld, nt = g.K / BK;
    int ts_lo = 0, ts_hi = 0, nts = 0; const unsigned long long rt_entry = STAMP ? (unsigned long long)wall_clock64() : 0ull;
#define PG8_STAMP() do { if (STAMP && wid == 0 && nts < 64) { const unsigned long long _c = (unsigned long long)clock64(); \
        ts_lo = (lane == nts) ? (int)(unsigned)_c : ts_lo; ts_hi = (lane == nts) ? (int)(unsigned)(_c >> 32) : ts_hi; ++nts; } } while (0)
    PG8_STAMP();
    unsigned voffA[2], voffB[2];
#pragma unroll
    for (int i = 0; i < 2; ++i) { int R, C; stage_rc(tid * 16 + i * 8192, R, C); const int Rb = Epi::PERM ? ((R & ~31) + perm32(R & 31)) : R;
        voffA[i] = (unsigned)(R * K + C) * 2u; voffB[i] = (unsigned)(Rb * K + C) * 2u; }
    const size_t kstep = (size_t)(BK * 2);
    const size_t hstep = (size_t)HALF * K * 2;
    const size_t tstep = 2 * hstep;
    const unsigned ldsw = (unsigned)wid * 1024u;
    const int aoff = lds_byte(wr * 64 + fr, fq * 8), boff = lds_byte(wc * 32 + fr, fq * 8);
#define PG8_SA(b, h) (((b) * 2 + (h)) * HTB)
#define PG8_SB(b, h) ((4 + (b) * 2 + (h)) * HTB)
#define PG8_STAGE(bufoff, gbase, voff) do { _Pragma("unroll") for (int _i = 0; _i < 2; ++_i) \
        __builtin_amdgcn_global_load_lds((const unsigned*)((const char*)(gbase) + (voff)[_i]), (PG8_LAS unsigned*)(lds + (bufoff) + ldsw + _i * 8192), 16, 0, 0); } while (0)
#define PG8_LDA(dst, b, h) do { _Pragma("unroll") for (int m = 0; m < 4; ++m) _Pragma("unroll") for (int k = 0; k < 2; ++k) dst[m][k] = *(const PG8_LAS bf16x8*)(lds + PG8_SA(b, h) + aoff + m * 2048 + k * 1024); } while (0)
#define PG8_LDB(dst, b, h) do { _Pragma("unroll") for (int n = 0; n < 2; ++n) _Pragma("unroll") for (int k = 0; k < 2; ++k) dst[n][k] = *(const PG8_LAS bf16x8*)(lds + PG8_SB(b, h) + boff + n * 2048 + k * 1024); } while (0)
#define PG8_MMA(ai, bj, At, Bt) do { __builtin_amdgcn_s_setprio(1); _Pragma("unroll") for (int m = 0; m < 4; ++m) _Pragma("unroll") for (int n = 0; n < 2; ++n) _Pragma("unroll") for (int k = 0; k < 2; ++k) \
        acc[ai][bj][m][n] = __builtin_amdgcn_mfma_f32_16x16x32_bf16(Bt[n][k], At[m][k], acc[ai][bj][m][n], 0, 0, 0); __builtin_amdgcn_s_setprio(0); } while (0)
#define PG8_WAIT_V(n) asm volatile("s_waitcnt vmcnt(" #n ")" ::: "memory")
#define PG8_WAIT_L(n) asm volatile("s_waitcnt lgkmcnt(" #n ")" ::: "memory")
#define PG8_BAR __builtin_amdgcn_s_barrier()
#define PG8_SCHED __builtin_amdgcn_sched_barrier(0)
    Unit cur, nxt; int ui = 0;
    if (!S.next(0, cur)) return;
    f32x4 acc[2][2][4][2];
#pragma unroll
    for (int a = 0; a < 2; ++a)
#pragma unroll
        for (int b = 0; b < 2; ++b)
#pragma unroll
            for (int m = 0; m < 4; ++m)
#pragma unroll
                for (int n = 0; n < 2; ++n) acc[a][b][m][n] = (f32x4){0.f, 0.f, 0.f, 0.f};
    bf16x8 At[4][2], B0[2][2], B1[2][2];
    const char* cA = (const char*)g.A + (size_t)cur.pm * tstep; const char* cB = (const char*)g.Bt + (size_t)cur.pn * tstep;
    S.a_ready(cur);
    PG8_STAGE(PG8_SB(0, 0), cB, voffB); PG8_STAGE(PG8_SA(0, 0), cA, voffA); PG8_STAGE(PG8_SB(0, 1), cB + hstep, voffB); PG8_STAGE(PG8_SA(0, 1), cA + hstep, voffA);
    if (wr == 1) PG8_BAR;
    PG8_WAIT_V(4); PG8_BAR;
    PG8_STAGE(PG8_SB(1, 0), cB + kstep, voffB); PG8_STAGE(PG8_SA(1, 0), cA + kstep, voffA); PG8_STAGE(PG8_SB(1, 1), cB + hstep + kstep, voffB);
    PG8_WAIT_V(6); PG8_BAR;
    PG8_STAMP();
    for (;;) {
        const bool has_next = S.next(ui + 1, nxt);
        const char* nA = has_next ? (const char*)g.A + (size_t)nxt.pm * tstep : cA; const char* nB = has_next ? (const char*)g.Bt + (size_t)nxt.pn * tstep : cB;
        for (int t = 0; t < nt; t += 2) {
            const bool last = (t == nt - 2);
            const char* a1 = cA + (size_t)(t + 1) * kstep;
            const char* a2 = last ? nA : cA + (size_t)(t + 2) * kstep; const char* b2 = last ? nB : cB + (size_t)(t + 2) * kstep;
            const char* a3 = a2 + kstep; const char* b3 = b2 + kstep;
            if (last && has_next) S.a_ready(nxt);
            PG8_LDB(B0, 0, 0); PG8_SCHED; PG8_LDA(At, 0, 0); PG8_STAGE(PG8_SA(1, 1), a1 + hstep, voffA);
            PG8_WAIT_L(8); PG8_BAR; PG8_WAIT_L(0); PG8_MMA(0, 0, At, B0); PG8_BAR; PG8_SCHED;
            PG8_LDB(B1, 0, 1); PG8_STAGE(PG8_SB(0, 0), b2, voffB);
            PG8_BAR; PG8_WAIT_L(0); PG8_MMA(0, 1, At, B1); PG8_BAR;
            PG8_LDA(At, 0, 1); PG8_STAGE(PG8_SA(0, 0), a2, voffA);
            PG8_BAR; PG8_WAIT_L(0); PG8_MMA(1, 0, At, B0); PG8_BAR; PG8_SCHED;
            PG8_STAGE(PG8_SB(0, 1), b2 + hstep, voffB);
            PG8_WAIT_V(6); PG8_BAR; PG8_MMA(1, 1, At, B1); PG8_BAR;
            PG8_LDB(B0, 1, 0); PG8_SCHED; PG8_LDA(At, 1, 0); PG8_STAGE(PG8_SA(0, 1), a2 + hstep, voffA);
            PG8_WAIT_L(8); PG8_BAR; PG8_WAIT_L(0); PG8_MMA(0, 0, At, B0); PG8_BAR; PG8_SCHED;
            PG8_LDB(B1, 1, 1); PG8_STAGE(PG8_SB(1, 0), b3, voffB);
            PG8_BAR; PG8_WAIT_L(0); PG8_MMA(0, 1, At, B1); PG8_BAR;
            PG8_LDA(At, 1, 1); PG8_STAGE(PG8_SA(1, 0), a3, voffA);
            PG8_BAR; PG8_WAIT_L(0); PG8_MMA(1, 0, At, B0); PG8_BAR; PG8_SCHED;
            PG8_STAGE(PG8_SB(1, 1), b3 + hstep, voffB);
            PG8_WAIT_V(6); PG8_BAR; PG8_MMA(1, 1, At, B1); PG8_BAR;
        }
        PG8_STAMP();
        if constexpr (!Epi::AFTER_DRAIN) { E(acc, cur, wr, wc, fr, fq); S.done(cur); }
        PG8_STAMP();
        if (!has_next) break;
#pragma unroll
        for (int a = 0; a < 2; ++a)
#pragma unroll
            for (int b = 0; b < 2; ++b)
#pragma unroll
                for (int m = 0; m < 4; ++m)
#pragma unroll
                    for (int n = 0; n < 2; ++n) acc[a][b][m][n] = (f32x4){0.f, 0.f, 0.f, 0.f};
        cur = nxt; cA = nA; cB = nB; ++ui;
    }
    PG8_WAIT_V(0);
    if (wr == 0) PG8_BAR;
    PG8_BAR;
    if constexpr (Epi::AFTER_DRAIN) { E.fused(acc, cur, wr, wc, fr, fq, lds, wid, lane); S.done(cur); }
    PG8_STAMP();
    if (STAMP && wid == 0) { stamps[lane] = lane < nts ? (((unsigned long long)(unsigned)ts_hi << 32) | (unsigned)ts_lo) : 0ull;
        if (lane == 62) stamps[62] = rt_entry; if (lane == 63) stamps[63] = (unsigned long long)wall_clock64(); }
#undef PG8_STAMP
#undef PG8_SA
#undef PG8_SB
#undef PG8_STAGE
#undef PG8_LDA
#undef PG8_LDB
#undef PG8_MMA
#undef PG8_WAIT_V
#undef PG8_WAIT_L
#undef PG8_BAR
#undef PG8_SCHED
}
}
#define XB_TMO      128
#define XB_XCNT(j)  (256  + 64 * (j))
#define XB_XSUB(j)  (1280 + 64 * (j))
#define XB_XGEN(j)  (2304 + 64 * (j))
#define XB_TOP      3328
#define XB_TOPGEN   3392
#define XCD_BAR_WORDS 3456
#define XB_SPIN_CAP (1u << 18)
#define LAS __attribute__((address_space(3)))

__device__ __forceinline__ unsigned xb_ld(unsigned* p)              { return __hip_atomic_load(p, __ATOMIC_RELAXED, __HIP_MEMORY_SCOPE_AGENT); }
__device__ __forceinline__ unsigned xb_add(unsigned* p, unsigned v) { return __hip_atomic_fetch_add(p, v, __ATOMIC_RELAXED, __HIP_MEMORY_SCOPE_AGENT); }
__device__ __forceinline__ unsigned xb_xcc_id() { return (unsigned)__builtin_amdgcn_s_getreg((3 << 11) | 20) & 0xFu; }
#define XB_SPIN(cond, bar) do { unsigned _sp = 0; while (cond) { __builtin_amdgcn_s_sleep(1); \
    if ((++_sp & 255u) == 0u) { if (xb_ld(&(bar)[XB_TMO])) break; if (_sp > XB_SPIN_CAP) { atomicAdd(&(bar)[XB_TMO], 1u); break; } } } } while (0)

struct XcdBarrier {
    unsigned* bar; unsigned x;
    volatile LAS unsigned* st;
};

__device__ __forceinline__ XcdBarrier xcd_barrier_post(unsigned* bar, volatile LAS unsigned* st) {
    XcdBarrier b; b.bar = bar; b.x = xb_xcc_id(); b.st = st;
    if (threadIdx.x == 0) (void)xb_add(&bar[XB_XCNT(b.x)], 1u);
    return b;
}
__device__ __forceinline__ void xcd_barrier_complete(unsigned* bar, unsigned x, unsigned& nloc, unsigned& nx) {
    const unsigned G = gridDim.x * gridDim.y * gridDim.z;
    unsigned sum, cnt, mine, sp = 0u;
    for (;;) {
        sum = 0u; cnt = 0u; mine = 0u;
#pragma unroll
        for (unsigned j = 0; j < 16; ++j) { const unsigned c = xb_ld(&bar[XB_XCNT(j)]); sum += c; cnt += (c > 0u) ? 1u : 0u; mine = (j == x) ? c : mine; }
        if (sum == G) break;
        __builtin_amdgcn_s_sleep(1);
        if ((++sp & 255u) == 0u) { if (xb_ld(&bar[XB_TMO])) break; if (sp > XB_SPIN_CAP) { atomicAdd(&bar[XB_TMO], 1u); break; } }
    }
    nloc = mine > 0u ? mine : 1u; nx = cnt > 0u ? cnt : 1u;
}

__device__ __forceinline__ void xcd_barrier(const XcdBarrier& b, const bool is_t0) {
    asm volatile("s_waitcnt vmcnt(0)" ::: "memory");
    __syncthreads();
    if (is_t0) {
        unsigned* bar = b.bar;
        __builtin_amdgcn_s_waitcnt(0);
        unsigned nloc = b.st[0], nx = b.st[1];
        if (nloc == 0u) { xcd_barrier_complete(bar, b.x, nloc, nx); b.st[0] = nloc; b.st[1] = nx; }
        const unsigned old = xb_add(&bar[XB_XSUB(b.x)], 1u);
        const unsigned gen = old / nloc;
        if (old + 1u == (gen + 1u) * nloc) {
            __builtin_amdgcn_fence(__ATOMIC_RELEASE, "agent");
            asm volatile("s_waitcnt vmcnt(0)" ::: "memory");
            const unsigned og = xb_add(&bar[XB_TOP], 1u);
            const unsigned tg = og / nx;
            if (og + 1u == (tg + 1u) * nx) xb_add(&bar[XB_TOPGEN], 1u);
            else XB_SPIN(xb_ld(&bar[XB_TOPGEN]) == tg, bar);
            __builtin_amdgcn_fence(__ATOMIC_ACQUIRE, "agent");
            xb_add(&bar[XB_XGEN(b.x)], 1u);
            asm volatile("s_waitcnt vmcnt(0)" ::: "memory");
        } else {
            XB_SPIN(xb_ld(&bar[XB_XGEN(b.x)]) == gen, bar);
            __builtin_amdgcn_fence(__ATOMIC_ACQUIRE, "agent");
            asm volatile("s_waitcnt vmcnt(0)" ::: "memory");
        }
    }
    __syncthreads();
}
typedef unsigned short bf16_t;
typedef short bf16x8 __attribute__((ext_vector_type(8)));
typedef float f32x4 __attribute__((ext_vector_type(4)));
typedef float f32x16 __attribute__((ext_vector_type(16)));
typedef unsigned u32x4 __attribute__((ext_vector_type(4)));
typedef unsigned u32x2 __attribute__((ext_vector_type(2)));
using pg8::cvt_pk_bf16;

constexpr int DM = 2048, TP = 16384, NSB = 32, TSQ = 32, NTOK = TP + NSB * TSQ, NSEQ = 33, PAST = 4096, NLAYER = 2;
constexpr int NU = 15104;
constexpr int U_AVAL = 0, U_AGATE = 512, U_ASG = 1024, U_Q = 1536, U_K = 2048, U_V = 2560, U_BSG = 3072, U_XC = 3584, U_CSG = 5248, U_DIN = 5760, U_DSG = 6272, U_G = 6784, U_F = 14976;
constexpr int IN_W = 14984, SHIFT_W = 1664;
constexpr float LOG2E = 1.4426950408889634f;
enum { I_XP = 0, I_XS, I_CK, I_CV, I_CLF, I_SCONV, I_SSHIFT, I_SWKV, I_SPOOL, I_CP, I_CS, I_NORMG, I_WADA, I_BADA, I_WIN, I_BF, I_CONVW, I_CONVB, I_CLNG, I_CLNB, I_MU, I_W0, I_W2, I_A0, I_A2,
       I_KK, I_KA, I_RK, I_GNG, I_GNB, I_POOLW, I_POOLB, I_POOLS, I_WBR, I_WOUT, I_FING, N_IN };
constexpr size_t O_YP = 0, O_YS = O_YP + (size_t)TP * DM, O_PK = O_YS + (size_t)1024 * DM, O_PV = O_PK + (size_t)2 * TP * 512, O_PLF = O_PV + (size_t)2 * TP * 512, O_PCONV = O_PLF + (size_t)2 * TP * 8,
                 O_PSHIFT = O_PCONV + 2 * 30 * 512, O_PWKV = O_PSHIFT + 2 * 1664, O_PPOOL = O_PWKV + 2 * 8 * 64 * 64, O_SK = O_PPOOL + 2 * 15 * 512, O_SV = O_SK + (size_t)2 * 1024 * 512,
                 O_SLF = O_SV + (size_t)2 * 1024 * 512, O_SCONV = O_SLF + 2 * 1024 * 8, O_SSHIFT = O_SCONV + (size_t)2 * 32 * 30 * 512, O_SWKV = O_SSHIFT + 2 * 32 * 1664,
                 O_SPOOL = O_SWKV + (size_t)2 * 32 * 8 * 64 * 64, O_END = O_SPOOL + (size_t)2 * 32 * 15 * 512;
static_assert(O_END == 75374848, "output size");
constexpr size_t al256(size_t x) { return (x + 255) & ~(size_t)255; }
constexpr int NCU_CH = 288, NRU = NCU_CH * 8;
constexpr size_t WS_CTL = 0, CTL_BYTES = 512 * 1024;
constexpr size_t WS_WIN = CTL_BYTES;
constexpr size_t WS_WBR = al256(WS_WIN + (size_t)2 * NU * 2048 * 2);
constexpr size_t WS_WOUT = al256(WS_WBR + (size_t)2 * 4 * 2048 * 512 * 2);
constexpr size_t WS_POOLW = al256(WS_WOUT + (size_t)2 * 2048 * 2048 * 2);
constexpr size_t WS_ADA = al256(WS_POOLW + (size_t)2 * 4 * 128 * 128 * 2);
constexpr size_t WS_H = al256(WS_ADA + (size_t)2 * 33 * 6144 * 4);
constexpr size_t WS_U = al256(WS_H + (size_t)NTOK * 2048 * 2);
constexpr size_t WS_XBUF = al256(WS_U + (size_t)NTOK * NU * 2);
constexpr size_t WS_OCAT = al256(WS_XBUF + (size_t)NTOK * 2048 * 4);
constexpr size_t WS_Z = al256(WS_OCAT + (size_t)4 * NTOK * 512 * 2);
constexpr size_t WS_MERGED = al256(WS_Z + (size_t)4 * NTOK * 2048 * 2);
constexpr size_t WS_FP = al256(WS_MERGED + (size_t)NTOK * 2048 * 2);
constexpr int GS_LEN = PAST + TSQ;
constexpr size_t WS_GS = al256(WS_FP + (size_t)8 * TP * 4);
constexpr size_t WS_VT = al256(WS_GS + (size_t)32 * 8 * GS_LEN * 4);
constexpr size_t WS_TQ = al256(WS_VT + (size_t)8 * 64 * TP * 2);
constexpr size_t WS_GM = al256(WS_TQ + (size_t)NRU * 4096 * 4);
constexpr size_t WS_ET = al256(WS_GM + (size_t)NRU * 4096 * 4);
constexpr size_t WS_Y0T = al256(WS_ET + (size_t)NRU * 4096 * 4);
constexpr size_t WS_SC = al256(WS_Y0T + (size_t)NRU * 4096 * 4);
constexpr size_t WS_BONUS = al256(WS_SC + (size_t)NRU * 4096 * 4);
constexpr size_t WS_GG = al256(WS_BONUS + (size_t)NRU * 64 * 4);
constexpr size_t WS_TG = al256(WS_GG + (size_t)16 * 8 * 4096 * 4);
constexpr size_t WS_SG = al256(WS_TG + (size_t)16 * 8 * 4096 * 4);
constexpr size_t WS_XPART = al256(WS_SG + (size_t)16 * 8 * 4096 * 4);
constexpr size_t WS_END = al256(WS_XPART + (size_t)2 * 8 * 1024 * 2048 * 4);
static_assert(WS_END < (size_t)2100 * 1024 * 1024, "workspace map exceeds the guaranteed d_ws size");
constexpr int CW_BAR = 0;
constexpr int CW_QUEUE = 16 * 3456 + 64;
constexpr int CW_KMAX = CW_QUEUE + 64 * 8;
static_assert((CW_KMAX + 64) * 4 <= (int)CTL_BYTES, "ctl");
constexpr int LDS_BYTES = 163840 - 256;
constexpr int LDS_XB_OFF = LDS_BYTES - 16;
constexpr int SLOT_F = 64 * 65;

#ifndef PROBE_ID
#define PROBE_ID 0
#endif
#ifndef PROBE_K
#define PROBE_K 1
#endif
constexpr int LDS_PROBE_OFF = 163840 - 256 - 64;
#if PROBE_ID
#define PT0() unsigned long long _pt0 = (blockIdx.x == 0 && threadIdx.x == 0) ? __builtin_amdgcn_s_memrealtime() : 0ull
#define PT1(id) do { if ((id) == PROBE_ID && blockIdx.x == 0 && threadIdx.x == 0) { *(LAS unsigned long long*)(lds + LDS_PROBE_OFF) += __builtin_amdgcn_s_memrealtime() - _pt0; } _pt0 = (blockIdx.x == 0 && threadIdx.x == 0) ? __builtin_amdgcn_s_memrealtime() : 0ull; } while (0)
#else
#define PT0() do {} while (0)
#define PT1(id) do {} while (0)
#endif
struct Params { const float* in[N_IN]; float* out; unsigned char* ws; int ph_lo, ph_hi, li, pad; };
typedef const __attribute__((address_space(4))) Params* KP;
__device__ __forceinline__ KP kp_fresh(KP k) { asm volatile("" : "+s"(k)); return k; }

__device__ __forceinline__ float bf2f(unsigned short b) { return __uint_as_float(((unsigned)b) << 16); }
__device__ __forceinline__ float bflo(unsigned w) { return __uint_as_float(w << 16); }
__device__ __forceinline__ float bfhi(unsigned w) { return __uint_as_float(w & 0xffff0000u); }
__device__ __forceinline__ unsigned short f2bf(float f) { return (unsigned short)(cvt_pk_bf16(f, 0.f) & 0xffffu); }
__device__ __forceinline__ float sigmoidf_(float x) { return 1.f / (1.f + __expf(-x)); }
__device__ __forceinline__ float siluf_(float x) { return x / (1.f + __expf(-x)); }
__device__ __forceinline__ float log_sigmoidf_(float z) { return fminf(z, 0.f) - log1pf(expf(-fabsf(z))); }
template <int CTRL> __device__ __forceinline__ float dpp_mov(float v) { return __int_as_float(__builtin_amdgcn_update_dpp(0, __float_as_int(v), CTRL, 0xF, 0xF, true)); }
__device__ __forceinline__ float wave_sum(float v) {
    v += dpp_mov<0xB1>(v); v += dpp_mov<0x4E>(v); v += dpp_mov<0x141>(v); v += dpp_mov<0x140>(v);
    const float r0 = __int_as_float(__builtin_amdgcn_readlane(__float_as_int(v), 0)), r1 = __int_as_float(__builtin_amdgcn_readlane(__float_as_int(v), 16));
    const float r2 = __int_as_float(__builtin_amdgcn_readlane(__float_as_int(v), 32)), r3 = __int_as_float(__builtin_amdgcn_readlane(__float_as_int(v), 48));
    return (r0 + r1) + (r2 + r3);
}
__device__ __forceinline__ float wave_max(float v) {
    v = fmaxf(v, dpp_mov<0xB1>(v)); v = fmaxf(v, dpp_mov<0x4E>(v)); v = fmaxf(v, dpp_mov<0x141>(v)); v = fmaxf(v, dpp_mov<0x140>(v));
    const float r0 = __int_as_float(__builtin_amdgcn_readlane(__float_as_int(v), 0)), r1 = __int_as_float(__builtin_amdgcn_readlane(__float_as_int(v), 16));
    const float r2 = __int_as_float(__builtin_amdgcn_readlane(__float_as_int(v), 32)), r3 = __int_as_float(__builtin_amdgcn_readlane(__float_as_int(v), 48));
    return fmaxf(fmaxf(r0, r1), fmaxf(r2, r3));
}
__device__ __forceinline__ float wave_min(float v) { return -wave_max(-v); }
__device__ __forceinline__ float xhalf_max(float m) { const auto rr = __builtin_amdgcn_permlane32_swap(__float_as_uint(m), __float_as_uint(m), false, false); return fmaxf(__uint_as_float(rr[0]), __uint_as_float(rr[1])); }
__device__ __forceinline__ float xhalf_sum(float m) { const auto rr = __builtin_amdgcn_permlane32_swap(__float_as_uint(m), __float_as_uint(m), false, false); return __uint_as_float(rr[0]) + __uint_as_float(rr[1]); }
__device__ __forceinline__ bf16x8 pack8f(const f32x4 a, const f32x4 b) { u32x4 w; w.x = cvt_pk_bf16(a[0], a[1]); w.y = cvt_pk_bf16(a[2], a[3]); w.z = cvt_pk_bf16(b[0], b[1]); w.w = cvt_pk_bf16(b[2], b[3]); return __builtin_bit_cast(bf16x8, w); }
__device__ __forceinline__ float fast_tanh(float x) { const float e = __expf(-2.f * fabsf(x)); const float t = (1.f - e) * __builtin_amdgcn_rcpf(1.f + e); return x < 0.f ? -t : t; }
__device__ __forceinline__ void tr_tile(const float* __restrict__ src, size_t ld, int k0, int c0, int nvalid, bf16_t* __restrict__ dst, int K, LAS float* scr, int lane) {
    float tv[64];
#pragma unroll
    for (int kk = 0; kk < 64; ++kk) tv[kk] = src[(size_t)(k0 + kk) * ld + c0 + (lane < nvalid ? lane : 0)];
#pragma unroll
    for (int kk = 0; kk < 64; ++kk) scr[kk * 65 + lane] = (lane < nvalid) ? tv[kk] : 0.f;
    const int nl = lane >> 3, kc8 = (lane & 7) * 8;
#pragma unroll
    for (int it = 0; it < 8; ++it) { const int nn = 8 * it + nl; const LAS float* s = scr + kc8 * 65 + nn;
        u32x4 w; w.x = cvt_pk_bf16(s[0], s[65]); w.y = cvt_pk_bf16(s[130], s[195]); w.z = cvt_pk_bf16(s[260], s[325]); w.w = cvt_pk_bf16(s[390], s[455]);
        *(u32x4*)(dst + (size_t)nn * K + k0 + kc8) = w; }
}
__device__ __forceinline__ void p0_weights(KP p, LAS unsigned char* lds, int gw, int ngw, int wave, int lane) {
    LAS float* scr = (LAS float*)lds + wave * SLOT_F;
    constexpr int T_WIN = (NU / 64) * 32, T_WBR = 4 * 32 * 8, T_WOUT = 32 * 32, T_POOL = 4 * 2 * 2, T_L = T_WIN + T_WBR + T_WOUT + T_POOL;
    for (int it = gw; it < 2 * T_L; it += ngw) {
        const int l = it / T_L; int r = it % T_L;
        if (r < T_WIN) {
            const int nt = r / 32, kt = r % 32, m0 = nt * 64;
            int c0, nvalid = 64;
            if (m0 < 3072) c0 = m0; else if (m0 < U_F) c0 = m0 + 8; else if (m0 == U_F) { c0 = 3072; nvalid = 8; } else { c0 = 0; nvalid = 0; }
            tr_tile(p->in[I_WIN] + (size_t)l * 2048 * IN_W, IN_W, kt * 64, c0, nvalid, (bf16_t*)(p->ws + WS_WIN) + ((size_t)l * NU + m0) * 2048, 2048, scr, lane);
            continue; }
        r -= T_WIN;
        if (r < T_WBR) {
            const int n = r / 256, q = r % 256, nt = q / 8, kt = q % 8;
            tr_tile(p->in[I_WBR] + ((size_t)(l * 4 + n) * 512) * 2048, 2048, kt * 64, nt * 64, 64, (bf16_t*)(p->ws + WS_WBR) + ((size_t)(l * 4 + n) * 2048 + nt * 64) * 512, 512, scr, lane);
            continue; }
        r -= T_WBR;
        if (r < T_WOUT) {
            const int nt = r / 32, kt = r % 32;
            tr_tile(p->in[I_WOUT] + (size_t)l * 2048 * 2048, 2048, kt * 64, nt * 64, 64, (bf16_t*)(p->ws + WS_WOUT) + ((size_t)l * 2048 + nt * 64) * 2048, 2048, scr, lane);
            continue; }
        r -= T_WOUT;
        {
            const int g = r / 4, q = r % 4, nt = q / 2, kt = q % 2;
            tr_tile(p->in[I_POOLW] + (size_t)(l * 4 + g) * 128 * 128, 128, kt * 64, nt * 64, 64, (bf16_t*)(p->ws + WS_POOLW) + ((size_t)(l * 4 + g) * 128 + nt * 64) * 128, 128, scr, lane);
        }
    }
}
__device__ __forceinline__ void ada_unit(KP p, int unit, LAS unsigned char* lds, int tid) {
    const int wave = tid >> 6, lane = tid & 63, l = unit / 96, n0 = (unit % 96) * 64;
    LAS float* cs = (LAS float*)lds + wave * (33 * 64);
    LAS float* red = (LAS float*)lds + 8 * 33 * 64;
    const float* W = p->in[I_WADA] + (size_t)l * 2048 * 6144;
    const float* cp = p->in[I_CP]; const float* csm = p->in[I_CS];
    float acc[33];
#pragma unroll
    for (int s = 0; s < 33; ++s) acc[s] = 0.f;
    float wv[16];
#pragma unroll
    for (int j = 0; j < 16; ++j) wv[j] = W[(size_t)(wave * 256 + j) * 6144 + n0 + lane];
#pragma unroll 1
    for (int step = 0; step < 16; ++step) {
        const int k0 = wave * 256 + step * 16, kn = wave * 256 + (step < 15 ? step + 1 : step) * 16;
        float wn[16];
#pragma unroll
        for (int j = 0; j < 16; ++j) wn[j] = W[(size_t)(kn + j) * 6144 + n0 + lane];
        if ((step & 3) == 0) {
#pragma unroll
            for (int s = 0; s < 33; ++s) { const float c = (s == 0) ? cp[k0 + lane] : csm[(size_t)(s - 1) * 2048 + k0 + lane]; cs[s * 64 + lane] = siluf_(c); } }
        const int kk0 = (step & 3) * 16;
#pragma unroll
        for (int q4 = 0; q4 < 4; ++q4) {
#pragma unroll
            for (int s = 0; s < 33; ++s) { const f32x4 c4 = *(const LAS f32x4*)(cs + s * 64 + kk0 + 4 * q4); acc[s] += c4.x * wv[4 * q4] + c4.y * wv[4 * q4 + 1] + c4.z * wv[4 * q4 + 2] + c4.w * wv[4 * q4 + 3]; } }
#pragma unroll
        for (int j = 0; j < 16; ++j) wv[j] = wn[j];
    }
#pragma unroll
    for (int s = 0; s < 33; ++s) red[(wave * 33 + s) * 64 + lane] = acc[s];
    __syncthreads();
    for (int idx = tid; idx < 33 * 64; idx += 512) { const int s = idx >> 6, n = idx & 63; float v = p->in[I_BADA][l * 6144 + n0 + n];
#pragma unroll
        for (int w = 0; w < 8; ++w) v += red[(w * 33 + s) * 64 + n];
        ((float*)(p->ws + WS_ADA))[((size_t)l * 33 + s) * 6144 + n0 + n] = v; }
    __syncthreads();
}
__device__ __forceinline__ void load_x8(KP p, int l, int row, int lane, f32x4 (&v)[8]) {
    if (row < TP) { const f32x4* x4 = (const f32x4*)(l == 0 ? p->in[I_XP] + (size_t)row * DM : (const float*)(p->ws + WS_XBUF) + (size_t)row * DM) + lane;
#pragma unroll
        for (int j = 0; j < 8; ++j) v[j] = x4[64 * j]; }
    else { const int r = row - TP; const f32x4* x4 = (const f32x4*)(p->in[I_XS] + (size_t)r * DM) + lane;
#pragma unroll
        for (int j = 0; j < 8; ++j) v[j] = x4[64 * j];
        for (int s = 0; s < 8 * l; ++s) { const f32x4* q4 = (const f32x4*)((const float*)(p->ws + WS_XPART) + ((size_t)s * 1024 + r) * DM) + lane;
#pragma unroll
            for (int j = 0; j < 8; ++j) v[j] += q4[64 * j]; } }
}
__device__ __forceinline__ void p1_rows(KP p, int l, int gw, int ngw, int lane) {
    const f32x4* g4 = (const f32x4*)(p->in[I_NORMG] + l * DM) + lane;
    f32x4 a[8], sh[8]; int cur_seq = -1;
    for (int row = gw; row < NTOK; row += ngw) {
        const int seq = row < TP ? 0 : 1 + ((row - TP) >> 5);
        f32x4 v[8]; float ss = 0.f; load_x8(p, l, row, lane, v);
#pragma unroll
        for (int j = 0; j < 8; ++j) { ss += (v[j].x * v[j].x + v[j].y * v[j].y) + (v[j].z * v[j].z + v[j].w * v[j].w); }
        if (seq != cur_seq) { cur_seq = seq;
            const f32x4* sh4 = (const f32x4*)((const float*)(p->ws + WS_ADA) + ((size_t)l * 33 + seq) * 6144) + lane; const f32x4* sc4 = sh4 + 512;
#pragma unroll
            for (int j = 0; j < 8; ++j) { a[j] = g4[64 * j] * (sc4[64 * j] + 1.f); sh[j] = sh4[64 * j]; } }
        const float rstd = 1.f / sqrtf(wave_sum(ss) * (1.f / DM) + 1e-6f);
        u32x2* o = (u32x2*)((bf16_t*)(p->ws + WS_H) + (size_t)row * DM) + lane;
#pragma unroll
        for (int j = 0; j < 8; ++j) { const f32x4 y = v[j] * rstd * a[j] + sh[j];
            u32x2 w; w.x = cvt_pk_bf16(y.x, y.y); w.y = cvt_pk_bf16(y.z, y.w); o[64 * j] = w; }
    }
}
__device__ __forceinline__ void p_final_rows(KP p, int gw, int ngw, int lane) {
    const f32x4* g4 = (const f32x4*)p->in[I_FING] + lane;
    for (int row = gw; row < NTOK; row += ngw) {
        f32x4 v[8]; float ss = 0.f; load_x8(p, 2, row, lane, v);
#pragma unroll
        for (int j = 0; j < 8; ++j) { ss += (v[j].x * v[j].x + v[j].y * v[j].y) + (v[j].z * v[j].z + v[j].w * v[j].w); }
        const float rstd = 1.f / sqrtf(wave_sum(ss) * (1.f / DM) + 1e-6f);
        f32x4* o = (f32x4*)(p->out + O_YP + (size_t)row * DM) + lane;
#pragma unroll
        for (int j = 0; j < 8; ++j) o[64 * j] = v[j] * rstd * g4[64 * j];
    }
}
struct EpiU {
    static constexpr bool PERM = true, AFTER_DRAIN = false;
    bf16_t* U; float* out; const float* bf; int l;
    __device__ __forceinline__ void operator()(const f32x4 (&acc)[2][2][4][2], const pg8::Unit& u, int wr, int wc, int fr, int fq) const {
        const int row0 = u.pm * 256 + wr * 64 + fr, col0 = u.pn * 256 + wc * 32 + 8 * fq;
#pragma unroll
        for (int ai = 0; ai < 2; ++ai)
#pragma unroll
            for (int m = 0; m < 4; ++m) { bf16_t* rowp = U + (size_t)(row0 + ai * 128 + m * 16) * NU + col0;
#pragma unroll
                for (int bj = 0; bj < 2; ++bj) { const f32x4 v0 = acc[ai][bj][m][0], v1 = acc[ai][bj][m][1];
                    u32x4 w; w.x = cvt_pk_bf16(v0[0], v0[1]); w.y = cvt_pk_bf16(v0[2], v0[3]); w.z = cvt_pk_bf16(v1[0], v1[1]); w.w = cvt_pk_bf16(v1[2], v1[3]);
                    *(u32x4*)(rowp + bj * 128) = w; } }
        if (u.pn >= 8 && u.pn < 12) {
            const bool isv = u.pn >= 10; const int cin = (u.pn - (isv ? 10 : 8)) * 256 + wc * 32 + 8 * fq;
#pragma unroll
            for (int ai = 0; ai < 2; ++ai)
#pragma unroll
                for (int m = 0; m < 4; ++m) { const int row = row0 + ai * 128 + m * 16;
                    float* dst = row < TP ? out + (isv ? O_PV : O_PK) + ((size_t)l * TP + row) * 512 : out + (isv ? O_SV : O_SK) + ((size_t)l * 1024 + (row - TP)) * 512;
#pragma unroll
                    for (int bj = 0; bj < 2; ++bj) { *(f32x4*)(dst + cin + bj * 128) = acc[ai][bj][m][0]; *(f32x4*)(dst + cin + bj * 128 + 4) = acc[ai][bj][m][1]; } }
        }
        if (u.pn == 58 && wc == 0 && fq == 0) {
            const f32x4 b0 = *(const f32x4*)(bf + l * 8), b1 = *(const f32x4*)(bf + l * 8 + 4);
#pragma unroll
            for (int ai = 0; ai < 2; ++ai)
#pragma unroll
                for (int m = 0; m < 4; ++m) { const int row = row0 + ai * 128 + m * 16;
                    float* dst = row < TP ? out + O_PLF + ((size_t)l * TP + row) * 8 : out + O_SLF + ((size_t)l * 1024 + (row - TP)) * 8;
                    const f32x4 z0 = acc[ai][1][m][0] + b0, z1 = acc[ai][1][m][1] + b1; f32x4 o0, o1;
#pragma unroll
                    for (int e = 0; e < 4; ++e) { o0[e] = log_sigmoidf_(z0[e]); o1[e] = log_sigmoidf_(z1[e]); }
                    *(f32x4*)dst = o0; *(f32x4*)(dst + 4) = o1; }
        }
    }
};
struct BranchOrder {
    int G, c;
    __device__ __forceinline__ bool next(int i, pg8::Unit& u) const { const int L = i * G + c; if (L >= 4 * 544) return false; const int n = L / 544, t = L - n * 544; u.pm = n * 68 + (t >> 3); u.pn = n * 8 + (t & 7); return true; }
    __device__ __forceinline__ void a_ready(const pg8::Unit&) const {}
    __device__ __forceinline__ void done(const pg8::Unit&) const {}
};
struct EpiZ {
    static constexpr bool PERM = true, AFTER_DRAIN = false;
    bf16_t* Z; const bf16_t* U;
    __device__ __forceinline__ void operator()(const f32x4 (&acc)[2][2][4][2], const pg8::Unit& u, int wr, int wc, int fr, int fq) const {
        const int row0 = u.pm * 256 + wr * 64 + fr, col0 = (u.pn & 7) * 256 + wc * 32 + 8 * fq;
#pragma unroll
        for (int ai = 0; ai < 2; ++ai)
#pragma unroll
            for (int m = 0; m < 4; ++m) { bf16_t* rowp = Z + (size_t)(row0 + ai * 128 + m * 16) * DM + col0;
#pragma unroll
                for (int bj = 0; bj < 2; ++bj) { const f32x4 v0 = acc[ai][bj][m][0], v1 = acc[ai][bj][m][1];
                    u32x4 w; w.x = cvt_pk_bf16(v0[0], v0[1]); w.y = cvt_pk_bf16(v0[2], v0[3]); w.z = cvt_pk_bf16(v1[0], v1[1]); w.w = cvt_pk_bf16(v1[2], v1[3]);
                    *(u32x4*)(rowp + bj * 128) = w; } }
    }
};
__device__ __forceinline__ void merge_pass(KP p, int l, int gtid, int ngt) {
    const bf16_t* U = (const bf16_t*)(p->ws + WS_U); const bf16_t* Z = (const bf16_t*)(p->ws + WS_Z); bf16_t* M = (bf16_t*)(p->ws + WS_MERGED);
    for (int it0 = gtid; it0 < NTOK * 256; it0 += 3 * ngt) {
        u32x4 gv[3][4], zv[3][4];
#pragma unroll
        for (int k = 0; k < 3; ++k) { const int it = it0 + k * ngt < NTOK * 256 ? it0 + k * ngt : it0; const int row = it >> 8, col = (it & 255) * 8;
#pragma unroll
            for (int n = 0; n < 4; ++n) { gv[k][n] = *(const u32x4*)(U + (size_t)row * NU + U_G + n * 2048 + col); zv[k][n] = *(const u32x4*)(Z + ((size_t)n * NTOK + row) * DM + col); } }
#pragma unroll
        for (int k = 0; k < 3; ++k) { const int it = it0 + k * ngt; if (it < NTOK * 256) { const int row = it >> 8, col = (it & 255) * 8;
            float s[8];
#pragma unroll
            for (int e = 0; e < 8; ++e) s[e] = 0.f;
#pragma unroll
            for (int n = 0; n < 4; ++n) { const u32x4 g = gv[k][n], z = zv[k][n];
                s[0] += sigmoidf_(bflo(g.x)) * bflo(z.x); s[1] += sigmoidf_(bfhi(g.x)) * bfhi(z.x); s[2] += sigmoidf_(bflo(g.y)) * bflo(z.y); s[3] += sigmoidf_(bfhi(g.y)) * bfhi(z.y);
                s[4] += sigmoidf_(bflo(g.z)) * bflo(z.z); s[5] += sigmoidf_(bfhi(g.z)) * bfhi(z.z); s[6] += sigmoidf_(bflo(g.w)) * bflo(z.w); s[7] += sigmoidf_(bfhi(g.w)) * bfhi(z.w); }
            u32x4 w; w.x = cvt_pk_bf16(s[0], s[1]); w.y = cvt_pk_bf16(s[2], s[3]); w.z = cvt_pk_bf16(s[4], s[5]); w.w = cvt_pk_bf16(s[6], s[7]);
            *(u32x4*)(M + (size_t)row * DM + col) = w; } }
    }
}
struct EpiOut {
    static constexpr bool PERM = false, AFTER_DRAIN = false;
    const float* xp; const float* xs; const float* xb; const float* ada; float* xout; int l;
    __device__ __forceinline__ void operator()(const f32x4 (&acc)[2][2][4][2], const pg8::Unit& u, int wr, int wc, int fr, int fq) const {
        const int row0 = u.pm * 256 + wr * 64 + fr, col0 = u.pn * 256 + wc * 32 + 4 * fq;
        f32x4 gt[2][2];
#pragma unroll
        for (int ai = 0; ai < 2; ++ai)
#pragma unroll
            for (int mp = 0; mp < 4; mp += 2) {
                f32x4 bs[2][2][2], gv[2][2][2];
#pragma unroll
                for (int mm = 0; mm < 2; ++mm) { const int row = row0 + ai * 128 + (mp + mm) * 16;
                    const float* base = l == 0 ? (row < TP ? xp + (size_t)row * DM : xs + (size_t)(row - TP) * DM) : xb + (size_t)row * DM;
                    const float* gate = ada + ((size_t)l * 33 + (row < TP ? 0 : 1 + ((row - TP) >> 5))) * 6144 + 4096;
#pragma unroll
                    for (int bj = 0; bj < 2; ++bj)
#pragma unroll
                        for (int n = 0; n < 2; ++n) { const int col = col0 + bj * 128 + n * 16; bs[mm][bj][n] = *(const f32x4*)(base + col); gv[mm][bj][n] = *(const f32x4*)(gate + col); } }
#pragma unroll
                for (int mm = 0; mm < 2; ++mm) { const int row = row0 + ai * 128 + (mp + mm) * 16;
#pragma unroll
                    for (int bj = 0; bj < 2; ++bj)
#pragma unroll
                        for (int n = 0; n < 2; ++n) { const int col = col0 + bj * 128 + n * 16; *(f32x4*)(xout + (size_t)row * DM + col) = bs[mm][bj][n] + gv[mm][bj][n] * acc[ai][bj][mp + mm][n]; } }
            }
        (void)gt;
    }
};
struct OneUnit {
    int pm, pn; bool valid;
    __device__ __forceinline__ bool next(int i, pg8::Unit& u) const { if (i > 0 || !valid) return false; u.pm = pm; u.pn = pn; return true; }
    __device__ __forceinline__ void a_ready(const pg8::Unit&) const {}
    __device__ __forceinline__ void done(const pg8::Unit&) const {}
};
struct EpiOutPart {
    static constexpr bool PERM = false, AFTER_DRAIN = false;
    const float* ada; float* part; int l;
    __device__ __forceinline__ void operator()(const f32x4 (&acc)[2][2][4][2], const pg8::Unit& u, int wr, int wc, int fr, int fq) const {
        const int row0 = u.pm * 256 + wr * 64 + fr - TP, col0 = u.pn * 256 + wc * 32 + 4 * fq;
#pragma unroll
        for (int ai = 0; ai < 2; ++ai)
#pragma unroll
            for (int m = 0; m < 4; ++m) { const int r = row0 + ai * 128 + m * 16;
                const float* gate = ada + ((size_t)l * 33 + 1 + (r >> 5)) * 6144 + 4096;
#pragma unroll
                for (int bj = 0; bj < 2; ++bj)
#pragma unroll
                    for (int n = 0; n < 2; ++n) { const int col = col0 + bj * 128 + n * 16; *(f32x4*)(part + (size_t)r * DM + col) = *(const f32x4*)(gate + col) * acc[ai][bj][m][n]; } }
    }
};
constexpr int CGS = 516;
__device__ __forceinline__ void conv_unit(KP p, int l, int tile, LAS unsigned char* lds, int tid) {
    const bf16_t* U = (const bf16_t*)(p->ws + WS_U);
    const int c = tid, wave = tid >> 6, lane = tid & 63;
    const bool samp = tile >= 512; const int b = tile - 512, row0 = samp ? TP + b * 32 : tile * 32;
    const bool last = samp || tile == 511;
    LAS float* gl = (LAS float*)lds;
    LAS bf16_t* sgl = (LAS bf16_t*)(lds + 62 * CGS * 4);
    LAS float* red = (LAS float*)(lds + 62 * CGS * 4 + 32 * 512 * 2);
    LAS float* st = red + 8 * 32;
#pragma unroll
    for (int k = 0; k < 8; ++k) { const int task = tid + 512 * k; if (task < 62 * 64) { const int i = task >> 6, ch = task & 63; f32x4 o0, o1;
        const int rel = i - 30;
        if (rel < 0 && samp) { const float* hp = p->in[I_SCONV] + (((size_t)l * 32 + b) * 30 + i) * 512 + 8 * ch; o0 = *(const f32x4*)hp; o1 = *(const f32x4*)(hp + 4); }
        else if (row0 + rel < 0) { o0 = (f32x4){0.f, 0.f, 0.f, 0.f}; o1 = o0; }
        else { const bf16_t* up = U + (size_t)(row0 + rel) * NU + 8 * ch; const u32x4 v = *(const u32x4*)(up + U_AVAL), g = *(const u32x4*)(up + U_AGATE);
            o0 = (f32x4){bflo(v.x) * sigmoidf_(bflo(g.x)), bfhi(v.x) * sigmoidf_(bfhi(g.x)), bflo(v.y) * sigmoidf_(bflo(g.y)), bfhi(v.y) * sigmoidf_(bfhi(g.y))};
            o1 = (f32x4){bflo(v.z) * sigmoidf_(bflo(g.z)), bfhi(v.z) * sigmoidf_(bfhi(g.z)), bflo(v.w) * sigmoidf_(bflo(g.w)), bfhi(v.w) * sigmoidf_(bfhi(g.w))}; }
        *(LAS f32x4*)(gl + i * CGS + 8 * ch) = o0; *(LAS f32x4*)(gl + i * CGS + 8 * ch + 4) = o1; } }
#pragma unroll
    for (int k = 0; k < 4; ++k) { const int task = tid + 512 * k, t = task >> 6, ch = task & 63; const u32x4 s = *(const u32x4*)(U + (size_t)(row0 + t) * NU + U_ASG + 8 * ch);
        u32x4 w; w.x = cvt_pk_bf16(siluf_(bflo(s.x)), siluf_(bfhi(s.x))); w.y = cvt_pk_bf16(siluf_(bflo(s.y)), siluf_(bfhi(s.y))); w.z = cvt_pk_bf16(siluf_(bflo(s.z)), siluf_(bfhi(s.z))); w.w = cvt_pk_bf16(siluf_(bflo(s.w)), siluf_(bfhi(s.w)));
        *(LAS u32x4*)(sgl + t * 512 + 8 * ch) = w; }
    const float cb = p->in[I_CONVB][l * 512 + c], lg = p->in[I_CLNG][l * 512 + c], lb = p->in[I_CLNB][l * 512 + c];
    float wk[31];
#pragma unroll
    for (int k = 0; k < 31; ++k) wk[k] = p->in[I_CONVW][((size_t)l * 31 + k) * 512 + c];
    __syncthreads();
    if (last) {
        float* dst = samp ? p->out + O_SCONV + (((size_t)l * 32 + b) * 30) * 512 + c : p->out + O_PCONV + ((size_t)l * 30) * 512 + c;
#pragma unroll
        for (int t = 2; t < 32; ++t) dst[(size_t)(t - 2) * 512] = gl[(30 + t) * CGS + c];
    }
    bf16_t* oa = (bf16_t*)(p->ws + WS_OCAT);
#pragma unroll 1
    for (int half = 0; half < 2; ++half) {
        float z[46];
#pragma unroll
        for (int i = 0; i < 46; ++i) z[i] = gl[(16 * half + i) * CGS + c];
        float hv[16];
#pragma unroll
        for (int tt = 0; tt < 16; ++tt) hv[tt] = cb;
#pragma unroll
        for (int k = 0; k < 31; ++k) {
#pragma unroll
            for (int tt = 0; tt < 16; ++tt) hv[tt] += z[tt + k] * wk[k]; }
#pragma unroll
        for (int tt = 0; tt < 16; ++tt) { const float s1 = wave_sum(hv[tt]), s2 = wave_sum(hv[tt] * hv[tt]); if (lane == 0) { red[(wave * 16 + tt) * 2] = s1; red[(wave * 16 + tt) * 2 + 1] = s2; } }
        __syncthreads();
        if (tid < 16) { float s1 = 0.f, s2 = 0.f;
#pragma unroll
            for (int w = 0; w < 8; ++w) { s1 += red[(w * 16 + tid) * 2]; s2 += red[(w * 16 + tid) * 2 + 1]; }
            const float mean = s1 * (1.f / 512.f), var = fmaxf(s2 * (1.f / 512.f) - mean * mean, 0.f);
            st[tid * 2] = mean; st[tid * 2 + 1] = 1.f / sqrtf(var + 1e-5f); }
        __syncthreads();
#pragma unroll
        for (int tt = 0; tt < 16; ++tt) { const float y = (hv[tt] - st[tt * 2]) * st[tt * 2 + 1] * lg + lb; const int t = 16 * half + tt;
            oa[(size_t)(row0 + t) * 512 + c] = f2bf(siluf_(y) * bf2f(sgl[t * 512 + c])); }
    }
    __syncthreads();
}
__device__ __forceinline__ void pool_unit(KP p, int l, int tile, LAS unsigned char* lds, int tid) {
    const bf16_t* U = (const bf16_t*)(p->ws + WS_U);
    const int c = tid, wave = tid >> 6, lane = tid & 63;
    const bool samp = tile >= 512; const int b = tile - 512, row0 = samp ? TP + b * 32 : tile * 32;
    constexpr int PST = 520;
    LAS float* zl = (LAS float*)lds;
    LAS bf16_t* pl = (LAS bf16_t*)(lds + 47 * CGS * 4);
#pragma unroll
    for (int k = 0; k < 6; ++k) { const int task = tid + 512 * k; if (task < 47 * 64) { const int i = task >> 6, ch = task & 63; f32x4 o0, o1; const int rel = i - 15;
        if (rel < 0 && samp) { const float* hp = p->in[I_SPOOL] + (((size_t)l * 32 + b) * 15 + i) * 512 + 8 * ch; o0 = *(const f32x4*)hp; o1 = *(const f32x4*)(hp + 4); }
        else if (row0 + rel < 0) { o0 = (f32x4){0.f, 0.f, 0.f, 0.f}; o1 = o0; }
        else { const u32x4 v = *(const u32x4*)(U + (size_t)(row0 + rel) * NU + U_DIN + 8 * ch); o0 = (f32x4){bflo(v.x), bfhi(v.x), bflo(v.y), bfhi(v.y)}; o1 = (f32x4){bflo(v.z), bfhi(v.z), bflo(v.w), bfhi(v.w)}; }
        *(LAS f32x4*)(zl + i * CGS + 8 * ch) = o0; *(LAS f32x4*)(zl + i * CGS + 8 * ch + 4) = o1; } }
    u32x4 sgv[4];
#pragma unroll
    for (int k = 0; k < 4; ++k) { const int task = tid + 512 * k; sgv[k] = *(const u32x4*)(U + (size_t)(row0 + (task >> 6)) * NU + U_DSG + 8 * (task & 63)); }
    __syncthreads();
    {
        float z[47];
#pragma unroll
        for (int i = 0; i < 47; ++i) z[i] = zl[i * CGS + c];
        if (samp || tile == 511) {
            float* dst = samp ? p->out + O_SPOOL + (((size_t)l * 32 + b) * 15) * 512 + c : p->out + O_PPOOL + ((size_t)l * 15) * 512 + c;
#pragma unroll
            for (int t = 17; t < 32; ++t) dst[(size_t)(t - 17) * 512] = z[15 + t];
        }
        const int w = 2 << (c >> 7);
#pragma unroll
        for (int t = 0; t < 32; ++t) { float s = 0.f;
#pragma unroll
            for (int i = 0; i < 16; ++i) s += (i < w) ? z[15 + t - i] : 0.f;
            const int pos = samp ? PAST + t : row0 + t; const int cnt = (pos + 1 < w) ? pos + 1 : w;
            pl[t * PST + c] = f2bf(s / (float)cnt - z[15 + t]); }
    }
    __syncthreads();
    LAS bf16_t* sl = (LAS bf16_t*)lds;
    LAS bf16_t* ol = sl + 32 * PST;
#pragma unroll
    for (int k = 0; k < 4; ++k) { const int task = tid + 512 * k, t = task >> 6, ch = task & 63; const u32x4 s = sgv[k];
        u32x4 w; w.x = cvt_pk_bf16(siluf_(bflo(s.x)), siluf_(bfhi(s.x))); w.y = cvt_pk_bf16(siluf_(bflo(s.y)), siluf_(bfhi(s.y))); w.z = cvt_pk_bf16(siluf_(bflo(s.z)), siluf_(bfhi(s.z))); w.w = cvt_pk_bf16(siluf_(bflo(s.w)), siluf_(bfhi(s.w)));
        *(LAS u32x4*)(sl + t * PST + 8 * ch) = w; }
    __syncthreads();
    {
        const int g = wave >> 1, fr = lane & 15, kq = lane >> 4;
        const bf16_t* WT = (const bf16_t*)(p->ws + WS_POOLW) + (size_t)(l * 4 + g) * 128 * 128;
        f32x4 acc[2][4];
#pragma unroll
        for (int mt = 0; mt < 2; ++mt)
#pragma unroll
            for (int nt = 0; nt < 4; ++nt) acc[mt][nt] = (f32x4){0.f, 0.f, 0.f, 0.f};
#pragma unroll
        for (int ks = 0; ks < 4; ++ks) {
            bf16x8 af[2];
#pragma unroll
            for (int mt = 0; mt < 2; ++mt) af[mt] = *(const LAS bf16x8*)(pl + (16 * mt + fr) * PST + g * 128 + 32 * ks + 8 * kq);
#pragma unroll
            for (int nt = 0; nt < 4; ++nt) { const int dl = (wave & 1) * 64 + 16 * nt + fr;
                const bf16x8 bfr = *(const bf16x8*)(WT + (size_t)dl * 128 + 32 * ks + 8 * kq);
#pragma unroll
                for (int mt = 0; mt < 2; ++mt) acc[mt][nt] = __builtin_amdgcn_mfma_f32_16x16x32_bf16(af[mt], bfr, acc[mt][nt], 0, 0, 0); }
        }
#pragma unroll
        for (int nt = 0; nt < 4; ++nt) { const int d = wave * 64 + 16 * nt + fr; const float pb = p->in[I_POOLB][l * 512 + d], ps = p->in[I_POOLS][l * 512 + d];
#pragma unroll
            for (int mt = 0; mt < 2; ++mt)
#pragma unroll
                for (int r = 0; r < 4; ++r) { const int t = 16 * mt + 4 * kq + r; ol[t * PST + d] = f2bf((acc[mt][nt][r] + pb) * ps * bf2f(sl[t * PST + d])); } }
    }
    __syncthreads();
    bf16_t* od = (bf16_t*)(p->ws + WS_OCAT) + (size_t)3 * NTOK * 512;
#pragma unroll
    for (int k = 0; k < 4; ++k) { const int task = tid + 512 * k, t = task >> 6, ch = task & 63; *(u32x4*)(od + (size_t)(row0 + t) * 512 + 8 * ch) = *(const LAS u32x4*)(ol + t * PST + 8 * ch); }
    __syncthreads();
}
__device__ __forceinline__ void fp_unit(KP p, int l, int h, LAS unsigned char* lds, int tid) {
    const float* lf = p->out + O_PLF + (size_t)l * TP * 8 + h;
    LAS float* part = (LAS float*)lds;
    float v[32]; float s = 0.f;
#pragma unroll
    for (int i = 0; i < 32; ++i) { v[i] = lf[(size_t)(tid * 32 + i) * 8]; s += v[i]; }
    part[tid] = s;
    __syncthreads();
    float pre = 0.f;
    for (int j = 0; j < tid; ++j) pre += part[j];
    float* F = (float*)(p->ws + WS_FP) + (size_t)h * TP + tid * 32;
#pragma unroll
    for (int i = 0; i < 32; ++i) { pre += v[i]; F[i] = pre * LOG2E; }
    __syncthreads();
}
__device__ __forceinline__ void gs_unit(KP p, int l, int b, LAS unsigned char* lds, int tid) {
    const int h = tid & 7, ch = tid >> 3;
    const float* cl = p->in[I_CLF] + (((size_t)l * 32 + b) * PAST + ch * 64) * 8 + h;
    LAS float* part = (LAS float*)lds;
    float v[64]; float s = 0.f;
#pragma unroll
    for (int i = 0; i < 64; ++i) v[i] = cl[(size_t)i * 8];
#pragma unroll
    for (int i = 0; i < 64; ++i) s += v[i];
    part[ch * 8 + h] = s;
    __syncthreads();
    float suf = 0.f;
    for (int j = ch + 1; j < 64; ++j) suf += part[j * 8 + h];
    float* G = (float*)(p->ws + WS_GS) + ((size_t)b * 8 + h) * GS_LEN + ch * 64;
#pragma unroll
    for (int i = 63; i >= 0; --i) { G[i] = -suf * LOG2E; suf += v[i]; }
    if (tid < 8) { const float* nl = p->out + O_SLF + ((size_t)l * 1024 + b * 32) * 8 + tid; float* Gn = (float*)(p->ws + WS_GS) + ((size_t)b * 8 + tid) * GS_LEN + PAST; float w[32]; float run = 0.f;
#pragma unroll
        for (int i = 0; i < 32; ++i) w[i] = nl[i * 8];
#pragma unroll
        for (int i = 0; i < 32; ++i) { run += w[i]; Gn[i] = run * LOG2E; } }
    __syncthreads();
}
__device__ __forceinline__ void vt_tile(KP p, int l, int tile, LAS unsigned char* lds, int wave, int lane) {
    const int h = tile >> 8, tb = tile & 255, tl = lane >> 3, q8 = (lane & 7) * 8;
    const bf16_t* U = (const bf16_t*)(p->ws + WS_U);
    LAS unsigned short* scr = (LAS unsigned short*)(lds + wave * (64 * 72 * 2));
    u32x4 kv[8], vv[8];
#pragma unroll
    for (int i = 0; i < 8; ++i) { const bf16_t* rp = U + (size_t)(tb * 64 + 8 * i + tl) * NU + h * 64 + q8; kv[i] = *(const u32x4*)(rp + U_K); vv[i] = *(const u32x4*)(rp + U_V); }
    float mx = 0.f;
#pragma unroll
    for (int i = 0; i < 8; ++i) { const u32x4 w = kv[i];
        float s = bflo(w.x) * bflo(w.x) + bfhi(w.x) * bfhi(w.x) + bflo(w.y) * bflo(w.y) + bfhi(w.y) * bfhi(w.y) + bflo(w.z) * bflo(w.z) + bfhi(w.z) * bfhi(w.z) + bflo(w.w) * bflo(w.w) + bfhi(w.w) * bfhi(w.w);
        s += dpp_mov<0xB1>(s); s += dpp_mov<0x4E>(s); s += dpp_mov<0x141>(s); mx = fmaxf(mx, s); }
    mx = wave_max(mx);
    if (lane == 0) atomicMax((unsigned*)(p->ws + WS_CTL) + CW_KMAX + l * 8 + h, __float_as_uint(mx));
#pragma unroll
    for (int i = 0; i < 8; ++i) { const int t = 8 * i + tl; const u32x4 w = vv[i];
        scr[(q8 + 0) * 72 + t] = (unsigned short)(w.x & 0xffffu); scr[(q8 + 1) * 72 + t] = (unsigned short)(w.x >> 16); scr[(q8 + 2) * 72 + t] = (unsigned short)(w.y & 0xffffu); scr[(q8 + 3) * 72 + t] = (unsigned short)(w.y >> 16);
        scr[(q8 + 4) * 72 + t] = (unsigned short)(w.z & 0xffffu); scr[(q8 + 5) * 72 + t] = (unsigned short)(w.z >> 16); scr[(q8 + 6) * 72 + t] = (unsigned short)(w.w & 0xffffu); scr[(q8 + 7) * 72 + t] = (unsigned short)(w.w >> 16); }
    bf16_t* Vt = (bf16_t*)(p->ws + WS_VT) + ((size_t)h * 64 + lane) * TP + tb * 64;
#pragma unroll
    for (int j = 0; j < 8; ++j) *(u32x4*)(Vt + 8 * j) = *(const LAS u32x4*)(scr + lane * 72 + 8 * j);
}
__device__ __forceinline__ void shift_out(KP p, int l, int tid) {
    const bf16_t* U = (const bf16_t*)(p->ws + WS_U);
    for (int base = tid; base < NSEQ * SHIFT_W; base += 512 * 8) {
        unsigned short v[8];
#pragma unroll
        for (int k = 0; k < 8; ++k) { const int idx = base + k * 512 < NSEQ * SHIFT_W ? base + k * 512 : tid; const int s = idx / SHIFT_W, j = idx - s * SHIFT_W; const int row = s == 0 ? TP - 1 : TP + (s - 1) * 32 + 31; v[k] = U[(size_t)row * NU + U_XC + j]; }
#pragma unroll
        for (int k = 0; k < 8; ++k) { const int idx = base + k * 512; if (idx < NSEQ * SHIFT_W) { const int s = idx / SHIFT_W, j = idx - s * SHIFT_W;
            float* dst = s == 0 ? p->out + O_PSHIFT + (size_t)l * SHIFT_W + j : p->out + O_SSHIFT + ((size_t)l * 32 + (s - 1)) * SHIFT_W + j; *dst = bf2f(v[k]); } }
    }
}
template <bool AT, bool BT, bool NEGA>
__device__ __forceinline__ void mm32(f32x16& acc, const LAS float* Ap, int i0, const LAS float* Bp, int j0, int lane) {
    const int li = lane & 31, kh = lane >> 5;
    const LAS float* ap = AT ? Ap + (8 * kh) * 65 + i0 + li : Ap + (i0 + li) * 65 + 8 * kh;
    const LAS float* bp = BT ? Bp + (j0 + li) * 65 + 8 * kh : Bp + (8 * kh) * 65 + j0 + li;
#pragma unroll 2
    for (int s = 0; s < 4; ++s) {
        float a[8], b[8];
#pragma unroll
        for (int e = 0; e < 8; ++e) { a[e] = AT ? ap[(16 * s + e) * 65] : ap[16 * s + e]; b[e] = BT ? bp[16 * s + e] : bp[(16 * s + e) * 65]; }
        if (NEGA) {
#pragma unroll
            for (int e = 0; e < 8; ++e) a[e] = -a[e]; }
        const bf16x8 af = pack8f((f32x4){a[0], a[1], a[2], a[3]}, (f32x4){a[4], a[5], a[6], a[7]}), bfg = pack8f((f32x4){b[0], b[1], b[2], b[3]}, (f32x4){b[4], b[5], b[6], b[7]});
        acc = __builtin_amdgcn_mfma_f32_32x32x16_bf16(af, bfg, acc, 0, 0, 0);
    }
}
template <int MASK>
__device__ __forceinline__ void st_tile(LAS float* dst, const f32x16& acc, int i0, int j0, int lane) {
    const int li = lane & 31, hi = lane >> 5, j = j0 + li;
#pragma unroll
    for (int r = 0; r < 16; ++r) { const int i = i0 + (r & 3) + 8 * (r >> 2) + 4 * hi; float v = acc[r];
        if (MASK == 1 && !(i < j)) v = 0.f; if (MASK == 2 && !(i <= j)) v = 0.f; dst[i * 65 + j] = v; }
}
struct RwkvSeqInfo { int row0, ntok, prev_kind  , b; };
__device__ __forceinline__ RwkvSeqInfo rwkv_info(int cu) { RwkvSeqInfo s; if (cu < 256) { s.row0 = cu * 64; s.ntok = 64; s.prev_kind = cu == 0 ? 0 : 1; s.b = 0; } else { s.b = cu - 256; s.row0 = TP + s.b * 32; s.ntok = 32; s.prev_kind = 2; } return s; }

__device__ __forceinline__ void rwkv_r1(KP p, int l, int unit, int unit_next, LAS unsigned char* lds, int tid) {
    const int cu = unit >> 3, h = unit & 7, wave = tid >> 6, lane = tid & 63, li = lane & 31, hi = lane >> 5;
    const RwkvSeqInfo si = rwkv_info(cu);
    const bf16_t* U = (const bf16_t*)(p->ws + WS_U);
    LAS float* S0 = (LAS float*)lds; LAS float *S1 = S0 + SLOT_F, *S2 = S0 + 2 * SLOT_F, *S3 = S0 + 3 * SLOT_F, *S4 = S0 + 4 * SLOT_F, *S5 = S0 + 5 * SLOT_F, *S6 = S0 + 6 * SLOT_F, *S7 = S0 + 7 * SLOT_F, *S8 = S0 + 8 * SLOT_F;
    LAS float* gC = S0 + 9 * SLOT_F;
    const int q = wave >> 2, wq = wave & 3, i0 = (wq >> 1) * 32, j0 = (wq & 1) * 32;
    PT0();
    {
        const int j = tid & 63, tq = tid >> 6;
        const int tl = lane >> 3, q8 = (lane & 7) * 8;
#pragma unroll
        for (int kb = 0; kb < 5; kb += 3) {
        u32x4 cur[5], prv[5];
#pragma unroll
        for (int k = kb; k < (kb + 3 < 5 ? kb + 3 : 5); ++k) { const int pid = wave * 5 + k, s = pid >> 3, tb = pid & 7, t = tb * 8 + tl;
            const int xo = (s < 3 ? s * 512 + h * 64 : 1536 + (s - 3) * 64) + q8;
            const int tc = t < si.ntok ? t : si.ntok - 1, tp = tc > 0 ? tc - 1 : (si.prev_kind == 1 ? -1 : 0);
            cur[k] = *(const u32x4*)(U + (size_t)(si.row0 + tc) * NU + U_XC + xo); prv[k] = *(const u32x4*)(U + (size_t)(si.row0 + tp) * NU + U_XC + xo); }
#pragma unroll
        for (int k = kb; k < (kb + 3 < 5 ? kb + 3 : 5); ++k) { const int pid = wave * 5 + k, s = pid >> 3, tb = pid & 7, t = tb * 8 + tl;
            const int xo = (s < 3 ? s * 512 + h * 64 : 1536 + (s - 3) * 64) + q8;
            LAS float* dst = (s == 0 ? S0 : s == 1 ? S1 : s == 2 ? S2 : s == 3 ? S3 : S4) + t * 65 + q8;
            const f32x4 m0 = *(const f32x4*)(p->in[I_MU] + l * SHIFT_W + xo), m1 = *(const f32x4*)(p->in[I_MU] + l * SHIFT_W + xo + 4);
            float x[8] = {bflo(cur[k].x), bfhi(cur[k].x), bflo(cur[k].y), bfhi(cur[k].y), bflo(cur[k].z), bfhi(cur[k].z), bflo(cur[k].w), bfhi(cur[k].w)};
            float pv[8] = {bflo(prv[k].x), bfhi(prv[k].x), bflo(prv[k].y), bfhi(prv[k].y), bflo(prv[k].z), bfhi(prv[k].z), bflo(prv[k].w), bfhi(prv[k].w)};
            if (t == 0 && si.prev_kind != 1) {
                if (si.prev_kind == 2) { const float* sp = p->in[I_SSHIFT] + ((size_t)l * 32 + si.b) * SHIFT_W + xo;
#pragma unroll
                    for (int e = 0; e < 8; ++e) pv[e] = sp[e]; }
                else {
#pragma unroll
                    for (int e = 0; e < 8; ++e) pv[e] = 0.f; } }
#pragma unroll
            for (int e = 0; e < 8; ++e) { const float mu = e < 4 ? m0[e] : m1[e - 4]; float xs = (t < si.ntok) ? x[e] + (pv[e] - x[e]) * mu : 0.f; if (s == 3) xs = fast_tanh(xs); dst[e] = xs; }
        }
        }
#pragma unroll
        for (int mm = 0; mm < 8; ++mm) { const int m = tq * 8 + mm;
            S5[m * 65 + j] = p->in[I_W2][((size_t)l * 64 + m) * 512 + h * 64 + j]; S6[m * 65 + j] = p->in[I_A2][((size_t)l * 64 + m) * 512 + h * 64 + j]; }
    }
    __syncthreads();
    PT1(1);
    {
        f32x16 acc = {};
        const int c = j0 + li;
        if (q == 0) { mm32<false, false, false>(acc, S3, i0, S5, j0, lane); const float w0 = p->in[I_W0][l * 512 + h * 64 + c];
#pragma unroll
            for (int r = 0; r < 16; ++r) { const int t = i0 + (r & 3) + 8 * (r >> 2) + 4 * hi; const float zz = acc[r] + w0;
                const float sp = fmaxf(-zz, 0.f) + __logf(1.f + __expf(-fabsf(zz)));
                S7[t * 65 + c] = (t < si.ntok) ? -__expf(-sp - 0.5f) : 0.f; } }
        else { mm32<false, false, false>(acc, S4, i0, S6, j0, lane); const float a0 = p->in[I_A0][l * 512 + h * 64 + c];
#pragma unroll
            for (int r = 0; r < 16; ++r) { const int t = i0 + (r & 3) + 8 * (r >> 2) + 4 * hi; S8[t * 65 + c] = __builtin_amdgcn_rcpf(1.f + __expf(-(acc[r] + a0))); } }
    }
    __syncthreads();
    PT1(2);
    if (wave == 0) { float run = 0.f;
#pragma unroll 8
        for (int t = 0; t < 64; ++t) { run += S7[t * 65 + lane]; S3[t * 65 + lane] = run; } }
    else { const int c = lane; const float kkw = p->in[I_KK][l * 512 + h * 64 + c], kaw = p->in[I_KA][l * 512 + h * 64 + c], rkw = p->in[I_RK][l * 512 + h * 64 + c];
        for (int t = wave - 1; t < 64; t += 7) { const float kr = S1[t * 65 + c], kv = kr * kkw; const float ss = wave_sum(kv * kv);
            const float kn = kv * (1.f / sqrtf(fmaxf(ss, 1e-24f))); const float a = S8[t * 65 + c]; const float km = kr * (1.f + (a - 1.f) * kaw);
            const float bon = wave_sum(S0[t * 65 + c] * km * rkw);
            S4[t * 65 + c] = kn; S1[t * 65 + c] = km; S8[t * 65 + c] = kn * a;
            if (lane == 0) ((float*)(p->ws + WS_BONUS))[(size_t)unit * 64 + t] = bon; } }
    __syncthreads();
    { const int c = tid & 63, tq = tid >> 6;
#pragma unroll
        for (int tt = 0; tt < 8; ++tt) { const int t = tq * 8 + tt, o = t * 65 + c; const float Lg = S3[o], lw = S7[o];
            const float g = __expf(Lg), gi = __expf(-Lg), gp = __expf(Lg - lw);
            S0[o] *= g; S1[o] *= gi; S8[o] *= gi; S4[o] *= gp; if (t == 63) gC[c] = g; } }
    __syncthreads();
    PT1(3);
    unsigned touch = 0u;
    if (unit_next < NRU && tid < 65 * 5) { const RwkvSeqInfo sn = rwkv_info(unit_next >> 3); const int hn = unit_next & 7, rr = tid / 5, ln = tid - rr * 5;
        const int trow = rr == 0 ? (sn.prev_kind == 1 ? -1 : 0) : (rr - 1 < sn.ntok ? rr - 1 : sn.ntok - 1);
        const int xo = ln < 3 ? ln * 512 + hn * 64 : 1536 + (ln - 3) * 64;
        touch = *(const unsigned*)(U + (size_t)(sn.row0 + trow) * NU + U_XC + xo); }
    { f32x16 acc = {};
      if (q == 0) { mm32<false, true, false>(acc, S1, i0, S4, j0, lane); st_tile<1>(S3, acc, i0, j0, lane); }
      else { mm32<false, true, false>(acc, S8, i0, S4, j0, lane); st_tile<1>(S5, acc, i0, j0, lane); } }
    __syncthreads();
    { f32x16 acc = {};
      if (q == 0) { mm32<true, false, false>(acc, S2, i0, S3, j0, lane); st_tile<0>(S6, acc, i0, j0, lane); }
      else { mm32<false, true, false>(acc, S1, i0, S0, j0, lane); st_tile<2>(S7, acc, i0, j0, lane); } }
    __syncthreads();
    asm volatile("" :: "v"(touch));
    PT1(4);
    { float xa[4], xb[4]; const int ra = 4 * wave, rb = 60 - 4 * wave;
#pragma unroll
      for (int k = 0; k < 4; ++k) { xa[k] = (lane == ra + k) ? 1.f : 0.f; xb[k] = (lane == rb + k) ? 1.f : 0.f; }
      for (int s = ra; s < rb; ++s) { const float mrow = S5[s * 65 + lane];
#pragma unroll
          for (int k = 0; k < 4; ++k) xa[k] -= __builtin_bit_cast(float, __builtin_amdgcn_readlane(__builtin_bit_cast(int, xa[k]), s)) * mrow; }
      for (int s = rb; s < 63; ++s) { const float mrow = S5[s * 65 + lane]; float ya[4], yb[4];
#pragma unroll
          for (int k = 0; k < 4; ++k) { ya[k] = __builtin_bit_cast(float, __builtin_amdgcn_readlane(__builtin_bit_cast(int, xa[k]), s)); yb[k] = __builtin_bit_cast(float, __builtin_amdgcn_readlane(__builtin_bit_cast(int, xb[k]), s)); }
#pragma unroll
          for (int k = 0; k < 4; ++k) { xa[k] -= ya[k] * mrow; xb[k] -= yb[k] * mrow; } }
#pragma unroll
      for (int k = 0; k < 4; ++k) { S3[(ra + k) * 65 + lane] = xa[k]; S3[(rb + k) * 65 + lane] = xb[k]; } }
    __syncthreads();
    { f32x16 acc = {};
      if (q == 0) mm32<true, false, false>(acc, S4, i0, S3, j0, lane); else mm32<false, false, false>(acc, S6, i0, S3, j0, lane);
      __syncthreads();
      st_tile<0>(q == 0 ? S3 : S6, acc, i0, j0, lane); }
    __syncthreads();
    PT1(5);
    { f32x16 acc = {};
      if (q == 1) { mm32<false, true, false>(acc, S8, i0, S0, j0, lane); st_tile<2>(S4, acc, i0, j0, lane); }
      else { mm32<false, false, false>(acc, S3, i0, S8, j0, lane);
          const int jc = j0 + li; const float gc = gC[jc]; float* TQ = (float*)(p->ws + WS_TQ) + (size_t)unit * 4096;
#pragma unroll
          for (int rg = 0; rg < 4; ++rg) { const int ab = i0 + 8 * rg + 4 * hi; f32x4 o;
#pragma unroll
              for (int e = 0; e < 4; ++e) o[e] = ((ab + e == jc) ? gc : 0.f) - acc[rg * 4 + e] * gc;
              *(f32x4*)(TQ + ((((jc >> 4) * 4 + (ab >> 4)) * 64 + ((ab & 15) >> 2) * 16 + (jc & 15)) * 4)) = o; } } }
    __syncthreads();
    { f32x16 acc = {};
      if (q == 0) { mm32<true, false, false>(acc, S2, i0, S1, j0, lane); mm32<false, false, true>(acc, S6, i0, S8, j0, lane);
          const int jc = j0 + li; const float gc = gC[jc]; float* GM = (float*)(p->ws + WS_GM) + (size_t)unit * 4096;
#pragma unroll
          for (int r = 0; r < 16; ++r) GM[(i0 + (r & 3) + 8 * (r >> 2) + 4 * hi) * 64 + jc] = acc[r] * gc; }
      else { mm32<true, false, false>(acc, S2, i0, S7, j0, lane); mm32<false, false, true>(acc, S6, i0, S4, j0, lane);
          float* Y0T = (float*)(p->ws + WS_Y0T) + (size_t)unit * 4096;
#pragma unroll
          for (int rg = 0; rg < 4; ++rg) *(f32x4*)(Y0T + (((((j0 >> 5) * 2 + (i0 >> 5)) * 4 + rg) * 2 + hi) * 32 + li) * 4) = (f32x4){acc[rg * 4], acc[rg * 4 + 1], acc[rg * 4 + 2], acc[rg * 4 + 3]}; } }
    if (q == 0) { f32x16 acc;
#pragma unroll
        for (int r = 0; r < 16; ++r) acc[r] = S0[(j0 + li) * 65 + i0 + (r & 3) + 8 * (r >> 2) + 4 * hi];
        mm32<false, false, true>(acc, S3, i0, S4, j0, lane);
        float* ET = (float*)(p->ws + WS_ET) + (size_t)unit * 4096;
#pragma unroll
        for (int rg = 0; rg < 4; ++rg) *(f32x4*)(ET + ((((j0 >> 5) * 2 + (i0 >> 5)) * 8 + 2 * rg + hi) * 32 + li) * 4) = (f32x4){acc[rg * 4], acc[rg * 4 + 1], acc[rg * 4 + 2], acc[rg * 4 + 3]}; }
    __syncthreads();
    PT1(6);
}
template <bool SCQ>
__device__ __forceinline__ void chain_run(f32x4 (&st)[4], const float* TQ, const float* GM, float* SC, int nsteps, int i, int g, int lane) {
    constexpr size_t STRIDE = (size_t)8 * 4096;
    f32x4 tq[16], gm[4];
#pragma unroll
    for (int x = 0; x < 16; ++x) tq[x] = *(const f32x4*)(TQ + (x * 64 + lane) * 4);
#pragma unroll
    for (int tl = 0; tl < 4; ++tl) gm[tl] = GM ? *(const f32x4*)(GM + i * 64 + 16 * tl + 4 * g) : (f32x4){0.f, 0.f, 0.f, 0.f};
    for (int c = 0; c < nsteps; ++c) {
        if (SC) {
            if (SCQ) {
#pragma unroll
                for (int tl = 0; tl < 4; ++tl) *(f32x4*)(SC + c * STRIDE + ((((i >> 5) * 2 + (tl >> 1)) * 8 + 4 * (tl & 1) + g) * 32 + (i & 31)) * 4) = st[tl]; }
            else {
#pragma unroll
                for (int tl = 0; tl < 4; ++tl) *(f32x4*)(SC + c * STRIDE + i * 64 + 16 * tl + 4 * g) = st[tl]; } }
        f32x4 tqn[16], gmn[4];
        const int cn = (c + 1 < nsteps) ? c + 1 : c;
#pragma unroll
        for (int x = 0; x < 16; ++x) tqn[x] = *(const f32x4*)(TQ + cn * STRIDE + (x * 64 + lane) * 4);
#pragma unroll
        for (int tl = 0; tl < 4; ++tl) gmn[tl] = GM ? *(const f32x4*)(GM + cn * STRIDE + i * 64 + 16 * tl + 4 * g) : (f32x4){0.f, 0.f, 0.f, 0.f};
        f32x4 acc[4];
#pragma unroll
        for (int tp = 0; tp < 4; ++tp) acc[tp] = gm[tp];
#pragma unroll
        for (int tl = 0; tl < 4; ++tl)
#pragma unroll
            for (int r = 0; r < 4; ++r)
#pragma unroll
                for (int tp = 0; tp < 4; ++tp) acc[tp] = __builtin_amdgcn_mfma_f32_16x16x4f32(tq[tp * 4 + tl][r], st[tl][r], acc[tp], 0, 0, 0);
#pragma unroll
        for (int tl = 0; tl < 4; ++tl) st[tl] = acc[tl];
#pragma unroll
        for (int x = 0; x < 16; ++x) tq[x] = tqn[x];
#pragma unroll
        for (int tl = 0; tl < 4; ++tl) gm[tl] = gmn[tl];
    }
}
constexpr int CH_SLOT = 32768;
#define CH_LD(R, STEP) do { const int s_ = (STEP) < nsteps ? (STEP) : nsteps - 1; _Pragma("unroll") for (int k = 0; k < 4; ++k) { R[k] = *(const f32x4*)(TQ + (size_t)s_ * STRIDE + (k * 256 + ll) * 4); \
        R[4 + k] = GM ? *(const f32x4*)(GM + (size_t)s_ * STRIDE + (k * 256 + ll) * 4) : (f32x4){0.f, 0.f, 0.f, 0.f}; } } while (0)
#define CH_WR(R, SLOT) do { LAS float* d_ = (LAS float*)(lds + (SLOT) * CH_SLOT); _Pragma("unroll") for (int k = 0; k < 4; ++k) { *(LAS f32x4*)(d_ + (k * 256 + ll) * 4) = R[k]; *(LAS f32x4*)(d_ + 4096 + (k * 256 + ll) * 4) = R[4 + k]; } } while (0)
template <bool SCQ>
__device__ __forceinline__ void chain_block(f32x4 (&st)[4], const float* TQ, const float* GM, float* SC, int nsteps, LAS unsigned char* lds, int wave, int lane) {
    constexpr size_t STRIDE = (size_t)8 * 4096;
    if (wave >= 4) {
        const int ll = (wave - 4) * 64 + lane;
        f32x4 r0[8], r1[8], r2[8];
        CH_LD(r0, 0); CH_LD(r1, 1); CH_LD(r2, 2);
        CH_WR(r0, 0);
        __syncthreads();
        for (int c = 0; c < nsteps; c += 3) {
            CH_WR(r1, (c + 1) & 1); CH_LD(r0, c + 3); __syncthreads();
            if (c + 1 < nsteps) { CH_WR(r2, (c + 2) & 1); CH_LD(r1, c + 4); __syncthreads(); }
            if (c + 2 < nsteps) { CH_WR(r0, (c + 3) & 1); CH_LD(r2, c + 5); __syncthreads(); }
        }
    } else {
        const int fr = lane & 15, g = lane >> 4, i = wave * 16 + fr;
        __syncthreads();
        for (int c = 0; c < nsteps; ++c) {
            if (SC) {
                if (SCQ) {
#pragma unroll
                    for (int tl = 0; tl < 4; ++tl) *(f32x4*)(SC + c * STRIDE + ((((i >> 5) * 2 + (tl >> 1)) * 8 + 4 * (tl & 1) + g) * 32 + (i & 31)) * 4) = st[tl]; }
                else {
#pragma unroll
                    for (int tl = 0; tl < 4; ++tl) *(f32x4*)(SC + c * STRIDE + i * 64 + 16 * tl + 4 * g) = st[tl]; } }
            const LAS float* sl = (const LAS float*)(lds + (c & 1) * CH_SLOT);
            f32x4 acc[4];
#pragma unroll
            for (int tp = 0; tp < 4; ++tp) acc[tp] = *(const LAS f32x4*)(sl + 4096 + i * 64 + 16 * tp + 4 * g);
#pragma unroll
            for (int tl = 0; tl < 4; ++tl) { f32x4 tq[4];
#pragma unroll
                for (int tp = 0; tp < 4; ++tp) tq[tp] = *(const LAS f32x4*)(sl + ((tp * 4 + tl) * 64 + lane) * 4);
#pragma unroll
                for (int r = 0; r < 4; ++r)
#pragma unroll
                    for (int tp = 0; tp < 4; ++tp) acc[tp] = __builtin_amdgcn_mfma_f32_16x16x4f32(tq[tp][r], st[tl][r], acc[tp], 0, 0, 0); }
#pragma unroll
            for (int tl = 0; tl < 4; ++tl) st[tl] = acc[tl];
            __syncthreads();
        }
    }
}
__device__ __forceinline__ void rwkv_l1_block(KP p, int task, LAS unsigned char* lds, int wave, int lane) {
    const int kind = task & 1, h = (task >> 1) & 7, grp = task >> 4, iq = wave & 3;
    const int fr = lane & 15, g = lane >> 4, i = iq * 16 + fr;
    const size_t u0 = ((size_t)(grp * 16) * 8 + h) * 4096;
    f32x4 st[4];
#pragma unroll
    for (int tl = 0; tl < 4; ++tl)
#pragma unroll
        for (int r = 0; r < 4; ++r) st[tl][r] = (kind == 1 && i == 16 * tl + 4 * g + r) ? 1.f : 0.f;
    chain_block<false>(st, (const float*)(p->ws + WS_TQ) + u0, kind == 0 ? (const float*)(p->ws + WS_GM) + u0 : nullptr, nullptr, 16, lds, wave, lane);
    if (wave < 4) { const size_t gb = ((size_t)grp * 8 + h) * 4096;
        if (kind == 0) { float* GG = (float*)(p->ws + WS_GG) + gb;
#pragma unroll
            for (int tl = 0; tl < 4; ++tl) *(f32x4*)(GG + i * 64 + 16 * tl + 4 * g) = st[tl]; }
        else { float* TG = (float*)(p->ws + WS_TG) + gb;
#pragma unroll
            for (int tl = 0; tl < 4; ++tl)
#pragma unroll
                for (int r = 0; r < 4; ++r) TG[((tl * 4 + iq) * 64 + (fr >> 2) * 16 + 4 * g + r) * 4 + (fr & 3)] = st[tl][r]; } }
    __syncthreads();
}
__device__ __forceinline__ void rwkv_l2_block(KP p, int l, int h, LAS unsigned char* lds, int wave, int lane) {
    const int iq = wave & 3, fr = lane & 15, g = lane >> 4, i = iq * 16 + fr;
    f32x4 st[4];
#pragma unroll
    for (int tl = 0; tl < 4; ++tl) st[tl] = (f32x4){0.f, 0.f, 0.f, 0.f};
    chain_block<false>(st, (const float*)(p->ws + WS_TG) + (size_t)h * 4096, (const float*)(p->ws + WS_GG) + (size_t)h * 4096, (float*)(p->ws + WS_SG) + (size_t)h * 4096, 16, lds, wave, lane);
    if (wave < 4) { float* dst = p->out + O_PWKV + (((size_t)l * 8 + h) * 64 + i) * 64;
#pragma unroll
        for (int tl = 0; tl < 4; ++tl) *(f32x4*)(dst + 16 * tl + 4 * g) = st[tl]; }
    __syncthreads();
}
__device__ __forceinline__ void rwkv_l3_block(KP p, int l, int task, LAS unsigned char* lds, int wave, int lane) {
    const int h = task & 7, grp = task >> 3, iq = wave & 3, fr = lane & 15, g = lane >> 4, i = iq * 16 + fr;
    f32x4 st[4];
#pragma unroll
    for (int tl = 0; tl < 4; ++tl) st[tl] = (f32x4){0.f, 0.f, 0.f, 0.f};
    if (grp > 0) chain_block<false>(st, (const float*)(p->ws + WS_TG) + (size_t)h * 4096, (const float*)(p->ws + WS_GG) + (size_t)h * 4096, nullptr, grp, lds, wave, lane);
    const size_t u0 = ((size_t)(grp * 16) * 8 + h) * 4096;
    chain_block<true>(st, (const float*)(p->ws + WS_TQ) + u0, (const float*)(p->ws + WS_GM) + u0, (float*)(p->ws + WS_SC) + u0, 16, lds, wave, lane);
    if (grp == 15 && wave < 4) { float* dst = p->out + O_PWKV + (((size_t)l * 8 + h) * 64 + i) * 64;
#pragma unroll
        for (int tl = 0; tl < 4; ++tl) *(f32x4*)(dst + 16 * tl + 4 * g) = st[tl]; }
    __syncthreads();
}
__device__ __forceinline__ void rwkv_samp_task(KP p, int l, int t2, int lane) {
    const int fr = lane & 15, g = lane >> 4, iq = t2 & 3, h = (t2 >> 2) & 7, b = t2 >> 5, i = iq * 16 + fr;
    f32x4 st[4];
    const float* s0 = p->in[I_SWKV] + ((((size_t)l * 32 + b) * 8 + h) * 64 + i) * 64;
#pragma unroll
    for (int tl = 0; tl < 4; ++tl) st[tl] = *(const f32x4*)(s0 + 16 * tl + 4 * g);
    const size_t u0 = ((size_t)(256 + b) * 8 + h) * 4096;
    chain_run<true>(st, (const float*)(p->ws + WS_TQ) + u0, (const float*)(p->ws + WS_GM) + u0, (float*)(p->ws + WS_SC) + u0, 1, i, g, lane);
    float* dst = p->out + O_SWKV + ((((size_t)l * 32 + b) * 8 + h) * 64 + i) * 64;
#pragma unroll
    for (int tl = 0; tl < 4; ++tl) *(f32x4*)(dst + 16 * tl + 4 * g) = st[tl];
}
__device__ __forceinline__ void rwkv_r3_task(KP p, int l, int task, int lane) {
    const int unit = task >> 1, th = task & 1, cu = unit >> 3, h = unit & 7, li = lane & 31, hi = lane >> 5;
    const RwkvSeqInfo si = rwkv_info(cu);
    if (th * 32 >= si.ntok) return;
    const bf16_t* U = (const bf16_t*)(p->ws + WS_U);
    const size_t ub = (size_t)unit * 4096; const int t = th * 32 + li;
    const float* SC = (const float*)(p->ws + WS_SC) + ub; const float* ET = (const float*)(p->ws + WS_ET) + ub; const float* Y0T = (const float*)(p->ws + WS_Y0T) + ub;
    f32x16 acc[2];
#pragma unroll
    for (int ti = 0; ti < 2; ++ti)
#pragma unroll
        for (int rg = 0; rg < 4; ++rg) { const f32x4 y0 = *(const f32x4*)(Y0T + ((((th * 2 + ti) * 4 + rg) * 2 + hi) * 32 + li) * 4);
#pragma unroll
            for (int e = 0; e < 4; ++e) acc[ti][rg * 4 + e] = y0[e]; }
    f32x4 eb[8], sa0[8], sa1[8];
#pragma unroll
    for (int s4 = 0; s4 < 8; ++s4) { eb[s4] = *(const f32x4*)(ET + (((th * 2 + hi) * 8 + s4) * 32 + li) * 4); sa0[s4] = *(const f32x4*)(SC + (((0 * 2 + hi) * 8 + s4) * 32 + li) * 4); sa1[s4] = *(const f32x4*)(SC + (((1 * 2 + hi) * 8 + s4) * 32 + li) * 4); }
#pragma unroll
    for (int s4 = 0; s4 < 8; ++s4) {
#pragma unroll
        for (int e = 0; e < 4; ++e) { acc[0] = __builtin_amdgcn_mfma_f32_32x32x2f32(sa0[s4][e], eb[s4][e], acc[0], 0, 0, 0); acc[1] = __builtin_amdgcn_mfma_f32_32x32x2f32(sa1[s4][e], eb[s4][e], acc[1], 0, 0, 0); }
    }
    float s1 = 0.f;
#pragma unroll
    for (int ti = 0; ti < 2; ++ti)
#pragma unroll
        for (int r = 0; r < 16; ++r) s1 += acc[ti][r];
    s1 = xhalf_sum(s1); const float mean = s1 * (1.f / 64.f);
    float s2 = 0.f;
#pragma unroll
    for (int ti = 0; ti < 2; ++ti)
#pragma unroll
        for (int r = 0; r < 16; ++r) { const float d = acc[ti][r] - mean; s2 += d * d; }
    s2 = xhalf_sum(s2); const float rstd = 1.f / sqrtf(s2 * (1.f / 64.f) + 64e-5f);
    if (t >= si.ntok) return;
    const float bon = ((const float*)(p->ws + WS_BONUS))[(size_t)unit * 64 + t];
    const size_t row = (size_t)(si.row0 + t);
    bf16_t* oc = (bf16_t*)(p->ws + WS_OCAT) + (size_t)2 * NTOK * 512 + row * 512 + h * 64;
    u32x2 wout[2][4];
#pragma unroll
    for (int ti = 0; ti < 2; ++ti)
#pragma unroll
        for (int rg = 0; rg < 4; ++rg) { const int i = 32 * ti + 8 * rg + 4 * hi, c = h * 64 + i;
            const f32x4 gg = *(const f32x4*)(p->in[I_GNG] + l * 512 + c), gb = *(const f32x4*)(p->in[I_GNB] + l * 512 + c), mu = *(const f32x4*)(p->in[I_MU] + l * SHIFT_W + 1024 + c);
            const u32x2 vx = *(const u32x2*)(U + row * NU + U_XC + 1024 + c); const u32x2 sg = *(const u32x2*)(U + row * NU + U_CSG + c);
            f32x4 vc = (f32x4){bflo(vx.x), bfhi(vx.x), bflo(vx.y), bfhi(vx.y)}, vp;
            {
                const u32x2 px = *(const u32x2*)(U + (row > 0 ? row - 1 : 0) * NU + U_XC + 1024 + c); const f32x4 ss = *(const f32x4*)(p->in[I_SSHIFT] + ((size_t)l * 32 + si.b) * SHIFT_W + 1024 + c);
                const f32x4 up = (f32x4){bflo(px.x), bfhi(px.x), bflo(px.y), bfhi(px.y)};
                vp = (t > 0 || si.prev_kind == 1) ? up : (si.prev_kind == 2 ? ss : (f32x4){0.f, 0.f, 0.f, 0.f}); }
            const f32x4 vs = vc + (vp - vc) * mu;
            const f32x4 sgf = (f32x4){bflo(sg.x), bfhi(sg.x), bflo(sg.y), bfhi(sg.y)};
            f32x4 o;
#pragma unroll
            for (int e = 0; e < 4; ++e) o[e] = (((acc[ti][rg * 4 + e] - mean) * rstd) * gg[e] + gb[e] + bon * vs[e]) * siluf_(sgf[e]);
            wout[ti][rg].x = cvt_pk_bf16(o[0], o[1]); wout[ti][rg].y = cvt_pk_bf16(o[2], o[3]); }
#pragma unroll
    for (int ti = 0; ti < 2; ++ti)
#pragma unroll
        for (int rg = 0; rg < 4; ++rg) *(u32x2*)(oc + 32 * ti + 8 * rg + 4 * hi) = wout[ti][rg];
}
__device__ __forceinline__ int krow(int i) { return (i & 3) + 4 * ((i >> 3) & 1) + 8 * ((i >> 2) & 1) + 16 * (i >> 4); }
__device__ __forceinline__ bf16x8 pack8(const f32x16& v, int o) { u32x4 w; w.x = cvt_pk_bf16(v[o], v[o + 1]); w.y = cvt_pk_bf16(v[o + 2], v[o + 3]); w.z = cvt_pk_bf16(v[o + 4], v[o + 5]); w.w = cvt_pk_bf16(v[o + 6], v[o + 7]); return __builtin_bit_cast(bf16x8, w); }
constexpr float ATT_NEG = -1e30f;
template <bool HALF>
__device__ __forceinline__ void softmax_tile(f32x16& p0, f32x16& p1, float& m, float& lsum, f32x16 (&O)[2], bf16x8 (&pb)[4]) {
    float mx = p0[0];
#pragma unroll
    for (int r = 1; r < 16; ++r) mx = fmaxf(mx, p0[r]);
    if (!HALF) {
#pragma unroll
        for (int r = 0; r < 16; ++r) mx = fmaxf(mx, p1[r]); }
    mx = xhalf_max(mx);
    const float mn = fmaxf(m, mx), alpha = __builtin_amdgcn_exp2f(m - mn);
    m = mn;
    float s = 0.f;
#pragma unroll
    for (int r = 0; r < 16; ++r) { p0[r] = __builtin_amdgcn_exp2f(p0[r] - mn); s += p0[r]; }
    if (!HALF) {
#pragma unroll
        for (int r = 0; r < 16; ++r) { p1[r] = __builtin_amdgcn_exp2f(p1[r] - mn); s += p1[r]; } }
    lsum = lsum * alpha + s;
#pragma unroll
    for (int r = 0; r < 16; ++r) { O[0][r] *= alpha; O[1][r] *= alpha; }
    pb[0] = pack8(p0, 0); pb[1] = pack8(p0, 8);
    if (!HALF) { pb[2] = pack8(p1, 0); pb[3] = pack8(p1, 8); }
}
constexpr int AKS = 72;
constexpr int ATT_KB = 0, ATT_VB = 2 * 64 * AKS * 2, ATT_FB = 4 * 64 * AKS * 2, ATT_SC = ATT_FB + 2 * 64 * 4;
__device__ __forceinline__ void attn_prompt_unit(KP p, int l, int h, int qb, LAS unsigned char* lds, int tid) {
    const bf16_t* U = (const bf16_t*)(p->ws + WS_U); const bf16_t* Vt = (const bf16_t*)(p->ws + WS_VT) + (size_t)h * 64 * TP; const float* F = (const float*)(p->ws + WS_FP) + (size_t)h * TP;
    const int wave = tid >> 6, lane = tid & 63, li = lane & 31, hi = lane >> 5;
    const int q0 = qb * 256, q = q0 + wave * 32 + li;
    bf16x8 qf[4];
    { const float sc = 0.125f * LOG2E;
#pragma unroll
      for (int d0 = 0; d0 < 4; ++d0) { const u32x4 w = *(const u32x4*)(U + (size_t)q * NU + U_Q + h * 64 + 16 * d0 + 8 * hi);
          qf[d0] = pack8f((f32x4){bflo(w.x) * sc, bfhi(w.x) * sc, bflo(w.y) * sc, bfhi(w.y) * sc}, (f32x4){bflo(w.z) * sc, bfhi(w.z) * sc, bflo(w.w) * sc, bfhi(w.w) * sc}); } }
    const float fq = F[q];
    float m = ATT_NEG, lsum = 0.f; f32x16 O[2] = {};
    const int NT = (q0 + 256) / 64;
    LAS float* qmx = (LAS float*)(lds + ATT_SC); LAS float* mmv = qmx + 8;
    { float q2 = 0.f;
#pragma unroll
      for (int d0 = 0; d0 < 4; ++d0) { const u32x4 w = __builtin_bit_cast(u32x4, qf[d0]); q2 += bflo(w.x) * bflo(w.x) + bfhi(w.x) * bfhi(w.x) + bflo(w.y) * bflo(w.y) + bfhi(w.y) * bfhi(w.y) + bflo(w.z) * bflo(w.z) + bfhi(w.z) * bfhi(w.z) + bflo(w.w) * bflo(w.w) + bfhi(w.w) * bfhi(w.w); }
      q2 = wave_max(xhalf_sum(q2)); if (lane == 0) { qmx[wave] = q2; mmv[wave] = ATT_NEG; } }
    const float kmax2 = __uint_as_float(((const unsigned*)(p->ws + WS_CTL))[CW_KMAX + l * 8 + h]), fq0 = F[q0];
    const int srow = tid >> 3, sch = tid & 7;
    const bf16_t* kg = U + (size_t)srow * NU + U_K + h * 64 + 8 * sch; const bf16_t* vg = Vt + (size_t)srow * TP + 8 * sch;
    LAS unsigned char* kdst = lds + ATT_KB + (srow * AKS + 8 * sch) * 2; LAS unsigned char* vdst = lds + ATT_VB + (srow * AKS + 8 * sch) * 2;
    u32x4 kr = *(const u32x4*)(kg + (size_t)(NT - 1) * 64 * NU), vr = *(const u32x4*)(vg + (NT - 1) * 64); float fr = tid < 64 ? F[(NT - 1) * 64 + tid] : 0.f;
    *(LAS u32x4*)kdst = kr; *(LAS u32x4*)vdst = vr; if (tid < 64) ((LAS float*)(lds + ATT_FB))[tid] = fr;
    __syncthreads();
    const int ka = krow(li);
    float qkb; { float q2 = qmx[0];
#pragma unroll
      for (int w = 1; w < 8; ++w) q2 = fmaxf(q2, qmx[w]);
      qkb = 1.02f * sqrtf(q2 * kmax2) + fq0; }
    for (int t = NT - 1, buf = 0; t >= 0; --t, buf ^= 1) {
        { float mmin = mmv[0];
#pragma unroll
          for (int w = 1; w < 8; ++w) mmin = fminf(mmin, mmv[w]);
          if (qkb - ((const LAS float*)(lds + ATT_FB))[buf * 64 + 63] < mmin - 40.f) break; }
        if (t > 0) { kr = *(const u32x4*)(kg + (size_t)(t - 1) * 64 * NU); vr = *(const u32x4*)(vg + (t - 1) * 64); if (tid < 64) fr = F[(t - 1) * 64 + tid]; }
        if (64 * t <= q0 + wave * 32 + 31) {
            const LAS bf16_t* Kb = (const LAS bf16_t*)(lds + ATT_KB) + buf * 64 * AKS; const LAS bf16_t* Vb = (const LAS bf16_t*)(lds + ATT_VB) + buf * 64 * AKS; const LAS float* Fb = (const LAS float*)(lds + ATT_FB) + buf * 64;
            f32x16 p0, p1;
#pragma unroll
            for (int g2 = 0; g2 < 2; ++g2) { const f32x4 a = *(const LAS f32x4*)(Fb + 8 * hi + 16 * g2), b = *(const LAS f32x4*)(Fb + 8 * hi + 16 * g2 + 4), c = *(const LAS f32x4*)(Fb + 32 + 8 * hi + 16 * g2), d = *(const LAS f32x4*)(Fb + 32 + 8 * hi + 16 * g2 + 4);
#pragma unroll
                for (int e = 0; e < 4; ++e) { p0[8 * g2 + e] = fq - a[e]; p0[8 * g2 + 4 + e] = fq - b[e]; p1[8 * g2 + e] = fq - c[e]; p1[8 * g2 + 4 + e] = fq - d[e]; } }
#pragma unroll
            for (int d0 = 0; d0 < 4; ++d0) { const bf16x8 a0 = *(const LAS bf16x8*)(Kb + ka * AKS + 16 * d0 + 8 * hi), a1 = *(const LAS bf16x8*)(Kb + (ka + 32) * AKS + 16 * d0 + 8 * hi);
                p0 = __builtin_amdgcn_mfma_f32_32x32x16_bf16(a0, qf[d0], p0, 0, 0, 0); p1 = __builtin_amdgcn_mfma_f32_32x32x16_bf16(a1, qf[d0], p1, 0, 0, 0); }
            if (64 * t + 63 > q0 + wave * 32) {
#pragma unroll
                for (int r = 0; r < 16; ++r) { const int kv = 64 * t + 8 * hi + 16 * (r >> 3) + (r & 7); if (kv > q) p0[r] = -INFINITY; if (kv + 32 > q) p1[r] = -INFINITY; } }
            bf16x8 pb[4];
            softmax_tile<false>(p0, p1, m, lsum, O, pb);
#pragma unroll
            for (int dt = 0; dt < 2; ++dt)
#pragma unroll
                for (int s = 0; s < 4; ++s) { const bf16x8 a = *(const LAS bf16x8*)(Vb + (32 * dt + li) * AKS + 16 * (s & 1) + 32 * (s >> 1) + 8 * hi);
                    O[dt] = __builtin_amdgcn_mfma_f32_32x32x16_bf16(a, pb[s], O[dt], 0, 0, 0); }
        }
        { const float wm = wave_min(m); if (lane == 0) mmv[wave] = wm; }
        if (t > 0) { const int nb = buf ^ 1; *(LAS u32x4*)(kdst + nb * 64 * AKS * 2) = kr; *(LAS u32x4*)(vdst + nb * 64 * AKS * 2) = vr; if (tid < 64) ((LAS float*)(lds + ATT_FB))[nb * 64 + tid] = fr; }
        __syncthreads();
    }
    __syncthreads();
    const float inv = 1.f / xhalf_sum(lsum);
    bf16_t* ob = (bf16_t*)(p->ws + WS_OCAT) + (size_t)1 * NTOK * 512 + (size_t)q * 512 + h * 64;
    u32x2 sgv[2][4];
#pragma unroll
    for (int dt = 0; dt < 2; ++dt)
#pragma unroll
        for (int rg = 0; rg < 4; ++rg) sgv[dt][rg] = *(const u32x2*)(U + (size_t)q * NU + U_BSG + h * 64 + 32 * dt + 8 * rg + 4 * hi);
#pragma unroll
    for (int dt = 0; dt < 2; ++dt)
#pragma unroll
        for (int rg = 0; rg < 4; ++rg) { const int d = 32 * dt + 8 * rg + 4 * hi; const u32x2 sg = sgv[dt][rg];
            u32x2 w; w.x = cvt_pk_bf16(O[dt][rg * 4] * inv * siluf_(bflo(sg.x)), O[dt][rg * 4 + 1] * inv * siluf_(bfhi(sg.x))); w.y = cvt_pk_bf16(O[dt][rg * 4 + 2] * inv * siluf_(bflo(sg.y)), O[dt][rg * 4 + 3] * inv * siluf_(bfhi(sg.y)));
            *(u32x2*)(ob + d) = w; }
}
__device__ __forceinline__ void attn_sample_unit(KP p, int l, int b, int h, LAS unsigned char* lds, int tid) {
    const bf16_t* U = (const bf16_t*)(p->ws + WS_U);
    const int wave = tid >> 6, lane = tid & 63, li = lane & 31, hi = lane >> 5;
    const size_t qrow = (size_t)TP + b * 32 + li;
    const float* G = (const float*)(p->ws + WS_GS) + ((size_t)b * 8 + h) * GS_LEN;
    bf16x8 qf[4];
    { const float sc = 0.125f * LOG2E;
#pragma unroll
      for (int d0 = 0; d0 < 4; ++d0) { const u32x4 w = *(const u32x4*)(U + qrow * NU + U_Q + h * 64 + 16 * d0 + 8 * hi);
          qf[d0] = pack8f((f32x4){bflo(w.x) * sc, bfhi(w.x) * sc, bflo(w.y) * sc, bfhi(w.y) * sc}, (f32x4){bflo(w.z) * sc, bfhi(w.z) * sc, bflo(w.w) * sc, bfhi(w.w) * sc}); } }
    const float fq = G[PAST + li];
    float m = ATT_NEG, lsum = 0.f; f32x16 O[2] = {};
    const float* CK = p->in[I_CK] + (((size_t)l * 32 + b) * PAST) * 512 + h * 64; const float* CV = p->in[I_CV] + (((size_t)l * 32 + b) * PAST) * 512 + h * 64;
    const int ka = krow(li);
    float kmax2;
    { float mx = 0.f; const f32x4* kp4 = (const f32x4*)CK + (tid & 15);
#pragma unroll 1
      for (int it = 0; it < 8; ++it) { f32x4 kv[16];
#pragma unroll
          for (int j = 0; j < 16; ++j) kv[j] = kp4[(size_t)((it * 16 + j) * 32 + (tid >> 4)) * 128];
#pragma unroll
          for (int j = 0; j < 16; ++j) { float s = kv[j][0] * kv[j][0] + kv[j][1] * kv[j][1] + kv[j][2] * kv[j][2] + kv[j][3] * kv[j][3];
              s += dpp_mov<0xB1>(s); s += dpp_mov<0x4E>(s); s += dpp_mov<0x141>(s); s += dpp_mov<0x140>(s); mx = fmaxf(mx, s); } }
      mx = wave_max(mx); LAS float* kml = (LAS float*)lds;
      if (lane == 0) kml[wave] = mx;
      __syncthreads();
      kmax2 = kml[0];
#pragma unroll
      for (int w = 1; w < 8; ++w) kmax2 = fmaxf(kmax2, kml[w]);
      __syncthreads(); }
    float qkb;
    { float q2 = 0.f;
#pragma unroll
      for (int d0 = 0; d0 < 4; ++d0) { const u32x4 w = __builtin_bit_cast(u32x4, qf[d0]); q2 += bflo(w.x) * bflo(w.x) + bfhi(w.x) * bfhi(w.x) + bflo(w.y) * bflo(w.y) + bfhi(w.y) * bfhi(w.y) + bflo(w.z) * bflo(w.z) + bfhi(w.z) * bfhi(w.z) + bflo(w.w) * bflo(w.w) + bfhi(w.w) * bfhi(w.w); }
      q2 = wave_max(xhalf_sum(q2)); qkb = 1.02f * sqrtf(q2 * kmax2) + G[PAST]; }
    {
        f32x16 p0, p1 = {};
#pragma unroll
        for (int g2 = 0; g2 < 2; ++g2) { const float* gp = G + PAST + 8 * hi + 16 * g2; const f32x4 a = *(const f32x4*)gp, bq = *(const f32x4*)(gp + 4);
#pragma unroll
            for (int e = 0; e < 4; ++e) { p0[8 * g2 + e] = fq - a[e]; p0[8 * g2 + 4 + e] = fq - bq[e]; } }
#pragma unroll
        for (int d0 = 0; d0 < 4; ++d0) { const bf16x8 a0 = *(const bf16x8*)(U + ((size_t)TP + b * 32 + ka) * NU + U_K + h * 64 + 16 * d0 + 8 * hi);
            p0 = __builtin_amdgcn_mfma_f32_32x32x16_bf16(a0, qf[d0], p0, 0, 0, 0); }
#pragma unroll
        for (int r = 0; r < 16; ++r) { const int kv = 8 * hi + 16 * (r >> 3) + (r & 7); if (kv > li) p0[r] = -INFINITY; }
        bf16x8 pb[4];
        softmax_tile<true>(p0, p1, m, lsum, O, pb);
        if (wave == 7) {
#pragma unroll
            for (int dt = 0; dt < 2; ++dt)
#pragma unroll
                for (int s = 0; s < 2; ++s) { const bf16_t* vp = U + ((size_t)TP + b * 32 + 16 * s + 8 * hi) * NU + U_V + h * 64 + 32 * dt + li; u32x4 w;
                    w.x = (unsigned)vp[0] | ((unsigned)vp[NU] << 16); w.y = (unsigned)vp[2 * NU] | ((unsigned)vp[3 * NU] << 16); w.z = (unsigned)vp[4 * NU] | ((unsigned)vp[5 * NU] << 16); w.w = (unsigned)vp[6 * NU] | ((unsigned)vp[7 * NU] << 16);
                    O[dt] = __builtin_amdgcn_mfma_f32_32x32x16_bf16(__builtin_bit_cast(bf16x8, w), pb[s], O[dt], 0, 0, 0); } }
        else lsum = 0.f;
    }
    const float mmin = wave_min(m);
    for (int tt = 0; tt < 8; ++tt) {
        const int key0 = (63 - wave - 8 * tt) * 64;
        if (qkb - G[key0 + 63] < mmin - 40.f) break;
        f32x16 p0, p1;
#pragma unroll
        for (int g2 = 0; g2 < 2; ++g2) { const float* gp = G + key0 + 8 * hi + 16 * g2; const f32x4 a = *(const f32x4*)gp, bq = *(const f32x4*)(gp + 4), c = *(const f32x4*)(gp + 32), d = *(const f32x4*)(gp + 36);
#pragma unroll
            for (int e = 0; e < 4; ++e) { p0[8 * g2 + e] = fq - a[e]; p0[8 * g2 + 4 + e] = fq - bq[e]; p1[8 * g2 + e] = fq - c[e]; p1[8 * g2 + 4 + e] = fq - d[e]; } }
#pragma unroll
        for (int d0 = 0; d0 < 4; ++d0) { const float* k0p = CK + (size_t)(key0 + ka) * 512 + 16 * d0 + 8 * hi; const float* k1p = k0p + (size_t)32 * 512;
            const bf16x8 a0 = pack8f(*(const f32x4*)k0p, *(const f32x4*)(k0p + 4)), a1 = pack8f(*(const f32x4*)k1p, *(const f32x4*)(k1p + 4));
            p0 = __builtin_amdgcn_mfma_f32_32x32x16_bf16(a0, qf[d0], p0, 0, 0, 0); p1 = __builtin_amdgcn_mfma_f32_32x32x16_bf16(a1, qf[d0], p1, 0, 0, 0); }
        bf16x8 pb[4];
        softmax_tile<false>(p0, p1, m, lsum, O, pb);
#pragma unroll
        for (int dt = 0; dt < 2; ++dt)
#pragma unroll
            for (int s = 0; s < 4; ++s) { const float* vp = CV + (size_t)(key0 + 16 * (s & 1) + 32 * (s >> 1) + 8 * hi) * 512 + 32 * dt + li;
                const bf16x8 a = pack8f((f32x4){vp[0], vp[512], vp[1024], vp[1536]}, (f32x4){vp[2048], vp[2560], vp[3072], vp[3584]});
                O[dt] = __builtin_amdgcn_mfma_f32_32x32x16_bf16(a, pb[s], O[dt], 0, 0, 0); }
    }
    LAS float* Ow = (LAS float*)lds;
    LAS float* ML = Ow + 8 * 32 * 64;
    lsum = xhalf_sum(lsum);
#pragma unroll
    for (int dt = 0; dt < 2; ++dt)
#pragma unroll
        for (int r = 0; r < 16; ++r) Ow[(wave * 32 + dt * 16 + r) * 64 + lane] = O[dt][r];
    if (hi == 0) { ML[(wave * 2) * 32 + li] = m; ML[(wave * 2 + 1) * 32 + li] = lsum; }
    __syncthreads();
    { const int qq = tid & 31, dg = tid >> 5; float M = ATT_NEG;
#pragma unroll
      for (int w = 0; w < 8; ++w) M = fmaxf(M, ML[(w * 2) * 32 + qq]);
      float L = 0.f; f32x4 o = {0.f, 0.f, 0.f, 0.f};
      const int d = 4 * dg, idx0 = (d >> 5) * 16 + ((d >> 3) & 3) * 4, ln = ((d >> 2) & 1) * 32 + qq;
#pragma unroll
      for (int w = 0; w < 8; ++w) { const float f = __builtin_amdgcn_exp2f(ML[(w * 2) * 32 + qq] - M); L += ML[(w * 2 + 1) * 32 + qq] * f;
#pragma unroll
          for (int e = 0; e < 4; ++e) o[e] += Ow[(w * 32 + idx0 + e) * 64 + ln] * f; }
      const float inv = 1.f / L; const size_t row = (size_t)TP + b * 32 + qq;
      const u32x2 sg = *(const u32x2*)(U + row * NU + U_BSG + h * 64 + d);
      u32x2 wv; wv.x = cvt_pk_bf16(o[0] * inv * siluf_(bflo(sg.x)), o[1] * inv * siluf_(bfhi(sg.x))); wv.y = cvt_pk_bf16(o[2] * inv * siluf_(bflo(sg.y)), o[3] * inv * siluf_(bfhi(sg.y)));
      *(u32x2*)((bf16_t*)(p->ws + WS_OCAT) + (size_t)1 * NTOK * 512 + row * 512 + h * 64 + d) = wv; }
    __syncthreads();
}
__device__ __forceinline__ bool xb_lane0() { unsigned ones_ = ~0u; asm volatile("" : "+s"(ones_)); return __builtin_amdgcn_mbcnt_hi(ones_, __builtin_amdgcn_mbcnt_lo(ones_, 0u)) == 0u; }
constexpr int NPHASE = 20;
__global__ void __launch_bounds__(512, 2) hse_fwd(Params p_) {
    const KP kp = (KP)__builtin_amdgcn_kernarg_segment_ptr();
    (void)p_;
    extern __shared__ __attribute__((aligned(16))) unsigned char lds_raw[];
    LAS unsigned char* lds = (LAS unsigned char*)lds_raw;
    const int tid0 = threadIdx.x;
    const int wave0 = __builtin_amdgcn_readfirstlane(tid0 >> 6);
    const int G = gridDim.x, bid = blockIdx.x, ngw = G * 8;
#define PH_LOCALS const KP p = kp_fresh(kp); unsigned ones_ = ~0u; asm volatile("" : "+s"(ones_)); int tid = wave0 * 64 + (int)__builtin_amdgcn_mbcnt_hi(ones_, __builtin_amdgcn_mbcnt_lo(ones_, 0u)); asm volatile("" : "+v"(tid)); const int lane = tid & 63, wave = __builtin_amdgcn_readfirstlane(tid >> 6), gw = bid * 8 + wave; (void)lane; (void)gw; (void)p;
    if (tid0 < 4) ((LAS unsigned*)(lds + LDS_XB_OFF))[tid0] = 0u;
#if PROBE_ID
    if (tid0 == 0) *(LAS unsigned long long*)(lds + LDS_PROBE_OFF) = 0ull;
#endif
    __syncthreads();
    unsigned* ctl = (unsigned*)(kp->ws + WS_CTL);
    XcdBarrier bar = xcd_barrier_post(ctl + CW_BAR + kp->li * XCD_BAR_WORDS, (volatile LAS unsigned*)(lds + LDS_XB_OFF));
    const int lo = kp->ph_lo, hi = kp->ph_hi;
#define IN(k) (lo <= (k) && (k) < hi)
#ifndef DUP_MASK
#define DUP_MASK 0
#endif
#define NREP(k) (((DUP_MASK >> (k)) & 1) + 1)
#define XB_T0 (wave0 == 0 && xb_lane0())
#define SEAM(k) do { if (IN(k) && IN((k) + 1)) xcd_barrier(bar, XB_T0); } while (0)
    PT0();
    if (IN(0)) { PH_LOCALS
        for (int u = bid; u < 192; u += G) ada_unit(p, u, lds, tid);
        p0_weights(p, lds, gw, ngw, wave, lane);
    }
    SEAM(0);
    PT1(9);
    for (int l = 0; l < NLAYER; ++l) {
        const int pb = 1 + 9 * l;
        for (int rep = 0; rep < NREP(0); ++rep) { if (rep) xcd_barrier(bar, XB_T0);
        if (IN(pb)) { PH_LOCALS p1_rows(p, l, gw, ngw, lane); } }
        SEAM(pb);
        PT1(10);
        for (int rep = 0; rep < NREP(1); ++rep) { if (rep) xcd_barrier(bar, XB_T0);
        if (IN(pb + 1)) { PH_LOCALS
            pg8::Gemm g{(const bf16_t*)(p->ws + WS_H), (const bf16_t*)(p->ws + WS_WIN) + (size_t)l * NU * 2048, NTOK, NU, 2048, 2048};
            pg8::StaticOrder S; S.init(NTOK, NU, G, bid);
            EpiU E{(bf16_t*)(p->ws + WS_U), p->out, p->in[I_BF], l};
            pg8::gemm_phase<EpiU, pg8::StaticOrder>(lds, g, S, E, nullptr, tid);
        }
        }
        SEAM(pb + 1);
        PT1(11);
        for (int rep = 0; rep < NREP(2); ++rep) { if (rep) xcd_barrier(bar, XB_T0);
        if (IN(pb + 2)) { PH_LOCALS
#ifndef DUP_SUB
#define DUP_SUB 0
#endif
            { PT0();
            { PH_LOCALS for (int u = bid; u < NRU * ((DUP_SUB & 1) + 1); u += G) rwkv_r1(p, l, u % NRU, u + G, lds, tid); }
            PT1(31);
            for (int u = (bid + G - 32) % G; u < 544 * (((DUP_SUB >> 1) & 1) + 1); u += G) conv_unit(p, l, u % 544, lds, tid);
            PT1(32);
            for (int u = (bid + G - 64) % G; u < 544 * (((DUP_SUB >> 2) & 1) + 1); u += G) pool_unit(p, l, u % 544, lds, tid);
            PT1(33);
            for (int u = bid; u < 256; u += G) { vt_tile(p, l, u * 8 + wave, lds, wave, lane); }
            __syncthreads();
            for (int u = (bid + G - 96) % G; u < 32; u += G) gs_unit(p, l, u, lds, tid);
            for (int u = G - 1 - bid; u < 8; u += G) fp_unit(p, l, u, lds, tid);
            if (bid == G / 2) shift_out(p, l, tid);
            PT1(34); }
        }
        }
        SEAM(pb + 2);
        PT1(12);
        for (int rep = 0; rep < NREP(3); ++rep) { if (rep) xcd_barrier(bar, XB_T0);
        if (IN(pb + 3)) { PH_LOCALS
            for (int tk = bid; tk < 256; tk += G) rwkv_l1_block(p, tk, lds, wave, lane);
            LAS int* qslot = (LAS int*)(lds + LDS_XB_OFF - 16);
            for (;;) {
                if (tid == 0) *qslot = (int)atomicAdd(ctl + CW_QUEUE + 64 * (2 * l + 4 * rep), 1u);
                __syncthreads();
                const int item = *qslot;
                __syncthreads();
                if (item >= 512) break;
                attn_prompt_unit(p, l, item & 7, 63 - (item >> 3), lds, tid);
            }
            for (;;) {
                if (tid == 0) *qslot = (int)atomicAdd(ctl + CW_QUEUE + 64 * (2 * l + 1 + 4 * rep), 1u);
                __syncthreads();
                const int item = *qslot;
                __syncthreads();
                if (item >= 256) break;
                attn_sample_unit(p, l, item >> 3, item & 7, lds, tid);
            }
        }
        }
        SEAM(pb + 3);
        PT1(13);
        if (IN(pb + 4)) { PH_LOCALS
            for (int tk = bid; tk < 128; tk += G) rwkv_l3_block(p, l, 127 - tk, lds, wave, lane);
            for (int tk = ((bid + G - 128) % G) * 8 + wave; tk < 1024; tk += ngw) rwkv_samp_task(p, l, tk, lane);
        }
        SEAM(pb + 4);
        PT1(14);
        if (IN(pb + 5)) { PH_LOCALS for (int tk = gw; tk < NRU * 2; tk += ngw) rwkv_r3_task(p, l, tk, lane); }
        SEAM(pb + 5);
        PT1(15);
        for (int rep = 0; rep < NREP(6); ++rep) { if (rep) xcd_barrier(bar, XB_T0);
        if (IN(pb + 6)) { PH_LOCALS
            pg8::Gemm g{(const bf16_t*)(p->ws + WS_OCAT), (const bf16_t*)(p->ws + WS_WBR) + (size_t)l * 4 * 2048 * 512, 4 * NTOK, 4 * 2048, 512, 512};
            BranchOrder S{G, (G % 8 == 0) ? (bid % 8) * (G / 8) + bid / 8 : bid};
            EpiZ E{(bf16_t*)(p->ws + WS_Z), (const bf16_t*)(p->ws + WS_U)};
            pg8::gemm_phase<EpiZ, BranchOrder>(lds, g, S, E, nullptr, tid);
        }
        }
        SEAM(pb + 6);
        PT1(16);
        if (IN(pb + 7)) { PH_LOCALS merge_pass(p, l, bid * 512 + tid, G * 512); }
        SEAM(pb + 7);
        PT1(17);
        if (IN(pb + 8)) { PH_LOCALS
            {
                pg8::Gemm g{(const bf16_t*)(p->ws + WS_MERGED), (const bf16_t*)(p->ws + WS_WOUT) + (size_t)l * 2048 * 2048, TP, 2048, 2048, 2048};
                pg8::StaticOrder S; S.init(TP, 2048, G, bid);
                EpiOut E{p->in[I_XP], p->in[I_XS], (const float*)(p->ws + WS_XBUF), (const float*)(p->ws + WS_ADA), (float*)(p->ws + WS_XBUF), l};
                pg8::gemm_phase<EpiOut, pg8::StaticOrder>(lds, g, S, E, nullptr, tid); }
            {
                const int tile = bid >> 3, ks = bid & 7;
                pg8::Gemm g{(const bf16_t*)(p->ws + WS_MERGED) + ks * 256, (const bf16_t*)(p->ws + WS_WOUT) + (size_t)l * 2048 * 2048 + ks * 256, NTOK, 2048, 256, 2048};
                OneUnit S{64 + (tile >> 3), tile & 7, bid < 256};
                EpiOutPart E{(const float*)(p->ws + WS_ADA), (float*)(p->ws + WS_XPART) + ((size_t)(l * 8 + ks) * 1024) * DM, l};
                pg8::gemm_phase<EpiOutPart, OneUnit>(lds, g, S, E, nullptr, tid); }
        }
        SEAM(pb + 8);
        PT1(18);
    }
    if (IN(19)) { PH_LOCALS p_final_rows(p, gw, ngw, lane); }
    PT1(20);
#if PROBE_ID
    if (bid == 0 && tid0 == 0) { const unsigned long long w = *(LAS unsigned long long*)(lds + LDS_PROBE_OFF) * PROBE_K, t0 = __builtin_amdgcn_s_memrealtime(); while (__builtin_amdgcn_s_memrealtime() - t0 < w) __builtin_amdgcn_s_sleep(8); }
#endif
#undef IN
#undef SEAM
}
#ifndef MK_SPLIT
#define MK_SPLIT 0
#endif
extern "C" void kernel_launch(void* const* d_in, const int* in_sizes, int n_in, void* d_out, int out_size, void* d_ws, size_t ws_size, hipStream_t stream) {
    static int grid = 0;
    if (grid == 0) {
        if (n_in != N_IN || (size_t)out_size != O_END || ws_size < WS_END) { fprintf(stderr, "kernel_launch: unexpected shapes (n_in %d, out %d, ws %zu)\n", n_in, out_size, ws_size); grid = -1; return; }
        int dev = 0, cus = 0, per_cu = 0;
        if (hipGetDevice(&dev) != hipSuccess || hipDeviceGetAttribute(&cus, hipDeviceAttributeMultiprocessorCount, dev) != hipSuccess) { grid = -1; return; }
        if (hipFuncSetAttribute((const void*)hse_fwd, hipFuncAttributeMaxDynamicSharedMemorySize, LDS_BYTES) != hipSuccess) { fprintf(stderr, "kernel_launch: hipFuncSetAttribute failed\n"); grid = -1; return; }
        if (hipOccupancyMaxActiveBlocksPerMultiprocessor(&per_cu, (const void*)hse_fwd, 512, LDS_BYTES) != hipSuccess || per_cu < 1) fprintf(stderr, "kernel_launch: occupancy query reports %d\n", per_cu);
        (void)hipGetLastError();
        grid = cus;
    }
    if (grid < 0) return;
    if (hipMemsetAsync((char*)d_ws + WS_CTL, 0, CTL_BYTES, stream) != hipSuccess) return;
    Params a{};
    for (int i = 0; i < N_IN; ++i) a.in[i] = (const float*)d_in[i];
    a.out = (float*)d_out; a.ws = (unsigned char*)d_ws;
#if MK_SPLIT
    for (int ph = 0; ph < NPHASE; ++ph) { a.ph_lo = ph; a.ph_hi = ph + 1; a.li = ph; hipLaunchKernelGGL(hse_fwd, dim3(grid), dim3(512), LDS_BYTES, stream, a); }
#else
    a.ph_lo = 0; a.ph_hi = NPHASE; a.li = 0;
    hipLaunchKernelGGL(hse_fwd, dim3(grid), dim3(512), LDS_BYTES, stream, a);
#endif
    const hipError_t le = hipPeekAtLastError();
    if (le != hipSuccess) fprintf(stderr, "kernel_launch: launch failed: %s\n", hipGetErrorName(le));
}
```

```cpp
#include <hip/hip_runtime.h>
#include <cstdio>
#include <cstdint>
namespace pg8 {
#define PG8_LAS __attribute__((address_space(3)))
typedef unsigned short bf16_t;
typedef short bf16x8 __attribute__((ext_vector_type(8)));
typedef float f32x4 __attribute__((ext_vector_type(4)));
typedef unsigned u32x4 __attribute__((ext_vector_type(4)));
constexpr int BM = 256, BK = 64, HALF = 128, HTB = HALF * BK * 2  , STAGE_BYTES = 8 * HTB, NXCD = 8, WGM = 4;

__host__ __device__ __forceinline__ int lds_byte(int r, int c) { const int st = (r >> 4) * 2 + (c >> 5), rr = r & 15, cc = c & 31, ob = rr * 64 + cc * 2; return st * 1024 + (ob ^ (((ob >> 9) & 1) << 5)); }
__host__ __device__ __forceinline__ void stage_rc(int b, int& R, int& C) { const int st = b / 1024, sb = b % 1024, swz = sb ^ (((sb >> 9) & 1) << 5); R = (st >> 1) * 16 + swz / 64; C = (st & 1) * 32 + (swz % 64) / 2; }
__host__ __device__ __forceinline__ int perm32(int rho) { const int n = rho >> 4, i = rho & 15; return 8 * (i >> 2) + 4 * n + (i & 3); }

struct Unit { int pm, pn; };
struct Gemm { const bf16_t* A; const bf16_t* Bt; int M, N, K, ld; };

struct StaticOrder {
    int nM, nN, nwg, G, c;
    __host__ __device__ void init(int M, int N, int G_, int c_) { nM = M / BM; nN = N / BM; nwg = nM * nN; G = G_; c = c_; }
    __host__ __device__ bool next(int i, Unit& u) const {
        const long L = (long)i * G + c; if (L >= nwg) return false;
        int wgid = (int)L; { const int q = nwg / NXCD, r = nwg % NXCD, xcd = wgid % NXCD, off = wgid / NXCD; wgid = (xcd < r ? xcd * (q + 1) : r * (q + 1) + (xcd - r) * q) + off; }
        const int nig = WGM * nN, gid = wgid / nig, fm = gid * WGM, gsz = (nM - fm) < WGM ? (nM - fm) : WGM;
        u.pm = fm + ((wgid % nig) % gsz); u.pn = (wgid % nig) / gsz; return true;
    }
    __device__ __forceinline__ void a_ready(const Unit&) const {}
    __device__ __forceinline__ void done(const Unit&) const {}
};
__device__ __forceinline__ unsigned cvt_pk_bf16(float lo, float hi) { unsigned r; asm volatile("v_cvt_pk_bf16_f32 %0, %1, %2" : "=v"(r) : "v"(lo), "v"(hi)); return r; }
typedef float f32x2 __attribute__((ext_vector_type(2)));
template <class Epi, class Sched, bool STAMP = false>
__device__ __forceinline__ void gemm_phase(PG8_LAS unsigned char* lds, const Gemm g, const Sched& S, const Epi& E, unsigned long long* stamps, int tid_in) {
    int tid = tid_in; asm volatile("" : "+v"(tid));
    const int wid = __builtin_amdgcn_readfirstlane(tid >> 6), lane = tid & 63, wr = wid >> 2, wc = wid & 3, fr = lane & 15, fq = lane >> 4;
    const int K = g.ld, nt = g.K / BK;
    int ts_lo = 0, ts_hi = 0, nts = 0; const unsigned long long rt_entry = STAMP ? (unsigned long long)wall_clock64() : 0ull;
#define PG8_STAMP() do { if (STAMP && wid == 0 && nts < 64) { const unsigned long long _c = (unsigned long long)clock64(); \
        ts_lo = (lane == nts) ? (int)(unsigned)_c : ts_lo; ts_hi = (lane == nts) ? (int)(unsigned)(_c >> 32) : ts_hi; ++nts; } } while (0)
    PG8_STAMP();
    unsigned voffA[2], voffB[2];
#pragma unroll
    for (int i = 0; i < 2; ++i) { int R, C; stage_rc(tid * 16 + i * 8192, R, C); const int Rb = Epi::PERM ? ((R & ~31) + perm32(R & 31)) : R;
        voffA[i] = (unsigned)(R * K + C) * 2u; voffB[i] = (unsigned)(Rb * K + C) * 2u; }
    const size_t kstep = (size_t)(BK * 2);
    const size_t hstep = (size_t)HALF * K * 2;
    const size_t tstep = 2 * hstep;
    const unsigned ldsw = (unsigned)wid * 1024u;
    const int aoff = lds_byte(wr * 64 + fr, fq * 8), boff = lds_byte(wc * 32 + fr, fq * 8);
#define PG8_SA(b, h) (((b) * 2 + (h)) * HTB)
#define PG8_SB(b, h) ((4 + (b) * 2 + (h)) * HTB)
#define PG8_STAGE(bufoff, gbase, voff) do { _Pragma("unroll") for (int _i = 0; _i < 2; ++_i) \
        __builtin_amdgcn_global_load_lds((const unsigned*)((const char*)(gbase) + (voff)[_i]), (PG8_LAS unsigned*)(lds + (bufoff) + ldsw + _i * 8192), 16, 0, 0); } while (0)
#define PG8_LDA(dst, b, h) do { _Pragma("unroll") for (int m = 0; m < 4; ++m) _Pragma("unroll") for (int k = 0; k < 2; ++k) dst[m][k] = *(const PG8_LAS bf16x8*)(lds + PG8_SA(b, h) + aoff + m * 2048 + k * 1024); } while (0)
#define PG8_LDB(dst, b, h) do { _Pragma("unroll") for (int n = 0; n < 2; ++n) _Pragma("unroll") for (int k = 0; k < 2; ++k) dst[n][k] = *(const PG8_LAS bf16x8*)(lds + PG8_SB(b, h) + boff + n * 2048 + k * 1024); } while (0)
#define PG8_MMA(ai, bj, At, Bt) do { __builtin_amdgcn_s_setprio(1); _Pragma("unroll") for (int m = 0; m < 4; ++m) _Pragma("unroll") for (int n = 0; n < 2; ++n) _Pragma("unroll") for (int k = 0; k < 2; ++k) \
        acc[ai][bj][m][n] = __builtin_amdgcn_mfma_f32_16x16x32_bf16(Bt[n][k], At[m][k], acc[ai][bj][m][n], 0, 0, 0); __builtin_amdgcn_s_setprio(0); } while (0)
#define PG8_WAIT_V(n) asm volatile("s_waitcnt vmcnt(" #n ")" ::: "memory")
#define PG8_WAIT_L(n) asm volatile("s_waitcnt lgkmcnt(" #n ")" ::: "memory")
#define PG8_BAR __builtin_amdgcn_s_barrier()
#define PG8_SCHED __builtin_amdgcn_sched_barrier(0)
    Unit cur, nxt; int ui = 0;
    if (!S.next(0, cur)) return;
    f32x4 acc[2][2][4][2];
#pragma unroll
    for (int a = 0; a < 2; ++a)
#pragma unroll
        for (int b = 0; b < 2; ++b)
#pragma unroll
            for (int m = 0; m < 4; ++m)
#pragma unroll
                for (int n = 0; n < 2; ++n) acc[a][b][m][n] = (f32x4){0.f, 0.f, 0.f, 0.f};
    bf16x8 At[4][2], B0[2][2], B1[2][2];
    const char* cA = (const char*)g.A + (size_t)cur.pm * tstep; const char* cB = (const char*)g.Bt + (size_t)cur.pn * tstep;
    S.a_ready(cur);
    PG8_STAGE(PG8_SB(0, 0), cB, voffB); PG8_STAGE(PG8_SA(0, 0), cA, voffA); PG8_STAGE(PG8_SB(0, 1), cB + hstep, voffB); PG8_STAGE(PG8_SA(0, 1), cA + hstep, voffA);
    if (wr == 1) PG8_BAR;
    PG8_WAIT_V(4); PG8_BAR;
    PG8_STAGE(PG8_SB(1, 0), cB + kstep, voffB); PG8_STAGE(PG8_SA(1, 0), cA + kstep, voffA); PG8_STAGE(PG8_SB(1, 1), cB + hstep + kstep, voffB);
    PG8_WAIT_V(6); PG8_BAR;
    PG8_STAMP();
    for (;;) {
        const bool has_next = S.next(ui + 1, nxt);
        const char* nA = has_next ? (const char*)g.A + (size_t)nxt.pm * tstep : cA; const char* nB = has_next ? (const char*)g.Bt + (size_t)nxt.pn * tstep : cB;
        for (int t = 0; t < nt; t += 2) {
            const bool last = (t == nt - 2);
            const char* a1 = cA + (size_t)(t + 1) * kstep;
            const char* a2 = last ? nA : cA + (size_t)(t + 2) * kstep; const char* b2 = last ? nB : cB + (size_t)(t + 2) * kstep;
            const char* a3 = a2 + kstep; const char* b3 = b2 + kstep;
            if (last && has_next) S.a_ready(nxt);
            PG8_LDB(B0, 0, 0); PG8_SCHED; PG8_LDA(At, 0, 0); PG8_STAGE(PG8_SA(1, 1), a1 + hstep, voffA);
            PG8_WAIT_L(8); PG8_BAR; PG8_WAIT_L(0); PG8_MMA(0, 0, At, B0); PG8_BAR; PG8_SCHED;
            PG8_LDB(B1, 0, 1); PG8_STAGE(PG8_SB(0, 0), b2, voffB);
            PG8_BAR; PG8_WAIT_L(0); PG8_MMA(0, 1, At, B1); PG8_BAR;
            PG8_LDA(At, 0, 1); PG8_STAGE(PG8_SA(0, 0), a2, voffA);
            PG8_BAR; PG8_WAIT_L(0); PG8_MMA(1, 0, At, B0); PG8_BAR; PG8_SCHED;
            PG8_STAGE(PG8_SB(0, 1), b2 + hstep, voffB);
            PG8_WAIT_V(6); PG8_BAR; PG8_MMA(1, 1, At, B1); PG8_BAR;
            PG8_LDB(B0, 1, 0); PG8_SCHED; PG8_LDA(At, 1, 0); PG8_STAGE(PG8_SA(0, 1), a2 + hstep, voffA);
            PG8_WAIT_L(8); PG8_BAR; PG8_WAIT_L(0); PG8_MMA(0, 0, At, B0); PG8_BAR; PG8_SCHED;
            PG8_LDB(B1, 1, 1); PG8_STAGE(PG8_SB(1, 0), b3, voffB);
            PG8_BAR; PG8_WAIT_L(0); PG8_MMA(0, 1, At, B1); PG8_BAR;
            PG8_LDA(At, 1, 1); PG8_STAGE(PG8_SA(1, 0), a3, voffA);
            PG8_BAR; PG8_WAIT_L(0); PG8_MMA(1, 0, At, B0); PG8_BAR; PG8_SCHED;
            PG8_STAGE(PG8_SB(1, 1), b3 + hstep, voffB);
            PG8_WAIT_V(6); PG8_BAR; PG8_MMA(1, 1, At, B1); PG8_BAR;
        }
        PG8_STAMP();
        if constexpr (!Epi::AFTER_DRAIN) { E(acc, cur, wr, wc, fr, fq); S.done(cur); }
        PG8_STAMP();
        if (!has_next) break;
#pragma unroll
        for (int a = 0; a < 2; ++a)
#pragma unroll
            for (int b = 0; b < 2; ++b)
#pragma unroll
                for (int m = 0; m < 4; ++m)
#pragma unroll
                    for (int n = 0; n < 2; ++n) acc[a][b][m][n] = (f32x4){0.f, 0.f, 0.f, 0.f};
        cur = nxt; cA = nA; cB = nB; ++ui;
    }
    PG8_WAIT_V(0);
    if (wr == 0) PG8_BAR;
    PG8_BAR;
    if constexpr (Epi::AFTER_DRAIN) { E.fused(acc, cur, wr, wc, fr, fq, lds, wid, lane); S.done(cur); }
    PG8_STAMP();
    if (STAMP && wid == 0) { stamps[lane] = lane < nts ? (((unsigned long long)(unsigned)ts_hi << 32) | (unsigned)ts_lo) : 0ull;
        if (lane == 62) stamps[62] = rt_entry; if (lane == 63) stamps[63] = (unsigned long long)wall_clock64(); }
#undef PG8_STAMP
#undef PG8_SA
#undef PG8_SB
#undef PG8_STAGE
#undef PG8_LDA
#undef PG8_LDB
#undef PG8_MMA
#undef PG8_WAIT_V
#undef PG8_WAIT_L
#undef PG8_BAR
#undef PG8_SCHED
}
}
#define XB_TMO      128
#define XB_XCNT(j)  (256  + 64 * (j))
#define XB_XSUB(j)  (1280 + 64 * (j))
#define XB_XGEN(j)  (2304 + 64 * (j))
#define XB_TOP      3328
#define XB_TOPGEN   3392
#define XCD_BAR_WORDS 3456
#define XB_SPIN_CAP (1u << 18)
#define LAS __attribute__((address_space(3)))

__device__ __forceinline__ unsigned xb_ld(unsigned* p)              { return __hip_atomic_load(p, __ATOMIC_RELAXED, __HIP_MEMORY_SCOPE_AGENT); }
__device__ __forceinline__ unsigned xb_add(unsigned* p, unsigned v) { return __hip_atomic_fetch_add(p, v, __ATOMIC_RELAXED, __HIP_MEMORY_SCOPE_AGENT); }
__device__ __forceinline__ unsigned xb_xcc_id() { return (unsigned)__builtin_amdgcn_s_getreg((3 << 11) | 20) & 0xFu; }
#define XB_SPIN(cond, bar) do { unsigned _sp = 0; while (cond) { __builtin_amdgcn_s_sleep(1); \
    if ((++_sp & 255u) == 0u) { if (xb_ld(&(bar)[XB_TMO])) break; if (_sp > XB_SPIN_CAP) { atomicAdd(&(bar)[XB_TMO], 1u); break; } } } } while (0)

struct XcdBarrier {
    unsigned* bar; unsigned x;
    volatile LAS unsigned* st;
};

__device__ __forceinline__ XcdBarrier xcd_barrier_post(unsigned* bar, volatile LAS unsigned* st) {
    XcdBarrier b; b.bar = bar; b.x = xb_xcc_id(); b.st = st;
    if (threadIdx.x == 0) (void)xb_add(&bar[XB_XCNT(b.x)], 1u);
    return b;
}
__device__ __forceinline__ void xcd_barrier_complete(unsigned* bar, unsigned x, unsigned& nloc, unsigned& nx) {
    const unsigned G = gridDim.x * gridDim.y * gridDim.z;
    unsigned sum, cnt, mine, sp = 0u;
    for (;;) {
        sum = 0u; cnt = 0u; mine = 0u;
#pragma unroll
        for (unsigned j = 0; j < 16; ++j) { const unsigned c = xb_ld(&bar[XB_XCNT(j)]); sum += c; cnt += (c > 0u) ? 1u : 0u; mine = (j == x) ? c : mine; }
        if (sum == G) break;
        __builtin_amdgcn_s_sleep(1);
        if ((++sp & 255u) == 0u) { if (xb_ld(&bar[XB_TMO])) break; if (sp > XB_SPIN_CAP) { atomicAdd(&bar[XB_TMO], 1u); break; } }
    }
    nloc = mine > 0u ? mine : 1u; nx = cnt > 0u ? cnt : 1u;
}

__device__ __forceinline__ void xcd_barrier(const XcdBarrier& b, const bool is_t0) {
    asm volatile("s_waitcnt vmcnt(0)" ::: "memory");
    __syncthreads();
    if (is_t0) {
        unsigned* bar = b.bar;
        __builtin_amdgcn_s_waitcnt(0);
        unsigned nloc = b.st[0], nx = b.st[1];
        if (nloc == 0u) { xcd_barrier_complete(bar, b.x, nloc, nx); b.st[0] = nloc; b.st[1] = nx; }
        const unsigned old = xb_add(&bar[XB_XSUB(b.x)], 1u);
        const unsigned gen = old / nloc;
        if (old + 1u == (gen + 1u) * nloc) {
            __builtin_amdgcn_fence(__ATOMIC_RELEASE, "agent");
            asm volatile("s_waitcnt vmcnt(0)" ::: "memory");
            const unsigned og = xb_add(&bar[XB_TOP], 1u);
            const unsigned tg = og / nx;
            if (og + 1u == (tg + 1u) * nx) xb_add(&bar[XB_TOPGEN], 1u);
            else XB_SPIN(xb_ld(&bar[XB_TOPGEN]) == tg, bar);
            __builtin_amdgcn_fence(__ATOMIC_ACQUIRE, "agent");
            xb_add(&bar[XB_XGEN(b.x)], 1u);
            asm volatile("s_waitcnt vmcnt(0)" ::: "memory");
        } else {
            XB_SPIN(xb_ld(&bar[XB_XGEN(b.x)]) == gen, bar);
            __builtin_amdgcn_fence(__ATOMIC_ACQUIRE, "agent");
            asm volatile("s_waitcnt vmcnt(0)" ::: "memory");
        }
    }
    __syncthreads();
}
typedef unsigned short bf16_t;
typedef short bf16x8 __attribute__((ext_vector_type(8)));
typedef float f32x4 __attribute__((ext_vector_type(4)));
typedef float f32x16 __attribute__((ext_vector_type(16)));
typedef unsigned u32x4 __attribute__((ext_vector_type(4)));
typedef unsigned u32x2 __attribute__((ext_vector_type(2)));
using pg8::cvt_pk_bf16;

constexpr int DM = 2048, TP = 16384, NSB = 32, TSQ = 32, NTOK = TP + NSB * TSQ, NSEQ = 33, PAST = 4096, NLAYER = 2;
constexpr int NU = 15104;
constexpr int U_AVAL = 0, U_AGATE = 512, U_ASG = 1024, U_Q = 1536, U_K = 2048, U_V = 2560, U_BSG = 3072, U_XC = 3584, U_CSG = 5248, U_DIN = 5760, U_DSG = 6272, U_G = 6784, U_F = 14976;
constexpr int IN_W = 14984, SHIFT_W = 1664;
constexpr float LOG2E = 1.4426950408889634f;
enum { I_XP = 0, I_XS, I_CK, I_CV, I_CLF, I_SCONV, I_SSHIFT, I_SWKV, I_SPOOL, I_CP, I_CS, I_NORMG, I_WADA, I_BADA, I_WIN, I_BF, I_CONVW, I_CONVB, I_CLNG, I_CLNB, I_MU, I_W0, I_W2, I_A0, I_A2,
       I_KK, I_KA, I_RK, I_GNG, I_GNB, I_POOLW, I_POOLB, I_POOLS, I_WBR, I_WOUT, I_FING, N_IN };
constexpr size_t O_YP = 0, O_YS = O_YP + (size_t)TP * DM, O_PK = O_YS + (size_t)1024 * DM, O_PV = O_PK + (size_t)2 * TP * 512, O_PLF = O_PV + (size_t)2 * TP * 512, O_PCONV = O_PLF + (size_t)2 * TP * 8,
                 O_PSHIFT = O_PCONV + 2 * 30 * 512, O_PWKV = O_PSHIFT + 2 * 1664, O_PPOOL = O_PWKV + 2 * 8 * 64 * 64, O_SK = O_PPOOL + 2 * 15 * 512, O_SV = O_SK + (size_t)2 * 1024 * 512,
                 O_SLF = O_SV + (size_t)2 * 1024 * 512, O_SCONV = O_SLF + 2 * 1024 * 8, O_SSHIFT = O_SCONV + (size_t)2 * 32 * 30 * 512, O_SWKV = O_SSHIFT + 2 * 32 * 1664,
                 O_SPOOL = O_SWKV + (size_t)2 * 32 * 8 * 64 * 64, O_END = O_SPOOL + (size_t)2 * 32 * 15 * 512;
static_assert(O_END == 75374848, "output size");
constexpr size_t al256(size_t x) { return (x + 255) & ~(size_t)255; }
constexpr int NCU_CH = 288, NRU = NCU_CH * 8;
constexpr size_t WS_CTL = 0, CTL_BYTES = 512 * 1024;
constexpr size_t WS_WIN = CTL_BYTES;
constexpr size_t WS_WBR = al256(WS_WIN + (size_t)2 * NU * 2048 * 2);
constexpr size_t WS_WOUT = al256(WS_WBR + (size_t)2 * 4 * 2048 * 512 * 2);
constexpr size_t WS_POOLW = al256(WS_WOUT + (size_t)2 * 2048 * 2048 * 2);
constexpr size_t WS_ADA = al256(WS_POOLW + (size_t)2 * 4 * 128 * 128 * 2);
constexpr size_t WS_H = al256(WS_ADA + (size_t)2 * 33 * 6144 * 4);
constexpr size_t WS_U = al256(WS_H + (size_t)NTOK * 2048 * 2);
constexpr size_t WS_XBUF = al256(WS_U + (size_t)NTOK * NU * 2);
constexpr size_t WS_OCAT = al256(WS_XBUF + (size_t)NTOK * 2048 * 4);
constexpr size_t WS_Z = al256(WS_OCAT + (size_t)4 * NTOK * 512 * 2);
constexpr size_t WS_MERGED = al256(WS_Z + (size_t)4 * NTOK * 2048 * 2);
constexpr size_t WS_FP = al256(WS_MERGED + (size_t)NTOK * 2048 * 2);
constexpr int GS_LEN = PAST + TSQ;
constexpr size_t WS_GS = al256(WS_FP + (size_t)8 * TP * 4);
constexpr size_t WS_VT = al256(WS_GS + (size_t)32 * 8 * GS_LEN * 4);
constexpr size_t WS_TQ = al256(WS_VT + (size_t)8 * 64 * TP * 2);
constexpr size_t WS_GM = al256(WS_TQ + (size_t)NRU * 4096 * 4);
constexpr size_t WS_ET = al256(WS_GM + (size_t)NRU * 4096 * 4);
constexpr size_t WS_Y0T = al256(WS_ET + (size_t)NRU * 4096 * 4);
constexpr size_t WS_SC = al256(WS_Y0T + (size_t)NRU * 4096 * 4);
constexpr size_t WS_BONUS = al256(WS_SC + (size_t)NRU * 4096 * 4);
constexpr size_t WS_GG = al256(WS_BONUS + (size_t)NRU * 64 * 4);
constexpr size_t WS_TG = al256(WS_GG + (size_t)16 * 8 * 4096 * 4);
constexpr size_t WS_SG = al256(WS_TG + (size_t)16 * 8 * 4096 * 4);
constexpr size_t WS_XPART = al256(WS_SG + (size_t)16 * 8 * 4096 * 4);
constexpr size_t WS_END = al256(WS_XPART + (size_t)2 * 8 * 1024 * 2048 * 4);
static_assert(WS_END < (size_t)2100 * 1024 * 1024, "workspace map exceeds the guaranteed d_ws size");
constexpr int CW_BAR = 0;
constexpr int CW_QUEUE = 16 * 3456 + 64;
constexpr int CW_KMAX = CW_QUEUE + 64 * 16;
static_assert((CW_KMAX + 64) * 4 <= (int)CTL_BYTES, "ctl");
constexpr int LDS_BYTES = 163840 - 256;
constexpr int LDS_XB_OFF = LDS_BYTES - 16;
constexpr int SLOT_F = 64 * 65;

#ifndef PROBE_ID
#define PROBE_ID 0
#endif
#ifndef PROBE_K
#define PROBE_K 1
#endif
constexpr int LDS_PROBE_OFF = 163840 - 256 - 64;
#if PROBE_ID
#define PT0() unsigned long long _pt0 = (blockIdx.x == 0 && threadIdx.x == 0) ? __builtin_amdgcn_s_memrealtime() : 0ull
#define PT1(id) do { if ((id) == PROBE_ID && blockIdx.x == 0 && threadIdx.x == 0) { *(LAS unsigned long long*)(lds + LDS_PROBE_OFF) += __builtin_amdgcn_s_memrealtime() - _pt0; } _pt0 = (blockIdx.x == 0 && threadIdx.x == 0) ? __builtin_amdgcn_s_memrealtime() : 0ull; } while (0)
#else
#define PT0() do {} while (0)
#define PT1(id) do {} while (0)
#endif
struct Params { const float* in[N_IN]; float* out; unsigned char* ws; int ph_lo, ph_hi, li, pad; };
typedef const __attribute__((address_space(4))) Params* KP;
__device__ __forceinline__ KP kp_fresh(KP k) { asm volatile("" : "+s"(k)); return k; }

__device__ __forceinline__ float bf2f(unsigned short b) { return __uint_as_float(((unsigned)b) << 16); }
__device__ __forceinline__ float bflo(unsigned w) { return __uint_as_float(w << 16); }
__device__ __forceinline__ float bfhi(unsigned w) { return __uint_as_float(w & 0xffff0000u); }
__device__ __forceinline__ unsigned short f2bf(float f) { return (unsigned short)(cvt_pk_bf16(f, 0.f) & 0xffffu); }
__device__ __forceinline__ float sigmoidf_(float x) { return 1.f / (1.f + __expf(-x)); }
__device__ __forceinline__ float siluf_(float x) { return x / (1.f + __expf(-x)); }
__device__ __forceinline__ float log_sigmoidf_(float z) { return fminf(z, 0.f) - log1pf(expf(-fabsf(z))); }
template <int CTRL> __device__ __forceinline__ float dpp_mov(float v) { return __int_as_float(__builtin_amdgcn_update_dpp(0, __float_as_int(v), CTRL, 0xF, 0xF, true)); }
__device__ __forceinline__ float wave_sum(float v) {
    v += dpp_mov<0xB1>(v); v += dpp_mov<0x4E>(v); v += dpp_mov<0x141>(v); v += dpp_mov<0x140>(v);
    const float r0 = __int_as_float(__builtin_amdgcn_readlane(__float_as_int(v), 0)), r1 = __int_as_float(__builtin_amdgcn_readlane(__float_as_int(v), 16));
    const float r2 = __int_as_float(__builtin_amdgcn_readlane(__float_as_int(v), 32)), r3 = __int_as_float(__builtin_amdgcn_readlane(__float_as_int(v), 48));
    return (r0 + r1) + (r2 + r3);
}
__device__ __forceinline__ float wave_max(float v) {
    v = fmaxf(v, dpp_mov<0xB1>(v)); v = fmaxf(v, dpp_mov<0x4E>(v)); v = fmaxf(v, dpp_mov<0x141>(v)); v = fmaxf(v, dpp_mov<0x140>(v));
    const float r0 = __int_as_float(__builtin_amdgcn_readlane(__float_as_int(v), 0)), r1 = __int_as_float(__builtin_amdgcn_readlane(__float_as_int(v), 16));
    const float r2 = __int_as_float(__builtin_amdgcn_readlane(__float_as_int(v), 32)), r3 = __int_as_float(__builtin_amdgcn_readlane(__float_as_int(v), 48));
    return fmaxf(fmaxf(r0, r1), fmaxf(r2, r3));
}
__device__ __forceinline__ float wave_min(float v) { return -wave_max(-v); }
__device__ __forceinline__ float xhalf_max(float m) { const auto rr = __builtin_amdgcn_permlane32_swap(__float_as_uint(m), __float_as_uint(m), false, false); return fmaxf(__uint_as_float(rr[0]), __uint_as_float(rr[1])); }
__device__ __forceinline__ float xhalf_sum(float m) { const auto rr = __builtin_amdgcn_permlane32_swap(__float_as_uint(m), __float_as_uint(m), false, false); return __uint_as_float(rr[0]) + __uint_as_float(rr[1]); }
__device__ __forceinline__ bf16x8 pack8f(const f32x4 a, const f32x4 b) { u32x4 w; w.x = cvt_pk_bf16(a[0], a[1]); w.y = cvt_pk_bf16(a[2], a[3]); w.z = cvt_pk_bf16(b[0], b[1]); w.w = cvt_pk_bf16(b[2], b[3]); return __builtin_bit_cast(bf16x8, w); }
__device__ __forceinline__ float fast_tanh(float x) { const float e = __expf(-2.f * fabsf(x)); const float t = (1.f - e) * __builtin_amdgcn_rcpf(1.f + e); return x < 0.f ? -t : t; }
__device__ __forceinline__ void tr_tile(const float* __restrict__ src, size_t ld, int k0, int c0, int nvalid, bf16_t* __restrict__ dst, int K, LAS float* scr, int lane) {
    float tv[64];
#pragma unroll
    for (int kk = 0; kk < 64; ++kk) tv[kk] = src[(size_t)(k0 + kk) * ld + c0 + (lane < nvalid ? lane : 0)];
#pragma unroll
    for (int kk = 0; kk < 64; ++kk) scr[kk * 65 + lane] = (lane < nvalid) ? tv[kk] : 0.f;
    const int nl = lane >> 3, kc8 = (lane & 7) * 8;
#pragma unroll
    for (int it = 0; it < 8; ++it) { const int nn = 8 * it + nl; const LAS float* s = scr + kc8 * 65 + nn;
        u32x4 w; w.x = cvt_pk_bf16(s[0], s[65]); w.y = cvt_pk_bf16(s[130], s[195]); w.z = cvt_pk_bf16(s[260], s[325]); w.w = cvt_pk_bf16(s[390], s[455]);
        *(u32x4*)(dst + (size_t)nn * K + k0 + kc8) = w; }
}
__device__ __forceinline__ void p0_weights(KP p, LAS unsigned char* lds, int gw, int ngw, int wave, int lane) {
    LAS float* scr = (LAS float*)lds + wave * SLOT_F;
    constexpr int T_WIN = (NU / 64) * 32, T_WBR = 4 * 32 * 8, T_WOUT = 32 * 32, T_POOL = 4 * 2 * 2, T_L = T_WIN + T_WBR + T_WOUT + T_POOL;
    for (int it = gw; it < 2 * T_L; it += ngw) {
        const int l = it / T_L; int r = it % T_L;
        if (r < T_WIN) {
            const int nt = r / 32, kt = r % 32, m0 = nt * 64;
            int c0, nvalid = 64;
            if (m0 < 3072) c0 = m0; else if (m0 < U_F) c0 = m0 + 8; else if (m0 == U_F) { c0 = 3072; nvalid = 8; } else { c0 = 0; nvalid = 0; }
            tr_tile(p->in[I_WIN] + (size_t)l * 2048 * IN_W, IN_W, kt * 64, c0, nvalid, (bf16_t*)(p->ws + WS_WIN) + ((size_t)l * NU + m0) * 2048, 2048, scr, lane);
            continue; }
        r -= T_WIN;
        if (r < T_WBR) {
            const int n = r / 256, q = r % 256, nt = q / 8, kt = q % 8;
            tr_tile(p->in[I_WBR] + ((size_t)(l * 4 + n) * 512) * 2048, 2048, kt * 64, nt * 64, 64, (bf16_t*)(p->ws + WS_WBR) + ((size_t)(l * 4 + n) * 2048 + nt * 64) * 512, 512, scr, lane);
            continue; }
        r -= T_WBR;
        if (r < T_WOUT) {
            const int nt = r / 32, kt = r % 32;
            tr_tile(p->in[I_WOUT] + (size_t)l * 2048 * 2048, 2048, kt * 64, nt * 64, 64, (bf16_t*)(p->ws + WS_WOUT) + ((size_t)l * 2048 + nt * 64) * 2048, 2048, scr, lane);
            continue; }
        r -= T_WOUT;
        {
            const int g = r / 4, q = r % 4, nt = q / 2, kt = q % 2;
            tr_tile(p->in[I_POOLW] + (size_t)(l * 4 + g) * 128 * 128, 128, kt * 64, nt * 64, 64, (bf16_t*)(p->ws + WS_POOLW) + ((size_t)(l * 4 + g) * 128 + nt * 64) * 128, 128, scr, lane);
        }
    }
}
__device__ __forceinline__ void ada_unit(KP p, int unit, LAS unsigned char* lds, int tid) {
    const int wave = tid >> 6, lane = tid & 63, l = unit / 96, n0 = (unit % 96) * 64;
    LAS float* cs = (LAS float*)lds + wave * (33 * 64);
    LAS float* red = (LAS float*)lds + 8 * 33 * 64;
    const float* W = p->in[I_WADA] + (size_t)l * 2048 * 6144;
    const float* cp = p->in[I_CP]; const float* csm = p->in[I_CS];
    float acc[33];
#pragma unroll
    for (int s = 0; s < 33; ++s) acc[s] = 0.f;
    float wv[16];
#pragma unroll
    for (int j = 0; j < 16; ++j) wv[j] = W[(size_t)(wave * 256 + j) * 6144 + n0 + lane];
#pragma unroll 1
    for (int step = 0; step < 16; ++step) {
        const int k0 = wave * 256 + step * 16, kn = wave * 256 + (step < 15 ? step + 1 : step) * 16;
        float wn[16];
#pragma unroll
        for (int j = 0; j < 16; ++j) wn[j] = W[(size_t)(kn + j) * 6144 + n0 + lane];
        if ((step & 3) == 0) {
#pragma unroll
            for (int s = 0; s < 33; ++s) { const float c = (s == 0) ? cp[k0 + lane] : csm[(size_t)(s - 1) * 2048 + k0 + lane]; cs[s * 64 + lane] = siluf_(c); } }
        const int kk0 = (step & 3) * 16;
#pragma unroll
        for (int q4 = 0; q4 < 4; ++q4) {
#pragma unroll
            for (int s = 0; s < 33; ++s) { const f32x4 c4 = *(const LAS f32x4*)(cs + s * 64 + kk0 + 4 * q4); acc[s] += c4.x * wv[4 * q4] + c4.y * wv[4 * q4 + 1] + c4.z * wv[4 * q4 + 2] + c4.w * wv[4 * q4 + 3]; } }
#pragma unroll
        for (int j = 0; j < 16; ++j) wv[j] = wn[j];
    }
#pragma unroll
    for (int s = 0; s < 33; ++s) red[(wave * 33 + s) * 64 + lane] = acc[s];
    __syncthreads();
    for (int idx = tid; idx < 33 * 64; idx += 512) { const int s = idx >> 6, n = idx & 63; float v = p->in[I_BADA][l * 6144 + n0 + n];
#pragma unroll
        for (int w = 0; w < 8; ++w) v += red[(w * 33 + s) * 64 + n];
        ((float*)(p->ws + WS_ADA))[((size_t)l * 33 + s) * 6144 + n0 + n] = v; }
    __syncthreads();
}
__device__ __forceinline__ void load_x8(KP p, int l, int row, int lane, f32x4 (&v)[8]) {
    if (row < TP) { const f32x4* x4 = (const f32x4*)(l == 0 ? p->in[I_XP] + (size_t)row * DM : (const float*)(p->ws + WS_XBUF) + (size_t)row * DM) + lane;
#pragma unroll
        for (int j = 0; j < 8; ++j) v[j] = x4[64 * j]; }
    else { const int r = row - TP; const f32x4* x4 = (const f32x4*)(p->in[I_XS] + (size_t)r * DM) + lane;
#pragma unroll
        for (int j = 0; j < 8; ++j) v[j] = x4[64 * j];
        for (int s = 0; s < 8 * l; ++s) { const f32x4* q4 = (const f32x4*)((const float*)(p->ws + WS_XPART) + ((size_t)s * 1024 + r) * DM) + lane;
#pragma unroll
            for (int j = 0; j < 8; ++j) v[j] += q4[64 * j]; } }
}
__device__ __forceinline__ void p1_rows(KP p, int l, int gw, int ngw, int lane) {
    const f32x4* g4 = (const f32x4*)(p->in[I_NORMG] + l * DM) + lane;
    f32x4 a[8], sh[8]; int cur_seq = -1;
    for (int row = gw; row < NTOK; row += ngw) {
        const int seq = row < TP ? 0 : 1 + ((row - TP) >> 5);
        f32x4 v[8]; float ss = 0.f; load_x8(p, l, row, lane, v);
#pragma unroll
        for (int j = 0; j < 8; ++j) { ss += (v[j].x * v[j].x + v[j].y * v[j].y) + (v[j].z * v[j].z + v[j].w * v[j].w); }
        if (seq != cur_seq) { cur_seq = seq;
            const f32x4* sh4 = (const f32x4*)((const float*)(p->ws + WS_ADA) + ((size_t)l * 33 + seq) * 6144) + lane; const f32x4* sc4 = sh4 + 512;
#pragma unroll
            for (int j = 0; j < 8; ++j) { a[j] = g4[64 * j] * (sc4[64 * j] + 1.f); sh[j] = sh4[64 * j]; } }
        const float rstd = 1.f / sqrtf(wave_sum(ss) * (1.f / DM) + 1e-6f);
        u32x2* o = (u32x2*)((bf16_t*)(p->ws + WS_H) + (size_t)row * DM) + lane;
#pragma unroll
        for (int j = 0; j < 8; ++j) { const f32x4 y = v[j] * rstd * a[j] + sh[j];
            u32x2 w; w.x = cvt_pk_bf16(y.x, y.y); w.y = cvt_pk_bf16(y.z, y.w); o[64 * j] = w; }
    }
}
__device__ __forceinline__ void p_final_rows(KP p, int gw, int ngw, int lane) {
    const f32x4* g4 = (const f32x4*)p->in[I_FING] + lane;
    for (int row = gw; row < NTOK; row += ngw) {
        f32x4 v[8]; float ss = 0.f; load_x8(p, 2, row, lane, v);
#pragma unroll
        for (int j = 0; j < 8; ++j) { ss += (v[j].x * v[j].x + v[j].y * v[j].y) + (v[j].z * v[j].z + v[j].w * v[j].w); }
        const float rstd = 1.f / sqrtf(wave_sum(ss) * (1.f / DM) + 1e-6f);
        f32x4* o = (f32x4*)(p->out + O_YP + (size_t)row * DM) + lane;
#pragma unroll
        for (int j = 0; j < 8; ++j) o[64 * j] = v[j] * rstd * g4[64 * j];
    }
}
struct EpiU {
    static constexpr bool PERM = true, AFTER_DRAIN = false;
    bf16_t* U; float* out; const float* bf; int l;
    __device__ __forceinline__ void operator()(const f32x4 (&acc)[2][2][4][2], const pg8::Unit& u, int wr, int wc, int fr, int fq) const {
        const int row0 = u.pm * 256 + wr * 64 + fr, col0 = u.pn * 256 + wc * 32 + 8 * fq;
#pragma unroll
        for (int ai = 0; ai < 2; ++ai)
#pragma unroll
            for (int m = 0; m < 4; ++m) { bf16_t* rowp = U + (size_t)(row0 + ai * 128 + m * 16) * NU + col0;
#pragma unroll
                for (int bj = 0; bj < 2; ++bj) { const f32x4 v0 = acc[ai][bj][m][0], v1 = acc[ai][bj][m][1];
                    u32x4 w; w.x = cvt_pk_bf16(v0[0], v0[1]); w.y = cvt_pk_bf16(v0[2], v0[3]); w.z = cvt_pk_bf16(v1[0], v1[1]); w.w = cvt_pk_bf16(v1[2], v1[3]);
                    *(u32x4*)(rowp + bj * 128) = w; } }
        if (u.pn >= 8 && u.pn < 12) {
            const bool isv = u.pn >= 10; const int cin = (u.pn - (isv ? 10 : 8)) * 256 + wc * 32 + 8 * fq;
#pragma unroll
            for (int ai = 0; ai < 2; ++ai)
#pragma unroll
                for (int m = 0; m < 4; ++m) { const int row = row0 + ai * 128 + m * 16;
                    float* dst = row < TP ? out + (isv ? O_PV : O_PK) + ((size_t)l * TP + row) * 512 : out + (isv ? O_SV : O_SK) + ((size_t)l * 1024 + (row - TP)) * 512;
#pragma unroll
                    for (int bj = 0; bj < 2; ++bj) { *(f32x4*)(dst + cin + bj * 128) = acc[ai][bj][m][0]; *(f32x4*)(dst + cin + bj * 128 + 4) = acc[ai][bj][m][1]; } }
        }
        if (u.pn == 58 && wc == 0 && fq == 0) {
            const f32x4 b0 = *(const f32x4*)(bf + l * 8), b1 = *(const f32x4*)(bf + l * 8 + 4);
#pragma unroll
            for (int ai = 0; ai < 2; ++ai)
#pragma unroll
                for (int m = 0; m < 4; ++m) { const int row = row0 + ai * 128 + m * 16;
                    float* dst = row < TP ? out + O_PLF + ((size_t)l * TP + row) * 8 : out + O_SLF + ((size_t)l * 1024 + (row - TP)) * 8;
                    const f32x4 z0 = acc[ai][1][m][0] + b0, z1 = acc[ai][1][m][1] + b1; f32x4 o0, o1;
#pragma unroll
                    for (int e = 0; e < 4; ++e) { o0[e] = log_sigmoidf_(z0[e]); o1[e] = log_sigmoidf_(z1[e]); }
                    *(f32x4*)dst = o0; *(f32x4*)(dst + 4) = o1; }
        }
    }
};
struct BranchOrder {
    int G, c;
    __device__ __forceinline__ bool next(int i, pg8::Unit& u) const { const int L = i * G + c; if (L >= 4 * 544) return false; const int n = L / 544, t = L - n * 544; u.pm = n * 68 + (t >> 3); u.pn = n * 8 + (t & 7); return true; }
    __device__ __forceinline__ void a_ready(const pg8::Unit&) const {}
    __device__ __forceinline__ void done(const pg8::Unit&) const {}
};
struct EpiZ {
    static constexpr bool PERM = true, AFTER_DRAIN = false;
    bf16_t* Z; const bf16_t* U;
    __device__ __forceinline__ void operator()(const f32x4 (&acc)[2][2][4][2], const pg8::Unit& u, int wr, int wc, int fr, int fq) const {
        const int row0 = u.pm * 256 + wr * 64 + fr, col0 = (u.pn & 7) * 256 + wc * 32 + 8 * fq;
#pragma unroll
        for (int ai = 0; ai < 2; ++ai)
#pragma unroll
            for (int m = 0; m < 4; ++m) { bf16_t* rowp = Z + (size_t)(row0 + ai * 128 + m * 16) * DM + col0;
#pragma unroll
                for (int bj = 0; bj < 2; ++bj) { const f32x4 v0 = acc[ai][bj][m][0], v1 = acc[ai][bj][m][1];
                    u32x4 w; w.x = cvt_pk_bf16(v0[0], v0[1]); w.y = cvt_pk_bf16(v0[2], v0[3]); w.z = cvt_pk_bf16(v1[0], v1[1]); w.w = cvt_pk_bf16(v1[2], v1[3]);
                    *(u32x4*)(rowp + bj * 128) = w; } }
    }
};
__device__ __forceinline__ void merge_pass(KP p, int l, int gtid, int ngt) {
    const bf16_t* U = (const bf16_t*)(p->ws + WS_U); const bf16_t* Z = (const bf16_t*)(p->ws + WS_Z); bf16_t* M = (bf16_t*)(p->ws + WS_MERGED);
    for (int it0 = gtid; it0 < NTOK * 256; it0 += 3 * ngt) {
        u32x4 gv[3][4], zv[3][4];
#pragma unroll
        for (int k = 0; k < 3; ++k) { const int it = it0 + k * ngt < NTOK * 256 ? it0 + k * ngt : it0; const int row = it >> 8, col = (it & 255) * 8;
#pragma unroll
            for (int n = 0; n < 4; ++n) { gv[k][n] = *(const u32x4*)(U + (size_t)row * NU + U_G + n * 2048 + col); zv[k][n] = *(const u32x4*)(Z + ((size_t)n * NTOK + row) * DM + col); } }
#pragma unroll
        for (int k = 0; k < 3; ++k) { const int it = it0 + k * ngt; if (it < NTOK * 256) { const int row = it >> 8, col = (it & 255) * 8;
            float s[8];
#pragma unroll
            for (int e = 0; e < 8; ++e) s[e] = 0.f;
#pragma unroll
            for (int n = 0; n < 4; ++n) { const u32x4 g = gv[k][n], z = zv[k][n];
                s[0] += sigmoidf_(bflo(g.x)) * bflo(z.x); s[1] += sigmoidf_(bfhi(g.x)) * bfhi(z.x); s[2] += sigmoidf_(bflo(g.y)) * bflo(z.y); s[3] += sigmoidf_(bfhi(g.y)) * bfhi(z.y);
                s[4] += sigmoidf_(bflo(g.z)) * bflo(z.z); s[5] += sigmoidf_(bfhi(g.z)) * bfhi(z.z); s[6] += sigmoidf_(bflo(g.w)) * bflo(z.w); s[7] += sigmoidf_(bfhi(g.w)) * bfhi(z.w); }
            u32x4 w; w.x = cvt_pk_bf16(s[0], s[1]); w.y = cvt_pk_bf16(s[2], s[3]); w.z = cvt_pk_bf16(s[4], s[5]); w.w = cvt_pk_bf16(s[6], s[7]);
            *(u32x4*)(M + (size_t)row * DM + col) = w; } }
    }
}
struct EpiOut {
    static constexpr bool PERM = false, AFTER_DRAIN = false;
    const float* xp; const float* xs; const float* xb; const float* ada; float* xout; int l;
    __device__ __forceinline__ void operator()(const f32x4 (&acc)[2][2][4][2], const pg8::Unit& u, int wr, int wc, int fr, int fq) const {
        const int row0 = u.pm * 256 + wr * 64 + fr, col0 = u.pn * 256 + wc * 32 + 4 * fq;
        f32x4 gt[2][2];
#pragma unroll
        for (int ai = 0; ai < 2; ++ai)
#pragma unroll
            for (int mp = 0; mp < 4; mp += 2) {
                f32x4 bs[2][2][2], gv[2][2][2];
#pragma unroll
                for (int mm = 0; mm < 2; ++mm) { const int row = row0 + ai * 128 + (mp + mm) * 16;
                    const float* base = l == 0 ? (row < TP ? xp + (size_t)row * DM : xs + (size_t)(row - TP) * DM) : xb + (size_t)row * DM;
                    const float* gate = ada + ((size_t)l * 33 + (row < TP ? 0 : 1 + ((row - TP) >> 5))) * 6144 + 4096;
#pragma unroll
                    for (int bj = 0; bj < 2; ++bj)
#pragma unroll
                        for (int n = 0; n < 2; ++n) { const int col = col0 + bj * 128 + n * 16; bs[mm][bj][n] = *(const f32x4*)(base + col); gv[mm][bj][n] = *(const f32x4*)(gate + col); } }
#pragma unroll
                for (int mm = 0; mm < 2; ++mm) { const int row = row0 + ai * 128 + (mp + mm) * 16;
#pragma unroll
                    for (int bj = 0; bj < 2; ++bj)
#pragma unroll
                        for (int n = 0; n < 2; ++n) { const int col = col0 + bj * 128 + n * 16; *(f32x4*)(xout + (size_t)row * DM + col) = bs[mm][bj][n] + gv[mm][bj][n] * acc[ai][bj][mp + mm][n]; } }
            }
        (void)gt;
    }
};
struct OneUnit {
    int pm, pn; bool valid;
    __device__ __forceinline__ bool next(int i, pg8::Unit& u) const { if (i > 0 || !valid) return false; u.pm = pm; u.pn = pn; return true; }
    __device__ __forceinline__ void a_ready(const pg8::Unit&) const {}
    __device__ __forceinline__ void done(const pg8::Unit&) const {}
};
struct EpiOutPart {
    static constexpr bool PERM = false, AFTER_DRAIN = false;
    const float* ada; float* part; int l;
    __device__ __forceinline__ void operator()(const f32x4 (&acc)[2][2][4][2], const pg8::Unit& u, int wr, int wc, int fr, int fq) const {
        const int row0 = u.pm * 256 + wr * 64 + fr - TP, col0 = u.pn * 256 + wc * 32 + 4 * fq;
#pragma unroll
        for (int ai = 0; ai < 2; ++ai)
#pragma unroll
            for (int m = 0; m < 4; ++m) { const int r = row0 + ai * 128 + m * 16;
                const float* gate = ada + ((size_t)l * 33 + 1 + (r >> 5)) * 6144 + 4096;
#pragma unroll
                for (int bj = 0; bj < 2; ++bj)
#pragma unroll
                    for (int n = 0; n < 2; ++n) { const int col = col0 + bj * 128 + n * 16; *(f32x4*)(part + (size_t)r * DM + col) = *(const f32x4*)(gate + col) * acc[ai][bj][m][n]; } }
    }
};
constexpr int CGS = 516;
__device__ __forceinline__ void conv_unit(KP p, int l, int tile, LAS unsigned char* lds, int tid) {
    const bf16_t* U = (const bf16_t*)(p->ws + WS_U);
    const int c = tid, wave = tid >> 6, lane = tid & 63;
    const bool samp = tile >= 512; const int b = tile - 512, row0 = samp ? TP + b * 32 : tile * 32;
    const bool last = samp || tile == 511;
    LAS float* gl = (LAS float*)lds;
    LAS bf16_t* sgl = (LAS bf16_t*)(lds + 62 * CGS * 4);
    LAS float* red = (LAS float*)(lds + 62 * CGS * 4 + 32 * 512 * 2);
    LAS float* st = red + 8 * 32;
#pragma unroll
    for (int k = 0; k < 8; ++k) { const int task = tid + 512 * k; if (task < 62 * 64) { const int i = task >> 6, ch = task & 63; f32x4 o0, o1;
        const int rel = i - 30;
        if (rel < 0 && samp) { const float* hp = p->in[I_SCONV] + (((size_t)l * 32 + b) * 30 + i) * 512 + 8 * ch; o0 = *(const f32x4*)hp; o1 = *(const f32x4*)(hp + 4); }
        else if (row0 + rel < 0) { o0 = (f32x4){0.f, 0.f, 0.f, 0.f}; o1 = o0; }
        else { const bf16_t* up = U + (size_t)(row0 + rel) * NU + 8 * ch; const u32x4 v = *(const u32x4*)(up + U_AVAL), g = *(const u32x4*)(up + U_AGATE);
            o0 = (f32x4){bflo(v.x) * sigmoidf_(bflo(g.x)), bfhi(v.x) * sigmoidf_(bfhi(g.x)), bflo(v.y) * sigmoidf_(bflo(g.y)), bfhi(v.y) * sigmoidf_(bfhi(g.y))};
            o1 = (f32x4){bflo(v.z) * sigmoidf_(bflo(g.z)), bfhi(v.z) * sigmoidf_(bfhi(g.z)), bflo(v.w) * sigmoidf_(bflo(g.w)), bfhi(v.w) * sigmoidf_(bfhi(g.w))}; }
        *(LAS f32x4*)(gl + i * CGS + 8 * ch) = o0; *(LAS f32x4*)(gl + i * CGS + 8 * ch + 4) = o1; } }
#pragma unroll
    for (int k = 0; k < 4; ++k) { const int task = tid + 512 * k, t = task >> 6, ch = task & 63; const u32x4 s = *(const u32x4*)(U + (size_t)(row0 + t) * NU + U_ASG + 8 * ch);
        u32x4 w; w.x = cvt_pk_bf16(siluf_(bflo(s.x)), siluf_(bfhi(s.x))); w.y = cvt_pk_bf16(siluf_(bflo(s.y)), siluf_(bfhi(s.y))); w.z = cvt_pk_bf16(siluf_(bflo(s.z)), siluf_(bfhi(s.z))); w.w = cvt_pk_bf16(siluf_(bflo(s.w)), siluf_(bfhi(s.w)));
        *(LAS u32x4*)(sgl + t * 512 + 8 * ch) = w; }
    const float cb = p->in[I_CONVB][l * 512 + c], lg = p->in[I_CLNG][l * 512 + c], lb = p->in[I_CLNB][l * 512 + c];
    float wk[31];
#pragma unroll
    for (int k = 0; k < 31; ++k) wk[k] = p->in[I_CONVW][((size_t)l * 31 + k) * 512 + c];
    __syncthreads();
    if (last) {
        float* dst = samp ? p->out + O_SCONV + (((size_t)l * 32 + b) * 30) * 512 + c : p->out + O_PCONV + ((size_t)l * 30) * 512 + c;
#pragma unroll
        for (int t = 2; t < 32; ++t) dst[(size_t)(t - 2) * 512] = gl[(30 + t) * CGS + c];
    }
    bf16_t* oa = (bf16_t*)(p->ws + WS_OCAT);
#pragma unroll 1
    for (int half = 0; half < 2; ++half) {
        float z[46];
#pragma unroll
        for (int i = 0; i < 46; ++i) z[i] = gl[(16 * half + i) * CGS + c];
        float hv[16];
#pragma unroll
        for (int tt = 0; tt < 16; ++tt) hv[tt] = cb;
#pragma unroll
        for (int k = 0; k < 31; ++k) {
#pragma unroll
            for (int tt = 0; tt < 16; ++tt) hv[tt] += z[tt + k] * wk[k]; }
#pragma unroll
        for (int tt = 0; tt < 16; ++tt) { const float s1 = wave_sum(hv[tt]), s2 = wave_sum(hv[tt] * hv[tt]); if (lane == 0) { red[(wave * 16 + tt) * 2] = s1; red[(wave * 16 + tt) * 2 + 1] = s2; } }
        __syncthreads();
        if (tid < 16) { float s1 = 0.f, s2 = 0.f;
#pragma unroll
            for (int w = 0; w < 8; ++w) { s1 += red[(w * 16 + tid) * 2]; s2 += red[(w * 16 + tid) * 2 + 1]; }
            const float mean = s1 * (1.f / 512.f), var = fmaxf(s2 * (1.f / 512.f) - mean * mean, 0.f);
            st[tid * 2] = mean; st[tid * 2 + 1] = 1.f / sqrtf(var + 1e-5f); }
        __syncthreads();
#pragma unroll
        for (int tt = 0; tt < 16; ++tt) { const float y = (hv[tt] - st[tt * 2]) * st[tt * 2 + 1] * lg + lb; const int t = 16 * half + tt;
            oa[(size_t)(row0 + t) * 512 + c] = f2bf(siluf_(y) * bf2f(sgl[t * 512 + c])); }
    }
    __syncthreads();
}
__device__ __forceinline__ void pool_unit(KP p, int l, int tile, LAS unsigned char* lds, int tid) {
    const bf16_t* U = (const bf16_t*)(p->ws + WS_U);
    const int c = tid, wave = tid >> 6, lane = tid & 63;
    const bool samp = tile >= 512; const int b = tile - 512, row0 = samp ? TP + b * 32 : tile * 32;
    constexpr int PST = 520;
    LAS float* zl = (LAS float*)lds;
    LAS bf16_t* pl = (LAS bf16_t*)(lds + 47 * CGS * 4);
#pragma unroll
    for (int k = 0; k < 6; ++k) { const int task = tid + 512 * k; if (task < 47 * 64) { const int i = task >> 6, ch = task & 63; f32x4 o0, o1; const int rel = i - 15;
        if (rel < 0 && samp) { const float* hp = p->in[I_SPOOL] + (((size_t)l * 32 + b) * 15 + i) * 512 + 8 * ch; o0 = *(const f32x4*)hp; o1 = *(const f32x4*)(hp + 4); }
        else if (row0 + rel < 0) { o0 = (f32x4){0.f, 0.f, 0.f, 0.f}; o1 = o0; }
        else { const u32x4 v = *(const u32x4*)(U + (size_t)(row0 + rel) * NU + U_DIN + 8 * ch); o0 = (f32x4){bflo(v.x), bfhi(v.x), bflo(v.y), bfhi(v.y)}; o1 = (f32x4){bflo(v.z), bfhi(v.z), bflo(v.w), bfhi(v.w)}; }
        *(LAS f32x4*)(zl + i * CGS + 8 * ch) = o0; *(LAS f32x4*)(zl + i * CGS + 8 * ch + 4) = o1; } }
    u32x4 sgv[4];
#pragma unroll
    for (int k = 0; k < 4; ++k) { const int task = tid + 512 * k; sgv[k] = *(const u32x4*)(U + (size_t)(row0 + (task >> 6)) * NU + U_DSG + 8 * (task & 63)); }
    __syncthreads();
    {
        float z[47];
#pragma unroll
        for (int i = 0; i < 47; ++i) z[i] = zl[i * CGS + c];
        if (samp || tile == 511) {
            float* dst = samp ? p->out + O_SPOOL + (((size_t)l * 32 + b) * 15) * 512 + c : p->out + O_PPOOL + ((size_t)l * 15) * 512 + c;
#pragma unroll
            for (int t = 17; t < 32; ++t) dst[(size_t)(t - 17) * 512] = z[15 + t];
        }
        const int w = 2 << (c >> 7);
#pragma unroll
        for (int t = 0; t < 32; ++t) { float s = 0.f;
#pragma unroll
            for (int i = 0; i < 16; ++i) s += (i < w) ? z[15 + t - i] : 0.f;
            const int pos = samp ? PAST + t : row0 + t; const int cnt = (pos + 1 < w) ? pos + 1 : w;
            pl[t * PST + c] = f2bf(s / (float)cnt - z[15 + t]); }
    }
    __syncthreads();
    LAS bf16_t* sl = (LAS bf16_t*)lds;
    LAS bf16_t* ol = sl + 32 * PST;
#pragma unroll
    for (int k = 0; k < 4; ++k) { const int task = tid + 512 * k, t = task >> 6, ch = task & 63; const u32x4 s = sgv[k];
        u32x4 w; w.x = cvt_pk_bf16(siluf_(bflo(s.x)), siluf_(bfhi(s.x))); w.y = cvt_pk_bf16(siluf_(bflo(s.y)), siluf_(bfhi(s.y))); w.z = cvt_pk_bf16(siluf_(bflo(s.z)), siluf_(bfhi(s.z))); w.w = cvt_pk_bf16(siluf_(bflo(s.w)), siluf_(bfhi(s.w)));
        *(LAS u32x4*)(sl + t * PST + 8 * ch) = w; }
    __syncthreads();
    {
        const int g = wave >> 1, fr = lane & 15, kq = lane >> 4;
        const bf16_t* WT = (const bf16_t*)(p->ws + WS_POOLW) + (size_t)(l * 4 + g) * 128 * 128;
        f32x4 acc[2][4];
#pragma unroll
        for (int mt = 0; mt < 2; ++mt)
#pragma unroll
            for (int nt = 0; nt < 4; ++nt) acc[mt][nt] = (f32x4){0.f, 0.f, 0.f, 0.f};
#pragma unroll
        for (int ks = 0; ks < 4; ++ks) {
            bf16x8 af[2];
#pragma unroll
            for (int mt = 0; mt < 2; ++mt) af[mt] = *(const LAS bf16x8*)(pl + (16 * mt + fr) * PST + g * 128 + 32 * ks + 8 * kq);
#pragma unroll
            for (int nt = 0; nt < 4; ++nt) { const int dl = (wave & 1) * 64 + 16 * nt + fr;
                const bf16x8 bfr = *(const bf16x8*)(WT + (size_t)dl * 128 + 32 * ks + 8 * kq);
#pragma unroll
                for (int mt = 0; mt < 2; ++mt) acc[mt][nt] = __builtin_amdgcn_mfma_f32_16x16x32_bf16(af[mt], bfr, acc[mt][nt], 0, 0, 0); }
        }
#pragma unroll
        for (int nt = 0; nt < 4; ++nt) { const int d = wave * 64 + 16 * nt + fr; const float pb = p->in[I_POOLB][l * 512 + d], ps = p->in[I_POOLS][l * 512 + d];
#pragma unroll
            for (int mt = 0; mt < 2; ++mt)
#pragma unroll
                for (int r = 0; r < 4; ++r) { const int t = 16 * mt + 4 * kq + r; ol[t * PST + d] = f2bf((acc[mt][nt][r] + pb) * ps * bf2f(sl[t * PST + d])); } }
    }
    __syncthreads();
    bf16_t* od = (bf16_t*)(p->ws + WS_OCAT) + (size_t)3 * NTOK * 512;
#pragma unroll
    for (int k = 0; k < 4; ++k) { const int task = tid + 512 * k, t = task >> 6, ch = task & 63; *(u32x4*)(od + (size_t)(row0 + t) * 512 + 8 * ch) = *(const LAS u32x4*)(ol + t * PST + 8 * ch); }
    __syncthreads();
}
__device__ __forceinline__ void fp_unit(KP p, int l, int h, LAS unsigned char* lds, int tid) {
    const float* lf = p->out + O_PLF + (size_t)l * TP * 8 + h;
    LAS float* part = (LAS float*)lds;
    float v[32]; float s = 0.f;
#pragma unroll
    for (int i = 0; i < 32; ++i) { v[i] = lf[(size_t)(tid * 32 + i) * 8]; s += v[i]; }
    part[tid] = s;
    __syncthreads();
    float pre = 0.f;
    for (int j = 0; j < tid; ++j) pre += part[j];
    float* F = (float*)(p->ws + WS_FP) + (size_t)h * TP + tid * 32;
#pragma unroll
    for (int i = 0; i < 32; ++i) { pre += v[i]; F[i] = pre * LOG2E; }
    __syncthreads();
}
__device__ __forceinline__ void gs_unit(KP p, int l, int b, LAS unsigned char* lds, int tid) {
    const int h = tid & 7, ch = tid >> 3;
    const float* cl = p->in[I_CLF] + (((size_t)l * 32 + b) * PAST + ch * 64) * 8 + h;
    LAS float* part = (LAS float*)lds;
    float v[64]; float s = 0.f;
#pragma unroll
    for (int i = 0; i < 64; ++i) v[i] = cl[(size_t)i * 8];
#pragma unroll
    for (int i = 0; i < 64; ++i) s += v[i];
    part[ch * 8 + h] = s;
    __syncthreads();
    float suf = 0.f;
    for (int j = ch + 1; j < 64; ++j) suf += part[j * 8 + h];
    float* G = (float*)(p->ws + WS_GS) + ((size_t)b * 8 + h) * GS_LEN + ch * 64;
#pragma unroll
    for (int i = 63; i >= 0; --i) { G[i] = -suf * LOG2E; suf += v[i]; }
    if (tid < 8) { const float* nl = p->out + O_SLF + ((size_t)l * 1024 + b * 32) * 8 + tid; float* Gn = (float*)(p->ws + WS_GS) + ((size_t)b * 8 + tid) * GS_LEN + PAST; float w[32]; float run = 0.f;
#pragma unroll
        for (int i = 0; i < 32; ++i) w[i] = nl[i * 8];
#pragma unroll
        for (int i = 0; i < 32; ++i) { run += w[i]; Gn[i] = run * LOG2E; } }
    __syncthreads();
}
__device__ __forceinline__ void vt_tile(KP p, int l, int tile, LAS unsigned char* lds, int wave, int lane) {
    const int h = tile >> 8, tb = tile & 255, tl = lane >> 3, q8 = (lane & 7) * 8;
    const bf16_t* U = (const bf16_t*)(p->ws + WS_U);
    LAS unsigned short* scr = (LAS unsigned short*)(lds + wave * (64 * 72 * 2));
    u32x4 kv[8], vv[8];
#pragma unroll
    for (int i = 0; i < 8; ++i) { const bf16_t* rp = U + (size_t)(tb * 64 + 8 * i + tl) * NU + h * 64 + q8; kv[i] = *(const u32x4*)(rp + U_K); vv[i] = *(const u32x4*)(rp + U_V); }
    float mx = 0.f;
#pragma unroll
    for (int i = 0; i < 8; ++i) { const u32x4 w = kv[i];
        float s = bflo(w.x) * bflo(w.x) + bfhi(w.x) * bfhi(w.x) + bflo(w.y) * bflo(w.y) + bfhi(w.y) * bfhi(w.y) + bflo(w.z) * bflo(w.z) + bfhi(w.z) * bfhi(w.z) + bflo(w.w) * bflo(w.w) + bfhi(w.w) * bfhi(w.w);
        s += dpp_mov<0xB1>(s); s += dpp_mov<0x4E>(s); s += dpp_mov<0x141>(s); mx = fmaxf(mx, s); }
    mx = wave_max(mx);
    if (lane == 0) atomicMax((unsigned*)(p->ws + WS_CTL) + CW_KMAX + l * 8 + h, __float_as_uint(mx));
#pragma unroll
    for (int i = 0; i < 8; ++i) { const int t = 8 * i + tl; const u32x4 w = vv[i];
        scr[(q8 + 0) * 72 + t] = (unsigned short)(w.x & 0xffffu); scr[(q8 + 1) * 72 + t] = (unsigned short)(w.x >> 16); scr[(q8 + 2) * 72 + t] = (unsigned short)(w.y & 0xffffu); scr[(q8 + 3) * 72 + t] = (unsigned short)(w.y >> 16);
        scr[(q8 + 4) * 72 + t] = (unsigned short)(w.z & 0xffffu); scr[(q8 + 5) * 72 + t] = (unsigned short)(w.z >> 16); scr[(q8 + 6) * 72 + t] = (unsigned short)(w.w & 0xffffu); scr[(q8 + 7) * 72 + t] = (unsigned short)(w.w >> 16); }
    bf16_t* Vt = (bf16_t*)(p->ws + WS_VT) + ((size_t)h * 64 + lane) * TP + tb * 64;
#pragma unroll
    for (int j = 0; j < 8; ++j) *(u32x4*)(Vt + 8 * j) = *(const LAS u32x4*)(scr + lane * 72 + 8 * j);
}
__device__ __forceinline__ void shift_out(KP p, int l, int tid) {
    const bf16_t* U = (const bf16_t*)(p->ws + WS_U);
    for (int base = tid; base < NSEQ * SHIFT_W; base += 512 * 8) {
        unsigned short v[8];
#pragma unroll
        for (int k = 0; k < 8; ++k) { const int idx = base + k * 512 < NSEQ * SHIFT_W ? base + k * 512 : tid; const int s = idx / SHIFT_W, j = idx - s * SHIFT_W; const int row = s == 0 ? TP - 1 : TP + (s - 1) * 32 + 31; v[k] = U[(size_t)row * NU + U_XC + j]; }
#pragma unroll
        for (int k = 0; k < 8; ++k) { const int idx = base + k * 512; if (idx < NSEQ * SHIFT_W) { const int s = idx / SHIFT_W, j = idx - s * SHIFT_W;
            float* dst = s == 0 ? p->out + O_PSHIFT + (size_t)l * SHIFT_W + j : p->out + O_SSHIFT + ((size_t)l * 32 + (s - 1)) * SHIFT_W + j; *dst = bf2f(v[k]); } }
    }
}
template <bool AT, bool BT, bool NEGA>
__device__ __forceinline__ void mm32(f32x16& acc, const LAS float* Ap, int i0, const LAS float* Bp, int j0, int lane) {
    const int li = lane & 31, kh = lane >> 5;
    const LAS float* ap = AT ? Ap + (8 * kh) * 65 + i0 + li : Ap + (i0 + li) * 65 + 8 * kh;
    const LAS float* bp = BT ? Bp + (j0 + li) * 65 + 8 * kh : Bp + (8 * kh) * 65 + j0 + li;
#pragma unroll 2
    for (int s = 0; s < 4; ++s) {
        float a[8], b[8];
#pragma unroll
        for (int e = 0; e < 8; ++e) { a[e] = AT ? ap[(16 * s + e) * 65] : ap[16 * s + e]; b[e] = BT ? bp[16 * s + e] : bp[(16 * s + e) * 65]; }
        if (NEGA) {
#pragma unroll
            for (int e = 0; e < 8; ++e) a[e] = -a[e]; }
        const bf16x8 af = pack8f((f32x4){a[0], a[1], a[2], a[3]}, (f32x4){a[4], a[5], a[6], a[7]}), bfg = pack8f((f32x4){b[0], b[1], b[2], b[3]}, (f32x4){b[4], b[5], b[6], b[7]});
        acc = __builtin_amdgcn_mfma_f32_32x32x16_bf16(af, bfg, acc, 0, 0, 0);
    }
}
template <int MASK>
__device__ __forceinline__ void st_tile(LAS float* dst, const f32x16& acc, int i0, int j0, int lane) {
    const int li = lane & 31, hi = lane >> 5, j = j0 + li;
#pragma unroll
    for (int r = 0; r < 16; ++r) { const int i = i0 + (r & 3) + 8 * (r >> 2) + 4 * hi; float v = acc[r];
        if (MASK == 1 && !(i < j)) v = 0.f; if (MASK == 2 && !(i <= j)) v = 0.f; dst[i * 65 + j] = v; }
}
struct RwkvSeqInfo { int row0, ntok, prev_kind  , b; };
__device__ __forceinline__ RwkvSeqInfo rwkv_info(int cu) { RwkvSeqInfo s; if (cu < 256) { s.row0 = cu * 64; s.ntok = 64; s.prev_kind = cu == 0 ? 0 : 1; s.b = 0; } else { s.b = cu - 256; s.row0 = TP + s.b * 32; s.ntok = 32; s.prev_kind = 2; } return s; }

__device__ __forceinline__ void rwkv_r1(KP p, int l, int unit, int unit_next, LAS unsigned char* lds, int tid) {
    const int cu = unit >> 3, h = unit & 7, wave = tid >> 6, lane = tid & 63, li = lane & 31, hi = lane >> 5;
    const RwkvSeqInfo si = rwkv_info(cu);
    const bf16_t* U = (const bf16_t*)(p->ws + WS_U);
    LAS float* S0 = (LAS float*)lds; LAS float *S1 = S0 + SLOT_F, *S2 = S0 + 2 * SLOT_F, *S3 = S0 + 3 * SLOT_F, *S4 = S0 + 4 * SLOT_F, *S5 = S0 + 5 * SLOT_F, *S6 = S0 + 6 * SLOT_F, *S7 = S0 + 7 * SLOT_F, *S8 = S0 + 8 * SLOT_F;
    LAS float* gC = S0 + 9 * SLOT_F;
    const int q = wave >> 2, wq = wave & 3, i0 = (wq >> 1) * 32, j0 = (wq & 1) * 32;
    PT0();
    {
        const int j = tid & 63, tq = tid >> 6;
        const int tl = lane >> 3, q8 = (lane & 7) * 8;
#pragma unroll
        for (int kb = 0; kb < 5; kb += 3) {
        u32x4 cur[5], prv[5];
#pragma unroll
        for (int k = kb; k < (kb + 3 < 5 ? kb + 3 : 5); ++k) { const int pid = wave * 5 + k, s = pid >> 3, tb = pid & 7, t = tb * 8 + tl;
            const int xo = (s < 3 ? s * 512 + h * 64 : 1536 + (s - 3) * 64) + q8;
            const int tc = t < si.ntok ? t : si.ntok - 1, tp = tc > 0 ? tc - 1 : (si.prev_kind == 1 ? -1 : 0);
            cur[k] = *(const u32x4*)(U + (size_t)(si.row0 + tc) * NU + U_XC + xo); prv[k] = *(const u32x4*)(U + (size_t)(si.row0 + tp) * NU + U_XC + xo); }
#pragma unroll
        for (int k = kb; k < (kb + 3 < 5 ? kb + 3 : 5); ++k) { const int pid = wave * 5 + k, s = pid >> 3, tb = pid & 7, t = tb * 8 + tl;
            const int xo = (s < 3 ? s * 512 + h * 64 : 1536 + (s - 3) * 64) + q8;
            LAS float* dst = (s == 0 ? S0 : s == 1 ? S1 : s == 2 ? S2 : s == 3 ? S3 : S4) + t * 65 + q8;
            const f32x4 m0 = *(const f32x4*)(p->in[I_MU] + l * SHIFT_W + xo), m1 = *(const f32x4*)(p->in[I_MU] + l * SHIFT_W + xo + 4);
            float x[8] = {bflo(cur[k].x), bfhi(cur[k].x), bflo(cur[k].y), bfhi(cur[k].y), bflo(cur[k].z), bfhi(cur[k].z), bflo(cur[k].w), bfhi(cur[k].w)};
            float pv[8] = {bflo(prv[k].x), bfhi(prv[k].x), bflo(prv[k].y), bfhi(prv[k].y), bflo(prv[k].z), bfhi(prv[k].z), bflo(prv[k].w), bfhi(prv[k].w)};
            if (t == 0 && si.prev_kind != 1) {
                if (si.prev_kind == 2) { const float* sp = p->in[I_SSHIFT] + ((size_t)l * 32 + si.b) * SHIFT_W + xo;
#pragma unroll
                    for (int e = 0; e < 8; ++e) pv[e] = sp[e]; }
                else {
#pragma unroll
                    for (int e = 0; e < 8; ++e) pv[e] = 0.f; } }
#pragma unroll
            for (int e = 0; e < 8; ++e) { const float mu = e < 4 ? m0[e] : m1[e - 4]; float xs = (t < si.ntok) ? x[e] + (pv[e] - x[e]) * mu : 0.f; if (s == 3) xs = fast_tanh(xs); dst[e] = xs; }
        }
        }
#pragma unroll
        for (int mm = 0; mm < 8; ++mm) { const int m = tq * 8 + mm;
            S5[m * 65 + j] = p->in[I_W2][((size_t)l * 64 + m) * 512 + h * 64 + j]; S6[m * 65 + j] = p->in[I_A2][((size_t)l * 64 + m) * 512 + h * 64 + j]; }
    }
    __syncthreads();
    PT1(1);
    {
        f32x16 acc = {};
        const int c = j0 + li;
        if (q == 0) { mm32<false, false, false>(acc, S3, i0, S5, j0, lane); const float w0 = p->in[I_W0][l * 512 + h * 64 + c];
#pragma unroll
            for (int r = 0; r < 16; ++r) { const int t = i0 + (r & 3) + 8 * (r >> 2) + 4 * hi; const float zz = acc[r] + w0;
                const float sp = fmaxf(-zz, 0.f) + __logf(1.f + __expf(-fabsf(zz)));
                S7[t * 65 + c] = (t < si.ntok) ? -__expf(-sp - 0.5f) : 0.f; } }
        else { mm32<false, false, false>(acc, S4, i0, S6, j0, lane); const float a0 = p->in[I_A0][l * 512 + h * 64 + c];
#pragma unroll
            for (int r = 0; r < 16; ++r) { const int t = i0 + (r & 3) + 8 * (r >> 2) + 4 * hi; S8[t * 65 + c] = __builtin_amdgcn_rcpf(1.f + __expf(-(acc[r] + a0))); } }
    }
    __syncthreads();
    PT1(2);
    if (wave == 0) { float run = 0.f;
#pragma unroll 8
        for (int t = 0; t < 64; ++t) { run += S7[t * 65 + lane]; S3[t * 65 + lane] = run; } }
    else { const int c = lane; const float kkw = p->in[I_KK][l * 512 + h * 64 + c], kaw = p->in[I_KA][l * 512 + h * 64 + c], rkw = p->in[I_RK][l * 512 + h * 64 + c];
        for (int t = wave - 1; t < 64; t += 7) { const float kr = S1[t * 65 + c], kv = kr * kkw; const float ss = wave_sum(kv * kv);
            const float kn = kv * (1.f / sqrtf(fmaxf(ss, 1e-24f))); const float a = S8[t * 65 + c]; const float km = kr * (1.f + (a - 1.f) * kaw);
            const float bon = wave_sum(S0[t * 65 + c] * km * rkw);
            S4[t * 65 + c] = kn; S1[t * 65 + c] = km; S8[t * 65 + c] = kn * a;
            if (lane == 0) ((float*)(p->ws + WS_BONUS))[(size_t)unit * 64 + t] = bon; } }
    __syncthreads();
    { const int c = tid & 63, tq = tid >> 6;
#pragma unroll
        for (int tt = 0; tt < 8; ++tt) { const int t = tq * 8 + tt, o = t * 65 + c; const float Lg = S3[o], lw = S7[o];
            const float g = __expf(Lg), gi = __expf(-Lg), gp = __expf(Lg - lw);
            S0[o] *= g; S1[o] *= gi; S8[o] *= gi; S4[o] *= gp; if (t == 63) gC[c] = g; } }
    __syncthreads();
    PT1(3);
    unsigned touch = 0u;
    if (unit_next < NRU && tid < 65 * 5) { const RwkvSeqInfo sn = rwkv_info(unit_next >> 3); const int hn = unit_next & 7, rr = tid / 5, ln = tid - rr * 5;
        const int trow = rr == 0 ? (sn.prev_kind == 1 ? -1 : 0) : (rr - 1 < sn.ntok ? rr - 1 : sn.ntok - 1);
        const int xo = ln < 3 ? ln * 512 + hn * 64 : 1536 + (ln - 3) * 64;
        touch = *(const unsigned*)(U + (size_t)(sn.row0 + trow) * NU + U_XC + xo); }
    { f32x16 acc = {};
      if (q == 0) { mm32<false, true, false>(acc, S1, i0, S4, j0, lane); st_tile<1>(S3, acc, i0, j0, lane); }
      else { mm32<false, true, false>(acc, S8, i0, S4, j0, lane); st_tile<1>(S5, acc, i0, j0, lane); } }
    __syncthreads();
    { f32x16 acc = {};
      if (q == 0) { mm32<true, false, false>(acc, S2, i0, S3, j0, lane); st_tile<0>(S6, acc, i0, j0, lane); }
      else { mm32<false, true, false>(acc, S1, i0, S0, j0, lane); st_tile<2>(S7, acc, i0, j0, lane); } }
    __syncthreads();
    asm volatile("" :: "v"(touch));
    PT1(4);
    { float xa[4], xb[4]; const int ra = 4 * wave, rb = 60 - 4 * wave;
#pragma unroll
      for (int k = 0; k < 4; ++k) { xa[k] = (lane == ra + k) ? 1.f : 0.f; xb[k] = (lane == rb + k) ? 1.f : 0.f; }
      for (int s = ra; s < rb; ++s) { const float mrow = S5[s * 65 + lane];
#pragma unroll
          for (int k = 0; k < 4; ++k) xa[k] -= __builtin_bit_cast(float, __builtin_amdgcn_readlane(__builtin_bit_cast(int, xa[k]), s)) * mrow; }
      for (int s = rb; s < 63; ++s) { const float mrow = S5[s * 65 + lane]; float ya[4], yb[4];
#pragma unroll
          for (int k = 0; k < 4; ++k) { ya[k] = __builtin_bit_cast(float, __builtin_amdgcn_readlane(__builtin_bit_cast(int, xa[k]), s)); yb[k] = __builtin_bit_cast(float, __builtin_amdgcn_readlane(__builtin_bit_cast(int, xb[k]), s)); }
#pragma unroll
          for (int k = 0; k < 4; ++k) { xa[k] -= ya[k] * mrow; xb[k] -= yb[k] * mrow; } }
#pragma unroll
      for (int k = 0; k < 4; ++k) { S3[(ra + k) * 65 + lane] = xa[k]; S3[(rb + k) * 65 + lane] = xb[k]; } }
    __syncthreads();
    { f32x16 acc = {};
      if (q == 0) mm32<true, false, false>(acc, S4, i0, S3, j0, lane); else mm32<false, false, false>(acc, S6, i0, S3, j0, lane);
      __syncthreads();
      st_tile<0>(q == 0 ? S3 : S6, acc, i0, j0, lane); }
    __syncthreads();
    PT1(5);
    { f32x16 acc = {};
      if (q == 1) { mm32<false, true, false>(acc, S8, i0, S0, j0, lane); st_tile<2>(S4, acc, i0, j0, lane); }
      else { mm32<false, false, false>(acc, S3, i0, S8, j0, lane);
          const int jc = j0 + li; const float gc = gC[jc]; float* TQ = (float*)(p->ws + WS_TQ) + (size_t)unit * 4096;
#pragma unroll
          for (int rg = 0; rg < 4; ++rg) { const int ab = i0 + 8 * rg + 4 * hi; f32x4 o;
#pragma unroll
              for (int e = 0; e < 4; ++e) o[e] = ((ab + e == jc) ? gc : 0.f) - acc[rg * 4 + e] * gc;
              *(f32x4*)(TQ + ((((jc >> 4) * 4 + (ab >> 4)) * 64 + ((ab & 15) >> 2) * 16 + (jc & 15)) * 4)) = o; } } }
    __syncthreads();
    { f32x16 acc = {};
      if (q == 0) { mm32<true, false, false>(acc, S2, i0, S1, j0, lane); mm32<false, false, true>(acc, S6, i0, S8, j0, lane);
          const int jc = j0 + li; const float gc = gC[jc]; float* GM = (float*)(p->ws + WS_GM) + (size_t)unit * 4096;
#pragma unroll
          for (int r = 0; r < 16; ++r) GM[(i0 + (r & 3) + 8 * (r >> 2) + 4 * hi) * 64 + jc] = acc[r] * gc; }
      else { mm32<true, false, false>(acc, S2, i0, S7, j0, lane); mm32<false, false, true>(acc, S6, i0, S4, j0, lane);
          float* Y0T = (float*)(p->ws + WS_Y0T) + (size_t)unit * 4096;
#pragma unroll
          for (int rg = 0; rg < 4; ++rg) *(f32x4*)(Y0T + (((((j0 >> 5) * 2 + (i0 >> 5)) * 4 + rg) * 2 + hi) * 32 + li) * 4) = (f32x4){acc[rg * 4], acc[rg * 4 + 1], acc[rg * 4 + 2], acc[rg * 4 + 3]}; } }
    if (q == 0) { f32x16 acc;
#pragma unroll
        for (int r = 0; r < 16; ++r) acc[r] = S0[(j0 + li) * 65 + i0 + (r & 3) + 8 * (r >> 2) + 4 * hi];
        mm32<false, false, true>(acc, S3, i0, S4, j0, lane);
        float* ET = (float*)(p->ws + WS_ET) + (size_t)unit * 4096;
#pragma unroll
        for (int rg = 0; rg < 4; ++rg) *(f32x4*)(ET + ((((j0 >> 5) * 2 + (i0 >> 5)) * 8 + 2 * rg + hi) * 32 + li) * 4) = (f32x4){acc[rg * 4], acc[rg * 4 + 1], acc[rg * 4 + 2], acc[rg * 4 + 3]}; }
    __syncthreads();
    PT1(6);
}
template <bool SCQ>
__device__ __forceinline__ void chain_run(f32x4 (&st)[4], const float* TQ, const float* GM, float* SC, int nsteps, int i, int g, int lane) {
    constexpr size_t STRIDE = (size_t)8 * 4096;
    f32x4 tq[16], gm[4];
#pragma unroll
    for (int x = 0; x < 16; ++x) tq[x] = *(const f32x4*)(TQ + (x * 64 + lane) * 4);
#pragma unroll
    for (int tl = 0; tl < 4; ++tl) gm[tl] = GM ? *(const f32x4*)(GM + i * 64 + 16 * tl + 4 * g) : (f32x4){0.f, 0.f, 0.f, 0.f};
    for (int c = 0; c < nsteps; ++c) {
        if (SC) {
            if (SCQ) {
#pragma unroll
                for (int tl = 0; tl < 4; ++tl) *(f32x4*)(SC + c * STRIDE + ((((i >> 5) * 2 + (tl >> 1)) * 8 + 4 * (tl & 1) + g) * 32 + (i & 31)) * 4) = st[tl]; }
            else {
#pragma unroll
                for (int tl = 0; tl < 4; ++tl) *(f32x4*)(SC + c * STRIDE + i * 64 + 16 * tl + 4 * g) = st[tl]; } }
        f32x4 tqn[16], gmn[4];
        const int cn = (c + 1 < nsteps) ? c + 1 : c;
#pragma unroll
        for (int x = 0; x < 16; ++x) tqn[x] = *(const f32x4*)(TQ + cn * STRIDE + (x * 64 + lane) * 4);
#pragma unroll
        for (int tl = 0; tl < 4; ++tl) gmn[tl] = GM ? *(const f32x4*)(GM + cn * STRIDE + i * 64 + 16 * tl + 4 * g) : (f32x4){0.f, 0.f, 0.f, 0.f};
        f32x4 acc[4];
#pragma unroll
        for (int tp = 0; tp < 4; ++tp) acc[tp] = gm[tp];
#pragma unroll
        for (int tl = 0; tl < 4; ++tl)
#pragma unroll
            for (int r = 0; r < 4; ++r)
#pragma unroll
                for (int tp = 0; tp < 4; ++tp) acc[tp] = __builtin_amdgcn_mfma_f32_16x16x4f32(tq[tp * 4 + tl][r], st[tl][r], acc[tp], 0, 0, 0);
#pragma unroll
        for (int tl = 0; tl < 4; ++tl) st[tl] = acc[tl];
#pragma unroll
        for (int x = 0; x < 16; ++x) tq[x] = tqn[x];
#pragma unroll
        for (int tl = 0; tl < 4; ++tl) gm[tl] = gmn[tl];
    }
}
constexpr int CH_SLOT = 32768;
#define CH_LD(R, STEP) do { const int s_ = (STEP) < nsteps ? (STEP) : nsteps - 1; _Pragma("unroll") for (int k = 0; k < 4; ++k) { R[k] = *(const f32x4*)(TQ + (size_t)s_ * STRIDE + (k * 256 + ll) * 4); \
        R[4 + k] = GM ? *(const f32x4*)(GM + (size_t)s_ * STRIDE + (k * 256 + ll) * 4) : (f32x4){0.f, 0.f, 0.f, 0.f}; } } while (0)
#define CH_WR(R, SLOT) do { LAS float* d_ = (LAS float*)(lds + (SLOT) * CH_SLOT); _Pragma("unroll") for (int k = 0; k < 4; ++k) { *(LAS f32x4*)(d_ + (k * 256 + ll) * 4) = R[k]; *(LAS f32x4*)(d_ + 4096 + (k * 256 + ll) * 4) = R[4 + k]; } } while (0)
template <bool SCQ>
__device__ __forceinline__ void chain_block(f32x4 (&st)[4], const float* TQ, const float* GM, float* SC, int nsteps, LAS unsigned char* lds, int wave, int lane) {
    constexpr size_t STRIDE = (size_t)8 * 4096;
    if (wave >= 4) {
        const int ll = (wave - 4) * 64 + lane;
        f32x4 r0[8], r1[8], r2[8];
        CH_LD(r0, 0); CH_LD(r1, 1); CH_LD(r2, 2);
        CH_WR(r0, 0);
        __syncthreads();
        for (int c = 0; c < nsteps; c += 3) {
            CH_WR(r1, (c + 1) & 1); CH_LD(r0, c + 3); __syncthreads();
            if (c + 1 < nsteps) { CH_WR(r2, (c + 2) & 1); CH_LD(r1, c + 4); __syncthreads(); }
            if (c + 2 < nsteps) { CH_WR(r0, (c + 3) & 1); CH_LD(r2, c + 5); __syncthreads(); }
        }
    } else {
        const int fr = lane & 15, g = lane >> 4, i = wave * 16 + fr;
        __syncthreads();
        for (int c = 0; c < nsteps; ++c) {
            if (SC) {
                if (SCQ) {
#pragma unroll
                    for (int tl = 0; tl < 4; ++tl) *(f32x4*)(SC + c * STRIDE + ((((i >> 5) * 2 + (tl >> 1)) * 8 + 4 * (tl & 1) + g) * 32 + (i & 31)) * 4) = st[tl]; }
                else {
#pragma unroll
                    for (int tl = 0; tl < 4; ++tl) *(f32x4*)(SC + c * STRIDE + i * 64 + 16 * tl + 4 * g) = st[tl]; } }
            const LAS float* sl = (const LAS float*)(lds + (c & 1) * CH_SLOT);
            f32x4 acc[4];
#pragma unroll
            for (int tp = 0; tp < 4; ++tp) acc[tp] = *(const LAS f32x4*)(sl + 4096 + i * 64 + 16 * tp + 4 * g);
#pragma unroll
            for (int tl = 0; tl < 4; ++tl) { f32x4 tq[4];
#pragma unroll
                for (int tp = 0; tp < 4; ++tp) tq[tp] = *(const LAS f32x4*)(sl + ((tp * 4 + tl) * 64 + lane) * 4);
#pragma unroll
                for (int r = 0; r < 4; ++r)
#pragma unroll
                    for (int tp = 0; tp < 4; ++tp) acc[tp] = __builtin_amdgcn_mfma_f32_16x16x4f32(tq[tp][r], st[tl][r], acc[tp], 0, 0, 0); }
#pragma unroll
            for (int tl = 0; tl < 4; ++tl) st[tl] = acc[tl];
            __syncthreads();
        }
    }
}
__device__ __forceinline__ void rwkv_l1_block(KP p, int task, LAS unsigned char* lds, int wave, int lane) {
    const int kind = task & 1, h = (task >> 1) & 7, grp = task >> 4, iq = wave & 3;
    const int fr = lane & 15, g = lane >> 4, i = iq * 16 + fr;
    const size_t u0 = ((size_t)(grp * 16) * 8 + h) * 4096;
    f32x4 st[4];
#pragma unroll
    for (int tl = 0; tl < 4; ++tl)
#pragma unroll
        for (int r = 0; r < 4; ++r) st[tl][r] = (kind == 1 && i == 16 * tl + 4 * g + r) ? 1.f : 0.f;
    chain_block<false>(st, (const float*)(p->ws + WS_TQ) + u0, kind == 0 ? (const float*)(p->ws + WS_GM) + u0 : nullptr, nullptr, 16, lds, wave, lane);
    if (wave < 4) { const size_t gb = ((size_t)grp * 8 + h) * 4096;
        if (kind == 0) { float* GG = (float*)(p->ws + WS_GG) + gb;
#pragma unroll
            for (int tl = 0; tl < 4; ++tl) *(f32x4*)(GG + i * 64 + 16 * tl + 4 * g) = st[tl]; }
        else { float* TG = (float*)(p->ws + WS_TG) + gb;
#pragma unroll
            for (int tl = 0; tl < 4; ++tl)
#pragma unroll
                for (int r = 0; r < 4; ++r) TG[((tl * 4 + iq) * 64 + (fr >> 2) * 16 + 4 * g + r) * 4 + (fr & 3)] = st[tl][r]; } }
    __syncthreads();
}
__device__ __forceinline__ void rwkv_l2_block(KP p, int l, int h, LAS unsigned char* lds, int wave, int lane) {
    const int iq = wave & 3, fr = lane & 15, g = lane >> 4, i = iq * 16 + fr;
    f32x4 st[4];
#pragma unroll
    for (int tl = 0; tl < 4; ++tl) st[tl] = (f32x4){0.f, 0.f, 0.f, 0.f};
    chain_block<false>(st, (const float*)(p->ws + WS_TG) + (size_t)h * 4096, (const float*)(p->ws + WS_GG) + (size_t)h * 4096, (float*)(p->ws + WS_SG) + (size_t)h * 4096, 16, lds, wave, lane);
    if (wave < 4) { float* dst = p->out + O_PWKV + (((size_t)l * 8 + h) * 64 + i) * 64;
#pragma unroll
        for (int tl = 0; tl < 4; ++tl) *(f32x4*)(dst + 16 * tl + 4 * g) = st[tl]; }
    __syncthreads();
}
__device__ __forceinline__ void rwkv_l3_block(KP p, int l, int task, LAS unsigned char* lds, int wave, int lane) {
    const int h = task & 7, grp = task >> 3, iq = wave & 3, fr = lane & 15, g = lane >> 4, i = iq * 16 + fr;
    f32x4 st[4];
#pragma unroll
    for (int tl = 0; tl < 4; ++tl) st[tl] = (f32x4){0.f, 0.f, 0.f, 0.f};
    if (grp > 0) chain_block<false>(st, (const float*)(p->ws + WS_TG) + (size_t)h * 4096, (const float*)(p->ws + WS_GG) + (size_t)h * 4096, nullptr, grp, lds, wave, lane);
    const size_t u0 = ((size_t)(grp * 16) * 8 + h) * 4096;
    chain_block<true>(st, (const float*)(p->ws + WS_TQ) + u0, (const float*)(p->ws + WS_GM) + u0, (float*)(p->ws + WS_SC) + u0, 16, lds, wave, lane);
    if (grp == 15 && wave < 4) { float* dst = p->out + O_PWKV + (((size_t)l * 8 + h) * 64 + i) * 64;
#pragma unroll
        for (int tl = 0; tl < 4; ++tl) *(f32x4*)(dst + 16 * tl + 4 * g) = st[tl]; }
    __syncthreads();
}
__device__ __forceinline__ void rwkv_samp_task(KP p, int l, int t2, int lane) {
    const int fr = lane & 15, g = lane >> 4, iq = t2 & 3, h = (t2 >> 2) & 7, b = t2 >> 5, i = iq * 16 + fr;
    f32x4 st[4];
    const float* s0 = p->in[I_SWKV] + ((((size_t)l * 32 + b) * 8 + h) * 64 + i) * 64;
#pragma unroll
    for (int tl = 0; tl < 4; ++tl) st[tl] = *(const f32x4*)(s0 + 16 * tl + 4 * g);
    const size_t u0 = ((size_t)(256 + b) * 8 + h) * 4096;
    chain_run<true>(st, (const float*)(p->ws + WS_TQ) + u0, (const float*)(p->ws + WS_GM) + u0, (float*)(p->ws + WS_SC) + u0, 1, i, g, lane);
    float* dst = p->out + O_SWKV + ((((size_t)l * 32 + b) * 8 + h) * 64 + i) * 64;
#pragma unroll
    for (int tl = 0; tl < 4; ++tl) *(f32x4*)(dst + 16 * tl + 4 * g) = st[tl];
}
__device__ __forceinline__ void rwkv_r3_task(KP p, int l, int task, int lane) {
    const int unit = task >> 1, th = task & 1, cu = unit >> 3, h = unit & 7, li = lane & 31, hi = lane >> 5;
    const RwkvSeqInfo si = rwkv_info(cu);
    if (th * 32 >= si.ntok) return;
    const bf16_t* U = (const bf16_t*)(p->ws + WS_U);
    const size_t ub = (size_t)unit * 4096; const int t = th * 32 + li;
    const float* SC = (const float*)(p->ws + WS_SC) + ub; const float* ET = (const float*)(p->ws + WS_ET) + ub; const float* Y0T = (const float*)(p->ws + WS_Y0T) + ub;
    f32x16 acc[2];
#pragma unroll
    for (int ti = 0; ti < 2; ++ti)
#pragma unroll
        for (int rg = 0; rg < 4; ++rg) { const f32x4 y0 = *(const f32x4*)(Y0T + ((((th * 2 + ti) * 4 + rg) * 2 + hi) * 32 + li) * 4);
#pragma unroll
            for (int e = 0; e < 4; ++e) acc[ti][rg * 4 + e] = y0[e]; }
    f32x4 eb[8], sa0[8], sa1[8];
#pragma unroll
    for (int s4 = 0; s4 < 8; ++s4) { eb[s4] = *(const f32x4*)(ET + (((th * 2 + hi) * 8 + s4) * 32 + li) * 4); sa0[s4] = *(const f32x4*)(SC + (((0 * 2 + hi) * 8 + s4) * 32 + li) * 4); sa1[s4] = *(const f32x4*)(SC + (((1 * 2 + hi) * 8 + s4) * 32 + li) * 4); }
#pragma unroll
    for (int ks = 0; ks < 4; ++ks) {
        const bf16x8 bfr = pack8f(eb[2 * ks], eb[2 * ks + 1]);
        acc[0] = __builtin_amdgcn_mfma_f32_32x32x16_bf16(pack8f(sa0[2 * ks], sa0[2 * ks + 1]), bfr, acc[0], 0, 0, 0);
        acc[1] = __builtin_amdgcn_mfma_f32_32x32x16_bf16(pack8f(sa1[2 * ks], sa1[2 * ks + 1]), bfr, acc[1], 0, 0, 0);
    }
    float s1 = 0.f;
#pragma unroll
    for (int ti = 0; ti < 2; ++ti)
#pragma unroll
        for (int r = 0; r < 16; ++r) s1 += acc[ti][r];
    s1 = xhalf_sum(s1); const float mean = s1 * (1.f / 64.f);
    float s2 = 0.f;
#pragma unroll
    for (int ti = 0; ti < 2; ++ti)
#pragma unroll
        for (int r = 0; r < 16; ++r) { const float d = acc[ti][r] - mean; s2 += d * d; }
    s2 = xhalf_sum(s2); const float rstd = 1.f / sqrtf(s2 * (1.f / 64.f) + 64e-5f);
    if (t >= si.ntok) return;
    const float bon = ((const float*)(p->ws + WS_BONUS))[(size_t)unit * 64 + t];
    const size_t row = (size_t)(si.row0 + t);
    bf16_t* oc = (bf16_t*)(p->ws + WS_OCAT) + (size_t)2 * NTOK * 512 + row * 512 + h * 64;
    u32x2 wout[2][4];
#pragma unroll
    for (int ti = 0; ti < 2; ++ti)
#pragma unroll
        for (int rg = 0; rg < 4; ++rg) { const int i = 32 * ti + 8 * rg + 4 * hi, c = h * 64 + i;
            const f32x4 gg = *(const f32x4*)(p->in[I_GNG] + l * 512 + c), gb = *(const f32x4*)(p->in[I_GNB] + l * 512 + c), mu = *(const f32x4*)(p->in[I_MU] + l * SHIFT_W + 1024 + c);
            const u32x2 vx = *(const u32x2*)(U + row * NU + U_XC + 1024 + c); const u32x2 sg = *(const u32x2*)(U + row * NU + U_CSG + c);
            f32x4 vc = (f32x4){bflo(vx.x), bfhi(vx.x), bflo(vx.y), bfhi(vx.y)}, vp;
            {
                const u32x2 px = *(const u32x2*)(U + (row > 0 ? row - 1 : 0) * NU + U_XC + 1024 + c); const f32x4 ss = *(const f32x4*)(p->in[I_SSHIFT] + ((size_t)l * 32 + si.b) * SHIFT_W + 1024 + c);
                const f32x4 up = (f32x4){bflo(px.x), bfhi(px.x), bflo(px.y), bfhi(px.y)};
                vp = (t > 0 || si.prev_kind == 1) ? up : (si.prev_kind == 2 ? ss : (f32x4){0.f, 0.f, 0.f, 0.f}); }
            const f32x4 vs = vc + (vp - vc) * mu;
            const f32x4 sgf = (f32x4){bflo(sg.x), bfhi(sg.x), bflo(sg.y), bfhi(sg.y)};
            f32x4 o;
#pragma unroll
            for (int e = 0; e < 4; ++e) o[e] = (((acc[ti][rg * 4 + e] - mean) * rstd) * gg[e] + gb[e] + bon * vs[e]) * siluf_(sgf[e]);
            wout[ti][rg].x = cvt_pk_bf16(o[0], o[1]); wout[ti][rg].y = cvt_pk_bf16(o[2], o[3]); }
#pragma unroll
    for (int ti = 0; ti < 2; ++ti)
#pragma unroll
        for (int rg = 0; rg < 4; ++rg) *(u32x2*)(oc + 32 * ti + 8 * rg + 4 * hi) = wout[ti][rg];
}
__device__ __forceinline__ int krow(int i) { return (i & 3) + 4 * ((i >> 3) & 1) + 8 * ((i >> 2) & 1) + 16 * (i >> 4); }
__device__ __forceinline__ bf16x8 pack8(const f32x16& v, int o) { u32x4 w; w.x = cvt_pk_bf16(v[o], v[o + 1]); w.y = cvt_pk_bf16(v[o + 2], v[o + 3]); w.z = cvt_pk_bf16(v[o + 4], v[o + 5]); w.w = cvt_pk_bf16(v[o + 6], v[o + 7]); return __builtin_bit_cast(bf16x8, w); }
constexpr float ATT_NEG = -1e30f;
template <bool HALF>
__device__ __forceinline__ void softmax_tile(f32x16& p0, f32x16& p1, float& m, float& lsum, f32x16 (&O)[2], bf16x8 (&pb)[4]) {
    float mx = p0[0];
#pragma unroll
    for (int r = 1; r < 16; ++r) mx = fmaxf(mx, p0[r]);
    if (!HALF) {
#pragma unroll
        for (int r = 0; r < 16; ++r) mx = fmaxf(mx, p1[r]); }
    mx = xhalf_max(mx);
    const float mn = fmaxf(m, mx), alpha = __builtin_amdgcn_exp2f(m - mn);
    m = mn;
    float s = 0.f;
#pragma unroll
    for (int r = 0; r < 16; ++r) { p0[r] = __builtin_amdgcn_exp2f(p0[r] - mn); s += p0[r]; }
    if (!HALF) {
#pragma unroll
        for (int r = 0; r < 16; ++r) { p1[r] = __builtin_amdgcn_exp2f(p1[r] - mn); s += p1[r]; } }
    lsum = lsum * alpha + s;
#pragma unroll
    for (int r = 0; r < 16; ++r) { O[0][r] *= alpha; O[1][r] *= alpha; }
    pb[0] = pack8(p0, 0); pb[1] = pack8(p0, 8);
    if (!HALF) { pb[2] = pack8(p1, 0); pb[3] = pack8(p1, 8); }
}
constexpr int AKS = 72;
constexpr int ATT_KB = 0, ATT_VB = 2 * 64 * AKS * 2, ATT_FB = 4 * 64 * AKS * 2, ATT_SC = ATT_FB + 2 * 64 * 4;
__device__ __forceinline__ void attn_prompt_unit(KP p, int l, int h, int qb, LAS unsigned char* lds, int tid) {
    const bf16_t* U = (const bf16_t*)(p->ws + WS_U); const bf16_t* Vt = (const bf16_t*)(p->ws + WS_VT) + (size_t)h * 64 * TP; const float* F = (const float*)(p->ws + WS_FP) + (size_t)h * TP;
    const int wave = tid >> 6, lane = tid & 63, li = lane & 31, hi = lane >> 5;
    const int q0 = qb * 256, q = q0 + wave * 32 + li;
    bf16x8 qf[4];
    { const float sc = 0.125f * LOG2E;
#pragma unroll
      for (int d0 = 0; d0 < 4; ++d0) { const u32x4 w = *(const u32x4*)(U + (size_t)q * NU + U_Q + h * 64 + 16 * d0 + 8 * hi);
          qf[d0] = pack8f((f32x4){bflo(w.x) * sc, bfhi(w.x) * sc, bflo(w.y) * sc, bfhi(w.y) * sc}, (f32x4){bflo(w.z) * sc, bfhi(w.z) * sc, bflo(w.w) * sc, bfhi(w.w) * sc}); } }
    const float fq = F[q];
    float m = ATT_NEG, lsum = 0.f; f32x16 O[2] = {};
    const int NT = (q0 + 256) / 64;
    LAS float* qmx = (LAS float*)(lds + ATT_SC); LAS float* mmv = qmx + 8;
    { float q2 = 0.f;
#pragma unroll
      for (int d0 = 0; d0 < 4; ++d0) { const u32x4 w = __builtin_bit_cast(u32x4, qf[d0]); q2 += bflo(w.x) * bflo(w.x) + bfhi(w.x) * bfhi(w.x) + bflo(w.y) * bflo(w.y) + bfhi(w.y) * bfhi(w.y) + bflo(w.z) * bflo(w.z) + bfhi(w.z) * bfhi(w.z) + bflo(w.w) * bflo(w.w) + bfhi(w.w) * bfhi(w.w); }
      q2 = wave_max(xhalf_sum(q2)); if (lane == 0) { qmx[wave] = q2; mmv[wave] = ATT_NEG; } }
    const float kmax2 = __uint_as_float(((const unsigned*)(p->ws + WS_CTL))[CW_KMAX + l * 8 + h]), fq0 = F[q0];
    const int srow = tid >> 3, sch = tid & 7;
    const bf16_t* kg = U + (size_t)srow * NU + U_K + h * 64 + 8 * sch; const bf16_t* vg = Vt + (size_t)srow * TP + 8 * sch;
    LAS unsigned char* kdst = lds + ATT_KB + (srow * AKS + 8 * sch) * 2; LAS unsigned char* vdst = lds + ATT_VB + (srow * AKS + 8 * sch) * 2;
    u32x4 kr = *(const u32x4*)(kg + (size_t)(NT - 1) * 64 * NU), vr = *(const u32x4*)(vg + (NT - 1) * 64); float fr = tid < 64 ? F[(NT - 1) * 64 + tid] : 0.f;
    *(LAS u32x4*)kdst = kr; *(LAS u32x4*)vdst = vr; if (tid < 64) ((LAS float*)(lds + ATT_FB))[tid] = fr;
    __syncthreads();
    const int ka = krow(li);
    float qkb; { float q2 = qmx[0];
#pragma unroll
      for (int w = 1; w < 8; ++w) q2 = fmaxf(q2, qmx[w]);
      qkb = 1.02f * sqrtf(q2 * kmax2) + fq0; }
    for (int t = NT - 1, buf = 0; t >= 0; --t, buf ^= 1) {
        { float mmin = mmv[0];
#pragma unroll
          for (int w = 1; w < 8; ++w) mmin = fminf(mmin, mmv[w]);
          if (qkb - ((const LAS float*)(lds + ATT_FB))[buf * 64 + 63] < mmin - 40.f) break; }
        if (t > 0) { kr = *(const u32x4*)(kg + (size_t)(t - 1) * 64 * NU); vr = *(const u32x4*)(vg + (t - 1) * 64); if (tid < 64) fr = F[(t - 1) * 64 + tid]; }
        if (64 * t <= q0 + wave * 32 + 31) {
            const LAS bf16_t* Kb = (const LAS bf16_t*)(lds + ATT_KB) + buf * 64 * AKS; const LAS bf16_t* Vb = (const LAS bf16_t*)(lds + ATT_VB) + buf * 64 * AKS; const LAS float* Fb = (const LAS float*)(lds + ATT_FB) + buf * 64;
            f32x16 p0, p1;
#pragma unroll
            for (int g2 = 0; g2 < 2; ++g2) { const f32x4 a = *(const LAS f32x4*)(Fb + 8 * hi + 16 * g2), b = *(const LAS f32x4*)(Fb + 8 * hi + 16 * g2 + 4), c = *(const LAS f32x4*)(Fb + 32 + 8 * hi + 16 * g2), d = *(const LAS f32x4*)(Fb + 32 + 8 * hi + 16 * g2 + 4);
#pragma unroll
                for (int e = 0; e < 4; ++e) { p0[8 * g2 + e] = fq - a[e]; p0[8 * g2 + 4 + e] = fq - b[e]; p1[8 * g2 + e] = fq - c[e]; p1[8 * g2 + 4 + e] = fq - d[e]; } }
#pragma unroll
            for (int d0 = 0; d0 < 4; ++d0) { const bf16x8 a0 = *(const LAS bf16x8*)(Kb + ka * AKS + 16 * d0 + 8 * hi), a1 = *(const LAS bf16x8*)(Kb + (ka + 32) * AKS + 16 * d0 + 8 * hi);
                p0 = __builtin_amdgcn_mfma_f32_32x32x16_bf16(a0, qf[d0], p0, 0, 0, 0); p1 = __builtin_amdgcn_mfma_f32_32x32x16_bf16(a1, qf[d0], p1, 0, 0, 0); }
            if (64 * t + 63 > q0 + wave * 32) {
#pragma unroll
                for (int r = 0; r < 16; ++r) { const int kv = 64 * t + 8 * hi + 16 * (r >> 3) + (r & 7); if (kv > q) p0[r] = -INFINITY; if (kv + 32 > q) p1[r] = -INFINITY; } }
            bf16x8 pb[4];
            softmax_tile<false>(p0, p1, m, lsum, O, pb);
#pragma unroll
            for (int dt = 0; dt < 2; ++dt)
#pragma unroll
                for (int s = 0; s < 4; ++s) { const bf16x8 a = *(const LAS bf16x8*)(Vb + (32 * dt + li) * AKS + 16 * (s & 1) + 32 * (s >> 1) + 8 * hi);
                    O[dt] = __builtin_amdgcn_mfma_f32_32x32x16_bf16(a, pb[s], O[dt], 0, 0, 0); }
        }
        { const float wm = wave_min(m); if (lane == 0) mmv[wave] = wm; }
        if (t > 0) { const int nb = buf ^ 1; *(LAS u32x4*)(kdst + nb * 64 * AKS * 2) = kr; *(LAS u32x4*)(vdst + nb * 64 * AKS * 2) = vr; if (tid < 64) ((LAS float*)(lds + ATT_FB))[nb * 64 + tid] = fr; }
        __syncthreads();
    }
    __syncthreads();
    const float inv = 1.f / xhalf_sum(lsum);
    bf16_t* ob = (bf16_t*)(p->ws + WS_OCAT) + (size_t)1 * NTOK * 512 + (size_t)q * 512 + h * 64;
    u32x2 sgv[2][4];
#pragma unroll
    for (int dt = 0; dt < 2; ++dt)
#pragma unroll
        for (int rg = 0; rg < 4; ++rg) sgv[dt][rg] = *(const u32x2*)(U + (size_t)q * NU + U_BSG + h * 64 + 32 * dt + 8 * rg + 4 * hi);
#pragma unroll
    for (int dt = 0; dt < 2; ++dt)
#pragma unroll
        for (int rg = 0; rg < 4; ++rg) { const int d = 32 * dt + 8 * rg + 4 * hi; const u32x2 sg = sgv[dt][rg];
            u32x2 w; w.x = cvt_pk_bf16(O[dt][rg * 4] * inv * siluf_(bflo(sg.x)), O[dt][rg * 4 + 1] * inv * siluf_(bfhi(sg.x))); w.y = cvt_pk_bf16(O[dt][rg * 4 + 2] * inv * siluf_(bflo(sg.y)), O[dt][rg * 4 + 3] * inv * siluf_(bfhi(sg.y)));
            *(u32x2*)(ob + d) = w; }
}
__device__ __forceinline__ void attn_sample_unit(KP p, int l, int b, int h, LAS unsigned char* lds, int tid) {
    const bf16_t* U = (const bf16_t*)(p->ws + WS_U);
    const int wave = tid >> 6, lane = tid & 63, li = lane & 31, hi = lane >> 5;
    const size_t qrow = (size_t)TP + b * 32 + li;
    const float* G = (const float*)(p->ws + WS_GS) + ((size_t)b * 8 + h) * GS_LEN;
    bf16x8 qf[4];
    { const float sc = 0.125f * LOG2E;
#pragma unroll
      for (int d0 = 0; d0 < 4; ++d0) { const u32x4 w = *(const u32x4*)(U + qrow * NU + U_Q + h * 64 + 16 * d0 + 8 * hi);
          qf[d0] = pack8f((f32x4){bflo(w.x) * sc, bfhi(w.x) * sc, bflo(w.y) * sc, bfhi(w.y) * sc}, (f32x4){bflo(w.z) * sc, bfhi(w.z) * sc, bflo(w.w) * sc, bfhi(w.w) * sc}); } }
    const float fq = G[PAST + li];
    float m = ATT_NEG, lsum = 0.f; f32x16 O[2] = {};
    const float* CK = p->in[I_CK] + (((size_t)l * 32 + b) * PAST) * 512 + h * 64; const float* CV = p->in[I_CV] + (((size_t)l * 32 + b) * PAST) * 512 + h * 64;
    const int ka = krow(li);
    float kmax2;
    { float mx = 0.f; const f32x4* kp4 = (const f32x4*)CK + (tid & 15);
#pragma unroll 1
      for (int it = 0; it < 8; ++it) { f32x4 kv[16];
#pragma unroll
          for (int j = 0; j < 16; ++j) kv[j] = kp4[(size_t)((it * 16 + j) * 32 + (tid >> 4)) * 128];
#pragma unroll
          for (int j = 0; j < 16; ++j) { float s = kv[j][0] * kv[j][0] + kv[j][1] * kv[j][1] + kv[j][2] * kv[j][2] + kv[j][3] * kv[j][3];
              s += dpp_mov<0xB1>(s); s += dpp_mov<0x4E>(s); s += dpp_mov<0x141>(s); s += dpp_mov<0x140>(s); mx = fmaxf(mx, s); } }
      mx = wave_max(mx); LAS float* kml = (LAS float*)lds;
      if (lane == 0) kml[wave] = mx;
      __syncthreads();
      kmax2 = kml[0];
#pragma unroll
      for (int w = 1; w < 8; ++w) kmax2 = fmaxf(kmax2, kml[w]);
      __syncthreads(); }
    float qkb;
    { float q2 = 0.f;
#pragma unroll
      for (int d0 = 0; d0 < 4; ++d0) { const u32x4 w = __builtin_bit_cast(u32x4, qf[d0]); q2 += bflo(w.x) * bflo(w.x) + bfhi(w.x) * bfhi(w.x) + bflo(w.y) * bflo(w.y) + bfhi(w.y) * bfhi(w.y) + bflo(w.z) * bflo(w.z) + bfhi(w.z) * bfhi(w.z) + bflo(w.w) * bflo(w.w) + bfhi(w.w) * bfhi(w.w); }
      q2 = wave_max(xhalf_sum(q2)); qkb = 1.02f * sqrtf(q2 * kmax2) + G[PAST]; }
    {
        f32x16 p0, p1 = {};
#pragma unroll
        for (int g2 = 0; g2 < 2; ++g2) { const float* gp = G + PAST + 8 * hi + 16 * g2; const f32x4 a = *(const f32x4*)gp, bq = *(const f32x4*)(gp + 4);
#pragma unroll
            for (int e = 0; e < 4; ++e) { p0[8 * g2 + e] = fq - a[e]; p0[8 * g2 + 4 + e] = fq - bq[e]; } }
#pragma unroll
        for (int d0 = 0; d0 < 4; ++d0) { const bf16x8 a0 = *(const bf16x8*)(U + ((size_t)TP + b * 32 + ka) * NU + U_K + h * 64 + 16 * d0 + 8 * hi);
            p0 = __builtin_amdgcn_mfma_f32_32x32x16_bf16(a0, qf[d0], p0, 0, 0, 0); }
#pragma unroll
        for (int r = 0; r < 16; ++r) { const int kv = 8 * hi + 16 * (r >> 3) + (r & 7); if (kv > li) p0[r] = -INFINITY; }
        bf16x8 pb[4];
        softmax_tile<true>(p0, p1, m, lsum, O, pb);
        if (wave == 7) {
#pragma unroll
            for (int dt = 0; dt < 2; ++dt)
#pragma unroll
                for (int s = 0; s < 2; ++s) { const bf16_t* vp = U + ((size_t)TP + b * 32 + 16 * s + 8 * hi) * NU + U_V + h * 64 + 32 * dt + li; u32x4 w;
                    w.x = (unsigned)vp[0] | ((unsigned)vp[NU] << 16); w.y = (unsigned)vp[2 * NU] | ((unsigned)vp[3 * NU] << 16); w.z = (unsigned)vp[4 * NU] | ((unsigned)vp[5 * NU] << 16); w.w = (unsigned)vp[6 * NU] | ((unsigned)vp[7 * NU] << 16);
                    O[dt] = __builtin_amdgcn_mfma_f32_32x32x16_bf16(__builtin_bit_cast(bf16x8, w), pb[s], O[dt], 0, 0, 0); } }
        else lsum = 0.f;
    }
    const float mmin = wave_min(m);
    for (int tt = 0; tt < 8; ++tt) {
        const int key0 = (63 - wave - 8 * tt) * 64;
        if (qkb - G[key0 + 63] < mmin - 40.f) break;
        f32x16 p0, p1;
#pragma unroll
        for (int g2 = 0; g2 < 2; ++g2) { const float* gp = G + key0 + 8 * hi + 16 * g2; const f32x4 a = *(const f32x4*)gp, bq = *(const f32x4*)(gp + 4), c = *(const f32x4*)(gp + 32), d = *(const f32x4*)(gp + 36);
#pragma unroll
            for (int e = 0; e < 4; ++e) { p0[8 * g2 + e] = fq - a[e]; p0[8 * g2 + 4 + e] = fq - bq[e]; p1[8 * g2 + e] = fq - c[e]; p1[8 * g2 + 4 + e] = fq - d[e]; } }
#pragma unroll
        for (int d0 = 0; d0 < 4; ++d0) { const float* k0p = CK + (size_t)(key0 + ka) * 512 + 16 * d0 + 8 * hi; const float* k1p = k0p + (size_t)32 * 512;
            const bf16x8 a0 = pack8f(*(const f32x4*)k0p, *(const f32x4*)(k0p + 4)), a1 = pack8f(*(const f32x4*)k1p, *(const f32x4*)(k1p + 4));
            p0 = __builtin_amdgcn_mfma_f32_32x32x16_bf16(a0, qf[d0], p0, 0, 0, 0); p1 = __builtin_amdgcn_mfma_f32_32x32x16_bf16(a1, qf[d0], p1, 0, 0, 0); }
        bf16x8 pb[4];
        softmax_tile<false>(p0, p1, m, lsum, O, pb);
#pragma unroll
        for (int dt = 0; dt < 2; ++dt)
#pragma unroll
            for (int s = 0; s < 4; ++s) { const float* vp = CV + (size_t)(key0 + 16 * (s & 1) + 32 * (s >> 1) + 8 * hi) * 512 + 32 * dt + li;
                const bf16x8 a = pack8f((f32x4){vp[0], vp[512], vp[1024], vp[1536]}, (f32x4){vp[2048], vp[2560], vp[3072], vp[3584]});
                O[dt] = __builtin_amdgcn_mfma_f32_32x32x16_bf16(a, pb[s], O[dt], 0, 0, 0); }
    }
    LAS float* Ow = (LAS float*)lds;
    LAS float* ML = Ow + 8 * 32 * 64;
    lsum = xhalf_sum(lsum);
#pragma unroll
    for (int dt = 0; dt < 2; ++dt)
#pragma unroll
        for (int r = 0; r < 16; ++r) Ow[(wave * 32 + dt * 16 + r) * 64 + lane] = O[dt][r];
    if (hi == 0) { ML[(wave * 2) * 32 + li] = m; ML[(wave * 2 + 1) * 32 + li] = lsum; }
    __syncthreads();
    { const int qq = tid & 31, dg = tid >> 5; float M = ATT_NEG;
#pragma unroll
      for (int w = 0; w < 8; ++w) M = fmaxf(M, ML[(w * 2) * 32 + qq]);
      float L = 0.f; f32x4 o = {0.f, 0.f, 0.f, 0.f};
      const int d = 4 * dg, idx0 = (d >> 5) * 16 + ((d >> 3) & 3) * 4, ln = ((d >> 2) & 1) * 32 + qq;
#pragma unroll
      for (int w = 0; w < 8; ++w) { const float f = __builtin_amdgcn_exp2f(ML[(w * 2) * 32 + qq] - M); L += ML[(w * 2 + 1) * 32 + qq] * f;
#pragma unroll
          for (int e = 0; e < 4; ++e) o[e] += Ow[(w * 32 + idx0 + e) * 64 + ln] * f; }
      const float inv = 1.f / L; const size_t row = (size_t)TP + b * 32 + qq;
      const u32x2 sg = *(const u32x2*)(U + row * NU + U_BSG + h * 64 + d);
      u32x2 wv; wv.x = cvt_pk_bf16(o[0] * inv * siluf_(bflo(sg.x)), o[1] * inv * siluf_(bfhi(sg.x))); wv.y = cvt_pk_bf16(o[2] * inv * siluf_(bflo(sg.y)), o[3] * inv * siluf_(bfhi(sg.y)));
      *(u32x2*)((bf16_t*)(p->ws + WS_OCAT) + (size_t)1 * NTOK * 512 + row * 512 + h * 64 + d) = wv; }
    __syncthreads();
}
__device__ __forceinline__ bool xb_lane0() { unsigned ones_ = ~0u; asm volatile("" : "+s"(ones_)); return __builtin_amdgcn_mbcnt_hi(ones_, __builtin_amdgcn_mbcnt_lo(ones_, 0u)) == 0u; }
constexpr int NPHASE = 20;
__global__ void __launch_bounds__(512, 2) hse_fwd(Params p_) {
    const KP kp = (KP)__builtin_amdgcn_kernarg_segment_ptr();
    (void)p_;
    extern __shared__ __attribute__((aligned(16))) unsigned char lds_raw[];
    LAS unsigned char* lds = (LAS unsigned char*)lds_raw;
    const int tid0 = threadIdx.x;
    const int wave0 = __builtin_amdgcn_readfirstlane(tid0 >> 6);
    const int G = gridDim.x, bid = blockIdx.x, ngw = G * 8;
#define PH_LOCALS const KP p = kp_fresh(kp); unsigned ones_ = ~0u; asm volatile("" : "+s"(ones_)); int tid = wave0 * 64 + (int)__builtin_amdgcn_mbcnt_hi(ones_, __builtin_amdgcn_mbcnt_lo(ones_, 0u)); asm volatile("" : "+v"(tid)); const int lane = tid & 63, wave = __builtin_amdgcn_readfirstlane(tid >> 6), gw = bid * 8 + wave; (void)lane; (void)gw; (void)p;
    if (tid0 < 4) ((LAS unsigned*)(lds + LDS_XB_OFF))[tid0] = 0u;
#if PROBE_ID
    if (tid0 == 0) *(LAS unsigned long long*)(lds + LDS_PROBE_OFF) = 0ull;
#endif
    __syncthreads();
    unsigned* ctl = (unsigned*)(kp->ws + WS_CTL);
    XcdBarrier bar = xcd_barrier_post(ctl + CW_BAR + kp->li * XCD_BAR_WORDS, (volatile LAS unsigned*)(lds + LDS_XB_OFF));
    const int lo = kp->ph_lo, hi = kp->ph_hi;
#define IN(k) (lo <= (k) && (k) < hi)
#ifndef DUP_MASK
#define DUP_MASK 0
#endif
#define NREP(k) (((DUP_MASK >> (k)) & 1) + 1)
#define XB_T0 (wave0 == 0 && xb_lane0())
#define SEAM(k) do { if (IN(k) && IN((k) + 1)) xcd_barrier(bar, XB_T0); } while (0)
    PT0();
    if (IN(0)) { PH_LOCALS
        for (int u = bid; u < 192; u += G) ada_unit(p, u, lds, tid);
        p0_weights(p, lds, gw, ngw, wave, lane);
    }
    SEAM(0);
    PT1(9);
    for (int l = 0; l < NLAYER; ++l) {
        const int pb = 1 + 9 * l;
        for (int rep = 0; rep < NREP(0); ++rep) { if (rep) xcd_barrier(bar, XB_T0);
        if (IN(pb)) { PH_LOCALS p1_rows(p, l, gw, ngw, lane); } }
        SEAM(pb);
        PT1(10);
        for (int rep = 0; rep < NREP(1); ++rep) { if (rep) xcd_barrier(bar, XB_T0);
        if (IN(pb + 1)) { PH_LOCALS
            pg8::Gemm g{(const bf16_t*)(p->ws + WS_H), (const bf16_t*)(p->ws + WS_WIN) + (size_t)l * NU * 2048, NTOK, NU, 2048, 2048};
            pg8::StaticOrder S; S.init(NTOK, NU, G, bid);
            EpiU E{(bf16_t*)(p->ws + WS_U), p->out, p->in[I_BF], l};
            pg8::gemm_phase<EpiU, pg8::StaticOrder>(lds, g, S, E, nullptr, tid);
        }
        }
        SEAM(pb + 1);
        PT1(11);
        for (int rep = 0; rep < NREP(2); ++rep) { if (rep) xcd_barrier(bar, XB_T0);
        if (IN(pb + 2)) { PH_LOCALS
#ifndef DUP_SUB
#define DUP_SUB 0
#endif
            { PT0();
            { PH_LOCALS for (int u = bid; u < NRU * ((DUP_SUB & 1) + 1); u += G) rwkv_r1(p, l, u % NRU, u + G, lds, tid); }
            PT1(31);
            for (int u = (bid + G - 32) % G; u < 544 * (((DUP_SUB >> 1) & 1) + 1); u += G) conv_unit(p, l, u % 544, lds, tid);
            PT1(32);
            for (int u = (bid + G - 64) % G; u < 544 * (((DUP_SUB >> 2) & 1) + 1); u += G) pool_unit(p, l, u % 544, lds, tid);
            PT1(33);
            for (int u = bid; u < 256; u += G) { vt_tile(p, l, u * 8 + wave, lds, wave, lane); }
            __syncthreads();
            for (int u = (bid + G - 96) % G; u < 32; u += G) gs_unit(p, l, u, lds, tid);
            for (int u = G - 1 - bid; u < 8; u += G) fp_unit(p, l, u, lds, tid);
            if (bid == G / 2) shift_out(p, l, tid);
            PT1(34); }
        }
        }
        SEAM(pb + 2);
        PT1(12);
        for (int rep = 0; rep < NREP(3); ++rep) { if (rep) xcd_barrier(bar, XB_T0);
        if (IN(pb + 3)) { PH_LOCALS
            for (int tk = bid; tk < 256; tk += G) rwkv_l1_block(p, tk, lds, wave, lane);
            LAS int* qslot = (LAS int*)(lds + LDS_XB_OFF - 16);
            for (;;) {
                if (tid == 0) *qslot = (int)atomicAdd(ctl + CW_QUEUE + 64 * (2 * l + 4 * rep), 1u);
                __syncthreads();
                const int item = *qslot;
                __syncthreads();
                if (item >= 512) break;
                attn_prompt_unit(p, l, item & 7, 63 - (item >> 3), lds, tid);
            }
            for (;;) {
                if (tid == 0) *qslot = (int)atomicAdd(ctl + CW_QUEUE + 64 * (2 * l + 1 + 4 * rep), 1u);
                __syncthreads();
                const int item = *qslot;
                __syncthreads();
                if (item >= 256) break;
                attn_sample_unit(p, l, item >> 3, item & 7, lds, tid);
            }
        }
        }
        SEAM(pb + 3);
        PT1(13);
        if (IN(pb + 4)) { PH_LOCALS
            for (int tk = bid; tk < 128; tk += G) rwkv_l3_block(p, l, 127 - tk, lds, wave, lane);
            for (int tk = ((bid + G - 128) % G) * 8 + wave; tk < 1024; tk += ngw) rwkv_samp_task(p, l, tk, lane);
        }
        SEAM(pb + 4);
        PT1(14);
        if (IN(pb + 5)) { PH_LOCALS for (int tk = gw; tk < NRU * 2; tk += ngw) rwkv_r3_task(p, l, tk, lane); }
        SEAM(pb + 5);
        PT1(15);
        for (int rep = 0; rep < NREP(6); ++rep) { if (rep) xcd_barrier(bar, XB_T0);
        if (IN(pb + 6)) { PH_LOCALS
            pg8::Gemm g{(const bf16_t*)(p->ws + WS_OCAT), (const bf16_t*)(p->ws + WS_WBR) + (size_t)l * 4 * 2048 * 512, 4 * NTOK, 4 * 2048, 512, 512};
            BranchOrder S{G, (G % 8 == 0) ? (bid % 8) * (G / 8) + bid / 8 : bid};
            EpiZ E{(bf16_t*)(p->ws + WS_Z), (const bf16_t*)(p->ws + WS_U)};
            pg8::gemm_phase<EpiZ, BranchOrder>(lds, g, S, E, nullptr, tid);
        }
        }
        SEAM(pb + 6);
        PT1(16);
        if (IN(pb + 7)) { PH_LOCALS merge_pass(p, l, bid * 512 + tid, G * 512); }
        SEAM(pb + 7);
        PT1(17);
        if (IN(pb + 8)) { PH_LOCALS
            {
                pg8::Gemm g{(const bf16_t*)(p->ws + WS_MERGED), (const bf16_t*)(p->ws + WS_WOUT) + (size_t)l * 2048 * 2048, TP, 2048, 2048, 2048};
                pg8::StaticOrder S; S.init(TP, 2048, G, bid);
                EpiOut E{p->in[I_XP], p->in[I_XS], (const float*)(p->ws + WS_XBUF), (const float*)(p->ws + WS_ADA), (float*)(p->ws + WS_XBUF), l};
                pg8::gemm_phase<EpiOut, pg8::StaticOrder>(lds, g, S, E, nullptr, tid); }
            {
                const int tile = bid >> 3, ks = bid & 7;
                pg8::Gemm g{(const bf16_t*)(p->ws + WS_MERGED) + ks * 256, (const bf16_t*)(p->ws + WS_WOUT) + (size_t)l * 2048 * 2048 + ks * 256, NTOK, 2048, 256, 2048};
                OneUnit S{64 + (tile >> 3), tile & 7, bid < 256};
                EpiOutPart E{(const float*)(p->ws + WS_ADA), (float*)(p->ws + WS_XPART) + ((size_t)(l * 8 + ks) * 1024) * DM, l};
                pg8::gemm_phase<EpiOutPart, OneUnit>(lds, g, S, E, nullptr, tid); }
        }
        SEAM(pb + 8);
        PT1(18);
    }
    if (IN(19)) { PH_LOCALS p_final_rows(p, gw, ngw, lane); }
    PT1(20);
#if PROBE_ID
    if (bid == 0 && tid0 == 0) { const unsigned long long w = *(LAS unsigned long long*)(lds + LDS_PROBE_OFF) * PROBE_K, t0 = __builtin_amdgcn_s_memrealtime(); while (__builtin_amdgcn_s_memrealtime() - t0 < w) __builtin_amdgcn_s_sleep(8); }
#endif
#undef IN
#undef SEAM
}
#ifndef MK_SPLIT
#define MK_SPLIT 0
#endif
extern "C" void kernel_launch(void* const* d_in, const int* in_sizes, int n_in, void* d_out, int out_size, void* d_ws, size_t ws_size, hipStream_t stream) {
    static int grid = 0;
    if (grid == 0) {
        if (n_in != N_IN || (size_t)out_size != O_END || ws_size < WS_END) { fprintf(stderr, "kernel_launch: unexpected shapes (n_in %d, out %d, ws %zu)\n", n_in, out_size, ws_size); grid = -1; return; }
        int dev = 0, cus = 0, per_cu = 0;
        if (hipGetDevice(&dev) != hipSuccess || hipDeviceGetAttribute(&cus, hipDeviceAttributeMultiprocessorCount, dev) != hipSuccess) { grid = -1; return; }
        if (hipFuncSetAttribute((const void*)hse_fwd, hipFuncAttributeMaxDynamicSharedMemorySize, LDS_BYTES) != hipSuccess) { fprintf(stderr, "kernel_launch: hipFuncSetAttribute failed\n"); grid = -1; return; }
        if (hipOccupancyMaxActiveBlocksPerMultiprocessor(&per_cu, (const void*)hse_fwd, 512, LDS_BYTES) != hipSuccess || per_cu < 1) fprintf(stderr, "kernel_launch: occupancy query reports %d\n", per_cu);
        (void)hipGetLastError();
        grid = cus;
    }
    if (grid < 0) return;
    if (hipMemsetAsync((char*)d_ws + WS_CTL, 0, CTL_BYTES, stream) != hipSuccess) return;
    Params a{};
    for (int i = 0; i < N_IN; ++i) a.in[i] = (const float*)d_in[i];
    a.out = (float*)d_out; a.ws = (unsigned char*)d_ws;
#if MK_SPLIT
    for (int ph = 0; ph < NPHASE; ++ph) { a.ph_lo = ph; a.ph_hi = ph + 1; a.li = ph; hipLaunchKernelGGL(hse_fwd, dim3(grid), dim3(512), LDS_BYTES, stream, a); }
#else
    a.ph_lo = 0; a.ph_hi = NPHASE; a.li = 0;
    hipLaunchKernelGGL(hse_fwd, dim3(grid), dim3(512), LDS_BYTES, stream, a);
#endif
    const hipError_t le = hipPeekAtLastError();
    if (le != hipSuccess) fprintf(stderr, "kernel_launch: launch failed: %s\n", hipGetErrorName(le));
}
```

```cpp
#include <hip/hip_runtime.h>
#include <cstdio>
#include <cstdint>
#ifndef PROBE_ID
#define PROBE_ID 0
#endif
#ifndef PROBE_K
#define PROBE_K 1
#endif
constexpr int LDS_PROBE_OFF = 163840 - 256 - 64;
#if PROBE_ID
#define PT0() unsigned long long _pt0 = (blockIdx.x == 0 && threadIdx.x == 0) ? __builtin_amdgcn_s_memrealtime() : 0ull
#define PT1(id) do { if ((id) == PROBE_ID && blockIdx.x == 0 && threadIdx.x == 0) { *(__attribute__((address_space(3))) unsigned long long*)(lds + LDS_PROBE_OFF) += __builtin_amdgcn_s_memrealtime() - _pt0; } _pt0 = (blockIdx.x == 0 && threadIdx.x == 0) ? __builtin_amdgcn_s_memrealtime() : 0ull; } while (0)
#else
#define PT0() do {} while (0)
#define PT1(id) do {} while (0)
#endif
namespace pg8 {
#define PG8_LAS __attribute__((address_space(3)))
typedef unsigned short bf16_t;
typedef short bf16x8 __attribute__((ext_vector_type(8)));
typedef float f32x4 __attribute__((ext_vector_type(4)));
typedef unsigned u32x4 __attribute__((ext_vector_type(4)));
constexpr int BM = 256, BK = 64, HALF = 128, HTB = HALF * BK * 2  , STAGE_BYTES = 8 * HTB, NXCD = 8, WGM = 4;

__host__ __device__ __forceinline__ int lds_byte(int r, int c) { const int st = (r >> 4) * 2 + (c >> 5), rr = r & 15, cc = c & 31, ob = rr * 64 + cc * 2; return st * 1024 + (ob ^ (((ob >> 9) & 1) << 5)); }
__host__ __device__ __forceinline__ void stage_rc(int b, int& R, int& C) { const int st = b / 1024, sb = b % 1024, swz = sb ^ (((sb >> 9) & 1) << 5); R = (st >> 1) * 16 + swz / 64; C = (st & 1) * 32 + (swz % 64) / 2; }
__host__ __device__ __forceinline__ int perm32(int rho) { const int n = rho >> 4, i = rho & 15; return 8 * (i >> 2) + 4 * n + (i & 3); }

struct Unit { int pm, pn; };
struct Gemm { const bf16_t* A; const bf16_t* Bt; int M, N, K, ld; };

struct StaticOrder {
    int nM, nN, nwg, G, c;
    __host__ __device__ void init(int M, int N, int G_, int c_) { nM = M / BM; nN = N / BM; nwg = nM * nN; G = G_; c = c_; }
    __host__ __device__ bool next(int i, Unit& u) const {
        const long L = (long)i * G + c; if (L >= nwg) return false;
        int wgid = (int)L; { const int q = nwg / NXCD, r = nwg % NXCD, xcd = wgid % NXCD, off = wgid / NXCD; wgid = (xcd < r ? xcd * (q + 1) : r * (q + 1) + (xcd - r) * q) + off; }
        const int nig = WGM * nN, gid = wgid / nig, fm = gid * WGM, gsz = (nM - fm) < WGM ? (nM - fm) : WGM;
        u.pm = fm + ((wgid % nig) % gsz); u.pn = (wgid % nig) / gsz; return true;
    }
    __device__ __forceinline__ void a_ready(const Unit&) const {}
    __device__ __forceinline__ void done(const Unit&) const {}
};
__device__ __forceinline__ unsigned cvt_pk_bf16(float lo, float hi) { unsigned r; asm volatile("v_cvt_pk_bf16_f32 %0, %1, %2" : "=v"(r) : "v"(lo), "v"(hi)); return r; }
typedef float f32x2 __attribute__((ext_vector_type(2)));
template <class Epi, class Sched, bool STAMP = false>
__device__ __forceinline__ void gemm_phase(PG8_LAS unsigned char* lds, const Gemm g, const Sched& S, const Epi& E, unsigned long long* stamps, int tid_in) {
    int tid = tid_in; asm volatile("" : "+v"(tid));
    const int wid = __builtin_amdgcn_readfirstlane(tid >> 6), lane = tid & 63, wr = wid >> 2, wc = wid & 3, fr = lane & 15, fq = lane >> 4;
    const int K = g.ld, nt = g.K / BK;
    int ts_lo = 0, ts_hi = 0, nts = 0; const unsigned long long rt_entry = STAMP ? (unsigned long long)wall_clock64() : 0ull;
#define PG8_STAMP() do { if (STAMP && wid == 0 && nts < 64) { const unsigned long long _c = (unsigned long long)clock64(); \
        ts_lo = (lane == nts) ? (int)(unsigned)_c : ts_lo; ts_hi = (lane == nts) ? (int)(unsigned)(_c >> 32) : ts_hi; ++nts; } } while (0)
    PG8_STAMP();
    unsigned voffA[2], voffB[2];
#pragma unroll
    for (int i = 0; i < 2; ++i) { int R, C; stage_rc(tid * 16 + i * 8192, R, C); const int Rb = Epi::PERM ? ((R & ~31) + perm32(R & 31)) : R;
        voffA[i] = (unsigned)(R * K + C) * 2u; voffB[i] = (unsigned)(Rb * K + C) * 2u; }
    const size_t kstep = (size_t)(BK * 2);
    const size_t hstep = (size_t)HALF * K * 2;
    const size_t tstep = 2 * hstep;
    const unsigned ldsw = (unsigned)wid * 1024u;
    const int aoff = lds_byte(wr * 64 + fr, fq * 8), boff = lds_byte(wc * 32 + fr, fq * 8);
#define PG8_SA(b, h) (((b) * 2 + (h)) * HTB)
#define PG8_SB(b, h) ((4 + (b) * 2 + (h)) * HTB)
#define PG8_STAGE(bufoff, gbase, voff) do { _Pragma("unroll") for (int _i = 0; _i < 2; ++_i) \
        __builtin_amdgcn_global_load_lds((const unsigned*)((const char*)(gbase) + (voff)[_i]), (PG8_LAS unsigned*)(lds + (bufoff) + ldsw + _i * 8192), 16, 0, 0); } while (0)
#define PG8_LDA(dst, b, h) do { _Pragma("unroll") for (int m = 0; m < 4; ++m) _Pragma("unroll") for (int k = 0; k < 2; ++k) dst[m][k] = *(const PG8_LAS bf16x8*)(lds + PG8_SA(b, h) + aoff + m * 2048 + k * 1024); } while (0)
#define PG8_LDB(dst, b, h) do { _Pragma("unroll") for (int n = 0; n < 2; ++n) _Pragma("unroll") for (int k = 0; k < 2; ++k) dst[n][k] = *(const PG8_LAS bf16x8*)(lds + PG8_SB(b, h) + boff + n * 2048 + k * 1024); } while (0)
#define PG8_MMA(ai, bj, At, Bt) do { __builtin_amdgcn_s_setprio(1); _Pragma("unroll") for (int m = 0; m < 4; ++m) _Pragma("unroll") for (int n = 0; n < 2; ++n) _Pragma("unroll") for (int k = 0; k < 2; ++k) \
        acc[ai][bj][m][n] = __builtin_amdgcn_mfma_f32_16x16x32_bf16(Bt[n][k], At[m][k], acc[ai][bj][m][n], 0, 0, 0); __builtin_amdgcn_s_setprio(0); } while (0)
#define PG8_WAIT_V(n) asm volatile("s_waitcnt vmcnt(" #n ")" ::: "memory")
#define PG8_WAIT_L(n) asm volatile("s_waitcnt lgkmcnt(" #n ")" ::: "memory")
#define PG8_BAR __builtin_amdgcn_s_barrier()
#define PG8_SCHED __builtin_amdgcn_sched_barrier(0)
    Unit cur, nxt; int ui = 0;
    if (!S.next(0, cur)) return;
    f32x4 acc[2][2][4][2];
#pragma unroll
    for (int a = 0; a < 2; ++a)
#pragma unroll
        for (int b = 0; b < 2; ++b)
#pragma unroll
            for (int m = 0; m < 4; ++m)
#pragma unroll
                for (int n = 0; n < 2; ++n) acc[a][b][m][n] = (f32x4){0.f, 0.f, 0.f, 0.f};
    bf16x8 At[4][2], B0[2][2], B1[2][2];
    const char* cA = (const char*)g.A + (size_t)cur.pm * tstep; const char* cB = (const char*)g.Bt + (size_t)cur.pn * tstep;
    S.a_ready(cur);
    PG8_STAGE(PG8_SB(0, 0), cB, voffB); PG8_STAGE(PG8_SA(0, 0), cA, voffA); PG8_STAGE(PG8_SB(0, 1), cB + hstep, voffB); PG8_STAGE(PG8_SA(0, 1), cA + hstep, voffA);
    if (wr == 1) PG8_BAR;
    PG8_WAIT_V(4); PG8_BAR;
    PG8_STAGE(PG8_SB(1, 0), cB + kstep, voffB); PG8_STAGE(PG8_SA(1, 0), cA + kstep, voffA); PG8_STAGE(PG8_SB(1, 1), cB + hstep + kstep, voffB);
    PG8_WAIT_V(6); PG8_BAR;
    PG8_STAMP();
    for (;;) {
        const bool has_next = S.next(ui + 1, nxt);
        const char* nA = has_next ? (const char*)g.A + (size_t)nxt.pm * tstep : cA; const char* nB = has_next ? (const char*)g.Bt + (size_t)nxt.pn * tstep : cB;
        for (int t = 0; t < nt; t += 2) {
            const bool last = (t == nt - 2);
            const char* a1 = cA + (size_t)(t + 1) * kstep;
            const char* a2 = last ? nA : cA + (size_t)(t + 2) * kstep; const char* b2 = last ? nB : cB + (size_t)(t + 2) * kstep;
            const char* a3 = a2 + kstep; const char* b3 = b2 + kstep;
            if (last && has_next) S.a_ready(nxt);
            PG8_LDB(B0, 0, 0); PG8_SCHED; PG8_LDA(At, 0, 0); PG8_STAGE(PG8_SA(1, 1), a1 + hstep, voffA);
            PG8_WAIT_L(8); PG8_BAR; PG8_WAIT_L(0); PG8_MMA(0, 0, At, B0); PG8_BAR; PG8_SCHED;
            PG8_LDB(B1, 0, 1); PG8_STAGE(PG8_SB(0, 0), b2, voffB);
            PG8_BAR; PG8_WAIT_L(0); PG8_MMA(0, 1, At, B1); PG8_BAR;
            PG8_LDA(At, 0, 1); PG8_STAGE(PG8_SA(0, 0), a2, voffA);
            PG8_BAR; PG8_WAIT_L(0); PG8_MMA(1, 0, At, B0); PG8_BAR; PG8_SCHED;
            PG8_STAGE(PG8_SB(0, 1), b2 + hstep, voffB);
            PG8_WAIT_V(6); PG8_BAR; PG8_MMA(1, 1, At, B1); PG8_BAR;
            PG8_LDB(B0, 1, 0); PG8_SCHED; PG8_LDA(At, 1, 0); PG8_STAGE(PG8_SA(0, 1), a2 + hstep, voffA);
            PG8_WAIT_L(8); PG8_BAR; PG8_WAIT_L(0); PG8_MMA(0, 0, At, B0); PG8_BAR; PG8_SCHED;
            PG8_LDB(B1, 1, 1); PG8_STAGE(PG8_SB(1, 0), b3, voffB);
            PG8_BAR; PG8_WAIT_L(0); PG8_MMA(0, 1, At, B1); PG8_BAR;
            PG8_LDA(At, 1, 1); PG8_STAGE(PG8_SA(1, 0), a3, voffA);
            PG8_BAR; PG8_WAIT_L(0); PG8_MMA(1, 0, At, B0); PG8_BAR; PG8_SCHED;
            PG8_STAGE(PG8_SB(1, 1), b3 + hstep, voffB);
            PG8_WAIT_V(6); PG8_BAR; PG8_MMA(1, 1, At, B1); PG8_BAR;
        }
        PG8_STAMP();
        { PT0(); if constexpr (!Epi::AFTER_DRAIN) { E(acc, cur, wr, wc, fr, fq); S.done(cur); } PT1(Epi::PROBE); }
        PG8_STAMP();
        if (!has_next) break;
#pragma unroll
        for (int a = 0; a < 2; ++a)
#pragma unroll
            for (int b = 0; b < 2; ++b)
#pragma unroll
                for (int m = 0; m < 4; ++m)
#pragma unroll
                    for (int n = 0; n < 2; ++n) acc[a][b][m][n] = (f32x4){0.f, 0.f, 0.f, 0.f};
        cur = nxt; cA = nA; cB = nB; ++ui;
    }
    PG8_WAIT_V(0);
    if (wr == 0) PG8_BAR;
    PG8_BAR;
    if constexpr (Epi::AFTER_DRAIN) { E.fused(acc, cur, wr, wc, fr, fq, lds, wid, lane); S.done(cur); }
    PG8_STAMP();
    if (STAMP && wid == 0) { stamps[lane] = lane < nts ? (((unsigned long long)(unsigned)ts_hi << 32) | (unsigned)ts_lo) : 0ull;
        if (lane == 62) stamps[62] = rt_entry; if (lane == 63) stamps[63] = (unsigned long long)wall_clock64(); }
#undef PG8_STAMP
#undef PG8_SA
#undef PG8_SB
#undef PG8_STAGE
#undef PG8_LDA
#undef PG8_LDB
#undef PG8_MMA
#undef PG8_WAIT_V
#undef PG8_WAIT_L
#undef PG8_BAR
#undef PG8_SCHED
}
}
#define XB_TMO      128
#define XB_XCNT(j)  (256  + 64 * (j))
#define XB_XSUB(j)  (1280 + 64 * (j))
#define XB_XGEN(j)  (2304 + 64 * (j))
#define XB_TOP      3328
#define XB_TOPGEN   3392
#define XCD_BAR_WORDS 3456
#define XB_SPIN_CAP (1u << 18)
#define LAS __attribute__((address_space(3)))

__device__ __forceinline__ unsigned xb_ld(unsigned* p)              { return __hip_atomic_load(p, __ATOMIC_RELAXED, __HIP_MEMORY_SCOPE_AGENT); }
__device__ __forceinline__ unsigned xb_add(unsigned* p, unsigned v) { return __hip_atomic_fetch_add(p, v, __ATOMIC_RELAXED, __HIP_MEMORY_SCOPE_AGENT); }
__device__ __forceinline__ unsigned xb_xcc_id() { return (unsigned)__builtin_amdgcn_s_getreg((3 << 11) | 20) & 0xFu; }
#define XB_SPIN(cond, bar) do { unsigned _sp = 0; while (cond) { __builtin_amdgcn_s_sleep(1); \
    if ((++_sp & 255u) == 0u) { if (xb_ld(&(bar)[XB_TMO])) break; if (_sp > XB_SPIN_CAP) { atomicAdd(&(bar)[XB_TMO], 1u); break; } } } } while (0)

struct XcdBarrier {
    unsigned* bar; unsigned x;
    volatile LAS unsigned* st;
};

__device__ __forceinline__ XcdBarrier xcd_barrier_post(unsigned* bar, volatile LAS unsigned* st) {
    XcdBarrier b; b.bar = bar; b.x = xb_xcc_id(); b.st = st;
    if (threadIdx.x == 0) (void)xb_add(&bar[XB_XCNT(b.x)], 1u);
    return b;
}
__device__ __forceinline__ void xcd_barrier_complete(unsigned* bar, unsigned x, unsigned& nloc, unsigned& nx) {
    const unsigned G = gridDim.x * gridDim.y * gridDim.z;
    unsigned sum, cnt, mine, sp = 0u;
    for (;;) {
        sum = 0u; cnt = 0u; mine = 0u;
#pragma unroll
        for (unsigned j = 0; j < 16; ++j) { const unsigned c = xb_ld(&bar[XB_XCNT(j)]); sum += c; cnt += (c > 0u) ? 1u : 0u; mine = (j == x) ? c : mine; }
        if (sum == G) break;
        __builtin_amdgcn_s_sleep(1);
        if ((++sp & 255u) == 0u) { if (xb_ld(&bar[XB_TMO])) break; if (sp > XB_SPIN_CAP) { atomicAdd(&bar[XB_TMO], 1u); break; } }
    }
    nloc = mine > 0u ? mine : 1u; nx = cnt > 0u ? cnt : 1u;
}

__device__ __forceinline__ void xcd_barrier(const XcdBarrier& b, const bool is_t0) {
    asm volatile("s_waitcnt vmcnt(0)" ::: "memory");
    __syncthreads();
    if (is_t0) {
        unsigned* bar = b.bar;
        __builtin_amdgcn_s_waitcnt(0);
        unsigned nloc = b.st[0], nx = b.st[1];
        if (nloc == 0u) { xcd_barrier_complete(bar, b.x, nloc, nx); b.st[0] = nloc; b.st[1] = nx; }
        const unsigned old = xb_add(&bar[XB_XSUB(b.x)], 1u);
        const unsigned gen = old / nloc;
        if (old + 1u == (gen + 1u) * nloc) {
            __builtin_amdgcn_fence(__ATOMIC_RELEASE, "agent");
            asm volatile("s_waitcnt vmcnt(0)" ::: "memory");
            const unsigned og = xb_add(&bar[XB_TOP], 1u);
            const unsigned tg = og / nx;
            if (og + 1u == (tg + 1u) * nx) xb_add(&bar[XB_TOPGEN], 1u);
            else XB_SPIN(xb_ld(&bar[XB_TOPGEN]) == tg, bar);
            __builtin_amdgcn_fence(__ATOMIC_ACQUIRE, "agent");
            xb_add(&bar[XB_XGEN(b.x)], 1u);
            asm volatile("s_waitcnt vmcnt(0)" ::: "memory");
        } else {
            XB_SPIN(xb_ld(&bar[XB_XGEN(b.x)]) == gen, bar);
            __builtin_amdgcn_fence(__ATOMIC_ACQUIRE, "agent");
            asm volatile("s_waitcnt vmcnt(0)" ::: "memory");
        }
    }
    __syncthreads();
}
typedef unsigned short bf16_t;
typedef short bf16x8 __attribute__((ext_vector_type(8)));
typedef float f32x4 __attribute__((ext_vector_type(4)));
typedef float f32x16 __attribute__((ext_vector_type(16)));
typedef unsigned u32x4 __attribute__((ext_vector_type(4)));
typedef unsigned u32x2 __attribute__((ext_vector_type(2)));
using pg8::cvt_pk_bf16;

constexpr int DM = 2048, TP = 16384, NSB = 32, TSQ = 32, NTOK = TP + NSB * TSQ, NSEQ = 33, PAST = 4096, NLAYER = 2;
constexpr int NU = 15104;
constexpr int U_AVAL = 0, U_AGATE = 512, U_ASG = 1024, U_Q = 1536, U_K = 2048, U_V = 2560, U_BSG = 3072, U_XC = 3584, U_CSG = 5248, U_DIN = 5760, U_DSG = 6272, U_G = 6784, U_F = 14976;
constexpr int IN_W = 14984, SHIFT_W = 1664;
constexpr float LOG2E = 1.4426950408889634f;
enum { I_XP = 0, I_XS, I_CK, I_CV, I_CLF, I_SCONV, I_SSHIFT, I_SWKV, I_SPOOL, I_CP, I_CS, I_NORMG, I_WADA, I_BADA, I_WIN, I_BF, I_CONVW, I_CONVB, I_CLNG, I_CLNB, I_MU, I_W0, I_W2, I_A0, I_A2,
       I_KK, I_KA, I_RK, I_GNG, I_GNB, I_POOLW, I_POOLB, I_POOLS, I_WBR, I_WOUT, I_FING, N_IN };
constexpr size_t O_YP = 0, O_YS = O_YP + (size_t)TP * DM, O_PK = O_YS + (size_t)1024 * DM, O_PV = O_PK + (size_t)2 * TP * 512, O_PLF = O_PV + (size_t)2 * TP * 512, O_PCONV = O_PLF + (size_t)2 * TP * 8,
                 O_PSHIFT = O_PCONV + 2 * 30 * 512, O_PWKV = O_PSHIFT + 2 * 1664, O_PPOOL = O_PWKV + 2 * 8 * 64 * 64, O_SK = O_PPOOL + 2 * 15 * 512, O_SV = O_SK + (size_t)2 * 1024 * 512,
                 O_SLF = O_SV + (size_t)2 * 1024 * 512, O_SCONV = O_SLF + 2 * 1024 * 8, O_SSHIFT = O_SCONV + (size_t)2 * 32 * 30 * 512, O_SWKV = O_SSHIFT + 2 * 32 * 1664,
                 O_SPOOL = O_SWKV + (size_t)2 * 32 * 8 * 64 * 64, O_END = O_SPOOL + (size_t)2 * 32 * 15 * 512;
static_assert(O_END == 75374848, "output size");
constexpr size_t al256(size_t x) { return (x + 255) & ~(size_t)255; }
constexpr int NCU_CH = 288, NRU = NCU_CH * 8;
constexpr size_t WS_CTL = 0, CTL_BYTES = 512 * 1024;
constexpr size_t WS_WIN = CTL_BYTES;
constexpr size_t WS_WBR = al256(WS_WIN + (size_t)2 * NU * 2048 * 2);
constexpr size_t WS_WOUT = al256(WS_WBR + (size_t)2 * 4 * 2048 * 512 * 2);
constexpr size_t WS_POOLW = al256(WS_WOUT + (size_t)2 * 2048 * 2048 * 2);
constexpr size_t WS_ADA = al256(WS_POOLW + (size_t)2 * 4 * 128 * 128 * 2);
constexpr size_t WS_H = al256(WS_ADA + (size_t)2 * 33 * 6144 * 4);
constexpr size_t WS_U = al256(WS_H + (size_t)NTOK * 2048 * 2);
constexpr size_t WS_XBUF = al256(WS_U + (size_t)NTOK * NU * 2);
constexpr size_t WS_OCAT = al256(WS_XBUF + (size_t)NTOK * 2048 * 4);
constexpr size_t WS_Z = al256(WS_OCAT + (size_t)4 * NTOK * 512 * 2);
constexpr size_t WS_MERGED = al256(WS_Z + (size_t)4 * NTOK * 2048 * 2);
constexpr size_t WS_FP = al256(WS_MERGED + (size_t)NTOK * 2048 * 2);
constexpr int GS_LEN = PAST + TSQ;
constexpr size_t WS_GS = al256(WS_FP + (size_t)8 * TP * 4);
constexpr size_t WS_VT = al256(WS_GS + (size_t)32 * 8 * GS_LEN * 4);
constexpr size_t WS_TQ = al256(WS_VT + (size_t)8 * 64 * TP * 2);
constexpr size_t WS_GM = al256(WS_TQ + (size_t)NRU * 4096 * 4);
constexpr size_t WS_ET = al256(WS_GM + (size_t)NRU * 4096 * 4);
constexpr size_t WS_Y0T = al256(WS_ET + (size_t)NRU * 4096 * 4);
constexpr size_t WS_SC = al256(WS_Y0T + (size_t)NRU * 4096 * 4);
constexpr size_t WS_BONUS = al256(WS_SC + (size_t)NRU * 4096 * 4);
constexpr size_t WS_GG = al256(WS_BONUS + (size_t)NRU * 64 * 4);
constexpr size_t WS_TG = al256(WS_GG + (size_t)16 * 8 * 4096 * 4);
constexpr size_t WS_SG = al256(WS_TG + (size_t)16 * 8 * 4096 * 4);
constexpr size_t WS_XPART = al256(WS_SG + (size_t)16 * 8 * 4096 * 4);
constexpr size_t WS_END = al256(WS_XPART + (size_t)2 * 8 * 1024 * 2048 * 4);
static_assert(WS_END < (size_t)2100 * 1024 * 1024, "workspace map exceeds the guaranteed d_ws size");
constexpr int CW_BAR = 0;
constexpr int CW_QUEUE = 16 * 3456 + 64;
constexpr int CW_KMAX = CW_QUEUE + 64 * 16;
static_assert((CW_KMAX + 64) * 4 <= (int)CTL_BYTES, "ctl");
constexpr int LDS_BYTES = 163840 - 256;
constexpr int LDS_XB_OFF = LDS_BYTES - 16;
constexpr int SLOT_F = 64 * 65;

struct Params { const float* in[N_IN]; float* out; unsigned char* ws; int ph_lo, ph_hi, li, pad; };
typedef const __attribute__((address_space(4))) Params* KP;
__device__ __forceinline__ KP kp_fresh(KP k) { asm volatile("" : "+s"(k)); return k; }

__device__ __forceinline__ float bf2f(unsigned short b) { return __uint_as_float(((unsigned)b) << 16); }
__device__ __forceinline__ float bflo(unsigned w) { return __uint_as_float(w << 16); }
__device__ __forceinline__ float bfhi(unsigned w) { return __uint_as_float(w & 0xffff0000u); }
__device__ __forceinline__ unsigned short f2bf(float f) { return (unsigned short)(cvt_pk_bf16(f, 0.f) & 0xffffu); }
__device__ __forceinline__ float sigmoidf_(float x) { return 1.f / (1.f + __expf(-x)); }
__device__ __forceinline__ float siluf_(float x) { return x / (1.f + __expf(-x)); }
__device__ __forceinline__ float log_sigmoidf_(float z) { return fminf(z, 0.f) - log1pf(expf(-fabsf(z))); }
template <int CTRL> __device__ __forceinline__ float dpp_mov(float v) { return __int_as_float(__builtin_amdgcn_update_dpp(0, __float_as_int(v), CTRL, 0xF, 0xF, true)); }
__device__ __forceinline__ float wave_sum(float v) {
    v += dpp_mov<0xB1>(v); v += dpp_mov<0x4E>(v); v += dpp_mov<0x141>(v); v += dpp_mov<0x140>(v);
    const float r0 = __int_as_float(__builtin_amdgcn_readlane(__float_as_int(v), 0)), r1 = __int_as_float(__builtin_amdgcn_readlane(__float_as_int(v), 16));
    const float r2 = __int_as_float(__builtin_amdgcn_readlane(__float_as_int(v), 32)), r3 = __int_as_float(__builtin_amdgcn_readlane(__float_as_int(v), 48));
    return (r0 + r1) + (r2 + r3);
}
__device__ __forceinline__ float wave_max(float v) {
    v = fmaxf(v, dpp_mov<0xB1>(v)); v = fmaxf(v, dpp_mov<0x4E>(v)); v = fmaxf(v, dpp_mov<0x141>(v)); v = fmaxf(v, dpp_mov<0x140>(v));
    const float r0 = __int_as_float(__builtin_amdgcn_readlane(__float_as_int(v), 0)), r1 = __int_as_float(__builtin_amdgcn_readlane(__float_as_int(v), 16));
    const float r2 = __int_as_float(__builtin_amdgcn_readlane(__float_as_int(v), 32)), r3 = __int_as_float(__builtin_amdgcn_readlane(__float_as_int(v), 48));
    return fmaxf(fmaxf(r0, r1), fmaxf(r2, r3));
}
__device__ __forceinline__ float wave_min(float v) { return -wave_max(-v); }
__device__ __forceinline__ float xhalf_max(float m) { const auto rr = __builtin_amdgcn_permlane32_swap(__float_as_uint(m), __float_as_uint(m), false, false); return fmaxf(__uint_as_float(rr[0]), __uint_as_float(rr[1])); }
__device__ __forceinline__ float xhalf_sum(float m) { const auto rr = __builtin_amdgcn_permlane32_swap(__float_as_uint(m), __float_as_uint(m), false, false); return __uint_as_float(rr[0]) + __uint_as_float(rr[1]); }
__device__ __forceinline__ bf16x8 pack8f(const f32x4 a, const f32x4 b) { u32x4 w; w.x = cvt_pk_bf16(a[0], a[1]); w.y = cvt_pk_bf16(a[2], a[3]); w.z = cvt_pk_bf16(b[0], b[1]); w.w = cvt_pk_bf16(b[2], b[3]); return __builtin_bit_cast(bf16x8, w); }
__device__ __forceinline__ float fast_tanh(float x) { const float e = __expf(-2.f * fabsf(x)); const float t = (1.f - e) * __builtin_amdgcn_rcpf(1.f + e); return x < 0.f ? -t : t; }
__device__ __forceinline__ void tr_tile(const float* __restrict__ src, size_t ld, int k0, int c0, int nvalid, bf16_t* __restrict__ dst, int K, LAS float* scr, int lane) {
    float tv[64];
#pragma unroll
    for (int kk = 0; kk < 64; ++kk) tv[kk] = src[(size_t)(k0 + kk) * ld + c0 + (lane < nvalid ? lane : 0)];
#pragma unroll
    for (int kk = 0; kk < 64; ++kk) scr[kk * 65 + lane] = (lane < nvalid) ? tv[kk] : 0.f;
    const int nl = lane >> 3, kc8 = (lane & 7) * 8;
#pragma unroll
    for (int it = 0; it < 8; ++it) { const int nn = 8 * it + nl; const LAS float* s = scr + kc8 * 65 + nn;
        u32x4 w; w.x = cvt_pk_bf16(s[0], s[65]); w.y = cvt_pk_bf16(s[130], s[195]); w.z = cvt_pk_bf16(s[260], s[325]); w.w = cvt_pk_bf16(s[390], s[455]);
        *(u32x4*)(dst + (size_t)nn * K + k0 + kc8) = w; }
}
__device__ __forceinline__ void p0_weights(KP p, LAS unsigned char* lds, int gw, int ngw, int wave, int lane) {
    LAS float* scr = (LAS float*)lds + wave * SLOT_F;
    constexpr int T_WIN = (NU / 64) * 32, T_WBR = 4 * 32 * 8, T_WOUT = 32 * 32, T_POOL = 4 * 2 * 2, T_L = T_WIN + T_WBR + T_WOUT + T_POOL;
    for (int it = gw; it < 2 * T_L; it += ngw) {
        const int l = it / T_L; int r = it % T_L;
        if (r < T_WIN) {
            const int nt = r / 32, kt = r % 32, m0 = nt * 64;
            int c0, nvalid = 64;
            if (m0 < 3072) c0 = m0; else if (m0 < U_F) c0 = m0 + 8; else if (m0 == U_F) { c0 = 3072; nvalid = 8; } else { c0 = 0; nvalid = 0; }
            tr_tile(p->in[I_WIN] + (size_t)l * 2048 * IN_W, IN_W, kt * 64, c0, nvalid, (bf16_t*)(p->ws + WS_WIN) + ((size_t)l * NU + m0) * 2048, 2048, scr, lane);
            continue; }
        r -= T_WIN;
        if (r < T_WBR) {
            const int n = r / 256, q = r % 256, nt = q / 8, kt = q % 8;
            tr_tile(p->in[I_WBR] + ((size_t)(l * 4 + n) * 512) * 2048, 2048, kt * 64, nt * 64, 64, (bf16_t*)(p->ws + WS_WBR) + ((size_t)(l * 4 + n) * 2048 + nt * 64) * 512, 512, scr, lane);
            continue; }
        r -= T_WBR;
        if (r < T_WOUT) {
            const int nt = r / 32, kt = r % 32;
            tr_tile(p->in[I_WOUT] + (size_t)l * 2048 * 2048, 2048, kt * 64, nt * 64, 64, (bf16_t*)(p->ws + WS_WOUT) + ((size_t)l * 2048 + nt * 64) * 2048, 2048, scr, lane);
            continue; }
        r -= T_WOUT;
        {
            const int g = r / 4, q = r % 4, nt = q / 2, kt = q % 2;
            tr_tile(p->in[I_POOLW] + (size_t)(l * 4 + g) * 128 * 128, 128, kt * 64, nt * 64, 64, (bf16_t*)(p->ws + WS_POOLW) + ((size_t)(l * 4 + g) * 128 + nt * 64) * 128, 128, scr, lane);
        }
    }
}
__device__ __forceinline__ void ada_unit(KP p, int unit, LAS unsigned char* lds, int tid) {
    const int wave = tid >> 6, lane = tid & 63, li = lane & 31, kh = lane >> 5, l = unit / 96, n0 = (unit % 96) * 64;
    LAS float* cs = (LAS float*)lds + wave * (32 * 65 + 64);
    LAS float* c0l = cs + 32 * 65;
    LAS float* red = (LAS float*)lds + 8 * (32 * 65 + 64);
    const float* W = p->in[I_WADA] + (size_t)l * 2048 * 6144 + n0 + li;
    const float* cp = p->in[I_CP]; const float* csm = p->in[I_CS];
    f32x16 acc0 = {}, acc1 = {}; float ap0 = 0.f, ap1 = 0.f;
#pragma unroll 1
    for (int ch = 0; ch < 4; ++ch) {
        const int k0 = wave * 256 + ch * 64;
        float wb[64];
#pragma unroll
        for (int j = 0; j < 32; ++j) { const float* wp = W + (size_t)(k0 + 2 * j + kh) * 6144; wb[2 * j] = wp[0]; wb[2 * j + 1] = wp[32]; }
#pragma unroll
        for (int s = 0; s < 32; ++s) cs[s * 65 + lane] = siluf_(csm[(size_t)s * 2048 + k0 + lane]);
        c0l[lane] = siluf_(cp[k0 + lane]);
#pragma unroll
        for (int j = 0; j < 32; ++j) { const float a = cs[li * 65 + 2 * j + kh], c0v = c0l[2 * j + kh], b0 = wb[2 * j], b1 = wb[2 * j + 1];
            acc0 = __builtin_amdgcn_mfma_f32_32x32x2f32(a, b0, acc0, 0, 0, 0); acc1 = __builtin_amdgcn_mfma_f32_32x32x2f32(a, b1, acc1, 0, 0, 0);
            ap0 += c0v * b0; ap1 += c0v * b1; }
    }
    ap0 = xhalf_sum(ap0); ap1 = xhalf_sum(ap1);
    if (kh == 0) { red[(wave * 33) * 64 + li] = ap0; red[(wave * 33) * 64 + 32 + li] = ap1; }
#pragma unroll
    for (int r = 0; r < 16; ++r) { const int s = 1 + (r & 3) + 8 * (r >> 2) + 4 * kh; red[(wave * 33 + s) * 64 + li] = acc0[r]; red[(wave * 33 + s) * 64 + 32 + li] = acc1[r]; }
    __syncthreads();
    for (int idx = tid; idx < 33 * 64; idx += 512) { const int s = idx >> 6, n = idx & 63; float v = p->in[I_BADA][l * 6144 + n0 + n];
#pragma unroll
        for (int w = 0; w < 8; ++w) v += red[(w * 33 + s) * 64 + n];
        ((float*)(p->ws + WS_ADA))[((size_t)l * 33 + s) * 6144 + n0 + n] = v; }
    __syncthreads();
}
__device__ __forceinline__ void load_x8(KP p, int l, int row, int lane, f32x4 (&v)[8]) {
    if (row < TP) { const f32x4* x4 = (const f32x4*)(l == 0 ? p->in[I_XP] + (size_t)row * DM : (const float*)(p->ws + WS_XBUF) + (size_t)row * DM) + lane;
#pragma unroll
        for (int j = 0; j < 8; ++j) v[j] = x4[64 * j]; }
    else { const int r = row - TP; const f32x4* x4 = (const f32x4*)(p->in[I_XS] + (size_t)r * DM) + lane;
#pragma unroll
        for (int j = 0; j < 8; ++j) v[j] = x4[64 * j];
        for (int s = 0; s < 8 * l; ++s) { const f32x4* q4 = (const f32x4*)((const float*)(p->ws + WS_XPART) + ((size_t)s * 1024 + r) * DM) + lane;
#pragma unroll
            for (int j = 0; j < 8; ++j) v[j] += q4[64 * j]; } }
}
__device__ __forceinline__ void p1_rows(KP p, int l, int gw, int ngw, int lane) {
    const f32x4* g4 = (const f32x4*)(p->in[I_NORMG] + l * DM) + lane;
    f32x4 a[8], sh[8]; int cur_seq = -1;
    for (int row = gw; row < NTOK; row += ngw) {
        const int seq = row < TP ? 0 : 1 + ((row - TP) >> 5);
        f32x4 v[8]; float ss = 0.f; load_x8(p, l, row, lane, v);
#pragma unroll
        for (int j = 0; j < 8; ++j) { ss += (v[j].x * v[j].x + v[j].y * v[j].y) + (v[j].z * v[j].z + v[j].w * v[j].w); }
        if (seq != cur_seq) { cur_seq = seq;
            const f32x4* sh4 = (const f32x4*)((const float*)(p->ws + WS_ADA) + ((size_t)l * 33 + seq) * 6144) + lane; const f32x4* sc4 = sh4 + 512;
#pragma unroll
            for (int j = 0; j < 8; ++j) { a[j] = g4[64 * j] * (sc4[64 * j] + 1.f); sh[j] = sh4[64 * j]; } }
        const float rstd = 1.f / sqrtf(wave_sum(ss) * (1.f / DM) + 1e-6f);
        u32x2* o = (u32x2*)((bf16_t*)(p->ws + WS_H) + (size_t)row * DM) + lane;
#pragma unroll
        for (int j = 0; j < 8; ++j) { const f32x4 y = v[j] * rstd * a[j] + sh[j];
            u32x2 w; w.x = cvt_pk_bf16(y.x, y.y); w.y = cvt_pk_bf16(y.z, y.w); o[64 * j] = w; }
    }
}
__device__ __forceinline__ void p_final_rows(KP p, int gw, int ngw, int lane) {
    const f32x4* g4 = (const f32x4*)p->in[I_FING] + lane;
    for (int row = gw; row < NTOK; row += ngw) {
        f32x4 v[8]; float ss = 0.f; load_x8(p, 2, row, lane, v);
#pragma unroll
        for (int j = 0; j < 8; ++j) { ss += (v[j].x * v[j].x + v[j].y * v[j].y) + (v[j].z * v[j].z + v[j].w * v[j].w); }
        const float rstd = 1.f / sqrtf(wave_sum(ss) * (1.f / DM) + 1e-6f);
        f32x4* o = (f32x4*)(p->out + O_YP + (size_t)row * DM) + lane;
#pragma unroll
        for (int j = 0; j < 8; ++j) o[64 * j] = v[j] * rstd * g4[64 * j];
    }
}
struct EpiU {
    static constexpr bool PERM = true, AFTER_DRAIN = false; static constexpr int PROBE = 50;
    bf16_t* U; float* out; const float* bf; int l;
    __device__ __forceinline__ void operator()(const f32x4 (&acc)[2][2][4][2], const pg8::Unit& u, int wr, int wc, int fr, int fq) const {
        const int row0 = u.pm * 256 + wr * 64 + fr, col0 = u.pn * 256 + wc * 32 + 8 * fq;
#pragma unroll
        for (int ai = 0; ai < 2; ++ai)
#pragma unroll
            for (int m = 0; m < 4; ++m) { bf16_t* rowp = U + (size_t)(row0 + ai * 128 + m * 16) * NU + col0;
#pragma unroll
                for (int bj = 0; bj < 2; ++bj) { const f32x4 v0 = acc[ai][bj][m][0], v1 = acc[ai][bj][m][1];
                    u32x4 w; w.x = cvt_pk_bf16(v0[0], v0[1]); w.y = cvt_pk_bf16(v0[2], v0[3]); w.z = cvt_pk_bf16(v1[0], v1[1]); w.w = cvt_pk_bf16(v1[2], v1[3]);
                    *(u32x4*)(rowp + bj * 128) = w; } }
        if (u.pn >= 8 && u.pn < 12) {
            const bool isv = u.pn >= 10; const int cin = (u.pn - (isv ? 10 : 8)) * 256 + wc * 32 + 8 * fq;
#pragma unroll
            for (int ai = 0; ai < 2; ++ai)
#pragma unroll
                for (int m = 0; m < 4; ++m) { const int row = row0 + ai * 128 + m * 16;
                    float* dst = row < TP ? out + (isv ? O_PV : O_PK) + ((size_t)l * TP + row) * 512 : out + (isv ? O_SV : O_SK) + ((size_t)l * 1024 + (row - TP)) * 512;
#pragma unroll
                    for (int bj = 0; bj < 2; ++bj) { *(f32x4*)(dst + cin + bj * 128) = acc[ai][bj][m][0]; *(f32x4*)(dst + cin + bj * 128 + 4) = acc[ai][bj][m][1]; } }
        }
        if (u.pn == 58 && wc == 0 && fq == 0) {
            const f32x4 b0 = *(const f32x4*)(bf + l * 8), b1 = *(const f32x4*)(bf + l * 8 + 4);
#pragma unroll
            for (int ai = 0; ai < 2; ++ai)
#pragma unroll
                for (int m = 0; m < 4; ++m) { const int row = row0 + ai * 128 + m * 16;
                    float* dst = row < TP ? out + O_PLF + ((size_t)l * TP + row) * 8 : out + O_SLF + ((size_t)l * 1024 + (row - TP)) * 8;
                    const f32x4 z0 = acc[ai][1][m][0] + b0, z1 = acc[ai][1][m][1] + b1; f32x4 o0, o1;
#pragma unroll
                    for (int e = 0; e < 4; ++e) { o0[e] = log_sigmoidf_(z0[e]); o1[e] = log_sigmoidf_(z1[e]); }
                    *(f32x4*)dst = o0; *(f32x4*)(dst + 4) = o1; }
        }
    }
};
struct BranchOrder {
    int G, c;
    __device__ __forceinline__ bool next(int i, pg8::Unit& u) const { const int L = i * G + c; if (L >= 4 * 544) return false; const int n = L / 544, t = L - n * 544; u.pm = n * 68 + (t >> 3); u.pn = n * 8 + (t & 7); return true; }
    __device__ __forceinline__ void a_ready(const pg8::Unit&) const {}
    __device__ __forceinline__ void done(const pg8::Unit&) const {}
};
struct EpiZ {
    static constexpr bool PERM = true, AFTER_DRAIN = false; static constexpr int PROBE = 51;
    bf16_t* Z; const bf16_t* U;
    __device__ __forceinline__ void operator()(const f32x4 (&acc)[2][2][4][2], const pg8::Unit& u, int wr, int wc, int fr, int fq) const {
        const int row0 = u.pm * 256 + wr * 64 + fr, col0 = (u.pn & 7) * 256 + wc * 32 + 8 * fq;
#pragma unroll
        for (int ai = 0; ai < 2; ++ai)
#pragma unroll
            for (int m = 0; m < 4; ++m) { bf16_t* rowp = Z + (size_t)(row0 + ai * 128 + m * 16) * DM + col0;
#pragma unroll
                for (int bj = 0; bj < 2; ++bj) { const f32x4 v0 = acc[ai][bj][m][0], v1 = acc[ai][bj][m][1];
                    u32x4 w; w.x = cvt_pk_bf16(v0[0], v0[1]); w.y = cvt_pk_bf16(v0[2], v0[3]); w.z = cvt_pk_bf16(v1[0], v1[1]); w.w = cvt_pk_bf16(v1[2], v1[3]);
                    *(u32x4*)(rowp + bj * 128) = w; } }
    }
};
__device__ __forceinline__ void merge_pass(KP p, int l, int gtid, int ngt) {
    const bf16_t* U = (const bf16_t*)(p->ws + WS_U); const bf16_t* Z = (const bf16_t*)(p->ws + WS_Z); bf16_t* M = (bf16_t*)(p->ws + WS_MERGED);
    for (int it0 = gtid; it0 < NTOK * 256; it0 += 3 * ngt) {
        u32x4 gv[3][4], zv[3][4];
#pragma unroll
        for (int k = 0; k < 3; ++k) { const int it = it0 + k * ngt < NTOK * 256 ? it0 + k * ngt : it0; const int row = it >> 8, col = (it & 255) * 8;
#pragma unroll
            for (int n = 0; n < 4; ++n) { gv[k][n] = *(const u32x4*)(U + (size_t)row * NU + U_G + n * 2048 + col); zv[k][n] = *(const u32x4*)(Z + ((size_t)n * NTOK + row) * DM + col); } }
#pragma unroll
        for (int k = 0; k < 3; ++k) { const int it = it0 + k * ngt; if (it < NTOK * 256) { const int row = it >> 8, col = (it & 255) * 8;
            float s[8];
#pragma unroll
            for (int e = 0; e < 8; ++e) s[e] = 0.f;
#pragma unroll
            for (int n = 0; n < 4; ++n) { const u32x4 g = gv[k][n], z = zv[k][n];
                s[0] += sigmoidf_(bflo(g.x)) * bflo(z.x); s[1] += sigmoidf_(bfhi(g.x)) * bfhi(z.x); s[2] += sigmoidf_(bflo(g.y)) * bflo(z.y); s[3] += sigmoidf_(bfhi(g.y)) * bfhi(z.y);
                s[4] += sigmoidf_(bflo(g.z)) * bflo(z.z); s[5] += sigmoidf_(bfhi(g.z)) * bfhi(z.z); s[6] += sigmoidf_(bflo(g.w)) * bflo(z.w); s[7] += sigmoidf_(bfhi(g.w)) * bfhi(z.w); }
            u32x4 w; w.x = cvt_pk_bf16(s[0], s[1]); w.y = cvt_pk_bf16(s[2], s[3]); w.z = cvt_pk_bf16(s[4], s[5]); w.w = cvt_pk_bf16(s[6], s[7]);
            *(u32x4*)(M + (size_t)row * DM + col) = w; } }
    }
}
struct EpiOut {
    static constexpr bool PERM = false, AFTER_DRAIN = false; static constexpr int PROBE = 52;
    const float* xp; const float* xs; const float* xb; const float* ada; float* xout; int l;
    __device__ __forceinline__ void operator()(const f32x4 (&acc)[2][2][4][2], const pg8::Unit& u, int wr, int wc, int fr, int fq) const {
        const int row0 = u.pm * 256 + wr * 64 + fr, col0 = u.pn * 256 + wc * 32 + 4 * fq;
        f32x4 gt[2][2];
#pragma unroll
        for (int ai = 0; ai < 2; ++ai)
#pragma unroll
            for (int mp = 0; mp < 4; mp += 2) {
                f32x4 bs[2][2][2], gv[2][2][2];
#pragma unroll
                for (int mm = 0; mm < 2; ++mm) { const int row = row0 + ai * 128 + (mp + mm) * 16;
                    const float* base = l == 0 ? (row < TP ? xp + (size_t)row * DM : xs + (size_t)(row - TP) * DM) : xb + (size_t)row * DM;
                    const float* gate = ada + ((size_t)l * 33 + (row < TP ? 0 : 1 + ((row - TP) >> 5))) * 6144 + 4096;
#pragma unroll
                    for (int bj = 0; bj < 2; ++bj)
#pragma unroll
                        for (int n = 0; n < 2; ++n) { const int col = col0 + bj * 128 + n * 16; bs[mm][bj][n] = *(const f32x4*)(base + col); gv[mm][bj][n] = *(const f32x4*)(gate + col); } }
#pragma unroll
                for (int mm = 0; mm < 2; ++mm) { const int row = row0 + ai * 128 + (mp + mm) * 16;
#pragma unroll
                    for (int bj = 0; bj < 2; ++bj)
#pragma unroll
                        for (int n = 0; n < 2; ++n) { const int col = col0 + bj * 128 + n * 16; *(f32x4*)(xout + (size_t)row * DM + col) = bs[mm][bj][n] + gv[mm][bj][n] * acc[ai][bj][mp + mm][n]; } }
            }
        (void)gt;
    }
};
struct OneUnit {
    int pm, pn; bool valid;
    __device__ __forceinline__ bool next(int i, pg8::Unit& u) const { if (i > 0 || !valid) return false; u.pm = pm; u.pn = pn; return true; }
    __device__ __forceinline__ void a_ready(const pg8::Unit&) const {}
    __device__ __forceinline__ void done(const pg8::Unit&) const {}
};
struct EpiOutPart {
    static constexpr bool PERM = false, AFTER_DRAIN = false; static constexpr int PROBE = 53;
    const float* ada; float* part; int l;
    __device__ __forceinline__ void operator()(const f32x4 (&acc)[2][2][4][2], const pg8::Unit& u, int wr, int wc, int fr, int fq) const {
        const int row0 = u.pm * 256 + wr * 64 + fr - TP, col0 = u.pn * 256 + wc * 32 + 4 * fq;
#pragma unroll
        for (int ai = 0; ai < 2; ++ai)
#pragma unroll
            for (int m = 0; m < 4; ++m) { const int r = row0 + ai * 128 + m * 16;
                const float* gate = ada + ((size_t)l * 33 + 1 + (r >> 5)) * 6144 + 4096;
#pragma unroll
                for (int bj = 0; bj < 2; ++bj)
#pragma unroll
                    for (int n = 0; n < 2; ++n) { const int col = col0 + bj * 128 + n * 16; *(f32x4*)(part + (size_t)r * DM + col) = *(const f32x4*)(gate + col) * acc[ai][bj][m][n]; } }
    }
};
constexpr int CGS = 516;
__device__ __forceinline__ void conv_unit(KP p, int l, int tile, LAS unsigned char* lds, int tid) {
    const bf16_t* U = (const bf16_t*)(p->ws + WS_U);
    const int c = tid, wave = tid >> 6, lane = tid & 63;
    const bool samp = tile >= 512; const int b = tile - 512, row0 = samp ? TP + b * 32 : tile * 32;
    const bool last = samp || tile == 511;
    LAS float* gl = (LAS float*)lds;
    LAS bf16_t* sgl = (LAS bf16_t*)(lds + 62 * CGS * 4);
    LAS float* red = (LAS float*)(lds + 62 * CGS * 4 + 32 * 512 * 2);
    LAS float* st = red + 8 * 32;
#pragma unroll
    for (int k = 0; k < 8; ++k) { const int task = tid + 512 * k; if (task < 62 * 64) { const int i = task >> 6, ch = task & 63; f32x4 o0, o1;
        const int rel = i - 30;
        if (rel < 0 && samp) { const float* hp = p->in[I_SCONV] + (((size_t)l * 32 + b) * 30 + i) * 512 + 8 * ch; o0 = *(const f32x4*)hp; o1 = *(const f32x4*)(hp + 4); }
        else if (row0 + rel < 0) { o0 = (f32x4){0.f, 0.f, 0.f, 0.f}; o1 = o0; }
        else { const bf16_t* up = U + (size_t)(row0 + rel) * NU + 8 * ch; const u32x4 v = *(const u32x4*)(up + U_AVAL), g = *(const u32x4*)(up + U_AGATE);
            o0 = (f32x4){bflo(v.x) * sigmoidf_(bflo(g.x)), bfhi(v.x) * sigmoidf_(bfhi(g.x)), bflo(v.y) * sigmoidf_(bflo(g.y)), bfhi(v.y) * sigmoidf_(bfhi(g.y))};
            o1 = (f32x4){bflo(v.z) * sigmoidf_(bflo(g.z)), bfhi(v.z) * sigmoidf_(bfhi(g.z)), bflo(v.w) * sigmoidf_(bflo(g.w)), bfhi(v.w) * sigmoidf_(bfhi(g.w))}; }
        *(LAS f32x4*)(gl + i * CGS + 8 * ch) = o0; *(LAS f32x4*)(gl + i * CGS + 8 * ch + 4) = o1; } }
#pragma unroll
    for (int k = 0; k < 4; ++k) { const int task = tid + 512 * k, t = task >> 6, ch = task & 63; const u32x4 s = *(const u32x4*)(U + (size_t)(row0 + t) * NU + U_ASG + 8 * ch);
        u32x4 w; w.x = cvt_pk_bf16(siluf_(bflo(s.x)), siluf_(bfhi(s.x))); w.y = cvt_pk_bf16(siluf_(bflo(s.y)), siluf_(bfhi(s.y))); w.z = cvt_pk_bf16(siluf_(bflo(s.z)), siluf_(bfhi(s.z))); w.w = cvt_pk_bf16(siluf_(bflo(s.w)), siluf_(bfhi(s.w)));
        *(LAS u32x4*)(sgl + t * 512 + 8 * ch) = w; }
    const float cb = p->in[I_CONVB][l * 512 + c], lg = p->in[I_CLNG][l * 512 + c], lb = p->in[I_CLNB][l * 512 + c];
    float wk[31];
#pragma unroll
    for (int k = 0; k < 31; ++k) wk[k] = p->in[I_CONVW][((size_t)l * 31 + k) * 512 + c];
    __syncthreads();
    if (last) {
        float* dst = samp ? p->out + O_SCONV + (((size_t)l * 32 + b) * 30) * 512 + c : p->out + O_PCONV + ((size_t)l * 30) * 512 + c;
#pragma unroll
        for (int t = 2; t < 32; ++t) dst[(size_t)(t - 2) * 512] = gl[(30 + t) * CGS + c];
    }
    bf16_t* oa = (bf16_t*)(p->ws + WS_OCAT);
#pragma unroll 1
    for (int half = 0; half < 2; ++half) {
        float z[46];
#pragma unroll
        for (int i = 0; i < 46; ++i) z[i] = gl[(16 * half + i) * CGS + c];
        float hv[16];
#pragma unroll
        for (int tt = 0; tt < 16; ++tt) hv[tt] = cb;
#pragma unroll
        for (int k = 0; k < 31; ++k) {
#pragma unroll
            for (int tt = 0; tt < 16; ++tt) hv[tt] += z[tt + k] * wk[k]; }
#pragma unroll
        for (int tt = 0; tt < 16; ++tt) { const float s1 = wave_sum(hv[tt]), s2 = wave_sum(hv[tt] * hv[tt]); if (lane == 0) { red[(wave * 16 + tt) * 2] = s1; red[(wave * 16 + tt) * 2 + 1] = s2; } }
        __syncthreads();
        if (tid < 16) { float s1 = 0.f, s2 = 0.f;
#pragma unroll
            for (int w = 0; w < 8; ++w) { s1 += red[(w * 16 + tid) * 2]; s2 += red[(w * 16 + tid) * 2 + 1]; }
            const float mean = s1 * (1.f / 512.f), var = fmaxf(s2 * (1.f / 512.f) - mean * mean, 0.f);
            st[tid * 2] = mean; st[tid * 2 + 1] = 1.f / sqrtf(var + 1e-5f); }
        __syncthreads();
#pragma unroll
        for (int tt = 0; tt < 16; ++tt) { const float y = (hv[tt] - st[tt * 2]) * st[tt * 2 + 1] * lg + lb; const int t = 16 * half + tt;
            oa[(size_t)(row0 + t) * 512 + c] = f2bf(siluf_(y) * bf2f(sgl[t * 512 + c])); }
    }
    __syncthreads();
}
__device__ __forceinline__ void pool_unit(KP p, int l, int tile, LAS unsigned char* lds, int tid) {
    const bf16_t* U = (const bf16_t*)(p->ws + WS_U);
    const int c = tid, wave = tid >> 6, lane = tid & 63;
    const bool samp = tile >= 512; const int b = tile - 512, row0 = samp ? TP + b * 32 : tile * 32;
    constexpr int PST = 520;
    LAS float* zl = (LAS float*)lds;
    LAS bf16_t* pl = (LAS bf16_t*)(lds + 47 * CGS * 4);
#pragma unroll
    for (int k = 0; k < 6; ++k) { const int task = tid + 512 * k; if (task < 47 * 64) { const int i = task >> 6, ch = task & 63; f32x4 o0, o1; const int rel = i - 15;
        if (rel < 0 && samp) { const float* hp = p->in[I_SPOOL] + (((size_t)l * 32 + b) * 15 + i) * 512 + 8 * ch; o0 = *(const f32x4*)hp; o1 = *(const f32x4*)(hp + 4); }
        else if (row0 + rel < 0) { o0 = (f32x4){0.f, 0.f, 0.f, 0.f}; o1 = o0; }
        else { const u32x4 v = *(const u32x4*)(U + (size_t)(row0 + rel) * NU + U_DIN + 8 * ch); o0 = (f32x4){bflo(v.x), bfhi(v.x), bflo(v.y), bfhi(v.y)}; o1 = (f32x4){bflo(v.z), bfhi(v.z), bflo(v.w), bfhi(v.w)}; }
        *(LAS f32x4*)(zl + i * CGS + 8 * ch) = o0; *(LAS f32x4*)(zl + i * CGS + 8 * ch + 4) = o1; } }
    u32x4 sgv[4];
#pragma unroll
    for (int k = 0; k < 4; ++k) { const int task = tid + 512 * k; sgv[k] = *(const u32x4*)(U + (size_t)(row0 + (task >> 6)) * NU + U_DSG + 8 * (task & 63)); }
    __syncthreads();
    {
        float z[47];
#pragma unroll
        for (int i = 0; i < 47; ++i) z[i] = zl[i * CGS + c];
        if (samp || tile == 511) {
            float* dst = samp ? p->out + O_SPOOL + (((size_t)l * 32 + b) * 15) * 512 + c : p->out + O_PPOOL + ((size_t)l * 15) * 512 + c;
#pragma unroll
            for (int t = 17; t < 32; ++t) dst[(size_t)(t - 17) * 512] = z[15 + t];
        }
        const int w = 2 << (c >> 7);
#pragma unroll
        for (int t = 0; t < 32; ++t) { float s = 0.f;
#pragma unroll
            for (int i = 0; i < 16; ++i) s += (i < w) ? z[15 + t - i] : 0.f;
            const int pos = samp ? PAST + t : row0 + t; const int cnt = (pos + 1 < w) ? pos + 1 : w;
            pl[t * PST + c] = f2bf(s / (float)cnt - z[15 + t]); }
    }
    __syncthreads();
    LAS bf16_t* sl = (LAS bf16_t*)lds;
    LAS bf16_t* ol = sl + 32 * PST;
#pragma unroll
    for (int k = 0; k < 4; ++k) { const int task = tid + 512 * k, t = task >> 6, ch = task & 63; const u32x4 s = sgv[k];
        u32x4 w; w.x = cvt_pk_bf16(siluf_(bflo(s.x)), siluf_(bfhi(s.x))); w.y = cvt_pk_bf16(siluf_(bflo(s.y)), siluf_(bfhi(s.y))); w.z = cvt_pk_bf16(siluf_(bflo(s.z)), siluf_(bfhi(s.z))); w.w = cvt_pk_bf16(siluf_(bflo(s.w)), siluf_(bfhi(s.w)));
        *(LAS u32x4*)(sl + t * PST + 8 * ch) = w; }
    __syncthreads();
    {
        const int g = wave >> 1, fr = lane & 15, kq = lane >> 4;
        const bf16_t* WT = (const bf16_t*)(p->ws + WS_POOLW) + (size_t)(l * 4 + g) * 128 * 128;
        f32x4 acc[2][4];
#pragma unroll
        for (int mt = 0; mt < 2; ++mt)
#pragma unroll
            for (int nt = 0; nt < 4; ++nt) acc[mt][nt] = (f32x4){0.f, 0.f, 0.f, 0.f};
#pragma unroll
        for (int ks = 0; ks < 4; ++ks) {
            bf16x8 af[2];
#pragma unroll
            for (int mt = 0; mt < 2; ++mt) af[mt] = *(const LAS bf16x8*)(pl + (16 * mt + fr) * PST + g * 128 + 32 * ks + 8 * kq);
#pragma unroll
            for (int nt = 0; nt < 4; ++nt) { const int dl = (wave & 1) * 64 + 16 * nt + fr;
                const bf16x8 bfr = *(const bf16x8*)(WT + (size_t)dl * 128 + 32 * ks + 8 * kq);
#pragma unroll
                for (int mt = 0; mt < 2; ++mt) acc[mt][nt] = __builtin_amdgcn_mfma_f32_16x16x32_bf16(af[mt], bfr, acc[mt][nt], 0, 0, 0); }
        }
#pragma unroll
        for (int nt = 0; nt < 4; ++nt) { const int d = wave * 64 + 16 * nt + fr; const float pb = p->in[I_POOLB][l * 512 + d], ps = p->in[I_POOLS][l * 512 + d];
#pragma unroll
            for (int mt = 0; mt < 2; ++mt)
#pragma unroll
                for (int r = 0; r < 4; ++r) { const int t = 16 * mt + 4 * kq + r; ol[t * PST + d] = f2bf((acc[mt][nt][r] + pb) * ps * bf2f(sl[t * PST + d])); } }
    }
    __syncthreads();
    bf16_t* od = (bf16_t*)(p->ws + WS_OCAT) + (size_t)3 * NTOK * 512;
#pragma unroll
    for (int k = 0; k < 4; ++k) { const int task = tid + 512 * k, t = task >> 6, ch = task & 63; *(u32x4*)(od + (size_t)(row0 + t) * 512 + 8 * ch) = *(const LAS u32x4*)(ol + t * PST + 8 * ch); }
    __syncthreads();
}
__device__ __forceinline__ void fp_unit(KP p, int l, int h, LAS unsigned char* lds, int tid) {
    const float* lf = p->out + O_PLF + (size_t)l * TP * 8 + h;
    LAS float* part = (LAS float*)lds;
    float v[32]; float s = 0.f;
#pragma unroll
    for (int i = 0; i < 32; ++i) { v[i] = lf[(size_t)(tid * 32 + i) * 8]; s += v[i]; }
    part[tid] = s;
    __syncthreads();
    float pre = 0.f;
    for (int j = 0; j < tid; ++j) pre += part[j];
    float* F = (float*)(p->ws + WS_FP) + (size_t)h * TP + tid * 32;
#pragma unroll
    for (int i = 0; i < 32; ++i) { pre += v[i]; F[i] = pre * LOG2E; }
    __syncthreads();
}
__device__ __forceinline__ void gs_unit(KP p, int l, int b, LAS unsigned char* lds, int tid) {
    const int h = tid & 7, ch = tid >> 3;
    const float* cl = p->in[I_CLF] + (((size_t)l * 32 + b) * PAST + ch * 64) * 8 + h;
    LAS float* part = (LAS float*)lds;
    float v[64]; float s = 0.f;
#pragma unroll
    for (int i = 0; i < 64; ++i) v[i] = cl[(size_t)i * 8];
#pragma unroll
    for (int i = 0; i < 64; ++i) s += v[i];
    part[ch * 8 + h] = s;
    __syncthreads();
    float suf = 0.f;
    for (int j = ch + 1; j < 64; ++j) suf += part[j * 8 + h];
    float* G = (float*)(p->ws + WS_GS) + ((size_t)b * 8 + h) * GS_LEN + ch * 64;
#pragma unroll
    for (int i = 63; i >= 0; --i) { G[i] = -suf * LOG2E; suf += v[i]; }
    if (tid < 8) { const float* nl = p->out + O_SLF + ((size_t)l * 1024 + b * 32) * 8 + tid; float* Gn = (float*)(p->ws + WS_GS) + ((size_t)b * 8 + tid) * GS_LEN + PAST; float w[32]; float run = 0.f;
#pragma unroll
        for (int i = 0; i < 32; ++i) w[i] = nl[i * 8];
#pragma unroll
        for (int i = 0; i < 32; ++i) { run += w[i]; Gn[i] = run * LOG2E; } }
    __syncthreads();
}
__device__ __forceinline__ void vt_tile(KP p, int l, int tile, LAS unsigned char* lds, int wave, int lane) {
    const int h = tile >> 8, tb = tile & 255, tl = lane >> 3, q8 = (lane & 7) * 8;
    const bf16_t* U = (const bf16_t*)(p->ws + WS_U);
    LAS unsigned short* scr = (LAS unsigned short*)(lds + wave * (64 * 72 * 2));
    u32x4 kv[8], vv[8];
#pragma unroll
    for (int i = 0; i < 8; ++i) { const bf16_t* rp = U + (size_t)(tb * 64 + 8 * i + tl) * NU + h * 64 + q8; kv[i] = *(const u32x4*)(rp + U_K); vv[i] = *(const u32x4*)(rp + U_V); }
    float mx = 0.f;
#pragma unroll
    for (int i = 0; i < 8; ++i) { const u32x4 w = kv[i];
        float s = bflo(w.x) * bflo(w.x) + bfhi(w.x) * bfhi(w.x) + bflo(w.y) * bflo(w.y) + bfhi(w.y) * bfhi(w.y) + bflo(w.z) * bflo(w.z) + bfhi(w.z) * bfhi(w.z) + bflo(w.w) * bflo(w.w) + bfhi(w.w) * bfhi(w.w);
        s += dpp_mov<0xB1>(s); s += dpp_mov<0x4E>(s); s += dpp_mov<0x141>(s); mx = fmaxf(mx, s); }
    mx = wave_max(mx);
    if (lane == 0) atomicMax((unsigned*)(p->ws + WS_CTL) + CW_KMAX + l * 8 + h, __float_as_uint(mx));
#pragma unroll
    for (int i = 0; i < 8; ++i) { const int t = 8 * i + tl; const u32x4 w = vv[i];
        scr[(q8 + 0) * 72 + t] = (unsigned short)(w.x & 0xffffu); scr[(q8 + 1) * 72 + t] = (unsigned short)(w.x >> 16); scr[(q8 + 2) * 72 + t] = (unsigned short)(w.y & 0xffffu); scr[(q8 + 3) * 72 + t] = (unsigned short)(w.y >> 16);
        scr[(q8 + 4) * 72 + t] = (unsigned short)(w.z & 0xffffu); scr[(q8 + 5) * 72 + t] = (unsigned short)(w.z >> 16); scr[(q8 + 6) * 72 + t] = (unsigned short)(w.w & 0xffffu); scr[(q8 + 7) * 72 + t] = (unsigned short)(w.w >> 16); }
    bf16_t* Vt = (bf16_t*)(p->ws + WS_VT) + ((size_t)h * 64 + lane) * TP + tb * 64;
#pragma unroll
    for (int j = 0; j < 8; ++j) *(u32x4*)(Vt + 8 * j) = *(const LAS u32x4*)(scr + lane * 72 + 8 * j);
}
__device__ __forceinline__ void shift_out(KP p, int l, int tid) {
    const bf16_t* U = (const bf16_t*)(p->ws + WS_U);
    for (int base = tid; base < NSEQ * SHIFT_W; base += 512 * 8) {
        unsigned short v[8];
#pragma unroll
        for (int k = 0; k < 8; ++k) { const int idx = base + k * 512 < NSEQ * SHIFT_W ? base + k * 512 : tid; const int s = idx / SHIFT_W, j = idx - s * SHIFT_W; const int row = s == 0 ? TP - 1 : TP + (s - 1) * 32 + 31; v[k] = U[(size_t)row * NU + U_XC + j]; }
#pragma unroll
        for (int k = 0; k < 8; ++k) { const int idx = base + k * 512; if (idx < NSEQ * SHIFT_W) { const int s = idx / SHIFT_W, j = idx - s * SHIFT_W;
            float* dst = s == 0 ? p->out + O_PSHIFT + (size_t)l * SHIFT_W + j : p->out + O_SSHIFT + ((size_t)l * 32 + (s - 1)) * SHIFT_W + j; *dst = bf2f(v[k]); } }
    }
}
template <bool AT, bool BT, bool NEGA>
__device__ __forceinline__ void mm32(f32x16& acc, const LAS float* Ap, int i0, const LAS float* Bp, int j0, int lane) {
    const int li = lane & 31, kh = lane >> 5;
    const LAS float* ap = AT ? Ap + (8 * kh) * 65 + i0 + li : Ap + (i0 + li) * 65 + 8 * kh;
    const LAS float* bp = BT ? Bp + (j0 + li) * 65 + 8 * kh : Bp + (8 * kh) * 65 + j0 + li;
#pragma unroll 2
    for (int s = 0; s < 4; ++s) {
        float a[8], b[8];
#pragma unroll
        for (int e = 0; e < 8; ++e) { a[e] = AT ? ap[(16 * s + e) * 65] : ap[16 * s + e]; b[e] = BT ? bp[16 * s + e] : bp[(16 * s + e) * 65]; }
        if (NEGA) {
#pragma unroll
            for (int e = 0; e < 8; ++e) a[e] = -a[e]; }
        const bf16x8 af = pack8f((f32x4){a[0], a[1], a[2], a[3]}, (f32x4){a[4], a[5], a[6], a[7]}), bfg = pack8f((f32x4){b[0], b[1], b[2], b[3]}, (f32x4){b[4], b[5], b[6], b[7]});
        acc = __builtin_amdgcn_mfma_f32_32x32x16_bf16(af, bfg, acc, 0, 0, 0);
    }
}
template <int MASK>
__device__ __forceinline__ void st_tile(LAS float* dst, const f32x16& acc, int i0, int j0, int lane) {
    const int li = lane & 31, hi = lane >> 5, j = j0 + li;
#pragma unroll
    for (int r = 0; r < 16; ++r) { const int i = i0 + (r & 3) + 8 * (r >> 2) + 4 * hi; float v = acc[r];
        if (MASK == 1 && !(i < j)) v = 0.f; if (MASK == 2 && !(i <= j)) v = 0.f; dst[i * 65 + j] = v; }
}
struct RwkvSeqInfo { int row0, ntok, prev_kind  , b; };
__device__ __forceinline__ RwkvSeqInfo rwkv_info(int cu) { RwkvSeqInfo s; if (cu < 256) { s.row0 = cu * 64; s.ntok = 64; s.prev_kind = cu == 0 ? 0 : 1; s.b = 0; } else { s.b = cu - 256; s.row0 = TP + s.b * 32; s.ntok = 32; s.prev_kind = 2; } return s; }

__device__ __forceinline__ void rwkv_r1(KP p, int l, int unit, int unit_next, LAS unsigned char* lds, int tid) {
    const int cu = unit >> 3, h = unit & 7, wave = tid >> 6, lane = tid & 63, li = lane & 31, hi = lane >> 5;
    const RwkvSeqInfo si = rwkv_info(cu);
    const bf16_t* U = (const bf16_t*)(p->ws + WS_U);
    LAS float* S0 = (LAS float*)lds; LAS float *S1 = S0 + SLOT_F, *S2 = S0 + 2 * SLOT_F, *S3 = S0 + 3 * SLOT_F, *S4 = S0 + 4 * SLOT_F, *S5 = S0 + 5 * SLOT_F, *S6 = S0 + 6 * SLOT_F, *S7 = S0 + 7 * SLOT_F, *S8 = S0 + 8 * SLOT_F;
    LAS float* gC = S0 + 9 * SLOT_F;
    const int q = wave >> 2, wq = wave & 3, i0 = (wq >> 1) * 32, j0 = (wq & 1) * 32;
    PT0();
    {
        const int j = tid & 63, tq = tid >> 6;
        const int tl = lane >> 3, q8 = (lane & 7) * 8;
#pragma unroll
        for (int kb = 0; kb < 5; kb += 3) {
        u32x4 cur[5], prv[5];
#pragma unroll
        for (int k = kb; k < (kb + 3 < 5 ? kb + 3 : 5); ++k) { const int pid = wave * 5 + k, s = pid >> 3, tb = pid & 7, t = tb * 8 + tl;
            const int xo = (s < 3 ? s * 512 + h * 64 : 1536 + (s - 3) * 64) + q8;
            const int tc = t < si.ntok ? t : si.ntok - 1, tp = tc > 0 ? tc - 1 : (si.prev_kind == 1 ? -1 : 0);
            cur[k] = *(const u32x4*)(U + (size_t)(si.row0 + tc) * NU + U_XC + xo); prv[k] = *(const u32x4*)(U + (size_t)(si.row0 + tp) * NU + U_XC + xo); }
#pragma unroll
        for (int k = kb; k < (kb + 3 < 5 ? kb + 3 : 5); ++k) { const int pid = wave * 5 + k, s = pid >> 3, tb = pid & 7, t = tb * 8 + tl;
            const int xo = (s < 3 ? s * 512 + h * 64 : 1536 + (s - 3) * 64) + q8;
            LAS float* dst = (s == 0 ? S0 : s == 1 ? S1 : s == 2 ? S2 : s == 3 ? S3 : S4) + t * 65 + q8;
            const f32x4 m0 = *(const f32x4*)(p->in[I_MU] + l * SHIFT_W + xo), m1 = *(const f32x4*)(p->in[I_MU] + l * SHIFT_W + xo + 4);
            float x[8] = {bflo(cur[k].x), bfhi(cur[k].x), bflo(cur[k].y), bfhi(cur[k].y), bflo(cur[k].z), bfhi(cur[k].z), bflo(cur[k].w), bfhi(cur[k].w)};
            float pv[8] = {bflo(prv[k].x), bfhi(prv[k].x), bflo(prv[k].y), bfhi(prv[k].y), bflo(prv[k].z), bfhi(prv[k].z), bflo(prv[k].w), bfhi(prv[k].w)};
            if (t == 0 && si.prev_kind != 1) {
                if (si.prev_kind == 2) { const float* sp = p->in[I_SSHIFT] + ((size_t)l * 32 + si.b) * SHIFT_W + xo;
#pragma unroll
                    for (int e = 0; e < 8; ++e) pv[e] = sp[e]; }
                else {
#pragma unroll
                    for (int e = 0; e < 8; ++e) pv[e] = 0.f; } }
#pragma unroll
            for (int e = 0; e < 8; ++e) { const float mu = e < 4 ? m0[e] : m1[e - 4]; float xs = (t < si.ntok) ? x[e] + (pv[e] - x[e]) * mu : 0.f; if (s == 3) xs = fast_tanh(xs); dst[e] = xs; }
        }
        }
#pragma unroll
        for (int mm = 0; mm < 8; ++mm) { const int m = tq * 8 + mm;
            S5[m * 65 + j] = p->in[I_W2][((size_t)l * 64 + m) * 512 + h * 64 + j]; S6[m * 65 + j] = p->in[I_A2][((size_t)l * 64 + m) * 512 + h * 64 + j]; }
    }
    __syncthreads();
    PT1(1);
    {
        f32x16 acc = {};
        const int c = j0 + li;
        if (q == 0) { mm32<false, false, false>(acc, S3, i0, S5, j0, lane); const float w0 = p->in[I_W0][l * 512 + h * 64 + c];
#pragma unroll
            for (int r = 0; r < 16; ++r) { const int t = i0 + (r & 3) + 8 * (r >> 2) + 4 * hi; const float zz = acc[r] + w0;
                const float sp = fmaxf(-zz, 0.f) + __logf(1.f + __expf(-fabsf(zz)));
                S7[t * 65 + c] = (t < si.ntok) ? -__expf(-sp - 0.5f) : 0.f; } }
        else { mm32<false, false, false>(acc, S4, i0, S6, j0, lane); const float a0 = p->in[I_A0][l * 512 + h * 64 + c];
#pragma unroll
            for (int r = 0; r < 16; ++r) { const int t = i0 + (r & 3) + 8 * (r >> 2) + 4 * hi; S8[t * 65 + c] = __builtin_amdgcn_rcpf(1.f + __expf(-(acc[r] + a0))); } }
    }
    __syncthreads();
    PT1(2);
    if (wave == 0) { float run = 0.f;
#pragma unroll 8
        for (int t = 0; t < 64; ++t) { run += S7[t * 65 + lane]; S3[t * 65 + lane] = run; } }
    else { const int c = lane; const float kkw = p->in[I_KK][l * 512 + h * 64 + c], kaw = p->in[I_KA][l * 512 + h * 64 + c], rkw = p->in[I_RK][l * 512 + h * 64 + c];
        for (int t = wave - 1; t < 64; t += 7) { const float kr = S1[t * 65 + c], kv = kr * kkw; const float ss = wave_sum(kv * kv);
            const float kn = kv * (1.f / sqrtf(fmaxf(ss, 1e-24f))); const float a = S8[t * 65 + c]; const float km = kr * (1.f + (a - 1.f) * kaw);
            const float bon = wave_sum(S0[t * 65 + c] * km * rkw);
            S4[t * 65 + c] = kn; S1[t * 65 + c] = km; S8[t * 65 + c] = kn * a;
            if (lane == 0) ((float*)(p->ws + WS_BONUS))[(size_t)unit * 64 + t] = bon; } }
    __syncthreads();
    { const int c = tid & 63, tq = tid >> 6;
#pragma unroll
        for (int tt = 0; tt < 8; ++tt) { const int t = tq * 8 + tt, o = t * 65 + c; const float Lg = S3[o], lw = S7[o];
            const float g = __expf(Lg), gi = __expf(-Lg), gp = __expf(Lg - lw);
            S0[o] *= g; S1[o] *= gi; S8[o] *= gi; S4[o] *= gp; if (t == 63) gC[c] = g; } }
    __syncthreads();
    PT1(3);
    unsigned touch = 0u;
    if (unit_next < NRU && tid < 65 * 5) { const RwkvSeqInfo sn = rwkv_info(unit_next >> 3); const int hn = unit_next & 7, rr = tid / 5, ln = tid - rr * 5;
        const int trow = rr == 0 ? (sn.prev_kind == 1 ? -1 : 0) : (rr - 1 < sn.ntok ? rr - 1 : sn.ntok - 1);
        const int xo = ln < 3 ? ln * 512 + hn * 64 : 1536 + (ln - 3) * 64;
        touch = *(const unsigned*)(U + (size_t)(sn.row0 + trow) * NU + U_XC + xo); }
    { f32x16 acc = {};
      if (q == 0) { mm32<false, true, false>(acc, S1, i0, S4, j0, lane); st_tile<1>(S3, acc, i0, j0, lane); }
      else { mm32<false, true, false>(acc, S8, i0, S4, j0, lane); st_tile<1>(S5, acc, i0, j0, lane); } }
    __syncthreads();
    { f32x16 acc = {};
      if (q == 0) { mm32<true, false, false>(acc, S2, i0, S3, j0, lane); st_tile<0>(S6, acc, i0, j0, lane); }
      else { mm32<false, true, false>(acc, S1, i0, S0, j0, lane); st_tile<2>(S7, acc, i0, j0, lane); } }
    __syncthreads();
    asm volatile("" :: "v"(touch));
    PT1(4);
    { float xa[4], xb[4]; const int ra = 4 * wave, rb = 60 - 4 * wave;
#pragma unroll
      for (int k = 0; k < 4; ++k) { xa[k] = (lane == ra + k) ? 1.f : 0.f; xb[k] = (lane == rb + k) ? 1.f : 0.f; }
      for (int s = ra; s < rb; ++s) { const float mrow = S5[s * 65 + lane];
#pragma unroll
          for (int k = 0; k < 4; ++k) xa[k] -= __builtin_bit_cast(float, __builtin_amdgcn_readlane(__builtin_bit_cast(int, xa[k]), s)) * mrow; }
      for (int s = rb; s < 63; ++s) { const float mrow = S5[s * 65 + lane]; float ya[4], yb[4];
#pragma unroll
          for (int k = 0; k < 4; ++k) { ya[k] = __builtin_bit_cast(float, __builtin_amdgcn_readlane(__builtin_bit_cast(int, xa[k]), s)); yb[k] = __builtin_bit_cast(float, __builtin_amdgcn_readlane(__builtin_bit_cast(int, xb[k]), s)); }
#pragma unroll
          for (int k = 0; k < 4; ++k) { xa[k] -= ya[k] * mrow; xb[k] -= yb[k] * mrow; } }
#pragma unroll
      for (int k = 0; k < 4; ++k) { S3[(ra + k) * 65 + lane] = xa[k]; S3[(rb + k) * 65 + lane] = xb[k]; } }
    __syncthreads();
    { f32x16 acc = {};
      if (q == 0) mm32<true, false, false>(acc, S4, i0, S3, j0, lane); else mm32<false, false, false>(acc, S6, i0, S3, j0, lane);
      __syncthreads();
      st_tile<0>(q == 0 ? S3 : S6, acc, i0, j0, lane); }
    __syncthreads();
    PT1(5);
    { f32x16 acc = {};
      if (q == 1) { mm32<false, true, false>(acc, S8, i0, S0, j0, lane); st_tile<2>(S4, acc, i0, j0, lane); }
      else { mm32<false, false, false>(acc, S3, i0, S8, j0, lane);
          const int jc = j0 + li; const float gc = gC[jc]; float* TQ = (float*)(p->ws + WS_TQ) + (size_t)unit * 4096;
#pragma unroll
          for (int rg = 0; rg < 4; ++rg) { const int ab = i0 + 8 * rg + 4 * hi; f32x4 o;
#pragma unroll
              for (int e = 0; e < 4; ++e) o[e] = ((ab + e == jc) ? gc : 0.f) - acc[rg * 4 + e] * gc;
              *(f32x4*)(TQ + ((((jc >> 4) * 4 + (ab >> 4)) * 64 + ((ab & 15) >> 2) * 16 + (jc & 15)) * 4)) = o; } } }
    __syncthreads();
    { f32x16 acc = {};
      if (q == 0) { mm32<true, false, false>(acc, S2, i0, S1, j0, lane); mm32<false, false, true>(acc, S6, i0, S8, j0, lane);
          const int jc = j0 + li; const float gc = gC[jc]; float* GM = (float*)(p->ws + WS_GM) + (size_t)unit * 4096;
#pragma unroll
          for (int r = 0; r < 16; ++r) GM[(i0 + (r & 3) + 8 * (r >> 2) + 4 * hi) * 64 + jc] = acc[r] * gc; }
      else { mm32<true, false, false>(acc, S2, i0, S7, j0, lane); mm32<false, false, true>(acc, S6, i0, S4, j0, lane);
          float* Y0T = (float*)(p->ws + WS_Y0T) + (size_t)unit * 4096;
#pragma unroll
          for (int rg = 0; rg < 4; ++rg) *(f32x4*)(Y0T + (((((j0 >> 5) * 2 + (i0 >> 5)) * 4 + rg) * 2 + hi) * 32 + li) * 4) = (f32x4){acc[rg * 4], acc[rg * 4 + 1], acc[rg * 4 + 2], acc[rg * 4 + 3]}; } }
    if (q == 0) { f32x16 acc;
#pragma unroll
        for (int r = 0; r < 16; ++r) acc[r] = S0[(j0 + li) * 65 + i0 + (r & 3) + 8 * (r >> 2) + 4 * hi];
        mm32<false, false, true>(acc, S3, i0, S4, j0, lane);
        float* ET = (float*)(p->ws + WS_ET) + (size_t)unit * 4096;
#pragma unroll
        for (int rg = 0; rg < 4; ++rg) *(f32x4*)(ET + ((((j0 >> 5) * 2 + (i0 >> 5)) * 8 + 2 * rg + hi) * 32 + li) * 4) = (f32x4){acc[rg * 4], acc[rg * 4 + 1], acc[rg * 4 + 2], acc[rg * 4 + 3]}; }
    __syncthreads();
    PT1(6);
}
template <bool SCQ>
__device__ __forceinline__ void chain_run(f32x4 (&st)[4], const float* TQ, const float* GM, float* SC, int nsteps, int i, int g, int lane) {
    constexpr size_t STRIDE = (size_t)8 * 4096;
    f32x4 tq[16], gm[4];
#pragma unroll
    for (int x = 0; x < 16; ++x) tq[x] = *(const f32x4*)(TQ + (x * 64 + lane) * 4);
#pragma unroll
    for (int tl = 0; tl < 4; ++tl) gm[tl] = GM ? *(const f32x4*)(GM + i * 64 + 16 * tl + 4 * g) : (f32x4){0.f, 0.f, 0.f, 0.f};
    for (int c = 0; c < nsteps; ++c) {
        if (SC) {
            if (SCQ) {
#pragma unroll
                for (int tl = 0; tl < 4; ++tl) *(f32x4*)(SC + c * STRIDE + ((((i >> 5) * 2 + (tl >> 1)) * 8 + 4 * (tl & 1) + g) * 32 + (i & 31)) * 4) = st[tl]; }
            else {
#pragma unroll
                for (int tl = 0; tl < 4; ++tl) *(f32x4*)(SC + c * STRIDE + i * 64 + 16 * tl + 4 * g) = st[tl]; } }
        f32x4 tqn[16], gmn[4];
        const int cn = (c + 1 < nsteps) ? c + 1 : c;
#pragma unroll
        for (int x = 0; x < 16; ++x) tqn[x] = *(const f32x4*)(TQ + cn * STRIDE + (x * 64 + lane) * 4);
#pragma unroll
        for (int tl = 0; tl < 4; ++tl) gmn[tl] = GM ? *(const f32x4*)(GM + cn * STRIDE + i * 64 + 16 * tl + 4 * g) : (f32x4){0.f, 0.f, 0.f, 0.f};
        f32x4 acc[4];
#pragma unroll
        for (int tp = 0; tp < 4; ++tp) acc[tp] = gm[tp];
#pragma unroll
        for (int tl = 0; tl < 4; ++tl)
#pragma unroll
            for (int r = 0; r < 4; ++r)
#pragma unroll
                for (int tp = 0; tp < 4; ++tp) acc[tp] = __builtin_amdgcn_mfma_f32_16x16x4f32(tq[tp * 4 + tl][r], st[tl][r], acc[tp], 0, 0, 0);
#pragma unroll
        for (int tl = 0; tl < 4; ++tl) st[tl] = acc[tl];
#pragma unroll
        for (int x = 0; x < 16; ++x) tq[x] = tqn[x];
#pragma unroll
        for (int tl = 0; tl < 4; ++tl) gm[tl] = gmn[tl];
    }
}
constexpr int CH_SLOT = 32768;
#define CH_LD(R, STEP) do { const int s_ = (STEP) < nsteps ? (STEP) : nsteps - 1; _Pragma("unroll") for (int k = 0; k < 4; ++k) { R[k] = *(const f32x4*)(TQ + (size_t)s_ * STRIDE + (k * 256 + ll) * 4); \
        R[4 + k] = GM ? *(const f32x4*)(GM + (size_t)s_ * STRIDE + (k * 256 + ll) * 4) : (f32x4){0.f, 0.f, 0.f, 0.f}; } } while (0)
#define CH_WR(R, SLOT) do { LAS float* d_ = (LAS float*)(lds + (SLOT) * CH_SLOT); _Pragma("unroll") for (int k = 0; k < 4; ++k) { *(LAS f32x4*)(d_ + (k * 256 + ll) * 4) = R[k]; *(LAS f32x4*)(d_ + 4096 + (k * 256 + ll) * 4) = R[4 + k]; } } while (0)
template <bool SCQ>
__device__ __forceinline__ void chain_block(f32x4 (&st)[4], const float* TQ, const float* GM, float* SC, int nsteps, LAS unsigned char* lds, int wave, int lane) {
    constexpr size_t STRIDE = (size_t)8 * 4096;
    if (wave >= 4) {
        const int ll = (wave - 4) * 64 + lane;
        f32x4 r0[8], r1[8], r2[8];
        CH_LD(r0, 0); CH_LD(r1, 1); CH_LD(r2, 2);
        CH_WR(r0, 0);
        __syncthreads();
        for (int c = 0; c < nsteps; c += 3) {
            CH_WR(r1, (c + 1) & 1); CH_LD(r0, c + 3); __syncthreads();
            if (c + 1 < nsteps) { CH_WR(r2, (c + 2) & 1); CH_LD(r1, c + 4); __syncthreads(); }
            if (c + 2 < nsteps) { CH_WR(r0, (c + 3) & 1); CH_LD(r2, c + 5); __syncthreads(); }
        }
    } else {
        const int fr = lane & 15, g = lane >> 4, i = wave * 16 + fr;
        __syncthreads();
        for (int c = 0; c < nsteps; ++c) {
            if (SC) {
                if (SCQ) {
#pragma unroll
                    for (int tl = 0; tl < 4; ++tl) *(f32x4*)(SC + c * STRIDE + ((((i >> 5) * 2 + (tl >> 1)) * 8 + 4 * (tl & 1) + g) * 32 + (i & 31)) * 4) = st[tl]; }
                else {
#pragma unroll
                    for (int tl = 0; tl < 4; ++tl) *(f32x4*)(SC + c * STRIDE + i * 64 + 16 * tl + 4 * g) = st[tl]; } }
            const LAS float* sl = (const LAS float*)(lds + (c & 1) * CH_SLOT);
            f32x4 acc[4];
#pragma unroll
            for (int tp = 0; tp < 4; ++tp) acc[tp] = *(const LAS f32x4*)(sl + 4096 + i * 64 + 16 * tp + 4 * g);
#pragma unroll
            for (int tl = 0; tl < 4; ++tl) { f32x4 tq[4];
#pragma unroll
                for (int tp = 0; tp < 4; ++tp) tq[tp] = *(const LAS f32x4*)(sl + ((tp * 4 + tl) * 64 + lane) * 4);
#pragma unroll
                for (int r = 0; r < 4; ++r)
#pragma unroll
                    for (int tp = 0; tp < 4; ++tp) acc[tp] = __builtin_amdgcn_mfma_f32_16x16x4f32(tq[tp][r], st[tl][r], acc[tp], 0, 0, 0); }
#pragma unroll
            for (int tl = 0; tl < 4; ++tl) st[tl] = acc[tl];
            __syncthreads();
        }
    }
}
__device__ __forceinline__ void rwkv_l1_block(KP p, int task, LAS unsigned char* lds, int wave, int lane) {
    const int kind = task & 1, h = (task >> 1) & 7, grp = task >> 4, iq = wave & 3;
    const int fr = lane & 15, g = lane >> 4, i = iq * 16 + fr;
    const size_t u0 = ((size_t)(grp * 16) * 8 + h) * 4096;
    f32x4 st[4];
#pragma unroll
    for (int tl = 0; tl < 4; ++tl)
#pragma unroll
        for (int r = 0; r < 4; ++r) st[tl][r] = (kind == 1 && i == 16 * tl + 4 * g + r) ? 1.f : 0.f;
    chain_block<false>(st, (const float*)(p->ws + WS_TQ) + u0, kind == 0 ? (const float*)(p->ws + WS_GM) + u0 : nullptr, nullptr, 16, lds, wave, lane);
    if (wave < 4) { const size_t gb = ((size_t)grp * 8 + h) * 4096;
        if (kind == 0) { float* GG = (float*)(p->ws + WS_GG) + gb;
#pragma unroll
            for (int tl = 0; tl < 4; ++tl) *(f32x4*)(GG + i * 64 + 16 * tl + 4 * g) = st[tl]; }
        else { float* TG = (float*)(p->ws + WS_TG) + gb;
#pragma unroll
            for (int tl = 0; tl < 4; ++tl)
#pragma unroll
                for (int r = 0; r < 4; ++r) TG[((tl * 4 + iq) * 64 + (fr >> 2) * 16 + 4 * g + r) * 4 + (fr & 3)] = st[tl][r]; } }
    __syncthreads();
}
__device__ __forceinline__ void rwkv_l2_block(KP p, int l, int h, LAS unsigned char* lds, int wave, int lane) {
    const int iq = wave & 3, fr = lane & 15, g = lane >> 4, i = iq * 16 + fr;
    f32x4 st[4];
#pragma unroll
    for (int tl = 0; tl < 4; ++tl) st[tl] = (f32x4){0.f, 0.f, 0.f, 0.f};
    chain_block<false>(st, (const float*)(p->ws + WS_TG) + (size_t)h * 4096, (const float*)(p->ws + WS_GG) + (size_t)h * 4096, (float*)(p->ws + WS_SG) + (size_t)h * 4096, 16, lds, wave, lane);
    if (wave < 4) { float* dst = p->out + O_PWKV + (((size_t)l * 8 + h) * 64 + i) * 64;
#pragma unroll
        for (int tl = 0; tl < 4; ++tl) *(f32x4*)(dst + 16 * tl + 4 * g) = st[tl]; }
    __syncthreads();
}
__device__ __forceinline__ void rwkv_l3_block(KP p, int l, int task, LAS unsigned char* lds, int wave, int lane) {
    const int h = task & 7, grp = task >> 3, iq = wave & 3, fr = lane & 15, g = lane >> 4, i = iq * 16 + fr;
    f32x4 st[4];
#pragma unroll
    for (int tl = 0; tl < 4; ++tl) st[tl] = (f32x4){0.f, 0.f, 0.f, 0.f};
    if (grp > 0) chain_block<false>(st, (const float*)(p->ws + WS_TG) + (size_t)h * 4096, (const float*)(p->ws + WS_GG) + (size_t)h * 4096, nullptr, grp, lds, wave, lane);
    const size_t u0 = ((size_t)(grp * 16) * 8 + h) * 4096;
    chain_block<true>(st, (const float*)(p->ws + WS_TQ) + u0, (const float*)(p->ws + WS_GM) + u0, (float*)(p->ws + WS_SC) + u0, 16, lds, wave, lane);
    if (grp == 15 && wave < 4) { float* dst = p->out + O_PWKV + (((size_t)l * 8 + h) * 64 + i) * 64;
#pragma unroll
        for (int tl = 0; tl < 4; ++tl) *(f32x4*)(dst + 16 * tl + 4 * g) = st[tl]; }
    __syncthreads();
}
__device__ __forceinline__ void rwkv_samp_task(KP p, int l, int t2, int lane) {
    const int fr = lane & 15, g = lane >> 4, iq = t2 & 3, h = (t2 >> 2) & 7, b = t2 >> 5, i = iq * 16 + fr;
    f32x4 st[4];
    const float* s0 = p->in[I_SWKV] + ((((size_t)l * 32 + b) * 8 + h) * 64 + i) * 64;
#pragma unroll
    for (int tl = 0; tl < 4; ++tl) st[tl] = *(const f32x4*)(s0 + 16 * tl + 4 * g);
    const size_t u0 = ((size_t)(256 + b) * 8 + h) * 4096;
    chain_run<true>(st, (const float*)(p->ws + WS_TQ) + u0, (const float*)(p->ws + WS_GM) + u0, (float*)(p->ws + WS_SC) + u0, 1, i, g, lane);
    float* dst = p->out + O_SWKV + ((((size_t)l * 32 + b) * 8 + h) * 64 + i) * 64;
#pragma unroll
    for (int tl = 0; tl < 4; ++tl) *(f32x4*)(dst + 16 * tl + 4 * g) = st[tl];
}
__device__ __forceinline__ void rwkv_r3_task(KP p, int l, int task, int lane) {
    const int unit = task >> 1, th = task & 1, cu = unit >> 3, h = unit & 7, li = lane & 31, hi = lane >> 5;
    const RwkvSeqInfo si = rwkv_info(cu);
    if (th * 32 >= si.ntok) return;
    const bf16_t* U = (const bf16_t*)(p->ws + WS_U);
    const size_t ub = (size_t)unit * 4096; const int t = th * 32 + li;
    const float* SC = (const float*)(p->ws + WS_SC) + ub; const float* ET = (const float*)(p->ws + WS_ET) + ub; const float* Y0T = (const float*)(p->ws + WS_Y0T) + ub;
    f32x16 acc[2];
#pragma unroll
    for (int ti = 0; ti < 2; ++ti)
#pragma unroll
        for (int rg = 0; rg < 4; ++rg) { const f32x4 y0 = *(const f32x4*)(Y0T + ((((th * 2 + ti) * 4 + rg) * 2 + hi) * 32 + li) * 4);
#pragma unroll
            for (int e = 0; e < 4; ++e) acc[ti][rg * 4 + e] = y0[e]; }
    f32x4 eb[8], sa0[8], sa1[8];
#pragma unroll
    for (int s4 = 0; s4 < 8; ++s4) { eb[s4] = *(const f32x4*)(ET + (((th * 2 + hi) * 8 + s4) * 32 + li) * 4); sa0[s4] = *(const f32x4*)(SC + (((0 * 2 + hi) * 8 + s4) * 32 + li) * 4); sa1[s4] = *(const f32x4*)(SC + (((1 * 2 + hi) * 8 + s4) * 32 + li) * 4); }
#pragma unroll
    for (int ks = 0; ks < 4; ++ks) {
        const bf16x8 bfr = pack8f(eb[2 * ks], eb[2 * ks + 1]);
        acc[0] = __builtin_amdgcn_mfma_f32_32x32x16_bf16(pack8f(sa0[2 * ks], sa0[2 * ks + 1]), bfr, acc[0], 0, 0, 0);
        acc[1] = __builtin_amdgcn_mfma_f32_32x32x16_bf16(pack8f(sa1[2 * ks], sa1[2 * ks + 1]), bfr, acc[1], 0, 0, 0);
    }
    float s1 = 0.f;
#pragma unroll
    for (int ti = 0; ti < 2; ++ti)
#pragma unroll
        for (int r = 0; r < 16; ++r) s1 += acc[ti][r];
    s1 = xhalf_sum(s1); const float mean = s1 * (1.f / 64.f);
    float s2 = 0.f;
#pragma unroll
    for (int ti = 0; ti < 2; ++ti)
#pragma unroll
        for (int r = 0; r < 16; ++r) { const float d = acc[ti][r] - mean; s2 += d * d; }
    s2 = xhalf_sum(s2); const float rstd = 1.f / sqrtf(s2 * (1.f / 64.f) + 64e-5f);
    if (t >= si.ntok) return;
    const float bon = ((const float*)(p->ws + WS_BONUS))[(size_t)unit * 64 + t];
    const size_t row = (size_t)(si.row0 + t);
    bf16_t* oc = (bf16_t*)(p->ws + WS_OCAT) + (size_t)2 * NTOK * 512 + row * 512 + h * 64;
    u32x2 wout[2][4];
#pragma unroll
    for (int ti = 0; ti < 2; ++ti)
#pragma unroll
        for (int rg = 0; rg < 4; ++rg) { const int i = 32 * ti + 8 * rg + 4 * hi, c = h * 64 + i;
            const f32x4 gg = *(const f32x4*)(p->in[I_GNG] + l * 512 + c), gb = *(const f32x4*)(p->in[I_GNB] + l * 512 + c), mu = *(const f32x4*)(p->in[I_MU] + l * SHIFT_W + 1024 + c);
            const u32x2 vx = *(const u32x2*)(U + row * NU + U_XC + 1024 + c); const u32x2 sg = *(const u32x2*)(U + row * NU + U_CSG + c);
            f32x4 vc = (f32x4){bflo(vx.x), bfhi(vx.x), bflo(vx.y), bfhi(vx.y)}, vp;
            {
                const u32x2 px = *(const u32x2*)(U + (row > 0 ? row - 1 : 0) * NU + U_XC + 1024 + c); const f32x4 ss = *(const f32x4*)(p->in[I_SSHIFT] + ((size_t)l * 32 + si.b) * SHIFT_W + 1024 + c);
                const f32x4 up = (f32x4){bflo(px.x), bfhi(px.x), bflo(px.y), bfhi(px.y)};
                vp = (t > 0 || si.prev_kind == 1) ? up : (si.prev_kind == 2 ? ss : (f32x4){0.f, 0.f, 0.f, 0.f}); }
            const f32x4 vs = vc + (vp - vc) * mu;
            const f32x4 sgf = (f32x4){bflo(sg.x), bfhi(sg.x), bflo(sg.y), bfhi(sg.y)};
            f32x4 o;
#pragma unroll
            for (int e = 0; e < 4; ++e) o[e] = (((acc[ti][rg * 4 + e] - mean) * rstd) * gg[e] + gb[e] + bon * vs[e]) * siluf_(sgf[e]);
            wout[ti][rg].x = cvt_pk_bf16(o[0], o[1]); wout[ti][rg].y = cvt_pk_bf16(o[2], o[3]); }
#pragma unroll
    for (int ti = 0; ti < 2; ++ti)
#pragma unroll
        for (int rg = 0; rg < 4; ++rg) *(u32x2*)(oc + 32 * ti + 8 * rg + 4 * hi) = wout[ti][rg];
}
__device__ __forceinline__ int krow(int i) { return (i & 3) + 4 * ((i >> 3) & 1) + 8 * ((i >> 2) & 1) + 16 * (i >> 4); }
__device__ __forceinline__ bf16x8 pack8(const f32x16& v, int o) { u32x4 w; w.x = cvt_pk_bf16(v[o], v[o + 1]); w.y = cvt_pk_bf16(v[o + 2], v[o + 3]); w.z = cvt_pk_bf16(v[o + 4], v[o + 5]); w.w = cvt_pk_bf16(v[o + 6], v[o + 7]); return __builtin_bit_cast(bf16x8, w); }
constexpr float ATT_NEG = -1e30f;
template <bool HALF>
__device__ __forceinline__ void softmax_tile(f32x16& p0, f32x16& p1, float& m, float& lsum, f32x16 (&O)[2], bf16x8 (&pb)[4]) {
    float mx = p0[0];
#pragma unroll
    for (int r = 1; r < 16; ++r) mx = fmaxf(mx, p0[r]);
    if (!HALF) {
#pragma unroll
        for (int r = 0; r < 16; ++r) mx = fmaxf(mx, p1[r]); }
    mx = xhalf_max(mx);
    const float mn = fmaxf(m, mx), alpha = __builtin_amdgcn_exp2f(m - mn);
    m = mn;
    float s = 0.f;
#pragma unroll
    for (int r = 0; r < 16; ++r) { p0[r] = __builtin_amdgcn_exp2f(p0[r] - mn); s += p0[r]; }
    if (!HALF) {
#pragma unroll
        for (int r = 0; r < 16; ++r) { p1[r] = __builtin_amdgcn_exp2f(p1[r] - mn); s += p1[r]; } }
    lsum = lsum * alpha + s;
#pragma unroll
    for (int r = 0; r < 16; ++r) { O[0][r] *= alpha; O[1][r] *= alpha; }
    pb[0] = pack8(p0, 0); pb[1] = pack8(p0, 8);
    if (!HALF) { pb[2] = pack8(p1, 0); pb[3] = pack8(p1, 8); }
}
constexpr int AKS = 72;
constexpr int ATT_KB = 0, ATT_VB = 2 * 64 * AKS * 2, ATT_FB = 4 * 64 * AKS * 2, ATT_SC = ATT_FB + 2 * 64 * 4;
__device__ __forceinline__ void attn_prompt_unit(KP p, int l, int h, int qb, LAS unsigned char* lds, int tid) {
    const bf16_t* U = (const bf16_t*)(p->ws + WS_U); const bf16_t* Vt = (const bf16_t*)(p->ws + WS_VT) + (size_t)h * 64 * TP; const float* F = (const float*)(p->ws + WS_FP) + (size_t)h * TP;
    const int wave = tid >> 6, lane = tid & 63, li = lane & 31, hi = lane >> 5;
    const int q0 = qb * 256, q = q0 + wave * 32 + li;
    bf16x8 qf[4];
    { const float sc = 0.125f * LOG2E;
#pragma unroll
      for (int d0 = 0; d0 < 4; ++d0) { const u32x4 w = *(const u32x4*)(U + (size_t)q * NU + U_Q + h * 64 + 16 * d0 + 8 * hi);
          qf[d0] = pack8f((f32x4){bflo(w.x) * sc, bfhi(w.x) * sc, bflo(w.y) * sc, bfhi(w.y) * sc}, (f32x4){bflo(w.z) * sc, bfhi(w.z) * sc, bflo(w.w) * sc, bfhi(w.w) * sc}); } }
    const float fq = F[q];
    float m = ATT_NEG, lsum = 0.f; f32x16 O[2] = {};
    const int NT = (q0 + 256) / 64;
    LAS float* qmx = (LAS float*)(lds + ATT_SC); LAS float* mmv = qmx + 8;
    { float q2 = 0.f;
#pragma unroll
      for (int d0 = 0; d0 < 4; ++d0) { const u32x4 w = __builtin_bit_cast(u32x4, qf[d0]); q2 += bflo(w.x) * bflo(w.x) + bfhi(w.x) * bfhi(w.x) + bflo(w.y) * bflo(w.y) + bfhi(w.y) * bfhi(w.y) + bflo(w.z) * bflo(w.z) + bfhi(w.z) * bfhi(w.z) + bflo(w.w) * bflo(w.w) + bfhi(w.w) * bfhi(w.w); }
      q2 = wave_max(xhalf_sum(q2)); if (lane == 0) { qmx[wave] = q2; mmv[wave] = ATT_NEG; } }
    const float kmax2 = __uint_as_float(((const unsigned*)(p->ws + WS_CTL))[CW_KMAX + l * 8 + h]), fq0 = F[q0];
    const int srow = tid >> 3, sch = tid & 7;
    const bf16_t* kg = U + (size_t)srow * NU + U_K + h * 64 + 8 * sch; const bf16_t* vg = Vt + (size_t)srow * TP + 8 * sch;
    LAS unsigned char* kdst = lds + ATT_KB + (srow * AKS + 8 * sch) * 2; LAS unsigned char* vdst = lds + ATT_VB + (srow * AKS + 8 * sch) * 2;
    u32x4 kr = *(const u32x4*)(kg + (size_t)(NT - 1) * 64 * NU), vr = *(const u32x4*)(vg + (NT - 1) * 64); float fr = tid < 64 ? F[(NT - 1) * 64 + tid] : 0.f;
    *(LAS u32x4*)kdst = kr; *(LAS u32x4*)vdst = vr; if (tid < 64) ((LAS float*)(lds + ATT_FB))[tid] = fr;
    __syncthreads();
    const int ka = krow(li);
    float qkb; { float q2 = qmx[0];
#pragma unroll
      for (int w = 1; w < 8; ++w) q2 = fmaxf(q2, qmx[w]);
      qkb = 1.02f * sqrtf(q2 * kmax2) + fq0; }
    for (int t = NT - 1, buf = 0; t >= 0; --t, buf ^= 1) {
        { float mmin = mmv[0];
#pragma unroll
          for (int w = 1; w < 8; ++w) mmin = fminf(mmin, mmv[w]);
          if (qkb - ((const LAS float*)(lds + ATT_FB))[buf * 64 + 63] < mmin - 40.f) break; }
        if (t > 0) { kr = *(const u32x4*)(kg + (size_t)(t - 1) * 64 * NU); vr = *(const u32x4*)(vg + (t - 1) * 64); if (tid < 64) fr = F[(t - 1) * 64 + tid]; }
        if (64 * t <= q0 + wave * 32 + 31) {
            const LAS bf16_t* Kb = (const LAS bf16_t*)(lds + ATT_KB) + buf * 64 * AKS; const LAS bf16_t* Vb = (const LAS bf16_t*)(lds + ATT_VB) + buf * 64 * AKS; const LAS float* Fb = (const LAS float*)(lds + ATT_FB) + buf * 64;
            f32x16 p0, p1;
#pragma unroll
            for (int g2 = 0; g2 < 2; ++g2) { const f32x4 a = *(const LAS f32x4*)(Fb + 8 * hi + 16 * g2), b = *(const LAS f32x4*)(Fb + 8 * hi + 16 * g2 + 4), c = *(const LAS f32x4*)(Fb + 32 + 8 * hi + 16 * g2), d = *(const LAS f32x4*)(Fb + 32 + 8 * hi + 16 * g2 + 4);
#pragma unroll
                for (int e = 0; e < 4; ++e) { p0[8 * g2 + e] = fq - a[e]; p0[8 * g2 + 4 + e] = fq - b[e]; p1[8 * g2 + e] = fq - c[e]; p1[8 * g2 + 4 + e] = fq - d[e]; } }
#pragma unroll
            for (int d0 = 0; d0 < 4; ++d0) { const bf16x8 a0 = *(const LAS bf16x8*)(Kb + ka * AKS + 16 * d0 + 8 * hi), a1 = *(const LAS bf16x8*)(Kb + (ka + 32) * AKS + 16 * d0 + 8 * hi);
                p0 = __builtin_amdgcn_mfma_f32_32x32x16_bf16(a0, qf[d0], p0, 0, 0, 0); p1 = __builtin_amdgcn_mfma_f32_32x32x16_bf16(a1, qf[d0], p1, 0, 0, 0); }
            if (64 * t + 63 > q0 + wave * 32) {
#pragma unroll
                for (int r = 0; r < 16; ++r) { const int kv = 64 * t + 8 * hi + 16 * (r >> 3) + (r & 7); if (kv > q) p0[r] = -INFINITY; if (kv + 32 > q) p1[r] = -INFINITY; } }
            bf16x8 pb[4];
            softmax_tile<false>(p0, p1, m, lsum, O, pb);
#pragma unroll
            for (int dt = 0; dt < 2; ++dt)
#pragma unroll
                for (int s = 0; s < 4; ++s) { const bf16x8 a = *(const LAS bf16x8*)(Vb + (32 * dt + li) * AKS + 16 * (s & 1) + 32 * (s >> 1) + 8 * hi);
                    O[dt] = __builtin_amdgcn_mfma_f32_32x32x16_bf16(a, pb[s], O[dt], 0, 0, 0); }
        }
        { const float wm = wave_min(m); if (lane == 0) mmv[wave] = wm; }
        if (t > 0) { const int nb = buf ^ 1; *(LAS u32x4*)(kdst + nb * 64 * AKS * 2) = kr; *(LAS u32x4*)(vdst + nb * 64 * AKS * 2) = vr; if (tid < 64) ((LAS float*)(lds + ATT_FB))[nb * 64 + tid] = fr; }
        __syncthreads();
    }
    __syncthreads();
    const float inv = 1.f / xhalf_sum(lsum);
    bf16_t* ob = (bf16_t*)(p->ws + WS_OCAT) + (size_t)1 * NTOK * 512 + (size_t)q * 512 + h * 64;
    u32x2 sgv[2][4];
#pragma unroll
    for (int dt = 0; dt < 2; ++dt)
#pragma unroll
        for (int rg = 0; rg < 4; ++rg) sgv[dt][rg] = *(const u32x2*)(U + (size_t)q * NU + U_BSG + h * 64 + 32 * dt + 8 * rg + 4 * hi);
#pragma unroll
    for (int dt = 0; dt < 2; ++dt)
#pragma unroll
        for (int rg = 0; rg < 4; ++rg) { const int d = 32 * dt + 8 * rg + 4 * hi; const u32x2 sg = sgv[dt][rg];
            u32x2 w; w.x = cvt_pk_bf16(O[dt][rg * 4] * inv * siluf_(bflo(sg.x)), O[dt][rg * 4 + 1] * inv * siluf_(bfhi(sg.x))); w.y = cvt_pk_bf16(O[dt][rg * 4 + 2] * inv * siluf_(bflo(sg.y)), O[dt][rg * 4 + 3] * inv * siluf_(bfhi(sg.y)));
            *(u32x2*)(ob + d) = w; }
}
__device__ __forceinline__ void attn_sample_unit(KP p, int l, int b, int h, LAS unsigned char* lds, int tid) {
    const bf16_t* U = (const bf16_t*)(p->ws + WS_U);
    const int wave = tid >> 6, lane = tid & 63, li = lane & 31, hi = lane >> 5;
    const size_t qrow = (size_t)TP + b * 32 + li;
    const float* G = (const float*)(p->ws + WS_GS) + ((size_t)b * 8 + h) * GS_LEN;
    bf16x8 qf[4];
    { const float sc = 0.125f * LOG2E;
#pragma unroll
      for (int d0 = 0; d0 < 4; ++d0) { const u32x4 w = *(const u32x4*)(U + qrow * NU + U_Q + h * 64 + 16 * d0 + 8 * hi);
          qf[d0] = pack8f((f32x4){bflo(w.x) * sc, bfhi(w.x) * sc, bflo(w.y) * sc, bfhi(w.y) * sc}, (f32x4){bflo(w.z) * sc, bfhi(w.z) * sc, bflo(w.w) * sc, bfhi(w.w) * sc}); } }
    const float fq = G[PAST + li];
    float m = ATT_NEG, lsum = 0.f; f32x16 O[2] = {};
    const float* CK = p->in[I_CK] + (((size_t)l * 32 + b) * PAST) * 512 + h * 64; const float* CV = p->in[I_CV] + (((size_t)l * 32 + b) * PAST) * 512 + h * 64;
    const int ka = krow(li);
    float kmax2;
    { float mx = 0.f; const f32x4* kp4 = (const f32x4*)CK + (tid & 15);
#pragma unroll 1
      for (int it = 0; it < 8; ++it) { f32x4 kv[16];
#pragma unroll
          for (int j = 0; j < 16; ++j) kv[j] = kp4[(size_t)((it * 16 + j) * 32 + (tid >> 4)) * 128];
#pragma unroll
          for (int j = 0; j < 16; ++j) { float s = kv[j][0] * kv[j][0] + kv[j][1] * kv[j][1] + kv[j][2] * kv[j][2] + kv[j][3] * kv[j][3];
              s += dpp_mov<0xB1>(s); s += dpp_mov<0x4E>(s); s += dpp_mov<0x141>(s); s += dpp_mov<0x140>(s); mx = fmaxf(mx, s); } }
      mx = wave_max(mx); LAS float* kml = (LAS float*)lds;
      if (lane == 0) kml[wave] = mx;
      __syncthreads();
      kmax2 = kml[0];
#pragma unroll
      for (int w = 1; w < 8; ++w) kmax2 = fmaxf(kmax2, kml[w]);
      __syncthreads(); }
    float qkb;
    { float q2 = 0.f;
#pragma unroll
      for (int d0 = 0; d0 < 4; ++d0) { const u32x4 w = __builtin_bit_cast(u32x4, qf[d0]); q2 += bflo(w.x) * bflo(w.x) + bfhi(w.x) * bfhi(w.x) + bflo(w.y) * bflo(w.y) + bfhi(w.y) * bfhi(w.y) + bflo(w.z) * bflo(w.z) + bfhi(w.z) * bfhi(w.z) + bflo(w.w) * bflo(w.w) + bfhi(w.w) * bfhi(w.w); }
      q2 = wave_max(xhalf_sum(q2)); qkb = 1.02f * sqrtf(q2 * kmax2) + G[PAST]; }
    {
        f32x16 p0, p1 = {};
#pragma unroll
        for (int g2 = 0; g2 < 2; ++g2) { const float* gp = G + PAST + 8 * hi + 16 * g2; const f32x4 a = *(const f32x4*)gp, bq = *(const f32x4*)(gp + 4);
#pragma unroll
            for (int e = 0; e < 4; ++e) { p0[8 * g2 + e] = fq - a[e]; p0[8 * g2 + 4 + e] = fq - bq[e]; } }
#pragma unroll
        for (int d0 = 0; d0 < 4; ++d0) { const bf16x8 a0 = *(const bf16x8*)(U + ((size_t)TP + b * 32 + ka) * NU + U_K + h * 64 + 16 * d0 + 8 * hi);
            p0 = __builtin_amdgcn_mfma_f32_32x32x16_bf16(a0, qf[d0], p0, 0, 0, 0); }
#pragma unroll
        for (int r = 0; r < 16; ++r) { const int kv = 8 * hi + 16 * (r >> 3) + (r & 7); if (kv > li) p0[r] = -INFINITY; }
        bf16x8 pb[4];
        softmax_tile<true>(p0, p1, m, lsum, O, pb);
        if (wave == 7) {
#pragma unroll
            for (int dt = 0; dt < 2; ++dt)
#pragma unroll
                for (int s = 0; s < 2; ++s) { const bf16_t* vp = U + ((size_t)TP + b * 32 + 16 * s + 8 * hi) * NU + U_V + h * 64 + 32 * dt + li; u32x4 w;
                    w.x = (unsigned)vp[0] | ((unsigned)vp[NU] << 16); w.y = (unsigned)vp[2 * NU] | ((unsigned)vp[3 * NU] << 16); w.z = (unsigned)vp[4 * NU] | ((unsigned)vp[5 * NU] << 16); w.w = (unsigned)vp[6 * NU] | ((unsigned)vp[7 * NU] << 16);
                    O[dt] = __builtin_amdgcn_mfma_f32_32x32x16_bf16(__builtin_bit_cast(bf16x8, w), pb[s], O[dt], 0, 0, 0); } }
        else lsum = 0.f;
    }
    const float mmin = wave_min(m);
    for (int tt = 0; tt < 8; ++tt) {
        const int key0 = (63 - wave - 8 * tt) * 64;
        if (qkb - G[key0 + 63] < mmin - 40.f) break;
        f32x16 p0, p1;
#pragma unroll
        for (int g2 = 0; g2 < 2; ++g2) { const float* gp = G + key0 + 8 * hi + 16 * g2; const f32x4 a = *(const f32x4*)gp, bq = *(const f32x4*)(gp + 4), c = *(const f32x4*)(gp + 32), d = *(const f32x4*)(gp + 36);
#pragma unroll
            for (int e = 0; e < 4; ++e) { p0[8 * g2 + e] = fq - a[e]; p0[8 * g2 + 4 + e] = fq - bq[e]; p1[8 * g2 + e] = fq - c[e]; p1[8 * g2 + 4 + e] = fq - d[e]; } }
#pragma unroll
        for (int d0 = 0; d0 < 4; ++d0) { const float* k0p = CK + (size_t)(key0 + ka) * 512 + 16 * d0 + 8 * hi; const float* k1p = k0p + (size_t)32 * 512;
            const bf16x8 a0 = pack8f(*(const f32x4*)k0p, *(const f32x4*)(k0p + 4)), a1 = pack8f(*(const f32x4*)k1p, *(const f32x4*)(k1p + 4));
            p0 = __builtin_amdgcn_mfma_f32_32x32x16_bf16(a0, qf[d0], p0, 0, 0, 0); p1 = __builtin_amdgcn_mfma_f32_32x32x16_bf16(a1, qf[d0], p1, 0, 0, 0); }
        bf16x8 pb[4];
        softmax_tile<false>(p0, p1, m, lsum, O, pb);
#pragma unroll
        for (int dt = 0; dt < 2; ++dt)
#pragma unroll
            for (int s = 0; s < 4; ++s) { const float* vp = CV + (size_t)(key0 + 16 * (s & 1) + 32 * (s >> 1) + 8 * hi) * 512 + 32 * dt + li;
                const bf16x8 a = pack8f((f32x4){vp[0], vp[512], vp[1024], vp[1536]}, (f32x4){vp[2048], vp[2560], vp[3072], vp[3584]});
                O[dt] = __builtin_amdgcn_mfma_f32_32x32x16_bf16(a, pb[s], O[dt], 0, 0, 0); }
    }
    LAS float* Ow = (LAS float*)lds;
    LAS float* ML = Ow + 8 * 32 * 64;
    lsum = xhalf_sum(lsum);
#pragma unroll
    for (int dt = 0; dt < 2; ++dt)
#pragma unroll
        for (int r = 0; r < 16; ++r) Ow[(wave * 32 + dt * 16 + r) * 64 + lane] = O[dt][r];
    if (hi == 0) { ML[(wave * 2) * 32 + li] = m; ML[(wave * 2 + 1) * 32 + li] = lsum; }
    __syncthreads();
    { const int qq = tid & 31, dg = tid >> 5; float M = ATT_NEG;
#pragma unroll
      for (int w = 0; w < 8; ++w) M = fmaxf(M, ML[(w * 2) * 32 + qq]);
      float L = 0.f; f32x4 o = {0.f, 0.f, 0.f, 0.f};
      const int d = 4 * dg, idx0 = (d >> 5) * 16 + ((d >> 3) & 3) * 4, ln = ((d >> 2) & 1) * 32 + qq;
#pragma unroll
      for (int w = 0; w < 8; ++w) { const float f = __builtin_amdgcn_exp2f(ML[(w * 2) * 32 + qq] - M); L += ML[(w * 2 + 1) * 32 + qq] * f;
#pragma unroll
          for (int e = 0; e < 4; ++e) o[e] += Ow[(w * 32 + idx0 + e) * 64 + ln] * f; }
      const float inv = 1.f / L; const size_t row = (size_t)TP + b * 32 + qq;
      const u32x2 sg = *(const u32x2*)(U + row * NU + U_BSG + h * 64 + d);
      u32x2 wv; wv.x = cvt_pk_bf16(o[0] * inv * siluf_(bflo(sg.x)), o[1] * inv * siluf_(bfhi(sg.x))); wv.y = cvt_pk_bf16(o[2] * inv * siluf_(bflo(sg.y)), o[3] * inv * siluf_(bfhi(sg.y)));
      *(u32x2*)((bf16_t*)(p->ws + WS_OCAT) + (size_t)1 * NTOK * 512 + row * 512 + h * 64 + d) = wv; }
    __syncthreads();
}
__device__ __forceinline__ bool xb_lane0() { unsigned ones_ = ~0u; asm volatile("" : "+s"(ones_)); return __builtin_amdgcn_mbcnt_hi(ones_, __builtin_amdgcn_mbcnt_lo(ones_, 0u)) == 0u; }
constexpr int NPHASE = 20;
__global__ void __launch_bounds__(512, 2) hse_fwd(Params p_) {
    const KP kp = (KP)__builtin_amdgcn_kernarg_segment_ptr();
    (void)p_;
    extern __shared__ __attribute__((aligned(16))) unsigned char lds_raw[];
    LAS unsigned char* lds = (LAS unsigned char*)lds_raw;
    const int tid0 = threadIdx.x;
    const int wave0 = __builtin_amdgcn_readfirstlane(tid0 >> 6);
    const int G = gridDim.x, bid = blockIdx.x, ngw = G * 8;
#define PH_LOCALS const KP p = kp_fresh(kp); unsigned ones_ = ~0u; asm volatile("" : "+s"(ones_)); int tid = wave0 * 64 + (int)__builtin_amdgcn_mbcnt_hi(ones_, __builtin_amdgcn_mbcnt_lo(ones_, 0u)); asm volatile("" : "+v"(tid)); const int lane = tid & 63, wave = __builtin_amdgcn_readfirstlane(tid >> 6), gw = bid * 8 + wave; (void)lane; (void)gw; (void)p;
    if (tid0 < 4) ((LAS unsigned*)(lds + LDS_XB_OFF))[tid0] = 0u;
#if PROBE_ID
    if (tid0 == 0) *(LAS unsigned long long*)(lds + LDS_PROBE_OFF) = 0ull;
#endif
    __syncthreads();
    unsigned* ctl = (unsigned*)(kp->ws + WS_CTL);
    XcdBarrier bar = xcd_barrier_post(ctl + CW_BAR + kp->li * XCD_BAR_WORDS, (volatile LAS unsigned*)(lds + LDS_XB_OFF));
    const int lo = kp->ph_lo, hi = kp->ph_hi;
#define IN(k) (lo <= (k) && (k) < hi)
#ifndef DUP_MASK
#define DUP_MASK 0
#endif
#define NREP(k) (((DUP_MASK >> (k)) & 1) + 1)
#define XB_T0 (wave0 == 0 && xb_lane0())
#define SEAM(k) do { if (IN(k) && IN((k) + 1)) xcd_barrier(bar, XB_T0); } while (0)
    PT0();
    if (IN(0)) { PH_LOCALS
        { PT0(); for (int u = bid; u < 192; u += G) ada_unit(p, u, lds, tid);
        PT1(60);
        p0_weights(p, lds, gw, ngw, wave, lane);
        PT1(61); }
    }
    SEAM(0);
    PT1(9);
    for (int l = 0; l < NLAYER; ++l) {
        const int pb = 1 + 9 * l;
        for (int rep = 0; rep < NREP(0); ++rep) { if (rep) xcd_barrier(bar, XB_T0);
        if (IN(pb)) { PH_LOCALS p1_rows(p, l, gw, ngw, lane); } }
        SEAM(pb);
        PT1(10);
        for (int rep = 0; rep < NREP(1); ++rep) { if (rep) xcd_barrier(bar, XB_T0);
        if (IN(pb + 1)) { PH_LOCALS
            pg8::Gemm g{(const bf16_t*)(p->ws + WS_H), (const bf16_t*)(p->ws + WS_WIN) + (size_t)l * NU * 2048, NTOK, NU, 2048, 2048};
            pg8::StaticOrder S; S.init(NTOK, NU, G, bid);
            EpiU E{(bf16_t*)(p->ws + WS_U), p->out, p->in[I_BF], l};
            pg8::gemm_phase<EpiU, pg8::StaticOrder>(lds, g, S, E, nullptr, tid);
        }
        }
        SEAM(pb + 1);
        PT1(11);
        for (int rep = 0; rep < NREP(2); ++rep) { if (rep) xcd_barrier(bar, XB_T0);
        if (IN(pb + 2)) { PH_LOCALS
#ifndef DUP_SUB
#define DUP_SUB 0
#endif
            { PT0();
            { PH_LOCALS for (int u = bid; u < NRU * ((DUP_SUB & 1) + 1); u += G) rwkv_r1(p, l, u % NRU, u + G, lds, tid); }
            PT1(31);
            for (int u = (bid + G - 32) % G; u < 544 * (((DUP_SUB >> 1) & 1) + 1); u += G) conv_unit(p, l, u % 544, lds, tid);
            PT1(32);
            for (int u = (bid + G - 64) % G; u < 544 * (((DUP_SUB >> 2) & 1) + 1); u += G) pool_unit(p, l, u % 544, lds, tid);
            PT1(33);
            for (int u = bid; u < 256; u += G) { vt_tile(p, l, u * 8 + wave, lds, wave, lane); }
            __syncthreads();
            for (int u = (bid + G - 96) % G; u < 32; u += G) gs_unit(p, l, u, lds, tid);
            for (int u = G - 1 - bid; u < 8; u += G) fp_unit(p, l, u, lds, tid);
            if (bid == G / 2) shift_out(p, l, tid);
            PT1(34); }
        }
        }
        SEAM(pb + 2);
        PT1(12);
        for (int rep = 0; rep < NREP(3); ++rep) { if (rep) xcd_barrier(bar, XB_T0);
        if (IN(pb + 3)) { PH_LOCALS
            for (int tk = bid; tk < 256; tk += G) rwkv_l1_block(p, tk, lds, wave, lane);
            LAS int* qslot = (LAS int*)(lds + LDS_XB_OFF - 16);
            for (;;) {
                if (tid == 0) *qslot = (int)atomicAdd(ctl + CW_QUEUE + 64 * (2 * l + 4 * rep), 1u);
                __syncthreads();
                const int item = *qslot;
                __syncthreads();
                if (item >= 512) break;
                attn_prompt_unit(p, l, item & 7, 63 - (item >> 3), lds, tid);
            }
            for (;;) {
                if (tid == 0) *qslot = (int)atomicAdd(ctl + CW_QUEUE + 64 * (2 * l + 1 + 4 * rep), 1u);
                __syncthreads();
                const int item = *qslot;
                __syncthreads();
                if (item >= 256) break;
                attn_sample_unit(p, l, item >> 3, item & 7, lds, tid);
            }
        }
        }
        SEAM(pb + 3);
        PT1(13);
        if (IN(pb + 4)) { PH_LOCALS
            for (int tk = bid; tk < 128; tk += G) rwkv_l3_block(p, l, 127 - tk, lds, wave, lane);
            for (int tk = ((bid + G - 128) % G) * 8 + wave; tk < 1024; tk += ngw) rwkv_samp_task(p, l, tk, lane);
        }
        SEAM(pb + 4);
        PT1(14);
        if (IN(pb + 5)) { PH_LOCALS for (int tk = gw; tk < NRU * 2; tk += ngw) rwkv_r3_task(p, l, tk, lane); }
        SEAM(pb + 5);
        PT1(15);
        for (int rep = 0; rep < NREP(6); ++rep) { if (rep) xcd_barrier(bar, XB_T0);
        if (IN(pb + 6)) { PH_LOCALS
            pg8::Gemm g{(const bf16_t*)(p->ws + WS_OCAT), (const bf16_t*)(p->ws + WS_WBR) + (size_t)l * 4 * 2048 * 512, 4 * NTOK, 4 * 2048, 512, 512};
            BranchOrder S{G, (G % 8 == 0) ? (bid % 8) * (G / 8) + bid / 8 : bid};
            EpiZ E{(bf16_t*)(p->ws + WS_Z), (const bf16_t*)(p->ws + WS_U)};
            pg8::gemm_phase<EpiZ, BranchOrder>(lds, g, S, E, nullptr, tid);
        }
        }
        SEAM(pb + 6);
        PT1(16);
        if (IN(pb + 7)) { PH_LOCALS merge_pass(p, l, bid * 512 + tid, G * 512); }
        SEAM(pb + 7);
        PT1(17);
        if (IN(pb + 8)) { PH_LOCALS
            {
                pg8::Gemm g{(const bf16_t*)(p->ws + WS_MERGED), (const bf16_t*)(p->ws + WS_WOUT) + (size_t)l * 2048 * 2048, TP, 2048, 2048, 2048};
                pg8::StaticOrder S; S.init(TP, 2048, G, bid);
                EpiOut E{p->in[I_XP], p->in[I_XS], (const float*)(p->ws + WS_XBUF), (const float*)(p->ws + WS_ADA), (float*)(p->ws + WS_XBUF), l};
                pg8::gemm_phase<EpiOut, pg8::StaticOrder>(lds, g, S, E, nullptr, tid); }
            {
                const int tile = bid >> 3, ks = bid & 7;
                pg8::Gemm g{(const bf16_t*)(p->ws + WS_MERGED) + ks * 256, (const bf16_t*)(p->ws + WS_WOUT) + (size_t)l * 2048 * 2048 + ks * 256, NTOK, 2048, 256, 2048};
                OneUnit S{64 + (tile >> 3), tile & 7, bid < 256};
                EpiOutPart E{(const float*)(p->ws + WS_ADA), (float*)(p->ws + WS_XPART) + ((size_t)(l * 8 + ks) * 1024) * DM, l};
                pg8::gemm_phase<EpiOutPart, OneUnit>(lds, g, S, E, nullptr, tid); }
        }
        SEAM(pb + 8);
        PT1(18);
    }
    if (IN(19)) { PH_LOCALS p_final_rows(p, gw, ngw, lane); }
    PT1(20);
#if PROBE_ID
    if (bid == 0 && tid0 == 0) { const unsigned long long w = *(LAS unsigned long long*)(lds + LDS_PROBE_OFF) * PROBE_K, t0 = __builtin_amdgcn_s_memrealtime(); while (__builtin_amdgcn_s_memrealtime() - t0 < w) __builtin_amdgcn_s_sleep(8); }
#endif
#undef IN
#undef SEAM
}
#ifndef MK_SPLIT
#define MK_SPLIT 0
#endif
extern "C" void kernel_launch(void* const* d_in, const int* in_sizes, int n_in, void* d_out, int out_size, void* d_ws, size_t ws_size, hipStream_t stream) {
    static int grid = 0;
    if (grid == 0) {
        if (n_in != N_IN || (size_t)out_size != O_END || ws_size < WS_END) { fprintf(stderr, "kernel_launch: unexpected shapes (n_in %d, out %d, ws %zu)\n", n_in, out_size, ws_size); grid = -1; return; }
        int dev = 0, cus = 0, per_cu = 0;
        if (hipGetDevice(&dev) != hipSuccess || hipDeviceGetAttribute(&cus, hipDeviceAttributeMultiprocessorCount, dev) != hipSuccess) { grid = -1; return; }
        if (hipFuncSetAttribute((const void*)hse_fwd, hipFuncAttributeMaxDynamicSharedMemorySize, LDS_BYTES) != hipSuccess) { fprintf(stderr, "kernel_launch: hipFuncSetAttribute failed\n"); grid = -1; return; }
        if (hipOccupancyMaxActiveBlocksPerMultiprocessor(&per_cu, (const void*)hse_fwd, 512, LDS_BYTES) != hipSuccess || per_cu < 1) fprintf(stderr, "kernel_launch: occupancy query reports %d\n", per_cu);
        (void)hipGetLastError();
        grid = cus;
    }
    if (grid < 0) return;
    if (hipMemsetAsync((char*)d_ws + WS_CTL, 0, CTL_BYTES, stream) != hipSuccess) return;
    Params a{};
    for (int i = 0; i < N_IN; ++i) a.in[i] = (const float*)d_in[i];
    a.out = (float*)d_out; a.ws = (unsigned char*)d_ws;
#if MK_SPLIT
    for (int ph = 0; ph < NPHASE; ++ph) { a.ph_lo = ph; a.ph_hi = ph + 1; a.li = ph; hipLaunchKernelGGL(hse_fwd, dim3(grid), dim3(512), LDS_BYTES, stream, a); }
#else
    a.ph_lo = 0; a.ph_hi = NPHASE; a.li = 0;
    hipLaunchKernelGGL(hse_fwd, dim3(grid), dim3(512), LDS_BYTES, stream, a);
#endif
    const hipError_t le = hipPeekAtLastError();
    if (le != hipSuccess) fprintf(stderr, "kernel_launch: launch failed: %s\n", hipGetErrorName(le));
}
```

```cpp
#include <hip/hip_runtime.h>
#include <cstdio>
#include <cstdint>
#ifndef PROBE_ID
#define PROBE_ID 0
#endif
#ifndef PROBE_K
#define PROBE_K 1
#endif
constexpr int LDS_PROBE_OFF = 163840 - 256 - 64;
#if PROBE_ID
#define PT0() unsigned long long _pt0 = (blockIdx.x == 0 && threadIdx.x == 0) ? __builtin_amdgcn_s_memrealtime() : 0ull
#define PT1(id) do { if ((id) == PROBE_ID && blockIdx.x == 0 && threadIdx.x == 0) { *(__attribute__((address_space(3))) unsigned long long*)(lds + LDS_PROBE_OFF) += __builtin_amdgcn_s_memrealtime() - _pt0; } _pt0 = (blockIdx.x == 0 && threadIdx.x == 0) ? __builtin_amdgcn_s_memrealtime() : 0ull; } while (0)
#else
#define PT0() do {} while (0)
#define PT1(id) do {} while (0)
#endif
namespace pg8 {
#define PG8_LAS __attribute__((address_space(3)))
typedef unsigned short bf16_t;
typedef short bf16x8 __attribute__((ext_vector_type(8)));
typedef float f32x4 __attribute__((ext_vector_type(4)));
typedef unsigned u32x4 __attribute__((ext_vector_type(4)));
constexpr int BM = 256, BK = 64, HALF = 128, HTB = HALF * BK * 2  , STAGE_BYTES = 8 * HTB, NXCD = 8, WGM = 4;

__host__ __device__ __forceinline__ int lds_byte(int r, int c) { const int st = (r >> 4) * 2 + (c >> 5), rr = r & 15, cc = c & 31, ob = rr * 64 + cc * 2; return st * 1024 + (ob ^ (((ob >> 9) & 1) << 5)); }
__host__ __device__ __forceinline__ void stage_rc(int b, int& R, int& C) { const int st = b / 1024, sb = b % 1024, swz = sb ^ (((sb >> 9) & 1) << 5); R = (st >> 1) * 16 + swz / 64; C = (st & 1) * 32 + (swz % 64) / 2; }
__host__ __device__ __forceinline__ int perm32(int rho) { const int n = rho >> 4, i = rho & 15; return 8 * (i >> 2) + 4 * n + (i & 3); }

struct Unit { int pm, pn; };
struct Gemm { const bf16_t* A; const bf16_t* Bt; int M, N, K, ld; };

struct StaticOrder {
    int nM, nN, nwg, G, c;
    __host__ __device__ void init(int M, int N, int G_, int c_) { nM = M / BM; nN = N / BM; nwg = nM * nN; G = G_; c = c_; }
    __host__ __device__ bool next(int i, Unit& u) const {
        const long L = (long)i * G + c; if (L >= nwg) return false;
        int wgid = (int)L; { const int q = nwg / NXCD, r = nwg % NXCD, xcd = wgid % NXCD, off = wgid / NXCD; wgid = (xcd < r ? xcd * (q + 1) : r * (q + 1) + (xcd - r) * q) + off; }
        const int nig = WGM * nN, gid = wgid / nig, fm = gid * WGM, gsz = (nM - fm) < WGM ? (nM - fm) : WGM;
        u.pm = fm + ((wgid % nig) % gsz); u.pn = (wgid % nig) / gsz; return true;
    }
    __device__ __forceinline__ void a_ready(const Unit&) const {}
    __device__ __forceinline__ void done(const Unit&) const {}
};
__device__ __forceinline__ unsigned cvt_pk_bf16(float lo, float hi) { unsigned r; asm volatile("v_cvt_pk_bf16_f32 %0, %1, %2" : "=v"(r) : "v"(lo), "v"(hi)); return r; }
typedef float f32x2 __attribute__((ext_vector_type(2)));
template <class Epi, class Sched, bool STAMP = false>
__device__ __forceinline__ void gemm_phase(PG8_LAS unsigned char* lds, const Gemm g, const Sched& S, const Epi& E, unsigned long long* stamps, int tid_in) {
    int tid = tid_in; asm volatile("" : "+v"(tid));
    const int wid = __builtin_amdgcn_readfirstlane(tid >> 6), lane = tid & 63, wr = wid >> 2, wc = wid & 3, fr = lane & 15, fq = lane >> 4;
    const int K = g.ld, nt = g.K / BK;
    int ts_lo = 0, ts_hi = 0, nts = 0; const unsigned long long rt_entry = STAMP ? (unsigned long long)wall_clock64() : 0ull;
#define PG8_STAMP() do { if (STAMP && wid == 0 && nts < 64) { const unsigned long long _c = (unsigned long long)clock64(); \
        ts_lo = (lane == nts) ? (int)(unsigned)_c : ts_lo; ts_hi = (lane == nts) ? (int)(unsigned)(_c >> 32) : ts_hi; ++nts; } } while (0)
    PG8_STAMP();
    unsigned voffA[2], voffB[2];
#pragma unroll
    for (int i = 0; i < 2; ++i) { int R, C; stage_rc(tid * 16 + i * 8192, R, C); const int Rb = Epi::PERM ? ((R & ~31) + perm32(R & 31)) : R;
        voffA[i] = (unsigned)(R * K + C) * 2u; voffB[i] = (unsigned)(Rb * K + C) * 2u; }
    const size_t kstep = (size_t)(BK * 2);
    const size_t hstep = (size_t)HALF * K * 2;
    const size_t tstep = 2 * hstep;
    const unsigned ldsw = (unsigned)wid * 1024u;
    const int aoff = lds_byte(wr * 64 + fr, fq * 8), boff = lds_byte(wc * 32 + fr, fq * 8);
#define PG8_SA(b, h) (((b) * 2 + (h)) * HTB)
#define PG8_SB(b, h) ((4 + (b) * 2 + (h)) * HTB)
#define PG8_STAGE(bufoff, gbase, voff) do { _Pragma("unroll") for (int _i = 0; _i < 2; ++_i) \
        __builtin_amdgcn_global_load_lds((const unsigned*)((const char*)(gbase) + (voff)[_i]), (PG8_LAS unsigned*)(lds + (bufoff) + ldsw + _i * 8192), 16, 0, 0); } while (0)
#define PG8_LDA(dst, b, h) do { _Pragma("unroll") for (int m = 0; m < 4; ++m) _Pragma("unroll") for (int k = 0; k < 2; ++k) dst[m][k] = *(const PG8_LAS bf16x8*)(lds + PG8_SA(b, h) + aoff + m * 2048 + k * 1024); } while (0)
#define PG8_LDB(dst, b, h) do { _Pragma("unroll") for (int n = 0; n < 2; ++n) _Pragma("unroll") for (int k = 0; k < 2; ++k) dst[n][k] = *(const PG8_LAS bf16x8*)(lds + PG8_SB(b, h) + boff + n * 2048 + k * 1024); } while (0)
#define PG8_MMA(ai, bj, At, Bt) do { __builtin_amdgcn_s_setprio(1); _Pragma("unroll") for (int m = 0; m < 4; ++m) _Pragma("unroll") for (int n = 0; n < 2; ++n) _Pragma("unroll") for (int k = 0; k < 2; ++k) \
        acc[ai][bj][m][n] = __builtin_amdgcn_mfma_f32_16x16x32_bf16(Bt[n][k], At[m][k], acc[ai][bj][m][n], 0, 0, 0); __builtin_amdgcn_s_setprio(0); } while (0)
#define PG8_WAIT_V(n) asm volatile("s_waitcnt vmcnt(" #n ")" ::: "memory")
#define PG8_WAIT_L(n) asm volatile("s_waitcnt lgkmcnt(" #n ")" ::: "memory")
#define PG8_BAR __builtin_amdgcn_s_barrier()
#define PG8_SCHED __builtin_amdgcn_sched_barrier(0)
    Unit cur, nxt; int ui = 0;
    if (!S.next(0, cur)) return;
    f32x4 acc[2][2][4][2];
#pragma unroll
    for (int a = 0; a < 2; ++a)
#pragma unroll
        for (int b = 0; b < 2; ++b)
#pragma unroll
            for (int m = 0; m < 4; ++m)
#pragma unroll
                for (int n = 0; n < 2; ++n) acc[a][b][m][n] = (f32x4){0.f, 0.f, 0.f, 0.f};
    bf16x8 At[4][2], B0[2][2], B1[2][2];
    const char* cA = (const char*)g.A + (size_t)cur.pm * tstep; const char* cB = (const char*)g.Bt + (size_t)cur.pn * tstep;
    S.a_ready(cur);
    PG8_STAGE(PG8_SB(0, 0), cB, voffB); PG8_STAGE(PG8_SA(0, 0), cA, voffA); PG8_STAGE(PG8_SB(0, 1), cB + hstep, voffB); PG8_STAGE(PG8_SA(0, 1), cA + hstep, voffA);
    if (wr == 1) PG8_BAR;
    PG8_WAIT_V(4); PG8_BAR;
    PG8_STAGE(PG8_SB(1, 0), cB + kstep, voffB); PG8_STAGE(PG8_SA(1, 0), cA + kstep, voffA); PG8_STAGE(PG8_SB(1, 1), cB + hstep + kstep, voffB);
    PG8_WAIT_V(6); PG8_BAR;
    PG8_STAMP();
    for (;;) {
        const bool has_next = S.next(ui + 1, nxt);
        const char* nA = has_next ? (const char*)g.A + (size_t)nxt.pm * tstep : cA; const char* nB = has_next ? (const char*)g.Bt + (size_t)nxt.pn * tstep : cB;
        for (int t = 0; t < nt; t += 2) {
            const bool last = (t == nt - 2);
            const char* a1 = cA + (size_t)(t + 1) * kstep;
            const char* a2 = last ? nA : cA + (size_t)(t + 2) * kstep; const char* b2 = last ? nB : cB + (size_t)(t + 2) * kstep;
            const char* a3 = a2 + kstep; const char* b3 = b2 + kstep;
            if (last && has_next) S.a_ready(nxt);
            PG8_LDB(B0, 0, 0); PG8_SCHED; PG8_LDA(At, 0, 0); PG8_STAGE(PG8_SA(1, 1), a1 + hstep, voffA);
            PG8_WAIT_L(8); PG8_BAR; PG8_WAIT_L(0); PG8_MMA(0, 0, At, B0); PG8_BAR; PG8_SCHED;
            PG8_LDB(B1, 0, 1); PG8_STAGE(PG8_SB(0, 0), b2, voffB);
            PG8_BAR; PG8_WAIT_L(0); PG8_MMA(0, 1, At, B1); PG8_BAR;
            PG8_LDA(At, 0, 1); PG8_STAGE(PG8_SA(0, 0), a2, voffA);
            PG8_BAR; PG8_WAIT_L(0); PG8_MMA(1, 0, At, B0); PG8_BAR; PG8_SCHED;
            PG8_STAGE(PG8_SB(0, 1), b2 + hstep, voffB);
            PG8_WAIT_V(6); PG8_BAR; PG8_MMA(1, 1, At, B1); PG8_BAR;
            PG8_LDB(B0, 1, 0); PG8_SCHED; PG8_LDA(At, 1, 0); PG8_STAGE(PG8_SA(0, 1), a2 + hstep, voffA);
            PG8_WAIT_L(8); PG8_BAR; PG8_WAIT_L(0); PG8_MMA(0, 0, At, B0); PG8_BAR; PG8_SCHED;
            PG8_LDB(B1, 1, 1); PG8_STAGE(PG8_SB(1, 0), b3, voffB);
            PG8_BAR; PG8_WAIT_L(0); PG8_MMA(0, 1, At, B1); PG8_BAR;
            PG8_LDA(At, 1, 1); PG8_STAGE(PG8_SA(1, 0), a3, voffA);
            PG8_BAR; PG8_WAIT_L(0); PG8_MMA(1, 0, At, B0); PG8_BAR; PG8_SCHED;
            PG8_STAGE(PG8_SB(1, 1), b3 + hstep, voffB);
            PG8_WAIT_V(6); PG8_BAR; PG8_MMA(1, 1, At, B1); PG8_BAR;
        }
        PG8_STAMP();
        { PT0(); if constexpr (!Epi::AFTER_DRAIN) { E(acc, cur, wr, wc, fr, fq); S.done(cur); } PT1(Epi::PROBE); }
        PG8_STAMP();
        if (!has_next) break;
#pragma unroll
        for (int a = 0; a < 2; ++a)
#pragma unroll
            for (int b = 0; b < 2; ++b)
#pragma unroll
                for (int m = 0; m < 4; ++m)
#pragma unroll
                    for (int n = 0; n < 2; ++n) acc[a][b][m][n] = (f32x4){0.f, 0.f, 0.f, 0.f};
        cur = nxt; cA = nA; cB = nB; ++ui;
    }
    PG8_WAIT_V(0);
    if (wr == 0) PG8_BAR;
    PG8_BAR;
    if constexpr (Epi::AFTER_DRAIN) { E.fused(acc, cur, wr, wc, fr, fq, lds, wid, lane); S.done(cur); }
    PG8_STAMP();
    if (STAMP && wid == 0) { stamps[lane] = lane < nts ? (((unsigned long long)(unsigned)ts_hi << 32) | (unsigned)ts_lo) : 0ull;
        if (lane == 62) stamps[62] = rt_entry; if (lane == 63) stamps[63] = (unsigned long long)wall_clock64(); }
#undef PG8_STAMP
#undef PG8_SA
#undef PG8_SB
#undef PG8_STAGE
#undef PG8_LDA
#undef PG8_LDB
#undef PG8_MMA
#undef PG8_WAIT_V
#undef PG8_WAIT_L
#undef PG8_BAR
#undef PG8_SCHED
}
}
#define XB_TMO      128
#define XB_XCNT(j)  (256  + 64 * (j))
#define XB_XSUB(j)  (1280 + 64 * (j))
#define XB_XGEN(j)  (2304 + 64 * (j))
#define XB_TOP      3328
#define XB_TOPGEN   3392
#define XCD_BAR_WORDS 3456
#define XB_SPIN_CAP (1u << 18)
#define LAS __attribute__((address_space(3)))

__device__ __forceinline__ unsigned xb_ld(unsigned* p)              { return __hip_atomic_load(p, __ATOMIC_RELAXED, __HIP_MEMORY_SCOPE_AGENT); }
__device__ __forceinline__ unsigned xb_add(unsigned* p, unsigned v) { return __hip_atomic_fetch_add(p, v, __ATOMIC_RELAXED, __HIP_MEMORY_SCOPE_AGENT); }
__device__ __forceinline__ unsigned xb_xcc_id() { return (unsigned)__builtin_amdgcn_s_getreg((3 << 11) | 20) & 0xFu; }
#define XB_SPIN(cond, bar) do { unsigned _sp = 0; while (cond) { __builtin_amdgcn_s_sleep(1); \
    if ((++_sp & 255u) == 0u) { if (xb_ld(&(bar)[XB_TMO])) break; if (_sp > XB_SPIN_CAP) { atomicAdd(&(bar)[XB_TMO], 1u); break; } } } } while (0)

struct XcdBarrier {
    unsigned* bar; unsigned x;
    volatile LAS unsigned* st;
};

__device__ __forceinline__ XcdBarrier xcd_barrier_post(unsigned* bar, volatile LAS unsigned* st) {
    XcdBarrier b; b.bar = bar; b.x = xb_xcc_id(); b.st = st;
    if (threadIdx.x == 0) (void)xb_add(&bar[XB_XCNT(b.x)], 1u);
    return b;
}
__device__ __forceinline__ void xcd_barrier_complete(unsigned* bar, unsigned x, unsigned& nloc, unsigned& nx) {
    const unsigned G = gridDim.x * gridDim.y * gridDim.z;
    unsigned sum, cnt, mine, sp = 0u;
    for (;;) {
        sum = 0u; cnt = 0u; mine = 0u;
#pragma unroll
        for (unsigned j = 0; j < 16; ++j) { const unsigned c = xb_ld(&bar[XB_XCNT(j)]); sum += c; cnt += (c > 0u) ? 1u : 0u; mine = (j == x) ? c : mine; }
        if (sum == G) break;
        __builtin_amdgcn_s_sleep(1);
        if ((++sp & 255u) == 0u) { if (xb_ld(&bar[XB_TMO])) break; if (sp > XB_SPIN_CAP) { atomicAdd(&bar[XB_TMO], 1u); break; } }
    }
    nloc = mine > 0u ? mine : 1u; nx = cnt > 0u ? cnt : 1u;
}

__device__ __forceinline__ void xcd_barrier(const XcdBarrier& b, const bool is_t0) {
    asm volatile("s_waitcnt vmcnt(0)" ::: "memory");
    __syncthreads();
    if (is_t0) {
        unsigned* bar = b.bar;
        __builtin_amdgcn_s_waitcnt(0);
        unsigned nloc = b.st[0], nx = b.st[1];
        if (nloc == 0u) { xcd_barrier_complete(bar, b.x, nloc, nx); b.st[0] = nloc; b.st[1] = nx; }
        const unsigned old = xb_add(&bar[XB_XSUB(b.x)], 1u);
        const unsigned gen = old / nloc;
        if (old + 1u == (gen + 1u) * nloc) {
            __builtin_amdgcn_fence(__ATOMIC_RELEASE, "agent");
            asm volatile("s_waitcnt vmcnt(0)" ::: "memory");
            const unsigned og = xb_add(&bar[XB_TOP], 1u);
            const unsigned tg = og / nx;
            if (og + 1u == (tg + 1u) * nx) xb_add(&bar[XB_TOPGEN], 1u);
            else XB_SPIN(xb_ld(&bar[XB_TOPGEN]) == tg, bar);
            __builtin_amdgcn_fence(__ATOMIC_ACQUIRE, "agent");
            xb_add(&bar[XB_XGEN(b.x)], 1u);
            asm volatile("s_waitcnt vmcnt(0)" ::: "memory");
        } else {
            XB_SPIN(xb_ld(&bar[XB_XGEN(b.x)]) == gen, bar);
            __builtin_amdgcn_fence(__ATOMIC_ACQUIRE, "agent");
            asm volatile("s_waitcnt vmcnt(0)" ::: "memory");
        }
    }
    __syncthreads();
}
typedef unsigned short bf16_t;
typedef short bf16x8 __attribute__((ext_vector_type(8)));
typedef float f32x4 __attribute__((ext_vector_type(4)));
typedef float f32x16 __attribute__((ext_vector_type(16)));
typedef unsigned u32x4 __attribute__((ext_vector_type(4)));
typedef unsigned u32x2 __attribute__((ext_vector_type(2)));
using pg8::cvt_pk_bf16;

constexpr int DM = 2048, TP = 16384, NSB = 32, TSQ = 32, NTOK = TP + NSB * TSQ, NSEQ = 33, PAST = 4096, NLAYER = 2;
constexpr int LDH = 2048;
constexpr int NU = 15104;
constexpr int U_AVAL = 0, U_AGATE = 512, U_ASG = 1024, U_Q = 1536, U_K = 2048, U_V = 2560, U_BSG = 3072, U_XC = 3584, U_CSG = 5248, U_DIN = 5760, U_DSG = 6272, U_G = 6784, U_F = 14976;
constexpr int IN_W = 14984, SHIFT_W = 1664;
constexpr float LOG2E = 1.4426950408889634f;
enum { I_XP = 0, I_XS, I_CK, I_CV, I_CLF, I_SCONV, I_SSHIFT, I_SWKV, I_SPOOL, I_CP, I_CS, I_NORMG, I_WADA, I_BADA, I_WIN, I_BF, I_CONVW, I_CONVB, I_CLNG, I_CLNB, I_MU, I_W0, I_W2, I_A0, I_A2,
       I_KK, I_KA, I_RK, I_GNG, I_GNB, I_POOLW, I_POOLB, I_POOLS, I_WBR, I_WOUT, I_FING, N_IN };
constexpr size_t O_YP = 0, O_YS = O_YP + (size_t)TP * DM, O_PK = O_YS + (size_t)1024 * DM, O_PV = O_PK + (size_t)2 * TP * 512, O_PLF = O_PV + (size_t)2 * TP * 512, O_PCONV = O_PLF + (size_t)2 * TP * 8,
                 O_PSHIFT = O_PCONV + 2 * 30 * 512, O_PWKV = O_PSHIFT + 2 * 1664, O_PPOOL = O_PWKV + 2 * 8 * 64 * 64, O_SK = O_PPOOL + 2 * 15 * 512, O_SV = O_SK + (size_t)2 * 1024 * 512,
                 O_SLF = O_SV + (size_t)2 * 1024 * 512, O_SCONV = O_SLF + 2 * 1024 * 8, O_SSHIFT = O_SCONV + (size_t)2 * 32 * 30 * 512, O_SWKV = O_SSHIFT + 2 * 32 * 1664,
                 O_SPOOL = O_SWKV + (size_t)2 * 32 * 8 * 64 * 64, O_END = O_SPOOL + (size_t)2 * 32 * 15 * 512;
static_assert(O_END == 75374848, "output size");
constexpr size_t al256(size_t x) { return (x + 255) & ~(size_t)255; }
constexpr int NCU_CH = 288, NRU = NCU_CH * 8;
constexpr size_t WS_CTL = 0, CTL_BYTES = 512 * 1024;
constexpr size_t WS_WIN = CTL_BYTES;
constexpr size_t WS_WBR = al256(WS_WIN + (size_t)2 * NU * LDH * 2);
constexpr size_t WS_WOUT = al256(WS_WBR + (size_t)2 * 4 * 2048 * 512 * 2);
constexpr size_t WS_POOLW = al256(WS_WOUT + (size_t)2 * 2048 * LDH * 2);
constexpr size_t WS_ADA = al256(WS_POOLW + (size_t)2 * 4 * 128 * 128 * 2);
constexpr size_t WS_H = al256(WS_ADA + (size_t)2 * 33 * 6144 * 4);
constexpr size_t WS_U = al256(WS_H + (size_t)NTOK * LDH * 2);
constexpr size_t WS_XBUF = al256(WS_U + (size_t)NTOK * NU * 2);
constexpr size_t WS_OCAT = al256(WS_XBUF + (size_t)NTOK * 2048 * 4);
constexpr size_t WS_Z = al256(WS_OCAT + (size_t)4 * NTOK * 512 * 2);
constexpr size_t WS_MERGED = al256(WS_Z + (size_t)4 * NTOK * 2048 * 2);
constexpr size_t WS_FP = al256(WS_MERGED + (size_t)NTOK * LDH * 2);
constexpr int GS_LEN = PAST + TSQ;
constexpr size_t WS_GS = al256(WS_FP + (size_t)8 * TP * 4);
constexpr size_t WS_VT = al256(WS_GS + (size_t)32 * 8 * GS_LEN * 4);
constexpr size_t WS_TQ = al256(WS_VT + (size_t)8 * 64 * TP * 2);
constexpr size_t WS_GM = al256(WS_TQ + (size_t)NRU * 4096 * 4);
constexpr size_t WS_ET = al256(WS_GM + (size_t)NRU * 4096 * 4);
constexpr size_t WS_Y0T = al256(WS_ET + (size_t)NRU * 4096 * 4);
constexpr size_t WS_SC = al256(WS_Y0T + (size_t)NRU * 4096 * 4);
constexpr size_t WS_BONUS = al256(WS_SC + (size_t)NRU * 4096 * 4);
constexpr size_t WS_GG = al256(WS_BONUS + (size_t)NRU * 64 * 4);
constexpr size_t WS_TG = al256(WS_GG + (size_t)16 * 8 * 4096 * 4);
constexpr size_t WS_SG = al256(WS_TG + (size_t)16 * 8 * 4096 * 4);
constexpr size_t WS_XPART = al256(WS_SG + (size_t)16 * 8 * 4096 * 4);
constexpr size_t WS_END = al256(WS_XPART + (size_t)2 * 8 * 1024 * 2048 * 4);
static_assert(WS_END < (size_t)2100 * 1024 * 1024, "workspace map exceeds the guaranteed d_ws size");
constexpr int CW_BAR = 0;
constexpr int CW_QUEUE = 16 * 3456 + 64;
constexpr int CW_KMAX = CW_QUEUE + 64 * 16;
static_assert((CW_KMAX + 64) * 4 <= (int)CTL_BYTES, "ctl");
constexpr int LDS_BYTES = 163840 - 256;
constexpr int LDS_XB_OFF = LDS_BYTES - 16;
constexpr int SLOT_F = 64 * 65;

struct Params { const float* in[N_IN]; float* out; unsigned char* ws; int ph_lo, ph_hi, li, pad; };
typedef const __attribute__((address_space(4))) Params* KP;
__device__ __forceinline__ KP kp_fresh(KP k) { asm volatile("" : "+s"(k)); return k; }

__device__ __forceinline__ float bf2f(unsigned short b) { return __uint_as_float(((unsigned)b) << 16); }
__device__ __forceinline__ float bflo(unsigned w) { return __uint_as_float(w << 16); }
__device__ __forceinline__ float bfhi(unsigned w) { return __uint_as_float(w & 0xffff0000u); }
__device__ __forceinline__ unsigned short f2bf(float f) { return (unsigned short)(cvt_pk_bf16(f, 0.f) & 0xffffu); }
__device__ __forceinline__ float sigmoidf_(float x) { return 1.f / (1.f + __expf(-x)); }
__device__ __forceinline__ float siluf_(float x) { return x / (1.f + __expf(-x)); }
__device__ __forceinline__ float log_sigmoidf_(float z) { return fminf(z, 0.f) - log1pf(expf(-fabsf(z))); }
template <int CTRL> __device__ __forceinline__ float dpp_mov(float v) { return __int_as_float(__builtin_amdgcn_update_dpp(0, __float_as_int(v), CTRL, 0xF, 0xF, true)); }
__device__ __forceinline__ float wave_sum(float v) {
    v += dpp_mov<0xB1>(v); v += dpp_mov<0x4E>(v); v += dpp_mov<0x141>(v); v += dpp_mov<0x140>(v);
    const float r0 = __int_as_float(__builtin_amdgcn_readlane(__float_as_int(v), 0)), r1 = __int_as_float(__builtin_amdgcn_readlane(__float_as_int(v), 16));
    const float r2 = __int_as_float(__builtin_amdgcn_readlane(__float_as_int(v), 32)), r3 = __int_as_float(__builtin_amdgcn_readlane(__float_as_int(v), 48));
    return (r0 + r1) + (r2 + r3);
}
__device__ __forceinline__ float wave_max(float v) {
    v = fmaxf(v, dpp_mov<0xB1>(v)); v = fmaxf(v, dpp_mov<0x4E>(v)); v = fmaxf(v, dpp_mov<0x141>(v)); v = fmaxf(v, dpp_mov<0x140>(v));
    const float r0 = __int_as_float(__builtin_amdgcn_readlane(__float_as_int(v), 0)), r1 = __int_as_float(__builtin_amdgcn_readlane(__float_as_int(v), 16));
    const float r2 = __int_as_float(__builtin_amdgcn_readlane(__float_as_int(v), 32)), r3 = __int_as_float(__builtin_amdgcn_readlane(__float_as_int(v), 48));
    return fmaxf(fmaxf(r0, r1), fmaxf(r2, r3));
}
__device__ __forceinline__ float wave_min(float v) { return -wave_max(-v); }
__device__ __forceinline__ float xhalf_max(float m) { const auto rr = __builtin_amdgcn_permlane32_swap(__float_as_uint(m), __float_as_uint(m), false, false); return fmaxf(__uint_as_float(rr[0]), __uint_as_float(rr[1])); }
__device__ __forceinline__ float xhalf_sum(float m) { const auto rr = __builtin_amdgcn_permlane32_swap(__float_as_uint(m), __float_as_uint(m), false, false); return __uint_as_float(rr[0]) + __uint_as_float(rr[1]); }
__device__ __forceinline__ bf16x8 pack8f(const f32x4 a, const f32x4 b) { u32x4 w; w.x = cvt_pk_bf16(a[0], a[1]); w.y = cvt_pk_bf16(a[2], a[3]); w.z = cvt_pk_bf16(b[0], b[1]); w.w = cvt_pk_bf16(b[2], b[3]); return __builtin_bit_cast(bf16x8, w); }
__device__ __forceinline__ float fast_tanh(float x) { const float e = __expf(-2.f * fabsf(x)); const float t = (1.f - e) * __builtin_amdgcn_rcpf(1.f + e); return x < 0.f ? -t : t; }
__device__ __forceinline__ void tr_tile(const float* __restrict__ src, size_t ld, int k0, int c0, int nvalid, bf16_t* __restrict__ dst, int K, LAS float* scr, int lane) {
    float tv[64];
#pragma unroll
    for (int kk = 0; kk < 64; ++kk) tv[kk] = src[(size_t)(k0 + kk) * ld + c0 + (lane < nvalid ? lane : 0)];
#pragma unroll
    for (int kk = 0; kk < 64; ++kk) scr[kk * 65 + lane] = (lane < nvalid) ? tv[kk] : 0.f;
    const int nl = lane >> 3, kc8 = (lane & 7) * 8;
#pragma unroll
    for (int it = 0; it < 8; ++it) { const int nn = 8 * it + nl; const LAS float* s = scr + kc8 * 65 + nn;
        u32x4 w; w.x = cvt_pk_bf16(s[0], s[65]); w.y = cvt_pk_bf16(s[130], s[195]); w.z = cvt_pk_bf16(s[260], s[325]); w.w = cvt_pk_bf16(s[390], s[455]);
        *(u32x4*)(dst + (size_t)nn * K + k0 + kc8) = w; }
}
__device__ __forceinline__ void p0_weights(KP p, LAS unsigned char* lds, int gw, int ngw, int wave, int lane) {
    LAS float* scr = (LAS float*)lds + wave * SLOT_F;
    constexpr int T_WIN = (NU / 64) * 32, T_WBR = 4 * 32 * 8, T_WOUT = 32 * 32, T_POOL = 4 * 2 * 2, T_L = T_WIN + T_WBR + T_WOUT + T_POOL;
    for (int it = gw; it < 2 * T_L; it += ngw) {
        const int l = it / T_L; int r = it % T_L;
        if (r < T_WIN) {
            const int nt = r / 32, kt = r % 32, m0 = nt * 64;
            int c0, nvalid = 64;
            if (m0 < 3072) c0 = m0; else if (m0 < U_F) c0 = m0 + 8; else if (m0 == U_F) { c0 = 3072; nvalid = 8; } else { c0 = 0; nvalid = 0; }
            tr_tile(p->in[I_WIN] + (size_t)l * 2048 * IN_W, IN_W, kt * 64, c0, nvalid, (bf16_t*)(p->ws + WS_WIN) + ((size_t)l * NU + m0) * LDH, LDH, scr, lane);
            continue; }
        r -= T_WIN;
        if (r < T_WBR) {
            const int n = r / 256, q = r % 256, nt = q / 8, kt = q % 8;
            tr_tile(p->in[I_WBR] + ((size_t)(l * 4 + n) * 512) * 2048, 2048, kt * 64, nt * 64, 64, (bf16_t*)(p->ws + WS_WBR) + ((size_t)(l * 4 + n) * 2048 + nt * 64) * 512, 512, scr, lane);
            continue; }
        r -= T_WBR;
        if (r < T_WOUT) {
            const int nt = r / 32, kt = r % 32;
            tr_tile(p->in[I_WOUT] + (size_t)l * 2048 * 2048, 2048, kt * 64, nt * 64, 64, (bf16_t*)(p->ws + WS_WOUT) + ((size_t)l * 2048 + nt * 64) * LDH, LDH, scr, lane);
            continue; }
        r -= T_WOUT;
        {
            const int g = r / 4, q = r % 4, nt = q / 2, kt = q % 2;
            tr_tile(p->in[I_POOLW] + (size_t)(l * 4 + g) * 128 * 128, 128, kt * 64, nt * 64, 64, (bf16_t*)(p->ws + WS_POOLW) + ((size_t)(l * 4 + g) * 128 + nt * 64) * 128, 128, scr, lane);
        }
    }
}
__device__ __forceinline__ void ada_unit(KP p, int unit, LAS unsigned char* lds, int tid) {
    const int wave = tid >> 6, lane = tid & 63, li = lane & 31, kh = lane >> 5, l = unit / 96, n0 = (unit % 96) * 64;
    LAS float* cs = (LAS float*)lds + wave * (32 * 65 + 64);
    LAS float* c0l = cs + 32 * 65;
    LAS float* red = (LAS float*)lds + 8 * (32 * 65 + 64);
    const float* W = p->in[I_WADA] + (size_t)l * 2048 * 6144 + n0 + li;
    const float* cp = p->in[I_CP]; const float* csm = p->in[I_CS];
    f32x16 acc0 = {}, acc1 = {}; float ap0 = 0.f, ap1 = 0.f;
#pragma unroll 1
    for (int ch = 0; ch < 4; ++ch) {
        const int k0 = wave * 256 + ch * 64;
        float wb[64];
#pragma unroll
        for (int j = 0; j < 32; ++j) { const float* wp = W + (size_t)(k0 + 2 * j + kh) * 6144; wb[2 * j] = wp[0]; wb[2 * j + 1] = wp[32]; }
#pragma unroll
        for (int s = 0; s < 32; ++s) cs[s * 65 + lane] = siluf_(csm[(size_t)s * 2048 + k0 + lane]);
        c0l[lane] = siluf_(cp[k0 + lane]);
#pragma unroll
        for (int j = 0; j < 32; ++j) { const float a = cs[li * 65 + 2 * j + kh], c0v = c0l[2 * j + kh], b0 = wb[2 * j], b1 = wb[2 * j + 1];
            acc0 = __builtin_amdgcn_mfma_f32_32x32x2f32(a, b0, acc0, 0, 0, 0); acc1 = __builtin_amdgcn_mfma_f32_32x32x2f32(a, b1, acc1, 0, 0, 0);
            ap0 += c0v * b0; ap1 += c0v * b1; }
    }
    ap0 = xhalf_sum(ap0); ap1 = xhalf_sum(ap1);
    if (kh == 0) { red[(wave * 33) * 64 + li] = ap0; red[(wave * 33) * 64 + 32 + li] = ap1; }
#pragma unroll
    for (int r = 0; r < 16; ++r) { const int s = 1 + (r & 3) + 8 * (r >> 2) + 4 * kh; red[(wave * 33 + s) * 64 + li] = acc0[r]; red[(wave * 33 + s) * 64 + 32 + li] = acc1[r]; }
    __syncthreads();
    for (int idx = tid; idx < 33 * 64; idx += 512) { const int s = idx >> 6, n = idx & 63; float v = p->in[I_BADA][l * 6144 + n0 + n];
#pragma unroll
        for (int w = 0; w < 8; ++w) v += red[(w * 33 + s) * 64 + n];
        ((float*)(p->ws + WS_ADA))[((size_t)l * 33 + s) * 6144 + n0 + n] = v; }
    __syncthreads();
}
__device__ __forceinline__ void load_x8(KP p, int l, int row, int lane, f32x4 (&v)[8]) {
    if (row < TP) { const f32x4* x4 = (const f32x4*)(l == 0 ? p->in[I_XP] + (size_t)row * DM : (const float*)(p->ws + WS_XBUF) + (size_t)row * DM) + lane;
#pragma unroll
        for (int j = 0; j < 8; ++j) v[j] = x4[64 * j]; }
    else { const int r = row - TP; const f32x4* x4 = (const f32x4*)(p->in[I_XS] + (size_t)r * DM) + lane;
#pragma unroll
        for (int j = 0; j < 8; ++j) v[j] = x4[64 * j];
        for (int s = 0; s < 8 * l; ++s) { const f32x4* q4 = (const f32x4*)((const float*)(p->ws + WS_XPART) + ((size_t)s * 1024 + r) * DM) + lane;
#pragma unroll
            for (int j = 0; j < 8; ++j) v[j] += q4[64 * j]; } }
}
__device__ __forceinline__ void p1_rows(KP p, int l, int gw, int ngw, int lane) {
    const f32x4* g4 = (const f32x4*)(p->in[I_NORMG] + l * DM) + lane;
    f32x4 a[8], sh[8]; int cur_seq = -1;
    for (int row = gw; row < NTOK; row += ngw) {
        const int seq = row < TP ? 0 : 1 + ((row - TP) >> 5);
        f32x4 v[8]; float ss = 0.f; load_x8(p, l, row, lane, v);
#pragma unroll
        for (int j = 0; j < 8; ++j) { ss += (v[j].x * v[j].x + v[j].y * v[j].y) + (v[j].z * v[j].z + v[j].w * v[j].w); }
        if (seq != cur_seq) { cur_seq = seq;
            const f32x4* sh4 = (const f32x4*)((const float*)(p->ws + WS_ADA) + ((size_t)l * 33 + seq) * 6144) + lane; const f32x4* sc4 = sh4 + 512;
#pragma unroll
            for (int j = 0; j < 8; ++j) { a[j] = g4[64 * j] * (sc4[64 * j] + 1.f); sh[j] = sh4[64 * j]; } }
        const float rstd = 1.f / sqrtf(wave_sum(ss) * (1.f / DM) + 1e-6f);
        u32x2* o = (u32x2*)((bf16_t*)(p->ws + WS_H) + (size_t)row * LDH) + lane;
#pragma unroll
        for (int j = 0; j < 8; ++j) { const f32x4 y = v[j] * rstd * a[j] + sh[j];
            u32x2 w; w.x = cvt_pk_bf16(y.x, y.y); w.y = cvt_pk_bf16(y.z, y.w); o[64 * j] = w; }
    }
}
__device__ __forceinline__ void p_final_rows(KP p, int gw, int ngw, int lane) {
    const f32x4* g4 = (const f32x4*)p->in[I_FING] + lane;
    for (int row = gw; row < NTOK; row += ngw) {
        f32x4 v[8]; float ss = 0.f; load_x8(p, 2, row, lane, v);
#pragma unroll
        for (int j = 0; j < 8; ++j) { ss += (v[j].x * v[j].x + v[j].y * v[j].y) + (v[j].z * v[j].z + v[j].w * v[j].w); }
        const float rstd = 1.f / sqrtf(wave_sum(ss) * (1.f / DM) + 1e-6f);
        f32x4* o = (f32x4*)(p->out + O_YP + (size_t)row * DM) + lane;
#pragma unroll
        for (int j = 0; j < 8; ++j) o[64 * j] = v[j] * rstd * g4[64 * j];
    }
}
struct EpiU {
    static constexpr bool PERM = true, AFTER_DRAIN = false; static constexpr int PROBE = 50;
    bf16_t* U; float* out; const float* bf; int l;
    __device__ __forceinline__ void operator()(const f32x4 (&acc)[2][2][4][2], const pg8::Unit& u, int wr, int wc, int fr, int fq) const {
        const int row0 = u.pm * 256 + wr * 64 + fr, col0 = u.pn * 256 + wc * 32 + 8 * fq;
#pragma unroll
        for (int ai = 0; ai < 2; ++ai)
#pragma unroll
            for (int m = 0; m < 4; ++m) { bf16_t* rowp = U + (size_t)(row0 + ai * 128 + m * 16) * NU + col0;
#pragma unroll
                for (int bj = 0; bj < 2; ++bj) { const f32x4 v0 = acc[ai][bj][m][0], v1 = acc[ai][bj][m][1];
                    u32x4 w; w.x = cvt_pk_bf16(v0[0], v0[1]); w.y = cvt_pk_bf16(v0[2], v0[3]); w.z = cvt_pk_bf16(v1[0], v1[1]); w.w = cvt_pk_bf16(v1[2], v1[3]);
                    *(u32x4*)(rowp + bj * 128) = w; } }
        if (u.pn >= 8 && u.pn < 12) {
            const bool isv = u.pn >= 10; const int cin = (u.pn - (isv ? 10 : 8)) * 256 + wc * 32 + 8 * fq;
#pragma unroll
            for (int ai = 0; ai < 2; ++ai)
#pragma unroll
                for (int m = 0; m < 4; ++m) { const int row = row0 + ai * 128 + m * 16;
                    float* dst = row < TP ? out + (isv ? O_PV : O_PK) + ((size_t)l * TP + row) * 512 : out + (isv ? O_SV : O_SK) + ((size_t)l * 1024 + (row - TP)) * 512;
#pragma unroll
                    for (int bj = 0; bj < 2; ++bj) { *(f32x4*)(dst + cin + bj * 128) = acc[ai][bj][m][0]; *(f32x4*)(dst + cin + bj * 128 + 4) = acc[ai][bj][m][1]; } }
        }
        if (u.pn == 58 && wc == 0 && fq == 0) {
            const f32x4 b0 = *(const f32x4*)(bf + l * 8), b1 = *(const f32x4*)(bf + l * 8 + 4);
#pragma unroll
            for (int ai = 0; ai < 2; ++ai)
#pragma unroll
                for (int m = 0; m < 4; ++m) { const int row = row0 + ai * 128 + m * 16;
                    float* dst = row < TP ? out + O_PLF + ((size_t)l * TP + row) * 8 : out + O_SLF + ((size_t)l * 1024 + (row - TP)) * 8;
                    const f32x4 z0 = acc[ai][1][m][0] + b0, z1 = acc[ai][1][m][1] + b1; f32x4 o0, o1;
#pragma unroll
                    for (int e = 0; e < 4; ++e) { o0[e] = log_sigmoidf_(z0[e]); o1[e] = log_sigmoidf_(z1[e]); }
                    *(f32x4*)dst = o0; *(f32x4*)(dst + 4) = o1; }
        }
    }
};
struct BranchOrder {
    int G, c;
    __device__ __forceinline__ bool next(int i, pg8::Unit& u) const { const int L = i * G + c; if (L >= 4 * 544) return false; const int n = L / 544, t = L - n * 544; u.pm = n * 68 + (t >> 3); u.pn = n * 8 + (t & 7); return true; }
    __device__ __forceinline__ void a_ready(const pg8::Unit&) const {}
    __device__ __forceinline__ void done(const pg8::Unit&) const {}
};
struct EpiZ {
    static constexpr bool PERM = true, AFTER_DRAIN = false; static constexpr int PROBE = 51;
    bf16_t* Z; const bf16_t* U;
    __device__ __forceinline__ void operator()(const f32x4 (&acc)[2][2][4][2], const pg8::Unit& u, int wr, int wc, int fr, int fq) const {
        const int row0 = u.pm * 256 + wr * 64 + fr, col0 = (u.pn & 7) * 256 + wc * 32 + 8 * fq;
#pragma unroll
        for (int ai = 0; ai < 2; ++ai)
#pragma unroll
            for (int m = 0; m < 4; ++m) { bf16_t* rowp = Z + (size_t)(row0 + ai * 128 + m * 16) * DM + col0;
#pragma unroll
                for (int bj = 0; bj < 2; ++bj) { const f32x4 v0 = acc[ai][bj][m][0], v1 = acc[ai][bj][m][1];
                    u32x4 w; w.x = cvt_pk_bf16(v0[0], v0[1]); w.y = cvt_pk_bf16(v0[2], v0[3]); w.z = cvt_pk_bf16(v1[0], v1[1]); w.w = cvt_pk_bf16(v1[2], v1[3]);
                    *(u32x4*)(rowp + bj * 128) = w; } }
    }
};
__device__ __forceinline__ void merge_pass(KP p, int l, int gtid, int ngt) {
    const bf16_t* U = (const bf16_t*)(p->ws + WS_U); const bf16_t* Z = (const bf16_t*)(p->ws + WS_Z); bf16_t* M = (bf16_t*)(p->ws + WS_MERGED);
    for (int it0 = gtid; it0 < NTOK * 256; it0 += 3 * ngt) {
        u32x4 gv[3][4], zv[3][4];
#pragma unroll
        for (int k = 0; k < 3; ++k) { const int it = it0 + k * ngt < NTOK * 256 ? it0 + k * ngt : it0; const int row = it >> 8, col = (it & 255) * 8;
#pragma unroll
            for (int n = 0; n < 4; ++n) { gv[k][n] = *(const u32x4*)(U + (size_t)row * NU + U_G + n * 2048 + col); zv[k][n] = *(const u32x4*)(Z + ((size_t)n * NTOK + row) * DM + col); } }
#pragma unroll
        for (int k = 0; k < 3; ++k) { const int it = it0 + k * ngt; if (it < NTOK * 256) { const int row = it >> 8, col = (it & 255) * 8;
            float s[8];
#pragma unroll
            for (int e = 0; e < 8; ++e) s[e] = 0.f;
#pragma unroll
            for (int n = 0; n < 4; ++n) { const u32x4 g = gv[k][n], z = zv[k][n];
                s[0] += sigmoidf_(bflo(g.x)) * bflo(z.x); s[1] += sigmoidf_(bfhi(g.x)) * bfhi(z.x); s[2] += sigmoidf_(bflo(g.y)) * bflo(z.y); s[3] += sigmoidf_(bfhi(g.y)) * bfhi(z.y);
                s[4] += sigmoidf_(bflo(g.z)) * bflo(z.z); s[5] += sigmoidf_(bfhi(g.z)) * bfhi(z.z); s[6] += sigmoidf_(bflo(g.w)) * bflo(z.w); s[7] += sigmoidf_(bfhi(g.w)) * bfhi(z.w); }
            u32x4 w; w.x = cvt_pk_bf16(s[0], s[1]); w.y = cvt_pk_bf16(s[2], s[3]); w.z = cvt_pk_bf16(s[4], s[5]); w.w = cvt_pk_bf16(s[6], s[7]);
            *(u32x4*)(M + (size_t)row * LDH + col) = w; } }
    }
}
struct EpiOut {
    static constexpr bool PERM = false, AFTER_DRAIN = false; static constexpr int PROBE = 52;
    const float* xp; const float* xs; const float* xb; const float* ada; float* xout; int l;
    __device__ __forceinline__ void operator()(const f32x4 (&acc)[2][2][4][2], const pg8::Unit& u, int wr, int wc, int fr, int fq) const {
        const int row0 = u.pm * 256 + wr * 64 + fr, col0 = u.pn * 256 + wc * 32 + 4 * fq;
        f32x4 gt[2][2];
#pragma unroll
        for (int ai = 0; ai < 2; ++ai)
#pragma unroll
            for (int mp = 0; mp < 4; mp += 2) {
                f32x4 bs[2][2][2], gv[2][2][2];
#pragma unroll
                for (int mm = 0; mm < 2; ++mm) { const int row = row0 + ai * 128 + (mp + mm) * 16;
                    const float* base = l == 0 ? (row < TP ? xp + (size_t)row * DM : xs + (size_t)(row - TP) * DM) : xb + (size_t)row * DM;
                    const float* gate = ada + ((size_t)l * 33 + (row < TP ? 0 : 1 + ((row - TP) >> 5))) * 6144 + 4096;
#pragma unroll
                    for (int bj = 0; bj < 2; ++bj)
#pragma unroll
                        for (int n = 0; n < 2; ++n) { const int col = col0 + bj * 128 + n * 16; bs[mm][bj][n] = *(const f32x4*)(base + col); gv[mm][bj][n] = *(const f32x4*)(gate + col); } }
#pragma unroll
                for (int mm = 0; mm < 2; ++mm) { const int row = row0 + ai * 128 + (mp + mm) * 16;
#pragma unroll
                    for (int bj = 0; bj < 2; ++bj)
#pragma unroll
                        for (int n = 0; n < 2; ++n) { const int col = col0 + bj * 128 + n * 16; *(f32x4*)(xout + (size_t)row * DM + col) = bs[mm][bj][n] + gv[mm][bj][n] * acc[ai][bj][mp + mm][n]; } }
            }
        (void)gt;
    }
};
struct OneUnit {
    int pm, pn; bool valid;
    __device__ __forceinline__ bool next(int i, pg8::Unit& u) const { if (i > 0 || !valid) return false; u.pm = pm; u.pn = pn; return true; }
    __device__ __forceinline__ void a_ready(const pg8::Unit&) const {}
    __device__ __forceinline__ void done(const pg8::Unit&) const {}
};
struct EpiOutPart {
    static constexpr bool PERM = false, AFTER_DRAIN = false; static constexpr int PROBE = 53;
    const float* ada; float* part; int l;
    __device__ __forceinline__ void operator()(const f32x4 (&acc)[2][2][4][2], const pg8::Unit& u, int wr, int wc, int fr, int fq) const {
        const int row0 = u.pm * 256 + wr * 64 + fr - TP, col0 = u.pn * 256 + wc * 32 + 4 * fq;
#pragma unroll
        for (int ai = 0; ai < 2; ++ai)
#pragma unroll
            for (int m = 0; m < 4; ++m) { const int r = row0 + ai * 128 + m * 16;
                const float* gate = ada + ((size_t)l * 33 + 1 + (r >> 5)) * 6144 + 4096;
#pragma unroll
                for (int bj = 0; bj < 2; ++bj)
#pragma unroll
                    for (int n = 0; n < 2; ++n) { const int col = col0 + bj * 128 + n * 16; *(f32x4*)(part + (size_t)r * DM + col) = *(const f32x4*)(gate + col) * acc[ai][bj][m][n]; } }
    }
};
constexpr int CGS = 516;
__device__ __forceinline__ void conv_unit(KP p, int l, int tile, LAS unsigned char* lds, int tid) {
    const bf16_t* U = (const bf16_t*)(p->ws + WS_U);
    const int c = tid, wave = tid >> 6, lane = tid & 63;
    const bool samp = tile >= 512; const int b = tile - 512, row0 = samp ? TP + b * 32 : tile * 32;
    const bool last = samp || tile == 511;
    LAS float* gl = (LAS float*)lds;
    LAS bf16_t* sgl = (LAS bf16_t*)(lds + 62 * CGS * 4);
    LAS float* red = (LAS float*)(lds + 62 * CGS * 4 + 32 * 512 * 2);
    LAS float* st = red + 8 * 32;
#pragma unroll
    for (int k = 0; k < 8; ++k) { const int task = tid + 512 * k; if (task < 62 * 64) { const int i = task >> 6, ch = task & 63; f32x4 o0, o1;
        const int rel = i - 30;
        if (rel < 0 && samp) { const float* hp = p->in[I_SCONV] + (((size_t)l * 32 + b) * 30 + i) * 512 + 8 * ch; o0 = *(const f32x4*)hp; o1 = *(const f32x4*)(hp + 4); }
        else if (row0 + rel < 0) { o0 = (f32x4){0.f, 0.f, 0.f, 0.f}; o1 = o0; }
        else { const bf16_t* up = U + (size_t)(row0 + rel) * NU + 8 * ch; const u32x4 v = *(const u32x4*)(up + U_AVAL), g = *(const u32x4*)(up + U_AGATE);
            o0 = (f32x4){bflo(v.x) * sigmoidf_(bflo(g.x)), bfhi(v.x) * sigmoidf_(bfhi(g.x)), bflo(v.y) * sigmoidf_(bflo(g.y)), bfhi(v.y) * sigmoidf_(bfhi(g.y))};
            o1 = (f32x4){bflo(v.z) * sigmoidf_(bflo(g.z)), bfhi(v.z) * sigmoidf_(bfhi(g.z)), bflo(v.w) * sigmoidf_(bflo(g.w)), bfhi(v.w) * sigmoidf_(bfhi(g.w))}; }
        *(LAS f32x4*)(gl + i * CGS + 8 * ch) = o0; *(LAS f32x4*)(gl + i * CGS + 8 * ch + 4) = o1; } }
#pragma unroll
    for (int k = 0; k < 4; ++k) { const int task = tid + 512 * k, t = task >> 6, ch = task & 63; const u32x4 s = *(const u32x4*)(U + (size_t)(row0 + t) * NU + U_ASG + 8 * ch);
        u32x4 w; w.x = cvt_pk_bf16(siluf_(bflo(s.x)), siluf_(bfhi(s.x))); w.y = cvt_pk_bf16(siluf_(bflo(s.y)), siluf_(bfhi(s.y))); w.z = cvt_pk_bf16(siluf_(bflo(s.z)), siluf_(bfhi(s.z))); w.w = cvt_pk_bf16(siluf_(bflo(s.w)), siluf_(bfhi(s.w)));
        *(LAS u32x4*)(sgl + t * 512 + 8 * ch) = w; }
    const float cb = p->in[I_CONVB][l * 512 + c], lg = p->in[I_CLNG][l * 512 + c], lb = p->in[I_CLNB][l * 512 + c];
    float wk[31];
#pragma unroll
    for (int k = 0; k < 31; ++k) wk[k] = p->in[I_CONVW][((size_t)l * 31 + k) * 512 + c];
    __syncthreads();
    if (last) {
        float* dst = samp ? p->out + O_SCONV + (((size_t)l * 32 + b) * 30) * 512 + c : p->out + O_PCONV + ((size_t)l * 30) * 512 + c;
#pragma unroll
        for (int t = 2; t < 32; ++t) dst[(size_t)(t - 2) * 512] = gl[(30 + t) * CGS + c];
    }
    bf16_t* oa = (bf16_t*)(p->ws + WS_OCAT);
#pragma unroll 1
    for (int half = 0; half < 2; ++half) {
        float z[46];
#pragma unroll
        for (int i = 0; i < 46; ++i) z[i] = gl[(16 * half + i) * CGS + c];
        float hv[16];
#pragma unroll
        for (int tt = 0; tt < 16; ++tt) hv[tt] = cb;
#pragma unroll
        for (int k = 0; k < 31; ++k) {
#pragma unroll
            for (int tt = 0; tt < 16; ++tt) hv[tt] += z[tt + k] * wk[k]; }
#pragma unroll
        for (int tt = 0; tt < 16; ++tt) { const float s1 = wave_sum(hv[tt]), s2 = wave_sum(hv[tt] * hv[tt]); if (lane == 0) { red[(wave * 16 + tt) * 2] = s1; red[(wave * 16 + tt) * 2 + 1] = s2; } }
        __syncthreads();
        if (tid < 16) { float s1 = 0.f, s2 = 0.f;
#pragma unroll
            for (int w = 0; w < 8; ++w) { s1 += red[(w * 16 + tid) * 2]; s2 += red[(w * 16 + tid) * 2 + 1]; }
            const float mean = s1 * (1.f / 512.f), var = fmaxf(s2 * (1.f / 512.f) - mean * mean, 0.f);
            st[tid * 2] = mean; st[tid * 2 + 1] = 1.f / sqrtf(var + 1e-5f); }
        __syncthreads();
#pragma unroll
        for (int tt = 0; tt < 16; ++tt) { const float y = (hv[tt] - st[tt * 2]) * st[tt * 2 + 1] * lg + lb; const int t = 16 * half + tt;
            oa[(size_t)(row0 + t) * 512 + c] = f2bf(siluf_(y) * bf2f(sgl[t * 512 + c])); }
    }
    __syncthreads();
}
__device__ __forceinline__ void pool_unit(KP p, int l, int tile, LAS unsigned char* lds, int tid) {
    const bf16_t* U = (const bf16_t*)(p->ws + WS_U);
    const int c = tid, wave = tid >> 6, lane = tid & 63;
    const bool samp = tile >= 512; const int b = tile - 512, row0 = samp ? TP + b * 32 : tile * 32;
    constexpr int PST = 520;
    LAS float* zl = (LAS float*)lds;
    LAS bf16_t* pl = (LAS bf16_t*)(lds + 47 * CGS * 4);
#pragma unroll
    for (int k = 0; k < 6; ++k) { const int task = tid + 512 * k; if (task < 47 * 64) { const int i = task >> 6, ch = task & 63; f32x4 o0, o1; const int rel = i - 15;
        if (rel < 0 && samp) { const float* hp = p->in[I_SPOOL] + (((size_t)l * 32 + b) * 15 + i) * 512 + 8 * ch; o0 = *(const f32x4*)hp; o1 = *(const f32x4*)(hp + 4); }
        else if (row0 + rel < 0) { o0 = (f32x4){0.f, 0.f, 0.f, 0.f}; o1 = o0; }
        else { const u32x4 v = *(const u32x4*)(U + (size_t)(row0 + rel) * NU + U_DIN + 8 * ch); o0 = (f32x4){bflo(v.x), bfhi(v.x), bflo(v.y), bfhi(v.y)}; o1 = (f32x4){bflo(v.z), bfhi(v.z), bflo(v.w), bfhi(v.w)}; }
        *(LAS f32x4*)(zl + i * CGS + 8 * ch) = o0; *(LAS f32x4*)(zl + i * CGS + 8 * ch + 4) = o1; } }
    u32x4 sgv[4];
#pragma unroll
    for (int k = 0; k < 4; ++k) { const int task = tid + 512 * k; sgv[k] = *(const u32x4*)(U + (size_t)(row0 + (task >> 6)) * NU + U_DSG + 8 * (task & 63)); }
    __syncthreads();
    {
        float z[47];
#pragma unroll
        for (int i = 0; i < 47; ++i) z[i] = zl[i * CGS + c];
        if (samp || tile == 511) {
            float* dst = samp ? p->out + O_SPOOL + (((size_t)l * 32 + b) * 15) * 512 + c : p->out + O_PPOOL + ((size_t)l * 15) * 512 + c;
#pragma unroll
            for (int t = 17; t < 32; ++t) dst[(size_t)(t - 17) * 512] = z[15 + t];
        }
        const int w = 2 << (c >> 7);
#pragma unroll
        for (int t = 0; t < 32; ++t) { float s = 0.f;
#pragma unroll
            for (int i = 0; i < 16; ++i) s += (i < w) ? z[15 + t - i] : 0.f;
            const int pos = samp ? PAST + t : row0 + t; const int cnt = (pos + 1 < w) ? pos + 1 : w;
            pl[t * PST + c] = f2bf(s / (float)cnt - z[15 + t]); }
    }
    __syncthreads();
    LAS bf16_t* sl = (LAS bf16_t*)lds;
    LAS bf16_t* ol = sl + 32 * PST;
#pragma unroll
    for (int k = 0; k < 4; ++k) { const int task = tid + 512 * k, t = task >> 6, ch = task & 63; const u32x4 s = sgv[k];
        u32x4 w; w.x = cvt_pk_bf16(siluf_(bflo(s.x)), siluf_(bfhi(s.x))); w.y = cvt_pk_bf16(siluf_(bflo(s.y)), siluf_(bfhi(s.y))); w.z = cvt_pk_bf16(siluf_(bflo(s.z)), siluf_(bfhi(s.z))); w.w = cvt_pk_bf16(siluf_(bflo(s.w)), siluf_(bfhi(s.w)));
        *(LAS u32x4*)(sl + t * PST + 8 * ch) = w; }
    __syncthreads();
    {
        const int g = wave >> 1, fr = lane & 15, kq = lane >> 4;
        const bf16_t* WT = (const bf16_t*)(p->ws + WS_POOLW) + (size_t)(l * 4 + g) * 128 * 128;
        f32x4 acc[2][4];
#pragma unroll
        for (int mt = 0; mt < 2; ++mt)
#pragma unroll
            for (int nt = 0; nt < 4; ++nt) acc[mt][nt] = (f32x4){0.f, 0.f, 0.f, 0.f};
#pragma unroll
        for (int ks = 0; ks < 4; ++ks) {
            bf16x8 af[2];
#pragma unroll
            for (int mt = 0; mt < 2; ++mt) af[mt] = *(const LAS bf16x8*)(pl + (16 * mt + fr) * PST + g * 128 + 32 * ks + 8 * kq);
#pragma unroll
            for (int nt = 0; nt < 4; ++nt) { const int dl = (wave & 1) * 64 + 16 * nt + fr;
                const bf16x8 bfr = *(const bf16x8*)(WT + (size_t)dl * 128 + 32 * ks + 8 * kq);
#pragma unroll
                for (int mt = 0; mt < 2; ++mt) acc[mt][nt] = __builtin_amdgcn_mfma_f32_16x16x32_bf16(af[mt], bfr, acc[mt][nt], 0, 0, 0); }
        }
#pragma unroll
        for (int nt = 0; nt < 4; ++nt) { const int d = wave * 64 + 16 * nt + fr; const float pb = p->in[I_POOLB][l * 512 + d], ps = p->in[I_POOLS][l * 512 + d];
#pragma unroll
            for (int mt = 0; mt < 2; ++mt)
#pragma unroll
                for (int r = 0; r < 4; ++r) { const int t = 16 * mt + 4 * kq + r; ol[t * PST + d] = f2bf((acc[mt][nt][r] + pb) * ps * bf2f(sl[t * PST + d])); } }
    }
    __syncthreads();
    bf16_t* od = (bf16_t*)(p->ws + WS_OCAT) + (size_t)3 * NTOK * 512;
#pragma unroll
    for (int k = 0; k < 4; ++k) { const int task = tid + 512 * k, t = task >> 6, ch = task & 63; *(u32x4*)(od + (size_t)(row0 + t) * 512 + 8 * ch) = *(const LAS u32x4*)(ol + t * PST + 8 * ch); }
    __syncthreads();
}
__device__ __forceinline__ void fp_unit(KP p, int l, int h, LAS unsigned char* lds, int tid) {
    const float* lf = p->out + O_PLF + (size_t)l * TP * 8 + h;
    LAS float* part = (LAS float*)lds;
    float v[32]; float s = 0.f;
#pragma unroll
    for (int i = 0; i < 32; ++i) { v[i] = lf[(size_t)(tid * 32 + i) * 8]; s += v[i]; }
    part[tid] = s;
    __syncthreads();
    float pre = 0.f;
    for (int j = 0; j < tid; ++j) pre += part[j];
    float* F = (float*)(p->ws + WS_FP) + (size_t)h * TP + tid * 32;
#pragma unroll
    for (int i = 0; i < 32; ++i) { pre += v[i]; F[i] = pre * LOG2E; }
    __syncthreads();
}
__device__ __forceinline__ void gs_unit(KP p, int l, int b, LAS unsigned char* lds, int tid) {
    const int h = tid & 7, ch = tid >> 3;
    const float* cl = p->in[I_CLF] + (((size_t)l * 32 + b) * PAST + ch * 64) * 8 + h;
    LAS float* part = (LAS float*)lds;
    float v[64]; float s = 0.f;
#pragma unroll
    for (int i = 0; i < 64; ++i) v[i] = cl[(size_t)i * 8];
#pragma unroll
    for (int i = 0; i < 64; ++i) s += v[i];
    part[ch * 8 + h] = s;
    __syncthreads();
    float suf = 0.f;
    for (int j = ch + 1; j < 64; ++j) suf += part[j * 8 + h];
    float* G = (float*)(p->ws + WS_GS) + ((size_t)b * 8 + h) * GS_LEN + ch * 64;
#pragma unroll
    for (int i = 63; i >= 0; --i) { G[i] = -suf * LOG2E; suf += v[i]; }
    if (tid < 8) { const float* nl = p->out + O_SLF + ((size_t)l * 1024 + b * 32) * 8 + tid; float* Gn = (float*)(p->ws + WS_GS) + ((size_t)b * 8 + tid) * GS_LEN + PAST; float w[32]; float run = 0.f;
#pragma unroll
        for (int i = 0; i < 32; ++i) w[i] = nl[i * 8];
#pragma unroll
        for (int i = 0; i < 32; ++i) { run += w[i]; Gn[i] = run * LOG2E; } }
    __syncthreads();
}
__device__ __forceinline__ void vt_tile(KP p, int l, int tile, LAS unsigned char* lds, int wave, int lane) {
    const int h = tile >> 8, tb = tile & 255, tl = lane >> 3, q8 = (lane & 7) * 8;
    const bf16_t* U = (const bf16_t*)(p->ws + WS_U);
    LAS unsigned short* scr = (LAS unsigned short*)(lds + wave * (64 * 72 * 2));
    u32x4 kv[8], vv[8];
#pragma unroll
    for (int i = 0; i < 8; ++i) { const bf16_t* rp = U + (size_t)(tb * 64 + 8 * i + tl) * NU + h * 64 + q8; kv[i] = *(const u32x4*)(rp + U_K); vv[i] = *(const u32x4*)(rp + U_V); }
    float mx = 0.f;
#pragma unroll
    for (int i = 0; i < 8; ++i) { const u32x4 w = kv[i];
        float s = bflo(w.x) * bflo(w.x) + bfhi(w.x) * bfhi(w.x) + bflo(w.y) * bflo(w.y) + bfhi(w.y) * bfhi(w.y) + bflo(w.z) * bflo(w.z) + bfhi(w.z) * bfhi(w.z) + bflo(w.w) * bflo(w.w) + bfhi(w.w) * bfhi(w.w);
        s += dpp_mov<0xB1>(s); s += dpp_mov<0x4E>(s); s += dpp_mov<0x141>(s); mx = fmaxf(mx, s); }
    mx = wave_max(mx);
    if (lane == 0) atomicMax((unsigned*)(p->ws + WS_CTL) + CW_KMAX + l * 8 + h, __float_as_uint(mx));
#pragma unroll
    for (int i = 0; i < 8; ++i) { const int t = 8 * i + tl; const u32x4 w = vv[i];
        scr[(q8 + 0) * 72 + t] = (unsigned short)(w.x & 0xffffu); scr[(q8 + 1) * 72 + t] = (unsigned short)(w.x >> 16); scr[(q8 + 2) * 72 + t] = (unsigned short)(w.y & 0xffffu); scr[(q8 + 3) * 72 + t] = (unsigned short)(w.y >> 16);
        scr[(q8 + 4) * 72 + t] = (unsigned short)(w.z & 0xffffu); scr[(q8 + 5) * 72 + t] = (unsigned short)(w.z >> 16); scr[(q8 + 6) * 72 + t] = (unsigned short)(w.w & 0xffffu); scr[(q8 + 7) * 72 + t] = (unsigned short)(w.w >> 16); }
    bf16_t* Vt = (bf16_t*)(p->ws + WS_VT) + ((size_t)h * 64 + lane) * TP + tb * 64;
#pragma unroll
    for (int j = 0; j < 8; ++j) *(u32x4*)(Vt + 8 * j) = *(const LAS u32x4*)(scr + lane * 72 + 8 * j);
}
__device__ __forceinline__ void shift_out(KP p, int l, int tid) {
    const bf16_t* U = (const bf16_t*)(p->ws + WS_U);
    for (int base = tid; base < NSEQ * SHIFT_W; base += 512 * 8) {
        unsigned short v[8];
#pragma unroll
        for (int k = 0; k < 8; ++k) { const int idx = base + k * 512 < NSEQ * SHIFT_W ? base + k * 512 : tid; const int s = idx / SHIFT_W, j = idx - s * SHIFT_W; const int row = s == 0 ? TP - 1 : TP + (s - 1) * 32 + 31; v[k] = U[(size_t)row * NU + U_XC + j]; }
#pragma unroll
        for (int k = 0; k < 8; ++k) { const int idx = base + k * 512; if (idx < NSEQ * SHIFT_W) { const int s = idx / SHIFT_W, j = idx - s * SHIFT_W;
            float* dst = s == 0 ? p->out + O_PSHIFT + (size_t)l * SHIFT_W + j : p->out + O_SSHIFT + ((size_t)l * 32 + (s - 1)) * SHIFT_W + j; *dst = bf2f(v[k]); } }
    }
}
template <bool AT, bool BT, bool NEGA>
__device__ __forceinline__ void mm32(f32x16& acc, const LAS float* Ap, int i0, const LAS float* Bp, int j0, int lane) {
    const int li = lane & 31, kh = lane >> 5;
    const LAS float* ap = AT ? Ap + (8 * kh) * 65 + i0 + li : Ap + (i0 + li) * 65 + 8 * kh;
    const LAS float* bp = BT ? Bp + (j0 + li) * 65 + 8 * kh : Bp + (8 * kh) * 65 + j0 + li;
#pragma unroll 2
    for (int s = 0; s < 4; ++s) {
        float a[8], b[8];
#pragma unroll
        for (int e = 0; e < 8; ++e) { a[e] = AT ? ap[(16 * s + e) * 65] : ap[16 * s + e]; b[e] = BT ? bp[16 * s + e] : bp[(16 * s + e) * 65]; }
        if (NEGA) {
#pragma unroll
            for (int e = 0; e < 8; ++e) a[e] = -a[e]; }
        const bf16x8 af = pack8f((f32x4){a[0], a[1], a[2], a[3]}, (f32x4){a[4], a[5], a[6], a[7]}), bfg = pack8f((f32x4){b[0], b[1], b[2], b[3]}, (f32x4){b[4], b[5], b[6], b[7]});
        acc = __builtin_amdgcn_mfma_f32_32x32x16_bf16(af, bfg, acc, 0, 0, 0);
    }
}
template <int MASK>
__device__ __forceinline__ void st_tile(LAS float* dst, const f32x16& acc, int i0, int j0, int lane) {
    const int li = lane & 31, hi = lane >> 5, j = j0 + li;
#pragma unroll
    for (int r = 0; r < 16; ++r) { const int i = i0 + (r & 3) + 8 * (r >> 2) + 4 * hi; float v = acc[r];
        if (MASK == 1 && !(i < j)) v = 0.f; if (MASK == 2 && !(i <= j)) v = 0.f; dst[i * 65 + j] = v; }
}
struct RwkvSeqInfo { int row0, ntok, prev_kind  , b; };
__device__ __forceinline__ RwkvSeqInfo rwkv_info(int cu) { RwkvSeqInfo s; if (cu < 256) { s.row0 = cu * 64; s.ntok = 64; s.prev_kind = cu == 0 ? 0 : 1; s.b = 0; } else { s.b = cu - 256; s.row0 = TP + s.b * 32; s.ntok = 32; s.prev_kind = 2; } return s; }

__device__ __forceinline__ void rwkv_r1(KP p, int l, int unit, int unit_next, LAS unsigned char* lds, int tid) {
    const int cu = unit >> 3, h = unit & 7, wave = tid >> 6, lane = tid & 63, li = lane & 31, hi = lane >> 5;
    const RwkvSeqInfo si = rwkv_info(cu);
    const bf16_t* U = (const bf16_t*)(p->ws + WS_U);
    LAS float* S0 = (LAS float*)lds; LAS float *S1 = S0 + SLOT_F, *S2 = S0 + 2 * SLOT_F, *S3 = S0 + 3 * SLOT_F, *S4 = S0 + 4 * SLOT_F, *S5 = S0 + 5 * SLOT_F, *S6 = S0 + 6 * SLOT_F, *S7 = S0 + 7 * SLOT_F, *S8 = S0 + 8 * SLOT_F;
    LAS float* gC = S0 + 9 * SLOT_F;
    const int q = wave >> 2, wq = wave & 3, i0 = (wq >> 1) * 32, j0 = (wq & 1) * 32;
    PT0();
    {
        const int j = tid & 63, tq = tid >> 6;
        const int tl = lane >> 3, q8 = (lane & 7) * 8;
#pragma unroll
        for (int kb = 0; kb < 5; kb += 3) {
        u32x4 cur[5], prv[5];
#pragma unroll
        for (int k = kb; k < (kb + 3 < 5 ? kb + 3 : 5); ++k) { const int pid = wave * 5 + k, s = pid >> 3, tb = pid & 7, t = tb * 8 + tl;
            const int xo = (s < 3 ? s * 512 + h * 64 : 1536 + (s - 3) * 64) + q8;
            const int tc = t < si.ntok ? t : si.ntok - 1, tp = tc > 0 ? tc - 1 : (si.prev_kind == 1 ? -1 : 0);
            cur[k] = *(const u32x4*)(U + (size_t)(si.row0 + tc) * NU + U_XC + xo); prv[k] = *(const u32x4*)(U + (size_t)(si.row0 + tp) * NU + U_XC + xo); }
#pragma unroll
        for (int k = kb; k < (kb + 3 < 5 ? kb + 3 : 5); ++k) { const int pid = wave * 5 + k, s = pid >> 3, tb = pid & 7, t = tb * 8 + tl;
            const int xo = (s < 3 ? s * 512 + h * 64 : 1536 + (s - 3) * 64) + q8;
            LAS float* dst = (s == 0 ? S0 : s == 1 ? S1 : s == 2 ? S2 : s == 3 ? S3 : S4) + t * 65 + q8;
            const f32x4 m0 = *(const f32x4*)(p->in[I_MU] + l * SHIFT_W + xo), m1 = *(const f32x4*)(p->in[I_MU] + l * SHIFT_W + xo + 4);
            float x[8] = {bflo(cur[k].x), bfhi(cur[k].x), bflo(cur[k].y), bfhi(cur[k].y), bflo(cur[k].z), bfhi(cur[k].z), bflo(cur[k].w), bfhi(cur[k].w)};
            float pv[8] = {bflo(prv[k].x), bfhi(prv[k].x), bflo(prv[k].y), bfhi(prv[k].y), bflo(prv[k].z), bfhi(prv[k].z), bflo(prv[k].w), bfhi(prv[k].w)};
            if (t == 0 && si.prev_kind != 1) {
                if (si.prev_kind == 2) { const float* sp = p->in[I_SSHIFT] + ((size_t)l * 32 + si.b) * SHIFT_W + xo;
#pragma unroll
                    for (int e = 0; e < 8; ++e) pv[e] = sp[e]; }
                else {
#pragma unroll
                    for (int e = 0; e < 8; ++e) pv[e] = 0.f; } }
#pragma unroll
            for (int e = 0; e < 8; ++e) { const float mu = e < 4 ? m0[e] : m1[e - 4]; float xs = (t < si.ntok) ? x[e] + (pv[e] - x[e]) * mu : 0.f; if (s == 3) xs = fast_tanh(xs); dst[e] = xs; }
        }
        }
#pragma unroll
        for (int mm = 0; mm < 8; ++mm) { const int m = tq * 8 + mm;
            S5[m * 65 + j] = p->in[I_W2][((size_t)l * 64 + m) * 512 + h * 64 + j]; S6[m * 65 + j] = p->in[I_A2][((size_t)l * 64 + m) * 512 + h * 64 + j]; }
    }
    __syncthreads();
    PT1(1);
    {
        f32x16 acc = {};
        const int c = j0 + li;
        if (q == 0) { mm32<false, false, false>(acc, S3, i0, S5, j0, lane); const float w0 = p->in[I_W0][l * 512 + h * 64 + c];
#pragma unroll
            for (int r = 0; r < 16; ++r) { const int t = i0 + (r & 3) + 8 * (r >> 2) + 4 * hi; const float zz = acc[r] + w0;
                const float sp = fmaxf(-zz, 0.f) + __logf(1.f + __expf(-fabsf(zz)));
                S7[t * 65 + c] = (t < si.ntok) ? -__expf(-sp - 0.5f) : 0.f; } }
        else { mm32<false, false, false>(acc, S4, i0, S6, j0, lane); const float a0 = p->in[I_A0][l * 512 + h * 64 + c];
#pragma unroll
            for (int r = 0; r < 16; ++r) { const int t = i0 + (r & 3) + 8 * (r >> 2) + 4 * hi; S8[t * 65 + c] = __builtin_amdgcn_rcpf(1.f + __expf(-(acc[r] + a0))); } }
    }
    __syncthreads();
    PT1(2);
    if (wave == 0) { float run = 0.f;
#pragma unroll 8
        for (int t = 0; t < 64; ++t) { run += S7[t * 65 + lane]; S3[t * 65 + lane] = run; } }
    else { const int c = lane; const float kkw = p->in[I_KK][l * 512 + h * 64 + c], kaw = p->in[I_KA][l * 512 + h * 64 + c], rkw = p->in[I_RK][l * 512 + h * 64 + c];
        for (int t = wave - 1; t < 64; t += 7) { const float kr = S1[t * 65 + c], kv = kr * kkw; const float ss = wave_sum(kv * kv);
            const float kn = kv * (1.f / sqrtf(fmaxf(ss, 1e-24f))); const float a = S8[t * 65 + c]; const float km = kr * (1.f + (a - 1.f) * kaw);
            const float bon = wave_sum(S0[t * 65 + c] * km * rkw);
            S4[t * 65 + c] = kn; S1[t * 65 + c] = km; S8[t * 65 + c] = kn * a;
            if (lane == 0) ((float*)(p->ws + WS_BONUS))[(size_t)unit * 64 + t] = bon; } }
    __syncthreads();
    { const int c = tid & 63, tq = tid >> 6;
#pragma unroll
        for (int tt = 0; tt < 8; ++tt) { const int t = tq * 8 + tt, o = t * 65 + c; const float Lg = S3[o], lw = S7[o];
            const float g = __expf(Lg), gi = __expf(-Lg), gp = __expf(Lg - lw);
            S0[o] *= g; S1[o] *= gi; S8[o] *= gi; S4[o] *= gp; if (t == 63) gC[c] = g; } }
    __syncthreads();
    PT1(3);
    unsigned touch = 0u;
    if (unit_next < NRU && tid < 65 * 5) { const RwkvSeqInfo sn = rwkv_info(unit_next >> 3); const int hn = unit_next & 7, rr = tid / 5, ln = tid - rr * 5;
        const int trow = rr == 0 ? (sn.prev_kind == 1 ? -1 : 0) : (rr - 1 < sn.ntok ? rr - 1 : sn.ntok - 1);
        const int xo = ln < 3 ? ln * 512 + hn * 64 : 1536 + (ln - 3) * 64;
        touch = *(const unsigned*)(U + (size_t)(sn.row0 + trow) * NU + U_XC + xo); }
    { f32x16 acc = {};
      if (q == 0) { mm32<false, true, false>(acc, S1, i0, S4, j0, lane); st_tile<1>(S3, acc, i0, j0, lane); }
      else { mm32<false, true, false>(acc, S8, i0, S4, j0, lane); st_tile<1>(S5, acc, i0, j0, lane); } }
    __syncthreads();
    { f32x16 acc = {};
      if (q == 0) { mm32<true, false, false>(acc, S2, i0, S3, j0, lane); st_tile<0>(S6, acc, i0, j0, lane); }
      else { mm32<false, true, false>(acc, S1, i0, S0, j0, lane); st_tile<2>(S7, acc, i0, j0, lane); } }
    __syncthreads();
    asm volatile("" :: "v"(touch));
    PT1(4);
    { float xa[4], xb[4]; const int ra = 4 * wave, rb = 60 - 4 * wave;
#pragma unroll
      for (int k = 0; k < 4; ++k) { xa[k] = (lane == ra + k) ? 1.f : 0.f; xb[k] = (lane == rb + k) ? 1.f : 0.f; }
      for (int s = ra; s < rb; ++s) { const float mrow = S5[s * 65 + lane];
#pragma unroll
          for (int k = 0; k < 4; ++k) xa[k] -= __builtin_bit_cast(float, __builtin_amdgcn_readlane(__builtin_bit_cast(int, xa[k]), s)) * mrow; }
      for (int s = rb; s < 63; ++s) { const float mrow = S5[s * 65 + lane]; float ya[4], yb[4];
#pragma unroll
          for (int k = 0; k < 4; ++k) { ya[k] = __builtin_bit_cast(float, __builtin_amdgcn_readlane(__builtin_bit_cast(int, xa[k]), s)); yb[k] = __builtin_bit_cast(float, __builtin_amdgcn_readlane(__builtin_bit_cast(int, xb[k]), s)); }
#pragma unroll
          for (int k = 0; k < 4; ++k) { xa[k] -= ya[k] * mrow; xb[k] -= yb[k] * mrow; } }
#pragma unroll
      for (int k = 0; k < 4; ++k) { S3[(ra + k) * 65 + lane] = xa[k]; S3[(rb + k) * 65 + lane] = xb[k]; } }
    __syncthreads();
    { f32x16 acc = {};
      if (q == 0) mm32<true, false, false>(acc, S4, i0, S3, j0, lane); else mm32<false, false, false>(acc, S6, i0, S3, j0, lane);
      __syncthreads();
      st_tile<0>(q == 0 ? S3 : S6, acc, i0, j0, lane); }
    __syncthreads();
    PT1(5);
    { f32x16 acc = {};
      if (q == 1) { mm32<false, true, false>(acc, S8, i0, S0, j0, lane); st_tile<2>(S4, acc, i0, j0, lane); }
      else { mm32<false, false, false>(acc, S3, i0, S8, j0, lane);
          const int jc = j0 + li; const float gc = gC[jc]; float* TQ = (float*)(p->ws + WS_TQ) + (size_t)unit * 4096;
#pragma unroll
          for (int rg = 0; rg < 4; ++rg) { const int ab = i0 + 8 * rg + 4 * hi; f32x4 o;
#pragma unroll
              for (int e = 0; e < 4; ++e) o[e] = ((ab + e == jc) ? gc : 0.f) - acc[rg * 4 + e] * gc;
              *(f32x4*)(TQ + ((((jc >> 4) * 4 + (ab >> 4)) * 64 + ((ab & 15) >> 2) * 16 + (jc & 15)) * 4)) = o; } } }
    __syncthreads();
    { f32x16 acc = {};
      if (q == 0) { mm32<true, false, false>(acc, S2, i0, S1, j0, lane); mm32<false, false, true>(acc, S6, i0, S8, j0, lane);
          const int jc = j0 + li; const float gc = gC[jc]; float* GM = (float*)(p->ws + WS_GM) + (size_t)unit * 4096;
#pragma unroll
          for (int r = 0; r < 16; ++r) GM[(i0 + (r & 3) + 8 * (r >> 2) + 4 * hi) * 64 + jc] = acc[r] * gc; }
      else { mm32<true, false, false>(acc, S2, i0, S7, j0, lane); mm32<false, false, true>(acc, S6, i0, S4, j0, lane);
          float* Y0T = (float*)(p->ws + WS_Y0T) + (size_t)unit * 4096;
#pragma unroll
          for (int rg = 0; rg < 4; ++rg) *(f32x4*)(Y0T + (((((j0 >> 5) * 2 + (i0 >> 5)) * 4 + rg) * 2 + hi) * 32 + li) * 4) = (f32x4){acc[rg * 4], acc[rg * 4 + 1], acc[rg * 4 + 2], acc[rg * 4 + 3]}; } }
    if (q == 0) { f32x16 acc;
#pragma unroll
        for (int r = 0; r < 16; ++r) acc[r] = S0[(j0 + li) * 65 + i0 + (r & 3) + 8 * (r >> 2) + 4 * hi];
        mm32<false, false, true>(acc, S3, i0, S4, j0, lane);
        float* ET = (float*)(p->ws + WS_ET) + (size_t)unit * 4096;
#pragma unroll
        for (int rg = 0; rg < 4; ++rg) *(f32x4*)(ET + ((((j0 >> 5) * 2 + (i0 >> 5)) * 8 + 2 * rg + hi) * 32 + li) * 4) = (f32x4){acc[rg * 4], acc[rg * 4 + 1], acc[rg * 4 + 2], acc[rg * 4 + 3]}; }
    __syncthreads();
    PT1(6);
}
template <bool SCQ>
__device__ __forceinline__ void chain_run(f32x4 (&st)[4], const float* TQ, const float* GM, float* SC, int nsteps, int i, int g, int lane) {
    constexpr size_t STRIDE = (size_t)8 * 4096;
    f32x4 tq[16], gm[4];
#pragma unroll
    for (int x = 0; x < 16; ++x) tq[x] = *(const f32x4*)(TQ + (x * 64 + lane) * 4);
#pragma unroll
    for (int tl = 0; tl < 4; ++tl) gm[tl] = GM ? *(const f32x4*)(GM + i * 64 + 16 * tl + 4 * g) : (f32x4){0.f, 0.f, 0.f, 0.f};
    for (int c = 0; c < nsteps; ++c) {
        if (SC) {
            if (SCQ) {
#pragma unroll
                for (int tl = 0; tl < 4; ++tl) *(f32x4*)(SC + c * STRIDE + ((((i >> 5) * 2 + (tl >> 1)) * 8 + 4 * (tl & 1) + g) * 32 + (i & 31)) * 4) = st[tl]; }
            else {
#pragma unroll
                for (int tl = 0; tl < 4; ++tl) *(f32x4*)(SC + c * STRIDE + i * 64 + 16 * tl + 4 * g) = st[tl]; } }
        f32x4 tqn[16], gmn[4];
        const int cn = (c + 1 < nsteps) ? c + 1 : c;
#pragma unroll
        for (int x = 0; x < 16; ++x) tqn[x] = *(const f32x4*)(TQ + cn * STRIDE + (x * 64 + lane) * 4);
#pragma unroll
        for (int tl = 0; tl < 4; ++tl) gmn[tl] = GM ? *(const f32x4*)(GM + cn * STRIDE + i * 64 + 16 * tl + 4 * g) : (f32x4){0.f, 0.f, 0.f, 0.f};
        f32x4 acc[4];
#pragma unroll
        for (int tp = 0; tp < 4; ++tp) acc[tp] = gm[tp];
#pragma unroll
        for (int tl = 0; tl < 4; ++tl)
#pragma unroll
            for (int r = 0; r < 4; ++r)
#pragma unroll
                for (int tp = 0; tp < 4; ++tp) acc[tp] = __builtin_amdgcn_mfma_f32_16x16x4f32(tq[tp * 4 + tl][r], st[tl][r], acc[tp], 0, 0, 0);
#pragma unroll
        for (int tl = 0; tl < 4; ++tl) st[tl] = acc[tl];
#pragma unroll
        for (int x = 0; x < 16; ++x) tq[x] = tqn[x];
#pragma unroll
        for (int tl = 0; tl < 4; ++tl) gm[tl] = gmn[tl];
    }
}
constexpr int CH_SLOT = 32768;
#define CH_LD(R, STEP) do { const int s_ = (STEP) < nsteps ? (STEP) : nsteps - 1; _Pragma("unroll") for (int k = 0; k < 4; ++k) { R[k] = *(const f32x4*)(TQ + (size_t)s_ * STRIDE + (k * 256 + ll) * 4); \
        R[4 + k] = GM ? *(const f32x4*)(GM + (size_t)s_ * STRIDE + (k * 256 + ll) * 4) : (f32x4){0.f, 0.f, 0.f, 0.f}; } } while (0)
#define CH_WR(R, SLOT) do { LAS float* d_ = (LAS float*)(lds + (SLOT) * CH_SLOT); _Pragma("unroll") for (int k = 0; k < 4; ++k) { *(LAS f32x4*)(d_ + (k * 256 + ll) * 4) = R[k]; *(LAS f32x4*)(d_ + 4096 + (k * 256 + ll) * 4) = R[4 + k]; } } while (0)
template <bool SCQ>
__device__ __forceinline__ void chain_block(f32x4 (&st)[4], const float* TQ, const float* GM, float* SC, int nsteps, LAS unsigned char* lds, int wave, int lane) {
    constexpr size_t STRIDE = (size_t)8 * 4096;
    if (wave >= 4) {
        const int ll = (wave - 4) * 64 + lane;
        f32x4 r0[8], r1[8], r2[8];
        CH_LD(r0, 0); CH_LD(r1, 1); CH_LD(r2, 2);
        CH_WR(r0, 0);
        __syncthreads();
        for (int c = 0; c < nsteps; c += 3) {
            CH_WR(r1, (c + 1) & 1); CH_LD(r0, c + 3); __syncthreads();
            if (c + 1 < nsteps) { CH_WR(r2, (c + 2) & 1); CH_LD(r1, c + 4); __syncthreads(); }
            if (c + 2 < nsteps) { CH_WR(r0, (c + 3) & 1); CH_LD(r2, c + 5); __syncthreads(); }
        }
    } else {
        const int fr = lane & 15, g = lane >> 4, i = wave * 16 + fr;
        __syncthreads();
        for (int c = 0; c < nsteps; ++c) {
            if (SC) {
                if (SCQ) {
#pragma unroll
                    for (int tl = 0; tl < 4; ++tl) *(f32x4*)(SC + c * STRIDE + ((((i >> 5) * 2 + (tl >> 1)) * 8 + 4 * (tl & 1) + g) * 32 + (i & 31)) * 4) = st[tl]; }
                else {
#pragma unroll
                    for (int tl = 0; tl < 4; ++tl) *(f32x4*)(SC + c * STRIDE + i * 64 + 16 * tl + 4 * g) = st[tl]; } }
            const LAS float* sl = (const LAS float*)(lds + (c & 1) * CH_SLOT);
            f32x4 acc[4];
#pragma unroll
            for (int tp = 0; tp < 4; ++tp) acc[tp] = *(const LAS f32x4*)(sl + 4096 + i * 64 + 16 * tp + 4 * g);
#pragma unroll
            for (int tl = 0; tl < 4; ++tl) { f32x4 tq[4];
#pragma unroll
                for (int tp = 0; tp < 4; ++tp) tq[tp] = *(const LAS f32x4*)(sl + ((tp * 4 + tl) * 64 + lane) * 4);
#pragma unroll
                for (int r = 0; r < 4; ++r)
#pragma unroll
                    for (int tp = 0; tp < 4; ++tp) acc[tp] = __builtin_amdgcn_mfma_f32_16x16x4f32(tq[tp][r], st[tl][r], acc[tp], 0, 0, 0); }
#pragma unroll
            for (int tl = 0; tl < 4; ++tl) st[tl] = acc[tl];
            __syncthreads();
        }
    }
}
__device__ __forceinline__ void rwkv_l1_block(KP p, int task, LAS unsigned char* lds, int wave, int lane) {
    const int kind = task & 1, h = (task >> 1) & 7, grp = task >> 4, iq = wave & 3;
    const int fr = lane & 15, g = lane >> 4, i = iq * 16 + fr;
    const size_t u0 = ((size_t)(grp * 16) * 8 + h) * 4096;
    f32x4 st[4];
#pragma unroll
    for (int tl = 0; tl < 4; ++tl)
#pragma unroll
        for (int r = 0; r < 4; ++r) st[tl][r] = (kind == 1 && i == 16 * tl + 4 * g + r) ? 1.f : 0.f;
    chain_block<false>(st, (const float*)(p->ws + WS_TQ) + u0, kind == 0 ? (const float*)(p->ws + WS_GM) + u0 : nullptr, nullptr, 16, lds, wave, lane);
    if (wave < 4) { const size_t gb = ((size_t)grp * 8 + h) * 4096;
        if (kind == 0) { float* GG = (float*)(p->ws + WS_GG) + gb;
#pragma unroll
            for (int tl = 0; tl < 4; ++tl) *(f32x4*)(GG + i * 64 + 16 * tl + 4 * g) = st[tl]; }
        else { float* TG = (float*)(p->ws + WS_TG) + gb;
#pragma unroll
            for (int tl = 0; tl < 4; ++tl)
#pragma unroll
                for (int r = 0; r < 4; ++r) TG[((tl * 4 + iq) * 64 + (fr >> 2) * 16 + 4 * g + r) * 4 + (fr & 3)] = st[tl][r]; } }
    __syncthreads();
}
__device__ __forceinline__ void rwkv_l2_block(KP p, int l, int h, LAS unsigned char* lds, int wave, int lane) {
    const int iq = wave & 3, fr = lane & 15, g = lane >> 4, i = iq * 16 + fr;
    f32x4 st[4];
#pragma unroll
    for (int tl = 0; tl < 4; ++tl) st[tl] = (f32x4){0.f, 0.f, 0.f, 0.f};
    chain_block<false>(st, (const float*)(p->ws + WS_TG) + (size_t)h * 4096, (const float*)(p->ws + WS_GG) + (size_t)h * 4096, (float*)(p->ws + WS_SG) + (size_t)h * 4096, 16, lds, wave, lane);
    if (wave < 4) { float* dst = p->out + O_PWKV + (((size_t)l * 8 + h) * 64 + i) * 64;
#pragma unroll
        for (int tl = 0; tl < 4; ++tl) *(f32x4*)(dst + 16 * tl + 4 * g) = st[tl]; }
    __syncthreads();
}
__device__ __forceinline__ void rwkv_l3_block(KP p, int l, int task, LAS unsigned char* lds, int wave, int lane) {
    const int h = task & 7, grp = task >> 3, iq = wave & 3, fr = lane & 15, g = lane >> 4, i = iq * 16 + fr;
    f32x4 st[4];
#pragma unroll
    for (int tl = 0; tl < 4; ++tl) st[tl] = (f32x4){0.f, 0.f, 0.f, 0.f};
    if (grp > 0) chain_block<false>(st, (const float*)(p->ws + WS_TG) + (size_t)h * 4096, (const float*)(p->ws + WS_GG) + (size_t)h * 4096, nullptr, grp, lds, wave, lane);
    const size_t u0 = ((size_t)(grp * 16) * 8 + h) * 4096;
    chain_block<true>(st, (const float*)(p->ws + WS_TQ) + u0, (const float*)(p->ws + WS_GM) + u0, (float*)(p->ws + WS_SC) + u0, 16, lds, wave, lane);
    if (grp == 15 && wave < 4) { float* dst = p->out + O_PWKV + (((size_t)l * 8 + h) * 64 + i) * 64;
#pragma unroll
        for (int tl = 0; tl < 4; ++tl) *(f32x4*)(dst + 16 * tl + 4 * g) = st[tl]; }
    __syncthreads();
}
__device__ __forceinline__ void rwkv_samp_task(KP p, int l, int t2, int lane) {
    const int fr = lane & 15, g = lane >> 4, iq = t2 & 3, h = (t2 >> 2) & 7, b = t2 >> 5, i = iq * 16 + fr;
    f32x4 st[4];
    const float* s0 = p->in[I_SWKV] + ((((size_t)l * 32 + b) * 8 + h) * 64 + i) * 64;
#pragma unroll
    for (int tl = 0; tl < 4; ++tl) st[tl] = *(const f32x4*)(s0 + 16 * tl + 4 * g);
    const size_t u0 = ((size_t)(256 + b) * 8 + h) * 4096;
    chain_run<true>(st, (const float*)(p->ws + WS_TQ) + u0, (const float*)(p->ws + WS_GM) + u0, (float*)(p->ws + WS_SC) + u0, 1, i, g, lane);
    float* dst = p->out + O_SWKV + ((((size_t)l * 32 + b) * 8 + h) * 64 + i) * 64;
#pragma unroll
    for (int tl = 0; tl < 4; ++tl) *(f32x4*)(dst + 16 * tl + 4 * g) = st[tl];
}
__device__ __forceinline__ void rwkv_r3_task(KP p, int l, int task, LAS unsigned char* lds, int wave, int lane) {
    const int unit = task >> 1, th = task & 1, cu = unit >> 3, h = unit & 7, li = lane & 31, hi = lane >> 5;
    const RwkvSeqInfo si = rwkv_info(cu);
    if (th * 32 >= si.ntok) return;
    const bf16_t* U = (const bf16_t*)(p->ws + WS_U);
    const size_t ub = (size_t)unit * 4096; const int t = th * 32 + li;
    const float* SC = (const float*)(p->ws + WS_SC) + ub; const float* ET = (const float*)(p->ws + WS_ET) + ub; const float* Y0T = (const float*)(p->ws + WS_Y0T) + ub;
    f32x16 acc[2];
#pragma unroll
    for (int ti = 0; ti < 2; ++ti)
#pragma unroll
        for (int rg = 0; rg < 4; ++rg) { const f32x4 y0 = *(const f32x4*)(Y0T + ((((th * 2 + ti) * 4 + rg) * 2 + hi) * 32 + li) * 4);
#pragma unroll
            for (int e = 0; e < 4; ++e) acc[ti][rg * 4 + e] = y0[e]; }
    f32x4 eb[8], sa0[8], sa1[8];
#pragma unroll
    for (int s4 = 0; s4 < 8; ++s4) { eb[s4] = *(const f32x4*)(ET + (((th * 2 + hi) * 8 + s4) * 32 + li) * 4); sa0[s4] = *(const f32x4*)(SC + (((0 * 2 + hi) * 8 + s4) * 32 + li) * 4); sa1[s4] = *(const f32x4*)(SC + (((1 * 2 + hi) * 8 + s4) * 32 + li) * 4); }
#pragma unroll
    for (int ks = 0; ks < 4; ++ks) {
        const bf16x8 bfr = pack8f(eb[2 * ks], eb[2 * ks + 1]);
        acc[0] = __builtin_amdgcn_mfma_f32_32x32x16_bf16(pack8f(sa0[2 * ks], sa0[2 * ks + 1]), bfr, acc[0], 0, 0, 0);
        acc[1] = __builtin_amdgcn_mfma_f32_32x32x16_bf16(pack8f(sa1[2 * ks], sa1[2 * ks + 1]), bfr, acc[1], 0, 0, 0);
    }
    float s1 = 0.f;
#pragma unroll
    for (int ti = 0; ti < 2; ++ti)
#pragma unroll
        for (int r = 0; r < 16; ++r) s1 += acc[ti][r];
    s1 = xhalf_sum(s1); const float mean = s1 * (1.f / 64.f);
    float s2 = 0.f;
#pragma unroll
    for (int ti = 0; ti < 2; ++ti)
#pragma unroll
        for (int r = 0; r < 16; ++r) { const float d = acc[ti][r] - mean; s2 += d * d; }
    s2 = xhalf_sum(s2); const float rstd = 1.f / sqrtf(s2 * (1.f / 64.f) + 64e-5f);
    LAS bf16_t* stg = (LAS bf16_t*)(lds + wave * (3 * 32 * 72 * 2));
    { const int tr = lane >> 3, c8 = (lane & 7) * 8;
#pragma unroll
      for (int i = 0; i < 4; ++i) { const int tt = 8 * i + tr, tg = th * 32 + tt, tc = tg < si.ntok ? tg : si.ntok - 1; const size_t rw = (size_t)(si.row0 + tc);
          const size_t rp = (tc > 0 || si.prev_kind == 1) ? rw - 1 : rw;
          const u32x4 a0 = *(const u32x4*)(U + rw * NU + U_XC + 1024 + h * 64 + c8), a1 = *(const u32x4*)(U + rp * NU + U_XC + 1024 + h * 64 + c8), a2 = *(const u32x4*)(U + rw * NU + U_CSG + h * 64 + c8);
          *(LAS u32x4*)(stg + tt * 72 + c8) = a0; *(LAS u32x4*)(stg + (32 + tt) * 72 + c8) = a1; *(LAS u32x4*)(stg + (64 + tt) * 72 + c8) = a2; } }
    if (t >= si.ntok) return;
    const float bon = ((const float*)(p->ws + WS_BONUS))[(size_t)unit * 64 + t];
    const size_t row = (size_t)(si.row0 + t);
    bf16_t* oc = (bf16_t*)(p->ws + WS_OCAT) + (size_t)2 * NTOK * 512 + row * 512 + h * 64;
    u32x2 wout[2][4];
#pragma unroll
    for (int ti = 0; ti < 2; ++ti)
#pragma unroll
        for (int rg = 0; rg < 4; ++rg) { const int i = 32 * ti + 8 * rg + 4 * hi, c = h * 64 + i;
            const f32x4 gg = *(const f32x4*)(p->in[I_GNG] + l * 512 + c), gb = *(const f32x4*)(p->in[I_GNB] + l * 512 + c), mu = *(const f32x4*)(p->in[I_MU] + l * SHIFT_W + 1024 + c);
            const u32x2 vx = *(const LAS u32x2*)(stg + li * 72 + i), px = *(const LAS u32x2*)(stg + (32 + li) * 72 + i), sg = *(const LAS u32x2*)(stg + (64 + li) * 72 + i);
            f32x4 vc = (f32x4){bflo(vx.x), bfhi(vx.x), bflo(vx.y), bfhi(vx.y)}, vp = (f32x4){bflo(px.x), bfhi(px.x), bflo(px.y), bfhi(px.y)};
            if (t == 0 && si.prev_kind != 1) { if (si.prev_kind == 2) vp = *(const f32x4*)(p->in[I_SSHIFT] + ((size_t)l * 32 + si.b) * SHIFT_W + 1024 + c); else vp = (f32x4){0.f, 0.f, 0.f, 0.f}; }
            const f32x4 vs = vc + (vp - vc) * mu;
            const f32x4 sgf = (f32x4){bflo(sg.x), bfhi(sg.x), bflo(sg.y), bfhi(sg.y)};
            f32x4 o;
#pragma unroll
            for (int e = 0; e < 4; ++e) o[e] = (((acc[ti][rg * 4 + e] - mean) * rstd) * gg[e] + gb[e] + bon * vs[e]) * siluf_(sgf[e]);
            wout[ti][rg].x = cvt_pk_bf16(o[0], o[1]); wout[ti][rg].y = cvt_pk_bf16(o[2], o[3]); }
#pragma unroll
    for (int ti = 0; ti < 2; ++ti)
#pragma unroll
        for (int rg = 0; rg < 4; ++rg) *(u32x2*)(oc + 32 * ti + 8 * rg + 4 * hi) = wout[ti][rg];
}
__device__ __forceinline__ int krow(int i) { return (i & 3) + 4 * ((i >> 3) & 1) + 8 * ((i >> 2) & 1) + 16 * (i >> 4); }
__device__ __forceinline__ bf16x8 pack8(const f32x16& v, int o) { u32x4 w; w.x = cvt_pk_bf16(v[o], v[o + 1]); w.y = cvt_pk_bf16(v[o + 2], v[o + 3]); w.z = cvt_pk_bf16(v[o + 4], v[o + 5]); w.w = cvt_pk_bf16(v[o + 6], v[o + 7]); return __builtin_bit_cast(bf16x8, w); }
constexpr float ATT_NEG = -1e30f;
template <bool HALF>
__device__ __forceinline__ void softmax_tile(f32x16& p0, f32x16& p1, float& m, float& lsum, f32x16 (&O)[2], bf16x8 (&pb)[4]) {
    float mx = p0[0];
#pragma unroll
    for (int r = 1; r < 16; ++r) mx = fmaxf(mx, p0[r]);
    if (!HALF) {
#pragma unroll
        for (int r = 0; r < 16; ++r) mx = fmaxf(mx, p1[r]); }
    mx = xhalf_max(mx);
    const float mn = fmaxf(m, mx), alpha = __builtin_amdgcn_exp2f(m - mn);
    m = mn;
    float s = 0.f;
#pragma unroll
    for (int r = 0; r < 16; ++r) { p0[r] = __builtin_amdgcn_exp2f(p0[r] - mn); s += p0[r]; }
    if (!HALF) {
#pragma unroll
        for (int r = 0; r < 16; ++r) { p1[r] = __builtin_amdgcn_exp2f(p1[r] - mn); s += p1[r]; } }
    lsum = lsum * alpha + s;
#pragma unroll
    for (int r = 0; r < 16; ++r) { O[0][r] *= alpha; O[1][r] *= alpha; }
    pb[0] = pack8(p0, 0); pb[1] = pack8(p0, 8);
    if (!HALF) { pb[2] = pack8(p1, 0); pb[3] = pack8(p1, 8); }
}
constexpr int AKS = 72;
constexpr int ATT_KB = 0, ATT_VB = 2 * 64 * AKS * 2, ATT_FB = 4 * 64 * AKS * 2, ATT_SC = ATT_FB + 2 * 64 * 4;
__device__ __forceinline__ void attn_prompt_unit(KP p, int l, int h, int qb, LAS unsigned char* lds, int tid) {
    const bf16_t* U = (const bf16_t*)(p->ws + WS_U); const bf16_t* Vt = (const bf16_t*)(p->ws + WS_VT) + (size_t)h * 64 * TP; const float* F = (const float*)(p->ws + WS_FP) + (size_t)h * TP;
    const int wave = tid >> 6, lane = tid & 63, li = lane & 31, hi = lane >> 5;
    const int q0 = qb * 256, q = q0 + wave * 32 + li;
    bf16x8 qf[4];
    { const float sc = 0.125f * LOG2E;
#pragma unroll
      for (int d0 = 0; d0 < 4; ++d0) { const u32x4 w = *(const u32x4*)(U + (size_t)q * NU + U_Q + h * 64 + 16 * d0 + 8 * hi);
          qf[d0] = pack8f((f32x4){bflo(w.x) * sc, bfhi(w.x) * sc, bflo(w.y) * sc, bfhi(w.y) * sc}, (f32x4){bflo(w.z) * sc, bfhi(w.z) * sc, bflo(w.w) * sc, bfhi(w.w) * sc}); } }
    const float fq = F[q];
    float m = ATT_NEG, lsum = 0.f; f32x16 O[2] = {};
    const int NT = (q0 + 256) / 64;
    LAS float* qmx = (LAS float*)(lds + ATT_SC); LAS float* mmv = qmx + 8;
    { float q2 = 0.f;
#pragma unroll
      for (int d0 = 0; d0 < 4; ++d0) { const u32x4 w = __builtin_bit_cast(u32x4, qf[d0]); q2 += bflo(w.x) * bflo(w.x) + bfhi(w.x) * bfhi(w.x) + bflo(w.y) * bflo(w.y) + bfhi(w.y) * bfhi(w.y) + bflo(w.z) * bflo(w.z) + bfhi(w.z) * bfhi(w.z) + bflo(w.w) * bflo(w.w) + bfhi(w.w) * bfhi(w.w); }
      q2 = wave_max(xhalf_sum(q2)); if (lane == 0) { qmx[wave] = q2; mmv[wave] = ATT_NEG; } }
    const float kmax2 = __uint_as_float(((const unsigned*)(p->ws + WS_CTL))[CW_KMAX + l * 8 + h]), fq0 = F[q0];
    const int srow = tid >> 3, sch = tid & 7;
    const bf16_t* kg = U + (size_t)srow * NU + U_K + h * 64 + 8 * sch; const bf16_t* vg = Vt + (size_t)srow * TP + 8 * sch;
    LAS unsigned char* kdst = lds + ATT_KB + (srow * AKS + 8 * sch) * 2; LAS unsigned char* vdst = lds + ATT_VB + (srow * AKS + 8 * sch) * 2;
    u32x4 kr = *(const u32x4*)(kg + (size_t)(NT - 1) * 64 * NU), vr = *(const u32x4*)(vg + (NT - 1) * 64); float fr = tid < 64 ? F[(NT - 1) * 64 + tid] : 0.f;
    *(LAS u32x4*)kdst = kr; *(LAS u32x4*)vdst = vr; if (tid < 64) ((LAS float*)(lds + ATT_FB))[tid] = fr;
    __syncthreads();
    const int ka = krow(li);
    float qkb; { float q2 = qmx[0];
#pragma unroll
      for (int w = 1; w < 8; ++w) q2 = fmaxf(q2, qmx[w]);
      qkb = 1.02f * sqrtf(q2 * kmax2) + fq0; }
    for (int t = NT - 1, buf = 0; t >= 0; --t, buf ^= 1) {
        { float mmin = mmv[0];
#pragma unroll
          for (int w = 1; w < 8; ++w) mmin = fminf(mmin, mmv[w]);
          if (qkb - ((const LAS float*)(lds + ATT_FB))[buf * 64 + 63] < mmin - 40.f) break; }
        if (t > 0) { kr = *(const u32x4*)(kg + (size_t)(t - 1) * 64 * NU); vr = *(const u32x4*)(vg + (t - 1) * 64); if (tid < 64) fr = F[(t - 1) * 64 + tid]; }
        if (64 * t <= q0 + wave * 32 + 31) {
            const LAS bf16_t* Kb = (const LAS bf16_t*)(lds + ATT_KB) + buf * 64 * AKS; const LAS bf16_t* Vb = (const LAS bf16_t*)(lds + ATT_VB) + buf * 64 * AKS; const LAS float* Fb = (const LAS float*)(lds + ATT_FB) + buf * 64;
            f32x16 p0, p1;
#pragma unroll
            for (int g2 = 0; g2 < 2; ++g2) { const f32x4 a = *(const LAS f32x4*)(Fb + 8 * hi + 16 * g2), b = *(const LAS f32x4*)(Fb + 8 * hi + 16 * g2 + 4), c = *(const LAS f32x4*)(Fb + 32 + 8 * hi + 16 * g2), d = *(const LAS f32x4*)(Fb + 32 + 8 * hi + 16 * g2 + 4);
#pragma unroll
                for (int e = 0; e < 4; ++e) { p0[8 * g2 + e] = fq - a[e]; p0[8 * g2 + 4 + e] = fq - b[e]; p1[8 * g2 + e] = fq - c[e]; p1[8 * g2 + 4 + e] = fq - d[e]; } }
#pragma unroll
            for (int d0 = 0; d0 < 4; ++d0) { const bf16x8 a0 = *(const LAS bf16x8*)(Kb + ka * AKS + 16 * d0 + 8 * hi), a1 = *(const LAS bf16x8*)(Kb + (ka + 32) * AKS + 16 * d0 + 8 * hi);
                p0 = __builtin_amdgcn_mfma_f32_32x32x16_bf16(a0, qf[d0], p0, 0, 0, 0); p1 = __builtin_amdgcn_mfma_f32_32x32x16_bf16(a1, qf[d0], p1, 0, 0, 0); }
            if (64 * t + 63 > q0 + wave * 32) {
#pragma unroll
                for (int r = 0; r < 16; ++r) { const int kv = 64 * t + 8 * hi + 16 * (r >> 3) + (r & 7); if (kv > q) p0[r] = -INFINITY; if (kv + 32 > q) p1[r] = -INFINITY; } }
            bf16x8 pb[4];
            softmax_tile<false>(p0, p1, m, lsum, O, pb);
#pragma unroll
            for (int dt = 0; dt < 2; ++dt)
#pragma unroll
                for (int s = 0; s < 4; ++s) { const bf16x8 a = *(const LAS bf16x8*)(Vb + (32 * dt + li) * AKS + 16 * (s & 1) + 32 * (s >> 1) + 8 * hi);
                    O[dt] = __builtin_amdgcn_mfma_f32_32x32x16_bf16(a, pb[s], O[dt], 0, 0, 0); }
        }
        { const float wm = wave_min(m); if (lane == 0) mmv[wave] = wm; }
        if (t > 0) { const int nb = buf ^ 1; *(LAS u32x4*)(kdst + nb * 64 * AKS * 2) = kr; *(LAS u32x4*)(vdst + nb * 64 * AKS * 2) = vr; if (tid < 64) ((LAS float*)(lds + ATT_FB))[nb * 64 + tid] = fr; }
        __syncthreads();
    }
    __syncthreads();
    const float inv = 1.f / xhalf_sum(lsum);
    bf16_t* ob = (bf16_t*)(p->ws + WS_OCAT) + (size_t)1 * NTOK * 512 + (size_t)q * 512 + h * 64;
    u32x2 sgv[2][4];
#pragma unroll
    for (int dt = 0; dt < 2; ++dt)
#pragma unroll
        for (int rg = 0; rg < 4; ++rg) sgv[dt][rg] = *(const u32x2*)(U + (size_t)q * NU + U_BSG + h * 64 + 32 * dt + 8 * rg + 4 * hi);
#pragma unroll
    for (int dt = 0; dt < 2; ++dt)
#pragma unroll
        for (int rg = 0; rg < 4; ++rg) { const int d = 32 * dt + 8 * rg + 4 * hi; const u32x2 sg = sgv[dt][rg];
            u32x2 w; w.x = cvt_pk_bf16(O[dt][rg * 4] * inv * siluf_(bflo(sg.x)), O[dt][rg * 4 + 1] * inv * siluf_(bfhi(sg.x))); w.y = cvt_pk_bf16(O[dt][rg * 4 + 2] * inv * siluf_(bflo(sg.y)), O[dt][rg * 4 + 3] * inv * siluf_(bfhi(sg.y)));
            *(u32x2*)(ob + d) = w; }
}
__device__ __forceinline__ void attn_sample_unit(KP p, int l, int b, int h, LAS unsigned char* lds, int tid) {
    const bf16_t* U = (const bf16_t*)(p->ws + WS_U);
    const int wave = tid >> 6, lane = tid & 63, li = lane & 31, hi = lane >> 5;
    const size_t qrow = (size_t)TP + b * 32 + li;
    const float* G = (const float*)(p->ws + WS_GS) + ((size_t)b * 8 + h) * GS_LEN;
    bf16x8 qf[4];
    { const float sc = 0.125f * LOG2E;
#pragma unroll
      for (int d0 = 0; d0 < 4; ++d0) { const u32x4 w = *(const u32x4*)(U + qrow * NU + U_Q + h * 64 + 16 * d0 + 8 * hi);
          qf[d0] = pack8f((f32x4){bflo(w.x) * sc, bfhi(w.x) * sc, bflo(w.y) * sc, bfhi(w.y) * sc}, (f32x4){bflo(w.z) * sc, bfhi(w.z) * sc, bflo(w.w) * sc, bfhi(w.w) * sc}); } }
    const float fq = G[PAST + li];
    float m = ATT_NEG, lsum = 0.f; f32x16 O[2] = {};
    const float* CK = p->in[I_CK] + (((size_t)l * 32 + b) * PAST) * 512 + h * 64; const float* CV = p->in[I_CV] + (((size_t)l * 32 + b) * PAST) * 512 + h * 64;
    const int ka = krow(li);
    float kmax2;
    { float mx = 0.f; const f32x4* kp4 = (const f32x4*)CK + (tid & 15);
#pragma unroll 1
      for (int it = 0; it < 8; ++it) { f32x4 kv[16];
#pragma unroll
          for (int j = 0; j < 16; ++j) kv[j] = kp4[(size_t)((it * 16 + j) * 32 + (tid >> 4)) * 128];
#pragma unroll
          for (int j = 0; j < 16; ++j) { float s = kv[j][0] * kv[j][0] + kv[j][1] * kv[j][1] + kv[j][2] * kv[j][2] + kv[j][3] * kv[j][3];
              s += dpp_mov<0xB1>(s); s += dpp_mov<0x4E>(s); s += dpp_mov<0x141>(s); s += dpp_mov<0x140>(s); mx = fmaxf(mx, s); } }
      mx = wave_max(mx); LAS float* kml = (LAS float*)lds;
      if (lane == 0) kml[wave] = mx;
      __syncthreads();
      kmax2 = kml[0];
#pragma unroll
      for (int w = 1; w < 8; ++w) kmax2 = fmaxf(kmax2, kml[w]);
      __syncthreads(); }
    float qkb;
    { float q2 = 0.f;
#pragma unroll
      for (int d0 = 0; d0 < 4; ++d0) { const u32x4 w = __builtin_bit_cast(u32x4, qf[d0]); q2 += bflo(w.x) * bflo(w.x) + bfhi(w.x) * bfhi(w.x) + bflo(w.y) * bflo(w.y) + bfhi(w.y) * bfhi(w.y) + bflo(w.z) * bflo(w.z) + bfhi(w.z) * bfhi(w.z) + bflo(w.w) * bflo(w.w) + bfhi(w.w) * bfhi(w.w); }
      q2 = wave_max(xhalf_sum(q2)); qkb = 1.02f * sqrtf(q2 * kmax2) + G[PAST]; }
    {
        f32x16 p0, p1 = {};
#pragma unroll
        for (int g2 = 0; g2 < 2; ++g2) { const float* gp = G + PAST + 8 * hi + 16 * g2; const f32x4 a = *(const f32x4*)gp, bq = *(const f32x4*)(gp + 4);
#pragma unroll
            for (int e = 0; e < 4; ++e) { p0[8 * g2 + e] = fq - a[e]; p0[8 * g2 + 4 + e] = fq - bq[e]; } }
#pragma unroll
        for (int d0 = 0; d0 < 4; ++d0) { const bf16x8 a0 = *(const bf16x8*)(U + ((size_t)TP + b * 32 + ka) * NU + U_K + h * 64 + 16 * d0 + 8 * hi);
            p0 = __builtin_amdgcn_mfma_f32_32x32x16_bf16(a0, qf[d0], p0, 0, 0, 0); }
#pragma unroll
        for (int r = 0; r < 16; ++r) { const int kv = 8 * hi + 16 * (r >> 3) + (r & 7); if (kv > li) p0[r] = -INFINITY; }
        bf16x8 pb[4];
        softmax_tile<true>(p0, p1, m, lsum, O, pb);
        if (wave == 7) {
#pragma unroll
            for (int dt = 0; dt < 2; ++dt)
#pragma unroll
                for (int s = 0; s < 2; ++s) { const bf16_t* vp = U + ((size_t)TP + b * 32 + 16 * s + 8 * hi) * NU + U_V + h * 64 + 32 * dt + li; u32x4 w;
                    w.x = (unsigned)vp[0] | ((unsigned)vp[NU] << 16); w.y = (unsigned)vp[2 * NU] | ((unsigned)vp[3 * NU] << 16); w.z = (unsigned)vp[4 * NU] | ((unsigned)vp[5 * NU] << 16); w.w = (unsigned)vp[6 * NU] | ((unsigned)vp[7 * NU] << 16);
                    O[dt] = __builtin_amdgcn_mfma_f32_32x32x16_bf16(__builtin_bit_cast(bf16x8, w), pb[s], O[dt], 0, 0, 0); } }
        else lsum = 0.f;
    }
    const float mmin = wave_min(m);
    for (int tt = 0; tt < 8; ++tt) {
        const int key0 = (63 - wave - 8 * tt) * 64;
        if (qkb - G[key0 + 63] < mmin - 40.f) break;
        f32x16 p0, p1;
#pragma unroll
        for (int g2 = 0; g2 < 2; ++g2) { const float* gp = G + key0 + 8 * hi + 16 * g2; const f32x4 a = *(const f32x4*)gp, bq = *(const f32x4*)(gp + 4), c = *(const f32x4*)(gp + 32), d = *(const f32x4*)(gp + 36);
#pragma unroll
            for (int e = 0; e < 4; ++e) { p0[8 * g2 + e] = fq - a[e]; p0[8 * g2 + 4 + e] = fq - bq[e]; p1[8 * g2 + e] = fq - c[e]; p1[8 * g2 + 4 + e] = fq - d[e]; } }
#pragma unroll
        for (int d0 = 0; d0 < 4; ++d0) { const float* k0p = CK + (size_t)(key0 + ka) * 512 + 16 * d0 + 8 * hi; const float* k1p = k0p + (size_t)32 * 512;
            const bf16x8 a0 = pack8f(*(const f32x4*)k0p, *(const f32x4*)(k0p + 4)), a1 = pack8f(*(const f32x4*)k1p, *(const f32x4*)(k1p + 4));
            p0 = __builtin_amdgcn_mfma_f32_32x32x16_bf16(a0, qf[d0], p0, 0, 0, 0); p1 = __builtin_amdgcn_mfma_f32_32x32x16_bf16(a1, qf[d0], p1, 0, 0, 0); }
        bf16x8 pb[4];
        softmax_tile<false>(p0, p1, m, lsum, O, pb);
#pragma unroll
        for (int dt = 0; dt < 2; ++dt)
#pragma unroll
            for (int s = 0; s < 4; ++s) { const float* vp = CV + (size_t)(key0 + 16 * (s & 1) + 32 * (s >> 1) + 8 * hi) * 512 + 32 * dt + li;
                const bf16x8 a = pack8f((f32x4){vp[0], vp[512], vp[1024], vp[1536]}, (f32x4){vp[2048], vp[2560], vp[3072], vp[3584]});
                O[dt] = __builtin_amdgcn_mfma_f32_32x32x16_bf16(a, pb[s], O[dt], 0, 0, 0); }
    }
    LAS float* Ow = (LAS float*)lds;
    LAS float* ML = Ow + 8 * 32 * 64;
    lsum = xhalf_sum(lsum);
#pragma unroll
    for (int dt = 0; dt < 2; ++dt)
#pragma unroll
        for (int r = 0; r < 16; ++r) Ow[(wave * 32 + dt * 16 + r) * 64 + lane] = O[dt][r];
    if (hi == 0) { ML[(wave * 2) * 32 + li] = m; ML[(wave * 2 + 1) * 32 + li] = lsum; }
    __syncthreads();
    { const int qq = tid & 31, dg = tid >> 5; float M = ATT_NEG;
#pragma unroll
      for (int w = 0; w < 8; ++w) M = fmaxf(M, ML[(w * 2) * 32 + qq]);
      float L = 0.f; f32x4 o = {0.f, 0.f, 0.f, 0.f};
      const int d = 4 * dg, idx0 = (d >> 5) * 16 + ((d >> 3) & 3) * 4, ln = ((d >> 2) & 1) * 32 + qq;
#pragma unroll
      for (int w = 0; w < 8; ++w) { const float f = __builtin_amdgcn_exp2f(ML[(w * 2) * 32 + qq] - M); L += ML[(w * 2 + 1) * 32 + qq] * f;
#pragma unroll
          for (int e = 0; e < 4; ++e) o[e] += Ow[(w * 32 + idx0 + e) * 64 + ln] * f; }
      const float inv = 1.f / L; const size_t row = (size_t)TP + b * 32 + qq;
      const u32x2 sg = *(const u32x2*)(U + row * NU + U_BSG + h * 64 + d);
      u32x2 wv; wv.x = cvt_pk_bf16(o[0] * inv * siluf_(bflo(sg.x)), o[1] * inv * siluf_(bfhi(sg.x))); wv.y = cvt_pk_bf16(o[2] * inv * siluf_(bflo(sg.y)), o[3] * inv * siluf_(bfhi(sg.y)));
      *(u32x2*)((bf16_t*)(p->ws + WS_OCAT) + (size_t)1 * NTOK * 512 + row * 512 + h * 64 + d) = wv; }
    __syncthreads();
}
__device__ __forceinline__ bool xb_lane0() { unsigned ones_ = ~0u; asm volatile("" : "+s"(ones_)); return __builtin_amdgcn_mbcnt_hi(ones_, __builtin_amdgcn_mbcnt_lo(ones_, 0u)) == 0u; }
constexpr int NPHASE = 20;
__global__ void __launch_bounds__(512, 2) hse_fwd(Params p_) {
    const KP kp = (KP)__builtin_amdgcn_kernarg_segment_ptr();
    (void)p_;
    extern __shared__ __attribute__((aligned(16))) unsigned char lds_raw[];
    LAS unsigned char* lds = (LAS unsigned char*)lds_raw;
    const int tid0 = threadIdx.x;
    const int wave0 = __builtin_amdgcn_readfirstlane(tid0 >> 6);
    const int G = gridDim.x, bid = blockIdx.x, ngw = G * 8;
#define PH_LOCALS const KP p = kp_fresh(kp); unsigned ones_ = ~0u; asm volatile("" : "+s"(ones_)); int tid = wave0 * 64 + (int)__builtin_amdgcn_mbcnt_hi(ones_, __builtin_amdgcn_mbcnt_lo(ones_, 0u)); asm volatile("" : "+v"(tid)); const int lane = tid & 63, wave = __builtin_amdgcn_readfirstlane(tid >> 6), gw = bid * 8 + wave; (void)lane; (void)gw; (void)p;
    if (tid0 < 4) ((LAS unsigned*)(lds + LDS_XB_OFF))[tid0] = 0u;
#if PROBE_ID
    if (tid0 == 0) *(LAS unsigned long long*)(lds + LDS_PROBE_OFF) = 0ull;
#endif
    __syncthreads();
    unsigned* ctl = (unsigned*)(kp->ws + WS_CTL);
    XcdBarrier bar = xcd_barrier_post(ctl + CW_BAR + kp->li * XCD_BAR_WORDS, (volatile LAS unsigned*)(lds + LDS_XB_OFF));
    const int lo = kp->ph_lo, hi = kp->ph_hi;
#define IN(k) (lo <= (k) && (k) < hi)
#ifndef DUP_MASK
#define DUP_MASK 0
#endif
#define NREP(k) (((DUP_MASK >> (k)) & 1) + 1)
#define XB_T0 (wave0 == 0 && xb_lane0())
#define SEAM(k) do { if (IN(k) && IN((k) + 1)) xcd_barrier(bar, XB_T0); } while (0)
    PT0();
    if (IN(0)) { PH_LOCALS
        { PT0(); for (int u = bid; u < 192; u += G) ada_unit(p, u, lds, tid);
        PT1(60);
        p0_weights(p, lds, gw, ngw, wave, lane);
        PT1(61); }
    }
    SEAM(0);
    PT1(9);
    for (int l = 0; l < NLAYER; ++l) {
        const int pb = 1 + 9 * l;
        for (int rep = 0; rep < NREP(0); ++rep) { if (rep) xcd_barrier(bar, XB_T0);
        if (IN(pb)) { PH_LOCALS p1_rows(p, l, gw, ngw, lane); } }
        SEAM(pb);
        PT1(10);
        for (int rep = 0; rep < NREP(1); ++rep) { if (rep) xcd_barrier(bar, XB_T0);
        if (IN(pb + 1)) { PH_LOCALS
            pg8::Gemm g{(const bf16_t*)(p->ws + WS_H), (const bf16_t*)(p->ws + WS_WIN) + (size_t)l * NU * LDH, NTOK, NU, 2048, LDH};
            pg8::StaticOrder S; S.init(NTOK, NU, G, bid);
            EpiU E{(bf16_t*)(p->ws + WS_U), p->out, p->in[I_BF], l};
            pg8::gemm_phase<EpiU, pg8::StaticOrder>(lds, g, S, E, nullptr, tid);
        }
        }
        SEAM(pb + 1);
        PT1(11);
        for (int rep = 0; rep < NREP(2); ++rep) { if (rep) xcd_barrier(bar, XB_T0);
        if (IN(pb + 2)) { PH_LOCALS
#ifndef DUP_SUB
#define DUP_SUB 0
#endif
            { PT0();
            { PH_LOCALS for (int u = bid; u < NRU * ((DUP_SUB & 1) + 1); u += G) rwkv_r1(p, l, u % NRU, u + G, lds, tid); }
            PT1(31);
            for (int u = (bid + G - 32) % G; u < 544 * (((DUP_SUB >> 1) & 1) + 1); u += G) conv_unit(p, l, u % 544, lds, tid);
            PT1(32);
            for (int u = (bid + G - 64) % G; u < 544 * (((DUP_SUB >> 2) & 1) + 1); u += G) pool_unit(p, l, u % 544, lds, tid);
            PT1(33);
            for (int u = bid; u < 256; u += G) { vt_tile(p, l, u * 8 + wave, lds, wave, lane); }
            __syncthreads();
            for (int u = (bid + G - 96) % G; u < 32; u += G) gs_unit(p, l, u, lds, tid);
            for (int u = G - 1 - bid; u < 8; u += G) fp_unit(p, l, u, lds, tid);
            if (bid == G / 2) shift_out(p, l, tid);
            PT1(34); }
        }
        }
        SEAM(pb + 2);
        PT1(12);
        for (int rep = 0; rep < NREP(3); ++rep) { if (rep) xcd_barrier(bar, XB_T0);
        if (IN(pb + 3)) { PH_LOCALS
            PT0();
            for (int tk = bid; tk < 256; tk += G) rwkv_l1_block(p, tk, lds, wave, lane);
            PT1(70);
            LAS int* qslot = (LAS int*)(lds + LDS_XB_OFF - 16);
            for (;;) {
                if (tid == 0) *qslot = (int)atomicAdd(ctl + CW_QUEUE + 64 * (2 * l + 4 * rep), 1u);
                __syncthreads();
                const int item = *qslot;
                __syncthreads();
                if (item >= 512) break;
                attn_prompt_unit(p, l, item & 7, 63 - (item >> 3), lds, tid);
            }
            PT1(71);
            for (;;) {
                if (tid == 0) *qslot = (int)atomicAdd(ctl + CW_QUEUE + 64 * (2 * l + 1 + 4 * rep), 1u);
                __syncthreads();
                const int item = *qslot;
                __syncthreads();
                if (item >= 256) break;
                attn_sample_unit(p, l, item >> 3, item & 7, lds, tid);
            }
            PT1(72);
        }
        }
        SEAM(pb + 3);
        PT1(13);
        if (IN(pb + 4)) { PH_LOCALS
            for (int tk = bid; tk < 128; tk += G) rwkv_l3_block(p, l, 127 - tk, lds, wave, lane);
            for (int tk = ((bid + G - 128) % G) * 8 + wave; tk < 1024; tk += ngw) rwkv_samp_task(p, l, tk, lane);
        }
        SEAM(pb + 4);
        PT1(14);
        if (IN(pb + 5)) { PH_LOCALS for (int tk = gw; tk < NRU * 2; tk += ngw) rwkv_r3_task(p, l, tk, lds, wave, lane); }
        SEAM(pb + 5);
        PT1(15);
        for (int rep = 0; rep < NREP(6); ++rep) { if (rep) xcd_barrier(bar, XB_T0);
        if (IN(pb + 6)) { PH_LOCALS
            pg8::Gemm g{(const bf16_t*)(p->ws + WS_OCAT), (const bf16_t*)(p->ws + WS_WBR) + (size_t)l * 4 * 2048 * 512, 4 * NTOK, 4 * 2048, 512, 512};
            BranchOrder S{G, (G % 8 == 0) ? (bid % 8) * (G / 8) + bid / 8 : bid};
            EpiZ E{(bf16_t*)(p->ws + WS_Z), (const bf16_t*)(p->ws + WS_U)};
            pg8::gemm_phase<EpiZ, BranchOrder>(lds, g, S, E, nullptr, tid);
        }
        }
        SEAM(pb + 6);
        PT1(16);
        if (IN(pb + 7)) { PH_LOCALS merge_pass(p, l, bid * 512 + tid, G * 512); }
        SEAM(pb + 7);
        PT1(17);
        if (IN(pb + 8)) { PH_LOCALS
            {
                pg8::Gemm g{(const bf16_t*)(p->ws + WS_MERGED), (const bf16_t*)(p->ws + WS_WOUT) + (size_t)l * 2048 * LDH, TP, 2048, 2048, LDH};
                pg8::StaticOrder S; S.init(TP, 2048, G, bid);
                EpiOut E{p->in[I_XP], p->in[I_XS], (const float*)(p->ws + WS_XBUF), (const float*)(p->ws + WS_ADA), (float*)(p->ws + WS_XBUF), l};
                pg8::gemm_phase<EpiOut, pg8::StaticOrder>(lds, g, S, E, nullptr, tid); }
            {
                const int tile = bid >> 3, ks = bid & 7;
                pg8::Gemm g{(const bf16_t*)(p->ws + WS_MERGED) + ks * 256, (const bf16_t*)(p->ws + WS_WOUT) + (size_t)l * 2048 * LDH + ks * 256, NTOK, 2048, 256, LDH};
                OneUnit S{64 + (tile >> 3), tile & 7, bid < 256};
                EpiOutPart E{(const float*)(p->ws + WS_ADA), (float*)(p->ws + WS_XPART) + ((size_t)(l * 8 + ks) * 1024) * DM, l};
                pg8::gemm_phase<EpiOutPart, OneUnit>(lds, g, S, E, nullptr, tid); }
        }
        SEAM(pb + 8);
        PT1(18);
    }
    if (IN(19)) { PH_LOCALS p_final_rows(p, gw, ngw, lane); }
    PT1(20);
#if PROBE_ID
    if (bid == 0 && tid0 == 0) { const unsigned long long w = *(LAS unsigned long long*)(lds + LDS_PROBE_OFF) * PROBE_K, t0 = __builtin_amdgcn_s_memrealtime(); while (__builtin_amdgcn_s_memrealtime() - t0 < w) __builtin_amdgcn_s_sleep(8); }
#endif
#undef IN
#undef SEAM
}
#ifndef MK_SPLIT
#define MK_SPLIT 0
#endif
extern "C" void kernel_launch(void* const* d_in, const int* in_sizes, int n_in, void* d_out, int out_size, void* d_ws, size_t ws_size, hipStream_t stream) {
    static int grid = 0;
    if (grid == 0) {
        if (n_in != N_IN || (size_t)out_size != O_END || ws_size < WS_END) { fprintf(stderr, "kernel_launch: unexpected shapes (n_in %d, out %d, ws %zu)\n", n_in, out_size, ws_size); grid = -1; return; }
        int dev = 0, cus = 0, per_cu = 0;
        if (hipGetDevice(&dev) != hipSuccess || hipDeviceGetAttribute(&cus, hipDeviceAttributeMultiprocessorCount, dev) != hipSuccess) { grid = -1; return; }
        if (hipFuncSetAttribute((const void*)hse_fwd, hipFuncAttributeMaxDynamicSharedMemorySize, LDS_BYTES) != hipSuccess) { fprintf(stderr, "kernel_launch: hipFuncSetAttribute failed\n"); grid = -1; return; }
        if (hipOccupancyMaxActiveBlocksPerMultiprocessor(&per_cu, (const void*)hse_fwd, 512, LDS_BYTES) != hipSuccess || per_cu < 1) fprintf(stderr, "kernel_launch: occupancy query reports %d\n", per_cu);
        (void)hipGetLastError();
        grid = cus;
    }
    if (grid < 0) return;
    if (hipMemsetAsync((char*)d_ws + WS_CTL, 0, CTL_BYTES, stream) != hipSuccess) return;
    Params a{};
    for (int i = 0; i < N_IN; ++i) a.in[i] = (const float*)d_in[i];
    a.out = (float*)d_out; a.ws = (unsigned char*)d_ws;
#if MK_SPLIT
    for (int ph = 0; ph < NPHASE; ++ph) { a.ph_lo = ph; a.ph_hi = ph + 1; a.li = ph; hipLaunchKernelGGL(hse_fwd, dim3(grid), dim3(512), LDS_BYTES, stream, a); }
#else
    a.ph_lo = 0; a.ph_hi = NPHASE; a.li = 0;
    hipLaunchKernelGGL(hse_fwd, dim3(grid), dim3(512), LDS_BYTES, stream, a);
#endif
    const hipError_t le = hipPeekAtLastError();
    if (le != hipSuccess) fprintf(stderr, "kernel_launch: launch failed: %s\n", hipGetErrorName(le));
}
```

```cpp
#include <hip/hip_runtime.h>
#include <cstdio>
#include <cstdint>
#ifndef PROBE_ID
#define PROBE_ID 0
#endif
#ifndef PROBE_K
#define PROBE_K 1
#endif
constexpr int LDS_PROBE_OFF = 163840 - 256 - 64;
#if PROBE_ID
#define PT0() unsigned long long _pt0 = (blockIdx.x == 0 && threadIdx.x == 0) ? __builtin_amdgcn_s_memrealtime() : 0ull
#define PT1(id) do { if ((id) == PROBE_ID && blockIdx.x == 0 && threadIdx.x == 0) { *(__attribute__((address_space(3))) unsigned long long*)(lds + LDS_PROBE_OFF) += __builtin_amdgcn_s_memrealtime() - _pt0; } _pt0 = (blockIdx.x == 0 && threadIdx.x == 0) ? __builtin_amdgcn_s_memrealtime() : 0ull; } while (0)
#else
#define PT0() do {} while (0)
#define PT1(id) do {} while (0)
#endif
namespace pg8 {
#define PG8_LAS __attribute__((address_space(3)))
typedef unsigned short bf16_t;
typedef short bf16x8 __attribute__((ext_vector_type(8)));
typedef float f32x4 __attribute__((ext_vector_type(4)));
typedef unsigned u32x4 __attribute__((ext_vector_type(4)));
constexpr int BM = 256, BK = 64, HALF = 128, HTB = HALF * BK * 2  , STAGE_BYTES = 8 * HTB, NXCD = 8, WGM = 4;

__host__ __device__ __forceinline__ int lds_byte(int r, int c) { const int st = (r >> 4) * 2 + (c >> 5), rr = r & 15, cc = c & 31, ob = rr * 64 + cc * 2; return st * 1024 + (ob ^ (((ob >> 9) & 1) << 5)); }
__host__ __device__ __forceinline__ void stage_rc(int b, int& R, int& C) { const int st = b / 1024, sb = b % 1024, swz = sb ^ (((sb >> 9) & 1) << 5); R = (st >> 1) * 16 + swz / 64; C = (st & 1) * 32 + (swz % 64) / 2; }
__host__ __device__ __forceinline__ int perm32(int rho) { const int n = rho >> 4, i = rho & 15; return 8 * (i >> 2) + 4 * n + (i & 3); }

struct Unit { int pm, pn; };
struct Gemm { const bf16_t* A; const bf16_t* Bt; int M, N, K, ld; };

struct StaticOrder {
    int nM, nN, nwg, G, c, wgm;
    __host__ __device__ void init(int M, int N, int G_, int c_, int wgm_ = WGM) { nM = M / BM; nN = N / BM; nwg = nM * nN; G = G_; c = c_; wgm = wgm_; }
    __host__ __device__ bool next(int i, Unit& u) const {
        const long L = (long)i * G + c; if (L >= nwg) return false;
        int wgid = (int)L; { const int q = nwg / NXCD, r = nwg % NXCD, xcd = wgid % NXCD, off = wgid / NXCD; wgid = (xcd < r ? xcd * (q + 1) : r * (q + 1) + (xcd - r) * q) + off; }
        const int nig = wgm * nN, gid = wgid / nig, fm = gid * wgm, gsz = (nM - fm) < wgm ? (nM - fm) : wgm;
        u.pm = fm + ((wgid % nig) % gsz); u.pn = (wgid % nig) / gsz; return true;
    }
    __device__ __forceinline__ void a_ready(const Unit&) const {}
    __device__ __forceinline__ void done(const Unit&) const {}
};
__device__ __forceinline__ unsigned cvt_pk_bf16(float lo, float hi) { unsigned r; asm volatile("v_cvt_pk_bf16_f32 %0, %1, %2" : "=v"(r) : "v"(lo), "v"(hi)); return r; }
typedef float f32x2 __attribute__((ext_vector_type(2)));
template <class Epi, class Sched, bool STAMP = false>
__device__ __forceinline__ void gemm_phase(PG8_LAS unsigned char* lds, const Gemm g, const Sched& S, const Epi& E, unsigned long long* stamps, int tid_in) {
    int tid = tid_in; asm volatile("" : "+v"(tid));
    const int wid = __builtin_amdgcn_readfirstlane(tid >> 6), lane = tid & 63, wr = wid >> 2, wc = wid & 3, fr = lane & 15, fq = lane >> 4;
    const int K = g.ld, nt = g.K / BK;
    int ts_lo = 0, ts_hi = 0, nts = 0; const unsigned long long rt_entry = STAMP ? (unsigned long long)wall_clock64() : 0ull;
#define PG8_STAMP() do { if (STAMP && wid == 0 && nts < 64) { const unsigned long long _c = (unsigned long long)clock64(); \
        ts_lo = (lane == nts) ? (int)(unsigned)_c : ts_lo; ts_hi = (lane == nts) ? (int)(unsigned)(_c >> 32) : ts_hi; ++nts; } } while (0)
    PG8_STAMP();
    unsigned voffA[2], voffB[2];
#pragma unroll
    for (int i = 0; i < 2; ++i) { int R, C; stage_rc(tid * 16 + i * 8192, R, C); const int Rb = Epi::PERM ? ((R & ~31) + perm32(R & 31)) : R;
        voffA[i] = (unsigned)(R * K + C) * 2u; voffB[i] = (unsigned)(Rb * K + C) * 2u; }
    const size_t kstep = (size_t)(BK * 2);
    const size_t hstep = (size_t)HALF * K * 2;
    const size_t tstep = 2 * hstep;
    const unsigned ldsw = (unsigned)wid * 1024u;
    const int aoff = lds_byte(wr * 64 + fr, fq * 8), boff = lds_byte(wc * 32 + fr, fq * 8);
#define PG8_SA(b, h) (((b) * 2 + (h)) * HTB)
#define PG8_SB(b, h) ((4 + (b) * 2 + (h)) * HTB)
#define PG8_STAGE(bufoff, gbase, voff) do { _Pragma("unroll") for (int _i = 0; _i < 2; ++_i) \
        __builtin_amdgcn_global_load_lds((const unsigned*)((const char*)(gbase) + (voff)[_i]), (PG8_LAS unsigned*)(lds + (bufoff) + ldsw + _i * 8192), 16, 0, 0); } while (0)
#define PG8_LDA(dst, b, h) do { _Pragma("unroll") for (int m = 0; m < 4; ++m) _Pragma("unroll") for (int k = 0; k < 2; ++k) dst[m][k] = *(const PG8_LAS bf16x8*)(lds + PG8_SA(b, h) + aoff + m * 2048 + k * 1024); } while (0)
#define PG8_LDB(dst, b, h) do { _Pragma("unroll") for (int n = 0; n < 2; ++n) _Pragma("unroll") for (int k = 0; k < 2; ++k) dst[n][k] = *(const PG8_LAS bf16x8*)(lds + PG8_SB(b, h) + boff + n * 2048 + k * 1024); } while (0)
#define PG8_MMA(ai, bj, At, Bt) do { __builtin_amdgcn_s_setprio(1); _Pragma("unroll") for (int m = 0; m < 4; ++m) _Pragma("unroll") for (int n = 0; n < 2; ++n) _Pragma("unroll") for (int k = 0; k < 2; ++k) \
        acc[ai][bj][m][n] = __builtin_amdgcn_mfma_f32_16x16x32_bf16(Bt[n][k], At[m][k], acc[ai][bj][m][n], 0, 0, 0); __builtin_amdgcn_s_setprio(0); } while (0)
#define PG8_WAIT_V(n) asm volatile("s_waitcnt vmcnt(" #n ")" ::: "memory")
#define PG8_WAIT_L(n) asm volatile("s_waitcnt lgkmcnt(" #n ")" ::: "memory")
#define PG8_BAR __builtin_amdgcn_s_barrier()
#define PG8_SCHED __builtin_amdgcn_sched_barrier(0)
    Unit cur, nxt; int ui = 0;
    if (!S.next(0, cur)) return;
    f32x4 acc[2][2][4][2];
#pragma unroll
    for (int a = 0; a < 2; ++a)
#pragma unroll
        for (int b = 0; b < 2; ++b)
#pragma unroll
            for (int m = 0; m < 4; ++m)
#pragma unroll
                for (int n = 0; n < 2; ++n) acc[a][b][m][n] = (f32x4){0.f, 0.f, 0.f, 0.f};
    bf16x8 At[4][2], B0[2][2], B1[2][2];
    const char* cA = (const char*)g.A + (size_t)cur.pm * tstep; const char* cB = (const char*)g.Bt + (size_t)cur.pn * tstep;
    S.a_ready(cur);
    PG8_STAGE(PG8_SB(0, 0), cB, voffB); PG8_STAGE(PG8_SA(0, 0), cA, voffA); PG8_STAGE(PG8_SB(0, 1), cB + hstep, voffB); PG8_STAGE(PG8_SA(0, 1), cA + hstep, voffA);
    if (wr == 1) PG8_BAR;
    PG8_WAIT_V(4); PG8_BAR;
    PG8_STAGE(PG8_SB(1, 0), cB + kstep, voffB); PG8_STAGE(PG8_SA(1, 0), cA + kstep, voffA); PG8_STAGE(PG8_SB(1, 1), cB + hstep + kstep, voffB);
    PG8_WAIT_V(6); PG8_BAR;
    PG8_STAMP();
    for (;;) {
        const bool has_next = S.next(ui + 1, nxt);
        const char* nA = has_next ? (const char*)g.A + (size_t)nxt.pm * tstep : cA; const char* nB = has_next ? (const char*)g.Bt + (size_t)nxt.pn * tstep : cB;
        for (int t = 0; t < nt; t += 2) {
            const bool last = (t == nt - 2);
            const char* a1 = cA + (size_t)(t + 1) * kstep;
            const char* a2 = last ? nA : cA + (size_t)(t + 2) * kstep; const char* b2 = last ? nB : cB + (size_t)(t + 2) * kstep;
            const char* a3 = a2 + kstep; const char* b3 = b2 + kstep;
            if (last && has_next) S.a_ready(nxt);
            PG8_LDB(B0, 0, 0); PG8_SCHED; PG8_LDA(At, 0, 0); PG8_STAGE(PG8_SA(1, 1), a1 + hstep, voffA);
            PG8_WAIT_L(8); PG8_BAR; PG8_WAIT_L(0); PG8_MMA(0, 0, At, B0); PG8_BAR; PG8_SCHED;
            PG8_LDB(B1, 0, 1); PG8_STAGE(PG8_SB(0, 0), b2, voffB);
            PG8_BAR; PG8_WAIT_L(0); PG8_MMA(0, 1, At, B1); PG8_BAR;
            PG8_LDA(At, 0, 1); PG8_STAGE(PG8_SA(0, 0), a2, voffA);
            PG8_BAR; PG8_WAIT_L(0); PG8_MMA(1, 0, At, B0); PG8_BAR; PG8_SCHED;
            PG8_STAGE(PG8_SB(0, 1), b2 + hstep, voffB);
            PG8_WAIT_V(6); PG8_BAR; PG8_MMA(1, 1, At, B1); PG8_BAR;
            PG8_LDB(B0, 1, 0); PG8_SCHED; PG8_LDA(At, 1, 0); PG8_STAGE(PG8_SA(0, 1), a2 + hstep, voffA);
            PG8_WAIT_L(8); PG8_BAR; PG8_WAIT_L(0); PG8_MMA(0, 0, At, B0); PG8_BAR; PG8_SCHED;
            PG8_LDB(B1, 1, 1); PG8_STAGE(PG8_SB(1, 0), b3, voffB);
            PG8_BAR; PG8_WAIT_L(0); PG8_MMA(0, 1, At, B1); PG8_BAR;
            PG8_LDA(At, 1, 1); PG8_STAGE(PG8_SA(1, 0), a3, voffA);
            PG8_BAR; PG8_WAIT_L(0); PG8_MMA(1, 0, At, B0); PG8_BAR; PG8_SCHED;
            PG8_STAGE(PG8_SB(1, 1), b3 + hstep, voffB);
            PG8_WAIT_V(6); PG8_BAR; PG8_MMA(1, 1, At, B1); PG8_BAR;
            if constexpr (Epi::SEAMS) { if (((t + 2) & 7) == 0 && !last) E.seam(acc, cur, (t + 2) >> 3, wr, wc, fr, fq); }
        }
        PG8_STAMP();
        { PT0(); if constexpr (!Epi::AFTER_DRAIN) { E(acc, cur, wr, wc, fr, fq); S.done(cur); } PT1(Epi::PROBE); }
        PG8_STAMP();
        if (!has_next) break;
#pragma unroll
        for (int a = 0; a < 2; ++a)
#pragma unroll
            for (int b = 0; b < 2; ++b)
#pragma unroll
                for (int m = 0; m < 4; ++m)
#pragma unroll
                    for (int n = 0; n < 2; ++n) acc[a][b][m][n] = (f32x4){0.f, 0.f, 0.f, 0.f};
        cur = nxt; cA = nA; cB = nB; ++ui;
    }
    PG8_WAIT_V(0);
    if (wr == 0) PG8_BAR;
    PG8_BAR;
    if constexpr (Epi::AFTER_DRAIN) { E.fused(acc, cur, wr, wc, fr, fq, lds, wid, lane); S.done(cur); }
    PG8_STAMP();
    if (STAMP && wid == 0) { stamps[lane] = lane < nts ? (((unsigned long long)(unsigned)ts_hi << 32) | (unsigned)ts_lo) : 0ull;
        if (lane == 62) stamps[62] = rt_entry; if (lane == 63) stamps[63] = (unsigned long long)wall_clock64(); }
#undef PG8_STAMP
#undef PG8_SA
#undef PG8_SB
#undef PG8_STAGE
#undef PG8_LDA
#undef PG8_LDB
#undef PG8_MMA
#undef PG8_WAIT_V
#undef PG8_WAIT_L
#undef PG8_BAR
#undef PG8_SCHED
}
}
#define XB_TMO      128
#define XB_XCNT(j)  (256  + 64 * (j))
#define XB_XSUB(j)  (1280 + 64 * (j))
#define XB_XGEN(j)  (2304 + 64 * (j))
#define XB_TOP      3328
#define XB_TOPGEN   3392
#define XCD_BAR_WORDS 3456
#define XB_SPIN_CAP (1u << 18)
#define LAS __attribute__((address_space(3)))

__device__ __forceinline__ unsigned xb_ld(unsigned* p)              { return __hip_atomic_load(p, __ATOMIC_RELAXED, __HIP_MEMORY_SCOPE_AGENT); }
__device__ __forceinline__ unsigned xb_add(unsigned* p, unsigned v) { return __hip_atomic_fetch_add(p, v, __ATOMIC_RELAXED, __HIP_MEMORY_SCOPE_AGENT); }
__device__ __forceinline__ unsigned xb_xcc_id() { return (unsigned)__builtin_amdgcn_s_getreg((3 << 11) | 20) & 0xFu; }
#define XB_SPIN(cond, bar) do { unsigned _sp = 0; while (cond) { __builtin_amdgcn_s_sleep(1); \
    if ((++_sp & 255u) == 0u) { if (xb_ld(&(bar)[XB_TMO])) break; if (_sp > XB_SPIN_CAP) { atomicAdd(&(bar)[XB_TMO], 1u); break; } } } } while (0)

struct XcdBarrier {
    unsigned* bar; unsigned x;
    volatile LAS unsigned* st;
};

__device__ __forceinline__ XcdBarrier xcd_barrier_post(unsigned* bar, volatile LAS unsigned* st) {
    XcdBarrier b; b.bar = bar; b.x = xb_xcc_id(); b.st = st;
    if (threadIdx.x == 0) (void)xb_add(&bar[XB_XCNT(b.x)], 1u);
    return b;
}
__device__ __forceinline__ void xcd_barrier_complete(unsigned* bar, unsigned x, unsigned& nloc, unsigned& nx) {
    const unsigned G = gridDim.x * gridDim.y * gridDim.z;
    unsigned sum, cnt, mine, sp = 0u;
    for (;;) {
        sum = 0u; cnt = 0u; mine = 0u;
#pragma unroll
        for (unsigned j = 0; j < 16; ++j) { const unsigned c = xb_ld(&bar[XB_XCNT(j)]); sum += c; cnt += (c > 0u) ? 1u : 0u; mine = (j == x) ? c : mine; }
        if (sum == G) break;
        __builtin_amdgcn_s_sleep(1);
        if ((++sp & 255u) == 0u) { if (xb_ld(&bar[XB_TMO])) break; if (sp > XB_SPIN_CAP) { atomicAdd(&bar[XB_TMO], 1u); break; } }
    }
    nloc = mine > 0u ? mine : 1u; nx = cnt > 0u ? cnt : 1u;
}

__device__ __forceinline__ void xcd_barrier(const XcdBarrier& b, const bool is_t0) {
    asm volatile("s_waitcnt vmcnt(0)" ::: "memory");
    __syncthreads();
    if (is_t0) {
        unsigned* bar = b.bar;
        __builtin_amdgcn_s_waitcnt(0);
        unsigned nloc = b.st[0], nx = b.st[1];
        if (nloc == 0u) { xcd_barrier_complete(bar, b.x, nloc, nx); b.st[0] = nloc; b.st[1] = nx; }
        const unsigned old = xb_add(&bar[XB_XSUB(b.x)], 1u);
        const unsigned gen = old / nloc;
        if (old + 1u == (gen + 1u) * nloc) {
            __builtin_amdgcn_fence(__ATOMIC_RELEASE, "agent");
            asm volatile("s_waitcnt vmcnt(0)" ::: "memory");
            const unsigned og = xb_add(&bar[XB_TOP], 1u);
            const unsigned tg = og / nx;
            if (og + 1u == (tg + 1u) * nx) xb_add(&bar[XB_TOPGEN], 1u);
            else XB_SPIN(xb_ld(&bar[XB_TOPGEN]) == tg, bar);
            __builtin_amdgcn_fence(__ATOMIC_ACQUIRE, "agent");
            xb_add(&bar[XB_XGEN(b.x)], 1u);
            asm volatile("s_waitcnt vmcnt(0)" ::: "memory");
        } else {
            XB_SPIN(xb_ld(&bar[XB_XGEN(b.x)]) == gen, bar);
            __builtin_amdgcn_fence(__ATOMIC_ACQUIRE, "agent");
            asm volatile("s_waitcnt vmcnt(0)" ::: "memory");
        }
    }
    __syncthreads();
}
typedef unsigned short bf16_t;
typedef short bf16x8 __attribute__((ext_vector_type(8)));
typedef float f32x4 __attribute__((ext_vector_type(4)));
typedef float f32x16 __attribute__((ext_vector_type(16)));
typedef unsigned u32x4 __attribute__((ext_vector_type(4)));
typedef unsigned u32x2 __attribute__((ext_vector_type(2)));
using pg8::cvt_pk_bf16;

constexpr int DM = 2048, TP = 16384, NSB = 32, TSQ = 32, NTOK = TP + NSB * TSQ, NSEQ = 33, PAST = 4096, NLAYER = 2;
constexpr int LDH = 2048;
constexpr int NU = 15104;
constexpr int U_AVAL = 0, U_AGATE = 512, U_ASG = 1024, U_Q = 1536, U_K = 2048, U_V = 2560, U_BSG = 3072, U_XC = 3584, U_CSG = 5248, U_DIN = 5760, U_DSG = 6272, U_G = 6784, U_F = 14976;
constexpr int IN_W = 14984, SHIFT_W = 1664;
constexpr float LOG2E = 1.4426950408889634f;
enum { I_XP = 0, I_XS, I_CK, I_CV, I_CLF, I_SCONV, I_SSHIFT, I_SWKV, I_SPOOL, I_CP, I_CS, I_NORMG, I_WADA, I_BADA, I_WIN, I_BF, I_CONVW, I_CONVB, I_CLNG, I_CLNB, I_MU, I_W0, I_W2, I_A0, I_A2,
       I_KK, I_KA, I_RK, I_GNG, I_GNB, I_POOLW, I_POOLB, I_POOLS, I_WBR, I_WOUT, I_FING, N_IN };
constexpr size_t O_YP = 0, O_YS = O_YP + (size_t)TP * DM, O_PK = O_YS + (size_t)1024 * DM, O_PV = O_PK + (size_t)2 * TP * 512, O_PLF = O_PV + (size_t)2 * TP * 512, O_PCONV = O_PLF + (size_t)2 * TP * 8,
                 O_PSHIFT = O_PCONV + 2 * 30 * 512, O_PWKV = O_PSHIFT + 2 * 1664, O_PPOOL = O_PWKV + 2 * 8 * 64 * 64, O_SK = O_PPOOL + 2 * 15 * 512, O_SV = O_SK + (size_t)2 * 1024 * 512,
                 O_SLF = O_SV + (size_t)2 * 1024 * 512, O_SCONV = O_SLF + 2 * 1024 * 8, O_SSHIFT = O_SCONV + (size_t)2 * 32 * 30 * 512, O_SWKV = O_SSHIFT + 2 * 32 * 1664,
                 O_SPOOL = O_SWKV + (size_t)2 * 32 * 8 * 64 * 64, O_END = O_SPOOL + (size_t)2 * 32 * 15 * 512;
static_assert(O_END == 75374848, "output size");
constexpr size_t al256(size_t x) { return (x + 255) & ~(size_t)255; }
constexpr int NCU_CH = 288, NRU = NCU_CH * 8;
constexpr size_t WS_CTL = 0, CTL_BYTES = 512 * 1024;
constexpr size_t WS_WIN = CTL_BYTES;
constexpr size_t WS_WBR = al256(WS_WIN + (size_t)2 * NU * LDH * 2);
constexpr size_t WS_WOUT = al256(WS_WBR + (size_t)2 * 4 * 2048 * 512 * 2);
constexpr size_t WS_POOLW = al256(WS_WOUT + (size_t)2 * 2048 * LDH * 2);
constexpr size_t WS_ADA = al256(WS_POOLW + (size_t)2 * 4 * 128 * 128 * 2);
constexpr size_t WS_H = al256(WS_ADA + (size_t)2 * 33 * 6144 * 4);
constexpr size_t WS_U = al256(WS_H + (size_t)NTOK * LDH * 2);
constexpr size_t WS_XBUF = al256(WS_U + (size_t)NTOK * NU * 2);
constexpr size_t WS_OCAT = al256(WS_XBUF + (size_t)NTOK * 2048 * 4);
constexpr size_t WS_Z = al256(WS_OCAT + (size_t)4 * NTOK * 512 * 2);
constexpr size_t WS_MERGED = al256(WS_Z + (size_t)4 * NTOK * 2048 * 2);
constexpr size_t WS_FP = al256(WS_MERGED + (size_t)NTOK * LDH * 2);
constexpr int GS_LEN = PAST + TSQ;
constexpr size_t WS_GS = al256(WS_FP + (size_t)8 * TP * 4);
constexpr size_t WS_VT = al256(WS_GS + (size_t)32 * 8 * GS_LEN * 4);
constexpr size_t WS_TQ = al256(WS_VT + (size_t)8 * 64 * TP * 2);
constexpr size_t WS_GM = al256(WS_TQ + (size_t)NRU * 4096 * 4);
constexpr size_t WS_ET = al256(WS_GM + (size_t)NRU * 4096 * 4);
constexpr size_t WS_Y0T = al256(WS_ET + (size_t)NRU * 4096 * 4);
constexpr size_t WS_SC = al256(WS_Y0T + (size_t)NRU * 4096 * 4);
constexpr size_t WS_BONUS = al256(WS_SC + (size_t)NRU * 4096 * 4);
constexpr size_t WS_GG = al256(WS_BONUS + (size_t)NRU * 64 * 4);
constexpr size_t WS_TG = al256(WS_GG + (size_t)16 * 8 * 4096 * 4);
constexpr size_t WS_SG = al256(WS_TG + (size_t)16 * 8 * 4096 * 4);
constexpr size_t WS_XPART = al256(WS_SG + (size_t)16 * 8 * 4096 * 4);
constexpr size_t WS_END = al256(WS_XPART + (size_t)2 * 8 * 1024 * 2048 * 4);
static_assert(WS_END < (size_t)2100 * 1024 * 1024, "workspace map exceeds the guaranteed d_ws size");
constexpr int CW_BAR = 0;
constexpr int CW_QUEUE = 16 * 3456 + 64;
constexpr int CW_XSYNC = CW_QUEUE + 64 * 16;
constexpr int CW_KMAX = CW_XSYNC + 64 * 32;
static_assert((CW_KMAX + 64) * 4 <= (int)CTL_BYTES, "ctl");
constexpr int LDS_BYTES = 163840 - 256;
constexpr int LDS_XB_OFF = LDS_BYTES - 16;
constexpr int SLOT_F = 64 * 65;

struct Params { const float* in[N_IN]; float* out; unsigned char* ws; int ph_lo, ph_hi, li, pad; };
typedef const __attribute__((address_space(4))) Params* KP;
__device__ __forceinline__ KP kp_fresh(KP k) { asm volatile("" : "+s"(k)); return k; }

__device__ __forceinline__ float bf2f(unsigned short b) { return __uint_as_float(((unsigned)b) << 16); }
__device__ __forceinline__ float bflo(unsigned w) { return __uint_as_float(w << 16); }
__device__ __forceinline__ float bfhi(unsigned w) { return __uint_as_float(w & 0xffff0000u); }
__device__ __forceinline__ unsigned short f2bf(float f) { return (unsigned short)(cvt_pk_bf16(f, 0.f) & 0xffffu); }
__device__ __forceinline__ float sigmoidf_(float x) { return 1.f / (1.f + __expf(-x)); }
__device__ __forceinline__ float siluf_(float x) { return x / (1.f + __expf(-x)); }
__device__ __forceinline__ float log_sigmoidf_(float z) { return fminf(z, 0.f) - log1pf(expf(-fabsf(z))); }
template <int CTRL> __device__ __forceinline__ float dpp_mov(float v) { return __int_as_float(__builtin_amdgcn_update_dpp(0, __float_as_int(v), CTRL, 0xF, 0xF, true)); }
__device__ __forceinline__ float wave_sum(float v) {
    v += dpp_mov<0xB1>(v); v += dpp_mov<0x4E>(v); v += dpp_mov<0x141>(v); v += dpp_mov<0x140>(v);
    const float r0 = __int_as_float(__builtin_amdgcn_readlane(__float_as_int(v), 0)), r1 = __int_as_float(__builtin_amdgcn_readlane(__float_as_int(v), 16));
    const float r2 = __int_as_float(__builtin_amdgcn_readlane(__float_as_int(v), 32)), r3 = __int_as_float(__builtin_amdgcn_readlane(__float_as_int(v), 48));
    return (r0 + r1) + (r2 + r3);
}
__device__ __forceinline__ float wave_max(float v) {
    v = fmaxf(v, dpp_mov<0xB1>(v)); v = fmaxf(v, dpp_mov<0x4E>(v)); v = fmaxf(v, dpp_mov<0x141>(v)); v = fmaxf(v, dpp_mov<0x140>(v));
    const float r0 = __int_as_float(__builtin_amdgcn_readlane(__float_as_int(v), 0)), r1 = __int_as_float(__builtin_amdgcn_readlane(__float_as_int(v), 16));
    const float r2 = __int_as_float(__builtin_amdgcn_readlane(__float_as_int(v), 32)), r3 = __int_as_float(__builtin_amdgcn_readlane(__float_as_int(v), 48));
    return fmaxf(fmaxf(r0, r1), fmaxf(r2, r3));
}
__device__ __forceinline__ float wave_min(float v) { return -wave_max(-v); }
__device__ __forceinline__ float xhalf_max(float m) { const auto rr = __builtin_amdgcn_permlane32_swap(__float_as_uint(m), __float_as_uint(m), false, false); return fmaxf(__uint_as_float(rr[0]), __uint_as_float(rr[1])); }
__device__ __forceinline__ float xhalf_sum(float m) { const auto rr = __builtin_amdgcn_permlane32_swap(__float_as_uint(m), __float_as_uint(m), false, false); return __uint_as_float(rr[0]) + __uint_as_float(rr[1]); }
__device__ __forceinline__ bf16x8 pack8f(const f32x4 a, const f32x4 b) { u32x4 w; w.x = cvt_pk_bf16(a[0], a[1]); w.y = cvt_pk_bf16(a[2], a[3]); w.z = cvt_pk_bf16(b[0], b[1]); w.w = cvt_pk_bf16(b[2], b[3]); return __builtin_bit_cast(bf16x8, w); }
__device__ __forceinline__ float fast_tanh(float x) { const float e = __expf(-2.f * fabsf(x)); const float t = (1.f - e) * __builtin_amdgcn_rcpf(1.f + e); return x < 0.f ? -t : t; }
__device__ __forceinline__ void tr_tile(const float* __restrict__ src, size_t ld, int k0, int c0, int nvalid, bf16_t* __restrict__ dst, int K, LAS float* scr, int lane, float scale = 1.f) {
    float tv[64];
#pragma unroll
    for (int kk = 0; kk < 64; ++kk) tv[kk] = src[(size_t)(k0 + kk) * ld + c0 + (lane < nvalid ? lane : 0)];
#pragma unroll
    for (int kk = 0; kk < 64; ++kk) scr[kk * 65 + lane] = (lane < nvalid) ? tv[kk] * scale : 0.f;
    const int nl = lane >> 3, kc8 = (lane & 7) * 8;
#pragma unroll
    for (int it = 0; it < 8; ++it) { const int nn = 8 * it + nl; const LAS float* s = scr + kc8 * 65 + nn;
        u32x4 w; w.x = cvt_pk_bf16(s[0], s[65]); w.y = cvt_pk_bf16(s[130], s[195]); w.z = cvt_pk_bf16(s[260], s[325]); w.w = cvt_pk_bf16(s[390], s[455]);
        *(u32x4*)(dst + (size_t)nn * K + k0 + kc8) = w; }
}
__device__ __forceinline__ void p0_weights(KP p, LAS unsigned char* lds, int gw, int ngw, int wave, int lane) {
    LAS float* scr = (LAS float*)lds + wave * SLOT_F;
    constexpr int T_WIN = (NU / 64) * 32, T_WBR = 4 * 32 * 8, T_WOUT = 32 * 32, T_POOL = 4 * 2 * 2, T_L = T_WIN + T_WBR + T_WOUT + T_POOL;
    for (int it = gw; it < 2 * T_L; it += ngw) {
        const int l = it / T_L; int r = it % T_L;
        if (r < T_WIN) {
            const int nt = r / 32, kt = r % 32, m0 = nt * 64;
            int c0, nvalid = 64;
            if (m0 < 3072) c0 = m0; else if (m0 < U_F) c0 = m0 + 8; else if (m0 == U_F) { c0 = 3072; nvalid = 8; } else { c0 = 0; nvalid = 0; }
            tr_tile(p->in[I_WIN] + (size_t)l * 2048 * IN_W, IN_W, kt * 64, c0, nvalid, (bf16_t*)(p->ws + WS_WIN) + ((size_t)l * NU + m0) * LDH, LDH, scr, lane, (m0 >= U_G && m0 < U_F) ? -LOG2E : 1.f);
            continue; }
        r -= T_WIN;
        if (r < T_WBR) {
            const int n = r / 256, q = r % 256, nt = q / 8, kt = q % 8;
            tr_tile(p->in[I_WBR] + ((size_t)(l * 4 + n) * 512) * 2048, 2048, kt * 64, nt * 64, 64, (bf16_t*)(p->ws + WS_WBR) + ((size_t)l * 2048 + nt * 64) * 2048 + n * 512, 2048, scr, lane);
            continue; }
        r -= T_WBR;
        if (r < T_WOUT) {
            const int nt = r / 32, kt = r % 32;
            tr_tile(p->in[I_WOUT] + (size_t)l * 2048 * 2048, 2048, kt * 64, nt * 64, 64, (bf16_t*)(p->ws + WS_WOUT) + ((size_t)l * 2048 + nt * 64) * LDH, LDH, scr, lane);
            continue; }
        r -= T_WOUT;
        {
            const int g = r / 4, q = r % 4, nt = q / 2, kt = q % 2;
            tr_tile(p->in[I_POOLW] + (size_t)(l * 4 + g) * 128 * 128, 128, kt * 64, nt * 64, 64, (bf16_t*)(p->ws + WS_POOLW) + ((size_t)(l * 4 + g) * 128 + nt * 64) * 128, 128, scr, lane);
        }
    }
}
__device__ __forceinline__ void ada_unit(KP p, int unit, LAS unsigned char* lds, int tid) {
    const int wave = tid >> 6, lane = tid & 63, li = lane & 31, kh = lane >> 5, l = unit / 96, n0 = (unit % 96) * 64;
    LAS float* cs = (LAS float*)lds + wave * (32 * 65 + 64);
    LAS float* c0l = cs + 32 * 65;
    LAS float* red = (LAS float*)lds + 8 * (32 * 65 + 64);
    const float* W = p->in[I_WADA] + (size_t)l * 2048 * 6144 + n0 + li;
    const float* cp = p->in[I_CP]; const float* csm = p->in[I_CS];
    f32x16 acc0 = {}, acc1 = {}; float ap0 = 0.f, ap1 = 0.f;
#pragma unroll 1
    for (int ch = 0; ch < 4; ++ch) {
        const int k0 = wave * 256 + ch * 64;
        float wb[64];
#pragma unroll
        for (int j = 0; j < 32; ++j) { const float* wp = W + (size_t)(k0 + 2 * j + kh) * 6144; wb[2 * j] = wp[0]; wb[2 * j + 1] = wp[32]; }
#pragma unroll
        for (int s = 0; s < 32; ++s) cs[s * 65 + lane] = siluf_(csm[(size_t)s * 2048 + k0 + lane]);
        c0l[lane] = siluf_(cp[k0 + lane]);
#pragma unroll
        for (int j = 0; j < 32; ++j) { const float a = cs[li * 65 + 2 * j + kh], c0v = c0l[2 * j + kh], b0 = wb[2 * j], b1 = wb[2 * j + 1];
            acc0 = __builtin_amdgcn_mfma_f32_32x32x2f32(a, b0, acc0, 0, 0, 0); acc1 = __builtin_amdgcn_mfma_f32_32x32x2f32(a, b1, acc1, 0, 0, 0);
            ap0 += c0v * b0; ap1 += c0v * b1; }
    }
    ap0 = xhalf_sum(ap0); ap1 = xhalf_sum(ap1);
    if (kh == 0) { red[(wave * 33) * 64 + li] = ap0; red[(wave * 33) * 64 + 32 + li] = ap1; }
#pragma unroll
    for (int r = 0; r < 16; ++r) { const int s = 1 + (r & 3) + 8 * (r >> 2) + 4 * kh; red[(wave * 33 + s) * 64 + li] = acc0[r]; red[(wave * 33 + s) * 64 + 32 + li] = acc1[r]; }
    __syncthreads();
    for (int idx = tid; idx < 33 * 64; idx += 512) { const int s = idx >> 6, n = idx & 63; float v = p->in[I_BADA][l * 6144 + n0 + n];
#pragma unroll
        for (int w = 0; w < 8; ++w) v += red[(w * 33 + s) * 64 + n];
        ((float*)(p->ws + WS_ADA))[((size_t)l * 33 + s) * 6144 + n0 + n] = v; }
    __syncthreads();
}
__device__ __forceinline__ void load_x8(KP p, int l, int row, int lane, f32x4 (&v)[8]) {
    if (row < TP) {
        if (l == 0) { const f32x4* x4 = (const f32x4*)(p->in[I_XP] + (size_t)row * DM) + lane;
#pragma unroll
            for (int j = 0; j < 8; ++j) v[j] = x4[64 * j]; }
        else { const u32x2* x2 = (const u32x2*)((const bf16_t*)(p->ws + WS_XBUF) + (size_t)row * DM) + lane;
            u32x2 w[8];
#pragma unroll
            for (int j = 0; j < 8; ++j) w[j] = x2[64 * j];
#pragma unroll
            for (int j = 0; j < 8; ++j) v[j] = (f32x4){bflo(w[j].x), bfhi(w[j].x), bflo(w[j].y), bfhi(w[j].y)}; } }
    else { const int r = row - TP; const f32x4* x4 = (const f32x4*)(p->in[I_XS] + (size_t)r * DM) + lane;
#pragma unroll
        for (int j = 0; j < 8; ++j) v[j] = x4[64 * j];
        for (int s = 0; s < 8 * l; s += 4) {
            const u32x2* q = (const u32x2*)((const bf16_t*)(p->ws + WS_XPART) + ((size_t)s * 1024 + r) * DM) + lane; u32x2 t[4][8];
#pragma unroll
            for (int k = 0; k < 4; ++k)
#pragma unroll
                for (int j = 0; j < 8; ++j) t[k][j] = q[(size_t)k * 1024 * DM / 4 + 64 * j];
#pragma unroll
            for (int j = 0; j < 8; ++j)
#pragma unroll
                for (int k = 0; k < 4; ++k) v[j] += (f32x4){bflo(t[k][j].x), bfhi(t[k][j].x), bflo(t[k][j].y), bfhi(t[k][j].y)}; } }
}
__device__ __forceinline__ int bal_row(int it, int gw, int ngw, bool bal, int PS) {
    if (!bal) { const int r = gw + it * ngw; return r < NTOK ? r : -1; }
    const int i = gw >> 1;
    if ((gw & 1) == 0) return it == 0 ? TP + i : (it <= PS ? i + 1024 * (it - 1) : -1);
    return it < 16 - PS ? PS * 1024 + i + 1024 * it : -1;
}
__device__ __forceinline__ void p1_rows(KP p, int l, int gw, int ngw, int lane) {
    const f32x4* g4 = (const f32x4*)(p->in[I_NORMG] + l * DM) + lane;
    f32x4 a[8], sh[8]; int cur_seq = -1;
    for (int it = 0;; ++it) { const int row = bal_row(it, gw, ngw, l > 0 && ngw == 2048, 3); if (row < 0) break;
        const int seq = row < TP ? 0 : 1 + ((row - TP) >> 5);
        f32x4 v[8]; float ss = 0.f; load_x8(p, l, row, lane, v);
#pragma unroll
        for (int j = 0; j < 8; ++j) { ss += (v[j].x * v[j].x + v[j].y * v[j].y) + (v[j].z * v[j].z + v[j].w * v[j].w); }
        if (seq != cur_seq) { cur_seq = seq;
            const f32x4* sh4 = (const f32x4*)((const float*)(p->ws + WS_ADA) + ((size_t)l * 33 + seq) * 6144) + lane; const f32x4* sc4 = sh4 + 512;
#pragma unroll
            for (int j = 0; j < 8; ++j) { a[j] = g4[64 * j] * (sc4[64 * j] + 1.f); sh[j] = sh4[64 * j]; } }
        const float rstd = 1.f / sqrtf(wave_sum(ss) * (1.f / DM) + 1e-6f);
        u32x2* o = (u32x2*)((bf16_t*)(p->ws + WS_H) + (size_t)row * LDH) + lane;
#pragma unroll
        for (int j = 0; j < 8; ++j) { const f32x4 y = v[j] * rstd * a[j] + sh[j];
            u32x2 w; w.x = cvt_pk_bf16(y.x, y.y); w.y = cvt_pk_bf16(y.z, y.w); o[64 * j] = w; }
    }
}
__device__ __forceinline__ void p_final_rows(KP p, int gw, int ngw, int lane) {
    const f32x4* g4 = (const f32x4*)p->in[I_FING] + lane;
    f32x4 gf[8];
#pragma unroll
    for (int j = 0; j < 8; ++j) gf[j] = g4[64 * j];
    for (int it = 0;; ++it) { const int row = bal_row(it, gw, ngw, ngw == 2048, 4); if (row < 0) break;
        f32x4 v[8]; float ss = 0.f; load_x8(p, 2, row, lane, v);
#pragma unroll
        for (int j = 0; j < 8; ++j) { ss += (v[j].x * v[j].x + v[j].y * v[j].y) + (v[j].z * v[j].z + v[j].w * v[j].w); }
        const float rstd = 1.f / sqrtf(wave_sum(ss) * (1.f / DM) + 1e-6f);
        f32x4* o = (f32x4*)(p->out + O_YP + (size_t)row * DM) + lane;
#pragma unroll
        for (int j = 0; j < 8; ++j) __builtin_nontemporal_store(v[j] * rstd * gf[j], &o[64 * j]);
    }
}
struct SyncOrder : pg8::StaticOrder {
    unsigned* cnt; unsigned nloc; int nsync; mutable int r;
    __device__ __forceinline__ void a_ready(const pg8::Unit&) const {
        if (r < nsync) {
            if (threadIdx.x < 64) {
                if (threadIdx.x == 0) __hip_atomic_fetch_add(cnt, 1u, __ATOMIC_RELAXED, __HIP_MEMORY_SCOPE_AGENT);
                const unsigned want = nloc * (unsigned)(r + 1); const unsigned long long t0 = __builtin_amdgcn_s_memrealtime();
                while ((unsigned)__builtin_amdgcn_readfirstlane(__hip_atomic_load(cnt, __ATOMIC_RELAXED, __HIP_MEMORY_SCOPE_AGENT)) < want) {
                    if (__builtin_amdgcn_s_memrealtime() - t0 > 2000ull) break;
                    __builtin_amdgcn_s_sleep(2); }
            }
        }
        ++r;
        asm volatile("" ::: "memory"); __builtin_amdgcn_s_barrier(); asm volatile("" ::: "memory");
    }
};
struct EpiU {
    static constexpr bool PERM = true, AFTER_DRAIN = false, SEAMS = false; static constexpr int PROBE = 50;
    bf16_t* U; float* out; const float* bf; int l;
    __device__ __forceinline__ void operator()(const f32x4 (&acc)[2][2][4][2], const pg8::Unit& u, int wr, int wc, int fr, int fq) const {
        const int row0 = u.pm * 256 + wr * 64 + fr, col0 = u.pn * 256 + wc * 32 + 8 * fq;
#pragma unroll
        for (int ai = 0; ai < 2; ++ai)
#pragma unroll
            for (int m = 0; m < 4; ++m) { bf16_t* rowp = U + (size_t)(row0 + ai * 128 + m * 16) * NU + col0;
#pragma unroll
                for (int bj = 0; bj < 2; ++bj) { f32x4 v0 = acc[ai][bj][m][0], v1 = acc[ai][bj][m][1];
                    const int kb = u.pn * 2 + bj;
                    if (kb >= U_G / 128 && kb < U_F / 128) {
#pragma unroll
                        for (int e = 0; e < 4; ++e) { v0[e] = 1.f + fminf(__builtin_amdgcn_exp2f(v0[e]), 1e26f); v1[e] = 1.f + fminf(__builtin_amdgcn_exp2f(v1[e]), 1e26f); } }
                    u32x4 w; w.x = cvt_pk_bf16(v0[0], v0[1]); w.y = cvt_pk_bf16(v0[2], v0[3]); w.z = cvt_pk_bf16(v1[0], v1[1]); w.w = cvt_pk_bf16(v1[2], v1[3]);
                    *(u32x4*)(rowp + bj * 128) = w; } }
        if (u.pn >= 8 && u.pn < 12) {
            const bool isv = u.pn >= 10; const int cin = (u.pn - (isv ? 10 : 8)) * 256 + wc * 32 + 8 * fq;
#pragma unroll
            for (int ai = 0; ai < 2; ++ai)
#pragma unroll
                for (int m = 0; m < 4; ++m) { const int row = row0 + ai * 128 + m * 16;
                    float* dst = row < TP ? out + (isv ? O_PV : O_PK) + ((size_t)l * TP + row) * 512 : out + (isv ? O_SV : O_SK) + ((size_t)l * 1024 + (row - TP)) * 512;
#pragma unroll
                    for (int bj = 0; bj < 2; ++bj) { __builtin_nontemporal_store(acc[ai][bj][m][0], (f32x4*)(dst + cin + bj * 128)); __builtin_nontemporal_store(acc[ai][bj][m][1], (f32x4*)(dst + cin + bj * 128 + 4)); } }
        }
        if (u.pn == 58 && wc == 0 && fq == 0) {
            const f32x4 b0 = *(const f32x4*)(bf + l * 8), b1 = *(const f32x4*)(bf + l * 8 + 4);
#pragma unroll
            for (int ai = 0; ai < 2; ++ai)
#pragma unroll
                for (int m = 0; m < 4; ++m) { const int row = row0 + ai * 128 + m * 16;
                    float* dst = row < TP ? out + O_PLF + ((size_t)l * TP + row) * 8 : out + O_SLF + ((size_t)l * 1024 + (row - TP)) * 8;
                    const f32x4 z0 = acc[ai][1][m][0] + b0, z1 = acc[ai][1][m][1] + b1; f32x4 o0, o1;
#pragma unroll
                    for (int e = 0; e < 4; ++e) { o0[e] = log_sigmoidf_(z0[e]); o1[e] = log_sigmoidf_(z1[e]); }
                    *(f32x4*)dst = o0; *(f32x4*)(dst + 4) = o1; }
        }
    }
};
__device__ __forceinline__ void gated_store(const f32x4 (&acc)[2][2][4][2], const bf16_t* gb, bf16_t* dst, int pitch) {
#pragma unroll
    for (int ai = 0; ai < 2; ++ai) {
        u32x4 g3[4][2];
#pragma unroll
        for (int m = 0; m < 4; ++m)
#pragma unroll
            for (int bj = 0; bj < 2; ++bj) g3[m][bj] = *(const u32x4*)(gb + (size_t)(ai * 128 + m * 16) * NU + bj * 128);
#pragma unroll
        for (int m = 0; m < 4; ++m) { bf16_t* rowp = dst + (size_t)(ai * 128 + m * 16) * pitch;
#pragma unroll
            for (int bj = 0; bj < 2; ++bj) { const u32x4 c = g3[m][bj]; const f32x4 v0 = acc[ai][bj][m][0], v1 = acc[ai][bj][m][1];
                u32x4 w;
                w.x = cvt_pk_bf16(v0[0] * __builtin_amdgcn_rcpf(bflo(c.x)), v0[1] * __builtin_amdgcn_rcpf(bfhi(c.x))); w.y = cvt_pk_bf16(v0[2] * __builtin_amdgcn_rcpf(bflo(c.y)), v0[3] * __builtin_amdgcn_rcpf(bfhi(c.y)));
                w.z = cvt_pk_bf16(v1[0] * __builtin_amdgcn_rcpf(bflo(c.z)), v1[1] * __builtin_amdgcn_rcpf(bfhi(c.z))); w.w = cvt_pk_bf16(v1[2] * __builtin_amdgcn_rcpf(bflo(c.w)), v1[3] * __builtin_amdgcn_rcpf(bfhi(c.w)));
                *(u32x4*)(rowp + bj * 128) = w; } }
    }
}
struct EpiMerge {
    static constexpr bool PERM = true, AFTER_DRAIN = false, SEAMS = true; static constexpr int PROBE = 51;
    bf16_t* M; const bf16_t* U;
    static __device__ __forceinline__ float dn(float d) { return d; }
    __device__ __forceinline__ void seam(f32x4 (&acc)[2][2][4][2], const pg8::Unit& u, int n, int wr, int wc, int fr, int fq) const {
        const bf16_t* gb = U + (size_t)(u.pm * 256 + wr * 64 + fr) * NU + U_G + (n - 1) * 2048 + u.pn * 256 + wc * 32 + 8 * fq;
        u32x4 gp[2][2][2], gn[2][2][2];
#define EM_LOAD(BUF, AI, MP) _Pragma("unroll") for (int mm = 0; mm < 2; ++mm) _Pragma("unroll") for (int bj = 0; bj < 2; ++bj) { const bf16_t* q_ = gb + (size_t)((AI) * 128 + ((MP) + mm) * 16) * NU + bj * 128; \
            gp[BUF][mm][bj] = *(const u32x4*)q_; gn[BUF][mm][bj] = *(const u32x4*)(q_ + 2048); }
        EM_LOAD(0, 0, 0);
#pragma unroll
        for (int b = 0; b < 4; ++b) { const int ai = b >> 1, mp = (b & 1) * 2;
            if (b == 0) { EM_LOAD(1, 0, 2); } else if (b == 1) { EM_LOAD(0, 1, 0); } else if (b == 2) { EM_LOAD(1, 1, 2); }
#pragma unroll
            for (int mm = 0; mm < 2; ++mm)
#pragma unroll
                for (int bj = 0; bj < 2; ++bj) { const u32x4 a = gp[b & 1][mm][bj], c = gn[b & 1][mm][bj];
                    f32x4 r0, r1;
                    r0[0] = dn(bflo(c.x)) * __builtin_amdgcn_rcpf(dn(bflo(a.x))); r0[1] = dn(bfhi(c.x)) * __builtin_amdgcn_rcpf(dn(bfhi(a.x)));
                    r0[2] = dn(bflo(c.y)) * __builtin_amdgcn_rcpf(dn(bflo(a.y))); r0[3] = dn(bfhi(c.y)) * __builtin_amdgcn_rcpf(dn(bfhi(a.y)));
                    r1[0] = dn(bflo(c.z)) * __builtin_amdgcn_rcpf(dn(bflo(a.z))); r1[1] = dn(bfhi(c.z)) * __builtin_amdgcn_rcpf(dn(bfhi(a.z)));
                    r1[2] = dn(bflo(c.w)) * __builtin_amdgcn_rcpf(dn(bflo(a.w))); r1[3] = dn(bfhi(c.w)) * __builtin_amdgcn_rcpf(dn(bfhi(a.w)));
                    acc[ai][bj][mp + mm][0] *= r0; acc[ai][bj][mp + mm][1] *= r1; }
        }
#undef EM_LOAD
    }
    __device__ __forceinline__ void operator()(const f32x4 (&acc)[2][2][4][2], const pg8::Unit& u, int wr, int wc, int fr, int fq) const {
        const int row0 = u.pm * 256 + wr * 64 + fr, col0 = u.pn * 256 + wc * 32 + 8 * fq;
        gated_store(acc, U + (size_t)row0 * NU + U_G + 3 * 2048 + col0, M + (size_t)row0 * LDH + col0, LDH);
    }
};
struct EpiGateZ {
    static constexpr bool PERM = true, AFTER_DRAIN = false, SEAMS = false; static constexpr int PROBE = 54;
    bf16_t* Zs; const bf16_t* U; int n;
    __device__ __forceinline__ void operator()(const f32x4 (&acc)[2][2][4][2], const pg8::Unit& u, int wr, int wc, int fr, int fq) const {
        const int row0 = u.pm * 256 + wr * 64 + fr, col0 = u.pn * 256 + wc * 32 + 8 * fq;
        gated_store(acc, U + (size_t)row0 * NU + U_G + n * 2048 + col0, Zs + (size_t)(row0 - TP) * 2048 + col0, 2048);
    }
};
struct EpiOut {
    static constexpr bool PERM = true, AFTER_DRAIN = false, SEAMS = false; static constexpr int PROBE = 52;
    const float* xp; const float* ada; bf16_t* xbuf; int l;
    __device__ __forceinline__ void operator()(const f32x4 (&acc)[2][2][4][2], const pg8::Unit& u, int wr, int wc, int fr, int fq) const {
        const int row0 = u.pm * 256 + wr * 64 + fr, col0 = u.pn * 256 + wc * 32 + 8 * fq;
        const float* gate = ada + ((size_t)l * 33) * 6144 + 4096 + col0; bf16_t* dst = xbuf + (size_t)row0 * DM + col0;
        f32x4 gt[2][2];
#pragma unroll
        for (int bj = 0; bj < 2; ++bj)
#pragma unroll
            for (int n = 0; n < 2; ++n) gt[bj][n] = *(const f32x4*)(gate + bj * 128 + n * 4);
        if (l == 0) {
            const float* base = xp + (size_t)row0 * DM + col0;
#pragma unroll
            for (int ai = 0; ai < 2; ++ai)
#pragma unroll
                for (int mp = 0; mp < 4; mp += 2) {
                    f32x4 bs[2][2][2];
#pragma unroll
                    for (int mm = 0; mm < 2; ++mm)
#pragma unroll
                        for (int bj = 0; bj < 2; ++bj)
#pragma unroll
                            for (int n = 0; n < 2; ++n) bs[mm][bj][n] = *(const f32x4*)(base + (size_t)(ai * 128 + (mp + mm) * 16) * DM + bj * 128 + n * 4);
#pragma unroll
                    for (int mm = 0; mm < 2; ++mm)
#pragma unroll
                        for (int bj = 0; bj < 2; ++bj) { const int m = mp + mm; const f32x4 v0 = bs[mm][bj][0] + gt[bj][0] * acc[ai][bj][m][0], v1 = bs[mm][bj][1] + gt[bj][1] * acc[ai][bj][m][1];
                            u32x4 w; w.x = cvt_pk_bf16(v0[0], v0[1]); w.y = cvt_pk_bf16(v0[2], v0[3]); w.z = cvt_pk_bf16(v1[0], v1[1]); w.w = cvt_pk_bf16(v1[2], v1[3]);
                            *(u32x4*)(dst + (size_t)(ai * 128 + m * 16) * DM + bj * 128) = w; }
                }
        } else {
#pragma unroll
            for (int ai = 0; ai < 2; ++ai) {
                u32x4 bs[4][2];
#pragma unroll
                for (int m = 0; m < 4; ++m)
#pragma unroll
                    for (int bj = 0; bj < 2; ++bj) bs[m][bj] = *(const u32x4*)(dst + (size_t)(ai * 128 + m * 16) * DM + bj * 128);
#pragma unroll
                for (int m = 0; m < 4; ++m)
#pragma unroll
                    for (int bj = 0; bj < 2; ++bj) { const u32x4 b = bs[m][bj];
                        const f32x4 v0 = (f32x4){bflo(b.x), bfhi(b.x), bflo(b.y), bfhi(b.y)} + gt[bj][0] * acc[ai][bj][m][0], v1 = (f32x4){bflo(b.z), bfhi(b.z), bflo(b.w), bfhi(b.w)} + gt[bj][1] * acc[ai][bj][m][1];
                        u32x4 w; w.x = cvt_pk_bf16(v0[0], v0[1]); w.y = cvt_pk_bf16(v0[2], v0[3]); w.z = cvt_pk_bf16(v1[0], v1[1]); w.w = cvt_pk_bf16(v1[2], v1[3]);
                        *(u32x4*)(dst + (size_t)(ai * 128 + m * 16) * DM + bj * 128) = w; }
            }
        }
    }
};
struct OneUnit {
    int pm, pn; bool valid;
    __device__ __forceinline__ bool next(int i, pg8::Unit& u) const { if (i > 0 || !valid) return false; u.pm = pm; u.pn = pn; return true; }
    __device__ __forceinline__ void a_ready(const pg8::Unit&) const {}
    __device__ __forceinline__ void done(const pg8::Unit&) const {}
};
struct EpiOutPart {
    static constexpr bool PERM = true, AFTER_DRAIN = false, SEAMS = false; static constexpr int PROBE = 53;
    const float* ada; bf16_t* part; int l;
    __device__ __forceinline__ void operator()(const f32x4 (&acc)[2][2][4][2], const pg8::Unit& u, int wr, int wc, int fr, int fq) const {
        const int row0 = u.pm * 256 + wr * 64 + fr - TP, col0 = u.pn * 256 + wc * 32 + 8 * fq;
#pragma unroll
        for (int ai = 0; ai < 2; ++ai)
#pragma unroll
            for (int mp = 0; mp < 4; mp += 2) {
                const int r0 = row0 + ai * 128 + mp * 16; const float* gate = ada + ((size_t)l * 33 + 1 + (r0 >> 5)) * 6144 + 4096 + col0;
                f32x4 gv[2][2];
#pragma unroll
                for (int bj = 0; bj < 2; ++bj)
#pragma unroll
                    for (int n = 0; n < 2; ++n) gv[bj][n] = *(const f32x4*)(gate + bj * 128 + n * 4);
#pragma unroll
                for (int mm = 0; mm < 2; ++mm)
#pragma unroll
                    for (int bj = 0; bj < 2; ++bj) { const f32x4 v0 = gv[bj][0] * acc[ai][bj][mp + mm][0], v1 = gv[bj][1] * acc[ai][bj][mp + mm][1];
                        u32x4 w; w.x = cvt_pk_bf16(v0[0], v0[1]); w.y = cvt_pk_bf16(v0[2], v0[3]); w.z = cvt_pk_bf16(v1[0], v1[1]); w.w = cvt_pk_bf16(v1[2], v1[3]);
                        *(u32x4*)(part + (size_t)(r0 + mm * 16) * DM + col0 + bj * 128) = w; }
            }
    }
};
constexpr int CGS = 516;
__device__ __forceinline__ void conv_unit(KP p, int l, int tile, LAS unsigned char* lds, int tid) {
    const bf16_t* U = (const bf16_t*)(p->ws + WS_U);
    const int c = tid, wave = tid >> 6, lane = tid & 63;
    const bool samp = tile >= 512; const int b = tile - 512, row0 = samp ? TP + b * 32 : tile * 32;
    const bool last = samp || tile == 511;
    LAS float* gl = (LAS float*)lds;
    LAS bf16_t* sgl = (LAS bf16_t*)(lds + 62 * CGS * 4);
    LAS float* red = (LAS float*)(lds + 62 * CGS * 4 + 32 * 512 * 2);
    LAS float* st = red + 16 * 32;
    {
        u32x4 vv[8], gg[8]; f32x4 h0[4], h1[4];
#pragma unroll
        for (int k = 0; k < 8; ++k) { const int task = tid + 512 * k, i = (task < 62 * 64 ? task : 62 * 64 - 1) >> 6, ch = task & 63, rel = i - 30; const int rowc = row0 + rel < 0 ? 0 : (rel < 0 && samp ? row0 : row0 + rel);
            const bf16_t* up = U + (size_t)rowc * NU + 8 * ch; vv[k] = *(const u32x4*)(up + U_AVAL); gg[k] = *(const u32x4*)(up + U_AGATE); }
#pragma unroll
        for (int k = 0; k < 4; ++k) { h0[k] = (f32x4){0.f, 0.f, 0.f, 0.f}; h1[k] = h0[k]; }
        if (samp) {
#pragma unroll
            for (int k = 0; k < 4; ++k) { const int task = tid + 512 * k, i = task >> 6, ch = task & 63; const float* hp = p->in[I_SCONV] + (((size_t)l * 32 + b) * 30 + (i < 30 ? i : 29)) * 512 + 8 * ch; h0[k] = *(const f32x4*)hp; h1[k] = *(const f32x4*)(hp + 4); } }
#pragma unroll
        for (int k = 0; k < 8; ++k) { const int task = tid + 512 * k, i = task >> 6, ch = task & 63, rel = i - 30; const u32x4 v = vv[k], g = gg[k];
            f32x4 o0 = (f32x4){bflo(v.x) * sigmoidf_(bflo(g.x)), bfhi(v.x) * sigmoidf_(bfhi(g.x)), bflo(v.y) * sigmoidf_(bflo(g.y)), bfhi(v.y) * sigmoidf_(bfhi(g.y))};
            f32x4 o1 = (f32x4){bflo(v.z) * sigmoidf_(bflo(g.z)), bfhi(v.z) * sigmoidf_(bfhi(g.z)), bflo(v.w) * sigmoidf_(bflo(g.w)), bfhi(v.w) * sigmoidf_(bfhi(g.w))};
            const bool hist = rel < 0 && samp, zero = !hist && row0 + rel < 0;
            if (k < 4) { o0 = hist ? h0[k & 3] : o0; o1 = hist ? h1[k & 3] : o1; }
            const float zm = zero ? 0.f : 1.f; o0 = o0 * zm; o1 = o1 * zm;
            if (task < 62 * 64) { *(LAS f32x4*)(gl + i * CGS + 8 * ch) = o0; *(LAS f32x4*)(gl + i * CGS + 8 * ch + 4) = o1; } }
    }
#pragma unroll
    for (int k = 0; k < 4; ++k) { const int task = tid + 512 * k, t = task >> 6, ch = task & 63; const u32x4 s = *(const u32x4*)(U + (size_t)(row0 + t) * NU + U_ASG + 8 * ch);
        u32x4 w; w.x = cvt_pk_bf16(siluf_(bflo(s.x)), siluf_(bfhi(s.x))); w.y = cvt_pk_bf16(siluf_(bflo(s.y)), siluf_(bfhi(s.y))); w.z = cvt_pk_bf16(siluf_(bflo(s.z)), siluf_(bfhi(s.z))); w.w = cvt_pk_bf16(siluf_(bflo(s.w)), siluf_(bfhi(s.w)));
        *(LAS u32x4*)(sgl + t * 512 + 8 * ch) = w; }
    const float cb = p->in[I_CONVB][l * 512 + c], lg = p->in[I_CLNG][l * 512 + c], lb = p->in[I_CLNB][l * 512 + c];
    float wk[31];
#pragma unroll
    for (int k = 0; k < 31; ++k) wk[k] = p->in[I_CONVW][((size_t)l * 31 + k) * 512 + c];
    __syncthreads();
    if (last) {
        float* dst = samp ? p->out + O_SCONV + (((size_t)l * 32 + b) * 30) * 512 + c : p->out + O_PCONV + ((size_t)l * 30) * 512 + c;
#pragma unroll
        for (int t = 2; t < 32; ++t) dst[(size_t)(t - 2) * 512] = gl[(30 + t) * CGS + c];
    }
    bf16_t* oa = (bf16_t*)(p->ws + WS_OCAT);
#pragma unroll 1
    for (int half = 0; half < 2; ++half) {
        float z[46];
#pragma unroll
        for (int i = 0; i < 46; ++i) z[i] = gl[(16 * half + i) * CGS + c];
        float hv[16];
#pragma unroll
        for (int tt = 0; tt < 16; ++tt) hv[tt] = cb;
#pragma unroll
        for (int k = 0; k < 31; ++k) {
#pragma unroll
            for (int tt = 0; tt < 16; ++tt) hv[tt] += z[tt + k] * wk[k]; }
#pragma unroll
        for (int tt = 0; tt < 16; ++tt) { float s1 = hv[tt], s2 = hv[tt] * hv[tt];
            s1 += dpp_mov<0xB1>(s1); s2 += dpp_mov<0xB1>(s2); s1 += dpp_mov<0x4E>(s1); s2 += dpp_mov<0x4E>(s2); s1 += dpp_mov<0x141>(s1); s2 += dpp_mov<0x141>(s2); s1 += dpp_mov<0x140>(s1); s2 += dpp_mov<0x140>(s2);
            s1 = xhalf_sum(s1); s2 = xhalf_sum(s2);
            if ((lane & 47) == 0) { red[((wave * 2 + (lane >> 4)) * 16 + tt) * 2] = s1; red[((wave * 2 + (lane >> 4)) * 16 + tt) * 2 + 1] = s2; } }
        __syncthreads();
        if (tid < 16) { float s1 = 0.f, s2 = 0.f;
#pragma unroll
            for (int w = 0; w < 16; ++w) { s1 += red[(w * 16 + tid) * 2]; s2 += red[(w * 16 + tid) * 2 + 1]; }
            const float mean = s1 * (1.f / 512.f), var = fmaxf(s2 * (1.f / 512.f) - mean * mean, 0.f);
            st[tid * 2] = mean; st[tid * 2 + 1] = 1.f / sqrtf(var + 1e-5f); }
        __syncthreads();
#pragma unroll
        for (int tt = 0; tt < 16; ++tt) { const float y = (hv[tt] - st[tt * 2]) * st[tt * 2 + 1] * lg + lb; const int t = 16 * half + tt;
            sgl[t * 512 + c] = f2bf(siluf_(y) * bf2f(sgl[t * 512 + c])); }
    }
    __syncthreads();
#pragma unroll
    for (int k = 0; k < 4; ++k) { const int task = tid + 512 * k, t = task >> 6, ch = task & 63; *(u32x4*)(oa + (size_t)(row0 + t) * 2048 + 8 * ch) = *(const LAS u32x4*)(sgl + t * 512 + 8 * ch); }
    __syncthreads();
}
__device__ __forceinline__ void pool_unit(KP p, int l, int tile, LAS unsigned char* lds, int tid) {
    const bf16_t* U = (const bf16_t*)(p->ws + WS_U);
    const int c = tid, wave = tid >> 6, lane = tid & 63;
    const bool samp = tile >= 512; const int b = tile - 512, row0 = samp ? TP + b * 32 : tile * 32;
    constexpr int PST = 520;
    LAS float* zl = (LAS float*)lds;
    LAS bf16_t* pl = (LAS bf16_t*)(lds + 47 * CGS * 4);
    {
        u32x4 vv[6]; f32x4 h0[2], h1[2];
#pragma unroll
        for (int k = 0; k < 6; ++k) { const int task = tid + 512 * k, i = (task < 47 * 64 ? task : 47 * 64 - 1) >> 6, ch = task & 63, rel = i - 15; const int rowc = row0 + rel < 0 ? 0 : (rel < 0 && samp ? row0 : row0 + rel);
            vv[k] = *(const u32x4*)(U + (size_t)rowc * NU + U_DIN + 8 * ch); }
#pragma unroll
        for (int k = 0; k < 2; ++k) { h0[k] = (f32x4){0.f, 0.f, 0.f, 0.f}; h1[k] = h0[k]; }
        if (samp) {
#pragma unroll
            for (int k = 0; k < 2; ++k) { const int task = tid + 512 * k, i = task >> 6, ch = task & 63; const float* hp = p->in[I_SPOOL] + (((size_t)l * 32 + b) * 15 + (i < 15 ? i : 14)) * 512 + 8 * ch; h0[k] = *(const f32x4*)hp; h1[k] = *(const f32x4*)(hp + 4); } }
#pragma unroll
        for (int k = 0; k < 6; ++k) { const int task = tid + 512 * k, i = task >> 6, ch = task & 63, rel = i - 15; const u32x4 v = vv[k];
            f32x4 o0 = (f32x4){bflo(v.x), bfhi(v.x), bflo(v.y), bfhi(v.y)}, o1 = (f32x4){bflo(v.z), bfhi(v.z), bflo(v.w), bfhi(v.w)};
            const bool hist = rel < 0 && samp, zero = !hist && row0 + rel < 0;
            if (k < 2) { o0 = hist ? h0[k & 1] : o0; o1 = hist ? h1[k & 1] : o1; }
            const float zm = zero ? 0.f : 1.f; o0 = o0 * zm; o1 = o1 * zm;
            if (task < 47 * 64) { *(LAS f32x4*)(zl + i * CGS + 8 * ch) = o0; *(LAS f32x4*)(zl + i * CGS + 8 * ch + 4) = o1; } }
    }
    u32x4 sgv[4];
#pragma unroll
    for (int k = 0; k < 4; ++k) { const int task = tid + 512 * k; sgv[k] = *(const u32x4*)(U + (size_t)(row0 + (task >> 6)) * NU + U_DSG + 8 * (task & 63)); }
    __syncthreads();
    {
        float z[47];
#pragma unroll
        for (int i = 0; i < 47; ++i) z[i] = zl[i * CGS + c];
        if (samp || tile == 511) {
            float* dst = samp ? p->out + O_SPOOL + (((size_t)l * 32 + b) * 15) * 512 + c : p->out + O_PPOOL + ((size_t)l * 15) * 512 + c;
#pragma unroll
            for (int t = 17; t < 32; ++t) dst[(size_t)(t - 17) * 512] = z[15 + t];
        }
        const int w = 2 << (c >> 7);
#pragma unroll
        for (int t = 0; t < 32; ++t) { float s = 0.f;
#pragma unroll
            for (int i = 0; i < 16; ++i) s += (i < w) ? z[15 + t - i] : 0.f;
            const int pos = samp ? PAST + t : row0 + t; const int cnt = (pos + 1 < w) ? pos + 1 : w;
            pl[t * PST + c] = f2bf(s / (float)cnt - z[15 + t]); }
    }
    __syncthreads();
    LAS bf16_t* sl = (LAS bf16_t*)lds;
    LAS bf16_t* ol = sl + 32 * PST;
#pragma unroll
    for (int k = 0; k < 4; ++k) { const int task = tid + 512 * k, t = task >> 6, ch = task & 63; const u32x4 s = sgv[k];
        u32x4 w; w.x = cvt_pk_bf16(siluf_(bflo(s.x)), siluf_(bfhi(s.x))); w.y = cvt_pk_bf16(siluf_(bflo(s.y)), siluf_(bfhi(s.y))); w.z = cvt_pk_bf16(siluf_(bflo(s.z)), siluf_(bfhi(s.z))); w.w = cvt_pk_bf16(siluf_(bflo(s.w)), siluf_(bfhi(s.w)));
        *(LAS u32x4*)(sl + t * PST + 8 * ch) = w; }
    __syncthreads();
    {
        const int g = wave >> 1, fr = lane & 15, kq = lane >> 4;
        const bf16_t* WT = (const bf16_t*)(p->ws + WS_POOLW) + (size_t)(l * 4 + g) * 128 * 128;
        f32x4 acc[2][4];
#pragma unroll
        for (int mt = 0; mt < 2; ++mt)
#pragma unroll
            for (int nt = 0; nt < 4; ++nt) acc[mt][nt] = (f32x4){0.f, 0.f, 0.f, 0.f};
        bf16x8 bfr[4][4];
#pragma unroll
        for (int ks = 0; ks < 4; ++ks)
#pragma unroll
            for (int nt = 0; nt < 4; ++nt) bfr[ks][nt] = *(const bf16x8*)(WT + (size_t)((wave & 1) * 64 + 16 * nt + fr) * 128 + 32 * ks + 8 * kq);
#pragma unroll
        for (int ks = 0; ks < 4; ++ks) {
            bf16x8 af[2];
#pragma unroll
            for (int mt = 0; mt < 2; ++mt) af[mt] = *(const LAS bf16x8*)(pl + (16 * mt + fr) * PST + g * 128 + 32 * ks + 8 * kq);
#pragma unroll
            for (int nt = 0; nt < 4; ++nt) {
#pragma unroll
                for (int mt = 0; mt < 2; ++mt) acc[mt][nt] = __builtin_amdgcn_mfma_f32_16x16x32_bf16(af[mt], bfr[ks][nt], acc[mt][nt], 0, 0, 0); }
        }
#pragma unroll
        for (int nt = 0; nt < 4; ++nt) { const int d = wave * 64 + 16 * nt + fr; const float pb = p->in[I_POOLB][l * 512 + d], ps = p->in[I_POOLS][l * 512 + d];
#pragma unroll
            for (int mt = 0; mt < 2; ++mt)
#pragma unroll
                for (int r = 0; r < 4; ++r) { const int t = 16 * mt + 4 * kq + r; ol[t * PST + d] = f2bf((acc[mt][nt][r] + pb) * ps * bf2f(sl[t * PST + d])); } }
    }
    __syncthreads();
    bf16_t* od = (bf16_t*)(p->ws + WS_OCAT) + 3 * 512;
#pragma unroll
    for (int k = 0; k < 4; ++k) { const int task = tid + 512 * k, t = task >> 6, ch = task & 63; *(u32x4*)(od + (size_t)(row0 + t) * 2048 + 8 * ch) = *(const LAS u32x4*)(ol + t * PST + 8 * ch); }
    __syncthreads();
}
__device__ __forceinline__ void fp_unit(KP p, int l, int h, LAS unsigned char* lds, int tid) {
    const float* lf = p->out + O_PLF + (size_t)l * TP * 8 + h;
    LAS float* part = (LAS float*)lds;
    float v[32]; float s = 0.f;
#pragma unroll
    for (int i = 0; i < 32; ++i) { v[i] = lf[(size_t)(tid * 32 + i) * 8]; s += v[i]; }
    part[tid] = s;
    __syncthreads();
    float pre = 0.f;
    for (int j = 0; j < tid; ++j) pre += part[j];
    float* F = (float*)(p->ws + WS_FP) + (size_t)h * TP + tid * 32;
#pragma unroll
    for (int i = 0; i < 32; ++i) { pre += v[i]; F[i] = pre * LOG2E; }
    __syncthreads();
}
__device__ __forceinline__ void gs_unit(KP p, int l, int b, LAS unsigned char* lds, int tid) {
    const int h = tid & 7, ch = tid >> 3;
    const float* cl = p->in[I_CLF] + (((size_t)l * 32 + b) * PAST + ch * 64) * 8 + h;
    LAS float* part = (LAS float*)lds;
    float v[64]; float s = 0.f;
#pragma unroll
    for (int i = 0; i < 64; ++i) v[i] = cl[(size_t)i * 8];
#pragma unroll
    for (int i = 0; i < 64; ++i) s += v[i];
    part[ch * 8 + h] = s;
    __syncthreads();
    float suf = 0.f;
    for (int j = ch + 1; j < 64; ++j) suf += part[j * 8 + h];
    float* G = (float*)(p->ws + WS_GS) + ((size_t)b * 8 + h) * GS_LEN + ch * 64;
#pragma unroll
    for (int i = 63; i >= 0; --i) { G[i] = -suf * LOG2E; suf += v[i]; }
    if (tid < 8) { const float* nl = p->out + O_SLF + ((size_t)l * 1024 + b * 32) * 8 + tid; float* Gn = (float*)(p->ws + WS_GS) + ((size_t)b * 8 + tid) * GS_LEN + PAST; float w[32]; float run = 0.f;
#pragma unroll
        for (int i = 0; i < 32; ++i) w[i] = nl[i * 8];
#pragma unroll
        for (int i = 0; i < 32; ++i) { run += w[i]; Gn[i] = run * LOG2E; } }
    __syncthreads();
}
__device__ __forceinline__ void vt_tile(KP p, int l, int tile, LAS unsigned char* lds, int wave, int lane) {
    const int h = tile >> 8, tb = tile & 255, tl = lane >> 3, q8 = (lane & 7) * 8;
    const bf16_t* U = (const bf16_t*)(p->ws + WS_U);
    LAS unsigned short* scr = (LAS unsigned short*)(lds + wave * (64 * 72 * 2));
    u32x4 kv[8], vv[8];
#pragma unroll
    for (int i = 0; i < 8; ++i) { const bf16_t* rp = U + (size_t)(tb * 64 + 8 * i + tl) * NU + h * 64 + q8; kv[i] = *(const u32x4*)(rp + U_K); vv[i] = *(const u32x4*)(rp + U_V); }
    float mx = 0.f;
#pragma unroll
    for (int i = 0; i < 8; ++i) { const u32x4 w = kv[i];
        float s = bflo(w.x) * bflo(w.x) + bfhi(w.x) * bfhi(w.x) + bflo(w.y) * bflo(w.y) + bfhi(w.y) * bfhi(w.y) + bflo(w.z) * bflo(w.z) + bfhi(w.z) * bfhi(w.z) + bflo(w.w) * bflo(w.w) + bfhi(w.w) * bfhi(w.w);
        s += dpp_mov<0xB1>(s); s += dpp_mov<0x4E>(s); s += dpp_mov<0x141>(s); mx = fmaxf(mx, s); }
    mx = wave_max(mx);
    if (lane == 0) atomicMax((unsigned*)(p->ws + WS_CTL) + CW_KMAX + l * 8 + h, __float_as_uint(mx));
#pragma unroll
    for (int i = 0; i < 8; ++i) { const int t = 8 * i + tl; const u32x4 w = vv[i];
        scr[(q8 + 0) * 72 + t] = (unsigned short)(w.x & 0xffffu); scr[(q8 + 1) * 72 + t] = (unsigned short)(w.x >> 16); scr[(q8 + 2) * 72 + t] = (unsigned short)(w.y & 0xffffu); scr[(q8 + 3) * 72 + t] = (unsigned short)(w.y >> 16);
        scr[(q8 + 4) * 72 + t] = (unsigned short)(w.z & 0xffffu); scr[(q8 + 5) * 72 + t] = (unsigned short)(w.z >> 16); scr[(q8 + 6) * 72 + t] = (unsigned short)(w.w & 0xffffu); scr[(q8 + 7) * 72 + t] = (unsigned short)(w.w >> 16); }
    bf16_t* Vt = (bf16_t*)(p->ws + WS_VT) + ((size_t)h * 64 + lane) * TP + tb * 64;
#pragma unroll
    for (int j = 0; j < 8; ++j) *(u32x4*)(Vt + 8 * j) = *(const LAS u32x4*)(scr + lane * 72 + 8 * j);
}
__device__ __forceinline__ void shift_out(KP p, int l, int tid) {
    const bf16_t* U = (const bf16_t*)(p->ws + WS_U);
    for (int base = tid; base < NSEQ * SHIFT_W; base += 512 * 8) {
        unsigned short v[8];
#pragma unroll
        for (int k = 0; k < 8; ++k) { const int idx = base + k * 512 < NSEQ * SHIFT_W ? base + k * 512 : tid; const int s = idx / SHIFT_W, j = idx - s * SHIFT_W; const int row = s == 0 ? TP - 1 : TP + (s - 1) * 32 + 31; v[k] = U[(size_t)row * NU + U_XC + j]; }
#pragma unroll
        for (int k = 0; k < 8; ++k) { const int idx = base + k * 512; if (idx < NSEQ * SHIFT_W) { const int s = idx / SHIFT_W, j = idx - s * SHIFT_W;
            float* dst = s == 0 ? p->out + O_PSHIFT + (size_t)l * SHIFT_W + j : p->out + O_SSHIFT + ((size_t)l * 32 + (s - 1)) * SHIFT_W + j; *dst = bf2f(v[k]); } }
    }
}
template <bool AT, bool BT, bool NEGA>
__device__ __forceinline__ void mm32(f32x16& acc, const LAS float* Ap, int i0, const LAS float* Bp, int j0, int lane) {
    const int li = lane & 31, kh = lane >> 5;
    const LAS float* ap = AT ? Ap + (8 * kh) * 65 + i0 + li : Ap + (i0 + li) * 65 + 8 * kh;
    const LAS float* bp = BT ? Bp + (j0 + li) * 65 + 8 * kh : Bp + (8 * kh) * 65 + j0 + li;
#pragma unroll 2
    for (int s = 0; s < 4; ++s) {
        float a[8], b[8];
#pragma unroll
        for (int e = 0; e < 8; ++e) { a[e] = AT ? ap[(16 * s + e) * 65] : ap[16 * s + e]; b[e] = BT ? bp[16 * s + e] : bp[(16 * s + e) * 65]; }
        if (NEGA) {
#pragma unroll
            for (int e = 0; e < 8; ++e) a[e] = -a[e]; }
        const bf16x8 af = pack8f((f32x4){a[0], a[1], a[2], a[3]}, (f32x4){a[4], a[5], a[6], a[7]}), bfg = pack8f((f32x4){b[0], b[1], b[2], b[3]}, (f32x4){b[4], b[5], b[6], b[7]});
        acc = __builtin_amdgcn_mfma_f32_32x32x16_bf16(af, bfg, acc, 0, 0, 0);
    }
}
template <int MASK>
__device__ __forceinline__ void st_tile(LAS float* dst, const f32x16& acc, int i0, int j0, int lane) {
    const int li = lane & 31, hi = lane >> 5, j = j0 + li;
#pragma unroll
    for (int r = 0; r < 16; ++r) { const int i = i0 + (r & 3) + 8 * (r >> 2) + 4 * hi; float v = acc[r];
        if (MASK == 1 && !(i < j)) v = 0.f; if (MASK == 2 && !(i <= j)) v = 0.f; dst[i * 65 + j] = v; }
}
struct RwkvSeqInfo { int row0, ntok, prev_kind  , b; };
__device__ __forceinline__ RwkvSeqInfo rwkv_info(int cu) { RwkvSeqInfo s; if (cu < 256) { s.row0 = cu * 64; s.ntok = 64; s.prev_kind = cu == 0 ? 0 : 1; s.b = 0; } else { s.b = cu - 256; s.row0 = TP + s.b * 32; s.ntok = 32; s.prev_kind = 2; } return s; }

__device__ __forceinline__ void rwkv_r1(KP p, int l, int unit, int unit_next, bool first, LAS unsigned char* lds, int tid) {
    const int cu = unit >> 3, h = unit & 7, wave = tid >> 6, lane = tid & 63, li = lane & 31, hi = lane >> 5;
    const RwkvSeqInfo si = rwkv_info(cu);
    const bf16_t* U = (const bf16_t*)(p->ws + WS_U);
    LAS float* S0 = (LAS float*)lds; LAS float *S1 = S0 + SLOT_F, *S2 = S0 + 2 * SLOT_F, *S3 = S0 + 3 * SLOT_F, *S4 = S0 + 4 * SLOT_F, *S5 = S0 + 5 * SLOT_F, *S6 = S0 + 6 * SLOT_F, *S7 = S0 + 7 * SLOT_F, *S8 = S0 + 8 * SLOT_F;
    LAS float* gC = S0 + 9 * SLOT_F;
    LAS float* mul = gC + 64;
    const int q = wave >> 2, wq = wave & 3, i0 = (wq >> 1) * 32, j0 = (wq & 1) * 32;
    PT0();
    if (first) { if (tid < 320) { const int s = tid >> 6, j = tid & 63; mul[tid] = p->in[I_MU][l * SHIFT_W + (s < 3 ? s * 512 + h * 64 : 1536 + (s - 3) * 64) + j]; }
        __syncthreads(); }
    {
        const int tl = lane >> 3, q8 = (lane & 7) * 8;
        u32x4 cur[5], prv[5]; f32x4 w2v[2], a2v[2];
#pragma unroll
        for (int k = 0; k < 5; ++k) { const int pid = wave * 5 + k, s = pid >> 3, tb = pid & 7, t = tb * 8 + tl;
            const int xo = (s < 3 ? s * 512 + h * 64 : 1536 + (s - 3) * 64) + q8;
            const int tc = t < si.ntok ? t : si.ntok - 1, tp = tc > 0 ? tc - 1 : (si.prev_kind == 1 ? -1 : 0);
            cur[k] = *(const u32x4*)(U + (size_t)(si.row0 + tc) * NU + U_XC + xo); prv[k] = *(const u32x4*)(U + (size_t)(si.row0 + tp) * NU + U_XC + xo); }
#pragma unroll
        for (int i = 0; i < 2; ++i) { const int f = tid + 512 * i, m = f >> 4, c4 = (f & 15) * 4;
            w2v[i] = *(const f32x4*)(p->in[I_W2] + ((size_t)l * 64 + m) * 512 + h * 64 + c4); a2v[i] = *(const f32x4*)(p->in[I_A2] + ((size_t)l * 64 + m) * 512 + h * 64 + c4); }
        const int kz = (8 - ((wave * 5) & 7)) & 7;
        f32x4 ss0 = {0.f, 0.f, 0.f, 0.f}, ss1 = ss0;
        if (si.prev_kind == 2 && kz < 5) { const int s = (wave * 5 + kz) >> 3; const float* sp = p->in[I_SSHIFT] + ((size_t)l * 32 + si.b) * SHIFT_W + (s < 3 ? s * 512 + h * 64 : 1536 + (s - 3) * 64) + q8;
            ss0 = *(const f32x4*)sp; ss1 = *(const f32x4*)(sp + 4); }
#pragma unroll
        for (int k = 0; k < 5; ++k) { const int pid = wave * 5 + k, s = pid >> 3, tb = pid & 7, t = tb * 8 + tl;
            LAS float* dst = (s == 0 ? S0 : s == 1 ? S1 : s == 2 ? S2 : s == 3 ? S3 : S4) + t * 65 + q8;
            const f32x4 ma = *(const LAS f32x4*)(mul + s * 64 + q8), mb = *(const LAS f32x4*)(mul + s * 64 + q8 + 4);
            const u32x4 cw = cur[k], pw = prv[k];
            const float x[8] = {bflo(cw.x), bfhi(cw.x), bflo(cw.y), bfhi(cw.y), bflo(cw.z), bfhi(cw.z), bflo(cw.w), bfhi(cw.w)};
            const float pu[8] = {bflo(pw.x), bfhi(pw.x), bflo(pw.y), bfhi(pw.y), bflo(pw.z), bfhi(pw.z), bflo(pw.w), bfhi(pw.w)};
            const bool ext = (t == 0 && si.prev_kind != 1);
            const float vm = (t < si.ntok) ? 1.f : 0.f;
            float xs[8];
#pragma unroll
            for (int e = 0; e < 8; ++e) { const float mu = e < 4 ? ma[e] : mb[e - 4], sv = e < 4 ? ss0[e] : ss1[e - 4]; const float pv = ext ? sv : pu[e]; xs[e] = (x[e] + (pv - x[e]) * mu) * vm; }
            if (s == 3) {
#pragma unroll
                for (int e = 0; e < 8; ++e) xs[e] = fast_tanh(xs[e]); }
#pragma unroll
            for (int e = 0; e < 8; ++e) dst[e] = xs[e];
        }
#pragma unroll
        for (int i = 0; i < 2; ++i) { const int f = tid + 512 * i, m = f >> 4, c4 = (f & 15) * 4;
#pragma unroll
            for (int e = 0; e < 4; ++e) { S5[m * 65 + c4 + e] = w2v[i][e]; S6[m * 65 + c4 + e] = a2v[i][e]; } }
    }
    __syncthreads();
    PT1(1);
    {
        f32x16 acc = {};
        const int c = j0 + li;
        if (q == 0) { mm32<false, false, false>(acc, S3, i0, S5, j0, lane); const float w0 = p->in[I_W0][l * 512 + h * 64 + c];
#pragma unroll
            for (int r = 0; r < 16; ++r) { const int t = i0 + (r & 3) + 8 * (r >> 2) + 4 * hi; const float zz = acc[r] + w0;
                const float sp = fmaxf(-zz, 0.f) + __logf(1.f + __expf(-fabsf(zz)));
                S7[t * 65 + c] = -__expf(-sp - 0.5f) * ((t < si.ntok) ? 1.f : 0.f); } }
        else { mm32<false, false, false>(acc, S4, i0, S6, j0, lane); const float a0 = p->in[I_A0][l * 512 + h * 64 + c];
#pragma unroll
            for (int r = 0; r < 16; ++r) { const int t = i0 + (r & 3) + 8 * (r >> 2) + 4 * hi; S8[t * 65 + c] = __builtin_amdgcn_rcpf(1.f + __expf(-(acc[r] + a0))); } }
    }
    __syncthreads();
    PT1(2);
    if (wave == 0) { float run = 0.f;
#pragma unroll 8
        for (int t = 0; t < 64; ++t) { run += S7[t * 65 + lane]; S3[t * 65 + lane] = run; } }
    else { const int c = lane; const float kkw = p->in[I_KK][l * 512 + h * 64 + c], kaw = p->in[I_KA][l * 512 + h * 64 + c], rkw = p->in[I_RK][l * 512 + h * 64 + c];
        for (int t = wave - 1; t < 64; t += 7) { const float kr = S1[t * 65 + c], kv = kr * kkw; const float ss = wave_sum(kv * kv);
            const float kn = kv * (1.f / sqrtf(fmaxf(ss, 1e-24f))); const float a = S8[t * 65 + c]; const float km = kr * (1.f + (a - 1.f) * kaw);
            const float bon = wave_sum(S0[t * 65 + c] * km * rkw);
            S4[t * 65 + c] = kn; S1[t * 65 + c] = km; S8[t * 65 + c] = kn * a;
            if (lane == 0) ((float*)(p->ws + WS_BONUS))[(size_t)unit * 64 + t] = bon; } }
    __syncthreads();
    { const int c = tid & 63, tq = tid >> 6;
#pragma unroll
        for (int tt = 0; tt < 8; ++tt) { const int t = tq * 8 + tt, o = t * 65 + c; const float Lg = S3[o], lw = S7[o];
            const float g = __expf(Lg), gi = __expf(-Lg), gp = __expf(Lg - lw);
            S0[o] *= g; S1[o] *= gi; S8[o] *= gi; S4[o] *= gp; if (t == 63) gC[c] = g; } }
    __syncthreads();
    PT1(3);
    unsigned touch = 0u;
    if (unit_next < NRU && tid < 65 * 5) { const RwkvSeqInfo sn = rwkv_info(unit_next >> 3); const int hn = unit_next & 7, rr = tid / 5, ln = tid - rr * 5;
        const int trow = rr == 0 ? (sn.prev_kind == 1 ? -1 : 0) : (rr - 1 < sn.ntok ? rr - 1 : sn.ntok - 1);
        const int xo = ln < 3 ? ln * 512 + hn * 64 : 1536 + (ln - 3) * 64;
        touch = *(const unsigned*)(U + (size_t)(sn.row0 + trow) * NU + U_XC + xo); }
    { f32x16 acc = {};
      if (q == 0) { mm32<false, true, false>(acc, S1, i0, S4, j0, lane); st_tile<1>(S3, acc, i0, j0, lane); }
      else { mm32<false, true, false>(acc, S8, i0, S4, j0, lane); st_tile<1>(S5, acc, i0, j0, lane); } }
    __syncthreads();
    { f32x16 acc = {};
      if (q == 0) { mm32<true, false, false>(acc, S2, i0, S3, j0, lane); st_tile<0>(S6, acc, i0, j0, lane); }
      else { mm32<false, true, false>(acc, S1, i0, S0, j0, lane); st_tile<2>(S7, acc, i0, j0, lane); } }
    __syncthreads();
    asm volatile("" :: "v"(touch));
    PT1(4);
    { float xa[4], xb[4]; const int ra = 4 * wave, rb = 60 - 4 * wave;
#pragma unroll
      for (int k = 0; k < 4; ++k) { xa[k] = (lane == ra + k) ? 1.f : 0.f; xb[k] = (lane == rb + k) ? 1.f : 0.f; }
      for (int s = ra; s < rb; ++s) { const float mrow = S5[s * 65 + lane];
#pragma unroll
          for (int k = 0; k < 4; ++k) xa[k] -= __builtin_bit_cast(float, __builtin_amdgcn_readlane(__builtin_bit_cast(int, xa[k]), s)) * mrow; }
      for (int s = rb; s < 63; ++s) { const float mrow = S5[s * 65 + lane]; float ya[4], yb[4];
#pragma unroll
          for (int k = 0; k < 4; ++k) { ya[k] = __builtin_bit_cast(float, __builtin_amdgcn_readlane(__builtin_bit_cast(int, xa[k]), s)); yb[k] = __builtin_bit_cast(float, __builtin_amdgcn_readlane(__builtin_bit_cast(int, xb[k]), s)); }
#pragma unroll
          for (int k = 0; k < 4; ++k) { xa[k] -= ya[k] * mrow; xb[k] -= yb[k] * mrow; } }
#pragma unroll
      for (int k = 0; k < 4; ++k) { S3[(ra + k) * 65 + lane] = xa[k]; S3[(rb + k) * 65 + lane] = xb[k]; } }
    __syncthreads();
    { f32x16 acc = {};
      if (q == 0) mm32<true, false, false>(acc, S4, i0, S3, j0, lane); else mm32<false, false, false>(acc, S6, i0, S3, j0, lane);
      __syncthreads();
      st_tile<0>(q == 0 ? S3 : S6, acc, i0, j0, lane); }
    __syncthreads();
    PT1(5);
    { f32x16 acc = {};
      if (q == 1) { mm32<false, true, false>(acc, S8, i0, S0, j0, lane); st_tile<2>(S4, acc, i0, j0, lane); }
      else { mm32<false, false, false>(acc, S3, i0, S8, j0, lane);
          const int jc = j0 + li; const float gc = gC[jc]; float* TQ = (float*)(p->ws + WS_TQ) + (size_t)unit * 4096;
#pragma unroll
          for (int rg = 0; rg < 4; ++rg) { const int ab = i0 + 8 * rg + 4 * hi; f32x4 o;
#pragma unroll
              for (int e = 0; e < 4; ++e) o[e] = ((ab + e == jc) ? gc : 0.f) - acc[rg * 4 + e] * gc;
              *(f32x4*)(TQ + ((((jc >> 4) * 4 + (ab >> 4)) * 64 + ((ab & 15) >> 2) * 16 + (jc & 15)) * 4)) = o; } } }
    __syncthreads();
    { f32x16 acc = {};
      if (q == 0) { mm32<true, false, false>(acc, S2, i0, S1, j0, lane); mm32<false, false, true>(acc, S6, i0, S8, j0, lane);
          const int jc = j0 + li; const float gc = gC[jc]; float* GM = (float*)(p->ws + WS_GM) + (size_t)unit * 4096;
#pragma unroll
          for (int r = 0; r < 16; ++r) GM[(i0 + (r & 3) + 8 * (r >> 2) + 4 * hi) * 64 + jc] = acc[r] * gc; }
      else { mm32<true, false, false>(acc, S2, i0, S7, j0, lane); mm32<false, false, true>(acc, S6, i0, S4, j0, lane);
          float* Y0T = (float*)(p->ws + WS_Y0T) + (size_t)unit * 4096;
#pragma unroll
          for (int rg = 0; rg < 4; ++rg) *(f32x4*)(Y0T + (((((j0 >> 5) * 2 + (i0 >> 5)) * 4 + rg) * 2 + hi) * 32 + li) * 4) = (f32x4){acc[rg * 4], acc[rg * 4 + 1], acc[rg * 4 + 2], acc[rg * 4 + 3]}; } }
    if (q == 0) { f32x16 acc;
#pragma unroll
        for (int r = 0; r < 16; ++r) acc[r] = S0[(j0 + li) * 65 + i0 + (r & 3) + 8 * (r >> 2) + 4 * hi];
        mm32<false, false, true>(acc, S3, i0, S4, j0, lane);
        float* ET = (float*)(p->ws + WS_ET) + (size_t)unit * 4096;
#pragma unroll
        for (int rg = 0; rg < 4; ++rg) *(f32x4*)(ET + ((((j0 >> 5) * 2 + (i0 >> 5)) * 8 + 2 * rg + hi) * 32 + li) * 4) = (f32x4){acc[rg * 4], acc[rg * 4 + 1], acc[rg * 4 + 2], acc[rg * 4 + 3]}; }
    __syncthreads();
    PT1(6);
}
template <bool SCQ>
__device__ __forceinline__ void chain_run(f32x4 (&st)[4], const float* TQ, const float* GM, float* SC, int nsteps, int i, int g, int lane) {
    constexpr size_t STRIDE = (size_t)8 * 4096;
    f32x4 tq[16], gm[4];
#pragma unroll
    for (int x = 0; x < 16; ++x) tq[x] = *(const f32x4*)(TQ + (x * 64 + lane) * 4);
#pragma unroll
    for (int tl = 0; tl < 4; ++tl) gm[tl] = GM ? *(const f32x4*)(GM + i * 64 + 16 * tl + 4 * g) : (f32x4){0.f, 0.f, 0.f, 0.f};
    for (int c = 0; c < nsteps; ++c) {
        if (SC) {
            if (SCQ) {
#pragma unroll
                for (int tl = 0; tl < 4; ++tl) *(f32x4*)(SC + c * STRIDE + ((((i >> 5) * 2 + (tl >> 1)) * 8 + 4 * (tl & 1) + g) * 32 + (i & 31)) * 4) = st[tl]; }
            else {
#pragma unroll
                for (int tl = 0; tl < 4; ++tl) *(f32x4*)(SC + c * STRIDE + i * 64 + 16 * tl + 4 * g) = st[tl]; } }
        f32x4 tqn[16], gmn[4];
        const int cn = (c + 1 < nsteps) ? c + 1 : c;
#pragma unroll
        for (int x = 0; x < 16; ++x) tqn[x] = *(const f32x4*)(TQ + cn * STRIDE + (x * 64 + lane) * 4);
#pragma unroll
        for (int tl = 0; tl < 4; ++tl) gmn[tl] = GM ? *(const f32x4*)(GM + cn * STRIDE + i * 64 + 16 * tl + 4 * g) : (f32x4){0.f, 0.f, 0.f, 0.f};
        f32x4 acc[4];
#pragma unroll
        for (int tp = 0; tp < 4; ++tp) acc[tp] = gm[tp];
#pragma unroll
        for (int tl = 0; tl < 4; ++tl)
#pragma unroll
            for (int r = 0; r < 4; ++r)
#pragma unroll
                for (int tp = 0; tp < 4; ++tp) acc[tp] = __builtin_amdgcn_mfma_f32_16x16x4f32(tq[tp * 4 + tl][r], st[tl][r], acc[tp], 0, 0, 0);
#pragma unroll
        for (int tl = 0; tl < 4; ++tl) st[tl] = acc[tl];
#pragma unroll
        for (int x = 0; x < 16; ++x) tq[x] = tqn[x];
#pragma unroll
        for (int tl = 0; tl < 4; ++tl) gm[tl] = gmn[tl];
    }
}
constexpr int CH_SLOT = 32768;
#define CH_LD(R, STEP) do { const int s_ = (STEP) < nsteps ? (STEP) : nsteps - 1; _Pragma("unroll") for (int k = 0; k < 4; ++k) { R[k] = *(const f32x4*)(TQ + (size_t)s_ * STRIDE + (k * 256 + ll) * 4); \
        R[4 + k] = GM ? *(const f32x4*)(GM + (size_t)s_ * STRIDE + (k * 256 + ll) * 4) : (f32x4){0.f, 0.f, 0.f, 0.f}; } } while (0)
#define CH_WR(R, SLOT) do { LAS unsigned char* d_ = lds + (SLOT) * CH_SLOT; _Pragma("unroll") for (int k = 0; k < 4; ++k) { const int f_ = k * 256 + ll, x_ = f_ >> 6, ln_ = f_ & 63; const f32x4 v_ = R[k]; \
        const unsigned h0_ = cvt_pk_bf16(v_[0], v_[1]), h1_ = cvt_pk_bf16(v_[2], v_[3]); const unsigned l0_ = cvt_pk_bf16(v_[0] - bflo(h0_), v_[1] - bfhi(h0_)), l1_ = cvt_pk_bf16(v_[2] - bflo(h1_), v_[3] - bfhi(h1_)); \
        const int o_ = ((((x_ >> 2) * 2 + ((x_ & 3) >> 1)) * 64 + ln_) * 16) + (x_ & 1) * 8; \
        *(LAS u32x2*)(d_ + o_) = (u32x2){h0_, h1_}; *(LAS u32x2*)(d_ + 8192 + o_) = (u32x2){l0_, l1_}; \
        *(LAS f32x4*)((LAS float*)d_ + 4096 + (k * 256 + ll) * 4) = R[4 + k]; } } while (0)
#define CH_BAR() asm volatile("s_waitcnt lgkmcnt(0)\n\ts_barrier" ::: "memory")
template <bool SCQ>
__device__ __forceinline__ void chain_block(f32x4 (&st)[4], const float* TQ, const float* GM, float* SC, int nsteps, LAS unsigned char* lds, int wave, int lane) {
    constexpr size_t STRIDE = (size_t)8 * 4096;
    if (wave >= 4) {
        const int ll = (wave - 4) * 64 + lane;
        f32x4 r0[8], r1[8], r2[8];
        CH_LD(r0, 0); CH_LD(r1, 1); CH_LD(r2, 2);
        CH_WR(r0, 0);
        __syncthreads();
        for (int c = 0; c < nsteps; c += 3) {
            CH_WR(r1, (c + 1) & 1); CH_LD(r0, c + 3); CH_BAR();
            if (c + 1 < nsteps) { CH_WR(r2, (c + 2) & 1); CH_LD(r1, c + 4); CH_BAR(); }
            if (c + 2 < nsteps) { CH_WR(r0, (c + 3) & 1); CH_LD(r2, c + 5); CH_BAR(); }
        }
    } else {
        const int fr = lane & 15, g = lane >> 4, i = wave * 16 + fr;
        __syncthreads();
        for (int c = 0; c < nsteps; ++c) {
            if (SC) {
                if (SCQ) {
#pragma unroll
                    for (int tl = 0; tl < 4; ++tl) *(f32x4*)(SC + c * STRIDE + ((((i >> 5) * 2 + (tl >> 1)) * 8 + 4 * (tl & 1) + g) * 32 + (i & 31)) * 4) = st[tl]; }
                else {
#pragma unroll
                    for (int tl = 0; tl < 4; ++tl) *(f32x4*)(SC + c * STRIDE + i * 64 + 16 * tl + 4 * g) = st[tl]; } }
            const LAS unsigned char* slb = lds + (c & 1) * CH_SLOT; const LAS float* sl = (const LAS float*)slb;
            f32x4 acc[4];
#pragma unroll
            for (int tp = 0; tp < 4; ++tp) acc[tp] = *(const LAS f32x4*)(sl + 4096 + i * 64 + 16 * tp + 4 * g);
            bf16x8 bh[2], bl[2];
#pragma unroll
            for (int s = 0; s < 2; ++s) { const f32x4 u0 = st[2 * s], u1 = st[2 * s + 1];
                u32x4 hw; hw.x = cvt_pk_bf16(u0[0], u0[1]); hw.y = cvt_pk_bf16(u0[2], u0[3]); hw.z = cvt_pk_bf16(u1[0], u1[1]); hw.w = cvt_pk_bf16(u1[2], u1[3]);
                u32x4 lw; lw.x = cvt_pk_bf16(u0[0] - bflo(hw.x), u0[1] - bfhi(hw.x)); lw.y = cvt_pk_bf16(u0[2] - bflo(hw.y), u0[3] - bfhi(hw.y)); lw.z = cvt_pk_bf16(u1[0] - bflo(hw.z), u1[1] - bfhi(hw.z)); lw.w = cvt_pk_bf16(u1[2] - bflo(hw.w), u1[3] - bfhi(hw.w));
                bh[s] = __builtin_bit_cast(bf16x8, hw); bl[s] = __builtin_bit_cast(bf16x8, lw); }
#pragma unroll
            for (int s = 0; s < 2; ++s)
#pragma unroll
                for (int tp = 0; tp < 4; ++tp) { const bf16x8 ah = *(const LAS bf16x8*)(slb + ((tp * 2 + s) * 64 + lane) * 16), al = *(const LAS bf16x8*)(slb + 8192 + ((tp * 2 + s) * 64 + lane) * 16);
                    acc[tp] = __builtin_amdgcn_mfma_f32_16x16x32_bf16(ah, bh[s], acc[tp], 0, 0, 0); acc[tp] = __builtin_amdgcn_mfma_f32_16x16x32_bf16(al, bh[s], acc[tp], 0, 0, 0); acc[tp] = __builtin_amdgcn_mfma_f32_16x16x32_bf16(ah, bl[s], acc[tp], 0, 0, 0); }
#pragma unroll
            for (int tl = 0; tl < 4; ++tl) st[tl] = acc[tl];
            CH_BAR();
        }
    }
}
__device__ __forceinline__ void rwkv_l1_block(KP p, int task, LAS unsigned char* lds, int wave, int lane) {
    const int kind = task & 1, h = (task >> 1) & 7, grp = task >> 4, iq = wave & 3;
    const int fr = lane & 15, g = lane >> 4, i = iq * 16 + fr;
    const size_t u0 = ((size_t)(grp * 16) * 8 + h) * 4096;
    f32x4 st[4];
#pragma unroll
    for (int tl = 0; tl < 4; ++tl)
#pragma unroll
        for (int r = 0; r < 4; ++r) st[tl][r] = (kind == 1 && i == 16 * tl + 4 * g + r) ? 1.f : 0.f;
    chain_block<false>(st, (const float*)(p->ws + WS_TQ) + u0, kind == 0 ? (const float*)(p->ws + WS_GM) + u0 : nullptr, nullptr, 16, lds, wave, lane);
    if (wave < 4) { const size_t gb = ((size_t)grp * 8 + h) * 4096;
        if (kind == 0) { float* GG = (float*)(p->ws + WS_GG) + gb;
#pragma unroll
            for (int tl = 0; tl < 4; ++tl) *(f32x4*)(GG + i * 64 + 16 * tl + 4 * g) = st[tl]; }
        else { float* TG = (float*)(p->ws + WS_TG) + gb;
#pragma unroll
            for (int tl = 0; tl < 4; ++tl)
#pragma unroll
                for (int r = 0; r < 4; ++r) TG[((tl * 4 + iq) * 64 + (fr >> 2) * 16 + 4 * g + r) * 4 + (fr & 3)] = st[tl][r]; } }
    __syncthreads();
}
__device__ __forceinline__ void rwkv_l2_block(KP p, int l, int h, LAS unsigned char* lds, int wave, int lane) {
    const int iq = wave & 3, fr = lane & 15, g = lane >> 4, i = iq * 16 + fr;
    f32x4 st[4];
#pragma unroll
    for (int tl = 0; tl < 4; ++tl) st[tl] = (f32x4){0.f, 0.f, 0.f, 0.f};
    chain_block<false>(st, (const float*)(p->ws + WS_TG) + (size_t)h * 4096, (const float*)(p->ws + WS_GG) + (size_t)h * 4096, (float*)(p->ws + WS_SG) + (size_t)h * 4096, 16, lds, wave, lane);
    if (wave < 4) { float* dst = p->out + O_PWKV + (((size_t)l * 8 + h) * 64 + i) * 64;
#pragma unroll
        for (int tl = 0; tl < 4; ++tl) *(f32x4*)(dst + 16 * tl + 4 * g) = st[tl]; }
    __syncthreads();
}
__device__ __forceinline__ void rwkv_l3_block(KP p, int l, int task, LAS unsigned char* lds, int wave, int lane) {
    const int h = task & 7, grp = task >> 3, iq = wave & 3, fr = lane & 15, g = lane >> 4, i = iq * 16 + fr;
    f32x4 st[4];
#pragma unroll
    for (int tl = 0; tl < 4; ++tl) st[tl] = (f32x4){0.f, 0.f, 0.f, 0.f};
    if (grp > 0) chain_block<false>(st, (const float*)(p->ws + WS_TG) + (size_t)h * 4096, (const float*)(p->ws + WS_GG) + (size_t)h * 4096, nullptr, grp, lds, wave, lane);
    const size_t u0 = ((size_t)(grp * 16) * 8 + h) * 4096;
    chain_block<true>(st, (const float*)(p->ws + WS_TQ) + u0, (const float*)(p->ws + WS_GM) + u0, (float*)(p->ws + WS_SC) + u0, 16, lds, wave, lane);
    if (grp == 15 && wave < 4) { float* dst = p->out + O_PWKV + (((size_t)l * 8 + h) * 64 + i) * 64;
#pragma unroll
        for (int tl = 0; tl < 4; ++tl) *(f32x4*)(dst + 16 * tl + 4 * g) = st[tl]; }
    __syncthreads();
}
__device__ __forceinline__ void rwkv_samp_task(KP p, int l, int t2, int lane) {
    const int fr = lane & 15, g = lane >> 4, iq = t2 & 3, h = (t2 >> 2) & 7, b = t2 >> 5, i = iq * 16 + fr;
    f32x4 st[4];
    const float* s0 = p->in[I_SWKV] + ((((size_t)l * 32 + b) * 8 + h) * 64 + i) * 64;
#pragma unroll
    for (int tl = 0; tl < 4; ++tl) st[tl] = *(const f32x4*)(s0 + 16 * tl + 4 * g);
    const size_t u0 = ((size_t)(256 + b) * 8 + h) * 4096;
    chain_run<true>(st, (const float*)(p->ws + WS_TQ) + u0, (const float*)(p->ws + WS_GM) + u0, (float*)(p->ws + WS_SC) + u0, 1, i, g, lane);
    float* dst = p->out + O_SWKV + ((((size_t)l * 32 + b) * 8 + h) * 64 + i) * 64;
#pragma unroll
    for (int tl = 0; tl < 4; ++tl) *(f32x4*)(dst + 16 * tl + 4 * g) = st[tl];
}
__device__ __forceinline__ void rwkv_r3_task(KP p, int l, int task, LAS unsigned char* lds, int wave, int lane) {
    const int unit = task >> 1, th = task & 1, cu = unit >> 3, h = unit & 7, li = lane & 31, hi = lane >> 5;
    const RwkvSeqInfo si = rwkv_info(cu);
    if (th * 32 >= si.ntok) return;
    const bf16_t* U = (const bf16_t*)(p->ws + WS_U);
    const size_t ub = (size_t)unit * 4096; const int t = th * 32 + li;
    const float* SC = (const float*)(p->ws + WS_SC) + ub; const float* ET = (const float*)(p->ws + WS_ET) + ub; const float* Y0T = (const float*)(p->ws + WS_Y0T) + ub;
    f32x16 acc[2];
#pragma unroll
    for (int ti = 0; ti < 2; ++ti)
#pragma unroll
        for (int rg = 0; rg < 4; ++rg) { const f32x4 y0 = *(const f32x4*)(Y0T + ((((th * 2 + ti) * 4 + rg) * 2 + hi) * 32 + li) * 4);
#pragma unroll
            for (int e = 0; e < 4; ++e) acc[ti][rg * 4 + e] = y0[e]; }
    f32x4 eb[8], sa0[8], sa1[8];
#pragma unroll
    for (int s4 = 0; s4 < 8; ++s4) { eb[s4] = *(const f32x4*)(ET + (((th * 2 + hi) * 8 + s4) * 32 + li) * 4); sa0[s4] = *(const f32x4*)(SC + (((0 * 2 + hi) * 8 + s4) * 32 + li) * 4); sa1[s4] = *(const f32x4*)(SC + (((1 * 2 + hi) * 8 + s4) * 32 + li) * 4); }
#pragma unroll
    for (int ks = 0; ks < 4; ++ks) {
        const bf16x8 bfr = pack8f(eb[2 * ks], eb[2 * ks + 1]);
        acc[0] = __builtin_amdgcn_mfma_f32_32x32x16_bf16(pack8f(sa0[2 * ks], sa0[2 * ks + 1]), bfr, acc[0], 0, 0, 0);
        acc[1] = __builtin_amdgcn_mfma_f32_32x32x16_bf16(pack8f(sa1[2 * ks], sa1[2 * ks + 1]), bfr, acc[1], 0, 0, 0);
    }
    float s1 = 0.f;
#pragma unroll
    for (int ti = 0; ti < 2; ++ti)
#pragma unroll
        for (int r = 0; r < 16; ++r) s1 += acc[ti][r];
    s1 = xhalf_sum(s1); const float mean = s1 * (1.f / 64.f);
    float s2 = 0.f;
#pragma unroll
    for (int ti = 0; ti < 2; ++ti)
#pragma unroll
        for (int r = 0; r < 16; ++r) { const float d = acc[ti][r] - mean; s2 += d * d; }
    s2 = xhalf_sum(s2); const float rstd = 1.f / sqrtf(s2 * (1.f / 64.f) + 64e-5f);
    LAS bf16_t* stg = (LAS bf16_t*)(lds + wave * (3 * 32 * 72 * 2));
    { const int tr = lane >> 3, c8 = (lane & 7) * 8;
#pragma unroll
      for (int i = 0; i < 4; ++i) { const int tt = 8 * i + tr, tg = th * 32 + tt, tc = tg < si.ntok ? tg : si.ntok - 1; const size_t rw = (size_t)(si.row0 + tc);
          const size_t rp = (tc > 0 || si.prev_kind == 1) ? rw - 1 : rw;
          const u32x4 a0 = *(const u32x4*)(U + rw * NU + U_XC + 1024 + h * 64 + c8), a1 = *(const u32x4*)(U + rp * NU + U_XC + 1024 + h * 64 + c8), a2 = *(const u32x4*)(U + rw * NU + U_CSG + h * 64 + c8);
          *(LAS u32x4*)(stg + tt * 72 + c8) = a0; *(LAS u32x4*)(stg + (32 + tt) * 72 + c8) = a1; *(LAS u32x4*)(stg + (64 + tt) * 72 + c8) = a2; } }
    if (t >= si.ntok) return;
    const float bon = ((const float*)(p->ws + WS_BONUS))[(size_t)unit * 64 + t];
    const size_t row = (size_t)(si.row0 + t);
    bf16_t* oc = (bf16_t*)(p->ws + WS_OCAT) + row * 2048 + 2 * 512 + h * 64;
    u32x2 wout[2][4];
    f32x4 ggv[2][4], gbv[2][4], muv[2][4];
#pragma unroll
    for (int ti = 0; ti < 2; ++ti)
#pragma unroll
        for (int rg = 0; rg < 4; ++rg) { const int c = h * 64 + 32 * ti + 8 * rg + 4 * hi; ggv[ti][rg] = *(const f32x4*)(p->in[I_GNG] + l * 512 + c); gbv[ti][rg] = *(const f32x4*)(p->in[I_GNB] + l * 512 + c); muv[ti][rg] = *(const f32x4*)(p->in[I_MU] + l * SHIFT_W + 1024 + c); }
    f32x4 ssv[2][4];
#pragma unroll
    for (int ti = 0; ti < 2; ++ti)
#pragma unroll
        for (int rg = 0; rg < 4; ++rg) ssv[ti][rg] = (f32x4){0.f, 0.f, 0.f, 0.f};
    if (si.prev_kind == 2 && th == 0) {
#pragma unroll
        for (int ti = 0; ti < 2; ++ti)
#pragma unroll
            for (int rg = 0; rg < 4; ++rg) ssv[ti][rg] = *(const f32x4*)(p->in[I_SSHIFT] + ((size_t)l * 32 + si.b) * SHIFT_W + 1024 + h * 64 + 32 * ti + 8 * rg + 4 * hi); }
#pragma unroll
    for (int ti = 0; ti < 2; ++ti)
#pragma unroll
        for (int rg = 0; rg < 4; ++rg) { const int i = 32 * ti + 8 * rg + 4 * hi, c = h * 64 + i;
            const f32x4 gg = ggv[ti][rg], gb = gbv[ti][rg], mu = muv[ti][rg]; (void)c;
            const u32x2 vx = *(const LAS u32x2*)(stg + li * 72 + i), px = *(const LAS u32x2*)(stg + (32 + li) * 72 + i), sg = *(const LAS u32x2*)(stg + (64 + li) * 72 + i);
            f32x4 vc = (f32x4){bflo(vx.x), bfhi(vx.x), bflo(vx.y), bfhi(vx.y)}, vp = (f32x4){bflo(px.x), bfhi(px.x), bflo(px.y), bfhi(px.y)};
            vp = (t == 0 && si.prev_kind != 1) ? ssv[ti][rg] : vp;
            const f32x4 vs = vc + (vp - vc) * mu;
            const f32x4 sgf = (f32x4){bflo(sg.x), bfhi(sg.x), bflo(sg.y), bfhi(sg.y)};
            f32x4 o;
#pragma unroll
            for (int e = 0; e < 4; ++e) o[e] = (((acc[ti][rg * 4 + e] - mean) * rstd) * gg[e] + gb[e] + bon * vs[e]) * siluf_(sgf[e]);
            wout[ti][rg].x = cvt_pk_bf16(o[0], o[1]); wout[ti][rg].y = cvt_pk_bf16(o[2], o[3]); }
#pragma unroll
    for (int ti = 0; ti < 2; ++ti)
#pragma unroll
        for (int rg = 0; rg < 4; ++rg) *(u32x2*)(oc + 32 * ti + 8 * rg + 4 * hi) = wout[ti][rg];
}
__device__ __forceinline__ int krow(int i) { return (i & 3) + 4 * ((i >> 3) & 1) + 8 * ((i >> 2) & 1) + 16 * (i >> 4); }
__device__ __forceinline__ bf16x8 pack8(const f32x16& v, int o) { u32x4 w; w.x = cvt_pk_bf16(v[o], v[o + 1]); w.y = cvt_pk_bf16(v[o + 2], v[o + 3]); w.z = cvt_pk_bf16(v[o + 4], v[o + 5]); w.w = cvt_pk_bf16(v[o + 6], v[o + 7]); return __builtin_bit_cast(bf16x8, w); }
constexpr float ATT_NEG = -1e30f;
template <bool HALF>
__device__ __forceinline__ void softmax_tile(f32x16& p0, f32x16& p1, float& m, float& lsum, f32x16 (&O)[2], bf16x8 (&pb)[4]) {
    float mx = p0[0];
#pragma unroll
    for (int r = 1; r < 16; ++r) mx = fmaxf(mx, p0[r]);
    if (!HALF) {
#pragma unroll
        for (int r = 0; r < 16; ++r) mx = fmaxf(mx, p1[r]); }
    mx = xhalf_max(mx);
    const float mn = fmaxf(m, mx), alpha = __builtin_amdgcn_exp2f(m - mn);
    m = mn;
    float s = 0.f;
#pragma unroll
    for (int r = 0; r < 16; ++r) { p0[r] = __builtin_amdgcn_exp2f(p0[r] - mn); s += p0[r]; }
    if (!HALF) {
#pragma unroll
        for (int r = 0; r < 16; ++r) { p1[r] = __builtin_amdgcn_exp2f(p1[r] - mn); s += p1[r]; } }
    lsum = lsum * alpha + s;
#pragma unroll
    for (int r = 0; r < 16; ++r) { O[0][r] *= alpha; O[1][r] *= alpha; }
    pb[0] = pack8(p0, 0); pb[1] = pack8(p0, 8);
    if (!HALF) { pb[2] = pack8(p1, 0); pb[3] = pack8(p1, 8); }
}
constexpr int AKS = 72;
constexpr int ATT_KB = 0, ATT_VB = 2 * 64 * AKS * 2, ATT_FB = 4 * 64 * AKS * 2, ATT_SC = ATT_FB + 2 * 64 * 4;
__device__ __forceinline__ void attn_prompt_unit(KP p, int l, int h, int qb, LAS unsigned char* lds, int tid) {
    const bf16_t* U = (const bf16_t*)(p->ws + WS_U); const bf16_t* Vt = (const bf16_t*)(p->ws + WS_VT) + (size_t)h * 64 * TP; const float* F = (const float*)(p->ws + WS_FP) + (size_t)h * TP;
    const int wave = tid >> 6, lane = tid & 63, li = lane & 31, hi = lane >> 5;
    const int q0 = qb * 256, q = q0 + wave * 32 + li;
    bf16x8 qf[4];
    { const float sc = 0.125f * LOG2E;
#pragma unroll
      for (int d0 = 0; d0 < 4; ++d0) { const u32x4 w = *(const u32x4*)(U + (size_t)q * NU + U_Q + h * 64 + 16 * d0 + 8 * hi);
          qf[d0] = pack8f((f32x4){bflo(w.x) * sc, bfhi(w.x) * sc, bflo(w.y) * sc, bfhi(w.y) * sc}, (f32x4){bflo(w.z) * sc, bfhi(w.z) * sc, bflo(w.w) * sc, bfhi(w.w) * sc}); } }
    const float fq = F[q];
    float m = ATT_NEG, lsum = 0.f; f32x16 O[2] = {};
    const int NT = (q0 + 256) / 64;
    LAS float* qmx = (LAS float*)(lds + ATT_SC); LAS float* mmv = qmx + 8;
    { float q2 = 0.f;
#pragma unroll
      for (int d0 = 0; d0 < 4; ++d0) { const u32x4 w = __builtin_bit_cast(u32x4, qf[d0]); q2 += bflo(w.x) * bflo(w.x) + bfhi(w.x) * bfhi(w.x) + bflo(w.y) * bflo(w.y) + bfhi(w.y) * bfhi(w.y) + bflo(w.z) * bflo(w.z) + bfhi(w.z) * bfhi(w.z) + bflo(w.w) * bflo(w.w) + bfhi(w.w) * bfhi(w.w); }
      q2 = wave_max(xhalf_sum(q2)); if (lane == 0) { qmx[wave] = q2; mmv[wave] = ATT_NEG; } }
    const float kmax2 = __uint_as_float(((const unsigned*)(p->ws + WS_CTL))[CW_KMAX + l * 8 + h]), fq0 = F[q0];
    const int srow = tid >> 3, sch = tid & 7;
    const bf16_t* kg = U + (size_t)srow * NU + U_K + h * 64 + 8 * sch; const bf16_t* vg = Vt + (size_t)srow * TP + 8 * sch;
    LAS unsigned char* kdst = lds + ATT_KB + (srow * AKS + 8 * sch) * 2; LAS unsigned char* vdst = lds + ATT_VB + (srow * AKS + 8 * sch) * 2;
    u32x4 kr = *(const u32x4*)(kg + (size_t)(NT - 1) * 64 * NU), vr = *(const u32x4*)(vg + (NT - 1) * 64); float fr = tid < 64 ? F[(NT - 1) * 64 + tid] : 0.f;
    *(LAS u32x4*)kdst = kr; *(LAS u32x4*)vdst = vr; if (tid < 64) ((LAS float*)(lds + ATT_FB))[tid] = fr;
    __syncthreads();
    const int ka = krow(li);
    float qkb; { float q2 = qmx[0];
#pragma unroll
      for (int w = 1; w < 8; ++w) q2 = fmaxf(q2, qmx[w]);
      qkb = 1.02f * sqrtf(q2 * kmax2) + fq0; }
    for (int t = NT - 1, buf = 0; t >= 0; --t, buf ^= 1) {
        { float mmin = mmv[0];
#pragma unroll
          for (int w = 1; w < 8; ++w) mmin = fminf(mmin, mmv[w]);
          if (qkb - ((const LAS float*)(lds + ATT_FB))[buf * 64 + 63] < mmin - 40.f) break; }
        if (t > 0) { kr = *(const u32x4*)(kg + (size_t)(t - 1) * 64 * NU); vr = *(const u32x4*)(vg + (t - 1) * 64); if (tid < 64) fr = F[(t - 1) * 64 + tid]; }
        if (64 * t <= q0 + wave * 32 + 31) {
            const LAS bf16_t* Kb = (const LAS bf16_t*)(lds + ATT_KB) + buf * 64 * AKS; const LAS bf16_t* Vb = (const LAS bf16_t*)(lds + ATT_VB) + buf * 64 * AKS; const LAS float* Fb = (const LAS float*)(lds + ATT_FB) + buf * 64;
            f32x16 p0, p1;
#pragma unroll
            for (int g2 = 0; g2 < 2; ++g2) { const f32x4 a = *(const LAS f32x4*)(Fb + 8 * hi + 16 * g2), b = *(const LAS f32x4*)(Fb + 8 * hi + 16 * g2 + 4), c = *(const LAS f32x4*)(Fb + 32 + 8 * hi + 16 * g2), d = *(const LAS f32x4*)(Fb + 32 + 8 * hi + 16 * g2 + 4);
#pragma unroll
                for (int e = 0; e < 4; ++e) { p0[8 * g2 + e] = fq - a[e]; p0[8 * g2 + 4 + e] = fq - b[e]; p1[8 * g2 + e] = fq - c[e]; p1[8 * g2 + 4 + e] = fq - d[e]; } }
#pragma unroll
            for (int d0 = 0; d0 < 4; ++d0) { const bf16x8 a0 = *(const LAS bf16x8*)(Kb + ka * AKS + 16 * d0 + 8 * hi), a1 = *(const LAS bf16x8*)(Kb + (ka + 32) * AKS + 16 * d0 + 8 * hi);
                p0 = __builtin_amdgcn_mfma_f32_32x32x16_bf16(a0, qf[d0], p0, 0, 0, 0); p1 = __builtin_amdgcn_mfma_f32_32x32x16_bf16(a1, qf[d0], p1, 0, 0, 0); }
            if (64 * t + 63 > q0 + wave * 32) {
#pragma unroll
                for (int r = 0; r < 16; ++r) { const int kv = 64 * t + 8 * hi + 16 * (r >> 3) + (r & 7); if (kv > q) p0[r] = -INFINITY; if (kv + 32 > q) p1[r] = -INFINITY; } }
            bf16x8 pb[4];
            softmax_tile<false>(p0, p1, m, lsum, O, pb);
#pragma unroll
            for (int dt = 0; dt < 2; ++dt)
#pragma unroll
                for (int s = 0; s < 4; ++s) { const bf16x8 a = *(const LAS bf16x8*)(Vb + (32 * dt + li) * AKS + 16 * (s & 1) + 32 * (s >> 1) + 8 * hi);
                    O[dt] = __builtin_amdgcn_mfma_f32_32x32x16_bf16(a, pb[s], O[dt], 0, 0, 0); }
        }
        { const float wm = wave_min(m); if (lane == 0) mmv[wave] = wm; }
        if (t > 0) { const int nb = buf ^ 1; *(LAS u32x4*)(kdst + nb * 64 * AKS * 2) = kr; *(LAS u32x4*)(vdst + nb * 64 * AKS * 2) = vr; if (tid < 64) ((LAS float*)(lds + ATT_FB))[nb * 64 + tid] = fr; }
        __syncthreads();
    }
    __syncthreads();
    const float inv = 1.f / xhalf_sum(lsum);
    bf16_t* ob = (bf16_t*)(p->ws + WS_OCAT) + (size_t)q * 2048 + 512 + h * 64;
    u32x2 sgv[2][4];
#pragma unroll
    for (int dt = 0; dt < 2; ++dt)
#pragma unroll
        for (int rg = 0; rg < 4; ++rg) sgv[dt][rg] = *(const u32x2*)(U + (size_t)q * NU + U_BSG + h * 64 + 32 * dt + 8 * rg + 4 * hi);
#pragma unroll
    for (int dt = 0; dt < 2; ++dt)
#pragma unroll
        for (int rg = 0; rg < 4; ++rg) { const int d = 32 * dt + 8 * rg + 4 * hi; const u32x2 sg = sgv[dt][rg];
            u32x2 w; w.x = cvt_pk_bf16(O[dt][rg * 4] * inv * siluf_(bflo(sg.x)), O[dt][rg * 4 + 1] * inv * siluf_(bfhi(sg.x))); w.y = cvt_pk_bf16(O[dt][rg * 4 + 2] * inv * siluf_(bflo(sg.y)), O[dt][rg * 4 + 3] * inv * siluf_(bfhi(sg.y)));
            *(u32x2*)(ob + d) = w; }
}
__device__ __forceinline__ void attn_sample_unit(KP p, int l, int b, int h, LAS unsigned char* lds, int tid) {
    const bf16_t* U = (const bf16_t*)(p->ws + WS_U);
    const int wave = tid >> 6, lane = tid & 63, li = lane & 31, hi = lane >> 5;
    const size_t qrow = (size_t)TP + b * 32 + li;
    const float* G = (const float*)(p->ws + WS_GS) + ((size_t)b * 8 + h) * GS_LEN;
    bf16x8 qf[4];
    { const float sc = 0.125f * LOG2E;
#pragma unroll
      for (int d0 = 0; d0 < 4; ++d0) { const u32x4 w = *(const u32x4*)(U + qrow * NU + U_Q + h * 64 + 16 * d0 + 8 * hi);
          qf[d0] = pack8f((f32x4){bflo(w.x) * sc, bfhi(w.x) * sc, bflo(w.y) * sc, bfhi(w.y) * sc}, (f32x4){bflo(w.z) * sc, bfhi(w.z) * sc, bflo(w.w) * sc, bfhi(w.w) * sc}); } }
    const float fq = G[PAST + li];
    float m = ATT_NEG, lsum = 0.f; f32x16 O[2] = {};
    const float* CK = p->in[I_CK] + (((size_t)l * 32 + b) * PAST) * 512 + h * 64; const float* CV = p->in[I_CV] + (((size_t)l * 32 + b) * PAST) * 512 + h * 64;
    const int ka = krow(li);
    float kmax2;
    { float mx = 0.f; const f32x4* kp4 = (const f32x4*)CK + (tid & 15);
#pragma unroll 1
      for (int it = 0; it < 8; ++it) { f32x4 kv[16];
#pragma unroll
          for (int j = 0; j < 16; ++j) kv[j] = kp4[(size_t)((it * 16 + j) * 32 + (tid >> 4)) * 128];
#pragma unroll
          for (int j = 0; j < 16; ++j) { float s = kv[j][0] * kv[j][0] + kv[j][1] * kv[j][1] + kv[j][2] * kv[j][2] + kv[j][3] * kv[j][3];
              s += dpp_mov<0xB1>(s); s += dpp_mov<0x4E>(s); s += dpp_mov<0x141>(s); s += dpp_mov<0x140>(s); mx = fmaxf(mx, s); } }
      mx = wave_max(mx); LAS float* kml = (LAS float*)lds;
      if (lane == 0) kml[wave] = mx;
      __syncthreads();
      kmax2 = kml[0];
#pragma unroll
      for (int w = 1; w < 8; ++w) kmax2 = fmaxf(kmax2, kml[w]);
      __syncthreads(); }
    float qkb;
    { float q2 = 0.f;
#pragma unroll
      for (int d0 = 0; d0 < 4; ++d0) { const u32x4 w = __builtin_bit_cast(u32x4, qf[d0]); q2 += bflo(w.x) * bflo(w.x) + bfhi(w.x) * bfhi(w.x) + bflo(w.y) * bflo(w.y) + bfhi(w.y) * bfhi(w.y) + bflo(w.z) * bflo(w.z) + bfhi(w.z) * bfhi(w.z) + bflo(w.w) * bflo(w.w) + bfhi(w.w) * bfhi(w.w); }
      q2 = wave_max(xhalf_sum(q2)); qkb = 1.02f * sqrtf(q2 * kmax2) + G[PAST]; }
    {
        f32x16 p0, p1 = {};
#pragma unroll
        for (int g2 = 0; g2 < 2; ++g2) { const float* gp = G + PAST + 8 * hi + 16 * g2; const f32x4 a = *(const f32x4*)gp, bq = *(const f32x4*)(gp + 4);
#pragma unroll
            for (int e = 0; e < 4; ++e) { p0[8 * g2 + e] = fq - a[e]; p0[8 * g2 + 4 + e] = fq - bq[e]; } }
#pragma unroll
        for (int d0 = 0; d0 < 4; ++d0) { const bf16x8 a0 = *(const bf16x8*)(U + ((size_t)TP + b * 32 + ka) * NU + U_K + h * 64 + 16 * d0 + 8 * hi);
            p0 = __builtin_amdgcn_mfma_f32_32x32x16_bf16(a0, qf[d0], p0, 0, 0, 0); }
#pragma unroll
        for (int r = 0; r < 16; ++r) { const int kv = 8 * hi + 16 * (r >> 3) + (r & 7); if (kv > li) p0[r] = -INFINITY; }
        bf16x8 pb[4];
        softmax_tile<true>(p0, p1, m, lsum, O, pb);
        if (wave == 7) {
#pragma unroll
            for (int dt = 0; dt < 2; ++dt)
#pragma unroll
                for (int s = 0; s < 2; ++s) { const bf16_t* vp = U + ((size_t)TP + b * 32 + 16 * s + 8 * hi) * NU + U_V + h * 64 + 32 * dt + li; u32x4 w;
                    w.x = (unsigned)vp[0] | ((unsigned)vp[NU] << 16); w.y = (unsigned)vp[2 * NU] | ((unsigned)vp[3 * NU] << 16); w.z = (unsigned)vp[4 * NU] | ((unsigned)vp[5 * NU] << 16); w.w = (unsigned)vp[6 * NU] | ((unsigned)vp[7 * NU] << 16);
                    O[dt] = __builtin_amdgcn_mfma_f32_32x32x16_bf16(__builtin_bit_cast(bf16x8, w), pb[s], O[dt], 0, 0, 0); } }
        else lsum = 0.f;
    }
    const float mmin = wave_min(m);
    for (int tt = 0; tt < 8; ++tt) {
        const int key0 = (63 - wave - 8 * tt) * 64;
        if (qkb - G[key0 + 63] < mmin - 40.f) break;
        f32x16 p0, p1;
#pragma unroll
        for (int g2 = 0; g2 < 2; ++g2) { const float* gp = G + key0 + 8 * hi + 16 * g2; const f32x4 a = *(const f32x4*)gp, bq = *(const f32x4*)(gp + 4), c = *(const f32x4*)(gp + 32), d = *(const f32x4*)(gp + 36);
#pragma unroll
            for (int e = 0; e < 4; ++e) { p0[8 * g2 + e] = fq - a[e]; p0[8 * g2 + 4 + e] = fq - bq[e]; p1[8 * g2 + e] = fq - c[e]; p1[8 * g2 + 4 + e] = fq - d[e]; } }
#pragma unroll
        for (int d0 = 0; d0 < 4; ++d0) { const float* k0p = CK + (size_t)(key0 + ka) * 512 + 16 * d0 + 8 * hi; const float* k1p = k0p + (size_t)32 * 512;
            const bf16x8 a0 = pack8f(*(const f32x4*)k0p, *(const f32x4*)(k0p + 4)), a1 = pack8f(*(const f32x4*)k1p, *(const f32x4*)(k1p + 4));
            p0 = __builtin_amdgcn_mfma_f32_32x32x16_bf16(a0, qf[d0], p0, 0, 0, 0); p1 = __builtin_amdgcn_mfma_f32_32x32x16_bf16(a1, qf[d0], p1, 0, 0, 0); }
        bf16x8 pb[4];
        softmax_tile<false>(p0, p1, m, lsum, O, pb);
#pragma unroll
        for (int dt = 0; dt < 2; ++dt)
#pragma unroll
            for (int s = 0; s < 4; ++s) { const float* vp = CV + (size_t)(key0 + 16 * (s & 1) + 32 * (s >> 1) + 8 * hi) * 512 + 32 * dt + li;
                const bf16x8 a = pack8f((f32x4){vp[0], vp[512], vp[1024], vp[1536]}, (f32x4){vp[2048], vp[2560], vp[3072], vp[3584]});
                O[dt] = __builtin_amdgcn_mfma_f32_32x32x16_bf16(a, pb[s], O[dt], 0, 0, 0); }
    }
    LAS float* Ow = (LAS float*)lds;
    LAS float* ML = Ow + 8 * 32 * 64;
    lsum = xhalf_sum(lsum);
#pragma unroll
    for (int dt = 0; dt < 2; ++dt)
#pragma unroll
        for (int r = 0; r < 16; ++r) Ow[(wave * 32 + dt * 16 + r) * 64 + lane] = O[dt][r];
    if (hi == 0) { ML[(wave * 2) * 32 + li] = m; ML[(wave * 2 + 1) * 32 + li] = lsum; }
    __syncthreads();
    { const int qq = tid & 31, dg = tid >> 5; float M = ATT_NEG;
#pragma unroll
      for (int w = 0; w < 8; ++w) M = fmaxf(M, ML[(w * 2) * 32 + qq]);
      float L = 0.f; f32x4 o = {0.f, 0.f, 0.f, 0.f};
      const int d = 4 * dg, idx0 = (d >> 5) * 16 + ((d >> 3) & 3) * 4, ln = ((d >> 2) & 1) * 32 + qq;
#pragma unroll
      for (int w = 0; w < 8; ++w) { const float f = __builtin_amdgcn_exp2f(ML[(w * 2) * 32 + qq] - M); L += ML[(w * 2 + 1) * 32 + qq] * f;
#pragma unroll
          for (int e = 0; e < 4; ++e) o[e] += Ow[(w * 32 + idx0 + e) * 64 + ln] * f; }
      const float inv = 1.f / L; const size_t row = (size_t)TP + b * 32 + qq;
      const u32x2 sg = *(const u32x2*)(U + row * NU + U_BSG + h * 64 + d);
      u32x2 wv; wv.x = cvt_pk_bf16(o[0] * inv * siluf_(bflo(sg.x)), o[1] * inv * siluf_(bfhi(sg.x))); wv.y = cvt_pk_bf16(o[2] * inv * siluf_(bflo(sg.y)), o[3] * inv * siluf_(bfhi(sg.y)));
      *(u32x2*)((bf16_t*)(p->ws + WS_OCAT) + row * 2048 + 512 + h * 64 + d) = wv; }
    __syncthreads();
}
__device__ __forceinline__ bool xb_lane0() { unsigned ones_ = ~0u; asm volatile("" : "+s"(ones_)); return __builtin_amdgcn_mbcnt_hi(ones_, __builtin_amdgcn_mbcnt_lo(ones_, 0u)) == 0u; }
constexpr int NPHASE = 18;
__global__ void __launch_bounds__(512, 2) hse_fwd(Params p_) {
    const KP kp = (KP)__builtin_amdgcn_kernarg_segment_ptr();
    (void)p_;
    extern __shared__ __attribute__((aligned(16))) unsigned char lds_raw[];
    LAS unsigned char* lds = (LAS unsigned char*)lds_raw;
    const int tid0 = threadIdx.x;
    const int wave0 = __builtin_amdgcn_readfirstlane(tid0 >> 6);
    const int G = gridDim.x, bid = blockIdx.x, ngw = G * 8;
#define PH_LOCALS const KP p = kp_fresh(kp); unsigned ones_ = ~0u; asm volatile("" : "+s"(ones_)); int tid = wave0 * 64 + (int)__builtin_amdgcn_mbcnt_hi(ones_, __builtin_amdgcn_mbcnt_lo(ones_, 0u)); asm volatile("" : "+v"(tid)); const int lane = tid & 63, wave = __builtin_amdgcn_readfirstlane(tid >> 6), gw = bid * 8 + wave; (void)lane; (void)gw; (void)p;
    if (tid0 < 4) ((LAS unsigned*)(lds + LDS_XB_OFF))[tid0] = 0u;
#if PROBE_ID
    if (tid0 == 0) *(LAS unsigned long long*)(lds + LDS_PROBE_OFF) = 0ull;
#endif
    __syncthreads();
    unsigned* ctl = (unsigned*)(kp->ws + WS_CTL);
    XcdBarrier bar = xcd_barrier_post(ctl + CW_BAR + kp->li * XCD_BAR_WORDS, (volatile LAS unsigned*)(lds + LDS_XB_OFF));
    const int lo = kp->ph_lo, hi = kp->ph_hi;
#define IN(k) (lo <= (k) && (k) < hi)
#ifndef DUP_MASK
#define DUP_MASK 0
#endif
#define NREP(k) (((DUP_MASK >> (k)) & 1) + 1)
#define XB_T0 (wave0 == 0 && xb_lane0())
#define SEAM(k) do { if (IN(k) && IN((k) + 1)) xcd_barrier(bar, XB_T0); } while (0)
    PT0();
    if (IN(0)) { PH_LOCALS
        { PT0(); for (int u = bid; u < 192; u += G) ada_unit(p, u, lds, tid);
        PT1(60);
        p0_weights(p, lds, gw, ngw, wave, lane);
        PT1(61); }
    }
    SEAM(0);
    PT1(9);
    for (int l = 0; l < NLAYER; ++l) {
        const int pb = 1 + 8 * l;
        for (int rep = 0; rep < NREP(0); ++rep) { if (rep) xcd_barrier(bar, XB_T0);
        if (IN(pb)) { PH_LOCALS p1_rows(p, l, gw, ngw, lane); } }
        SEAM(pb);
        PT1(10);
        for (int rep = 0; rep < NREP(1); ++rep) { if (rep) xcd_barrier(bar, XB_T0);
        if (IN(pb + 1)) { PH_LOCALS
            pg8::Gemm g{(const bf16_t*)(p->ws + WS_H), (const bf16_t*)(p->ws + WS_WIN) + (size_t)l * NU * LDH, NTOK, NU, 2048, LDH};
            pg8::StaticOrder S; S.init(NTOK, NU, G, bid);
            EpiU E{(bf16_t*)(p->ws + WS_U), p->out, p->in[I_BF], l};
            pg8::gemm_phase<EpiU, pg8::StaticOrder>(lds, g, S, E, nullptr, tid);
        }
        }
        SEAM(pb + 1);
        PT1(11);
        for (int rep = 0; rep < NREP(2); ++rep) { if (rep) xcd_barrier(bar, XB_T0);
        if (IN(pb + 2)) { PH_LOCALS
#ifndef DUP_SUB
#define DUP_SUB 0
#endif
#define P3A_LIGHT() do { \
            for (int u = (bid + G - 32) % G; u < 544; u += G) conv_unit(p, l, u, lds, tid);       \
            for (int u = (bid + G - 64) % G; u < 544; u += G) pool_unit(p, l, u, lds, tid);       \
            for (int u = bid; u < 256; u += G) { vt_tile(p, l, u * 8 + wave, lds, wave, lane); } \
            __syncthreads(); \
            for (int u = (bid + G - 96) % G; u < 32; u += G) gs_unit(p, l, u, lds, tid);          \
            for (int u = G - 1 - bid; u < 8; u += G) fp_unit(p, l, u, lds, tid); \
            if (bid == G / 2) shift_out(p, l, tid); } while (0)
            if (((bid >> 3) & 1) == 1) { PH_LOCALS P3A_LIGHT(); __syncthreads(); }
            { PH_LOCALS for (int u = bid; u < NRU; u += G) rwkv_r1(p, l, u, u + G, u == bid || (G & 7) != 0, lds, tid); }
            if (((bid >> 3) & 1) == 0) { PH_LOCALS __syncthreads(); P3A_LIGHT(); }
#undef P3A_LIGHT
        }
        }
        SEAM(pb + 2);
        PT1(12);
        for (int rep = 0; rep < NREP(3); ++rep) { if (rep) xcd_barrier(bar, XB_T0);
        if (IN(pb + 3)) { PH_LOCALS
            PT0();
            for (int tk = bid; tk < 256; tk += G) rwkv_l1_block(p, tk, lds, wave, lane);
            PT1(70);
            LAS int* qslot = (LAS int*)(lds + LDS_XB_OFF - 16);
            for (;;) {
                if (tid == 0) *qslot = (int)atomicAdd(ctl + CW_QUEUE + 64 * (2 * l + 4 * rep), 1u);
                __syncthreads();
                const int item = *qslot;
                __syncthreads();
                if (item >= 512) break;
                attn_prompt_unit(p, l, item & 7, 63 - (item >> 3), lds, tid);
            }
            PT1(71);
            for (;;) {
                if (tid == 0) *qslot = (int)atomicAdd(ctl + CW_QUEUE + 64 * (2 * l + 1 + 4 * rep), 1u);
                __syncthreads();
                const int item = *qslot;
                __syncthreads();
                if (item >= 256) break;
                attn_sample_unit(p, l, item >> 3, item & 7, lds, tid);
            }
            PT1(72);
        }
        }
        SEAM(pb + 3);
        PT1(13);
        if (IN(pb + 4)) { PH_LOCALS
            for (int tk = bid; tk < 128; tk += G) rwkv_l3_block(p, l, 127 - tk, lds, wave, lane);
            for (int tk = ((bid + G - 128) % G) * 8 + wave; tk < 1024; tk += ngw) rwkv_samp_task(p, l, tk, lane);
        }
        SEAM(pb + 4);
        PT1(14);
        if (IN(pb + 5)) { PH_LOCALS
            for (int tk = gw; tk < 4096; tk += ngw) rwkv_r3_task(p, l, tk, lds, wave, lane);
            if (wave == 0) for (int s = bid; s < 256; s += G) rwkv_r3_task(p, l, 4096 + 2 * s, lds, wave, lane);
        }
        SEAM(pb + 5);
        PT1(15);
        for (int rep = 0; rep < NREP(6); ++rep) { if (rep) xcd_barrier(bar, XB_T0);
        if (IN(pb + 6)) { PH_LOCALS
            pg8::Gemm g{(const bf16_t*)(p->ws + WS_OCAT), (const bf16_t*)(p->ws + WS_WBR) + (size_t)l * 2048 * 2048, NTOK, 2048, 2048, 2048};
            {
                const int su = (bid >> 4) * 8 + (bid & 7), tile = su >> 2, n = su & 3;
                pg8::Gemm gs{g.A + n * 512, g.Bt + n * 512, NTOK, 2048, 512, 2048};
                OneUnit S{64 + (tile >> 3), tile & 7, ((bid >> 3) & 1) == 1 && su < 128};
                EpiGateZ E{(bf16_t*)(p->ws + WS_Z) + (size_t)n * 1024 * 2048, (const bf16_t*)(p->ws + WS_U), n};
                pg8::gemm_phase<EpiGateZ, OneUnit>(lds, gs, S, E, nullptr, tid); }
            {
                pg8::StaticOrder S; S.init(TP, 2048, G, bid);
                EpiMerge E{(bf16_t*)(p->ws + WS_MERGED), (const bf16_t*)(p->ws + WS_U)};
                pg8::gemm_phase<EpiMerge, pg8::StaticOrder>(lds, g, S, E, nullptr, tid); }
        }
        }
        SEAM(pb + 6);
        PT1(16);
        if (IN(pb + 7)) { PH_LOCALS
            {
                const int tile = bid >> 3, ks = bid & 7;
                pg8::Gemm g{(const bf16_t*)(p->ws + WS_Z) + (size_t)(ks >> 1) * 1024 * 2048 - (size_t)TP * 2048 + (ks & 1) * 1024, (const bf16_t*)(p->ws + WS_WOUT) + (size_t)l * 2048 * LDH + (ks & 1) * 1024, NTOK, 2048, 1024, LDH};
                OneUnit S{64 + (tile >> 3), tile & 7, bid < 256 && ((bid >> 3) & 1) == 1};
                EpiOutPart E{(const float*)(p->ws + WS_ADA), (bf16_t*)(p->ws + WS_XPART) + ((size_t)(l * 8 + ks) * 1024) * DM, l};
                pg8::gemm_phase<EpiOutPart, OneUnit>(lds, g, S, E, nullptr, tid); }
            {
                pg8::Gemm g{(const bf16_t*)(p->ws + WS_MERGED), (const bf16_t*)(p->ws + WS_WOUT) + (size_t)l * 2048 * LDH, TP, 2048, 2048, LDH};
                pg8::StaticOrder S; S.init(TP, 2048, G, bid);
                EpiOut E{p->in[I_XP], (const float*)(p->ws + WS_ADA), (bf16_t*)(p->ws + WS_XBUF), l};
                pg8::gemm_phase<EpiOut, pg8::StaticOrder>(lds, g, S, E, nullptr, tid); }
            {
                const int tile = bid >> 3, ks = bid & 7;
                pg8::Gemm g{(const bf16_t*)(p->ws + WS_Z) + (size_t)(ks >> 1) * 1024 * 2048 - (size_t)TP * 2048 + (ks & 1) * 1024, (const bf16_t*)(p->ws + WS_WOUT) + (size_t)l * 2048 * LDH + (ks & 1) * 1024, NTOK, 2048, 1024, LDH};
                OneUnit S{64 + (tile >> 3), tile & 7, bid < 256 && ((bid >> 3) & 1) == 0};
                EpiOutPart E{(const float*)(p->ws + WS_ADA), (bf16_t*)(p->ws + WS_XPART) + ((size_t)(l * 8 + ks) * 1024) * DM, l};
                pg8::gemm_phase<EpiOutPart, OneUnit>(lds, g, S, E, nullptr, tid); }
        }
        SEAM(pb + 7);
        PT1(18);
    }
    if (IN(17)) { PH_LOCALS p_final_rows(p, gw, ngw, lane); }
    PT1(20);
#if PROBE_ID
    if (bid == 0 && tid0 == 0) { const unsigned long long w = *(LAS unsigned long long*)(lds + LDS_PROBE_OFF) * PROBE_K, t0 = __builtin_amdgcn_s_memrealtime(); while (__builtin_amdgcn_s_memrealtime() - t0 < w) __builtin_amdgcn_s_sleep(8); }
#endif
#undef IN
#undef SEAM
}
#ifndef MK_SPLIT
#define MK_SPLIT 0
#endif
extern "C" void kernel_launch(void* const* d_in, const int* in_sizes, int n_in, void* d_out, int out_size, void* d_ws, size_t ws_size, hipStream_t stream) {
    static int grid = 0;
    if (grid == 0) {
        if (n_in != N_IN || (size_t)out_size != O_END || ws_size < WS_END) { fprintf(stderr, "kernel_launch: unexpected shapes (n_in %d, out %d, ws %zu)\n", n_in, out_size, ws_size); grid = -1; return; }
        int dev = 0, cus = 0, per_cu = 0;
        if (hipGetDevice(&dev) != hipSuccess || hipDeviceGetAttribute(&cus, hipDeviceAttributeMultiprocessorCount, dev) != hipSuccess) { grid = -1; return; }
        if (hipFuncSetAttribute((const void*)hse_fwd, hipFuncAttributeMaxDynamicSharedMemorySize, LDS_BYTES) != hipSuccess) { fprintf(stderr, "kernel_launch: hipFuncSetAttribute failed\n"); grid = -1; return; }
        if (hipOccupancyMaxActiveBlocksPerMultiprocessor(&per_cu, (const void*)hse_fwd, 512, LDS_BYTES) != hipSuccess || per_cu < 1) fprintf(stderr, "kernel_launch: occupancy query reports %d\n", per_cu);
        (void)hipGetLastError();
        grid = cus;
    }
    if (grid < 0) return;
    if (hipMemsetAsync((char*)d_ws + WS_CTL, 0, CTL_BYTES, stream) != hipSuccess) return;
    Params a{};
    for (int i = 0; i < N_IN; ++i) a.in[i] = (const float*)d_in[i];
    a.out = (float*)d_out; a.ws = (unsigned char*)d_ws;
#if MK_SPLIT
    for (int ph = 0; ph < NPHASE; ++ph) { a.ph_lo = ph; a.ph_hi = ph + 1; a.li = ph; hipLaunchKernelGGL(hse_fwd, dim3(grid), dim3(512), LDS_BYTES, stream, a); }
#else
    a.ph_lo = 0; a.ph_hi = NPHASE; a.li = 0;
    hipLaunchKernelGGL(hse_fwd, dim3(grid), dim3(512), LDS_BYTES, stream, a);
#endif
    const hipError_t le = hipPeekAtLastError();
    if (le != hipSuccess) fprintf(stderr, "kernel_launch: launch failed: %s\n", hipGetErrorName(le));
}
```
